# Optimizing an MI355X kernel written in HIP

```python
import math
import jax
import jax.numpy as jnp
from jax import lax
import numpy as np

D_MODEL = 1024
BATCH = 4
SEQ = 4096
DEPTH = 2

GRID_W = 64
CTX_LEN = 256

A_HEADS = 8
A_HEAD_DIM = 64
A_W = A_HEADS * A_HEAD_DIM
A_DECAY_RANK = 64
A_ICL_RANK = 64
A_GATE_RANK = 128
A_IN = 3 * A_W + 2 * A_DECAY_RANK + 2 * A_ICL_RANK + A_GATE_RANK
A_DECAY_SCALE = math.exp(-0.5)
GN_EPS_RWKV = 64e-5
B_W = 512
B_BLOCKS = 8
B_BLOCK = B_W // B_BLOCKS
B_CONV = 4
B_C = 8.0
B_IN = 2 * B_W
C_HEADS = 4
C_HEAD_DIM = 128
C_W = C_HEADS * C_HEAD_DIM
C_IN = 4 * C_W
ROPE_BASE = 10000.0
D_HEADS = 4
D_HEAD_DIM = 128
D_W = D_HEADS * D_HEAD_DIM
D_IN = 4 * D_W + 4 * D_HEADS
CHUNK = 128
EVEN_IN = A_IN + B_IN
ODD_IN = C_IN + D_IN
MIX_W = A_W + B_W
N_EXPERTS = 32
TOP_K = 4
D_FF = 1024
SWIGLU_ALPHA = 1.702
SWIGLU_LIMIT = 7.0
DN_ALPHA = (2 * DEPTH) ** 0.25
DN_BETA = (8 * DEPTH) ** -0.25
LN_EPS = 1e-5
N_MOD = 6
N_EVEN = (DEPTH + 1) // 2
N_ODD = DEPTH // 2

kernel_name = 'hybrid_rwkv7_rglru_retention_mlstm_moe_dit'


def _flip(t):
    return t[:, ::-1]


def _ident(t):
    return t


def _heads(t, n):
    return t.reshape(t.shape[:-1] + (n, t.shape[-1] // n))


def layer_norm(x, g, b):
    xf = x.astype(jnp.float32)
    mu = jnp.mean(xf, -1, keepdims=True)
    var = jnp.mean(jnp.square(xf - mu), -1, keepdims=True)
    return ((xf - mu) * lax.rsqrt(var + LN_EPS) * g + b).astype(x.dtype)


def group_norm(x, g, b, n_groups, eps):
    xf = _heads(x.astype(jnp.float32), n_groups)
    mu = jnp.mean(xf, -1, keepdims=True)
    var = jnp.mean(jnp.square(xf - mu), -1, keepdims=True)
    return ((xf - mu) * lax.rsqrt(var + eps)).reshape(x.shape) * g + b


def grid_qshift(z):
    bz, t, w = z.shape
    rows = t // GRID_W
    g = z.reshape(bz, rows, GRID_W, w // 4, 4)
    left = jnp.pad(g[:, :, :-1, :, 0], ((0, 0), (0, 0), (1, 0), (0, 0)))
    right = jnp.pad(g[:, :, 1:, :, 1], ((0, 0), (0, 0), (0, 1), (0, 0)))
    up = jnp.pad(g[:, :-1, :, :, 2], ((0, 0), (1, 0), (0, 0), (0, 0)))
    down = jnp.pad(g[:, 1:, :, :, 3], ((0, 0), (0, 1), (0, 0), (0, 0)))
    return jnp.stack([left, right, up, down], -1).reshape(bz, t, w)


def bidir_shift(z):
    bz, t, w = z.shape
    g = z.reshape(bz, t, w // 2, 2)
    prev = jnp.pad(g[:, :-1, :, 0], ((0, 0), (1, 0), (0, 0)))
    nxt = jnp.pad(g[:, 1:, :, 1], ((0, 0), (0, 1), (0, 0)))
    return jnp.stack([prev, nxt], -1).reshape(bz, t, w)


def axial_rope(t):
    n_tok, dh = t.shape[1], t.shape[-1]
    idx = jnp.arange(n_tok)
    row = (idx // GRID_W).astype(jnp.float32)
    col = (idx % GRID_W).astype(jnp.float32)
    n_freq = dh // 4
    inv = ROPE_BASE ** (-jnp.arange(n_freq, dtype=jnp.float32) / n_freq)
    ang = jnp.concatenate([row[:, None] * inv, col[:, None] * inv], -1)[None, :, None, :]
    cos, sin = jnp.cos(ang), jnp.sin(ang)
    t1, t2 = t[..., : dh // 2], t[..., dh // 2:]
    return jnp.concatenate([t1 * cos - t2 * sin, t1 * sin + t2 * cos], -1)


def centred_depthwise_conv(u, w, bias):
    y = lax.conv_general_dilated(
        u, w[:, None, :].astype(u.dtype), window_strides=(1,),
        padding=[(B_CONV // 2, B_CONV - 1 - B_CONV // 2)],
        dimension_numbers=('NWC', 'WIO', 'NWC'), feature_group_count=u.shape[-1])
    return y + bias


def _lin_comb(left, right):
    al, bl = left
    ar, br = right
    return al * ar, ar * bl + br


def linear_recurrence(a, b, h0):
    b = b.at[:, 0].add(a[:, 0] * h0)
    _, h = lax.associative_scan(_lin_comb, (a, b), axis=1)
    return h, h[:, -1]


def rwkv7_scan(s0, r, w, k, v, kk, a):
    xs = tuple(jnp.moveaxis(t, 1, 0) for t in (r, w, k, v, kk, a))

    def step(s, inp):
        r_t, w_t, k_t, v_t, kk_t, a_t = inp
        s_kk = jnp.einsum('bhvk,bhk->bhv', s, kk_t)
        s = (s * w_t[:, :, None, :] - s_kk[..., None] * (kk_t * a_t)[:, :, None, :]
             + v_t[..., None] * k_t[:, :, None, :])
        return s, jnp.einsum('bhvk,bhk->bhv', s, r_t)

    s_end, out = lax.scan(step, s0, xs)
    return jnp.moveaxis(out, 0, 1), s_end


def rwkv7_group(pc, pl, mu, w0, w_b, a0, a_b, g_b, k_k, k_a, r_k, gn_g, gn_b):
    zc = pc + (bidir_shift(pc) - pc) * mu
    zl = pl + (grid_qshift(pl) - pl) * mu

    def prep(z):
        z = z.astype(jnp.float32)
        r, k, v = (z[..., j * A_W:(j + 1) * A_W] for j in range(3))
        o = 3 * A_W
        wd = z[..., o:o + 2 * A_DECAY_RANK].reshape(z.shape[:-1] + (2, A_DECAY_RANK))
        o += 2 * A_DECAY_RANK
        ad = z[..., o:o + 2 * A_ICL_RANK].reshape(z.shape[:-1] + (2, A_ICL_RANK))
        o += 2 * A_ICL_RANK
        g = jax.nn.sigmoid(z[..., o:o + A_GATE_RANK]) @ g_b
        kk = _heads(k * k_k, A_HEADS)
        kk = kk / jnp.maximum(jnp.sqrt(jnp.sum(kk * kk, -1, keepdims=True)), 1e-12)
        dirs = []
        for d in range(2):
            w = jnp.exp(-A_DECAY_SCALE * jax.nn.sigmoid(w0[d] + jnp.tanh(wd[..., d, :]) @ w_b[d]))
            a = jax.nn.sigmoid(a0[d] + ad[..., d, :] @ a_b[d])
            kd = k * (1.0 + (a - 1.0) * k_a)
            dirs.append(tuple(_heads(t, A_HEADS) for t in (r, w, kd, v)) + (kk, _heads(a, A_HEADS)))
        return dirs, g

    def finish(wkv, dirs, g):
        r, v = dirs[0][0], dirs[0][3]
        bonus = sum(jnp.sum(r * dd[2] * r_k, -1, keepdims=True) for dd in dirs) * v
        y = group_norm(wkv.reshape(g.shape), gn_g, gn_b, A_HEADS, GN_EPS_RWKV) + bonus.reshape(g.shape)
        return y * g

    dirs_c, g_c = prep(zc)
    dirs_l, g_l = prep(zl)
    s0 = jnp.zeros((pc.shape[0], A_HEADS, A_HEAD_DIM, A_HEAD_DIM), jnp.float32)
    wkv_c = 0.0
    wkv_l = 0.0
    for d, fl in enumerate((_ident, _flip)):
        out_c, s_c = rwkv7_scan(s0, *(fl(t) for t in dirs_c[d]))
        out_l, _ = rwkv7_scan(s_c, *(fl(t) for t in dirs_l[d]))
        wkv_c = wkv_c + fl(out_c)
        wkv_l = wkv_l + fl(out_l)
    return finish(wkv_c, dirs_c, g_c).astype(pc.dtype), finish(wkv_l, dirs_l, g_l).astype(pl.dtype)


def rglru_group(pc, pl, conv_w, conv_b, gate_w, gate_b, lam):
    def prep(p):
        u = centred_depthwise_conv(p[..., :B_W], conv_w, conv_b).astype(jnp.float32)
        gate = jax.nn.gelu(p[..., B_W:].astype(jnp.float32))
        pre = jnp.einsum('btgi,dsgio->btdsgo', _heads(u, B_BLOCKS), gate_w)
        pre = pre.reshape(u.shape[:2] + (2, 2, B_W)) + gate_b
        rec = jax.nn.sigmoid(pre[..., 0, :])
        inp = jax.nn.sigmoid(pre[..., 1, :])
        log_a = -B_C * rec * jax.nn.softplus(-lam)
        a = jnp.exp(log_a)
        bx = jnp.sqrt(-jnp.expm1(2.0 * log_a)) * inp * u[..., None, :]
        return a, bx, gate

    a_c, b_c, g_c = prep(pc)
    a_l, b_l, g_l = prep(pl)
    h0 = jnp.zeros((pc.shape[0], B_W), jnp.float32)
    h_c = 0.0
    h_l = 0.0
    for d, fl in enumerate((_ident, _flip)):
        hc_d, h_end = linear_recurrence(fl(a_c[..., d, :]), fl(b_c[..., d, :]), h0)
        hl_d, _ = linear_recurrence(fl(a_l[..., d, :]), fl(b_l[..., d, :]), h_end)
        h_c = h_c + fl(hc_d)
        h_l = h_l + fl(hl_d)
    return (h_c * g_c).astype(pc.dtype), (h_l * g_l).astype(pl.dtype)


def retention_chunked(q, k, v, log_gamma, r0):
    bq, n_tok, nh, dk = q.shape
    dv = v.shape[-1]
    n = n_tok // CHUNK
    q, k = (t.reshape(bq, n, CHUNK, nh, dk) for t in (q, k))
    v = v.reshape(bq, n, CHUNK, nh, dv)
    pos = jnp.arange(CHUNK, dtype=jnp.float32)
    lg = log_gamma.astype(jnp.float32)[:, None]
    diff = pos[:, None] - pos[None, :]
    decay = jnp.where(diff >= 0, jnp.exp(lg[:, :, None] * jnp.maximum(diff, 0.0)), 0.0)
    scores = jnp.einsum('bnihd,bnjhd->bnhij', q, k) * decay
    intra = jnp.einsum('bnhij,bnjhe->bnihe', scores, v)
    zeta = jnp.exp(lg * (CHUNK - 1.0 - pos))
    kv = jnp.einsum('bnjhd,hj,bnjhe->bnhde', k, zeta, v)
    chunk_decay = jnp.exp(lg[:, 0] * CHUNK)[:, None, None]

    def step(r, kv_i):
        return r * chunk_decay + kv_i, r

    r_last, r_prev = lax.scan(step, r0, jnp.moveaxis(kv, 1, 0))
    r_prev = jnp.moveaxis(r_prev, 0, 1)
    xi = jnp.exp(lg * (pos + 1.0)).T
    inter = jnp.einsum('bnihd,bnhde->bnihe', q, r_prev) * xi[:, :, None]
    return (intra + inter).reshape(bq, n_tok, nh, dv), r_last


def retention_group(pc, pl, log_gamma, gn_g, gn_b):
    def prep(p, rotate):
        p = p.astype(jnp.float32)
        q, k, v = (_heads(p[..., j * C_W:(j + 1) * C_W], C_HEADS) for j in range(3))
        k = k * C_HEAD_DIM ** -0.5
        if rotate:
            q, k = axial_rope(q), axial_rope(k)
        return q, k, v, p[..., 3 * C_W:]

    qc, kc, vc, gc = prep(pc, False)
    ql, kl, vl, gl = prep(pl, True)
    r0 = jnp.zeros((pc.shape[0], C_HEADS, C_HEAD_DIM, C_HEAD_DIM), jnp.float32)
    o_c = 0.0
    o_l = 0.0
    for d, fl in enumerate((_ident, _flip)):
        oc_d, r_c = retention_chunked(fl(qc), fl(kc), fl(vc), log_gamma[d], r0)
        ol_d, _ = retention_chunked(fl(ql), fl(kl), fl(vl), log_gamma[d], r_c)
        o_c = o_c + fl(oc_d)
        o_l = o_l + fl(ol_d)
    y_c = group_norm(o_c.reshape(gc.shape), gn_g, gn_b, C_HEADS, LN_EPS) * jax.nn.silu(gc)
    y_l = group_norm(o_l.reshape(gl.shape), gn_g, gn_b, C_HEADS, LN_EPS) * jax.nn.silu(gl)
    return y_c.astype(pc.dtype), y_l.astype(pl.dtype)


def mlstm_chunked(q, k, v, ig, lf, state):
    bq, n_tok, nh, dh = q.shape
    n = n_tok // CHUNK
    q, k, v = (t.reshape(bq, n, CHUNK, nh, dh) for t in (q, k, v))
    ig, lf = (t.reshape(bq, n, CHUNK, nh) for t in (ig, lf))
    b = jnp.cumsum(lf, axis=2)
    tri = jnp.tril(jnp.ones((CHUNK, CHUNK), bool))[None, None, :, :, None]
    d_log = jnp.where(tri, b[:, :, :, None, :] - b[:, :, None, :, :] + ig[:, :, None, :, :], -jnp.inf)
    b_end = b[:, :, -1]
    w_end = b_end[:, :, None, :] - b + ig
    m_end = jnp.max(w_end, axis=2)
    e_end = jnp.exp(w_end - m_end[:, :, None, :])
    c_chunk = jnp.einsum('bnjh,bnjhd,bnjhe->bnhed', e_end, k, v)
    n_chunk = jnp.einsum('bnjh,bnjhd->bnhd', e_end, k)

    def step(carry, inp):
        c_st, n_st, m_st = carry
        c_i, n_i, m_i, b_i = inp
        m_new = jnp.maximum(b_i + m_st, m_i)
        s_old = jnp.exp(b_i + m_st - m_new)
        s_new = jnp.exp(m_i - m_new)
        new = (c_st * s_old[..., None, None] + c_i * s_new[..., None, None],
               n_st * s_old[..., None] + n_i * s_new[..., None], m_new)
        return new, carry

    xs = tuple(jnp.moveaxis(t, 1, 0) for t in (c_chunk, n_chunk, m_end, b_end))
    final, prev = lax.scan(step, state, xs)
    c_prev, n_prev, m_prev = (jnp.moveaxis(t, 0, 1) for t in prev)
    g_inter = b + m_prev[:, :, None, :]
    m_t = jnp.maximum(g_inter, jnp.max(d_log, axis=3))
    s_intra = jnp.einsum('bnihd,bnjhd->bnijh', q, k) * jnp.exp(d_log - m_t[:, :, :, None, :])
    s_inter = jnp.exp(g_inter - m_t)
    num = (jnp.einsum('bnijh,bnjhe->bnihe', s_intra, v)
           + jnp.einsum('bnihd,bnhed->bnihe', q, c_prev) * s_inter[..., None])
    den = jnp.sum(s_intra, axis=3) + jnp.einsum('bnihd,bnhd->bnih', q, n_prev) * s_inter
    den = jnp.maximum(jnp.abs(den), jnp.exp(-m_t))
    h = num / den[..., None]
    return h.reshape(bq, n_tok, nh, dh), final


def mlstm_group(pc, pl, ibias, fbias, gn_g, gn_b):
    def prep(p):
        p = p.astype(jnp.float32)
        q, k, v = (_heads(p[..., j * D_W:(j + 1) * D_W], D_HEADS) for j in range(3))
        gt = p[..., 4 * D_W:].reshape(p.shape[:2] + (2, 2, D_HEADS))
        ig = gt[..., 0, :, :] + ibias
        lf = jax.nn.log_sigmoid(gt[..., 1, :, :] + fbias)
        return q, k * D_HEAD_DIM ** -0.5, v, p[..., 3 * D_W:4 * D_W], ig, lf

    qc, kc, vc, oc, igc, lfc = prep(pc)
    ql, kl, vl, ol, igl, lfl = prep(pl)
    bz = pc.shape[0]
    s0 = (jnp.zeros((bz, D_HEADS, D_HEAD_DIM, D_HEAD_DIM), jnp.float32),
          jnp.zeros((bz, D_HEADS, D_HEAD_DIM), jnp.float32),
          jnp.full((bz, D_HEADS), -jnp.inf, jnp.float32))
    h_c = 0.0
    h_l = 0.0
    for d, fl in enumerate((_ident, _flip)):
        hc_d, s_c = mlstm_chunked(fl(qc), fl(kc), fl(vc), fl(igc[..., d, :]), fl(lfc[..., d, :]), s0)
        hl_d, _ = mlstm_chunked(fl(ql), fl(kl), fl(vl), fl(igl[..., d, :]), fl(lfl[..., d, :]), s_c)
        h_c = h_c + fl(hc_d)
        h_l = h_l + fl(hl_d)
    y_c = group_norm(h_c.reshape(oc.shape), gn_g, gn_b, D_HEADS, LN_EPS) * jax.nn.sigmoid(oc)
    y_l = group_norm(h_l.reshape(ol.shape), gn_g, gn_b, D_HEADS, LN_EPS) * jax.nn.sigmoid(ol)
    return y_c.astype(pc.dtype), y_l.astype(pl.dtype)


def moe(h, router_w, router_b, w1, b1, w2, b2):
    logits = (h @ router_w + router_b).astype(jnp.float32)
    top_val, top_idx = lax.top_k(logits, TOP_K)
    top_w = jax.nn.softmax(top_val, axis=-1)
    gates = jnp.sum(jax.nn.one_hot(top_idx, N_EXPERTS, dtype=jnp.float32) * top_w[..., None], axis=1)
    gates = gates.astype(h.dtype)
    y = jnp.zeros_like(h)
    for e in range(N_EXPERTS):
        u = h @ w1[e] + b1[e]
        glu = jnp.minimum(u[:, :D_FF], SWIGLU_LIMIT)
        lin = jnp.clip(u[:, D_FF:], -SWIGLU_LIMIT, SWIGLU_LIMIT)
        act = (lin + 1.0) * glu * jax.nn.sigmoid(SWIGLU_ALPHA * glu)
        y = y + gates[:, e:e + 1] * (act @ w2[e] + b2[e])
    return y


def setup_inputs(seed: int = 0) -> dict:
    key = jax.random.key(seed)
    ks = iter(jax.random.split(key, 64))

    def nrm(shape, scale):
        return jax.random.normal(next(ks), shape, jnp.float32) * scale

    lam_u = jax.random.uniform(next(ks), (N_EVEN, 2, B_W), jnp.float32, 0.9, 0.999)
    lam_base = lam_u ** (1.0 / B_C)
    gammas = jnp.log(1.0 - 2.0 ** (-5.0 - jnp.arange(C_HEADS, dtype=jnp.float32)))
    return {
        'x': nrm((BATCH, SEQ, D_MODEL), 1.0),
        'c': nrm((BATCH, D_MODEL), 1.0),
        'ctx': nrm((BATCH, CTX_LEN, D_MODEL), 1.0),
        'c_ctx': nrm((D_MODEL,), 1.0),
        'w_mod': nrm((DEPTH, D_MODEL, N_MOD * D_MODEL), D_MODEL ** -0.5),
        'b_mod': nrm((DEPTH, N_MOD * D_MODEL), 0.02),
        'ln_g': 1.0 + nrm((DEPTH, 2, D_MODEL), 0.02),
        'ln_b': nrm((DEPTH, 2, D_MODEL), 0.02),
        'even_w_in': nrm((N_EVEN, D_MODEL, EVEN_IN), D_MODEL ** -0.5),
        'even_w_out': nrm((N_EVEN, MIX_W, D_MODEL), MIX_W ** -0.5 * DN_BETA),
        'a_mu': jax.random.uniform(next(ks), (N_EVEN, A_IN), jnp.float32),
        'a_w0': jnp.linspace(-5.0, 1.0, A_W) + nrm((N_EVEN, 2, A_W), 0.1),
        'a_wB': nrm((N_EVEN, 2, A_DECAY_RANK, A_W), 0.1),
        'a_a0': nrm((N_EVEN, 2, A_W), 0.1),
        'a_aB': nrm((N_EVEN, 2, A_ICL_RANK, A_W), 0.5 * A_ICL_RANK ** -0.5),
        'a_gB': nrm((N_EVEN, A_GATE_RANK, A_W), A_GATE_RANK ** -0.5),
        'a_kk': 0.85 + nrm((N_EVEN, A_W), 0.05),
        'a_ka': 1.0 + nrm((N_EVEN, A_W), 0.05),
        'a_rk': nrm((N_EVEN, A_HEADS, A_HEAD_DIM), 0.1),
        'a_gn_g': 1.0 + nrm((N_EVEN, A_W), 0.02),
        'a_gn_b': nrm((N_EVEN, A_W), 0.02),
        'b_conv_w': nrm((N_EVEN, B_CONV, B_W), 0.5),
        'b_conv_b': nrm((N_EVEN, B_W), 0.02),
        'b_gate_w': nrm((N_EVEN, 2, 2, B_BLOCKS, B_BLOCK, B_BLOCK), B_BLOCK ** -0.5),
        'b_gate_b': nrm((N_EVEN, 2, 2, B_W), 0.02),
        'b_lam': jnp.log(lam_base) - jnp.log1p(-lam_base),
        'odd_w_in': nrm((N_ODD, D_MODEL, ODD_IN), D_MODEL ** -0.5),
        'odd_w_out': nrm((N_ODD, MIX_W, D_MODEL), MIX_W ** -0.5 * DN_BETA),
        'c_log_gamma': gammas * (1.0 + nrm((N_ODD, 2, C_HEADS), 0.05)),
        'c_gn_g': 1.0 + nrm((N_ODD, C_W), 0.02),
        'c_gn_b': nrm((N_ODD, C_W), 0.02),
        'd_ibias': nrm((N_ODD, 2, D_HEADS), 0.1),
        'd_fbias': jnp.linspace(3.0, 6.0, D_HEADS) + nrm((N_ODD, 2, D_HEADS), 0.1),
        'd_gn_g': 1.0 + nrm((N_ODD, D_W), 0.02),
        'd_gn_b': nrm((N_ODD, D_W), 0.02),
        'router_w': nrm((DEPTH, D_MODEL, N_EXPERTS), D_MODEL ** -0.5),
        'router_b': nrm((DEPTH, N_EXPERTS), 0.01),
        'exp_w1': nrm((DEPTH, N_EXPERTS, D_MODEL, 2 * D_FF), D_MODEL ** -0.5),
        'exp_b1': nrm((DEPTH, N_EXPERTS, 2 * D_FF), 0.02),
        'exp_w2': nrm((DEPTH, N_EXPERTS, D_FF, D_MODEL), D_FF ** -0.5 * DN_BETA),
        'exp_b2': nrm((DEPTH, N_EXPERTS, D_MODEL), 0.02),
    }


def reference(x, c, ctx, c_ctx, w_mod, b_mod, ln_g, ln_b, even_w_in, even_w_out, a_mu, a_w0, a_wB,
              a_a0, a_aB, a_gB, a_kk, a_ka, a_rk, a_gn_g, a_gn_b, b_conv_w, b_conv_b, b_gate_w,
              b_gate_b, b_lam, odd_w_in, odd_w_out, c_log_gamma, c_gn_g, c_gn_b, d_ibias, d_fbias,
              d_gn_g, d_gn_b, router_w, router_b, exp_w1, exp_b1, exp_w2, exp_b2):
    xl, xc = x, ctx
    bz = x.shape[0]
    for layer in range(DEPTH):
        last = layer == DEPTH - 1
        mod_l = (jax.nn.silu(c) @ w_mod[layer] + b_mod[layer]).reshape(bz, N_MOD, 1, D_MODEL)
        mod_c = (jax.nn.silu(c_ctx) @ w_mod[layer] + b_mod[layer]).reshape(N_MOD, 1, D_MODEL)
        hl = xl * (1.0 + mod_l[:, 1]) + mod_l[:, 0]
        hc = xc * (1.0 + mod_c[1]) + mod_c[0]
        i = layer // 2
        if layer % 2 == 0:
            pc, pl = hc @ even_w_in[i], hl @ even_w_in[i]
            ya_c, ya_l = rwkv7_group(pc[..., :A_IN], pl[..., :A_IN], a_mu[i], a_w0[i], a_wB[i], a_a0[i],
                                     a_aB[i], a_gB[i], a_kk[i], a_ka[i], a_rk[i], a_gn_g[i], a_gn_b[i])
            yb_c, yb_l = rglru_group(pc[..., A_IN:], pl[..., A_IN:], b_conv_w[i], b_conv_b[i],
                                     b_gate_w[i], b_gate_b[i], b_lam[i])
            w_out = even_w_out[i]
        else:
            pc, pl = hc @ odd_w_in[i], hl @ odd_w_in[i]
            ya_c, ya_l = retention_group(pc[..., :C_IN], pl[..., :C_IN], c_log_gamma[i], c_gn_g[i], c_gn_b[i])
            yb_c, yb_l = mlstm_group(pc[..., C_IN:], pl[..., C_IN:], d_ibias[i], d_fbias[i], d_gn_g[i], d_gn_b[i])
            w_out = odd_w_out[i]
        y_l = jnp.concatenate([ya_l, yb_l], -1) @ w_out
        xl = layer_norm(DN_ALPHA * xl + mod_l[:, 2] * y_l, ln_g[layer, 0], ln_b[layer, 0])
        moe_args = (router_w[layer], router_b[layer], exp_w1[layer], exp_b1[layer], exp_w2[layer], exp_b2[layer])
        hl = xl * (1.0 + mod_l[:, 4]) + mod_l[:, 3]
        if last:
            ffn_l = moe(hl.reshape(-1, D_MODEL), *moe_args).reshape(hl.shape)
        else:
            y_c = jnp.concatenate([ya_c, yb_c], -1) @ w_out
            xc = layer_norm(DN_ALPHA * xc + mod_c[2] * y_c, ln_g[layer, 0], ln_b[layer, 0])
            hc = xc * (1.0 + mod_c[4]) + mod_c[3]
            n_ctx = hc.shape[0] * hc.shape[1]
            ffn = moe(jnp.concatenate([hc.reshape(-1, D_MODEL), hl.reshape(-1, D_MODEL)], 0), *moe_args)
            ffn_c = ffn[:n_ctx].reshape(hc.shape)
            ffn_l = ffn[n_ctx:].reshape(hl.shape)
            xc = layer_norm(DN_ALPHA * xc + mod_c[5] * ffn_c, ln_g[layer, 1], ln_b[layer, 1])
        xl = layer_norm(DN_ALPHA * xl + mod_l[:, 5] * ffn_l, ln_g[layer, 1], ln_b[layer, 1])
    return xl
```

```cpp
#include <hip/hip_runtime.h>
#include <stdint.h>
#include <stdio.h>

#define LAS __attribute__((address_space(3)))
typedef unsigned short bf16_t;
typedef short bf16x8 __attribute__((ext_vector_type(8)));
typedef float f32x4 __attribute__((ext_vector_type(4)));
typedef float f32x2 __attribute__((ext_vector_type(2)));
typedef unsigned u32x4 __attribute__((ext_vector_type(4)));
typedef unsigned u32x2 __attribute__((ext_vector_type(2)));

constexpr int NB = 4, SEQL = 4096, CTXL = 256, DM = 1024;
constexpr int NCTX = NB * CTXL;
constexpr int MROWS = NCTX + NB * SEQL;
constexpr int NTHR = 512;
constexpr int LDP0 = 3072, LDP1 = 4096;
constexpr int A_IN = 1920, EVEN_IN = 2944, ODD_IN = 4112;
constexpr int NEXP = 32, DFF = 1024;
constexpr int MOE_ROWS_MAX = 69632 + 32 * 256;
constexpr float DN_ALPHA = 1.41421356237309515f;
constexpr float LN_EPS = 1e-5f;
constexpr int NCHUNK = 34;

enum { I_X = 0, I_C, I_CTX, I_CCTX, I_WMOD, I_BMOD, I_LNG, I_LNB, I_EWIN, I_EWOUT, I_AMU, I_AW0, I_AWB, I_AA0, I_AAB, I_AGB, I_AKK, I_AKA, I_ARK,
       I_AGNG, I_AGNB, I_BCW, I_BCB, I_BGW, I_BGB, I_BLAM, I_OWIN, I_OWOUT, I_CLG, I_CGNG, I_CGNB, I_DIB, I_DFB, I_DGNG, I_DGNB, I_RW, I_RB,
       I_W1, I_B1, I_W2, I_B2, N_INPUTS };

constexpr size_t al256(size_t x) { return (x + 255) & ~(size_t)255; }
constexpr size_t WS_CTL   = 0;
constexpr size_t CTL_BYTES = 65536;
constexpr size_t CTL_CNT  = 16384;
constexpr size_t WS_MOD   = WS_CTL + CTL_BYTES;
constexpr size_t WS_ROPE  = WS_MOD + al256((size_t)2 * 5 * 6144 * 4);
constexpr size_t WS_WIN0T = WS_ROPE + 16384;
constexpr size_t WS_WIN1T = WS_WIN0T + (size_t)3072 * 1024 * 2;
constexpr size_t WS_WOUTT = WS_WIN1T + (size_t)4096 * 1024 * 2;
constexpr size_t WS_W1T   = WS_WOUTT + (size_t)2 * 1024 * 1024 * 2;
constexpr size_t WS_W2T   = WS_W1T + (size_t)2 * 32 * 2048 * 1024 * 2;
constexpr size_t WS_XS    = WS_W2T + (size_t)2 * 32 * 1024 * 1024 * 2;
constexpr size_t WS_H     = WS_XS + (size_t)MROWS * 1024 * 4;
constexpr size_t WS_YMIX  = WS_H + (size_t)MROWS * 1024 * 2;
constexpr size_t WS_YP    = WS_YMIX + (size_t)MROWS * 1024 * 2;
constexpr size_t WS_GT    = WS_YP + (size_t)MROWS * 1024 * 4;
constexpr size_t WS_TOPE  = WS_GT + (size_t)MROWS * 16 * 4;
constexpr size_t WS_TOPW  = WS_TOPE + (size_t)MROWS * 16;
constexpr size_t WS_TOPS  = WS_TOPW + (size_t)MROWS * 16;
constexpr size_t WS_POS   = WS_TOPS + (size_t)MROWS * 16;
constexpr size_t WS_P     = WS_POS + (size_t)MROWS * 16;
constexpr size_t WS_BIG   = WS_P + (size_t)MROWS * 4096 * 4;
constexpr size_t ARR512   = (size_t)MROWS * 512 * 4;
enum { E_R = 0, E_V, E_KK, E_G, E_W0, E_W1, E_KD0, E_KD1, E_KKA0, E_KKA1, E_O0, E_O1, E_A0, E_A1, E_BX0, E_BX1, E_GATE, E_NARR };
constexpr size_t WS_EARR  = WS_BIG;
constexpr size_t WS_BC    = WS_EARR + (size_t)E_NARR * ARR512;
constexpr size_t WS_CHA   = WS_BC + (size_t)MROWS * 8 * 4;
constexpr size_t WS_CHH   = WS_CHA + (size_t)2 * 512 * 512 * 4;
constexpr size_t WS_CIN   = WS_CHH + (size_t)2 * 512 * 512 * 4;
constexpr size_t WS_EEND  = WS_CIN + (size_t)2 * 512 * 512 * 4;
constexpr int NSID = 2 * 2 * NB * NCHUNK * 4;
constexpr size_t WS_ST    = WS_BIG;
constexpr size_t WS_NST   = WS_ST + (size_t)NSID * 16384 * 4;
constexpr size_t WS_MEND  = WS_NST + (size_t)NSID * 128 * 4;
constexpr size_t WS_BEND  = WS_MEND + al256((size_t)NSID * 4);
constexpr size_t WS_MPREV = WS_BEND + al256((size_t)NSID * 4);
constexpr size_t WS_OEND  = WS_MPREV + al256((size_t)NSID * 4);
constexpr size_t WS_ASORT = WS_BIG;
constexpr size_t WS_ACT   = WS_ASORT + (size_t)MOE_ROWS_MAX * 1024 * 2;
constexpr size_t WS_YE    = WS_ACT + (size_t)MOE_ROWS_MAX * 1024 * 2;
constexpr size_t WS_MEND_ = WS_YE + (size_t)MOE_ROWS_MAX * 1024 * 4;
constexpr size_t WS_TOTAL = (WS_EEND > WS_MEND_ ? (WS_EEND > WS_OEND ? WS_EEND : WS_OEND) : (WS_MEND_ > WS_OEND ? WS_MEND_ : WS_OEND));

constexpr int LDS_BYTES = 155648;
constexpr int LDS_BAR = 0;
constexpr int LDS_WORK = 1024;

struct Params {
    const float* in[N_INPUTS];
    float* out;
    unsigned char* ws;
    int lo, hi;
};

__device__ __forceinline__ bf16_t f2bf(float f) { unsigned u = __float_as_uint(f); u += 0x7FFFu + ((u >> 16) & 1u); return (bf16_t)(u >> 16); }
__device__ __forceinline__ float bf2f(bf16_t b) { return __uint_as_float(((unsigned)b) << 16); }
__device__ __forceinline__ unsigned pack_bf16(float lo, float hi) { return (unsigned)f2bf(lo) | ((unsigned)f2bf(hi) << 16); }
__device__ __forceinline__ float sigm(float x) { return 1.0f / (1.0f + expf(-x)); }
__device__ __forceinline__ float softplusf(float x) { return fmaxf(x, 0.f) + log1pf(expf(-fabsf(x))); }
__device__ __forceinline__ float wave_sum(float v) {
#pragma unroll
    for (int o = 32; o > 0; o >>= 1) v += __shfl_xor(v, o, 64);
    return v;
}
__device__ __forceinline__ float wave_max(float v) {
#pragma unroll
    for (int o = 32; o > 0; o >>= 1) v = fmaxf(v, __shfl_xor(v, o, 64));
    return v;
}
__device__ __forceinline__ float row16_sum(float v) {
    v += __int_as_float(__builtin_amdgcn_update_dpp(0, __float_as_int(v), 0x121, 0xf, 0xf, false));
    v += __int_as_float(__builtin_amdgcn_update_dpp(0, __float_as_int(v), 0x122, 0xf, 0xf, false));
    v += __int_as_float(__builtin_amdgcn_update_dpp(0, __float_as_int(v), 0x124, 0xf, 0xf, false));
    v += __int_as_float(__builtin_amdgcn_update_dpp(0, __float_as_int(v), 0x128, 0xf, 0xf, false));
    return v;
}
__device__ __forceinline__ int row_batch(int row) { return row < NCTX ? (row >> 8) : ((row - NCTX) >> 12); }
__device__ __forceinline__ int row_modr(int row) { return row < NCTX ? 4 : ((row - NCTX) >> 12); }
#define XB_TMO      128
#define XB_XCNT(j)  (256  + 64 * (j))
#define XB_XSUB(j)  (1280 + 64 * (j))
#define XB_XGEN(j)  (2304 + 64 * (j))
#define XB_TOP      3328
#define XB_TOPGEN   3392
#define XCD_BAR_WORDS 3456
#define XB_SPIN_CAP (1u << 18)

__device__ __forceinline__ unsigned xb_ld(unsigned* p)              { return __hip_atomic_load(p, __ATOMIC_RELAXED, __HIP_MEMORY_SCOPE_AGENT); }
__device__ __forceinline__ unsigned xb_add(unsigned* p, unsigned v) { return __hip_atomic_fetch_add(p, v, __ATOMIC_RELAXED, __HIP_MEMORY_SCOPE_AGENT); }
__device__ __forceinline__ unsigned xb_xcc_id() { return (unsigned)__builtin_amdgcn_s_getreg((3 << 11) | 20) & 0xFu; }
#define XB_SPIN(cond, bar) do { unsigned _sp = 0; while (cond) { __builtin_amdgcn_s_sleep(1); \
    if ((++_sp & 255u) == 0u) { if (xb_ld(&(bar)[XB_TMO])) break; if (_sp > XB_SPIN_CAP) { atomicAdd(&(bar)[XB_TMO], 1u); break; } } } } while (0)

struct XcdBarrier {
    unsigned* bar; unsigned x;
    volatile LAS unsigned* st;
};

__device__ __forceinline__ XcdBarrier xcd_barrier_post(unsigned* bar, volatile LAS unsigned* st) {
    XcdBarrier b; b.bar = bar; b.x = xb_xcc_id(); b.st = st;
    if (threadIdx.x == 0) (void)xb_add(&bar[XB_XCNT(b.x)], 1u);
    return b;
}
__device__ __forceinline__ void xcd_barrier_complete(unsigned* bar, unsigned x, unsigned& nloc, unsigned& nx) {
    const unsigned G = gridDim.x * gridDim.y * gridDim.z;
    unsigned sum, cnt, mine, sp = 0u;
    for (;;) {
        sum = 0u; cnt = 0u; mine = 0u;
#pragma unroll
        for (unsigned j = 0; j < 16; ++j) { const unsigned c = xb_ld(&bar[XB_XCNT(j)]); sum += c; cnt += (c > 0u) ? 1u : 0u; mine = (j == x) ? c : mine; }
        if (sum == G) break;
        __builtin_amdgcn_s_sleep(1);
        if ((++sp & 255u) == 0u) { if (xb_ld(&bar[XB_TMO])) break; if (sp > XB_SPIN_CAP) { atomicAdd(&bar[XB_TMO], 1u); break; } }
    }
    nloc = mine > 0u ? mine : 1u; nx = cnt > 0u ? cnt : 1u;
}

__device__ __forceinline__ void xcd_barrier(const XcdBarrier& b) {
    asm volatile("s_waitcnt vmcnt(0)" ::: "memory");
    __syncthreads();
    if (threadIdx.x == 0) {
        unsigned* bar = b.bar;
        __builtin_amdgcn_s_waitcnt(0);
        unsigned nloc = b.st[0], nx = b.st[1];
        if (nloc == 0u) { xcd_barrier_complete(bar, b.x, nloc, nx); b.st[0] = nloc; b.st[1] = nx; }
        const unsigned old = xb_add(&bar[XB_XSUB(b.x)], 1u);
        const unsigned gen = old / nloc;
        if (old + 1u == (gen + 1u) * nloc) {
            __builtin_amdgcn_fence(__ATOMIC_RELEASE, "agent");
            asm volatile("s_waitcnt vmcnt(0)" ::: "memory");
            const unsigned og = xb_add(&bar[XB_TOP], 1u);
            const unsigned tg = og / nx;
            if (og + 1u == (tg + 1u) * nx) xb_add(&bar[XB_TOPGEN], 1u);
            else XB_SPIN(xb_ld(&bar[XB_TOPGEN]) == tg, bar);
            __builtin_amdgcn_fence(__ATOMIC_ACQUIRE, "agent");
            xb_add(&bar[XB_XGEN(b.x)], 1u);
            asm volatile("s_waitcnt vmcnt(0)" ::: "memory");
        } else {
            XB_SPIN(xb_ld(&bar[XB_XGEN(b.x)]) == gen, bar);
            __builtin_amdgcn_fence(__ATOMIC_ACQUIRE, "agent");
            asm volatile("s_waitcnt vmcnt(0)" ::: "memory");
        }
    }
    __syncthreads();
}
namespace pg8 {
constexpr int BM = 256, BK = 64, HALF = 128, HTB = HALF * BK * 2  , STAGE_BYTES = 8 * HTB, NXCD = 8, WGM = 8;

__host__ __device__ __forceinline__ int lds_byte(int r, int c) { const int st = (r >> 4) * 2 + (c >> 5), rr = r & 15, cc = c & 31, ob = rr * 64 + cc * 2; return st * 1024 + (ob ^ (((ob >> 9) & 1) << 5)); }
__host__ __device__ __forceinline__ void stage_rc(int b, int& R, int& C) { const int st = b / 1024, sb = b % 1024, swz = sb ^ (((sb >> 9) & 1) << 5); R = (st >> 1) * 16 + swz / 64; C = (st & 1) * 32 + (swz % 64) / 2; }
__host__ __device__ __forceinline__ int perm32(int rho) { const int n = rho >> 4, i = rho & 15; return 8 * (i >> 2) + 4 * n + (i & 3); }

struct Unit { int pm, pn; };
struct Gemm { const bf16_t* A; const bf16_t* Bt; int M, N, K; };
__device__ __forceinline__ unsigned cvt_pk_bf16(float lo, float hi) { unsigned r; asm volatile("v_cvt_pk_bf16_f32 %0, %1, %2" : "=v"(r) : "v"(lo), "v"(hi)); return r; }
template <class Epi, class Sched, bool STAMP = false>
__device__ __forceinline__ void gemm_phase(LAS unsigned char* lds, const Gemm g, const Sched& S, const Epi& E, unsigned long long* stamps) {
    const int tid = threadIdx.x, wid = __builtin_amdgcn_readfirstlane(tid >> 6), lane = tid & 63, wr = wid >> 2, wc = wid & 3, fr = lane & 15, fq = lane >> 4;
    const int K = g.K, nt = K / BK;
    int ts_lo = 0, ts_hi = 0, nts = 0; const unsigned long long rt_entry = STAMP ? (unsigned long long)wall_clock64() : 0ull;
#define PG8_STAMP() do { if (STAMP && wid == 0 && nts < 64) { const unsigned long long _c = (unsigned long long)clock64(); \
        ts_lo = (lane == nts) ? (int)(unsigned)_c : ts_lo; ts_hi = (lane == nts) ? (int)(unsigned)(_c >> 32) : ts_hi; ++nts; } } while (0)
    PG8_STAMP();
    unsigned voffA[2], voffB[2];
#pragma unroll
    for (int i = 0; i < 2; ++i) { int R, C; stage_rc(tid * 16 + i * 8192, R, C); const int Rb = Epi::PERM ? ((R & ~31) + perm32(R & 31)) : R;
        voffA[i] = (unsigned)(R * K + C) * 2u; voffB[i] = (unsigned)(Rb * K + C) * 2u; }
    const size_t kstep = (size_t)(BK * 2);
    const size_t hstep = (size_t)HALF * K * 2;
    const size_t tstep = 2 * hstep;
    const unsigned ldsw = (unsigned)wid * 1024u;
    const int aoff = lds_byte(wr * 64 + fr, fq * 8), boff = lds_byte(wc * 32 + fr, fq * 8);
#define PG8_SA(b, h) (((b) * 2 + (h)) * HTB)
#define PG8_SB(b, h) ((4 + (b) * 2 + (h)) * HTB)
#define PG8_STAGE(bufoff, gbase, voff) do { _Pragma("unroll") for (int _i = 0; _i < 2; ++_i) \
        __builtin_amdgcn_global_load_lds((const unsigned*)((const char*)(gbase) + (voff)[_i]), (LAS unsigned*)(lds + (bufoff) + ldsw + _i * 8192), 16, 0, 0); } while (0)
#define PG8_LDA(dst, b, h) do { _Pragma("unroll") for (int m = 0; m < 4; ++m) _Pragma("unroll") for (int k = 0; k < 2; ++k) dst[m][k] = *(const LAS bf16x8*)(lds + PG8_SA(b, h) + aoff + m * 2048 + k * 1024); } while (0)
#define PG8_LDB(dst, b, h) do { _Pragma("unroll") for (int n = 0; n < 2; ++n) _Pragma("unroll") for (int k = 0; k < 2; ++k) dst[n][k] = *(const LAS bf16x8*)(lds + PG8_SB(b, h) + boff + n * 2048 + k * 1024); } while (0)
#define PG8_MMA(ai, bj, At, Bt) do { __builtin_amdgcn_s_setprio(1); _Pragma("unroll") for (int m = 0; m < 4; ++m) _Pragma("unroll") for (int n = 0; n < 2; ++n) _Pragma("unroll") for (int k = 0; k < 2; ++k) \
        acc[ai][bj][m][n] = __builtin_amdgcn_mfma_f32_16x16x32_bf16(Bt[n][k], At[m][k], acc[ai][bj][m][n], 0, 0, 0); __builtin_amdgcn_s_setprio(0); } while (0)
#define PG8_WAIT_V(n) asm volatile("s_waitcnt vmcnt(" #n ")" ::: "memory")
#define PG8_WAIT_L(n) asm volatile("s_waitcnt lgkmcnt(" #n ")" ::: "memory")
#define PG8_BAR __builtin_amdgcn_s_barrier()
#define PG8_SCHED __builtin_amdgcn_sched_barrier(0)
    Unit cur, nxt; int ui = 0;
    if (!S.next(0, cur)) return;
    f32x4 acc[2][2][4][2];
#pragma unroll
    for (int a = 0; a < 2; ++a)
#pragma unroll
        for (int b = 0; b < 2; ++b)
#pragma unroll
            for (int m = 0; m < 4; ++m)
#pragma unroll
                for (int n = 0; n < 2; ++n) acc[a][b][m][n] = (f32x4){0.f, 0.f, 0.f, 0.f};
    bf16x8 At[4][2], B0[2][2], B1[2][2];
    const char* cA = (const char*)g.A + (size_t)cur.pm * tstep; const char* cB = (const char*)g.Bt + (size_t)cur.pn * tstep;
    S.a_ready(cur);
    PG8_STAGE(PG8_SB(0, 0), cB, voffB); PG8_STAGE(PG8_SA(0, 0), cA, voffA); PG8_STAGE(PG8_SB(0, 1), cB + hstep, voffB); PG8_STAGE(PG8_SA(0, 1), cA + hstep, voffA);
    if (wr == 1) PG8_BAR;
    PG8_WAIT_V(4); PG8_BAR;
    PG8_STAGE(PG8_SB(1, 0), cB + kstep, voffB); PG8_STAGE(PG8_SA(1, 0), cA + kstep, voffA); PG8_STAGE(PG8_SB(1, 1), cB + hstep + kstep, voffB);
    PG8_WAIT_V(6); PG8_BAR;
    PG8_STAMP();
    for (;;) {
        const bool has_next = S.next(ui + 1, nxt);
        const char* nA = has_next ? (const char*)g.A + (size_t)nxt.pm * tstep : cA; const char* nB = has_next ? (const char*)g.Bt + (size_t)nxt.pn * tstep : cB;
        for (int t = 0; t < nt; t += 2) {
            const bool last = (t == nt - 2);
            const char* a1 = cA + (size_t)(t + 1) * kstep;
            const char* a2 = last ? nA : cA + (size_t)(t + 2) * kstep; const char* b2 = last ? nB : cB + (size_t)(t + 2) * kstep;
            const char* a3 = a2 + kstep; const char* b3 = b2 + kstep;
            if (last && has_next) S.a_ready(nxt);
            PG8_LDB(B0, 0, 0); PG8_SCHED; PG8_LDA(At, 0, 0); PG8_STAGE(PG8_SA(1, 1), a1 + hstep, voffA);
            PG8_WAIT_L(8); PG8_BAR; PG8_WAIT_L(0); PG8_MMA(0, 0, At, B0); PG8_BAR; PG8_SCHED;
            PG8_LDB(B1, 0, 1); PG8_STAGE(PG8_SB(0, 0), b2, voffB);
            PG8_BAR; PG8_WAIT_L(0); PG8_MMA(0, 1, At, B1); PG8_BAR;
            PG8_LDA(At, 0, 1); PG8_STAGE(PG8_SA(0, 0), a2, voffA);
            PG8_BAR; PG8_WAIT_L(0); PG8_MMA(1, 0, At, B0); PG8_BAR; PG8_SCHED;
            PG8_STAGE(PG8_SB(0, 1), b2 + hstep, voffB);
            PG8_WAIT_V(6); PG8_BAR; PG8_MMA(1, 1, At, B1); PG8_BAR;
            PG8_LDB(B0, 1, 0); PG8_SCHED; PG8_LDA(At, 1, 0); PG8_STAGE(PG8_SA(0, 1), a2 + hstep, voffA);
            PG8_WAIT_L(8); PG8_BAR; PG8_WAIT_L(0); PG8_MMA(0, 0, At, B0); PG8_BAR; PG8_SCHED;
            PG8_LDB(B1, 1, 1); PG8_STAGE(PG8_SB(1, 0), b3, voffB);
            PG8_BAR; PG8_WAIT_L(0); PG8_MMA(0, 1, At, B1); PG8_BAR;
            PG8_LDA(At, 1, 1); PG8_STAGE(PG8_SA(1, 0), a3, voffA);
            PG8_BAR; PG8_WAIT_L(0); PG8_MMA(1, 0, At, B0); PG8_BAR; PG8_SCHED;
            PG8_STAGE(PG8_SB(1, 1), b3 + hstep, voffB);
            PG8_WAIT_V(6); PG8_BAR; PG8_MMA(1, 1, At, B1); PG8_BAR;
        }
        PG8_STAMP();
        if constexpr (!Epi::AFTER_DRAIN) { E(acc, cur, wr, wc, fr, fq); S.done(cur); }
        PG8_STAMP();
        if (!has_next) break;
#pragma unroll
        for (int a = 0; a < 2; ++a)
#pragma unroll
            for (int b = 0; b < 2; ++b)
#pragma unroll
                for (int m = 0; m < 4; ++m)
#pragma unroll
                    for (int n = 0; n < 2; ++n) acc[a][b][m][n] = (f32x4){0.f, 0.f, 0.f, 0.f};
        cur = nxt; cA = nA; cB = nB; ++ui;
    }
    PG8_WAIT_V(0);
    if (wr == 0) PG8_BAR;
    PG8_BAR;
    if constexpr (Epi::AFTER_DRAIN) { E.fused(acc, cur, wr, wc, fr, fq, lds, wid, lane); S.done(cur); }
    PG8_STAMP();
    if (STAMP && wid == 0) { stamps[lane] = lane < nts ? (((unsigned long long)(unsigned)ts_hi << 32) | (unsigned)ts_lo) : 0ull;
        if (lane == 62) stamps[62] = rt_entry; if (lane == 63) stamps[63] = (unsigned long long)wall_clock64(); }
#undef PG8_STAMP
#undef PG8_SA
#undef PG8_SB
#undef PG8_STAGE
#undef PG8_LDA
#undef PG8_LDB
#undef PG8_MMA
#undef PG8_WAIT_V
#undef PG8_WAIT_L
#undef PG8_BAR
#undef PG8_SCHED
}
struct SchedDense {
    int nM, nN, pm0, G, c;
    __device__ __forceinline__ bool next(int i, Unit& u) const { const long L = (long)i * G + c; if (L >= (long)nM * nN) return false; u.pm = pm0 + (int)(L / nN); u.pn = (int)(L % nN); return true; }
    __device__ __forceinline__ void a_ready(const Unit&) const {}
    __device__ __forceinline__ void done(const Unit&) const {}
};
struct SchedMoe {
    int T, nN, G, c; const LAS int* tileE;
    __device__ __forceinline__ bool next(int i, Unit& u) const { const long L = (long)i * G + c; if (L >= (long)T * nN) return false; const int pt = (int)(L / nN); u.pm = pt; u.pn = tileE[pt] * nN + (int)(L % nN); return true; }
    __device__ __forceinline__ void a_ready(const Unit&) const {}
    __device__ __forceinline__ void done(const Unit&) const {}
};
struct EpiStore {
    static constexpr bool PERM = false, AFTER_DRAIN = false;
    float* C; int ldc;
    __device__ __forceinline__ void operator()(const f32x4 (&acc)[2][2][4][2], const Unit& u, int wr, int wc, int fr, int fq) const {
        const int row0 = u.pm * BM + wr * 64 + fr, col0 = u.pn * BM + wc * 32 + 4 * fq;
#pragma unroll
        for (int ai = 0; ai < 2; ++ai)
#pragma unroll
            for (int m = 0; m < 4; ++m) { float* rowp = C + (size_t)(row0 + ai * HALF + m * 16) * ldc + col0;
#pragma unroll
                for (int bj = 0; bj < 2; ++bj)
#pragma unroll
                    for (int n = 0; n < 2; ++n) *(f32x4*)(rowp + bj * HALF + n * 16) = acc[ai][bj][m][n]; }
    }
};
struct EpiYE {
    static constexpr bool PERM = false, AFTER_DRAIN = false;
    float* C; const float* b2;
    __device__ __forceinline__ void operator()(const f32x4 (&acc)[2][2][4][2], const Unit& u, int wr, int wc, int fr, int fq) const {
        const int e = u.pn >> 2, pn = u.pn & 3;
        const int row0 = u.pm * BM + wr * 64 + fr, col0 = pn * BM + wc * 32 + 4 * fq;
        const float* bp = b2 + e * 1024 + col0;
        f32x4 bv[2][2];
#pragma unroll
        for (int bj = 0; bj < 2; ++bj)
#pragma unroll
            for (int n = 0; n < 2; ++n) bv[bj][n] = *(const f32x4*)(bp + bj * HALF + n * 16);
#pragma unroll
        for (int ai = 0; ai < 2; ++ai)
#pragma unroll
            for (int m = 0; m < 4; ++m) { float* rowp = C + (size_t)(row0 + ai * HALF + m * 16) * 1024 + col0;
#pragma unroll
                for (int bj = 0; bj < 2; ++bj)
#pragma unroll
                    for (int n = 0; n < 2; ++n) *(f32x4*)(rowp + bj * HALF + n * 16) = acc[ai][bj][m][n] + bv[bj][n]; }
    }
};
struct EpiAct {
    static constexpr bool PERM = true, AFTER_DRAIN = false;
    bf16_t* O; const float* b1;
    __device__ __forceinline__ void operator()(const f32x4 (&acc)[2][2][4][2], const Unit& u, int wr, int wc, int fr, int fq) const {
        const int e = u.pn >> 3, pn = u.pn & 7;
        const int row0 = u.pm * BM + wr * 64 + fr, x0 = pn * 128 + wc * 32 + 8 * fq;
        const float* bg = b1 + e * 2048 + x0; const float* bl = bg + 1024;
        f32x4 g0 = *(const f32x4*)bg, g1 = *(const f32x4*)(bg + 4), l0 = *(const f32x4*)bl, l1 = *(const f32x4*)(bl + 4);
#pragma unroll
        for (int ai = 0; ai < 2; ++ai)
#pragma unroll
            for (int m = 0; m < 4; ++m) {
                float o[8];
#pragma unroll
                for (int n = 0; n < 2; ++n)
#pragma unroll
                    for (int j = 0; j < 4; ++j) {
                        float glu = acc[ai][0][m][n][j] + (n ? g1[j] : g0[j]);
                        float lin = acc[ai][1][m][n][j] + (n ? l1[j] : l0[j]);
                        glu = fminf(glu, 7.0f); lin = fminf(fmaxf(lin, -7.0f), 7.0f);
                        o[n * 4 + j] = (lin + 1.0f) * glu * (1.0f / (1.0f + __expf(-1.702f * glu)));
                    }
                u32x4 w; w.x = cvt_pk_bf16(o[0], o[1]); w.y = cvt_pk_bf16(o[2], o[3]); w.z = cvt_pk_bf16(o[4], o[5]); w.w = cvt_pk_bf16(o[6], o[7]);
                *(u32x4*)(O + (size_t)(row0 + ai * HALF + m * 16) * 1024 + x0) = w;
            }
    }
};
}
using pg8::Unit;
__device__ __forceinline__ void my_sincos(double a, float& s, float& c) {
    const double n = rint(a * 0.63661977236758134308);
    const double r = (a - n * 1.57079632679489655800e+00) - n * 6.12323399573676603587e-17;
    const double r2 = r * r;
    const double sp = r * (1.0 + r2 * (-1.0 / 6.0 + r2 * (1.0 / 120.0 + r2 * (-1.0 / 5040.0 + r2 * (1.0 / 362880.0 + r2 * (-1.0 / 39916800.0 + r2 * (1.0 / 6227020800.0 + r2 * (-1.0 / 1307674368000.0))))))));
    const double cp = 1.0 + r2 * (-0.5 + r2 * (1.0 / 24.0 + r2 * (-1.0 / 720.0 + r2 * (1.0 / 40320.0 + r2 * (-1.0 / 3628800.0 + r2 * (1.0 / 479001600.0 + r2 * (-1.0 / 87178291200.0 + r2 * (1.0 / 20922789888000.0))))))));
    const int q = ((int)n) & 3;
    const double sn = q == 0 ? sp : q == 1 ? cp : q == 2 ? -sp : -cp;
    const double cn = q == 0 ? cp : q == 1 ? -sp : q == 2 ? -cp : sp;
    s = (float)sn; c = (float)cn;
}
__device__ __forceinline__ void ph_prologue(const Params& p, LAS unsigned char* lds, int bid, int nblk) {
    const int tid = threadIdx.x;
    unsigned char* ws = p.ws;
    {
        LAS float* sv = (LAS float*)(lds + LDS_WORK);
        LAS float* red = sv + 5 * 1024;
        for (int i = tid; i < 5 * 1024; i += NTHR) { const int r = i >> 10, k = i & 1023; const float c = r < 4 ? p.in[I_C][r * 1024 + k] : p.in[I_CCTX][k]; sv[i] = c / (1.0f + expf(-c)); }
        __syncthreads();
        float* MOD = (float*)(ws + WS_MOD);
        for (int item = bid; item < 256; item += nblk) {
            if (tid < 480) {
                const int cl = tid % 48, kp = tid / 48;
                const int gc = item * 48 + cl, l = gc / 6144, n = gc % 6144;
                const float* w = p.in[I_WMOD] + (size_t)l * 1024 * 6144 + n;
                float a0 = 0.f, a1 = 0.f, a2 = 0.f, a3 = 0.f, a4 = 0.f;
                for (int k = kp; k < 1024; k += 10) { const float wv = w[(size_t)k * 6144]; a0 += sv[k] * wv; a1 += sv[1024 + k] * wv; a2 += sv[2048 + k] * wv; a3 += sv[3072 + k] * wv; a4 += sv[4096 + k] * wv; }
                LAS float* rp = red + (kp * 48 + cl) * 5; rp[0] = a0; rp[1] = a1; rp[2] = a2; rp[3] = a3; rp[4] = a4;
            }
            __syncthreads();
            if (tid < 240) {
                const int cl = tid / 5, r = tid % 5; float s = 0.f;
                for (int kp = 0; kp < 10; ++kp) s += red[(kp * 48 + cl) * 5 + r];
                const int gc = item * 48 + cl, l = gc / 6144, n = gc % 6144;
                MOD[(size_t)(l * 5 + r) * 6144 + n] = s + p.in[I_BMOD][l * 6144 + n];
            }
            __syncthreads();
        }
    }
    if (bid == (nblk > 1 ? 1 : 0)) {
        float* ROPE = (float*)(ws + WS_ROPE);
        for (int i = tid; i < 2048; i += NTHR) { const int pos = i >> 5, f = i & 31; const double inv = exp(-(double)f * 0.28782313662425575); float s, c; my_sincos((double)pos * inv, s, c); ROPE[2 * i] = c; ROPE[2 * i + 1] = s; }
    }
    {
        LAS float* tile = (LAS float*)(lds + LDS_WORK);
        for (int t = bid; t < 12864; t += nblk) {
            const float* src; int ld, nvalid, k0, n0, w1map = 0; bf16_t* dst; int tt = t;
            if (tt < 8192) { const int mat = tt >> 7, r = tt & 127; k0 = (r >> 3) * 64; n0 = (r & 7) * 256; src = p.in[I_W1] + (size_t)mat * 1024 * 2048; ld = 2048; nvalid = 2048; dst = (bf16_t*)(ws + WS_W1T) + (size_t)mat * 2048 * 1024; w1map = 1; }
            else if ((tt -= 8192) < 4096) { const int mat = tt >> 6, r = tt & 63; k0 = (r >> 2) * 64; n0 = (r & 3) * 256; src = p.in[I_W2] + (size_t)mat * 1024 * 1024; ld = 1024; nvalid = 1024; dst = (bf16_t*)(ws + WS_W2T) + (size_t)mat * 1024 * 1024; }
            else if ((tt -= 4096) < 192) { k0 = (tt / 12) * 64; n0 = (tt % 12) * 256; src = p.in[I_EWIN]; ld = EVEN_IN; nvalid = EVEN_IN; dst = (bf16_t*)(ws + WS_WIN0T); }
            else if ((tt -= 192) < 256) { k0 = (tt >> 4) * 64; n0 = (tt & 15) * 256; src = p.in[I_OWIN]; ld = ODD_IN; nvalid = 4096; dst = (bf16_t*)(ws + WS_WIN1T); }
            else { tt -= 256; const int mat = tt >> 6, r = tt & 63; k0 = (r >> 2) * 64; n0 = (r & 3) * 256; src = mat ? p.in[I_OWOUT] : p.in[I_EWOUT]; ld = 1024; nvalid = 1024; dst = (bf16_t*)(ws + WS_WOUTT) + (size_t)mat * 1024 * 1024; }
            {
                const int j4 = (tid & 63) * 4, i0 = tid >> 6;
                f32x4 v[8];
#pragma unroll
                for (int r = 0; r < 8; ++r) v[r] = (n0 + j4 < nvalid) ? *(const f32x4*)(src + (size_t)(k0 + i0 + 8 * r) * ld + n0 + j4) : (f32x4){0.f, 0.f, 0.f, 0.f};
#pragma unroll
                for (int r = 0; r < 8; ++r) { LAS float* tp = tile + (i0 + 8 * r) * 257 + j4; tp[0] = v[r][0]; tp[1] = v[r][1]; tp[2] = v[r][2]; tp[3] = v[r][3]; }
            }
            __syncthreads();
            {
                const int ip = (tid & 31) * 2, j0 = tid >> 5;
#pragma unroll
                for (int r = 0; r < 16; ++r) {
                    const int j = j0 + 16 * r, n = n0 + j;
                    const int rho = w1map ? ((((n & 1023) >> 7) << 8) + ((n >> 10) << 7) + (n & 127)) : n;
                    *(unsigned*)(dst + (size_t)rho * 1024 + k0 + ip) = pack_bf16(tile[ip * 257 + j], tile[(ip + 1) * 257 + j]);
                }
            }
            __syncthreads();
        }
    }
}
__device__ __forceinline__ void ph_mod_in(const Params& p, int bid, int nblk) {
    const int tid = threadIdx.x, wid = tid >> 6, lane = tid & 63;
    const float* MOD = (const float*)(p.ws + WS_MOD);
    bf16_t* H = (bf16_t*)(p.ws + WS_H);
    for (int row = bid * 8 + wid; row < MROWS; row += nblk * 8) {
        const float* src = row < NCTX ? p.in[I_CTX] + (size_t)row * 1024 : p.in[I_X] + (size_t)(row - NCTX) * 1024;
        const float* md = MOD + (size_t)row_modr(row) * 6144;
#pragma unroll
        for (int q = 0; q < 4; ++q) {
            const int col = q * 256 + lane * 4;
            const f32x4 x = *(const f32x4*)(src + col), sh = *(const f32x4*)(md + col), sc = *(const f32x4*)(md + 1024 + col);
            const f32x4 h = x * (sc + 1.0f) + sh;
            u32x2 w; w.x = pack_bf16(h[0], h[1]); w.y = pack_bf16(h[2], h[3]);
            *(u32x2*)(H + (size_t)row * 1024 + col) = w;
        }
    }
}
__device__ __forceinline__ int even_tok_row(int w, int idx) { return idx < 64 ? NCTX + (w >> 6) * 4096 + (w & 63) * 64 + idx : w * 4 + (idx - 64); }
__device__ __forceinline__ int shift_nb(int row, int cc) {
    if (row >= NCTX) { const int s = (row - NCTX) & 4095, gr = s >> 6, gc = s & 63, slot = cc & 3;
        if (slot == 0) return gc > 0 ? row - 1 : -1;
        if (slot == 1) return gc < 63 ? row + 1 : -1;
        if (slot == 2) return gr > 0 ? row - 64 : -1;
        return gr < 63 ? row + 64 : -1; }
    const int t = row & 255; return (cc & 1) == 0 ? (t > 0 ? row - 1 : -1) : (t < 255 ? row + 1 : -1);
}
__device__ __forceinline__ float shifted_z(const float* P, const float* mu, int row, int cc) {
    const float pv = P[(size_t)row * LDP0 + cc]; const int nb = shift_nb(row, cc);
    const float sv = nb >= 0 ? P[(size_t)nb * LDP0 + cc] : 0.f;
    return pv + (sv - pv) * mu[cc];
}
__device__ __forceinline__ float dot64_lds(const LAS float* x, const float (&w)[64]) {
    float a0 = 0.f, a1 = 0.f, a2 = 0.f, a3 = 0.f;
#pragma unroll
    for (int j = 0; j < 64; j += 4) { const f32x4 v = *(const LAS f32x4*)(x + j); a0 += v[0] * w[j]; a1 += v[1] * w[j + 1]; a2 += v[2] * w[j + 2]; a3 += v[3] * w[j + 3]; }
    return (a0 + a1) + (a2 + a3);
}
__device__ __forceinline__ void ph_prep_even(const Params& p, LAS unsigned char* lds, int bid, int nblk) {
    const int tid = threadIdx.x, wid = tid >> 6, c = tid;
    const float* P = (const float*)(p.ws + WS_P);
    float* EA = (float*)(p.ws + WS_EARR);
#define EARR(k) (EA + (size_t)(k) * ((size_t)MROWS * 512))
    float* BC = (float*)(p.ws + WS_BC);
    float* CHA = (float*)(p.ws + WS_CHA); float* CHH = (float*)(p.ws + WS_CHH);
    const float* mu = p.in[I_AMU];
    LAS float* lin = (LAS float*)(lds + LDS_WORK);
    LAS float* ul = (LAS float*)(lds + LDS_WORK);
    for (int w = bid; w < 256; w += nblk) {
        for (int e = tid; e < 68 * 384; e += NTHR) {
            const int tok = e / 384, j = e - tok * 384, row = even_tok_row(w, tok);
            const float z = shifted_z(P, mu, row, 1536 + j);
            lin[e] = j < 128 ? tanhf(z) : (j < 256 ? z : sigm(z));
        }
        {
            const float kkc = p.in[I_AKK][c];
            for (int tok = 0; tok < 68; ++tok) {
                const int row = even_tok_row(w, tok);
                const float zr = shifted_z(P, mu, row, c), zk = shifted_z(P, mu, row, 512 + c), zv = shifted_z(P, mu, row, 1024 + c);
                const float kkr = zk * kkc, ss = wave_sum(kkr * kkr);
                const size_t o = (size_t)row * 512 + c;
                EARR(E_R)[o] = zr; EARR(E_V)[o] = zv; EARR(E_KK)[o] = kkr / fmaxf(sqrtf(ss), 1e-12f); EARR(E_KD0)[o] = zk; EARR(E_KD1)[o] = zk;
            }
        }
        __syncthreads();
        float wreg[64];
#pragma unroll 1
        for (int ps = 0; ps < 6; ++ps) {
            const int d = (ps >> 1) & 1, kind = ps < 4 ? (ps & 1) : 2, hf = ps & 1;
            const float* wsrc = (kind == 0 ? p.in[I_AWB] + (size_t)d * 64 * 512 : kind == 1 ? p.in[I_AAB] + (size_t)d * 64 * 512 : p.in[I_AGB] + (size_t)hf * 64 * 512) + c;
            const int linoff = kind == 0 ? d * 64 : kind == 1 ? 128 + d * 64 : 256 + hf * 64;
#pragma unroll
            for (int j = 0; j < 64; ++j) wreg[j] = wsrc[(size_t)j * 512];
            const float bias = kind == 0 ? p.in[I_AW0][d * 512 + c] : kind == 1 ? p.in[I_AA0][d * 512 + c] : 0.f;
            const float kav = p.in[I_AKA][c];
            float* Wd = EARR(E_W0 + d); float* KDd = EARR(E_KD0 + d); float* KKAd = EARR(E_KKA0 + d); const float* KKp = EARR(E_KK); float* G = EARR(E_G);
#pragma unroll 1
            for (int tok = 0; tok < 68; ++tok) {
                const float acc = dot64_lds(lin + tok * 384 + linoff, wreg);
                const size_t o = (size_t)even_tok_row(w, tok) * 512 + c;
                if (kind == 0) {
                    Wd[o] = expf(-0.60653065971263342f * sigm(bias + acc));
                } else if (kind == 1) {
                    const float a = sigm(bias + acc), zk = KDd[o], kk = KKp[o];
                    KDd[o] = zk * (1.0f + (a - 1.0f) * kav); KKAd[o] = kk * a;
                } else {
                    if (hf == 0) G[o] = acc; else G[o] += acc;
                }
            }
        }
        {
            const float rk = p.in[I_ARK][c];
            for (int tok = 0; tok < 68; ++tok) {
                const int row = even_tok_row(w, tok); const size_t o = (size_t)row * 512 + c;
                const float s = wave_sum(EARR(E_R)[o] * (EARR(E_KD0)[o] + EARR(E_KD1)[o]) * rk);
                if ((tid & 63) == 0) BC[row * 8 + wid] = s;
            }
        }
        __syncthreads();
        {
            const float cw0 = p.in[I_BCW][c], cw1 = p.in[I_BCW][512 + c], cw2 = p.in[I_BCW][1024 + c], cw3 = p.in[I_BCW][1536 + c], cb = p.in[I_BCB][c];
            for (int tok = 0; tok < 68; ++tok) {
                const int row = even_tok_row(w, tok);
                int base, pos, len;
                if (row >= NCTX) { pos = (row - NCTX) & 4095; base = row - pos; len = 4096; } else { pos = row & 255; base = row - pos; len = 256; }
                float u = cb;
                { const int q = pos - 2; if (q >= 0) u += cw0 * P[(size_t)(base + q) * LDP0 + 1920 + c]; }
                { const int q = pos - 1; if (q >= 0) u += cw1 * P[(size_t)(base + q) * LDP0 + 1920 + c]; }
                u += cw2 * P[(size_t)row * LDP0 + 1920 + c];
                { const int q = pos + 1; if (q < len) u += cw3 * P[(size_t)(base + q) * LDP0 + 1920 + c]; }
                ul[tok * 512 + c] = u;
                const float gx = P[(size_t)row * LDP0 + 1920 + 512 + c];
                EARR(E_GATE)[(size_t)row * 512 + c] = 0.5f * gx * (1.0f + tanhf(0.7978845608028654f * (gx + 0.044715f * gx * gx * gx)));
            }
        }
        __syncthreads();
#pragma unroll 1
        for (int ps = 0; ps < 4; ++ps) {
            const int d = ps >> 1, sk = ps & 1;
            float* Ad = EARR(E_A0 + d); float* BXd = EARR(E_BX0 + d);
            const float* gsrc = p.in[I_BGW] + (size_t)(((d * 2 + sk) * 8 + wid) * 64) * 64 + (tid & 63);
#pragma unroll
            for (int i = 0; i < 64; ++i) wreg[i] = gsrc[i * 64];
            const float gb = p.in[I_BGB][(d * 2 + sk) * 512 + c];
            if (sk == 0) {
                const float spl = softplusf(-p.in[I_BLAM][d * 512 + c]);
#pragma unroll 1
                for (int tok = 0; tok < 68; ++tok) {
                    const float acc = gb + dot64_lds(ul + tok * 512 + wid * 64, wreg);
                    Ad[(size_t)even_tok_row(w, tok) * 512 + c] = -8.0f * sigm(acc) * spl;
                }
            } else {
                float h = 0.f, cum = 1.f;
#pragma unroll 1
                for (int n = 0; n < 68; ++n) {
                    if (n == 64) {
                        const int cid = (w >> 6) * 128 + 64 + (w & 63);
                        CHA[(size_t)(d * 512 + cid) * 512 + c] = cum; CHH[(size_t)(d * 512 + cid) * 512 + c] = h; h = 0.f; cum = 1.f;
                    }
                    const int tok = n < 64 ? (d == 0 ? n : 63 - n) : 64 + (d == 0 ? n - 64 : 67 - n);
                    const size_t o = (size_t)even_tok_row(w, tok) * 512 + c;
                    const float acc = gb + dot64_lds(ul + tok * 512 + wid * 64, wreg);
                    const float la = Ad[o], a = expf(la);
                    const float bx = sqrtf(-expm1f(2.0f * la)) * sigm(acc) * ul[tok * 512 + c];
                    h = a * h + bx; cum *= a;
                    Ad[o] = cum; BXd[o] = h;
                }
                const int cid = (w >> 6) * 128 + (w & 63);
                CHA[(size_t)(d * 512 + cid) * 512 + c] = cum; CHH[(size_t)(d * 512 + cid) * 512 + c] = h;
            }
        }
        __syncthreads();
    }
}
__device__ __forceinline__ int scan_row(int d, int b, int q) {
    if (q < 256) return b * 256 + (d ? 255 - q : q);
    const int s = q - 256; return NCTX + b * 4096 + (d ? 4095 - s : s);
}
__device__ __forceinline__ void ph_scan_even(const Params& p, LAS unsigned char* lds, int bid, int nblk) {
    const int tid = threadIdx.x, wid = tid >> 6, lane = tid & 63;
    float* EA = (float*)(p.ws + WS_EARR);
    if (tid >= 256) {
        const float* CHA = (const float*)(p.ws + WS_CHA); const float* CHH = (const float*)(p.ws + WS_CHH); float* CIN = (float*)(p.ws + WS_CIN);
        for (int item = bid; item < 16; item += nblk) {
            const int gi = item * 256 + (tid - 256), d = gi >> 11, b = (gi >> 9) & 3, c = gi & 511;
            float carry = 0.f;
            for (int s0 = 0; s0 < 128; s0 += 16) {
                float av[16], hv[16];
#pragma unroll
                for (int k = 0; k < 16; ++k) { const int st = s0 + k; const int cl = d == 0 ? st : (st < 64 ? 63 - st : 191 - st);
                    const size_t o = (size_t)(d * 512 + b * 128 + cl) * 512 + c; av[k] = CHA[o]; hv[k] = CHH[o]; }
#pragma unroll
                for (int k = 0; k < 16; ++k) { const int st = s0 + k; const int cl = d == 0 ? st : (st < 64 ? 63 - st : 191 - st);
                    CIN[(size_t)(d * 512 + b * 128 + cl) * 512 + c] = carry; carry = av[k] * carry + hv[k]; }
            }
        }
    }
    constexpr int SBT = 32, STEPF = 336, NBATCH = 4352 / SBT;
    LAS float* bufs = (LAS float*)(lds + LDS_WORK);
    LAS float* obufs = bufs + 2 * SBT * STEPF;
    for (int w = bid; w < 256; w += nblk) {
        const int chain = w >> 2, rb = w & 3, d = chain >> 5, b = (chain >> 3) & 3, h = chain & 7;
        const float* Vp = EARR(E_V); float* Od = EARR(E_O0 + d);
        const int lt = tid - 256;
        f32x4 regs[11];
        auto issue = [&](int n) {
#pragma unroll
            for (int i = 0; i < 11; ++i) { const int idx = lt + 256 * i;
                if (idx < SBT * 84) { const int st = idx / 84, f = idx - st * 84; const int row = scan_row(d, b, n * SBT + st);
                    const int sel = f >> 4, karr = sel == 0 ? E_KK : sel == 1 ? E_W0 + d : sel == 2 ? E_KD0 + d : sel == 3 ? E_KKA0 + d : E_R;
                    const float* src = f < 80 ? EARR(karr) + (size_t)row * 512 + h * 64 + (f & 15) * 4 : Vp + (size_t)row * 512 + h * 64 + rb * 16 + (f - 80) * 4;
                    regs[i] = *(const f32x4*)src; } }
        };
        auto put = [&](int n) {
            LAS float* bp = bufs + (n & 1) * SBT * STEPF;
#pragma unroll
            for (int i = 0; i < 11; ++i) { const int idx = lt + 256 * i;
                if (idx < SBT * 84) { const int st = idx / 84, f = idx - st * 84; *(LAS f32x4*)(bp + st * STEPF + f * 4) = regs[i]; } }
        };
        if (tid >= 256) { issue(0); put(0); }
        __syncthreads();
        const int ri = lane >> 4, seg = lane & 15;
        float S0 = 0.f, S1 = 0.f, S2 = 0.f, S3 = 0.f;
        for (int n = 0; n < NBATCH; ++n) {
            if (tid >= 256) {
                if (n + 1 < NBATCH) issue(n + 1);
                if (n >= 1) { const LAS float* ob = obufs + ((n - 1) & 1) * SBT * 16; const int idx = lt * 2, st = idx >> 4, j = idx & 15;
                    const int row = scan_row(d, b, (n - 1) * SBT + st);
                    *(f32x2*)(Od + (size_t)row * 512 + h * 64 + rb * 16 + j) = *(const LAS f32x2*)(ob + idx); }
                if (n + 1 < NBATCH) put(n + 1);
            } else {
                const LAS float* bp = bufs + (n & 1) * SBT * STEPF; LAS float* ob = obufs + (n & 1) * SBT * 16;
#pragma unroll 4
                for (int st = 0; st < SBT; ++st) {
                    const LAS float* sp = bp + st * STEPF;
                    const f32x4 kk = *(const LAS f32x4*)(sp + seg * 4), wv = *(const LAS f32x4*)(sp + 64 + seg * 4), kd = *(const LAS f32x4*)(sp + 128 + seg * 4),
                                kka = *(const LAS f32x4*)(sp + 192 + seg * 4), rr = *(const LAS f32x4*)(sp + 256 + seg * 4);
                    const float vv = sp[320 + wid * 4 + ri];
                    const float dot = row16_sum((S0 * kk[0] + S1 * kk[1]) + (S2 * kk[2] + S3 * kk[3]));
                    S0 = (S0 * wv[0] + vv * kd[0]) - dot * kka[0]; S1 = (S1 * wv[1] + vv * kd[1]) - dot * kka[1];
                    S2 = (S2 * wv[2] + vv * kd[2]) - dot * kka[2]; S3 = (S3 * wv[3] + vv * kd[3]) - dot * kka[3];
                    const float o = row16_sum((S0 * rr[0] + S1 * rr[1]) + (S2 * rr[2] + S3 * rr[3]));
                    if (seg == 0) ob[st * 16 + wid * 4 + ri] = o;
                }
            }
            __syncthreads();
        }
        if (tid >= 256) { const LAS float* ob = obufs + ((NBATCH - 1) & 1) * SBT * 16; const int idx = lt * 2, st = idx >> 4, j = idx & 15;
            const int row = scan_row(d, b, (NBATCH - 1) * SBT + st);
            *(f32x2*)(Od + (size_t)row * 512 + h * 64 + rb * 16 + j) = *(const LAS f32x2*)(ob + idx); }
        __syncthreads();
    }
}
__device__ __forceinline__ void ph_fin_even(const Params& p, int bid, int nblk) {
    const int tid = threadIdx.x, wid = tid >> 6, c = tid;
    float* EA = (float*)(p.ws + WS_EARR);
    const float* BC = (const float*)(p.ws + WS_BC); const float* CIN = (const float*)(p.ws + WS_CIN);
    bf16_t* Y = (bf16_t*)(p.ws + WS_YMIX);
    const float gg = p.in[I_AGNG][c], gb = p.in[I_AGNB][c];
    for (int row = bid; row < MROWS; row += nblk) {
        const size_t o = (size_t)row * 512 + c;
        const float wkv = EARR(E_O0)[o] + EARR(E_O1)[o];
        const float mean = wave_sum(wkv) * (1.0f / 64.0f), dv = wkv - mean, var = wave_sum(dv * dv) * (1.0f / 64.0f);
        float y = dv * rsqrtf(var + 64e-5f) * gg + gb + BC[row * 8 + wid] * EARR(E_V)[o];
        y *= EARR(E_G)[o];
        Y[(size_t)row * 1024 + c] = f2bf(y);
        const int cid = row < NCTX ? (row >> 8) * 128 + ((row >> 2) & 63) : ((row - NCTX) >> 12) * 128 + 64 + (((row - NCTX) & 4095) >> 6);
        const float h0 = EARR(E_BX0)[o] + EARR(E_A0)[o] * CIN[(size_t)cid * 512 + c];
        const float h1 = EARR(E_BX1)[o] + EARR(E_A1)[o] * CIN[(size_t)(512 + cid) * 512 + c];
        Y[(size_t)row * 1024 + 512 + c] = f2bf((h0 + h1) * EARR(E_GATE)[o]);
    }
#undef EARR
}
template <int LAYER>
__device__ __forceinline__ void ph_ln1(const Params& p, LAS unsigned char* lds, int bid, int nblk) {
    const int tid = threadIdx.x, wid = tid >> 6, lane = tid & 63;
    LAS float* rwT = (LAS float*)(lds + LDS_WORK);
    for (int i = tid; i < 32768; i += NTHR) { const int k = i >> 5, e = i & 31; rwT[e * 1028 + k] = p.in[I_RW][(size_t)LAYER * 32768 + i]; }
    __syncthreads();
    const float* MOD = (const float*)(p.ws + WS_MOD);
    float* XS = (float*)(p.ws + WS_XS); const float* YP = (const float*)(p.ws + WS_YP); bf16_t* H = (bf16_t*)(p.ws + WS_H);
    int* TOPE = (int*)(p.ws + WS_TOPE); float* TOPW = (float*)(p.ws + WS_TOPW); int* TOPS = (int*)(p.ws + WS_TOPS);
    int* CNT = (int*)(p.ws + WS_CTL + CTL_CNT) + LAYER * 32;
    const float* lng = p.in[I_LNG] + (LAYER * 2 + 0) * 1024; const float* lnb = p.in[I_LNB] + (LAYER * 2 + 0) * 1024;
    for (int row = (LAYER == 0 ? 0 : NCTX) + bid * 8 + wid; row < MROWS; row += nblk * 8) {
        const float* res = LAYER == 0 ? (row < NCTX ? p.in[I_CTX] + (size_t)row * 1024 : p.in[I_X] + (size_t)(row - NCTX) * 1024) : XS + (size_t)row * 1024;
        const float* md = MOD + (size_t)(LAYER * 5 + row_modr(row)) * 6144;
        f32x4 v[4]; float s = 0.f;
#pragma unroll
        for (int q = 0; q < 4; ++q) { const int col = q * 256 + lane * 4;
            v[q] = *(const f32x4*)(res + col) * DN_ALPHA + *(const f32x4*)(md + 2048 + col) * *(const f32x4*)(YP + (size_t)row * 1024 + col);
            s += (v[q][0] + v[q][1]) + (v[q][2] + v[q][3]); }
        const float mean = wave_sum(s) * (1.0f / 1024.0f);
        float ss = 0.f;
#pragma unroll
        for (int q = 0; q < 4; ++q) { v[q] = v[q] - mean; ss += (v[q][0] * v[q][0] + v[q][1] * v[q][1]) + (v[q][2] * v[q][2] + v[q][3] * v[q][3]); }
        const float rstd = rsqrtf(wave_sum(ss) * (1.0f / 1024.0f) + LN_EPS);
#pragma unroll
        for (int q = 0; q < 4; ++q) { const int col = q * 256 + lane * 4;
            const f32x4 xn = v[q] * rstd * *(const f32x4*)(lng + col) + *(const f32x4*)(lnb + col);
            *(f32x4*)(XS + (size_t)row * 1024 + col) = xn;
            v[q] = xn * (*(const f32x4*)(md + 4096 + col) + 1.0f) + *(const f32x4*)(md + 3072 + col);
            u32x2 w; w.x = pack_bf16(v[q][0], v[q][1]); w.y = pack_bf16(v[q][2], v[q][3]);
            *(u32x2*)(H + (size_t)row * 1024 + col) = w; }
        float tv[4] = {-3.0e38f, -3.0e38f, -3.0e38f, -3.0e38f}; int te[4] = {0, 0, 0, 0};
#pragma unroll 2
        for (int e = 0; e < 32; ++e) { float a = 0.f;
#pragma unroll
            for (int q = 0; q < 4; ++q) { const f32x4 r = *(const LAS f32x4*)(rwT + e * 1028 + q * 256 + lane * 4); a += (v[q][0] * r[0] + v[q][1] * r[1]) + (v[q][2] * r[2] + v[q][3] * r[3]); }
            a = wave_sum(a) + p.in[I_RB][LAYER * 32 + e];
            const bool c0 = a > tv[0], c1 = a > tv[1], c2 = a > tv[2], c3 = a > tv[3];
            tv[3] = c2 ? tv[2] : (c3 ? a : tv[3]); te[3] = c2 ? te[2] : (c3 ? e : te[3]);
            tv[2] = c1 ? tv[1] : (c2 ? a : tv[2]); te[2] = c1 ? te[1] : (c2 ? e : te[2]);
            tv[1] = c0 ? tv[0] : (c1 ? a : tv[1]); te[1] = c0 ? te[0] : (c1 ? e : te[1]);
            tv[0] = c0 ? a : tv[0]; te[0] = c0 ? e : te[0]; }
        const float e1 = expf(tv[1] - tv[0]), e2 = expf(tv[2] - tv[0]), e3 = expf(tv[3] - tv[0]), inv = 1.0f / (1.0f + e1 + e2 + e3);
        if (lane == 0) {
            const float wv[4] = {inv, e1 * inv, e2 * inv, e3 * inv};
#pragma unroll
            for (int k = 0; k < 4; ++k) { const int slot = atomicAdd(&CNT[te[k]], 1); TOPE[row * 4 + k] = te[k]; TOPW[row * 4 + k] = wv[k]; TOPS[row * 4 + k] = slot; }
        }
    }
}
constexpr int LDS_TAB = LDS_WORK + 131072;
__device__ __forceinline__ int moe_tables(const int* cnt, LAS int* tab) {
    if (threadIdx.x == 0) { int o = 0, t = 0;
        for (int e = 0; e < 32; ++e) { tab[e] = o; const int n = (cnt[e] + 255) >> 8; for (int i = 0; i < n; ++i) tab[64 + t++] = e; o += n * 256; }
        tab[32] = o; tab[40] = t; }
    __syncthreads();
    return tab[40];
}
template <int LAYER>
__device__ __forceinline__ void ph_moe_gather(const Params& p, LAS unsigned char* lds, int bid, int nblk) {
    const int tid = threadIdx.x, wid = tid >> 6, lane = tid & 63;
    LAS int* tab = (LAS int*)(lds + LDS_TAB);
    (void)moe_tables((const int*)(p.ws + WS_CTL + CTL_CNT) + LAYER * 32, tab);
    const int* TOPE = (const int*)(p.ws + WS_TOPE); const int* TOPS = (const int*)(p.ws + WS_TOPS); int* POS = (int*)(p.ws + WS_POS);
    const bf16_t* H = (const bf16_t*)(p.ws + WS_H); bf16_t* AS = (bf16_t*)(p.ws + WS_ASORT);
    for (int row = (LAYER == 0 ? 0 : NCTX) + bid * 8 + wid; row < MROWS; row += nblk * 8) {
        const u32x4 a = *(const u32x4*)(H + (size_t)row * 1024 + lane * 16), b = *(const u32x4*)(H + (size_t)row * 1024 + lane * 16 + 8);
#pragma unroll
        for (int k = 0; k < 4; ++k) {
            const int pos = tab[TOPE[row * 4 + k]] + TOPS[row * 4 + k];
            if (lane == 0) POS[row * 4 + k] = pos;
            *(u32x4*)(AS + (size_t)pos * 1024 + lane * 16) = a; *(u32x4*)(AS + (size_t)pos * 1024 + lane * 16 + 8) = b;
        }
    }
}
template <int LAYER>
__device__ __forceinline__ void ph_moe_gemm1(const Params& p, LAS unsigned char* lds, int bid, int nblk) {
    LAS int* tab = (LAS int*)(lds + LDS_TAB);
    const int T = moe_tables((const int*)(p.ws + WS_CTL + CTL_CNT) + LAYER * 32, tab);
    pg8::SchedMoe S{T, 8, nblk, bid, tab + 64};
    pg8::Gemm g{(const bf16_t*)(p.ws + WS_ASORT), (const bf16_t*)(p.ws + WS_W1T) + (size_t)LAYER * 32 * 2048 * 1024, 0, 0, 1024};
    pg8::EpiAct E{(bf16_t*)(p.ws + WS_ACT), p.in[I_B1] + (size_t)LAYER * 32 * 2048};
    pg8::gemm_phase<pg8::EpiAct, pg8::SchedMoe, false>(lds + LDS_WORK, g, S, E, nullptr);
}
template <int LAYER>
__device__ __forceinline__ void ph_moe_gemm2(const Params& p, LAS unsigned char* lds, int bid, int nblk) {
    LAS int* tab = (LAS int*)(lds + LDS_TAB);
    const int T = moe_tables((const int*)(p.ws + WS_CTL + CTL_CNT) + LAYER * 32, tab);
    pg8::SchedMoe S{T, 4, nblk, bid, tab + 64};
    pg8::Gemm g{(const bf16_t*)(p.ws + WS_ACT), (const bf16_t*)(p.ws + WS_W2T) + (size_t)LAYER * 32 * 1024 * 1024, 0, 0, 1024};
    pg8::EpiYE E{(float*)(p.ws + WS_YE), p.in[I_B2] + (size_t)LAYER * 32 * 1024};
    pg8::gemm_phase<pg8::EpiYE, pg8::SchedMoe, false>(lds + LDS_WORK, g, S, E, nullptr);
}
__device__ __forceinline__ void ph_gemm_dense(LAS unsigned char* lds, const bf16_t* A, const bf16_t* Bt, float* C, int ldc, int pm0, int nM, int nN, int bid, int nblk) {
    pg8::SchedDense S{nM, nN, pm0, nblk, bid};
    pg8::Gemm g{A, Bt, 0, 0, 1024};
    pg8::EpiStore E{C, ldc};
    pg8::gemm_phase<pg8::EpiStore, pg8::SchedDense, false>(lds + LDS_WORK, g, S, E, nullptr);
}
template <int LAYER>
__device__ __forceinline__ void ph_ln2(const Params& p, LAS unsigned char* lds, int bid, int nblk) {
    const int tid = threadIdx.x, wid = tid >> 6, lane = tid & 63;
    LAS float* wgT = (LAS float*)(lds + LDS_WORK);
    if (LAYER == 0) {
        for (int i = tid; i < 16384; i += NTHR) { const int k = i >> 4, g = i & 15; wgT[g * 1028 + k] = p.in[I_OWIN][(size_t)k * ODD_IN + 4096 + g]; }
        __syncthreads();
    }
    const float* MOD = (const float*)(p.ws + WS_MOD);
    float* XS = (float*)(p.ws + WS_XS); const float* YE = (const float*)(p.ws + WS_YE); bf16_t* H = (bf16_t*)(p.ws + WS_H); float* GT = (float*)(p.ws + WS_GT);
    const float* TOPW = (const float*)(p.ws + WS_TOPW); const int* POS = (const int*)(p.ws + WS_POS);
    const float* lng = p.in[I_LNG] + (LAYER * 2 + 1) * 1024; const float* lnb = p.in[I_LNB] + (LAYER * 2 + 1) * 1024;
    for (int row = (LAYER == 0 ? 0 : NCTX) + bid * 8 + wid; row < MROWS; row += nblk * 8) {
        const float* md = MOD + (size_t)(LAYER * 5 + row_modr(row)) * 6144;
        const float w0 = TOPW[row * 4], w1 = TOPW[row * 4 + 1], w2 = TOPW[row * 4 + 2], w3 = TOPW[row * 4 + 3];
        const float* y0 = YE + (size_t)POS[row * 4] * 1024; const float* y1 = YE + (size_t)POS[row * 4 + 1] * 1024;
        const float* y2 = YE + (size_t)POS[row * 4 + 2] * 1024; const float* y3 = YE + (size_t)POS[row * 4 + 3] * 1024;
        f32x4 v[4]; float s = 0.f;
#pragma unroll
        for (int q = 0; q < 4; ++q) { const int col = q * 256 + lane * 4;
            const f32x4 ffn = (*(const f32x4*)(y0 + col) * w0 + *(const f32x4*)(y1 + col) * w1) + (*(const f32x4*)(y2 + col) * w2 + *(const f32x4*)(y3 + col) * w3);
            v[q] = *(const f32x4*)(XS + (size_t)row * 1024 + col) * DN_ALPHA + *(const f32x4*)(md + 5120 + col) * ffn;
            s += (v[q][0] + v[q][1]) + (v[q][2] + v[q][3]); }
        const float mean = wave_sum(s) * (1.0f / 1024.0f);
        float ss = 0.f;
#pragma unroll
        for (int q = 0; q < 4; ++q) { v[q] = v[q] - mean; ss += (v[q][0] * v[q][0] + v[q][1] * v[q][1]) + (v[q][2] * v[q][2] + v[q][3] * v[q][3]); }
        const float rstd = rsqrtf(wave_sum(ss) * (1.0f / 1024.0f) + LN_EPS);
        if (LAYER == 1) {
#pragma unroll
            for (int q = 0; q < 4; ++q) { const int col = q * 256 + lane * 4;
                *(f32x4*)(p.out + (size_t)(row - NCTX) * 1024 + col) = v[q] * rstd * *(const f32x4*)(lng + col) + *(const f32x4*)(lnb + col); }
        } else {
            const float* md1 = MOD + (size_t)(5 + row_modr(row)) * 6144;
#pragma unroll
            for (int q = 0; q < 4; ++q) { const int col = q * 256 + lane * 4;
                const f32x4 xn = v[q] * rstd * *(const f32x4*)(lng + col) + *(const f32x4*)(lnb + col);
                *(f32x4*)(XS + (size_t)row * 1024 + col) = xn;
                v[q] = xn * (*(const f32x4*)(md1 + 1024 + col) + 1.0f) + *(const f32x4*)(md1 + col);
                u32x2 w; w.x = pack_bf16(v[q][0], v[q][1]); w.y = pack_bf16(v[q][2], v[q][3]);
                *(u32x2*)(H + (size_t)row * 1024 + col) = w; }
            float gt = 0.f;
#pragma unroll 2
            for (int g = 0; g < 16; ++g) { float a = 0.f;
#pragma unroll
                for (int q = 0; q < 4; ++q) { const f32x4 r = *(const LAS f32x4*)(wgT + g * 1028 + q * 256 + lane * 4); a += (v[q][0] * r[0] + v[q][1] * r[1]) + (v[q][2] * r[2] + v[q][3] * r[3]); }
                a = wave_sum(a); gt = lane == g ? a : gt; }
            if (lane < 16) GT[row * 16 + lane] = gt;
        }
    }
}
constexpr int LDK = 136;
__device__ __forceinline__ int sid_of(int mixer, int dir, int b, int ch, int h) { return (((mixer * 2 + dir) * 4 + b) * NCHUNK + ch) * 4 + h; }
__device__ __forceinline__ void unit_decode(int u, int& mixer, int& h, int& ch, int& b, int& row0) {
    mixer = u & 1; h = (u >> 1) & 3; const int rest = u >> 3; ch = rest % NCHUNK; b = rest / NCHUNK;
    row0 = ch < 2 ? b * 256 + ch * 128 : NCTX + b * 4096 + (ch - 2) * 128;
}
__device__ __forceinline__ void ld_rows(const float* P, int row0, int col, bool rope, int s0, const float* ROPE, float (&lo)[16], float (&hi)[16]) {
    const int t = threadIdx.x, i = t >> 2, part = t & 3, pr = part & 1, hf = part >> 1, i0 = pr * 32 + hf * 16;
    const float* src = P + (size_t)(row0 + i) * LDP1 + col + i0;
#pragma unroll
    for (int jj = 0; jj < 16; jj += 4) { const f32x4 a = *(const f32x4*)(src + jj), b = *(const f32x4*)(src + 64 + jj);
        lo[jj] = a[0]; lo[jj + 1] = a[1]; lo[jj + 2] = a[2]; lo[jj + 3] = a[3]; hi[jj] = b[0]; hi[jj + 1] = b[1]; hi[jj + 2] = b[2]; hi[jj + 3] = b[3]; }
    if (rope) {
        const int s = s0 + i, pos = pr == 0 ? (s >> 6) : (s & 63);
        const float* rp = ROPE + (size_t)(pos * 32 + hf * 16) * 2;
#pragma unroll
        for (int jj = 0; jj < 16; ++jj) { const float c = rp[2 * jj], sn = rp[2 * jj + 1], a = lo[jj], b = hi[jj]; lo[jj] = a * c - b * sn; hi[jj] = a * sn + b * c; }
    }
}
__device__ __forceinline__ void st_rows(LAS bf16_t* dst, const float (&lo)[16], const float (&hi)[16], float scale) {
    const int t = threadIdx.x, i = t >> 2, part = t & 3, i0 = (part & 1) * 32 + (part >> 1) * 16;
    u32x4 w0, w1, w2, w3;
    w0.x = pack_bf16(lo[0] * scale, lo[1] * scale); w0.y = pack_bf16(lo[2] * scale, lo[3] * scale); w0.z = pack_bf16(lo[4] * scale, lo[5] * scale); w0.w = pack_bf16(lo[6] * scale, lo[7] * scale);
    w1.x = pack_bf16(lo[8] * scale, lo[9] * scale); w1.y = pack_bf16(lo[10] * scale, lo[11] * scale); w1.z = pack_bf16(lo[12] * scale, lo[13] * scale); w1.w = pack_bf16(lo[14] * scale, lo[15] * scale);
    w2.x = pack_bf16(hi[0] * scale, hi[1] * scale); w2.y = pack_bf16(hi[2] * scale, hi[3] * scale); w2.z = pack_bf16(hi[4] * scale, hi[5] * scale); w2.w = pack_bf16(hi[6] * scale, hi[7] * scale);
    w3.x = pack_bf16(hi[8] * scale, hi[9] * scale); w3.y = pack_bf16(hi[10] * scale, hi[11] * scale); w3.z = pack_bf16(hi[12] * scale, hi[13] * scale); w3.w = pack_bf16(hi[14] * scale, hi[15] * scale);
    LAS bf16_t* d = dst + i * LDK + i0;
    *(LAS u32x4*)d = w0; *(LAS u32x4*)(d + 8) = w1; *(LAS u32x4*)(d + 64) = w2; *(LAS u32x4*)(d + 72) = w3;
}
__device__ __forceinline__ void st_rows_T(LAS bf16_t* dst, const float (&lo)[16], const float (&hi)[16], float scale) {
    const int t = threadIdx.x, i = t >> 2, part = t & 3, i0 = (part & 1) * 32 + (part >> 1) * 16;
#pragma unroll
    for (int jj = 0; jj < 16; ++jj) { dst[(i0 + jj) * LDK + i] = f2bf(lo[jj] * scale); dst[(i0 + 64 + jj) * LDK + i] = f2bf(hi[jj] * scale); }
}
__device__ __forceinline__ void mma_128(const LAS bf16_t* A, const LAS bf16_t* B, f32x4 (&acc)[2][4], int wr, int wc, int lane) {
    const int fr = lane & 15, fq = lane >> 4;
#pragma unroll
    for (int ks = 0; ks < 4; ++ks) {
        bf16x8 a[2], b[4];
#pragma unroll
        for (int mt = 0; mt < 2; ++mt) a[mt] = *(const LAS bf16x8*)(A + (wr * 32 + mt * 16 + fr) * LDK + ks * 32 + fq * 8);
#pragma unroll
        for (int nt = 0; nt < 4; ++nt) b[nt] = *(const LAS bf16x8*)(B + (wc * 64 + nt * 16 + fr) * LDK + ks * 32 + fq * 8);
#pragma unroll
        for (int mt = 0; mt < 2; ++mt)
#pragma unroll
            for (int nt = 0; nt < 4; ++nt) acc[mt][nt] = __builtin_amdgcn_mfma_f32_16x16x32_bf16(a[mt], b[nt], acc[mt][nt], 0, 0, 0);
    }
}
__device__ __forceinline__ void zero_acc(f32x4 (&acc)[2][4]) {
#pragma unroll
    for (int mt = 0; mt < 2; ++mt)
#pragma unroll
        for (int nt = 0; nt < 4; ++nt) acc[mt][nt] = (f32x4){0.f, 0.f, 0.f, 0.f};
}
__device__ __forceinline__ void ph_c1(const Params& p, LAS unsigned char* lds, int bid, int nblk) {
    const int tid = threadIdx.x, wid = tid >> 6, lane = tid & 63, wr = wid >> 1, wc = wid & 1, fr = lane & 15, fq = lane >> 4;
    LAS bf16_t* KsT = (LAS bf16_t*)(lds + LDS_WORK); LAS bf16_t* VsT0 = KsT + 128 * LDK; LAS bf16_t* VsT1 = VsT0 + 128 * LDK;
    LAS float* z = (LAS float*)(VsT1 + 128 * LDK);
    LAS float* lfA = z + 256; LAS float* igA = lfA + 256; LAS float* zmax = igA + 256;
    const float* P = (const float*)(p.ws + WS_P); const float* GT = (const float*)(p.ws + WS_GT); const float* ROPE = (const float*)(p.ws + WS_ROPE);
    float* ST = (float*)(p.ws + WS_ST); float* NST = (float*)(p.ws + WS_NST); float* MEND = (float*)(p.ws + WS_MEND); float* BEND = (float*)(p.ws + WS_BEND);
    for (int u = bid; u < NB * NCHUNK * 4 * 2; u += nblk) {
        int mixer, h, ch, b, row0; unit_decode(u, mixer, h, ch, b, row0);
        const int colQ = mixer * 2048 + h * 128;
        if (mixer == 0) {
            if (tid < 256) { const int dir = tid >> 7, j = tid & 127; const float lg = p.in[I_CLG][dir * 4 + h]; z[tid] = expf(lg * (float)(dir == 0 ? 127 - j : j)); }
        } else {
            if (tid < 256) { const int dir = tid >> 7, j = tid & 127, row = row0 + j;
                igA[tid] = GT[row * 16 + dir * 4 + h] + p.in[I_DIB][dir * 4 + h];
                lfA[tid] = -softplusf(-(GT[row * 16 + 8 + dir * 4 + h] + p.in[I_DFB][dir * 4 + h])); }
            __syncthreads();
            if (tid == 0 || tid == 64) { const int dir = tid >> 6; float total = 0.f;
                for (int j = 0; j < 128; ++j) total += lfA[dir * 128 + j];
                float run = 0.f, mx = -3.0e38f;
                for (int j = 0; j < 128; ++j) { const float lf = lfA[dir * 128 + j]; run += lf;
                    const float we = (dir == 0 ? total - run : run - lf) + igA[dir * 128 + j]; z[dir * 128 + j] = we; mx = fmaxf(mx, we); }
                zmax[dir] = mx; const int sid = sid_of(1, dir, b, ch, h); MEND[sid] = mx; BEND[sid] = total; }
            __syncthreads();
            if (tid < 256) z[tid] = expf(z[tid] - zmax[tid >> 7]);
        }
        __syncthreads();
        {
            float lo[16], hi[16];
            ld_rows(P, row0, colQ + 512, mixer == 0 && ch >= 2, (ch - 2) * 128, ROPE, lo, hi);
            st_rows_T(KsT, lo, hi, 0.08838834764831845f);
            ld_rows(P, row0, colQ + 1024, false, 0, ROPE, lo, hi);
            const int i = tid >> 2;
            st_rows_T(VsT0, lo, hi, z[i]); st_rows_T(VsT1, lo, hi, z[128 + i]);
        }
        __syncthreads();
#pragma unroll
        for (int dir = 0; dir < 2; ++dir) {
            f32x4 acc[2][4]; zero_acc(acc);
            mma_128(dir == 0 ? VsT0 : VsT1, KsT, acc, wr, wc, lane);
            float* dst = ST + (size_t)sid_of(mixer, dir, b, ch, h) * 16384;
#pragma unroll
            for (int mt = 0; mt < 2; ++mt)
#pragma unroll
                for (int nt = 0; nt < 4; ++nt)
#pragma unroll
                    for (int r = 0; r < 4; ++r) dst[(wr * 32 + mt * 16 + fq * 4 + r) * 128 + wc * 64 + nt * 16 + fr] = acc[mt][nt][r];
        }
        if (mixer == 1 && tid < 256) { const int dir = tid >> 7, dd = tid & 127; float s = 0.f;
            for (int j = 0; j < 128; ++j) s += z[dir * 128 + j] * bf2f(KsT[dd * LDK + j]);
            NST[(size_t)sid_of(1, dir, b, ch, h) * 128 + dd] = s; }
        __syncthreads();
    }
}
__device__ __forceinline__ void ph_c2(const Params& p, int bid, int nblk) {
    const int tid = threadIdx.x;
    float* ST = (float*)(p.ws + WS_ST); float* NST = (float*)(p.ws + WS_NST);
    const float* MEND = (const float*)(p.ws + WS_MEND); const float* BEND = (const float*)(p.ws + WS_BEND); float* MPREV = (float*)(p.ws + WS_MPREV);
    for (int item = bid; item < 2048; item += nblk) {
        const int mixer = item >> 10, chain = (item >> 5) & 31, slab = item & 31, dir = chain >> 4, b = (chain >> 2) & 3, h = chain & 3;
        const int idx = slab * 512 + tid;
        float kv[NCHUNK];
#pragma unroll
        for (int k = 0; k < NCHUNK; ++k) { const int ch = dir == 0 ? k : (k < 2 ? 1 - k : 35 - k); kv[k] = ST[(size_t)sid_of(mixer, dir, b, ch, h) * 16384 + idx]; }
        if (mixer == 0) {
            const float gdec = expf(p.in[I_CLG][dir * 4 + h] * 128.0f); float r = 0.f;
#pragma unroll
            for (int k = 0; k < NCHUNK; ++k) { const int ch = dir == 0 ? k : (k < 2 ? 1 - k : 35 - k); ST[(size_t)sid_of(0, dir, b, ch, h) * 16384 + idx] = r; r = r * gdec + kv[k]; }
        } else {
            const bool do_n = slab == 0 && tid < 128;
            float nv[NCHUNK];
#pragma unroll
            for (int k = 0; k < NCHUNK; ++k) { const int ch = dir == 0 ? k : (k < 2 ? 1 - k : 35 - k); nv[k] = do_n ? NST[(size_t)sid_of(1, dir, b, ch, h) * 128 + tid] : 0.f; }
            float m = -__builtin_inff(), c = 0.f, n = 0.f;
#pragma unroll
            for (int k = 0; k < NCHUNK; ++k) { const int ch = dir == 0 ? k : (k < 2 ? 1 - k : 35 - k); const int sid = sid_of(1, dir, b, ch, h);
                const float me = MEND[sid], be = BEND[sid], mnew = fmaxf(be + m, me), so = expf(be + m - mnew), sn = expf(me - mnew);
                ST[(size_t)sid * 16384 + idx] = c; c = c * so + kv[k] * sn;
                if (do_n) { NST[(size_t)sid * 128 + tid] = n; n = n * so + nv[k] * sn; }
                if (slab == 0 && tid == 0) MPREV[sid] = m;
                m = mnew; }
        }
    }
}
template <int mixer>
__device__ __forceinline__ void c3_unit(const Params& p, LAS unsigned char* lds, int h, int ch, int b, int row0) {
    const int tid = threadIdx.x, wid = tid >> 6, lane = tid & 63, wr = wid >> 1, wc = wid & 1, fr = lane & 15, fq = lane >> 4;
    LAS bf16_t* Qs = (LAS bf16_t*)(lds + LDS_WORK); LAS bf16_t* Ks = Qs + 128 * LDK; LAS bf16_t* VsT = Ks + 128 * LDK; LAS bf16_t* RT = VsT + 128 * LDK;
    LAS float* fa = (LAS float*)(RT + 128 * LDK);
    LAS float* lfA = fa; LAS float* igA = fa + 256; LAS float* bA = fa + 512; LAS float* miA = fa + 768; LAS float* mtA = fa + 1024; LAS float* sintA = fa + 1280;
    LAS float* rowsum = fa + 1536; LAS float* qn = fa + 2048; LAS float* nA = fa + 2304;
    LAS float* Os = (LAS float*)Qs;
    LAS bf16_t* Pm = Ks;
    const float* P = (const float*)(p.ws + WS_P); const float* GT = (const float*)(p.ws + WS_GT); const float* ROPE = (const float*)(p.ws + WS_ROPE);
    const float* ST = (const float*)(p.ws + WS_ST); const float* NST = (const float*)(p.ws + WS_NST); const float* MPREV = (const float*)(p.ws + WS_MPREV);
    bf16_t* Y = (bf16_t*)(p.ws + WS_YMIX);
    {
        const int colQ = mixer * 2048 + h * 128; const bool rope = mixer == 0 && ch >= 2;
        {
            float lo[16], hi[16];
            ld_rows(P, row0, colQ, rope, (ch - 2) * 128, ROPE, lo, hi); st_rows(Qs, lo, hi, 1.0f);
            ld_rows(P, row0, colQ + 512, rope, (ch - 2) * 128, ROPE, lo, hi); st_rows(Ks, lo, hi, 0.08838834764831845f);
            ld_rows(P, row0, colQ + 1024, false, 0, ROPE, lo, hi); st_rows_T(VsT, lo, hi, 1.0f);
        }
        if (mixer == 1) {
            if (tid < 256) { const int dir = tid >> 7, j = tid & 127, row = row0 + j;
                igA[tid] = GT[row * 16 + dir * 4 + h] + p.in[I_DIB][dir * 4 + h];
                lfA[tid] = -softplusf(-(GT[row * 16 + 8 + dir * 4 + h] + p.in[I_DFB][dir * 4 + h]));
                nA[tid] = NST[(size_t)sid_of(1, dir, b, ch, h) * 128 + j]; }
            __syncthreads();
            if (tid == 0) { float run = 0.f, pm = -3.0e38f;
                for (int j = 0; j < 128; ++j) { run += lfA[j]; pm = fmaxf(pm, igA[j] - run); bA[j] = run; miA[j] = run + pm; } }
            if (tid == 64) { float run = 0.f, pm = -3.0e38f;
                for (int j = 127; j >= 0; --j) { run += lfA[128 + j]; pm = fmaxf(pm, igA[128 + j] - run); bA[128 + j] = run; miA[128 + j] = run + pm; } }
            __syncthreads();
            if (tid < 256) { const int dir = tid >> 7, i = tid & 127; const float mprev = MPREV[sid_of(1, dir, b, ch, h)];
                const float gi = bA[tid] + mprev, mt = fmaxf(gi, miA[tid]); mtA[tid] = mt; sintA[tid] = expf(gi - mt);
                float s = 0.f;
                for (int d0 = 0; d0 < 128; ++d0) s += bf2f(Qs[i * LDK + d0]) * nA[dir * 128 + d0];
                qn[tid] = s; }
        }
        __syncthreads();
        f32x4 S[2][4]; zero_acc(S);
        mma_128(Qs, Ks, S, wr, wc, lane);
        __syncthreads();
        f32x4 O[2][4]; zero_acc(O);
        if (mixer == 0) {
            const float lg0 = p.in[I_CLG][h], lg1 = p.in[I_CLG][4 + h];
#pragma unroll
            for (int mt = 0; mt < 2; ++mt)
#pragma unroll
                for (int nt = 0; nt < 4; ++nt)
#pragma unroll
                    for (int r = 0; r < 4; ++r) { const int i = wr * 32 + mt * 16 + fq * 4 + r, j = wc * 64 + nt * 16 + fr;
                        const float dcy = (i >= j ? expf(lg0 * (float)(i - j)) : 0.f) + (j >= i ? expf(lg1 * (float)(j - i)) : 0.f);
                        Pm[i * LDK + j] = f2bf(S[mt][nt][r] * dcy); }
            __syncthreads();
            mma_128(Pm, VsT, O, wr, wc, lane);
#pragma unroll
            for (int dir = 0; dir < 2; ++dir) {
                { const float* src = ST + (size_t)sid_of(0, dir, b, ch, h) * 16384 + (tid >> 2) * 128 + (tid & 3) * 32; LAS bf16_t* d = RT + (tid >> 2) * LDK + (tid & 3) * 32;
#pragma unroll
                    for (int q = 0; q < 4; ++q) { const f32x4 a = *(const f32x4*)(src + q * 8), c2 = *(const f32x4*)(src + q * 8 + 4);
                        u32x4 w; w.x = pack_bf16(a[0], a[1]); w.y = pack_bf16(a[2], a[3]); w.z = pack_bf16(c2[0], c2[1]); w.w = pack_bf16(c2[2], c2[3]); *(LAS u32x4*)(d + q * 8) = w; } }
                __syncthreads();
                f32x4 T[2][4]; zero_acc(T);
                mma_128(Qs, RT, T, wr, wc, lane);
#pragma unroll
                for (int mt = 0; mt < 2; ++mt)
#pragma unroll
                    for (int r = 0; r < 4; ++r) { const int i = wr * 32 + mt * 16 + fq * 4 + r; const float xi = dir == 0 ? expf(lg0 * (float)(i + 1)) : expf(lg1 * (float)(128 - i));
#pragma unroll
                        for (int nt = 0; nt < 4; ++nt) O[mt][nt][r] += xi * T[mt][nt][r]; }
                __syncthreads();
            }
        } else {
#pragma unroll
            for (int dir = 0; dir < 2; ++dir) {
                float rp[2][4];
#pragma unroll
                for (int mt = 0; mt < 2; ++mt)
#pragma unroll
                    for (int r = 0; r < 4; ++r) { const int i = wr * 32 + mt * 16 + fq * 4 + r; const float bi = bA[dir * 128 + i] - mtA[dir * 128 + i]; float acc = 0.f;
#pragma unroll
                        for (int nt = 0; nt < 4; ++nt) { const int j = wc * 64 + nt * 16 + fr; const bool valid = dir == 0 ? (j <= i) : (j >= i);
                            const float e = valid ? expf(bi - bA[dir * 128 + j] + igA[dir * 128 + j]) : 0.f; const float pv = S[mt][nt][r] * e;
                            Pm[i * LDK + j] = f2bf(pv); acc += pv; }
                        rp[mt][r] = row16_sum(acc); }
                if (fr == 0) {
#pragma unroll
                    for (int mt = 0; mt < 2; ++mt)
#pragma unroll
                        for (int r = 0; r < 4; ++r) rowsum[wc * 256 + dir * 128 + wr * 32 + mt * 16 + fq * 4 + r] = rp[mt][r];
                }
                { const float* src = ST + (size_t)sid_of(1, dir, b, ch, h) * 16384 + (tid >> 2) * 128 + (tid & 3) * 32; LAS bf16_t* d = RT + (tid >> 2) * LDK + (tid & 3) * 32;
#pragma unroll
                    for (int q = 0; q < 4; ++q) { const f32x4 a = *(const f32x4*)(src + q * 8), c2 = *(const f32x4*)(src + q * 8 + 4);
                        u32x4 w; w.x = pack_bf16(a[0], a[1]); w.y = pack_bf16(a[2], a[3]); w.z = pack_bf16(c2[0], c2[1]); w.w = pack_bf16(c2[2], c2[3]); *(LAS u32x4*)(d + q * 8) = w; } }
                __syncthreads();
                f32x4 T[2][4]; zero_acc(T);
                mma_128(Qs, RT, T, wr, wc, lane);
#pragma unroll
                for (int mt = 0; mt < 2; ++mt)
#pragma unroll
                    for (int r = 0; r < 4; ++r) { const float si = sintA[dir * 128 + wr * 32 + mt * 16 + fq * 4 + r];
#pragma unroll
                        for (int nt = 0; nt < 4; ++nt) T[mt][nt][r] *= si; }
                mma_128(Pm, VsT, T, wr, wc, lane);
#pragma unroll
                for (int mt = 0; mt < 2; ++mt)
#pragma unroll
                    for (int r = 0; r < 4; ++r) { const int i = wr * 32 + mt * 16 + fq * 4 + r; const float si = sintA[dir * 128 + i];
                        float den = (rowsum[dir * 128 + i] + rowsum[256 + dir * 128 + i]) + qn[dir * 128 + i] * si; den = fmaxf(fabsf(den), expf(-mtA[dir * 128 + i])); const float rden = 1.0f / den;
#pragma unroll
                        for (int nt = 0; nt < 4; ++nt) O[mt][nt][r] += T[mt][nt][r] * rden; }
                __syncthreads();
            }
        }
#pragma unroll
        for (int mt = 0; mt < 2; ++mt)
#pragma unroll
            for (int nt = 0; nt < 4; ++nt)
#pragma unroll
                for (int r = 0; r < 4; ++r) Os[(wr * 32 + mt * 16 + fq * 4 + r) * 132 + wc * 64 + nt * 16 + fr] = O[mt][nt][r];
        __syncthreads();
        {
            const float* gng = (mixer == 0 ? p.in[I_CGNG] : p.in[I_DGNG]) + h * 128; const float* gnb = (mixer == 0 ? p.in[I_CGNB] : p.in[I_DGNB]) + h * 128;
            const float g0 = gng[lane], g1 = gng[lane + 64], b0 = gnb[lane], b1 = gnb[lane + 64];
            for (int ii = 0; ii < 16; ++ii) { const int i = wid * 16 + ii, row = row0 + i;
                const float x0 = Os[i * 132 + lane], x1 = Os[i * 132 + 64 + lane];
                const float mean = wave_sum(x0 + x1) * (1.0f / 128.0f), d0 = x0 - mean, d1 = x1 - mean;
                const float rstd = rsqrtf(wave_sum(d0 * d0 + d1 * d1) * (1.0f / 128.0f) + LN_EPS);
                const float q0 = P[(size_t)row * LDP1 + colQ + 1536 + lane], q1 = P[(size_t)row * LDP1 + colQ + 1536 + 64 + lane];
                const float s0 = sigm(q0), s1 = sigm(q1);
                const float y0 = (d0 * rstd * g0 + b0) * (mixer == 0 ? q0 * s0 : s0), y1 = (d1 * rstd * g1 + b1) * (mixer == 0 ? q1 * s1 : s1);
                Y[(size_t)row * 1024 + mixer * 512 + h * 128 + lane] = f2bf(y0); Y[(size_t)row * 1024 + mixer * 512 + h * 128 + 64 + lane] = f2bf(y1); }
        }
        __syncthreads();
    }
}
__device__ __forceinline__ void ph_c3(const Params& p, LAS unsigned char* lds, int bid, int nblk) {
    for (int u2 = bid; u2 < NB * NCHUNK * 4; u2 += nblk) {
        int mixer, h, ch, b, row0; unit_decode(u2 * 2, mixer, h, ch, b, row0);
        c3_unit<0>(p, lds, h, ch, b, row0);
    }
    for (int u2 = nblk - 1 - bid; u2 < NB * NCHUNK * 4; u2 += nblk) {
        int mixer, h, ch, b, row0; unit_decode(u2 * 2 + 1, mixer, h, ch, b, row0);
        c3_unit<1>(p, lds, h, ch, b, row0);
    }
}
constexpr int NPHASE = 22;
__global__ void __launch_bounds__(NTHR, 2) fwd(Params p) {
    extern __shared__ __attribute__((aligned(16))) unsigned char smem_raw[];
    LAS unsigned char* lds = (LAS unsigned char*)smem_raw;
    if (threadIdx.x == 0) { LAS unsigned* st = (LAS unsigned*)(lds + LDS_BAR); st[0] = 0u; st[1] = 0u; st[2] = 0u; st[3] = 0u; }
    __syncthreads();
    XcdBarrier bar = xcd_barrier_post((unsigned*)(p.ws + WS_CTL), (volatile LAS unsigned*)(lds + LDS_BAR));
    const int bid = blockIdx.x, nblk = gridDim.x;
    unsigned char* ws = p.ws;
#ifndef PHASE_ONLY
#define PHASE_ONLY -1
#endif
#define PHASE(k, call) if constexpr (PHASE_ONLY < 0 || PHASE_ONLY == (k)) { if (p.lo <= (k) && (k) < p.hi) { call; if ((k) + 1 < p.hi) xcd_barrier(bar); } }
    PHASE(0, ph_prologue(p, lds, bid, nblk))
    PHASE(1, ph_mod_in(p, bid, nblk))
    PHASE(2, ph_gemm_dense(lds, (const bf16_t*)(ws + WS_H), (const bf16_t*)(ws + WS_WIN0T), (float*)(ws + WS_P), LDP0, 0, 68, 12, bid, nblk))
    PHASE(3, ph_prep_even(p, lds, bid, nblk))
    PHASE(4, ph_scan_even(p, lds, bid, nblk))
    PHASE(5, ph_fin_even(p, bid, nblk))
    PHASE(6, ph_gemm_dense(lds, (const bf16_t*)(ws + WS_YMIX), (const bf16_t*)(ws + WS_WOUTT), (float*)(ws + WS_YP), 1024, 0, 68, 4, bid, nblk))
    PHASE(7, ph_ln1<0>(p, lds, bid, nblk))
    PHASE(8, ph_moe_gather<0>(p, lds, bid, nblk))
    PHASE(9, ph_moe_gemm1<0>(p, lds, bid, nblk))
    PHASE(10, ph_moe_gemm2<0>(p, lds, bid, nblk))
    PHASE(11, ph_ln2<0>(p, lds, bid, nblk))
    PHASE(12, ph_gemm_dense(lds, (const bf16_t*)(ws + WS_H), (const bf16_t*)(ws + WS_WIN1T), (float*)(ws + WS_P), LDP1, 0, 68, 16, bid, nblk))
    PHASE(13, ph_c1(p, lds, bid, nblk))
    PHASE(14, ph_c2(p, bid, nblk))
    PHASE(15, ph_c3(p, lds, bid, nblk))
    PHASE(16, ph_gemm_dense(lds, (const bf16_t*)(ws + WS_YMIX), (const bf16_t*)(ws + WS_WOUTT) + (size_t)1024 * 1024, (float*)(ws + WS_YP), 1024, 4, 64, 4, bid, nblk))
    PHASE(17, ph_ln1<1>(p, lds, bid, nblk))
    PHASE(18, ph_moe_gather<1>(p, lds, bid, nblk))
    PHASE(19, ph_moe_gemm1<1>(p, lds, bid, nblk))
    PHASE(20, ph_moe_gemm2<1>(p, lds, bid, nblk))
    PHASE(21, ph_ln2<1>(p, lds, bid, nblk))
#undef PHASE
}

#ifndef MK_ONE_LAUNCH
#define MK_ONE_LAUNCH 1
#endif
extern "C" void kernel_launch(void* const* d_in, const int* in_sizes, int n_in, void* d_out, int out_size, void* d_ws, size_t ws_size, hipStream_t stream) {
    static int grid = 0;
    if (grid == 0) {
        if (n_in != N_INPUTS || out_size != NB * SEQL * DM || ws_size < WS_TOTAL) { fprintf(stderr, "kernel_launch: unexpected problem (n_in %d, out %d, ws %zu < %zu)\n", n_in, out_size, ws_size, (size_t)WS_TOTAL); grid = -1; return; }
        int dev = 0, cus = 0, per_cu = 0;
        if (hipGetDevice(&dev) != hipSuccess || hipDeviceGetAttribute(&cus, hipDeviceAttributeMultiprocessorCount, dev) != hipSuccess) { grid = -1; return; }
        if (hipFuncSetAttribute((const void*)fwd, hipFuncAttributeMaxDynamicSharedMemorySize, LDS_BYTES) != hipSuccess) { fprintf(stderr, "kernel_launch: hipFuncSetAttribute failed\n"); grid = -1; return; }
        if (hipOccupancyMaxActiveBlocksPerMultiprocessor(&per_cu, (const void*)fwd, NTHR, LDS_BYTES) != hipSuccess || per_cu < 1) { fprintf(stderr, "kernel_launch: occupancy query says %d\n", per_cu); (void)hipGetLastError(); per_cu = 1; }
        grid = cus;
    }
    if (grid < 0) return;
    (void)hipMemsetAsync((char*)d_ws + WS_CTL, 0, CTL_BYTES, stream);
    Params p{};
    for (int i = 0; i < N_INPUTS; ++i) p.in[i] = (const float*)d_in[i];
    p.out = (float*)d_out; p.ws = (unsigned char*)d_ws;
#if MK_ONE_LAUNCH
    p.lo = 0; p.hi = NPHASE;
    hipLaunchKernelGGL(fwd, dim3(grid), dim3(NTHR), LDS_BYTES, stream, p);
#else
    for (int k = 0; k < NPHASE; ++k) { p.lo = k; p.hi = k + 1; hipLaunchKernelGGL(fwd, dim3(grid), dim3(NTHR), LDS_BYTES, stream, p); }
#endif
}
```

```cpp
#include <hip/hip_runtime.h>
#include <stdint.h>
#include <stdio.h>

#define LAS __attribute__((address_space(3)))
typedef unsigned short bf16_t;
typedef short bf16x8 __attribute__((ext_vector_type(8)));
typedef float f32x4 __attribute__((ext_vector_type(4)));
typedef float f32x2 __attribute__((ext_vector_type(2)));
typedef unsigned u32x4 __attribute__((ext_vector_type(4)));
typedef unsigned u32x2 __attribute__((ext_vector_type(2)));

constexpr int NB = 4, SEQL = 4096, CTXL = 256, DM = 1024;
constexpr int NCTX = NB * CTXL;
constexpr int MROWS = NCTX + NB * SEQL;
constexpr int NTHR = 512;
constexpr int LDP0 = 3072, LDP1 = 4096;
constexpr int A_IN = 1920, EVEN_IN = 2944, ODD_IN = 4112;
constexpr int NEXP = 32, DFF = 1024;
constexpr int MOE_ROWS_MAX = 69632 + 32 * 256;
constexpr float DN_ALPHA = 1.41421356237309515f;
constexpr float LN_EPS = 1e-5f;
constexpr int NCHUNK = 34;

enum { I_X = 0, I_C, I_CTX, I_CCTX, I_WMOD, I_BMOD, I_LNG, I_LNB, I_EWIN, I_EWOUT, I_AMU, I_AW0, I_AWB, I_AA0, I_AAB, I_AGB, I_AKK, I_AKA, I_ARK,
       I_AGNG, I_AGNB, I_BCW, I_BCB, I_BGW, I_BGB, I_BLAM, I_OWIN, I_OWOUT, I_CLG, I_CGNG, I_CGNB, I_DIB, I_DFB, I_DGNG, I_DGNB, I_RW, I_RB,
       I_W1, I_B1, I_W2, I_B2, N_INPUTS };

constexpr size_t al256(size_t x) { return (x + 255) & ~(size_t)255; }
constexpr size_t WS_CTL   = 0;
constexpr size_t CTL_BYTES = 65536;
constexpr size_t CTL_CNT  = 16384;
constexpr size_t WS_MOD   = WS_CTL + CTL_BYTES;
constexpr size_t WS_ROPE  = WS_MOD + al256((size_t)2 * 5 * 6144 * 4);
constexpr size_t WS_WIN0T = WS_ROPE + 16384;
constexpr size_t WS_WIN1T = WS_WIN0T + (size_t)3072 * 1024 * 2;
constexpr size_t WS_WOUTT = WS_WIN1T + (size_t)4096 * 1024 * 2;
constexpr size_t WS_W1T   = WS_WOUTT + (size_t)2 * 1024 * 1024 * 2;
constexpr size_t WS_W2T   = WS_W1T + (size_t)2 * 32 * 2048 * 1024 * 2;
constexpr size_t WS_XS    = WS_W2T + (size_t)2 * 32 * 1024 * 1024 * 2;
constexpr size_t WS_H     = WS_XS + (size_t)MROWS * 1024 * 4;
constexpr size_t WS_YMIX  = WS_H + (size_t)MROWS * 1024 * 2;
constexpr size_t WS_YP    = WS_YMIX + (size_t)MROWS * 1024 * 2;
constexpr size_t WS_GT    = WS_YP + (size_t)MROWS * 1024 * 4;
constexpr size_t WS_TOPE  = WS_GT + (size_t)MROWS * 16 * 4;
constexpr size_t WS_TOPW  = WS_TOPE + (size_t)MROWS * 16;
constexpr size_t WS_TOPS  = WS_TOPW + (size_t)MROWS * 16;
constexpr size_t WS_POS   = WS_TOPS + (size_t)MROWS * 16;
constexpr size_t WS_CNTB  = WS_POS + (size_t)MROWS * 16;
constexpr size_t WS_WLT   = WS_CNTB + (size_t)2 * 512 * 32 * 4;
constexpr size_t WLT_WB = 0, WLT_AB = 65536, WLT_GB = 131072, WLT_GW = 196608, WLT_N = 327680;
constexpr size_t WS_P     = WS_WLT + (size_t)WLT_N * 2;
constexpr size_t WS_BIG   = WS_P + (size_t)MROWS * 4096 * 4;
constexpr size_t ARR512   = (size_t)MROWS * 512 * 4;
constexpr int SCREC = 448;
constexpr int SCLEN = CTXL + SEQL;
constexpr size_t WS_SC    = WS_BIG;
enum { E_G = 0, E_O0, E_O1, E_A0, E_A1, E_BX0, E_BX1, E_GATE, E_NARR };
constexpr size_t WS_EARR  = WS_SC + (size_t)64 * SCLEN * SCREC * 2;
constexpr size_t WS_BC    = WS_EARR + (size_t)E_NARR * ARR512;
constexpr size_t WS_CHA   = WS_BC + (size_t)MROWS * 8 * 4;
constexpr size_t WS_CHH   = WS_CHA + (size_t)2 * 512 * 512 * 4;
constexpr size_t WS_CIN   = WS_CHH + (size_t)2 * 512 * 512 * 4;
constexpr int RCH = 64, NRCH = SCLEN / RCH, NRUNIT = 64 * NRCH;
constexpr size_t WS_RU    = WS_CIN + (size_t)2 * 512 * 512 * 4;
constexpr size_t WS_EEND  = WS_RU + (size_t)NRUNIT * 4 * 4096 * 4;
constexpr int NSID = 2 * 2 * NB * NCHUNK * 4;
constexpr size_t WS_ST    = WS_BIG;
constexpr size_t WS_NST   = WS_ST + (size_t)NSID * 16384 * 4;
constexpr size_t WS_MEND  = WS_NST + (size_t)NSID * 128 * 4;
constexpr size_t WS_BEND  = WS_MEND + al256((size_t)NSID * 4);
constexpr size_t WS_MPREV = WS_BEND + al256((size_t)NSID * 4);
constexpr size_t WS_CB    = WS_MPREV + al256((size_t)NSID * 4);
constexpr size_t WS_CMI   = WS_CB + (size_t)NSID * 128 * 4;
constexpr size_t WS_STB   = WS_CMI + (size_t)NSID * 128 * 4;
constexpr size_t WS_OEND  = WS_STB + (size_t)NSID * 16384 * 2;
constexpr size_t WS_ASORT = WS_BIG;
constexpr size_t WS_ACT   = WS_ASORT + (size_t)MOE_ROWS_MAX * 1024 * 2;
constexpr size_t WS_YE    = WS_ACT + (size_t)MOE_ROWS_MAX * 1024 * 2;
constexpr size_t WS_MEND_ = WS_YE + (size_t)MOE_ROWS_MAX * 1024 * 4;
constexpr size_t WS_TOTAL = (WS_EEND > WS_MEND_ ? (WS_EEND > WS_OEND ? WS_EEND : WS_OEND) : (WS_MEND_ > WS_OEND ? WS_MEND_ : WS_OEND));

constexpr int LDS_BYTES = 155648;
constexpr int LDS_BAR = 0;
constexpr int LDS_WORK = 1024;

struct Params {
    const float* in[N_INPUTS];
    float* out;
    unsigned char* ws;
    int lo, hi;
};

typedef __bf16 nbf16x2 __attribute__((ext_vector_type(2)));
__device__ __forceinline__ unsigned pack_bf16(float lo, float hi) { const nbf16x2 v = {(__bf16)lo, (__bf16)hi}; return __builtin_bit_cast(unsigned, v); }
__device__ __forceinline__ bf16_t f2bf(float f) { return __builtin_bit_cast(bf16_t, (__bf16)f); }
__device__ __forceinline__ float bf2f(bf16_t b) { return __uint_as_float(((unsigned)b) << 16); }
__device__ __forceinline__ f32x4 ld_bf16x4(const bf16_t* p) { const u32x2 w = *(const u32x2*)p; return (f32x4){__uint_as_float(w.x << 16), __uint_as_float(w.x & 0xffff0000u), __uint_as_float(w.y << 16), __uint_as_float(w.y & 0xffff0000u)}; }
__device__ __forceinline__ float fexp(float x) { return __builtin_amdgcn_exp2f(x * 1.4426950408889634f); }
__device__ __forceinline__ float frcp(float x) { return __builtin_amdgcn_rcpf(x); }
__device__ __forceinline__ float fsqrt(float x) { return __builtin_amdgcn_sqrtf(x); }
__device__ __forceinline__ float sigm(float x) { return frcp(1.0f + fexp(-x)); }
__device__ __forceinline__ float ftanh(float x) { const float e = fexp(-2.0f * fabsf(x)), t = (1.0f - e) * frcp(1.0f + e); return x < 0.f ? -t : t; }
__device__ __forceinline__ float fexpm1_neg(float x) {
    const float p = x * (1.0f + x * (0.5f + x * (0.16666667f + x * (0.041666668f + x * 0.0083333338f))));
    return x > -0.25f ? p : fexp(x) - 1.0f; }
__device__ __forceinline__ float softplusf(float x) { return fmaxf(x, 0.f) + log1pf(expf(-fabsf(x))); }
__device__ __forceinline__ float wave_sum(float v) {
    v += __int_as_float(__builtin_amdgcn_update_dpp(0, __float_as_int(v), 0x121, 0xf, 0xf, false));
    v += __int_as_float(__builtin_amdgcn_update_dpp(0, __float_as_int(v), 0x122, 0xf, 0xf, false));
    v += __int_as_float(__builtin_amdgcn_update_dpp(0, __float_as_int(v), 0x124, 0xf, 0xf, false));
    v += __int_as_float(__builtin_amdgcn_update_dpp(0, __float_as_int(v), 0x128, 0xf, 0xf, false));
    v += __int_as_float(__builtin_amdgcn_update_dpp(0, __float_as_int(v), 0x142, 0xa, 0xf, false));
    v += __int_as_float(__builtin_amdgcn_update_dpp(0, __float_as_int(v), 0x143, 0xc, 0xf, false));
    return __int_as_float(__builtin_amdgcn_readlane(__float_as_int(v), 63));
}
__device__ __forceinline__ float wave_max(float v) {
    const int ninf = 0xff800000;
    v = fmaxf(v, __int_as_float(__builtin_amdgcn_update_dpp(ninf, __float_as_int(v), 0x121, 0xf, 0xf, false)));
    v = fmaxf(v, __int_as_float(__builtin_amdgcn_update_dpp(ninf, __float_as_int(v), 0x122, 0xf, 0xf, false)));
    v = fmaxf(v, __int_as_float(__builtin_amdgcn_update_dpp(ninf, __float_as_int(v), 0x124, 0xf, 0xf, false)));
    v = fmaxf(v, __int_as_float(__builtin_amdgcn_update_dpp(ninf, __float_as_int(v), 0x128, 0xf, 0xf, false)));
    v = fmaxf(v, __int_as_float(__builtin_amdgcn_update_dpp(ninf, __float_as_int(v), 0x142, 0xa, 0xf, false)));
    v = fmaxf(v, __int_as_float(__builtin_amdgcn_update_dpp(ninf, __float_as_int(v), 0x143, 0xc, 0xf, false)));
    return __int_as_float(__builtin_amdgcn_readlane(__float_as_int(v), 63));
}
__device__ __forceinline__ int wave_min_i(int v) {
    const int big = 0x7fffffff;
    v = min(v, __builtin_amdgcn_update_dpp(big, v, 0x121, 0xf, 0xf, false));
    v = min(v, __builtin_amdgcn_update_dpp(big, v, 0x122, 0xf, 0xf, false));
    v = min(v, __builtin_amdgcn_update_dpp(big, v, 0x124, 0xf, 0xf, false));
    v = min(v, __builtin_amdgcn_update_dpp(big, v, 0x128, 0xf, 0xf, false));
    v = min(v, __builtin_amdgcn_update_dpp(big, v, 0x142, 0xa, 0xf, false));
    v = min(v, __builtin_amdgcn_update_dpp(big, v, 0x143, 0xc, 0xf, false));
    return __builtin_amdgcn_readlane(v, 63);
}
__device__ __forceinline__ float row16_sum(float v) {
    v += __int_as_float(__builtin_amdgcn_update_dpp(0, __float_as_int(v), 0x121, 0xf, 0xf, false));
    v += __int_as_float(__builtin_amdgcn_update_dpp(0, __float_as_int(v), 0x122, 0xf, 0xf, false));
    v += __int_as_float(__builtin_amdgcn_update_dpp(0, __float_as_int(v), 0x124, 0xf, 0xf, false));
    v += __int_as_float(__builtin_amdgcn_update_dpp(0, __float_as_int(v), 0x128, 0xf, 0xf, false));
    return v;
}
__device__ __forceinline__ int row_batch(int row) { return row < NCTX ? (row >> 8) : ((row - NCTX) >> 12); }
__device__ __forceinline__ int row_modr(int row) { return row < NCTX ? 4 : ((row - NCTX) >> 12); }
#define XB_TMO      128
#define XB_XCNT(j)  (256  + 64 * (j))
#define XB_XSUB(j)  (1280 + 64 * (j))
#define XB_XGEN(j)  (2304 + 64 * (j))
#define XB_TOP      3328
#define XB_TOPGEN   3392
#define XCD_BAR_WORDS 3456
#define XB_SPIN_CAP (1u << 18)

__device__ __forceinline__ unsigned xb_ld(unsigned* p)              { return __hip_atomic_load(p, __ATOMIC_RELAXED, __HIP_MEMORY_SCOPE_AGENT); }
__device__ __forceinline__ unsigned xb_add(unsigned* p, unsigned v) { return __hip_atomic_fetch_add(p, v, __ATOMIC_RELAXED, __HIP_MEMORY_SCOPE_AGENT); }
__device__ __forceinline__ unsigned xb_xcc_id() { return (unsigned)__builtin_amdgcn_s_getreg((3 << 11) | 20) & 0xFu; }
#define XB_SPIN(cond, bar) do { unsigned _sp = 0; while (cond) { __builtin_amdgcn_s_sleep(1); \
    if ((++_sp & 255u) == 0u) { if (xb_ld(&(bar)[XB_TMO])) break; if (_sp > XB_SPIN_CAP) { atomicAdd(&(bar)[XB_TMO], 1u); break; } } } } while (0)

struct XcdBarrier {
    unsigned* bar; unsigned x;
    volatile LAS unsigned* st;
};

__device__ __forceinline__ XcdBarrier xcd_barrier_post(unsigned* bar, volatile LAS unsigned* st) {
    XcdBarrier b; b.bar = bar; b.x = xb_xcc_id(); b.st = st;
    if (threadIdx.x == 0) (void)xb_add(&bar[XB_XCNT(b.x)], 1u);
    return b;
}
__device__ __forceinline__ void xcd_barrier_complete(unsigned* bar, unsigned x, unsigned& nloc, unsigned& nx) {
    const unsigned G = gridDim.x * gridDim.y * gridDim.z;
    unsigned sum, cnt, mine, sp = 0u;
    for (;;) {
        sum = 0u; cnt = 0u; mine = 0u;
#pragma unroll
        for (unsigned j = 0; j < 16; ++j) { const unsigned c = xb_ld(&bar[XB_XCNT(j)]); sum += c; cnt += (c > 0u) ? 1u : 0u; mine = (j == x) ? c : mine; }
        if (sum == G) break;
        __builtin_amdgcn_s_sleep(1);
        if ((++sp & 255u) == 0u) { if (xb_ld(&bar[XB_TMO])) break; if (sp > XB_SPIN_CAP) { atomicAdd(&bar[XB_TMO], 1u); break; } }
    }
    nloc = mine > 0u ? mine : 1u; nx = cnt > 0u ? cnt : 1u;
}

__device__ __forceinline__ void xcd_barrier(const XcdBarrier& b) {
    asm volatile("s_waitcnt vmcnt(0)" ::: "memory");
    __syncthreads();
    if (threadIdx.x == 0) {
        unsigned* bar = b.bar;
        __builtin_amdgcn_s_waitcnt(0);
        unsigned nloc = b.st[0], nx = b.st[1];
        if (nloc == 0u) { xcd_barrier_complete(bar, b.x, nloc, nx); b.st[0] = nloc; b.st[1] = nx; }
        const unsigned old = xb_add(&bar[XB_XSUB(b.x)], 1u);
        const unsigned gen = old / nloc;
        if (old + 1u == (gen + 1u) * nloc) {
            __builtin_amdgcn_fence(__ATOMIC_RELEASE, "agent");
            asm volatile("s_waitcnt vmcnt(0)" ::: "memory");
            const unsigned og = xb_add(&bar[XB_TOP], 1u);
            const unsigned tg = og / nx;
            if (og + 1u == (tg + 1u) * nx) xb_add(&bar[XB_TOPGEN], 1u);
            else XB_SPIN(xb_ld(&bar[XB_TOPGEN]) == tg, bar);
            __builtin_amdgcn_fence(__ATOMIC_ACQUIRE, "agent");
            xb_add(&bar[XB_XGEN(b.x)], 1u);
            asm volatile("s_waitcnt vmcnt(0)" ::: "memory");
        } else {
            XB_SPIN(xb_ld(&bar[XB_XGEN(b.x)]) == gen, bar);
            __builtin_amdgcn_fence(__ATOMIC_ACQUIRE, "agent");
            asm volatile("s_waitcnt vmcnt(0)" ::: "memory");
        }
    }
    __syncthreads();
}
namespace pg8 {
constexpr int BM = 256, BK = 64, HALF = 128, HTB = HALF * BK * 2  , STAGE_BYTES = 8 * HTB, NXCD = 8, WGM = 8;

__host__ __device__ __forceinline__ int lds_byte(int r, int c) { const int st = (r >> 4) * 2 + (c >> 5), rr = r & 15, cc = c & 31, ob = rr * 64 + cc * 2; return st * 1024 + (ob ^ (((ob >> 9) & 1) << 5)); }
__host__ __device__ __forceinline__ void stage_rc(int b, int& R, int& C) { const int st = b / 1024, sb = b % 1024, swz = sb ^ (((sb >> 9) & 1) << 5); R = (st >> 1) * 16 + swz / 64; C = (st & 1) * 32 + (swz % 64) / 2; }
__host__ __device__ __forceinline__ int perm32(int rho) { const int n = rho >> 4, i = rho & 15; return 8 * (i >> 2) + 4 * n + (i & 3); }

struct Unit { int pm, pn; };
struct Gemm { const bf16_t* A; const bf16_t* Bt; int M, N, K; };
__device__ __forceinline__ unsigned cvt_pk_bf16(float lo, float hi) { return pack_bf16(lo, hi); }
template <class Epi, class Sched, bool STAMP = false, bool ATILED = false, bool BTILED = false>
__device__ __forceinline__ void gemm_phase(LAS unsigned char* lds, const Gemm g, const Sched& S, const Epi& E, unsigned long long* stamps) {
    const int tid = threadIdx.x, wid = __builtin_amdgcn_readfirstlane(tid >> 6), lane = tid & 63, wr = wid >> 2, wc = wid & 3, fr = lane & 15, fq = lane >> 4;
    const int K = g.K, nt = K / BK;
    int ts_lo = 0, ts_hi = 0, nts = 0; const unsigned long long rt_entry = STAMP ? (unsigned long long)wall_clock64() : 0ull;
#define PG8_STAMP() do { if (STAMP && wid == 0 && nts < 64) { const unsigned long long _c = (unsigned long long)clock64(); \
        ts_lo = (lane == nts) ? (int)(unsigned)_c : ts_lo; ts_hi = (lane == nts) ? (int)(unsigned)(_c >> 32) : ts_hi; ++nts; } } while (0)
    PG8_STAMP();
    unsigned voffA[2], voffB[2];
#pragma unroll
    for (int i = 0; i < 2; ++i) { int R, C; stage_rc(tid * 16 + i * 8192, R, C); const int Rb = Epi::PERM ? ((R & ~31) + perm32(R & 31)) : R;
        voffA[i] = (unsigned)(R * (ATILED ? BK : K) + C) * 2u; voffB[i] = (unsigned)(Rb * (BTILED ? BK : K) + C) * 2u; }
    const size_t kstepA = ATILED ? (size_t)BM * BK * 2 : (size_t)(BK * 2), kstepB = BTILED ? (size_t)BM * BK * 2 : (size_t)(BK * 2);
    const size_t hstepA = ATILED ? (size_t)HALF * BK * 2 : (size_t)HALF * K * 2, hstepB = BTILED ? (size_t)HALF * BK * 2 : (size_t)HALF * K * 2;
    const size_t tstep = (size_t)BM * K * 2;
    const unsigned ldsw = (unsigned)wid * 1024u;
    const int aoff = lds_byte(wr * 64 + fr, fq * 8), boff = lds_byte(wc * 32 + fr, fq * 8);
#define PG8_SA(b, h) (((b) * 2 + (h)) * HTB)
#define PG8_SB(b, h) ((4 + (b) * 2 + (h)) * HTB)
#define PG8_STAGE(bufoff, gbase, voff) do { _Pragma("unroll") for (int _i = 0; _i < 2; ++_i) \
        __builtin_amdgcn_global_load_lds((const unsigned*)((const char*)(gbase) + (voff)[_i]), (LAS unsigned*)(lds + (bufoff) + ldsw + _i * 8192), 16, 0, 0); } while (0)
#define PG8_LDA(dst, b, h) do { _Pragma("unroll") for (int m = 0; m < 4; ++m) _Pragma("unroll") for (int k = 0; k < 2; ++k) dst[m][k] = *(const LAS bf16x8*)(lds + PG8_SA(b, h) + aoff + m * 2048 + k * 1024); } while (0)
#define PG8_LDB(dst, b, h) do { _Pragma("unroll") for (int n = 0; n < 2; ++n) _Pragma("unroll") for (int k = 0; k < 2; ++k) dst[n][k] = *(const LAS bf16x8*)(lds + PG8_SB(b, h) + boff + n * 2048 + k * 1024); } while (0)
#define PG8_MMA(ai, bj, At, Bt) do { __builtin_amdgcn_s_setprio(1); _Pragma("unroll") for (int m = 0; m < 4; ++m) _Pragma("unroll") for (int n = 0; n < 2; ++n) _Pragma("unroll") for (int k = 0; k < 2; ++k) \
        acc[ai][bj][m][n] = __builtin_amdgcn_mfma_f32_16x16x32_bf16(Bt[n][k], At[m][k], acc[ai][bj][m][n], 0, 0, 0); __builtin_amdgcn_s_setprio(0); } while (0)
#define PG8_WAIT_V(n) asm volatile("s_waitcnt vmcnt(" #n ")" ::: "memory")
#define PG8_WAIT_L(n) asm volatile("s_waitcnt lgkmcnt(" #n ")" ::: "memory")
#define PG8_BAR __builtin_amdgcn_s_barrier()
#define PG8_SCHED __builtin_amdgcn_sched_barrier(0)
    Unit cur, nxt; int ui = 0;
    if (!S.next(0, cur)) return;
    f32x4 acc[2][2][4][2];
#pragma unroll
    for (int a = 0; a < 2; ++a)
#pragma unroll
        for (int b = 0; b < 2; ++b)
#pragma unroll
            for (int m = 0; m < 4; ++m)
#pragma unroll
                for (int n = 0; n < 2; ++n) acc[a][b][m][n] = (f32x4){0.f, 0.f, 0.f, 0.f};
    bf16x8 At[4][2], B0[2][2], B1[2][2];
    const char* cA = (const char*)g.A + (size_t)cur.pm * tstep; const char* cB = (const char*)g.Bt + (size_t)cur.pn * tstep;
    S.a_ready(cur);
    PG8_STAGE(PG8_SB(0, 0), cB, voffB); PG8_STAGE(PG8_SA(0, 0), cA, voffA); PG8_STAGE(PG8_SB(0, 1), cB + hstepB, voffB); PG8_STAGE(PG8_SA(0, 1), cA + hstepA, voffA);
    if (wr == 1) PG8_BAR;
    PG8_WAIT_V(4); PG8_BAR;
    PG8_STAGE(PG8_SB(1, 0), cB + kstepB, voffB); PG8_STAGE(PG8_SA(1, 0), cA + kstepA, voffA); PG8_STAGE(PG8_SB(1, 1), cB + hstepB + kstepB, voffB);
    PG8_WAIT_V(6); PG8_BAR;
    PG8_STAMP();
    for (;;) {
        const bool has_next = S.next(ui + 1, nxt);
        const char* nA = has_next ? (const char*)g.A + (size_t)nxt.pm * tstep : cA; const char* nB = has_next ? (const char*)g.Bt + (size_t)nxt.pn * tstep : cB;
        E.pre(lds, ui & 1, cur, wid, lane);
        for (int t = 0; t < nt; t += 2) {
            const bool last = (t == nt - 2);
            const char* a1 = cA + (size_t)(t + 1) * kstepA;
            const char* a2 = last ? nA : cA + (size_t)(t + 2) * kstepA; const char* b2 = last ? nB : cB + (size_t)(t + 2) * kstepB;
            const char* a3 = a2 + kstepA; const char* b3 = b2 + kstepB;
            if (last && has_next) S.a_ready(nxt);
            PG8_LDB(B0, 0, 0); PG8_SCHED; PG8_LDA(At, 0, 0); PG8_STAGE(PG8_SA(1, 1), a1 + hstepA, voffA);
            PG8_WAIT_L(8); PG8_WAIT_V(10); PG8_BAR; PG8_WAIT_L(0); PG8_MMA(0, 0, At, B0); PG8_BAR; PG8_SCHED;
            PG8_LDB(B1, 0, 1); PG8_STAGE(PG8_SB(0, 0), b2, voffB);
            PG8_WAIT_V(10); PG8_BAR; PG8_WAIT_L(0); PG8_MMA(0, 1, At, B1); PG8_BAR;
            PG8_LDA(At, 0, 1); PG8_STAGE(PG8_SA(0, 0), a2, voffA);
            PG8_BAR; PG8_WAIT_L(0); PG8_MMA(1, 0, At, B0); PG8_BAR; PG8_SCHED;
            PG8_STAGE(PG8_SB(0, 1), b2 + hstepB, voffB);
            PG8_WAIT_V(10); PG8_BAR; PG8_MMA(1, 1, At, B1); PG8_BAR;
            PG8_LDB(B0, 1, 0); PG8_SCHED; PG8_LDA(At, 1, 0); PG8_STAGE(PG8_SA(0, 1), a2 + hstepA, voffA);
            PG8_WAIT_L(8); PG8_WAIT_V(10); PG8_BAR; PG8_WAIT_L(0); PG8_MMA(0, 0, At, B0); PG8_BAR; PG8_SCHED;
            PG8_LDB(B1, 1, 1); PG8_STAGE(PG8_SB(1, 0), b3, voffB);
            PG8_WAIT_V(10); PG8_BAR; PG8_WAIT_L(0); PG8_MMA(0, 1, At, B1); PG8_BAR;
            PG8_LDA(At, 1, 1); PG8_STAGE(PG8_SA(1, 0), a3, voffA);
            PG8_BAR; PG8_WAIT_L(0); PG8_MMA(1, 0, At, B0); PG8_BAR; PG8_SCHED;
            PG8_STAGE(PG8_SB(1, 1), b3 + hstepB, voffB);
            PG8_WAIT_V(10); PG8_BAR; PG8_MMA(1, 1, At, B1); PG8_BAR;
        }
        PG8_STAMP();
        if constexpr (!Epi::AFTER_DRAIN) { E(acc, cur, wr, wc, fr, fq, lds, ui & 1); S.done(cur); }
        PG8_STAMP();
        if (!has_next) break;
#pragma unroll
        for (int a = 0; a < 2; ++a)
#pragma unroll
            for (int b = 0; b < 2; ++b)
#pragma unroll
                for (int m = 0; m < 4; ++m)
#pragma unroll
                    for (int n = 0; n < 2; ++n) acc[a][b][m][n] = (f32x4){0.f, 0.f, 0.f, 0.f};
        cur = nxt; cA = nA; cB = nB; ++ui;
    }
    PG8_WAIT_V(0);
    if (wr == 0) PG8_BAR;
    PG8_BAR;
    if constexpr (Epi::AFTER_DRAIN) { E.fused(acc, cur, wr, wc, fr, fq, lds, wid, lane); S.done(cur); }
    PG8_STAMP();
    if (STAMP && wid == 0) { stamps[lane] = lane < nts ? (((unsigned long long)(unsigned)ts_hi << 32) | (unsigned)ts_lo) : 0ull;
        if (lane == 62) stamps[62] = rt_entry; if (lane == 63) stamps[63] = (unsigned long long)wall_clock64(); }
#undef PG8_STAMP
#undef PG8_SA
#undef PG8_SB
#undef PG8_STAGE
#undef PG8_LDA
#undef PG8_LDB
#undef PG8_MMA
#undef PG8_WAIT_V
#undef PG8_WAIT_L
#undef PG8_BAR
#undef PG8_SCHED
}
__device__ __forceinline__ int xcd_contig(long L, int nwg) { const int q = nwg / NXCD, r = nwg % NXCD, xcd = (int)(L % NXCD), off = (int)(L / NXCD); return (xcd < r ? xcd * (q + 1) : r * (q + 1) + (xcd - r) * q) + off; }
template <int nN>
struct SchedDense {
    int nM, pm0, G, c;
    __device__ __forceinline__ bool next(int i, Unit& u) const {
        const long L = (long)i * G + c; const int nwg = nM * nN; if (L >= nwg) return false;
        const int wgid = xcd_contig(L, nwg);
        constexpr int nig = WGM * nN; const int gid = wgid / nig, fm = gid * WGM, gsz = (nM - fm) < WGM ? (nM - fm) : WGM, w = wgid % nig;
        if (gsz == WGM) { u.pm = pm0 + fm + (w & (WGM - 1)); u.pn = w >> 3; } else { u.pm = pm0 + fm + (w % gsz); u.pn = w / gsz; }
        return true; }
    __device__ __forceinline__ void a_ready(const Unit&) const {}
    __device__ __forceinline__ void done(const Unit&) const {}
};
template <int nN>
struct SchedMoe {
    int T, G, c; const LAS int* tileE;
    __device__ __forceinline__ bool next(int i, Unit& u) const { const long L = (long)i * G + c; const int nwg = T * nN; if (L >= nwg) return false;
        const int wgid = xcd_contig(L, nwg), pt = wgid / nN; u.pm = pt; u.pn = tileE[pt] * nN + (wgid % nN); return true; }
    __device__ __forceinline__ void a_ready(const Unit&) const {}
    __device__ __forceinline__ void done(const Unit&) const {}
};
constexpr int EPI_BIAS_OFF = STAGE_BYTES + 8192;
struct EpiStore {
    static constexpr bool PERM = true, AFTER_DRAIN = false;
    bf16_t* O; int ldc;
    __device__ __forceinline__ void pre(LAS unsigned char*, int, const Unit&, int, int) const {}
    __device__ __forceinline__ void operator()(const f32x4 (&acc)[2][2][4][2], const Unit& u, int wr, int wc, int fr, int fq, const LAS unsigned char*, int) const {
        const int row0 = u.pm * BM + wr * 64 + fr, col0 = u.pn * BM + wc * 32 + 8 * fq;
#pragma unroll
        for (int ai = 0; ai < 2; ++ai)
#pragma unroll
            for (int m = 0; m < 4; ++m) { bf16_t* rowp = O + (size_t)(row0 + ai * HALF + m * 16) * ldc + col0;
#pragma unroll
                for (int bj = 0; bj < 2; ++bj) { const f32x4 v0 = acc[ai][bj][m][0], v1 = acc[ai][bj][m][1];
                    u32x4 w; w.x = cvt_pk_bf16(v0[0], v0[1]); w.y = cvt_pk_bf16(v0[2], v0[3]); w.z = cvt_pk_bf16(v1[0], v1[1]); w.w = cvt_pk_bf16(v1[2], v1[3]);
                    *(u32x4*)(rowp + bj * HALF) = w; } }
    }
};
struct EpiYE {
    static constexpr bool PERM = true, AFTER_DRAIN = false;
    bf16_t* O; const float* b2;
    __device__ __forceinline__ void pre(LAS unsigned char* lds, int par, const Unit& u, int wid, int lane) const {
        if (wid == 0) __builtin_amdgcn_global_load_lds((const unsigned*)(b2 + (u.pn >> 2) * 1024 + (u.pn & 3) * BM + lane * 4), (LAS unsigned*)(lds + EPI_BIAS_OFF + par * 1024), 16, 0, 0);
    }
    __device__ __forceinline__ void operator()(const f32x4 (&acc)[2][2][4][2], const Unit& u, int wr, int wc, int fr, int fq, const LAS unsigned char* lds, int par) const {
        const int pn = u.pn & 3;
        const int row0 = u.pm * BM + wr * 64 + fr, col0 = pn * BM + wc * 32 + 8 * fq;
        const LAS float* bp = (const LAS float*)(lds + EPI_BIAS_OFF + par * 1024) + wc * 32 + 8 * fq;
        f32x4 bv[2][2];
#pragma unroll
        for (int bj = 0; bj < 2; ++bj)
#pragma unroll
            for (int n = 0; n < 2; ++n) bv[bj][n] = *(const LAS f32x4*)(bp + bj * HALF + 4 * n);
#pragma unroll
        for (int ai = 0; ai < 2; ++ai)
#pragma unroll
            for (int m = 0; m < 4; ++m) { bf16_t* rowp = O + (size_t)(row0 + ai * HALF + m * 16) * 1024 + col0;
#pragma unroll
                for (int bj = 0; bj < 2; ++bj) { const f32x4 v0 = acc[ai][bj][m][0] + bv[bj][0], v1 = acc[ai][bj][m][1] + bv[bj][1];
                    u32x4 w; w.x = cvt_pk_bf16(v0[0], v0[1]); w.y = cvt_pk_bf16(v0[2], v0[3]); w.z = cvt_pk_bf16(v1[0], v1[1]); w.w = cvt_pk_bf16(v1[2], v1[3]);
                    *(u32x4*)(rowp + bj * HALF) = w; } }
    }
};
struct EpiAct {
    static constexpr bool PERM = true, AFTER_DRAIN = false;
    bf16_t* O; const float* b1;
    __device__ __forceinline__ void pre(LAS unsigned char* lds, int par, const Unit& u, int wid, int lane) const {
        if (wid == 0) __builtin_amdgcn_global_load_lds((const unsigned*)(b1 + (u.pn >> 3) * 2048 + (lane >> 5) * 1024 + (u.pn & 7) * 128 + (lane & 31) * 4), (LAS unsigned*)(lds + EPI_BIAS_OFF + par * 1024), 16, 0, 0);
    }
    __device__ __forceinline__ void operator()(const f32x4 (&acc)[2][2][4][2], const Unit& u, int wr, int wc, int fr, int fq, const LAS unsigned char* lds, int par) const {
        const int pn = u.pn & 7;
        const int row0 = u.pm * BM + wr * 64 + fr, x0 = pn * 128 + wc * 32 + 8 * fq;
        const LAS float* bg = (const LAS float*)(lds + EPI_BIAS_OFF + par * 1024) + wc * 32 + 8 * fq; const LAS float* bl = bg + 128;
        const f32x4 g0 = *(const LAS f32x4*)bg, g1 = *(const LAS f32x4*)(bg + 4), l0 = *(const LAS f32x4*)bl, l1 = *(const LAS f32x4*)(bl + 4);
#pragma unroll
        for (int ai = 0; ai < 2; ++ai)
#pragma unroll
            for (int m = 0; m < 4; ++m) {
                float o[8];
#pragma unroll
                for (int n = 0; n < 2; ++n)
#pragma unroll
                    for (int j = 0; j < 4; ++j) {
                        float glu = acc[ai][0][m][n][j] + (n ? g1[j] : g0[j]);
                        float lin = acc[ai][1][m][n][j] + (n ? l1[j] : l0[j]);
                        glu = fminf(glu, 7.0f); lin = fminf(fmaxf(lin, -7.0f), 7.0f);
                        o[n * 4 + j] = (lin + 1.0f) * glu * __builtin_amdgcn_rcpf(1.0f + __expf(-1.702f * glu));
                    }
                u32x4 w; w.x = cvt_pk_bf16(o[0], o[1]); w.y = cvt_pk_bf16(o[2], o[3]); w.z = cvt_pk_bf16(o[4], o[5]); w.w = cvt_pk_bf16(o[6], o[7]);
                *(u32x4*)(O + ((size_t)(u.pm * 16 + (x0 >> 6)) * 256 + (wr * 64 + fr + ai * HALF + m * 16)) * 64 + (x0 & 63)) = w;
            }
    }
};
}
using pg8::Unit;
__device__ __forceinline__ void my_sincos(double a, float& s, float& c) {
    const double n = rint(a * 0.63661977236758134308);
    const double r = (a - n * 1.57079632679489655800e+00) - n * 6.12323399573676603587e-17;
    const double r2 = r * r;
    const double sp = r * (1.0 + r2 * (-1.0 / 6.0 + r2 * (1.0 / 120.0 + r2 * (-1.0 / 5040.0 + r2 * (1.0 / 362880.0 + r2 * (-1.0 / 39916800.0 + r2 * (1.0 / 6227020800.0 + r2 * (-1.0 / 1307674368000.0))))))));
    const double cp = 1.0 + r2 * (-0.5 + r2 * (1.0 / 24.0 + r2 * (-1.0 / 720.0 + r2 * (1.0 / 40320.0 + r2 * (-1.0 / 3628800.0 + r2 * (1.0 / 479001600.0 + r2 * (-1.0 / 87178291200.0 + r2 * (1.0 / 20922789888000.0))))))));
    const int q = ((int)n) & 3;
    const double sn = q == 0 ? sp : q == 1 ? cp : q == 2 ? -sp : -cp;
    const double cn = q == 0 ? cp : q == 1 ? -sp : q == 2 ? -cp : sp;
    s = (float)sn; c = (float)cn;
}
__device__ __forceinline__ void ph_prologue(const Params& p, LAS unsigned char* lds, int bid, int nblk) {
    const int tid = threadIdx.x;
    unsigned char* ws = p.ws;
    {
        LAS float* sv = (LAS float*)(lds + LDS_WORK);
        LAS float* red = sv + 5 * 1024;
        for (int i = tid; i < 5 * 1024; i += NTHR) { const int r = i >> 10, k = i & 1023; const float c = r < 4 ? p.in[I_C][r * 1024 + k] : p.in[I_CCTX][k]; sv[i] = c / (1.0f + expf(-c)); }
        __syncthreads();
        float* MOD = (float*)(ws + WS_MOD);
        for (int item = bid; item < 256; item += nblk) {
            if (tid < 480) {
                const int cl = tid % 48, kp = tid / 48;
                const int gc = item * 48 + cl, l = gc / 6144, n = gc % 6144;
                const float* w = p.in[I_WMOD] + (size_t)l * 1024 * 6144 + n;
                float a0 = 0.f, a1 = 0.f, a2 = 0.f, a3 = 0.f, a4 = 0.f;
#pragma unroll 1
                for (int k0 = kp; k0 < 1024; k0 += 130) {
                    float wv[13];
#pragma unroll
                    for (int u = 0; u < 13; ++u) { const int k = k0 + 10 * u; wv[u] = k < 1024 ? w[(size_t)k * 6144] : 0.f; }
#pragma unroll
                    for (int u = 0; u < 13; ++u) { const int k = k0 + 10 * u < 1024 ? k0 + 10 * u : 1023; a0 += sv[k] * wv[u]; a1 += sv[1024 + k] * wv[u]; a2 += sv[2048 + k] * wv[u]; a3 += sv[3072 + k] * wv[u]; a4 += sv[4096 + k] * wv[u]; }
                }
                LAS float* rp = red + (kp * 48 + cl) * 5; rp[0] = a0; rp[1] = a1; rp[2] = a2; rp[3] = a3; rp[4] = a4;
            }
            __syncthreads();
            if (tid < 240) {
                const int cl = tid / 5, r = tid % 5; float s = 0.f;
                for (int kp = 0; kp < 10; ++kp) s += red[(kp * 48 + cl) * 5 + r];
                const int gc = item * 48 + cl, l = gc / 6144, n = gc % 6144;
                MOD[(size_t)(l * 5 + r) * 6144 + n] = s + p.in[I_BMOD][l * 6144 + n];
            }
            __syncthreads();
        }
    }
    if (bid == (nblk > 1 ? 1 : 0)) {
        float* ROPE = (float*)(ws + WS_ROPE);
        for (int i = tid; i < 2048; i += NTHR) { const int pos = i >> 5, f = i & 31; const double inv = exp(-(double)f * 0.28782313662425575); float s, c; my_sincos((double)pos * inv, s, c); ROPE[2 * i] = c; ROPE[2 * i + 1] = s; }
    }
    {
        bf16_t* WLT = (bf16_t*)(ws + WS_WLT);
        for (int i = bid * NTHR + tid; i < (int)WLT_N; i += nblk * NTHR) {
            float v;
            if (i < 131072) { const int which = i >> 16, r = i & 65535, d = r >> 15, n = (r >> 6) & 511, k = r & 63; v = (which ? p.in[I_AAB] : p.in[I_AWB])[(size_t)(d * 64 + k) * 512 + n]; }
            else if (i < 196608) { const int r = i - 131072, n = r >> 7, k = r & 127; v = p.in[I_AGB][(size_t)k * 512 + n]; }
            else { const int r = i - 196608, blk = r >> 12, o = (r >> 6) & 63, ii = r & 63; v = p.in[I_BGW][(size_t)blk * 4096 + ii * 64 + o]; }
            WLT[i] = f2bf(v);
        }
    }
    {
        LAS float* tile = (LAS float*)(lds + LDS_WORK);
        for (int t = bid; t < 576; t += nblk) {
            const float* src; int ld, nvalid, k0, n0, w1map = 0; bf16_t* dst; int tt = t;
            if (tt < 192) { k0 = (tt / 12) * 64; n0 = (tt % 12) * 256; src = p.in[I_EWIN]; ld = EVEN_IN; nvalid = EVEN_IN; dst = (bf16_t*)(ws + WS_WIN0T); }
            else if ((tt -= 192) < 256) { k0 = (tt >> 4) * 64; n0 = (tt & 15) * 256; src = p.in[I_OWIN]; ld = ODD_IN; nvalid = 4096; dst = (bf16_t*)(ws + WS_WIN1T); }
            else { tt -= 256; const int mat = tt >> 6, r = tt & 63; k0 = (r >> 2) * 64; n0 = (r & 3) * 256; src = mat ? p.in[I_OWOUT] : p.in[I_EWOUT]; ld = 1024; nvalid = 1024; dst = (bf16_t*)(ws + WS_WOUTT) + (size_t)mat * 1024 * 1024; }
            {
                const int j4 = (tid & 63) * 4, i0 = tid >> 6;
                f32x4 v[8];
#pragma unroll
                for (int r = 0; r < 8; ++r) v[r] = (n0 + j4 < nvalid) ? *(const f32x4*)(src + (size_t)(k0 + i0 + 8 * r) * ld + n0 + j4) : (f32x4){0.f, 0.f, 0.f, 0.f};
#pragma unroll
                for (int r = 0; r < 8; ++r) { LAS float* tp = tile + (i0 + 8 * r) * 257 + j4; tp[0] = v[r][0]; tp[1] = v[r][1]; tp[2] = v[r][2]; tp[3] = v[r][3]; }
            }
            __syncthreads();
            {
                const int ip = (tid & 31) * 2, j0 = tid >> 5;
#pragma unroll
                for (int r = 0; r < 16; ++r) {
                    const int j = j0 + 16 * r, n = n0 + j;
                    const int rho = w1map ? ((((n & 1023) >> 7) << 8) + ((n >> 10) << 7) + (n & 127)) : n;
                    *(unsigned*)(dst + (size_t)rho * 1024 + k0 + ip) = pack_bf16(tile[ip * 257 + j], tile[(ip + 1) * 257 + j]);
                }
            }
            __syncthreads();
        }
    }
}
__device__ __forceinline__ void ph_mod_in(const Params& p, int bid, int nblk) {
    const int tid = threadIdx.x, wid = tid >> 6, lane = tid & 63;
    const float* MOD = (const float*)(p.ws + WS_MOD);
    bf16_t* H = (bf16_t*)(p.ws + WS_H);
    for (int row = bid * 8 + wid; row < MROWS; row += nblk * 8) {
        const float* src = row < NCTX ? p.in[I_CTX] + (size_t)row * 1024 : p.in[I_X] + (size_t)(row - NCTX) * 1024;
        const float* md = MOD + (size_t)row_modr(row) * 6144;
#pragma unroll
        for (int q = 0; q < 4; ++q) {
            const int col = q * 256 + lane * 4;
            const f32x4 x = *(const f32x4*)(src + col), sh = *(const f32x4*)(md + col), sc = *(const f32x4*)(md + 1024 + col);
            const f32x4 h = x * (sc + 1.0f) + sh;
            u32x2 w; w.x = pack_bf16(h[0], h[1]); w.y = pack_bf16(h[2], h[3]);
            *(u32x2*)(H + (size_t)row * 1024 + col) = w;
        }
    }
}
__device__ __forceinline__ int even_tok_row(int w, int idx) { return idx < 64 ? NCTX + (w >> 6) * 4096 + (w & 63) * 64 + idx : w * 4 + (idx - 64); }
__device__ __forceinline__ int shift_nb(int row, int cc) {
    if (row >= NCTX) { const int s = (row - NCTX) & 4095, gr = s >> 6, gc = s & 63, slot = cc & 3;
        if (slot == 0) return gc > 0 ? row - 1 : -1;
        if (slot == 1) return gc < 63 ? row + 1 : -1;
        if (slot == 2) return gr > 0 ? row - 64 : -1;
        return gr < 63 ? row + 64 : -1; }
    const int t = row & 255; return (cc & 1) == 0 ? (t > 0 ? row - 1 : -1) : (t < 255 ? row + 1 : -1);
}
__device__ __forceinline__ float shifted_z(const bf16_t* P, const float* mu, int row, int cc) {
    const float pv = bf2f(P[(size_t)row * LDP0 + cc]); const int nb = shift_nb(row, cc);
    const float sv = nb >= 0 ? bf2f(P[(size_t)nb * LDP0 + cc]) : 0.f;
    return pv + (sv - pv) * mu[cc];
}
__device__ __forceinline__ int scan_q(int row, int d) {
    if (row < NCTX) { const int t = row & 255; return d ? 255 - t : t; }
    const int s = (row - NCTX) & 4095; return 256 + (d ? 4095 - s : s);
}
__device__ __forceinline__ bf16_t* sc_rec(float* SC, int d, int row, int h) { return (bf16_t*)SC + ((size_t)((d * 4 + row_batch(row)) * 8 + h) * SCLEN + scan_q(row, d)) * SCREC; }
constexpr int LDL = 392, LDU = 520;
template <int KS>
__device__ __forceinline__ void load_b(const bf16_t* Bt, bf16x8 (&b)[4][KS], int lane) {
    const int fr = lane & 15, fq = lane >> 4;
#pragma unroll
    for (int nt = 0; nt < 4; ++nt)
#pragma unroll
        for (int ks = 0; ks < KS; ++ks) b[nt][ks] = *(const bf16x8*)(Bt + (size_t)(nt * 16 + fr) * (32 * KS) + ks * 32 + fq * 8);
}
template <int KS>
__device__ __forceinline__ void mma_mt(const LAS bf16_t* A, int lda, int mt, const bf16x8 (&b)[4][KS], f32x4 (&acc)[4], int lane) {
    const int fr = lane & 15, fq = lane >> 4;
#pragma unroll
    for (int nt = 0; nt < 4; ++nt) acc[nt] = (f32x4){0.f, 0.f, 0.f, 0.f};
#pragma unroll
    for (int ks = 0; ks < KS; ++ks) {
        const bf16x8 a = *(const LAS bf16x8*)(A + (mt * 16 + fr) * lda + ks * 32 + fq * 8);
#pragma unroll
        for (int nt = 0; nt < 4; ++nt) acc[nt] = __builtin_amdgcn_mfma_f32_16x16x32_bf16(a, b[nt][ks], acc[nt], 0, 0, 0);
    }
}
__device__ __forceinline__ void ph_prep_even(const Params& p, LAS unsigned char* lds, int bid, int nblk) {
    const int tid = threadIdx.x, wid = tid >> 6, lane = tid & 63, c = tid, fr = lane & 15, fq = lane >> 4;
    const bf16_t* P = (const bf16_t*)(p.ws + WS_P);
    float* SC = (float*)(p.ws + WS_SC);
    float* EA = (float*)(p.ws + WS_EARR);
#define EARR(k) (EA + (size_t)(k) * ((size_t)MROWS * 512))
    float* BC = (float*)(p.ws + WS_BC);
    float* CHA = (float*)(p.ws + WS_CHA); float* CHH = (float*)(p.ws + WS_CHH);
    const bf16_t* WLT = (const bf16_t*)(p.ws + WS_WLT);
    const float* mu = p.in[I_AMU];
    LAS bf16_t* linb = (LAS bf16_t*)(lds + LDS_WORK);
    LAS bf16_t* ub = linb + 80 * LDL;
    LAS float* rnorm = (LAS float*)(ub + 80 * LDU);
    for (int w = bid; w < 256; w += nblk) {
        for (int i = tid; i < 12 * LDL; i += NTHR) linb[68 * LDL + i] = 0;
        for (int i = tid; i < 12 * LDU; i += NTHR) ub[68 * LDU + i] = 0;
#pragma unroll 1
        for (int g = 0; g < 3; ++g) {
            float pv[17], sv[17];
#pragma unroll
            for (int u = 0; u < 17; ++u) { const int e = tid + NTHR * (g * 17 + u), tok = e / 384, j = e - tok * 384, row = even_tok_row(w, tok), nb = shift_nb(row, 1536 + j);
                pv[u] = bf2f(P[(size_t)row * LDP0 + 1536 + j]); sv[u] = nb >= 0 ? bf2f(P[(size_t)nb * LDP0 + 1536 + j]) : 0.f; }
#pragma unroll
            for (int u = 0; u < 17; ++u) { const int e = tid + NTHR * (g * 17 + u), tok = e / 384, j = e - tok * 384;
                const float z = pv[u] + (sv[u] - pv[u]) * mu[1536 + j];
                linb[tok * LDL + j] = f2bf(j < 128 ? ftanh(z) : (j < 256 ? z : sigm(z))); }
        }
        {
            const float kkc = p.in[I_AKK][c], mur = mu[c], muk = mu[512 + c], muv = mu[1024 + c];
#pragma unroll 1
            for (int t0 = 0; t0 < 68; t0 += 8) {
                float pr[8], pk[8], pv[8], sr[8], sk[8], sv[8];
#pragma unroll
                for (int u = 0; u < 8; ++u) { const int tk = t0 + u < 68 ? t0 + u : 67; const int row = even_tok_row(w, tk); const int nb = shift_nb(row, c);
                    const bf16_t* pp = P + (size_t)row * LDP0 + c; pr[u] = bf2f(pp[0]); pk[u] = bf2f(pp[512]); pv[u] = bf2f(pp[1024]);
                    if (nb >= 0) { const bf16_t* pn = P + (size_t)nb * LDP0 + c; sr[u] = bf2f(pn[0]); sk[u] = bf2f(pn[512]); sv[u] = bf2f(pn[1024]); } else { sr[u] = 0.f; sk[u] = 0.f; sv[u] = 0.f; } }
#pragma unroll
                for (int u = 0; u < 8; ++u) if (t0 + u < 68) { const int row = even_tok_row(w, t0 + u);
                    const float zr = pr[u] + (sr[u] - pr[u]) * mur, zk = pk[u] + (sk[u] - pk[u]) * muk, zv = pv[u] + (sv[u] - pv[u]) * muv;
                    const float kkr = zk * kkc, ss = wave_sum(kkr * kkr), rn = frcp(fmaxf(fsqrt(ss), 1e-12f)), kk = kkr * rn;
                    if (lane == 0) rnorm[(t0 + u) * 8 + wid] = rn;
#pragma unroll
                    for (int d = 0; d < 2; ++d) { bf16_t* rec = sc_rec(SC, d, row, wid) + lane; rec[128] = f2bf(kk); rec[320] = f2bf(zr); rec[384] = f2bf(zv); } }
            }
        }
        {
            const float cw0 = p.in[I_BCW][c], cw1 = p.in[I_BCW][512 + c], cw2 = p.in[I_BCW][1024 + c], cw3 = p.in[I_BCW][1536 + c], cb = p.in[I_BCB][c];
#pragma unroll 1
            for (int t0 = 0; t0 < 68; t0 += 8) {
                float x0[8], x1[8], x2[8], x3[8], gx[8];
#pragma unroll
                for (int u = 0; u < 8; ++u) { const int tk = t0 + u < 68 ? t0 + u : 67; const int row = even_tok_row(w, tk);
                    int pos, len;
                    if (row >= NCTX) { pos = (row - NCTX) & 4095; len = 4096; } else { pos = row & 255; len = 256; }
                    x0[u] = pos >= 2 ? bf2f(P[(size_t)(row - 2) * LDP0 + 1920 + c]) : 0.f; x1[u] = pos >= 1 ? bf2f(P[(size_t)(row - 1) * LDP0 + 1920 + c]) : 0.f;
                    x2[u] = bf2f(P[(size_t)row * LDP0 + 1920 + c]); x3[u] = pos + 1 < len ? bf2f(P[(size_t)(row + 1) * LDP0 + 1920 + c]) : 0.f;
                    gx[u] = bf2f(P[(size_t)row * LDP0 + 1920 + 512 + c]); }
#pragma unroll
                for (int u = 0; u < 8; ++u) if (t0 + u < 68) { const int tok = t0 + u, row = even_tok_row(w, tok);
                    const float uu = cb + cw0 * x0[u] + cw1 * x1[u] + cw2 * x2[u] + cw3 * x3[u];
                    ub[tok * LDU + c] = f2bf(uu);
                    const size_t o = (size_t)row * 512 + c;
                    ((bf16_t*)EARR(E_GATE))[o] = f2bf(0.5f * gx[u] * (1.0f + ftanh(0.7978845608028654f * (gx[u] + 0.044715f * gx[u] * gx[u] * gx[u])))); }
            }
        }
        __syncthreads();
#pragma unroll 1
        for (int d = 0; d < 2; ++d) {
            {
                bf16x8 bw[4][2]; load_b<2>(WLT + WLT_WB + (size_t)(d * 512 + wid * 64) * 64, bw, lane);
                float w0v[4];
#pragma unroll
                for (int nt = 0; nt < 4; ++nt) w0v[nt] = p.in[I_AW0][d * 512 + wid * 64 + nt * 16 + fr];
#pragma unroll 1
                for (int mt = 0; mt < 5; ++mt) {
                    f32x4 acc[4]; mma_mt<2>(linb + d * 64, LDL, mt, bw, acc, lane);
#pragma unroll
                    for (int r = 0; r < 4; ++r) { const int tok = mt * 16 + fq * 4 + r;
                        if (tok < 68) { float* rec = (float*)sc_rec(SC, d, even_tok_row(w, tok), wid) + fr;
#pragma unroll
                            for (int nt = 0; nt < 4; ++nt) rec[nt * 16] = -0.60653065971263342f * sigm(w0v[nt] + acc[nt][r]);   } }
                }
            }
            {
                bf16x8 bw[4][2]; load_b<2>(WLT + WLT_AB + (size_t)(d * 512 + wid * 64) * 64, bw, lane);
                float a0v[4], kav[4], mukv[4], kkcv[4];
#pragma unroll
                for (int nt = 0; nt < 4; ++nt) { const int n = wid * 64 + nt * 16 + fr; a0v[nt] = p.in[I_AA0][d * 512 + n]; kav[nt] = p.in[I_AKA][n]; mukv[nt] = mu[512 + n]; kkcv[nt] = p.in[I_AKK][n]; }
#pragma unroll 1
                for (int mt = 0; mt < 5; ++mt) {
                    f32x4 acc[4]; mma_mt<2>(linb + 128 + d * 64, LDL, mt, bw, acc, lane);
                    float pkv[4][4], skv[4][4];
#pragma unroll
                    for (int r = 0; r < 4; ++r) { const int tok = mt * 16 + fq * 4 + r, row = even_tok_row(w, tok < 68 ? tok : 0);
#pragma unroll
                        for (int nt = 0; nt < 4; ++nt) { const int n = wid * 64 + nt * 16 + fr, nb = shift_nb(row, n);
                            pkv[r][nt] = bf2f(P[(size_t)row * LDP0 + 512 + n]); skv[r][nt] = nb >= 0 ? bf2f(P[(size_t)nb * LDP0 + 512 + n]) : 0.f; } }
#pragma unroll
                    for (int r = 0; r < 4; ++r) { const int tok = mt * 16 + fq * 4 + r;
                        if (tok < 68) { bf16_t* rec = sc_rec(SC, d, even_tok_row(w, tok), wid) + fr; const float rn = rnorm[tok * 8 + wid];
#pragma unroll
                            for (int nt = 0; nt < 4; ++nt) { const float a = sigm(a0v[nt] + acc[nt][r]);
                                const float zk = pkv[r][nt] + (skv[r][nt] - pkv[r][nt]) * mukv[nt];
                                rec[192 + nt * 16] = f2bf(zk * (1.0f + (a - 1.0f) * kav[nt])); rec[256 + nt * 16] = f2bf(zk * kkcv[nt] * rn * a); } } }
                }
            }
        }
        {
            bf16x8 bw[4][4]; load_b<4>(WLT + WLT_GB + (size_t)(wid * 64) * 128, bw, lane);
            bf16_t* G = (bf16_t*)EARR(E_G);
#pragma unroll 1
            for (int mt = 0; mt < 5; ++mt) {
                f32x4 acc[4]; mma_mt<4>(linb + 256, LDL, mt, bw, acc, lane);
#pragma unroll
                for (int r = 0; r < 4; ++r) { const int tok = mt * 16 + fq * 4 + r;
                    if (tok < 68) { bf16_t* gp = G + (size_t)even_tok_row(w, tok) * 512 + wid * 64 + fr;
#pragma unroll
                        for (int nt = 0; nt < 4; ++nt) gp[nt * 16] = f2bf(acc[nt][r]); } }
            }
        }
#pragma unroll 1
        for (int d = 0; d < 2; ++d) {
            bf16x8 b0[4][2];
            load_b<2>(WLT + WLT_GW + (size_t)(((d * 2 + 0) * 8 + wid) * 64) * 64, b0, lane);
            float gb0[4], gb1[4], spl[4];
#pragma unroll
            for (int nt = 0; nt < 4; ++nt) { const int n = wid * 64 + nt * 16 + fr; gb0[nt] = p.in[I_BGB][(d * 2 + 0) * 512 + n]; gb1[nt] = p.in[I_BGB][(d * 2 + 1) * 512 + n]; spl[nt] = softplusf(-p.in[I_BLAM][d * 512 + n]); }
            float* Ad = EARR(E_A0 + d); float* BXd = EARR(E_BX0 + d);
#pragma unroll 1
            for (int mt = 0; mt < 5; ++mt) {
                f32x4 la[4], acc[4];
                mma_mt<2>(ub + wid * 64, LDU, mt, b0, la, lane);
                { bf16x8 b1[4][2]; load_b<2>(WLT + WLT_GW + (size_t)(((d * 2 + 1) * 8 + wid) * 64) * 64, b1, lane); mma_mt<2>(ub + wid * 64, LDU, mt, b1, acc, lane); }
#pragma unroll
                for (int r = 0; r < 4; ++r) { const int tok = mt * 16 + fq * 4 + r;
                    if (tok < 68) { const size_t o = (size_t)even_tok_row(w, tok) * 512 + wid * 64 + fr;
#pragma unroll
                        for (int nt = 0; nt < 4; ++nt) { const float lg = -8.0f * sigm(gb0[nt] + la[nt][r]) * spl[nt];
                            const float av = fexp(lg); Ad[o + nt * 16] = av; BXd[o + nt * 16] = fsqrt(fmaxf(1.0f - av * av, 0.f)) * sigm(gb1[nt] + acc[nt][r]) * bf2f(ub[tok * LDU + wid * 64 + nt * 16 + fr]);         } } }
            }
        }
        __syncthreads();
        {
            const float rk = p.in[I_ARK][c];
#pragma unroll 1
            for (int t0 = 0; t0 < 68; t0 += 17) {
                float a[17], b0[17], b1[17];
#pragma unroll
                for (int u = 0; u < 17; ++u) { const int row = even_tok_row(w, t0 + u); const bf16_t* r0 = sc_rec(SC, 0, row, wid) + lane; const bf16_t* r1 = sc_rec(SC, 1, row, wid) + lane;
                    a[u] = bf2f(r0[320]); b0[u] = bf2f(r0[192]); b1[u] = bf2f(r1[192]); }
#pragma unroll
                for (int u = 0; u < 17; ++u) { const float sm = wave_sum(a[u] * (b0[u] + b1[u]) * rk); if (lane == 0) BC[even_tok_row(w, t0 + u) * 8 + wid] = sm; }
            }
        }
#pragma unroll 1
        for (int d = 0; d < 2; ++d) {
            float* Ad = EARR(E_A0 + d); float* BXd = EARR(E_BX0 + d);
            float h = 0.f, cum = 1.f;
#pragma unroll 1
            for (int n0 = 0; n0 < 64; n0 += 16) {
                float av[16], bv[16];
#pragma unroll
                for (int i = 0; i < 16; ++i) { const int tok = d == 0 ? n0 + i : 63 - n0 - i; const size_t o = (size_t)even_tok_row(w, tok) * 512 + c; av[i] = Ad[o]; bv[i] = BXd[o]; }
#pragma unroll
                for (int i = 0; i < 16; ++i) { const int tok = d == 0 ? n0 + i : 63 - n0 - i; const size_t o = (size_t)even_tok_row(w, tok) * 512 + c;
                    h = av[i] * h + bv[i]; cum *= av[i]; Ad[o] = cum; BXd[o] = h; }
            }
            { const int cid = (w >> 6) * 128 + 64 + (w & 63); CHA[(size_t)(d * 512 + cid) * 512 + c] = cum; CHH[(size_t)(d * 512 + cid) * 512 + c] = h; }
            h = 0.f; cum = 1.f;
#pragma unroll
            for (int i = 0; i < 4; ++i) { const int tok = 64 + (d == 0 ? i : 3 - i); const size_t o = (size_t)even_tok_row(w, tok) * 512 + c;
                const float a = Ad[o], bx = BXd[o]; h = a * h + bx; cum *= a; Ad[o] = cum; BXd[o] = h; }
            { const int cid = (w >> 6) * 128 + (w & 63); CHA[(size_t)(d * 512 + cid) * 512 + c] = cum; CHH[(size_t)(d * 512 + cid) * 512 + c] = h; }
        }
        __syncthreads();
    }
}
__device__ __forceinline__ float vfma(float a, float b, float c) { float d; asm("v_fma_f32 %0, %1, %2, %3" : "=v"(d) : "v"(a), "v"(b), "v"(c)); return d; }
__device__ __forceinline__ float vmul(float a, float b) { float d; asm("v_mul_f32 %0, %1, %2" : "=v"(d) : "v"(a), "v"(b)); return d; }
#define WG_BAR() do { asm volatile("" ::: "memory"); __builtin_amdgcn_s_barrier(); asm volatile("" ::: "memory"); } while (0)
__device__ __forceinline__ int scan_row(int d, int b, int q) {
    if (q < 256) return b * 256 + (d ? 255 - q : q);
    const int s = q - 256; return NCTX + b * 4096 + (d ? 4095 - s : s);
}
__device__ __forceinline__ void ph_fin_even(const Params& p, int bid, int nblk) {
    const int tid = threadIdx.x, wid = tid >> 6, c = tid;
    float* EA = (float*)(p.ws + WS_EARR);
    float* SC = (float*)(p.ws + WS_SC);
    const float* BC = (const float*)(p.ws + WS_BC); const float* CIN = (const float*)(p.ws + WS_CIN);
    bf16_t* Y = (bf16_t*)(p.ws + WS_YMIX);
    const float gg = p.in[I_AGNG][c], gb = p.in[I_AGNB][c];
    for (int r0 = bid * 4; r0 < MROWS; r0 += nblk * 4) {
        float o0[4], o1[4], vv[4], gv[4], bc[4], x0[4], x1[4], a0[4], a1[4], c0[4], c1[4], gt[4];
#pragma unroll
        for (int u = 0; u < 4; ++u) { const int row = r0 + u; const size_t o = (size_t)row * 512 + c;
            const int cid = row < NCTX ? (row >> 8) * 128 + ((row >> 2) & 63) : ((row - NCTX) >> 12) * 128 + 64 + (((row - NCTX) & 4095) >> 6);
            o0[u] = bf2f(((const bf16_t*)EARR(E_O0))[o]); o1[u] = bf2f(((const bf16_t*)EARR(E_O1))[o]); vv[u] = bf2f(sc_rec(SC, 0, row, wid)[384 + (tid & 63)]); gv[u] = bf2f(((const bf16_t*)EARR(E_G))[o]); bc[u] = BC[row * 8 + wid];
            x0[u] = EARR(E_BX0)[o]; x1[u] = EARR(E_BX1)[o]; a0[u] = EARR(E_A0)[o]; a1[u] = EARR(E_A1)[o];
            c0[u] = CIN[(size_t)cid * 512 + c]; c1[u] = CIN[(size_t)(512 + cid) * 512 + c]; gt[u] = bf2f(((const bf16_t*)EARR(E_GATE))[o]); }
#pragma unroll
        for (int u = 0; u < 4; ++u) { const int row = r0 + u;
            const float wkv = o0[u] + o1[u];
            const float mean = wave_sum(wkv) * (1.0f / 64.0f), dv = wkv - mean, var = wave_sum(dv * dv) * (1.0f / 64.0f);
            const float y = (dv * rsqrtf(var + 64e-5f) * gg + gb + bc[u] * vv[u]) * gv[u];
            Y[(size_t)row * 1024 + c] = f2bf(y);
            Y[(size_t)row * 1024 + 512 + c] = f2bf(((x0[u] + a0[u] * c0[u]) + (x1[u] + a1[u] * c1[u])) * gt[u]); }
    }
#undef EARR
}
constexpr int LDT = 72;
__device__ __forceinline__ float quad_sum(float v) {
    v += __int_as_float(__builtin_amdgcn_update_dpp(0, __float_as_int(v), 0xB1, 0xf, 0xf, false));
    v += __int_as_float(__builtin_amdgcn_update_dpp(0, __float_as_int(v), 0x4E, 0xf, 0xf, false));
    return v;
}
template <int PO> __device__ __forceinline__ float quad_bcast(float v) { return __int_as_float(__builtin_amdgcn_update_dpp(0, __float_as_int(v), PO * 0x55, 0xf, 0xf, false)); }
__device__ __forceinline__ bf16x8 ldt8(const LAS bf16_t* T, int row, int col) { return *(const LAS bf16x8*)(T + row * LDT + col); }
__device__ __forceinline__ void ph_r1(const Params& p, LAS unsigned char* lds, int bid, int nblk) {
    const int tid = threadIdx.x, wid = tid >> 6, lane = tid & 63, fr = lane & 15, fq = lane >> 4;
    LAS bf16_t* T0 = (LAS bf16_t*)(lds + LDS_WORK);
#define TL(i) (T0 + (i) * 64 * LDT)
    LAS float* F0 = (LAS float*)(T0 + 11 * 64 * LDT);
    LAS float* F1 = F0 + 4096;
    LAS float* F2 = F1 + 4096;
    LAS float* segt = F2 + 4096;
    LAS float* gl = segt + 512;
    const float* SC = (const float*)(p.ws + WS_SC);
    float* RU = (float*)(p.ws + WS_RU);
    const int k = tid & 63, seg = tid >> 6, t0 = seg * 8;
    const int tr = (wid >> 1) * 16, tc0 = (wid & 1) * 32;
    float kk[8], lw[8], kd[8], ka[8], rr[8], vv[8];
    auto fetch = [&](int unit) {
        const int chain = unit / NRCH, c = unit - chain * NRCH;
        const bf16_t* rec = (const bf16_t*)SC + ((size_t)chain * SCLEN + c * RCH + t0) * SCREC + k;
#pragma unroll
        for (int u = 0; u < 8; ++u) { const bf16_t* r = rec + u * SCREC; lw[u] = ((const float*)(r - k))[k]; kk[u] = bf2f(r[128]); kd[u] = bf2f(r[192]); ka[u] = bf2f(r[256]); rr[u] = bf2f(r[320]); vv[u] = bf2f(r[384]); }
    };
    if (bid < NRUNIT) fetch(bid);
    for (int unit = bid; unit < NRUNIT; unit += nblk) {
        float cum[8]; { float run = 0.f;
#pragma unroll
            for (int u = 0; u < 8; ++u) { run += lw[u]; cum[u] = run; }
            segt[seg * 64 + k] = run; }
        __syncthreads();
        float off = 0.f, tot = 0.f;
#pragma unroll
        for (int s2 = 0; s2 < 8; ++s2) { const float v = segt[s2 * 64 + k]; off += s2 < seg ? v : 0.f; tot += v; }
        if (seg == 0) gl[k] = fexp(tot);
        {
            u32x4 wk, wb, wv; unsigned pk[4], pb[4], pv[4]; float hk = 0.f, hb = 0.f, hv = 0.f;
#pragma unroll
            for (int u = 0; u < 8; ++u) { const int t = t0 + u; const float cu = cum[u] + off;
                const float ginc = fexp(cu), gexc = fexp(cu - lw[u]), ginv = fexp(-cu), gtail = fexp(tot - cu);
                const float kt = kk[u] * gexc;
                TL(0)[t * LDT + k] = f2bf(kt); F0[t * 64 + k] = kt;
                TL(1)[t * LDT + k] = f2bf(kd[u] * ginv); TL(2)[t * LDT + k] = f2bf(ka[u] * ginv); TL(3)[t * LDT + k] = f2bf(rr[u] * ginc);
                const float ktl = kd[u] * gtail, btl = ka[u] * gtail;
                if (u & 1) { pk[u >> 1] = pack_bf16(hk, ktl); pb[u >> 1] = pack_bf16(hb, btl); pv[u >> 1] = pack_bf16(hv, vv[u]); } else { hk = ktl; hb = btl; hv = vv[u]; } }
            wk.x = pk[0]; wk.y = pk[1]; wk.z = pk[2]; wk.w = pk[3]; wb.x = pb[0]; wb.y = pb[1]; wb.z = pb[2]; wb.w = pb[3]; wv.x = pv[0]; wv.y = pv[1]; wv.z = pv[2]; wv.w = pv[3];
            *(LAS u32x4*)(TL(4) + k * LDT + t0) = wk; *(LAS u32x4*)(TL(5) + k * LDT + t0) = wb; *(LAS u32x4*)(TL(6) + k * LDT + t0) = wv;
        }
        if (unit + nblk < NRUNIT) fetch(unit + nblk);
        __syncthreads();
        {
            f32x4 mk[2], mb[2], ak[2], ab[2];
#pragma unroll
            for (int nt = 0; nt < 2; ++nt) { mk[nt] = (f32x4){0.f, 0.f, 0.f, 0.f}; mb[nt] = mk[nt]; ak[nt] = mk[nt]; ab[nt] = mk[nt]; }
#pragma unroll
            for (int ks = 0; ks < 2; ++ks) { const bf16x8 aK = ldt8(TL(0), tr + fr, ks * 32 + fq * 8), aR = ldt8(TL(3), tr + fr, ks * 32 + fq * 8);
#pragma unroll
                for (int nt = 0; nt < 2; ++nt) { const bf16x8 bK = ldt8(TL(1), tc0 + nt * 16 + fr, ks * 32 + fq * 8), bB = ldt8(TL(2), tc0 + nt * 16 + fr, ks * 32 + fq * 8);
                    mk[nt] = __builtin_amdgcn_mfma_f32_16x16x32_bf16(aK, bK, mk[nt], 0, 0, 0); mb[nt] = __builtin_amdgcn_mfma_f32_16x16x32_bf16(aK, bB, mb[nt], 0, 0, 0);
                    ak[nt] = __builtin_amdgcn_mfma_f32_16x16x32_bf16(aR, bK, ak[nt], 0, 0, 0); ab[nt] = __builtin_amdgcn_mfma_f32_16x16x32_bf16(aR, bB, ab[nt], 0, 0, 0); } }
#pragma unroll
            for (int nt = 0; nt < 2; ++nt)
#pragma unroll
                for (int r = 0; r < 4; ++r) { const int t = tr + fq * 4 + r, j = tc0 + nt * 16 + fr;
                    TL(7)[t * LDT + j] = f2bf(j < t ? mk[nt][r] : 0.f); F1[j * 64 + (t & 3) * 16 + (t >> 2)] = j < t ? mb[nt][r] : 0.f;
                    TL(8)[t * LDT + j] = f2bf(j <= t ? ak[nt][r] : 0.f); TL(9)[t * LDT + j] = f2bf(j <= t ? ab[nt][r] : 0.f); }
        }
        __syncthreads();
        {
            f32x4 acc[2] = {(f32x4){0.f, 0.f, 0.f, 0.f}, (f32x4){0.f, 0.f, 0.f, 0.f}};
#pragma unroll
            for (int ks = 0; ks < 2; ++ks) { const bf16x8 a = ldt8(TL(7), tr + fr, ks * 32 + fq * 8);
#pragma unroll
                for (int nt = 0; nt < 2; ++nt) acc[nt] = __builtin_amdgcn_mfma_f32_16x16x32_bf16(a, ldt8(TL(6), tc0 + nt * 16 + fr, ks * 32 + fq * 8), acc[nt], 0, 0, 0); }
#pragma unroll
            for (int nt = 0; nt < 2; ++nt)
#pragma unroll
                for (int r = 0; r < 4; ++r) F2[(tr + fq * 4 + r) * 64 + tc0 + nt * 16 + fr] = acc[nt][r];
        }
        __syncthreads();
        {
            const int col = tid >> 2, part = tid & 3;
            f32x2 acc2[8]; float x[16];
#pragma unroll
            for (int q = 0; q < 16; ++q) { const int t = 4 * q + part; acc2[q >> 1][q & 1] = col < 64 ? F0[t * 64 + col] : F2[t * 64 + col - 64]; x[q] = 0.f; }
#pragma unroll
            for (int t = 0; t < 64; ++t) {
                const int qo = t >> 2, po = t & 3; const float aq = acc2[qo >> 1][qo & 1];
                const float xt = po == 0 ? quad_bcast<0>(aq) : po == 1 ? quad_bcast<1>(aq) : po == 2 ? quad_bcast<2>(aq) : quad_bcast<3>(aq);
                x[qo] = part == po ? xt : x[qo];
                const f32x2 nx = {-xt, -xt};
#pragma unroll
                for (int q4 = qo >> 2; q4 < 4; ++q4) { const f32x4 m = *(const LAS f32x4*)(F1 + t * 64 + part * 16 + q4 * 4);
                    acc2[q4 * 2] = (f32x2){m[0], m[1]} * nx + acc2[q4 * 2]; acc2[q4 * 2 + 1] = (f32x2){m[2], m[3]} * nx + acc2[q4 * 2 + 1]; }
            }
            LAS bf16_t* dstT = col < 64 ? TL(7) + col * LDT : TL(10) + (col - 64) * LDT;
#pragma unroll
            for (int q = 0; q < 16; ++q) dstT[4 * q + part] = f2bf(-x[q]);
        }
        __syncthreads();
        {
            f32x4 rh[2], ol[2], pm[2], qq[2];
#pragma unroll
            for (int nt = 0; nt < 2; ++nt) { rh[nt] = (f32x4){0.f, 0.f, 0.f, 0.f}; ol[nt] = rh[nt]; pm[nt] = rh[nt]; qq[nt] = rh[nt]; }
#pragma unroll
            for (int ks = 0; ks < 2; ++ks) { const int kc = ks * 32 + fq * 8;
                const bf16x8 a7 = ldt8(TL(7), tr + fr, kc), a8 = ldt8(TL(8), tr + fr, kc), a9 = ldt8(TL(9), tr + fr, kc), a6 = ldt8(TL(6), tr + fr, kc), a10 = ldt8(TL(10), tr + fr, kc);
#pragma unroll
                for (int nt = 0; nt < 2; ++nt) { const int br = tc0 + nt * 16 + fr;
                    const bf16x8 b9 = ldt8(TL(9), br, kc), b6 = ldt8(TL(6), br, kc), b10 = ldt8(TL(10), br, kc), b5 = ldt8(TL(5), br, kc), b4 = ldt8(TL(4), br, kc);
                    rh[nt] = __builtin_amdgcn_mfma_f32_16x16x32_bf16(a7, b9, rh[nt], 0, 0, 0);
                    ol[nt] = __builtin_amdgcn_mfma_f32_16x16x32_bf16(a8, b6, ol[nt], 0, 0, 0); ol[nt] = __builtin_amdgcn_mfma_f32_16x16x32_bf16(a9, b10, ol[nt], 0, 0, 0);
                    pm[nt] = __builtin_amdgcn_mfma_f32_16x16x32_bf16(a7, b5, pm[nt], 0, 0, 0);
                    qq[nt] = __builtin_amdgcn_mfma_f32_16x16x32_bf16(a6, b4, qq[nt], 0, 0, 0); qq[nt] = __builtin_amdgcn_mfma_f32_16x16x32_bf16(a10, b5, qq[nt], 0, 0, 0); } }
            float* U = RU + (size_t)unit * 4 * 4096;
#pragma unroll
            for (int nt = 0; nt < 2; ++nt)
#pragma unroll
                for (int r = 0; r < 4; ++r) { const int row = tr + fq * 4 + r, cx = tc0 + nt * 16 + fr; const int o = row * 64 + cx;
                    U[o] = pm[nt][r] + (row == cx ? gl[row] : 0.f);
                    U[4096 + o] = qq[nt][r];
                    U[8192 + o] = rh[nt][r] + bf2f(TL(3)[cx * LDT + row]);
                    U[12288 + o] = ol[nt][r]; }
        }
        __syncthreads();
    }
#undef TL
}
__device__ __forceinline__ void moe_weight_tiles(const Params& p, LAS unsigned char* lds, int first, int stride) {
    const int tid = threadIdx.x; unsigned char* ws = p.ws;
    LAS float* tile = (LAS float*)(lds + LDS_WORK);
    const int j4 = (tid & 31) * 4, i0 = tid >> 5;
    auto decode = [&](int tt, const float*& src, int& ld, int& k0, int& n0, int& w1map, bf16_t*& dst) {
        if (tt < 8192) { const int mat = tt >> 7, r = tt & 127; k0 = (r >> 4) * 128; n0 = (r & 15) * 128; src = p.in[I_W1] + (size_t)mat * 1024 * 2048; ld = 2048; dst = (bf16_t*)(ws + WS_W1T) + (size_t)mat * 2048 * 1024; w1map = 1; }
        else { tt -= 8192; const int mat = tt >> 6, r = tt & 63; k0 = (r >> 3) * 128; n0 = (r & 7) * 128; src = p.in[I_W2] + (size_t)mat * 1024 * 1024; ld = 1024; dst = (bf16_t*)(ws + WS_W2T) + (size_t)mat * 1024 * 1024; w1map = 0; }
    };
    f32x4 v[8];
    if (first < 12288) { const float* src; int ld, k0, n0, w1; bf16_t* dst; decode(first, src, ld, k0, n0, w1, dst);
#pragma unroll
        for (int r = 0; r < 8; ++r) v[r] = __builtin_nontemporal_load((const f32x4*)(src + (size_t)(k0 + i0 + 16 * r) * ld + n0 + j4)); }
    for (int t = first; t < 12288; t += stride) {
        const float* src; int ld, k0, n0, w1map; bf16_t* dst; decode(t, src, ld, k0, n0, w1map, dst);
#pragma unroll
        for (int r = 0; r < 8; ++r) { LAS float* tp = tile + (i0 + 16 * r) * 129 + j4; tp[0] = v[r][0]; tp[1] = v[r][1]; tp[2] = v[r][2]; tp[3] = v[r][3]; }
        __syncthreads();
        if (t + stride < 12288) { const float* s2; int ld2, k2, n2, w2; bf16_t* d2; decode(t + stride, s2, ld2, k2, n2, w2, d2);
#pragma unroll
            for (int r = 0; r < 8; ++r) v[r] = __builtin_nontemporal_load((const f32x4*)(s2 + (size_t)(k2 + i0 + 16 * r) * ld2 + n2 + j4)); }
        { const int ip = (tid & 15) * 8, j0 = tid >> 4;
            const int rho0 = w1map ? ((((n0 & 1023) >> 7) << 8) + ((n0 >> 10) << 7)) : n0;
#pragma unroll
            for (int r = 0; r < 4; ++r) { const int j = j0 + 32 * r;
                u32x4 w; w.x = pack_bf16(tile[ip * 129 + j], tile[(ip + 1) * 129 + j]); w.y = pack_bf16(tile[(ip + 2) * 129 + j], tile[(ip + 3) * 129 + j]);
                w.z = pack_bf16(tile[(ip + 4) * 129 + j], tile[(ip + 5) * 129 + j]); w.w = pack_bf16(tile[(ip + 6) * 129 + j], tile[(ip + 7) * 129 + j]);
                const int rho = rho0 + j, kk8 = k0 + ip; *(u32x4*)(dst + ((size_t)((rho >> 8) * 16 + (kk8 >> 6)) * 256 + (rho & 255)) * 64 + (kk8 & 63)) = w; } }
        __syncthreads();
    }
}
__device__ __forceinline__ void ph_r2(const Params& p, LAS unsigned char* lds, int bid, int nblk) {
    const int tid = threadIdx.x, wid = tid >> 6, lane = tid & 63, fr = lane & 15, g = lane >> 4;
    const int nchainwg = nblk >= 128 ? 64 : 0;
    if (bid >= nchainwg) {
        const int nconv = nblk - nchainwg, cb = bid - nchainwg;
        if (tid < 256) {
            const float* CHA = (const float*)(p.ws + WS_CHA); const float* CHH = (const float*)(p.ws + WS_CHH); float* CIN = (float*)(p.ws + WS_CIN);
            for (int item = cb; item < 16; item += nconv) {
                const int gi = item * 256 + tid, d = gi >> 11, b = (gi >> 9) & 3, c = gi & 511;
                float carry = 0.f;
                for (int s0 = 0; s0 < 128; s0 += 16) {
                    float av[16], hv[16];
#pragma unroll
                    for (int q = 0; q < 16; ++q) { const int st = s0 + q; const int cl = d == 0 ? st : (st < 64 ? 63 - st : 191 - st);
                        const size_t o = (size_t)(d * 512 + b * 128 + cl) * 512 + c; av[q] = CHA[o]; hv[q] = CHH[o]; }
#pragma unroll
                    for (int q = 0; q < 16; ++q) { const int st = s0 + q; const int cl = d == 0 ? st : (st < 64 ? 63 - st : 191 - st);
                        CIN[(size_t)(d * 512 + b * 128 + cl) * 512 + c] = carry; carry = av[q] * carry + hv[q]; }
                }
            }
        }
        __syncthreads();
        moe_weight_tiles(p, lds, cb, nconv);
        if (nchainwg) return;
    }
    LAS float* ring = (LAS float*)(lds + LDS_WORK);
    const float* RU = (const float*)(p.ws + WS_RU);
    float* EA = (float*)(p.ws + WS_EARR);
    for (int chain = nchainwg ? bid : bid; chain < 64; chain += (nchainwg ? 64 : nblk)) {
        const int d = chain >> 5, b = (chain >> 3) & 3, h = chain & 7;
        bf16_t* Od = (bf16_t*)(EA + (size_t)(E_O0 + d) * ((size_t)MROWS * 512));
        auto issue = [&](int c) {
            const float* src = RU + ((size_t)chain * NRCH + c) * 4 * 4096; LAS float* dst = ring + (c & 1) * 4 * 4096;
#pragma unroll
            for (int i = 0; i < 16; ++i) { const int slot = ((wid - 4) * 16 + i) * 64;
                __builtin_amdgcn_global_load_lds((const unsigned*)(src + (size_t)(slot + lane) * 4), (LAS unsigned*)(dst + slot * 4), 16, 0, 0); }
        };
        if (tid >= 256) { issue(0); asm volatile("s_waitcnt vmcnt(0)" ::: "memory"); }
        asm volatile("" ::: "memory"); __builtin_amdgcn_s_barrier(); asm volatile("" ::: "memory");
        f32x4 S[4];
#pragma unroll
        for (int m = 0; m < 4; ++m) S[m] = (f32x4){0.f, 0.f, 0.f, 0.f};
        const int v0 = wid * 16;
        for (int c = 0; c < NRCH; ++c) {
            if (tid >= 256) { if (c + 1 < NRCH) issue(c + 1); asm volatile("s_waitcnt vmcnt(0)" ::: "memory"); }
            else {
                const LAS float* PM = ring + (c & 1) * 4 * 4096; const LAS float* QQ = PM + 4096; const LAS float* RHT = PM + 8192; const LAS float* OL = PM + 12288;
                f32x4 acc[4], Sn[4];
#pragma unroll
                for (int tt = 0; tt < 4; ++tt) {
#pragma unroll
                    for (int i = 0; i < 4; ++i) acc[tt][i] = OL[(16 * tt + 4 * g + i) * 64 + v0 + fr];
                    Sn[tt] = *(const LAS f32x4*)(QQ + (v0 + fr) * 64 + 16 * tt + 4 * g); }
                float A[3][4];
#pragma unroll
                for (int s0 = 0; s0 < 2; ++s0) { const LAS float* ar = RHT + (16 * (s0 >> 2) + 4 * g + (s0 & 3)) * 64 + fr;
#pragma unroll
                    for (int u = 0; u < 4; ++u) A[s0][u] = ar[16 * u]; }
#pragma unroll
                for (int st = 0; st < 32; ++st) {
                    if (st + 2 < 32) { const int s2 = st + 2, mi = s2 & 15; const LAS float* ar = (s2 < 16 ? RHT : PM) + (16 * (mi >> 2) + 4 * g + (mi & 3)) * 64 + fr;
#pragma unroll
                        for (int u = 0; u < 4; ++u) A[s2 % 3][u] = ar[16 * u]; }
                    __builtin_amdgcn_sched_barrier(0);
                    const int mi = st & 15; const float bq = S[mi >> 2][mi & 3];
                    if (st < 16) {
#pragma unroll
                        for (int u = 0; u < 4; ++u) acc[u] = __builtin_amdgcn_mfma_f32_16x16x4f32(A[st % 3][u], bq, acc[u], 0, 0, 0);
                    } else {
#pragma unroll
                        for (int u = 0; u < 4; ++u) Sn[u] = __builtin_amdgcn_mfma_f32_16x16x4f32(A[st % 3][u], bq, Sn[u], 0, 0, 0);
                    }
                }
#pragma unroll
                for (int tt = 0; tt < 4; ++tt)
#pragma unroll
                    for (int i = 0; i < 4; ++i) { const int row = scan_row(d, b, c * RCH + 16 * tt + 4 * g + i); Od[(size_t)row * 512 + h * 64 + v0 + fr] = f2bf(acc[tt][i]); }
#pragma unroll
                for (int m = 0; m < 4; ++m) S[m] = Sn[m];
                asm volatile("s_waitcnt lgkmcnt(0)" ::: "memory");
            }
            asm volatile("" ::: "memory"); __builtin_amdgcn_s_barrier(); asm volatile("" ::: "memory");
        }
    }
}
template <int LAYER>
__device__ __forceinline__ void ph_ln1(const Params& p, LAS unsigned char* lds, int bid, int nblk) {
    const int tid = threadIdx.x, wid = tid >> 6, lane = tid & 63;
    LAS float* rwT = (LAS float*)(lds + LDS_WORK);
    LAS int* lcnt = (LAS int*)(rwT + 32 * 1028);
#pragma unroll 1
    for (int i0 = tid; i0 < 32768; i0 += NTHR * 16) {
        float t[16];
#pragma unroll
        for (int u = 0; u < 16; ++u) t[u] = p.in[I_RW][(size_t)LAYER * 32768 + i0 + u * NTHR];
#pragma unroll
        for (int u = 0; u < 16; ++u) { const int i = i0 + u * NTHR; rwT[(i & 31) * 1028 + (i >> 5)] = t[u]; }
    }
    if (tid < 32) lcnt[tid] = 0;
    __syncthreads();
    const float* MOD = (const float*)(p.ws + WS_MOD);
    float* XS = (float*)(p.ws + WS_XS); const bf16_t* YP = (const bf16_t*)(p.ws + WS_YP); bf16_t* H = (bf16_t*)(p.ws + WS_H);
    int* TOPE = (int*)(p.ws + WS_TOPE); float* TOPW = (float*)(p.ws + WS_TOPW); int* TOPS = (int*)(p.ws + WS_TOPS);
    int* CNTB = (int*)(p.ws + WS_CNTB) + (size_t)(LAYER * 512 + bid) * 32;
    const float* lng = p.in[I_LNG] + (LAYER * 2 + 0) * 1024; const float* lnb = p.in[I_LNB] + (LAYER * 2 + 0) * 1024;
    const int rstride = nblk * 8;
    f32x4 nres[4], ngate[4]; u32x2 nyp[4];
    auto fetch = [&](int row) {
        const float* res = LAYER == 0 ? (row < NCTX ? p.in[I_CTX] + (size_t)row * 1024 : p.in[I_X] + (size_t)(row - NCTX) * 1024) : XS + (size_t)row * 1024;
        const float* md = MOD + (size_t)(LAYER * 5 + row_modr(row)) * 6144;
#pragma unroll
        for (int q = 0; q < 4; ++q) { const int col = q * 256 + lane * 4; nres[q] = *(const f32x4*)(res + col); ngate[q] = *(const f32x4*)(md + 2048 + col); nyp[q] = *(const u32x2*)(YP + (size_t)row * 1024 + col); }
    };
    { const int row0 = (LAYER == 0 ? 0 : NCTX) + bid * 8 + wid; if (row0 < MROWS) fetch(row0); }
    for (int row = (LAYER == 0 ? 0 : NCTX) + bid * 8 + wid; row < MROWS; row += rstride) {
        const float* md = MOD + (size_t)(LAYER * 5 + row_modr(row)) * 6144;
        f32x4 v[4], msc[4], msh[4]; float s = 0.f;
#pragma unroll
        for (int q = 0; q < 4; ++q) { const u32x2 w = nyp[q];
            const f32x4 y = (f32x4){__uint_as_float(w.x << 16), __uint_as_float(w.x & 0xffff0000u), __uint_as_float(w.y << 16), __uint_as_float(w.y & 0xffff0000u)};
            v[q] = nres[q] * DN_ALPHA + ngate[q] * y;
            s += (v[q][0] + v[q][1]) + (v[q][2] + v[q][3]); }
#pragma unroll
        for (int q = 0; q < 4; ++q) { const int col = q * 256 + lane * 4; msc[q] = *(const f32x4*)(md + 4096 + col); msh[q] = *(const f32x4*)(md + 3072 + col); }
        if (row + rstride < MROWS) fetch(row + rstride);
        const float mean = wave_sum(s) * (1.0f / 1024.0f);
        float ss = 0.f;
#pragma unroll
        for (int q = 0; q < 4; ++q) { v[q] = v[q] - mean; ss += (v[q][0] * v[q][0] + v[q][1] * v[q][1]) + (v[q][2] * v[q][2] + v[q][3] * v[q][3]); }
        const float rstd = rsqrtf(wave_sum(ss) * (1.0f / 1024.0f) + LN_EPS);
#pragma unroll
        for (int q = 0; q < 4; ++q) { const int col = q * 256 + lane * 4;
            const f32x4 xn = v[q] * rstd * *(const f32x4*)(lng + col) + *(const f32x4*)(lnb + col);
            *(f32x4*)(XS + (size_t)row * 1024 + col) = xn;
            v[q] = xn * (msc[q] + 1.0f) + msh[q];
            u32x2 w; w.x = pack_bf16(v[q][0], v[q][1]); w.y = pack_bf16(v[q][2], v[q][3]);
            *(u32x2*)(H + (size_t)row * 1024 + col) = w; }
        float pa[32];
#pragma unroll
        for (int e = 0; e < 32; ++e) { float a = 0.f;
#pragma unroll
            for (int q = 0; q < 4; ++q) { const f32x4 r = *(const LAS f32x4*)(rwT + e * 1028 + q * 256 + lane * 4); a += (v[q][0] * r[0] + v[q][1] * r[1]) + (v[q][2] * r[2] + v[q][3] * r[3]); }
            pa[e] = a; }
#pragma unroll
        for (int i = 0; i < 16; ++i) { const bool hi = lane & 32; const float snd = hi ? pa[i] : pa[i + 16], kp = hi ? pa[i + 16] : pa[i]; pa[i] = kp + __shfl_xor(snd, 32, 64); }
#pragma unroll
        for (int i = 0; i < 8; ++i) { const bool hi = lane & 16; const float snd = hi ? pa[i] : pa[i + 8], kp = hi ? pa[i + 8] : pa[i]; pa[i] = kp + __shfl_xor(snd, 16, 64); }
#pragma unroll
        for (int i = 0; i < 4; ++i) { const bool hi = lane & 8; const float snd = hi ? pa[i] : pa[i + 4], kp = hi ? pa[i + 4] : pa[i]; pa[i] = kp + __shfl_xor(snd, 8, 64); }
#pragma unroll
        for (int i = 0; i < 2; ++i) { const bool hi = lane & 4; const float snd = hi ? pa[i] : pa[i + 2], kp = hi ? pa[i + 2] : pa[i]; pa[i] = kp + __shfl_xor(snd, 4, 64); }
        { const bool hi = lane & 2; const float snd = hi ? pa[0] : pa[1], kp = hi ? pa[1] : pa[0]; pa[0] = kp + __shfl_xor(snd, 2, 64); }
        float lg = pa[0] + __shfl_xor(pa[0], 1, 64) + p.in[I_RB][LAYER * 32 + (lane >> 1)];
        float tv[4]; int te[4];
#pragma unroll
        for (int k = 0; k < 4; ++k) { const float bv = wave_max(lg); const int bi = wave_min_i(lg == bv ? (lane >> 1) : 99);
            tv[k] = bv; te[k] = bi & 31; lg = (lane >> 1) == bi ? -3.0e38f : lg; }
        const float e1 = expf(tv[1] - tv[0]), e2 = expf(tv[2] - tv[0]), e3 = expf(tv[3] - tv[0]), inv = 1.0f / (1.0f + e1 + e2 + e3);
        if (lane == 0) {
            const float wv[4] = {inv, e1 * inv, e2 * inv, e3 * inv};
#pragma unroll
            for (int k = 0; k < 4; ++k) { const int slot = __hip_atomic_fetch_add(lcnt + te[k], 1, __ATOMIC_RELAXED, __HIP_MEMORY_SCOPE_WORKGROUP); TOPE[row * 4 + k] = te[k]; TOPW[row * 4 + k] = wv[k]; TOPS[row * 4 + k] = slot; }
        }
    }
    __syncthreads();
    if (tid < 32) CNTB[tid] = lcnt[tid];
}
constexpr int LDS_TAB = LDS_WORK + 131072;
__device__ __forceinline__ int moe_tables(const int* cntb, int nblk, LAS int* tab, LAS int* bb) {
    const int tid = threadIdx.x, e = tid & 31, seg = tid >> 5, per = (nblk + 15) >> 4;
    const int b0 = seg * per, b1 = (b0 + per) < nblk ? (b0 + per) : nblk;
    int s = 0;
    if (per <= 16) {
        int cv[16];
#pragma unroll
        for (int u = 0; u < 16; ++u) cv[u] = (b0 + u) < b1 ? cntb[(b0 + u) * 32 + e] : 0;
#pragma unroll
        for (int u = 0; u < 16; ++u) s += cv[u];
        tab[512 + seg * 32 + e] = s;
        __syncthreads();
        if (tid < 32) { int run = 0; for (int sg = 0; sg < 16; ++sg) { const int v = tab[512 + sg * 32 + tid]; tab[512 + sg * 32 + tid] = run; run += v; } tab[448 + tid] = run; }
        __syncthreads();
        if (bb) { int run = tab[512 + seg * 32 + e];
#pragma unroll
            for (int u = 0; u < 16; ++u) if ((b0 + u) < b1) { bb[(b0 + u) * 32 + e] = run; run += cv[u]; } }
    } else {
        for (int b = b0; b < b1; ++b) s += cntb[b * 32 + e];
        tab[512 + seg * 32 + e] = s;
        __syncthreads();
        if (tid < 32) { int run = 0; for (int sg = 0; sg < 16; ++sg) { const int v = tab[512 + sg * 32 + tid]; tab[512 + sg * 32 + tid] = run; run += v; } tab[448 + tid] = run; }
        __syncthreads();
        if (bb) { int run = tab[512 + seg * 32 + e]; for (int b = b0; b < b1; ++b) { bb[b * 32 + e] = run; run += cntb[b * 32 + e]; } }
    }
    if (tid < 64) {
        const int x = tid & 31, n = (tab[448 + x] + 255) >> 8; int inc = n;
#pragma unroll
        for (int o = 1; o < 32; o <<= 1) { const int t = __shfl_up(inc, o, 64); if ((tid & 31) >= o) inc += t; }
        if (tid < 32) { const int t0 = inc - n; tab[x] = t0 * 256; for (int i = 0; i < n; ++i) tab[64 + t0 + i] = x; if (x == 31) { tab[32] = inc * 256; tab[40] = inc; } }
    }
    __syncthreads();
    return tab[40];
}
template <int LAYER>
__device__ __forceinline__ void ph_moe_gather(const Params& p, LAS unsigned char* lds, int bid, int nblk) {
    const int tid = threadIdx.x, wid = tid >> 6, lane = tid & 63;
    LAS int* tab = (LAS int*)(lds + LDS_TAB); LAS int* bb = (LAS int*)(lds + LDS_WORK);
    (void)moe_tables((const int*)(p.ws + WS_CNTB) + (size_t)LAYER * 512 * 32, nblk, tab, bb);
    const int* TOPE = (const int*)(p.ws + WS_TOPE); const int* TOPS = (const int*)(p.ws + WS_TOPS); int* POS = (int*)(p.ws + WS_POS);
    const bf16_t* H = (const bf16_t*)(p.ws + WS_H); bf16_t* AS = (bf16_t*)(p.ws + WS_ASORT);
    const int rstride = nblk * 8, rfirst = (LAYER == 0 ? 0 : NCTX) + bid * 8 + wid;
    u32x4 na = {0u, 0u, 0u, 0u}, nb2 = {0u, 0u, 0u, 0u}; int ne[4] = {0, 0, 0, 0}, ns[4] = {0, 0, 0, 0};
    auto fetch = [&](int row) {
        na = *(const u32x4*)(H + (size_t)row * 1024 + lane * 16); nb2 = *(const u32x4*)(H + (size_t)row * 1024 + lane * 16 + 8);
#pragma unroll
        for (int k = 0; k < 4; ++k) { ne[k] = TOPE[row * 4 + k]; ns[k] = TOPS[row * 4 + k]; }
    };
    if (rfirst < MROWS) fetch(rfirst);
    for (int row = rfirst; row < MROWS; row += rstride) {
        const u32x4 a = na, b = nb2; int ce[4], cs[4];
#pragma unroll
        for (int k = 0; k < 4; ++k) { ce[k] = ne[k]; cs[k] = ns[k]; }
        if (row + rstride < MROWS) fetch(row + rstride);
#pragma unroll
        for (int k = 0; k < 4; ++k) {
            const int e = ce[k], pos = tab[e] + bb[((((row - (LAYER == 0 ? 0 : NCTX)) >> 3) % nblk) << 5) + e] + cs[k];
            if (lane == 0) POS[row * 4 + k] = pos;
            bf16_t* ad = AS + ((size_t)((pos >> 8) * 16 + (lane >> 2)) * 256 + (pos & 255)) * 64 + (lane & 3) * 16;
            *(u32x4*)ad = a; *(u32x4*)(ad + 8) = b;
        }
    }
}
template <int LAYER>
__device__ __forceinline__ void ph_moe_gemm1(const Params& p, LAS unsigned char* lds, int bid, int nblk) {
    LAS int* tab = (LAS int*)(lds + LDS_TAB);
    const int T = moe_tables((const int*)(p.ws + WS_CNTB) + (size_t)LAYER * 512 * 32, nblk, tab, (LAS int*)nullptr);
    pg8::SchedMoe<8> S{T, nblk, bid, tab + 64};
    pg8::Gemm g{(const bf16_t*)(p.ws + WS_ASORT), (const bf16_t*)(p.ws + WS_W1T) + (size_t)LAYER * 32 * 2048 * 1024, 0, 0, 1024};
    pg8::EpiAct E{(bf16_t*)(p.ws + WS_ACT), p.in[I_B1] + (size_t)LAYER * 32 * 2048};
    pg8::gemm_phase<pg8::EpiAct, pg8::SchedMoe<8>, false, true, true>(lds + LDS_WORK, g, S, E, nullptr);
}
template <int LAYER>
__device__ __forceinline__ void ph_moe_gemm2(const Params& p, LAS unsigned char* lds, int bid, int nblk) {
    LAS int* tab = (LAS int*)(lds + LDS_TAB);
    const int T = moe_tables((const int*)(p.ws + WS_CNTB) + (size_t)LAYER * 512 * 32, nblk, tab, (LAS int*)nullptr);
    pg8::SchedMoe<4> S{T, nblk, bid, tab + 64};
    pg8::Gemm g{(const bf16_t*)(p.ws + WS_ACT), (const bf16_t*)(p.ws + WS_W2T) + (size_t)LAYER * 32 * 1024 * 1024, 0, 0, 1024};
    pg8::EpiYE E{(bf16_t*)(p.ws + WS_YE), p.in[I_B2] + (size_t)LAYER * 32 * 1024};
    pg8::gemm_phase<pg8::EpiYE, pg8::SchedMoe<4>, false, true, true>(lds + LDS_WORK, g, S, E, nullptr);
}
template <int NN>
__device__ __forceinline__ void ph_gemm_dense(LAS unsigned char* lds, const bf16_t* A, const bf16_t* Bt, bf16_t* C, int ldc, int pm0, int nM, int bid, int nblk) {
    pg8::SchedDense<NN> S{nM, pm0, nblk, bid};
    pg8::Gemm g{A, Bt, 0, 0, 1024};
    pg8::EpiStore E{C, ldc};
    pg8::gemm_phase<pg8::EpiStore, pg8::SchedDense<NN>, false>(lds + LDS_WORK, g, S, E, nullptr);
}
template <int LAYER>
__device__ __forceinline__ void ph_ln2(const Params& p, LAS unsigned char* lds, int bid, int nblk) {
    const int tid = threadIdx.x, wid = tid >> 6, lane = tid & 63;
    LAS float* wgT = (LAS float*)(lds + LDS_WORK);
    if (LAYER == 0) {
#pragma unroll 1
        for (int i0 = tid; i0 < 16384; i0 += NTHR * 16) {
            float t[16];
#pragma unroll
            for (int u = 0; u < 16; ++u) { const int i = i0 + u * NTHR; t[u] = p.in[I_OWIN][(size_t)(i >> 4) * ODD_IN + 4096 + (i & 15)]; }
#pragma unroll
            for (int u = 0; u < 16; ++u) { const int i = i0 + u * NTHR; wgT[(i & 15) * 1028 + (i >> 4)] = t[u]; }
        }
        __syncthreads();
    }
    const float* MOD = (const float*)(p.ws + WS_MOD);
    float* XS = (float*)(p.ws + WS_XS); const bf16_t* YE = (const bf16_t*)(p.ws + WS_YE); bf16_t* H = (bf16_t*)(p.ws + WS_H); float* GT = (float*)(p.ws + WS_GT);
    const float* TOPW = (const float*)(p.ws + WS_TOPW); const int* POS = (const int*)(p.ws + WS_POS);
    const float* lng = p.in[I_LNG] + (LAYER * 2 + 1) * 1024; const float* lnb = p.in[I_LNB] + (LAYER * 2 + 1) * 1024;
    const int rstride = nblk * 8, rfirst = (LAYER == 0 ? 0 : NCTX) + bid * 8 + wid;
    f32x4 nw = {0.f, 0.f, 0.f, 0.f}; int np0 = 0, np1 = 0, np2 = 0, np3 = 0;
    if (rfirst < MROWS) { nw = *(const f32x4*)(TOPW + rfirst * 4); np0 = POS[rfirst * 4]; np1 = POS[rfirst * 4 + 1]; np2 = POS[rfirst * 4 + 2]; np3 = POS[rfirst * 4 + 3]; }
    for (int row = rfirst; row < MROWS; row += rstride) {
        const float* md = MOD + (size_t)(LAYER * 5 + row_modr(row)) * 6144;
        const float w0 = nw[0], w1 = nw[1], w2 = nw[2], w3 = nw[3];
        const bf16_t* y0 = YE + (size_t)np0 * 1024; const bf16_t* y1 = YE + (size_t)np1 * 1024;
        const bf16_t* y2 = YE + (size_t)np2 * 1024; const bf16_t* y3 = YE + (size_t)np3 * 1024;
        if (row + rstride < MROWS) { const int rn = row + rstride; nw = *(const f32x4*)(TOPW + rn * 4); np0 = POS[rn * 4]; np1 = POS[rn * 4 + 1]; np2 = POS[rn * 4 + 2]; np3 = POS[rn * 4 + 3]; }
        f32x4 v[4]; float s = 0.f;
#pragma unroll
        for (int q = 0; q < 4; ++q) { const int col = q * 256 + lane * 4;
            const f32x4 ffn = (ld_bf16x4(y0 + col) * w0 + ld_bf16x4(y1 + col) * w1) + (ld_bf16x4(y2 + col) * w2 + ld_bf16x4(y3 + col) * w3);
            v[q] = *(const f32x4*)(XS + (size_t)row * 1024 + col) * DN_ALPHA + *(const f32x4*)(md + 5120 + col) * ffn;
            s += (v[q][0] + v[q][1]) + (v[q][2] + v[q][3]); }
        const float mean = wave_sum(s) * (1.0f / 1024.0f);
        float ss = 0.f;
#pragma unroll
        for (int q = 0; q < 4; ++q) { v[q] = v[q] - mean; ss += (v[q][0] * v[q][0] + v[q][1] * v[q][1]) + (v[q][2] * v[q][2] + v[q][3] * v[q][3]); }
        const float rstd = rsqrtf(wave_sum(ss) * (1.0f / 1024.0f) + LN_EPS);
        if (LAYER == 1) {
#pragma unroll
            for (int q = 0; q < 4; ++q) { const int col = q * 256 + lane * 4;
                *(f32x4*)(p.out + (size_t)(row - NCTX) * 1024 + col) = v[q] * rstd * *(const f32x4*)(lng + col) + *(const f32x4*)(lnb + col); }
        } else {
            const float* md1 = MOD + (size_t)(5 + row_modr(row)) * 6144;
#pragma unroll
            for (int q = 0; q < 4; ++q) { const int col = q * 256 + lane * 4;
                const f32x4 xn = v[q] * rstd * *(const f32x4*)(lng + col) + *(const f32x4*)(lnb + col);
                *(f32x4*)(XS + (size_t)row * 1024 + col) = xn;
                v[q] = xn * (*(const f32x4*)(md1 + 1024 + col) + 1.0f) + *(const f32x4*)(md1 + col);
                u32x2 w; w.x = pack_bf16(v[q][0], v[q][1]); w.y = pack_bf16(v[q][2], v[q][3]);
                *(u32x2*)(H + (size_t)row * 1024 + col) = w; }
            float gt = 0.f;
#pragma unroll 2
            for (int g = 0; g < 16; ++g) { float a = 0.f;
#pragma unroll
                for (int q = 0; q < 4; ++q) { const f32x4 r = *(const LAS f32x4*)(wgT + g * 1028 + q * 256 + lane * 4); a += (v[q][0] * r[0] + v[q][1] * r[1]) + (v[q][2] * r[2] + v[q][3] * r[3]); }
                a = wave_sum(a); gt = lane == g ? a : gt; }
            if (lane < 16) GT[row * 16 + lane] = gt;
        }
    }
}
constexpr int LDK = 136;
__device__ __forceinline__ int sid_of(int mixer, int dir, int b, int ch, int h) { return (((mixer * 2 + dir) * 4 + b) * NCHUNK + ch) * 4 + h; }
__device__ __forceinline__ void unit_decode(int u, int& mixer, int& h, int& ch, int& b, int& row0) {
    mixer = u & 1; h = (u >> 1) & 3; const int rest = u >> 3; ch = rest % NCHUNK; b = rest / NCHUNK;
    row0 = ch < 2 ? b * 256 + ch * 128 : NCTX + b * 4096 + (ch - 2) * 128;
}
__device__ __forceinline__ void ld_raw(const bf16_t* P, int row0, int col, u32x2 (&raw)[8]) {
    const int t = threadIdx.x, i = t >> 2, part = t & 3, i0 = (part & 1) * 32 + (part >> 1) * 16;
    const bf16_t* src = P + (size_t)(row0 + i) * LDP1 + col + i0;
#pragma unroll
    for (int q = 0; q < 4; ++q) { raw[q] = *(const u32x2*)(src + q * 4); raw[4 + q] = *(const u32x2*)(src + 64 + q * 4); }
}
__device__ __forceinline__ void cvt_rows(const u32x2 (&raw)[8], bool rope, int s0, const float* ROPE, float (&lo)[16], float (&hi)[16]) {
    const int t = threadIdx.x, i = t >> 2, part = t & 3, pr = part & 1, hf = part >> 1;
#pragma unroll
    for (int q = 0; q < 4; ++q) {
        lo[q * 4] = __uint_as_float(raw[q].x << 16); lo[q * 4 + 1] = __uint_as_float(raw[q].x & 0xffff0000u); lo[q * 4 + 2] = __uint_as_float(raw[q].y << 16); lo[q * 4 + 3] = __uint_as_float(raw[q].y & 0xffff0000u);
        hi[q * 4] = __uint_as_float(raw[4 + q].x << 16); hi[q * 4 + 1] = __uint_as_float(raw[4 + q].x & 0xffff0000u); hi[q * 4 + 2] = __uint_as_float(raw[4 + q].y << 16); hi[q * 4 + 3] = __uint_as_float(raw[4 + q].y & 0xffff0000u); }
    if (rope) {
        const int s = s0 + i, pos = pr == 0 ? (s >> 6) : (s & 63);
        const float* rp = ROPE + (size_t)(pos * 32 + hf * 16) * 2;
#pragma unroll
        for (int jj = 0; jj < 16; ++jj) { const float c = rp[2 * jj], sn = rp[2 * jj + 1], a = lo[jj], b = hi[jj]; lo[jj] = a * c - b * sn; hi[jj] = a * sn + b * c; }
    }
}
__device__ __forceinline__ void st_rows(LAS bf16_t* dst, const float (&lo)[16], const float (&hi)[16], float scale) {
    const int t = threadIdx.x, i = t >> 2, part = t & 3, i0 = (part & 1) * 32 + (part >> 1) * 16;
    u32x4 w0, w1, w2, w3;
    w0.x = pack_bf16(lo[0] * scale, lo[1] * scale); w0.y = pack_bf16(lo[2] * scale, lo[3] * scale); w0.z = pack_bf16(lo[4] * scale, lo[5] * scale); w0.w = pack_bf16(lo[6] * scale, lo[7] * scale);
    w1.x = pack_bf16(lo[8] * scale, lo[9] * scale); w1.y = pack_bf16(lo[10] * scale, lo[11] * scale); w1.z = pack_bf16(lo[12] * scale, lo[13] * scale); w1.w = pack_bf16(lo[14] * scale, lo[15] * scale);
    w2.x = pack_bf16(hi[0] * scale, hi[1] * scale); w2.y = pack_bf16(hi[2] * scale, hi[3] * scale); w2.z = pack_bf16(hi[4] * scale, hi[5] * scale); w2.w = pack_bf16(hi[6] * scale, hi[7] * scale);
    w3.x = pack_bf16(hi[8] * scale, hi[9] * scale); w3.y = pack_bf16(hi[10] * scale, hi[11] * scale); w3.z = pack_bf16(hi[12] * scale, hi[13] * scale); w3.w = pack_bf16(hi[14] * scale, hi[15] * scale);
    LAS bf16_t* d = dst + i * LDK + i0;
    *(LAS u32x4*)d = w0; *(LAS u32x4*)(d + 8) = w1; *(LAS u32x4*)(d + 64) = w2; *(LAS u32x4*)(d + 72) = w3;
}
__device__ __forceinline__ void st_rows_T(LAS bf16_t* dst, const float (&lo)[16], const float (&hi)[16], float scale) {
    const int t = threadIdx.x, i = t >> 2, part = t & 3, i0 = (part & 1) * 32 + (part >> 1) * 16;
#pragma unroll
    for (int jj = 0; jj < 16; ++jj) { dst[(i0 + jj) * LDK + i] = f2bf(lo[jj] * scale); dst[(i0 + 64 + jj) * LDK + i] = f2bf(hi[jj] * scale); }
}
__device__ __forceinline__ void mma_128(const LAS bf16_t* A, const LAS bf16_t* B, f32x4 (&acc)[2][4], int wr, int wc, int lane) {
    const int fr = lane & 15, fq = lane >> 4;
#pragma unroll
    for (int ks = 0; ks < 4; ++ks) {
        bf16x8 a[2], b[4];
#pragma unroll
        for (int mt = 0; mt < 2; ++mt) a[mt] = *(const LAS bf16x8*)(A + (wr * 32 + mt * 16 + fr) * LDK + ks * 32 + fq * 8);
#pragma unroll
        for (int nt = 0; nt < 4; ++nt) b[nt] = *(const LAS bf16x8*)(B + (wc * 64 + nt * 16 + fr) * LDK + ks * 32 + fq * 8);
#pragma unroll
        for (int mt = 0; mt < 2; ++mt)
#pragma unroll
            for (int nt = 0; nt < 4; ++nt) acc[mt][nt] = __builtin_amdgcn_mfma_f32_16x16x32_bf16(a[mt], b[nt], acc[mt][nt], 0, 0, 0);
    }
}
__device__ __forceinline__ void zero_acc(f32x4 (&acc)[2][4]) {
#pragma unroll
    for (int mt = 0; mt < 2; ++mt)
#pragma unroll
        for (int nt = 0; nt < 4; ++nt) acc[mt][nt] = (f32x4){0.f, 0.f, 0.f, 0.f};
}
__device__ __forceinline__ void wave_scan_sum2(float x0, float x1, float& p0, float& p1, float& total) {
    const int lane = threadIdx.x & 63; float s = x0 + x1, inc = s;
#pragma unroll
    for (int o = 1; o < 64; o <<= 1) { const float t = __shfl_up(inc, o, 64); if (lane >= o) inc += t; }
    const float exc = inc - s; p0 = exc + x0; p1 = exc + s; total = __shfl(inc, 63, 64);
}
__device__ __forceinline__ void wave_scan_max2(float x0, float x1, float& p0, float& p1) {
    const int lane = threadIdx.x & 63; const float m = fmaxf(x0, x1); float inc = m;
#pragma unroll
    for (int o = 1; o < 64; o <<= 1) { const float t = __shfl_up(inc, o, 64); if (lane >= o) inc = fmaxf(inc, t); }
    float exc = __shfl_up(inc, 1, 64); if (lane == 0) exc = -3.0e38f;
    p0 = fmaxf(exc, x0); p1 = fmaxf(exc, m);
}
__device__ __forceinline__ void ph_c1(const Params& p, LAS unsigned char* lds, int bid, int nblk) {
    const int tid = threadIdx.x, wid = tid >> 6, lane = tid & 63, wr = wid >> 1, wc = wid & 1, fr = lane & 15, fq = lane >> 4;
    LAS bf16_t* KsT = (LAS bf16_t*)(lds + LDS_WORK); LAS bf16_t* VsT0 = KsT + 128 * LDK; LAS bf16_t* VsT1 = VsT0 + 128 * LDK;
    LAS float* z = (LAS float*)(VsT1 + 128 * LDK);
    LAS float* lfA = z + 256; LAS float* igA = lfA + 256; LAS float* zmax = igA + 256;
    const bf16_t* P = (const bf16_t*)(p.ws + WS_P); const float* GT = (const float*)(p.ws + WS_GT); const float* ROPE = (const float*)(p.ws + WS_ROPE);
    float* ST = (float*)(p.ws + WS_ST); float* NST = (float*)(p.ws + WS_NST); float* MEND = (float*)(p.ws + WS_MEND); float* BEND = (float*)(p.ws + WS_BEND);
    for (int u = bid; u < NB * NCHUNK * 4 * 2; u += nblk) {
        int mixer, h, ch, b, row0; unit_decode(u, mixer, h, ch, b, row0);
        const int colQ = mixer * 2048 + h * 128;
        u32x2 rawK[8], rawV[8]; ld_raw(P, row0, colQ + 512, rawK); ld_raw(P, row0, colQ + 1024, rawV);
        if (mixer == 0) {
            if (tid < 256) { const int dir = tid >> 7, j = tid & 127; const float lg = p.in[I_CLG][dir * 4 + h]; z[tid] = fexp(lg * (float)(dir == 0 ? 127 - j : j)); }
        } else {
            if (tid < 256) { const int dir = tid >> 7, j = tid & 127, row = row0 + j;
                igA[tid] = GT[row * 16 + dir * 4 + h] + p.in[I_DIB][dir * 4 + h];
                lfA[tid] = -softplusf(-(GT[row * 16 + 8 + dir * 4 + h] + p.in[I_DFB][dir * 4 + h])); }
            __syncthreads();
            if (tid < 128) { const int dir = tid >> 6, j0 = 2 * lane, j1 = j0 + 1;
                const float l0 = lfA[dir * 128 + j0], l1 = lfA[dir * 128 + j1], g0 = igA[dir * 128 + j0], g1 = igA[dir * 128 + j1];
                float r0, r1, total; wave_scan_sum2(l0, l1, r0, r1, total);
                const float w0 = (dir == 0 ? total - r0 : r0 - l0) + g0, w1 = (dir == 0 ? total - r1 : r1 - l1) + g1;
                const float mx = wave_max(fmaxf(w0, w1));
                z[dir * 128 + j0] = fexp(w0 - mx); z[dir * 128 + j1] = fexp(w1 - mx);
                const int sid = sid_of(1, dir, b, ch, h);
                if (lane == 0) { MEND[sid] = mx; BEND[sid] = total; }
                float* CB = (float*)(p.ws + WS_CB) + (size_t)sid * 128; float* CMI = (float*)(p.ws + WS_CMI) + (size_t)sid * 128;
                if (dir == 0) { float m0, m1; wave_scan_max2(g0 - r0, g1 - r1, m0, m1); CB[j0] = r0; CB[j1] = r1; CMI[j0] = r0 + m0; CMI[j1] = r1 + m1; }
                else { const float s0 = total - r0 + l0, s1 = total - r1 + l1;
                    lfA[128 + j0] = g0 - s0; lfA[128 + j1] = g1 - s1; igA[128 + j0] = s0; igA[128 + j1] = s1; CB[j0] = s0; CB[j1] = s1;
                    asm volatile("s_waitcnt lgkmcnt(0)" ::: "memory");
                    const int q0 = 127 - 2 * lane, q1 = q0 - 1; float m0, m1; wave_scan_max2(lfA[128 + q0], lfA[128 + q1], m0, m1);
                    CMI[q0] = igA[128 + q0] + m0; CMI[q1] = igA[128 + q1] + m1; } }
        }
        __syncthreads();
        {
            float lo[16], hi[16];
            cvt_rows(rawK, mixer == 0 && ch >= 2, (ch - 2) * 128, ROPE, lo, hi);
            st_rows_T(KsT, lo, hi, 0.08838834764831845f);
            cvt_rows(rawV, false, 0, ROPE, lo, hi);
            const int i = tid >> 2;
            st_rows_T(VsT0, lo, hi, z[i]); st_rows_T(VsT1, lo, hi, z[128 + i]);
        }
        __syncthreads();
#pragma unroll
        for (int dir = 0; dir < 2; ++dir) {
            f32x4 acc[2][4]; zero_acc(acc);
            mma_128(dir == 0 ? VsT0 : VsT1, KsT, acc, wr, wc, lane);
            bf16_t* dst = (bf16_t*)ST + (size_t)sid_of(mixer, dir, b, ch, h) * 16384;
#pragma unroll
            for (int mt = 0; mt < 2; ++mt)
#pragma unroll
                for (int nt = 0; nt < 4; ++nt)
#pragma unroll
                    for (int r = 0; r < 4; ++r) dst[(wr * 32 + mt * 16 + fq * 4 + r) * 128 + wc * 64 + nt * 16 + fr] = f2bf(acc[mt][nt][r]);
        }
        if (mixer == 1 && tid < 256) { const int dir = tid >> 7, dd = tid & 127; float s = 0.f;
            for (int j = 0; j < 128; ++j) s += z[dir * 128 + j] * bf2f(KsT[dd * LDK + j]);
            NST[(size_t)sid_of(1, dir, b, ch, h) * 128 + dd] = s; }
        __syncthreads();
    }
}
__device__ __forceinline__ void ph_c2(const Params& p, int bid, int nblk) {
    const int tid = threadIdx.x;
    float* ST = (float*)(p.ws + WS_ST); float* NST = (float*)(p.ws + WS_NST); bf16_t* STB = (bf16_t*)(p.ws + WS_STB);
    const float* MEND = (const float*)(p.ws + WS_MEND); const float* BEND = (const float*)(p.ws + WS_BEND); float* MPREV = (float*)(p.ws + WS_MPREV);
    for (int item = bid; item < 2048; item += nblk) {
        const int mixer = item >> 10, chain = (item >> 5) & 31, slab = item & 31, dir = chain >> 4, b = (chain >> 2) & 3, h = chain & 3;
        const int idx = slab * 512 + tid;
        float kv[NCHUNK];
#pragma unroll
        for (int k = 0; k < NCHUNK; ++k) { const int ch = dir == 0 ? k : (k < 2 ? 1 - k : 35 - k); kv[k] = bf2f(((const bf16_t*)ST)[(size_t)sid_of(mixer, dir, b, ch, h) * 16384 + idx]); }
        if (mixer == 0) {
            const float gdec = fexp(p.in[I_CLG][dir * 4 + h] * 128.0f); float r = 0.f;
#pragma unroll
            for (int k = 0; k < NCHUNK; ++k) { const int ch = dir == 0 ? k : (k < 2 ? 1 - k : 35 - k); STB[(size_t)sid_of(0, dir, b, ch, h) * 16384 + idx] = f2bf(r); r = r * gdec + kv[k]; }
        } else {
            const bool do_n = slab == 0 && tid < 128;
            float nv[NCHUNK];
#pragma unroll
            for (int k = 0; k < NCHUNK; ++k) { const int ch = dir == 0 ? k : (k < 2 ? 1 - k : 35 - k); nv[k] = do_n ? NST[(size_t)sid_of(1, dir, b, ch, h) * 128 + tid] : 0.f; }
            float m = -__builtin_inff(), c = 0.f, n = 0.f;
#pragma unroll
            for (int k = 0; k < NCHUNK; ++k) { const int ch = dir == 0 ? k : (k < 2 ? 1 - k : 35 - k); const int sid = sid_of(1, dir, b, ch, h);
                const float me = MEND[sid], be = BEND[sid], mnew = fmaxf(be + m, me), so = fexp(be + m - mnew), sn = fexp(me - mnew);
                STB[(size_t)sid * 16384 + idx] = f2bf(c); c = c * so + kv[k] * sn;
                if (do_n) { NST[(size_t)sid * 128 + tid] = n; n = n * so + nv[k] * sn; }
                if (slab == 0 && tid == 0) MPREV[sid] = m;
                m = mnew; }
        }
    }
}
template <int mixer>
__device__ __forceinline__ void c3_unit(const Params& p, LAS unsigned char* lds, int h, int ch, int b, int row0) {
    const int tid = threadIdx.x, wid = tid >> 6, lane = tid & 63, wr = wid >> 1, wc = wid & 1, fr = lane & 15, fq = lane >> 4;
    LAS bf16_t* Qs = (LAS bf16_t*)(lds + LDS_WORK); LAS bf16_t* Ks = Qs + 128 * LDK; LAS bf16_t* VsT = Ks + 128 * LDK; LAS bf16_t* RT = VsT + 128 * LDK;
    LAS float* fa = (LAS float*)(RT + 128 * LDK);
    LAS float* lfA = fa; LAS float* igA = fa + 256; LAS float* bA = fa + 512; LAS float* miA = fa + 768; LAS float* mtA = fa + 1024; LAS float* sintA = fa + 1280;
    LAS float* rowsum = fa + 1536; LAS float* qn = fa + 2048; LAS float* nA = fa + 2304;
    LAS float* Os = (LAS float*)Qs;
    LAS bf16_t* Pm = Ks;
    const bf16_t* P = (const bf16_t*)(p.ws + WS_P); const float* GT = (const float*)(p.ws + WS_GT); const float* ROPE = (const float*)(p.ws + WS_ROPE);
    const bf16_t* STB = (const bf16_t*)(p.ws + WS_STB); const float* NST = (const float*)(p.ws + WS_NST); const float* MPREV = (const float*)(p.ws + WS_MPREV);
    bf16_t* Y = (bf16_t*)(p.ws + WS_YMIX);
    {
        const int colQ = mixer * 2048 + h * 128; const bool rope = mixer == 0 && ch >= 2;
        {
            u32x2 rawQ[8], rawK[8], rawV[8]; ld_raw(P, row0, colQ, rawQ); ld_raw(P, row0, colQ + 512, rawK); ld_raw(P, row0, colQ + 1024, rawV);
            float lo[16], hi[16];
            cvt_rows(rawQ, rope, (ch - 2) * 128, ROPE, lo, hi); st_rows(Qs, lo, hi, 1.0f);
            cvt_rows(rawK, rope, (ch - 2) * 128, ROPE, lo, hi); st_rows(Ks, lo, hi, 0.08838834764831845f);
            cvt_rows(rawV, false, 0, ROPE, lo, hi); st_rows_T(VsT, lo, hi, 1.0f);
        }
        if (mixer == 1) {
            if (tid < 256) { const int dir = tid >> 7, j = tid & 127, row = row0 + j;
                igA[tid] = GT[row * 16 + dir * 4 + h] + p.in[I_DIB][dir * 4 + h];
                nA[tid] = NST[(size_t)sid_of(1, dir, b, ch, h) * 128 + j];
                bA[tid] = ((const float*)(p.ws + WS_CB))[(size_t)sid_of(1, dir, b, ch, h) * 128 + j]; miA[tid] = ((const float*)(p.ws + WS_CMI))[(size_t)sid_of(1, dir, b, ch, h) * 128 + j]; }
            __syncthreads();
            __syncthreads();
            if (tid < 256) { const int dir = tid >> 7, i = tid & 127; const float mprev = MPREV[sid_of(1, dir, b, ch, h)];
                const float gi = bA[tid] + mprev, mt = fmaxf(gi, miA[tid]); mtA[tid] = mt; sintA[tid] = fexp(gi - mt);
                float s = 0.f;
                for (int d0 = 0; d0 < 128; ++d0) s += bf2f(Qs[i * LDK + d0]) * nA[dir * 128 + d0];
                qn[tid] = s; }
        }
        __syncthreads();
        f32x4 S[2][4]; zero_acc(S);
        mma_128(Qs, Ks, S, wr, wc, lane);
        __syncthreads();
        f32x4 O[2][4]; zero_acc(O);
        if (mixer == 0) {
            const float lg0 = p.in[I_CLG][h], lg1 = p.in[I_CLG][4 + h];
#pragma unroll
            for (int mt = 0; mt < 2; ++mt)
#pragma unroll
                for (int nt = 0; nt < 4; ++nt)
#pragma unroll
                    for (int r = 0; r < 4; ++r) { const int i = wr * 32 + mt * 16 + fq * 4 + r, j = wc * 64 + nt * 16 + fr;
                        const float dcy = (i >= j ? fexp(lg0 * (float)(i - j)) : 0.f) + (j >= i ? fexp(lg1 * (float)(j - i)) : 0.f);
                        Pm[i * LDK + j] = f2bf(S[mt][nt][r] * dcy); }
            __syncthreads();
            mma_128(Pm, VsT, O, wr, wc, lane);
#pragma unroll
            for (int dir = 0; dir < 2; ++dir) {
                { const bf16_t* src = STB + (size_t)sid_of(0, dir, b, ch, h) * 16384 + (tid >> 2) * 128 + (tid & 3) * 32; LAS bf16_t* d = RT + (tid >> 2) * LDK + (tid & 3) * 32;
#pragma unroll
                    for (int q = 0; q < 4; ++q) *(LAS u32x4*)(d + q * 8) = *(const u32x4*)(src + q * 8); }
                __syncthreads();
                f32x4 T[2][4]; zero_acc(T);
                mma_128(Qs, RT, T, wr, wc, lane);
#pragma unroll
                for (int mt = 0; mt < 2; ++mt)
#pragma unroll
                    for (int r = 0; r < 4; ++r) { const int i = wr * 32 + mt * 16 + fq * 4 + r; const float xi = dir == 0 ? fexp(lg0 * (float)(i + 1)) : fexp(lg1 * (float)(128 - i));
#pragma unroll
                        for (int nt = 0; nt < 4; ++nt) O[mt][nt][r] += xi * T[mt][nt][r]; }
                __syncthreads();
            }
        } else {
#pragma unroll
            for (int dir = 0; dir < 2; ++dir) {
                float rp[2][4];
#pragma unroll
                for (int mt = 0; mt < 2; ++mt)
#pragma unroll
                    for (int r = 0; r < 4; ++r) { const int i = wr * 32 + mt * 16 + fq * 4 + r; const float bi = bA[dir * 128 + i] - mtA[dir * 128 + i]; float acc = 0.f;
#pragma unroll
                        for (int nt = 0; nt < 4; ++nt) { const int j = wc * 64 + nt * 16 + fr; const bool valid = dir == 0 ? (j <= i) : (j >= i);
                            const float e = valid ? fexp(bi - bA[dir * 128 + j] + igA[dir * 128 + j]) : 0.f; const float pv = S[mt][nt][r] * e;
                            Pm[i * LDK + j] = f2bf(pv); acc += pv; }
                        rp[mt][r] = row16_sum(acc); }
                if (fr == 0) {
#pragma unroll
                    for (int mt = 0; mt < 2; ++mt)
#pragma unroll
                        for (int r = 0; r < 4; ++r) rowsum[wc * 256 + dir * 128 + wr * 32 + mt * 16 + fq * 4 + r] = rp[mt][r];
                }
                { const bf16_t* src = STB + (size_t)sid_of(1, dir, b, ch, h) * 16384 + (tid >> 2) * 128 + (tid & 3) * 32; LAS bf16_t* d = RT + (tid >> 2) * LDK + (tid & 3) * 32;
#pragma unroll
                    for (int q = 0; q < 4; ++q) *(LAS u32x4*)(d + q * 8) = *(const u32x4*)(src + q * 8); }
                __syncthreads();
                f32x4 T[2][4]; zero_acc(T);
                mma_128(Qs, RT, T, wr, wc, lane);
#pragma unroll
                for (int mt = 0; mt < 2; ++mt)
#pragma unroll
                    for (int r = 0; r < 4; ++r) { const float si = sintA[dir * 128 + wr * 32 + mt * 16 + fq * 4 + r];
#pragma unroll
                        for (int nt = 0; nt < 4; ++nt) T[mt][nt][r] *= si; }
                mma_128(Pm, VsT, T, wr, wc, lane);
#pragma unroll
                for (int mt = 0; mt < 2; ++mt)
#pragma unroll
                    for (int r = 0; r < 4; ++r) { const int i = wr * 32 + mt * 16 + fq * 4 + r; const float si = sintA[dir * 128 + i];
                        float den = (rowsum[dir * 128 + i] + rowsum[256 + dir * 128 + i]) + qn[dir * 128 + i] * si; den = fmaxf(fabsf(den), fexp(-mtA[dir * 128 + i])); const float rden = frcp(den);
#pragma unroll
                        for (int nt = 0; nt < 4; ++nt) O[mt][nt][r] += T[mt][nt][r] * rden; }
                __syncthreads();
            }
        }
#pragma unroll
        for (int mt = 0; mt < 2; ++mt)
#pragma unroll
            for (int nt = 0; nt < 4; ++nt)
#pragma unroll
                for (int r = 0; r < 4; ++r) Os[(wr * 32 + mt * 16 + fq * 4 + r) * 132 + wc * 64 + nt * 16 + fr] = O[mt][nt][r];
        __syncthreads();
        {
            const float* gng = (mixer == 0 ? p.in[I_CGNG] : p.in[I_DGNG]) + h * 128; const float* gnb = (mixer == 0 ? p.in[I_CGNB] : p.in[I_DGNB]) + h * 128;
            const float g0 = gng[lane], g1 = gng[lane + 64], b0 = gnb[lane], b1 = gnb[lane + 64];
#pragma unroll 1
            for (int i4 = 0; i4 < 16; i4 += 4) {
                float qg0[4], qg1[4];
#pragma unroll
                for (int u = 0; u < 4; ++u) { const int row = row0 + wid * 16 + i4 + u; qg0[u] = bf2f(P[(size_t)row * LDP1 + colQ + 1536 + lane]); qg1[u] = bf2f(P[(size_t)row * LDP1 + colQ + 1536 + 64 + lane]); }
#pragma unroll
                for (int u = 0; u < 4; ++u) { const int i = wid * 16 + i4 + u, row = row0 + i;
                    const float x0 = Os[i * 132 + lane], x1 = Os[i * 132 + 64 + lane];
                    const float mean = wave_sum(x0 + x1) * (1.0f / 128.0f), d0 = x0 - mean, d1 = x1 - mean;
                    const float rstd = rsqrtf(wave_sum(d0 * d0 + d1 * d1) * (1.0f / 128.0f) + LN_EPS);
                    const float q0 = qg0[u], q1 = qg1[u];
                    const float s0 = sigm(q0), s1 = sigm(q1);
                    const float y0 = (d0 * rstd * g0 + b0) * (mixer == 0 ? q0 * s0 : s0), y1 = (d1 * rstd * g1 + b1) * (mixer == 0 ? q1 * s1 : s1);
                    Y[(size_t)row * 1024 + mixer * 512 + h * 128 + lane] = f2bf(y0); Y[(size_t)row * 1024 + mixer * 512 + h * 128 + 64 + lane] = f2bf(y1); }
            }
        }
        __syncthreads();
    }
}
__device__ __forceinline__ void ph_c3(const Params& p, LAS unsigned char* lds, int bid, int nblk) {
    for (int u2 = bid; u2 < NB * NCHUNK * 4; u2 += nblk) {
        int mixer, h, ch, b, row0; unit_decode(u2 * 2, mixer, h, ch, b, row0);
        c3_unit<0>(p, lds, h, ch, b, row0);
    }
    for (int u2 = nblk - 1 - bid; u2 < NB * NCHUNK * 4; u2 += nblk) {
        int mixer, h, ch, b, row0; unit_decode(u2 * 2 + 1, mixer, h, ch, b, row0);
        c3_unit<1>(p, lds, h, ch, b, row0);
    }
}
constexpr int NPHASE = 23;
__global__ void __launch_bounds__(NTHR, 2) fwd(Params p) {
    extern __shared__ __attribute__((aligned(16))) unsigned char smem_raw[];
    LAS unsigned char* lds = (LAS unsigned char*)smem_raw;
    if (threadIdx.x == 0) { LAS unsigned* st = (LAS unsigned*)(lds + LDS_BAR); st[0] = 0u; st[1] = 0u; st[2] = 0u; st[3] = 0u; }
    __syncthreads();
    XcdBarrier bar = xcd_barrier_post((unsigned*)(p.ws + WS_CTL), (volatile LAS unsigned*)(lds + LDS_BAR));
    const int bid = blockIdx.x, nblk = gridDim.x;
    unsigned char* ws = p.ws;
#ifndef PHASE_ONLY
#define PHASE_ONLY -1
#endif
#ifndef DBL_MASK
#define DBL_MASK 0u
#endif
#define PHASE(k, call) if constexpr (PHASE_ONLY < 0 || PHASE_ONLY == (k)) { if (p.lo <= (k) && (k) < p.hi) { call; if constexpr ((DBL_MASK >> (k)) & 1u) { xcd_barrier(bar); call; } if ((k) + 1 < p.hi) xcd_barrier(bar); } }
    PHASE(0, ph_prologue(p, lds, bid, nblk))
    PHASE(1, ph_mod_in(p, bid, nblk))
    PHASE(2, ph_gemm_dense<12>(lds, (const bf16_t*)(ws + WS_H), (const bf16_t*)(ws + WS_WIN0T), (bf16_t*)(ws + WS_P), LDP0, 0, 68, bid, nblk))
    PHASE(3, ph_prep_even(p, lds, bid, nblk))
    PHASE(4, ph_r1(p, lds, bid, nblk))
    PHASE(5, ph_r2(p, lds, bid, nblk))
    PHASE(6, ph_fin_even(p, bid, nblk))
    PHASE(7, ph_gemm_dense<4>(lds, (const bf16_t*)(ws + WS_YMIX), (const bf16_t*)(ws + WS_WOUTT), (bf16_t*)(ws + WS_YP), 1024, 0, 68, bid, nblk))
    PHASE(8, ph_ln1<0>(p, lds, bid, nblk))
    PHASE(9, ph_moe_gather<0>(p, lds, bid, nblk))
    PHASE(10, ph_moe_gemm1<0>(p, lds, bid, nblk))
    PHASE(11, ph_moe_gemm2<0>(p, lds, bid, nblk))
    PHASE(12, ph_ln2<0>(p, lds, bid, nblk))
    PHASE(13, ph_gemm_dense<16>(lds, (const bf16_t*)(ws + WS_H), (const bf16_t*)(ws + WS_WIN1T), (bf16_t*)(ws + WS_P), LDP1, 0, 68, bid, nblk))
    PHASE(14, ph_c1(p, lds, bid, nblk))
    PHASE(15, ph_c2(p, bid, nblk))
    PHASE(16, ph_c3(p, lds, bid, nblk))
    PHASE(17, ph_gemm_dense<4>(lds, (const bf16_t*)(ws + WS_YMIX), (const bf16_t*)(ws + WS_WOUTT) + (size_t)1024 * 1024, (bf16_t*)(ws + WS_YP), 1024, 4, 64, bid, nblk))
    PHASE(18, ph_ln1<1>(p, lds, bid, nblk))
    PHASE(19, ph_moe_gather<1>(p, lds, bid, nblk))
    PHASE(20, ph_moe_gemm1<1>(p, lds, bid, nblk))
    PHASE(21, ph_moe_gemm2<1>(p, lds, bid, nblk))
    PHASE(22, ph_ln2<1>(p, lds, bid, nblk))
#undef PHASE
}

#ifndef MK_ONE_LAUNCH
#define MK_ONE_LAUNCH 1
#endif
extern "C" void kernel_launch(void* const* d_in, const int* in_sizes, int n_in, void* d_out, int out_size, void* d_ws, size_t ws_size, hipStream_t stream) {
    static int grid = 0;
    if (grid == 0) {
        if (n_in != N_INPUTS || out_size != NB * SEQL * DM || ws_size < WS_TOTAL) { fprintf(stderr, "kernel_launch: unexpected problem (n_in %d, out %d, ws %zu < %zu)\n", n_in, out_size, ws_size, (size_t)WS_TOTAL); grid = -1; return; }
        int dev = 0, cus = 0, per_cu = 0;
        if (hipGetDevice(&dev) != hipSuccess || hipDeviceGetAttribute(&cus, hipDeviceAttributeMultiprocessorCount, dev) != hipSuccess) { grid = -1; return; }
        if (hipFuncSetAttribute((const void*)fwd, hipFuncAttributeMaxDynamicSharedMemorySize, LDS_BYTES) != hipSuccess) { fprintf(stderr, "kernel_launch: hipFuncSetAttribute failed\n"); grid = -1; return; }
        if (hipOccupancyMaxActiveBlocksPerMultiprocessor(&per_cu, (const void*)fwd, NTHR, LDS_BYTES) != hipSuccess || per_cu < 1) { fprintf(stderr, "kernel_launch: occupancy query says %d\n", per_cu); (void)hipGetLastError(); per_cu = 1; }
        grid = cus;
    }
    if (grid < 0) return;
    (void)hipMemsetAsync((char*)d_ws + WS_CTL, 0, CTL_BYTES, stream);
    Params p{};
    for (int i = 0; i < N_INPUTS; ++i) p.in[i] = (const float*)d_in[i];
    p.out = (float*)d_out; p.ws = (unsigned char*)d_ws;
#if MK_ONE_LAUNCH
    p.lo = 0; p.hi = NPHASE;
    hipLaunchKernelGGL(fwd, dim3(grid), dim3(NTHR), LDS_BYTES, stream, p);
#else
    for (int k = 0; k < NPHASE; ++k) { p.lo = k; p.hi = k + 1; hipLaunchKernelGGL(fwd, dim3(grid), dim3(NTHR), LDS_BYTES, stream, p); }
#endif
}
```

```cpp
#include <hip/hip_runtime.h>
#include <stdint.h>
#include <stdio.h>

#define LAS __attribute__((address_space(3)))
typedef unsigned short bf16_t;
typedef short bf16x8 __attribute__((ext_vector_type(8)));
typedef float f32x4 __attribute__((ext_vector_type(4)));
typedef float f32x2 __attribute__((ext_vector_type(2)));
typedef unsigned u32x4 __attribute__((ext_vector_type(4)));
typedef unsigned u32x2 __attribute__((ext_vector_type(2)));

constexpr int NB = 4, SEQL = 4096, CTXL = 256, DM = 1024;
constexpr int NCTX = NB * CTXL;
constexpr int MROWS = NCTX + NB * SEQL;
constexpr int NTHR = 512;
constexpr int LDP0 = 3072, LDP1 = 4096;
constexpr int A_IN = 1920, EVEN_IN = 2944, ODD_IN = 4112;
constexpr int NEXP = 32, DFF = 1024;
constexpr int MOE_ROWS_MAX = 69632 + 32 * 256;
constexpr float DN_ALPHA = 1.41421356237309515f;
constexpr float LN_EPS = 1e-5f;
constexpr int NCHUNK = 34;

enum { I_X = 0, I_C, I_CTX, I_CCTX, I_WMOD, I_BMOD, I_LNG, I_LNB, I_EWIN, I_EWOUT, I_AMU, I_AW0, I_AWB, I_AA0, I_AAB, I_AGB, I_AKK, I_AKA, I_ARK,
       I_AGNG, I_AGNB, I_BCW, I_BCB, I_BGW, I_BGB, I_BLAM, I_OWIN, I_OWOUT, I_CLG, I_CGNG, I_CGNB, I_DIB, I_DFB, I_DGNG, I_DGNB, I_RW, I_RB,
       I_W1, I_B1, I_W2, I_B2, N_INPUTS };

constexpr size_t al256(size_t x) { return (x + 255) & ~(size_t)255; }
constexpr size_t WS_CTL   = 0;
constexpr size_t CTL_BYTES = 65536;
constexpr size_t CTL_CNT  = 16384;
constexpr size_t WS_MOD   = WS_CTL + CTL_BYTES;
constexpr size_t WS_ROPE  = WS_MOD + al256((size_t)2 * 5 * 6144 * 4);
constexpr size_t WS_WIN0T = WS_ROPE + 16384;
constexpr size_t WS_WIN1T = WS_WIN0T + (size_t)3072 * 1024 * 2;
constexpr size_t WS_WOUTT = WS_WIN1T + (size_t)4096 * 1024 * 2;
constexpr size_t WS_W1T   = WS_WOUTT + (size_t)2 * 1024 * 1024 * 2;
constexpr size_t WS_W2T   = WS_W1T + (size_t)2 * 32 * 2048 * 1024 * 2;
constexpr size_t WS_XS    = WS_W2T + (size_t)2 * 32 * 1024 * 1024 * 2;
constexpr size_t WS_H     = WS_XS + (size_t)MROWS * 1024 * 4;
constexpr size_t WS_YMIX  = WS_H + (size_t)MROWS * 1024 * 2;
constexpr size_t WS_YP    = WS_YMIX + (size_t)MROWS * 1024 * 2;
constexpr size_t WS_GT    = WS_YP + (size_t)MROWS * 1024 * 4;
constexpr size_t WS_TOPE  = WS_GT + (size_t)MROWS * 16 * 4;
constexpr size_t WS_TOPW  = WS_TOPE + (size_t)MROWS * 16;
constexpr size_t WS_TOPS  = WS_TOPW + (size_t)MROWS * 16;
constexpr size_t WS_POS   = WS_TOPS + (size_t)MROWS * 16;
constexpr size_t WS_CNTB  = WS_POS + (size_t)MROWS * 16;
constexpr size_t WS_WLT   = WS_CNTB + (size_t)2 * 512 * 32 * 4;
constexpr size_t WLT_WB = 0, WLT_AB = 65536, WLT_GB = 131072, WLT_GW = 196608, WLT_N = 327680;
constexpr size_t WS_P     = WS_WLT + (size_t)WLT_N * 2;
constexpr size_t WS_BIG   = WS_P + (size_t)MROWS * 4096 * 4;
constexpr size_t ARR512   = (size_t)MROWS * 512 * 4;
constexpr int SCREC = 448;
constexpr int SCLEN = CTXL + SEQL;
constexpr size_t WS_SC    = WS_BIG;
enum { E_G = 0, E_O0, E_O1, E_A0, E_A1, E_BX0, E_BX1, E_GATE, E_NARR };
constexpr size_t WS_EARR  = WS_SC + (size_t)64 * SCLEN * SCREC * 2;
constexpr size_t WS_BC    = WS_EARR + (size_t)E_NARR * ARR512;
constexpr size_t WS_CHA   = WS_BC + (size_t)MROWS * 8 * 4;
constexpr size_t WS_CHH   = WS_CHA + (size_t)2 * 512 * 512 * 4;
constexpr size_t WS_CIN   = WS_CHH + (size_t)2 * 512 * 512 * 4;
constexpr int RCH = 64, NRCH = SCLEN / RCH, NRUNIT = 64 * NRCH;
constexpr size_t WS_RU    = WS_CIN + (size_t)2 * 512 * 512 * 4;
constexpr size_t WS_EEND  = WS_RU + (size_t)NRUNIT * 4 * 4096 * 4;
constexpr int NSID = 2 * 2 * NB * NCHUNK * 4;
constexpr size_t WS_ST    = WS_BIG;
constexpr size_t WS_NST   = WS_ST + (size_t)NSID * 16384 * 4;
constexpr size_t WS_MEND  = WS_NST + (size_t)NSID * 128 * 4;
constexpr size_t WS_BEND  = WS_MEND + al256((size_t)NSID * 4);
constexpr size_t WS_MPREV = WS_BEND + al256((size_t)NSID * 4);
constexpr size_t WS_CB    = WS_MPREV + al256((size_t)NSID * 4);
constexpr size_t WS_CMI   = WS_CB + (size_t)NSID * 128 * 4;
constexpr size_t WS_STB   = WS_CMI + (size_t)NSID * 128 * 4;
constexpr size_t WS_OEND  = WS_STB + (size_t)NSID * 16384 * 2;
constexpr size_t WS_ASORT = WS_BIG;
constexpr size_t WS_ACT   = WS_ASORT + (size_t)MOE_ROWS_MAX * 1024 * 2;
constexpr size_t WS_YE    = WS_ACT + (size_t)MOE_ROWS_MAX * 1024 * 2;
constexpr size_t WS_MEND_ = WS_YE + (size_t)MOE_ROWS_MAX * 1024 * 4;
constexpr size_t WS_TOTAL = (WS_EEND > WS_MEND_ ? (WS_EEND > WS_OEND ? WS_EEND : WS_OEND) : (WS_MEND_ > WS_OEND ? WS_MEND_ : WS_OEND));

constexpr int LDS_BYTES = 155648;
constexpr int LDS_BAR = 0;
constexpr int LDS_WORK = 1024;

struct Params {
    const float* in[N_INPUTS];
    float* out;
    unsigned char* ws;
    int lo, hi;
};

typedef __bf16 nbf16x2 __attribute__((ext_vector_type(2)));
__device__ __forceinline__ unsigned pack_bf16(float lo, float hi) { const nbf16x2 v = {(__bf16)lo, (__bf16)hi}; return __builtin_bit_cast(unsigned, v); }
__device__ __forceinline__ bf16_t f2bf(float f) { return __builtin_bit_cast(bf16_t, (__bf16)f); }
__device__ __forceinline__ float bf2f(bf16_t b) { return __uint_as_float(((unsigned)b) << 16); }
__device__ __forceinline__ f32x4 ld_bf16x4(const bf16_t* p) { const u32x2 w = *(const u32x2*)p; return (f32x4){__uint_as_float(w.x << 16), __uint_as_float(w.x & 0xffff0000u), __uint_as_float(w.y << 16), __uint_as_float(w.y & 0xffff0000u)}; }
__device__ __forceinline__ float fexp(float x) { return __builtin_amdgcn_exp2f(x * 1.4426950408889634f); }
__device__ __forceinline__ float frcp(float x) { return __builtin_amdgcn_rcpf(x); }
__device__ __forceinline__ float fsqrt(float x) { return __builtin_amdgcn_sqrtf(x); }
__device__ __forceinline__ float sigm(float x) { return frcp(1.0f + fexp(-x)); }
__device__ __forceinline__ float ftanh(float x) { const float e = fexp(-2.0f * fabsf(x)), t = (1.0f - e) * frcp(1.0f + e); return x < 0.f ? -t : t; }
__device__ __forceinline__ float fexpm1_neg(float x) {
    const float p = x * (1.0f + x * (0.5f + x * (0.16666667f + x * (0.041666668f + x * 0.0083333338f))));
    return x > -0.25f ? p : fexp(x) - 1.0f; }
__device__ __forceinline__ float softplusf(float x) { return fmaxf(x, 0.f) + log1pf(expf(-fabsf(x))); }
__device__ __forceinline__ float wave_sum(float v) {
    v += __int_as_float(__builtin_amdgcn_update_dpp(0, __float_as_int(v), 0x121, 0xf, 0xf, false));
    v += __int_as_float(__builtin_amdgcn_update_dpp(0, __float_as_int(v), 0x122, 0xf, 0xf, false));
    v += __int_as_float(__builtin_amdgcn_update_dpp(0, __float_as_int(v), 0x124, 0xf, 0xf, false));
    v += __int_as_float(__builtin_amdgcn_update_dpp(0, __float_as_int(v), 0x128, 0xf, 0xf, false));
    v += __int_as_float(__builtin_amdgcn_update_dpp(0, __float_as_int(v), 0x142, 0xa, 0xf, false));
    v += __int_as_float(__builtin_amdgcn_update_dpp(0, __float_as_int(v), 0x143, 0xc, 0xf, false));
    return __int_as_float(__builtin_amdgcn_readlane(__float_as_int(v), 63));
}
__device__ __forceinline__ float wave_max(float v) {
    const int ninf = 0xff800000;
    v = fmaxf(v, __int_as_float(__builtin_amdgcn_update_dpp(ninf, __float_as_int(v), 0x121, 0xf, 0xf, false)));
    v = fmaxf(v, __int_as_float(__builtin_amdgcn_update_dpp(ninf, __float_as_int(v), 0x122, 0xf, 0xf, false)));
    v = fmaxf(v, __int_as_float(__builtin_amdgcn_update_dpp(ninf, __float_as_int(v), 0x124, 0xf, 0xf, false)));
    v = fmaxf(v, __int_as_float(__builtin_amdgcn_update_dpp(ninf, __float_as_int(v), 0x128, 0xf, 0xf, false)));
    v = fmaxf(v, __int_as_float(__builtin_amdgcn_update_dpp(ninf, __float_as_int(v), 0x142, 0xa, 0xf, false)));
    v = fmaxf(v, __int_as_float(__builtin_amdgcn_update_dpp(ninf, __float_as_int(v), 0x143, 0xc, 0xf, false)));
    return __int_as_float(__builtin_amdgcn_readlane(__float_as_int(v), 63));
}
__device__ __forceinline__ int wave_min_i(int v) {
    const int big = 0x7fffffff;
    v = min(v, __builtin_amdgcn_update_dpp(big, v, 0x121, 0xf, 0xf, false));
    v = min(v, __builtin_amdgcn_update_dpp(big, v, 0x122, 0xf, 0xf, false));
    v = min(v, __builtin_amdgcn_update_dpp(big, v, 0x124, 0xf, 0xf, false));
    v = min(v, __builtin_amdgcn_update_dpp(big, v, 0x128, 0xf, 0xf, false));
    v = min(v, __builtin_amdgcn_update_dpp(big, v, 0x142, 0xa, 0xf, false));
    v = min(v, __builtin_amdgcn_update_dpp(big, v, 0x143, 0xc, 0xf, false));
    return __builtin_amdgcn_readlane(v, 63);
}
__device__ __forceinline__ float row16_sum(float v) {
    v += __int_as_float(__builtin_amdgcn_update_dpp(0, __float_as_int(v), 0x121, 0xf, 0xf, false));
    v += __int_as_float(__builtin_amdgcn_update_dpp(0, __float_as_int(v), 0x122, 0xf, 0xf, false));
    v += __int_as_float(__builtin_amdgcn_update_dpp(0, __float_as_int(v), 0x124, 0xf, 0xf, false));
    v += __int_as_float(__builtin_amdgcn_update_dpp(0, __float_as_int(v), 0x128, 0xf, 0xf, false));
    return v;
}
__device__ __forceinline__ int row_batch(int row) { return row < NCTX ? (row >> 8) : ((row - NCTX) >> 12); }
__device__ __forceinline__ int row_modr(int row) { return row < NCTX ? 4 : ((row - NCTX) >> 12); }
#define XB_TMO      128
#define XB_XCNT(j)  (256  + 64 * (j))
#define XB_XSUB(j)  (1280 + 64 * (j))
#define XB_XGEN(j)  (2304 + 64 * (j))
#define XB_TOP      3328
#define XB_TOPGEN   3392
#define XCD_BAR_WORDS 3456
#define XB_SPIN_CAP (1u << 18)

__device__ __forceinline__ unsigned xb_ld(unsigned* p)              { return __hip_atomic_load(p, __ATOMIC_RELAXED, __HIP_MEMORY_SCOPE_AGENT); }
__device__ __forceinline__ unsigned xb_add(unsigned* p, unsigned v) { return __hip_atomic_fetch_add(p, v, __ATOMIC_RELAXED, __HIP_MEMORY_SCOPE_AGENT); }
__device__ __forceinline__ unsigned xb_xcc_id() { return (unsigned)__builtin_amdgcn_s_getreg((3 << 11) | 20) & 0xFu; }
#define XB_SPIN(cond, bar) do { unsigned _sp = 0; while (cond) { __builtin_amdgcn_s_sleep(1); \
    if ((++_sp & 255u) == 0u) { if (xb_ld(&(bar)[XB_TMO])) break; if (_sp > XB_SPIN_CAP) { atomicAdd(&(bar)[XB_TMO], 1u); break; } } } } while (0)

struct XcdBarrier {
    unsigned* bar; unsigned x;
    volatile LAS unsigned* st;
};

__device__ __forceinline__ XcdBarrier xcd_barrier_post(unsigned* bar, volatile LAS unsigned* st) {
    XcdBarrier b; b.bar = bar; b.x = xb_xcc_id(); b.st = st;
    if (threadIdx.x == 0) (void)xb_add(&bar[XB_XCNT(b.x)], 1u);
    return b;
}
__device__ __forceinline__ void xcd_barrier_complete(unsigned* bar, unsigned x, unsigned& nloc, unsigned& nx) {
    const unsigned G = gridDim.x * gridDim.y * gridDim.z;
    unsigned sum, cnt, mine, sp = 0u;
    for (;;) {
        sum = 0u; cnt = 0u; mine = 0u;
#pragma unroll
        for (unsigned j = 0; j < 16; ++j) { const unsigned c = xb_ld(&bar[XB_XCNT(j)]); sum += c; cnt += (c > 0u) ? 1u : 0u; mine = (j == x) ? c : mine; }
        if (sum == G) break;
        __builtin_amdgcn_s_sleep(1);
        if ((++sp & 255u) == 0u) { if (xb_ld(&bar[XB_TMO])) break; if (sp > XB_SPIN_CAP) { atomicAdd(&bar[XB_TMO], 1u); break; } }
    }
    nloc = mine > 0u ? mine : 1u; nx = cnt > 0u ? cnt : 1u;
}

__device__ __forceinline__ void xcd_barrier(const XcdBarrier& b) {
    asm volatile("s_waitcnt vmcnt(0)" ::: "memory");
    __syncthreads();
    if (threadIdx.x == 0) {
        unsigned* bar = b.bar;
        __builtin_amdgcn_s_waitcnt(0);
        unsigned nloc = b.st[0], nx = b.st[1];
        if (nloc == 0u) { xcd_barrier_complete(bar, b.x, nloc, nx); b.st[0] = nloc; b.st[1] = nx; }
        const unsigned old = xb_add(&bar[XB_XSUB(b.x)], 1u);
        const unsigned gen = old / nloc;
        if (old + 1u == (gen + 1u) * nloc) {
            __builtin_amdgcn_fence(__ATOMIC_RELEASE, "agent");
            asm volatile("s_waitcnt vmcnt(0)" ::: "memory");
            const unsigned og = xb_add(&bar[XB_TOP], 1u);
            const unsigned tg = og / nx;
            if (og + 1u == (tg + 1u) * nx) xb_add(&bar[XB_TOPGEN], 1u);
            else XB_SPIN(xb_ld(&bar[XB_TOPGEN]) == tg, bar);
            __builtin_amdgcn_fence(__ATOMIC_ACQUIRE, "agent");
            xb_add(&bar[XB_XGEN(b.x)], 1u);
            asm volatile("s_waitcnt vmcnt(0)" ::: "memory");
        } else {
            XB_SPIN(xb_ld(&bar[XB_XGEN(b.x)]) == gen, bar);
            __builtin_amdgcn_fence(__ATOMIC_ACQUIRE, "agent");
            asm volatile("s_waitcnt vmcnt(0)" ::: "memory");
        }
    }
    __syncthreads();
}
namespace pg8 {
constexpr int BM = 256, BK = 64, HALF = 128, HTB = HALF * BK * 2  , STAGE_BYTES = 8 * HTB, NXCD = 8, WGM = 8;

__host__ __device__ __forceinline__ int lds_byte(int r, int c) { const int st = (r >> 4) * 2 + (c >> 5), rr = r & 15, cc = c & 31, ob = rr * 64 + cc * 2; return st * 1024 + (ob ^ (((ob >> 9) & 1) << 5)); }
__host__ __device__ __forceinline__ void stage_rc(int b, int& R, int& C) { const int st = b / 1024, sb = b % 1024, swz = sb ^ (((sb >> 9) & 1) << 5); R = (st >> 1) * 16 + swz / 64; C = (st & 1) * 32 + (swz % 64) / 2; }
__host__ __device__ __forceinline__ int perm32(int rho) { const int n = rho >> 4, i = rho & 15; return 8 * (i >> 2) + 4 * n + (i & 3); }

struct Unit { int pm, pn; };
struct Gemm { const bf16_t* A; const bf16_t* Bt; int M, N, K; };
__device__ __forceinline__ unsigned cvt_pk_bf16(float lo, float hi) { return pack_bf16(lo, hi); }
template <class Epi, class Sched, bool STAMP = false, bool ATILED = false, bool BTILED = false>
__device__ __forceinline__ void gemm_phase(LAS unsigned char* lds, const Gemm g, const Sched& S, const Epi& E, unsigned long long* stamps) {
    const int tid = threadIdx.x, wid = __builtin_amdgcn_readfirstlane(tid >> 6), lane = tid & 63, wr = wid >> 2, wc = wid & 3, fr = lane & 15, fq = lane >> 4;
    const int K = g.K, nt = K / BK;
    int ts_lo = 0, ts_hi = 0, nts = 0; const unsigned long long rt_entry = STAMP ? (unsigned long long)wall_clock64() : 0ull;
#define PG8_STAMP() do { if (STAMP && wid == 0 && nts < 64) { const unsigned long long _c = (unsigned long long)clock64(); \
        ts_lo = (lane == nts) ? (int)(unsigned)_c : ts_lo; ts_hi = (lane == nts) ? (int)(unsigned)(_c >> 32) : ts_hi; ++nts; } } while (0)
    PG8_STAMP();
    unsigned voffA[2], voffB[2];
#pragma unroll
    for (int i = 0; i < 2; ++i) { int R, C; stage_rc(tid * 16 + i * 8192, R, C); const int Rb = Epi::PERM ? ((R & ~31) + perm32(R & 31)) : R;
        voffA[i] = (unsigned)(R * (ATILED ? BK : K) + C) * 2u; voffB[i] = (unsigned)(Rb * (BTILED ? BK : K) + C) * 2u; }
    const size_t kstepA = ATILED ? (size_t)BM * BK * 2 : (size_t)(BK * 2), kstepB = BTILED ? (size_t)BM * BK * 2 : (size_t)(BK * 2);
    const size_t hstepA = ATILED ? (size_t)HALF * BK * 2 : (size_t)HALF * K * 2, hstepB = BTILED ? (size_t)HALF * BK * 2 : (size_t)HALF * K * 2;
    const size_t tstep = (size_t)BM * K * 2;
    const unsigned ldsw = (unsigned)wid * 1024u;
    const int aoff = lds_byte(wr * 64 + fr, fq * 8), boff = lds_byte(wc * 32 + fr, fq * 8);
#define PG8_SA(b, h) (((b) * 2 + (h)) * HTB)
#define PG8_SB(b, h) ((4 + (b) * 2 + (h)) * HTB)
#define PG8_STAGE(bufoff, gbase, voff) do { _Pragma("unroll") for (int _i = 0; _i < 2; ++_i) \
        __builtin_amdgcn_global_load_lds((const unsigned*)((const char*)(gbase) + (voff)[_i]), (LAS unsigned*)(lds + (bufoff) + ldsw + _i * 8192), 16, 0, 0); } while (0)
#define PG8_LDA(dst, b, h) do { _Pragma("unroll") for (int m = 0; m < 4; ++m) _Pragma("unroll") for (int k = 0; k < 2; ++k) dst[m][k] = *(const LAS bf16x8*)(lds + PG8_SA(b, h) + aoff + m * 2048 + k * 1024); } while (0)
#define PG8_LDB(dst, b, h) do { _Pragma("unroll") for (int n = 0; n < 2; ++n) _Pragma("unroll") for (int k = 0; k < 2; ++k) dst[n][k] = *(const LAS bf16x8*)(lds + PG8_SB(b, h) + boff + n * 2048 + k * 1024); } while (0)
#define PG8_MMA(ai, bj, At, Bt) do { __builtin_amdgcn_s_setprio(1); _Pragma("unroll") for (int m = 0; m < 4; ++m) _Pragma("unroll") for (int n = 0; n < 2; ++n) _Pragma("unroll") for (int k = 0; k < 2; ++k) \
        acc[ai][bj][m][n] = __builtin_amdgcn_mfma_f32_16x16x32_bf16(Bt[n][k], At[m][k], acc[ai][bj][m][n], 0, 0, 0); __builtin_amdgcn_s_setprio(0); } while (0)
#define PG8_WAIT_V(n) asm volatile("s_waitcnt vmcnt(" #n ")" ::: "memory")
#define PG8_WAIT_L(n) asm volatile("s_waitcnt lgkmcnt(" #n ")" ::: "memory")
#define PG8_BAR __builtin_amdgcn_s_barrier()
#define PG8_SCHED __builtin_amdgcn_sched_barrier(0)
    Unit cur, nxt; int ui = 0;
    if (!S.next(0, cur)) return;
    f32x4 acc[2][2][4][2];
#pragma unroll
    for (int a = 0; a < 2; ++a)
#pragma unroll
        for (int b = 0; b < 2; ++b)
#pragma unroll
            for (int m = 0; m < 4; ++m)
#pragma unroll
                for (int n = 0; n < 2; ++n) acc[a][b][m][n] = (f32x4){0.f, 0.f, 0.f, 0.f};
    bf16x8 At[4][2], B0[2][2], B1[2][2];
    const char* cA = (const char*)g.A + (size_t)cur.pm * tstep; const char* cB = (const char*)g.Bt + (size_t)cur.pn * tstep;
    S.a_ready(cur);
    PG8_STAGE(PG8_SB(0, 0), cB, voffB); PG8_STAGE(PG8_SA(0, 0), cA, voffA); PG8_STAGE(PG8_SB(0, 1), cB + hstepB, voffB); PG8_STAGE(PG8_SA(0, 1), cA + hstepA, voffA);
    if (wr == 1) PG8_BAR;
    PG8_WAIT_V(4); PG8_BAR;
    PG8_STAGE(PG8_SB(1, 0), cB + kstepB, voffB); PG8_STAGE(PG8_SA(1, 0), cA + kstepA, voffA); PG8_STAGE(PG8_SB(1, 1), cB + hstepB + kstepB, voffB);
    PG8_WAIT_V(6); PG8_BAR;
    PG8_STAMP();
    for (;;) {
        const bool has_next = S.next(ui + 1, nxt);
        const char* nA = has_next ? (const char*)g.A + (size_t)nxt.pm * tstep : cA; const char* nB = has_next ? (const char*)g.Bt + (size_t)nxt.pn * tstep : cB;
        E.pre(lds, ui & 1, cur, wid, lane);
        for (int t = 0; t < nt; t += 2) {
            const bool last = (t == nt - 2);
            const char* a1 = cA + (size_t)(t + 1) * kstepA;
            const char* a2 = last ? nA : cA + (size_t)(t + 2) * kstepA; const char* b2 = last ? nB : cB + (size_t)(t + 2) * kstepB;
            const char* a3 = a2 + kstepA; const char* b3 = b2 + kstepB;
            if (last && has_next) S.a_ready(nxt);
            PG8_LDB(B0, 0, 0); PG8_SCHED; PG8_LDA(At, 0, 0); PG8_STAGE(PG8_SA(1, 1), a1 + hstepA, voffA);
            PG8_WAIT_L(8); PG8_BAR; PG8_WAIT_L(0); PG8_MMA(0, 0, At, B0); PG8_BAR; PG8_SCHED;
            PG8_LDB(B1, 0, 1); PG8_STAGE(PG8_SB(0, 0), b2, voffB);
            PG8_BAR; PG8_WAIT_L(0); PG8_MMA(0, 1, At, B1); PG8_BAR;
            PG8_LDA(At, 0, 1); PG8_STAGE(PG8_SA(0, 0), a2, voffA);
            PG8_BAR; PG8_WAIT_L(0); PG8_MMA(1, 0, At, B0); PG8_BAR; PG8_SCHED;
            PG8_STAGE(PG8_SB(0, 1), b2 + hstepB, voffB);
            PG8_WAIT_V(6); PG8_BAR; PG8_MMA(1, 1, At, B1); PG8_BAR;
            PG8_LDB(B0, 1, 0); PG8_SCHED; PG8_LDA(At, 1, 0); PG8_STAGE(PG8_SA(0, 1), a2 + hstepA, voffA);
            PG8_WAIT_L(8); PG8_BAR; PG8_WAIT_L(0); PG8_MMA(0, 0, At, B0); PG8_BAR; PG8_SCHED;
            PG8_LDB(B1, 1, 1); PG8_STAGE(PG8_SB(1, 0), b3, voffB);
            PG8_BAR; PG8_WAIT_L(0); PG8_MMA(0, 1, At, B1); PG8_BAR;
            PG8_LDA(At, 1, 1); PG8_STAGE(PG8_SA(1, 0), a3, voffA);
            PG8_BAR; PG8_WAIT_L(0); PG8_MMA(1, 0, At, B0); PG8_BAR; PG8_SCHED;
            PG8_STAGE(PG8_SB(1, 1), b3 + hstepB, voffB);
            PG8_WAIT_V(6); PG8_BAR; PG8_MMA(1, 1, At, B1); PG8_BAR;
        }
        PG8_STAMP();
        if constexpr (!Epi::AFTER_DRAIN) { E(acc, cur, wr, wc, fr, fq, lds, ui & 1); S.done(cur); }
        PG8_STAMP();
        if (!has_next) break;
#pragma unroll
        for (int a = 0; a < 2; ++a)
#pragma unroll
            for (int b = 0; b < 2; ++b)
#pragma unroll
                for (int m = 0; m < 4; ++m)
#pragma unroll
                    for (int n = 0; n < 2; ++n) acc[a][b][m][n] = (f32x4){0.f, 0.f, 0.f, 0.f};
        cur = nxt; cA = nA; cB = nB; ++ui;
    }
    PG8_WAIT_V(0);
    if (wr == 0) PG8_BAR;
    PG8_BAR;
    if constexpr (Epi::AFTER_DRAIN) { E.fused(acc, cur, wr, wc, fr, fq, lds, wid, lane); S.done(cur); }
    PG8_STAMP();
    if (STAMP && wid == 0) { stamps[lane] = lane < nts ? (((unsigned long long)(unsigned)ts_hi << 32) | (unsigned)ts_lo) : 0ull;
        if (lane == 62) stamps[62] = rt_entry; if (lane == 63) stamps[63] = (unsigned long long)wall_clock64(); }
#undef PG8_STAMP
#undef PG8_SA
#undef PG8_SB
#undef PG8_STAGE
#undef PG8_LDA
#undef PG8_LDB
#undef PG8_MMA
#undef PG8_WAIT_V
#undef PG8_WAIT_L
#undef PG8_BAR
#undef PG8_SCHED
}
__device__ __forceinline__ int xcd_contig(long L, int nwg) { const int q = nwg / NXCD, r = nwg % NXCD, xcd = (int)(L % NXCD), off = (int)(L / NXCD); return (xcd < r ? xcd * (q + 1) : r * (q + 1) + (xcd - r) * q) + off; }
template <int nN>
struct SchedDense {
    int nM, pm0, G, c;
    __device__ __forceinline__ bool next(int i, Unit& u) const {
        const long L = (long)i * G + c; const int nwg = nM * nN; if (L >= nwg) return false;
        const int wgid = xcd_contig(L, nwg);
        constexpr int nig = WGM * nN; const int gid = wgid / nig, fm = gid * WGM, gsz = (nM - fm) < WGM ? (nM - fm) : WGM, w = wgid % nig;
        if (gsz == WGM) { u.pm = pm0 + fm + (w & (WGM - 1)); u.pn = w >> 3; } else { u.pm = pm0 + fm + (w % gsz); u.pn = w / gsz; }
        return true; }
    __device__ __forceinline__ void a_ready(const Unit&) const {}
    __device__ __forceinline__ void done(const Unit&) const {}
};
template <int nN>
struct SchedMoe {
    int T, G, c; const LAS int* tileE;
    __device__ __forceinline__ bool next(int i, Unit& u) const { const long L = (long)i * G + c; const int nwg = T * nN; if (L >= nwg) return false;
        const int wgid = xcd_contig(L, nwg), pt = wgid / nN; u.pm = pt; u.pn = tileE[pt] * nN + (wgid % nN); return true; }
    __device__ __forceinline__ void a_ready(const Unit&) const {}
    __device__ __forceinline__ void done(const Unit&) const {}
};
constexpr int EPI_BIAS_OFF = STAGE_BYTES + 8192;
struct EpiStore {
    static constexpr bool PERM = true, AFTER_DRAIN = false;
    bf16_t* O; int ldc;
    __device__ __forceinline__ void pre(LAS unsigned char*, int, const Unit&, int, int) const {}
    __device__ __forceinline__ void operator()(const f32x4 (&acc)[2][2][4][2], const Unit& u, int wr, int wc, int fr, int fq, const LAS unsigned char*, int) const {
        const int row0 = u.pm * BM + wr * 64 + fr, col0 = u.pn * BM + wc * 32 + 8 * fq;
#pragma unroll
        for (int ai = 0; ai < 2; ++ai)
#pragma unroll
            for (int m = 0; m < 4; ++m) { bf16_t* rowp = O + (size_t)(row0 + ai * HALF + m * 16) * ldc + col0;
#pragma unroll
                for (int bj = 0; bj < 2; ++bj) { const f32x4 v0 = acc[ai][bj][m][0], v1 = acc[ai][bj][m][1];
                    u32x4 w; w.x = cvt_pk_bf16(v0[0], v0[1]); w.y = cvt_pk_bf16(v0[2], v0[3]); w.z = cvt_pk_bf16(v1[0], v1[1]); w.w = cvt_pk_bf16(v1[2], v1[3]);
                    *(u32x4*)(rowp + bj * HALF) = w; } }
    }
};
struct EpiYE {
    static constexpr bool PERM = true, AFTER_DRAIN = false;
    bf16_t* O; const float* b2;
    __device__ __forceinline__ void pre(LAS unsigned char* lds, int par, const Unit& u, int wid, int lane) const {
        if (wid == 0) __builtin_amdgcn_global_load_lds((const unsigned*)(b2 + (u.pn >> 2) * 1024 + (u.pn & 3) * BM + lane * 4), (LAS unsigned*)(lds + EPI_BIAS_OFF + par * 1024), 16, 0, 0);
    }
    __device__ __forceinline__ void operator()(const f32x4 (&acc)[2][2][4][2], const Unit& u, int wr, int wc, int fr, int fq, const LAS unsigned char* lds, int par) const {
        const int pn = u.pn & 3;
        const int row0 = u.pm * BM + wr * 64 + fr, col0 = pn * BM + wc * 32 + 8 * fq;
        const LAS float* bp = (const LAS float*)(lds + EPI_BIAS_OFF + par * 1024) + wc * 32 + 8 * fq;
        f32x4 bv[2][2];
#pragma unroll
        for (int bj = 0; bj < 2; ++bj)
#pragma unroll
            for (int n = 0; n < 2; ++n) bv[bj][n] = *(const LAS f32x4*)(bp + bj * HALF + 4 * n);
#pragma unroll
        for (int ai = 0; ai < 2; ++ai)
#pragma unroll
            for (int m = 0; m < 4; ++m) { bf16_t* rowp = O + (size_t)(row0 + ai * HALF + m * 16) * 1024 + col0;
#pragma unroll
                for (int bj = 0; bj < 2; ++bj) { const f32x4 v0 = acc[ai][bj][m][0] + bv[bj][0], v1 = acc[ai][bj][m][1] + bv[bj][1];
                    u32x4 w; w.x = cvt_pk_bf16(v0[0], v0[1]); w.y = cvt_pk_bf16(v0[2], v0[3]); w.z = cvt_pk_bf16(v1[0], v1[1]); w.w = cvt_pk_bf16(v1[2], v1[3]);
                    *(u32x4*)(rowp + bj * HALF) = w; } }
    }
};
struct EpiAct {
    static constexpr bool PERM = true, AFTER_DRAIN = false;
    bf16_t* O; const float* b1;
    __device__ __forceinline__ void pre(LAS unsigned char* lds, int par, const Unit& u, int wid, int lane) const {
        if (wid == 0) __builtin_amdgcn_global_load_lds((const unsigned*)(b1 + (u.pn >> 3) * 2048 + (lane >> 5) * 1024 + (u.pn & 7) * 128 + (lane & 31) * 4), (LAS unsigned*)(lds + EPI_BIAS_OFF + par * 1024), 16, 0, 0);
    }
    __device__ __forceinline__ void operator()(const f32x4 (&acc)[2][2][4][2], const Unit& u, int wr, int wc, int fr, int fq, const LAS unsigned char* lds, int par) const {
        const int pn = u.pn & 7;
        const int row0 = u.pm * BM + wr * 64 + fr, x0 = pn * 128 + wc * 32 + 8 * fq;
        const LAS float* bg = (const LAS float*)(lds + EPI_BIAS_OFF + par * 1024) + wc * 32 + 8 * fq; const LAS float* bl = bg + 128;
        const f32x4 g0 = *(const LAS f32x4*)bg, g1 = *(const LAS f32x4*)(bg + 4), l0 = *(const LAS f32x4*)bl, l1 = *(const LAS f32x4*)(bl + 4);
#pragma unroll
        for (int ai = 0; ai < 2; ++ai)
#pragma unroll
            for (int m = 0; m < 4; ++m) {
                float o[8];
#pragma unroll
                for (int n = 0; n < 2; ++n)
#pragma unroll
                    for (int j = 0; j < 4; ++j) {
                        float glu = acc[ai][0][m][n][j] + (n ? g1[j] : g0[j]);
                        float lin = acc[ai][1][m][n][j] + (n ? l1[j] : l0[j]);
                        glu = fminf(glu, 7.0f); lin = fminf(fmaxf(lin, -7.0f), 7.0f);
                        o[n * 4 + j] = (lin + 1.0f) * glu * __builtin_amdgcn_rcpf(1.0f + __expf(-1.702f * glu));
                    }
                u32x4 w; w.x = cvt_pk_bf16(o[0], o[1]); w.y = cvt_pk_bf16(o[2], o[3]); w.z = cvt_pk_bf16(o[4], o[5]); w.w = cvt_pk_bf16(o[6], o[7]);
                *(u32x4*)(O + ((size_t)(u.pm * 16 + (x0 >> 6)) * 256 + (wr * 64 + fr + ai * HALF + m * 16)) * 64 + (x0 & 63)) = w;
            }
    }
};
}
using pg8::Unit;
__device__ __forceinline__ void my_sincos(double a, float& s, float& c) {
    const double n = rint(a * 0.63661977236758134308);
    const double r = (a - n * 1.57079632679489655800e+00) - n * 6.12323399573676603587e-17;
    const double r2 = r * r;
    const double sp = r * (1.0 + r2 * (-1.0 / 6.0 + r2 * (1.0 / 120.0 + r2 * (-1.0 / 5040.0 + r2 * (1.0 / 362880.0 + r2 * (-1.0 / 39916800.0 + r2 * (1.0 / 6227020800.0 + r2 * (-1.0 / 1307674368000.0))))))));
    const double cp = 1.0 + r2 * (-0.5 + r2 * (1.0 / 24.0 + r2 * (-1.0 / 720.0 + r2 * (1.0 / 40320.0 + r2 * (-1.0 / 3628800.0 + r2 * (1.0 / 479001600.0 + r2 * (-1.0 / 87178291200.0 + r2 * (1.0 / 20922789888000.0))))))));
    const int q = ((int)n) & 3;
    const double sn = q == 0 ? sp : q == 1 ? cp : q == 2 ? -sp : -cp;
    const double cn = q == 0 ? cp : q == 1 ? -sp : q == 2 ? -cp : sp;
    s = (float)sn; c = (float)cn;
}
__device__ __forceinline__ void ph_prologue(const Params& p, LAS unsigned char* lds, int bid, int nblk) {
    const int tid = threadIdx.x;
    unsigned char* ws = p.ws;
    {
        LAS float* sv = (LAS float*)(lds + LDS_WORK);
        LAS float* red = sv + 5 * 1024;
        for (int i = tid; i < 5 * 1024; i += NTHR) { const int r = i >> 10, k = i & 1023; const float c = r < 4 ? p.in[I_C][r * 1024 + k] : p.in[I_CCTX][k]; sv[i] = c / (1.0f + expf(-c)); }
        __syncthreads();
        float* MOD = (float*)(ws + WS_MOD);
        for (int item = bid; item < 256; item += nblk) {
            if (tid < 480) {
                const int cl = tid % 48, kp = tid / 48;
                const int gc = item * 48 + cl, l = gc / 6144, n = gc % 6144;
                const float* w = p.in[I_WMOD] + (size_t)l * 1024 * 6144 + n;
                float a0 = 0.f, a1 = 0.f, a2 = 0.f, a3 = 0.f, a4 = 0.f;
#pragma unroll 1
                for (int k0 = kp; k0 < 1024; k0 += 130) {
                    float wv[13];
#pragma unroll
                    for (int u = 0; u < 13; ++u) { const int k = k0 + 10 * u; wv[u] = k < 1024 ? w[(size_t)k * 6144] : 0.f; }
#pragma unroll
                    for (int u = 0; u < 13; ++u) { const int k = k0 + 10 * u < 1024 ? k0 + 10 * u : 1023; a0 += sv[k] * wv[u]; a1 += sv[1024 + k] * wv[u]; a2 += sv[2048 + k] * wv[u]; a3 += sv[3072 + k] * wv[u]; a4 += sv[4096 + k] * wv[u]; }
                }
                LAS float* rp = red + (kp * 48 + cl) * 5; rp[0] = a0; rp[1] = a1; rp[2] = a2; rp[3] = a3; rp[4] = a4;
            }
            __syncthreads();
            if (tid < 240) {
                const int cl = tid / 5, r = tid % 5; float s = 0.f;
                for (int kp = 0; kp < 10; ++kp) s += red[(kp * 48 + cl) * 5 + r];
                const int gc = item * 48 + cl, l = gc / 6144, n = gc % 6144;
                MOD[(size_t)(l * 5 + r) * 6144 + n] = s + p.in[I_BMOD][l * 6144 + n];
            }
            __syncthreads();
        }
    }
    if (bid == (nblk > 1 ? 1 : 0)) {
        float* ROPE = (float*)(ws + WS_ROPE);
        for (int i = tid; i < 2048; i += NTHR) { const int pos = i >> 5, f = i & 31; const double inv = exp(-(double)f * 0.28782313662425575); float s, c; my_sincos((double)pos * inv, s, c); ROPE[2 * i] = c; ROPE[2 * i + 1] = s; }
    }
    {
        bf16_t* WLT = (bf16_t*)(ws + WS_WLT);
        for (int i = bid * NTHR + tid; i < (int)WLT_N; i += nblk * NTHR) {
            float v;
            if (i < 131072) { const int which = i >> 16, r = i & 65535, d = r >> 15, n = (r >> 6) & 511, k = r & 63; v = (which ? p.in[I_AAB] : p.in[I_AWB])[(size_t)(d * 64 + k) * 512 + n]; }
            else if (i < 196608) { const int r = i - 131072, n = r >> 7, k = r & 127; v = p.in[I_AGB][(size_t)k * 512 + n]; }
            else { const int r = i - 196608, blk = r >> 12, o = (r >> 6) & 63, ii = r & 63; v = p.in[I_BGW][(size_t)blk * 4096 + ii * 64 + o]; }
            WLT[i] = f2bf(v);
        }
    }
    {
        LAS float* tile = (LAS float*)(lds + LDS_WORK);
        for (int t = bid; t < 576; t += nblk) {
            const float* src; int ld, nvalid, k0, n0, w1map = 0; bf16_t* dst; int tt = t;
            if (tt < 192) { k0 = (tt / 12) * 64; n0 = (tt % 12) * 256; src = p.in[I_EWIN]; ld = EVEN_IN; nvalid = EVEN_IN; dst = (bf16_t*)(ws + WS_WIN0T); }
            else if ((tt -= 192) < 256) { k0 = (tt >> 4) * 64; n0 = (tt & 15) * 256; src = p.in[I_OWIN]; ld = ODD_IN; nvalid = 4096; dst = (bf16_t*)(ws + WS_WIN1T); }
            else { tt -= 256; const int mat = tt >> 6, r = tt & 63; k0 = (r >> 2) * 64; n0 = (r & 3) * 256; src = mat ? p.in[I_OWOUT] : p.in[I_EWOUT]; ld = 1024; nvalid = 1024; dst = (bf16_t*)(ws + WS_WOUTT) + (size_t)mat * 1024 * 1024; }
            {
                const int j4 = (tid & 63) * 4, i0 = tid >> 6;
                f32x4 v[8];
#pragma unroll
                for (int r = 0; r < 8; ++r) v[r] = (n0 + j4 < nvalid) ? *(const f32x4*)(src + (size_t)(k0 + i0 + 8 * r) * ld + n0 + j4) : (f32x4){0.f, 0.f, 0.f, 0.f};
#pragma unroll
                for (int r = 0; r < 8; ++r) { LAS float* tp = tile + (i0 + 8 * r) * 257 + j4; tp[0] = v[r][0]; tp[1] = v[r][1]; tp[2] = v[r][2]; tp[3] = v[r][3]; }
            }
            __syncthreads();
            {
                const int ip = (tid & 31) * 2, j0 = tid >> 5;
#pragma unroll
                for (int r = 0; r < 16; ++r) {
                    const int j = j0 + 16 * r, n = n0 + j;
                    const int rho = w1map ? ((((n & 1023) >> 7) << 8) + ((n >> 10) << 7) + (n & 127)) : n;
                    *(unsigned*)(dst + (size_t)rho * 1024 + k0 + ip) = pack_bf16(tile[ip * 257 + j], tile[(ip + 1) * 257 + j]);
                }
            }
            __syncthreads();
        }
    }
}
__device__ __forceinline__ void ph_mod_in(const Params& p, int bid, int nblk) {
    const int tid = threadIdx.x, wid = tid >> 6, lane = tid & 63;
    const float* MOD = (const float*)(p.ws + WS_MOD);
    bf16_t* H = (bf16_t*)(p.ws + WS_H);
    for (int row = bid * 8 + wid; row < MROWS; row += nblk * 8) {
        const float* src = row < NCTX ? p.in[I_CTX] + (size_t)row * 1024 : p.in[I_X] + (size_t)(row - NCTX) * 1024;
        const float* md = MOD + (size_t)row_modr(row) * 6144;
#pragma unroll
        for (int q = 0; q < 4; ++q) {
            const int col = q * 256 + lane * 4;
            const f32x4 x = *(const f32x4*)(src + col), sh = *(const f32x4*)(md + col), sc = *(const f32x4*)(md + 1024 + col);
            const f32x4 h = x * (sc + 1.0f) + sh;
            u32x2 w; w.x = pack_bf16(h[0], h[1]); w.y = pack_bf16(h[2], h[3]);
            *(u32x2*)(H + (size_t)row * 1024 + col) = w;
        }
    }
}
__device__ __forceinline__ int even_tok_row(int w, int idx) { return idx < 64 ? NCTX + (w >> 6) * 4096 + (w & 63) * 64 + idx : w * 4 + (idx - 64); }
__device__ __forceinline__ int shift_nb(int row, int cc) {
    if (row >= NCTX) { const int s = (row - NCTX) & 4095, gr = s >> 6, gc = s & 63, slot = cc & 3;
        if (slot == 0) return gc > 0 ? row - 1 : -1;
        if (slot == 1) return gc < 63 ? row + 1 : -1;
        if (slot == 2) return gr > 0 ? row - 64 : -1;
        return gr < 63 ? row + 64 : -1; }
    const int t = row & 255; return (cc & 1) == 0 ? (t > 0 ? row - 1 : -1) : (t < 255 ? row + 1 : -1);
}
__device__ __forceinline__ float shifted_z(const bf16_t* P, const float* mu, int row, int cc) {
    const float pv = bf2f(P[(size_t)row * LDP0 + cc]); const int nb = shift_nb(row, cc);
    const float sv = nb >= 0 ? bf2f(P[(size_t)nb * LDP0 + cc]) : 0.f;
    return pv + (sv - pv) * mu[cc];
}
__device__ __forceinline__ int scan_q(int row, int d) {
    if (row < NCTX) { const int t = row & 255; return d ? 255 - t : t; }
    const int s = (row - NCTX) & 4095; return 256 + (d ? 4095 - s : s);
}
__device__ __forceinline__ bf16_t* sc_rec(float* SC, int d, int row, int h) { return (bf16_t*)SC + ((size_t)((d * 4 + row_batch(row)) * 8 + h) * SCLEN + scan_q(row, d)) * SCREC; }
constexpr int LDL = 392, LDU = 520;
template <int KS>
__device__ __forceinline__ void load_b(const bf16_t* Bt, bf16x8 (&b)[4][KS], int lane) {
    const int fr = lane & 15, fq = lane >> 4;
#pragma unroll
    for (int nt = 0; nt < 4; ++nt)
#pragma unroll
        for (int ks = 0; ks < KS; ++ks) b[nt][ks] = *(const bf16x8*)(Bt + (size_t)(nt * 16 + fr) * (32 * KS) + ks * 32 + fq * 8);
}
template <int KS>
__device__ __forceinline__ void mma_mt(const LAS bf16_t* A, int lda, int mt, const bf16x8 (&b)[4][KS], f32x4 (&acc)[4], int lane) {
    const int fr = lane & 15, fq = lane >> 4;
#pragma unroll
    for (int nt = 0; nt < 4; ++nt) acc[nt] = (f32x4){0.f, 0.f, 0.f, 0.f};
#pragma unroll
    for (int ks = 0; ks < KS; ++ks) {
        const bf16x8 a = *(const LAS bf16x8*)(A + (mt * 16 + fr) * lda + ks * 32 + fq * 8);
#pragma unroll
        for (int nt = 0; nt < 4; ++nt) acc[nt] = __builtin_amdgcn_mfma_f32_16x16x32_bf16(a, b[nt][ks], acc[nt], 0, 0, 0);
    }
}
__device__ __forceinline__ void ph_prep_even(const Params& p, LAS unsigned char* lds, int bid, int nblk) {
    const int tid = threadIdx.x, wid = tid >> 6, lane = tid & 63, c = tid, fr = lane & 15, fq = lane >> 4;
    const bf16_t* P = (const bf16_t*)(p.ws + WS_P);
    float* SC = (float*)(p.ws + WS_SC);
    float* EA = (float*)(p.ws + WS_EARR);
#define EARR(k) (EA + (size_t)(k) * ((size_t)MROWS * 512))
    float* BC = (float*)(p.ws + WS_BC);
    float* CHA = (float*)(p.ws + WS_CHA); float* CHH = (float*)(p.ws + WS_CHH);
    const bf16_t* WLT = (const bf16_t*)(p.ws + WS_WLT);
    const float* mu = p.in[I_AMU];
    LAS bf16_t* linb = (LAS bf16_t*)(lds + LDS_WORK);
    LAS bf16_t* ub = linb + 80 * LDL;
    LAS float* rnorm = (LAS float*)(ub + 80 * LDU);
    for (int w = bid; w < 256; w += nblk) {
        for (int i = tid; i < 12 * LDL; i += NTHR) linb[68 * LDL + i] = 0;
        for (int i = tid; i < 12 * LDU; i += NTHR) ub[68 * LDU + i] = 0;
#pragma unroll 1
        for (int g = 0; g < 3; ++g) {
            float pv[17], sv[17];
#pragma unroll
            for (int u = 0; u < 17; ++u) { const int e = tid + NTHR * (g * 17 + u), tok = e / 384, j = e - tok * 384, row = even_tok_row(w, tok), nb = shift_nb(row, 1536 + j);
                pv[u] = bf2f(P[(size_t)row * LDP0 + 1536 + j]); sv[u] = nb >= 0 ? bf2f(P[(size_t)nb * LDP0 + 1536 + j]) : 0.f; }
#pragma unroll
            for (int u = 0; u < 17; ++u) { const int e = tid + NTHR * (g * 17 + u), tok = e / 384, j = e - tok * 384;
                const float z = pv[u] + (sv[u] - pv[u]) * mu[1536 + j];
                linb[tok * LDL + j] = f2bf(j < 128 ? ftanh(z) : (j < 256 ? z : sigm(z))); }
        }
        {
            const float kkc = p.in[I_AKK][c], mur = mu[c], muk = mu[512 + c], muv = mu[1024 + c];
#pragma unroll 1
            for (int t0 = 0; t0 < 68; t0 += 8) {
                float pr[8], pk[8], pv[8], sr[8], sk[8], sv[8];
#pragma unroll
                for (int u = 0; u < 8; ++u) { const int tk = t0 + u < 68 ? t0 + u : 67; const int row = even_tok_row(w, tk); const int nb = shift_nb(row, c);
                    const bf16_t* pp = P + (size_t)row * LDP0 + c; pr[u] = bf2f(pp[0]); pk[u] = bf2f(pp[512]); pv[u] = bf2f(pp[1024]);
                    if (nb >= 0) { const bf16_t* pn = P + (size_t)nb * LDP0 + c; sr[u] = bf2f(pn[0]); sk[u] = bf2f(pn[512]); sv[u] = bf2f(pn[1024]); } else { sr[u] = 0.f; sk[u] = 0.f; sv[u] = 0.f; } }
#pragma unroll
                for (int u = 0; u < 8; ++u) if (t0 + u < 68) { const int row = even_tok_row(w, t0 + u);
                    const float zr = pr[u] + (sr[u] - pr[u]) * mur, zk = pk[u] + (sk[u] - pk[u]) * muk, zv = pv[u] + (sv[u] - pv[u]) * muv;
                    const float kkr = zk * kkc, ss = wave_sum(kkr * kkr), rn = frcp(fmaxf(fsqrt(ss), 1e-12f)), kk = kkr * rn;
                    if (lane == 0) rnorm[(t0 + u) * 8 + wid] = rn;
#pragma unroll
                    for (int d = 0; d < 2; ++d) { bf16_t* rec = sc_rec(SC, d, row, wid) + lane; rec[128] = f2bf(kk); rec[320] = f2bf(zr); rec[384] = f2bf(zv); } }
            }
        }
        {
            const float cw0 = p.in[I_BCW][c], cw1 = p.in[I_BCW][512 + c], cw2 = p.in[I_BCW][1024 + c], cw3 = p.in[I_BCW][1536 + c], cb = p.in[I_BCB][c];
#pragma unroll 1
            for (int t0 = 0; t0 < 68; t0 += 8) {
                float x0[8], x1[8], x2[8], x3[8], gx[8];
#pragma unroll
                for (int u = 0; u < 8; ++u) { const int tk = t0 + u < 68 ? t0 + u : 67; const int row = even_tok_row(w, tk);
                    int pos, len;
                    if (row >= NCTX) { pos = (row - NCTX) & 4095; len = 4096; } else { pos = row & 255; len = 256; }
                    x0[u] = pos >= 2 ? bf2f(P[(size_t)(row - 2) * LDP0 + 1920 + c]) : 0.f; x1[u] = pos >= 1 ? bf2f(P[(size_t)(row - 1) * LDP0 + 1920 + c]) : 0.f;
                    x2[u] = bf2f(P[(size_t)row * LDP0 + 1920 + c]); x3[u] = pos + 1 < len ? bf2f(P[(size_t)(row + 1) * LDP0 + 1920 + c]) : 0.f;
                    gx[u] = bf2f(P[(size_t)row * LDP0 + 1920 + 512 + c]); }
#pragma unroll
                for (int u = 0; u < 8; ++u) if (t0 + u < 68) { const int tok = t0 + u, row = even_tok_row(w, tok);
                    const float uu = cb + cw0 * x0[u] + cw1 * x1[u] + cw2 * x2[u] + cw3 * x3[u];
                    ub[tok * LDU + c] = f2bf(uu);
                    const size_t o = (size_t)row * 512 + c;
                    ((bf16_t*)EARR(E_GATE))[o] = f2bf(0.5f * gx[u] * (1.0f + ftanh(0.7978845608028654f * (gx[u] + 0.044715f * gx[u] * gx[u] * gx[u])))); }
            }
        }
        __syncthreads();
#pragma unroll 1
        for (int d = 0; d < 2; ++d) {
            {
                bf16x8 bw[4][2]; load_b<2>(WLT + WLT_WB + (size_t)(d * 512 + wid * 64) * 64, bw, lane);
                float w0v[4];
#pragma unroll
                for (int nt = 0; nt < 4; ++nt) w0v[nt] = p.in[I_AW0][d * 512 + wid * 64 + nt * 16 + fr];
#pragma unroll 1
                for (int mt = 0; mt < 5; ++mt) {
                    f32x4 acc[4]; mma_mt<2>(linb + d * 64, LDL, mt, bw, acc, lane);
#pragma unroll
                    for (int r = 0; r < 4; ++r) { const int tok = mt * 16 + fq * 4 + r;
                        if (tok < 68) { float* rec = (float*)sc_rec(SC, d, even_tok_row(w, tok), wid) + fr;
#pragma unroll
                            for (int nt = 0; nt < 4; ++nt) rec[nt * 16] = -0.60653065971263342f * sigm(w0v[nt] + acc[nt][r]);   } }
                }
            }
            {
                bf16x8 bw[4][2]; load_b<2>(WLT + WLT_AB + (size_t)(d * 512 + wid * 64) * 64, bw, lane);
                float a0v[4], kav[4], mukv[4], kkcv[4];
#pragma unroll
                for (int nt = 0; nt < 4; ++nt) { const int n = wid * 64 + nt * 16 + fr; a0v[nt] = p.in[I_AA0][d * 512 + n]; kav[nt] = p.in[I_AKA][n]; mukv[nt] = mu[512 + n]; kkcv[nt] = p.in[I_AKK][n]; }
#pragma unroll 1
                for (int mt = 0; mt < 5; ++mt) {
                    f32x4 acc[4]; mma_mt<2>(linb + 128 + d * 64, LDL, mt, bw, acc, lane);
                    float pkv[4][4], skv[4][4];
#pragma unroll
                    for (int r = 0; r < 4; ++r) { const int tok = mt * 16 + fq * 4 + r, row = even_tok_row(w, tok < 68 ? tok : 0);
#pragma unroll
                        for (int nt = 0; nt < 4; ++nt) { const int n = wid * 64 + nt * 16 + fr, nb = shift_nb(row, n);
                            pkv[r][nt] = bf2f(P[(size_t)row * LDP0 + 512 + n]); skv[r][nt] = nb >= 0 ? bf2f(P[(size_t)nb * LDP0 + 512 + n]) : 0.f; } }
#pragma unroll
                    for (int r = 0; r < 4; ++r) { const int tok = mt * 16 + fq * 4 + r;
                        if (tok < 68) { bf16_t* rec = sc_rec(SC, d, even_tok_row(w, tok), wid) + fr; const float rn = rnorm[tok * 8 + wid];
#pragma unroll
                            for (int nt = 0; nt < 4; ++nt) { const float a = sigm(a0v[nt] + acc[nt][r]);
                                const float zk = pkv[r][nt] + (skv[r][nt] - pkv[r][nt]) * mukv[nt];
                                rec[192 + nt * 16] = f2bf(zk * (1.0f + (a - 1.0f) * kav[nt])); rec[256 + nt * 16] = f2bf(zk * kkcv[nt] * rn * a); } } }
                }
            }
        }
        {
            bf16x8 bw[4][4]; load_b<4>(WLT + WLT_GB + (size_t)(wid * 64) * 128, bw, lane);
            bf16_t* G = (bf16_t*)EARR(E_G);
#pragma unroll 1
            for (int mt = 0; mt < 5; ++mt) {
                f32x4 acc[4]; mma_mt<4>(linb + 256, LDL, mt, bw, acc, lane);
#pragma unroll
                for (int r = 0; r < 4; ++r) { const int tok = mt * 16 + fq * 4 + r;
                    if (tok < 68) { bf16_t* gp = G + (size_t)even_tok_row(w, tok) * 512 + wid * 64 + fr;
#pragma unroll
                        for (int nt = 0; nt < 4; ++nt) gp[nt * 16] = f2bf(acc[nt][r]); } }
            }
        }
#pragma unroll 1
        for (int d = 0; d < 2; ++d) {
            bf16x8 b0[4][2];
            load_b<2>(WLT + WLT_GW + (size_t)(((d * 2 + 0) * 8 + wid) * 64) * 64, b0, lane);
            float gb0[4], gb1[4], spl[4];
#pragma unroll
            for (int nt = 0; nt < 4; ++nt) { const int n = wid * 64 + nt * 16 + fr; gb0[nt] = p.in[I_BGB][(d * 2 + 0) * 512 + n]; gb1[nt] = p.in[I_BGB][(d * 2 + 1) * 512 + n]; spl[nt] = softplusf(-p.in[I_BLAM][d * 512 + n]); }
            float* Ad = EARR(E_A0 + d); float* BXd = EARR(E_BX0 + d);
#pragma unroll 1
            for (int mt = 0; mt < 5; ++mt) {
                f32x4 la[4], acc[4];
                mma_mt<2>(ub + wid * 64, LDU, mt, b0, la, lane);
                { bf16x8 b1[4][2]; load_b<2>(WLT + WLT_GW + (size_t)(((d * 2 + 1) * 8 + wid) * 64) * 64, b1, lane); mma_mt<2>(ub + wid * 64, LDU, mt, b1, acc, lane); }
#pragma unroll
                for (int r = 0; r < 4; ++r) { const int tok = mt * 16 + fq * 4 + r;
                    if (tok < 68) { const size_t o = (size_t)even_tok_row(w, tok) * 512 + wid * 64 + fr;
#pragma unroll
                        for (int nt = 0; nt < 4; ++nt) { const float lg = -8.0f * sigm(gb0[nt] + la[nt][r]) * spl[nt];
                            const float av = fexp(lg); Ad[o + nt * 16] = av; BXd[o + nt * 16] = fsqrt(fmaxf(1.0f - av * av, 0.f)) * sigm(gb1[nt] + acc[nt][r]) * bf2f(ub[tok * LDU + wid * 64 + nt * 16 + fr]);         } } }
            }
        }
        __syncthreads();
        {
            const float rk = p.in[I_ARK][c];
#pragma unroll 1
            for (int t0 = 0; t0 < 68; t0 += 17) {
                float a[17], b0[17], b1[17];
#pragma unroll
                for (int u = 0; u < 17; ++u) { const int row = even_tok_row(w, t0 + u); const bf16_t* r0 = sc_rec(SC, 0, row, wid) + lane; const bf16_t* r1 = sc_rec(SC, 1, row, wid) + lane;
                    a[u] = bf2f(r0[320]); b0[u] = bf2f(r0[192]); b1[u] = bf2f(r1[192]); }
#pragma unroll
                for (int u = 0; u < 17; ++u) { const float sm = wave_sum(a[u] * (b0[u] + b1[u]) * rk); if (lane == 0) BC[even_tok_row(w, t0 + u) * 8 + wid] = sm; }
            }
        }
#pragma unroll 1
        for (int d = 0; d < 2; ++d) {
            float* Ad = EARR(E_A0 + d); float* BXd = EARR(E_BX0 + d);
            float h = 0.f, cum = 1.f;
#pragma unroll 1
            for (int n0 = 0; n0 < 64; n0 += 16) {
                float av[16], bv[16];
#pragma unroll
                for (int i = 0; i < 16; ++i) { const int tok = d == 0 ? n0 + i : 63 - n0 - i; const size_t o = (size_t)even_tok_row(w, tok) * 512 + c; av[i] = Ad[o]; bv[i] = BXd[o]; }
#pragma unroll
                for (int i = 0; i < 16; ++i) { const int tok = d == 0 ? n0 + i : 63 - n0 - i; const size_t o = (size_t)even_tok_row(w, tok) * 512 + c;
                    h = av[i] * h + bv[i]; cum *= av[i]; Ad[o] = cum; BXd[o] = h; }
            }
            { const int cid = (w >> 6) * 128 + 64 + (w & 63); CHA[(size_t)(d * 512 + cid) * 512 + c] = cum; CHH[(size_t)(d * 512 + cid) * 512 + c] = h; }
            h = 0.f; cum = 1.f;
#pragma unroll
            for (int i = 0; i < 4; ++i) { const int tok = 64 + (d == 0 ? i : 3 - i); const size_t o = (size_t)even_tok_row(w, tok) * 512 + c;
                const float a = Ad[o], bx = BXd[o]; h = a * h + bx; cum *= a; Ad[o] = cum; BXd[o] = h; }
            { const int cid = (w >> 6) * 128 + (w & 63); CHA[(size_t)(d * 512 + cid) * 512 + c] = cum; CHH[(size_t)(d * 512 + cid) * 512 + c] = h; }
        }
        __syncthreads();
    }
}
__device__ __forceinline__ float vfma(float a, float b, float c) { float d; asm("v_fma_f32 %0, %1, %2, %3" : "=v"(d) : "v"(a), "v"(b), "v"(c)); return d; }
__device__ __forceinline__ float vmul(float a, float b) { float d; asm("v_mul_f32 %0, %1, %2" : "=v"(d) : "v"(a), "v"(b)); return d; }
#define WG_BAR() do { asm volatile("" ::: "memory"); __builtin_amdgcn_s_barrier(); asm volatile("" ::: "memory"); } while (0)
__device__ __forceinline__ int scan_row(int d, int b, int q) {
    if (q < 256) return b * 256 + (d ? 255 - q : q);
    const int s = q - 256; return NCTX + b * 4096 + (d ? 4095 - s : s);
}
__device__ __forceinline__ void ph_fin_even(const Params& p, int bid, int nblk) {
    const int tid = threadIdx.x, wid = tid >> 6, c = tid;
    float* EA = (float*)(p.ws + WS_EARR);
    float* SC = (float*)(p.ws + WS_SC);
    const float* BC = (const float*)(p.ws + WS_BC); const float* CIN = (const float*)(p.ws + WS_CIN);
    bf16_t* Y = (bf16_t*)(p.ws + WS_YMIX);
    const float gg = p.in[I_AGNG][c], gb = p.in[I_AGNB][c];
    for (int r0 = bid * 4; r0 < MROWS; r0 += nblk * 4) {
        float o0[4], o1[4], vv[4], gv[4], bc[4], x0[4], x1[4], a0[4], a1[4], c0[4], c1[4], gt[4];
#pragma unroll
        for (int u = 0; u < 4; ++u) { const int row = r0 + u; const size_t o = (size_t)row * 512 + c;
            const int cid = row < NCTX ? (row >> 8) * 128 + ((row >> 2) & 63) : ((row - NCTX) >> 12) * 128 + 64 + (((row - NCTX) & 4095) >> 6);
            o0[u] = bf2f(((const bf16_t*)EARR(E_O0))[o]); o1[u] = bf2f(((const bf16_t*)EARR(E_O1))[o]); vv[u] = bf2f(sc_rec(SC, 0, row, wid)[384 + (tid & 63)]); gv[u] = bf2f(((const bf16_t*)EARR(E_G))[o]); bc[u] = BC[row * 8 + wid];
            x0[u] = EARR(E_BX0)[o]; x1[u] = EARR(E_BX1)[o]; a0[u] = EARR(E_A0)[o]; a1[u] = EARR(E_A1)[o];
            c0[u] = CIN[(size_t)cid * 512 + c]; c1[u] = CIN[(size_t)(512 + cid) * 512 + c]; gt[u] = bf2f(((const bf16_t*)EARR(E_GATE))[o]); }
#pragma unroll
        for (int u = 0; u < 4; ++u) { const int row = r0 + u;
            const float wkv = o0[u] + o1[u];
            const float mean = wave_sum(wkv) * (1.0f / 64.0f), dv = wkv - mean, var = wave_sum(dv * dv) * (1.0f / 64.0f);
            const float y = (dv * rsqrtf(var + 64e-5f) * gg + gb + bc[u] * vv[u]) * gv[u];
            Y[(size_t)row * 1024 + c] = f2bf(y);
            Y[(size_t)row * 1024 + 512 + c] = f2bf(((x0[u] + a0[u] * c0[u]) + (x1[u] + a1[u] * c1[u])) * gt[u]); }
    }
#undef EARR
}
constexpr int LDT = 72;
__device__ __forceinline__ float quad_sum(float v) {
    v += __int_as_float(__builtin_amdgcn_update_dpp(0, __float_as_int(v), 0xB1, 0xf, 0xf, false));
    v += __int_as_float(__builtin_amdgcn_update_dpp(0, __float_as_int(v), 0x4E, 0xf, 0xf, false));
    return v;
}
template <int PO> __device__ __forceinline__ float quad_bcast(float v) { return __int_as_float(__builtin_amdgcn_update_dpp(0, __float_as_int(v), PO * 0x55, 0xf, 0xf, false)); }
__device__ __forceinline__ bf16x8 ldt8(const LAS bf16_t* T, int row, int col) { return *(const LAS bf16x8*)(T + row * LDT + col); }
__device__ __forceinline__ void ph_r1(const Params& p, LAS unsigned char* lds, int bid, int nblk) {
    const int tid = threadIdx.x, wid = tid >> 6, lane = tid & 63, fr = lane & 15, fq = lane >> 4;
    LAS bf16_t* T0 = (LAS bf16_t*)(lds + LDS_WORK);
#define TL(i) (T0 + (i) * 64 * LDT)
    LAS float* F0 = (LAS float*)(T0 + 11 * 64 * LDT);
    LAS float* F1 = F0 + 4096;
    LAS float* F2 = F1 + 4096;
    LAS float* segt = F2 + 4096;
    LAS float* gl = segt + 512;
    const float* SC = (const float*)(p.ws + WS_SC);
    float* RU = (float*)(p.ws + WS_RU);
    const int k = tid & 63, seg = tid >> 6, t0 = seg * 8;
    const int tr = (wid >> 1) * 16, tc0 = (wid & 1) * 32;
    float kk[8], lw[8], kd[8], ka[8], rr[8], vv[8];
    auto fetch = [&](int unit) {
        const int chain = unit / NRCH, c = unit - chain * NRCH;
        const bf16_t* rec = (const bf16_t*)SC + ((size_t)chain * SCLEN + c * RCH + t0) * SCREC + k;
#pragma unroll
        for (int u = 0; u < 8; ++u) { const bf16_t* r = rec + u * SCREC; lw[u] = ((const float*)(r - k))[k]; kk[u] = bf2f(r[128]); kd[u] = bf2f(r[192]); ka[u] = bf2f(r[256]); rr[u] = bf2f(r[320]); vv[u] = bf2f(r[384]); }
    };
    if (bid < NRUNIT) fetch(bid);
    for (int unit = bid; unit < NRUNIT; unit += nblk) {
        float cum[8]; { float run = 0.f;
#pragma unroll
            for (int u = 0; u < 8; ++u) { run += lw[u]; cum[u] = run; }
            segt[seg * 64 + k] = run; }
        __syncthreads();
        float off = 0.f, tot = 0.f;
#pragma unroll
        for (int s2 = 0; s2 < 8; ++s2) { const float v = segt[s2 * 64 + k]; off += s2 < seg ? v : 0.f; tot += v; }
        if (seg == 0) gl[k] = fexp(tot);
        {
            u32x4 wk, wb, wv; unsigned pk[4], pb[4], pv[4]; float hk = 0.f, hb = 0.f, hv = 0.f;
#pragma unroll
            for (int u = 0; u < 8; ++u) { const int t = t0 + u; const float cu = cum[u] + off;
                const float ginc = fexp(cu), gexc = fexp(cu - lw[u]), ginv = fexp(-cu), gtail = fexp(tot - cu);
                const float kt = kk[u] * gexc;
                TL(0)[t * LDT + k] = f2bf(kt); F0[t * 64 + k] = kt;
                TL(1)[t * LDT + k] = f2bf(kd[u] * ginv); TL(2)[t * LDT + k] = f2bf(ka[u] * ginv); TL(3)[t * LDT + k] = f2bf(rr[u] * ginc);
                const float ktl = kd[u] * gtail, btl = ka[u] * gtail;
                if (u & 1) { pk[u >> 1] = pack_bf16(hk, ktl); pb[u >> 1] = pack_bf16(hb, btl); pv[u >> 1] = pack_bf16(hv, vv[u]); } else { hk = ktl; hb = btl; hv = vv[u]; } }
            wk.x = pk[0]; wk.y = pk[1]; wk.z = pk[2]; wk.w = pk[3]; wb.x = pb[0]; wb.y = pb[1]; wb.z = pb[2]; wb.w = pb[3]; wv.x = pv[0]; wv.y = pv[1]; wv.z = pv[2]; wv.w = pv[3];
            *(LAS u32x4*)(TL(4) + k * LDT + t0) = wk; *(LAS u32x4*)(TL(5) + k * LDT + t0) = wb; *(LAS u32x4*)(TL(6) + k * LDT + t0) = wv;
        }
        if (unit + nblk < NRUNIT) fetch(unit + nblk);
        __syncthreads();
        {
            f32x4 mk[2], mb[2], ak[2], ab[2];
#pragma unroll
            for (int nt = 0; nt < 2; ++nt) { mk[nt] = (f32x4){0.f, 0.f, 0.f, 0.f}; mb[nt] = mk[nt]; ak[nt] = mk[nt]; ab[nt] = mk[nt]; }
#pragma unroll
            for (int ks = 0; ks < 2; ++ks) { const bf16x8 aK = ldt8(TL(0), tr + fr, ks * 32 + fq * 8), aR = ldt8(TL(3), tr + fr, ks * 32 + fq * 8);
#pragma unroll
                for (int nt = 0; nt < 2; ++nt) { const bf16x8 bK = ldt8(TL(1), tc0 + nt * 16 + fr, ks * 32 + fq * 8), bB = ldt8(TL(2), tc0 + nt * 16 + fr, ks * 32 + fq * 8);
                    mk[nt] = __builtin_amdgcn_mfma_f32_16x16x32_bf16(aK, bK, mk[nt], 0, 0, 0); mb[nt] = __builtin_amdgcn_mfma_f32_16x16x32_bf16(aK, bB, mb[nt], 0, 0, 0);
                    ak[nt] = __builtin_amdgcn_mfma_f32_16x16x32_bf16(aR, bK, ak[nt], 0, 0, 0); ab[nt] = __builtin_amdgcn_mfma_f32_16x16x32_bf16(aR, bB, ab[nt], 0, 0, 0); } }
#pragma unroll
            for (int nt = 0; nt < 2; ++nt)
#pragma unroll
                for (int r = 0; r < 4; ++r) { const int t = tr + fq * 4 + r, j = tc0 + nt * 16 + fr;
                    TL(7)[t * LDT + j] = f2bf(j < t ? mk[nt][r] : 0.f); F1[j * 64 + (t & 3) * 16 + (t >> 2)] = j < t ? mb[nt][r] : 0.f;
                    TL(8)[t * LDT + j] = f2bf(j <= t ? ak[nt][r] : 0.f); TL(9)[t * LDT + j] = f2bf(j <= t ? ab[nt][r] : 0.f); }
        }
        __syncthreads();
        {
            f32x4 acc[2] = {(f32x4){0.f, 0.f, 0.f, 0.f}, (f32x4){0.f, 0.f, 0.f, 0.f}};
#pragma unroll
            for (int ks = 0; ks < 2; ++ks) { const bf16x8 a = ldt8(TL(7), tr + fr, ks * 32 + fq * 8);
#pragma unroll
                for (int nt = 0; nt < 2; ++nt) acc[nt] = __builtin_amdgcn_mfma_f32_16x16x32_bf16(a, ldt8(TL(6), tc0 + nt * 16 + fr, ks * 32 + fq * 8), acc[nt], 0, 0, 0); }
#pragma unroll
            for (int nt = 0; nt < 2; ++nt)
#pragma unroll
                for (int r = 0; r < 4; ++r) F2[(tr + fq * 4 + r) * 64 + tc0 + nt * 16 + fr] = acc[nt][r];
        }
        __syncthreads();
        {
            const int col = tid >> 2, part = tid & 3;
            f32x2 acc2[8]; float x[16];
#pragma unroll
            for (int q = 0; q < 16; ++q) { const int t = 4 * q + part; acc2[q >> 1][q & 1] = col < 64 ? F0[t * 64 + col] : F2[t * 64 + col - 64]; x[q] = 0.f; }
#pragma unroll
            for (int t = 0; t < 64; ++t) {
                const int qo = t >> 2, po = t & 3; const float aq = acc2[qo >> 1][qo & 1];
                const float xt = po == 0 ? quad_bcast<0>(aq) : po == 1 ? quad_bcast<1>(aq) : po == 2 ? quad_bcast<2>(aq) : quad_bcast<3>(aq);
                x[qo] = part == po ? xt : x[qo];
                const f32x2 nx = {-xt, -xt};
#pragma unroll
                for (int q4 = qo >> 2; q4 < 4; ++q4) { const f32x4 m = *(const LAS f32x4*)(F1 + t * 64 + part * 16 + q4 * 4);
                    acc2[q4 * 2] = (f32x2){m[0], m[1]} * nx + acc2[q4 * 2]; acc2[q4 * 2 + 1] = (f32x2){m[2], m[3]} * nx + acc2[q4 * 2 + 1]; }
            }
            LAS bf16_t* dstT = col < 64 ? TL(7) + col * LDT : TL(10) + (col - 64) * LDT;
#pragma unroll
            for (int q = 0; q < 16; ++q) dstT[4 * q + part] = f2bf(-x[q]);
        }
        __syncthreads();
        {
            f32x4 rh[2], ol[2], pm[2], qq[2];
#pragma unroll
            for (int nt = 0; nt < 2; ++nt) { rh[nt] = (f32x4){0.f, 0.f, 0.f, 0.f}; ol[nt] = rh[nt]; pm[nt] = rh[nt]; qq[nt] = rh[nt]; }
#pragma unroll
            for (int ks = 0; ks < 2; ++ks) { const int kc = ks * 32 + fq * 8;
                const bf16x8 a7 = ldt8(TL(7), tr + fr, kc), a8 = ldt8(TL(8), tr + fr, kc), a9 = ldt8(TL(9), tr + fr, kc), a6 = ldt8(TL(6), tr + fr, kc), a10 = ldt8(TL(10), tr + fr, kc);
#pragma unroll
                for (int nt = 0; nt < 2; ++nt) { const int br = tc0 + nt * 16 + fr;
                    const bf16x8 b9 = ldt8(TL(9), br, kc), b6 = ldt8(TL(6), br, kc), b10 = ldt8(TL(10), br, kc), b5 = ldt8(TL(5), br, kc), b4 = ldt8(TL(4), br, kc);
                    rh[nt] = __builtin_amdgcn_mfma_f32_16x16x32_bf16(a7, b9, rh[nt], 0, 0, 0);
                    ol[nt] = __builtin_amdgcn_mfma_f32_16x16x32_bf16(a8, b6, ol[nt], 0, 0, 0); ol[nt] = __builtin_amdgcn_mfma_f32_16x16x32_bf16(a9, b10, ol[nt], 0, 0, 0);
                    pm[nt] = __builtin_amdgcn_mfma_f32_16x16x32_bf16(a7, b5, pm[nt], 0, 0, 0);
                    qq[nt] = __builtin_amdgcn_mfma_f32_16x16x32_bf16(a6, b4, qq[nt], 0, 0, 0); qq[nt] = __builtin_amdgcn_mfma_f32_16x16x32_bf16(a10, b5, qq[nt], 0, 0, 0); } }
            float* U = RU + (size_t)unit * 4 * 4096;
#pragma unroll
            for (int nt = 0; nt < 2; ++nt)
#pragma unroll
                for (int r = 0; r < 4; ++r) { const int row = tr + fq * 4 + r, cx = tc0 + nt * 16 + fr; const int o = row * 64 + cx;
                    U[o] = pm[nt][r] + (row == cx ? gl[row] : 0.f);
                    U[4096 + o] = qq[nt][r];
                    U[8192 + o] = rh[nt][r] + bf2f(TL(3)[cx * LDT + row]);
                    U[12288 + o] = ol[nt][r]; }
        }
        __syncthreads();
    }
#undef TL
}
__device__ __forceinline__ void moe_weight_tiles(const Params& p, LAS unsigned char* lds, int first, int stride) {
    const int tid = threadIdx.x; unsigned char* ws = p.ws;
    LAS float* tile = (LAS float*)(lds + LDS_WORK);
    const int j4 = (tid & 31) * 4, i0 = tid >> 5;
    auto decode = [&](int tt, const float*& src, int& ld, int& k0, int& n0, int& w1map, bf16_t*& dst) {
        if (tt < 8192) { const int mat = tt >> 7, r = tt & 127; k0 = (r >> 4) * 128; n0 = (r & 15) * 128; src = p.in[I_W1] + (size_t)mat * 1024 * 2048; ld = 2048; dst = (bf16_t*)(ws + WS_W1T) + (size_t)mat * 2048 * 1024; w1map = 1; }
        else { tt -= 8192; const int mat = tt >> 6, r = tt & 63; k0 = (r >> 3) * 128; n0 = (r & 7) * 128; src = p.in[I_W2] + (size_t)mat * 1024 * 1024; ld = 1024; dst = (bf16_t*)(ws + WS_W2T) + (size_t)mat * 1024 * 1024; w1map = 0; }
    };
    f32x4 v[8];
    if (first < 12288) { const float* src; int ld, k0, n0, w1; bf16_t* dst; decode(first, src, ld, k0, n0, w1, dst);
#pragma unroll
        for (int r = 0; r < 8; ++r) v[r] = __builtin_nontemporal_load((const f32x4*)(src + (size_t)(k0 + i0 + 16 * r) * ld + n0 + j4)); }
    for (int t = first; t < 12288; t += stride) {
        const float* src; int ld, k0, n0, w1map; bf16_t* dst; decode(t, src, ld, k0, n0, w1map, dst);
#pragma unroll
        for (int r = 0; r < 8; ++r) { LAS float* tp = tile + (i0 + 16 * r) * 129 + j4; tp[0] = v[r][0]; tp[1] = v[r][1]; tp[2] = v[r][2]; tp[3] = v[r][3]; }
        __syncthreads();
        if (t + stride < 12288) { const float* s2; int ld2, k2, n2, w2; bf16_t* d2; decode(t + stride, s2, ld2, k2, n2, w2, d2);
#pragma unroll
            for (int r = 0; r < 8; ++r) v[r] = __builtin_nontemporal_load((const f32x4*)(s2 + (size_t)(k2 + i0 + 16 * r) * ld2 + n2 + j4)); }
        { const int ip = (tid & 15) * 8, j0 = tid >> 4;
            const int rho0 = w1map ? ((((n0 & 1023) >> 7) << 8) + ((n0 >> 10) << 7)) : n0;
#pragma unroll
            for (int r = 0; r < 4; ++r) { const int j = j0 + 32 * r;
                u32x4 w; w.x = pack_bf16(tile[ip * 129 + j], tile[(ip + 1) * 129 + j]); w.y = pack_bf16(tile[(ip + 2) * 129 + j], tile[(ip + 3) * 129 + j]);
                w.z = pack_bf16(tile[(ip + 4) * 129 + j], tile[(ip + 5) * 129 + j]); w.w = pack_bf16(tile[(ip + 6) * 129 + j], tile[(ip + 7) * 129 + j]);
                const int rho = rho0 + j, kk8 = k0 + ip; *(u32x4*)(dst + ((size_t)((rho >> 8) * 16 + (kk8 >> 6)) * 256 + (rho & 255)) * 64 + (kk8 & 63)) = w; } }
        __syncthreads();
    }
}
__device__ __forceinline__ void ph_r2(const Params& p, LAS unsigned char* lds, int bid, int nblk) {
    const int tid = threadIdx.x, wid = tid >> 6, lane = tid & 63, fr = lane & 15, g = lane >> 4;
    const int nchainwg = nblk >= 128 ? 64 : 0;
    if (bid >= nchainwg) {
        const int nconv = nblk - nchainwg, cb = bid - nchainwg;
        if (tid < 256) {
            const float* CHA = (const float*)(p.ws + WS_CHA); const float* CHH = (const float*)(p.ws + WS_CHH); float* CIN = (float*)(p.ws + WS_CIN);
            for (int item = cb; item < 16; item += nconv) {
                const int gi = item * 256 + tid, d = gi >> 11, b = (gi >> 9) & 3, c = gi & 511;
                float carry = 0.f;
                for (int s0 = 0; s0 < 128; s0 += 16) {
                    float av[16], hv[16];
#pragma unroll
                    for (int q = 0; q < 16; ++q) { const int st = s0 + q; const int cl = d == 0 ? st : (st < 64 ? 63 - st : 191 - st);
                        const size_t o = (size_t)(d * 512 + b * 128 + cl) * 512 + c; av[q] = CHA[o]; hv[q] = CHH[o]; }
#pragma unroll
                    for (int q = 0; q < 16; ++q) { const int st = s0 + q; const int cl = d == 0 ? st : (st < 64 ? 63 - st : 191 - st);
                        CIN[(size_t)(d * 512 + b * 128 + cl) * 512 + c] = carry; carry = av[q] * carry + hv[q]; }
                }
            }
        }
        __syncthreads();
        moe_weight_tiles(p, lds, cb, nconv);
        if (nchainwg) return;
    }
    LAS float* ring = (LAS float*)(lds + LDS_WORK);
    const float* RU = (const float*)(p.ws + WS_RU);
    float* EA = (float*)(p.ws + WS_EARR);
    for (int chain = nchainwg ? bid : bid; chain < 64; chain += (nchainwg ? 64 : nblk)) {
        const int d = chain >> 5, b = (chain >> 3) & 3, h = chain & 7;
        bf16_t* Od = (bf16_t*)(EA + (size_t)(E_O0 + d) * ((size_t)MROWS * 512));
        auto issue = [&](int c) {
            const float* src = RU + ((size_t)chain * NRCH + c) * 4 * 4096; LAS float* dst = ring + (c & 1) * 4 * 4096;
#pragma unroll
            for (int i = 0; i < 16; ++i) { const int slot = ((wid - 4) * 16 + i) * 64;
                __builtin_amdgcn_global_load_lds((const unsigned*)(src + (size_t)(slot + lane) * 4), (LAS unsigned*)(dst + slot * 4), 16, 0, 0); }
        };
        if (tid >= 256) { issue(0); asm volatile("s_waitcnt vmcnt(0)" ::: "memory"); }
        asm volatile("" ::: "memory"); __builtin_amdgcn_s_barrier(); asm volatile("" ::: "memory");
        f32x4 S[4];
#pragma unroll
        for (int m = 0; m < 4; ++m) S[m] = (f32x4){0.f, 0.f, 0.f, 0.f};
        const int v0 = wid * 16;
        for (int c = 0; c < NRCH; ++c) {
            if (tid >= 256) { if (c + 1 < NRCH) issue(c + 1); asm volatile("s_waitcnt vmcnt(0)" ::: "memory"); }
            else {
                const LAS float* PM = ring + (c & 1) * 4 * 4096; const LAS float* QQ = PM + 4096; const LAS float* RHT = PM + 8192; const LAS float* OL = PM + 12288;
                f32x4 acc[4], Sn[4];
#pragma unroll
                for (int tt = 0; tt < 4; ++tt) {
#pragma unroll
                    for (int i = 0; i < 4; ++i) acc[tt][i] = OL[(16 * tt + 4 * g + i) * 64 + v0 + fr];
                    Sn[tt] = *(const LAS f32x4*)(QQ + (v0 + fr) * 64 + 16 * tt + 4 * g); }
                float A[3][4];
#pragma unroll
                for (int s0 = 0; s0 < 2; ++s0) { const LAS float* ar = RHT + (16 * (s0 >> 2) + 4 * g + (s0 & 3)) * 64 + fr;
#pragma unroll
                    for (int u = 0; u < 4; ++u) A[s0][u] = ar[16 * u]; }
#pragma unroll
                for (int st = 0; st < 32; ++st) {
                    if (st + 2 < 32) { const int s2 = st + 2, mi = s2 & 15; const LAS float* ar = (s2 < 16 ? RHT : PM) + (16 * (mi >> 2) + 4 * g + (mi & 3)) * 64 + fr;
#pragma unroll
                        for (int u = 0; u < 4; ++u) A[s2 % 3][u] = ar[16 * u]; }
                    __builtin_amdgcn_sched_barrier(0);
                    const int mi = st & 15; const float bq = S[mi >> 2][mi & 3];
                    if (st < 16) {
#pragma unroll
                        for (int u = 0; u < 4; ++u) acc[u] = __builtin_amdgcn_mfma_f32_16x16x4f32(A[st % 3][u], bq, acc[u], 0, 0, 0);
                    } else {
#pragma unroll
                        for (int u = 0; u < 4; ++u) Sn[u] = __builtin_amdgcn_mfma_f32_16x16x4f32(A[st % 3][u], bq, Sn[u], 0, 0, 0);
                    }
                }
#pragma unroll
                for (int tt = 0; tt < 4; ++tt)
#pragma unroll
                    for (int i = 0; i < 4; ++i) { const int row = scan_row(d, b, c * RCH + 16 * tt + 4 * g + i); Od[(size_t)row * 512 + h * 64 + v0 + fr] = f2bf(acc[tt][i]); }
#pragma unroll
                for (int m = 0; m < 4; ++m) S[m] = Sn[m];
                asm volatile("s_waitcnt lgkmcnt(0)" ::: "memory");
            }
            asm volatile("" ::: "memory"); __builtin_amdgcn_s_barrier(); asm volatile("" ::: "memory");
        }
    }
}
template <int LAYER>
__device__ __forceinline__ void ph_ln1(const Params& p, LAS unsigned char* lds, int bid, int nblk) {
    const int tid = threadIdx.x, wid = tid >> 6, lane = tid & 63;
    LAS float* rwT = (LAS float*)(lds + LDS_WORK);
    LAS int* lcnt = (LAS int*)(rwT + 32 * 1028);
#pragma unroll 1
    for (int i0 = tid; i0 < 32768; i0 += NTHR * 16) {
        float t[16];
#pragma unroll
        for (int u = 0; u < 16; ++u) t[u] = p.in[I_RW][(size_t)LAYER * 32768 + i0 + u * NTHR];
#pragma unroll
        for (int u = 0; u < 16; ++u) { const int i = i0 + u * NTHR; rwT[(i & 31) * 1028 + (i >> 5)] = t[u]; }
    }
    if (tid < 32) lcnt[tid] = 0;
    __syncthreads();
    const float* MOD = (const float*)(p.ws + WS_MOD);
    bf16_t* XS = (bf16_t*)(p.ws + WS_XS); const bf16_t* YP = (const bf16_t*)(p.ws + WS_YP); bf16_t* H = (bf16_t*)(p.ws + WS_H);
    int* TOPE = (int*)(p.ws + WS_TOPE); float* TOPW = (float*)(p.ws + WS_TOPW); int* TOPS = (int*)(p.ws + WS_TOPS);
    int* CNTB = (int*)(p.ws + WS_CNTB) + (size_t)(LAYER * 512 + bid) * 32;
    const float* lng = p.in[I_LNG] + (LAYER * 2 + 0) * 1024; const float* lnb = p.in[I_LNB] + (LAYER * 2 + 0) * 1024;
    const int rstride = nblk * 8;
    f32x4 nres[4], ngate[4]; u32x2 nyp[4];
    auto fetch = [&](int row) {
        const float* res = row < NCTX ? p.in[I_CTX] + (size_t)row * 1024 : p.in[I_X] + (size_t)(row - NCTX) * 1024;
        const float* md = MOD + (size_t)(LAYER * 5 + row_modr(row)) * 6144;
#pragma unroll
        for (int q = 0; q < 4; ++q) { const int col = q * 256 + lane * 4; nres[q] = LAYER == 0 ? *(const f32x4*)(res + col) : ld_bf16x4(XS + (size_t)row * 1024 + col);
            ngate[q] = *(const f32x4*)(md + 2048 + col); nyp[q] = *(const u32x2*)(YP + (size_t)row * 1024 + col); }
    };
    { const int row0 = (LAYER == 0 ? 0 : NCTX) + bid * 8 + wid; if (row0 < MROWS) fetch(row0); }
    for (int row = (LAYER == 0 ? 0 : NCTX) + bid * 8 + wid; row < MROWS; row += rstride) {
        const float* md = MOD + (size_t)(LAYER * 5 + row_modr(row)) * 6144;
        f32x4 v[4], msc[4], msh[4]; float s = 0.f;
#pragma unroll
        for (int q = 0; q < 4; ++q) { const u32x2 w = nyp[q];
            const f32x4 y = (f32x4){__uint_as_float(w.x << 16), __uint_as_float(w.x & 0xffff0000u), __uint_as_float(w.y << 16), __uint_as_float(w.y & 0xffff0000u)};
            v[q] = nres[q] * DN_ALPHA + ngate[q] * y;
            s += (v[q][0] + v[q][1]) + (v[q][2] + v[q][3]); }
#pragma unroll
        for (int q = 0; q < 4; ++q) { const int col = q * 256 + lane * 4; msc[q] = *(const f32x4*)(md + 4096 + col); msh[q] = *(const f32x4*)(md + 3072 + col); }
        if (row + rstride < MROWS) fetch(row + rstride);
        const float mean = wave_sum(s) * (1.0f / 1024.0f);
        float ss = 0.f;
#pragma unroll
        for (int q = 0; q < 4; ++q) { v[q] = v[q] - mean; ss += (v[q][0] * v[q][0] + v[q][1] * v[q][1]) + (v[q][2] * v[q][2] + v[q][3] * v[q][3]); }
        const float rstd = rsqrtf(wave_sum(ss) * (1.0f / 1024.0f) + LN_EPS);
#pragma unroll
        for (int q = 0; q < 4; ++q) { const int col = q * 256 + lane * 4;
            const f32x4 xn = v[q] * rstd * *(const f32x4*)(lng + col) + *(const f32x4*)(lnb + col);
            { u32x2 wx; wx.x = pack_bf16(xn[0], xn[1]); wx.y = pack_bf16(xn[2], xn[3]); *(u32x2*)(XS + (size_t)row * 1024 + col) = wx; }
            v[q] = xn * (msc[q] + 1.0f) + msh[q];
            u32x2 w; w.x = pack_bf16(v[q][0], v[q][1]); w.y = pack_bf16(v[q][2], v[q][3]);
            *(u32x2*)(H + (size_t)row * 1024 + col) = w; }
        float pa[32];
#pragma unroll
        for (int e = 0; e < 32; ++e) { float a = 0.f;
#pragma unroll
            for (int q = 0; q < 4; ++q) { const f32x4 r = *(const LAS f32x4*)(rwT + e * 1028 + q * 256 + lane * 4); a += (v[q][0] * r[0] + v[q][1] * r[1]) + (v[q][2] * r[2] + v[q][3] * r[3]); }
            pa[e] = a; }
#pragma unroll
        for (int i = 0; i < 16; ++i) { const bool hi = lane & 32; const float snd = hi ? pa[i] : pa[i + 16], kp = hi ? pa[i + 16] : pa[i]; pa[i] = kp + __shfl_xor(snd, 32, 64); }
#pragma unroll
        for (int i = 0; i < 8; ++i) { const bool hi = lane & 16; const float snd = hi ? pa[i] : pa[i + 8], kp = hi ? pa[i + 8] : pa[i]; pa[i] = kp + __shfl_xor(snd, 16, 64); }
#pragma unroll
        for (int i = 0; i < 4; ++i) { const bool hi = lane & 8; const float snd = hi ? pa[i] : pa[i + 4], kp = hi ? pa[i + 4] : pa[i]; pa[i] = kp + __shfl_xor(snd, 8, 64); }
#pragma unroll
        for (int i = 0; i < 2; ++i) { const bool hi = lane & 4; const float snd = hi ? pa[i] : pa[i + 2], kp = hi ? pa[i + 2] : pa[i]; pa[i] = kp + __shfl_xor(snd, 4, 64); }
        { const bool hi = lane & 2; const float snd = hi ? pa[0] : pa[1], kp = hi ? pa[1] : pa[0]; pa[0] = kp + __shfl_xor(snd, 2, 64); }
        float lg = pa[0] + __shfl_xor(pa[0], 1, 64) + p.in[I_RB][LAYER * 32 + (lane >> 1)];
        float tv[4]; int te[4];
#pragma unroll
        for (int k = 0; k < 4; ++k) { const float bv = wave_max(lg); const int bi = wave_min_i(lg == bv ? (lane >> 1) : 99);
            tv[k] = bv; te[k] = bi & 31; lg = (lane >> 1) == bi ? -3.0e38f : lg; }
        const float e1 = expf(tv[1] - tv[0]), e2 = expf(tv[2] - tv[0]), e3 = expf(tv[3] - tv[0]), inv = 1.0f / (1.0f + e1 + e2 + e3);
        if (lane == 0) {
            const float wv[4] = {inv, e1 * inv, e2 * inv, e3 * inv};
#pragma unroll
            for (int k = 0; k < 4; ++k) { const int slot = __hip_atomic_fetch_add(lcnt + te[k], 1, __ATOMIC_RELAXED, __HIP_MEMORY_SCOPE_WORKGROUP); TOPE[row * 4 + k] = te[k]; TOPW[row * 4 + k] = wv[k]; TOPS[row * 4 + k] = slot; }
        }
    }
    __syncthreads();
    if (tid < 32) CNTB[tid] = lcnt[tid];
}
constexpr int LDS_TAB = LDS_WORK + 131072;
__device__ __forceinline__ int moe_tables(const int* cntb, int nblk, LAS int* tab, LAS int* bb) {
    const int tid = threadIdx.x, e = tid & 31, seg = tid >> 5, per = (nblk + 15) >> 4;
    const int b0 = seg * per, b1 = (b0 + per) < nblk ? (b0 + per) : nblk;
    int s = 0;
    if (per <= 16) {
        int cv[16];
#pragma unroll
        for (int u = 0; u < 16; ++u) cv[u] = (b0 + u) < b1 ? cntb[(b0 + u) * 32 + e] : 0;
#pragma unroll
        for (int u = 0; u < 16; ++u) s += cv[u];
        tab[512 + seg * 32 + e] = s;
        __syncthreads();
        if (tid < 32) { int run = 0; for (int sg = 0; sg < 16; ++sg) { const int v = tab[512 + sg * 32 + tid]; tab[512 + sg * 32 + tid] = run; run += v; } tab[448 + tid] = run; }
        __syncthreads();
        if (bb) { int run = tab[512 + seg * 32 + e];
#pragma unroll
            for (int u = 0; u < 16; ++u) if ((b0 + u) < b1) { bb[(b0 + u) * 32 + e] = run; run += cv[u]; } }
    } else {
        for (int b = b0; b < b1; ++b) s += cntb[b * 32 + e];
        tab[512 + seg * 32 + e] = s;
        __syncthreads();
        if (tid < 32) { int run = 0; for (int sg = 0; sg < 16; ++sg) { const int v = tab[512 + sg * 32 + tid]; tab[512 + sg * 32 + tid] = run; run += v; } tab[448 + tid] = run; }
        __syncthreads();
        if (bb) { int run = tab[512 + seg * 32 + e]; for (int b = b0; b < b1; ++b) { bb[b * 32 + e] = run; run += cntb[b * 32 + e]; } }
    }
    if (tid < 64) {
        const int x = tid & 31, n = (tab[448 + x] + 255) >> 8; int inc = n;
#pragma unroll
        for (int o = 1; o < 32; o <<= 1) { const int t = __shfl_up(inc, o, 64); if ((tid & 31) >= o) inc += t; }
        if (tid < 32) { const int t0 = inc - n; tab[x] = t0 * 256; for (int i = 0; i < n; ++i) tab[64 + t0 + i] = x; if (x == 31) { tab[32] = inc * 256; tab[40] = inc; } }
    }
    __syncthreads();
    return tab[40];
}
template <int LAYER>
__device__ __forceinline__ void ph_moe_gather(const Params& p, LAS unsigned char* lds, int bid, int nblk) {
    const int tid = threadIdx.x, wid = tid >> 6, lane = tid & 63;
    LAS int* tab = (LAS int*)(lds + LDS_TAB); LAS int* bb = (LAS int*)(lds + LDS_WORK);
    (void)moe_tables((const int*)(p.ws + WS_CNTB) + (size_t)LAYER * 512 * 32, nblk, tab, bb);
    const int* TOPE = (const int*)(p.ws + WS_TOPE); const int* TOPS = (const int*)(p.ws + WS_TOPS); int* POS = (int*)(p.ws + WS_POS);
    const bf16_t* H = (const bf16_t*)(p.ws + WS_H); bf16_t* AS = (bf16_t*)(p.ws + WS_ASORT);
    const int rstride = nblk * 8, rfirst = (LAYER == 0 ? 0 : NCTX) + bid * 8 + wid;
    u32x4 na = {0u, 0u, 0u, 0u}, nb2 = {0u, 0u, 0u, 0u}; int ne[4] = {0, 0, 0, 0}, ns[4] = {0, 0, 0, 0};
    auto fetch = [&](int row) {
        na = *(const u32x4*)(H + (size_t)row * 1024 + lane * 16); nb2 = *(const u32x4*)(H + (size_t)row * 1024 + lane * 16 + 8);
#pragma unroll
        for (int k = 0; k < 4; ++k) { ne[k] = TOPE[row * 4 + k]; ns[k] = TOPS[row * 4 + k]; }
    };
    if (rfirst < MROWS) fetch(rfirst);
    for (int row = rfirst; row < MROWS; row += rstride) {
        const u32x4 a = na, b = nb2; int ce[4], cs[4];
#pragma unroll
        for (int k = 0; k < 4; ++k) { ce[k] = ne[k]; cs[k] = ns[k]; }
        if (row + rstride < MROWS) fetch(row + rstride);
#pragma unroll
        for (int k = 0; k < 4; ++k) {
            const int e = ce[k], pos = tab[e] + bb[((((row - (LAYER == 0 ? 0 : NCTX)) >> 3) % nblk) << 5) + e] + cs[k];
            if (lane == 0) POS[row * 4 + k] = pos;
            bf16_t* ad = AS + ((size_t)((pos >> 8) * 16 + (lane >> 2)) * 256 + (pos & 255)) * 64 + (lane & 3) * 16;
            *(u32x4*)ad = a; *(u32x4*)(ad + 8) = b;
        }
    }
}
template <int LAYER>
__device__ __forceinline__ void ph_moe_gemm1(const Params& p, LAS unsigned char* lds, int bid, int nblk) {
    LAS int* tab = (LAS int*)(lds + LDS_TAB);
    const int T = moe_tables((const int*)(p.ws + WS_CNTB) + (size_t)LAYER * 512 * 32, nblk, tab, (LAS int*)nullptr);
    pg8::SchedMoe<8> S{T, nblk, bid, tab + 64};
    pg8::Gemm g{(const bf16_t*)(p.ws + WS_ASORT), (const bf16_t*)(p.ws + WS_W1T) + (size_t)LAYER * 32 * 2048 * 1024, 0, 0, 1024};
    pg8::EpiAct E{(bf16_t*)(p.ws + WS_ACT), p.in[I_B1] + (size_t)LAYER * 32 * 2048};
    pg8::gemm_phase<pg8::EpiAct, pg8::SchedMoe<8>, false, true, true>(lds + LDS_WORK, g, S, E, nullptr);
}
template <int LAYER>
__device__ __forceinline__ void ph_moe_gemm2(const Params& p, LAS unsigned char* lds, int bid, int nblk) {
    LAS int* tab = (LAS int*)(lds + LDS_TAB);
    const int T = moe_tables((const int*)(p.ws + WS_CNTB) + (size_t)LAYER * 512 * 32, nblk, tab, (LAS int*)nullptr);
    pg8::SchedMoe<4> S{T, nblk, bid, tab + 64};
    pg8::Gemm g{(const bf16_t*)(p.ws + WS_ACT), (const bf16_t*)(p.ws + WS_W2T) + (size_t)LAYER * 32 * 1024 * 1024, 0, 0, 1024};
    pg8::EpiYE E{(bf16_t*)(p.ws + WS_YE), p.in[I_B2] + (size_t)LAYER * 32 * 1024};
    pg8::gemm_phase<pg8::EpiYE, pg8::SchedMoe<4>, false, true, true>(lds + LDS_WORK, g, S, E, nullptr);
}
template <int NN>
__device__ __forceinline__ void ph_gemm_dense(LAS unsigned char* lds, const bf16_t* A, const bf16_t* Bt, bf16_t* C, int ldc, int pm0, int nM, int bid, int nblk) {
    pg8::SchedDense<NN> S{nM, pm0, nblk, bid};
    pg8::Gemm g{A, Bt, 0, 0, 1024};
    pg8::EpiStore E{C, ldc};
    pg8::gemm_phase<pg8::EpiStore, pg8::SchedDense<NN>, false>(lds + LDS_WORK, g, S, E, nullptr);
}
template <int LAYER>
__device__ __forceinline__ void ph_ln2(const Params& p, LAS unsigned char* lds, int bid, int nblk) {
    const int tid = threadIdx.x, wid = tid >> 6, lane = tid & 63;
    LAS float* wgT = (LAS float*)(lds + LDS_WORK);
    if (LAYER == 0) {
#pragma unroll 1
        for (int i0 = tid; i0 < 16384; i0 += NTHR * 16) {
            float t[16];
#pragma unroll
            for (int u = 0; u < 16; ++u) { const int i = i0 + u * NTHR; t[u] = p.in[I_OWIN][(size_t)(i >> 4) * ODD_IN + 4096 + (i & 15)]; }
#pragma unroll
            for (int u = 0; u < 16; ++u) { const int i = i0 + u * NTHR; wgT[(i & 15) * 1028 + (i >> 4)] = t[u]; }
        }
        __syncthreads();
    }
    const float* MOD = (const float*)(p.ws + WS_MOD);
    bf16_t* XS = (bf16_t*)(p.ws + WS_XS); const bf16_t* YE = (const bf16_t*)(p.ws + WS_YE); bf16_t* H = (bf16_t*)(p.ws + WS_H); float* GT = (float*)(p.ws + WS_GT);
    const float* TOPW = (const float*)(p.ws + WS_TOPW); const int* POS = (const int*)(p.ws + WS_POS);
    const float* lng = p.in[I_LNG] + (LAYER * 2 + 1) * 1024; const float* lnb = p.in[I_LNB] + (LAYER * 2 + 1) * 1024;
    const int rstride = nblk * 8, rfirst = (LAYER == 0 ? 0 : NCTX) + bid * 8 + wid;
    f32x4 nw = {0.f, 0.f, 0.f, 0.f}; int np0 = 0, np1 = 0, np2 = 0, np3 = 0;
    if (rfirst < MROWS) { nw = *(const f32x4*)(TOPW + rfirst * 4); np0 = POS[rfirst * 4]; np1 = POS[rfirst * 4 + 1]; np2 = POS[rfirst * 4 + 2]; np3 = POS[rfirst * 4 + 3]; }
    for (int row = rfirst; row < MROWS; row += rstride) {
        const float* md = MOD + (size_t)(LAYER * 5 + row_modr(row)) * 6144;
        const float w0 = nw[0], w1 = nw[1], w2 = nw[2], w3 = nw[3];
        const bf16_t* y0 = YE + (size_t)np0 * 1024; const bf16_t* y1 = YE + (size_t)np1 * 1024;
        const bf16_t* y2 = YE + (size_t)np2 * 1024; const bf16_t* y3 = YE + (size_t)np3 * 1024;
        if (row + rstride < MROWS) { const int rn = row + rstride; nw = *(const f32x4*)(TOPW + rn * 4); np0 = POS[rn * 4]; np1 = POS[rn * 4 + 1]; np2 = POS[rn * 4 + 2]; np3 = POS[rn * 4 + 3]; }
        f32x4 v[4]; float s = 0.f;
#pragma unroll
        for (int q = 0; q < 4; ++q) { const int col = q * 256 + lane * 4;
            const f32x4 ffn = (ld_bf16x4(y0 + col) * w0 + ld_bf16x4(y1 + col) * w1) + (ld_bf16x4(y2 + col) * w2 + ld_bf16x4(y3 + col) * w3);
            v[q] = ld_bf16x4(XS + (size_t)row * 1024 + col) * DN_ALPHA + *(const f32x4*)(md + 5120 + col) * ffn;
            s += (v[q][0] + v[q][1]) + (v[q][2] + v[q][3]); }
        const float mean = wave_sum(s) * (1.0f / 1024.0f);
        float ss = 0.f;
#pragma unroll
        for (int q = 0; q < 4; ++q) { v[q] = v[q] - mean; ss += (v[q][0] * v[q][0] + v[q][1] * v[q][1]) + (v[q][2] * v[q][2] + v[q][3] * v[q][3]); }
        const float rstd = rsqrtf(wave_sum(ss) * (1.0f / 1024.0f) + LN_EPS);
        if (LAYER == 1) {
#pragma unroll
            for (int q = 0; q < 4; ++q) { const int col = q * 256 + lane * 4;
                *(f32x4*)(p.out + (size_t)(row - NCTX) * 1024 + col) = v[q] * rstd * *(const f32x4*)(lng + col) + *(const f32x4*)(lnb + col); }
        } else {
            const float* md1 = MOD + (size_t)(5 + row_modr(row)) * 6144;
#pragma unroll
            for (int q = 0; q < 4; ++q) { const int col = q * 256 + lane * 4;
                const f32x4 xn = v[q] * rstd * *(const f32x4*)(lng + col) + *(const f32x4*)(lnb + col);
                { u32x2 wx; wx.x = pack_bf16(xn[0], xn[1]); wx.y = pack_bf16(xn[2], xn[3]); *(u32x2*)(XS + (size_t)row * 1024 + col) = wx; }
                v[q] = xn * (*(const f32x4*)(md1 + 1024 + col) + 1.0f) + *(const f32x4*)(md1 + col);
                u32x2 w; w.x = pack_bf16(v[q][0], v[q][1]); w.y = pack_bf16(v[q][2], v[q][3]);
                *(u32x2*)(H + (size_t)row * 1024 + col) = w; }
            float gt = 0.f;
#pragma unroll 2
            for (int g = 0; g < 16; ++g) { float a = 0.f;
#pragma unroll
                for (int q = 0; q < 4; ++q) { const f32x4 r = *(const LAS f32x4*)(wgT + g * 1028 + q * 256 + lane * 4); a += (v[q][0] * r[0] + v[q][1] * r[1]) + (v[q][2] * r[2] + v[q][3] * r[3]); }
                a = wave_sum(a); gt = lane == g ? a : gt; }
            if (lane < 16) GT[row * 16 + lane] = gt;
        }
    }
}
constexpr int LDK = 136;
__device__ __forceinline__ int sid_of(int mixer, int dir, int b, int ch, int h) { return (((mixer * 2 + dir) * 4 + b) * NCHUNK + ch) * 4 + h; }
__device__ __forceinline__ void unit_decode(int u, int& mixer, int& h, int& ch, int& b, int& row0) {
    mixer = u & 1; h = (u >> 1) & 3; const int rest = u >> 3; ch = rest % NCHUNK; b = rest / NCHUNK;
    row0 = ch < 2 ? b * 256 + ch * 128 : NCTX + b * 4096 + (ch - 2) * 128;
}
__device__ __forceinline__ void ld_raw(const bf16_t* P, int row0, int col, u32x2 (&raw)[8]) {
    const int t = threadIdx.x, i = t >> 2, part = t & 3, i0 = (part & 1) * 32 + (part >> 1) * 16;
    const bf16_t* src = P + (size_t)(row0 + i) * LDP1 + col + i0;
#pragma unroll
    for (int q = 0; q < 4; ++q) { raw[q] = *(const u32x2*)(src + q * 4); raw[4 + q] = *(const u32x2*)(src + 64 + q * 4); }
}
__device__ __forceinline__ void cvt_rows(const u32x2 (&raw)[8], bool rope, int s0, const float* ROPE, float (&lo)[16], float (&hi)[16]) {
    const int t = threadIdx.x, i = t >> 2, part = t & 3, pr = part & 1, hf = part >> 1;
#pragma unroll
    for (int q = 0; q < 4; ++q) {
        lo[q * 4] = __uint_as_float(raw[q].x << 16); lo[q * 4 + 1] = __uint_as_float(raw[q].x & 0xffff0000u); lo[q * 4 + 2] = __uint_as_float(raw[q].y << 16); lo[q * 4 + 3] = __uint_as_float(raw[q].y & 0xffff0000u);
        hi[q * 4] = __uint_as_float(raw[4 + q].x << 16); hi[q * 4 + 1] = __uint_as_float(raw[4 + q].x & 0xffff0000u); hi[q * 4 + 2] = __uint_as_float(raw[4 + q].y << 16); hi[q * 4 + 3] = __uint_as_float(raw[4 + q].y & 0xffff0000u); }
    if (rope) {
        const int s = s0 + i, pos = pr == 0 ? (s >> 6) : (s & 63);
        const float* rp = ROPE + (size_t)(pos * 32 + hf * 16) * 2;
#pragma unroll
        for (int jj = 0; jj < 16; ++jj) { const float c = rp[2 * jj], sn = rp[2 * jj + 1], a = lo[jj], b = hi[jj]; lo[jj] = a * c - b * sn; hi[jj] = a * sn + b * c; }
    }
}
__device__ __forceinline__ void st_rows(LAS bf16_t* dst, const float (&lo)[16], const float (&hi)[16], float scale) {
    const int t = threadIdx.x, i = t >> 2, part = t & 3, i0 = (part & 1) * 32 + (part >> 1) * 16;
    u32x4 w0, w1, w2, w3;
    w0.x = pack_bf16(lo[0] * scale, lo[1] * scale); w0.y = pack_bf16(lo[2] * scale, lo[3] * scale); w0.z = pack_bf16(lo[4] * scale, lo[5] * scale); w0.w = pack_bf16(lo[6] * scale, lo[7] * scale);
    w1.x = pack_bf16(lo[8] * scale, lo[9] * scale); w1.y = pack_bf16(lo[10] * scale, lo[11] * scale); w1.z = pack_bf16(lo[12] * scale, lo[13] * scale); w1.w = pack_bf16(lo[14] * scale, lo[15] * scale);
    w2.x = pack_bf16(hi[0] * scale, hi[1] * scale); w2.y = pack_bf16(hi[2] * scale, hi[3] * scale); w2.z = pack_bf16(hi[4] * scale, hi[5] * scale); w2.w = pack_bf16(hi[6] * scale, hi[7] * scale);
    w3.x = pack_bf16(hi[8] * scale, hi[9] * scale); w3.y = pack_bf16(hi[10] * scale, hi[11] * scale); w3.z = pack_bf16(hi[12] * scale, hi[13] * scale); w3.w = pack_bf16(hi[14] * scale, hi[15] * scale);
    LAS bf16_t* d = dst + i * LDK + i0;
    *(LAS u32x4*)d = w0; *(LAS u32x4*)(d + 8) = w1; *(LAS u32x4*)(d + 64) = w2; *(LAS u32x4*)(d + 72) = w3;
}
__device__ __forceinline__ void st_rows_T(LAS bf16_t* dst, const float (&lo)[16], const float (&hi)[16], float scale) {
    const int t = threadIdx.x, i = t >> 2, part = t & 3, i0 = (part & 1) * 32 + (part >> 1) * 16;
#pragma unroll
    for (int jj = 0; jj < 16; ++jj) { dst[(i0 + jj) * LDK + i] = f2bf(lo[jj] * scale); dst[(i0 + 64 + jj) * LDK + i] = f2bf(hi[jj] * scale); }
}
__device__ __forceinline__ void mma_128(const LAS bf16_t* A, const LAS bf16_t* B, f32x4 (&acc)[2][4], int wr, int wc, int lane) {
    const int fr = lane & 15, fq = lane >> 4;
#pragma unroll
    for (int ks = 0; ks < 4; ++ks) {
        bf16x8 a[2], b[4];
#pragma unroll
        for (int mt = 0; mt < 2; ++mt) a[mt] = *(const LAS bf16x8*)(A + (wr * 32 + mt * 16 + fr) * LDK + ks * 32 + fq * 8);
#pragma unroll
        for (int nt = 0; nt < 4; ++nt) b[nt] = *(const LAS bf16x8*)(B + (wc * 64 + nt * 16 + fr) * LDK + ks * 32 + fq * 8);
#pragma unroll
        for (int mt = 0; mt < 2; ++mt)
#pragma unroll
            for (int nt = 0; nt < 4; ++nt) acc[mt][nt] = __builtin_amdgcn_mfma_f32_16x16x32_bf16(a[mt], b[nt], acc[mt][nt], 0, 0, 0);
    }
}
__device__ __forceinline__ void zero_acc(f32x4 (&acc)[2][4]) {
#pragma unroll
    for (int mt = 0; mt < 2; ++mt)
#pragma unroll
        for (int nt = 0; nt < 4; ++nt) acc[mt][nt] = (f32x4){0.f, 0.f, 0.f, 0.f};
}
__device__ __forceinline__ void wave_scan_sum2(float x0, float x1, float& p0, float& p1, float& total) {
    const int lane = threadIdx.x & 63; float s = x0 + x1, inc = s;
#pragma unroll
    for (int o = 1; o < 64; o <<= 1) { const float t = __shfl_up(inc, o, 64); if (lane >= o) inc += t; }
    const float exc = inc - s; p0 = exc + x0; p1 = exc + s; total = __shfl(inc, 63, 64);
}
__device__ __forceinline__ void wave_scan_max2(float x0, float x1, float& p0, float& p1) {
    const int lane = threadIdx.x & 63; const float m = fmaxf(x0, x1); float inc = m;
#pragma unroll
    for (int o = 1; o < 64; o <<= 1) { const float t = __shfl_up(inc, o, 64); if (lane >= o) inc = fmaxf(inc, t); }
    float exc = __shfl_up(inc, 1, 64); if (lane == 0) exc = -3.0e38f;
    p0 = fmaxf(exc, x0); p1 = fmaxf(exc, m);
}
__device__ __forceinline__ void ph_c1(const Params& p, LAS unsigned char* lds, int bid, int nblk) {
    const int tid = threadIdx.x, wid = tid >> 6, lane = tid & 63, wr = wid >> 1, wc = wid & 1, fr = lane & 15, fq = lane >> 4;
    LAS bf16_t* KsT = (LAS bf16_t*)(lds + LDS_WORK); LAS bf16_t* VsT0 = KsT + 128 * LDK; LAS bf16_t* VsT1 = VsT0 + 128 * LDK;
    LAS float* z = (LAS float*)(VsT1 + 128 * LDK);
    LAS float* lfA = z + 256; LAS float* igA = lfA + 256; LAS float* zmax = igA + 256;
    const bf16_t* P = (const bf16_t*)(p.ws + WS_P); const float* GT = (const float*)(p.ws + WS_GT); const float* ROPE = (const float*)(p.ws + WS_ROPE);
    float* ST = (float*)(p.ws + WS_ST); float* NST = (float*)(p.ws + WS_NST); float* MEND = (float*)(p.ws + WS_MEND); float* BEND = (float*)(p.ws + WS_BEND);
    for (int u = bid; u < NB * NCHUNK * 4 * 2; u += nblk) {
        int mixer, h, ch, b, row0; unit_decode(u, mixer, h, ch, b, row0);
        const int colQ = mixer * 2048 + h * 128;
        u32x2 rawK[8], rawV[8]; ld_raw(P, row0, colQ + 512, rawK); ld_raw(P, row0, colQ + 1024, rawV);
        if (mixer == 0) {
            if (tid < 256) { const int dir = tid >> 7, j = tid & 127; const float lg = p.in[I_CLG][dir * 4 + h]; z[tid] = fexp(lg * (float)(dir == 0 ? 127 - j : j)); }
        } else {
            if (tid < 256) { const int dir = tid >> 7, j = tid & 127, row = row0 + j;
                igA[tid] = GT[row * 16 + dir * 4 + h] + p.in[I_DIB][dir * 4 + h];
                lfA[tid] = -softplusf(-(GT[row * 16 + 8 + dir * 4 + h] + p.in[I_DFB][dir * 4 + h])); }
            __syncthreads();
            if (tid < 128) { const int dir = tid >> 6, j0 = 2 * lane, j1 = j0 + 1;
                const float l0 = lfA[dir * 128 + j0], l1 = lfA[dir * 128 + j1], g0 = igA[dir * 128 + j0], g1 = igA[dir * 128 + j1];
                float r0, r1, total; wave_scan_sum2(l0, l1, r0, r1, total);
                const float w0 = (dir == 0 ? total - r0 : r0 - l0) + g0, w1 = (dir == 0 ? total - r1 : r1 - l1) + g1;
                const float mx = wave_max(fmaxf(w0, w1));
                z[dir * 128 + j0] = fexp(w0 - mx); z[dir * 128 + j1] = fexp(w1 - mx);
                const int sid = sid_of(1, dir, b, ch, h);
                if (lane == 0) { MEND[sid] = mx; BEND[sid] = total; }
                float* CB = (float*)(p.ws + WS_CB) + (size_t)sid * 128; float* CMI = (float*)(p.ws + WS_CMI) + (size_t)sid * 128;
                if (dir == 0) { float m0, m1; wave_scan_max2(g0 - r0, g1 - r1, m0, m1); CB[j0] = r0; CB[j1] = r1; CMI[j0] = r0 + m0; CMI[j1] = r1 + m1; }
                else { const float s0 = total - r0 + l0, s1 = total - r1 + l1;
                    lfA[128 + j0] = g0 - s0; lfA[128 + j1] = g1 - s1; igA[128 + j0] = s0; igA[128 + j1] = s1; CB[j0] = s0; CB[j1] = s1;
                    asm volatile("s_waitcnt lgkmcnt(0)" ::: "memory");
                    const int q0 = 127 - 2 * lane, q1 = q0 - 1; float m0, m1; wave_scan_max2(lfA[128 + q0], lfA[128 + q1], m0, m1);
                    CMI[q0] = igA[128 + q0] + m0; CMI[q1] = igA[128 + q1] + m1; } }
        }
        __syncthreads();
        {
            float lo[16], hi[16];
            cvt_rows(rawK, mixer == 0 && ch >= 2, (ch - 2) * 128, ROPE, lo, hi);
            st_rows_T(KsT, lo, hi, 0.08838834764831845f);
            cvt_rows(rawV, false, 0, ROPE, lo, hi);
            const int i = tid >> 2;
            st_rows_T(VsT0, lo, hi, z[i]); st_rows_T(VsT1, lo, hi, z[128 + i]);
        }
        __syncthreads();
#pragma unroll
        for (int dir = 0; dir < 2; ++dir) {
            f32x4 acc[2][4]; zero_acc(acc);
            mma_128(dir == 0 ? VsT0 : VsT1, KsT, acc, wr, wc, lane);
            bf16_t* dst = (bf16_t*)ST + (size_t)sid_of(mixer, dir, b, ch, h) * 16384;
#pragma unroll
            for (int mt = 0; mt < 2; ++mt)
#pragma unroll
                for (int nt = 0; nt < 4; ++nt)
#pragma unroll
                    for (int r = 0; r < 4; ++r) dst[(wr * 32 + mt * 16 + fq * 4 + r) * 128 + wc * 64 + nt * 16 + fr] = f2bf(acc[mt][nt][r]);
        }
        if (mixer == 1 && tid < 256) { const int dir = tid >> 7, dd = tid & 127; float s = 0.f;
            for (int j = 0; j < 128; ++j) s += z[dir * 128 + j] * bf2f(KsT[dd * LDK + j]);
            NST[(size_t)sid_of(1, dir, b, ch, h) * 128 + dd] = s; }
        __syncthreads();
    }
}
__device__ __forceinline__ void ph_c2(const Params& p, int bid, int nblk) {
    const int tid = threadIdx.x;
    float* ST = (float*)(p.ws + WS_ST); float* NST = (float*)(p.ws + WS_NST); bf16_t* STB = (bf16_t*)(p.ws + WS_STB);
    const float* MEND = (const float*)(p.ws + WS_MEND); const float* BEND = (const float*)(p.ws + WS_BEND); float* MPREV = (float*)(p.ws + WS_MPREV);
    for (int item = bid; item < 2048; item += nblk) {
        const int mixer = item >> 10, chain = (item >> 5) & 31, slab = item & 31, dir = chain >> 4, b = (chain >> 2) & 3, h = chain & 3;
        const int idx = slab * 512 + tid;
        float kv[NCHUNK];
#pragma unroll
        for (int k = 0; k < NCHUNK; ++k) { const int ch = dir == 0 ? k : (k < 2 ? 1 - k : 35 - k); kv[k] = bf2f(((const bf16_t*)ST)[(size_t)sid_of(mixer, dir, b, ch, h) * 16384 + idx]); }
        if (mixer == 0) {
            const float gdec = fexp(p.in[I_CLG][dir * 4 + h] * 128.0f); float r = 0.f;
#pragma unroll
            for (int k = 0; k < NCHUNK; ++k) { const int ch = dir == 0 ? k : (k < 2 ? 1 - k : 35 - k); STB[(size_t)sid_of(0, dir, b, ch, h) * 16384 + idx] = f2bf(r); r = r * gdec + kv[k]; }
        } else {
            const bool do_n = slab == 0 && tid < 128;
            float nv[NCHUNK];
#pragma unroll
            for (int k = 0; k < NCHUNK; ++k) { const int ch = dir == 0 ? k : (k < 2 ? 1 - k : 35 - k); nv[k] = do_n ? NST[(size_t)sid_of(1, dir, b, ch, h) * 128 + tid] : 0.f; }
            float m = -__builtin_inff(), c = 0.f, n = 0.f;
#pragma unroll
            for (int k = 0; k < NCHUNK; ++k) { const int ch = dir == 0 ? k : (k < 2 ? 1 - k : 35 - k); const int sid = sid_of(1, dir, b, ch, h);
                const float me = MEND[sid], be = BEND[sid], mnew = fmaxf(be + m, me), so = fexp(be + m - mnew), sn = fexp(me - mnew);
                STB[(size_t)sid * 16384 + idx] = f2bf(c); c = c * so + kv[k] * sn;
                if (do_n) { NST[(size_t)sid * 128 + tid] = n; n = n * so + nv[k] * sn; }
                if (slab == 0 && tid == 0) MPREV[sid] = m;
                m = mnew; }
        }
    }
}
template <int mixer>
__device__ __forceinline__ void c3_unit(const Params& p, LAS unsigned char* lds, int h, int ch, int b, int row0) {
    const int tid = threadIdx.x, wid = tid >> 6, lane = tid & 63, wr = wid >> 1, wc = wid & 1, fr = lane & 15, fq = lane >> 4;
    LAS bf16_t* Qs = (LAS bf16_t*)(lds + LDS_WORK); LAS bf16_t* Ks = Qs + 128 * LDK; LAS bf16_t* VsT = Ks + 128 * LDK; LAS bf16_t* RT = VsT + 128 * LDK;
    LAS float* fa = (LAS float*)(RT + 128 * LDK);
    LAS float* lfA = fa; LAS float* igA = fa + 256; LAS float* bA = fa + 512; LAS float* miA = fa + 768; LAS float* mtA = fa + 1024; LAS float* sintA = fa + 1280;
    LAS float* rowsum = fa + 1536; LAS float* qn = fa + 2048; LAS float* nA = fa + 2304;
    LAS float* Os = (LAS float*)Qs;
    LAS bf16_t* Pm = Ks;
    const bf16_t* P = (const bf16_t*)(p.ws + WS_P); const float* GT = (const float*)(p.ws + WS_GT); const float* ROPE = (const float*)(p.ws + WS_ROPE);
    const bf16_t* STB = (const bf16_t*)(p.ws + WS_STB); const float* NST = (const float*)(p.ws + WS_NST); const float* MPREV = (const float*)(p.ws + WS_MPREV);
    bf16_t* Y = (bf16_t*)(p.ws + WS_YMIX);
    {
        const int colQ = mixer * 2048 + h * 128; const bool rope = mixer == 0 && ch >= 2;
        {
            u32x2 rawQ[8], rawK[8], rawV[8]; ld_raw(P, row0, colQ, rawQ); ld_raw(P, row0, colQ + 512, rawK); ld_raw(P, row0, colQ + 1024, rawV);
            float lo[16], hi[16];
            cvt_rows(rawQ, rope, (ch - 2) * 128, ROPE, lo, hi); st_rows(Qs, lo, hi, 1.0f);
            cvt_rows(rawK, rope, (ch - 2) * 128, ROPE, lo, hi); st_rows(Ks, lo, hi, 0.08838834764831845f);
            cvt_rows(rawV, false, 0, ROPE, lo, hi); st_rows_T(VsT, lo, hi, 1.0f);
        }
        if (mixer == 1) {
            if (tid < 256) { const int dir = tid >> 7, j = tid & 127, row = row0 + j;
                igA[tid] = GT[row * 16 + dir * 4 + h] + p.in[I_DIB][dir * 4 + h];
                nA[tid] = NST[(size_t)sid_of(1, dir, b, ch, h) * 128 + j];
                bA[tid] = ((const float*)(p.ws + WS_CB))[(size_t)sid_of(1, dir, b, ch, h) * 128 + j]; miA[tid] = ((const float*)(p.ws + WS_CMI))[(size_t)sid_of(1, dir, b, ch, h) * 128 + j]; }
            __syncthreads();
            __syncthreads();
            if (tid < 256) { const int dir = tid >> 7, i = tid & 127; const float mprev = MPREV[sid_of(1, dir, b, ch, h)];
                const float gi = bA[tid] + mprev, mt = fmaxf(gi, miA[tid]); mtA[tid] = mt; sintA[tid] = fexp(gi - mt);
                float s = 0.f;
                for (int d0 = 0; d0 < 128; ++d0) s += bf2f(Qs[i * LDK + d0]) * nA[dir * 128 + d0];
                qn[tid] = s; }
        }
        __syncthreads();
        f32x4 S[2][4]; zero_acc(S);
        mma_128(Qs, Ks, S, wr, wc, lane);
        __syncthreads();
        f32x4 O[2][4]; zero_acc(O);
        if (mixer == 0) {
            const float lg0 = p.in[I_CLG][h], lg1 = p.in[I_CLG][4 + h];
#pragma unroll
            for (int mt = 0; mt < 2; ++mt)
#pragma unroll
                for (int nt = 0; nt < 4; ++nt)
#pragma unroll
                    for (int r = 0; r < 4; ++r) { const int i = wr * 32 + mt * 16 + fq * 4 + r, j = wc * 64 + nt * 16 + fr;
                        const float dcy = (i >= j ? fexp(lg0 * (float)(i - j)) : 0.f) + (j >= i ? fexp(lg1 * (float)(j - i)) : 0.f);
                        Pm[i * LDK + j] = f2bf(S[mt][nt][r] * dcy); }
            __syncthreads();
            mma_128(Pm, VsT, O, wr, wc, lane);
#pragma unroll
            for (int dir = 0; dir < 2; ++dir) {
                { const bf16_t* src = STB + (size_t)sid_of(0, dir, b, ch, h) * 16384 + (tid >> 2) * 128 + (tid & 3) * 32; LAS bf16_t* d = RT + (tid >> 2) * LDK + (tid & 3) * 32;
#pragma unroll
                    for (int q = 0; q < 4; ++q) *(LAS u32x4*)(d + q * 8) = *(const u32x4*)(src + q * 8); }
                __syncthreads();
                f32x4 T[2][4]; zero_acc(T);
                mma_128(Qs, RT, T, wr, wc, lane);
#pragma unroll
                for (int mt = 0; mt < 2; ++mt)
#pragma unroll
                    for (int r = 0; r < 4; ++r) { const int i = wr * 32 + mt * 16 + fq * 4 + r; const float xi = dir == 0 ? fexp(lg0 * (float)(i + 1)) : fexp(lg1 * (float)(128 - i));
#pragma unroll
                        for (int nt = 0; nt < 4; ++nt) O[mt][nt][r] += xi * T[mt][nt][r]; }
                __syncthreads();
            }
        } else {
#pragma unroll
            for (int dir = 0; dir < 2; ++dir) {
                float rp[2][4];
#pragma unroll
                for (int mt = 0; mt < 2; ++mt)
#pragma unroll
                    for (int r = 0; r < 4; ++r) { const int i = wr * 32 + mt * 16 + fq * 4 + r; const float bi = bA[dir * 128 + i] - mtA[dir * 128 + i]; float acc = 0.f;
#pragma unroll
                        for (int nt = 0; nt < 4; ++nt) { const int j = wc * 64 + nt * 16 + fr; const bool valid = dir == 0 ? (j <= i) : (j >= i);
                            const float e = valid ? fexp(bi - bA[dir * 128 + j] + igA[dir * 128 + j]) : 0.f; const float pv = S[mt][nt][r] * e;
                            Pm[i * LDK + j] = f2bf(pv); acc += pv; }
                        rp[mt][r] = row16_sum(acc); }
                if (fr == 0) {
#pragma unroll
                    for (int mt = 0; mt < 2; ++mt)
#pragma unroll
                        for (int r = 0; r < 4; ++r) rowsum[wc * 256 + dir * 128 + wr * 32 + mt * 16 + fq * 4 + r] = rp[mt][r];
                }
                { const bf16_t* src = STB + (size_t)sid_of(1, dir, b, ch, h) * 16384 + (tid >> 2) * 128 + (tid & 3) * 32; LAS bf16_t* d = RT + (tid >> 2) * LDK + (tid & 3) * 32;
#pragma unroll
                    for (int q = 0; q < 4; ++q) *(LAS u32x4*)(d + q * 8) = *(const u32x4*)(src + q * 8); }
                __syncthreads();
                f32x4 T[2][4]; zero_acc(T);
                mma_128(Qs, RT, T, wr, wc, lane);
#pragma unroll
                for (int mt = 0; mt < 2; ++mt)
#pragma unroll
                    for (int r = 0; r < 4; ++r) { const float si = sintA[dir * 128 + wr * 32 + mt * 16 + fq * 4 + r];
#pragma unroll
                        for (int nt = 0; nt < 4; ++nt) T[mt][nt][r] *= si; }
                mma_128(Pm, VsT, T, wr, wc, lane);
#pragma unroll
                for (int mt = 0; mt < 2; ++mt)
#pragma unroll
                    for (int r = 0; r < 4; ++r) { const int i = wr * 32 + mt * 16 + fq * 4 + r; const float si = sintA[dir * 128 + i];
                        float den = (rowsum[dir * 128 + i] + rowsum[256 + dir * 128 + i]) + qn[dir * 128 + i] * si; den = fmaxf(fabsf(den), fexp(-mtA[dir * 128 + i])); const float rden = frcp(den);
#pragma unroll
                        for (int nt = 0; nt < 4; ++nt) O[mt][nt][r] += T[mt][nt][r] * rden; }
                __syncthreads();
            }
        }
#pragma unroll
        for (int mt = 0; mt < 2; ++mt)
#pragma unroll
            for (int nt = 0; nt < 4; ++nt)
#pragma unroll
                for (int r = 0; r < 4; ++r) Os[(wr * 32 + mt * 16 + fq * 4 + r) * 132 + wc * 64 + nt * 16 + fr] = O[mt][nt][r];
        __syncthreads();
        {
            const float* gng = (mixer == 0 ? p.in[I_CGNG] : p.in[I_DGNG]) + h * 128; const float* gnb = (mixer == 0 ? p.in[I_CGNB] : p.in[I_DGNB]) + h * 128;
            const float g0 = gng[lane], g1 = gng[lane + 64], b0 = gnb[lane], b1 = gnb[lane + 64];
#pragma unroll 1
            for (int i4 = 0; i4 < 16; i4 += 4) {
                float qg0[4], qg1[4];
#pragma unroll
                for (int u = 0; u < 4; ++u) { const int row = row0 + wid * 16 + i4 + u; qg0[u] = bf2f(P[(size_t)row * LDP1 + colQ + 1536 + lane]); qg1[u] = bf2f(P[(size_t)row * LDP1 + colQ + 1536 + 64 + lane]); }
#pragma unroll
                for (int u = 0; u < 4; ++u) { const int i = wid * 16 + i4 + u, row = row0 + i;
                    const float x0 = Os[i * 132 + lane], x1 = Os[i * 132 + 64 + lane];
                    const float mean = wave_sum(x0 + x1) * (1.0f / 128.0f), d0 = x0 - mean, d1 = x1 - mean;
                    const float rstd = rsqrtf(wave_sum(d0 * d0 + d1 * d1) * (1.0f / 128.0f) + LN_EPS);
                    const float q0 = qg0[u], q1 = qg1[u];
                    const float s0 = sigm(q0), s1 = sigm(q1);
                    const float y0 = (d0 * rstd * g0 + b0) * (mixer == 0 ? q0 * s0 : s0), y1 = (d1 * rstd * g1 + b1) * (mixer == 0 ? q1 * s1 : s1);
                    Y[(size_t)row * 1024 + mixer * 512 + h * 128 + lane] = f2bf(y0); Y[(size_t)row * 1024 + mixer * 512 + h * 128 + 64 + lane] = f2bf(y1); }
            }
        }
        __syncthreads();
    }
}
__device__ __forceinline__ void ph_c3(const Params& p, LAS unsigned char* lds, int bid, int nblk) {
    for (int u2 = bid; u2 < NB * NCHUNK * 4; u2 += nblk) {
        int mixer, h, ch, b, row0; unit_decode(u2 * 2, mixer, h, ch, b, row0);
        c3_unit<0>(p, lds, h, ch, b, row0);
    }
    for (int u2 = nblk - 1 - bid; u2 < NB * NCHUNK * 4; u2 += nblk) {
        int mixer, h, ch, b, row0; unit_decode(u2 * 2 + 1, mixer, h, ch, b, row0);
        c3_unit<1>(p, lds, h, ch, b, row0);
    }
}
constexpr int NPHASE = 23;
__global__ void __launch_bounds__(NTHR, 2) fwd(Params p) {
    extern __shared__ __attribute__((aligned(16))) unsigned char smem_raw[];
    LAS unsigned char* lds = (LAS unsigned char*)smem_raw;
    if (threadIdx.x == 0) { LAS unsigned* st = (LAS unsigned*)(lds + LDS_BAR); st[0] = 0u; st[1] = 0u; st[2] = 0u; st[3] = 0u; }
    __syncthreads();
    XcdBarrier bar = xcd_barrier_post((unsigned*)(p.ws + WS_CTL), (volatile LAS unsigned*)(lds + LDS_BAR));
    const int bid = blockIdx.x, nblk = gridDim.x;
    unsigned char* ws = p.ws;
#ifndef PHASE_ONLY
#define PHASE_ONLY -1
#endif
#ifndef DBL_MASK
#define DBL_MASK 0u
#endif
#define PHASE(k, call) if constexpr (PHASE_ONLY < 0 || PHASE_ONLY == (k)) { if (p.lo <= (k) && (k) < p.hi) { call; if constexpr ((DBL_MASK >> (k)) & 1u) { xcd_barrier(bar); call; } if ((k) + 1 < p.hi) xcd_barrier(bar); } }
    PHASE(0, ph_prologue(p, lds, bid, nblk))
    PHASE(1, ph_mod_in(p, bid, nblk))
    PHASE(2, ph_gemm_dense<12>(lds, (const bf16_t*)(ws + WS_H), (const bf16_t*)(ws + WS_WIN0T), (bf16_t*)(ws + WS_P), LDP0, 0, 68, bid, nblk))
    PHASE(3, ph_prep_even(p, lds, bid, nblk))
    PHASE(4, ph_r1(p, lds, bid, nblk))
    PHASE(5, ph_r2(p, lds, bid, nblk))
    PHASE(6, ph_fin_even(p, bid, nblk))
    PHASE(7, ph_gemm_dense<4>(lds, (const bf16_t*)(ws + WS_YMIX), (const bf16_t*)(ws + WS_WOUTT), (bf16_t*)(ws + WS_YP), 1024, 0, 68, bid, nblk))
    PHASE(8, ph_ln1<0>(p, lds, bid, nblk))
    PHASE(9, ph_moe_gather<0>(p, lds, bid, nblk))
    PHASE(10, ph_moe_gemm1<0>(p, lds, bid, nblk))
    PHASE(11, ph_moe_gemm2<0>(p, lds, bid, nblk))
    PHASE(12, ph_ln2<0>(p, lds, bid, nblk))
    PHASE(13, ph_gemm_dense<16>(lds, (const bf16_t*)(ws + WS_H), (const bf16_t*)(ws + WS_WIN1T), (bf16_t*)(ws + WS_P), LDP1, 0, 68, bid, nblk))
    PHASE(14, ph_c1(p, lds, bid, nblk))
    PHASE(15, ph_c2(p, bid, nblk))
    PHASE(16, ph_c3(p, lds, bid, nblk))
    PHASE(17, ph_gemm_dense<4>(lds, (const bf16_t*)(ws + WS_YMIX), (const bf16_t*)(ws + WS_WOUTT) + (size_t)1024 * 1024, (bf16_t*)(ws + WS_YP), 1024, 4, 64, bid, nblk))
    PHASE(18, ph_ln1<1>(p, lds, bid, nblk))
    PHASE(19, ph_moe_gather<1>(p, lds, bid, nblk))
    PHASE(20, ph_moe_gemm1<1>(p, lds, bid, nblk))
    PHASE(21, ph_moe_gemm2<1>(p, lds, bid, nblk))
    PHASE(22, ph_ln2<1>(p, lds, bid, nblk))
#undef PHASE
}

#ifndef MK_ONE_LAUNCH
#define MK_ONE_LAUNCH 1
#endif
extern "C" void kernel_launch(void* const* d_in, const int* in_sizes, int n_in, void* d_out, int out_size, void* d_ws, size_t ws_size, hipStream_t stream) {
    static int grid = 0;
    if (grid == 0) {
        if (n_in != N_INPUTS || out_size != NB * SEQL * DM || ws_size < WS_TOTAL) { fprintf(stderr, "kernel_launch: unexpected problem (n_in %d, out %d, ws %zu < %zu)\n", n_in, out_size, ws_size, (size_t)WS_TOTAL); grid = -1; return; }
        int dev = 0, cus = 0, per_cu = 0;
        if (hipGetDevice(&dev) != hipSuccess || hipDeviceGetAttribute(&cus, hipDeviceAttributeMultiprocessorCount, dev) != hipSuccess) { grid = -1; return; }
        if (hipFuncSetAttribute((const void*)fwd, hipFuncAttributeMaxDynamicSharedMemorySize, LDS_BYTES) != hipSuccess) { fprintf(stderr, "kernel_launch: hipFuncSetAttribute failed\n"); grid = -1; return; }
        if (hipOccupancyMaxActiveBlocksPerMultiprocessor(&per_cu, (const void*)fwd, NTHR, LDS_BYTES) != hipSuccess || per_cu < 1) { fprintf(stderr, "kernel_launch: occupancy query says %d\n", per_cu); (void)hipGetLastError(); per_cu = 1; }
        grid = cus;
    }
    if (grid < 0) return;
    (void)hipMemsetAsync((char*)d_ws + WS_CTL, 0, CTL_BYTES, stream);
    Params p{};
    for (int i = 0; i < N_INPUTS; ++i) p.in[i] = (const float*)d_in[i];
    p.out = (float*)d_out; p.ws = (unsigned char*)d_ws;
#if MK_ONE_LAUNCH
    p.lo = 0; p.hi = NPHASE;
    hipLaunchKernelGGL(fwd, dim3(grid), dim3(NTHR), LDS_BYTES, stream, p);
#else
    for (int k = 0; k < NPHASE; ++k) { p.lo = k; p.hi = k + 1; hipLaunchKernelGGL(fwd, dim3(grid), dim3(NTHR), LDS_BYTES, stream, p); }
#endif
}
```

```cpp
#include <hip/hip_runtime.h>
#include <stdint.h>
#include <stdio.h>

#define LAS __attribute__((address_space(3)))
typedef unsigned short bf16_t;
typedef short bf16x8 __attribute__((ext_vector_type(8)));
typedef float f32x4 __attribute__((ext_vector_type(4)));
typedef float f32x2 __attribute__((ext_vector_type(2)));
typedef unsigned u32x4 __attribute__((ext_vector_type(4)));
typedef unsigned u32x2 __attribute__((ext_vector_type(2)));

constexpr int NB = 4, SEQL = 4096, CTXL = 256, DM = 1024;
constexpr int NCTX = NB * CTXL;
constexpr int MROWS = NCTX + NB * SEQL;
constexpr int NTHR = 512;
constexpr int LDP0 = 3072, LDP1 = 4096;
constexpr int A_IN = 1920, EVEN_IN = 2944, ODD_IN = 4112;
constexpr int NEXP = 32, DFF = 1024;
constexpr int MOE_ROWS_MAX = 69632 + 32 * 256;
constexpr float DN_ALPHA = 1.41421356237309515f;
constexpr float LN_EPS = 1e-5f;
constexpr int NCHUNK = 34;

enum { I_X = 0, I_C, I_CTX, I_CCTX, I_WMOD, I_BMOD, I_LNG, I_LNB, I_EWIN, I_EWOUT, I_AMU, I_AW0, I_AWB, I_AA0, I_AAB, I_AGB, I_AKK, I_AKA, I_ARK,
       I_AGNG, I_AGNB, I_BCW, I_BCB, I_BGW, I_BGB, I_BLAM, I_OWIN, I_OWOUT, I_CLG, I_CGNG, I_CGNB, I_DIB, I_DFB, I_DGNG, I_DGNB, I_RW, I_RB,
       I_W1, I_B1, I_W2, I_B2, N_INPUTS };

constexpr size_t al256(size_t x) { return (x + 255) & ~(size_t)255; }
constexpr size_t WS_CTL   = 0;
constexpr size_t CTL_BYTES = 65536;
constexpr size_t CTL_CNT  = 16384;
constexpr size_t WS_MOD   = WS_CTL + CTL_BYTES;
constexpr size_t WS_ROPE  = WS_MOD + al256((size_t)2 * 5 * 6144 * 4);
constexpr size_t WS_WIN0T = WS_ROPE + 16384;
constexpr size_t WS_WIN1T = WS_WIN0T + (size_t)3072 * 1024 * 2;
constexpr size_t WS_WOUTT = WS_WIN1T + (size_t)4096 * 1024 * 2;
constexpr size_t WS_W1T   = WS_WOUTT + (size_t)2 * 1024 * 1024 * 2;
constexpr size_t WS_W2T   = WS_W1T + (size_t)2 * 32 * 2048 * 1024 * 2;
constexpr size_t WS_XS    = WS_W2T + (size_t)2 * 32 * 1024 * 1024 * 2;
constexpr size_t WS_H     = WS_XS + (size_t)MROWS * 1024 * 4;
constexpr size_t WS_YMIX  = WS_H + (size_t)MROWS * 1024 * 2;
constexpr size_t WS_YP    = WS_YMIX + (size_t)MROWS * 1024 * 2;
constexpr size_t WS_GT    = WS_YP + (size_t)MROWS * 1024 * 4;
constexpr size_t WS_TOPE  = WS_GT + (size_t)MROWS * 16 * 4;
constexpr size_t WS_TOPW  = WS_TOPE + (size_t)MROWS * 16;
constexpr size_t WS_TOPS  = WS_TOPW + (size_t)MROWS * 16;
constexpr size_t WS_POS   = WS_TOPS + (size_t)MROWS * 16;
constexpr size_t WS_CNTB  = WS_POS + (size_t)MROWS * 16;
constexpr size_t WS_WLT   = WS_CNTB + (size_t)2 * 512 * 32 * 4;
constexpr size_t WLT_WB = 0, WLT_AB = 65536, WLT_GB = 131072, WLT_GW = 196608, WLT_N = 327680;
constexpr size_t WS_P     = WS_WLT + (size_t)WLT_N * 2;
constexpr size_t WS_BIG   = WS_P + (size_t)MROWS * 4096 * 4;
constexpr size_t ARR512   = (size_t)MROWS * 512 * 4;
constexpr int SCREC = 448;
constexpr int SCLEN = CTXL + SEQL;
constexpr size_t WS_SC    = WS_BIG;
enum { E_G = 0, E_O0, E_O1, E_A0, E_A1, E_BX0, E_BX1, E_GATE, E_NARR };
constexpr size_t WS_EARR  = WS_SC + (size_t)64 * SCLEN * SCREC * 2;
constexpr size_t WS_BC    = WS_EARR + (size_t)E_NARR * ARR512;
constexpr size_t WS_CHA   = WS_BC + (size_t)MROWS * 8 * 4;
constexpr size_t WS_CHH   = WS_CHA + (size_t)2 * 512 * 512 * 4;
constexpr size_t WS_CIN   = WS_CHH + (size_t)2 * 512 * 512 * 4;
constexpr int RCH = 64, NRCH = SCLEN / RCH, NRUNIT = 64 * NRCH;
constexpr size_t WS_RU    = WS_CIN + (size_t)2 * 512 * 512 * 4;
constexpr size_t WS_EEND  = WS_RU + (size_t)NRUNIT * 4 * 4096 * 4;
constexpr int NSID = 2 * 2 * NB * NCHUNK * 4;
constexpr size_t WS_ST    = WS_BIG;
constexpr size_t WS_NST   = WS_ST + (size_t)NSID * 16384 * 4;
constexpr size_t WS_MEND  = WS_NST + (size_t)NSID * 128 * 4;
constexpr size_t WS_BEND  = WS_MEND + al256((size_t)NSID * 4);
constexpr size_t WS_MPREV = WS_BEND + al256((size_t)NSID * 4);
constexpr size_t WS_CB    = WS_MPREV + al256((size_t)NSID * 4);
constexpr size_t WS_CMI   = WS_CB + (size_t)NSID * 128 * 4;
constexpr size_t WS_STB   = WS_CMI + (size_t)NSID * 128 * 4;
constexpr size_t WS_OEND  = WS_STB + (size_t)NSID * 16384 * 2;
constexpr size_t WS_ASORT = WS_BIG;
constexpr size_t WS_ACT   = WS_ASORT + (size_t)MOE_ROWS_MAX * 1024 * 2;
constexpr size_t WS_YE    = WS_ACT + (size_t)MOE_ROWS_MAX * 1024 * 2;
constexpr size_t WS_MEND_ = WS_YE + (size_t)MOE_ROWS_MAX * 1024 * 4;
constexpr size_t WS_TOTAL = (WS_EEND > WS_MEND_ ? (WS_EEND > WS_OEND ? WS_EEND : WS_OEND) : (WS_MEND_ > WS_OEND ? WS_MEND_ : WS_OEND));

constexpr int LDS_BYTES = 155648;
constexpr int LDS_BAR = 0;
constexpr int LDS_WORK = 1024;

struct Params {
    const float* in[N_INPUTS];
    float* out;
    unsigned char* ws;
    int lo, hi;
};

typedef __bf16 nbf16x2 __attribute__((ext_vector_type(2)));
__device__ __forceinline__ unsigned pack_bf16(float lo, float hi) { const nbf16x2 v = {(__bf16)lo, (__bf16)hi}; return __builtin_bit_cast(unsigned, v); }
__device__ __forceinline__ bf16_t f2bf(float f) { return __builtin_bit_cast(bf16_t, (__bf16)f); }
__device__ __forceinline__ float bf2f(bf16_t b) { return __uint_as_float(((unsigned)b) << 16); }
__device__ __forceinline__ f32x4 ld_bf16x4(const bf16_t* p) { const u32x2 w = *(const u32x2*)p; return (f32x4){__uint_as_float(w.x << 16), __uint_as_float(w.x & 0xffff0000u), __uint_as_float(w.y << 16), __uint_as_float(w.y & 0xffff0000u)}; }
__device__ __forceinline__ float fexp(float x) { return __builtin_amdgcn_exp2f(x * 1.4426950408889634f); }
__device__ __forceinline__ float frcp(float x) { return __builtin_amdgcn_rcpf(x); }
__device__ __forceinline__ float fsqrt(float x) { return __builtin_amdgcn_sqrtf(x); }
__device__ __forceinline__ float sigm(float x) { return frcp(1.0f + fexp(-x)); }
__device__ __forceinline__ float ftanh(float x) { const float e = fexp(-2.0f * fabsf(x)), t = (1.0f - e) * frcp(1.0f + e); return x < 0.f ? -t : t; }
__device__ __forceinline__ float fexpm1_neg(float x) {
    const float p = x * (1.0f + x * (0.5f + x * (0.16666667f + x * (0.041666668f + x * 0.0083333338f))));
    return x > -0.25f ? p : fexp(x) - 1.0f; }
__device__ __forceinline__ float softplusf(float x) { return fmaxf(x, 0.f) + log1pf(expf(-fabsf(x))); }
__device__ __forceinline__ float wave_sum(float v) {
    v += __int_as_float(__builtin_amdgcn_update_dpp(0, __float_as_int(v), 0x121, 0xf, 0xf, false));
    v += __int_as_float(__builtin_amdgcn_update_dpp(0, __float_as_int(v), 0x122, 0xf, 0xf, false));
    v += __int_as_float(__builtin_amdgcn_update_dpp(0, __float_as_int(v), 0x124, 0xf, 0xf, false));
    v += __int_as_float(__builtin_amdgcn_update_dpp(0, __float_as_int(v), 0x128, 0xf, 0xf, false));
    v += __int_as_float(__builtin_amdgcn_update_dpp(0, __float_as_int(v), 0x142, 0xa, 0xf, false));
    v += __int_as_float(__builtin_amdgcn_update_dpp(0, __float_as_int(v), 0x143, 0xc, 0xf, false));
    return __int_as_float(__builtin_amdgcn_readlane(__float_as_int(v), 63));
}
__device__ __forceinline__ float wave_max(float v) {
    const int ninf = 0xff800000;
    v = fmaxf(v, __int_as_float(__builtin_amdgcn_update_dpp(ninf, __float_as_int(v), 0x121, 0xf, 0xf, false)));
    v = fmaxf(v, __int_as_float(__builtin_amdgcn_update_dpp(ninf, __float_as_int(v), 0x122, 0xf, 0xf, false)));
    v = fmaxf(v, __int_as_float(__builtin_amdgcn_update_dpp(ninf, __float_as_int(v), 0x124, 0xf, 0xf, false)));
    v = fmaxf(v, __int_as_float(__builtin_amdgcn_update_dpp(ninf, __float_as_int(v), 0x128, 0xf, 0xf, false)));
    v = fmaxf(v, __int_as_float(__builtin_amdgcn_update_dpp(ninf, __float_as_int(v), 0x142, 0xa, 0xf, false)));
    v = fmaxf(v, __int_as_float(__builtin_amdgcn_update_dpp(ninf, __float_as_int(v), 0x143, 0xc, 0xf, false)));
    return __int_as_float(__builtin_amdgcn_readlane(__float_as_int(v), 63));
}
__device__ __forceinline__ int wave_min_i(int v) {
    const int big = 0x7fffffff;
    v = min(v, __builtin_amdgcn_update_dpp(big, v, 0x121, 0xf, 0xf, false));
    v = min(v, __builtin_amdgcn_update_dpp(big, v, 0x122, 0xf, 0xf, false));
    v = min(v, __builtin_amdgcn_update_dpp(big, v, 0x124, 0xf, 0xf, false));
    v = min(v, __builtin_amdgcn_update_dpp(big, v, 0x128, 0xf, 0xf, false));
    v = min(v, __builtin_amdgcn_update_dpp(big, v, 0x142, 0xa, 0xf, false));
    v = min(v, __builtin_amdgcn_update_dpp(big, v, 0x143, 0xc, 0xf, false));
    return __builtin_amdgcn_readlane(v, 63);
}
__device__ __forceinline__ float row16_sum(float v) {
    v += __int_as_float(__builtin_amdgcn_update_dpp(0, __float_as_int(v), 0x121, 0xf, 0xf, false));
    v += __int_as_float(__builtin_amdgcn_update_dpp(0, __float_as_int(v), 0x122, 0xf, 0xf, false));
    v += __int_as_float(__builtin_amdgcn_update_dpp(0, __float_as_int(v), 0x124, 0xf, 0xf, false));
    v += __int_as_float(__builtin_amdgcn_update_dpp(0, __float_as_int(v), 0x128, 0xf, 0xf, false));
    return v;
}
__device__ __forceinline__ int row_batch(int row) { return row < NCTX ? (row >> 8) : ((row - NCTX) >> 12); }
__device__ __forceinline__ int row_modr(int row) { return row < NCTX ? 4 : ((row - NCTX) >> 12); }
#define XB_TMO      128
#define XB_XCNT(j)  (256  + 64 * (j))
#define XB_XSUB(j)  (1280 + 64 * (j))
#define XB_XGEN(j)  (2304 + 64 * (j))
#define XB_TOP      3328
#define XB_TOPGEN   3392
#define XCD_BAR_WORDS 3456
#define XB_SPIN_CAP (1u << 18)

__device__ __forceinline__ unsigned xb_ld(unsigned* p)              { return __hip_atomic_load(p, __ATOMIC_RELAXED, __HIP_MEMORY_SCOPE_AGENT); }
__device__ __forceinline__ unsigned xb_add(unsigned* p, unsigned v) { return __hip_atomic_fetch_add(p, v, __ATOMIC_RELAXED, __HIP_MEMORY_SCOPE_AGENT); }
__device__ __forceinline__ unsigned xb_xcc_id() { return (unsigned)__builtin_amdgcn_s_getreg((3 << 11) | 20) & 0xFu; }
#define XB_SPIN(cond, bar) do { unsigned _sp = 0; while (cond) { __builtin_amdgcn_s_sleep(1); \
    if ((++_sp & 255u) == 0u) { if (xb_ld(&(bar)[XB_TMO])) break; if (_sp > XB_SPIN_CAP) { atomicAdd(&(bar)[XB_TMO], 1u); break; } } } } while (0)

struct XcdBarrier {
    unsigned* bar; unsigned x;
    volatile LAS unsigned* st;
};

__device__ __forceinline__ XcdBarrier xcd_barrier_post(unsigned* bar, volatile LAS unsigned* st) {
    XcdBarrier b; b.bar = bar; b.x = xb_xcc_id(); b.st = st;
    if (threadIdx.x == 0) (void)xb_add(&bar[XB_XCNT(b.x)], 1u);
    return b;
}
__device__ __forceinline__ void xcd_barrier_complete(unsigned* bar, unsigned x, unsigned& nloc, unsigned& nx) {
    const unsigned G = gridDim.x * gridDim.y * gridDim.z;
    unsigned sum, cnt, mine, sp = 0u;
    for (;;) {
        sum = 0u; cnt = 0u; mine = 0u;
#pragma unroll
        for (unsigned j = 0; j < 16; ++j) { const unsigned c = xb_ld(&bar[XB_XCNT(j)]); sum += c; cnt += (c > 0u) ? 1u : 0u; mine = (j == x) ? c : mine; }
        if (sum == G) break;
        __builtin_amdgcn_s_sleep(1);
        if ((++sp & 255u) == 0u) { if (xb_ld(&bar[XB_TMO])) break; if (sp > XB_SPIN_CAP) { atomicAdd(&bar[XB_TMO], 1u); break; } }
    }
    nloc = mine > 0u ? mine : 1u; nx = cnt > 0u ? cnt : 1u;
}

__device__ __forceinline__ void xcd_barrier(const XcdBarrier& b) {
    asm volatile("s_waitcnt vmcnt(0)" ::: "memory");
    __syncthreads();
    if (threadIdx.x == 0) {
        unsigned* bar = b.bar;
        __builtin_amdgcn_s_waitcnt(0);
        unsigned nloc = b.st[0], nx = b.st[1];
        if (nloc == 0u) { xcd_barrier_complete(bar, b.x, nloc, nx); b.st[0] = nloc; b.st[1] = nx; }
        const unsigned old = xb_add(&bar[XB_XSUB(b.x)], 1u);
        const unsigned gen = old / nloc;
        if (old + 1u == (gen + 1u) * nloc) {
            __builtin_amdgcn_fence(__ATOMIC_RELEASE, "agent");
            asm volatile("s_waitcnt vmcnt(0)" ::: "memory");
            const unsigned og = xb_add(&bar[XB_TOP], 1u);
            const unsigned tg = og / nx;
            if (og + 1u == (tg + 1u) * nx) xb_add(&bar[XB_TOPGEN], 1u);
            else XB_SPIN(xb_ld(&bar[XB_TOPGEN]) == tg, bar);
            __builtin_amdgcn_fence(__ATOMIC_ACQUIRE, "agent");
            xb_add(&bar[XB_XGEN(b.x)], 1u);
            asm volatile("s_waitcnt vmcnt(0)" ::: "memory");
        } else {
            XB_SPIN(xb_ld(&bar[XB_XGEN(b.x)]) == gen, bar);
            __builtin_amdgcn_fence(__ATOMIC_ACQUIRE, "agent");
            asm volatile("s_waitcnt vmcnt(0)" ::: "memory");
        }
    }
    __syncthreads();
}
namespace pg8 {
constexpr int BM = 256, BK = 64, HALF = 128, HTB = HALF * BK * 2  , STAGE_BYTES = 8 * HTB, NXCD = 8, WGM = 8;

__host__ __device__ __forceinline__ int lds_byte(int r, int c) { const int st = (r >> 4) * 2 + (c >> 5), rr = r & 15, cc = c & 31, ob = rr * 64 + cc * 2; return st * 1024 + (ob ^ (((ob >> 9) & 1) << 5)); }
__host__ __device__ __forceinline__ void stage_rc(int b, int& R, int& C) { const int st = b / 1024, sb = b % 1024, swz = sb ^ (((sb >> 9) & 1) << 5); R = (st >> 1) * 16 + swz / 64; C = (st & 1) * 32 + (swz % 64) / 2; }
__host__ __device__ __forceinline__ int perm32(int rho) { const int n = rho >> 4, i = rho & 15; return 8 * (i >> 2) + 4 * n + (i & 3); }

struct Unit { int pm, pn; };
struct Gemm { const bf16_t* A; const bf16_t* Bt; int M, N, K; };
__device__ __forceinline__ unsigned cvt_pk_bf16(float lo, float hi) { return pack_bf16(lo, hi); }
template <class Epi, class Sched, bool STAMP = false, bool ATILED = false, bool BTILED = false>
__device__ __forceinline__ void gemm_phase(LAS unsigned char* lds, const Gemm g, const Sched& S, const Epi& E, unsigned long long* stamps) {
    const int tid = threadIdx.x, wid = __builtin_amdgcn_readfirstlane(tid >> 6), lane = tid & 63, wr = wid >> 2, wc = wid & 3, fr = lane & 15, fq = lane >> 4;
    const int K = g.K, nt = K / BK;
    int ts_lo = 0, ts_hi = 0, nts = 0; const unsigned long long rt_entry = STAMP ? (unsigned long long)wall_clock64() : 0ull;
#define PG8_STAMP() do { if (STAMP && wid == 0 && nts < 64) { const unsigned long long _c = (unsigned long long)clock64(); \
        ts_lo = (lane == nts) ? (int)(unsigned)_c : ts_lo; ts_hi = (lane == nts) ? (int)(unsigned)(_c >> 32) : ts_hi; ++nts; } } while (0)
    PG8_STAMP();
    unsigned voffA[2], voffB[2];
#pragma unroll
    for (int i = 0; i < 2; ++i) { int R, C; stage_rc(tid * 16 + i * 8192, R, C); const int Rb = Epi::PERM ? ((R & ~31) + perm32(R & 31)) : R;
        voffA[i] = (unsigned)(R * (ATILED ? BK : K) + C) * 2u; voffB[i] = (unsigned)(Rb * (BTILED ? BK : K) + C) * 2u; }
    const size_t kstepA = ATILED ? (size_t)BM * BK * 2 : (size_t)(BK * 2), kstepB = BTILED ? (size_t)BM * BK * 2 : (size_t)(BK * 2);
    const size_t hstepA = ATILED ? (size_t)HALF * BK * 2 : (size_t)HALF * K * 2, hstepB = BTILED ? (size_t)HALF * BK * 2 : (size_t)HALF * K * 2;
    const size_t tstep = (size_t)BM * K * 2;
    const unsigned ldsw = (unsigned)wid * 1024u;
    const int aoff = lds_byte(wr * 64 + fr, fq * 8), boff = lds_byte(wc * 32 + fr, fq * 8);
#define PG8_SA(b, h) (((b) * 2 + (h)) * HTB)
#define PG8_SB(b, h) ((4 + (b) * 2 + (h)) * HTB)
#define PG8_STAGE(bufoff, gbase, voff) do { _Pragma("unroll") for (int _i = 0; _i < 2; ++_i) \
        __builtin_amdgcn_global_load_lds((const unsigned*)((const char*)(gbase) + (voff)[_i]), (LAS unsigned*)(lds + (bufoff) + ldsw + _i * 8192), 16, 0, 0); } while (0)
#define PG8_LDA(dst, b, h) do { _Pragma("unroll") for (int m = 0; m < 4; ++m) _Pragma("unroll") for (int k = 0; k < 2; ++k) dst[m][k] = *(const LAS bf16x8*)(lds + PG8_SA(b, h) + aoff + m * 2048 + k * 1024); } while (0)
#define PG8_LDB(dst, b, h) do { _Pragma("unroll") for (int n = 0; n < 2; ++n) _Pragma("unroll") for (int k = 0; k < 2; ++k) dst[n][k] = *(const LAS bf16x8*)(lds + PG8_SB(b, h) + boff + n * 2048 + k * 1024); } while (0)
#define PG8_MMA(ai, bj, At, Bt) do { __builtin_amdgcn_s_setprio(1); _Pragma("unroll") for (int m = 0; m < 4; ++m) _Pragma("unroll") for (int n = 0; n < 2; ++n) _Pragma("unroll") for (int k = 0; k < 2; ++k) \
        acc[ai][bj][m][n] = __builtin_amdgcn_mfma_f32_16x16x32_bf16(Bt[n][k], At[m][k], acc[ai][bj][m][n], 0, 0, 0); __builtin_amdgcn_s_setprio(0); } while (0)
#define PG8_WAIT_V(n) asm volatile("s_waitcnt vmcnt(" #n ")" ::: "memory")
#define PG8_WAIT_L(n) asm volatile("s_waitcnt lgkmcnt(" #n ")" ::: "memory")
#define PG8_BAR __builtin_amdgcn_s_barrier()
#define PG8_SCHED __builtin_amdgcn_sched_barrier(0)
    Unit cur, nxt; int ui = 0;
    if (!S.next(0, cur)) return;
    f32x4 acc[2][2][4][2];
#pragma unroll
    for (int a = 0; a < 2; ++a)
#pragma unroll
        for (int b = 0; b < 2; ++b)
#pragma unroll
            for (int m = 0; m < 4; ++m)
#pragma unroll
                for (int n = 0; n < 2; ++n) acc[a][b][m][n] = (f32x4){0.f, 0.f, 0.f, 0.f};
    bf16x8 At[4][2], B0[2][2], B1[2][2];
    const char* cA = (const char*)g.A + (size_t)cur.pm * tstep; const char* cB = (const char*)g.Bt + (size_t)cur.pn * tstep;
    S.a_ready(cur);
    PG8_STAGE(PG8_SB(0, 0), cB, voffB); PG8_STAGE(PG8_SA(0, 0), cA, voffA); PG8_STAGE(PG8_SB(0, 1), cB + hstepB, voffB); PG8_STAGE(PG8_SA(0, 1), cA + hstepA, voffA);
    if (wr == 1) PG8_BAR;
    PG8_WAIT_V(4); PG8_BAR;
    PG8_STAGE(PG8_SB(1, 0), cB + kstepB, voffB); PG8_STAGE(PG8_SA(1, 0), cA + kstepA, voffA); PG8_STAGE(PG8_SB(1, 1), cB + hstepB + kstepB, voffB);
    PG8_WAIT_V(6); PG8_BAR;
    PG8_STAMP();
    for (;;) {
        const bool has_next = S.next(ui + 1, nxt);
        const char* nA = has_next ? (const char*)g.A + (size_t)nxt.pm * tstep : cA; const char* nB = has_next ? (const char*)g.Bt + (size_t)nxt.pn * tstep : cB;
        E.pre(lds, ui & 1, cur, wid, lane);
        for (int t = 0; t < nt; t += 2) {
            const bool last = (t == nt - 2);
            const char* a1 = cA + (size_t)(t + 1) * kstepA;
            const char* a2 = last ? nA : cA + (size_t)(t + 2) * kstepA; const char* b2 = last ? nB : cB + (size_t)(t + 2) * kstepB;
            const char* a3 = a2 + kstepA; const char* b3 = b2 + kstepB;
            if (last && has_next) S.a_ready(nxt);
            PG8_LDB(B0, 0, 0); PG8_SCHED; PG8_LDA(At, 0, 0); PG8_STAGE(PG8_SA(1, 1), a1 + hstepA, voffA);
            PG8_WAIT_L(8); PG8_BAR; PG8_WAIT_L(0); PG8_MMA(0, 0, At, B0); PG8_BAR; PG8_SCHED;
            PG8_LDB(B1, 0, 1); PG8_STAGE(PG8_SB(0, 0), b2, voffB);
            PG8_BAR; PG8_WAIT_L(0); PG8_MMA(0, 1, At, B1); PG8_BAR;
            PG8_LDA(At, 0, 1); PG8_STAGE(PG8_SA(0, 0), a2, voffA);
            PG8_BAR; PG8_WAIT_L(0); PG8_MMA(1, 0, At, B0); PG8_BAR; PG8_SCHED;
            PG8_STAGE(PG8_SB(0, 1), b2 + hstepB, voffB);
            PG8_WAIT_V(6); PG8_BAR; PG8_MMA(1, 1, At, B1); PG8_BAR;
            PG8_LDB(B0, 1, 0); PG8_SCHED; PG8_LDA(At, 1, 0); PG8_STAGE(PG8_SA(0, 1), a2 + hstepA, voffA);
            PG8_WAIT_L(8); PG8_BAR; PG8_WAIT_L(0); PG8_MMA(0, 0, At, B0); PG8_BAR; PG8_SCHED;
            PG8_LDB(B1, 1, 1); PG8_STAGE(PG8_SB(1, 0), b3, voffB);
            PG8_BAR; PG8_WAIT_L(0); PG8_MMA(0, 1, At, B1); PG8_BAR;
            PG8_LDA(At, 1, 1); PG8_STAGE(PG8_SA(1, 0), a3, voffA);
            PG8_BAR; PG8_WAIT_L(0); PG8_MMA(1, 0, At, B0); PG8_BAR; PG8_SCHED;
            PG8_STAGE(PG8_SB(1, 1), b3 + hstepB, voffB);
            PG8_WAIT_V(6); PG8_BAR; PG8_MMA(1, 1, At, B1); PG8_BAR;
        }
        PG8_STAMP();
        if constexpr (!Epi::AFTER_DRAIN) { E(acc, cur, wr, wc, fr, fq, lds, ui & 1); S.done(cur); }
        PG8_STAMP();
        if (!has_next) break;
#pragma unroll
        for (int a = 0; a < 2; ++a)
#pragma unroll
            for (int b = 0; b < 2; ++b)
#pragma unroll
                for (int m = 0; m < 4; ++m)
#pragma unroll
                    for (int n = 0; n < 2; ++n) acc[a][b][m][n] = (f32x4){0.f, 0.f, 0.f, 0.f};
        cur = nxt; cA = nA; cB = nB; ++ui;
    }
    PG8_WAIT_V(0);
    if (wr == 0) PG8_BAR;
    PG8_BAR;
    if constexpr (Epi::AFTER_DRAIN) { E.fused(acc, cur, wr, wc, fr, fq, lds, wid, lane); S.done(cur); }
    PG8_STAMP();
    if (STAMP && wid == 0) { stamps[lane] = lane < nts ? (((unsigned long long)(unsigned)ts_hi << 32) | (unsigned)ts_lo) : 0ull;
        if (lane == 62) stamps[62] = rt_entry; if (lane == 63) stamps[63] = (unsigned long long)wall_clock64(); }
#undef PG8_STAMP
#undef PG8_SA
#undef PG8_SB
#undef PG8_STAGE
#undef PG8_LDA
#undef PG8_LDB
#undef PG8_MMA
#undef PG8_WAIT_V
#undef PG8_WAIT_L
#undef PG8_BAR
#undef PG8_SCHED
}
__device__ __forceinline__ int xcd_contig(long L, int nwg) { const int q = nwg / NXCD, r = nwg % NXCD, xcd = (int)(L % NXCD), off = (int)(L / NXCD); return (xcd < r ? xcd * (q + 1) : r * (q + 1) + (xcd - r) * q) + off; }
template <int nN>
struct SchedDense {
    int nM, pm0, G, c;
    __device__ __forceinline__ bool next(int i, Unit& u) const {
        const long L = (long)i * G + c; const int nwg = nM * nN; if (L >= nwg) return false;
        const int wgid = xcd_contig(L, nwg);
        constexpr int nig = WGM * nN; const int gid = wgid / nig, fm = gid * WGM, gsz = (nM - fm) < WGM ? (nM - fm) : WGM, w = wgid % nig;
        if (gsz == WGM) { u.pm = pm0 + fm + (w & (WGM - 1)); u.pn = w >> 3; } else { u.pm = pm0 + fm + (w % gsz); u.pn = w / gsz; }
        return true; }
    __device__ __forceinline__ void a_ready(const Unit&) const {}
    __device__ __forceinline__ void done(const Unit&) const {}
};
template <int nN>
struct SchedMoe {
    int T, G, c; const LAS int* tileE;
    __device__ __forceinline__ bool next(int i, Unit& u) const { const long L = (long)i * G + c; const int nwg = T * nN; if (L >= nwg) return false;
        const int wgid = xcd_contig(L, nwg), pt = wgid / nN; u.pm = pt; u.pn = tileE[pt] * nN + (wgid % nN); return true; }
    __device__ __forceinline__ void a_ready(const Unit&) const {}
    __device__ __forceinline__ void done(const Unit&) const {}
};
constexpr int EPI_BIAS_OFF = STAGE_BYTES + 8192;
struct EpiStore {
    static constexpr bool PERM = true, AFTER_DRAIN = false;
    bf16_t* O; int ldc;
    __device__ __forceinline__ void pre(LAS unsigned char*, int, const Unit&, int, int) const {}
    __device__ __forceinline__ void operator()(const f32x4 (&acc)[2][2][4][2], const Unit& u, int wr, int wc, int fr, int fq, const LAS unsigned char*, int) const {
        const int row0 = u.pm * BM + wr * 64 + fr, col0 = u.pn * BM + wc * 32 + 8 * fq;
#pragma unroll
        for (int ai = 0; ai < 2; ++ai)
#pragma unroll
            for (int m = 0; m < 4; ++m) { bf16_t* rowp = O + (size_t)(row0 + ai * HALF + m * 16) * ldc + col0;
#pragma unroll
                for (int bj = 0; bj < 2; ++bj) { const f32x4 v0 = acc[ai][bj][m][0], v1 = acc[ai][bj][m][1];
                    u32x4 w; w.x = cvt_pk_bf16(v0[0], v0[1]); w.y = cvt_pk_bf16(v0[2], v0[3]); w.z = cvt_pk_bf16(v1[0], v1[1]); w.w = cvt_pk_bf16(v1[2], v1[3]);
                    *(u32x4*)(rowp + bj * HALF) = w; } }
    }
};
struct EpiYE {
    static constexpr bool PERM = true, AFTER_DRAIN = false;
    bf16_t* O; const float* b2;
    __device__ __forceinline__ void pre(LAS unsigned char* lds, int par, const Unit& u, int wid, int lane) const {
        if (wid == 0) __builtin_amdgcn_global_load_lds((const unsigned*)(b2 + (u.pn >> 2) * 1024 + (u.pn & 3) * BM + lane * 4), (LAS unsigned*)(lds + EPI_BIAS_OFF + par * 1024), 16, 0, 0);
    }
    __device__ __forceinline__ void operator()(const f32x4 (&acc)[2][2][4][2], const Unit& u, int wr, int wc, int fr, int fq, const LAS unsigned char* lds, int par) const {
        const int pn = u.pn & 3;
        const int row0 = u.pm * BM + wr * 64 + fr, col0 = pn * BM + wc * 32 + 8 * fq;
        const LAS float* bp = (const LAS float*)(lds + EPI_BIAS_OFF + par * 1024) + wc * 32 + 8 * fq;
        f32x4 bv[2][2];
#pragma unroll
        for (int bj = 0; bj < 2; ++bj)
#pragma unroll
            for (int n = 0; n < 2; ++n) bv[bj][n] = *(const LAS f32x4*)(bp + bj * HALF + 4 * n);
#pragma unroll
        for (int ai = 0; ai < 2; ++ai)
#pragma unroll
            for (int m = 0; m < 4; ++m) { bf16_t* rowp = O + (size_t)(row0 + ai * HALF + m * 16) * 1024 + col0;
#pragma unroll
                for (int bj = 0; bj < 2; ++bj) { const f32x4 v0 = acc[ai][bj][m][0] + bv[bj][0], v1 = acc[ai][bj][m][1] + bv[bj][1];
                    u32x4 w; w.x = cvt_pk_bf16(v0[0], v0[1]); w.y = cvt_pk_bf16(v0[2], v0[3]); w.z = cvt_pk_bf16(v1[0], v1[1]); w.w = cvt_pk_bf16(v1[2], v1[3]);
                    *(u32x4*)(rowp + bj * HALF) = w; } }
    }
};
struct EpiAct {
    static constexpr bool PERM = true, AFTER_DRAIN = false;
    bf16_t* O; const float* b1;
    __device__ __forceinline__ void pre(LAS unsigned char* lds, int par, const Unit& u, int wid, int lane) const {
        if (wid == 0) __builtin_amdgcn_global_load_lds((const unsigned*)(b1 + (u.pn >> 3) * 2048 + (lane >> 5) * 1024 + (u.pn & 7) * 128 + (lane & 31) * 4), (LAS unsigned*)(lds + EPI_BIAS_OFF + par * 1024), 16, 0, 0);
    }
    __device__ __forceinline__ void operator()(const f32x4 (&acc)[2][2][4][2], const Unit& u, int wr, int wc, int fr, int fq, const LAS unsigned char* lds, int par) const {
        const int pn = u.pn & 7;
        const int row0 = u.pm * BM + wr * 64 + fr, x0 = pn * 128 + wc * 32 + 8 * fq;
        const LAS float* bg = (const LAS float*)(lds + EPI_BIAS_OFF + par * 1024) + wc * 32 + 8 * fq; const LAS float* bl = bg + 128;
        const f32x4 g0 = *(const LAS f32x4*)bg, g1 = *(const LAS f32x4*)(bg + 4), l0 = *(const LAS f32x4*)bl, l1 = *(const LAS f32x4*)(bl + 4);
#pragma unroll
        for (int ai = 0; ai < 2; ++ai)
#pragma unroll
            for (int m = 0; m < 4; ++m) {
                float o[8];
#pragma unroll
                for (int n = 0; n < 2; ++n)
#pragma unroll
                    for (int j = 0; j < 4; ++j) {
                        float glu = acc[ai][0][m][n][j] + (n ? g1[j] : g0[j]);
                        float lin = acc[ai][1][m][n][j] + (n ? l1[j] : l0[j]);
                        glu = fminf(glu, 7.0f); lin = fminf(fmaxf(lin, -7.0f), 7.0f);
                        o[n * 4 + j] = (lin + 1.0f) * glu * __builtin_amdgcn_rcpf(1.0f + __expf(-1.702f * glu));
                    }
                u32x4 w; w.x = cvt_pk_bf16(o[0], o[1]); w.y = cvt_pk_bf16(o[2], o[3]); w.z = cvt_pk_bf16(o[4], o[5]); w.w = cvt_pk_bf16(o[6], o[7]);
                *(u32x4*)(O + ((size_t)(u.pm * 16 + (x0 >> 6)) * 256 + (wr * 64 + fr + ai * HALF + m * 16)) * 64 + (x0 & 63)) = w;
            }
    }
};
}
using pg8::Unit;
__device__ __forceinline__ void my_sincos(double a, float& s, float& c) {
    const double n = rint(a * 0.63661977236758134308);
    const double r = (a - n * 1.57079632679489655800e+00) - n * 6.12323399573676603587e-17;
    const double r2 = r * r;
    const double sp = r * (1.0 + r2 * (-1.0 / 6.0 + r2 * (1.0 / 120.0 + r2 * (-1.0 / 5040.0 + r2 * (1.0 / 362880.0 + r2 * (-1.0 / 39916800.0 + r2 * (1.0 / 6227020800.0 + r2 * (-1.0 / 1307674368000.0))))))));
    const double cp = 1.0 + r2 * (-0.5 + r2 * (1.0 / 24.0 + r2 * (-1.0 / 720.0 + r2 * (1.0 / 40320.0 + r2 * (-1.0 / 3628800.0 + r2 * (1.0 / 479001600.0 + r2 * (-1.0 / 87178291200.0 + r2 * (1.0 / 20922789888000.0))))))));
    const int q = ((int)n) & 3;
    const double sn = q == 0 ? sp : q == 1 ? cp : q == 2 ? -sp : -cp;
    const double cn = q == 0 ? cp : q == 1 ? -sp : q == 2 ? -cp : sp;
    s = (float)sn; c = (float)cn;
}
__device__ __forceinline__ void ph_prologue(const Params& p, LAS unsigned char* lds, int bid, int nblk) {
    const int tid = threadIdx.x;
    unsigned char* ws = p.ws;
    {
        LAS float* sv = (LAS float*)(lds + LDS_WORK);
        LAS float* red = sv + 5 * 1024;
        for (int i = tid; i < 5 * 1024; i += NTHR) { const int r = i >> 10, k = i & 1023; const float c = r < 4 ? p.in[I_C][r * 1024 + k] : p.in[I_CCTX][k]; sv[i] = c / (1.0f + expf(-c)); }
        __syncthreads();
        float* MOD = (float*)(ws + WS_MOD);
        for (int item = bid; item < 256; item += nblk) {
            if (tid < 480) {
                const int cl = tid % 48, kp = tid / 48;
                const int gc = item * 48 + cl, l = gc / 6144, n = gc % 6144;
                const float* w = p.in[I_WMOD] + (size_t)l * 1024 * 6144 + n;
                float a0 = 0.f, a1 = 0.f, a2 = 0.f, a3 = 0.f, a4 = 0.f;
#pragma unroll 1
                for (int k0 = kp; k0 < 1024; k0 += 130) {
                    float wv[13];
#pragma unroll
                    for (int u = 0; u < 13; ++u) { const int k = k0 + 10 * u; wv[u] = k < 1024 ? w[(size_t)k * 6144] : 0.f; }
#pragma unroll
                    for (int u = 0; u < 13; ++u) { const int k = k0 + 10 * u < 1024 ? k0 + 10 * u : 1023; a0 += sv[k] * wv[u]; a1 += sv[1024 + k] * wv[u]; a2 += sv[2048 + k] * wv[u]; a3 += sv[3072 + k] * wv[u]; a4 += sv[4096 + k] * wv[u]; }
                }
                LAS float* rp = red + (kp * 48 + cl) * 5; rp[0] = a0; rp[1] = a1; rp[2] = a2; rp[3] = a3; rp[4] = a4;
            }
            __syncthreads();
            if (tid < 240) {
                const int cl = tid / 5, r = tid % 5; float s = 0.f;
                for (int kp = 0; kp < 10; ++kp) s += red[(kp * 48 + cl) * 5 + r];
                const int gc = item * 48 + cl, l = gc / 6144, n = gc % 6144;
                MOD[(size_t)(l * 5 + r) * 6144 + n] = s + p.in[I_BMOD][l * 6144 + n];
            }
            __syncthreads();
        }
    }
    if (bid == (nblk > 1 ? 1 : 0)) {
        float* ROPE = (float*)(ws + WS_ROPE);
        for (int i = tid; i < 2048; i += NTHR) { const int pos = i >> 5, f = i & 31; const double inv = exp(-(double)f * 0.28782313662425575); float s, c; my_sincos((double)pos * inv, s, c); ROPE[2 * i] = c; ROPE[2 * i + 1] = s; }
    }
    {
        bf16_t* WLT = (bf16_t*)(ws + WS_WLT);
        for (int i = bid * NTHR + tid; i < (int)WLT_N; i += nblk * NTHR) {
            float v;
            if (i < 131072) { const int which = i >> 16, r = i & 65535, d = r >> 15, n = (r >> 6) & 511, k = r & 63; v = (which ? p.in[I_AAB] : p.in[I_AWB])[(size_t)(d * 64 + k) * 512 + n]; }
            else if (i < 196608) { const int r = i - 131072, n = r >> 7, k = r & 127; v = p.in[I_AGB][(size_t)k * 512 + n]; }
            else { const int r = i - 196608, blk = r >> 12, o = (r >> 6) & 63, ii = r & 63; v = p.in[I_BGW][(size_t)blk * 4096 + ii * 64 + o]; }
            WLT[i] = f2bf(v);
        }
    }
    {
        LAS float* tile = (LAS float*)(lds + LDS_WORK);
        for (int t = bid; t < 576; t += nblk) {
            const float* src; int ld, nvalid, k0, n0, w1map = 0; bf16_t* dst; int tt = t;
            if (tt < 192) { k0 = (tt / 12) * 64; n0 = (tt % 12) * 256; src = p.in[I_EWIN]; ld = EVEN_IN; nvalid = EVEN_IN; dst = (bf16_t*)(ws + WS_WIN0T); }
            else if ((tt -= 192) < 256) { k0 = (tt >> 4) * 64; n0 = (tt & 15) * 256; src = p.in[I_OWIN]; ld = ODD_IN; nvalid = 4096; dst = (bf16_t*)(ws + WS_WIN1T); }
            else { tt -= 256; const int mat = tt >> 6, r = tt & 63; k0 = (r >> 2) * 64; n0 = (r & 3) * 256; src = mat ? p.in[I_OWOUT] : p.in[I_EWOUT]; ld = 1024; nvalid = 1024; dst = (bf16_t*)(ws + WS_WOUTT) + (size_t)mat * 1024 * 1024; }
            {
                const int j4 = (tid & 63) * 4, i0 = tid >> 6;
                f32x4 v[8];
#pragma unroll
                for (int r = 0; r < 8; ++r) v[r] = (n0 + j4 < nvalid) ? *(const f32x4*)(src + (size_t)(k0 + i0 + 8 * r) * ld + n0 + j4) : (f32x4){0.f, 0.f, 0.f, 0.f};
#pragma unroll
                for (int r = 0; r < 8; ++r) { LAS float* tp = tile + (i0 + 8 * r) * 257 + j4; tp[0] = v[r][0]; tp[1] = v[r][1]; tp[2] = v[r][2]; tp[3] = v[r][3]; }
            }
            __syncthreads();
            {
                const int ip = (tid & 31) * 2, j0 = tid >> 5;
#pragma unroll
                for (int r = 0; r < 16; ++r) {
                    const int j = j0 + 16 * r, n = n0 + j;
                    const int rho = w1map ? ((((n & 1023) >> 7) << 8) + ((n >> 10) << 7) + (n & 127)) : n;
                    *(unsigned*)(dst + (size_t)rho * 1024 + k0 + ip) = pack_bf16(tile[ip * 257 + j], tile[(ip + 1) * 257 + j]);
                }
            }
            __syncthreads();
        }
    }
}
__device__ __forceinline__ void ph_mod_in(const Params& p, int bid, int nblk) {
    const int tid = threadIdx.x, wid = tid >> 6, lane = tid & 63;
    const float* MOD = (const float*)(p.ws + WS_MOD);
    bf16_t* H = (bf16_t*)(p.ws + WS_H);
    for (int row = bid * 8 + wid; row < MROWS; row += nblk * 8) {
        const float* src = row < NCTX ? p.in[I_CTX] + (size_t)row * 1024 : p.in[I_X] + (size_t)(row - NCTX) * 1024;
        const float* md = MOD + (size_t)row_modr(row) * 6144;
#pragma unroll
        for (int q = 0; q < 4; ++q) {
            const int col = q * 256 + lane * 4;
            const f32x4 x = *(const f32x4*)(src + col), sh = *(const f32x4*)(md + col), sc = *(const f32x4*)(md + 1024 + col);
            const f32x4 h = x * (sc + 1.0f) + sh;
            u32x2 w; w.x = pack_bf16(h[0], h[1]); w.y = pack_bf16(h[2], h[3]);
            *(u32x2*)(H + (size_t)row * 1024 + col) = w;
        }
    }
}
__device__ __forceinline__ int even_tok_row(int w, int idx) { return idx < 64 ? NCTX + (w >> 6) * 4096 + (w & 63) * 64 + idx : w * 4 + (idx - 64); }
__device__ __forceinline__ int shift_nb(int row, int cc) {
    if (row >= NCTX) { const int s = (row - NCTX) & 4095, gr = s >> 6, gc = s & 63, slot = cc & 3;
        if (slot == 0) return gc > 0 ? row - 1 : -1;
        if (slot == 1) return gc < 63 ? row + 1 : -1;
        if (slot == 2) return gr > 0 ? row - 64 : -1;
        return gr < 63 ? row + 64 : -1; }
    const int t = row & 255; return (cc & 1) == 0 ? (t > 0 ? row - 1 : -1) : (t < 255 ? row + 1 : -1);
}
__device__ __forceinline__ float shifted_z(const bf16_t* P, const float* mu, int row, int cc) {
    const float pv = bf2f(P[(size_t)row * LDP0 + cc]); const int nb = shift_nb(row, cc);
    const float sv = nb >= 0 ? bf2f(P[(size_t)nb * LDP0 + cc]) : 0.f;
    return pv + (sv - pv) * mu[cc];
}
__device__ __forceinline__ int scan_q(int row, int d) {
    if (row < NCTX) { const int t = row & 255; return d ? 255 - t : t; }
    const int s = (row - NCTX) & 4095; return 256 + (d ? 4095 - s : s);
}
__device__ __forceinline__ bf16_t* sc_rec(float* SC, int d, int row, int h) { return (bf16_t*)SC + ((size_t)((d * 4 + row_batch(row)) * 8 + h) * SCLEN + scan_q(row, d)) * SCREC; }
constexpr int LDL = 392, LDU = 520;
template <int KS>
__device__ __forceinline__ void load_b(const bf16_t* Bt, bf16x8 (&b)[4][KS], int lane) {
    const int fr = lane & 15, fq = lane >> 4;
#pragma unroll
    for (int nt = 0; nt < 4; ++nt)
#pragma unroll
        for (int ks = 0; ks < KS; ++ks) b[nt][ks] = *(const bf16x8*)(Bt + (size_t)(nt * 16 + fr) * (32 * KS) + ks * 32 + fq * 8);
}
template <int KS>
__device__ __forceinline__ void mma_mt(const LAS bf16_t* A, int lda, int mt, const bf16x8 (&b)[4][KS], f32x4 (&acc)[4], int lane) {
    const int fr = lane & 15, fq = lane >> 4;
#pragma unroll
    for (int nt = 0; nt < 4; ++nt) acc[nt] = (f32x4){0.f, 0.f, 0.f, 0.f};
#pragma unroll
    for (int ks = 0; ks < KS; ++ks) {
        const bf16x8 a = *(const LAS bf16x8*)(A + (mt * 16 + fr) * lda + ks * 32 + fq * 8);
#pragma unroll
        for (int nt = 0; nt < 4; ++nt) acc[nt] = __builtin_amdgcn_mfma_f32_16x16x32_bf16(a, b[nt][ks], acc[nt], 0, 0, 0);
    }
}
__device__ __forceinline__ void ph_prep_even(const Params& p, LAS unsigned char* lds, int bid, int nblk) {
    const int tid = threadIdx.x, wid = tid >> 6, lane = tid & 63, c = tid, fr = lane & 15, fq = lane >> 4;
    const bf16_t* P = (const bf16_t*)(p.ws + WS_P);
    float* SC = (float*)(p.ws + WS_SC);
    float* EA = (float*)(p.ws + WS_EARR);
#define EARR(k) (EA + (size_t)(k) * ((size_t)MROWS * 512))
    float* BC = (float*)(p.ws + WS_BC);
    float* CHA = (float*)(p.ws + WS_CHA); float* CHH = (float*)(p.ws + WS_CHH);
    const bf16_t* WLT = (const bf16_t*)(p.ws + WS_WLT);
    const float* mu = p.in[I_AMU];
    LAS bf16_t* linb = (LAS bf16_t*)(lds + LDS_WORK);
    LAS bf16_t* ub = linb + 80 * LDL;
    LAS float* rnorm = (LAS float*)(ub + 80 * LDU);
    for (int w = bid; w < 256; w += nblk) {
        for (int i = tid; i < 12 * LDL; i += NTHR) linb[68 * LDL + i] = 0;
        for (int i = tid; i < 12 * LDU; i += NTHR) ub[68 * LDU + i] = 0;
#pragma unroll 1
        for (int g = 0; g < 3; ++g) {
            float pv[17], sv[17];
#pragma unroll
            for (int u = 0; u < 17; ++u) { const int e = tid + NTHR * (g * 17 + u), tok = e / 384, j = e - tok * 384, row = even_tok_row(w, tok), nb = shift_nb(row, 1536 + j);
                pv[u] = bf2f(P[(size_t)row * LDP0 + 1536 + j]); sv[u] = nb >= 0 ? bf2f(P[(size_t)nb * LDP0 + 1536 + j]) : 0.f; }
#pragma unroll
            for (int u = 0; u < 17; ++u) { const int e = tid + NTHR * (g * 17 + u), tok = e / 384, j = e - tok * 384;
                const float z = pv[u] + (sv[u] - pv[u]) * mu[1536 + j];
                linb[tok * LDL + j] = f2bf(j < 128 ? ftanh(z) : (j < 256 ? z : sigm(z))); }
        }
        {
            const float kkc = p.in[I_AKK][c], mur = mu[c], muk = mu[512 + c], muv = mu[1024 + c];
#pragma unroll 1
            for (int t0 = 0; t0 < 68; t0 += 8) {
                float pr[8], pk[8], pv[8], sr[8], sk[8], sv[8];
#pragma unroll
                for (int u = 0; u < 8; ++u) { const int tk = t0 + u < 68 ? t0 + u : 67; const int row = even_tok_row(w, tk); const int nb = shift_nb(row, c);
                    const bf16_t* pp = P + (size_t)row * LDP0 + c; pr[u] = bf2f(pp[0]); pk[u] = bf2f(pp[512]); pv[u] = bf2f(pp[1024]);
                    if (nb >= 0) { const bf16_t* pn = P + (size_t)nb * LDP0 + c; sr[u] = bf2f(pn[0]); sk[u] = bf2f(pn[512]); sv[u] = bf2f(pn[1024]); } else { sr[u] = 0.f; sk[u] = 0.f; sv[u] = 0.f; } }
#pragma unroll
                for (int u = 0; u < 8; ++u) if (t0 + u < 68) { const int row = even_tok_row(w, t0 + u);
                    const float zr = pr[u] + (sr[u] - pr[u]) * mur, zk = pk[u] + (sk[u] - pk[u]) * muk, zv = pv[u] + (sv[u] - pv[u]) * muv;
                    const float kkr = zk * kkc, ss = wave_sum(kkr * kkr), rn = frcp(fmaxf(fsqrt(ss), 1e-12f)), kk = kkr * rn;
                    if (lane == 0) rnorm[(t0 + u) * 8 + wid] = rn;
#pragma unroll
                    for (int d = 0; d < 2; ++d) { bf16_t* rec = sc_rec(SC, d, row, wid) + lane; rec[128] = f2bf(kk); rec[320] = f2bf(zr); rec[384] = f2bf(zv); } }
            }
        }
        {
            const float cw0 = p.in[I_BCW][c], cw1 = p.in[I_BCW][512 + c], cw2 = p.in[I_BCW][1024 + c], cw3 = p.in[I_BCW][1536 + c], cb = p.in[I_BCB][c];
#pragma unroll 1
            for (int t0 = 0; t0 < 68; t0 += 8) {
                float x0[8], x1[8], x2[8], x3[8], gx[8];
#pragma unroll
                for (int u = 0; u < 8; ++u) { const int tk = t0 + u < 68 ? t0 + u : 67; const int row = even_tok_row(w, tk);
                    int pos, len;
                    if (row >= NCTX) { pos = (row - NCTX) & 4095; len = 4096; } else { pos = row & 255; len = 256; }
                    x0[u] = pos >= 2 ? bf2f(P[(size_t)(row - 2) * LDP0 + 1920 + c]) : 0.f; x1[u] = pos >= 1 ? bf2f(P[(size_t)(row - 1) * LDP0 + 1920 + c]) : 0.f;
                    x2[u] = bf2f(P[(size_t)row * LDP0 + 1920 + c]); x3[u] = pos + 1 < len ? bf2f(P[(size_t)(row + 1) * LDP0 + 1920 + c]) : 0.f;
                    gx[u] = bf2f(P[(size_t)row * LDP0 + 1920 + 512 + c]); }
#pragma unroll
                for (int u = 0; u < 8; ++u) if (t0 + u < 68) { const int tok = t0 + u, row = even_tok_row(w, tok);
                    const float uu = cb + cw0 * x0[u] + cw1 * x1[u] + cw2 * x2[u] + cw3 * x3[u];
                    ub[tok * LDU + c] = f2bf(uu);
                    const size_t o = (size_t)row * 512 + c;
                    ((bf16_t*)EARR(E_GATE))[o] = f2bf(0.5f * gx[u] * (1.0f + ftanh(0.7978845608028654f * (gx[u] + 0.044715f * gx[u] * gx[u] * gx[u])))); }
            }
        }
        __syncthreads();
#pragma unroll 1
        for (int d = 0; d < 2; ++d) {
            {
                bf16x8 bw[4][2]; load_b<2>(WLT + WLT_WB + (size_t)(d * 512 + wid * 64) * 64, bw, lane);
                float w0v[4];
#pragma unroll
                for (int nt = 0; nt < 4; ++nt) w0v[nt] = p.in[I_AW0][d * 512 + wid * 64 + nt * 16 + fr];
#pragma unroll 1
                for (int mt = 0; mt < 5; ++mt) {
                    f32x4 acc[4]; mma_mt<2>(linb + d * 64, LDL, mt, bw, acc, lane);
#pragma unroll
                    for (int r = 0; r < 4; ++r) { const int tok = mt * 16 + fq * 4 + r;
                        if (tok < 68) { float* rec = (float*)sc_rec(SC, d, even_tok_row(w, tok), wid) + fr;
#pragma unroll
                            for (int nt = 0; nt < 4; ++nt) rec[nt * 16] = -0.60653065971263342f * sigm(w0v[nt] + acc[nt][r]);   } }
                }
            }
            {
                bf16x8 bw[4][2]; load_b<2>(WLT + WLT_AB + (size_t)(d * 512 + wid * 64) * 64, bw, lane);
                float a0v[4], kav[4], mukv[4], kkcv[4];
#pragma unroll
                for (int nt = 0; nt < 4; ++nt) { const int n = wid * 64 + nt * 16 + fr; a0v[nt] = p.in[I_AA0][d * 512 + n]; kav[nt] = p.in[I_AKA][n]; mukv[nt] = mu[512 + n]; kkcv[nt] = p.in[I_AKK][n]; }
#pragma unroll 1
                for (int mt = 0; mt < 5; ++mt) {
                    f32x4 acc[4]; mma_mt<2>(linb + 128 + d * 64, LDL, mt, bw, acc, lane);
                    float pkv[4][4], skv[4][4];
#pragma unroll
                    for (int r = 0; r < 4; ++r) { const int tok = mt * 16 + fq * 4 + r, row = even_tok_row(w, tok < 68 ? tok : 0);
#pragma unroll
                        for (int nt = 0; nt < 4; ++nt) { const int n = wid * 64 + nt * 16 + fr, nb = shift_nb(row, n);
                            pkv[r][nt] = bf2f(P[(size_t)row * LDP0 + 512 + n]); skv[r][nt] = nb >= 0 ? bf2f(P[(size_t)nb * LDP0 + 512 + n]) : 0.f; } }
#pragma unroll
                    for (int r = 0; r < 4; ++r) { const int tok = mt * 16 + fq * 4 + r;
                        if (tok < 68) { bf16_t* rec = sc_rec(SC, d, even_tok_row(w, tok), wid) + fr; const float rn = rnorm[tok * 8 + wid];
#pragma unroll
                            for (int nt = 0; nt < 4; ++nt) { const float a = sigm(a0v[nt] + acc[nt][r]);
                                const float zk = pkv[r][nt] + (skv[r][nt] - pkv[r][nt]) * mukv[nt];
                                rec[192 + nt * 16] = f2bf(zk * (1.0f + (a - 1.0f) * kav[nt])); rec[256 + nt * 16] = f2bf(zk * kkcv[nt] * rn * a); } } }
                }
            }
        }
        {
            bf16x8 bw[4][4]; load_b<4>(WLT + WLT_GB + (size_t)(wid * 64) * 128, bw, lane);
            bf16_t* G = (bf16_t*)EARR(E_G);
#pragma unroll 1
            for (int mt = 0; mt < 5; ++mt) {
                f32x4 acc[4]; mma_mt<4>(linb + 256, LDL, mt, bw, acc, lane);
#pragma unroll
                for (int r = 0; r < 4; ++r) { const int tok = mt * 16 + fq * 4 + r;
                    if (tok < 68) { bf16_t* gp = G + (size_t)even_tok_row(w, tok) * 512 + wid * 64 + fr;
#pragma unroll
                        for (int nt = 0; nt < 4; ++nt) gp[nt * 16] = f2bf(acc[nt][r]); } }
            }
        }
#pragma unroll 1
        for (int d = 0; d < 2; ++d) {
            bf16x8 b0[4][2];
            load_b<2>(WLT + WLT_GW + (size_t)(((d * 2 + 0) * 8 + wid) * 64) * 64, b0, lane);
            float gb0[4], gb1[4], spl[4];
#pragma unroll
            for (int nt = 0; nt < 4; ++nt) { const int n = wid * 64 + nt * 16 + fr; gb0[nt] = p.in[I_BGB][(d * 2 + 0) * 512 + n]; gb1[nt] = p.in[I_BGB][(d * 2 + 1) * 512 + n]; spl[nt] = softplusf(-p.in[I_BLAM][d * 512 + n]); }
            float* Ad = EARR(E_A0 + d); float* BXd = EARR(E_BX0 + d);
#pragma unroll 1
            for (int mt = 0; mt < 5; ++mt) {
                f32x4 la[4], acc[4];
                mma_mt<2>(ub + wid * 64, LDU, mt, b0, la, lane);
                { bf16x8 b1[4][2]; load_b<2>(WLT + WLT_GW + (size_t)(((d * 2 + 1) * 8 + wid) * 64) * 64, b1, lane); mma_mt<2>(ub + wid * 64, LDU, mt, b1, acc, lane); }
#pragma unroll
                for (int r = 0; r < 4; ++r) { const int tok = mt * 16 + fq * 4 + r;
                    if (tok < 68) { const size_t o = (size_t)even_tok_row(w, tok) * 512 + wid * 64 + fr;
#pragma unroll
                        for (int nt = 0; nt < 4; ++nt) { const float lg = -8.0f * sigm(gb0[nt] + la[nt][r]) * spl[nt];
                            const float av = fexp(lg); Ad[o + nt * 16] = av; BXd[o + nt * 16] = fsqrt(fmaxf(1.0f - av * av, 0.f)) * sigm(gb1[nt] + acc[nt][r]) * bf2f(ub[tok * LDU + wid * 64 + nt * 16 + fr]);         } } }
            }
        }
        __syncthreads();
        {
            const float rk = p.in[I_ARK][c];
#pragma unroll 1
            for (int t0 = 0; t0 < 68; t0 += 17) {
                float a[17], b0[17], b1[17];
#pragma unroll
                for (int u = 0; u < 17; ++u) { const int row = even_tok_row(w, t0 + u); const bf16_t* r0 = sc_rec(SC, 0, row, wid) + lane; const bf16_t* r1 = sc_rec(SC, 1, row, wid) + lane;
                    a[u] = bf2f(r0[320]); b0[u] = bf2f(r0[192]); b1[u] = bf2f(r1[192]); }
#pragma unroll
                for (int u = 0; u < 17; ++u) { const float sm = wave_sum(a[u] * (b0[u] + b1[u]) * rk); if (lane == 0) BC[even_tok_row(w, t0 + u) * 8 + wid] = sm; }
            }
        }
#pragma unroll 1
        for (int d = 0; d < 2; ++d) {
            float* Ad = EARR(E_A0 + d); float* BXd = EARR(E_BX0 + d);
            float h = 0.f, cum = 1.f;
#pragma unroll 1
            for (int n0 = 0; n0 < 64; n0 += 16) {
                float av[16], bv[16];
#pragma unroll
                for (int i = 0; i < 16; ++i) { const int tok = d == 0 ? n0 + i : 63 - n0 - i; const size_t o = (size_t)even_tok_row(w, tok) * 512 + c; av[i] = Ad[o]; bv[i] = BXd[o]; }
#pragma unroll
                for (int i = 0; i < 16; ++i) { const int tok = d == 0 ? n0 + i : 63 - n0 - i; const size_t o = (size_t)even_tok_row(w, tok) * 512 + c;
                    h = av[i] * h + bv[i]; cum *= av[i]; Ad[o] = cum; BXd[o] = h; }
            }
            { const int cid = (w >> 6) * 128 + 64 + (w & 63); CHA[(size_t)(d * 512 + cid) * 512 + c] = cum; CHH[(size_t)(d * 512 + cid) * 512 + c] = h; }
            h = 0.f; cum = 1.f;
#pragma unroll
            for (int i = 0; i < 4; ++i) { const int tok = 64 + (d == 0 ? i : 3 - i); const size_t o = (size_t)even_tok_row(w, tok) * 512 + c;
                const float a = Ad[o], bx = BXd[o]; h = a * h + bx; cum *= a; Ad[o] = cum; BXd[o] = h; }
            { const int cid = (w >> 6) * 128 + (w & 63); CHA[(size_t)(d * 512 + cid) * 512 + c] = cum; CHH[(size_t)(d * 512 + cid) * 512 + c] = h; }
        }
        __syncthreads();
    }
}
__device__ __forceinline__ float vfma(float a, float b, float c) { float d; asm("v_fma_f32 %0, %1, %2, %3" : "=v"(d) : "v"(a), "v"(b), "v"(c)); return d; }
__device__ __forceinline__ float vmul(float a, float b) { float d; asm("v_mul_f32 %0, %1, %2" : "=v"(d) : "v"(a), "v"(b)); return d; }
#define WG_BAR() do { asm volatile("" ::: "memory"); __builtin_amdgcn_s_barrier(); asm volatile("" ::: "memory"); } while (0)
__device__ __forceinline__ int scan_row(int d, int b, int q) {
    if (q < 256) return b * 256 + (d ? 255 - q : q);
    const int s = q - 256; return NCTX + b * 4096 + (d ? 4095 - s : s);
}
__device__ __forceinline__ void ph_fin_even(const Params& p, int bid, int nblk) {
    const int tid = threadIdx.x, wid = tid >> 6, c = tid;
    float* EA = (float*)(p.ws + WS_EARR);
    float* SC = (float*)(p.ws + WS_SC);
    const float* BC = (const float*)(p.ws + WS_BC); const float* CIN = (const float*)(p.ws + WS_CIN);
    bf16_t* Y = (bf16_t*)(p.ws + WS_YMIX);
    const float gg = p.in[I_AGNG][c], gb = p.in[I_AGNB][c];
    for (int r0 = bid * 4; r0 < MROWS; r0 += nblk * 4) {
        float o0[4], o1[4], vv[4], gv[4], bc[4], x0[4], x1[4], a0[4], a1[4], c0[4], c1[4], gt[4];
#pragma unroll
        for (int u = 0; u < 4; ++u) { const int row = r0 + u; const size_t o = (size_t)row * 512 + c;
            const int cid = row < NCTX ? (row >> 8) * 128 + ((row >> 2) & 63) : ((row - NCTX) >> 12) * 128 + 64 + (((row - NCTX) & 4095) >> 6);
            o0[u] = bf2f(((const bf16_t*)EARR(E_O0))[o]); o1[u] = bf2f(((const bf16_t*)EARR(E_O1))[o]); vv[u] = bf2f(sc_rec(SC, 0, row, wid)[384 + (tid & 63)]); gv[u] = bf2f(((const bf16_t*)EARR(E_G))[o]); bc[u] = BC[row * 8 + wid];
            x0[u] = EARR(E_BX0)[o]; x1[u] = EARR(E_BX1)[o]; a0[u] = EARR(E_A0)[o]; a1[u] = EARR(E_A1)[o];
            c0[u] = CIN[(size_t)cid * 512 + c]; c1[u] = CIN[(size_t)(512 + cid) * 512 + c]; gt[u] = bf2f(((const bf16_t*)EARR(E_GATE))[o]); }
#pragma unroll
        for (int u = 0; u < 4; ++u) { const int row = r0 + u;
            const float wkv = o0[u] + o1[u];
            const float mean = wave_sum(wkv) * (1.0f / 64.0f), dv = wkv - mean, var = wave_sum(dv * dv) * (1.0f / 64.0f);
            const float y = (dv * rsqrtf(var + 64e-5f) * gg + gb + bc[u] * vv[u]) * gv[u];
            Y[(size_t)row * 1024 + c] = f2bf(y);
            Y[(size_t)row * 1024 + 512 + c] = f2bf(((x0[u] + a0[u] * c0[u]) + (x1[u] + a1[u] * c1[u])) * gt[u]); }
    }
#undef EARR
}
constexpr int LDT = 72;
__device__ __forceinline__ float quad_sum(float v) {
    v += __int_as_float(__builtin_amdgcn_update_dpp(0, __float_as_int(v), 0xB1, 0xf, 0xf, false));
    v += __int_as_float(__builtin_amdgcn_update_dpp(0, __float_as_int(v), 0x4E, 0xf, 0xf, false));
    return v;
}
template <int PO> __device__ __forceinline__ float quad_bcast(float v) { return __int_as_float(__builtin_amdgcn_update_dpp(0, __float_as_int(v), PO * 0x55, 0xf, 0xf, false)); }
__device__ __forceinline__ bf16x8 ldt8(const LAS bf16_t* T, int row, int col) { return *(const LAS bf16x8*)(T + row * LDT + col); }
__device__ __forceinline__ void ph_r1(const Params& p, LAS unsigned char* lds, int bid, int nblk) {
    const int tid = threadIdx.x, wid = tid >> 6, lane = tid & 63, fr = lane & 15, fq = lane >> 4;
    LAS bf16_t* T0 = (LAS bf16_t*)(lds + LDS_WORK);
#define TL(i) (T0 + (i) * 64 * LDT)
    LAS float* F0 = (LAS float*)(T0 + 11 * 64 * LDT);
    LAS float* F1 = F0 + 4096;
    LAS float* F2 = F1 + 4096;
    LAS float* segt = F2 + 4096;
    LAS float* gl = segt + 512;
    const float* SC = (const float*)(p.ws + WS_SC);
    float* RU = (float*)(p.ws + WS_RU);
    const int k = tid & 63, seg = tid >> 6, t0 = seg * 8;
    const int tr = (wid >> 1) * 16, tc0 = (wid & 1) * 32;
    float kk[8], lw[8], kd[8], ka[8], rr[8], vv[8];
    auto fetch = [&](int unit) {
        const int chain = unit / NRCH, c = unit - chain * NRCH;
        const bf16_t* rec = (const bf16_t*)SC + ((size_t)chain * SCLEN + c * RCH + t0) * SCREC + k;
#pragma unroll
        for (int u = 0; u < 8; ++u) { const bf16_t* r = rec + u * SCREC; lw[u] = ((const float*)(r - k))[k]; kk[u] = bf2f(r[128]); kd[u] = bf2f(r[192]); ka[u] = bf2f(r[256]); rr[u] = bf2f(r[320]); vv[u] = bf2f(r[384]); }
    };
    if (bid < NRUNIT) fetch(bid);
    for (int unit = bid; unit < NRUNIT; unit += nblk) {
        float cum[8]; { float run = 0.f;
#pragma unroll
            for (int u = 0; u < 8; ++u) { run += lw[u]; cum[u] = run; }
            segt[seg * 64 + k] = run; }
        __syncthreads();
        float off = 0.f, tot = 0.f;
#pragma unroll
        for (int s2 = 0; s2 < 8; ++s2) { const float v = segt[s2 * 64 + k]; off += s2 < seg ? v : 0.f; tot += v; }
        if (seg == 0) gl[k] = fexp(tot);
        {
            u32x4 wk, wb, wv; unsigned pk[4], pb[4], pv[4]; float hk = 0.f, hb = 0.f, hv = 0.f;
#pragma unroll
            for (int u = 0; u < 8; ++u) { const int t = t0 + u; const float cu = cum[u] + off;
                const float ginc = fexp(cu), gexc = fexp(cu - lw[u]), ginv = fexp(-cu), gtail = fexp(tot - cu);
                const float kt = kk[u] * gexc;
                TL(0)[t * LDT + k] = f2bf(kt); F0[t * 64 + k] = kt;
                TL(1)[t * LDT + k] = f2bf(kd[u] * ginv); TL(2)[t * LDT + k] = f2bf(ka[u] * ginv); TL(3)[t * LDT + k] = f2bf(rr[u] * ginc);
                const float ktl = kd[u] * gtail, btl = ka[u] * gtail;
                if (u & 1) { pk[u >> 1] = pack_bf16(hk, ktl); pb[u >> 1] = pack_bf16(hb, btl); pv[u >> 1] = pack_bf16(hv, vv[u]); } else { hk = ktl; hb = btl; hv = vv[u]; } }
            wk.x = pk[0]; wk.y = pk[1]; wk.z = pk[2]; wk.w = pk[3]; wb.x = pb[0]; wb.y = pb[1]; wb.z = pb[2]; wb.w = pb[3]; wv.x = pv[0]; wv.y = pv[1]; wv.z = pv[2]; wv.w = pv[3];
            *(LAS u32x4*)(TL(4) + k * LDT + t0) = wk; *(LAS u32x4*)(TL(5) + k * LDT + t0) = wb; *(LAS u32x4*)(TL(6) + k * LDT + t0) = wv;
        }
        if (unit + nblk < NRUNIT) fetch(unit + nblk);
        __syncthreads();
        {
            f32x4 mk[2], mb[2], ak[2], ab[2];
#pragma unroll
            for (int nt = 0; nt < 2; ++nt) { mk[nt] = (f32x4){0.f, 0.f, 0.f, 0.f}; mb[nt] = mk[nt]; ak[nt] = mk[nt]; ab[nt] = mk[nt]; }
#pragma unroll
            for (int ks = 0; ks < 2; ++ks) { const bf16x8 aK = ldt8(TL(0), tr + fr, ks * 32 + fq * 8), aR = ldt8(TL(3), tr + fr, ks * 32 + fq * 8);
#pragma unroll
                for (int nt = 0; nt < 2; ++nt) { const bf16x8 bK = ldt8(TL(1), tc0 + nt * 16 + fr, ks * 32 + fq * 8), bB = ldt8(TL(2), tc0 + nt * 16 + fr, ks * 32 + fq * 8);
                    mk[nt] = __builtin_amdgcn_mfma_f32_16x16x32_bf16(aK, bK, mk[nt], 0, 0, 0); mb[nt] = __builtin_amdgcn_mfma_f32_16x16x32_bf16(aK, bB, mb[nt], 0, 0, 0);
                    ak[nt] = __builtin_amdgcn_mfma_f32_16x16x32_bf16(aR, bK, ak[nt], 0, 0, 0); ab[nt] = __builtin_amdgcn_mfma_f32_16x16x32_bf16(aR, bB, ab[nt], 0, 0, 0); } }
#pragma unroll
            for (int nt = 0; nt < 2; ++nt)
#pragma unroll
                for (int r = 0; r < 4; ++r) { const int t = tr + fq * 4 + r, j = tc0 + nt * 16 + fr;
                    TL(7)[t * LDT + j] = f2bf(j < t ? mk[nt][r] : 0.f); F1[j * 64 + (t & 3) * 16 + (t >> 2)] = j < t ? mb[nt][r] : 0.f;
                    TL(8)[t * LDT + j] = f2bf(j <= t ? ak[nt][r] : 0.f); TL(9)[t * LDT + j] = f2bf(j <= t ? ab[nt][r] : 0.f); }
        }
        __syncthreads();
        {
            f32x4 acc[2] = {(f32x4){0.f, 0.f, 0.f, 0.f}, (f32x4){0.f, 0.f, 0.f, 0.f}};
#pragma unroll
            for (int ks = 0; ks < 2; ++ks) { const bf16x8 a = ldt8(TL(7), tr + fr, ks * 32 + fq * 8);
#pragma unroll
                for (int nt = 0; nt < 2; ++nt) acc[nt] = __builtin_amdgcn_mfma_f32_16x16x32_bf16(a, ldt8(TL(6), tc0 + nt * 16 + fr, ks * 32 + fq * 8), acc[nt], 0, 0, 0); }
#pragma unroll
            for (int nt = 0; nt < 2; ++nt)
#pragma unroll
                for (int r = 0; r < 4; ++r) F2[(tr + fq * 4 + r) * 64 + tc0 + nt * 16 + fr] = acc[nt][r];
        }
        __syncthreads();
        {
            const int col = tid >> 2, part = tid & 3;
            f32x2 acc2[8]; float x[16];
#pragma unroll
            for (int q = 0; q < 16; ++q) { const int t = 4 * q + part; acc2[q >> 1][q & 1] = col < 64 ? F0[t * 64 + col] : F2[t * 64 + col - 64]; x[q] = 0.f; }
#pragma unroll
            for (int t = 0; t < 64; ++t) {
                const int qo = t >> 2, po = t & 3; const float aq = acc2[qo >> 1][qo & 1];
                const float xt = po == 0 ? quad_bcast<0>(aq) : po == 1 ? quad_bcast<1>(aq) : po == 2 ? quad_bcast<2>(aq) : quad_bcast<3>(aq);
                x[qo] = part == po ? xt : x[qo];
                const f32x2 nx = {-xt, -xt};
#pragma unroll
                for (int q4 = qo >> 2; q4 < 4; ++q4) { const f32x4 m = *(const LAS f32x4*)(F1 + t * 64 + part * 16 + q4 * 4);
                    acc2[q4 * 2] = (f32x2){m[0], m[1]} * nx + acc2[q4 * 2]; acc2[q4 * 2 + 1] = (f32x2){m[2], m[3]} * nx + acc2[q4 * 2 + 1]; }
            }
            LAS bf16_t* dstT = col < 64 ? TL(7) + col * LDT : TL(10) + (col - 64) * LDT;
#pragma unroll
            for (int q = 0; q < 16; ++q) dstT[4 * q + part] = f2bf(-x[q]);
        }
        __syncthreads();
        {
            f32x4 rh[2], ol[2], pm[2], qq[2];
#pragma unroll
            for (int nt = 0; nt < 2; ++nt) { rh[nt] = (f32x4){0.f, 0.f, 0.f, 0.f}; ol[nt] = rh[nt]; pm[nt] = rh[nt]; qq[nt] = rh[nt]; }
#pragma unroll
            for (int ks = 0; ks < 2; ++ks) { const int kc = ks * 32 + fq * 8;
                const bf16x8 a7 = ldt8(TL(7), tr + fr, kc), a8 = ldt8(TL(8), tr + fr, kc), a9 = ldt8(TL(9), tr + fr, kc), a6 = ldt8(TL(6), tr + fr, kc), a10 = ldt8(TL(10), tr + fr, kc);
#pragma unroll
                for (int nt = 0; nt < 2; ++nt) { const int br = tc0 + nt * 16 + fr;
                    const bf16x8 b9 = ldt8(TL(9), br, kc), b6 = ldt8(TL(6), br, kc), b10 = ldt8(TL(10), br, kc), b5 = ldt8(TL(5), br, kc), b4 = ldt8(TL(4), br, kc);
                    rh[nt] = __builtin_amdgcn_mfma_f32_16x16x32_bf16(a7, b9, rh[nt], 0, 0, 0);
                    ol[nt] = __builtin_amdgcn_mfma_f32_16x16x32_bf16(a8, b6, ol[nt], 0, 0, 0); ol[nt] = __builtin_amdgcn_mfma_f32_16x16x32_bf16(a9, b10, ol[nt], 0, 0, 0);
                    pm[nt] = __builtin_amdgcn_mfma_f32_16x16x32_bf16(a7, b5, pm[nt], 0, 0, 0);
                    qq[nt] = __builtin_amdgcn_mfma_f32_16x16x32_bf16(a6, b4, qq[nt], 0, 0, 0); qq[nt] = __builtin_amdgcn_mfma_f32_16x16x32_bf16(a10, b5, qq[nt], 0, 0, 0); } }
            float* U = RU + (size_t)unit * 4 * 4096;
#pragma unroll
            for (int nt = 0; nt < 2; ++nt)
#pragma unroll
                for (int r = 0; r < 4; ++r) { const int row = tr + fq * 4 + r, cx = tc0 + nt * 16 + fr; const int o = row * 64 + cx;
                    U[o] = pm[nt][r] + (row == cx ? gl[row] : 0.f);
                    U[4096 + o] = qq[nt][r];
                    U[8192 + o] = rh[nt][r] + bf2f(TL(3)[cx * LDT + row]);
                    U[12288 + o] = ol[nt][r]; }
        }
        __syncthreads();
    }
#undef TL
}
__device__ __forceinline__ void moe_weight_tiles(const Params& p, LAS unsigned char* lds, int first, int stride) {
    const int tid = threadIdx.x; unsigned char* ws = p.ws;
    LAS float* tile = (LAS float*)(lds + LDS_WORK);
    const int j4 = (tid & 31) * 4, i0 = tid >> 5;
    auto decode = [&](int tt, const float*& src, int& ld, int& k0, int& n0, int& w1map, bf16_t*& dst) {
        if (tt < 8192) { const int mat = tt >> 7, r = tt & 127; k0 = (r >> 4) * 128; n0 = (r & 15) * 128; src = p.in[I_W1] + (size_t)mat * 1024 * 2048; ld = 2048; dst = (bf16_t*)(ws + WS_W1T) + (size_t)mat * 2048 * 1024; w1map = 1; }
        else { tt -= 8192; const int mat = tt >> 6, r = tt & 63; k0 = (r >> 3) * 128; n0 = (r & 7) * 128; src = p.in[I_W2] + (size_t)mat * 1024 * 1024; ld = 1024; dst = (bf16_t*)(ws + WS_W2T) + (size_t)mat * 1024 * 1024; w1map = 0; }
    };
    f32x4 v[8];
    if (first < 12288) { const float* src; int ld, k0, n0, w1; bf16_t* dst; decode(first, src, ld, k0, n0, w1, dst);
#pragma unroll
        for (int r = 0; r < 8; ++r) v[r] = __builtin_nontemporal_load((const f32x4*)(src + (size_t)(k0 + i0 + 16 * r) * ld + n0 + j4)); }
    for (int t = first; t < 12288; t += stride) {
        const float* src; int ld, k0, n0, w1map; bf16_t* dst; decode(t, src, ld, k0, n0, w1map, dst);
#pragma unroll
        for (int r = 0; r < 8; ++r) { LAS float* tp = tile + (i0 + 16 * r) * 129 + j4; tp[0] = v[r][0]; tp[1] = v[r][1]; tp[2] = v[r][2]; tp[3] = v[r][3]; }
        __syncthreads();
        if (t + stride < 12288) { const float* s2; int ld2, k2, n2, w2; bf16_t* d2; decode(t + stride, s2, ld2, k2, n2, w2, d2);
#pragma unroll
            for (int r = 0; r < 8; ++r) v[r] = __builtin_nontemporal_load((const f32x4*)(s2 + (size_t)(k2 + i0 + 16 * r) * ld2 + n2 + j4)); }
        { const int ip = (tid & 15) * 8, j0 = tid >> 4;
            const int rho0 = w1map ? ((((n0 & 1023) >> 7) << 8) + ((n0 >> 10) << 7)) : n0;
#pragma unroll
            for (int r = 0; r < 4; ++r) { const int j = j0 + 32 * r;
                u32x4 w; w.x = pack_bf16(tile[ip * 129 + j], tile[(ip + 1) * 129 + j]); w.y = pack_bf16(tile[(ip + 2) * 129 + j], tile[(ip + 3) * 129 + j]);
                w.z = pack_bf16(tile[(ip + 4) * 129 + j], tile[(ip + 5) * 129 + j]); w.w = pack_bf16(tile[(ip + 6) * 129 + j], tile[(ip + 7) * 129 + j]);
                const int rho = rho0 + j, kk8 = k0 + ip; *(u32x4*)(dst + ((size_t)((rho >> 8) * 16 + (kk8 >> 6)) * 256 + (rho & 255)) * 64 + (kk8 & 63)) = w; } }
        __syncthreads();
    }
}
__device__ __forceinline__ void ph_r2(const Params& p, LAS unsigned char* lds, int bid, int nblk) {
    const int tid = threadIdx.x, wid = tid >> 6, lane = tid & 63, fr = lane & 15, g = lane >> 4;
    const int nchainwg = nblk >= 128 ? 64 : 0;
    if (bid >= nchainwg) {
        const int nconv = nblk - nchainwg, cb = bid - nchainwg;
        if (tid < 256) {
            const float* CHA = (const float*)(p.ws + WS_CHA); const float* CHH = (const float*)(p.ws + WS_CHH); float* CIN = (float*)(p.ws + WS_CIN);
            for (int item = cb; item < 16; item += nconv) {
                const int gi = item * 256 + tid, d = gi >> 11, b = (gi >> 9) & 3, c = gi & 511;
                float carry = 0.f;
                for (int s0 = 0; s0 < 128; s0 += 16) {
                    float av[16], hv[16];
#pragma unroll
                    for (int q = 0; q < 16; ++q) { const int st = s0 + q; const int cl = d == 0 ? st : (st < 64 ? 63 - st : 191 - st);
                        const size_t o = (size_t)(d * 512 + b * 128 + cl) * 512 + c; av[q] = CHA[o]; hv[q] = CHH[o]; }
#pragma unroll
                    for (int q = 0; q < 16; ++q) { const int st = s0 + q; const int cl = d == 0 ? st : (st < 64 ? 63 - st : 191 - st);
                        CIN[(size_t)(d * 512 + b * 128 + cl) * 512 + c] = carry; carry = av[q] * carry + hv[q]; }
                }
            }
        }
        __syncthreads();
        moe_weight_tiles(p, lds, cb, nconv);
        if (nchainwg) return;
    }
    LAS float* ring = (LAS float*)(lds + LDS_WORK);
    const float* RU = (const float*)(p.ws + WS_RU);
    float* EA = (float*)(p.ws + WS_EARR);
    for (int chain = nchainwg ? bid : bid; chain < 64; chain += (nchainwg ? 64 : nblk)) {
        const int d = chain >> 5, b = (chain >> 3) & 3, h = chain & 7;
        bf16_t* Od = (bf16_t*)(EA + (size_t)(E_O0 + d) * ((size_t)MROWS * 512));
        auto issue = [&](int c) {
            const float* src = RU + ((size_t)chain * NRCH + c) * 4 * 4096; LAS float* dst = ring + (c & 1) * 4 * 4096;
#pragma unroll
            for (int i = 0; i < 16; ++i) { const int slot = ((wid - 4) * 16 + i) * 64;
                __builtin_amdgcn_global_load_lds((const unsigned*)(src + (size_t)(slot + lane) * 4), (LAS unsigned*)(dst + slot * 4), 16, 0, 0); }
        };
        if (tid >= 256) { issue(0); asm volatile("s_waitcnt vmcnt(0)" ::: "memory"); }
        asm volatile("" ::: "memory"); __builtin_amdgcn_s_barrier(); asm volatile("" ::: "memory");
        f32x4 S[4];
#pragma unroll
        for (int m = 0; m < 4; ++m) S[m] = (f32x4){0.f, 0.f, 0.f, 0.f};
        const int v0 = wid * 16;
        for (int c = 0; c < NRCH; ++c) {
            if (tid >= 256) { if (c + 1 < NRCH) issue(c + 1); asm volatile("s_waitcnt vmcnt(0)" ::: "memory"); }
            else {
                const LAS float* PM = ring + (c & 1) * 4 * 4096; const LAS float* QQ = PM + 4096; const LAS float* RHT = PM + 8192; const LAS float* OL = PM + 12288;
                f32x4 acc[4], Sn[4];
#pragma unroll
                for (int tt = 0; tt < 4; ++tt) {
#pragma unroll
                    for (int i = 0; i < 4; ++i) acc[tt][i] = OL[(16 * tt + 4 * g + i) * 64 + v0 + fr];
                    Sn[tt] = *(const LAS f32x4*)(QQ + (v0 + fr) * 64 + 16 * tt + 4 * g); }
                float A[3][4];
#pragma unroll
                for (int s0 = 0; s0 < 2; ++s0) { const LAS float* ar = RHT + (16 * (s0 >> 2) + 4 * g + (s0 & 3)) * 64 + fr;
#pragma unroll
                    for (int u = 0; u < 4; ++u) A[s0][u] = ar[16 * u]; }
#pragma unroll
                for (int st = 0; st < 32; ++st) {
                    if (st + 2 < 32) { const int s2 = st + 2, mi = s2 & 15; const LAS float* ar = (s2 < 16 ? RHT : PM) + (16 * (mi >> 2) + 4 * g + (mi & 3)) * 64 + fr;
#pragma unroll
                        for (int u = 0; u < 4; ++u) A[s2 % 3][u] = ar[16 * u]; }
                    __builtin_amdgcn_sched_barrier(0);
                    const int mi = st & 15; const float bq = S[mi >> 2][mi & 3];
                    if (st < 16) {
#pragma unroll
                        for (int u = 0; u < 4; ++u) acc[u] = __builtin_amdgcn_mfma_f32_16x16x4f32(A[st % 3][u], bq, acc[u], 0, 0, 0);
                    } else {
#pragma unroll
                        for (int u = 0; u < 4; ++u) Sn[u] = __builtin_amdgcn_mfma_f32_16x16x4f32(A[st % 3][u], bq, Sn[u], 0, 0, 0);
                    }
                }
#pragma unroll
                for (int tt = 0; tt < 4; ++tt)
#pragma unroll
                    for (int i = 0; i < 4; ++i) { const int row = scan_row(d, b, c * RCH + 16 * tt + 4 * g + i); Od[(size_t)row * 512 + h * 64 + v0 + fr] = f2bf(acc[tt][i]); }
#pragma unroll
                for (int m = 0; m < 4; ++m) S[m] = Sn[m];
                asm volatile("s_waitcnt lgkmcnt(0)" ::: "memory");
            }
            asm volatile("" ::: "memory"); __builtin_amdgcn_s_barrier(); asm volatile("" ::: "memory");
        }
    }
}
__device__ __forceinline__ float half_max(float v, int lane) {
    const int ninf = 0xff800000;
    v = fmaxf(v, __int_as_float(__builtin_amdgcn_update_dpp(ninf, __float_as_int(v), 0x121, 0xf, 0xf, false)));
    v = fmaxf(v, __int_as_float(__builtin_amdgcn_update_dpp(ninf, __float_as_int(v), 0x122, 0xf, 0xf, false)));
    v = fmaxf(v, __int_as_float(__builtin_amdgcn_update_dpp(ninf, __float_as_int(v), 0x124, 0xf, 0xf, false)));
    v = fmaxf(v, __int_as_float(__builtin_amdgcn_update_dpp(ninf, __float_as_int(v), 0x128, 0xf, 0xf, false)));
    v = fmaxf(v, __int_as_float(__builtin_amdgcn_update_dpp(ninf, __float_as_int(v), 0x142, 0xa, 0xf, false)));
    const float lo = __int_as_float(__builtin_amdgcn_readlane(__float_as_int(v), 31)), hi = __int_as_float(__builtin_amdgcn_readlane(__float_as_int(v), 63));
    return (lane & 32) ? hi : lo;
}
__device__ __forceinline__ int half_min_i(int v, int lane) {
    const int big = 0x7fffffff;
    v = min(v, __builtin_amdgcn_update_dpp(big, v, 0x121, 0xf, 0xf, false));
    v = min(v, __builtin_amdgcn_update_dpp(big, v, 0x122, 0xf, 0xf, false));
    v = min(v, __builtin_amdgcn_update_dpp(big, v, 0x124, 0xf, 0xf, false));
    v = min(v, __builtin_amdgcn_update_dpp(big, v, 0x128, 0xf, 0xf, false));
    v = min(v, __builtin_amdgcn_update_dpp(big, v, 0x142, 0xa, 0xf, false));
    const int lo = __builtin_amdgcn_readlane(v, 31), hi = __builtin_amdgcn_readlane(v, 63);
    return (lane & 32) ? hi : lo;
}
template <int LAYER>
__device__ __forceinline__ void ph_ln1(const Params& p, LAS unsigned char* lds, int bid, int nblk) {
    const int tid = threadIdx.x, wid = tid >> 6, lane = tid & 63, fr = lane & 15, fq = lane >> 4;
    LAS float* vb = (LAS float*)(lds + LDS_WORK);
    LAS float* part = vb + 16 * 1028;
    LAS int* lcnt = (LAS int*)(part + 8 * 16 * 32);
    float rwf[2][32];
    { const float* rw = p.in[I_RW] + (size_t)LAYER * 32768 + (size_t)(128 * wid + 32 * fq) * 32 + fr;
#pragma unroll
        for (int s2 = 0; s2 < 32; ++s2) { rwf[0][s2] = rw[s2 * 32]; rwf[1][s2] = rw[s2 * 32 + 16]; } }
    if (tid < 32) lcnt[tid] = 0;
    __syncthreads();
    const float* MOD = (const float*)(p.ws + WS_MOD);
    bf16_t* XS = (bf16_t*)(p.ws + WS_XS); const bf16_t* YP = (const bf16_t*)(p.ws + WS_YP); bf16_t* H = (bf16_t*)(p.ws + WS_H);
    int* TOPE = (int*)(p.ws + WS_TOPE); float* TOPW = (float*)(p.ws + WS_TOPW); int* TOPS = (int*)(p.ws + WS_TOPS);
    int* CNTB = (int*)(p.ws + WS_CNTB) + (size_t)(LAYER * 512 + bid) * 32;
    const float* lng = p.in[I_LNG] + (LAYER * 2 + 0) * 1024; const float* lnb = p.in[I_LNB] + (LAYER * 2 + 0) * 1024;
    const int rstride = nblk * 8, rbase = (LAYER == 0 ? 0 : NCTX) + bid * 8;
    f32x4 nres[4], ngate[4]; u32x2 nyp[4];
    auto fetch = [&](int row) {
        const float* res = row < NCTX ? p.in[I_CTX] + (size_t)row * 1024 : p.in[I_X] + (size_t)(row - NCTX) * 1024;
        const float* md = MOD + (size_t)(LAYER * 5 + row_modr(row)) * 6144;
#pragma unroll
        for (int q = 0; q < 4; ++q) { const int col = q * 256 + lane * 4; nres[q] = LAYER == 0 ? *(const f32x4*)(res + col) : ld_bf16x4(XS + (size_t)row * 1024 + col);
            ngate[q] = *(const f32x4*)(md + 2048 + col); nyp[q] = *(const u32x2*)(YP + (size_t)row * 1024 + col); }
    };
    if (rbase < MROWS) fetch(rbase + wid);
#pragma unroll 1
    for (int j0 = 0; rbase + j0 * rstride < MROWS; j0 += 2) {
#pragma unroll 1
        for (int jj = 0; jj < 2; ++jj) {
            const int row = rbase + wid + (j0 + jj) * rstride;
            if (row >= MROWS) break;
            const float* md = MOD + (size_t)(LAYER * 5 + row_modr(row)) * 6144;
            f32x4 v[4], msc[4], msh[4]; float s = 0.f;
#pragma unroll
            for (int q = 0; q < 4; ++q) { const u32x2 w = nyp[q];
                const f32x4 y = (f32x4){__uint_as_float(w.x << 16), __uint_as_float(w.x & 0xffff0000u), __uint_as_float(w.y << 16), __uint_as_float(w.y & 0xffff0000u)};
                v[q] = nres[q] * DN_ALPHA + ngate[q] * y;
                s += (v[q][0] + v[q][1]) + (v[q][2] + v[q][3]); }
#pragma unroll
            for (int q = 0; q < 4; ++q) { const int col = q * 256 + lane * 4; msc[q] = *(const f32x4*)(md + 4096 + col); msh[q] = *(const f32x4*)(md + 3072 + col); }
            if (row + rstride < MROWS) fetch(row + rstride);
            const float mean = wave_sum(s) * (1.0f / 1024.0f);
            float ss = 0.f;
#pragma unroll
            for (int q = 0; q < 4; ++q) { v[q] = v[q] - mean; ss += (v[q][0] * v[q][0] + v[q][1] * v[q][1]) + (v[q][2] * v[q][2] + v[q][3] * v[q][3]); }
            const float rstd = rsqrtf(wave_sum(ss) * (1.0f / 1024.0f) + LN_EPS);
#pragma unroll
            for (int q = 0; q < 4; ++q) { const int col = q * 256 + lane * 4;
                const f32x4 xn = v[q] * rstd * *(const f32x4*)(lng + col) + *(const f32x4*)(lnb + col);
                { u32x2 wx; wx.x = pack_bf16(xn[0], xn[1]); wx.y = pack_bf16(xn[2], xn[3]); *(u32x2*)(XS + (size_t)row * 1024 + col) = wx; }
                v[q] = xn * (msc[q] + 1.0f) + msh[q];
                u32x2 w; w.x = pack_bf16(v[q][0], v[q][1]); w.y = pack_bf16(v[q][2], v[q][3]);
                *(u32x2*)(H + (size_t)row * 1024 + col) = w;
                *(LAS f32x4*)(vb + (wid + 8 * jj) * 1028 + col) = v[q]; }
        }
        __syncthreads();
        {
            const LAS float* ar = vb + fr * 1028 + 128 * wid + 32 * fq;
            f32x4 acc0 = {0.f, 0.f, 0.f, 0.f}, acc1 = {0.f, 0.f, 0.f, 0.f};
#pragma unroll
            for (int h = 0; h < 2; ++h) { f32x4 va[4];
#pragma unroll
                for (int u = 0; u < 4; ++u) va[u] = *(const LAS f32x4*)(ar + h * 16 + u * 4);
#pragma unroll
                for (int u = 0; u < 4; ++u)
#pragma unroll
                    for (int i = 0; i < 4; ++i) { acc0 = __builtin_amdgcn_mfma_f32_16x16x4f32(va[u][i], rwf[0][h * 16 + u * 4 + i], acc0, 0, 0, 0);
                        acc1 = __builtin_amdgcn_mfma_f32_16x16x4f32(va[u][i], rwf[1][h * 16 + u * 4 + i], acc1, 0, 0, 0); } }
            LAS float* pw = part + wid * 512 + (4 * fq) * 32 + fr;
#pragma unroll
            for (int i = 0; i < 4; ++i) { pw[i * 32] = acc0[i]; pw[i * 32 + 16] = acc1[i]; }
        }
        __syncthreads();
        {
            const int e = lane & 31, lr = 2 * wid + (lane >> 5), row = rbase + (lr & 7) + (j0 + (lr >> 3)) * rstride;
            float lg = p.in[I_RB][LAYER * 32 + e];
#pragma unroll
            for (int w2 = 0; w2 < 8; ++w2) lg += part[w2 * 512 + lr * 32 + e];
            float tv[4]; int te[4];
#pragma unroll
            for (int k = 0; k < 4; ++k) { const float bv = half_max(lg, lane); const int bi = half_min_i(lg == bv ? e : 99, lane);
                tv[k] = bv; te[k] = bi & 31; lg = e == bi ? -3.0e38f : lg; }
            const float e1 = expf(tv[1] - tv[0]), e2 = expf(tv[2] - tv[0]), e3 = expf(tv[3] - tv[0]), inv = 1.0f / (1.0f + e1 + e2 + e3);
            if (e == 0 && row < MROWS) {
                const float wv[4] = {inv, e1 * inv, e2 * inv, e3 * inv};
#pragma unroll
                for (int k = 0; k < 4; ++k) { const int slot = __hip_atomic_fetch_add(lcnt + te[k], 1, __ATOMIC_RELAXED, __HIP_MEMORY_SCOPE_WORKGROUP); TOPE[row * 4 + k] = te[k]; TOPW[row * 4 + k] = wv[k]; TOPS[row * 4 + k] = slot; }
            }
        }
    }
    __syncthreads();
    if (tid < 32) CNTB[tid] = lcnt[tid];
}
constexpr int LDS_TAB = LDS_WORK + 131072;
__device__ __forceinline__ int moe_tables(const int* cntb, int nblk, LAS int* tab, LAS int* bb) {
    const int tid = threadIdx.x, e = tid & 31, seg = tid >> 5, per = (nblk + 15) >> 4;
    const int b0 = seg * per, b1 = (b0 + per) < nblk ? (b0 + per) : nblk;
    int s = 0;
    if (per <= 16) {
        int cv[16];
#pragma unroll
        for (int u = 0; u < 16; ++u) cv[u] = (b0 + u) < b1 ? cntb[(b0 + u) * 32 + e] : 0;
#pragma unroll
        for (int u = 0; u < 16; ++u) s += cv[u];
        tab[512 + seg * 32 + e] = s;
        __syncthreads();
        if (tid < 32) { int run = 0; for (int sg = 0; sg < 16; ++sg) { const int v = tab[512 + sg * 32 + tid]; tab[512 + sg * 32 + tid] = run; run += v; } tab[448 + tid] = run; }
        __syncthreads();
        if (bb) { int run = tab[512 + seg * 32 + e];
#pragma unroll
            for (int u = 0; u < 16; ++u) if ((b0 + u) < b1) { bb[(b0 + u) * 32 + e] = run; run += cv[u]; } }
    } else {
        for (int b = b0; b < b1; ++b) s += cntb[b * 32 + e];
        tab[512 + seg * 32 + e] = s;
        __syncthreads();
        if (tid < 32) { int run = 0; for (int sg = 0; sg < 16; ++sg) { const int v = tab[512 + sg * 32 + tid]; tab[512 + sg * 32 + tid] = run; run += v; } tab[448 + tid] = run; }
        __syncthreads();
        if (bb) { int run = tab[512 + seg * 32 + e]; for (int b = b0; b < b1; ++b) { bb[b * 32 + e] = run; run += cntb[b * 32 + e]; } }
    }
    if (tid < 64) {
        const int x = tid & 31, n = (tab[448 + x] + 255) >> 8; int inc = n;
#pragma unroll
        for (int o = 1; o < 32; o <<= 1) { const int t = __shfl_up(inc, o, 64); if ((tid & 31) >= o) inc += t; }
        if (tid < 32) { const int t0 = inc - n; tab[x] = t0 * 256; for (int i = 0; i < n; ++i) tab[64 + t0 + i] = x; if (x == 31) { tab[32] = inc * 256; tab[40] = inc; } }
    }
    __syncthreads();
    return tab[40];
}
template <int LAYER>
__device__ __forceinline__ void ph_moe_gather(const Params& p, LAS unsigned char* lds, int bid, int nblk) {
    const int tid = threadIdx.x, wid = tid >> 6, lane = tid & 63;
    LAS int* tab = (LAS int*)(lds + LDS_TAB); LAS int* bb = (LAS int*)(lds + LDS_WORK);
    (void)moe_tables((const int*)(p.ws + WS_CNTB) + (size_t)LAYER * 512 * 32, nblk, tab, bb);
    const int* TOPE = (const int*)(p.ws + WS_TOPE); const int* TOPS = (const int*)(p.ws + WS_TOPS); int* POS = (int*)(p.ws + WS_POS);
    const bf16_t* H = (const bf16_t*)(p.ws + WS_H); bf16_t* AS = (bf16_t*)(p.ws + WS_ASORT);
    const int rstride = nblk * 8, rfirst = (LAYER == 0 ? 0 : NCTX) + bid * 8 + wid;
    u32x4 na = {0u, 0u, 0u, 0u}, nb2 = {0u, 0u, 0u, 0u}; int ne[4] = {0, 0, 0, 0}, ns[4] = {0, 0, 0, 0};
    auto fetch = [&](int row) {
        na = *(const u32x4*)(H + (size_t)row * 1024 + lane * 16); nb2 = *(const u32x4*)(H + (size_t)row * 1024 + lane * 16 + 8);
#pragma unroll
        for (int k = 0; k < 4; ++k) { ne[k] = TOPE[row * 4 + k]; ns[k] = TOPS[row * 4 + k]; }
    };
    if (rfirst < MROWS) fetch(rfirst);
    for (int row = rfirst; row < MROWS; row += rstride) {
        const u32x4 a = na, b = nb2; int ce[4], cs[4];
#pragma unroll
        for (int k = 0; k < 4; ++k) { ce[k] = ne[k]; cs[k] = ns[k]; }
        if (row + rstride < MROWS) fetch(row + rstride);
#pragma unroll
        for (int k = 0; k < 4; ++k) {
            const int e = ce[k], pos = tab[e] + bb[((((row - (LAYER == 0 ? 0 : NCTX)) >> 3) % nblk) << 5) + e] + cs[k];
            if (lane == 0) POS[row * 4 + k] = pos;
            bf16_t* ad = AS + ((size_t)((pos >> 8) * 16 + (lane >> 2)) * 256 + (pos & 255)) * 64 + (lane & 3) * 16;
            *(u32x4*)ad = a; *(u32x4*)(ad + 8) = b;
        }
    }
}
template <int LAYER>
__device__ __forceinline__ void ph_moe_gemm1(const Params& p, LAS unsigned char* lds, int bid, int nblk) {
    LAS int* tab = (LAS int*)(lds + LDS_TAB);
    const int T = moe_tables((const int*)(p.ws + WS_CNTB) + (size_t)LAYER * 512 * 32, nblk, tab, (LAS int*)nullptr);
    pg8::SchedMoe<8> S{T, nblk, bid, tab + 64};
    pg8::Gemm g{(const bf16_t*)(p.ws + WS_ASORT), (const bf16_t*)(p.ws + WS_W1T) + (size_t)LAYER * 32 * 2048 * 1024, 0, 0, 1024};
    pg8::EpiAct E{(bf16_t*)(p.ws + WS_ACT), p.in[I_B1] + (size_t)LAYER * 32 * 2048};
    pg8::gemm_phase<pg8::EpiAct, pg8::SchedMoe<8>, false, true, true>(lds + LDS_WORK, g, S, E, nullptr);
}
template <int LAYER>
__device__ __forceinline__ void ph_moe_gemm2(const Params& p, LAS unsigned char* lds, int bid, int nblk) {
    LAS int* tab = (LAS int*)(lds + LDS_TAB);
    const int T = moe_tables((const int*)(p.ws + WS_CNTB) + (size_t)LAYER * 512 * 32, nblk, tab, (LAS int*)nullptr);
    pg8::SchedMoe<4> S{T, nblk, bid, tab + 64};
    pg8::Gemm g{(const bf16_t*)(p.ws + WS_ACT), (const bf16_t*)(p.ws + WS_W2T) + (size_t)LAYER * 32 * 1024 * 1024, 0, 0, 1024};
    pg8::EpiYE E{(bf16_t*)(p.ws + WS_YE), p.in[I_B2] + (size_t)LAYER * 32 * 1024};
    pg8::gemm_phase<pg8::EpiYE, pg8::SchedMoe<4>, false, true, true>(lds + LDS_WORK, g, S, E, nullptr);
}
template <int NN>
__device__ __forceinline__ void ph_gemm_dense(LAS unsigned char* lds, const bf16_t* A, const bf16_t* Bt, bf16_t* C, int ldc, int pm0, int nM, int bid, int nblk) {
    pg8::SchedDense<NN> S{nM, pm0, nblk, bid};
    pg8::Gemm g{A, Bt, 0, 0, 1024};
    pg8::EpiStore E{C, ldc};
    pg8::gemm_phase<pg8::EpiStore, pg8::SchedDense<NN>, false>(lds + LDS_WORK, g, S, E, nullptr);
}
template <int LAYER>
__device__ __forceinline__ void ph_ln2(const Params& p, LAS unsigned char* lds, int bid, int nblk) {
    const int tid = threadIdx.x, wid = tid >> 6, lane = tid & 63;
    LAS float* wgT = (LAS float*)(lds + LDS_WORK);
    if (LAYER == 0) {
#pragma unroll 1
        for (int i0 = tid; i0 < 16384; i0 += NTHR * 16) {
            float t[16];
#pragma unroll
            for (int u = 0; u < 16; ++u) { const int i = i0 + u * NTHR; t[u] = p.in[I_OWIN][(size_t)(i >> 4) * ODD_IN + 4096 + (i & 15)]; }
#pragma unroll
            for (int u = 0; u < 16; ++u) { const int i = i0 + u * NTHR; wgT[(i & 15) * 1028 + (i >> 4)] = t[u]; }
        }
        __syncthreads();
    }
    const float* MOD = (const float*)(p.ws + WS_MOD);
    bf16_t* XS = (bf16_t*)(p.ws + WS_XS); const bf16_t* YE = (const bf16_t*)(p.ws + WS_YE); bf16_t* H = (bf16_t*)(p.ws + WS_H); float* GT = (float*)(p.ws + WS_GT);
    const float* TOPW = (const float*)(p.ws + WS_TOPW); const int* POS = (const int*)(p.ws + WS_POS);
    const float* lng = p.in[I_LNG] + (LAYER * 2 + 1) * 1024; const float* lnb = p.in[I_LNB] + (LAYER * 2 + 1) * 1024;
    const int rstride = nblk * 8, rfirst = (LAYER == 0 ? 0 : NCTX) + bid * 8 + wid;
    f32x4 nw = {0.f, 0.f, 0.f, 0.f}; int np0 = 0, np1 = 0, np2 = 0, np3 = 0;
    if (rfirst < MROWS) { nw = *(const f32x4*)(TOPW + rfirst * 4); np0 = POS[rfirst * 4]; np1 = POS[rfirst * 4 + 1]; np2 = POS[rfirst * 4 + 2]; np3 = POS[rfirst * 4 + 3]; }
    for (int row = rfirst; row < MROWS; row += rstride) {
        const float* md = MOD + (size_t)(LAYER * 5 + row_modr(row)) * 6144;
        const float w0 = nw[0], w1 = nw[1], w2 = nw[2], w3 = nw[3];
        const bf16_t* y0 = YE + (size_t)np0 * 1024; const bf16_t* y1 = YE + (size_t)np1 * 1024;
        const bf16_t* y2 = YE + (size_t)np2 * 1024; const bf16_t* y3 = YE + (size_t)np3 * 1024;
        if (row + rstride < MROWS) { const int rn = row + rstride; nw = *(const f32x4*)(TOPW + rn * 4); np0 = POS[rn * 4]; np1 = POS[rn * 4 + 1]; np2 = POS[rn * 4 + 2]; np3 = POS[rn * 4 + 3]; }
        f32x4 v[4]; float s = 0.f;
#pragma unroll
        for (int q = 0; q < 4; ++q) { const int col = q * 256 + lane * 4;
            const f32x4 ffn = (ld_bf16x4(y0 + col) * w0 + ld_bf16x4(y1 + col) * w1) + (ld_bf16x4(y2 + col) * w2 + ld_bf16x4(y3 + col) * w3);
            v[q] = ld_bf16x4(XS + (size_t)row * 1024 + col) * DN_ALPHA + *(const f32x4*)(md + 5120 + col) * ffn;
            s += (v[q][0] + v[q][1]) + (v[q][2] + v[q][3]); }
        const float mean = wave_sum(s) * (1.0f / 1024.0f);
        float ss = 0.f;
#pragma unroll
        for (int q = 0; q < 4; ++q) { v[q] = v[q] - mean; ss += (v[q][0] * v[q][0] + v[q][1] * v[q][1]) + (v[q][2] * v[q][2] + v[q][3] * v[q][3]); }
        const float rstd = rsqrtf(wave_sum(ss) * (1.0f / 1024.0f) + LN_EPS);
        if (LAYER == 1) {
#pragma unroll
            for (int q = 0; q < 4; ++q) { const int col = q * 256 + lane * 4;
                *(f32x4*)(p.out + (size_t)(row - NCTX) * 1024 + col) = v[q] * rstd * *(const f32x4*)(lng + col) + *(const f32x4*)(lnb + col); }
        } else {
            const float* md1 = MOD + (size_t)(5 + row_modr(row)) * 6144;
#pragma unroll
            for (int q = 0; q < 4; ++q) { const int col = q * 256 + lane * 4;
                const f32x4 xn = v[q] * rstd * *(const f32x4*)(lng + col) + *(const f32x4*)(lnb + col);
                { u32x2 wx; wx.x = pack_bf16(xn[0], xn[1]); wx.y = pack_bf16(xn[2], xn[3]); *(u32x2*)(XS + (size_t)row * 1024 + col) = wx; }
                v[q] = xn * (*(const f32x4*)(md1 + 1024 + col) + 1.0f) + *(const f32x4*)(md1 + col);
                u32x2 w; w.x = pack_bf16(v[q][0], v[q][1]); w.y = pack_bf16(v[q][2], v[q][3]);
                *(u32x2*)(H + (size_t)row * 1024 + col) = w; }
            float gt = 0.f;
#pragma unroll 2
            for (int g = 0; g < 16; ++g) { float a = 0.f;
#pragma unroll
                for (int q = 0; q < 4; ++q) { const f32x4 r = *(const LAS f32x4*)(wgT + g * 1028 + q * 256 + lane * 4); a += (v[q][0] * r[0] + v[q][1] * r[1]) + (v[q][2] * r[2] + v[q][3] * r[3]); }
                a = wave_sum(a); gt = lane == g ? a : gt; }
            if (lane < 16) GT[row * 16 + lane] = gt;
        }
    }
}
constexpr int LDK = 136;
__device__ __forceinline__ int sid_of(int mixer, int dir, int b, int ch, int h) { return (((mixer * 2 + dir) * 4 + b) * NCHUNK + ch) * 4 + h; }
__device__ __forceinline__ void unit_decode(int u, int& mixer, int& h, int& ch, int& b, int& row0) {
    mixer = u & 1; h = (u >> 1) & 3; const int rest = u >> 3; ch = rest % NCHUNK; b = rest / NCHUNK;
    row0 = ch < 2 ? b * 256 + ch * 128 : NCTX + b * 4096 + (ch - 2) * 128;
}
__device__ __forceinline__ void ld_raw(const bf16_t* P, int row0, int col, u32x2 (&raw)[8]) {
    const int t = threadIdx.x, i = t >> 2, part = t & 3, i0 = (part & 1) * 32 + (part >> 1) * 16;
    const bf16_t* src = P + (size_t)(row0 + i) * LDP1 + col + i0;
#pragma unroll
    for (int q = 0; q < 4; ++q) { raw[q] = *(const u32x2*)(src + q * 4); raw[4 + q] = *(const u32x2*)(src + 64 + q * 4); }
}
__device__ __forceinline__ void cvt_rows(const u32x2 (&raw)[8], bool rope, int s0, const float* ROPE, float (&lo)[16], float (&hi)[16]) {
    const int t = threadIdx.x, i = t >> 2, part = t & 3, pr = part & 1, hf = part >> 1;
#pragma unroll
    for (int q = 0; q < 4; ++q) {
        lo[q * 4] = __uint_as_float(raw[q].x << 16); lo[q * 4 + 1] = __uint_as_float(raw[q].x & 0xffff0000u); lo[q * 4 + 2] = __uint_as_float(raw[q].y << 16); lo[q * 4 + 3] = __uint_as_float(raw[q].y & 0xffff0000u);
        hi[q * 4] = __uint_as_float(raw[4 + q].x << 16); hi[q * 4 + 1] = __uint_as_float(raw[4 + q].x & 0xffff0000u); hi[q * 4 + 2] = __uint_as_float(raw[4 + q].y << 16); hi[q * 4 + 3] = __uint_as_float(raw[4 + q].y & 0xffff0000u); }
    if (rope) {
        const int s = s0 + i, pos = pr == 0 ? (s >> 6) : (s & 63);
        const float* rp = ROPE + (size_t)(pos * 32 + hf * 16) * 2;
#pragma unroll
        for (int jj = 0; jj < 16; ++jj) { const float c = rp[2 * jj], sn = rp[2 * jj + 1], a = lo[jj], b = hi[jj]; lo[jj] = a * c - b * sn; hi[jj] = a * sn + b * c; }
    }
}
__device__ __forceinline__ void st_rows(LAS bf16_t* dst, const float (&lo)[16], const float (&hi)[16], float scale) {
    const int t = threadIdx.x, i = t >> 2, part = t & 3, i0 = (part & 1) * 32 + (part >> 1) * 16;
    u32x4 w0, w1, w2, w3;
    w0.x = pack_bf16(lo[0] * scale, lo[1] * scale); w0.y = pack_bf16(lo[2] * scale, lo[3] * scale); w0.z = pack_bf16(lo[4] * scale, lo[5] * scale); w0.w = pack_bf16(lo[6] * scale, lo[7] * scale);
    w1.x = pack_bf16(lo[8] * scale, lo[9] * scale); w1.y = pack_bf16(lo[10] * scale, lo[11] * scale); w1.z = pack_bf16(lo[12] * scale, lo[13] * scale); w1.w = pack_bf16(lo[14] * scale, lo[15] * scale);
    w2.x = pack_bf16(hi[0] * scale, hi[1] * scale); w2.y = pack_bf16(hi[2] * scale, hi[3] * scale); w2.z = pack_bf16(hi[4] * scale, hi[5] * scale); w2.w = pack_bf16(hi[6] * scale, hi[7] * scale);
    w3.x = pack_bf16(hi[8] * scale, hi[9] * scale); w3.y = pack_bf16(hi[10] * scale, hi[11] * scale); w3.z = pack_bf16(hi[12] * scale, hi[13] * scale); w3.w = pack_bf16(hi[14] * scale, hi[15] * scale);
    LAS bf16_t* d = dst + i * LDK + i0;
    *(LAS u32x4*)d = w0; *(LAS u32x4*)(d + 8) = w1; *(LAS u32x4*)(d + 64) = w2; *(LAS u32x4*)(d + 72) = w3;
}
__device__ __forceinline__ void st_rows_T(LAS bf16_t* dst, const float (&lo)[16], const float (&hi)[16], float scale) {
    const int t = threadIdx.x, i = t >> 2, part = t & 3, i0 = (part & 1) * 32 + (part >> 1) * 16;
#pragma unroll
    for (int jj = 0; jj < 16; ++jj) { dst[(i0 + jj) * LDK + i] = f2bf(lo[jj] * scale); dst[(i0 + 64 + jj) * LDK + i] = f2bf(hi[jj] * scale); }
}
__device__ __forceinline__ void mma_128(const LAS bf16_t* A, const LAS bf16_t* B, f32x4 (&acc)[2][4], int wr, int wc, int lane) {
    const int fr = lane & 15, fq = lane >> 4;
#pragma unroll
    for (int ks = 0; ks < 4; ++ks) {
        bf16x8 a[2], b[4];
#pragma unroll
        for (int mt = 0; mt < 2; ++mt) a[mt] = *(const LAS bf16x8*)(A + (wr * 32 + mt * 16 + fr) * LDK + ks * 32 + fq * 8);
#pragma unroll
        for (int nt = 0; nt < 4; ++nt) b[nt] = *(const LAS bf16x8*)(B + (wc * 64 + nt * 16 + fr) * LDK + ks * 32 + fq * 8);
#pragma unroll
        for (int mt = 0; mt < 2; ++mt)
#pragma unroll
            for (int nt = 0; nt < 4; ++nt) acc[mt][nt] = __builtin_amdgcn_mfma_f32_16x16x32_bf16(a[mt], b[nt], acc[mt][nt], 0, 0, 0);
    }
}
__device__ __forceinline__ void zero_acc(f32x4 (&acc)[2][4]) {
#pragma unroll
    for (int mt = 0; mt < 2; ++mt)
#pragma unroll
        for (int nt = 0; nt < 4; ++nt) acc[mt][nt] = (f32x4){0.f, 0.f, 0.f, 0.f};
}
__device__ __forceinline__ void wave_scan_sum2(float x0, float x1, float& p0, float& p1, float& total) {
    const int lane = threadIdx.x & 63; float s = x0 + x1, inc = s;
#pragma unroll
    for (int o = 1; o < 64; o <<= 1) { const float t = __shfl_up(inc, o, 64); if (lane >= o) inc += t; }
    const float exc = inc - s; p0 = exc + x0; p1 = exc + s; total = __shfl(inc, 63, 64);
}
__device__ __forceinline__ void wave_scan_max2(float x0, float x1, float& p0, float& p1) {
    const int lane = threadIdx.x & 63; const float m = fmaxf(x0, x1); float inc = m;
#pragma unroll
    for (int o = 1; o < 64; o <<= 1) { const float t = __shfl_up(inc, o, 64); if (lane >= o) inc = fmaxf(inc, t); }
    float exc = __shfl_up(inc, 1, 64); if (lane == 0) exc = -3.0e38f;
    p0 = fmaxf(exc, x0); p1 = fmaxf(exc, m);
}
__device__ __forceinline__ void ph_c1(const Params& p, LAS unsigned char* lds, int bid, int nblk) {
    const int tid = threadIdx.x, wid = tid >> 6, lane = tid & 63, wr = wid >> 1, wc = wid & 1, fr = lane & 15, fq = lane >> 4;
    LAS bf16_t* KsT = (LAS bf16_t*)(lds + LDS_WORK); LAS bf16_t* VsT0 = KsT + 128 * LDK; LAS bf16_t* VsT1 = VsT0 + 128 * LDK;
    LAS float* z = (LAS float*)(VsT1 + 128 * LDK);
    LAS float* lfA = z + 256; LAS float* igA = lfA + 256; LAS float* zmax = igA + 256;
    const bf16_t* P = (const bf16_t*)(p.ws + WS_P); const float* GT = (const float*)(p.ws + WS_GT); const float* ROPE = (const float*)(p.ws + WS_ROPE);
    float* ST = (float*)(p.ws + WS_ST); float* NST = (float*)(p.ws + WS_NST); float* MEND = (float*)(p.ws + WS_MEND); float* BEND = (float*)(p.ws + WS_BEND);
    for (int u = bid; u < NB * NCHUNK * 4 * 2; u += nblk) {
        int mixer, h, ch, b, row0; unit_decode(u, mixer, h, ch, b, row0);
        const int colQ = mixer * 2048 + h * 128;
        u32x2 rawK[8], rawV[8]; ld_raw(P, row0, colQ + 512, rawK); ld_raw(P, row0, colQ + 1024, rawV);
        if (mixer == 0) {
            if (tid < 256) { const int dir = tid >> 7, j = tid & 127; const float lg = p.in[I_CLG][dir * 4 + h]; z[tid] = fexp(lg * (float)(dir == 0 ? 127 - j : j)); }
        } else {
            if (tid < 256) { const int dir = tid >> 7, j = tid & 127, row = row0 + j;
                igA[tid] = GT[row * 16 + dir * 4 + h] + p.in[I_DIB][dir * 4 + h];
                lfA[tid] = -softplusf(-(GT[row * 16 + 8 + dir * 4 + h] + p.in[I_DFB][dir * 4 + h])); }
            __syncthreads();
            if (tid < 128) { const int dir = tid >> 6, j0 = 2 * lane, j1 = j0 + 1;
                const float l0 = lfA[dir * 128 + j0], l1 = lfA[dir * 128 + j1], g0 = igA[dir * 128 + j0], g1 = igA[dir * 128 + j1];
                float r0, r1, total; wave_scan_sum2(l0, l1, r0, r1, total);
                const float w0 = (dir == 0 ? total - r0 : r0 - l0) + g0, w1 = (dir == 0 ? total - r1 : r1 - l1) + g1;
                const float mx = wave_max(fmaxf(w0, w1));
                z[dir * 128 + j0] = fexp(w0 - mx); z[dir * 128 + j1] = fexp(w1 - mx);
                const int sid = sid_of(1, dir, b, ch, h);
                if (lane == 0) { MEND[sid] = mx; BEND[sid] = total; }
                float* CB = (float*)(p.ws + WS_CB) + (size_t)sid * 128; float* CMI = (float*)(p.ws + WS_CMI) + (size_t)sid * 128;
                if (dir == 0) { float m0, m1; wave_scan_max2(g0 - r0, g1 - r1, m0, m1); CB[j0] = r0; CB[j1] = r1; CMI[j0] = r0 + m0; CMI[j1] = r1 + m1; }
                else { const float s0 = total - r0 + l0, s1 = total - r1 + l1;
                    lfA[128 + j0] = g0 - s0; lfA[128 + j1] = g1 - s1; igA[128 + j0] = s0; igA[128 + j1] = s1; CB[j0] = s0; CB[j1] = s1;
                    asm volatile("s_waitcnt lgkmcnt(0)" ::: "memory");
                    const int q0 = 127 - 2 * lane, q1 = q0 - 1; float m0, m1; wave_scan_max2(lfA[128 + q0], lfA[128 + q1], m0, m1);
                    CMI[q0] = igA[128 + q0] + m0; CMI[q1] = igA[128 + q1] + m1; } }
        }
        __syncthreads();
        {
            float lo[16], hi[16];
            cvt_rows(rawK, mixer == 0 && ch >= 2, (ch - 2) * 128, ROPE, lo, hi);
            st_rows_T(KsT, lo, hi, 0.08838834764831845f);
            cvt_rows(rawV, false, 0, ROPE, lo, hi);
            const int i = tid >> 2;
            st_rows_T(VsT0, lo, hi, z[i]); st_rows_T(VsT1, lo, hi, z[128 + i]);
        }
        __syncthreads();
#pragma unroll
        for (int dir = 0; dir < 2; ++dir) {
            f32x4 acc[2][4]; zero_acc(acc);
            mma_128(dir == 0 ? VsT0 : VsT1, KsT, acc, wr, wc, lane);
            bf16_t* dst = (bf16_t*)ST + (size_t)sid_of(mixer, dir, b, ch, h) * 16384;
#pragma unroll
            for (int mt = 0; mt < 2; ++mt)
#pragma unroll
                for (int nt = 0; nt < 4; ++nt)
#pragma unroll
                    for (int r = 0; r < 4; ++r) dst[(wr * 32 + mt * 16 + fq * 4 + r) * 128 + wc * 64 + nt * 16 + fr] = f2bf(acc[mt][nt][r]);
        }
        if (mixer == 1 && tid < 256) { const int dir = tid >> 7, dd = tid & 127; float s = 0.f;
            for (int j = 0; j < 128; ++j) s += z[dir * 128 + j] * bf2f(KsT[dd * LDK + j]);
            NST[(size_t)sid_of(1, dir, b, ch, h) * 128 + dd] = s; }
        __syncthreads();
    }
}
__device__ __forceinline__ void ph_c2(const Params& p, int bid, int nblk) {
    const int tid = threadIdx.x;
    float* ST = (float*)(p.ws + WS_ST); float* NST = (float*)(p.ws + WS_NST); bf16_t* STB = (bf16_t*)(p.ws + WS_STB);
    const float* MEND = (const float*)(p.ws + WS_MEND); const float* BEND = (const float*)(p.ws + WS_BEND); float* MPREV = (float*)(p.ws + WS_MPREV);
    for (int item = bid; item < 2048; item += nblk) {
        const int mixer = item >> 10, chain = (item >> 5) & 31, slab = item & 31, dir = chain >> 4, b = (chain >> 2) & 3, h = chain & 3;
        const int idx = slab * 512 + tid;
        float kv[NCHUNK];
#pragma unroll
        for (int k = 0; k < NCHUNK; ++k) { const int ch = dir == 0 ? k : (k < 2 ? 1 - k : 35 - k); kv[k] = bf2f(((const bf16_t*)ST)[(size_t)sid_of(mixer, dir, b, ch, h) * 16384 + idx]); }
        if (mixer == 0) {
            const float gdec = fexp(p.in[I_CLG][dir * 4 + h] * 128.0f); float r = 0.f;
#pragma unroll
            for (int k = 0; k < NCHUNK; ++k) { const int ch = dir == 0 ? k : (k < 2 ? 1 - k : 35 - k); STB[(size_t)sid_of(0, dir, b, ch, h) * 16384 + idx] = f2bf(r); r = r * gdec + kv[k]; }
        } else {
            const bool do_n = slab == 0 && tid < 128;
            float nv[NCHUNK];
#pragma unroll
            for (int k = 0; k < NCHUNK; ++k) { const int ch = dir == 0 ? k : (k < 2 ? 1 - k : 35 - k); nv[k] = do_n ? NST[(size_t)sid_of(1, dir, b, ch, h) * 128 + tid] : 0.f; }
            float m = -__builtin_inff(), c = 0.f, n = 0.f;
#pragma unroll
            for (int k = 0; k < NCHUNK; ++k) { const int ch = dir == 0 ? k : (k < 2 ? 1 - k : 35 - k); const int sid = sid_of(1, dir, b, ch, h);
                const float me = MEND[sid], be = BEND[sid], mnew = fmaxf(be + m, me), so = fexp(be + m - mnew), sn = fexp(me - mnew);
                STB[(size_t)sid * 16384 + idx] = f2bf(c); c = c * so + kv[k] * sn;
                if (do_n) { NST[(size_t)sid * 128 + tid] = n; n = n * so + nv[k] * sn; }
                if (slab == 0 && tid == 0) MPREV[sid] = m;
                m = mnew; }
        }
    }
}
template <int mixer>
__device__ __forceinline__ void c3_unit(const Params& p, LAS unsigned char* lds, int h, int ch, int b, int row0) {
    const int tid = threadIdx.x, wid = tid >> 6, lane = tid & 63, wr = wid >> 1, wc = wid & 1, fr = lane & 15, fq = lane >> 4;
    LAS bf16_t* Qs = (LAS bf16_t*)(lds + LDS_WORK); LAS bf16_t* Ks = Qs + 128 * LDK; LAS bf16_t* VsT = Ks + 128 * LDK; LAS bf16_t* RT = VsT + 128 * LDK;
    LAS float* fa = (LAS float*)(RT + 128 * LDK);
    LAS float* lfA = fa; LAS float* igA = fa + 256; LAS float* bA = fa + 512; LAS float* miA = fa + 768; LAS float* mtA = fa + 1024; LAS float* sintA = fa + 1280;
    LAS float* rowsum = fa + 1536; LAS float* qn = fa + 2048; LAS float* nA = fa + 2304;
    LAS float* Os = (LAS float*)Qs;
    LAS bf16_t* Pm = Ks;
    const bf16_t* P = (const bf16_t*)(p.ws + WS_P); const float* GT = (const float*)(p.ws + WS_GT); const float* ROPE = (const float*)(p.ws + WS_ROPE);
    const bf16_t* STB = (const bf16_t*)(p.ws + WS_STB); const float* NST = (const float*)(p.ws + WS_NST); const float* MPREV = (const float*)(p.ws + WS_MPREV);
    bf16_t* Y = (bf16_t*)(p.ws + WS_YMIX);
    {
        const int colQ = mixer * 2048 + h * 128; const bool rope = mixer == 0 && ch >= 2;
        {
            u32x2 rawQ[8], rawK[8], rawV[8]; ld_raw(P, row0, colQ, rawQ); ld_raw(P, row0, colQ + 512, rawK); ld_raw(P, row0, colQ + 1024, rawV);
            float lo[16], hi[16];
            cvt_rows(rawQ, rope, (ch - 2) * 128, ROPE, lo, hi); st_rows(Qs, lo, hi, 1.0f);
            cvt_rows(rawK, rope, (ch - 2) * 128, ROPE, lo, hi); st_rows(Ks, lo, hi, 0.08838834764831845f);
            cvt_rows(rawV, false, 0, ROPE, lo, hi); st_rows_T(VsT, lo, hi, 1.0f);
        }
        if (mixer == 1) {
            if (tid < 256) { const int dir = tid >> 7, j = tid & 127, row = row0 + j;
                igA[tid] = GT[row * 16 + dir * 4 + h] + p.in[I_DIB][dir * 4 + h];
                nA[tid] = NST[(size_t)sid_of(1, dir, b, ch, h) * 128 + j];
                bA[tid] = ((const float*)(p.ws + WS_CB))[(size_t)sid_of(1, dir, b, ch, h) * 128 + j]; miA[tid] = ((const float*)(p.ws + WS_CMI))[(size_t)sid_of(1, dir, b, ch, h) * 128 + j]; }
            __syncthreads();
            __syncthreads();
            if (tid < 256) { const int dir = tid >> 7, i = tid & 127; const float mprev = MPREV[sid_of(1, dir, b, ch, h)];
                const float gi = bA[tid] + mprev, mt = fmaxf(gi, miA[tid]); mtA[tid] = mt; sintA[tid] = fexp(gi - mt);
                float s = 0.f;
                for (int d0 = 0; d0 < 128; ++d0) s += bf2f(Qs[i * LDK + d0]) * nA[dir * 128 + d0];
                qn[tid] = s; }
        }
        __syncthreads();
        f32x4 S[2][4]; zero_acc(S);
        mma_128(Qs, Ks, S, wr, wc, lane);
        __syncthreads();
        f32x4 O[2][4]; zero_acc(O);
        if (mixer == 0) {
            const float lg0 = p.in[I_CLG][h], lg1 = p.in[I_CLG][4 + h];
#pragma unroll
            for (int mt = 0; mt < 2; ++mt)
#pragma unroll
                for (int nt = 0; nt < 4; ++nt)
#pragma unroll
                    for (int r = 0; r < 4; ++r) { const int i = wr * 32 + mt * 16 + fq * 4 + r, j = wc * 64 + nt * 16 + fr;
                        const float dcy = (i >= j ? fexp(lg0 * (float)(i - j)) : 0.f) + (j >= i ? fexp(lg1 * (float)(j - i)) : 0.f);
                        Pm[i * LDK + j] = f2bf(S[mt][nt][r] * dcy); }
            __syncthreads();
            mma_128(Pm, VsT, O, wr, wc, lane);
#pragma unroll
            for (int dir = 0; dir < 2; ++dir) {
                { const bf16_t* src = STB + (size_t)sid_of(0, dir, b, ch, h) * 16384 + (tid >> 2) * 128 + (tid & 3) * 32; LAS bf16_t* d = RT + (tid >> 2) * LDK + (tid & 3) * 32;
#pragma unroll
                    for (int q = 0; q < 4; ++q) *(LAS u32x4*)(d + q * 8) = *(const u32x4*)(src + q * 8); }
                __syncthreads();
                f32x4 T[2][4]; zero_acc(T);
                mma_128(Qs, RT, T, wr, wc, lane);
#pragma unroll
                for (int mt = 0; mt < 2; ++mt)
#pragma unroll
                    for (int r = 0; r < 4; ++r) { const int i = wr * 32 + mt * 16 + fq * 4 + r; const float xi = dir == 0 ? fexp(lg0 * (float)(i + 1)) : fexp(lg1 * (float)(128 - i));
#pragma unroll
                        for (int nt = 0; nt < 4; ++nt) O[mt][nt][r] += xi * T[mt][nt][r]; }
                __syncthreads();
            }
        } else {
#pragma unroll
            for (int dir = 0; dir < 2; ++dir) {
                float rp[2][4];
#pragma unroll
                for (int mt = 0; mt < 2; ++mt)
#pragma unroll
                    for (int r = 0; r < 4; ++r) { const int i = wr * 32 + mt * 16 + fq * 4 + r; const float bi = bA[dir * 128 + i] - mtA[dir * 128 + i]; float acc = 0.f;
#pragma unroll
                        for (int nt = 0; nt < 4; ++nt) { const int j = wc * 64 + nt * 16 + fr; const bool valid = dir == 0 ? (j <= i) : (j >= i);
                            const float e = valid ? fexp(bi - bA[dir * 128 + j] + igA[dir * 128 + j]) : 0.f; const float pv = S[mt][nt][r] * e;
                            Pm[i * LDK + j] = f2bf(pv); acc += pv; }
                        rp[mt][r] = row16_sum(acc); }
                if (fr == 0) {
#pragma unroll
                    for (int mt = 0; mt < 2; ++mt)
#pragma unroll
                        for (int r = 0; r < 4; ++r) rowsum[wc * 256 + dir * 128 + wr * 32 + mt * 16 + fq * 4 + r] = rp[mt][r];
                }
                { const bf16_t* src = STB + (size_t)sid_of(1, dir, b, ch, h) * 16384 + (tid >> 2) * 128 + (tid & 3) * 32; LAS bf16_t* d = RT + (tid >> 2) * LDK + (tid & 3) * 32;
#pragma unroll
                    for (int q = 0; q < 4; ++q) *(LAS u32x4*)(d + q * 8) = *(const u32x4*)(src + q * 8); }
                __syncthreads();
                f32x4 T[2][4]; zero_acc(T);
                mma_128(Qs, RT, T, wr, wc, lane);
#pragma unroll
                for (int mt = 0; mt < 2; ++mt)
#pragma unroll
                    for (int r = 0; r < 4; ++r) { const float si = sintA[dir * 128 + wr * 32 + mt * 16 + fq * 4 + r];
#pragma unroll
                        for (int nt = 0; nt < 4; ++nt) T[mt][nt][r] *= si; }
                mma_128(Pm, VsT, T, wr, wc, lane);
#pragma unroll
                for (int mt = 0; mt < 2; ++mt)
#pragma unroll
                    for (int r = 0; r < 4; ++r) { const int i = wr * 32 + mt * 16 + fq * 4 + r; const float si = sintA[dir * 128 + i];
                        float den = (rowsum[dir * 128 + i] + rowsum[256 + dir * 128 + i]) + qn[dir * 128 + i] * si; den = fmaxf(fabsf(den), fexp(-mtA[dir * 128 + i])); const float rden = frcp(den);
#pragma unroll
                        for (int nt = 0; nt < 4; ++nt) O[mt][nt][r] += T[mt][nt][r] * rden; }
                __syncthreads();
            }
        }
#pragma unroll
        for (int mt = 0; mt < 2; ++mt)
#pragma unroll
            for (int nt = 0; nt < 4; ++nt)
#pragma unroll
                for (int r = 0; r < 4; ++r) Os[(wr * 32 + mt * 16 + fq * 4 + r) * 132 + wc * 64 + nt * 16 + fr] = O[mt][nt][r];
        __syncthreads();
        {
            const float* gng = (mixer == 0 ? p.in[I_CGNG] : p.in[I_DGNG]) + h * 128; const float* gnb = (mixer == 0 ? p.in[I_CGNB] : p.in[I_DGNB]) + h * 128;
            const float g0 = gng[lane], g1 = gng[lane + 64], b0 = gnb[lane], b1 = gnb[lane + 64];
#pragma unroll 1
            for (int i4 = 0; i4 < 16; i4 += 4) {
                float qg0[4], qg1[4];
#pragma unroll
                for (int u = 0; u < 4; ++u) { const int row = row0 + wid * 16 + i4 + u; qg0[u] = bf2f(P[(size_t)row * LDP1 + colQ + 1536 + lane]); qg1[u] = bf2f(P[(size_t)row * LDP1 + colQ + 1536 + 64 + lane]); }
#pragma unroll
                for (int u = 0; u < 4; ++u) { const int i = wid * 16 + i4 + u, row = row0 + i;
                    const float x0 = Os[i * 132 + lane], x1 = Os[i * 132 + 64 + lane];
                    const float mean = wave_sum(x0 + x1) * (1.0f / 128.0f), d0 = x0 - mean, d1 = x1 - mean;
                    const float rstd = rsqrtf(wave_sum(d0 * d0 + d1 * d1) * (1.0f / 128.0f) + LN_EPS);
                    const float q0 = qg0[u], q1 = qg1[u];
                    const float s0 = sigm(q0), s1 = sigm(q1);
                    const float y0 = (d0 * rstd * g0 + b0) * (mixer == 0 ? q0 * s0 : s0), y1 = (d1 * rstd * g1 + b1) * (mixer == 0 ? q1 * s1 : s1);
                    Y[(size_t)row * 1024 + mixer * 512 + h * 128 + lane] = f2bf(y0); Y[(size_t)row * 1024 + mixer * 512 + h * 128 + 64 + lane] = f2bf(y1); }
            }
        }
        __syncthreads();
    }
}
__device__ __forceinline__ void ph_c3(const Params& p, LAS unsigned char* lds, int bid, int nblk) {
    for (int u2 = bid; u2 < NB * NCHUNK * 4; u2 += nblk) {
        int mixer, h, ch, b, row0; unit_decode(u2 * 2, mixer, h, ch, b, row0);
        c3_unit<0>(p, lds, h, ch, b, row0);
    }
    for (int u2 = nblk - 1 - bid; u2 < NB * NCHUNK * 4; u2 += nblk) {
        int mixer, h, ch, b, row0; unit_decode(u2 * 2 + 1, mixer, h, ch, b, row0);
        c3_unit<1>(p, lds, h, ch, b, row0);
    }
}
constexpr int NPHASE = 23;
__global__ void __launch_bounds__(NTHR, 2) fwd(Params p) {
    extern __shared__ __attribute__((aligned(16))) unsigned char smem_raw[];
    LAS unsigned char* lds = (LAS unsigned char*)smem_raw;
    if (threadIdx.x == 0) { LAS unsigned* st = (LAS unsigned*)(lds + LDS_BAR); st[0] = 0u; st[1] = 0u; st[2] = 0u; st[3] = 0u; }
    __syncthreads();
    XcdBarrier bar = xcd_barrier_post((unsigned*)(p.ws + WS_CTL), (volatile LAS unsigned*)(lds + LDS_BAR));
    const int bid = blockIdx.x, nblk = gridDim.x;
    unsigned char* ws = p.ws;
#ifndef PHASE_ONLY
#define PHASE_ONLY -1
#endif
#ifndef DBL_MASK
#define DBL_MASK 0u
#endif
#define PHASE(k, call) if constexpr (PHASE_ONLY < 0 || PHASE_ONLY == (k)) { if (p.lo <= (k) && (k) < p.hi) { call; if constexpr ((DBL_MASK >> (k)) & 1u) { xcd_barrier(bar); call; } if ((k) + 1 < p.hi) xcd_barrier(bar); } }
    PHASE(0, ph_prologue(p, lds, bid, nblk))
    PHASE(1, ph_mod_in(p, bid, nblk))
    PHASE(2, ph_gemm_dense<12>(lds, (const bf16_t*)(ws + WS_H), (const bf16_t*)(ws + WS_WIN0T), (bf16_t*)(ws + WS_P), LDP0, 0, 68, bid, nblk))
    PHASE(3, ph_prep_even(p, lds, bid, nblk))
    PHASE(4, ph_r1(p, lds, bid, nblk))
    PHASE(5, ph_r2(p, lds, bid, nblk))
    PHASE(6, ph_fin_even(p, bid, nblk))
    PHASE(7, ph_gemm_dense<4>(lds, (const bf16_t*)(ws + WS_YMIX), (const bf16_t*)(ws + WS_WOUTT), (bf16_t*)(ws + WS_YP), 1024, 0, 68, bid, nblk))
    PHASE(8, ph_ln1<0>(p, lds, bid, nblk))
    PHASE(9, ph_moe_gather<0>(p, lds, bid, nblk))
    PHASE(10, ph_moe_gemm1<0>(p, lds, bid, nblk))
    PHASE(11, ph_moe_gemm2<0>(p, lds, bid, nblk))
    PHASE(12, ph_ln2<0>(p, lds, bid, nblk))
    PHASE(13, ph_gemm_dense<16>(lds, (const bf16_t*)(ws + WS_H), (const bf16_t*)(ws + WS_WIN1T), (bf16_t*)(ws + WS_P), LDP1, 0, 68, bid, nblk))
    PHASE(14, ph_c1(p, lds, bid, nblk))
    PHASE(15, ph_c2(p, bid, nblk))
    PHASE(16, ph_c3(p, lds, bid, nblk))
    PHASE(17, ph_gemm_dense<4>(lds, (const bf16_t*)(ws + WS_YMIX), (const bf16_t*)(ws + WS_WOUTT) + (size_t)1024 * 1024, (bf16_t*)(ws + WS_YP), 1024, 4, 64, bid, nblk))
    PHASE(18, ph_ln1<1>(p, lds, bid, nblk))
    PHASE(19, ph_moe_gather<1>(p, lds, bid, nblk))
    PHASE(20, ph_moe_gemm1<1>(p, lds, bid, nblk))
    PHASE(21, ph_moe_gemm2<1>(p, lds, bid, nblk))
    PHASE(22, ph_ln2<1>(p, lds, bid, nblk))
#undef PHASE
}

#ifndef MK_ONE_LAUNCH
#define MK_ONE_LAUNCH 1
#endif
extern "C" void kernel_launch(void* const* d_in, const int* in_sizes, int n_in, void* d_out, int out_size, void* d_ws, size_t ws_size, hipStream_t stream) {
    static int grid = 0;
    if (grid == 0) {
        if (n_in != N_INPUTS || out_size != NB * SEQL * DM || ws_size < WS_TOTAL) { fprintf(stderr, "kernel_launch: unexpected problem (n_in %d, out %d, ws %zu < %zu)\n", n_in, out_size, ws_size, (size_t)WS_TOTAL); grid = -1; return; }
        int dev = 0, cus = 0, per_cu = 0;
        if (hipGetDevice(&dev) != hipSuccess || hipDeviceGetAttribute(&cus, hipDeviceAttributeMultiprocessorCount, dev) != hipSuccess) { grid = -1; return; }
        if (hipFuncSetAttribute((const void*)fwd, hipFuncAttributeMaxDynamicSharedMemorySize, LDS_BYTES) != hipSuccess) { fprintf(stderr, "kernel_launch: hipFuncSetAttribute failed\n"); grid = -1; return; }
        if (hipOccupancyMaxActiveBlocksPerMultiprocessor(&per_cu, (const void*)fwd, NTHR, LDS_BYTES) != hipSuccess || per_cu < 1) { fprintf(stderr, "kernel_launch: occupancy query says %d\n", per_cu); (void)hipGetLastError(); per_cu = 1; }
        grid = cus;
    }
    if (grid < 0) return;
    (void)hipMemsetAsync((char*)d_ws + WS_CTL, 0, CTL_BYTES, stream);
    Params p{};
    for (int i = 0; i < N_INPUTS; ++i) p.in[i] = (const float*)d_in[i];
    p.out = (float*)d_out; p.ws = (unsigned char*)d_ws;
#if MK_ONE_LAUNCH
    p.lo = 0; p.hi = NPHASE;
    hipLaunchKernelGGL(fwd, dim3(grid), dim3(NTHR), LDS_BYTES, stream, p);
#else
    for (int k = 0; k < NPHASE; ++k) { p.lo = k; p.hi = k + 1; hipLaunchKernelGGL(fwd, dim3(grid), dim3(NTHR), LDS_BYTES, stream, p); }
#endif
}
```

```cpp
#include <hip/hip_runtime.h>
#include <stdint.h>
#include <stdio.h>

#define LAS __attribute__((address_space(3)))
typedef unsigned short bf16_t;
typedef short bf16x8 __attribute__((ext_vector_type(8)));
typedef float f32x4 __attribute__((ext_vector_type(4)));
typedef float f32x2 __attribute__((ext_vector_type(2)));
typedef unsigned u32x4 __attribute__((ext_vector_type(4)));
typedef unsigned u32x2 __attribute__((ext_vector_type(2)));

constexpr int NB = 4, SEQL = 4096, CTXL = 256, DM = 1024;
constexpr int NCTX = NB * CTXL;
constexpr int MROWS = NCTX + NB * SEQL;
constexpr int NTHR = 512;
constexpr int LDP0 = 3072, LDP1 = 4096;
constexpr int A_IN = 1920, EVEN_IN = 2944, ODD_IN = 4112;
constexpr int NEXP = 32, DFF = 1024;
constexpr int MOE_ROWS_MAX = 69632 + 32 * 256;
constexpr float DN_ALPHA = 1.41421356237309515f;
constexpr float LN_EPS = 1e-5f;
constexpr int NCHUNK = 34;

enum { I_X = 0, I_C, I_CTX, I_CCTX, I_WMOD, I_BMOD, I_LNG, I_LNB, I_EWIN, I_EWOUT, I_AMU, I_AW0, I_AWB, I_AA0, I_AAB, I_AGB, I_AKK, I_AKA, I_ARK,
       I_AGNG, I_AGNB, I_BCW, I_BCB, I_BGW, I_BGB, I_BLAM, I_OWIN, I_OWOUT, I_CLG, I_CGNG, I_CGNB, I_DIB, I_DFB, I_DGNG, I_DGNB, I_RW, I_RB,
       I_W1, I_B1, I_W2, I_B2, N_INPUTS };

constexpr size_t al256(size_t x) { return (x + 255) & ~(size_t)255; }
constexpr size_t WS_CTL   = 0;
constexpr size_t CTL_BYTES = 65536;
constexpr size_t CTL_CNT  = 16384;
constexpr size_t WS_MOD   = WS_CTL + CTL_BYTES;
constexpr size_t WS_ROPE  = WS_MOD + al256((size_t)2 * 5 * 6144 * 4);
constexpr size_t WS_WIN0T = WS_ROPE + 16384;
constexpr size_t WS_WIN1T = WS_WIN0T + (size_t)3072 * 1024 * 2;
constexpr size_t WS_WOUTT = WS_WIN1T + (size_t)4096 * 1024 * 2;
constexpr size_t WS_W1T   = WS_WOUTT + (size_t)2 * 1024 * 1024 * 2;
constexpr size_t WS_W2T   = WS_W1T + (size_t)2 * 32 * 2048 * 1024 * 2;
constexpr size_t WS_XS    = WS_W2T + (size_t)2 * 32 * 1024 * 1024 * 2;
constexpr size_t WS_H     = WS_XS + (size_t)MROWS * 1024 * 4;
constexpr size_t WS_YMIX  = WS_H + (size_t)MROWS * 1024 * 2;
constexpr size_t WS_YP    = WS_YMIX + (size_t)MROWS * 1024 * 2;
constexpr size_t WS_GT    = WS_YP + (size_t)MROWS * 1024 * 4;
constexpr size_t WS_TOPE  = WS_GT + (size_t)MROWS * 16 * 4;
constexpr size_t WS_TOPW  = WS_TOPE + (size_t)MROWS * 16;
constexpr size_t WS_TOPS  = WS_TOPW + (size_t)MROWS * 16;
constexpr size_t WS_POS   = WS_TOPS + (size_t)MROWS * 16;
constexpr size_t WS_CNTB  = WS_POS + (size_t)MROWS * 16;
constexpr size_t WS_WLT   = WS_CNTB + (size_t)2 * 512 * 32 * 4;
constexpr size_t WLT_WB = 0, WLT_AB = 65536, WLT_GB = 131072, WLT_GW = 196608, WLT_N = 327680;
constexpr size_t WS_P     = WS_WLT + (size_t)WLT_N * 2;
constexpr size_t WS_BIG   = WS_P + (size_t)MROWS * 4096 * 4;
constexpr size_t ARR512   = (size_t)MROWS * 512 * 4;
constexpr int SCREC = 448;
constexpr int SCLEN = CTXL + SEQL;
constexpr size_t WS_SC    = WS_BIG;
enum { E_G = 0, E_O0, E_O1, E_A0, E_A1, E_BX0, E_BX1, E_GATE, E_NARR };
constexpr size_t WS_EARR  = WS_SC + (size_t)64 * SCLEN * SCREC * 2;
constexpr size_t WS_BC    = WS_EARR + (size_t)E_NARR * ARR512;
constexpr size_t WS_CHA   = WS_BC + (size_t)MROWS * 8 * 4;
constexpr size_t WS_CHH   = WS_CHA + (size_t)2 * 512 * 512 * 4;
constexpr size_t WS_CIN   = WS_CHH + (size_t)2 * 512 * 512 * 4;
constexpr int RCH = 64, NRCH = SCLEN / RCH, NRUNIT = 64 * NRCH;
constexpr size_t WS_RU    = WS_CIN + (size_t)2 * 512 * 512 * 4;
constexpr size_t WS_EEND  = WS_RU + (size_t)NRUNIT * 4 * 4096 * 4;
constexpr int NSID = 2 * 2 * NB * NCHUNK * 4;
constexpr size_t WS_ST    = WS_BIG;
constexpr size_t WS_NST   = WS_ST + (size_t)NSID * 16384 * 4;
constexpr size_t WS_MEND  = WS_NST + (size_t)NSID * 128 * 4;
constexpr size_t WS_BEND  = WS_MEND + al256((size_t)NSID * 4);
constexpr size_t WS_MPREV = WS_BEND + al256((size_t)NSID * 4);
constexpr size_t WS_CB    = WS_MPREV + al256((size_t)NSID * 4);
constexpr size_t WS_CMI   = WS_CB + (size_t)NSID * 128 * 4;
constexpr size_t WS_STB   = WS_CMI + (size_t)NSID * 128 * 4;
constexpr size_t WS_OEND  = WS_STB + (size_t)NSID * 16384 * 2;
constexpr size_t WS_ASORT = WS_BIG;
constexpr size_t WS_ACT   = WS_ASORT + (size_t)MOE_ROWS_MAX * 1024 * 2;
constexpr size_t WS_YE    = WS_ACT + (size_t)MOE_ROWS_MAX * 1024 * 2;
constexpr size_t WS_MEND_ = WS_YE + (size_t)MOE_ROWS_MAX * 1024 * 4;
constexpr size_t WS_TOTAL = (WS_EEND > WS_MEND_ ? (WS_EEND > WS_OEND ? WS_EEND : WS_OEND) : (WS_MEND_ > WS_OEND ? WS_MEND_ : WS_OEND));

constexpr int LDS_BYTES = 155648;
constexpr int LDS_BAR = 0;
constexpr int LDS_WORK = 1024;

struct Params {
    const float* in[N_INPUTS];
    float* out;
    unsigned char* ws;
    int lo, hi;
};

typedef __bf16 nbf16x2 __attribute__((ext_vector_type(2)));
__device__ __forceinline__ unsigned pack_bf16(float lo, float hi) { const nbf16x2 v = {(__bf16)lo, (__bf16)hi}; return __builtin_bit_cast(unsigned, v); }
__device__ __forceinline__ bf16_t f2bf(float f) { return __builtin_bit_cast(bf16_t, (__bf16)f); }
__device__ __forceinline__ float bf2f(bf16_t b) { return __uint_as_float(((unsigned)b) << 16); }
__device__ __forceinline__ f32x4 ld_bf16x4(const bf16_t* p) { const u32x2 w = *(const u32x2*)p; return (f32x4){__uint_as_float(w.x << 16), __uint_as_float(w.x & 0xffff0000u), __uint_as_float(w.y << 16), __uint_as_float(w.y & 0xffff0000u)}; }
__device__ __forceinline__ float fexp(float x) { return __builtin_amdgcn_exp2f(x * 1.4426950408889634f); }
__device__ __forceinline__ float frcp(float x) { return __builtin_amdgcn_rcpf(x); }
__device__ __forceinline__ float fsqrt(float x) { return __builtin_amdgcn_sqrtf(x); }
__device__ __forceinline__ float sigm(float x) { return frcp(1.0f + fexp(-x)); }
__device__ __forceinline__ float ftanh(float x) { const float e = fexp(-2.0f * fabsf(x)), t = (1.0f - e) * frcp(1.0f + e); return x < 0.f ? -t : t; }
__device__ __forceinline__ float fexpm1_neg(float x) {
    const float p = x * (1.0f + x * (0.5f + x * (0.16666667f + x * (0.041666668f + x * 0.0083333338f))));
    return x > -0.25f ? p : fexp(x) - 1.0f; }
__device__ __forceinline__ float softplusf(float x) { return fmaxf(x, 0.f) + log1pf(expf(-fabsf(x))); }
__device__ __forceinline__ float wave_sum(float v) {
    v += __int_as_float(__builtin_amdgcn_update_dpp(0, __float_as_int(v), 0x121, 0xf, 0xf, false));
    v += __int_as_float(__builtin_amdgcn_update_dpp(0, __float_as_int(v), 0x122, 0xf, 0xf, false));
    v += __int_as_float(__builtin_amdgcn_update_dpp(0, __float_as_int(v), 0x124, 0xf, 0xf, false));
    v += __int_as_float(__builtin_amdgcn_update_dpp(0, __float_as_int(v), 0x128, 0xf, 0xf, false));
    v += __int_as_float(__builtin_amdgcn_update_dpp(0, __float_as_int(v), 0x142, 0xa, 0xf, false));
    v += __int_as_float(__builtin_amdgcn_update_dpp(0, __float_as_int(v), 0x143, 0xc, 0xf, false));
    return __int_as_float(__builtin_amdgcn_readlane(__float_as_int(v), 63));
}
__device__ __forceinline__ float wave_max(float v) {
    const int ninf = 0xff800000;
    v = fmaxf(v, __int_as_float(__builtin_amdgcn_update_dpp(ninf, __float_as_int(v), 0x121, 0xf, 0xf, false)));
    v = fmaxf(v, __int_as_float(__builtin_amdgcn_update_dpp(ninf, __float_as_int(v), 0x122, 0xf, 0xf, false)));
    v = fmaxf(v, __int_as_float(__builtin_amdgcn_update_dpp(ninf, __float_as_int(v), 0x124, 0xf, 0xf, false)));
    v = fmaxf(v, __int_as_float(__builtin_amdgcn_update_dpp(ninf, __float_as_int(v), 0x128, 0xf, 0xf, false)));
    v = fmaxf(v, __int_as_float(__builtin_amdgcn_update_dpp(ninf, __float_as_int(v), 0x142, 0xa, 0xf, false)));
    v = fmaxf(v, __int_as_float(__builtin_amdgcn_update_dpp(ninf, __float_as_int(v), 0x143, 0xc, 0xf, false)));
    return __int_as_float(__builtin_amdgcn_readlane(__float_as_int(v), 63));
}
__device__ __forceinline__ int wave_min_i(int v) {
    const int big = 0x7fffffff;
    v = min(v, __builtin_amdgcn_update_dpp(big, v, 0x121, 0xf, 0xf, false));
    v = min(v, __builtin_amdgcn_update_dpp(big, v, 0x122, 0xf, 0xf, false));
    v = min(v, __builtin_amdgcn_update_dpp(big, v, 0x124, 0xf, 0xf, false));
    v = min(v, __builtin_amdgcn_update_dpp(big, v, 0x128, 0xf, 0xf, false));
    v = min(v, __builtin_amdgcn_update_dpp(big, v, 0x142, 0xa, 0xf, false));
    v = min(v, __builtin_amdgcn_update_dpp(big, v, 0x143, 0xc, 0xf, false));
    return __builtin_amdgcn_readlane(v, 63);
}
__device__ __forceinline__ float row16_sum(float v) {
    v += __int_as_float(__builtin_amdgcn_update_dpp(0, __float_as_int(v), 0x121, 0xf, 0xf, false));
    v += __int_as_float(__builtin_amdgcn_update_dpp(0, __float_as_int(v), 0x122, 0xf, 0xf, false));
    v += __int_as_float(__builtin_amdgcn_update_dpp(0, __float_as_int(v), 0x124, 0xf, 0xf, false));
    v += __int_as_float(__builtin_amdgcn_update_dpp(0, __float_as_int(v), 0x128, 0xf, 0xf, false));
    return v;
}
__device__ __forceinline__ int row_batch(int row) { return row < NCTX ? (row >> 8) : ((row - NCTX) >> 12); }
__device__ __forceinline__ int row_modr(int row) { return row < NCTX ? 4 : ((row - NCTX) >> 12); }
#define XB_TMO      128
#define XB_XCNT(j)  (256  + 64 * (j))
#define XB_XSUB(j)  (1280 + 64 * (j))
#define XB_XGEN(j)  (2304 + 64 * (j))
#define XB_TOP      3328
#define XB_TOPGEN   3392
#define XCD_BAR_WORDS 3456
#define XB_SPIN_CAP (1u << 18)

__device__ __forceinline__ unsigned xb_ld(unsigned* p)              { return __hip_atomic_load(p, __ATOMIC_RELAXED, __HIP_MEMORY_SCOPE_AGENT); }
__device__ __forceinline__ unsigned xb_add(unsigned* p, unsigned v) { return __hip_atomic_fetch_add(p, v, __ATOMIC_RELAXED, __HIP_MEMORY_SCOPE_AGENT); }
__device__ __forceinline__ unsigned xb_xcc_id() { return (unsigned)__builtin_amdgcn_s_getreg((3 << 11) | 20) & 0xFu; }
#define XB_SPIN(cond, bar) do { unsigned _sp = 0; while (cond) { __builtin_amdgcn_s_sleep(1); \
    if ((++_sp & 255u) == 0u) { if (xb_ld(&(bar)[XB_TMO])) break; if (_sp > XB_SPIN_CAP) { atomicAdd(&(bar)[XB_TMO], 1u); break; } } } } while (0)

struct XcdBarrier {
    unsigned* bar; unsigned x;
    volatile LAS unsigned* st;
};

__device__ __forceinline__ XcdBarrier xcd_barrier_post(unsigned* bar, volatile LAS unsigned* st) {
    XcdBarrier b; b.bar = bar; b.x = xb_xcc_id(); b.st = st;
    if (threadIdx.x == 0) (void)xb_add(&bar[XB_XCNT(b.x)], 1u);
    return b;
}
__device__ __forceinline__ void xcd_barrier_complete(unsigned* bar, unsigned x, unsigned& nloc, unsigned& nx) {
    const unsigned G = gridDim.x * gridDim.y * gridDim.z;
    unsigned sum, cnt, mine, sp = 0u;
    for (;;) {
        sum = 0u; cnt = 0u; mine = 0u;
#pragma unroll
        for (unsigned j = 0; j < 16; ++j) { const unsigned c = xb_ld(&bar[XB_XCNT(j)]); sum += c; cnt += (c > 0u) ? 1u : 0u; mine = (j == x) ? c : mine; }
        if (sum == G) break;
        __builtin_amdgcn_s_sleep(1);
        if ((++sp & 255u) == 0u) { if (xb_ld(&bar[XB_TMO])) break; if (sp > XB_SPIN_CAP) { atomicAdd(&bar[XB_TMO], 1u); break; } }
    }
    nloc = mine > 0u ? mine : 1u; nx = cnt > 0u ? cnt : 1u;
}

__device__ __forceinline__ void xcd_barrier(const XcdBarrier& b) {
    asm volatile("s_waitcnt vmcnt(0)" ::: "memory");
    __syncthreads();
    if (threadIdx.x == 0) {
        unsigned* bar = b.bar;
        __builtin_amdgcn_s_waitcnt(0);
        unsigned nloc = b.st[0], nx = b.st[1];
        if (nloc == 0u) { xcd_barrier_complete(bar, b.x, nloc, nx); b.st[0] = nloc; b.st[1] = nx; }
        const unsigned old = xb_add(&bar[XB_XSUB(b.x)], 1u);
        const unsigned gen = old / nloc;
        if (old + 1u == (gen + 1u) * nloc) {
            __builtin_amdgcn_fence(__ATOMIC_RELEASE, "agent");
            asm volatile("s_waitcnt vmcnt(0)" ::: "memory");
            const unsigned og = xb_add(&bar[XB_TOP], 1u);
            const unsigned tg = og / nx;
            if (og + 1u == (tg + 1u) * nx) xb_add(&bar[XB_TOPGEN], 1u);
            else XB_SPIN(xb_ld(&bar[XB_TOPGEN]) == tg, bar);
            __builtin_amdgcn_fence(__ATOMIC_ACQUIRE, "agent");
            xb_add(&bar[XB_XGEN(b.x)], 1u);
            asm volatile("s_waitcnt vmcnt(0)" ::: "memory");
        } else {
            XB_SPIN(xb_ld(&bar[XB_XGEN(b.x)]) == gen, bar);
            __builtin_amdgcn_fence(__ATOMIC_ACQUIRE, "agent");
            asm volatile("s_waitcnt vmcnt(0)" ::: "memory");
        }
    }
    __syncthreads();
}
namespace pg8 {
constexpr int BM = 256, BK = 64, HALF = 128, HTB = HALF * BK * 2  , STAGE_BYTES = 8 * HTB, NXCD = 8, WGM = 8;

__host__ __device__ __forceinline__ int lds_byte(int r, int c) { const int st = (r >> 4) * 2 + (c >> 5), rr = r & 15, cc = c & 31, ob = rr * 64 + cc * 2; return st * 1024 + (ob ^ (((ob >> 9) & 1) << 5)); }
__host__ __device__ __forceinline__ void stage_rc(int b, int& R, int& C) { const int st = b / 1024, sb = b % 1024, swz = sb ^ (((sb >> 9) & 1) << 5); R = (st >> 1) * 16 + swz / 64; C = (st & 1) * 32 + (swz % 64) / 2; }
__host__ __device__ __forceinline__ int perm32(int rho) { const int n = rho >> 4, i = rho & 15; return 8 * (i >> 2) + 4 * n + (i & 3); }

struct Unit { int pm, pn; };
struct Gemm { const bf16_t* A; const bf16_t* Bt; int M, N, K; };
__device__ __forceinline__ unsigned cvt_pk_bf16(float lo, float hi) { return pack_bf16(lo, hi); }
template <class Epi, class Sched, bool STAMP = false, bool ATILED = false, bool BTILED = false>
__device__ __forceinline__ void gemm_phase(LAS unsigned char* lds, const Gemm g, const Sched& S, const Epi& E, unsigned long long* stamps) {
    const int tid = threadIdx.x, wid = __builtin_amdgcn_readfirstlane(tid >> 6), lane = tid & 63, wr = wid >> 2, wc = wid & 3, fr = lane & 15, fq = lane >> 4;
    const int K = g.K, nt = K / BK;
    int ts_lo = 0, ts_hi = 0, nts = 0; const unsigned long long rt_entry = STAMP ? (unsigned long long)wall_clock64() : 0ull;
#define PG8_STAMP() do { if (STAMP && wid == 0 && nts < 64) { const unsigned long long _c = (unsigned long long)clock64(); \
        ts_lo = (lane == nts) ? (int)(unsigned)_c : ts_lo; ts_hi = (lane == nts) ? (int)(unsigned)(_c >> 32) : ts_hi; ++nts; } } while (0)
    PG8_STAMP();
    unsigned voffA[2], voffB[2];
#pragma unroll
    for (int i = 0; i < 2; ++i) { int R, C; stage_rc(tid * 16 + i * 8192, R, C); const int Rb = Epi::PERM ? ((R & ~31) + perm32(R & 31)) : R;
        voffA[i] = (unsigned)(R * (ATILED ? BK : K) + C) * 2u; voffB[i] = (unsigned)(Rb * (BTILED ? BK : K) + C) * 2u; }
    const size_t kstepA = ATILED ? (size_t)BM * BK * 2 : (size_t)(BK * 2), kstepB = BTILED ? (size_t)BM * BK * 2 : (size_t)(BK * 2);
    const size_t hstepA = ATILED ? (size_t)HALF * BK * 2 : (size_t)HALF * K * 2, hstepB = BTILED ? (size_t)HALF * BK * 2 : (size_t)HALF * K * 2;
    const size_t tstep = (size_t)BM * K * 2;
    const unsigned ldsw = (unsigned)wid * 1024u;
    const int aoff = lds_byte(wr * 64 + fr, fq * 8), boff = lds_byte(wc * 32 + fr, fq * 8);
#define PG8_SA(b, h) (((b) * 2 + (h)) * HTB)
#define PG8_SB(b, h) ((4 + (b) * 2 + (h)) * HTB)
#define PG8_STAGE(bufoff, gbase, voff) do { _Pragma("unroll") for (int _i = 0; _i < 2; ++_i) \
        __builtin_amdgcn_global_load_lds((const unsigned*)((const char*)(gbase) + (voff)[_i]), (LAS unsigned*)(lds + (bufoff) + ldsw + _i * 8192), 16, 0, 0); } while (0)
#define PG8_LDA(dst, b, h) do { _Pragma("unroll") for (int m = 0; m < 4; ++m) _Pragma("unroll") for (int k = 0; k < 2; ++k) dst[m][k] = *(const LAS bf16x8*)(lds + PG8_SA(b, h) + aoff + m * 2048 + k * 1024); } while (0)
#define PG8_LDB(dst, b, h) do { _Pragma("unroll") for (int n = 0; n < 2; ++n) _Pragma("unroll") for (int k = 0; k < 2; ++k) dst[n][k] = *(const LAS bf16x8*)(lds + PG8_SB(b, h) + boff + n * 2048 + k * 1024); } while (0)
#define PG8_MMA(ai, bj, At, Bt) do { __builtin_amdgcn_s_setprio(1); _Pragma("unroll") for (int m = 0; m < 4; ++m) _Pragma("unroll") for (int n = 0; n < 2; ++n) _Pragma("unroll") for (int k = 0; k < 2; ++k) \
        acc[ai][bj][m][n] = __builtin_amdgcn_mfma_f32_16x16x32_bf16(Bt[n][k], At[m][k], acc[ai][bj][m][n], 0, 0, 0); __builtin_amdgcn_s_setprio(0); } while (0)
#define PG8_WAIT_V(n) asm volatile("s_waitcnt vmcnt(" #n ")" ::: "memory")
#define PG8_WAIT_L(n) asm volatile("s_waitcnt lgkmcnt(" #n ")" ::: "memory")
#define PG8_BAR __builtin_amdgcn_s_barrier()
#define PG8_SCHED __builtin_amdgcn_sched_barrier(0)
    Unit cur, nxt; int ui = 0;
    if (!S.next(0, cur)) return;
    f32x4 acc[2][2][4][2];
#pragma unroll
    for (int a = 0; a < 2; ++a)
#pragma unroll
        for (int b = 0; b < 2; ++b)
#pragma unroll
            for (int m = 0; m < 4; ++m)
#pragma unroll
                for (int n = 0; n < 2; ++n) acc[a][b][m][n] = (f32x4){0.f, 0.f, 0.f, 0.f};
    bf16x8 At[4][2], B0[2][2], B1[2][2];
    const char* cA = (const char*)g.A + (size_t)cur.pm * tstep; const char* cB = (const char*)g.Bt + (size_t)cur.pn * tstep;
    S.a_ready(cur);
    PG8_STAGE(PG8_SB(0, 0), cB, voffB); PG8_STAGE(PG8_SA(0, 0), cA, voffA); PG8_STAGE(PG8_SB(0, 1), cB + hstepB, voffB); PG8_STAGE(PG8_SA(0, 1), cA + hstepA, voffA);
    if (wr == 1) PG8_BAR;
    PG8_WAIT_V(4); PG8_BAR;
    PG8_STAGE(PG8_SB(1, 0), cB + kstepB, voffB); PG8_STAGE(PG8_SA(1, 0), cA + kstepA, voffA); PG8_STAGE(PG8_SB(1, 1), cB + hstepB + kstepB, voffB);
    PG8_WAIT_V(6); PG8_BAR;
    PG8_STAMP();
    for (;;) {
        const bool has_next = S.next(ui + 1, nxt);
        const char* nA = has_next ? (const char*)g.A + (size_t)nxt.pm * tstep : cA; const char* nB = has_next ? (const char*)g.Bt + (size_t)nxt.pn * tstep : cB;
        E.pre(lds, ui & 1, cur, wid, lane);
        for (int t = 0; t < nt; t += 2) {
            const bool last = (t == nt - 2);
            const char* a1 = cA + (size_t)(t + 1) * kstepA;
            const char* a2 = last ? nA : cA + (size_t)(t + 2) * kstepA; const char* b2 = last ? nB : cB + (size_t)(t + 2) * kstepB;
            const char* a3 = a2 + kstepA; const char* b3 = b2 + kstepB;
            if (last && has_next) S.a_ready(nxt);
            PG8_LDB(B0, 0, 0); PG8_SCHED; PG8_LDA(At, 0, 0); PG8_STAGE(PG8_SA(1, 1), a1 + hstepA, voffA);
            PG8_WAIT_L(8); PG8_BAR; PG8_WAIT_L(0); PG8_MMA(0, 0, At, B0); PG8_BAR; PG8_SCHED;
            PG8_LDB(B1, 0, 1); PG8_STAGE(PG8_SB(0, 0), b2, voffB);
            PG8_BAR; PG8_WAIT_L(0); PG8_MMA(0, 1, At, B1); PG8_BAR;
            PG8_LDA(At, 0, 1); PG8_STAGE(PG8_SA(0, 0), a2, voffA);
            PG8_BAR; PG8_WAIT_L(0); PG8_MMA(1, 0, At, B0); PG8_BAR; PG8_SCHED;
            PG8_STAGE(PG8_SB(0, 1), b2 + hstepB, voffB);
            PG8_WAIT_V(6); PG8_BAR; PG8_MMA(1, 1, At, B1); PG8_BAR;
            PG8_LDB(B0, 1, 0); PG8_SCHED; PG8_LDA(At, 1, 0); PG8_STAGE(PG8_SA(0, 1), a2 + hstepA, voffA);
            PG8_WAIT_L(8); PG8_BAR; PG8_WAIT_L(0); PG8_MMA(0, 0, At, B0); PG8_BAR; PG8_SCHED;
            PG8_LDB(B1, 1, 1); PG8_STAGE(PG8_SB(1, 0), b3, voffB);
            PG8_BAR; PG8_WAIT_L(0); PG8_MMA(0, 1, At, B1); PG8_BAR;
            PG8_LDA(At, 1, 1); PG8_STAGE(PG8_SA(1, 0), a3, voffA);
            PG8_BAR; PG8_WAIT_L(0); PG8_MMA(1, 0, At, B0); PG8_BAR; PG8_SCHED;
            PG8_STAGE(PG8_SB(1, 1), b3 + hstepB, voffB);
            PG8_WAIT_V(6); PG8_BAR; PG8_MMA(1, 1, At, B1); PG8_BAR;
        }
        PG8_STAMP();
        if constexpr (!Epi::AFTER_DRAIN) { E(acc, cur, wr, wc, fr, fq, lds, ui & 1); S.done(cur); }
        PG8_STAMP();
        if (!has_next) break;
#pragma unroll
        for (int a = 0; a < 2; ++a)
#pragma unroll
            for (int b = 0; b < 2; ++b)
#pragma unroll
                for (int m = 0; m < 4; ++m)
#pragma unroll
                    for (int n = 0; n < 2; ++n) acc[a][b][m][n] = (f32x4){0.f, 0.f, 0.f, 0.f};
        cur = nxt; cA = nA; cB = nB; ++ui;
    }
    PG8_WAIT_V(0);
    if (wr == 0) PG8_BAR;
    PG8_BAR;
    if constexpr (Epi::AFTER_DRAIN) { E.fused(acc, cur, wr, wc, fr, fq, lds, wid, lane); S.done(cur); }
    PG8_STAMP();
    if (STAMP && wid == 0) { stamps[lane] = lane < nts ? (((unsigned long long)(unsigned)ts_hi << 32) | (unsigned)ts_lo) : 0ull;
        if (lane == 62) stamps[62] = rt_entry; if (lane == 63) stamps[63] = (unsigned long long)wall_clock64(); }
#undef PG8_STAMP
#undef PG8_SA
#undef PG8_SB
#undef PG8_STAGE
#undef PG8_LDA
#undef PG8_LDB
#undef PG8_MMA
#undef PG8_WAIT_V
#undef PG8_WAIT_L
#undef PG8_BAR
#undef PG8_SCHED
}
__device__ __forceinline__ int xcd_contig(long L, int nwg) { const int q = nwg / NXCD, r = nwg % NXCD, xcd = (int)(L % NXCD), off = (int)(L / NXCD); return (xcd < r ? xcd * (q + 1) : r * (q + 1) + (xcd - r) * q) + off; }
template <int nN>
struct SchedDense {
    int nM, pm0, G, c;
    __device__ __forceinline__ bool next(int i, Unit& u) const {
        const long L = (long)i * G + c; const int nwg = nM * nN; if (L >= nwg) return false;
        const int wgid = xcd_contig(L, nwg);
        constexpr int nig = WGM * nN; const int gid = wgid / nig, fm = gid * WGM, gsz = (nM - fm) < WGM ? (nM - fm) : WGM, w = wgid % nig;
        if (gsz == WGM) { u.pm = pm0 + fm + (w & (WGM - 1)); u.pn = w >> 3; } else { u.pm = pm0 + fm + (w % gsz); u.pn = w / gsz; }
        return true; }
    __device__ __forceinline__ void a_ready(const Unit&) const {}
    __device__ __forceinline__ void done(const Unit&) const {}
};
template <int nN>
struct SchedMoe {
    int T, G, c; const LAS int* tileE;
    __device__ __forceinline__ bool next(int i, Unit& u) const { const long L = (long)i * G + c; const int nwg = T * nN; if (L >= nwg) return false;
        const int wgid = xcd_contig(L, nwg), pt = wgid / nN; u.pm = pt; u.pn = tileE[pt] * nN + (wgid % nN); return true; }
    __device__ __forceinline__ void a_ready(const Unit&) const {}
    __device__ __forceinline__ void done(const Unit&) const {}
};
constexpr int EPI_BIAS_OFF = STAGE_BYTES + 8192;
struct EpiStore {
    static constexpr bool PERM = true, AFTER_DRAIN = false;
    bf16_t* O; int ldc;
    __device__ __forceinline__ void pre(LAS unsigned char*, int, const Unit&, int, int) const {}
    __device__ __forceinline__ void operator()(const f32x4 (&acc)[2][2][4][2], const Unit& u, int wr, int wc, int fr, int fq, const LAS unsigned char*, int) const {
        const int row0 = u.pm * BM + wr * 64 + fr, col0 = u.pn * BM + wc * 32 + 8 * fq;
#pragma unroll
        for (int ai = 0; ai < 2; ++ai)
#pragma unroll
            for (int m = 0; m < 4; ++m) { bf16_t* rowp = O + (size_t)(row0 + ai * HALF + m * 16) * ldc + col0;
#pragma unroll
                for (int bj = 0; bj < 2; ++bj) { const f32x4 v0 = acc[ai][bj][m][0], v1 = acc[ai][bj][m][1];
                    u32x4 w; w.x = cvt_pk_bf16(v0[0], v0[1]); w.y = cvt_pk_bf16(v0[2], v0[3]); w.z = cvt_pk_bf16(v1[0], v1[1]); w.w = cvt_pk_bf16(v1[2], v1[3]);
                    *(u32x4*)(rowp + bj * HALF) = w; } }
    }
};
struct EpiYE {
    static constexpr bool PERM = true, AFTER_DRAIN = false;
    bf16_t* O; const float* b2;
    __device__ __forceinline__ void pre(LAS unsigned char* lds, int par, const Unit& u, int wid, int lane) const {
        if (wid == 0) __builtin_amdgcn_global_load_lds((const unsigned*)(b2 + (u.pn >> 2) * 1024 + (u.pn & 3) * BM + lane * 4), (LAS unsigned*)(lds + EPI_BIAS_OFF + par * 1024), 16, 0, 0);
    }
    __device__ __forceinline__ void operator()(const f32x4 (&acc)[2][2][4][2], const Unit& u, int wr, int wc, int fr, int fq, const LAS unsigned char* lds, int par) const {
        const int pn = u.pn & 3;
        const int row0 = u.pm * BM + wr * 64 + fr, col0 = pn * BM + wc * 32 + 8 * fq;
        const LAS float* bp = (const LAS float*)(lds + EPI_BIAS_OFF + par * 1024) + wc * 32 + 8 * fq;
        f32x4 bv[2][2];
#pragma unroll
        for (int bj = 0; bj < 2; ++bj)
#pragma unroll
            for (int n = 0; n < 2; ++n) bv[bj][n] = *(const LAS f32x4*)(bp + bj * HALF + 4 * n);
#pragma unroll
        for (int ai = 0; ai < 2; ++ai)
#pragma unroll
            for (int m = 0; m < 4; ++m) { bf16_t* rowp = O + (size_t)(row0 + ai * HALF + m * 16) * 1024 + col0;
#pragma unroll
                for (int bj = 0; bj < 2; ++bj) { const f32x4 v0 = acc[ai][bj][m][0] + bv[bj][0], v1 = acc[ai][bj][m][1] + bv[bj][1];
                    u32x4 w; w.x = cvt_pk_bf16(v0[0], v0[1]); w.y = cvt_pk_bf16(v0[2], v0[3]); w.z = cvt_pk_bf16(v1[0], v1[1]); w.w = cvt_pk_bf16(v1[2], v1[3]);
                    *(u32x4*)(rowp + bj * HALF) = w; } }
    }
};
struct EpiAct {
    static constexpr bool PERM = true, AFTER_DRAIN = false;
    bf16_t* O; const float* b1;
    __device__ __forceinline__ void pre(LAS unsigned char* lds, int par, const Unit& u, int wid, int lane) const {
        if (wid == 0) __builtin_amdgcn_global_load_lds((const unsigned*)(b1 + (u.pn >> 3) * 2048 + (lane >> 5) * 1024 + (u.pn & 7) * 128 + (lane & 31) * 4), (LAS unsigned*)(lds + EPI_BIAS_OFF + par * 1024), 16, 0, 0);
    }
    __device__ __forceinline__ void operator()(const f32x4 (&acc)[2][2][4][2], const Unit& u, int wr, int wc, int fr, int fq, const LAS unsigned char* lds, int par) const {
        const int pn = u.pn & 7;
        const int row0 = u.pm * BM + wr * 64 + fr, x0 = pn * 128 + wc * 32 + 8 * fq;
        const LAS float* bg = (const LAS float*)(lds + EPI_BIAS_OFF + par * 1024) + wc * 32 + 8 * fq; const LAS float* bl = bg + 128;
        const f32x4 g0 = *(const LAS f32x4*)bg, g1 = *(const LAS f32x4*)(bg + 4), l0 = *(const LAS f32x4*)bl, l1 = *(const LAS f32x4*)(bl + 4);
#pragma unroll
        for (int ai = 0; ai < 2; ++ai)
#pragma unroll
            for (int m = 0; m < 4; ++m) {
                float o[8];
#pragma unroll
                for (int n = 0; n < 2; ++n)
#pragma unroll
                    for (int j = 0; j < 4; ++j) {
                        float glu = acc[ai][0][m][n][j] + (n ? g1[j] : g0[j]);
                        float lin = acc[ai][1][m][n][j] + (n ? l1[j] : l0[j]);
                        glu = fminf(glu, 7.0f); lin = fminf(fmaxf(lin, -7.0f), 7.0f);
                        o[n * 4 + j] = (lin + 1.0f) * glu * __builtin_amdgcn_rcpf(1.0f + __expf(-1.702f * glu));
                    }
                u32x4 w; w.x = cvt_pk_bf16(o[0], o[1]); w.y = cvt_pk_bf16(o[2], o[3]); w.z = cvt_pk_bf16(o[4], o[5]); w.w = cvt_pk_bf16(o[6], o[7]);
                *(u32x4*)(O + ((size_t)(u.pm * 16 + (x0 >> 6)) * 256 + (wr * 64 + fr + ai * HALF + m * 16)) * 64 + (x0 & 63)) = w;
            }
    }
};
}
using pg8::Unit;
__device__ __forceinline__ void my_sincos(double a, float& s, float& c) {
    const double n = rint(a * 0.63661977236758134308);
    const double r = (a - n * 1.57079632679489655800e+00) - n * 6.12323399573676603587e-17;
    const double r2 = r * r;
    const double sp = r * (1.0 + r2 * (-1.0 / 6.0 + r2 * (1.0 / 120.0 + r2 * (-1.0 / 5040.0 + r2 * (1.0 / 362880.0 + r2 * (-1.0 / 39916800.0 + r2 * (1.0 / 6227020800.0 + r2 * (-1.0 / 1307674368000.0))))))));
    const double cp = 1.0 + r2 * (-0.5 + r2 * (1.0 / 24.0 + r2 * (-1.0 / 720.0 + r2 * (1.0 / 40320.0 + r2 * (-1.0 / 3628800.0 + r2 * (1.0 / 479001600.0 + r2 * (-1.0 / 87178291200.0 + r2 * (1.0 / 20922789888000.0))))))));
    const int q = ((int)n) & 3;
    const double sn = q == 0 ? sp : q == 1 ? cp : q == 2 ? -sp : -cp;
    const double cn = q == 0 ? cp : q == 1 ? -sp : q == 2 ? -cp : sp;
    s = (float)sn; c = (float)cn;
}
__device__ __forceinline__ void ph_prologue(const Params& p, LAS unsigned char* lds, int bid, int nblk) {
    const int tid = threadIdx.x;
    unsigned char* ws = p.ws;
    {
        LAS float* sv = (LAS float*)(lds + LDS_WORK);
        LAS float* red = sv + 5 * 1024;
        for (int i = tid; i < 5 * 1024; i += NTHR) { const int r = i >> 10, k = i & 1023; const float c = r < 4 ? p.in[I_C][r * 1024 + k] : p.in[I_CCTX][k]; sv[i] = c / (1.0f + expf(-c)); }
        __syncthreads();
        float* MOD = (float*)(ws + WS_MOD);
        for (int item = bid; item < 256; item += nblk) {
            if (tid < 480) {
                const int cl = tid % 48, kp = tid / 48;
                const int gc = item * 48 + cl, l = gc / 6144, n = gc % 6144;
                const float* w = p.in[I_WMOD] + (size_t)l * 1024 * 6144 + n;
                float a0 = 0.f, a1 = 0.f, a2 = 0.f, a3 = 0.f, a4 = 0.f;
#pragma unroll 1
                for (int k0 = kp; k0 < 1024; k0 += 130) {
                    float wv[13];
#pragma unroll
                    for (int u = 0; u < 13; ++u) { const int k = k0 + 10 * u; wv[u] = k < 1024 ? w[(size_t)k * 6144] : 0.f; }
#pragma unroll
                    for (int u = 0; u < 13; ++u) { const int k = k0 + 10 * u < 1024 ? k0 + 10 * u : 1023; a0 += sv[k] * wv[u]; a1 += sv[1024 + k] * wv[u]; a2 += sv[2048 + k] * wv[u]; a3 += sv[3072 + k] * wv[u]; a4 += sv[4096 + k] * wv[u]; }
                }
                LAS float* rp = red + (kp * 48 + cl) * 5; rp[0] = a0; rp[1] = a1; rp[2] = a2; rp[3] = a3; rp[4] = a4;
            }
            __syncthreads();
            if (tid < 240) {
                const int cl = tid / 5, r = tid % 5; float s = 0.f;
                for (int kp = 0; kp < 10; ++kp) s += red[(kp * 48 + cl) * 5 + r];
                const int gc = item * 48 + cl, l = gc / 6144, n = gc % 6144;
                MOD[(size_t)(l * 5 + r) * 6144 + n] = s + p.in[I_BMOD][l * 6144 + n];
            }
            __syncthreads();
        }
    }
    if (bid == (nblk > 1 ? 1 : 0)) {
        float* ROPE = (float*)(ws + WS_ROPE);
        for (int i = tid; i < 2048; i += NTHR) { const int pos = i >> 5, f = i & 31; const double inv = exp(-(double)f * 0.28782313662425575); float s, c; my_sincos((double)pos * inv, s, c); ROPE[2 * i] = c; ROPE[2 * i + 1] = s; }
    }
    {
        bf16_t* WLT = (bf16_t*)(ws + WS_WLT);
        for (int i = bid * NTHR + tid; i < (int)WLT_N; i += nblk * NTHR) {
            float v;
            if (i < 131072) { const int which = i >> 16, r = i & 65535, d = r >> 15, n = (r >> 6) & 511, k = r & 63; v = (which ? p.in[I_AAB] : p.in[I_AWB])[(size_t)(d * 64 + k) * 512 + n]; }
            else if (i < 196608) { const int r = i - 131072, n = r >> 7, k = r & 127; v = p.in[I_AGB][(size_t)k * 512 + n]; }
            else { const int r = i - 196608, blk = r >> 12, o = (r >> 6) & 63, ii = r & 63; v = p.in[I_BGW][(size_t)blk * 4096 + ii * 64 + o]; }
            WLT[i] = f2bf(v);
        }
    }
    {
        LAS float* tile = (LAS float*)(lds + LDS_WORK);
        for (int t = bid; t < 576; t += nblk) {
            const float* src; int ld, nvalid, k0, n0, w1map = 0; bf16_t* dst; int tt = t;
            if (tt < 192) { k0 = (tt / 12) * 64; n0 = (tt % 12) * 256; src = p.in[I_EWIN]; ld = EVEN_IN; nvalid = EVEN_IN; dst = (bf16_t*)(ws + WS_WIN0T); }
            else if ((tt -= 192) < 256) { k0 = (tt >> 4) * 64; n0 = (tt & 15) * 256; src = p.in[I_OWIN]; ld = ODD_IN; nvalid = 4096; dst = (bf16_t*)(ws + WS_WIN1T); }
            else { tt -= 256; const int mat = tt >> 6, r = tt & 63; k0 = (r >> 2) * 64; n0 = (r & 3) * 256; src = mat ? p.in[I_OWOUT] : p.in[I_EWOUT]; ld = 1024; nvalid = 1024; dst = (bf16_t*)(ws + WS_WOUTT) + (size_t)mat * 1024 * 1024; }
            {
                const int j4 = (tid & 63) * 4, i0 = tid >> 6;
                f32x4 v[8];
#pragma unroll
                for (int r = 0; r < 8; ++r) v[r] = (n0 + j4 < nvalid) ? *(const f32x4*)(src + (size_t)(k0 + i0 + 8 * r) * ld + n0 + j4) : (f32x4){0.f, 0.f, 0.f, 0.f};
#pragma unroll
                for (int r = 0; r < 8; ++r) { LAS float* tp = tile + (i0 + 8 * r) * 257 + j4; tp[0] = v[r][0]; tp[1] = v[r][1]; tp[2] = v[r][2]; tp[3] = v[r][3]; }
            }
            __syncthreads();
            {
                const int ip = (tid & 31) * 2, j0 = tid >> 5;
#pragma unroll
                for (int r = 0; r < 16; ++r) {
                    const int j = j0 + 16 * r, n = n0 + j;
                    const int rho = w1map ? ((((n & 1023) >> 7) << 8) + ((n >> 10) << 7) + (n & 127)) : n;
                    *(unsigned*)(dst + (size_t)rho * 1024 + k0 + ip) = pack_bf16(tile[ip * 257 + j], tile[(ip + 1) * 257 + j]);
                }
            }
            __syncthreads();
        }
    }
}
__device__ __forceinline__ void ph_mod_in(const Params& p, int bid, int nblk) {
    const int tid = threadIdx.x, wid = tid >> 6, lane = tid & 63;
    const float* MOD = (const float*)(p.ws + WS_MOD);
    bf16_t* H = (bf16_t*)(p.ws + WS_H);
    for (int row = bid * 8 + wid; row < MROWS; row += nblk * 8) {
        const float* src = row < NCTX ? p.in[I_CTX] + (size_t)row * 1024 : p.in[I_X] + (size_t)(row - NCTX) * 1024;
        const float* md = MOD + (size_t)row_modr(row) * 6144;
#pragma unroll
        for (int q = 0; q < 4; ++q) {
            const int col = q * 256 + lane * 4;
            const f32x4 x = *(const f32x4*)(src + col), sh = *(const f32x4*)(md + col), sc = *(const f32x4*)(md + 1024 + col);
            const f32x4 h = x * (sc + 1.0f) + sh;
            u32x2 w; w.x = pack_bf16(h[0], h[1]); w.y = pack_bf16(h[2], h[3]);
            *(u32x2*)(H + (size_t)row * 1024 + col) = w;
        }
    }
}
__device__ __forceinline__ int even_tok_row(int w, int idx) { return idx < 64 ? NCTX + (w >> 6) * 4096 + (w & 63) * 64 + idx : w * 4 + (idx - 64); }
__device__ __forceinline__ int shift_nb(int row, int cc) {
    if (row >= NCTX) { const int s = (row - NCTX) & 4095, gr = s >> 6, gc = s & 63, slot = cc & 3;
        if (slot == 0) return gc > 0 ? row - 1 : -1;
        if (slot == 1) return gc < 63 ? row + 1 : -1;
        if (slot == 2) return gr > 0 ? row - 64 : -1;
        return gr < 63 ? row + 64 : -1; }
    const int t = row & 255; return (cc & 1) == 0 ? (t > 0 ? row - 1 : -1) : (t < 255 ? row + 1 : -1);
}
__device__ __forceinline__ float shifted_z(const bf16_t* P, const float* mu, int row, int cc) {
    const float pv = bf2f(P[(size_t)row * LDP0 + cc]); const int nb = shift_nb(row, cc);
    const float sv = nb >= 0 ? bf2f(P[(size_t)nb * LDP0 + cc]) : 0.f;
    return pv + (sv - pv) * mu[cc];
}
__device__ __forceinline__ int scan_q(int row, int d) {
    if (row < NCTX) { const int t = row & 255; return d ? 255 - t : t; }
    const int s = (row - NCTX) & 4095; return 256 + (d ? 4095 - s : s);
}
__device__ __forceinline__ bf16_t* sc_rec(float* SC, int d, int row, int h) { return (bf16_t*)SC + ((size_t)((d * 4 + row_batch(row)) * 8 + h) * SCLEN + scan_q(row, d)) * SCREC; }
constexpr int LDL = 392, LDU = 520;
template <int KS>
__device__ __forceinline__ void load_b(const bf16_t* Bt, bf16x8 (&b)[4][KS], int lane) {
    const int fr = lane & 15, fq = lane >> 4;
#pragma unroll
    for (int nt = 0; nt < 4; ++nt)
#pragma unroll
        for (int ks = 0; ks < KS; ++ks) b[nt][ks] = *(const bf16x8*)(Bt + (size_t)(nt * 16 + fr) * (32 * KS) + ks * 32 + fq * 8);
}
template <int KS>
__device__ __forceinline__ void mma_mt(const LAS bf16_t* A, int lda, int mt, const bf16x8 (&b)[4][KS], f32x4 (&acc)[4], int lane) {
    const int fr = lane & 15, fq = lane >> 4;
#pragma unroll
    for (int nt = 0; nt < 4; ++nt) acc[nt] = (f32x4){0.f, 0.f, 0.f, 0.f};
#pragma unroll
    for (int ks = 0; ks < KS; ++ks) {
        const bf16x8 a = *(const LAS bf16x8*)(A + (mt * 16 + fr) * lda + ks * 32 + fq * 8);
#pragma unroll
        for (int nt = 0; nt < 4; ++nt) acc[nt] = __builtin_amdgcn_mfma_f32_16x16x32_bf16(a, b[nt][ks], acc[nt], 0, 0, 0);
    }
}
__device__ __forceinline__ void ph_prep_even(const Params& p, LAS unsigned char* lds, int bid, int nblk) {
    const int tid = threadIdx.x, wid = tid >> 6, lane = tid & 63, c = tid, fr = lane & 15, fq = lane >> 4;
    const bf16_t* P = (const bf16_t*)(p.ws + WS_P);
    float* SC = (float*)(p.ws + WS_SC);
    float* EA = (float*)(p.ws + WS_EARR);
#define EARR(k) (EA + (size_t)(k) * ((size_t)MROWS * 512))
    float* BC = (float*)(p.ws + WS_BC);
    float* CHA = (float*)(p.ws + WS_CHA); float* CHH = (float*)(p.ws + WS_CHH);
    const bf16_t* WLT = (const bf16_t*)(p.ws + WS_WLT);
    const float* mu = p.in[I_AMU];
    LAS bf16_t* linb = (LAS bf16_t*)(lds + LDS_WORK);
    LAS bf16_t* ub = linb + 80 * LDL;
    LAS float* rnorm = (LAS float*)(ub + 80 * LDU);
    for (int w = bid; w < 256; w += nblk) {
        for (int i = tid; i < 12 * LDL; i += NTHR) linb[68 * LDL + i] = 0;
        for (int i = tid; i < 12 * LDU; i += NTHR) ub[68 * LDU + i] = 0;
#pragma unroll 1
        for (int g = 0; g < 3; ++g) {
            float pv[17], sv[17];
#pragma unroll
            for (int u = 0; u < 17; ++u) { const int e = tid + NTHR * (g * 17 + u), tok = e / 384, j = e - tok * 384, row = even_tok_row(w, tok), nb = shift_nb(row, 1536 + j);
                pv[u] = bf2f(P[(size_t)row * LDP0 + 1536 + j]); sv[u] = nb >= 0 ? bf2f(P[(size_t)nb * LDP0 + 1536 + j]) : 0.f; }
#pragma unroll
            for (int u = 0; u < 17; ++u) { const int e = tid + NTHR * (g * 17 + u), tok = e / 384, j = e - tok * 384;
                const float z = pv[u] + (sv[u] - pv[u]) * mu[1536 + j];
                linb[tok * LDL + j] = f2bf(j < 128 ? ftanh(z) : (j < 256 ? z : sigm(z))); }
        }
        {
            const float kkc = p.in[I_AKK][c], mur = mu[c], muk = mu[512 + c], muv = mu[1024 + c];
#pragma unroll 1
            for (int t0 = 0; t0 < 68; t0 += 8) {
                float pr[8], pk[8], pv[8], sr[8], sk[8], sv[8];
#pragma unroll
                for (int u = 0; u < 8; ++u) { const int tk = t0 + u < 68 ? t0 + u : 67; const int row = even_tok_row(w, tk); const int nb = shift_nb(row, c);
                    const bf16_t* pp = P + (size_t)row * LDP0 + c; pr[u] = bf2f(pp[0]); pk[u] = bf2f(pp[512]); pv[u] = bf2f(pp[1024]);
                    if (nb >= 0) { const bf16_t* pn = P + (size_t)nb * LDP0 + c; sr[u] = bf2f(pn[0]); sk[u] = bf2f(pn[512]); sv[u] = bf2f(pn[1024]); } else { sr[u] = 0.f; sk[u] = 0.f; sv[u] = 0.f; } }
#pragma unroll
                for (int u = 0; u < 8; ++u) if (t0 + u < 68) { const int row = even_tok_row(w, t0 + u);
                    const float zr = pr[u] + (sr[u] - pr[u]) * mur, zk = pk[u] + (sk[u] - pk[u]) * muk, zv = pv[u] + (sv[u] - pv[u]) * muv;
                    const float kkr = zk * kkc, ss = wave_sum(kkr * kkr), rn = frcp(fmaxf(fsqrt(ss), 1e-12f)), kk = kkr * rn;
                    if (lane == 0) rnorm[(t0 + u) * 8 + wid] = rn;
#pragma unroll
                    for (int d = 0; d < 2; ++d) { bf16_t* rec = sc_rec(SC, d, row, wid) + lane; rec[128] = f2bf(kk); rec[320] = f2bf(zr); rec[384] = f2bf(zv); } }
            }
        }
        {
            const float cw0 = p.in[I_BCW][c], cw1 = p.in[I_BCW][512 + c], cw2 = p.in[I_BCW][1024 + c], cw3 = p.in[I_BCW][1536 + c], cb = p.in[I_BCB][c];
#pragma unroll 1
            for (int t0 = 0; t0 < 68; t0 += 8) {
                float x0[8], x1[8], x2[8], x3[8], gx[8];
#pragma unroll
                for (int u = 0; u < 8; ++u) { const int tk = t0 + u < 68 ? t0 + u : 67; const int row = even_tok_row(w, tk);
                    int pos, len;
                    if (row >= NCTX) { pos = (row - NCTX) & 4095; len = 4096; } else { pos = row & 255; len = 256; }
                    x0[u] = pos >= 2 ? bf2f(P[(size_t)(row - 2) * LDP0 + 1920 + c]) : 0.f; x1[u] = pos >= 1 ? bf2f(P[(size_t)(row - 1) * LDP0 + 1920 + c]) : 0.f;
                    x2[u] = bf2f(P[(size_t)row * LDP0 + 1920 + c]); x3[u] = pos + 1 < len ? bf2f(P[(size_t)(row + 1) * LDP0 + 1920 + c]) : 0.f;
                    gx[u] = bf2f(P[(size_t)row * LDP0 + 1920 + 512 + c]); }
#pragma unroll
                for (int u = 0; u < 8; ++u) if (t0 + u < 68) { const int tok = t0 + u, row = even_tok_row(w, tok);
                    const float uu = cb + cw0 * x0[u] + cw1 * x1[u] + cw2 * x2[u] + cw3 * x3[u];
                    ub[tok * LDU + c] = f2bf(uu);
                    const size_t o = (size_t)row * 512 + c;
                    ((bf16_t*)EARR(E_GATE))[o] = f2bf(0.5f * gx[u] * (1.0f + ftanh(0.7978845608028654f * (gx[u] + 0.044715f * gx[u] * gx[u] * gx[u])))); }
            }
        }
        __syncthreads();
#pragma unroll 1
        for (int d = 0; d < 2; ++d) {
            {
                bf16x8 bw[4][2]; load_b<2>(WLT + WLT_WB + (size_t)(d * 512 + wid * 64) * 64, bw, lane);
                float w0v[4];
#pragma unroll
                for (int nt = 0; nt < 4; ++nt) w0v[nt] = p.in[I_AW0][d * 512 + wid * 64 + nt * 16 + fr];
#pragma unroll 1
                for (int mt = 0; mt < 5; ++mt) {
                    f32x4 acc[4]; mma_mt<2>(linb + d * 64, LDL, mt, bw, acc, lane);
#pragma unroll
                    for (int r = 0; r < 4; ++r) { const int tok = mt * 16 + fq * 4 + r;
                        if (tok < 68) { float* rec = (float*)sc_rec(SC, d, even_tok_row(w, tok), wid) + fr;
#pragma unroll
                            for (int nt = 0; nt < 4; ++nt) rec[nt * 16] = -0.60653065971263342f * sigm(w0v[nt] + acc[nt][r]);   } }
                }
            }
            {
                bf16x8 bw[4][2]; load_b<2>(WLT + WLT_AB + (size_t)(d * 512 + wid * 64) * 64, bw, lane);
                float a0v[4], kav[4], mukv[4], kkcv[4];
#pragma unroll
                for (int nt = 0; nt < 4; ++nt) { const int n = wid * 64 + nt * 16 + fr; a0v[nt] = p.in[I_AA0][d * 512 + n]; kav[nt] = p.in[I_AKA][n]; mukv[nt] = mu[512 + n]; kkcv[nt] = p.in[I_AKK][n]; }
#pragma unroll 1
                for (int mt = 0; mt < 5; ++mt) {
                    f32x4 acc[4]; mma_mt<2>(linb + 128 + d * 64, LDL, mt, bw, acc, lane);
                    float pkv[4][4], skv[4][4];
#pragma unroll
                    for (int r = 0; r < 4; ++r) { const int tok = mt * 16 + fq * 4 + r, row = even_tok_row(w, tok < 68 ? tok : 0);
#pragma unroll
                        for (int nt = 0; nt < 4; ++nt) { const int n = wid * 64 + nt * 16 + fr, nb = shift_nb(row, n);
                            pkv[r][nt] = bf2f(P[(size_t)row * LDP0 + 512 + n]); skv[r][nt] = nb >= 0 ? bf2f(P[(size_t)nb * LDP0 + 512 + n]) : 0.f; } }
#pragma unroll
                    for (int r = 0; r < 4; ++r) { const int tok = mt * 16 + fq * 4 + r;
                        if (tok < 68) { bf16_t* rec = sc_rec(SC, d, even_tok_row(w, tok), wid) + fr; const float rn = rnorm[tok * 8 + wid];
#pragma unroll
                            for (int nt = 0; nt < 4; ++nt) { const float a = sigm(a0v[nt] + acc[nt][r]);
                                const float zk = pkv[r][nt] + (skv[r][nt] - pkv[r][nt]) * mukv[nt];
                                rec[192 + nt * 16] = f2bf(zk * (1.0f + (a - 1.0f) * kav[nt])); rec[256 + nt * 16] = f2bf(zk * kkcv[nt] * rn * a); } } }
                }
            }
        }
        {
            bf16x8 bw[4][4]; load_b<4>(WLT + WLT_GB + (size_t)(wid * 64) * 128, bw, lane);
            bf16_t* G = (bf16_t*)EARR(E_G);
#pragma unroll 1
            for (int mt = 0; mt < 5; ++mt) {
                f32x4 acc[4]; mma_mt<4>(linb + 256, LDL, mt, bw, acc, lane);
#pragma unroll
                for (int r = 0; r < 4; ++r) { const int tok = mt * 16 + fq * 4 + r;
                    if (tok < 68) { bf16_t* gp = G + (size_t)even_tok_row(w, tok) * 512 + wid * 64 + fr;
#pragma unroll
                        for (int nt = 0; nt < 4; ++nt) gp[nt * 16] = f2bf(acc[nt][r]); } }
            }
        }
#pragma unroll 1
        for (int d = 0; d < 2; ++d) {
            bf16x8 b0[4][2];
            load_b<2>(WLT + WLT_GW + (size_t)(((d * 2 + 0) * 8 + wid) * 64) * 64, b0, lane);
            float gb0[4], gb1[4], spl[4];
#pragma unroll
            for (int nt = 0; nt < 4; ++nt) { const int n = wid * 64 + nt * 16 + fr; gb0[nt] = p.in[I_BGB][(d * 2 + 0) * 512 + n]; gb1[nt] = p.in[I_BGB][(d * 2 + 1) * 512 + n]; spl[nt] = softplusf(-p.in[I_BLAM][d * 512 + n]); }
            float* Ad = EARR(E_A0 + d); float* BXd = EARR(E_BX0 + d);
#pragma unroll 1
            for (int mt = 0; mt < 5; ++mt) {
                f32x4 la[4], acc[4];
                mma_mt<2>(ub + wid * 64, LDU, mt, b0, la, lane);
                { bf16x8 b1[4][2]; load_b<2>(WLT + WLT_GW + (size_t)(((d * 2 + 1) * 8 + wid) * 64) * 64, b1, lane); mma_mt<2>(ub + wid * 64, LDU, mt, b1, acc, lane); }
#pragma unroll
                for (int r = 0; r < 4; ++r) { const int tok = mt * 16 + fq * 4 + r;
                    if (tok < 68) { const size_t o = (size_t)even_tok_row(w, tok) * 512 + wid * 64 + fr;
#pragma unroll
                        for (int nt = 0; nt < 4; ++nt) { const float lg = -8.0f * sigm(gb0[nt] + la[nt][r]) * spl[nt];
                            const float av = fexp(lg); Ad[o + nt * 16] = av; BXd[o + nt * 16] = fsqrt(fmaxf(1.0f - av * av, 0.f)) * sigm(gb1[nt] + acc[nt][r]) * bf2f(ub[tok * LDU + wid * 64 + nt * 16 + fr]);         } } }
            }
        }
        __syncthreads();
        {
            const float rk = p.in[I_ARK][c];
#pragma unroll 1
            for (int t0 = 0; t0 < 68; t0 += 17) {
                float a[17], b0[17], b1[17];
#pragma unroll
                for (int u = 0; u < 17; ++u) { const int row = even_tok_row(w, t0 + u); const bf16_t* r0 = sc_rec(SC, 0, row, wid) + lane; const bf16_t* r1 = sc_rec(SC, 1, row, wid) + lane;
                    a[u] = bf2f(r0[320]); b0[u] = bf2f(r0[192]); b1[u] = bf2f(r1[192]); }
#pragma unroll
                for (int u = 0; u < 17; ++u) { const float sm = wave_sum(a[u] * (b0[u] + b1[u]) * rk); if (lane == 0) BC[even_tok_row(w, t0 + u) * 8 + wid] = sm; }
            }
        }
#pragma unroll 1
        for (int d = 0; d < 2; ++d) {
            float* Ad = EARR(E_A0 + d); float* BXd = EARR(E_BX0 + d);
            float h = 0.f, cum = 1.f;
#pragma unroll 1
            for (int n0 = 0; n0 < 64; n0 += 16) {
                float av[16], bv[16];
#pragma unroll
                for (int i = 0; i < 16; ++i) { const int tok = d == 0 ? n0 + i : 63 - n0 - i; const size_t o = (size_t)even_tok_row(w, tok) * 512 + c; av[i] = Ad[o]; bv[i] = BXd[o]; }
#pragma unroll
                for (int i = 0; i < 16; ++i) { const int tok = d == 0 ? n0 + i : 63 - n0 - i; const size_t o = (size_t)even_tok_row(w, tok) * 512 + c;
                    h = av[i] * h + bv[i]; cum *= av[i]; Ad[o] = cum; BXd[o] = h; }
            }
            { const int cid = (w >> 6) * 128 + 64 + (w & 63); CHA[(size_t)(d * 512 + cid) * 512 + c] = cum; CHH[(size_t)(d * 512 + cid) * 512 + c] = h; }
            h = 0.f; cum = 1.f;
#pragma unroll
            for (int i = 0; i < 4; ++i) { const int tok = 64 + (d == 0 ? i : 3 - i); const size_t o = (size_t)even_tok_row(w, tok) * 512 + c;
                const float a = Ad[o], bx = BXd[o]; h = a * h + bx; cum *= a; Ad[o] = cum; BXd[o] = h; }
            { const int cid = (w >> 6) * 128 + (w & 63); CHA[(size_t)(d * 512 + cid) * 512 + c] = cum; CHH[(size_t)(d * 512 + cid) * 512 + c] = h; }
        }
        __syncthreads();
    }
}
__device__ __forceinline__ float vfma(float a, float b, float c) { float d; asm("v_fma_f32 %0, %1, %2, %3" : "=v"(d) : "v"(a), "v"(b), "v"(c)); return d; }
__device__ __forceinline__ float vmul(float a, float b) { float d; asm("v_mul_f32 %0, %1, %2" : "=v"(d) : "v"(a), "v"(b)); return d; }
#define WG_BAR() do { asm volatile("" ::: "memory"); __builtin_amdgcn_s_barrier(); asm volatile("" ::: "memory"); } while (0)
__device__ __forceinline__ int scan_row(int d, int b, int q) {
    if (q < 256) return b * 256 + (d ? 255 - q : q);
    const int s = q - 256; return NCTX + b * 4096 + (d ? 4095 - s : s);
}
__device__ __forceinline__ void ph_fin_even(const Params& p, int bid, int nblk) {
    const int tid = threadIdx.x, wid = tid >> 6, c = tid;
    float* EA = (float*)(p.ws + WS_EARR);
    float* SC = (float*)(p.ws + WS_SC);
    const float* BC = (const float*)(p.ws + WS_BC); const float* CIN = (const float*)(p.ws + WS_CIN);
    bf16_t* Y = (bf16_t*)(p.ws + WS_YMIX);
    const float gg = p.in[I_AGNG][c], gb = p.in[I_AGNB][c];
    for (int r0 = bid * 4; r0 < MROWS; r0 += nblk * 4) {
        float o0[4], o1[4], vv[4], gv[4], bc[4], x0[4], x1[4], a0[4], a1[4], c0[4], c1[4], gt[4];
#pragma unroll
        for (int u = 0; u < 4; ++u) { const int row = r0 + u; const size_t o = (size_t)row * 512 + c;
            const int cid = row < NCTX ? (row >> 8) * 128 + ((row >> 2) & 63) : ((row - NCTX) >> 12) * 128 + 64 + (((row - NCTX) & 4095) >> 6);
            o0[u] = bf2f(((const bf16_t*)EARR(E_O0))[o]); o1[u] = bf2f(((const bf16_t*)EARR(E_O1))[o]); vv[u] = bf2f(sc_rec(SC, 0, row, wid)[384 + (tid & 63)]); gv[u] = bf2f(((const bf16_t*)EARR(E_G))[o]); bc[u] = BC[row * 8 + wid];
            x0[u] = EARR(E_BX0)[o]; x1[u] = EARR(E_BX1)[o]; a0[u] = EARR(E_A0)[o]; a1[u] = EARR(E_A1)[o];
            c0[u] = CIN[(size_t)cid * 512 + c]; c1[u] = CIN[(size_t)(512 + cid) * 512 + c]; gt[u] = bf2f(((const bf16_t*)EARR(E_GATE))[o]); }
#pragma unroll
        for (int u = 0; u < 4; ++u) { const int row = r0 + u;
            const float wkv = o0[u] + o1[u];
            const float mean = wave_sum(wkv) * (1.0f / 64.0f), dv = wkv - mean, var = wave_sum(dv * dv) * (1.0f / 64.0f);
            const float y = (dv * rsqrtf(var + 64e-5f) * gg + gb + bc[u] * vv[u]) * gv[u];
            Y[(size_t)row * 1024 + c] = f2bf(y);
            Y[(size_t)row * 1024 + 512 + c] = f2bf(((x0[u] + a0[u] * c0[u]) + (x1[u] + a1[u] * c1[u])) * gt[u]); }
    }
#undef EARR
}
constexpr int LDT = 72;
__device__ __forceinline__ float quad_sum(float v) {
    v += __int_as_float(__builtin_amdgcn_update_dpp(0, __float_as_int(v), 0xB1, 0xf, 0xf, false));
    v += __int_as_float(__builtin_amdgcn_update_dpp(0, __float_as_int(v), 0x4E, 0xf, 0xf, false));
    return v;
}
template <int PO> __device__ __forceinline__ float quad_bcast(float v) { return __int_as_float(__builtin_amdgcn_update_dpp(0, __float_as_int(v), PO * 0x55, 0xf, 0xf, false)); }
__device__ __forceinline__ bf16x8 ldt8(const LAS bf16_t* T, int row, int col) { return *(const LAS bf16x8*)(T + row * LDT + col); }
__device__ __forceinline__ void ph_r1(const Params& p, LAS unsigned char* lds, int bid, int nblk) {
    const int tid = threadIdx.x, wid = tid >> 6, lane = tid & 63, fr = lane & 15, fq = lane >> 4;
    LAS bf16_t* T0 = (LAS bf16_t*)(lds + LDS_WORK);
#define TL(i) (T0 + (i) * 64 * LDT)
    LAS float* F0 = (LAS float*)(T0 + 11 * 64 * LDT);
    LAS float* F1 = F0 + 4096;
    LAS float* F2 = F1 + 4096;
    LAS float* segt = F2 + 4096;
    LAS float* gl = segt + 512;
    const float* SC = (const float*)(p.ws + WS_SC);
    float* RU = (float*)(p.ws + WS_RU);
    const int k = tid & 63, seg = tid >> 6, t0 = seg * 8;
    const int tr = (wid >> 1) * 16, tc0 = (wid & 1) * 32;
    float kk[8], lw[8], kd[8], ka[8], rr[8], vv[8];
    auto fetch = [&](int unit) {
        const int chain = unit / NRCH, c = unit - chain * NRCH;
        const bf16_t* rec = (const bf16_t*)SC + ((size_t)chain * SCLEN + c * RCH + t0) * SCREC + k;
#pragma unroll
        for (int u = 0; u < 8; ++u) { const bf16_t* r = rec + u * SCREC; lw[u] = ((const float*)(r - k))[k]; kk[u] = bf2f(r[128]); kd[u] = bf2f(r[192]); ka[u] = bf2f(r[256]); rr[u] = bf2f(r[320]); vv[u] = bf2f(r[384]); }
    };
    if (bid < NRUNIT) fetch(bid);
    for (int unit = bid; unit < NRUNIT; unit += nblk) {
        float cum[8]; { float run = 0.f;
#pragma unroll
            for (int u = 0; u < 8; ++u) { run += lw[u]; cum[u] = run; }
            segt[seg * 64 + k] = run; }
        __syncthreads();
        float off = 0.f, tot = 0.f;
#pragma unroll
        for (int s2 = 0; s2 < 8; ++s2) { const float v = segt[s2 * 64 + k]; off += s2 < seg ? v : 0.f; tot += v; }
        if (seg == 0) gl[k] = fexp(tot);
        {
            u32x4 wk, wb, wv; unsigned pk[4], pb[4], pv[4]; float hk = 0.f, hb = 0.f, hv = 0.f;
#pragma unroll
            for (int u = 0; u < 8; ++u) { const int t = t0 + u; const float cu = cum[u] + off;
                const float ginc = fexp(cu), gexc = fexp(cu - lw[u]), ginv = fexp(-cu), gtail = fexp(tot - cu);
                const float kt = kk[u] * gexc;
                TL(0)[t * LDT + k] = f2bf(kt); F0[t * 64 + k] = kt;
                TL(1)[t * LDT + k] = f2bf(kd[u] * ginv); TL(2)[t * LDT + k] = f2bf(ka[u] * ginv); TL(3)[t * LDT + k] = f2bf(rr[u] * ginc);
                const float ktl = kd[u] * gtail, btl = ka[u] * gtail;
                if (u & 1) { pk[u >> 1] = pack_bf16(hk, ktl); pb[u >> 1] = pack_bf16(hb, btl); pv[u >> 1] = pack_bf16(hv, vv[u]); } else { hk = ktl; hb = btl; hv = vv[u]; } }
            wk.x = pk[0]; wk.y = pk[1]; wk.z = pk[2]; wk.w = pk[3]; wb.x = pb[0]; wb.y = pb[1]; wb.z = pb[2]; wb.w = pb[3]; wv.x = pv[0]; wv.y = pv[1]; wv.z = pv[2]; wv.w = pv[3];
            *(LAS u32x4*)(TL(4) + k * LDT + t0) = wk; *(LAS u32x4*)(TL(5) + k * LDT + t0) = wb; *(LAS u32x4*)(TL(6) + k * LDT + t0) = wv;
        }
        if (unit + nblk < NRUNIT) fetch(unit + nblk);
        __syncthreads();
        {
            f32x4 mk[2], mb[2], ak[2], ab[2];
#pragma unroll
            for (int nt = 0; nt < 2; ++nt) { mk[nt] = (f32x4){0.f, 0.f, 0.f, 0.f}; mb[nt] = mk[nt]; ak[nt] = mk[nt]; ab[nt] = mk[nt]; }
#pragma unroll
            for (int ks = 0; ks < 2; ++ks) { const bf16x8 aK = ldt8(TL(0), tr + fr, ks * 32 + fq * 8), aR = ldt8(TL(3), tr + fr, ks * 32 + fq * 8);
#pragma unroll
                for (int nt = 0; nt < 2; ++nt) { const bf16x8 bK = ldt8(TL(1), tc0 + nt * 16 + fr, ks * 32 + fq * 8), bB = ldt8(TL(2), tc0 + nt * 16 + fr, ks * 32 + fq * 8);
                    mk[nt] = __builtin_amdgcn_mfma_f32_16x16x32_bf16(aK, bK, mk[nt], 0, 0, 0); mb[nt] = __builtin_amdgcn_mfma_f32_16x16x32_bf16(aK, bB, mb[nt], 0, 0, 0);
                    ak[nt] = __builtin_amdgcn_mfma_f32_16x16x32_bf16(aR, bK, ak[nt], 0, 0, 0); ab[nt] = __builtin_amdgcn_mfma_f32_16x16x32_bf16(aR, bB, ab[nt], 0, 0, 0); } }
#pragma unroll
            for (int nt = 0; nt < 2; ++nt)
#pragma unroll
                for (int r = 0; r < 4; ++r) { const int t = tr + fq * 4 + r, j = tc0 + nt * 16 + fr;
                    TL(7)[t * LDT + j] = f2bf(j < t ? mk[nt][r] : 0.f); F1[j * 64 + (t & 3) * 16 + (t >> 2)] = j < t ? mb[nt][r] : 0.f;
                    TL(8)[t * LDT + j] = f2bf(j <= t ? ak[nt][r] : 0.f); TL(9)[t * LDT + j] = f2bf(j <= t ? ab[nt][r] : 0.f); }
        }
        __syncthreads();
        {
            f32x4 acc[2] = {(f32x4){0.f, 0.f, 0.f, 0.f}, (f32x4){0.f, 0.f, 0.f, 0.f}};
#pragma unroll
            for (int ks = 0; ks < 2; ++ks) { const bf16x8 a = ldt8(TL(7), tr + fr, ks * 32 + fq * 8);
#pragma unroll
                for (int nt = 0; nt < 2; ++nt) acc[nt] = __builtin_amdgcn_mfma_f32_16x16x32_bf16(a, ldt8(TL(6), tc0 + nt * 16 + fr, ks * 32 + fq * 8), acc[nt], 0, 0, 0); }
#pragma unroll
            for (int nt = 0; nt < 2; ++nt)
#pragma unroll
                for (int r = 0; r < 4; ++r) F2[(tr + fq * 4 + r) * 64 + tc0 + nt * 16 + fr] = acc[nt][r];
        }
        __syncthreads();
        {
            const int col = tid >> 2, part = tid & 3;
            f32x2 acc2[8]; float x[16];
#pragma unroll
            for (int q = 0; q < 16; ++q) { const int t = 4 * q + part; acc2[q >> 1][q & 1] = col < 64 ? F0[t * 64 + col] : F2[t * 64 + col - 64]; x[q] = 0.f; }
#pragma unroll
            for (int t = 0; t < 64; ++t) {
                const int qo = t >> 2, po = t & 3; const float aq = acc2[qo >> 1][qo & 1];
                const float xt = po == 0 ? quad_bcast<0>(aq) : po == 1 ? quad_bcast<1>(aq) : po == 2 ? quad_bcast<2>(aq) : quad_bcast<3>(aq);
                x[qo] = part == po ? xt : x[qo];
                const f32x2 nx = {-xt, -xt};
#pragma unroll
                for (int q4 = qo >> 2; q4 < 4; ++q4) { const f32x4 m = *(const LAS f32x4*)(F1 + t * 64 + part * 16 + q4 * 4);
                    acc2[q4 * 2] = (f32x2){m[0], m[1]} * nx + acc2[q4 * 2]; acc2[q4 * 2 + 1] = (f32x2){m[2], m[3]} * nx + acc2[q4 * 2 + 1]; }
            }
            LAS bf16_t* dstT = col < 64 ? TL(7) + col * LDT : TL(10) + (col - 64) * LDT;
#pragma unroll
            for (int q = 0; q < 16; ++q) dstT[4 * q + part] = f2bf(-x[q]);
        }
        __syncthreads();
        {
            f32x4 rh[2], ol[2], pm[2], qq[2];
#pragma unroll
            for (int nt = 0; nt < 2; ++nt) { rh[nt] = (f32x4){0.f, 0.f, 0.f, 0.f}; ol[nt] = rh[nt]; pm[nt] = rh[nt]; qq[nt] = rh[nt]; }
#pragma unroll
            for (int ks = 0; ks < 2; ++ks) { const int kc = ks * 32 + fq * 8;
                const bf16x8 a7 = ldt8(TL(7), tr + fr, kc), a8 = ldt8(TL(8), tr + fr, kc), a9 = ldt8(TL(9), tr + fr, kc), a6 = ldt8(TL(6), tr + fr, kc), a10 = ldt8(TL(10), tr + fr, kc);
#pragma unroll
                for (int nt = 0; nt < 2; ++nt) { const int br = tc0 + nt * 16 + fr;
                    const bf16x8 b9 = ldt8(TL(9), br, kc), b6 = ldt8(TL(6), br, kc), b10 = ldt8(TL(10), br, kc), b5 = ldt8(TL(5), br, kc), b4 = ldt8(TL(4), br, kc);
                    rh[nt] = __builtin_amdgcn_mfma_f32_16x16x32_bf16(a7, b9, rh[nt], 0, 0, 0);
                    ol[nt] = __builtin_amdgcn_mfma_f32_16x16x32_bf16(a8, b6, ol[nt], 0, 0, 0); ol[nt] = __builtin_amdgcn_mfma_f32_16x16x32_bf16(a9, b10, ol[nt], 0, 0, 0);
                    pm[nt] = __builtin_amdgcn_mfma_f32_16x16x32_bf16(a7, b5, pm[nt], 0, 0, 0);
                    qq[nt] = __builtin_amdgcn_mfma_f32_16x16x32_bf16(a6, b4, qq[nt], 0, 0, 0); qq[nt] = __builtin_amdgcn_mfma_f32_16x16x32_bf16(a10, b5, qq[nt], 0, 0, 0); } }
            float* U = RU + (size_t)unit * 4 * 4096;
#pragma unroll
            for (int nt = 0; nt < 2; ++nt)
#pragma unroll
                for (int r = 0; r < 4; ++r) { const int row = tr + fq * 4 + r, cx = tc0 + nt * 16 + fr; const int o = row * 64 + cx;
                    U[o] = pm[nt][r] + (row == cx ? gl[row] : 0.f);
                    U[4096 + o] = qq[nt][r];
                    U[8192 + o] = rh[nt][r] + bf2f(TL(3)[cx * LDT + row]);
                    U[12288 + o] = ol[nt][r]; }
        }
        __syncthreads();
    }
#undef TL
}
__device__ __forceinline__ void moe_weight_tiles(const Params& p, LAS unsigned char* lds, int first, int stride) {
    const int tid = threadIdx.x; unsigned char* ws = p.ws;
    LAS float* tile = (LAS float*)(lds + LDS_WORK);
    const int j4 = (tid & 31) * 4, i0 = tid >> 5;
    auto decode = [&](int tt, const float*& src, int& ld, int& k0, int& n0, int& w1map, bf16_t*& dst) {
        if (tt < 8192) { const int mat = tt >> 7, r = tt & 127; k0 = (r >> 4) * 128; n0 = (r & 15) * 128; src = p.in[I_W1] + (size_t)mat * 1024 * 2048; ld = 2048; dst = (bf16_t*)(ws + WS_W1T) + (size_t)mat * 2048 * 1024; w1map = 1; }
        else { tt -= 8192; const int mat = tt >> 6, r = tt & 63; k0 = (r >> 3) * 128; n0 = (r & 7) * 128; src = p.in[I_W2] + (size_t)mat * 1024 * 1024; ld = 1024; dst = (bf16_t*)(ws + WS_W2T) + (size_t)mat * 1024 * 1024; w1map = 0; }
    };
    f32x4 v[8];
    if (first < 12288) { const float* src; int ld, k0, n0, w1; bf16_t* dst; decode(first, src, ld, k0, n0, w1, dst);
#pragma unroll
        for (int r = 0; r < 8; ++r) v[r] = __builtin_nontemporal_load((const f32x4*)(src + (size_t)(k0 + i0 + 16 * r) * ld + n0 + j4)); }
    for (int t = first; t < 12288; t += stride) {
        const float* src; int ld, k0, n0, w1map; bf16_t* dst; decode(t, src, ld, k0, n0, w1map, dst);
#pragma unroll
        for (int r = 0; r < 8; ++r) { LAS float* tp = tile + (i0 + 16 * r) * 129 + j4; tp[0] = v[r][0]; tp[1] = v[r][1]; tp[2] = v[r][2]; tp[3] = v[r][3]; }
        __syncthreads();
        if (t + stride < 12288) { const float* s2; int ld2, k2, n2, w2; bf16_t* d2; decode(t + stride, s2, ld2, k2, n2, w2, d2);
#pragma unroll
            for (int r = 0; r < 8; ++r) v[r] = __builtin_nontemporal_load((const f32x4*)(s2 + (size_t)(k2 + i0 + 16 * r) * ld2 + n2 + j4)); }
        { const int ip = (tid & 15) * 8, j0 = tid >> 4;
            const int rho0 = w1map ? ((((n0 & 1023) >> 7) << 8) + ((n0 >> 10) << 7)) : n0;
#pragma unroll
            for (int r = 0; r < 4; ++r) { const int j = j0 + 32 * r;
                u32x4 w; w.x = pack_bf16(tile[ip * 129 + j], tile[(ip + 1) * 129 + j]); w.y = pack_bf16(tile[(ip + 2) * 129 + j], tile[(ip + 3) * 129 + j]);
                w.z = pack_bf16(tile[(ip + 4) * 129 + j], tile[(ip + 5) * 129 + j]); w.w = pack_bf16(tile[(ip + 6) * 129 + j], tile[(ip + 7) * 129 + j]);
                const int rho = rho0 + j, kk8 = k0 + ip; *(u32x4*)(dst + ((size_t)((rho >> 8) * 16 + (kk8 >> 6)) * 256 + (rho & 255)) * 64 + (kk8 & 63)) = w; } }
        __syncthreads();
    }
}
__device__ __forceinline__ void ph_r2(const Params& p, LAS unsigned char* lds, int bid, int nblk) {
    const int tid = threadIdx.x, wid = tid >> 6, lane = tid & 63, fr = lane & 15, g = lane >> 4;
    const int nchainwg = nblk >= 128 ? 64 : 0;
    if (bid >= nchainwg) {
        const int nconv = nblk - nchainwg, cb = bid - nchainwg;
        if (tid < 256) {
            const float* CHA = (const float*)(p.ws + WS_CHA); const float* CHH = (const float*)(p.ws + WS_CHH); float* CIN = (float*)(p.ws + WS_CIN);
            for (int item = cb; item < 16; item += nconv) {
                const int gi = item * 256 + tid, d = gi >> 11, b = (gi >> 9) & 3, c = gi & 511;
                float carry = 0.f;
                for (int s0 = 0; s0 < 128; s0 += 16) {
                    float av[16], hv[16];
#pragma unroll
                    for (int q = 0; q < 16; ++q) { const int st = s0 + q; const int cl = d == 0 ? st : (st < 64 ? 63 - st : 191 - st);
                        const size_t o = (size_t)(d * 512 + b * 128 + cl) * 512 + c; av[q] = CHA[o]; hv[q] = CHH[o]; }
#pragma unroll
                    for (int q = 0; q < 16; ++q) { const int st = s0 + q; const int cl = d == 0 ? st : (st < 64 ? 63 - st : 191 - st);
                        CIN[(size_t)(d * 512 + b * 128 + cl) * 512 + c] = carry; carry = av[q] * carry + hv[q]; }
                }
            }
        }
        __syncthreads();
        moe_weight_tiles(p, lds, cb, nconv);
        if (nchainwg) return;
    }
    LAS float* ring = (LAS float*)(lds + LDS_WORK);
    const float* RU = (const float*)(p.ws + WS_RU);
    float* EA = (float*)(p.ws + WS_EARR);
    for (int chain = nchainwg ? bid : bid; chain < 64; chain += (nchainwg ? 64 : nblk)) {
        const int d = chain >> 5, b = (chain >> 3) & 3, h = chain & 7;
        bf16_t* Od = (bf16_t*)(EA + (size_t)(E_O0 + d) * ((size_t)MROWS * 512));
        auto issue = [&](int c) {
            const float* src = RU + ((size_t)chain * NRCH + c) * 4 * 4096; LAS float* dst = ring + (c & 1) * 4 * 4096;
#pragma unroll
            for (int i = 0; i < 16; ++i) { const int slot = ((wid - 4) * 16 + i) * 64;
                __builtin_amdgcn_global_load_lds((const unsigned*)(src + (size_t)(slot + lane) * 4), (LAS unsigned*)(dst + slot * 4), 16, 0, 0); }
        };
        if (tid >= 256) { issue(0); asm volatile("s_waitcnt vmcnt(0)" ::: "memory"); }
        asm volatile("" ::: "memory"); __builtin_amdgcn_s_barrier(); asm volatile("" ::: "memory");
        f32x4 S[4];
#pragma unroll
        for (int m = 0; m < 4; ++m) S[m] = (f32x4){0.f, 0.f, 0.f, 0.f};
        const int v0 = wid * 16;
        for (int c = 0; c < NRCH; ++c) {
            if (tid >= 256) { if (c + 1 < NRCH) issue(c + 1); asm volatile("s_waitcnt vmcnt(0)" ::: "memory"); }
            else {
                const LAS float* PM = ring + (c & 1) * 4 * 4096; const LAS float* QQ = PM + 4096; const LAS float* RHT = PM + 8192; const LAS float* OL = PM + 12288;
                f32x4 acc[4], Sn[4];
#pragma unroll
                for (int tt = 0; tt < 4; ++tt) {
#pragma unroll
                    for (int i = 0; i < 4; ++i) acc[tt][i] = OL[(16 * tt + 4 * g + i) * 64 + v0 + fr];
                    Sn[tt] = *(const LAS f32x4*)(QQ + (v0 + fr) * 64 + 16 * tt + 4 * g); }
                float A[3][4];
#pragma unroll
                for (int s0 = 0; s0 < 2; ++s0) { const LAS float* ar = RHT + (16 * (s0 >> 2) + 4 * g + (s0 & 3)) * 64 + fr;
#pragma unroll
                    for (int u = 0; u < 4; ++u) A[s0][u] = ar[16 * u]; }
#pragma unroll
                for (int st = 0; st < 32; ++st) {
                    if (st + 2 < 32) { const int s2 = st + 2, mi = s2 & 15; const LAS float* ar = (s2 < 16 ? RHT : PM) + (16 * (mi >> 2) + 4 * g + (mi & 3)) * 64 + fr;
#pragma unroll
                        for (int u = 0; u < 4; ++u) A[s2 % 3][u] = ar[16 * u]; }
                    __builtin_amdgcn_sched_barrier(0);
                    const int mi = st & 15; const float bq = S[mi >> 2][mi & 3];
                    if (st < 16) {
#pragma unroll
                        for (int u = 0; u < 4; ++u) acc[u] = __builtin_amdgcn_mfma_f32_16x16x4f32(A[st % 3][u], bq, acc[u], 0, 0, 0);
                    } else {
#pragma unroll
                        for (int u = 0; u < 4; ++u) Sn[u] = __builtin_amdgcn_mfma_f32_16x16x4f32(A[st % 3][u], bq, Sn[u], 0, 0, 0);
                    }
                }
#pragma unroll
                for (int tt = 0; tt < 4; ++tt)
#pragma unroll
                    for (int i = 0; i < 4; ++i) { const int row = scan_row(d, b, c * RCH + 16 * tt + 4 * g + i); Od[(size_t)row * 512 + h * 64 + v0 + fr] = f2bf(acc[tt][i]); }
#pragma unroll
                for (int m = 0; m < 4; ++m) S[m] = Sn[m];
                asm volatile("s_waitcnt lgkmcnt(0)" ::: "memory");
            }
            asm volatile("" ::: "memory"); __builtin_amdgcn_s_barrier(); asm volatile("" ::: "memory");
        }
    }
}
__device__ __forceinline__ float half_max(float v, int lane) {
    const int ninf = 0xff800000;
    v = fmaxf(v, __int_as_float(__builtin_amdgcn_update_dpp(ninf, __float_as_int(v), 0x121, 0xf, 0xf, false)));
    v = fmaxf(v, __int_as_float(__builtin_amdgcn_update_dpp(ninf, __float_as_int(v), 0x122, 0xf, 0xf, false)));
    v = fmaxf(v, __int_as_float(__builtin_amdgcn_update_dpp(ninf, __float_as_int(v), 0x124, 0xf, 0xf, false)));
    v = fmaxf(v, __int_as_float(__builtin_amdgcn_update_dpp(ninf, __float_as_int(v), 0x128, 0xf, 0xf, false)));
    v = fmaxf(v, __int_as_float(__builtin_amdgcn_update_dpp(ninf, __float_as_int(v), 0x142, 0xa, 0xf, false)));
    const float lo = __int_as_float(__builtin_amdgcn_readlane(__float_as_int(v), 31)), hi = __int_as_float(__builtin_amdgcn_readlane(__float_as_int(v), 63));
    return (lane & 32) ? hi : lo;
}
__device__ __forceinline__ int half_min_i(int v, int lane) {
    const int big = 0x7fffffff;
    v = min(v, __builtin_amdgcn_update_dpp(big, v, 0x121, 0xf, 0xf, false));
    v = min(v, __builtin_amdgcn_update_dpp(big, v, 0x122, 0xf, 0xf, false));
    v = min(v, __builtin_amdgcn_update_dpp(big, v, 0x124, 0xf, 0xf, false));
    v = min(v, __builtin_amdgcn_update_dpp(big, v, 0x128, 0xf, 0xf, false));
    v = min(v, __builtin_amdgcn_update_dpp(big, v, 0x142, 0xa, 0xf, false));
    const int lo = __builtin_amdgcn_readlane(v, 31), hi = __builtin_amdgcn_readlane(v, 63);
    return (lane & 32) ? hi : lo;
}
template <int LAYER>
__device__ __forceinline__ void ph_ln1(const Params& p, LAS unsigned char* lds, int bid, int nblk) {
    const int tid = threadIdx.x, wid = tid >> 6, lane = tid & 63, fr = lane & 15, fq = lane >> 4;
    LAS float* vb = (LAS float*)(lds + LDS_WORK);
    LAS float* part = vb + 16 * 1028;
    LAS int* lcnt = (LAS int*)(part + 8 * 16 * 32);
    float rwf[2][32];
    { const float* rw = p.in[I_RW] + (size_t)LAYER * 32768 + (size_t)(128 * wid + 32 * fq) * 32 + fr;
#pragma unroll
        for (int s2 = 0; s2 < 32; ++s2) { rwf[0][s2] = rw[s2 * 32]; rwf[1][s2] = rw[s2 * 32 + 16]; } }
    if (tid < 32) lcnt[tid] = 0;
    __syncthreads();
    const float* MOD = (const float*)(p.ws + WS_MOD);
    bf16_t* XS = (bf16_t*)(p.ws + WS_XS); const bf16_t* YP = (const bf16_t*)(p.ws + WS_YP); bf16_t* H = (bf16_t*)(p.ws + WS_H);
    int* TOPE = (int*)(p.ws + WS_TOPE); float* TOPW = (float*)(p.ws + WS_TOPW); int* TOPS = (int*)(p.ws + WS_TOPS);
    int* CNTB = (int*)(p.ws + WS_CNTB) + (size_t)(LAYER * 512 + bid) * 32;
    const float* lng = p.in[I_LNG] + (LAYER * 2 + 0) * 1024; const float* lnb = p.in[I_LNB] + (LAYER * 2 + 0) * 1024;
    const int rstride = nblk * 8, rbase = (LAYER == 0 ? 0 : NCTX) + bid * 8;
    f32x4 nres[4], ngate[4]; u32x2 nyp[4];
    auto fetch = [&](int row) {
        const float* res = row < NCTX ? p.in[I_CTX] + (size_t)row * 1024 : p.in[I_X] + (size_t)(row - NCTX) * 1024;
        const float* md = MOD + (size_t)(LAYER * 5 + row_modr(row)) * 6144;
#pragma unroll
        for (int q = 0; q < 4; ++q) { const int col = q * 256 + lane * 4; nres[q] = LAYER == 0 ? *(const f32x4*)(res + col) : ld_bf16x4(XS + (size_t)row * 1024 + col);
            ngate[q] = *(const f32x4*)(md + 2048 + col); nyp[q] = *(const u32x2*)(YP + (size_t)row * 1024 + col); }
    };
    if (rbase < MROWS) fetch(rbase + wid);
#pragma unroll 1
    for (int j0 = 0; rbase + j0 * rstride < MROWS; j0 += 2) {
#pragma unroll 1
        for (int jj = 0; jj < 2; ++jj) {
            const int row = rbase + wid + (j0 + jj) * rstride;
            if (row >= MROWS) break;
            const float* md = MOD + (size_t)(LAYER * 5 + row_modr(row)) * 6144;
            f32x4 v[4], msc[4], msh[4]; float s = 0.f;
#pragma unroll
            for (int q = 0; q < 4; ++q) { const u32x2 w = nyp[q];
                const f32x4 y = (f32x4){__uint_as_float(w.x << 16), __uint_as_float(w.x & 0xffff0000u), __uint_as_float(w.y << 16), __uint_as_float(w.y & 0xffff0000u)};
                v[q] = nres[q] * DN_ALPHA + ngate[q] * y;
                s += (v[q][0] + v[q][1]) + (v[q][2] + v[q][3]); }
#pragma unroll
            for (int q = 0; q < 4; ++q) { const int col = q * 256 + lane * 4; msc[q] = *(const f32x4*)(md + 4096 + col); msh[q] = *(const f32x4*)(md + 3072 + col); }
            if (row + rstride < MROWS) fetch(row + rstride);
            const float mean = wave_sum(s) * (1.0f / 1024.0f);
            float ss = 0.f;
#pragma unroll
            for (int q = 0; q < 4; ++q) { v[q] = v[q] - mean; ss += (v[q][0] * v[q][0] + v[q][1] * v[q][1]) + (v[q][2] * v[q][2] + v[q][3] * v[q][3]); }
            const float rstd = rsqrtf(wave_sum(ss) * (1.0f / 1024.0f) + LN_EPS);
#pragma unroll
            for (int q = 0; q < 4; ++q) { const int col = q * 256 + lane * 4;
                const f32x4 xn = v[q] * rstd * *(const f32x4*)(lng + col) + *(const f32x4*)(lnb + col);
                { u32x2 wx; wx.x = pack_bf16(xn[0], xn[1]); wx.y = pack_bf16(xn[2], xn[3]); *(u32x2*)(XS + (size_t)row * 1024 + col) = wx; }
                v[q] = xn * (msc[q] + 1.0f) + msh[q];
                u32x2 w; w.x = pack_bf16(v[q][0], v[q][1]); w.y = pack_bf16(v[q][2], v[q][3]);
                *(u32x2*)(H + (size_t)row * 1024 + col) = w;
                *(LAS f32x4*)(vb + (wid + 8 * jj) * 1028 + col) = v[q]; }
        }
        __syncthreads();
        {
            const LAS float* ar = vb + fr * 1028 + 128 * wid + 32 * fq;
            f32x4 acc0 = {0.f, 0.f, 0.f, 0.f}, acc1 = {0.f, 0.f, 0.f, 0.f};
#pragma unroll
            for (int h = 0; h < 2; ++h) { f32x4 va[4];
#pragma unroll
                for (int u = 0; u < 4; ++u) va[u] = *(const LAS f32x4*)(ar + h * 16 + u * 4);
#pragma unroll
                for (int u = 0; u < 4; ++u)
#pragma unroll
                    for (int i = 0; i < 4; ++i) { acc0 = __builtin_amdgcn_mfma_f32_16x16x4f32(va[u][i], rwf[0][h * 16 + u * 4 + i], acc0, 0, 0, 0);
                        acc1 = __builtin_amdgcn_mfma_f32_16x16x4f32(va[u][i], rwf[1][h * 16 + u * 4 + i], acc1, 0, 0, 0); } }
            LAS float* pw = part + wid * 512 + (4 * fq) * 32 + fr;
#pragma unroll
            for (int i = 0; i < 4; ++i) { pw[i * 32] = acc0[i]; pw[i * 32 + 16] = acc1[i]; }
        }
        __syncthreads();
        {
            const int e = lane & 31, lr = 2 * wid + (lane >> 5), row = rbase + (lr & 7) + (j0 + (lr >> 3)) * rstride;
            float lg = p.in[I_RB][LAYER * 32 + e];
#pragma unroll
            for (int w2 = 0; w2 < 8; ++w2) lg += part[w2 * 512 + lr * 32 + e];
            float tv[4]; int te[4];
#pragma unroll
            for (int k = 0; k < 4; ++k) { const float bv = half_max(lg, lane); const int bi = half_min_i(lg == bv ? e : 99, lane);
                tv[k] = bv; te[k] = bi & 31; lg = e == bi ? -3.0e38f : lg; }
            const float e1 = expf(tv[1] - tv[0]), e2 = expf(tv[2] - tv[0]), e3 = expf(tv[3] - tv[0]), inv = 1.0f / (1.0f + e1 + e2 + e3);
            if (e == 0 && row < MROWS) {
                const float wv[4] = {inv, e1 * inv, e2 * inv, e3 * inv};
#pragma unroll
                for (int k = 0; k < 4; ++k) { const int slot = __hip_atomic_fetch_add(lcnt + te[k], 1, __ATOMIC_RELAXED, __HIP_MEMORY_SCOPE_WORKGROUP); TOPE[row * 4 + k] = te[k]; TOPW[row * 4 + k] = wv[k]; TOPS[row * 4 + k] = slot; }
            }
        }
    }
    __syncthreads();
    if (tid < 32) CNTB[tid] = lcnt[tid];
}
constexpr int LDS_TAB = LDS_WORK + 131072;
__device__ __forceinline__ int moe_tables(const int* cntb, int nblk, LAS int* tab, LAS int* bb) {
    const int tid = threadIdx.x, e = tid & 31, seg = tid >> 5, per = (nblk + 15) >> 4;
    const int b0 = seg * per, b1 = (b0 + per) < nblk ? (b0 + per) : nblk;
    int s = 0;
    if (per <= 16) {
        int cv[16];
#pragma unroll
        for (int u = 0; u < 16; ++u) cv[u] = (b0 + u) < b1 ? cntb[(b0 + u) * 32 + e] : 0;
#pragma unroll
        for (int u = 0; u < 16; ++u) s += cv[u];
        tab[512 + seg * 32 + e] = s;
        __syncthreads();
        if (tid < 32) { int run = 0; for (int sg = 0; sg < 16; ++sg) { const int v = tab[512 + sg * 32 + tid]; tab[512 + sg * 32 + tid] = run; run += v; } tab[448 + tid] = run; }
        __syncthreads();
        if (bb) { int run = tab[512 + seg * 32 + e];
#pragma unroll
            for (int u = 0; u < 16; ++u) if ((b0 + u) < b1) { bb[(b0 + u) * 32 + e] = run; run += cv[u]; } }
    } else {
        for (int b = b0; b < b1; ++b) s += cntb[b * 32 + e];
        tab[512 + seg * 32 + e] = s;
        __syncthreads();
        if (tid < 32) { int run = 0; for (int sg = 0; sg < 16; ++sg) { const int v = tab[512 + sg * 32 + tid]; tab[512 + sg * 32 + tid] = run; run += v; } tab[448 + tid] = run; }
        __syncthreads();
        if (bb) { int run = tab[512 + seg * 32 + e]; for (int b = b0; b < b1; ++b) { bb[b * 32 + e] = run; run += cntb[b * 32 + e]; } }
    }
    if (tid < 64) {
        const int x = tid & 31, n = (tab[448 + x] + 255) >> 8; int inc = n;
#pragma unroll
        for (int o = 1; o < 32; o <<= 1) { const int t = __shfl_up(inc, o, 64); if ((tid & 31) >= o) inc += t; }
        if (tid < 32) { const int t0 = inc - n; tab[x] = t0 * 256; for (int i = 0; i < n; ++i) tab[64 + t0 + i] = x; if (x == 31) { tab[32] = inc * 256; tab[40] = inc; } }
    }
    __syncthreads();
    return tab[40];
}
template <int LAYER>
__device__ __forceinline__ void ph_moe_gather(const Params& p, LAS unsigned char* lds, int bid, int nblk) {
    const int tid = threadIdx.x, wid = tid >> 6, lane = tid & 63;
    LAS int* tab = (LAS int*)(lds + LDS_TAB); LAS int* bb = (LAS int*)(lds + LDS_WORK);
    (void)moe_tables((const int*)(p.ws + WS_CNTB) + (size_t)LAYER * 512 * 32, nblk, tab, bb);
    const int* TOPE = (const int*)(p.ws + WS_TOPE); const int* TOPS = (const int*)(p.ws + WS_TOPS); int* POS = (int*)(p.ws + WS_POS);
    const bf16_t* H = (const bf16_t*)(p.ws + WS_H); bf16_t* AS = (bf16_t*)(p.ws + WS_ASORT);
    const int rstride = nblk * 8, rfirst = (LAYER == 0 ? 0 : NCTX) + bid * 8 + wid;
    u32x4 na = {0u, 0u, 0u, 0u}, nb2 = {0u, 0u, 0u, 0u}; int ne[4] = {0, 0, 0, 0}, ns[4] = {0, 0, 0, 0};
    auto fetch = [&](int row) {
        na = *(const u32x4*)(H + (size_t)row * 1024 + lane * 16); nb2 = *(const u32x4*)(H + (size_t)row * 1024 + lane * 16 + 8);
#pragma unroll
        for (int k = 0; k < 4; ++k) { ne[k] = TOPE[row * 4 + k]; ns[k] = TOPS[row * 4 + k]; }
    };
    if (rfirst < MROWS) fetch(rfirst);
    for (int row = rfirst; row < MROWS; row += rstride) {
        const u32x4 a = na, b = nb2; int ce[4], cs[4];
#pragma unroll
        for (int k = 0; k < 4; ++k) { ce[k] = ne[k]; cs[k] = ns[k]; }
        if (row + rstride < MROWS) fetch(row + rstride);
#pragma unroll
        for (int k = 0; k < 4; ++k) {
            const int e = ce[k], pos = tab[e] + bb[((((row - (LAYER == 0 ? 0 : NCTX)) >> 3) % nblk) << 5) + e] + cs[k];
            if (lane == 0) POS[row * 4 + k] = pos;
            bf16_t* ad = AS + ((size_t)((pos >> 8) * 16 + (lane >> 2)) * 256 + (pos & 255)) * 64 + (lane & 3) * 16;
            *(u32x4*)ad = a; *(u32x4*)(ad + 8) = b;
        }
    }
}
template <int LAYER>
__device__ __forceinline__ void ph_moe_gemm1(const Params& p, LAS unsigned char* lds, int bid, int nblk) {
    LAS int* tab = (LAS int*)(lds + LDS_TAB);
    const int T = moe_tables((const int*)(p.ws + WS_CNTB) + (size_t)LAYER * 512 * 32, nblk, tab, (LAS int*)nullptr);
    pg8::SchedMoe<8> S{T, nblk, bid, tab + 64};
    pg8::Gemm g{(const bf16_t*)(p.ws + WS_ASORT), (const bf16_t*)(p.ws + WS_W1T) + (size_t)LAYER * 32 * 2048 * 1024, 0, 0, 1024};
    pg8::EpiAct E{(bf16_t*)(p.ws + WS_ACT), p.in[I_B1] + (size_t)LAYER * 32 * 2048};
    pg8::gemm_phase<pg8::EpiAct, pg8::SchedMoe<8>, false, true, true>(lds + LDS_WORK, g, S, E, nullptr);
}
template <int LAYER>
__device__ __forceinline__ void ph_moe_gemm2(const Params& p, LAS unsigned char* lds, int bid, int nblk) {
    LAS int* tab = (LAS int*)(lds + LDS_TAB);
    const int T = moe_tables((const int*)(p.ws + WS_CNTB) + (size_t)LAYER * 512 * 32, nblk, tab, (LAS int*)nullptr);
    pg8::SchedMoe<4> S{T, nblk, bid, tab + 64};
    pg8::Gemm g{(const bf16_t*)(p.ws + WS_ACT), (const bf16_t*)(p.ws + WS_W2T) + (size_t)LAYER * 32 * 1024 * 1024, 0, 0, 1024};
    pg8::EpiYE E{(bf16_t*)(p.ws + WS_YE), p.in[I_B2] + (size_t)LAYER * 32 * 1024};
    pg8::gemm_phase<pg8::EpiYE, pg8::SchedMoe<4>, false, true, true>(lds + LDS_WORK, g, S, E, nullptr);
}
template <int NN>
__device__ __forceinline__ void ph_gemm_dense(LAS unsigned char* lds, const bf16_t* A, const bf16_t* Bt, bf16_t* C, int ldc, int pm0, int nM, int bid, int nblk) {
    pg8::SchedDense<NN> S{nM, pm0, nblk, bid};
    pg8::Gemm g{A, Bt, 0, 0, 1024};
    pg8::EpiStore E{C, ldc};
    pg8::gemm_phase<pg8::EpiStore, pg8::SchedDense<NN>, false>(lds + LDS_WORK, g, S, E, nullptr);
}
template <int LAYER>
__device__ __forceinline__ void ph_ln2(const Params& p, LAS unsigned char* lds, int bid, int nblk) {
    const int tid = threadIdx.x, wid = tid >> 6, lane = tid & 63, fr = lane & 15, fq = lane >> 4;
    LAS float* vb = (LAS float*)(lds + LDS_WORK);
    LAS float* part = vb + 16 * 1028;
    float wgf[32];
    if (LAYER == 0) { const float* wg = p.in[I_OWIN] + (size_t)(128 * wid + 32 * fq) * ODD_IN + 4096 + fr;
#pragma unroll
        for (int s2 = 0; s2 < 32; ++s2) wgf[s2] = wg[(size_t)s2 * ODD_IN]; }
    const float* MOD = (const float*)(p.ws + WS_MOD);
    bf16_t* XS = (bf16_t*)(p.ws + WS_XS); const bf16_t* YE = (const bf16_t*)(p.ws + WS_YE); bf16_t* H = (bf16_t*)(p.ws + WS_H); float* GT = (float*)(p.ws + WS_GT);
    const float* TOPW = (const float*)(p.ws + WS_TOPW); const int* POS = (const int*)(p.ws + WS_POS);
    const float* lng = p.in[I_LNG] + (LAYER * 2 + 1) * 1024; const float* lnb = p.in[I_LNB] + (LAYER * 2 + 1) * 1024;
    const int rstride = nblk * 8, rbase = (LAYER == 0 ? 0 : NCTX) + bid * 8, rfirst = rbase + wid;
    f32x4 nw = {0.f, 0.f, 0.f, 0.f}; int np0 = 0, np1 = 0, np2 = 0, np3 = 0;
    if (rfirst < MROWS) { nw = *(const f32x4*)(TOPW + rfirst * 4); np0 = POS[rfirst * 4]; np1 = POS[rfirst * 4 + 1]; np2 = POS[rfirst * 4 + 2]; np3 = POS[rfirst * 4 + 3]; }
    auto do_row = [&](int row, int jj) {
        const float* md = MOD + (size_t)(LAYER * 5 + row_modr(row)) * 6144;
        const float w0 = nw[0], w1 = nw[1], w2 = nw[2], w3 = nw[3];
        const bf16_t* y0 = YE + (size_t)np0 * 1024; const bf16_t* y1 = YE + (size_t)np1 * 1024;
        const bf16_t* y2 = YE + (size_t)np2 * 1024; const bf16_t* y3 = YE + (size_t)np3 * 1024;
        if (row + rstride < MROWS) { const int rn = row + rstride; nw = *(const f32x4*)(TOPW + rn * 4); np0 = POS[rn * 4]; np1 = POS[rn * 4 + 1]; np2 = POS[rn * 4 + 2]; np3 = POS[rn * 4 + 3]; }
        f32x4 v[4]; float s = 0.f;
#pragma unroll
        for (int q = 0; q < 4; ++q) { const int col = q * 256 + lane * 4;
            const f32x4 ffn = (ld_bf16x4(y0 + col) * w0 + ld_bf16x4(y1 + col) * w1) + (ld_bf16x4(y2 + col) * w2 + ld_bf16x4(y3 + col) * w3);
            v[q] = ld_bf16x4(XS + (size_t)row * 1024 + col) * DN_ALPHA + *(const f32x4*)(md + 5120 + col) * ffn;
            s += (v[q][0] + v[q][1]) + (v[q][2] + v[q][3]); }
        const float mean = wave_sum(s) * (1.0f / 1024.0f);
        float ss = 0.f;
#pragma unroll
        for (int q = 0; q < 4; ++q) { v[q] = v[q] - mean; ss += (v[q][0] * v[q][0] + v[q][1] * v[q][1]) + (v[q][2] * v[q][2] + v[q][3] * v[q][3]); }
        const float rstd = rsqrtf(wave_sum(ss) * (1.0f / 1024.0f) + LN_EPS);
        if (LAYER == 1) {
#pragma unroll
            for (int q = 0; q < 4; ++q) { const int col = q * 256 + lane * 4;
                *(f32x4*)(p.out + (size_t)(row - NCTX) * 1024 + col) = v[q] * rstd * *(const f32x4*)(lng + col) + *(const f32x4*)(lnb + col); }
        } else {
            const float* md1 = MOD + (size_t)(5 + row_modr(row)) * 6144;
#pragma unroll
            for (int q = 0; q < 4; ++q) { const int col = q * 256 + lane * 4;
                const f32x4 xn = v[q] * rstd * *(const f32x4*)(lng + col) + *(const f32x4*)(lnb + col);
                { u32x2 wx; wx.x = pack_bf16(xn[0], xn[1]); wx.y = pack_bf16(xn[2], xn[3]); *(u32x2*)(XS + (size_t)row * 1024 + col) = wx; }
                v[q] = xn * (*(const f32x4*)(md1 + 1024 + col) + 1.0f) + *(const f32x4*)(md1 + col);
                u32x2 w; w.x = pack_bf16(v[q][0], v[q][1]); w.y = pack_bf16(v[q][2], v[q][3]);
                *(u32x2*)(H + (size_t)row * 1024 + col) = w;
                *(LAS f32x4*)(vb + (wid + 8 * jj) * 1028 + col) = v[q]; }
        }
    };
    if (LAYER == 1) {
#pragma unroll 1
        for (int row = rfirst; row < MROWS; row += rstride) do_row(row, 0);
    } else {
#pragma unroll 1
        for (int j0 = 0; rbase + j0 * rstride < MROWS; j0 += 2) {
#pragma unroll 1
            for (int jj = 0; jj < 2; ++jj) { const int row = rfirst + (j0 + jj) * rstride; if (row >= MROWS) break; do_row(row, jj); }
            __syncthreads();
            {
                const LAS float* ar = vb + fr * 1028 + 128 * wid + 32 * fq;
                f32x4 acc = {0.f, 0.f, 0.f, 0.f};
#pragma unroll
                for (int h = 0; h < 2; ++h) { f32x4 va[4];
#pragma unroll
                    for (int u = 0; u < 4; ++u) va[u] = *(const LAS f32x4*)(ar + h * 16 + u * 4);
#pragma unroll
                    for (int u = 0; u < 4; ++u)
#pragma unroll
                        for (int i = 0; i < 4; ++i) acc = __builtin_amdgcn_mfma_f32_16x16x4f32(va[u][i], wgf[h * 16 + u * 4 + i], acc, 0, 0, 0); }
                LAS float* pw = part + wid * 256 + (4 * fq) * 16 + fr;
#pragma unroll
                for (int i = 0; i < 4; ++i) pw[i * 16] = acc[i];
            }
            __syncthreads();
            if (tid < 256) { const int lr = tid >> 4, row = rbase + (lr & 7) + (j0 + (lr >> 3)) * rstride;
                float a = 0.f;
#pragma unroll
                for (int w2 = 0; w2 < 8; ++w2) a += part[w2 * 256 + tid];
                if (row < MROWS) GT[row * 16 + (tid & 15)] = a; }
        }
    }
}
constexpr int LDK = 136;
__device__ __forceinline__ int sid_of(int mixer, int dir, int b, int ch, int h) { return (((mixer * 2 + dir) * 4 + b) * NCHUNK + ch) * 4 + h; }
__device__ __forceinline__ void unit_decode(int u, int& mixer, int& h, int& ch, int& b, int& row0) {
    mixer = u & 1; h = (u >> 1) & 3; const int rest = u >> 3; ch = rest % NCHUNK; b = rest / NCHUNK;
    row0 = ch < 2 ? b * 256 + ch * 128 : NCTX + b * 4096 + (ch - 2) * 128;
}
__device__ __forceinline__ void ld_raw(const bf16_t* P, int row0, int col, u32x2 (&raw)[8]) {
    const int t = threadIdx.x, i = t >> 2, part = t & 3, i0 = (part & 1) * 32 + (part >> 1) * 16;
    const bf16_t* src = P + (size_t)(row0 + i) * LDP1 + col + i0;
#pragma unroll
    for (int q = 0; q < 4; ++q) { raw[q] = *(const u32x2*)(src + q * 4); raw[4 + q] = *(const u32x2*)(src + 64 + q * 4); }
}
__device__ __forceinline__ void cvt_rows(const u32x2 (&raw)[8], bool rope, int s0, const float* ROPE, float (&lo)[16], float (&hi)[16]) {
    const int t = threadIdx.x, i = t >> 2, part = t & 3, pr = part & 1, hf = part >> 1;
#pragma unroll
    for (int q = 0; q < 4; ++q) {
        lo[q * 4] = __uint_as_float(raw[q].x << 16); lo[q * 4 + 1] = __uint_as_float(raw[q].x & 0xffff0000u); lo[q * 4 + 2] = __uint_as_float(raw[q].y << 16); lo[q * 4 + 3] = __uint_as_float(raw[q].y & 0xffff0000u);
        hi[q * 4] = __uint_as_float(raw[4 + q].x << 16); hi[q * 4 + 1] = __uint_as_float(raw[4 + q].x & 0xffff0000u); hi[q * 4 + 2] = __uint_as_float(raw[4 + q].y << 16); hi[q * 4 + 3] = __uint_as_float(raw[4 + q].y & 0xffff0000u); }
    if (rope) {
        const int s = s0 + i, pos = pr == 0 ? (s >> 6) : (s & 63);
        const float* rp = ROPE + (size_t)(pos * 32 + hf * 16) * 2;
#pragma unroll
        for (int jj = 0; jj < 16; ++jj) { const float c = rp[2 * jj], sn = rp[2 * jj + 1], a = lo[jj], b = hi[jj]; lo[jj] = a * c - b * sn; hi[jj] = a * sn + b * c; }
    }
}
__device__ __forceinline__ void st_rows(LAS bf16_t* dst, const float (&lo)[16], const float (&hi)[16], float scale) {
    const int t = threadIdx.x, i = t >> 2, part = t & 3, i0 = (part & 1) * 32 + (part >> 1) * 16;
    u32x4 w0, w1, w2, w3;
    w0.x = pack_bf16(lo[0] * scale, lo[1] * scale); w0.y = pack_bf16(lo[2] * scale, lo[3] * scale); w0.z = pack_bf16(lo[4] * scale, lo[5] * scale); w0.w = pack_bf16(lo[6] * scale, lo[7] * scale);
    w1.x = pack_bf16(lo[8] * scale, lo[9] * scale); w1.y = pack_bf16(lo[10] * scale, lo[11] * scale); w1.z = pack_bf16(lo[12] * scale, lo[13] * scale); w1.w = pack_bf16(lo[14] * scale, lo[15] * scale);
    w2.x = pack_bf16(hi[0] * scale, hi[1] * scale); w2.y = pack_bf16(hi[2] * scale, hi[3] * scale); w2.z = pack_bf16(hi[4] * scale, hi[5] * scale); w2.w = pack_bf16(hi[6] * scale, hi[7] * scale);
    w3.x = pack_bf16(hi[8] * scale, hi[9] * scale); w3.y = pack_bf16(hi[10] * scale, hi[11] * scale); w3.z = pack_bf16(hi[12] * scale, hi[13] * scale); w3.w = pack_bf16(hi[14] * scale, hi[15] * scale);
    LAS bf16_t* d = dst + i * LDK + i0;
    *(LAS u32x4*)d = w0; *(LAS u32x4*)(d + 8) = w1; *(LAS u32x4*)(d + 64) = w2; *(LAS u32x4*)(d + 72) = w3;
}
__device__ __forceinline__ void st_rows_T(LAS bf16_t* dst, const float (&lo)[16], const float (&hi)[16], float scale) {
    const int t = threadIdx.x, i = t >> 2, part = t & 3, i0 = (part & 1) * 32 + (part >> 1) * 16;
#pragma unroll
    for (int jj = 0; jj < 16; ++jj) { dst[(i0 + jj) * LDK + i] = f2bf(lo[jj] * scale); dst[(i0 + 64 + jj) * LDK + i] = f2bf(hi[jj] * scale); }
}
__device__ __forceinline__ void mma_128(const LAS bf16_t* A, const LAS bf16_t* B, f32x4 (&acc)[2][4], int wr, int wc, int lane) {
    const int fr = lane & 15, fq = lane >> 4;
#pragma unroll
    for (int ks = 0; ks < 4; ++ks) {
        bf16x8 a[2], b[4];
#pragma unroll
        for (int mt = 0; mt < 2; ++mt) a[mt] = *(const LAS bf16x8*)(A + (wr * 32 + mt * 16 + fr) * LDK + ks * 32 + fq * 8);
#pragma unroll
        for (int nt = 0; nt < 4; ++nt) b[nt] = *(const LAS bf16x8*)(B + (wc * 64 + nt * 16 + fr) * LDK + ks * 32 + fq * 8);
#pragma unroll
        for (int mt = 0; mt < 2; ++mt)
#pragma unroll
            for (int nt = 0; nt < 4; ++nt) acc[mt][nt] = __builtin_amdgcn_mfma_f32_16x16x32_bf16(a[mt], b[nt], acc[mt][nt], 0, 0, 0);
    }
}
__device__ __forceinline__ void zero_acc(f32x4 (&acc)[2][4]) {
#pragma unroll
    for (int mt = 0; mt < 2; ++mt)
#pragma unroll
        for (int nt = 0; nt < 4; ++nt) acc[mt][nt] = (f32x4){0.f, 0.f, 0.f, 0.f};
}
__device__ __forceinline__ void wave_scan_sum2(float x0, float x1, float& p0, float& p1, float& total) {
    const int lane = threadIdx.x & 63; float s = x0 + x1, inc = s;
#pragma unroll
    for (int o = 1; o < 64; o <<= 1) { const float t = __shfl_up(inc, o, 64); if (lane >= o) inc += t; }
    const float exc = inc - s; p0 = exc + x0; p1 = exc + s; total = __shfl(inc, 63, 64);
}
__device__ __forceinline__ void wave_scan_max2(float x0, float x1, float& p0, float& p1) {
    const int lane = threadIdx.x & 63; const float m = fmaxf(x0, x1); float inc = m;
#pragma unroll
    for (int o = 1; o < 64; o <<= 1) { const float t = __shfl_up(inc, o, 64); if (lane >= o) inc = fmaxf(inc, t); }
    float exc = __shfl_up(inc, 1, 64); if (lane == 0) exc = -3.0e38f;
    p0 = fmaxf(exc, x0); p1 = fmaxf(exc, m);
}
__device__ __forceinline__ void ph_c1(const Params& p, LAS unsigned char* lds, int bid, int nblk) {
    const int tid = threadIdx.x, wid = tid >> 6, lane = tid & 63, wr = wid >> 1, wc = wid & 1, fr = lane & 15, fq = lane >> 4;
    LAS bf16_t* KsT = (LAS bf16_t*)(lds + LDS_WORK); LAS bf16_t* VsT0 = KsT + 128 * LDK; LAS bf16_t* VsT1 = VsT0 + 128 * LDK;
    LAS float* z = (LAS float*)(VsT1 + 128 * LDK);
    LAS float* lfA = z + 256; LAS float* igA = lfA + 256; LAS float* zmax = igA + 256;
    const bf16_t* P = (const bf16_t*)(p.ws + WS_P); const float* GT = (const float*)(p.ws + WS_GT); const float* ROPE = (const float*)(p.ws + WS_ROPE);
    float* ST = (float*)(p.ws + WS_ST); float* NST = (float*)(p.ws + WS_NST); float* MEND = (float*)(p.ws + WS_MEND); float* BEND = (float*)(p.ws + WS_BEND);
    for (int u = bid; u < NB * NCHUNK * 4 * 2; u += nblk) {
        int mixer, h, ch, b, row0; unit_decode(u, mixer, h, ch, b, row0);
        const int colQ = mixer * 2048 + h * 128;
        u32x2 rawK[8], rawV[8]; ld_raw(P, row0, colQ + 512, rawK); ld_raw(P, row0, colQ + 1024, rawV);
        if (mixer == 0) {
            if (tid < 256) { const int dir = tid >> 7, j = tid & 127; const float lg = p.in[I_CLG][dir * 4 + h]; z[tid] = fexp(lg * (float)(dir == 0 ? 127 - j : j)); }
        } else {
            if (tid < 256) { const int dir = tid >> 7, j = tid & 127, row = row0 + j;
                igA[tid] = GT[row * 16 + dir * 4 + h] + p.in[I_DIB][dir * 4 + h];
                lfA[tid] = -softplusf(-(GT[row * 16 + 8 + dir * 4 + h] + p.in[I_DFB][dir * 4 + h])); }
            __syncthreads();
            if (tid < 128) { const int dir = tid >> 6, j0 = 2 * lane, j1 = j0 + 1;
                const float l0 = lfA[dir * 128 + j0], l1 = lfA[dir * 128 + j1], g0 = igA[dir * 128 + j0], g1 = igA[dir * 128 + j1];
                float r0, r1, total; wave_scan_sum2(l0, l1, r0, r1, total);
                const float w0 = (dir == 0 ? total - r0 : r0 - l0) + g0, w1 = (dir == 0 ? total - r1 : r1 - l1) + g1;
                const float mx = wave_max(fmaxf(w0, w1));
                z[dir * 128 + j0] = fexp(w0 - mx); z[dir * 128 + j1] = fexp(w1 - mx);
                const int sid = sid_of(1, dir, b, ch, h);
                if (lane == 0) { MEND[sid] = mx; BEND[sid] = total; }
                float* CB = (float*)(p.ws + WS_CB) + (size_t)sid * 128; float* CMI = (float*)(p.ws + WS_CMI) + (size_t)sid * 128;
                if (dir == 0) { float m0, m1; wave_scan_max2(g0 - r0, g1 - r1, m0, m1); CB[j0] = r0; CB[j1] = r1; CMI[j0] = r0 + m0; CMI[j1] = r1 + m1; }
                else { const float s0 = total - r0 + l0, s1 = total - r1 + l1;
                    lfA[128 + j0] = g0 - s0; lfA[128 + j1] = g1 - s1; igA[128 + j0] = s0; igA[128 + j1] = s1; CB[j0] = s0; CB[j1] = s1;
                    asm volatile("s_waitcnt lgkmcnt(0)" ::: "memory");
                    const int q0 = 127 - 2 * lane, q1 = q0 - 1; float m0, m1; wave_scan_max2(lfA[128 + q0], lfA[128 + q1], m0, m1);
                    CMI[q0] = igA[128 + q0] + m0; CMI[q1] = igA[128 + q1] + m1; } }
        }
        __syncthreads();
        {
            float lo[16], hi[16];
            cvt_rows(rawK, mixer == 0 && ch >= 2, (ch - 2) * 128, ROPE, lo, hi);
            st_rows_T(KsT, lo, hi, 0.08838834764831845f);
            cvt_rows(rawV, false, 0, ROPE, lo, hi);
            const int i = tid >> 2;
            st_rows_T(VsT0, lo, hi, z[i]); st_rows_T(VsT1, lo, hi, z[128 + i]);
        }
        __syncthreads();
#pragma unroll
        for (int dir = 0; dir < 2; ++dir) {
            f32x4 acc[2][4]; zero_acc(acc);
            mma_128(dir == 0 ? VsT0 : VsT1, KsT, acc, wr, wc, lane);
            bf16_t* dst = (bf16_t*)ST + (size_t)sid_of(mixer, dir, b, ch, h) * 16384;
#pragma unroll
            for (int mt = 0; mt < 2; ++mt)
#pragma unroll
                for (int nt = 0; nt < 4; ++nt)
#pragma unroll
                    for (int r = 0; r < 4; ++r) dst[(wr * 32 + mt * 16 + fq * 4 + r) * 128 + wc * 64 + nt * 16 + fr] = f2bf(acc[mt][nt][r]);
        }
        if (mixer == 1 && tid < 256) { const int dir = tid >> 7, dd = tid & 127; float s = 0.f;
            for (int j = 0; j < 128; ++j) s += z[dir * 128 + j] * bf2f(KsT[dd * LDK + j]);
            NST[(size_t)sid_of(1, dir, b, ch, h) * 128 + dd] = s; }
        __syncthreads();
    }
}
__device__ __forceinline__ void ph_c2(const Params& p, int bid, int nblk) {
    const int tid = threadIdx.x;
    float* ST = (float*)(p.ws + WS_ST); float* NST = (float*)(p.ws + WS_NST); bf16_t* STB = (bf16_t*)(p.ws + WS_STB);
    const float* MEND = (const float*)(p.ws + WS_MEND); const float* BEND = (const float*)(p.ws + WS_BEND); float* MPREV = (float*)(p.ws + WS_MPREV);
    for (int item = bid; item < 2048; item += nblk) {
        const int mixer = item >> 10, chain = (item >> 5) & 31, slab = item & 31, dir = chain >> 4, b = (chain >> 2) & 3, h = chain & 3;
        const int idx = slab * 512 + tid;
        float kv[NCHUNK];
#pragma unroll
        for (int k = 0; k < NCHUNK; ++k) { const int ch = dir == 0 ? k : (k < 2 ? 1 - k : 35 - k); kv[k] = bf2f(((const bf16_t*)ST)[(size_t)sid_of(mixer, dir, b, ch, h) * 16384 + idx]); }
        if (mixer == 0) {
            const float gdec = fexp(p.in[I_CLG][dir * 4 + h] * 128.0f); float r = 0.f;
#pragma unroll
            for (int k = 0; k < NCHUNK; ++k) { const int ch = dir == 0 ? k : (k < 2 ? 1 - k : 35 - k); STB[(size_t)sid_of(0, dir, b, ch, h) * 16384 + idx] = f2bf(r); r = r * gdec + kv[k]; }
        } else {
            const bool do_n = slab == 0 && tid < 128;
            float nv[NCHUNK];
#pragma unroll
            for (int k = 0; k < NCHUNK; ++k) { const int ch = dir == 0 ? k : (k < 2 ? 1 - k : 35 - k); nv[k] = do_n ? NST[(size_t)sid_of(1, dir, b, ch, h) * 128 + tid] : 0.f; }
            float m = -__builtin_inff(), c = 0.f, n = 0.f;
#pragma unroll
            for (int k = 0; k < NCHUNK; ++k) { const int ch = dir == 0 ? k : (k < 2 ? 1 - k : 35 - k); const int sid = sid_of(1, dir, b, ch, h);
                const float me = MEND[sid], be = BEND[sid], mnew = fmaxf(be + m, me), so = fexp(be + m - mnew), sn = fexp(me - mnew);
                STB[(size_t)sid * 16384 + idx] = f2bf(c); c = c * so + kv[k] * sn;
                if (do_n) { NST[(size_t)sid * 128 + tid] = n; n = n * so + nv[k] * sn; }
                if (slab == 0 && tid == 0) MPREV[sid] = m;
                m = mnew; }
        }
    }
}
template <int mixer>
__device__ __forceinline__ void c3_unit(const Params& p, LAS unsigned char* lds, int h, int ch, int b, int row0) {
    const int tid = threadIdx.x, wid = tid >> 6, lane = tid & 63, wr = wid >> 1, wc = wid & 1, fr = lane & 15, fq = lane >> 4;
    LAS bf16_t* Qs = (LAS bf16_t*)(lds + LDS_WORK); LAS bf16_t* Ks = Qs + 128 * LDK; LAS bf16_t* VsT = Ks + 128 * LDK; LAS bf16_t* RT = VsT + 128 * LDK;
    LAS float* fa = (LAS float*)(RT + 128 * LDK);
    LAS float* lfA = fa; LAS float* igA = fa + 256; LAS float* bA = fa + 512; LAS float* miA = fa + 768; LAS float* mtA = fa + 1024; LAS float* sintA = fa + 1280;
    LAS float* rowsum = fa + 1536; LAS float* qn = fa + 2048; LAS float* nA = fa + 2304;
    LAS float* Os = (LAS float*)Qs;
    LAS bf16_t* Pm = Ks;
    const bf16_t* P = (const bf16_t*)(p.ws + WS_P); const float* GT = (const float*)(p.ws + WS_GT); const float* ROPE = (const float*)(p.ws + WS_ROPE);
    const bf16_t* STB = (const bf16_t*)(p.ws + WS_STB); const float* NST = (const float*)(p.ws + WS_NST); const float* MPREV = (const float*)(p.ws + WS_MPREV);
    bf16_t* Y = (bf16_t*)(p.ws + WS_YMIX);
    {
        const int colQ = mixer * 2048 + h * 128; const bool rope = mixer == 0 && ch >= 2;
        {
            u32x2 rawQ[8], rawK[8], rawV[8]; ld_raw(P, row0, colQ, rawQ); ld_raw(P, row0, colQ + 512, rawK); ld_raw(P, row0, colQ + 1024, rawV);
            float lo[16], hi[16];
            cvt_rows(rawQ, rope, (ch - 2) * 128, ROPE, lo, hi); st_rows(Qs, lo, hi, 1.0f);
            cvt_rows(rawK, rope, (ch - 2) * 128, ROPE, lo, hi); st_rows(Ks, lo, hi, 0.08838834764831845f);
            cvt_rows(rawV, false, 0, ROPE, lo, hi); st_rows_T(VsT, lo, hi, 1.0f);
        }
        if (mixer == 1) {
            if (tid < 256) { const int dir = tid >> 7, j = tid & 127, row = row0 + j;
                igA[tid] = GT[row * 16 + dir * 4 + h] + p.in[I_DIB][dir * 4 + h];
                nA[tid] = NST[(size_t)sid_of(1, dir, b, ch, h) * 128 + j];
                bA[tid] = ((const float*)(p.ws + WS_CB))[(size_t)sid_of(1, dir, b, ch, h) * 128 + j]; miA[tid] = ((const float*)(p.ws + WS_CMI))[(size_t)sid_of(1, dir, b, ch, h) * 128 + j]; }
            __syncthreads();
            __syncthreads();
            if (tid < 256) { const int dir = tid >> 7, i = tid & 127; const float mprev = MPREV[sid_of(1, dir, b, ch, h)];
                const float gi = bA[tid] + mprev, mt = fmaxf(gi, miA[tid]); mtA[tid] = mt; sintA[tid] = fexp(gi - mt);
                float s = 0.f;
                for (int d0 = 0; d0 < 128; ++d0) s += bf2f(Qs[i * LDK + d0]) * nA[dir * 128 + d0];
                qn[tid] = s; }
        }
        __syncthreads();
        f32x4 S[2][4]; zero_acc(S);
        mma_128(Qs, Ks, S, wr, wc, lane);
        __syncthreads();
        f32x4 O[2][4]; zero_acc(O);
        if (mixer == 0) {
            const float lg0 = p.in[I_CLG][h], lg1 = p.in[I_CLG][4 + h];
#pragma unroll
            for (int mt = 0; mt < 2; ++mt)
#pragma unroll
                for (int nt = 0; nt < 4; ++nt)
#pragma unroll
                    for (int r = 0; r < 4; ++r) { const int i = wr * 32 + mt * 16 + fq * 4 + r, j = wc * 64 + nt * 16 + fr;
                        const float dcy = (i >= j ? fexp(lg0 * (float)(i - j)) : 0.f) + (j >= i ? fexp(lg1 * (float)(j - i)) : 0.f);
                        Pm[i * LDK + j] = f2bf(S[mt][nt][r] * dcy); }
            __syncthreads();
            mma_128(Pm, VsT, O, wr, wc, lane);
#pragma unroll
            for (int dir = 0; dir < 2; ++dir) {
                { const bf16_t* src = STB + (size_t)sid_of(0, dir, b, ch, h) * 16384 + (tid >> 2) * 128 + (tid & 3) * 32; LAS bf16_t* d = RT + (tid >> 2) * LDK + (tid & 3) * 32;
#pragma unroll
                    for (int q = 0; q < 4; ++q) *(LAS u32x4*)(d + q * 8) = *(const u32x4*)(src + q * 8); }
                __syncthreads();
                f32x4 T[2][4]; zero_acc(T);
                mma_128(Qs, RT, T, wr, wc, lane);
#pragma unroll
                for (int mt = 0; mt < 2; ++mt)
#pragma unroll
                    for (int r = 0; r < 4; ++r) { const int i = wr * 32 + mt * 16 + fq * 4 + r; const float xi = dir == 0 ? fexp(lg0 * (float)(i + 1)) : fexp(lg1 * (float)(128 - i));
#pragma unroll
                        for (int nt = 0; nt < 4; ++nt) O[mt][nt][r] += xi * T[mt][nt][r]; }
                __syncthreads();
            }
        } else {
#pragma unroll
            for (int dir = 0; dir < 2; ++dir) {
                float rp[2][4];
#pragma unroll
                for (int mt = 0; mt < 2; ++mt)
#pragma unroll
                    for (int r = 0; r < 4; ++r) { const int i = wr * 32 + mt * 16 + fq * 4 + r; const float bi = bA[dir * 128 + i] - mtA[dir * 128 + i]; float acc = 0.f;
#pragma unroll
                        for (int nt = 0; nt < 4; ++nt) { const int j = wc * 64 + nt * 16 + fr; const bool valid = dir == 0 ? (j <= i) : (j >= i);
                            const float e = valid ? fexp(bi - bA[dir * 128 + j] + igA[dir * 128 + j]) : 0.f; const float pv = S[mt][nt][r] * e;
                            Pm[i * LDK + j] = f2bf(pv); acc += pv; }
                        rp[mt][r] = row16_sum(acc); }
                if (fr == 0) {
#pragma unroll
                    for (int mt = 0; mt < 2; ++mt)
#pragma unroll
                        for (int r = 0; r < 4; ++r) rowsum[wc * 256 + dir * 128 + wr * 32 + mt * 16 + fq * 4 + r] = rp[mt][r];
                }
                { const bf16_t* src = STB + (size_t)sid_of(1, dir, b, ch, h) * 16384 + (tid >> 2) * 128 + (tid & 3) * 32; LAS bf16_t* d = RT + (tid >> 2) * LDK + (tid & 3) * 32;
#pragma unroll
                    for (int q = 0; q < 4; ++q) *(LAS u32x4*)(d + q * 8) = *(const u32x4*)(src + q * 8); }
                __syncthreads();
                f32x4 T[2][4]; zero_acc(T);
                mma_128(Qs, RT, T, wr, wc, lane);
#pragma unroll
                for (int mt = 0; mt < 2; ++mt)
#pragma unroll
                    for (int r = 0; r < 4; ++r) { const float si = sintA[dir * 128 + wr * 32 + mt * 16 + fq * 4 + r];
#pragma unroll
                        for (int nt = 0; nt < 4; ++nt) T[mt][nt][r] *= si; }
                mma_128(Pm, VsT, T, wr, wc, lane);
#pragma unroll
                for (int mt = 0; mt < 2; ++mt)
#pragma unroll
                    for (int r = 0; r < 4; ++r) { const int i = wr * 32 + mt * 16 + fq * 4 + r; const float si = sintA[dir * 128 + i];
                        float den = (rowsum[dir * 128 + i] + rowsum[256 + dir * 128 + i]) + qn[dir * 128 + i] * si; den = fmaxf(fabsf(den), fexp(-mtA[dir * 128 + i])); const float rden = frcp(den);
#pragma unroll
                        for (int nt = 0; nt < 4; ++nt) O[mt][nt][r] += T[mt][nt][r] * rden; }
                __syncthreads();
            }
        }
#pragma unroll
        for (int mt = 0; mt < 2; ++mt)
#pragma unroll
            for (int nt = 0; nt < 4; ++nt)
#pragma unroll
                for (int r = 0; r < 4; ++r) Os[(wr * 32 + mt * 16 + fq * 4 + r) * 132 + wc * 64 + nt * 16 + fr] = O[mt][nt][r];
        __syncthreads();
        {
            const float* gng = (mixer == 0 ? p.in[I_CGNG] : p.in[I_DGNG]) + h * 128; const float* gnb = (mixer == 0 ? p.in[I_CGNB] : p.in[I_DGNB]) + h * 128;
            const float g0 = gng[lane], g1 = gng[lane + 64], b0 = gnb[lane], b1 = gnb[lane + 64];
#pragma unroll 1
            for (int i4 = 0; i4 < 16; i4 += 4) {
                float qg0[4], qg1[4];
#pragma unroll
                for (int u = 0; u < 4; ++u) { const int row = row0 + wid * 16 + i4 + u; qg0[u] = bf2f(P[(size_t)row * LDP1 + colQ + 1536 + lane]); qg1[u] = bf2f(P[(size_t)row * LDP1 + colQ + 1536 + 64 + lane]); }
#pragma unroll
                for (int u = 0; u < 4; ++u) { const int i = wid * 16 + i4 + u, row = row0 + i;
                    const float x0 = Os[i * 132 + lane], x1 = Os[i * 132 + 64 + lane];
                    const float mean = wave_sum(x0 + x1) * (1.0f / 128.0f), d0 = x0 - mean, d1 = x1 - mean;
                    const float rstd = rsqrtf(wave_sum(d0 * d0 + d1 * d1) * (1.0f / 128.0f) + LN_EPS);
                    const float q0 = qg0[u], q1 = qg1[u];
                    const float s0 = sigm(q0), s1 = sigm(q1);
                    const float y0 = (d0 * rstd * g0 + b0) * (mixer == 0 ? q0 * s0 : s0), y1 = (d1 * rstd * g1 + b1) * (mixer == 0 ? q1 * s1 : s1);
                    Y[(size_t)row * 1024 + mixer * 512 + h * 128 + lane] = f2bf(y0); Y[(size_t)row * 1024 + mixer * 512 + h * 128 + 64 + lane] = f2bf(y1); }
            }
        }
        __syncthreads();
    }
}
__device__ __forceinline__ void ph_c3(const Params& p, LAS unsigned char* lds, int bid, int nblk) {
    for (int u2 = bid; u2 < NB * NCHUNK * 4; u2 += nblk) {
        int mixer, h, ch, b, row0; unit_decode(u2 * 2, mixer, h, ch, b, row0);
        c3_unit<0>(p, lds, h, ch, b, row0);
    }
    for (int u2 = nblk - 1 - bid; u2 < NB * NCHUNK * 4; u2 += nblk) {
        int mixer, h, ch, b, row0; unit_decode(u2 * 2 + 1, mixer, h, ch, b, row0);
        c3_unit<1>(p, lds, h, ch, b, row0);
    }
}
constexpr int NPHASE = 23;
__global__ void __launch_bounds__(NTHR, 2) fwd(Params p) {
    extern __shared__ __attribute__((aligned(16))) unsigned char smem_raw[];
    LAS unsigned char* lds = (LAS unsigned char*)smem_raw;
    if (threadIdx.x == 0) { LAS unsigned* st = (LAS unsigned*)(lds + LDS_BAR); st[0] = 0u; st[1] = 0u; st[2] = 0u; st[3] = 0u; }
    __syncthreads();
    XcdBarrier bar = xcd_barrier_post((unsigned*)(p.ws + WS_CTL), (volatile LAS unsigned*)(lds + LDS_BAR));
    const int bid = blockIdx.x, nblk = gridDim.x;
    unsigned char* ws = p.ws;
#ifndef PHASE_ONLY
#define PHASE_ONLY -1
#endif
#ifndef DBL_MASK
#define DBL_MASK 0u
#endif
#define PHASE(k, call) if constexpr (PHASE_ONLY < 0 || PHASE_ONLY == (k)) { if (p.lo <= (k) && (k) < p.hi) { call; if constexpr ((DBL_MASK >> (k)) & 1u) { xcd_barrier(bar); call; } if ((k) + 1 < p.hi) xcd_barrier(bar); } }
    PHASE(0, ph_prologue(p, lds, bid, nblk))
    PHASE(1, ph_mod_in(p, bid, nblk))
    PHASE(2, ph_gemm_dense<12>(lds, (const bf16_t*)(ws + WS_H), (const bf16_t*)(ws + WS_WIN0T), (bf16_t*)(ws + WS_P), LDP0, 0, 68, bid, nblk))
    PHASE(3, ph_prep_even(p, lds, bid, nblk))
    PHASE(4, ph_r1(p, lds, bid, nblk))
    PHASE(5, ph_r2(p, lds, bid, nblk))
    PHASE(6, ph_fin_even(p, bid, nblk))
    PHASE(7, ph_gemm_dense<4>(lds, (const bf16_t*)(ws + WS_YMIX), (const bf16_t*)(ws + WS_WOUTT), (bf16_t*)(ws + WS_YP), 1024, 0, 68, bid, nblk))
    PHASE(8, ph_ln1<0>(p, lds, bid, nblk))
    PHASE(9, ph_moe_gather<0>(p, lds, bid, nblk))
    PHASE(10, ph_moe_gemm1<0>(p, lds, bid, nblk))
    PHASE(11, ph_moe_gemm2<0>(p, lds, bid, nblk))
    PHASE(12, ph_ln2<0>(p, lds, bid, nblk))
    PHASE(13, ph_gemm_dense<16>(lds, (const bf16_t*)(ws + WS_H), (const bf16_t*)(ws + WS_WIN1T), (bf16_t*)(ws + WS_P), LDP1, 0, 68, bid, nblk))
    PHASE(14, ph_c1(p, lds, bid, nblk))
    PHASE(15, ph_c2(p, bid, nblk))
    PHASE(16, ph_c3(p, lds, bid, nblk))
    PHASE(17, ph_gemm_dense<4>(lds, (const bf16_t*)(ws + WS_YMIX), (const bf16_t*)(ws + WS_WOUTT) + (size_t)1024 * 1024, (bf16_t*)(ws + WS_YP), 1024, 4, 64, bid, nblk))
    PHASE(18, ph_ln1<1>(p, lds, bid, nblk))
    PHASE(19, ph_moe_gather<1>(p, lds, bid, nblk))
    PHASE(20, ph_moe_gemm1<1>(p, lds, bid, nblk))
    PHASE(21, ph_moe_gemm2<1>(p, lds, bid, nblk))
    PHASE(22, ph_ln2<1>(p, lds, bid, nblk))
#undef PHASE
}

#ifndef MK_ONE_LAUNCH
#define MK_ONE_LAUNCH 1
#endif
extern "C" void kernel_launch(void* const* d_in, const int* in_sizes, int n_in, void* d_out, int out_size, void* d_ws, size_t ws_size, hipStream_t stream) {
    static int grid = 0;
    if (grid == 0) {
        if (n_in != N_INPUTS || out_size != NB * SEQL * DM || ws_size < WS_TOTAL) { fprintf(stderr, "kernel_launch: unexpected problem (n_in %d, out %d, ws %zu < %zu)\n", n_in, out_size, ws_size, (size_t)WS_TOTAL); grid = -1; return; }
        int dev = 0, cus = 0, per_cu = 0;
        if (hipGetDevice(&dev) != hipSuccess || hipDeviceGetAttribute(&cus, hipDeviceAttributeMultiprocessorCount, dev) != hipSuccess) { grid = -1; return; }
        if (hipFuncSetAttribute((const void*)fwd, hipFuncAttributeMaxDynamicSharedMemorySize, LDS_BYTES) != hipSuccess) { fprintf(stderr, "kernel_launch: hipFuncSetAttribute failed\n"); grid = -1; return; }
        if (hipOccupancyMaxActiveBlocksPerMultiprocessor(&per_cu, (const void*)fwd, NTHR, LDS_BYTES) != hipSuccess || per_cu < 1) { fprintf(stderr, "kernel_launch: occupancy query says %d\n", per_cu); (void)hipGetLastError(); per_cu = 1; }
        grid = cus;
    }
    if (grid < 0) return;
    (void)hipMemsetAsync((char*)d_ws + WS_CTL, 0, CTL_BYTES, stream);
    Params p{};
    for (int i = 0; i < N_INPUTS; ++i) p.in[i] = (const float*)d_in[i];
    p.out = (float*)d_out; p.ws = (unsigned char*)d_ws;
#if MK_ONE_LAUNCH
    p.lo = 0; p.hi = NPHASE;
    hipLaunchKernelGGL(fwd, dim3(grid), dim3(NTHR), LDS_BYTES, stream, p);
#else
    for (int k = 0; k < NPHASE; ++k) { p.lo = k; p.hi = k + 1; hipLaunchKernelGGL(fwd, dim3(grid), dim3(NTHR), LDS_BYTES, stream, p); }
#endif
}
```

```cpp
#include <hip/hip_runtime.h>
#include <stdint.h>
#include <stdio.h>

#define LAS __attribute__((address_space(3)))
typedef unsigned short bf16_t;
typedef short bf16x8 __attribute__((ext_vector_type(8)));
typedef float f32x4 __attribute__((ext_vector_type(4)));
typedef float f32x2 __attribute__((ext_vector_type(2)));
typedef unsigned u32x4 __attribute__((ext_vector_type(4)));
typedef unsigned u32x2 __attribute__((ext_vector_type(2)));

constexpr int NB = 4, SEQL = 4096, CTXL = 256, DM = 1024;
constexpr int NCTX = NB * CTXL;
constexpr int MROWS = NCTX + NB * SEQL;
constexpr int NTHR = 512;
constexpr int LDP0 = 3072, LDP1 = 4096;
constexpr int A_IN = 1920, EVEN_IN = 2944, ODD_IN = 4112;
constexpr int NEXP = 32, DFF = 1024;
constexpr int MOE_ROWS_MAX = 69632 + 32 * 256;
constexpr float DN_ALPHA = 1.41421356237309515f;
constexpr float LN_EPS = 1e-5f;
constexpr int NCHUNK = 34;

enum { I_X = 0, I_C, I_CTX, I_CCTX, I_WMOD, I_BMOD, I_LNG, I_LNB, I_EWIN, I_EWOUT, I_AMU, I_AW0, I_AWB, I_AA0, I_AAB, I_AGB, I_AKK, I_AKA, I_ARK,
       I_AGNG, I_AGNB, I_BCW, I_BCB, I_BGW, I_BGB, I_BLAM, I_OWIN, I_OWOUT, I_CLG, I_CGNG, I_CGNB, I_DIB, I_DFB, I_DGNG, I_DGNB, I_RW, I_RB,
       I_W1, I_B1, I_W2, I_B2, N_INPUTS };

constexpr size_t al256(size_t x) { return (x + 255) & ~(size_t)255; }
constexpr size_t WS_CTL   = 0;
constexpr size_t CTL_BYTES = 65536;
constexpr size_t CTL_CNT  = 16384;
constexpr size_t WS_MOD   = WS_CTL + CTL_BYTES;
constexpr size_t WS_ROPE  = WS_MOD + al256((size_t)2 * 5 * 6144 * 4);
constexpr size_t WS_WIN0T = WS_ROPE + 16384;
constexpr size_t WS_WIN1T = WS_WIN0T + (size_t)3072 * 1024 * 2;
constexpr size_t WS_WOUTT = WS_WIN1T + (size_t)4096 * 1024 * 2;
constexpr size_t WS_W1T   = WS_WOUTT + (size_t)2 * 1024 * 1024 * 2;
constexpr size_t WS_W2T   = WS_W1T + (size_t)2 * 32 * 2048 * 1024 * 2;
constexpr size_t WS_XS    = WS_W2T + (size_t)2 * 32 * 1024 * 1024 * 2;
constexpr size_t WS_H     = WS_XS + (size_t)MROWS * 1024 * 4;
constexpr size_t WS_YMIX  = WS_H + (size_t)MROWS * 1024 * 2;
constexpr size_t WS_YP    = WS_YMIX + (size_t)MROWS * 1024 * 2;
constexpr size_t WS_GT    = WS_YP + (size_t)MROWS * 1024 * 4;
constexpr size_t WS_TOPE  = WS_GT + (size_t)MROWS * 16 * 4;
constexpr size_t WS_TOPW  = WS_TOPE + (size_t)MROWS * 16;
constexpr size_t WS_TOPS  = WS_TOPW + (size_t)MROWS * 16;
constexpr size_t WS_POS   = WS_TOPS + (size_t)MROWS * 16;
constexpr size_t WS_CNTB  = WS_POS + (size_t)MROWS * 16;
constexpr size_t WS_WLT   = WS_CNTB + (size_t)2 * 512 * 32 * 4;
constexpr size_t WLT_WB = 0, WLT_AB = 65536, WLT_GB = 131072, WLT_GW = 196608, WLT_N = 327680;
constexpr size_t WS_P     = WS_WLT + (size_t)WLT_N * 2;
constexpr size_t WS_BIG   = WS_P + (size_t)MROWS * 4096 * 4;
constexpr size_t ARR512   = (size_t)MROWS * 512 * 4;
constexpr int SCREC = 448;
constexpr int SCLEN = CTXL + SEQL;
constexpr size_t WS_SC    = WS_BIG;
enum { E_G = 0, E_O0, E_O1, E_A0, E_A1, E_BX0, E_BX1, E_GATE, E_NARR };
constexpr size_t WS_EARR  = WS_SC + (size_t)64 * SCLEN * SCREC * 2;
constexpr size_t WS_BC    = WS_EARR + (size_t)E_NARR * ARR512;
constexpr size_t WS_CHA   = WS_BC + (size_t)MROWS * 8 * 4;
constexpr size_t WS_CHH   = WS_CHA + (size_t)2 * 512 * 512 * 4;
constexpr size_t WS_CIN   = WS_CHH + (size_t)2 * 512 * 512 * 4;
constexpr int RCH = 64, NRCH = SCLEN / RCH, NRUNIT = 64 * NRCH;
constexpr size_t WS_RU    = WS_CIN + (size_t)2 * 512 * 512 * 4;
constexpr size_t WS_EEND  = WS_RU + (size_t)NRUNIT * 4 * 4096 * 4;
constexpr int NSID = 2 * 2 * NB * NCHUNK * 4;
constexpr size_t WS_ST    = WS_BIG;
constexpr size_t WS_NST   = WS_ST + (size_t)NSID * 16384 * 4;
constexpr size_t WS_MEND  = WS_NST + (size_t)NSID * 128 * 4;
constexpr size_t WS_BEND  = WS_MEND + al256((size_t)NSID * 4);
constexpr size_t WS_MPREV = WS_BEND + al256((size_t)NSID * 4);
constexpr size_t WS_CB    = WS_MPREV + al256((size_t)NSID * 4);
constexpr size_t WS_CMI   = WS_CB + (size_t)NSID * 128 * 4;
constexpr size_t WS_STB   = WS_CMI + (size_t)NSID * 128 * 4;
constexpr size_t WS_OEND  = WS_STB + (size_t)NSID * 16384 * 2;
constexpr size_t WS_ASORT = WS_BIG;
constexpr size_t WS_IDX   = WS_BIG;
constexpr size_t WS_ACT   = WS_ASORT + (size_t)MOE_ROWS_MAX * 1024 * 2;
constexpr size_t WS_YE    = WS_ACT + (size_t)MOE_ROWS_MAX * 1024 * 2;
constexpr size_t WS_MEND_ = WS_YE + (size_t)MOE_ROWS_MAX * 1024 * 4;
constexpr size_t WS_TOTAL = (WS_EEND > WS_MEND_ ? (WS_EEND > WS_OEND ? WS_EEND : WS_OEND) : (WS_MEND_ > WS_OEND ? WS_MEND_ : WS_OEND));

constexpr int LDS_BYTES = 155648;
constexpr int LDS_BAR = 0;
constexpr int LDS_WORK = 1024;

struct Params {
    const float* in[N_INPUTS];
    float* out;
    unsigned char* ws;
    int lo, hi;
};

typedef __bf16 nbf16x2 __attribute__((ext_vector_type(2)));
__device__ __forceinline__ unsigned pack_bf16(float lo, float hi) { const nbf16x2 v = {(__bf16)lo, (__bf16)hi}; return __builtin_bit_cast(unsigned, v); }
__device__ __forceinline__ bf16_t f2bf(float f) { return __builtin_bit_cast(bf16_t, (__bf16)f); }
__device__ __forceinline__ float bf2f(bf16_t b) { return __uint_as_float(((unsigned)b) << 16); }
__device__ __forceinline__ f32x4 ld_bf16x4(const bf16_t* p) { const u32x2 w = *(const u32x2*)p; return (f32x4){__uint_as_float(w.x << 16), __uint_as_float(w.x & 0xffff0000u), __uint_as_float(w.y << 16), __uint_as_float(w.y & 0xffff0000u)}; }
__device__ __forceinline__ float fexp(float x) { return __builtin_amdgcn_exp2f(x * 1.4426950408889634f); }
__device__ __forceinline__ float frcp(float x) { return __builtin_amdgcn_rcpf(x); }
__device__ __forceinline__ float fsqrt(float x) { return __builtin_amdgcn_sqrtf(x); }
__device__ __forceinline__ float sigm(float x) { return frcp(1.0f + fexp(-x)); }
__device__ __forceinline__ float ftanh(float x) { const float e = fexp(-2.0f * fabsf(x)), t = (1.0f - e) * frcp(1.0f + e); return x < 0.f ? -t : t; }
__device__ __forceinline__ float fexpm1_neg(float x) {
    const float p = x * (1.0f + x * (0.5f + x * (0.16666667f + x * (0.041666668f + x * 0.0083333338f))));
    return x > -0.25f ? p : fexp(x) - 1.0f; }
__device__ __forceinline__ float softplusf(float x) { return fmaxf(x, 0.f) + log1pf(expf(-fabsf(x))); }
__device__ __forceinline__ float wave_sum(float v) {
    v += __int_as_float(__builtin_amdgcn_update_dpp(0, __float_as_int(v), 0x121, 0xf, 0xf, false));
    v += __int_as_float(__builtin_amdgcn_update_dpp(0, __float_as_int(v), 0x122, 0xf, 0xf, false));
    v += __int_as_float(__builtin_amdgcn_update_dpp(0, __float_as_int(v), 0x124, 0xf, 0xf, false));
    v += __int_as_float(__builtin_amdgcn_update_dpp(0, __float_as_int(v), 0x128, 0xf, 0xf, false));
    v += __int_as_float(__builtin_amdgcn_update_dpp(0, __float_as_int(v), 0x142, 0xa, 0xf, false));
    v += __int_as_float(__builtin_amdgcn_update_dpp(0, __float_as_int(v), 0x143, 0xc, 0xf, false));
    return __int_as_float(__builtin_amdgcn_readlane(__float_as_int(v), 63));
}
__device__ __forceinline__ float wave_max(float v) {
    const int ninf = 0xff800000;
    v = fmaxf(v, __int_as_float(__builtin_amdgcn_update_dpp(ninf, __float_as_int(v), 0x121, 0xf, 0xf, false)));
    v = fmaxf(v, __int_as_float(__builtin_amdgcn_update_dpp(ninf, __float_as_int(v), 0x122, 0xf, 0xf, false)));
    v = fmaxf(v, __int_as_float(__builtin_amdgcn_update_dpp(ninf, __float_as_int(v), 0x124, 0xf, 0xf, false)));
    v = fmaxf(v, __int_as_float(__builtin_amdgcn_update_dpp(ninf, __float_as_int(v), 0x128, 0xf, 0xf, false)));
    v = fmaxf(v, __int_as_float(__builtin_amdgcn_update_dpp(ninf, __float_as_int(v), 0x142, 0xa, 0xf, false)));
    v = fmaxf(v, __int_as_float(__builtin_amdgcn_update_dpp(ninf, __float_as_int(v), 0x143, 0xc, 0xf, false)));
    return __int_as_float(__builtin_amdgcn_readlane(__float_as_int(v), 63));
}
__device__ __forceinline__ int wave_min_i(int v) {
    const int big = 0x7fffffff;
    v = min(v, __builtin_amdgcn_update_dpp(big, v, 0x121, 0xf, 0xf, false));
    v = min(v, __builtin_amdgcn_update_dpp(big, v, 0x122, 0xf, 0xf, false));
    v = min(v, __builtin_amdgcn_update_dpp(big, v, 0x124, 0xf, 0xf, false));
    v = min(v, __builtin_amdgcn_update_dpp(big, v, 0x128, 0xf, 0xf, false));
    v = min(v, __builtin_amdgcn_update_dpp(big, v, 0x142, 0xa, 0xf, false));
    v = min(v, __builtin_amdgcn_update_dpp(big, v, 0x143, 0xc, 0xf, false));
    return __builtin_amdgcn_readlane(v, 63);
}
__device__ __forceinline__ float row16_sum(float v) {
    v += __int_as_float(__builtin_amdgcn_update_dpp(0, __float_as_int(v), 0x121, 0xf, 0xf, false));
    v += __int_as_float(__builtin_amdgcn_update_dpp(0, __float_as_int(v), 0x122, 0xf, 0xf, false));
    v += __int_as_float(__builtin_amdgcn_update_dpp(0, __float_as_int(v), 0x124, 0xf, 0xf, false));
    v += __int_as_float(__builtin_amdgcn_update_dpp(0, __float_as_int(v), 0x128, 0xf, 0xf, false));
    return v;
}
__device__ __forceinline__ int row_batch(int row) { return row < NCTX ? (row >> 8) : ((row - NCTX) >> 12); }
__device__ __forceinline__ int row_modr(int row) { return row < NCTX ? 4 : ((row - NCTX) >> 12); }
#define XB_TMO      128
#define XB_XCNT(j)  (256  + 64 * (j))
#define XB_XSUB(j)  (1280 + 64 * (j))
#define XB_XGEN(j)  (2304 + 64 * (j))
#define XB_TOP      3328
#define XB_TOPGEN   3392
#define XCD_BAR_WORDS 3456
#define XB_SPIN_CAP (1u << 18)

__device__ __forceinline__ unsigned xb_ld(unsigned* p)              { return __hip_atomic_load(p, __ATOMIC_RELAXED, __HIP_MEMORY_SCOPE_AGENT); }
__device__ __forceinline__ unsigned xb_add(unsigned* p, unsigned v) { return __hip_atomic_fetch_add(p, v, __ATOMIC_RELAXED, __HIP_MEMORY_SCOPE_AGENT); }
__device__ __forceinline__ unsigned xb_xcc_id() { return (unsigned)__builtin_amdgcn_s_getreg((3 << 11) | 20) & 0xFu; }
#define XB_SPIN(cond, bar) do { unsigned _sp = 0; while (cond) { __builtin_amdgcn_s_sleep(1); \
    if ((++_sp & 255u) == 0u) { if (xb_ld(&(bar)[XB_TMO])) break; if (_sp > XB_SPIN_CAP) { atomicAdd(&(bar)[XB_TMO], 1u); break; } } } } while (0)

struct XcdBarrier {
    unsigned* bar; unsigned x;
    volatile LAS unsigned* st;
};

__device__ __forceinline__ XcdBarrier xcd_barrier_post(unsigned* bar, volatile LAS unsigned* st) {
    XcdBarrier b; b.bar = bar; b.x = xb_xcc_id(); b.st = st;
    if (threadIdx.x == 0) (void)xb_add(&bar[XB_XCNT(b.x)], 1u);
    return b;
}
__device__ __forceinline__ void xcd_barrier_complete(unsigned* bar, unsigned x, unsigned& nloc, unsigned& nx) {
    const unsigned G = gridDim.x * gridDim.y * gridDim.z;
    unsigned sum, cnt, mine, sp = 0u;
    for (;;) {
        sum = 0u; cnt = 0u; mine = 0u;
#pragma unroll
        for (unsigned j = 0; j < 16; ++j) { const unsigned c = xb_ld(&bar[XB_XCNT(j)]); sum += c; cnt += (c > 0u) ? 1u : 0u; mine = (j == x) ? c : mine; }
        if (sum == G) break;
        __builtin_amdgcn_s_sleep(1);
        if ((++sp & 255u) == 0u) { if (xb_ld(&bar[XB_TMO])) break; if (sp > XB_SPIN_CAP) { atomicAdd(&bar[XB_TMO], 1u); break; } }
    }
    nloc = mine > 0u ? mine : 1u; nx = cnt > 0u ? cnt : 1u;
}

__device__ __forceinline__ void xcd_barrier(const XcdBarrier& b) {
    asm volatile("s_waitcnt vmcnt(0)" ::: "memory");
    __syncthreads();
    if (threadIdx.x == 0) {
        unsigned* bar = b.bar;
        __builtin_amdgcn_s_waitcnt(0);
        unsigned nloc = b.st[0], nx = b.st[1];
        if (nloc == 0u) { xcd_barrier_complete(bar, b.x, nloc, nx); b.st[0] = nloc; b.st[1] = nx; }
        const unsigned old = xb_add(&bar[XB_XSUB(b.x)], 1u);
        const unsigned gen = old / nloc;
        if (old + 1u == (gen + 1u) * nloc) {
            __builtin_amdgcn_fence(__ATOMIC_RELEASE, "agent");
            asm volatile("s_waitcnt vmcnt(0)" ::: "memory");
            const unsigned og = xb_add(&bar[XB_TOP], 1u);
            const unsigned tg = og / nx;
            if (og + 1u == (tg + 1u) * nx) xb_add(&bar[XB_TOPGEN], 1u);
            else XB_SPIN(xb_ld(&bar[XB_TOPGEN]) == tg, bar);
            __builtin_amdgcn_fence(__ATOMIC_ACQUIRE, "agent");
            xb_add(&bar[XB_XGEN(b.x)], 1u);
            asm volatile("s_waitcnt vmcnt(0)" ::: "memory");
        } else {
            XB_SPIN(xb_ld(&bar[XB_XGEN(b.x)]) == gen, bar);
            __builtin_amdgcn_fence(__ATOMIC_ACQUIRE, "agent");
            asm volatile("s_waitcnt vmcnt(0)" ::: "memory");
        }
    }
    __syncthreads();
}
namespace pg8 {
constexpr int BM = 256, BK = 64, HALF = 128, HTB = HALF * BK * 2  , STAGE_BYTES = 8 * HTB, NXCD = 8, WGM = 8;

__host__ __device__ __forceinline__ int lds_byte(int r, int c) { const int st = (r >> 4) * 2 + (c >> 5), rr = r & 15, cc = c & 31, ob = rr * 64 + cc * 2; return st * 1024 + (ob ^ (((ob >> 9) & 1) << 5)); }
__host__ __device__ __forceinline__ void stage_rc(int b, int& R, int& C) { const int st = b / 1024, sb = b % 1024, swz = sb ^ (((sb >> 9) & 1) << 5); R = (st >> 1) * 16 + swz / 64; C = (st & 1) * 32 + (swz % 64) / 2; }
__host__ __device__ __forceinline__ int perm32(int rho) { const int n = rho >> 4, i = rho & 15; return 8 * (i >> 2) + 4 * n + (i & 3); }

struct Unit { int pm, pn; };
struct Gemm { const bf16_t* A; const bf16_t* Bt; int M, N, K; const int* aidx; };
__device__ __forceinline__ unsigned cvt_pk_bf16(float lo, float hi) { return pack_bf16(lo, hi); }
template <class Epi, class Sched, bool STAMP = false, bool ATILED = false, bool BTILED = false, bool AGATHER = false>
__device__ __forceinline__ void gemm_phase(LAS unsigned char* lds, const Gemm g, const Sched& S, const Epi& E, unsigned long long* stamps) {
    const int tid = threadIdx.x, wid = __builtin_amdgcn_readfirstlane(tid >> 6), lane = tid & 63, wr = wid >> 2, wc = wid & 3, fr = lane & 15, fq = lane >> 4;
    const int K = g.K, nt = K / BK;
    int ts_lo = 0, ts_hi = 0, nts = 0; const unsigned long long rt_entry = STAMP ? (unsigned long long)wall_clock64() : 0ull;
#define PG8_STAMP() do { if (STAMP && wid == 0 && nts < 64) { const unsigned long long _c = (unsigned long long)clock64(); \
        ts_lo = (lane == nts) ? (int)(unsigned)_c : ts_lo; ts_hi = (lane == nts) ? (int)(unsigned)(_c >> 32) : ts_hi; ++nts; } } while (0)
    PG8_STAMP();
    unsigned voffA[2], voffB[2];
#pragma unroll
    for (int i = 0; i < 2; ++i) { int R, C; stage_rc(tid * 16 + i * 8192, R, C); const int Rb = Epi::PERM ? ((R & ~31) + perm32(R & 31)) : R;
        voffA[i] = (unsigned)(R * (ATILED ? BK : K) + C) * 2u; voffB[i] = (unsigned)(Rb * (BTILED ? BK : K) + C) * 2u; }
    const size_t kstepA = ATILED ? (size_t)BM * BK * 2 : (size_t)(BK * 2), kstepB = BTILED ? (size_t)BM * BK * 2 : (size_t)(BK * 2);
    const size_t hstepA = ATILED ? (size_t)HALF * BK * 2 : (size_t)HALF * K * 2, hstepB = BTILED ? (size_t)HALF * BK * 2 : (size_t)HALF * K * 2;
    const size_t tstep = (size_t)BM * K * 2;
    const unsigned ldsw = (unsigned)wid * 1024u;
    static_assert(!(AGATHER && ATILED), "a gathered operand is row-major");
    int gR0 = 0, gC0 = 0; { int R, C; stage_rc(tid * 16, R, C); gR0 = R; gC0 = C * 2; }
    unsigned vAc[4] = {0u, 0u, 0u, 0u};
    LAS int* gslot = (LAS int*)(lds + STAGE_BYTES + 8192 + 2048);
    const int aoff = lds_byte(wr * 64 + fr, fq * 8), boff = lds_byte(wc * 32 + fr, fq * 8);
#define PG8_SA(b, h) (((b) * 2 + (h)) * HTB)
#define PG8_SB(b, h) ((4 + (b) * 2 + (h)) * HTB)
#define PG8_STAGE(bufoff, gbase, voff) do { _Pragma("unroll") for (int _i = 0; _i < 2; ++_i) \
        __builtin_amdgcn_global_load_lds((const unsigned*)((const char*)(gbase) + (voff)[_i]), (LAS unsigned*)(lds + (bufoff) + ldsw + _i * 8192), 16, 0, 0); } while (0)
#define PG8_STAGE_A(bufoff, gbase, kbytes, h, vg) do { if constexpr (AGATHER) { _Pragma("unroll") for (int _i = 0; _i < 2; ++_i) \
        __builtin_amdgcn_global_load_lds((const unsigned*)((const char*)g.A + (kbytes) + (vg)[(h) * 2 + _i]), (LAS unsigned*)(lds + (bufoff) + ldsw + _i * 8192), 16, 0, 0); } \
        else PG8_STAGE(bufoff, gbase, voffA); } while (0)
#define PG8_LDA(dst, b, h) do { _Pragma("unroll") for (int m = 0; m < 4; ++m) _Pragma("unroll") for (int k = 0; k < 2; ++k) dst[m][k] = *(const LAS bf16x8*)(lds + PG8_SA(b, h) + aoff + m * 2048 + k * 1024); } while (0)
#define PG8_LDB(dst, b, h) do { _Pragma("unroll") for (int n = 0; n < 2; ++n) _Pragma("unroll") for (int k = 0; k < 2; ++k) dst[n][k] = *(const LAS bf16x8*)(lds + PG8_SB(b, h) + boff + n * 2048 + k * 1024); } while (0)
#define PG8_MMA(ai, bj, At, Bt) do { __builtin_amdgcn_s_setprio(1); _Pragma("unroll") for (int m = 0; m < 4; ++m) _Pragma("unroll") for (int n = 0; n < 2; ++n) _Pragma("unroll") for (int k = 0; k < 2; ++k) \
        acc[ai][bj][m][n] = __builtin_amdgcn_mfma_f32_16x16x32_bf16(Bt[n][k], At[m][k], acc[ai][bj][m][n], 0, 0, 0); __builtin_amdgcn_s_setprio(0); } while (0)
#define PG8_WAIT_V(n) asm volatile("s_waitcnt vmcnt(" #n ")" ::: "memory")
#define PG8_WAIT_L(n) asm volatile("s_waitcnt lgkmcnt(" #n ")" ::: "memory")
#define PG8_BAR __builtin_amdgcn_s_barrier()
#define PG8_SCHED __builtin_amdgcn_sched_barrier(0)
    Unit cur, nxt; int ui = 0;
    if (!S.next(0, cur)) return;
    f32x4 acc[2][2][4][2];
#pragma unroll
    for (int a = 0; a < 2; ++a)
#pragma unroll
        for (int b = 0; b < 2; ++b)
#pragma unroll
            for (int m = 0; m < 4; ++m)
#pragma unroll
                for (int n = 0; n < 2; ++n) acc[a][b][m][n] = (f32x4){0.f, 0.f, 0.f, 0.f};
    bf16x8 At[4][2], B0[2][2], B1[2][2];
    const char* cA = (const char*)g.A + (size_t)cur.pm * tstep; const char* cB = (const char*)g.Bt + (size_t)cur.pn * tstep;
    S.a_ready(cur);
    if constexpr (AGATHER) {
#pragma unroll
        for (int j = 0; j < 4; ++j) vAc[j] = (unsigned)g.aidx[cur.pm * BM + gR0 + 64 * j] * (unsigned)(K * 2) + (unsigned)gC0;
    }
    PG8_STAGE(PG8_SB(0, 0), cB, voffB); PG8_STAGE_A(PG8_SA(0, 0), cA, 0, 0, vAc); PG8_STAGE(PG8_SB(0, 1), cB + hstepB, voffB); PG8_STAGE_A(PG8_SA(0, 1), cA + hstepA, 0, 1, vAc);
    if (wr == 1) PG8_BAR;
    PG8_WAIT_V(4); PG8_BAR;
    PG8_STAGE(PG8_SB(1, 0), cB + kstepB, voffB); PG8_STAGE_A(PG8_SA(1, 0), cA + kstepA, BK * 2, 0, vAc); PG8_STAGE(PG8_SB(1, 1), cB + hstepB + kstepB, voffB);
    PG8_WAIT_V(6); PG8_BAR;
    PG8_STAMP();
    for (;;) {
        const bool has_next = S.next(ui + 1, nxt);
        const char* nA = has_next ? (const char*)g.A + (size_t)nxt.pm * tstep : cA; const char* nB = has_next ? (const char*)g.Bt + (size_t)nxt.pn * tstep : cB;
        E.pre(lds, ui & 1, cur, wid, lane);
        if constexpr (AGATHER) { if (has_next && wid == 0) __builtin_amdgcn_global_load_lds((const unsigned*)(g.aidx + nxt.pm * BM + lane * 4), (LAS unsigned*)(gslot + ((ui + 1) & 1) * 256), 16, 0, 0); }
        for (int t = 0; t < nt; t += 2) {
            const bool last = (t == nt - 2);
            const char* a1 = cA + (size_t)(t + 1) * kstepA;
            const char* a2 = last ? nA : cA + (size_t)(t + 2) * kstepA; const char* b2 = last ? nB : cB + (size_t)(t + 2) * kstepB;
            const char* a3 = a2 + kstepA; const char* b3 = b2 + kstepB;
            if (last && has_next) S.a_ready(nxt);
            const int kb2 = AGATHER ? (last ? 0 : (t + 2) * BK * 2) : 0;
            PG8_LDB(B0, 0, 0); PG8_SCHED; PG8_LDA(At, 0, 0); PG8_STAGE_A(PG8_SA(1, 1), a1 + hstepA, (t + 1) * BK * 2, 1, vAc);
            if constexpr (AGATHER) { if (last && has_next) {
#pragma unroll
                for (int j = 0; j < 4; ++j) vAc[j] = (unsigned)gslot[((ui + 1) & 1) * 256 + gR0 + 64 * j] * (unsigned)(K * 2) + (unsigned)gC0; } }
            PG8_WAIT_L(8); PG8_BAR; PG8_WAIT_L(0); PG8_MMA(0, 0, At, B0); PG8_BAR; PG8_SCHED;
            PG8_LDB(B1, 0, 1); PG8_STAGE(PG8_SB(0, 0), b2, voffB);
            PG8_BAR; PG8_WAIT_L(0); PG8_MMA(0, 1, At, B1); PG8_BAR;
            PG8_LDA(At, 0, 1); PG8_STAGE_A(PG8_SA(0, 0), a2, kb2, 0, vAc);
            PG8_BAR; PG8_WAIT_L(0); PG8_MMA(1, 0, At, B0); PG8_BAR; PG8_SCHED;
            PG8_STAGE(PG8_SB(0, 1), b2 + hstepB, voffB);
            PG8_WAIT_V(6); PG8_BAR; PG8_MMA(1, 1, At, B1); PG8_BAR;
            PG8_LDB(B0, 1, 0); PG8_SCHED; PG8_LDA(At, 1, 0); PG8_STAGE_A(PG8_SA(0, 1), a2 + hstepA, kb2, 1, vAc);
            PG8_WAIT_L(8); PG8_BAR; PG8_WAIT_L(0); PG8_MMA(0, 0, At, B0); PG8_BAR; PG8_SCHED;
            PG8_LDB(B1, 1, 1); PG8_STAGE(PG8_SB(1, 0), b3, voffB);
            PG8_BAR; PG8_WAIT_L(0); PG8_MMA(0, 1, At, B1); PG8_BAR;
            PG8_LDA(At, 1, 1); PG8_STAGE_A(PG8_SA(1, 0), a3, kb2 + BK * 2, 0, vAc);
            PG8_BAR; PG8_WAIT_L(0); PG8_MMA(1, 0, At, B0); PG8_BAR; PG8_SCHED;
            PG8_STAGE(PG8_SB(1, 1), b3 + hstepB, voffB);
            PG8_WAIT_V(6); PG8_BAR; PG8_MMA(1, 1, At, B1); PG8_BAR;
        }
        PG8_STAMP();
        if constexpr (!Epi::AFTER_DRAIN) { E(acc, cur, wr, wc, fr, fq, lds, ui & 1); S.done(cur); }
        PG8_STAMP();
        if (!has_next) break;
#pragma unroll
        for (int a = 0; a < 2; ++a)
#pragma unroll
            for (int b = 0; b < 2; ++b)
#pragma unroll
                for (int m = 0; m < 4; ++m)
#pragma unroll
                    for (int n = 0; n < 2; ++n) acc[a][b][m][n] = (f32x4){0.f, 0.f, 0.f, 0.f};
        cur = nxt; cA = nA; cB = nB; ++ui;

    }
    PG8_WAIT_V(0);
    if (wr == 0) PG8_BAR;
    PG8_BAR;
    if constexpr (Epi::AFTER_DRAIN) { E.fused(acc, cur, wr, wc, fr, fq, lds, wid, lane); S.done(cur); }
    PG8_STAMP();
    if (STAMP && wid == 0) { stamps[lane] = lane < nts ? (((unsigned long long)(unsigned)ts_hi << 32) | (unsigned)ts_lo) : 0ull;
        if (lane == 62) stamps[62] = rt_entry; if (lane == 63) stamps[63] = (unsigned long long)wall_clock64(); }
#undef PG8_STAMP
#undef PG8_SA
#undef PG8_SB
#undef PG8_STAGE
#undef PG8_STAGE_A
#undef PG8_LDA
#undef PG8_LDB
#undef PG8_MMA
#undef PG8_WAIT_V
#undef PG8_WAIT_L
#undef PG8_BAR
#undef PG8_SCHED
}
__device__ __forceinline__ int xcd_contig(long L, int nwg) { const int q = nwg / NXCD, r = nwg % NXCD, xcd = (int)(L % NXCD), off = (int)(L / NXCD); return (xcd < r ? xcd * (q + 1) : r * (q + 1) + (xcd - r) * q) + off; }
template <int nN>
struct SchedDense {
    int nM, pm0, G, c;
    __device__ __forceinline__ bool next(int i, Unit& u) const {
        const long L = (long)i * G + c; const int nwg = nM * nN; if (L >= nwg) return false;
        const int wgid = xcd_contig(L, nwg);
        constexpr int nig = WGM * nN; const int gid = wgid / nig, fm = gid * WGM, gsz = (nM - fm) < WGM ? (nM - fm) : WGM, w = wgid % nig;
        if (gsz == WGM) { u.pm = pm0 + fm + (w & (WGM - 1)); u.pn = w >> 3; } else { u.pm = pm0 + fm + (w % gsz); u.pn = w / gsz; }
        return true; }
    __device__ __forceinline__ void a_ready(const Unit&) const {}
    __device__ __forceinline__ void done(const Unit&) const {}
};
template <int nN>
struct SchedMoe {
    int T, G, c; const LAS int* tileE;
    __device__ __forceinline__ bool next(int i, Unit& u) const { const long L = (long)i * G + c; const int nwg = T * nN; if (L >= nwg) return false;
        const int wgid = xcd_contig(L, nwg), pt = wgid / nN; u.pm = pt; u.pn = tileE[pt] * nN + (wgid % nN); return true; }
    __device__ __forceinline__ void a_ready(const Unit&) const {}
    __device__ __forceinline__ void done(const Unit&) const {}
};
constexpr int EPI_BIAS_OFF = STAGE_BYTES + 8192;
struct EpiStore {
    static constexpr bool PERM = true, AFTER_DRAIN = false;
    bf16_t* O; int ldc;
    __device__ __forceinline__ void pre(LAS unsigned char*, int, const Unit&, int, int) const {}
    __device__ __forceinline__ void operator()(const f32x4 (&acc)[2][2][4][2], const Unit& u, int wr, int wc, int fr, int fq, const LAS unsigned char*, int) const {
        const int row0 = u.pm * BM + wr * 64 + fr, col0 = u.pn * BM + wc * 32 + 8 * fq;
#pragma unroll
        for (int ai = 0; ai < 2; ++ai)
#pragma unroll
            for (int m = 0; m < 4; ++m) { bf16_t* rowp = O + (size_t)(row0 + ai * HALF + m * 16) * ldc + col0;
#pragma unroll
                for (int bj = 0; bj < 2; ++bj) { const f32x4 v0 = acc[ai][bj][m][0], v1 = acc[ai][bj][m][1];
                    u32x4 w; w.x = cvt_pk_bf16(v0[0], v0[1]); w.y = cvt_pk_bf16(v0[2], v0[3]); w.z = cvt_pk_bf16(v1[0], v1[1]); w.w = cvt_pk_bf16(v1[2], v1[3]);
                    *(u32x4*)(rowp + bj * HALF) = w; } }
    }
};
struct EpiYE {
    static constexpr bool PERM = true, AFTER_DRAIN = false;
    bf16_t* O; const float* b2;
    __device__ __forceinline__ void pre(LAS unsigned char* lds, int par, const Unit& u, int wid, int lane) const {
        if (wid == 0) __builtin_amdgcn_global_load_lds((const unsigned*)(b2 + (u.pn >> 2) * 1024 + (u.pn & 3) * BM + lane * 4), (LAS unsigned*)(lds + EPI_BIAS_OFF + par * 1024), 16, 0, 0);
    }
    __device__ __forceinline__ void operator()(const f32x4 (&acc)[2][2][4][2], const Unit& u, int wr, int wc, int fr, int fq, const LAS unsigned char* lds, int par) const {
        const int pn = u.pn & 3;
        const int row0 = u.pm * BM + wr * 64 + fr, col0 = pn * BM + wc * 32 + 8 * fq;
        const LAS float* bp = (const LAS float*)(lds + EPI_BIAS_OFF + par * 1024) + wc * 32 + 8 * fq;
        f32x4 bv[2][2];
#pragma unroll
        for (int bj = 0; bj < 2; ++bj)
#pragma unroll
            for (int n = 0; n < 2; ++n) bv[bj][n] = *(const LAS f32x4*)(bp + bj * HALF + 4 * n);
#pragma unroll
        for (int ai = 0; ai < 2; ++ai)
#pragma unroll
            for (int m = 0; m < 4; ++m) { bf16_t* rowp = O + (size_t)(row0 + ai * HALF + m * 16) * 1024 + col0;
#pragma unroll
                for (int bj = 0; bj < 2; ++bj) { const f32x4 v0 = acc[ai][bj][m][0] + bv[bj][0], v1 = acc[ai][bj][m][1] + bv[bj][1];
                    u32x4 w; w.x = cvt_pk_bf16(v0[0], v0[1]); w.y = cvt_pk_bf16(v0[2], v0[3]); w.z = cvt_pk_bf16(v1[0], v1[1]); w.w = cvt_pk_bf16(v1[2], v1[3]);
                    *(u32x4*)(rowp + bj * HALF) = w; } }
    }
};
struct EpiAct {
    static constexpr bool PERM = true, AFTER_DRAIN = false;
    bf16_t* O; const float* b1;
    __device__ __forceinline__ void pre(LAS unsigned char* lds, int par, const Unit& u, int wid, int lane) const {
        if (wid == 0) __builtin_amdgcn_global_load_lds((const unsigned*)(b1 + (u.pn >> 3) * 2048 + (lane >> 5) * 1024 + (u.pn & 7) * 128 + (lane & 31) * 4), (LAS unsigned*)(lds + EPI_BIAS_OFF + par * 1024), 16, 0, 0);
    }
    __device__ __forceinline__ void operator()(const f32x4 (&acc)[2][2][4][2], const Unit& u, int wr, int wc, int fr, int fq, const LAS unsigned char* lds, int par) const {
        const int pn = u.pn & 7;
        const int row0 = u.pm * BM + wr * 64 + fr, x0 = pn * 128 + wc * 32 + 8 * fq;
        const LAS float* bg = (const LAS float*)(lds + EPI_BIAS_OFF + par * 1024) + wc * 32 + 8 * fq; const LAS float* bl = bg + 128;
        const f32x4 g0 = *(const LAS f32x4*)bg, g1 = *(const LAS f32x4*)(bg + 4), l0 = *(const LAS f32x4*)bl, l1 = *(const LAS f32x4*)(bl + 4);
#pragma unroll
        for (int ai = 0; ai < 2; ++ai)
#pragma unroll
            for (int m = 0; m < 4; ++m) {
                float o[8];
#pragma unroll
                for (int n = 0; n < 2; ++n)
#pragma unroll
                    for (int j = 0; j < 4; ++j) {
                        float glu = acc[ai][0][m][n][j] + (n ? g1[j] : g0[j]);
                        float lin = acc[ai][1][m][n][j] + (n ? l1[j] : l0[j]);
                        glu = fminf(glu, 7.0f); lin = fminf(fmaxf(lin, -7.0f), 7.0f);
                        o[n * 4 + j] = (lin + 1.0f) * glu * __builtin_amdgcn_rcpf(1.0f + __expf(-1.702f * glu));
                    }
                u32x4 w; w.x = cvt_pk_bf16(o[0], o[1]); w.y = cvt_pk_bf16(o[2], o[3]); w.z = cvt_pk_bf16(o[4], o[5]); w.w = cvt_pk_bf16(o[6], o[7]);
                *(u32x4*)(O + ((size_t)(u.pm * 16 + (x0 >> 6)) * 256 + (wr * 64 + fr + ai * HALF + m * 16)) * 64 + (x0 & 63)) = w;
            }
    }
};
}
using pg8::Unit;
__device__ __forceinline__ void my_sincos(double a, float& s, float& c) {
    const double n = rint(a * 0.63661977236758134308);
    const double r = (a - n * 1.57079632679489655800e+00) - n * 6.12323399573676603587e-17;
    const double r2 = r * r;
    const double sp = r * (1.0 + r2 * (-1.0 / 6.0 + r2 * (1.0 / 120.0 + r2 * (-1.0 / 5040.0 + r2 * (1.0 / 362880.0 + r2 * (-1.0 / 39916800.0 + r2 * (1.0 / 6227020800.0 + r2 * (-1.0 / 1307674368000.0))))))));
    const double cp = 1.0 + r2 * (-0.5 + r2 * (1.0 / 24.0 + r2 * (-1.0 / 720.0 + r2 * (1.0 / 40320.0 + r2 * (-1.0 / 3628800.0 + r2 * (1.0 / 479001600.0 + r2 * (-1.0 / 87178291200.0 + r2 * (1.0 / 20922789888000.0))))))));
    const int q = ((int)n) & 3;
    const double sn = q == 0 ? sp : q == 1 ? cp : q == 2 ? -sp : -cp;
    const double cn = q == 0 ? cp : q == 1 ? -sp : q == 2 ? -cp : sp;
    s = (float)sn; c = (float)cn;
}
__device__ __forceinline__ void ph_prologue(const Params& p, LAS unsigned char* lds, int bid, int nblk) {
    const int tid = threadIdx.x;
    unsigned char* ws = p.ws;
    {
        LAS float* sv = (LAS float*)(lds + LDS_WORK);
        LAS float* red = sv + 5 * 1024;
        for (int i = tid; i < 5 * 1024; i += NTHR) { const int r = i >> 10, k = i & 1023; const float c = r < 4 ? p.in[I_C][r * 1024 + k] : p.in[I_CCTX][k]; sv[i] = c / (1.0f + expf(-c)); }
        __syncthreads();
        float* MOD = (float*)(ws + WS_MOD);
        for (int item = bid; item < 256; item += nblk) {
            if (tid < 480) {
                const int cl = tid % 48, kp = tid / 48;
                const int gc = item * 48 + cl, l = gc / 6144, n = gc % 6144;
                const float* w = p.in[I_WMOD] + (size_t)l * 1024 * 6144 + n;
                float a0 = 0.f, a1 = 0.f, a2 = 0.f, a3 = 0.f, a4 = 0.f;
#pragma unroll 1
                for (int k0 = kp; k0 < 1024; k0 += 130) {
                    float wv[13];
#pragma unroll
                    for (int u = 0; u < 13; ++u) { const int k = k0 + 10 * u; wv[u] = k < 1024 ? w[(size_t)k * 6144] : 0.f; }
#pragma unroll
                    for (int u = 0; u < 13; ++u) { const int k = k0 + 10 * u < 1024 ? k0 + 10 * u : 1023; a0 += sv[k] * wv[u]; a1 += sv[1024 + k] * wv[u]; a2 += sv[2048 + k] * wv[u]; a3 += sv[3072 + k] * wv[u]; a4 += sv[4096 + k] * wv[u]; }
                }
                LAS float* rp = red + (kp * 48 + cl) * 5; rp[0] = a0; rp[1] = a1; rp[2] = a2; rp[3] = a3; rp[4] = a4;
            }
            __syncthreads();
            if (tid < 240) {
                const int cl = tid / 5, r = tid % 5; float s = 0.f;
                for (int kp = 0; kp < 10; ++kp) s += red[(kp * 48 + cl) * 5 + r];
                const int gc = item * 48 + cl, l = gc / 6144, n = gc % 6144;
                MOD[(size_t)(l * 5 + r) * 6144 + n] = s + p.in[I_BMOD][l * 6144 + n];
            }
            __syncthreads();
        }
    }
    if (bid == (nblk > 1 ? 1 : 0)) {
        float* ROPE = (float*)(ws + WS_ROPE);
        for (int i = tid; i < 2048; i += NTHR) { const int pos = i >> 5, f = i & 31; const double inv = exp(-(double)f * 0.28782313662425575); float s, c; my_sincos((double)pos * inv, s, c); ROPE[2 * i] = c; ROPE[2 * i + 1] = s; }
    }
    {
        bf16_t* WLT = (bf16_t*)(ws + WS_WLT);
        for (int i = bid * NTHR + tid; i < (int)WLT_N; i += nblk * NTHR) {
            float v;
            if (i < 131072) { const int which = i >> 16, r = i & 65535, d = r >> 15, n = (r >> 6) & 511, k = r & 63; v = (which ? p.in[I_AAB] : p.in[I_AWB])[(size_t)(d * 64 + k) * 512 + n]; }
            else if (i < 196608) { const int r = i - 131072, n = r >> 7, k = r & 127; v = p.in[I_AGB][(size_t)k * 512 + n]; }
            else { const int r = i - 196608, blk = r >> 12, o = (r >> 6) & 63, ii = r & 63; v = p.in[I_BGW][(size_t)blk * 4096 + ii * 64 + o]; }
            WLT[i] = f2bf(v);
        }
    }
    {
        LAS float* tile = (LAS float*)(lds + LDS_WORK);
        for (int t = bid; t < 576; t += nblk) {
            const float* src; int ld, nvalid, k0, n0, w1map = 0; bf16_t* dst; int tt = t;
            if (tt < 192) { k0 = (tt / 12) * 64; n0 = (tt % 12) * 256; src = p.in[I_EWIN]; ld = EVEN_IN; nvalid = EVEN_IN; dst = (bf16_t*)(ws + WS_WIN0T); }
            else if ((tt -= 192) < 256) { k0 = (tt >> 4) * 64; n0 = (tt & 15) * 256; src = p.in[I_OWIN]; ld = ODD_IN; nvalid = 4096; dst = (bf16_t*)(ws + WS_WIN1T); }
            else { tt -= 256; const int mat = tt >> 6, r = tt & 63; k0 = (r >> 2) * 64; n0 = (r & 3) * 256; src = mat ? p.in[I_OWOUT] : p.in[I_EWOUT]; ld = 1024; nvalid = 1024; dst = (bf16_t*)(ws + WS_WOUTT) + (size_t)mat * 1024 * 1024; }
            {
                const int j4 = (tid & 63) * 4, i0 = tid >> 6;
                f32x4 v[8];
#pragma unroll
                for (int r = 0; r < 8; ++r) v[r] = (n0 + j4 < nvalid) ? *(const f32x4*)(src + (size_t)(k0 + i0 + 8 * r) * ld + n0 + j4) : (f32x4){0.f, 0.f, 0.f, 0.f};
#pragma unroll
                for (int r = 0; r < 8; ++r) { LAS float* tp = tile + (i0 + 8 * r) * 257 + j4; tp[0] = v[r][0]; tp[1] = v[r][1]; tp[2] = v[r][2]; tp[3] = v[r][3]; }
            }
            __syncthreads();
            {
                const int ip = (tid & 31) * 2, j0 = tid >> 5;
#pragma unroll
                for (int r = 0; r < 16; ++r) {
                    const int j = j0 + 16 * r, n = n0 + j;
                    const int rho = w1map ? ((((n & 1023) >> 7) << 8) + ((n >> 10) << 7) + (n & 127)) : n;
                    *(unsigned*)(dst + (size_t)rho * 1024 + k0 + ip) = pack_bf16(tile[ip * 257 + j], tile[(ip + 1) * 257 + j]);
                }
            }
            __syncthreads();
        }
    }
}
__device__ __forceinline__ void ph_mod_in(const Params& p, int bid, int nblk) {
    const int tid = threadIdx.x, wid = tid >> 6, lane = tid & 63;
    const float* MOD = (const float*)(p.ws + WS_MOD);
    bf16_t* H = (bf16_t*)(p.ws + WS_H);
    for (int row = bid * 8 + wid; row < MROWS; row += nblk * 8) {
        const float* src = row < NCTX ? p.in[I_CTX] + (size_t)row * 1024 : p.in[I_X] + (size_t)(row - NCTX) * 1024;
        const float* md = MOD + (size_t)row_modr(row) * 6144;
#pragma unroll
        for (int q = 0; q < 4; ++q) {
            const int col = q * 256 + lane * 4;
            const f32x4 x = *(const f32x4*)(src + col), sh = *(const f32x4*)(md + col), sc = *(const f32x4*)(md + 1024 + col);
            const f32x4 h = x * (sc + 1.0f) + sh;
            u32x2 w; w.x = pack_bf16(h[0], h[1]); w.y = pack_bf16(h[2], h[3]);
            *(u32x2*)(H + (size_t)row * 1024 + col) = w;
        }
    }
}
__device__ __forceinline__ int even_tok_row(int w, int idx) { return idx < 64 ? NCTX + (w >> 6) * 4096 + (w & 63) * 64 + idx : w * 4 + (idx - 64); }
__device__ __forceinline__ int shift_nb(int row, int cc) {
    if (row >= NCTX) { const int s = (row - NCTX) & 4095, gr = s >> 6, gc = s & 63, slot = cc & 3;
        if (slot == 0) return gc > 0 ? row - 1 : -1;
        if (slot == 1) return gc < 63 ? row + 1 : -1;
        if (slot == 2) return gr > 0 ? row - 64 : -1;
        return gr < 63 ? row + 64 : -1; }
    const int t = row & 255; return (cc & 1) == 0 ? (t > 0 ? row - 1 : -1) : (t < 255 ? row + 1 : -1);
}
__device__ __forceinline__ float shifted_z(const bf16_t* P, const float* mu, int row, int cc) {
    const float pv = bf2f(P[(size_t)row * LDP0 + cc]); const int nb = shift_nb(row, cc);
    const float sv = nb >= 0 ? bf2f(P[(size_t)nb * LDP0 + cc]) : 0.f;
    return pv + (sv - pv) * mu[cc];
}
__device__ __forceinline__ int scan_q(int row, int d) {
    if (row < NCTX) { const int t = row & 255; return d ? 255 - t : t; }
    const int s = (row - NCTX) & 4095; return 256 + (d ? 4095 - s : s);
}
__device__ __forceinline__ bf16_t* sc_rec(float* SC, int d, int row, int h) { return (bf16_t*)SC + ((size_t)((d * 4 + row_batch(row)) * 8 + h) * SCLEN + scan_q(row, d)) * SCREC; }
constexpr int LDL = 392, LDU = 520;
template <int KS>
__device__ __forceinline__ void load_b(const bf16_t* Bt, bf16x8 (&b)[4][KS], int lane) {
    const int fr = lane & 15, fq = lane >> 4;
#pragma unroll
    for (int nt = 0; nt < 4; ++nt)
#pragma unroll
        for (int ks = 0; ks < KS; ++ks) b[nt][ks] = *(const bf16x8*)(Bt + (size_t)(nt * 16 + fr) * (32 * KS) + ks * 32 + fq * 8);
}
template <int KS>
__device__ __forceinline__ void mma_mt(const LAS bf16_t* A, int lda, int mt, const bf16x8 (&b)[4][KS], f32x4 (&acc)[4], int lane) {
    const int fr = lane & 15, fq = lane >> 4;
#pragma unroll
    for (int nt = 0; nt < 4; ++nt) acc[nt] = (f32x4){0.f, 0.f, 0.f, 0.f};
#pragma unroll
    for (int ks = 0; ks < KS; ++ks) {
        const bf16x8 a = *(const LAS bf16x8*)(A + (mt * 16 + fr) * lda + ks * 32 + fq * 8);
#pragma unroll
        for (int nt = 0; nt < 4; ++nt) acc[nt] = __builtin_amdgcn_mfma_f32_16x16x32_bf16(a, b[nt][ks], acc[nt], 0, 0, 0);
    }
}
__device__ __forceinline__ void ph_prep_even(const Params& p, LAS unsigned char* lds, int bid, int nblk) {
    const int tid = threadIdx.x, wid = tid >> 6, lane = tid & 63, c = tid, fr = lane & 15, fq = lane >> 4;
    const bf16_t* P = (const bf16_t*)(p.ws + WS_P);
    float* SC = (float*)(p.ws + WS_SC);
    float* EA = (float*)(p.ws + WS_EARR);
#define EARR(k) (EA + (size_t)(k) * ((size_t)MROWS * 512))
    float* BC = (float*)(p.ws + WS_BC);
    float* CHA = (float*)(p.ws + WS_CHA); float* CHH = (float*)(p.ws + WS_CHH);
    const bf16_t* WLT = (const bf16_t*)(p.ws + WS_WLT);
    const float* mu = p.in[I_AMU];
    LAS bf16_t* linb = (LAS bf16_t*)(lds + LDS_WORK);
    LAS bf16_t* ub = linb + 80 * LDL;
    LAS float* rnorm = (LAS float*)(ub + 80 * LDU);
    for (int w = bid; w < 256; w += nblk) {
        for (int i = tid; i < 12 * LDL; i += NTHR) linb[68 * LDL + i] = 0;
        for (int i = tid; i < 12 * LDU; i += NTHR) ub[68 * LDU + i] = 0;
#pragma unroll 1
        for (int g = 0; g < 3; ++g) {
            float pv[17], sv[17];
#pragma unroll
            for (int u = 0; u < 17; ++u) { const int e = tid + NTHR * (g * 17 + u), tok = e / 384, j = e - tok * 384, row = even_tok_row(w, tok), nb = shift_nb(row, 1536 + j);
                pv[u] = bf2f(P[(size_t)row * LDP0 + 1536 + j]); sv[u] = nb >= 0 ? bf2f(P[(size_t)nb * LDP0 + 1536 + j]) : 0.f; }
#pragma unroll
            for (int u = 0; u < 17; ++u) { const int e = tid + NTHR * (g * 17 + u), tok = e / 384, j = e - tok * 384;
                const float z = pv[u] + (sv[u] - pv[u]) * mu[1536 + j];
                linb[tok * LDL + j] = f2bf(j < 128 ? ftanh(z) : (j < 256 ? z : sigm(z))); }
        }
        {
            const float kkc = p.in[I_AKK][c], mur = mu[c], muk = mu[512 + c], muv = mu[1024 + c];
#pragma unroll 1
            for (int t0 = 0; t0 < 68; t0 += 8) {
                float pr[8], pk[8], pv[8], sr[8], sk[8], sv[8];
#pragma unroll
                for (int u = 0; u < 8; ++u) { const int tk = t0 + u < 68 ? t0 + u : 67; const int row = even_tok_row(w, tk); const int nb = shift_nb(row, c);
                    const bf16_t* pp = P + (size_t)row * LDP0 + c; pr[u] = bf2f(pp[0]); pk[u] = bf2f(pp[512]); pv[u] = bf2f(pp[1024]);
                    if (nb >= 0) { const bf16_t* pn = P + (size_t)nb * LDP0 + c; sr[u] = bf2f(pn[0]); sk[u] = bf2f(pn[512]); sv[u] = bf2f(pn[1024]); } else { sr[u] = 0.f; sk[u] = 0.f; sv[u] = 0.f; } }
#pragma unroll
                for (int u = 0; u < 8; ++u) if (t0 + u < 68) { const int row = even_tok_row(w, t0 + u);
                    const float zr = pr[u] + (sr[u] - pr[u]) * mur, zk = pk[u] + (sk[u] - pk[u]) * muk, zv = pv[u] + (sv[u] - pv[u]) * muv;
                    const float kkr = zk * kkc, ss = wave_sum(kkr * kkr), rn = frcp(fmaxf(fsqrt(ss), 1e-12f)), kk = kkr * rn;
                    if (lane == 0) rnorm[(t0 + u) * 8 + wid] = rn;
#pragma unroll
                    for (int d = 0; d < 2; ++d) { bf16_t* rec = sc_rec(SC, d, row, wid) + lane; rec[128] = f2bf(kk); rec[320] = f2bf(zr); rec[384] = f2bf(zv); } }
            }
        }
        {
            const float cw0 = p.in[I_BCW][c], cw1 = p.in[I_BCW][512 + c], cw2 = p.in[I_BCW][1024 + c], cw3 = p.in[I_BCW][1536 + c], cb = p.in[I_BCB][c];
#pragma unroll 1
            for (int t0 = 0; t0 < 68; t0 += 8) {
                float x0[8], x1[8], x2[8], x3[8], gx[8];
#pragma unroll
                for (int u = 0; u < 8; ++u) { const int tk = t0 + u < 68 ? t0 + u : 67; const int row = even_tok_row(w, tk);
                    int pos, len;
                    if (row >= NCTX) { pos = (row - NCTX) & 4095; len = 4096; } else { pos = row & 255; len = 256; }
                    x0[u] = pos >= 2 ? bf2f(P[(size_t)(row - 2) * LDP0 + 1920 + c]) : 0.f; x1[u] = pos >= 1 ? bf2f(P[(size_t)(row - 1) * LDP0 + 1920 + c]) : 0.f;
                    x2[u] = bf2f(P[(size_t)row * LDP0 + 1920 + c]); x3[u] = pos + 1 < len ? bf2f(P[(size_t)(row + 1) * LDP0 + 1920 + c]) : 0.f;
                    gx[u] = bf2f(P[(size_t)row * LDP0 + 1920 + 512 + c]); }
#pragma unroll
                for (int u = 0; u < 8; ++u) if (t0 + u < 68) { const int tok = t0 + u, row = even_tok_row(w, tok);
                    const float uu = cb + cw0 * x0[u] + cw1 * x1[u] + cw2 * x2[u] + cw3 * x3[u];
                    ub[tok * LDU + c] = f2bf(uu);
                    const size_t o = (size_t)row * 512 + c;
                    ((bf16_t*)EARR(E_GATE))[o] = f2bf(0.5f * gx[u] * (1.0f + ftanh(0.7978845608028654f * (gx[u] + 0.044715f * gx[u] * gx[u] * gx[u])))); }
            }
        }
        __syncthreads();
#pragma unroll 1
        for (int d = 0; d < 2; ++d) {
            {
                bf16x8 bw[4][2]; load_b<2>(WLT + WLT_WB + (size_t)(d * 512 + wid * 64) * 64, bw, lane);
                float w0v[4];
#pragma unroll
                for (int nt = 0; nt < 4; ++nt) w0v[nt] = p.in[I_AW0][d * 512 + wid * 64 + nt * 16 + fr];
#pragma unroll 1
                for (int mt = 0; mt < 5; ++mt) {
                    f32x4 acc[4]; mma_mt<2>(linb + d * 64, LDL, mt, bw, acc, lane);
#pragma unroll
                    for (int r = 0; r < 4; ++r) { const int tok = mt * 16 + fq * 4 + r;
                        if (tok < 68) { float* rec = (float*)sc_rec(SC, d, even_tok_row(w, tok), wid) + fr;
#pragma unroll
                            for (int nt = 0; nt < 4; ++nt) rec[nt * 16] = -0.60653065971263342f * sigm(w0v[nt] + acc[nt][r]);   } }
                }
            }
            {
                bf16x8 bw[4][2]; load_b<2>(WLT + WLT_AB + (size_t)(d * 512 + wid * 64) * 64, bw, lane);
                float a0v[4], kav[4], mukv[4], kkcv[4];
#pragma unroll
                for (int nt = 0; nt < 4; ++nt) { const int n = wid * 64 + nt * 16 + fr; a0v[nt] = p.in[I_AA0][d * 512 + n]; kav[nt] = p.in[I_AKA][n]; mukv[nt] = mu[512 + n]; kkcv[nt] = p.in[I_AKK][n]; }
#pragma unroll 1
                for (int mt = 0; mt < 5; ++mt) {
                    f32x4 acc[4]; mma_mt<2>(linb + 128 + d * 64, LDL, mt, bw, acc, lane);
                    float pkv[4][4], skv[4][4];
#pragma unroll
                    for (int r = 0; r < 4; ++r) { const int tok = mt * 16 + fq * 4 + r, row = even_tok_row(w, tok < 68 ? tok : 0);
#pragma unroll
                        for (int nt = 0; nt < 4; ++nt) { const int n = wid * 64 + nt * 16 + fr, nb = shift_nb(row, n);
                            pkv[r][nt] = bf2f(P[(size_t)row * LDP0 + 512 + n]); skv[r][nt] = nb >= 0 ? bf2f(P[(size_t)nb * LDP0 + 512 + n]) : 0.f; } }
#pragma unroll
                    for (int r = 0; r < 4; ++r) { const int tok = mt * 16 + fq * 4 + r;
                        if (tok < 68) { bf16_t* rec = sc_rec(SC, d, even_tok_row(w, tok), wid) + fr; const float rn = rnorm[tok * 8 + wid];
#pragma unroll
                            for (int nt = 0; nt < 4; ++nt) { const float a = sigm(a0v[nt] + acc[nt][r]);
                                const float zk = pkv[r][nt] + (skv[r][nt] - pkv[r][nt]) * mukv[nt];
                                rec[192 + nt * 16] = f2bf(zk * (1.0f + (a - 1.0f) * kav[nt])); rec[256 + nt * 16] = f2bf(zk * kkcv[nt] * rn * a); } } }
                }
            }
        }
        {
            bf16x8 bw[4][4]; load_b<4>(WLT + WLT_GB + (size_t)(wid * 64) * 128, bw, lane);
            bf16_t* G = (bf16_t*)EARR(E_G);
#pragma unroll 1
            for (int mt = 0; mt < 5; ++mt) {
                f32x4 acc[4]; mma_mt<4>(linb + 256, LDL, mt, bw, acc, lane);
#pragma unroll
                for (int r = 0; r < 4; ++r) { const int tok = mt * 16 + fq * 4 + r;
                    if (tok < 68) { bf16_t* gp = G + (size_t)even_tok_row(w, tok) * 512 + wid * 64 + fr;
#pragma unroll
                        for (int nt = 0; nt < 4; ++nt) gp[nt * 16] = f2bf(acc[nt][r]); } }
            }
        }
#pragma unroll 1
        for (int d = 0; d < 2; ++d) {
            bf16x8 b0[4][2];
            load_b<2>(WLT + WLT_GW + (size_t)(((d * 2 + 0) * 8 + wid) * 64) * 64, b0, lane);
            float gb0[4], gb1[4], spl[4];
#pragma unroll
            for (int nt = 0; nt < 4; ++nt) { const int n = wid * 64 + nt * 16 + fr; gb0[nt] = p.in[I_BGB][(d * 2 + 0) * 512 + n]; gb1[nt] = p.in[I_BGB][(d * 2 + 1) * 512 + n]; spl[nt] = softplusf(-p.in[I_BLAM][d * 512 + n]); }
            float* Ad = EARR(E_A0 + d); float* BXd = EARR(E_BX0 + d);
#pragma unroll 1
            for (int mt = 0; mt < 5; ++mt) {
                f32x4 la[4], acc[4];
                mma_mt<2>(ub + wid * 64, LDU, mt, b0, la, lane);
                { bf16x8 b1[4][2]; load_b<2>(WLT + WLT_GW + (size_t)(((d * 2 + 1) * 8 + wid) * 64) * 64, b1, lane); mma_mt<2>(ub + wid * 64, LDU, mt, b1, acc, lane); }
#pragma unroll
                for (int r = 0; r < 4; ++r) { const int tok = mt * 16 + fq * 4 + r;
                    if (tok < 68) { const size_t o = (size_t)even_tok_row(w, tok) * 512 + wid * 64 + fr;
#pragma unroll
                        for (int nt = 0; nt < 4; ++nt) { const float lg = -8.0f * sigm(gb0[nt] + la[nt][r]) * spl[nt];
                            const float av = fexp(lg); Ad[o + nt * 16] = av; BXd[o + nt * 16] = fsqrt(fmaxf(1.0f - av * av, 0.f)) * sigm(gb1[nt] + acc[nt][r]) * bf2f(ub[tok * LDU + wid * 64 + nt * 16 + fr]);         } } }
            }
        }
        __syncthreads();
        {
            const float rk = p.in[I_ARK][c];
#pragma unroll 1
            for (int t0 = 0; t0 < 68; t0 += 17) {
                float a[17], b0[17], b1[17];
#pragma unroll
                for (int u = 0; u < 17; ++u) { const int row = even_tok_row(w, t0 + u); const bf16_t* r0 = sc_rec(SC, 0, row, wid) + lane; const bf16_t* r1 = sc_rec(SC, 1, row, wid) + lane;
                    a[u] = bf2f(r0[320]); b0[u] = bf2f(r0[192]); b1[u] = bf2f(r1[192]); }
#pragma unroll
                for (int u = 0; u < 17; ++u) { const float sm = wave_sum(a[u] * (b0[u] + b1[u]) * rk); if (lane == 0) BC[even_tok_row(w, t0 + u) * 8 + wid] = sm; }
            }
        }
#pragma unroll 1
        for (int d = 0; d < 2; ++d) {
            float* Ad = EARR(E_A0 + d); float* BXd = EARR(E_BX0 + d);
            float h = 0.f, cum = 1.f;
#pragma unroll 1
            for (int n0 = 0; n0 < 64; n0 += 16) {
                float av[16], bv[16];
#pragma unroll
                for (int i = 0; i < 16; ++i) { const int tok = d == 0 ? n0 + i : 63 - n0 - i; const size_t o = (size_t)even_tok_row(w, tok) * 512 + c; av[i] = Ad[o]; bv[i] = BXd[o]; }
#pragma unroll
                for (int i = 0; i < 16; ++i) { const int tok = d == 0 ? n0 + i : 63 - n0 - i; const size_t o = (size_t)even_tok_row(w, tok) * 512 + c;
                    h = av[i] * h + bv[i]; cum *= av[i]; Ad[o] = cum; BXd[o] = h; }
            }
            { const int cid = (w >> 6) * 128 + 64 + (w & 63); CHA[(size_t)(d * 512 + cid) * 512 + c] = cum; CHH[(size_t)(d * 512 + cid) * 512 + c] = h; }
            h = 0.f; cum = 1.f;
#pragma unroll
            for (int i = 0; i < 4; ++i) { const int tok = 64 + (d == 0 ? i : 3 - i); const size_t o = (size_t)even_tok_row(w, tok) * 512 + c;
                const float a = Ad[o], bx = BXd[o]; h = a * h + bx; cum *= a; Ad[o] = cum; BXd[o] = h; }
            { const int cid = (w >> 6) * 128 + (w & 63); CHA[(size_t)(d * 512 + cid) * 512 + c] = cum; CHH[(size_t)(d * 512 + cid) * 512 + c] = h; }
        }
        __syncthreads();
    }
}
__device__ __forceinline__ float vfma(float a, float b, float c) { float d; asm("v_fma_f32 %0, %1, %2, %3" : "=v"(d) : "v"(a), "v"(b), "v"(c)); return d; }
__device__ __forceinline__ float vmul(float a, float b) { float d; asm("v_mul_f32 %0, %1, %2" : "=v"(d) : "v"(a), "v"(b)); return d; }
#define WG_BAR() do { asm volatile("" ::: "memory"); __builtin_amdgcn_s_barrier(); asm volatile("" ::: "memory"); } while (0)
__device__ __forceinline__ int scan_row(int d, int b, int q) {
    if (q < 256) return b * 256 + (d ? 255 - q : q);
    const int s = q - 256; return NCTX + b * 4096 + (d ? 4095 - s : s);
}
__device__ __forceinline__ void ph_fin_even(const Params& p, int bid, int nblk) {
    const int tid = threadIdx.x, wid = tid >> 6, c = tid;
    float* EA = (float*)(p.ws + WS_EARR);
    float* SC = (float*)(p.ws + WS_SC);
    const float* BC = (const float*)(p.ws + WS_BC); const float* CIN = (const float*)(p.ws + WS_CIN);
    bf16_t* Y = (bf16_t*)(p.ws + WS_YMIX);
    const float gg = p.in[I_AGNG][c], gb = p.in[I_AGNB][c];
    for (int r0 = bid * 4; r0 < MROWS; r0 += nblk * 4) {
        float o0[4], o1[4], vv[4], gv[4], bc[4], x0[4], x1[4], a0[4], a1[4], c0[4], c1[4], gt[4];
#pragma unroll
        for (int u = 0; u < 4; ++u) { const int row = r0 + u; const size_t o = (size_t)row * 512 + c;
            const int cid = row < NCTX ? (row >> 8) * 128 + ((row >> 2) & 63) : ((row - NCTX) >> 12) * 128 + 64 + (((row - NCTX) & 4095) >> 6);
            o0[u] = bf2f(((const bf16_t*)EARR(E_O0))[o]); o1[u] = bf2f(((const bf16_t*)EARR(E_O1))[o]); vv[u] = bf2f(sc_rec(SC, 0, row, wid)[384 + (tid & 63)]); gv[u] = bf2f(((const bf16_t*)EARR(E_G))[o]); bc[u] = BC[row * 8 + wid];
            x0[u] = EARR(E_BX0)[o]; x1[u] = EARR(E_BX1)[o]; a0[u] = EARR(E_A0)[o]; a1[u] = EARR(E_A1)[o];
            c0[u] = CIN[(size_t)cid * 512 + c]; c1[u] = CIN[(size_t)(512 + cid) * 512 + c]; gt[u] = bf2f(((const bf16_t*)EARR(E_GATE))[o]); }
#pragma unroll
        for (int u = 0; u < 4; ++u) { const int row = r0 + u;
            const float wkv = o0[u] + o1[u];
            const float mean = wave_sum(wkv) * (1.0f / 64.0f), dv = wkv - mean, var = wave_sum(dv * dv) * (1.0f / 64.0f);
            const float y = (dv * rsqrtf(var + 64e-5f) * gg + gb + bc[u] * vv[u]) * gv[u];
            Y[(size_t)row * 1024 + c] = f2bf(y);
            Y[(size_t)row * 1024 + 512 + c] = f2bf(((x0[u] + a0[u] * c0[u]) + (x1[u] + a1[u] * c1[u])) * gt[u]); }
    }
#undef EARR
}
constexpr int LDT = 72;
__device__ __forceinline__ float quad_sum(float v) {
    v += __int_as_float(__builtin_amdgcn_update_dpp(0, __float_as_int(v), 0xB1, 0xf, 0xf, false));
    v += __int_as_float(__builtin_amdgcn_update_dpp(0, __float_as_int(v), 0x4E, 0xf, 0xf, false));
    return v;
}
template <int PO> __device__ __forceinline__ float quad_bcast(float v) { return __int_as_float(__builtin_amdgcn_update_dpp(0, __float_as_int(v), PO * 0x55, 0xf, 0xf, false)); }
__device__ __forceinline__ bf16x8 ldt8(const LAS bf16_t* T, int row, int col) { return *(const LAS bf16x8*)(T + row * LDT + col); }
__device__ __forceinline__ void ph_r1(const Params& p, LAS unsigned char* lds, int bid, int nblk) {
    const int tid = threadIdx.x, wid = tid >> 6, lane = tid & 63, fr = lane & 15, fq = lane >> 4;
    LAS bf16_t* T0 = (LAS bf16_t*)(lds + LDS_WORK);
#define TL(i) (T0 + (i) * 64 * LDT)
    LAS float* F0 = (LAS float*)(T0 + 11 * 64 * LDT);
    LAS float* F1 = F0 + 4096;
    LAS float* F2 = F1 + 4096;
    LAS float* segt = F2 + 4096;
    LAS float* gl = segt + 512;
    const float* SC = (const float*)(p.ws + WS_SC);
    float* RU = (float*)(p.ws + WS_RU);
    const int k = tid & 63, seg = tid >> 6, t0 = seg * 8;
    const int tr = (wid >> 1) * 16, tc0 = (wid & 1) * 32;
    float kk[8], lw[8], kd[8], ka[8], rr[8], vv[8];
    auto fetch = [&](int unit) {
        const int chain = unit / NRCH, c = unit - chain * NRCH;
        const bf16_t* rec = (const bf16_t*)SC + ((size_t)chain * SCLEN + c * RCH + t0) * SCREC + k;
#pragma unroll
        for (int u = 0; u < 8; ++u) { const bf16_t* r = rec + u * SCREC; lw[u] = ((const float*)(r - k))[k]; kk[u] = bf2f(r[128]); kd[u] = bf2f(r[192]); ka[u] = bf2f(r[256]); rr[u] = bf2f(r[320]); vv[u] = bf2f(r[384]); }
    };
    if (bid < NRUNIT) fetch(bid);
    for (int unit = bid; unit < NRUNIT; unit += nblk) {
        float cum[8]; { float run = 0.f;
#pragma unroll
            for (int u = 0; u < 8; ++u) { run += lw[u]; cum[u] = run; }
            segt[seg * 64 + k] = run; }
        __syncthreads();
        float off = 0.f, tot = 0.f;
#pragma unroll
        for (int s2 = 0; s2 < 8; ++s2) { const float v = segt[s2 * 64 + k]; off += s2 < seg ? v : 0.f; tot += v; }
        if (seg == 0) gl[k] = fexp(tot);
        {
            u32x4 wk, wb, wv; unsigned pk[4], pb[4], pv[4]; float hk = 0.f, hb = 0.f, hv = 0.f;
#pragma unroll
            for (int u = 0; u < 8; ++u) { const int t = t0 + u; const float cu = cum[u] + off;
                const float ginc = fexp(cu), gexc = fexp(cu - lw[u]), ginv = fexp(-cu), gtail = fexp(tot - cu);
                const float kt = kk[u] * gexc;
                TL(0)[t * LDT + k] = f2bf(kt); F0[t * 64 + k] = kt;
                TL(1)[t * LDT + k] = f2bf(kd[u] * ginv); TL(2)[t * LDT + k] = f2bf(ka[u] * ginv); TL(3)[t * LDT + k] = f2bf(rr[u] * ginc);
                const float ktl = kd[u] * gtail, btl = ka[u] * gtail;
                if (u & 1) { pk[u >> 1] = pack_bf16(hk, ktl); pb[u >> 1] = pack_bf16(hb, btl); pv[u >> 1] = pack_bf16(hv, vv[u]); } else { hk = ktl; hb = btl; hv = vv[u]; } }
            wk.x = pk[0]; wk.y = pk[1]; wk.z = pk[2]; wk.w = pk[3]; wb.x = pb[0]; wb.y = pb[1]; wb.z = pb[2]; wb.w = pb[3]; wv.x = pv[0]; wv.y = pv[1]; wv.z = pv[2]; wv.w = pv[3];
            *(LAS u32x4*)(TL(4) + k * LDT + t0) = wk; *(LAS u32x4*)(TL(5) + k * LDT + t0) = wb; *(LAS u32x4*)(TL(6) + k * LDT + t0) = wv;
        }
        if (unit + nblk < NRUNIT) fetch(unit + nblk);
        __syncthreads();
        {
            f32x4 mk[2], mb[2], ak[2], ab[2];
#pragma unroll
            for (int nt = 0; nt < 2; ++nt) { mk[nt] = (f32x4){0.f, 0.f, 0.f, 0.f}; mb[nt] = mk[nt]; ak[nt] = mk[nt]; ab[nt] = mk[nt]; }
#pragma unroll
            for (int ks = 0; ks < 2; ++ks) { const bf16x8 aK = ldt8(TL(0), tr + fr, ks * 32 + fq * 8), aR = ldt8(TL(3), tr + fr, ks * 32 + fq * 8);
#pragma unroll
                for (int nt = 0; nt < 2; ++nt) { const bf16x8 bK = ldt8(TL(1), tc0 + nt * 16 + fr, ks * 32 + fq * 8), bB = ldt8(TL(2), tc0 + nt * 16 + fr, ks * 32 + fq * 8);
                    mk[nt] = __builtin_amdgcn_mfma_f32_16x16x32_bf16(aK, bK, mk[nt], 0, 0, 0); mb[nt] = __builtin_amdgcn_mfma_f32_16x16x32_bf16(aK, bB, mb[nt], 0, 0, 0);
                    ak[nt] = __builtin_amdgcn_mfma_f32_16x16x32_bf16(aR, bK, ak[nt], 0, 0, 0); ab[nt] = __builtin_amdgcn_mfma_f32_16x16x32_bf16(aR, bB, ab[nt], 0, 0, 0); } }
#pragma unroll
            for (int nt = 0; nt < 2; ++nt)
#pragma unroll
                for (int r = 0; r < 4; ++r) { const int t = tr + fq * 4 + r, j = tc0 + nt * 16 + fr;
                    TL(7)[t * LDT + j] = f2bf(j < t ? mk[nt][r] : 0.f); F1[j * 64 + (t & 3) * 16 + (t >> 2)] = j < t ? mb[nt][r] : 0.f;
                    TL(8)[t * LDT + j] = f2bf(j <= t ? ak[nt][r] : 0.f); TL(9)[t * LDT + j] = f2bf(j <= t ? ab[nt][r] : 0.f); }
        }
        __syncthreads();
        {
            f32x4 acc[2] = {(f32x4){0.f, 0.f, 0.f, 0.f}, (f32x4){0.f, 0.f, 0.f, 0.f}};
#pragma unroll
            for (int ks = 0; ks < 2; ++ks) { const bf16x8 a = ldt8(TL(7), tr + fr, ks * 32 + fq * 8);
#pragma unroll
                for (int nt = 0; nt < 2; ++nt) acc[nt] = __builtin_amdgcn_mfma_f32_16x16x32_bf16(a, ldt8(TL(6), tc0 + nt * 16 + fr, ks * 32 + fq * 8), acc[nt], 0, 0, 0); }
#pragma unroll
            for (int nt = 0; nt < 2; ++nt)
#pragma unroll
                for (int r = 0; r < 4; ++r) F2[(tr + fq * 4 + r) * 64 + tc0 + nt * 16 + fr] = acc[nt][r];
        }
        __syncthreads();
        {
            const int col = tid >> 2, part = tid & 3;
            f32x2 acc2[8]; float x[16];
#pragma unroll
            for (int q = 0; q < 16; ++q) { const int t = 4 * q + part; acc2[q >> 1][q & 1] = col < 64 ? F0[t * 64 + col] : F2[t * 64 + col - 64]; x[q] = 0.f; }
#pragma unroll
            for (int t = 0; t < 64; ++t) {
                const int qo = t >> 2, po = t & 3; const float aq = acc2[qo >> 1][qo & 1];
                const float xt = po == 0 ? quad_bcast<0>(aq) : po == 1 ? quad_bcast<1>(aq) : po == 2 ? quad_bcast<2>(aq) : quad_bcast<3>(aq);
                x[qo] = part == po ? xt : x[qo];
                const f32x2 nx = {-xt, -xt};
#pragma unroll
                for (int q4 = qo >> 2; q4 < 4; ++q4) { const f32x4 m = *(const LAS f32x4*)(F1 + t * 64 + part * 16 + q4 * 4);
                    acc2[q4 * 2] = (f32x2){m[0], m[1]} * nx + acc2[q4 * 2]; acc2[q4 * 2 + 1] = (f32x2){m[2], m[3]} * nx + acc2[q4 * 2 + 1]; }
            }
            LAS bf16_t* dstT = col < 64 ? TL(7) + col * LDT : TL(10) + (col - 64) * LDT;
#pragma unroll
            for (int q = 0; q < 16; ++q) dstT[4 * q + part] = f2bf(-x[q]);
        }
        __syncthreads();
        {
            f32x4 rh[2], ol[2], pm[2], qq[2];
#pragma unroll
            for (int nt = 0; nt < 2; ++nt) { rh[nt] = (f32x4){0.f, 0.f, 0.f, 0.f}; ol[nt] = rh[nt]; pm[nt] = rh[nt]; qq[nt] = rh[nt]; }
#pragma unroll
            for (int ks = 0; ks < 2; ++ks) { const int kc = ks * 32 + fq * 8;
                const bf16x8 a7 = ldt8(TL(7), tr + fr, kc), a8 = ldt8(TL(8), tr + fr, kc), a9 = ldt8(TL(9), tr + fr, kc), a6 = ldt8(TL(6), tr + fr, kc), a10 = ldt8(TL(10), tr + fr, kc);
#pragma unroll
                for (int nt = 0; nt < 2; ++nt) { const int br = tc0 + nt * 16 + fr;
                    const bf16x8 b9 = ldt8(TL(9), br, kc), b6 = ldt8(TL(6), br, kc), b10 = ldt8(TL(10), br, kc), b5 = ldt8(TL(5), br, kc), b4 = ldt8(TL(4), br, kc);
                    rh[nt] = __builtin_amdgcn_mfma_f32_16x16x32_bf16(a7, b9, rh[nt], 0, 0, 0);
                    ol[nt] = __builtin_amdgcn_mfma_f32_16x16x32_bf16(a8, b6, ol[nt], 0, 0, 0); ol[nt] = __builtin_amdgcn_mfma_f32_16x16x32_bf16(a9, b10, ol[nt], 0, 0, 0);
                    pm[nt] = __builtin_amdgcn_mfma_f32_16x16x32_bf16(a7, b5, pm[nt], 0, 0, 0);
                    qq[nt] = __builtin_amdgcn_mfma_f32_16x16x32_bf16(a6, b4, qq[nt], 0, 0, 0); qq[nt] = __builtin_amdgcn_mfma_f32_16x16x32_bf16(a10, b5, qq[nt], 0, 0, 0); } }
            float* U = RU + (size_t)unit * 4 * 4096;
#pragma unroll
            for (int nt = 0; nt < 2; ++nt)
#pragma unroll
                for (int r = 0; r < 4; ++r) { const int row = tr + fq * 4 + r, cx = tc0 + nt * 16 + fr; const int o = row * 64 + cx;
                    U[o] = pm[nt][r] + (row == cx ? gl[row] : 0.f);
                    U[4096 + o] = qq[nt][r];
                    U[8192 + o] = rh[nt][r] + bf2f(TL(3)[cx * LDT + row]);
                    U[12288 + o] = ol[nt][r]; }
        }
        __syncthreads();
    }
#undef TL
}
__device__ __forceinline__ void moe_weight_tiles(const Params& p, LAS unsigned char* lds, int first, int stride) {
    const int tid = threadIdx.x; unsigned char* ws = p.ws;
    LAS float* tile = (LAS float*)(lds + LDS_WORK);
    const int j4 = (tid & 31) * 4, i0 = tid >> 5;
    auto decode = [&](int tt, const float*& src, int& ld, int& k0, int& n0, int& w1map, bf16_t*& dst) {
        if (tt < 8192) { const int mat = tt >> 7, r = tt & 127; k0 = (r >> 4) * 128; n0 = (r & 15) * 128; src = p.in[I_W1] + (size_t)mat * 1024 * 2048; ld = 2048; dst = (bf16_t*)(ws + WS_W1T) + (size_t)mat * 2048 * 1024; w1map = 1; }
        else { tt -= 8192; const int mat = tt >> 6, r = tt & 63; k0 = (r >> 3) * 128; n0 = (r & 7) * 128; src = p.in[I_W2] + (size_t)mat * 1024 * 1024; ld = 1024; dst = (bf16_t*)(ws + WS_W2T) + (size_t)mat * 1024 * 1024; w1map = 0; }
    };
    f32x4 v[8];
    if (first < 12288) { const float* src; int ld, k0, n0, w1; bf16_t* dst; decode(first, src, ld, k0, n0, w1, dst);
#pragma unroll
        for (int r = 0; r < 8; ++r) v[r] = __builtin_nontemporal_load((const f32x4*)(src + (size_t)(k0 + i0 + 16 * r) * ld + n0 + j4)); }
    for (int t = first; t < 12288; t += stride) {
        const float* src; int ld, k0, n0, w1map; bf16_t* dst; decode(t, src, ld, k0, n0, w1map, dst);
#pragma unroll
        for (int r = 0; r < 8; ++r) { LAS float* tp = tile + (i0 + 16 * r) * 129 + j4; tp[0] = v[r][0]; tp[1] = v[r][1]; tp[2] = v[r][2]; tp[3] = v[r][3]; }
        __syncthreads();
        if (t + stride < 12288) { const float* s2; int ld2, k2, n2, w2; bf16_t* d2; decode(t + stride, s2, ld2, k2, n2, w2, d2);
#pragma unroll
            for (int r = 0; r < 8; ++r) v[r] = __builtin_nontemporal_load((const f32x4*)(s2 + (size_t)(k2 + i0 + 16 * r) * ld2 + n2 + j4)); }
        { const int ip = (tid & 15) * 8, j0 = tid >> 4;
            const int rho0 = w1map ? ((((n0 & 1023) >> 7) << 8) + ((n0 >> 10) << 7)) : n0;
#pragma unroll
            for (int r = 0; r < 4; ++r) { const int j = j0 + 32 * r;
                u32x4 w; w.x = pack_bf16(tile[ip * 129 + j], tile[(ip + 1) * 129 + j]); w.y = pack_bf16(tile[(ip + 2) * 129 + j], tile[(ip + 3) * 129 + j]);
                w.z = pack_bf16(tile[(ip + 4) * 129 + j], tile[(ip + 5) * 129 + j]); w.w = pack_bf16(tile[(ip + 6) * 129 + j], tile[(ip + 7) * 129 + j]);
                const int rho = rho0 + j, kk8 = k0 + ip; *(u32x4*)(dst + ((size_t)((rho >> 8) * 16 + (kk8 >> 6)) * 256 + (rho & 255)) * 64 + (kk8 & 63)) = w; } }
        __syncthreads();
    }
}
__device__ __forceinline__ void ph_r2(const Params& p, LAS unsigned char* lds, int bid, int nblk) {
    const int tid = threadIdx.x, wid = tid >> 6, lane = tid & 63, fr = lane & 15, g = lane >> 4;
    const int nchainwg = nblk >= 128 ? 64 : 0;
    if (bid >= nchainwg) {
        const int nconv = nblk - nchainwg, cb = bid - nchainwg;
        if (tid < 256) {
            const float* CHA = (const float*)(p.ws + WS_CHA); const float* CHH = (const float*)(p.ws + WS_CHH); float* CIN = (float*)(p.ws + WS_CIN);
            for (int item = cb; item < 16; item += nconv) {
                const int gi = item * 256 + tid, d = gi >> 11, b = (gi >> 9) & 3, c = gi & 511;
                float carry = 0.f;
                for (int s0 = 0; s0 < 128; s0 += 16) {
                    float av[16], hv[16];
#pragma unroll
                    for (int q = 0; q < 16; ++q) { const int st = s0 + q; const int cl = d == 0 ? st : (st < 64 ? 63 - st : 191 - st);
                        const size_t o = (size_t)(d * 512 + b * 128 + cl) * 512 + c; av[q] = CHA[o]; hv[q] = CHH[o]; }
#pragma unroll
                    for (int q = 0; q < 16; ++q) { const int st = s0 + q; const int cl = d == 0 ? st : (st < 64 ? 63 - st : 191 - st);
                        CIN[(size_t)(d * 512 + b * 128 + cl) * 512 + c] = carry; carry = av[q] * carry + hv[q]; }
                }
            }
        }
        __syncthreads();
        moe_weight_tiles(p, lds, cb, nconv);
        if (nchainwg) return;
    }
    LAS float* ring = (LAS float*)(lds + LDS_WORK);
    const float* RU = (const float*)(p.ws + WS_RU);
    float* EA = (float*)(p.ws + WS_EARR);
    for (int chain = nchainwg ? bid : bid; chain < 64; chain += (nchainwg ? 64 : nblk)) {
        const int d = chain >> 5, b = (chain >> 3) & 3, h = chain & 7;
        bf16_t* Od = (bf16_t*)(EA + (size_t)(E_O0 + d) * ((size_t)MROWS * 512));
        auto issue = [&](int c) {
            const float* src = RU + ((size_t)chain * NRCH + c) * 4 * 4096; LAS float* dst = ring + (c & 1) * 4 * 4096;
#pragma unroll
            for (int i = 0; i < 16; ++i) { const int slot = ((wid - 4) * 16 + i) * 64;
                __builtin_amdgcn_global_load_lds((const unsigned*)(src + (size_t)(slot + lane) * 4), (LAS unsigned*)(dst + slot * 4), 16, 0, 0); }
        };
        if (tid >= 256) { issue(0); asm volatile("s_waitcnt vmcnt(0)" ::: "memory"); }
        asm volatile("" ::: "memory"); __builtin_amdgcn_s_barrier(); asm volatile("" ::: "memory");
        f32x4 S[4];
#pragma unroll
        for (int m = 0; m < 4; ++m) S[m] = (f32x4){0.f, 0.f, 0.f, 0.f};
        const int v0 = wid * 16;
        for (int c = 0; c < NRCH; ++c) {
            if (tid >= 256) { if (c + 1 < NRCH) issue(c + 1); asm volatile("s_waitcnt vmcnt(0)" ::: "memory"); }
            else {
                const LAS float* PM = ring + (c & 1) * 4 * 4096; const LAS float* QQ = PM + 4096; const LAS float* RHT = PM + 8192; const LAS float* OL = PM + 12288;
                f32x4 acc[4], Sn[4];
#pragma unroll
                for (int tt = 0; tt < 4; ++tt) {
#pragma unroll
                    for (int i = 0; i < 4; ++i) acc[tt][i] = OL[(16 * tt + 4 * g + i) * 64 + v0 + fr];
                    Sn[tt] = *(const LAS f32x4*)(QQ + (v0 + fr) * 64 + 16 * tt + 4 * g); }
                float A[3][4];
#pragma unroll
                for (int s0 = 0; s0 < 2; ++s0) { const LAS float* ar = RHT + (16 * (s0 >> 2) + 4 * g + (s0 & 3)) * 64 + fr;
#pragma unroll
                    for (int u = 0; u < 4; ++u) A[s0][u] = ar[16 * u]; }
#pragma unroll
                for (int st = 0; st < 32; ++st) {
                    if (st + 2 < 32) { const int s2 = st + 2, mi = s2 & 15; const LAS float* ar = (s2 < 16 ? RHT : PM) + (16 * (mi >> 2) + 4 * g + (mi & 3)) * 64 + fr;
#pragma unroll
                        for (int u = 0; u < 4; ++u) A[s2 % 3][u] = ar[16 * u]; }
                    __builtin_amdgcn_sched_barrier(0);
                    const int mi = st & 15; const float bq = S[mi >> 2][mi & 3];
                    if (st < 16) {
#pragma unroll
                        for (int u = 0; u < 4; ++u) acc[u] = __builtin_amdgcn_mfma_f32_16x16x4f32(A[st % 3][u], bq, acc[u], 0, 0, 0);
                    } else {
#pragma unroll
                        for (int u = 0; u < 4; ++u) Sn[u] = __builtin_amdgcn_mfma_f32_16x16x4f32(A[st % 3][u], bq, Sn[u], 0, 0, 0);
                    }
                }
#pragma unroll
                for (int tt = 0; tt < 4; ++tt)
#pragma unroll
                    for (int i = 0; i < 4; ++i) { const int row = scan_row(d, b, c * RCH + 16 * tt + 4 * g + i); Od[(size_t)row * 512 + h * 64 + v0 + fr] = f2bf(acc[tt][i]); }
#pragma unroll
                for (int m = 0; m < 4; ++m) S[m] = Sn[m];
                asm volatile("s_waitcnt lgkmcnt(0)" ::: "memory");
            }
            asm volatile("" ::: "memory"); __builtin_amdgcn_s_barrier(); asm volatile("" ::: "memory");
        }
    }
}
__device__ __forceinline__ float half_max(float v, int lane) {
    const int ninf = 0xff800000;
    v = fmaxf(v, __int_as_float(__builtin_amdgcn_update_dpp(ninf, __float_as_int(v), 0x121, 0xf, 0xf, false)));
    v = fmaxf(v, __int_as_float(__builtin_amdgcn_update_dpp(ninf, __float_as_int(v), 0x122, 0xf, 0xf, false)));
    v = fmaxf(v, __int_as_float(__builtin_amdgcn_update_dpp(ninf, __float_as_int(v), 0x124, 0xf, 0xf, false)));
    v = fmaxf(v, __int_as_float(__builtin_amdgcn_update_dpp(ninf, __float_as_int(v), 0x128, 0xf, 0xf, false)));
    v = fmaxf(v, __int_as_float(__builtin_amdgcn_update_dpp(ninf, __float_as_int(v), 0x142, 0xa, 0xf, false)));
    const float lo = __int_as_float(__builtin_amdgcn_readlane(__float_as_int(v), 31)), hi = __int_as_float(__builtin_amdgcn_readlane(__float_as_int(v), 63));
    return (lane & 32) ? hi : lo;
}
__device__ __forceinline__ int half_min_i(int v, int lane) {
    const int big = 0x7fffffff;
    v = min(v, __builtin_amdgcn_update_dpp(big, v, 0x121, 0xf, 0xf, false));
    v = min(v, __builtin_amdgcn_update_dpp(big, v, 0x122, 0xf, 0xf, false));
    v = min(v, __builtin_amdgcn_update_dpp(big, v, 0x124, 0xf, 0xf, false));
    v = min(v, __builtin_amdgcn_update_dpp(big, v, 0x128, 0xf, 0xf, false));
    v = min(v, __builtin_amdgcn_update_dpp(big, v, 0x142, 0xa, 0xf, false));
    const int lo = __builtin_amdgcn_readlane(v, 31), hi = __builtin_amdgcn_readlane(v, 63);
    return (lane & 32) ? hi : lo;
}
template <int LAYER>
__device__ __forceinline__ void ph_ln1(const Params& p, LAS unsigned char* lds, int bid, int nblk) {
    const int tid = threadIdx.x, wid = tid >> 6, lane = tid & 63, fr = lane & 15, fq = lane >> 4;
    LAS float* vb = (LAS float*)(lds + LDS_WORK);
    LAS float* part = vb + 16 * 1028;
    LAS int* lcnt = (LAS int*)(part + 8 * 16 * 32);
    float rwf[2][32];
    { const float* rw = p.in[I_RW] + (size_t)LAYER * 32768 + (size_t)(128 * wid + 32 * fq) * 32 + fr;
#pragma unroll
        for (int s2 = 0; s2 < 32; ++s2) { rwf[0][s2] = rw[s2 * 32]; rwf[1][s2] = rw[s2 * 32 + 16]; } }
    if (tid < 32) lcnt[tid] = 0;
    __syncthreads();
    const float* MOD = (const float*)(p.ws + WS_MOD);
    bf16_t* XS = (bf16_t*)(p.ws + WS_XS); const bf16_t* YP = (const bf16_t*)(p.ws + WS_YP); bf16_t* H = (bf16_t*)(p.ws + WS_H);
    int* TOPE = (int*)(p.ws + WS_TOPE); float* TOPW = (float*)(p.ws + WS_TOPW); int* TOPS = (int*)(p.ws + WS_TOPS);
    int* CNTB = (int*)(p.ws + WS_CNTB) + (size_t)(LAYER * 512 + bid) * 32;
    const float* lng = p.in[I_LNG] + (LAYER * 2 + 0) * 1024; const float* lnb = p.in[I_LNB] + (LAYER * 2 + 0) * 1024;
    const int rstride = nblk * 8, rbase = (LAYER == 0 ? 0 : NCTX) + bid * 8;
    f32x4 nres[4], ngate[4]; u32x2 nyp[4];
    auto fetch = [&](int row) {
        const float* res = row < NCTX ? p.in[I_CTX] + (size_t)row * 1024 : p.in[I_X] + (size_t)(row - NCTX) * 1024;
        const float* md = MOD + (size_t)(LAYER * 5 + row_modr(row)) * 6144;
#pragma unroll
        for (int q = 0; q < 4; ++q) { const int col = q * 256 + lane * 4; nres[q] = LAYER == 0 ? *(const f32x4*)(res + col) : ld_bf16x4(XS + (size_t)row * 1024 + col);
            ngate[q] = *(const f32x4*)(md + 2048 + col); nyp[q] = *(const u32x2*)(YP + (size_t)row * 1024 + col); }
    };
    if (rbase < MROWS) fetch(rbase + wid);
#pragma unroll 1
    for (int j0 = 0; rbase + j0 * rstride < MROWS; j0 += 2) {
#pragma unroll 1
        for (int jj = 0; jj < 2; ++jj) {
            const int row = rbase + wid + (j0 + jj) * rstride;
            if (row >= MROWS) break;
            const float* md = MOD + (size_t)(LAYER * 5 + row_modr(row)) * 6144;
            f32x4 v[4], msc[4], msh[4]; float s = 0.f;
#pragma unroll
            for (int q = 0; q < 4; ++q) { const u32x2 w = nyp[q];
                const f32x4 y = (f32x4){__uint_as_float(w.x << 16), __uint_as_float(w.x & 0xffff0000u), __uint_as_float(w.y << 16), __uint_as_float(w.y & 0xffff0000u)};
                v[q] = nres[q] * DN_ALPHA + ngate[q] * y;
                s += (v[q][0] + v[q][1]) + (v[q][2] + v[q][3]); }
#pragma unroll
            for (int q = 0; q < 4; ++q) { const int col = q * 256 + lane * 4; msc[q] = *(const f32x4*)(md + 4096 + col); msh[q] = *(const f32x4*)(md + 3072 + col); }
            if (row + rstride < MROWS) fetch(row + rstride);
            const float mean = wave_sum(s) * (1.0f / 1024.0f);
            float ss = 0.f;
#pragma unroll
            for (int q = 0; q < 4; ++q) { v[q] = v[q] - mean; ss += (v[q][0] * v[q][0] + v[q][1] * v[q][1]) + (v[q][2] * v[q][2] + v[q][3] * v[q][3]); }
            const float rstd = rsqrtf(wave_sum(ss) * (1.0f / 1024.0f) + LN_EPS);
#pragma unroll
            for (int q = 0; q < 4; ++q) { const int col = q * 256 + lane * 4;
                const f32x4 xn = v[q] * rstd * *(const f32x4*)(lng + col) + *(const f32x4*)(lnb + col);
                { u32x2 wx; wx.x = pack_bf16(xn[0], xn[1]); wx.y = pack_bf16(xn[2], xn[3]); *(u32x2*)(XS + (size_t)row * 1024 + col) = wx; }
                v[q] = xn * (msc[q] + 1.0f) + msh[q];
                u32x2 w; w.x = pack_bf16(v[q][0], v[q][1]); w.y = pack_bf16(v[q][2], v[q][3]);
                *(u32x2*)(H + (size_t)row * 1024 + col) = w;
                *(LAS f32x4*)(vb + (wid + 8 * jj) * 1028 + col) = v[q]; }
        }
        __syncthreads();
        {
            const LAS float* ar = vb + fr * 1028 + 128 * wid + 32 * fq;
            f32x4 acc0 = {0.f, 0.f, 0.f, 0.f}, acc1 = {0.f, 0.f, 0.f, 0.f};
#pragma unroll
            for (int h = 0; h < 2; ++h) { f32x4 va[4];
#pragma unroll
                for (int u = 0; u < 4; ++u) va[u] = *(const LAS f32x4*)(ar + h * 16 + u * 4);
#pragma unroll
                for (int u = 0; u < 4; ++u)
#pragma unroll
                    for (int i = 0; i < 4; ++i) { acc0 = __builtin_amdgcn_mfma_f32_16x16x4f32(va[u][i], rwf[0][h * 16 + u * 4 + i], acc0, 0, 0, 0);
                        acc1 = __builtin_amdgcn_mfma_f32_16x16x4f32(va[u][i], rwf[1][h * 16 + u * 4 + i], acc1, 0, 0, 0); } }
            LAS float* pw = part + wid * 512 + (4 * fq) * 32 + fr;
#pragma unroll
            for (int i = 0; i < 4; ++i) { pw[i * 32] = acc0[i]; pw[i * 32 + 16] = acc1[i]; }
        }
        __syncthreads();
        {
            const int e = lane & 31, lr = 2 * wid + (lane >> 5), row = rbase + (lr & 7) + (j0 + (lr >> 3)) * rstride;
            float lg = p.in[I_RB][LAYER * 32 + e];
#pragma unroll
            for (int w2 = 0; w2 < 8; ++w2) lg += part[w2 * 512 + lr * 32 + e];
            float tv[4]; int te[4];
#pragma unroll
            for (int k = 0; k < 4; ++k) { const float bv = half_max(lg, lane); const int bi = half_min_i(lg == bv ? e : 99, lane);
                tv[k] = bv; te[k] = bi & 31; lg = e == bi ? -3.0e38f : lg; }
            const float e1 = expf(tv[1] - tv[0]), e2 = expf(tv[2] - tv[0]), e3 = expf(tv[3] - tv[0]), inv = 1.0f / (1.0f + e1 + e2 + e3);
            if (e == 0 && row < MROWS) {
                const float wv[4] = {inv, e1 * inv, e2 * inv, e3 * inv};
#pragma unroll
                for (int k = 0; k < 4; ++k) { const int slot = __hip_atomic_fetch_add(lcnt + te[k], 1, __ATOMIC_RELAXED, __HIP_MEMORY_SCOPE_WORKGROUP); TOPE[row * 4 + k] = te[k]; TOPW[row * 4 + k] = wv[k]; TOPS[row * 4 + k] = slot; }
            }
        }
    }
    __syncthreads();
    if (tid < 32) CNTB[tid] = lcnt[tid];
}
constexpr int LDS_TAB = LDS_WORK + 131072;
__device__ __forceinline__ int moe_tables(const int* cntb, int nblk, LAS int* tab, LAS int* bb) {
    const int tid = threadIdx.x, e = tid & 31, seg = tid >> 5, per = (nblk + 15) >> 4;
    const int b0 = seg * per, b1 = (b0 + per) < nblk ? (b0 + per) : nblk;
    int s = 0;
    if (per <= 16) {
        int cv[16];
#pragma unroll
        for (int u = 0; u < 16; ++u) cv[u] = (b0 + u) < b1 ? cntb[(b0 + u) * 32 + e] : 0;
#pragma unroll
        for (int u = 0; u < 16; ++u) s += cv[u];
        tab[512 + seg * 32 + e] = s;
        __syncthreads();
        if (tid < 32) { int run = 0; for (int sg = 0; sg < 16; ++sg) { const int v = tab[512 + sg * 32 + tid]; tab[512 + sg * 32 + tid] = run; run += v; } tab[448 + tid] = run; }
        __syncthreads();
        if (bb) { int run = tab[512 + seg * 32 + e];
#pragma unroll
            for (int u = 0; u < 16; ++u) if ((b0 + u) < b1) { bb[(b0 + u) * 32 + e] = run; run += cv[u]; } }
    } else {
        for (int b = b0; b < b1; ++b) s += cntb[b * 32 + e];
        tab[512 + seg * 32 + e] = s;
        __syncthreads();
        if (tid < 32) { int run = 0; for (int sg = 0; sg < 16; ++sg) { const int v = tab[512 + sg * 32 + tid]; tab[512 + sg * 32 + tid] = run; run += v; } tab[448 + tid] = run; }
        __syncthreads();
        if (bb) { int run = tab[512 + seg * 32 + e]; for (int b = b0; b < b1; ++b) { bb[b * 32 + e] = run; run += cntb[b * 32 + e]; } }
    }
    if (tid < 64) {
        const int x = tid & 31, n = (tab[448 + x] + 255) >> 8; int inc = n;
#pragma unroll
        for (int o = 1; o < 32; o <<= 1) { const int t = __shfl_up(inc, o, 64); if ((tid & 31) >= o) inc += t; }
        if (tid < 32) { const int t0 = inc - n; tab[x] = t0 * 256; for (int i = 0; i < n; ++i) tab[64 + t0 + i] = x; if (x == 31) { tab[32] = inc * 256; tab[40] = inc; } }
    }
    __syncthreads();
    return tab[40];
}
template <int LAYER>
__device__ __forceinline__ void ph_moe_gather(const Params& p, LAS unsigned char* lds, int bid, int nblk) {
    const int tid = threadIdx.x;
    LAS int* tab = (LAS int*)(lds + LDS_TAB); LAS int* bb = (LAS int*)(lds + LDS_WORK);
    (void)moe_tables((const int*)(p.ws + WS_CNTB) + (size_t)LAYER * 512 * 32, nblk, tab, bb);
    const int* TOPE = (const int*)(p.ws + WS_TOPE); const int* TOPS = (const int*)(p.ws + WS_TOPS); int* POS = (int*)(p.ws + WS_POS); int* IDX = (int*)(p.ws + WS_IDX);
    constexpr int R0 = LAYER == 0 ? 0 : NCTX;
    for (int i = R0 * 4 + bid * NTHR + tid; i < MROWS * 4; i += nblk * NTHR) {
        const int row = i >> 2, e = TOPE[i], pos = tab[e] + bb[((((row - R0) >> 3) % nblk) << 5) + e] + TOPS[i];
        POS[i] = pos; IDX[pos] = row;
    }
    for (int e = bid; e < 32; e += nblk) {
        const int cnt = tab[448 + e], beg = tab[e] + cnt, end = tab[e] + ((cnt + 255) & ~255);
        for (int q = beg + tid; q < end; q += NTHR) IDX[q] = R0;
    }
}
template <int LAYER>
__device__ __forceinline__ void ph_moe_gemm1(const Params& p, LAS unsigned char* lds, int bid, int nblk) {
    LAS int* tab = (LAS int*)(lds + LDS_TAB);
    const int T = moe_tables((const int*)(p.ws + WS_CNTB) + (size_t)LAYER * 512 * 32, nblk, tab, (LAS int*)nullptr);
    pg8::SchedMoe<8> S{T, nblk, bid, tab + 64};
    pg8::Gemm g{(const bf16_t*)(p.ws + WS_H), (const bf16_t*)(p.ws + WS_W1T) + (size_t)LAYER * 32 * 2048 * 1024, 0, 0, 1024, (const int*)(p.ws + WS_IDX)};
    pg8::EpiAct E{(bf16_t*)(p.ws + WS_ACT), p.in[I_B1] + (size_t)LAYER * 32 * 2048};
    pg8::gemm_phase<pg8::EpiAct, pg8::SchedMoe<8>, false, false, true, true>(lds + LDS_WORK, g, S, E, nullptr);
}
template <int LAYER>
__device__ __forceinline__ void ph_moe_gemm2(const Params& p, LAS unsigned char* lds, int bid, int nblk) {
    LAS int* tab = (LAS int*)(lds + LDS_TAB);
    const int T = moe_tables((const int*)(p.ws + WS_CNTB) + (size_t)LAYER * 512 * 32, nblk, tab, (LAS int*)nullptr);
    pg8::SchedMoe<4> S{T, nblk, bid, tab + 64};
    pg8::Gemm g{(const bf16_t*)(p.ws + WS_ACT), (const bf16_t*)(p.ws + WS_W2T) + (size_t)LAYER * 32 * 1024 * 1024, 0, 0, 1024};
    pg8::EpiYE E{(bf16_t*)(p.ws + WS_YE), p.in[I_B2] + (size_t)LAYER * 32 * 1024};
    pg8::gemm_phase<pg8::EpiYE, pg8::SchedMoe<4>, false, true, true>(lds + LDS_WORK, g, S, E, nullptr);
}
template <int NN>
__device__ __forceinline__ void ph_gemm_dense(LAS unsigned char* lds, const bf16_t* A, const bf16_t* Bt, bf16_t* C, int ldc, int pm0, int nM, int bid, int nblk) {
    pg8::SchedDense<NN> S{nM, pm0, nblk, bid};
    pg8::Gemm g{A, Bt, 0, 0, 1024};
    pg8::EpiStore E{C, ldc};
    pg8::gemm_phase<pg8::EpiStore, pg8::SchedDense<NN>, false>(lds + LDS_WORK, g, S, E, nullptr);
}
template <int LAYER>
__device__ __forceinline__ void ph_ln2(const Params& p, LAS unsigned char* lds, int bid, int nblk) {
    const int tid = threadIdx.x, wid = tid >> 6, lane = tid & 63, fr = lane & 15, fq = lane >> 4;
    LAS float* vb = (LAS float*)(lds + LDS_WORK);
    LAS float* part = vb + 16 * 1028;
    float wgf[32];
    if (LAYER == 0) { const float* wg = p.in[I_OWIN] + (size_t)(128 * wid + 32 * fq) * ODD_IN + 4096 + fr;
#pragma unroll
        for (int s2 = 0; s2 < 32; ++s2) wgf[s2] = wg[(size_t)s2 * ODD_IN]; }
    const float* MOD = (const float*)(p.ws + WS_MOD);
    bf16_t* XS = (bf16_t*)(p.ws + WS_XS); const bf16_t* YE = (const bf16_t*)(p.ws + WS_YE); bf16_t* H = (bf16_t*)(p.ws + WS_H); float* GT = (float*)(p.ws + WS_GT);
    const float* TOPW = (const float*)(p.ws + WS_TOPW); const int* POS = (const int*)(p.ws + WS_POS);
    const float* lng = p.in[I_LNG] + (LAYER * 2 + 1) * 1024; const float* lnb = p.in[I_LNB] + (LAYER * 2 + 1) * 1024;
    const int rstride = nblk * 8, rbase = (LAYER == 0 ? 0 : NCTX) + bid * 8, rfirst = rbase + wid;
    f32x4 nw = {0.f, 0.f, 0.f, 0.f}; int np0 = 0, np1 = 0, np2 = 0, np3 = 0;
    if (rfirst < MROWS) { nw = *(const f32x4*)(TOPW + rfirst * 4); np0 = POS[rfirst * 4]; np1 = POS[rfirst * 4 + 1]; np2 = POS[rfirst * 4 + 2]; np3 = POS[rfirst * 4 + 3]; }
    auto do_row = [&](int row, int jj) {
        const float* md = MOD + (size_t)(LAYER * 5 + row_modr(row)) * 6144;
        const float w0 = nw[0], w1 = nw[1], w2 = nw[2], w3 = nw[3];
        const bf16_t* y0 = YE + (size_t)np0 * 1024; const bf16_t* y1 = YE + (size_t)np1 * 1024;
        const bf16_t* y2 = YE + (size_t)np2 * 1024; const bf16_t* y3 = YE + (size_t)np3 * 1024;
        if (row + rstride < MROWS) { const int rn = row + rstride; nw = *(const f32x4*)(TOPW + rn * 4); np0 = POS[rn * 4]; np1 = POS[rn * 4 + 1]; np2 = POS[rn * 4 + 2]; np3 = POS[rn * 4 + 3]; }
        f32x4 v[4]; float s = 0.f;
#pragma unroll
        for (int q = 0; q < 4; ++q) { const int col = q * 256 + lane * 4;
            const f32x4 ffn = (ld_bf16x4(y0 + col) * w0 + ld_bf16x4(y1 + col) * w1) + (ld_bf16x4(y2 + col) * w2 + ld_bf16x4(y3 + col) * w3);
            v[q] = ld_bf16x4(XS + (size_t)row * 1024 + col) * DN_ALPHA + *(const f32x4*)(md + 5120 + col) * ffn;
            s += (v[q][0] + v[q][1]) + (v[q][2] + v[q][3]); }
        const float mean = wave_sum(s) * (1.0f / 1024.0f);
        float ss = 0.f;
#pragma unroll
        for (int q = 0; q < 4; ++q) { v[q] = v[q] - mean; ss += (v[q][0] * v[q][0] + v[q][1] * v[q][1]) + (v[q][2] * v[q][2] + v[q][3] * v[q][3]); }
        const float rstd = rsqrtf(wave_sum(ss) * (1.0f / 1024.0f) + LN_EPS);
        if (LAYER == 1) {
#pragma unroll
            for (int q = 0; q < 4; ++q) { const int col = q * 256 + lane * 4;
                *(f32x4*)(p.out + (size_t)(row - NCTX) * 1024 + col) = v[q] * rstd * *(const f32x4*)(lng + col) + *(const f32x4*)(lnb + col); }
        } else {
            const float* md1 = MOD + (size_t)(5 + row_modr(row)) * 6144;
#pragma unroll
            for (int q = 0; q < 4; ++q) { const int col = q * 256 + lane * 4;
                const f32x4 xn = v[q] * rstd * *(const f32x4*)(lng + col) + *(const f32x4*)(lnb + col);
                { u32x2 wx; wx.x = pack_bf16(xn[0], xn[1]); wx.y = pack_bf16(xn[2], xn[3]); *(u32x2*)(XS + (size_t)row * 1024 + col) = wx; }
                v[q] = xn * (*(const f32x4*)(md1 + 1024 + col) + 1.0f) + *(const f32x4*)(md1 + col);
                u32x2 w; w.x = pack_bf16(v[q][0], v[q][1]); w.y = pack_bf16(v[q][2], v[q][3]);
                *(u32x2*)(H + (size_t)row * 1024 + col) = w;
                *(LAS f32x4*)(vb + (wid + 8 * jj) * 1028 + col) = v[q]; }
        }
    };
    if (LAYER == 1) {
#pragma unroll 1
        for (int row = rfirst; row < MROWS; row += rstride) do_row(row, 0);
    } else {
#pragma unroll 1
        for (int j0 = 0; rbase + j0 * rstride < MROWS; j0 += 2) {
#pragma unroll 1
            for (int jj = 0; jj < 2; ++jj) { const int row = rfirst + (j0 + jj) * rstride; if (row >= MROWS) break; do_row(row, jj); }
            __syncthreads();
            {
                const LAS float* ar = vb + fr * 1028 + 128 * wid + 32 * fq;
                f32x4 acc = {0.f, 0.f, 0.f, 0.f};
#pragma unroll
                for (int h = 0; h < 2; ++h) { f32x4 va[4];
#pragma unroll
                    for (int u = 0; u < 4; ++u) va[u] = *(const LAS f32x4*)(ar + h * 16 + u * 4);
#pragma unroll
                    for (int u = 0; u < 4; ++u)
#pragma unroll
                        for (int i = 0; i < 4; ++i) acc = __builtin_amdgcn_mfma_f32_16x16x4f32(va[u][i], wgf[h * 16 + u * 4 + i], acc, 0, 0, 0); }
                LAS float* pw = part + wid * 256 + (4 * fq) * 16 + fr;
#pragma unroll
                for (int i = 0; i < 4; ++i) pw[i * 16] = acc[i];
            }
            __syncthreads();
            if (tid < 256) { const int lr = tid >> 4, row = rbase + (lr & 7) + (j0 + (lr >> 3)) * rstride;
                float a = 0.f;
#pragma unroll
                for (int w2 = 0; w2 < 8; ++w2) a += part[w2 * 256 + tid];
                if (row < MROWS) GT[row * 16 + (tid & 15)] = a; }
        }
    }
}
constexpr int LDK = 136;
__device__ __forceinline__ int sid_of(int mixer, int dir, int b, int ch, int h) { return (((mixer * 2 + dir) * 4 + b) * NCHUNK + ch) * 4 + h; }
__device__ __forceinline__ void unit_decode(int u, int& mixer, int& h, int& ch, int& b, int& row0) {
    mixer = u & 1; h = (u >> 1) & 3; const int rest = u >> 3; ch = rest % NCHUNK; b = rest / NCHUNK;
    row0 = ch < 2 ? b * 256 + ch * 128 : NCTX + b * 4096 + (ch - 2) * 128;
}
__device__ __forceinline__ void ld_raw(const bf16_t* P, int row0, int col, u32x2 (&raw)[8]) {
    const int t = threadIdx.x, i = t >> 2, part = t & 3, i0 = (part & 1) * 32 + (part >> 1) * 16;
    const bf16_t* src = P + (size_t)(row0 + i) * LDP1 + col + i0;
#pragma unroll
    for (int q = 0; q < 4; ++q) { raw[q] = *(const u32x2*)(src + q * 4); raw[4 + q] = *(const u32x2*)(src + 64 + q * 4); }
}
__device__ __forceinline__ void cvt_rows(const u32x2 (&raw)[8], bool rope, int s0, const float* ROPE, float (&lo)[16], float (&hi)[16]) {
    const int t = threadIdx.x, i = t >> 2, part = t & 3, pr = part & 1, hf = part >> 1;
#pragma unroll
    for (int q = 0; q < 4; ++q) {
        lo[q * 4] = __uint_as_float(raw[q].x << 16); lo[q * 4 + 1] = __uint_as_float(raw[q].x & 0xffff0000u); lo[q * 4 + 2] = __uint_as_float(raw[q].y << 16); lo[q * 4 + 3] = __uint_as_float(raw[q].y & 0xffff0000u);
        hi[q * 4] = __uint_as_float(raw[4 + q].x << 16); hi[q * 4 + 1] = __uint_as_float(raw[4 + q].x & 0xffff0000u); hi[q * 4 + 2] = __uint_as_float(raw[4 + q].y << 16); hi[q * 4 + 3] = __uint_as_float(raw[4 + q].y & 0xffff0000u); }
    if (rope) {
        const int s = s0 + i, pos = pr == 0 ? (s >> 6) : (s & 63);
        const float* rp = ROPE + (size_t)(pos * 32 + hf * 16) * 2;
#pragma unroll
        for (int jj = 0; jj < 16; ++jj) { const float c = rp[2 * jj], sn = rp[2 * jj + 1], a = lo[jj], b = hi[jj]; lo[jj] = a * c - b * sn; hi[jj] = a * sn + b * c; }
    }
}
__device__ __forceinline__ void st_rows(LAS bf16_t* dst, const float (&lo)[16], const float (&hi)[16], float scale) {
    const int t = threadIdx.x, i = t >> 2, part = t & 3, i0 = (part & 1) * 32 + (part >> 1) * 16;
    u32x4 w0, w1, w2, w3;
    w0.x = pack_bf16(lo[0] * scale, lo[1] * scale); w0.y = pack_bf16(lo[2] * scale, lo[3] * scale); w0.z = pack_bf16(lo[4] * scale, lo[5] * scale); w0.w = pack_bf16(lo[6] * scale, lo[7] * scale);
    w1.x = pack_bf16(lo[8] * scale, lo[9] * scale); w1.y = pack_bf16(lo[10] * scale, lo[11] * scale); w1.z = pack_bf16(lo[12] * scale, lo[13] * scale); w1.w = pack_bf16(lo[14] * scale, lo[15] * scale);
    w2.x = pack_bf16(hi[0] * scale, hi[1] * scale); w2.y = pack_bf16(hi[2] * scale, hi[3] * scale); w2.z = pack_bf16(hi[4] * scale, hi[5] * scale); w2.w = pack_bf16(hi[6] * scale, hi[7] * scale);
    w3.x = pack_bf16(hi[8] * scale, hi[9] * scale); w3.y = pack_bf16(hi[10] * scale, hi[11] * scale); w3.z = pack_bf16(hi[12] * scale, hi[13] * scale); w3.w = pack_bf16(hi[14] * scale, hi[15] * scale);
    LAS bf16_t* d = dst + i * LDK + i0;
    *(LAS u32x4*)d = w0; *(LAS u32x4*)(d + 8) = w1; *(LAS u32x4*)(d + 64) = w2; *(LAS u32x4*)(d + 72) = w3;
}
__device__ __forceinline__ void st_rows_T(LAS bf16_t* dst, const float (&lo)[16], const float (&hi)[16], float scale) {
    const int t = threadIdx.x, i = t >> 2, part = t & 3, i0 = (part & 1) * 32 + (part >> 1) * 16;
#pragma unroll
    for (int jj = 0; jj < 16; ++jj) { dst[(i0 + jj) * LDK + i] = f2bf(lo[jj] * scale); dst[(i0 + 64 + jj) * LDK + i] = f2bf(hi[jj] * scale); }
}
__device__ __forceinline__ void mma_128(const LAS bf16_t* A, const LAS bf16_t* B, f32x4 (&acc)[2][4], int wr, int wc, int lane) {
    const int fr = lane & 15, fq = lane >> 4;
#pragma unroll
    for (int ks = 0; ks < 4; ++ks) {
        bf16x8 a[2], b[4];
#pragma unroll
        for (int mt = 0; mt < 2; ++mt) a[mt] = *(const LAS bf16x8*)(A + (wr * 32 + mt * 16 + fr) * LDK + ks * 32 + fq * 8);
#pragma unroll
        for (int nt = 0; nt < 4; ++nt) b[nt] = *(const LAS bf16x8*)(B + (wc * 64 + nt * 16 + fr) * LDK + ks * 32 + fq * 8);
#pragma unroll
        for (int mt = 0; mt < 2; ++mt)
#pragma unroll
            for (int nt = 0; nt < 4; ++nt) acc[mt][nt] = __builtin_amdgcn_mfma_f32_16x16x32_bf16(a[mt], b[nt], acc[mt][nt], 0, 0, 0);
    }
}
__device__ __forceinline__ void zero_acc(f32x4 (&acc)[2][4]) {
#pragma unroll
    for (int mt = 0; mt < 2; ++mt)
#pragma unroll
        for (int nt = 0; nt < 4; ++nt) acc[mt][nt] = (f32x4){0.f, 0.f, 0.f, 0.f};
}
__device__ __forceinline__ void wave_scan_sum2(float x0, float x1, float& p0, float& p1, float& total) {
    const int lane = threadIdx.x & 63; float s = x0 + x1, inc = s;
#pragma unroll
    for (int o = 1; o < 64; o <<= 1) { const float t = __shfl_up(inc, o, 64); if (lane >= o) inc += t; }
    const float exc = inc - s; p0 = exc + x0; p1 = exc + s; total = __shfl(inc, 63, 64);
}
__device__ __forceinline__ void wave_scan_max2(float x0, float x1, float& p0, float& p1) {
    const int lane = threadIdx.x & 63; const float m = fmaxf(x0, x1); float inc = m;
#pragma unroll
    for (int o = 1; o < 64; o <<= 1) { const float t = __shfl_up(inc, o, 64); if (lane >= o) inc = fmaxf(inc, t); }
    float exc = __shfl_up(inc, 1, 64); if (lane == 0) exc = -3.0e38f;
    p0 = fmaxf(exc, x0); p1 = fmaxf(exc, m);
}
__device__ __forceinline__ void ph_c1(const Params& p, LAS unsigned char* lds, int bid, int nblk) {
    const int tid = threadIdx.x, wid = tid >> 6, lane = tid & 63, wr = wid >> 1, wc = wid & 1, fr = lane & 15, fq = lane >> 4;
    LAS bf16_t* KsT = (LAS bf16_t*)(lds + LDS_WORK); LAS bf16_t* VsT0 = KsT + 128 * LDK; LAS bf16_t* VsT1 = VsT0 + 128 * LDK;
    LAS float* z = (LAS float*)(VsT1 + 128 * LDK);
    LAS float* lfA = z + 256; LAS float* igA = lfA + 256; LAS float* zmax = igA + 256;
    const bf16_t* P = (const bf16_t*)(p.ws + WS_P); const float* GT = (const float*)(p.ws + WS_GT); const float* ROPE = (const float*)(p.ws + WS_ROPE);
    float* ST = (float*)(p.ws + WS_ST); float* NST = (float*)(p.ws + WS_NST); float* MEND = (float*)(p.ws + WS_MEND); float* BEND = (float*)(p.ws + WS_BEND);
    for (int u = bid; u < NB * NCHUNK * 4 * 2; u += nblk) {
        int mixer, h, ch, b, row0; unit_decode(u, mixer, h, ch, b, row0);
        const int colQ = mixer * 2048 + h * 128;
        u32x2 rawK[8], rawV[8]; ld_raw(P, row0, colQ + 512, rawK); ld_raw(P, row0, colQ + 1024, rawV);
        if (mixer == 0) {
            if (tid < 256) { const int dir = tid >> 7, j = tid & 127; const float lg = p.in[I_CLG][dir * 4 + h]; z[tid] = fexp(lg * (float)(dir == 0 ? 127 - j : j)); }
        } else {
            if (tid < 256) { const int dir = tid >> 7, j = tid & 127, row = row0 + j;
                igA[tid] = GT[row * 16 + dir * 4 + h] + p.in[I_DIB][dir * 4 + h];
                lfA[tid] = -softplusf(-(GT[row * 16 + 8 + dir * 4 + h] + p.in[I_DFB][dir * 4 + h])); }
            __syncthreads();
            if (tid < 128) { const int dir = tid >> 6, j0 = 2 * lane, j1 = j0 + 1;
                const float l0 = lfA[dir * 128 + j0], l1 = lfA[dir * 128 + j1], g0 = igA[dir * 128 + j0], g1 = igA[dir * 128 + j1];
                float r0, r1, total; wave_scan_sum2(l0, l1, r0, r1, total);
                const float w0 = (dir == 0 ? total - r0 : r0 - l0) + g0, w1 = (dir == 0 ? total - r1 : r1 - l1) + g1;
                const float mx = wave_max(fmaxf(w0, w1));
                z[dir * 128 + j0] = fexp(w0 - mx); z[dir * 128 + j1] = fexp(w1 - mx);
                const int sid = sid_of(1, dir, b, ch, h);
                if (lane == 0) { MEND[sid] = mx; BEND[sid] = total; }
                float* CB = (float*)(p.ws + WS_CB) + (size_t)sid * 128; float* CMI = (float*)(p.ws + WS_CMI) + (size_t)sid * 128;
                if (dir == 0) { float m0, m1; wave_scan_max2(g0 - r0, g1 - r1, m0, m1); CB[j0] = r0; CB[j1] = r1; CMI[j0] = r0 + m0; CMI[j1] = r1 + m1; }
                else { const float s0 = total - r0 + l0, s1 = total - r1 + l1;
                    lfA[128 + j0] = g0 - s0; lfA[128 + j1] = g1 - s1; igA[128 + j0] = s0; igA[128 + j1] = s1; CB[j0] = s0; CB[j1] = s1;
                    asm volatile("s_waitcnt lgkmcnt(0)" ::: "memory");
                    const int q0 = 127 - 2 * lane, q1 = q0 - 1; float m0, m1; wave_scan_max2(lfA[128 + q0], lfA[128 + q1], m0, m1);
                    CMI[q0] = igA[128 + q0] + m0; CMI[q1] = igA[128 + q1] + m1; } }
        }
        __syncthreads();
        {
            float lo[16], hi[16];
            cvt_rows(rawK, mixer == 0 && ch >= 2, (ch - 2) * 128, ROPE, lo, hi);
            st_rows_T(KsT, lo, hi, 0.08838834764831845f);
            cvt_rows(rawV, false, 0, ROPE, lo, hi);
            const int i = tid >> 2;
            st_rows_T(VsT0, lo, hi, z[i]); st_rows_T(VsT1, lo, hi, z[128 + i]);
        }
        __syncthreads();
#pragma unroll
        for (int dir = 0; dir < 2; ++dir) {
            f32x4 acc[2][4]; zero_acc(acc);
            mma_128(dir == 0 ? VsT0 : VsT1, KsT, acc, wr, wc, lane);
            bf16_t* dst = (bf16_t*)ST + (size_t)sid_of(mixer, dir, b, ch, h) * 16384;
#pragma unroll
            for (int mt = 0; mt < 2; ++mt)
#pragma unroll
                for (int nt = 0; nt < 4; ++nt)
#pragma unroll
                    for (int r = 0; r < 4; ++r) dst[(wr * 32 + mt * 16 + fq * 4 + r) * 128 + wc * 64 + nt * 16 + fr] = f2bf(acc[mt][nt][r]);
        }
        if (mixer == 1 && tid < 256) { const int dir = tid >> 7, dd = tid & 127; float s = 0.f;
            for (int j = 0; j < 128; ++j) s += z[dir * 128 + j] * bf2f(KsT[dd * LDK + j]);
            NST[(size_t)sid_of(1, dir, b, ch, h) * 128 + dd] = s; }
        __syncthreads();
    }
}
__device__ __forceinline__ void ph_c2(const Params& p, int bid, int nblk) {
    const int tid = threadIdx.x;
    float* ST = (float*)(p.ws + WS_ST); float* NST = (float*)(p.ws + WS_NST); bf16_t* STB = (bf16_t*)(p.ws + WS_STB);
    const float* MEND = (const float*)(p.ws + WS_MEND); const float* BEND = (const float*)(p.ws + WS_BEND); float* MPREV = (float*)(p.ws + WS_MPREV);
    for (int item = bid; item < 2048; item += nblk) {
        const int mixer = item >> 10, chain = (item >> 5) & 31, slab = item & 31, dir = chain >> 4, b = (chain >> 2) & 3, h = chain & 3;
        const int idx = slab * 512 + tid;
        float kv[NCHUNK];
#pragma unroll
        for (int k = 0; k < NCHUNK; ++k) { const int ch = dir == 0 ? k : (k < 2 ? 1 - k : 35 - k); kv[k] = bf2f(((const bf16_t*)ST)[(size_t)sid_of(mixer, dir, b, ch, h) * 16384 + idx]); }
        if (mixer == 0) {
            const float gdec = fexp(p.in[I_CLG][dir * 4 + h] * 128.0f); float r = 0.f;
#pragma unroll
            for (int k = 0; k < NCHUNK; ++k) { const int ch = dir == 0 ? k : (k < 2 ? 1 - k : 35 - k); STB[(size_t)sid_of(0, dir, b, ch, h) * 16384 + idx] = f2bf(r); r = r * gdec + kv[k]; }
        } else {
            const bool do_n = slab == 0 && tid < 128;
            float nv[NCHUNK];
#pragma unroll
            for (int k = 0; k < NCHUNK; ++k) { const int ch = dir == 0 ? k : (k < 2 ? 1 - k : 35 - k); nv[k] = do_n ? NST[(size_t)sid_of(1, dir, b, ch, h) * 128 + tid] : 0.f; }
            float m = -__builtin_inff(), c = 0.f, n = 0.f;
#pragma unroll
            for (int k = 0; k < NCHUNK; ++k) { const int ch = dir == 0 ? k : (k < 2 ? 1 - k : 35 - k); const int sid = sid_of(1, dir, b, ch, h);
                const float me = MEND[sid], be = BEND[sid], mnew = fmaxf(be + m, me), so = fexp(be + m - mnew), sn = fexp(me - mnew);
                STB[(size_t)sid * 16384 + idx] = f2bf(c); c = c * so + kv[k] * sn;
                if (do_n) { NST[(size_t)sid * 128 + tid] = n; n = n * so + nv[k] * sn; }
                if (slab == 0 && tid == 0) MPREV[sid] = m;
                m = mnew; }
        }
    }
}
template <int mixer>
__device__ __forceinline__ void c3_unit(const Params& p, LAS unsigned char* lds, int h, int ch, int b, int row0) {
    const int tid = threadIdx.x, wid = tid >> 6, lane = tid & 63, wr = wid >> 1, wc = wid & 1, fr = lane & 15, fq = lane >> 4;
    LAS bf16_t* Qs = (LAS bf16_t*)(lds + LDS_WORK); LAS bf16_t* Ks = Qs + 128 * LDK; LAS bf16_t* VsT = Ks + 128 * LDK; LAS bf16_t* RT = VsT + 128 * LDK;
    LAS float* fa = (LAS float*)(RT + 128 * LDK);
    LAS float* lfA = fa; LAS float* igA = fa + 256; LAS float* bA = fa + 512; LAS float* miA = fa + 768; LAS float* mtA = fa + 1024; LAS float* sintA = fa + 1280;
    LAS float* rowsum = fa + 1536; LAS float* qn = fa + 2048; LAS float* nA = fa + 2304;
    LAS float* Os = (LAS float*)Qs;
    LAS bf16_t* Pm = Ks;
    const bf16_t* P = (const bf16_t*)(p.ws + WS_P); const float* GT = (const float*)(p.ws + WS_GT); const float* ROPE = (const float*)(p.ws + WS_ROPE);
    const bf16_t* STB = (const bf16_t*)(p.ws + WS_STB); const float* NST = (const float*)(p.ws + WS_NST); const float* MPREV = (const float*)(p.ws + WS_MPREV);
    bf16_t* Y = (bf16_t*)(p.ws + WS_YMIX);
    {
        const int colQ = mixer * 2048 + h * 128; const bool rope = mixer == 0 && ch >= 2;
        {
            u32x2 rawQ[8], rawK[8], rawV[8]; ld_raw(P, row0, colQ, rawQ); ld_raw(P, row0, colQ + 512, rawK); ld_raw(P, row0, colQ + 1024, rawV);
            float lo[16], hi[16];
            cvt_rows(rawQ, rope, (ch - 2) * 128, ROPE, lo, hi); st_rows(Qs, lo, hi, 1.0f);
            cvt_rows(rawK, rope, (ch - 2) * 128, ROPE, lo, hi); st_rows(Ks, lo, hi, 0.08838834764831845f);
            cvt_rows(rawV, false, 0, ROPE, lo, hi); st_rows_T(VsT, lo, hi, 1.0f);
        }
        if (mixer == 1) {
            if (tid < 256) { const int dir = tid >> 7, j = tid & 127, row = row0 + j;
                igA[tid] = GT[row * 16 + dir * 4 + h] + p.in[I_DIB][dir * 4 + h];
                nA[tid] = NST[(size_t)sid_of(1, dir, b, ch, h) * 128 + j];
                bA[tid] = ((const float*)(p.ws + WS_CB))[(size_t)sid_of(1, dir, b, ch, h) * 128 + j]; miA[tid] = ((const float*)(p.ws + WS_CMI))[(size_t)sid_of(1, dir, b, ch, h) * 128 + j]; }
            __syncthreads();
            __syncthreads();
            if (tid < 256) { const int dir = tid >> 7, i = tid & 127; const float mprev = MPREV[sid_of(1, dir, b, ch, h)];
                const float gi = bA[tid] + mprev, mt = fmaxf(gi, miA[tid]); mtA[tid] = mt; sintA[tid] = fexp(gi - mt);
                float s = 0.f;
                for (int d0 = 0; d0 < 128; ++d0) s += bf2f(Qs[i * LDK + d0]) * nA[dir * 128 + d0];
                qn[tid] = s; }
        }
        __syncthreads();
        f32x4 S[2][4]; zero_acc(S);
        mma_128(Qs, Ks, S, wr, wc, lane);
        __syncthreads();
        f32x4 O[2][4]; zero_acc(O);
        if (mixer == 0) {
            const float lg0 = p.in[I_CLG][h], lg1 = p.in[I_CLG][4 + h];
#pragma unroll
            for (int mt = 0; mt < 2; ++mt)
#pragma unroll
                for (int nt = 0; nt < 4; ++nt)
#pragma unroll
                    for (int r = 0; r < 4; ++r) { const int i = wr * 32 + mt * 16 + fq * 4 + r, j = wc * 64 + nt * 16 + fr;
                        const float dcy = (i >= j ? fexp(lg0 * (float)(i - j)) : 0.f) + (j >= i ? fexp(lg1 * (float)(j - i)) : 0.f);
                        Pm[i * LDK + j] = f2bf(S[mt][nt][r] * dcy); }
            __syncthreads();
            mma_128(Pm, VsT, O, wr, wc, lane);
#pragma unroll
            for (int dir = 0; dir < 2; ++dir) {
                { const bf16_t* src = STB + (size_t)sid_of(0, dir, b, ch, h) * 16384 + (tid >> 2) * 128 + (tid & 3) * 32; LAS bf16_t* d = RT + (tid >> 2) * LDK + (tid & 3) * 32;
#pragma unroll
                    for (int q = 0; q < 4; ++q) *(LAS u32x4*)(d + q * 8) = *(const u32x4*)(src + q * 8); }
                __syncthreads();
                f32x4 T[2][4]; zero_acc(T);
                mma_128(Qs, RT, T, wr, wc, lane);
#pragma unroll
                for (int mt = 0; mt < 2; ++mt)
#pragma unroll
                    for (int r = 0; r < 4; ++r) { const int i = wr * 32 + mt * 16 + fq * 4 + r; const float xi = dir == 0 ? fexp(lg0 * (float)(i + 1)) : fexp(lg1 * (float)(128 - i));
#pragma unroll
                        for (int nt = 0; nt < 4; ++nt) O[mt][nt][r] += xi * T[mt][nt][r]; }
                __syncthreads();
            }
        } else {
#pragma unroll
            for (int dir = 0; dir < 2; ++dir) {
                float rp[2][4];
#pragma unroll
                for (int mt = 0; mt < 2; ++mt)
#pragma unroll
                    for (int r = 0; r < 4; ++r) { const int i = wr * 32 + mt * 16 + fq * 4 + r; const float bi = bA[dir * 128 + i] - mtA[dir * 128 + i]; float acc = 0.f;
#pragma unroll
                        for (int nt = 0; nt < 4; ++nt) { const int j = wc * 64 + nt * 16 + fr; const bool valid = dir == 0 ? (j <= i) : (j >= i);
                            const float e = valid ? fexp(bi - bA[dir * 128 + j] + igA[dir * 128 + j]) : 0.f; const float pv = S[mt][nt][r] * e;
                            Pm[i * LDK + j] = f2bf(pv); acc += pv; }
                        rp[mt][r] = row16_sum(acc); }
                if (fr == 0) {
#pragma unroll
                    for (int mt = 0; mt < 2; ++mt)
#pragma unroll
                        for (int r = 0; r < 4; ++r) rowsum[wc * 256 + dir * 128 + wr * 32 + mt * 16 + fq * 4 + r] = rp[mt][r];
                }
                { const bf16_t* src = STB + (size_t)sid_of(1, dir, b, ch, h) * 16384 + (tid >> 2) * 128 + (tid & 3) * 32; LAS bf16_t* d = RT + (tid >> 2) * LDK + (tid & 3) * 32;
#pragma unroll
                    for (int q = 0; q < 4; ++q) *(LAS u32x4*)(d + q * 8) = *(const u32x4*)(src + q * 8); }
                __syncthreads();
                f32x4 T[2][4]; zero_acc(T);
                mma_128(Qs, RT, T, wr, wc, lane);
#pragma unroll
                for (int mt = 0; mt < 2; ++mt)
#pragma unroll
                    for (int r = 0; r < 4; ++r) { const float si = sintA[dir * 128 + wr * 32 + mt * 16 + fq * 4 + r];
#pragma unroll
                        for (int nt = 0; nt < 4; ++nt) T[mt][nt][r] *= si; }
                mma_128(Pm, VsT, T, wr, wc, lane);
#pragma unroll
                for (int mt = 0; mt < 2; ++mt)
#pragma unroll
                    for (int r = 0; r < 4; ++r) { const int i = wr * 32 + mt * 16 + fq * 4 + r; const float si = sintA[dir * 128 + i];
                        float den = (rowsum[dir * 128 + i] + rowsum[256 + dir * 128 + i]) + qn[dir * 128 + i] * si; den = fmaxf(fabsf(den), fexp(-mtA[dir * 128 + i])); const float rden = frcp(den);
#pragma unroll
                        for (int nt = 0; nt < 4; ++nt) O[mt][nt][r] += T[mt][nt][r] * rden; }
                __syncthreads();
            }
        }
#pragma unroll
        for (int mt = 0; mt < 2; ++mt)
#pragma unroll
            for (int nt = 0; nt < 4; ++nt)
#pragma unroll
                for (int r = 0; r < 4; ++r) Os[(wr * 32 + mt * 16 + fq * 4 + r) * 132 + wc * 64 + nt * 16 + fr] = O[mt][nt][r];
        __syncthreads();
        {
            const float* gng = (mixer == 0 ? p.in[I_CGNG] : p.in[I_DGNG]) + h * 128; const float* gnb = (mixer == 0 ? p.in[I_CGNB] : p.in[I_DGNB]) + h * 128;
            const float g0 = gng[lane], g1 = gng[lane + 64], b0 = gnb[lane], b1 = gnb[lane + 64];
#pragma unroll 1
            for (int i4 = 0; i4 < 16; i4 += 4) {
                float qg0[4], qg1[4];
#pragma unroll
                for (int u = 0; u < 4; ++u) { const int row = row0 + wid * 16 + i4 + u; qg0[u] = bf2f(P[(size_t)row * LDP1 + colQ + 1536 + lane]); qg1[u] = bf2f(P[(size_t)row * LDP1 + colQ + 1536 + 64 + lane]); }
#pragma unroll
                for (int u = 0; u < 4; ++u) { const int i = wid * 16 + i4 + u, row = row0 + i;
                    const float x0 = Os[i * 132 + lane], x1 = Os[i * 132 + 64 + lane];
                    const float mean = wave_sum(x0 + x1) * (1.0f / 128.0f), d0 = x0 - mean, d1 = x1 - mean;
                    const float rstd = rsqrtf(wave_sum(d0 * d0 + d1 * d1) * (1.0f / 128.0f) + LN_EPS);
                    const float q0 = qg0[u], q1 = qg1[u];
                    const float s0 = sigm(q0), s1 = sigm(q1);
                    const float y0 = (d0 * rstd * g0 + b0) * (mixer == 0 ? q0 * s0 : s0), y1 = (d1 * rstd * g1 + b1) * (mixer == 0 ? q1 * s1 : s1);
                    Y[(size_t)row * 1024 + mixer * 512 + h * 128 + lane] = f2bf(y0); Y[(size_t)row * 1024 + mixer * 512 + h * 128 + 64 + lane] = f2bf(y1); }
            }
        }
        __syncthreads();
    }
}
__device__ __forceinline__ void ph_c3(const Params& p, LAS unsigned char* lds, int bid, int nblk) {
    for (int u2 = bid; u2 < NB * NCHUNK * 4; u2 += nblk) {
        int mixer, h, ch, b, row0; unit_decode(u2 * 2, mixer, h, ch, b, row0);
        c3_unit<0>(p, lds, h, ch, b, row0);
    }
    for (int u2 = nblk - 1 - bid; u2 < NB * NCHUNK * 4; u2 += nblk) {
        int mixer, h, ch, b, row0; unit_decode(u2 * 2 + 1, mixer, h, ch, b, row0);
        c3_unit<1>(p, lds, h, ch, b, row0);
    }
}
constexpr int NPHASE = 23;
__global__ void __launch_bounds__(NTHR, 2) fwd(Params p) {
    extern __shared__ __attribute__((aligned(16))) unsigned char smem_raw[];
    LAS unsigned char* lds = (LAS unsigned char*)smem_raw;
    if (threadIdx.x == 0) { LAS unsigned* st = (LAS unsigned*)(lds + LDS_BAR); st[0] = 0u; st[1] = 0u; st[2] = 0u; st[3] = 0u; }
    __syncthreads();
    XcdBarrier bar = xcd_barrier_post((unsigned*)(p.ws + WS_CTL), (volatile LAS unsigned*)(lds + LDS_BAR));
    const int bid = blockIdx.x, nblk = gridDim.x;
    unsigned char* ws = p.ws;
#ifndef PHASE_ONLY
#define PHASE_ONLY -1
#endif
#ifndef DBL_MASK
#define DBL_MASK 0u
#endif
#define PHASE(k, call) if constexpr (PHASE_ONLY < 0 || PHASE_ONLY == (k)) { if (p.lo <= (k) && (k) < p.hi) { call; if constexpr ((DBL_MASK >> (k)) & 1u) { xcd_barrier(bar); call; } if ((k) + 1 < p.hi) xcd_barrier(bar); } }
    PHASE(0, ph_prologue(p, lds, bid, nblk))
    PHASE(1, ph_mod_in(p, bid, nblk))
    PHASE(2, ph_gemm_dense<12>(lds, (const bf16_t*)(ws + WS_H), (const bf16_t*)(ws + WS_WIN0T), (bf16_t*)(ws + WS_P), LDP0, 0, 68, bid, nblk))
    PHASE(3, ph_prep_even(p, lds, bid, nblk))
    PHASE(4, ph_r1(p, lds, bid, nblk))
    PHASE(5, ph_r2(p, lds, bid, nblk))
    PHASE(6, ph_fin_even(p, bid, nblk))
    PHASE(7, ph_gemm_dense<4>(lds, (const bf16_t*)(ws + WS_YMIX), (const bf16_t*)(ws + WS_WOUTT), (bf16_t*)(ws + WS_YP), 1024, 0, 68, bid, nblk))
    PHASE(8, ph_ln1<0>(p, lds, bid, nblk))
    PHASE(9, ph_moe_gather<0>(p, lds, bid, nblk))
    PHASE(10, ph_moe_gemm1<0>(p, lds, bid, nblk))
    PHASE(11, ph_moe_gemm2<0>(p, lds, bid, nblk))
    PHASE(12, ph_ln2<0>(p, lds, bid, nblk))
    PHASE(13, ph_gemm_dense<16>(lds, (const bf16_t*)(ws + WS_H), (const bf16_t*)(ws + WS_WIN1T), (bf16_t*)(ws + WS_P), LDP1, 0, 68, bid, nblk))
    PHASE(14, ph_c1(p, lds, bid, nblk))
    PHASE(15, ph_c2(p, bid, nblk))
    PHASE(16, ph_c3(p, lds, bid, nblk))
    PHASE(17, ph_gemm_dense<4>(lds, (const bf16_t*)(ws + WS_YMIX), (const bf16_t*)(ws + WS_WOUTT) + (size_t)1024 * 1024, (bf16_t*)(ws + WS_YP), 1024, 4, 64, bid, nblk))
    PHASE(18, ph_ln1<1>(p, lds, bid, nblk))
    PHASE(19, ph_moe_gather<1>(p, lds, bid, nblk))
    PHASE(20, ph_moe_gemm1<1>(p, lds, bid, nblk))
    PHASE(21, ph_moe_gemm2<1>(p, lds, bid, nblk))
    PHASE(22, ph_ln2<1>(p, lds, bid, nblk))
#undef PHASE
}

#ifndef MK_ONE_LAUNCH
#define MK_ONE_LAUNCH 1
#endif
extern "C" void kernel_launch(void* const* d_in, const int* in_sizes, int n_in, void* d_out, int out_size, void* d_ws, size_t ws_size, hipStream_t stream) {
    static int grid = 0;
    if (grid == 0) {
        if (n_in != N_INPUTS || out_size != NB * SEQL * DM || ws_size < WS_TOTAL) { fprintf(stderr, "kernel_launch: unexpected problem (n_in %d, out %d, ws %zu < %zu)\n", n_in, out_size, ws_size, (size_t)WS_TOTAL); grid = -1; return; }
        int dev = 0, cus = 0, per_cu = 0;
        if (hipGetDevice(&dev) != hipSuccess || hipDeviceGetAttribute(&cus, hipDeviceAttributeMultiprocessorCount, dev) != hipSuccess) { grid = -1; return; }
        if (hipFuncSetAttribute((const void*)fwd, hipFuncAttributeMaxDynamicSharedMemorySize, LDS_BYTES) != hipSuccess) { fprintf(stderr, "kernel_launch: hipFuncSetAttribute failed\n"); grid = -1; return; }
        if (hipOccupancyMaxActiveBlocksPerMultiprocessor(&per_cu, (const void*)fwd, NTHR, LDS_BYTES) != hipSuccess || per_cu < 1) { fprintf(stderr, "kernel_launch: occupancy query says %d\n", per_cu); (void)hipGetLastError(); per_cu = 1; }
        grid = cus;
    }
    if (grid < 0) return;
    (void)hipMemsetAsync((char*)d_ws + WS_CTL, 0, CTL_BYTES, stream);
    Params p{};
    for (int i = 0; i < N_INPUTS; ++i) p.in[i] = (const float*)d_in[i];
    p.out = (float*)d_out; p.ws = (unsigned char*)d_ws;
#if MK_ONE_LAUNCH
    p.lo = 0; p.hi = NPHASE;
    hipLaunchKernelGGL(fwd, dim3(grid), dim3(NTHR), LDS_BYTES, stream, p);
#else
    for (int k = 0; k < NPHASE; ++k) { p.lo = k; p.hi = k + 1; hipLaunchKernelGGL(fwd, dim3(grid), dim3(NTHR), LDS_BYTES, stream, p); }
#endif
}
```

```cpp
#include <hip/hip_runtime.h>
#include <stdint.h>
#include <stdio.h>

#define LAS __attribute__((address_space(3)))
typedef unsigned short bf16_t;
typedef short bf16x8 __attribute__((ext_vector_type(8)));
typedef float f32x4 __attribute__((ext_vector_type(4)));
typedef float f32x2 __attribute__((ext_vector_type(2)));
typedef unsigned u32x4 __attribute__((ext_vector_type(4)));
typedef unsigned u32x2 __attribute__((ext_vector_type(2)));

constexpr int NB = 4, SEQL = 4096, CTXL = 256, DM = 1024;
constexpr int NCTX = NB * CTXL;
constexpr int MROWS = NCTX + NB * SEQL;
constexpr int NTHR = 512;
constexpr int LDP0 = 3072, LDP1 = 4096;
constexpr int A_IN = 1920, EVEN_IN = 2944, ODD_IN = 4112;
constexpr int NEXP = 32, DFF = 1024;
constexpr int MOE_ROWS_MAX = 69632 + 32 * 256;
constexpr float DN_ALPHA = 1.41421356237309515f;
constexpr float LN_EPS = 1e-5f;
constexpr int NCHUNK = 34;

enum { I_X = 0, I_C, I_CTX, I_CCTX, I_WMOD, I_BMOD, I_LNG, I_LNB, I_EWIN, I_EWOUT, I_AMU, I_AW0, I_AWB, I_AA0, I_AAB, I_AGB, I_AKK, I_AKA, I_ARK,
       I_AGNG, I_AGNB, I_BCW, I_BCB, I_BGW, I_BGB, I_BLAM, I_OWIN, I_OWOUT, I_CLG, I_CGNG, I_CGNB, I_DIB, I_DFB, I_DGNG, I_DGNB, I_RW, I_RB,
       I_W1, I_B1, I_W2, I_B2, N_INPUTS };

constexpr size_t al256(size_t x) { return (x + 255) & ~(size_t)255; }
constexpr size_t WS_CTL   = 0;
constexpr size_t CTL_BYTES = 65536;
constexpr size_t CTL_CNT  = 16384;
constexpr size_t WS_MOD   = WS_CTL + CTL_BYTES;
constexpr size_t WS_ROPE  = WS_MOD + al256((size_t)2 * 5 * 6144 * 4);
constexpr size_t WS_WIN0T = WS_ROPE + 16384;
constexpr size_t WS_WIN1T = WS_WIN0T + (size_t)3072 * 1024 * 2;
constexpr size_t WS_WOUTT = WS_WIN1T + (size_t)4096 * 1024 * 2;
constexpr size_t WS_W1T   = WS_WOUTT + (size_t)2 * 1024 * 1024 * 2;
constexpr size_t WS_W2T   = WS_W1T + (size_t)2 * 32 * 2048 * 1024 * 2;
constexpr size_t WS_XS    = WS_W2T + (size_t)2 * 32 * 1024 * 1024 * 2;
constexpr size_t WS_H     = WS_XS + (size_t)MROWS * 1024 * 4;
constexpr size_t WS_YMIX  = WS_H + (size_t)MROWS * 1024 * 2;
constexpr size_t WS_YP    = WS_YMIX + (size_t)MROWS * 1024 * 2;
constexpr size_t WS_GT    = WS_YP + (size_t)MROWS * 1024 * 4;
constexpr size_t WS_TOPE  = WS_GT + (size_t)MROWS * 16 * 4;
constexpr size_t WS_TOPW  = WS_TOPE + (size_t)MROWS * 16;
constexpr size_t WS_TOPS  = WS_TOPW + (size_t)MROWS * 16;
constexpr size_t WS_POS   = WS_TOPS + (size_t)MROWS * 16;
constexpr size_t WS_CNTB  = WS_POS + (size_t)MROWS * 16;
constexpr size_t WS_WLT   = WS_CNTB + (size_t)2 * 512 * 32 * 4;
constexpr size_t WLT_WB = 0, WLT_AB = 65536, WLT_GB = 131072, WLT_GW = 196608, WLT_N = 327680;
constexpr size_t WS_P     = WS_WLT + (size_t)WLT_N * 2;
constexpr size_t WS_BIG   = WS_P + (size_t)MROWS * 4096 * 4;
constexpr size_t ARR512   = (size_t)MROWS * 512 * 4;
constexpr int SCREC = 448;
constexpr int SCLEN = CTXL + SEQL;
constexpr size_t WS_SC    = WS_BIG;
enum { E_G = 0, E_O0, E_O1, E_A0, E_A1, E_BX0, E_BX1, E_GATE, E_NARR };
constexpr size_t WS_EARR  = WS_SC + (size_t)64 * SCLEN * SCREC * 2;
constexpr size_t WS_BC    = WS_EARR + (size_t)E_NARR * ARR512;
constexpr size_t WS_CHA   = WS_BC + (size_t)MROWS * 8 * 4;
constexpr size_t WS_CHH   = WS_CHA + (size_t)2 * 512 * 512 * 4;
constexpr size_t WS_CIN   = WS_CHH + (size_t)2 * 512 * 512 * 4;
constexpr int RCH = 64, NRCH = SCLEN / RCH, NRUNIT = 64 * NRCH;
constexpr size_t WS_RU    = WS_CIN + (size_t)2 * 512 * 512 * 4;
constexpr size_t WS_EEND  = WS_RU + (size_t)NRUNIT * 4 * 4096 * 4;
constexpr int NSID = 2 * 2 * NB * NCHUNK * 4;
constexpr size_t WS_ST    = WS_BIG;
constexpr size_t WS_NST   = WS_ST + (size_t)NSID * 16384 * 4;
constexpr size_t WS_MEND  = WS_NST + (size_t)NSID * 128 * 4;
constexpr size_t WS_BEND  = WS_MEND + al256((size_t)NSID * 4);
constexpr size_t WS_MPREV = WS_BEND + al256((size_t)NSID * 4);
constexpr size_t WS_CB    = WS_MPREV + al256((size_t)NSID * 4);
constexpr size_t WS_CMI   = WS_CB + (size_t)NSID * 128 * 4;
constexpr size_t WS_STB   = WS_CMI + (size_t)NSID * 128 * 4;
constexpr size_t WS_OEND  = WS_STB + (size_t)NSID * 16384 * 2;
constexpr size_t WS_ASORT = WS_BIG;
constexpr size_t WS_IDX   = WS_BIG;
constexpr size_t WS_ACT   = WS_ASORT + (size_t)MOE_ROWS_MAX * 1024 * 2;
constexpr size_t WS_YE    = WS_ACT + (size_t)MOE_ROWS_MAX * 1024 * 2;
constexpr size_t WS_MEND_ = WS_YE + (size_t)MOE_ROWS_MAX * 1024 * 4;
constexpr size_t WS_TOTAL = (WS_EEND > WS_MEND_ ? (WS_EEND > WS_OEND ? WS_EEND : WS_OEND) : (WS_MEND_ > WS_OEND ? WS_MEND_ : WS_OEND));

constexpr int LDS_BYTES = 155648;
constexpr int LDS_BAR = 0;
constexpr int LDS_WORK = 1024;

struct Params {
    const float* in[N_INPUTS];
    float* out;
    unsigned char* ws;
    int lo, hi;
};

typedef __bf16 nbf16x2 __attribute__((ext_vector_type(2)));
__device__ __forceinline__ unsigned pack_bf16(float lo, float hi) { const nbf16x2 v = {(__bf16)lo, (__bf16)hi}; return __builtin_bit_cast(unsigned, v); }
__device__ __forceinline__ bf16_t f2bf(float f) { return __builtin_bit_cast(bf16_t, (__bf16)f); }
__device__ __forceinline__ float bf2f(bf16_t b) { return __uint_as_float(((unsigned)b) << 16); }
__device__ __forceinline__ f32x4 ld_bf16x4(const bf16_t* p) { const u32x2 w = *(const u32x2*)p; return (f32x4){__uint_as_float(w.x << 16), __uint_as_float(w.x & 0xffff0000u), __uint_as_float(w.y << 16), __uint_as_float(w.y & 0xffff0000u)}; }
__device__ __forceinline__ float fexp(float x) { return __builtin_amdgcn_exp2f(x * 1.4426950408889634f); }
__device__ __forceinline__ float frcp(float x) { return __builtin_amdgcn_rcpf(x); }
__device__ __forceinline__ float fsqrt(float x) { return __builtin_amdgcn_sqrtf(x); }
__device__ __forceinline__ float sigm(float x) { return frcp(1.0f + fexp(-x)); }
__device__ __forceinline__ float ftanh(float x) { const float e = fexp(-2.0f * fabsf(x)), t = (1.0f - e) * frcp(1.0f + e); return x < 0.f ? -t : t; }
__device__ __forceinline__ float fexpm1_neg(float x) {
    const float p = x * (1.0f + x * (0.5f + x * (0.16666667f + x * (0.041666668f + x * 0.0083333338f))));
    return x > -0.25f ? p : fexp(x) - 1.0f; }
__device__ __forceinline__ float softplusf(float x) { return fmaxf(x, 0.f) + log1pf(expf(-fabsf(x))); }
__device__ __forceinline__ float wave_sum(float v) {
    v += __int_as_float(__builtin_amdgcn_update_dpp(0, __float_as_int(v), 0x121, 0xf, 0xf, false));
    v += __int_as_float(__builtin_amdgcn_update_dpp(0, __float_as_int(v), 0x122, 0xf, 0xf, false));
    v += __int_as_float(__builtin_amdgcn_update_dpp(0, __float_as_int(v), 0x124, 0xf, 0xf, false));
    v += __int_as_float(__builtin_amdgcn_update_dpp(0, __float_as_int(v), 0x128, 0xf, 0xf, false));
    v += __int_as_float(__builtin_amdgcn_update_dpp(0, __float_as_int(v), 0x142, 0xa, 0xf, false));
    v += __int_as_float(__builtin_amdgcn_update_dpp(0, __float_as_int(v), 0x143, 0xc, 0xf, false));
    return __int_as_float(__builtin_amdgcn_readlane(__float_as_int(v), 63));
}
__device__ __forceinline__ float wave_max(float v) {
    const int ninf = 0xff800000;
    v = fmaxf(v, __int_as_float(__builtin_amdgcn_update_dpp(ninf, __float_as_int(v), 0x121, 0xf, 0xf, false)));
    v = fmaxf(v, __int_as_float(__builtin_amdgcn_update_dpp(ninf, __float_as_int(v), 0x122, 0xf, 0xf, false)));
    v = fmaxf(v, __int_as_float(__builtin_amdgcn_update_dpp(ninf, __float_as_int(v), 0x124, 0xf, 0xf, false)));
    v = fmaxf(v, __int_as_float(__builtin_amdgcn_update_dpp(ninf, __float_as_int(v), 0x128, 0xf, 0xf, false)));
    v = fmaxf(v, __int_as_float(__builtin_amdgcn_update_dpp(ninf, __float_as_int(v), 0x142, 0xa, 0xf, false)));
    v = fmaxf(v, __int_as_float(__builtin_amdgcn_update_dpp(ninf, __float_as_int(v), 0x143, 0xc, 0xf, false)));
    return __int_as_float(__builtin_amdgcn_readlane(__float_as_int(v), 63));
}
__device__ __forceinline__ int wave_min_i(int v) {
    const int big = 0x7fffffff;
    v = min(v, __builtin_amdgcn_update_dpp(big, v, 0x121, 0xf, 0xf, false));
    v = min(v, __builtin_amdgcn_update_dpp(big, v, 0x122, 0xf, 0xf, false));
    v = min(v, __builtin_amdgcn_update_dpp(big, v, 0x124, 0xf, 0xf, false));
    v = min(v, __builtin_amdgcn_update_dpp(big, v, 0x128, 0xf, 0xf, false));
    v = min(v, __builtin_amdgcn_update_dpp(big, v, 0x142, 0xa, 0xf, false));
    v = min(v, __builtin_amdgcn_update_dpp(big, v, 0x143, 0xc, 0xf, false));
    return __builtin_amdgcn_readlane(v, 63);
}
__device__ __forceinline__ float row16_sum(float v) {
    v += __int_as_float(__builtin_amdgcn_update_dpp(0, __float_as_int(v), 0x121, 0xf, 0xf, false));
    v += __int_as_float(__builtin_amdgcn_update_dpp(0, __float_as_int(v), 0x122, 0xf, 0xf, false));
    v += __int_as_float(__builtin_amdgcn_update_dpp(0, __float_as_int(v), 0x124, 0xf, 0xf, false));
    v += __int_as_float(__builtin_amdgcn_update_dpp(0, __float_as_int(v), 0x128, 0xf, 0xf, false));
    return v;
}
__device__ __forceinline__ int row_batch(int row) { return row < NCTX ? (row >> 8) : ((row - NCTX) >> 12); }
__device__ __forceinline__ int row_modr(int row) { return row < NCTX ? 4 : ((row - NCTX) >> 12); }
#define XB_TMO      128
#define XB_XCNT(j)  (256  + 64 * (j))
#define XB_XSUB(j)  (1280 + 64 * (j))
#define XB_XGEN(j)  (2304 + 64 * (j))
#define XB_TOP      3328
#define XB_TOPGEN   3392
#define XCD_BAR_WORDS 3456
#define XB_SPIN_CAP (1u << 18)

__device__ __forceinline__ unsigned xb_ld(unsigned* p)              { return __hip_atomic_load(p, __ATOMIC_RELAXED, __HIP_MEMORY_SCOPE_AGENT); }
__device__ __forceinline__ unsigned xb_add(unsigned* p, unsigned v) { return __hip_atomic_fetch_add(p, v, __ATOMIC_RELAXED, __HIP_MEMORY_SCOPE_AGENT); }
__device__ __forceinline__ unsigned xb_xcc_id() { return (unsigned)__builtin_amdgcn_s_getreg((3 << 11) | 20) & 0xFu; }
#define XB_SPIN(cond, bar) do { unsigned _sp = 0; while (cond) { __builtin_amdgcn_s_sleep(1); \
    if ((++_sp & 255u) == 0u) { if (xb_ld(&(bar)[XB_TMO])) break; if (_sp > XB_SPIN_CAP) { atomicAdd(&(bar)[XB_TMO], 1u); break; } } } } while (0)

struct XcdBarrier {
    unsigned* bar; unsigned x;
    volatile LAS unsigned* st;
};

__device__ __forceinline__ XcdBarrier xcd_barrier_post(unsigned* bar, volatile LAS unsigned* st) {
    XcdBarrier b; b.bar = bar; b.x = xb_xcc_id(); b.st = st;
    if (threadIdx.x == 0) (void)xb_add(&bar[XB_XCNT(b.x)], 1u);
    return b;
}
__device__ __forceinline__ void xcd_barrier_complete(unsigned* bar, unsigned x, unsigned& nloc, unsigned& nx) {
    const unsigned G = gridDim.x * gridDim.y * gridDim.z;
    unsigned sum, cnt, mine, sp = 0u;
    for (;;) {
        sum = 0u; cnt = 0u; mine = 0u;
#pragma unroll
        for (unsigned j = 0; j < 16; ++j) { const unsigned c = xb_ld(&bar[XB_XCNT(j)]); sum += c; cnt += (c > 0u) ? 1u : 0u; mine = (j == x) ? c : mine; }
        if (sum == G) break;
        __builtin_amdgcn_s_sleep(1);
        if ((++sp & 255u) == 0u) { if (xb_ld(&bar[XB_TMO])) break; if (sp > XB_SPIN_CAP) { atomicAdd(&bar[XB_TMO], 1u); break; } }
    }
    nloc = mine > 0u ? mine : 1u; nx = cnt > 0u ? cnt : 1u;
}

__device__ __forceinline__ void xcd_barrier(const XcdBarrier& b) {
    asm volatile("s_waitcnt vmcnt(0)" ::: "memory");
    __syncthreads();
    if (threadIdx.x == 0) {
        unsigned* bar = b.bar;
        __builtin_amdgcn_s_waitcnt(0);
        unsigned nloc = b.st[0], nx = b.st[1];
        if (nloc == 0u) { xcd_barrier_complete(bar, b.x, nloc, nx); b.st[0] = nloc; b.st[1] = nx; }
        const unsigned old = xb_add(&bar[XB_XSUB(b.x)], 1u);
        const unsigned gen = old / nloc;
        if (old + 1u == (gen + 1u) * nloc) {
            __builtin_amdgcn_fence(__ATOMIC_RELEASE, "agent");
            asm volatile("s_waitcnt vmcnt(0)" ::: "memory");
            const unsigned og = xb_add(&bar[XB_TOP], 1u);
            const unsigned tg = og / nx;
            if (og + 1u == (tg + 1u) * nx) xb_add(&bar[XB_TOPGEN], 1u);
            else XB_SPIN(xb_ld(&bar[XB_TOPGEN]) == tg, bar);
            __builtin_amdgcn_fence(__ATOMIC_ACQUIRE, "agent");
            xb_add(&bar[XB_XGEN(b.x)], 1u);
            asm volatile("s_waitcnt vmcnt(0)" ::: "memory");
        } else {
            XB_SPIN(xb_ld(&bar[XB_XGEN(b.x)]) == gen, bar);
            __builtin_amdgcn_fence(__ATOMIC_ACQUIRE, "agent");
            asm volatile("s_waitcnt vmcnt(0)" ::: "memory");
        }
    }
    __syncthreads();
}
namespace pg8 {
constexpr int BM = 256, BK = 64, HALF = 128, HTB = HALF * BK * 2  , STAGE_BYTES = 8 * HTB, NXCD = 8, WGM = 8;

__host__ __device__ __forceinline__ int lds_byte(int r, int c) { const int st = (r >> 4) * 2 + (c >> 5), rr = r & 15, cc = c & 31, ob = rr * 64 + cc * 2; return st * 1024 + (ob ^ (((ob >> 9) & 1) << 5)); }
__host__ __device__ __forceinline__ void stage_rc(int b, int& R, int& C) { const int st = b / 1024, sb = b % 1024, swz = sb ^ (((sb >> 9) & 1) << 5); R = (st >> 1) * 16 + swz / 64; C = (st & 1) * 32 + (swz % 64) / 2; }
__host__ __device__ __forceinline__ int perm32(int rho) { const int n = rho >> 4, i = rho & 15; return 8 * (i >> 2) + 4 * n + (i & 3); }

struct Unit { int pm, pn; };
struct Gemm { const bf16_t* A; const bf16_t* Bt; int M, N, K; const int* aidx; };
__device__ __forceinline__ unsigned cvt_pk_bf16(float lo, float hi) { return pack_bf16(lo, hi); }
template <class Epi, class Sched, bool STAMP = false, bool ATILED = false, bool BTILED = false, bool AGATHER = false>
__device__ __forceinline__ void gemm_phase(LAS unsigned char* lds, const Gemm g, const Sched& S, const Epi& E, unsigned long long* stamps) {
    const int tid = threadIdx.x, wid = __builtin_amdgcn_readfirstlane(tid >> 6), lane = tid & 63, wr = wid >> 2, wc = wid & 3, fr = lane & 15, fq = lane >> 4;
    const int K = g.K, nt = K / BK;
    int ts_lo = 0, ts_hi = 0, nts = 0; const unsigned long long rt_entry = STAMP ? (unsigned long long)wall_clock64() : 0ull;
#define PG8_STAMP() do { if (STAMP && wid == 0 && nts < 64) { const unsigned long long _c = (unsigned long long)clock64(); \
        ts_lo = (lane == nts) ? (int)(unsigned)_c : ts_lo; ts_hi = (lane == nts) ? (int)(unsigned)(_c >> 32) : ts_hi; ++nts; } } while (0)
    PG8_STAMP();
    unsigned voffA[2], voffB[2];
#pragma unroll
    for (int i = 0; i < 2; ++i) { int R, C; stage_rc(tid * 16 + i * 8192, R, C); const int Rb = Epi::PERM ? ((R & ~31) + perm32(R & 31)) : R;
        voffA[i] = (unsigned)(R * (ATILED ? BK : K) + C) * 2u; voffB[i] = (unsigned)(Rb * (BTILED ? BK : K) + C) * 2u; }
    const size_t kstepA = ATILED ? (size_t)BM * BK * 2 : (size_t)(BK * 2), kstepB = BTILED ? (size_t)BM * BK * 2 : (size_t)(BK * 2);
    const size_t hstepA = ATILED ? (size_t)HALF * BK * 2 : (size_t)HALF * K * 2, hstepB = BTILED ? (size_t)HALF * BK * 2 : (size_t)HALF * K * 2;
    const size_t tstep = (size_t)BM * K * 2;
    const unsigned ldsw = (unsigned)wid * 1024u;
    static_assert(!(AGATHER && ATILED), "a gathered operand is row-major");
    int gR0 = 0, gC0 = 0; { int R, C; stage_rc(tid * 16, R, C); gR0 = R; gC0 = C * 2; }
    unsigned vAc[4] = {0u, 0u, 0u, 0u};
    LAS int* gslot = (LAS int*)(lds + STAGE_BYTES + 8192 + 2048);
    const int aoff = lds_byte(wr * 64 + fr, fq * 8), boff = lds_byte(wc * 32 + fr, fq * 8);
#define PG8_SA(b, h) (((b) * 2 + (h)) * HTB)
#define PG8_SB(b, h) ((4 + (b) * 2 + (h)) * HTB)
#define PG8_STAGE(bufoff, gbase, voff) do { _Pragma("unroll") for (int _i = 0; _i < 2; ++_i) \
        __builtin_amdgcn_global_load_lds((const unsigned*)((const char*)(gbase) + (voff)[_i]), (LAS unsigned*)(lds + (bufoff) + ldsw + _i * 8192), 16, 0, 0); } while (0)
#define PG8_STAGE_A(bufoff, gbase, kbytes, h, vg) do { if constexpr (AGATHER) { _Pragma("unroll") for (int _i = 0; _i < 2; ++_i) \
        __builtin_amdgcn_global_load_lds((const unsigned*)((const char*)g.A + (kbytes) + (vg)[(h) * 2 + _i]), (LAS unsigned*)(lds + (bufoff) + ldsw + _i * 8192), 16, 0, 0); } \
        else PG8_STAGE(bufoff, gbase, voffA); } while (0)
#define PG8_LDA(dst, b, h) do { _Pragma("unroll") for (int m = 0; m < 4; ++m) _Pragma("unroll") for (int k = 0; k < 2; ++k) dst[m][k] = *(const LAS bf16x8*)(lds + PG8_SA(b, h) + aoff + m * 2048 + k * 1024); } while (0)
#define PG8_LDB(dst, b, h) do { _Pragma("unroll") for (int n = 0; n < 2; ++n) _Pragma("unroll") for (int k = 0; k < 2; ++k) dst[n][k] = *(const LAS bf16x8*)(lds + PG8_SB(b, h) + boff + n * 2048 + k * 1024); } while (0)
#define PG8_MMA(ai, bj, At, Bt) do { __builtin_amdgcn_s_setprio(1); _Pragma("unroll") for (int m = 0; m < 4; ++m) _Pragma("unroll") for (int n = 0; n < 2; ++n) _Pragma("unroll") for (int k = 0; k < 2; ++k) \
        acc[ai][bj][m][n] = __builtin_amdgcn_mfma_f32_16x16x32_bf16(Bt[n][k], At[m][k], acc[ai][bj][m][n], 0, 0, 0); __builtin_amdgcn_s_setprio(0); } while (0)
#define PG8_WAIT_V(n) asm volatile("s_waitcnt vmcnt(" #n ")" ::: "memory")
#define PG8_WAIT_L(n) asm volatile("s_waitcnt lgkmcnt(" #n ")" ::: "memory")
#define PG8_BAR __builtin_amdgcn_s_barrier()
#define PG8_SCHED __builtin_amdgcn_sched_barrier(0)
    Unit cur, nxt; int ui = 0;
    if (!S.next(0, cur)) return;
    f32x4 acc[2][2][4][2];
#pragma unroll
    for (int a = 0; a < 2; ++a)
#pragma unroll
        for (int b = 0; b < 2; ++b)
#pragma unroll
            for (int m = 0; m < 4; ++m)
#pragma unroll
                for (int n = 0; n < 2; ++n) acc[a][b][m][n] = (f32x4){0.f, 0.f, 0.f, 0.f};
    bf16x8 At[4][2], B0[2][2], B1[2][2];
    const char* cA = (const char*)g.A + (size_t)cur.pm * tstep; const char* cB = (const char*)g.Bt + (size_t)cur.pn * tstep;
    S.a_ready(cur);
    if constexpr (AGATHER) {
#pragma unroll
        for (int j = 0; j < 4; ++j) vAc[j] = (unsigned)g.aidx[cur.pm * BM + gR0 + 64 * j] * (unsigned)(K * 2) + (unsigned)gC0;
    }
    PG8_STAGE(PG8_SB(0, 0), cB, voffB); PG8_STAGE_A(PG8_SA(0, 0), cA, 0, 0, vAc); PG8_STAGE(PG8_SB(0, 1), cB + hstepB, voffB); PG8_STAGE_A(PG8_SA(0, 1), cA + hstepA, 0, 1, vAc);
    if (wr == 1) PG8_BAR;
    PG8_WAIT_V(4); PG8_BAR;
    PG8_STAGE(PG8_SB(1, 0), cB + kstepB, voffB); PG8_STAGE_A(PG8_SA(1, 0), cA + kstepA, BK * 2, 0, vAc); PG8_STAGE(PG8_SB(1, 1), cB + hstepB + kstepB, voffB);
    PG8_WAIT_V(6); PG8_BAR;
    PG8_STAMP();
    for (;;) {
        const bool has_next = S.next(ui + 1, nxt);
        const char* nA = has_next ? (const char*)g.A + (size_t)nxt.pm * tstep : cA; const char* nB = has_next ? (const char*)g.Bt + (size_t)nxt.pn * tstep : cB;
        E.pre(lds, ui & 1, cur, wid, lane);
        if constexpr (AGATHER) { if (has_next && wid == 0) __builtin_amdgcn_global_load_lds((const unsigned*)(g.aidx + nxt.pm * BM + lane * 4), (LAS unsigned*)(gslot + ((ui + 1) & 1) * 256), 16, 0, 0); }
        for (int t = 0; t < nt; t += 2) {
            const bool last = (t == nt - 2);
            const char* a1 = cA + (size_t)(t + 1) * kstepA;
            const char* a2 = last ? nA : cA + (size_t)(t + 2) * kstepA; const char* b2 = last ? nB : cB + (size_t)(t + 2) * kstepB;
            const char* a3 = a2 + kstepA; const char* b3 = b2 + kstepB;
            if (last && has_next) S.a_ready(nxt);
            const int kb2 = AGATHER ? (last ? 0 : (t + 2) * BK * 2) : 0;
            PG8_LDB(B0, 0, 0); PG8_SCHED; PG8_LDA(At, 0, 0); PG8_STAGE_A(PG8_SA(1, 1), a1 + hstepA, (t + 1) * BK * 2, 1, vAc);
            if constexpr (AGATHER) { if (last && has_next) {
#pragma unroll
                for (int j = 0; j < 4; ++j) vAc[j] = (unsigned)gslot[((ui + 1) & 1) * 256 + gR0 + 64 * j] * (unsigned)(K * 2) + (unsigned)gC0; } }
            PG8_WAIT_L(8); PG8_BAR; PG8_WAIT_L(0); PG8_MMA(0, 0, At, B0); PG8_BAR; PG8_SCHED;
            PG8_LDB(B1, 0, 1); PG8_STAGE(PG8_SB(0, 0), b2, voffB);
            PG8_BAR; PG8_WAIT_L(0); PG8_MMA(0, 1, At, B1); PG8_BAR;
            PG8_LDA(At, 0, 1); PG8_STAGE_A(PG8_SA(0, 0), a2, kb2, 0, vAc);
            PG8_BAR; PG8_WAIT_L(0); PG8_MMA(1, 0, At, B0); PG8_BAR; PG8_SCHED;
            PG8_STAGE(PG8_SB(0, 1), b2 + hstepB, voffB);
            PG8_WAIT_V(6); PG8_BAR; PG8_MMA(1, 1, At, B1); PG8_BAR;
            PG8_LDB(B0, 1, 0); PG8_SCHED; PG8_LDA(At, 1, 0); PG8_STAGE_A(PG8_SA(0, 1), a2 + hstepA, kb2, 1, vAc);
            PG8_WAIT_L(8); PG8_BAR; PG8_WAIT_L(0); PG8_MMA(0, 0, At, B0); PG8_BAR; PG8_SCHED;
            PG8_LDB(B1, 1, 1); PG8_STAGE(PG8_SB(1, 0), b3, voffB);
            PG8_BAR; PG8_WAIT_L(0); PG8_MMA(0, 1, At, B1); PG8_BAR;
            PG8_LDA(At, 1, 1); PG8_STAGE_A(PG8_SA(1, 0), a3, kb2 + BK * 2, 0, vAc);
            PG8_BAR; PG8_WAIT_L(0); PG8_MMA(1, 0, At, B0); PG8_BAR; PG8_SCHED;
            PG8_STAGE(PG8_SB(1, 1), b3 + hstepB, voffB);
            PG8_WAIT_V(6); PG8_BAR; PG8_MMA(1, 1, At, B1); PG8_BAR;
        }
        PG8_STAMP();
        if constexpr (!Epi::AFTER_DRAIN) { E(acc, cur, wr, wc, fr, fq, lds, ui & 1); S.done(cur); }
        PG8_STAMP();
        if (!has_next) break;
#pragma unroll
        for (int a = 0; a < 2; ++a)
#pragma unroll
            for (int b = 0; b < 2; ++b)
#pragma unroll
                for (int m = 0; m < 4; ++m)
#pragma unroll
                    for (int n = 0; n < 2; ++n) acc[a][b][m][n] = (f32x4){0.f, 0.f, 0.f, 0.f};
        cur = nxt; cA = nA; cB = nB; ++ui;

    }
    PG8_WAIT_V(0);
    if (wr == 0) PG8_BAR;
    PG8_BAR;
    if constexpr (Epi::AFTER_DRAIN) { E.fused(acc, cur, wr, wc, fr, fq, lds, wid, lane); S.done(cur); }
    PG8_STAMP();
    if (STAMP && wid == 0) { stamps[lane] = lane < nts ? (((unsigned long long)(unsigned)ts_hi << 32) | (unsigned)ts_lo) : 0ull;
        if (lane == 62) stamps[62] = rt_entry; if (lane == 63) stamps[63] = (unsigned long long)wall_clock64(); }
#undef PG8_STAMP
#undef PG8_SA
#undef PG8_SB
#undef PG8_STAGE
#undef PG8_STAGE_A
#undef PG8_LDA
#undef PG8_LDB
#undef PG8_MMA
#undef PG8_WAIT_V
#undef PG8_WAIT_L
#undef PG8_BAR
#undef PG8_SCHED
}
__device__ __forceinline__ int xcd_contig(long L, int nwg) { const int q = nwg / NXCD, r = nwg % NXCD, xcd = (int)(L % NXCD), off = (int)(L / NXCD); return (xcd < r ? xcd * (q + 1) : r * (q + 1) + (xcd - r) * q) + off; }
template <int nN>
struct SchedDense {
    int nM, pm0, G, c;
    __device__ __forceinline__ bool next(int i, Unit& u) const {
        const long L = (long)i * G + c; const int nwg = nM * nN; if (L >= nwg) return false;
        const int wgid = xcd_contig(L, nwg);
        constexpr int nig = WGM * nN; const int gid = wgid / nig, fm = gid * WGM, gsz = (nM - fm) < WGM ? (nM - fm) : WGM, w = wgid % nig;
        if (gsz == WGM) { u.pm = pm0 + fm + (w & (WGM - 1)); u.pn = w >> 3; } else { u.pm = pm0 + fm + (w % gsz); u.pn = w / gsz; }
        return true; }
    __device__ __forceinline__ void a_ready(const Unit&) const {}
    __device__ __forceinline__ void done(const Unit&) const {}
};
template <int nN>
struct SchedMoe {
    int T, G, c; const LAS int* tileE;
    __device__ __forceinline__ bool next(int i, Unit& u) const { const long L = (long)i * G + c; const int nwg = T * nN; if (L >= nwg) return false;
        const int wgid = xcd_contig(L, nwg), pt = wgid / nN; u.pm = pt; u.pn = tileE[pt] * nN + (wgid % nN); return true; }
    __device__ __forceinline__ void a_ready(const Unit&) const {}
    __device__ __forceinline__ void done(const Unit&) const {}
};
constexpr int EPI_BIAS_OFF = STAGE_BYTES + 8192;
struct EpiStore {
    static constexpr bool PERM = true, AFTER_DRAIN = false;
    bf16_t* O; int ldc;
    __device__ __forceinline__ void pre(LAS unsigned char*, int, const Unit&, int, int) const {}
    __device__ __forceinline__ void operator()(const f32x4 (&acc)[2][2][4][2], const Unit& u, int wr, int wc, int fr, int fq, const LAS unsigned char*, int) const {
        const int row0 = u.pm * BM + wr * 64 + fr, col0 = u.pn * BM + wc * 32 + 8 * fq;
#pragma unroll
        for (int ai = 0; ai < 2; ++ai)
#pragma unroll
            for (int m = 0; m < 4; ++m) { bf16_t* rowp = O + (size_t)(row0 + ai * HALF + m * 16) * ldc + col0;
#pragma unroll
                for (int bj = 0; bj < 2; ++bj) { const f32x4 v0 = acc[ai][bj][m][0], v1 = acc[ai][bj][m][1];
                    u32x4 w; w.x = cvt_pk_bf16(v0[0], v0[1]); w.y = cvt_pk_bf16(v0[2], v0[3]); w.z = cvt_pk_bf16(v1[0], v1[1]); w.w = cvt_pk_bf16(v1[2], v1[3]);
                    *(u32x4*)(rowp + bj * HALF) = w; } }
    }
};
struct EpiYE {
    static constexpr bool PERM = true, AFTER_DRAIN = false;
    bf16_t* O; const float* b2;
    __device__ __forceinline__ void pre(LAS unsigned char* lds, int par, const Unit& u, int wid, int lane) const {
        if (wid == 0) __builtin_amdgcn_global_load_lds((const unsigned*)(b2 + (u.pn >> 2) * 1024 + (u.pn & 3) * BM + lane * 4), (LAS unsigned*)(lds + EPI_BIAS_OFF + par * 1024), 16, 0, 0);
    }
    __device__ __forceinline__ void operator()(const f32x4 (&acc)[2][2][4][2], const Unit& u, int wr, int wc, int fr, int fq, const LAS unsigned char* lds, int par) const {
        const int pn = u.pn & 3;
        const int row0 = u.pm * BM + wr * 64 + fr, col0 = pn * BM + wc * 32 + 8 * fq;
        const LAS float* bp = (const LAS float*)(lds + EPI_BIAS_OFF + par * 1024) + wc * 32 + 8 * fq;
        f32x4 bv[2][2];
#pragma unroll
        for (int bj = 0; bj < 2; ++bj)
#pragma unroll
            for (int n = 0; n < 2; ++n) bv[bj][n] = *(const LAS f32x4*)(bp + bj * HALF + 4 * n);
#pragma unroll
        for (int ai = 0; ai < 2; ++ai)
#pragma unroll
            for (int m = 0; m < 4; ++m) { bf16_t* rowp = O + (size_t)(row0 + ai * HALF + m * 16) * 1024 + col0;
#pragma unroll
                for (int bj = 0; bj < 2; ++bj) { const f32x4 v0 = acc[ai][bj][m][0] + bv[bj][0], v1 = acc[ai][bj][m][1] + bv[bj][1];
                    u32x4 w; w.x = cvt_pk_bf16(v0[0], v0[1]); w.y = cvt_pk_bf16(v0[2], v0[3]); w.z = cvt_pk_bf16(v1[0], v1[1]); w.w = cvt_pk_bf16(v1[2], v1[3]);
                    *(u32x4*)(rowp + bj * HALF) = w; } }
    }
};
struct EpiAct {
    static constexpr bool PERM = true, AFTER_DRAIN = false;
    bf16_t* O; const float* b1;
    __device__ __forceinline__ void pre(LAS unsigned char* lds, int par, const Unit& u, int wid, int lane) const {
        if (wid == 0) __builtin_amdgcn_global_load_lds((const unsigned*)(b1 + (u.pn >> 3) * 2048 + (lane >> 5) * 1024 + (u.pn & 7) * 128 + (lane & 31) * 4), (LAS unsigned*)(lds + EPI_BIAS_OFF + par * 1024), 16, 0, 0);
    }
    __device__ __forceinline__ void operator()(const f32x4 (&acc)[2][2][4][2], const Unit& u, int wr, int wc, int fr, int fq, const LAS unsigned char* lds, int par) const {
        const int pn = u.pn & 7;
        const int row0 = u.pm * BM + wr * 64 + fr, x0 = pn * 128 + wc * 32 + 8 * fq;
        const LAS float* bg = (const LAS float*)(lds + EPI_BIAS_OFF + par * 1024) + wc * 32 + 8 * fq; const LAS float* bl = bg + 128;
        const f32x4 g0 = *(const LAS f32x4*)bg, g1 = *(const LAS f32x4*)(bg + 4), l0 = *(const LAS f32x4*)bl, l1 = *(const LAS f32x4*)(bl + 4);
#pragma unroll
        for (int ai = 0; ai < 2; ++ai)
#pragma unroll
            for (int m = 0; m < 4; ++m) {
                float o[8];
#pragma unroll
                for (int n = 0; n < 2; ++n)
#pragma unroll
                    for (int j = 0; j < 4; ++j) {
                        float glu = acc[ai][0][m][n][j] + (n ? g1[j] : g0[j]);
                        float lin = acc[ai][1][m][n][j] + (n ? l1[j] : l0[j]);
                        glu = fminf(glu, 7.0f); lin = fminf(fmaxf(lin, -7.0f), 7.0f);
                        o[n * 4 + j] = (lin + 1.0f) * glu * __builtin_amdgcn_rcpf(1.0f + __expf(-1.702f * glu));
                    }
                u32x4 w; w.x = cvt_pk_bf16(o[0], o[1]); w.y = cvt_pk_bf16(o[2], o[3]); w.z = cvt_pk_bf16(o[4], o[5]); w.w = cvt_pk_bf16(o[6], o[7]);
                *(u32x4*)(O + ((size_t)(u.pm * 16 + (x0 >> 6)) * 256 + (wr * 64 + fr + ai * HALF + m * 16)) * 64 + (x0 & 63)) = w;
            }
    }
};
}
using pg8::Unit;
__device__ __forceinline__ void my_sincos(double a, float& s, float& c) {
    const double n = rint(a * 0.63661977236758134308);
    const double r = (a - n * 1.57079632679489655800e+00) - n * 6.12323399573676603587e-17;
    const double r2 = r * r;
    const double sp = r * (1.0 + r2 * (-1.0 / 6.0 + r2 * (1.0 / 120.0 + r2 * (-1.0 / 5040.0 + r2 * (1.0 / 362880.0 + r2 * (-1.0 / 39916800.0 + r2 * (1.0 / 6227020800.0 + r2 * (-1.0 / 1307674368000.0))))))));
    const double cp = 1.0 + r2 * (-0.5 + r2 * (1.0 / 24.0 + r2 * (-1.0 / 720.0 + r2 * (1.0 / 40320.0 + r2 * (-1.0 / 3628800.0 + r2 * (1.0 / 479001600.0 + r2 * (-1.0 / 87178291200.0 + r2 * (1.0 / 20922789888000.0))))))));
    const int q = ((int)n) & 3;
    const double sn = q == 0 ? sp : q == 1 ? cp : q == 2 ? -sp : -cp;
    const double cn = q == 0 ? cp : q == 1 ? -sp : q == 2 ? -cp : sp;
    s = (float)sn; c = (float)cn;
}
__device__ __forceinline__ void ph_prologue(const Params& p, LAS unsigned char* lds, int bid, int nblk) {
    const int tid = threadIdx.x;
    unsigned char* ws = p.ws;
    {
        LAS float* sv = (LAS float*)(lds + LDS_WORK);
        LAS float* red = sv + 5 * 1024;
        for (int i = tid; i < 5 * 1024; i += NTHR) { const int r = i >> 10, k = i & 1023; const float c = r < 4 ? p.in[I_C][r * 1024 + k] : p.in[I_CCTX][k]; sv[i] = c / (1.0f + expf(-c)); }
        __syncthreads();
        float* MOD = (float*)(ws + WS_MOD);
        for (int item = bid; item < 256; item += nblk) {
            if (tid < 480) {
                const int cl = tid % 48, kp = tid / 48;
                const int gc = item * 48 + cl, l = gc / 6144, n = gc % 6144;
                const float* w = p.in[I_WMOD] + (size_t)l * 1024 * 6144 + n;
                float a0 = 0.f, a1 = 0.f, a2 = 0.f, a3 = 0.f, a4 = 0.f;
#pragma unroll 1
                for (int k0 = kp; k0 < 1024; k0 += 130) {
                    float wv[13];
#pragma unroll
                    for (int u = 0; u < 13; ++u) { const int k = k0 + 10 * u; wv[u] = k < 1024 ? w[(size_t)k * 6144] : 0.f; }
#pragma unroll
                    for (int u = 0; u < 13; ++u) { const int k = k0 + 10 * u < 1024 ? k0 + 10 * u : 1023; a0 += sv[k] * wv[u]; a1 += sv[1024 + k] * wv[u]; a2 += sv[2048 + k] * wv[u]; a3 += sv[3072 + k] * wv[u]; a4 += sv[4096 + k] * wv[u]; }
                }
                LAS float* rp = red + (kp * 48 + cl) * 5; rp[0] = a0; rp[1] = a1; rp[2] = a2; rp[3] = a3; rp[4] = a4;
            }
            __syncthreads();
            if (tid < 240) {
                const int cl = tid / 5, r = tid % 5; float s = 0.f;
                for (int kp = 0; kp < 10; ++kp) s += red[(kp * 48 + cl) * 5 + r];
                const int gc = item * 48 + cl, l = gc / 6144, n = gc % 6144;
                MOD[(size_t)(l * 5 + r) * 6144 + n] = s + p.in[I_BMOD][l * 6144 + n];
            }
            __syncthreads();
        }
    }
    if (bid == (nblk > 1 ? 1 : 0)) {
        float* ROPE = (float*)(ws + WS_ROPE);
        for (int i = tid; i < 2048; i += NTHR) { const int pos = i >> 5, f = i & 31; const double inv = exp(-(double)f * 0.28782313662425575); float s, c; my_sincos((double)pos * inv, s, c); ROPE[2 * i] = c; ROPE[2 * i + 1] = s; }
    }
    {
        bf16_t* WLT = (bf16_t*)(ws + WS_WLT);
        for (int i = bid * NTHR + tid; i < (int)WLT_N; i += nblk * NTHR) {
            float v;
            if (i < 131072) { const int which = i >> 16, r = i & 65535, d = r >> 15, n = (r >> 6) & 511, k = r & 63; v = (which ? p.in[I_AAB] : p.in[I_AWB])[(size_t)(d * 64 + k) * 512 + n]; }
            else if (i < 196608) { const int r = i - 131072, n = r >> 7, k = r & 127; v = p.in[I_AGB][(size_t)k * 512 + n]; }
            else { const int r = i - 196608, blk = r >> 12, o = (r >> 6) & 63, ii = r & 63; v = p.in[I_BGW][(size_t)blk * 4096 + ii * 64 + o]; }
            WLT[i] = f2bf(v);
        }
    }
    {
        LAS float* tile = (LAS float*)(lds + LDS_WORK);
        for (int t = bid; t < 576; t += nblk) {
            const float* src; int ld, nvalid, k0, n0, w1map = 0; bf16_t* dst; int tt = t;
            if (tt < 192) { k0 = (tt / 12) * 64; n0 = (tt % 12) * 256; src = p.in[I_EWIN]; ld = EVEN_IN; nvalid = EVEN_IN; dst = (bf16_t*)(ws + WS_WIN0T); }
            else if ((tt -= 192) < 256) { k0 = (tt >> 4) * 64; n0 = (tt & 15) * 256; src = p.in[I_OWIN]; ld = ODD_IN; nvalid = 4096; dst = (bf16_t*)(ws + WS_WIN1T); }
            else { tt -= 256; const int mat = tt >> 6, r = tt & 63; k0 = (r >> 2) * 64; n0 = (r & 3) * 256; src = mat ? p.in[I_OWOUT] : p.in[I_EWOUT]; ld = 1024; nvalid = 1024; dst = (bf16_t*)(ws + WS_WOUTT) + (size_t)mat * 1024 * 1024; }
            {
                const int j4 = (tid & 63) * 4, i0 = tid >> 6;
                f32x4 v[8];
#pragma unroll
                for (int r = 0; r < 8; ++r) v[r] = (n0 + j4 < nvalid) ? *(const f32x4*)(src + (size_t)(k0 + i0 + 8 * r) * ld + n0 + j4) : (f32x4){0.f, 0.f, 0.f, 0.f};
#pragma unroll
                for (int r = 0; r < 8; ++r) { LAS float* tp = tile + (i0 + 8 * r) * 257 + j4; tp[0] = v[r][0]; tp[1] = v[r][1]; tp[2] = v[r][2]; tp[3] = v[r][3]; }
            }
            __syncthreads();
            {
                const int ip = (tid & 31) * 2, j0 = tid >> 5;
#pragma unroll
                for (int r = 0; r < 16; ++r) {
                    const int j = j0 + 16 * r, n = n0 + j;
                    const int rho = w1map ? ((((n & 1023) >> 7) << 8) + ((n >> 10) << 7) + (n & 127)) : n;
                    *(unsigned*)(dst + (size_t)rho * 1024 + k0 + ip) = pack_bf16(tile[ip * 257 + j], tile[(ip + 1) * 257 + j]);
                }
            }
            __syncthreads();
        }
    }
}
__device__ __forceinline__ void ph_mod_in(const Params& p, int bid, int nblk) {
    const int tid = threadIdx.x, wid = tid >> 6, lane = tid & 63;
    const float* MOD = (const float*)(p.ws + WS_MOD);
    bf16_t* H = (bf16_t*)(p.ws + WS_H);
    for (int row = bid * 8 + wid; row < MROWS; row += nblk * 8) {
        const float* src = row < NCTX ? p.in[I_CTX] + (size_t)row * 1024 : p.in[I_X] + (size_t)(row - NCTX) * 1024;
        const float* md = MOD + (size_t)row_modr(row) * 6144;
#pragma unroll
        for (int q = 0; q < 4; ++q) {
            const int col = q * 256 + lane * 4;
            const f32x4 x = *(const f32x4*)(src + col), sh = *(const f32x4*)(md + col), sc = *(const f32x4*)(md + 1024 + col);
            const f32x4 h = x * (sc + 1.0f) + sh;
            u32x2 w; w.x = pack_bf16(h[0], h[1]); w.y = pack_bf16(h[2], h[3]);
            *(u32x2*)(H + (size_t)row * 1024 + col) = w;
        }
    }
}
__device__ __forceinline__ int even_tok_row(int w, int idx) { return idx < 64 ? NCTX + (w >> 6) * 4096 + (w & 63) * 64 + idx : w * 4 + (idx - 64); }
__device__ __forceinline__ int shift_nb(int row, int cc) {
    if (row >= NCTX) { const int s = (row - NCTX) & 4095, gr = s >> 6, gc = s & 63, slot = cc & 3;
        if (slot == 0) return gc > 0 ? row - 1 : -1;
        if (slot == 1) return gc < 63 ? row + 1 : -1;
        if (slot == 2) return gr > 0 ? row - 64 : -1;
        return gr < 63 ? row + 64 : -1; }
    const int t = row & 255; return (cc & 1) == 0 ? (t > 0 ? row - 1 : -1) : (t < 255 ? row + 1 : -1);
}
__device__ __forceinline__ float shifted_z(const bf16_t* P, const float* mu, int row, int cc) {
    const float pv = bf2f(P[(size_t)row * LDP0 + cc]); const int nb = shift_nb(row, cc);
    const float sv = nb >= 0 ? bf2f(P[(size_t)nb * LDP0 + cc]) : 0.f;
    return pv + (sv - pv) * mu[cc];
}
__device__ __forceinline__ int scan_q(int row, int d) {
    if (row < NCTX) { const int t = row & 255; return d ? 255 - t : t; }
    const int s = (row - NCTX) & 4095; return 256 + (d ? 4095 - s : s);
}
__device__ __forceinline__ bf16_t* sc_rec(float* SC, int d, int row, int h) { return (bf16_t*)SC + ((size_t)((d * 4 + row_batch(row)) * 8 + h) * SCLEN + scan_q(row, d)) * SCREC; }
constexpr int LDL = 392, LDU = 520;
template <int KS>
__device__ __forceinline__ void load_b(const bf16_t* Bt, bf16x8 (&b)[4][KS], int lane) {
    const int fr = lane & 15, fq = lane >> 4;
#pragma unroll
    for (int nt = 0; nt < 4; ++nt)
#pragma unroll
        for (int ks = 0; ks < KS; ++ks) b[nt][ks] = *(const bf16x8*)(Bt + (size_t)(nt * 16 + fr) * (32 * KS) + ks * 32 + fq * 8);
}
template <int KS>
__device__ __forceinline__ void mma_mt(const LAS bf16_t* A, int lda, int mt, const bf16x8 (&b)[4][KS], f32x4 (&acc)[4], int lane) {
    const int fr = lane & 15, fq = lane >> 4;
#pragma unroll
    for (int nt = 0; nt < 4; ++nt) acc[nt] = (f32x4){0.f, 0.f, 0.f, 0.f};
#pragma unroll
    for (int ks = 0; ks < KS; ++ks) {
        const bf16x8 a = *(const LAS bf16x8*)(A + (mt * 16 + fr) * lda + ks * 32 + fq * 8);
#pragma unroll
        for (int nt = 0; nt < 4; ++nt) acc[nt] = __builtin_amdgcn_mfma_f32_16x16x32_bf16(a, b[nt][ks], acc[nt], 0, 0, 0);
    }
}
__device__ __forceinline__ void ph_prep_even(const Params& p, LAS unsigned char* lds, int bid, int nblk) {
    const int tid = threadIdx.x, wid = tid >> 6, lane = tid & 63, c = tid, fr = lane & 15, fq = lane >> 4;
    const bf16_t* P = (const bf16_t*)(p.ws + WS_P);
    float* SC = (float*)(p.ws + WS_SC);
    float* EA = (float*)(p.ws + WS_EARR);
#define EARR(k) (EA + (size_t)(k) * ((size_t)MROWS * 512))
    float* BC = (float*)(p.ws + WS_BC);
    float* CHA = (float*)(p.ws + WS_CHA); float* CHH = (float*)(p.ws + WS_CHH);
    const bf16_t* WLT = (const bf16_t*)(p.ws + WS_WLT);
    const float* mu = p.in[I_AMU];
    LAS bf16_t* linb = (LAS bf16_t*)(lds + LDS_WORK);
    LAS bf16_t* ub = linb + 80 * LDL;
    LAS float* rnorm = (LAS float*)(ub + 80 * LDU);
    for (int w = bid; w < 256; w += nblk) {
        for (int i = tid; i < 12 * LDL; i += NTHR) linb[68 * LDL + i] = 0;
        for (int i = tid; i < 12 * LDU; i += NTHR) ub[68 * LDU + i] = 0;
#pragma unroll 1
        for (int g = 0; g < 3; ++g) {
            float pv[17], sv[17];
#pragma unroll
            for (int u = 0; u < 17; ++u) { const int e = tid + NTHR * (g * 17 + u), tok = e / 384, j = e - tok * 384, row = even_tok_row(w, tok), nb = shift_nb(row, 1536 + j);
                pv[u] = bf2f(P[(size_t)row * LDP0 + 1536 + j]); sv[u] = nb >= 0 ? bf2f(P[(size_t)nb * LDP0 + 1536 + j]) : 0.f; }
#pragma unroll
            for (int u = 0; u < 17; ++u) { const int e = tid + NTHR * (g * 17 + u), tok = e / 384, j = e - tok * 384;
                const float z = pv[u] + (sv[u] - pv[u]) * mu[1536 + j];
                linb[tok * LDL + j] = f2bf(j < 128 ? ftanh(z) : (j < 256 ? z : sigm(z))); }
        }
        {
            float murv[8], mukv8[8], muvv[8], kkc8[8];
#pragma unroll
            for (int i = 0; i < 8; ++i) { murv[i] = mu[lane * 8 + i]; mukv8[i] = mu[512 + lane * 8 + i]; muvv[i] = mu[1024 + lane * 8 + i]; kkc8[i] = p.in[I_AKK][lane * 8 + i]; }
#pragma unroll 1
            for (int tok = wid; tok < 68; tok += 8) {
                const int row = even_tok_row(w, tok);
                int nbr[4];
#pragma unroll
                for (int sl = 0; sl < 4; ++sl) nbr[sl] = shift_nb(row, sl);
                u32x4 ps[3], pn[3][4];
#pragma unroll
                for (int a = 0; a < 3; ++a) { ps[a] = *(const u32x4*)(P + (size_t)row * LDP0 + a * 512 + lane * 8);
#pragma unroll
                    for (int sl = 0; sl < 4; ++sl) pn[a][sl] = nbr[sl] >= 0 ? *(const u32x4*)(P + (size_t)nbr[sl] * LDP0 + a * 512 + lane * 8) : (u32x4){0u, 0u, 0u, 0u}; }
                float z[3][8];
#pragma unroll
                for (int a = 0; a < 3; ++a)
#pragma unroll
                    for (int i = 0; i < 8; ++i) { const unsigned wp = ps[a][i >> 1], wn = pn[a][i & 3][i >> 1];
                        const float pv = __uint_as_float((i & 1) ? (wp & 0xffff0000u) : (wp << 16)), sv = __uint_as_float((i & 1) ? (wn & 0xffff0000u) : (wn << 16));
                        z[a][i] = pv + (sv - pv) * (a == 0 ? murv[i] : (a == 1 ? mukv8[i] : muvv[i])); }
                float kkr[8], ss = 0.f;
#pragma unroll
                for (int i = 0; i < 8; ++i) { kkr[i] = z[1][i] * kkc8[i]; ss += kkr[i] * kkr[i]; }
                ss += __int_as_float(__builtin_amdgcn_update_dpp(0, __float_as_int(ss), 0xb1, 0xf, 0xf, false));
                ss += __int_as_float(__builtin_amdgcn_update_dpp(0, __float_as_int(ss), 0x4e, 0xf, 0xf, false));
                ss += __int_as_float(__builtin_amdgcn_update_dpp(0, __float_as_int(ss), 0x141, 0xf, 0xf, false));
                const float rn = frcp(fmaxf(fsqrt(ss), 1e-12f));
                if ((lane & 7) == 0) rnorm[tok * 8 + (lane >> 3)] = rn;
                u32x4 qk, qr, qv;
#pragma unroll
                for (int i = 0; i < 4; ++i) { qk[i] = pack_bf16(kkr[2 * i] * rn, kkr[2 * i + 1] * rn); qr[i] = pack_bf16(z[0][2 * i], z[0][2 * i + 1]); qv[i] = pack_bf16(z[2][2 * i], z[2][2 * i + 1]); }
#pragma unroll
                for (int d = 0; d < 2; ++d) { bf16_t* rec = sc_rec(SC, d, row, lane >> 3) + (lane & 7) * 8; *(u32x4*)(rec + 128) = qk; *(u32x4*)(rec + 320) = qr; *(u32x4*)(rec + 384) = qv; }
            }
        }
        {
            float cw[4][8], cb8[8];
#pragma unroll
            for (int i = 0; i < 8; ++i) { cb8[i] = p.in[I_BCB][lane * 8 + i];
#pragma unroll
                for (int k = 0; k < 4; ++k) cw[k][i] = p.in[I_BCW][k * 512 + lane * 8 + i]; }
#pragma unroll 1
            for (int tok = wid; tok < 68; tok += 8) {
                const int row = even_tok_row(w, tok);
                int pos, len;
                if (row >= NCTX) { pos = (row - NCTX) & 4095; len = 4096; } else { pos = row & 255; len = 256; }
                const u32x4 zero4 = {0u, 0u, 0u, 0u};
                const bf16_t* px = P + (size_t)row * LDP0 + 1920 + lane * 8;
                u32x4 xv[4];
                xv[0] = pos >= 2 ? *(const u32x4*)(px - 2 * (size_t)LDP0) : zero4; xv[1] = pos >= 1 ? *(const u32x4*)(px - (size_t)LDP0) : zero4;
                xv[2] = *(const u32x4*)px; xv[3] = pos + 1 < len ? *(const u32x4*)(px + (size_t)LDP0) : zero4;
                const u32x4 gxv = *(const u32x4*)(px + 512);
                float uu[8], gg[8];
#pragma unroll
                for (int i = 0; i < 8; ++i) { float a = cb8[i];
#pragma unroll
                    for (int k = 0; k < 4; ++k) { const unsigned wv = xv[k][i >> 1]; a += cw[k][i] * __uint_as_float((i & 1) ? (wv & 0xffff0000u) : (wv << 16)); }
                    uu[i] = a;
                    const unsigned wg = gxv[i >> 1]; const float gx = __uint_as_float((i & 1) ? (wg & 0xffff0000u) : (wg << 16));
                    gg[i] = 0.5f * gx * (1.0f + ftanh(0.7978845608028654f * (gx + 0.044715f * gx * gx * gx))); }
                u32x4 qu, qg;
#pragma unroll
                for (int i = 0; i < 4; ++i) { qu[i] = pack_bf16(uu[2 * i], uu[2 * i + 1]); qg[i] = pack_bf16(gg[2 * i], gg[2 * i + 1]); }
                *(LAS u32x4*)(ub + tok * LDU + lane * 8) = qu;
                *(u32x4*)((bf16_t*)EARR(E_GATE) + (size_t)row * 512 + lane * 8) = qg;
            }
        }
        __syncthreads();
#pragma unroll 1
        for (int d = 0; d < 2; ++d) {
            {
                bf16x8 bw[4][2]; load_b<2>(WLT + WLT_WB + (size_t)(d * 512 + wid * 64) * 64, bw, lane);
                float w0v[4];
#pragma unroll
                for (int nt = 0; nt < 4; ++nt) w0v[nt] = p.in[I_AW0][d * 512 + wid * 64 + nt * 16 + fr];
#pragma unroll 1
                for (int mt = 0; mt < 5; ++mt) {
                    f32x4 acc[4]; mma_mt<2>(linb + d * 64, LDL, mt, bw, acc, lane);
#pragma unroll
                    for (int r = 0; r < 4; ++r) { const int tok = mt * 16 + fq * 4 + r;
                        if (tok < 68) { float* rec = (float*)sc_rec(SC, d, even_tok_row(w, tok), wid) + fr;
#pragma unroll
                            for (int nt = 0; nt < 4; ++nt) rec[nt * 16] = -0.60653065971263342f * sigm(w0v[nt] + acc[nt][r]);   } }
                }
            }
            {
                bf16x8 bw[4][2]; load_b<2>(WLT + WLT_AB + (size_t)(d * 512 + wid * 64) * 64, bw, lane);
                float a0v[4], kav[4], mukv[4], kkcv[4];
#pragma unroll
                for (int nt = 0; nt < 4; ++nt) { const int n = wid * 64 + nt * 16 + fr; a0v[nt] = p.in[I_AA0][d * 512 + n]; kav[nt] = p.in[I_AKA][n]; mukv[nt] = mu[512 + n]; kkcv[nt] = p.in[I_AKK][n]; }
#pragma unroll 1
                for (int mt = 0; mt < 5; ++mt) {
                    f32x4 acc[4]; mma_mt<2>(linb + 128 + d * 64, LDL, mt, bw, acc, lane);
                    float pkv[4][4], skv[4][4];
#pragma unroll
                    for (int r = 0; r < 4; ++r) { const int tok = mt * 16 + fq * 4 + r, row = even_tok_row(w, tok < 68 ? tok : 0);
#pragma unroll
                        for (int nt = 0; nt < 4; ++nt) { const int n = wid * 64 + nt * 16 + fr, nb = shift_nb(row, n);
                            pkv[r][nt] = bf2f(P[(size_t)row * LDP0 + 512 + n]); skv[r][nt] = nb >= 0 ? bf2f(P[(size_t)nb * LDP0 + 512 + n]) : 0.f; } }
#pragma unroll
                    for (int r = 0; r < 4; ++r) { const int tok = mt * 16 + fq * 4 + r;
                        if (tok < 68) { bf16_t* rec = sc_rec(SC, d, even_tok_row(w, tok), wid) + fr; const float rn = rnorm[tok * 8 + wid];
#pragma unroll
                            for (int nt = 0; nt < 4; ++nt) { const float a = sigm(a0v[nt] + acc[nt][r]);
                                const float zk = pkv[r][nt] + (skv[r][nt] - pkv[r][nt]) * mukv[nt];
                                rec[192 + nt * 16] = f2bf(zk * (1.0f + (a - 1.0f) * kav[nt])); rec[256 + nt * 16] = f2bf(zk * kkcv[nt] * rn * a); } } }
                }
            }
        }
        {
            bf16x8 bw[4][4]; load_b<4>(WLT + WLT_GB + (size_t)(wid * 64) * 128, bw, lane);
            bf16_t* G = (bf16_t*)EARR(E_G);
#pragma unroll 1
            for (int mt = 0; mt < 5; ++mt) {
                f32x4 acc[4]; mma_mt<4>(linb + 256, LDL, mt, bw, acc, lane);
#pragma unroll
                for (int r = 0; r < 4; ++r) { const int tok = mt * 16 + fq * 4 + r;
                    if (tok < 68) { bf16_t* gp = G + (size_t)even_tok_row(w, tok) * 512 + wid * 64 + fr;
#pragma unroll
                        for (int nt = 0; nt < 4; ++nt) gp[nt * 16] = f2bf(acc[nt][r]); } }
            }
        }
#pragma unroll 1
        for (int d = 0; d < 2; ++d) {
            bf16x8 b0[4][2];
            load_b<2>(WLT + WLT_GW + (size_t)(((d * 2 + 0) * 8 + wid) * 64) * 64, b0, lane);
            float gb0[4], gb1[4], spl[4];
#pragma unroll
            for (int nt = 0; nt < 4; ++nt) { const int n = wid * 64 + nt * 16 + fr; gb0[nt] = p.in[I_BGB][(d * 2 + 0) * 512 + n]; gb1[nt] = p.in[I_BGB][(d * 2 + 1) * 512 + n]; spl[nt] = softplusf(-p.in[I_BLAM][d * 512 + n]); }
            float* Ad = EARR(E_A0 + d); float* BXd = EARR(E_BX0 + d);
#pragma unroll 1
            for (int mt = 0; mt < 5; ++mt) {
                f32x4 la[4], acc[4];
                mma_mt<2>(ub + wid * 64, LDU, mt, b0, la, lane);
                { bf16x8 b1[4][2]; load_b<2>(WLT + WLT_GW + (size_t)(((d * 2 + 1) * 8 + wid) * 64) * 64, b1, lane); mma_mt<2>(ub + wid * 64, LDU, mt, b1, acc, lane); }
#pragma unroll
                for (int r = 0; r < 4; ++r) { const int tok = mt * 16 + fq * 4 + r;
                    if (tok < 68) { const size_t o = (size_t)even_tok_row(w, tok) * 512 + wid * 64 + fr;
#pragma unroll
                        for (int nt = 0; nt < 4; ++nt) { const float lg = -8.0f * sigm(gb0[nt] + la[nt][r]) * spl[nt];
                            const float av = fexp(lg); Ad[o + nt * 16] = av; BXd[o + nt * 16] = fsqrt(fmaxf(1.0f - av * av, 0.f)) * sigm(gb1[nt] + acc[nt][r]) * bf2f(ub[tok * LDU + wid * 64 + nt * 16 + fr]);         } } }
            }
        }
        __syncthreads();
        {
            const float rk = p.in[I_ARK][c];
#pragma unroll 1
            for (int t0 = 0; t0 < 68; t0 += 17) {
                float a[17], b0[17], b1[17];
#pragma unroll
                for (int u = 0; u < 17; ++u) { const int row = even_tok_row(w, t0 + u); const bf16_t* r0 = sc_rec(SC, 0, row, wid) + lane; const bf16_t* r1 = sc_rec(SC, 1, row, wid) + lane;
                    a[u] = bf2f(r0[320]); b0[u] = bf2f(r0[192]); b1[u] = bf2f(r1[192]); }
#pragma unroll
                for (int u = 0; u < 17; ++u) { const float sm = wave_sum(a[u] * (b0[u] + b1[u]) * rk); if (lane == 0) BC[even_tok_row(w, t0 + u) * 8 + wid] = sm; }
            }
        }
#pragma unroll 1
        for (int d = 0; d < 2; ++d) {
            float* Ad = EARR(E_A0 + d); float* BXd = EARR(E_BX0 + d);
            float h = 0.f, cum = 1.f;
#pragma unroll 1
            for (int n0 = 0; n0 < 64; n0 += 16) {
                float av[16], bv[16];
#pragma unroll
                for (int i = 0; i < 16; ++i) { const int tok = d == 0 ? n0 + i : 63 - n0 - i; const size_t o = (size_t)even_tok_row(w, tok) * 512 + c; av[i] = Ad[o]; bv[i] = BXd[o]; }
#pragma unroll
                for (int i = 0; i < 16; ++i) { const int tok = d == 0 ? n0 + i : 63 - n0 - i; const size_t o = (size_t)even_tok_row(w, tok) * 512 + c;
                    h = av[i] * h + bv[i]; cum *= av[i]; Ad[o] = cum; BXd[o] = h; }
            }
            { const int cid = (w >> 6) * 128 + 64 + (w & 63); CHA[(size_t)(d * 512 + cid) * 512 + c] = cum; CHH[(size_t)(d * 512 + cid) * 512 + c] = h; }
            h = 0.f; cum = 1.f;
#pragma unroll
            for (int i = 0; i < 4; ++i) { const int tok = 64 + (d == 0 ? i : 3 - i); const size_t o = (size_t)even_tok_row(w, tok) * 512 + c;
                const float a = Ad[o], bx = BXd[o]; h = a * h + bx; cum *= a; Ad[o] = cum; BXd[o] = h; }
            { const int cid = (w >> 6) * 128 + (w & 63); CHA[(size_t)(d * 512 + cid) * 512 + c] = cum; CHH[(size_t)(d * 512 + cid) * 512 + c] = h; }
        }
        __syncthreads();
    }
}
__device__ __forceinline__ float vfma(float a, float b, float c) { float d; asm("v_fma_f32 %0, %1, %2, %3" : "=v"(d) : "v"(a), "v"(b), "v"(c)); return d; }
__device__ __forceinline__ float vmul(float a, float b) { float d; asm("v_mul_f32 %0, %1, %2" : "=v"(d) : "v"(a), "v"(b)); return d; }
#define WG_BAR() do { asm volatile("" ::: "memory"); __builtin_amdgcn_s_barrier(); asm volatile("" ::: "memory"); } while (0)
__device__ __forceinline__ int scan_row(int d, int b, int q) {
    if (q < 256) return b * 256 + (d ? 255 - q : q);
    const int s = q - 256; return NCTX + b * 4096 + (d ? 4095 - s : s);
}
__device__ __forceinline__ void ph_fin_even(const Params& p, int bid, int nblk) {
    const int tid = threadIdx.x, wid = tid >> 6, c = tid;
    float* EA = (float*)(p.ws + WS_EARR);
    float* SC = (float*)(p.ws + WS_SC);
    const float* BC = (const float*)(p.ws + WS_BC); const float* CIN = (const float*)(p.ws + WS_CIN);
    bf16_t* Y = (bf16_t*)(p.ws + WS_YMIX);
    const float gg = p.in[I_AGNG][c], gb = p.in[I_AGNB][c];
    for (int r0 = bid * 4; r0 < MROWS; r0 += nblk * 4) {
        float o0[4], o1[4], vv[4], gv[4], bc[4], x0[4], x1[4], a0[4], a1[4], c0[4], c1[4], gt[4];
#pragma unroll
        for (int u = 0; u < 4; ++u) { const int row = r0 + u; const size_t o = (size_t)row * 512 + c;
            const int cid = row < NCTX ? (row >> 8) * 128 + ((row >> 2) & 63) : ((row - NCTX) >> 12) * 128 + 64 + (((row - NCTX) & 4095) >> 6);
            o0[u] = bf2f(((const bf16_t*)EARR(E_O0))[o]); o1[u] = bf2f(((const bf16_t*)EARR(E_O1))[o]); vv[u] = bf2f(sc_rec(SC, 0, row, wid)[384 + (tid & 63)]); gv[u] = bf2f(((const bf16_t*)EARR(E_G))[o]); bc[u] = BC[row * 8 + wid];
            x0[u] = EARR(E_BX0)[o]; x1[u] = EARR(E_BX1)[o]; a0[u] = EARR(E_A0)[o]; a1[u] = EARR(E_A1)[o];
            c0[u] = CIN[(size_t)cid * 512 + c]; c1[u] = CIN[(size_t)(512 + cid) * 512 + c]; gt[u] = bf2f(((const bf16_t*)EARR(E_GATE))[o]); }
#pragma unroll
        for (int u = 0; u < 4; ++u) { const int row = r0 + u;
            const float wkv = o0[u] + o1[u];
            const float mean = wave_sum(wkv) * (1.0f / 64.0f), dv = wkv - mean, var = wave_sum(dv * dv) * (1.0f / 64.0f);
            const float y = (dv * rsqrtf(var + 64e-5f) * gg + gb + bc[u] * vv[u]) * gv[u];
            Y[(size_t)row * 1024 + c] = f2bf(y);
            Y[(size_t)row * 1024 + 512 + c] = f2bf(((x0[u] + a0[u] * c0[u]) + (x1[u] + a1[u] * c1[u])) * gt[u]); }
    }
#undef EARR
}
constexpr int LDT = 72;
__device__ __forceinline__ float quad_sum(float v) {
    v += __int_as_float(__builtin_amdgcn_update_dpp(0, __float_as_int(v), 0xB1, 0xf, 0xf, false));
    v += __int_as_float(__builtin_amdgcn_update_dpp(0, __float_as_int(v), 0x4E, 0xf, 0xf, false));
    return v;
}
template <int PO> __device__ __forceinline__ float quad_bcast(float v) { return __int_as_float(__builtin_amdgcn_update_dpp(0, __float_as_int(v), PO * 0x55, 0xf, 0xf, false)); }
__device__ __forceinline__ bf16x8 ldt8(const LAS bf16_t* T, int row, int col) { return *(const LAS bf16x8*)(T + row * LDT + col); }
__device__ __forceinline__ void ph_r1(const Params& p, LAS unsigned char* lds, int bid, int nblk) {
    const int tid = threadIdx.x, wid = tid >> 6, lane = tid & 63, fr = lane & 15, fq = lane >> 4;
    LAS bf16_t* T0 = (LAS bf16_t*)(lds + LDS_WORK);
#define TL(i) (T0 + (i) * 64 * LDT)
    LAS float* F0 = (LAS float*)(T0 + 11 * 64 * LDT);
    LAS float* F1 = F0 + 4096;
    LAS float* F2 = F1 + 4096;
    LAS float* segt = F2 + 4096;
    LAS float* gl = segt + 512;
    const float* SC = (const float*)(p.ws + WS_SC);
    float* RU = (float*)(p.ws + WS_RU);
    const int k = tid & 63, seg = tid >> 6, t0 = seg * 8;
    const int tr = (wid >> 1) * 16, tc0 = (wid & 1) * 32;
    float kk[8], lw[8], kd[8], ka[8], rr[8], vv[8];
    auto fetch = [&](int unit) {
        const int chain = unit / NRCH, c = unit - chain * NRCH;
        const bf16_t* rec = (const bf16_t*)SC + ((size_t)chain * SCLEN + c * RCH + t0) * SCREC + k;
#pragma unroll
        for (int u = 0; u < 8; ++u) { const bf16_t* r = rec + u * SCREC; lw[u] = ((const float*)(r - k))[k]; kk[u] = bf2f(r[128]); kd[u] = bf2f(r[192]); ka[u] = bf2f(r[256]); rr[u] = bf2f(r[320]); vv[u] = bf2f(r[384]); }
    };
    if (bid < NRUNIT) fetch(bid);
    for (int unit = bid; unit < NRUNIT; unit += nblk) {
        float cum[8]; { float run = 0.f;
#pragma unroll
            for (int u = 0; u < 8; ++u) { run += lw[u]; cum[u] = run; }
            segt[seg * 64 + k] = run; }
        __syncthreads();
        float off = 0.f, tot = 0.f;
#pragma unroll
        for (int s2 = 0; s2 < 8; ++s2) { const float v = segt[s2 * 64 + k]; off += s2 < seg ? v : 0.f; tot += v; }
        if (seg == 0) gl[k] = fexp(tot);
        {
            u32x4 wk, wb, wv; unsigned pk[4], pb[4], pv[4]; float hk = 0.f, hb = 0.f, hv = 0.f;
#pragma unroll
            for (int u = 0; u < 8; ++u) { const int t = t0 + u; const float cu = cum[u] + off;
                const float ginc = fexp(cu), gexc = fexp(cu - lw[u]), ginv = fexp(-cu), gtail = fexp(tot - cu);
                const float kt = kk[u] * gexc;
                TL(0)[t * LDT + k] = f2bf(kt); F0[t * 64 + k] = kt;
                TL(1)[t * LDT + k] = f2bf(kd[u] * ginv); TL(2)[t * LDT + k] = f2bf(ka[u] * ginv); TL(3)[t * LDT + k] = f2bf(rr[u] * ginc);
                const float ktl = kd[u] * gtail, btl = ka[u] * gtail;
                if (u & 1) { pk[u >> 1] = pack_bf16(hk, ktl); pb[u >> 1] = pack_bf16(hb, btl); pv[u >> 1] = pack_bf16(hv, vv[u]); } else { hk = ktl; hb = btl; hv = vv[u]; } }
            wk.x = pk[0]; wk.y = pk[1]; wk.z = pk[2]; wk.w = pk[3]; wb.x = pb[0]; wb.y = pb[1]; wb.z = pb[2]; wb.w = pb[3]; wv.x = pv[0]; wv.y = pv[1]; wv.z = pv[2]; wv.w = pv[3];
            *(LAS u32x4*)(TL(4) + k * LDT + t0) = wk; *(LAS u32x4*)(TL(5) + k * LDT + t0) = wb; *(LAS u32x4*)(TL(6) + k * LDT + t0) = wv;
        }
        if (unit + nblk < NRUNIT) fetch(unit + nblk);
        __syncthreads();
        {
            f32x4 mk[2], mb[2], ak[2], ab[2];
#pragma unroll
            for (int nt = 0; nt < 2; ++nt) { mk[nt] = (f32x4){0.f, 0.f, 0.f, 0.f}; mb[nt] = mk[nt]; ak[nt] = mk[nt]; ab[nt] = mk[nt]; }
#pragma unroll
            for (int ks = 0; ks < 2; ++ks) { const bf16x8 aK = ldt8(TL(0), tr + fr, ks * 32 + fq * 8), aR = ldt8(TL(3), tr + fr, ks * 32 + fq * 8);
#pragma unroll
                for (int nt = 0; nt < 2; ++nt) { const bf16x8 bK = ldt8(TL(1), tc0 + nt * 16 + fr, ks * 32 + fq * 8), bB = ldt8(TL(2), tc0 + nt * 16 + fr, ks * 32 + fq * 8);
                    mk[nt] = __builtin_amdgcn_mfma_f32_16x16x32_bf16(aK, bK, mk[nt], 0, 0, 0); mb[nt] = __builtin_amdgcn_mfma_f32_16x16x32_bf16(aK, bB, mb[nt], 0, 0, 0);
                    ak[nt] = __builtin_amdgcn_mfma_f32_16x16x32_bf16(aR, bK, ak[nt], 0, 0, 0); ab[nt] = __builtin_amdgcn_mfma_f32_16x16x32_bf16(aR, bB, ab[nt], 0, 0, 0); } }
#pragma unroll
            for (int nt = 0; nt < 2; ++nt)
#pragma unroll
                for (int r = 0; r < 4; ++r) { const int t = tr + fq * 4 + r, j = tc0 + nt * 16 + fr;
                    TL(7)[t * LDT + j] = f2bf(j < t ? mk[nt][r] : 0.f); F1[j * 64 + (t & 3) * 16 + (t >> 2)] = j < t ? mb[nt][r] : 0.f;
                    TL(8)[t * LDT + j] = f2bf(j <= t ? ak[nt][r] : 0.f); TL(9)[t * LDT + j] = f2bf(j <= t ? ab[nt][r] : 0.f); }
        }
        __syncthreads();
        {
            f32x4 acc[2] = {(f32x4){0.f, 0.f, 0.f, 0.f}, (f32x4){0.f, 0.f, 0.f, 0.f}};
#pragma unroll
            for (int ks = 0; ks < 2; ++ks) { const bf16x8 a = ldt8(TL(7), tr + fr, ks * 32 + fq * 8);
#pragma unroll
                for (int nt = 0; nt < 2; ++nt) acc[nt] = __builtin_amdgcn_mfma_f32_16x16x32_bf16(a, ldt8(TL(6), tc0 + nt * 16 + fr, ks * 32 + fq * 8), acc[nt], 0, 0, 0); }
#pragma unroll
            for (int nt = 0; nt < 2; ++nt)
#pragma unroll
                for (int r = 0; r < 4; ++r) F2[(tr + fq * 4 + r) * 64 + tc0 + nt * 16 + fr] = acc[nt][r];
        }
        __syncthreads();
        {
            const int col = tid >> 2, part = tid & 3;
            f32x2 acc2[8]; float x[16];
#pragma unroll
            for (int q = 0; q < 16; ++q) { const int t = 4 * q + part; acc2[q >> 1][q & 1] = col < 64 ? F0[t * 64 + col] : F2[t * 64 + col - 64]; x[q] = 0.f; }
#pragma unroll
            for (int t = 0; t < 64; ++t) {
                const int qo = t >> 2, po = t & 3; const float aq = acc2[qo >> 1][qo & 1];
                const float xt = po == 0 ? quad_bcast<0>(aq) : po == 1 ? quad_bcast<1>(aq) : po == 2 ? quad_bcast<2>(aq) : quad_bcast<3>(aq);
                x[qo] = part == po ? xt : x[qo];
                const f32x2 nx = {-xt, -xt};
#pragma unroll
                for (int q4 = qo >> 2; q4 < 4; ++q4) { const f32x4 m = *(const LAS f32x4*)(F1 + t * 64 + part * 16 + q4 * 4);
                    acc2[q4 * 2] = (f32x2){m[0], m[1]} * nx + acc2[q4 * 2]; acc2[q4 * 2 + 1] = (f32x2){m[2], m[3]} * nx + acc2[q4 * 2 + 1]; }
            }
            LAS bf16_t* dstT = col < 64 ? TL(7) + col * LDT : TL(10) + (col - 64) * LDT;
#pragma unroll
            for (int q = 0; q < 16; ++q) dstT[4 * q + part] = f2bf(-x[q]);
        }
        __syncthreads();
        {
            f32x4 rh[2], ol[2], pm[2], qq[2];
#pragma unroll
            for (int nt = 0; nt < 2; ++nt) { rh[nt] = (f32x4){0.f, 0.f, 0.f, 0.f}; ol[nt] = rh[nt]; pm[nt] = rh[nt]; qq[nt] = rh[nt]; }
#pragma unroll
            for (int ks = 0; ks < 2; ++ks) { const int kc = ks * 32 + fq * 8;
                const bf16x8 a7 = ldt8(TL(7), tr + fr, kc), a8 = ldt8(TL(8), tr + fr, kc), a9 = ldt8(TL(9), tr + fr, kc), a6 = ldt8(TL(6), tr + fr, kc), a10 = ldt8(TL(10), tr + fr, kc);
#pragma unroll
                for (int nt = 0; nt < 2; ++nt) { const int br = tc0 + nt * 16 + fr;
                    const bf16x8 b9 = ldt8(TL(9), br, kc), b6 = ldt8(TL(6), br, kc), b10 = ldt8(TL(10), br, kc), b5 = ldt8(TL(5), br, kc), b4 = ldt8(TL(4), br, kc);
                    rh[nt] = __builtin_amdgcn_mfma_f32_16x16x32_bf16(a7, b9, rh[nt], 0, 0, 0);
                    ol[nt] = __builtin_amdgcn_mfma_f32_16x16x32_bf16(a8, b6, ol[nt], 0, 0, 0); ol[nt] = __builtin_amdgcn_mfma_f32_16x16x32_bf16(a9, b10, ol[nt], 0, 0, 0);
                    pm[nt] = __builtin_amdgcn_mfma_f32_16x16x32_bf16(a7, b5, pm[nt], 0, 0, 0);
                    qq[nt] = __builtin_amdgcn_mfma_f32_16x16x32_bf16(a6, b4, qq[nt], 0, 0, 0); qq[nt] = __builtin_amdgcn_mfma_f32_16x16x32_bf16(a10, b5, qq[nt], 0, 0, 0); } }
            float* U = RU + (size_t)unit * 4 * 4096;
#pragma unroll
            for (int nt = 0; nt < 2; ++nt)
#pragma unroll
                for (int r = 0; r < 4; ++r) { const int row = tr + fq * 4 + r, cx = tc0 + nt * 16 + fr; const int o = row * 64 + cx;
                    U[o] = pm[nt][r] + (row == cx ? gl[row] : 0.f);
                    U[4096 + o] = qq[nt][r];
                    U[8192 + o] = rh[nt][r] + bf2f(TL(3)[cx * LDT + row]);
                    U[12288 + o] = ol[nt][r]; }
        }
        __syncthreads();
    }
#undef TL
}
__device__ __forceinline__ void moe_weight_tiles(const Params& p, LAS unsigned char* lds, int first, int stride) {
    const int tid = threadIdx.x; unsigned char* ws = p.ws;
    LAS float* tile = (LAS float*)(lds + LDS_WORK);
    const int j4 = (tid & 31) * 4, i0 = tid >> 5;
    auto decode = [&](int tt, const float*& src, int& ld, int& k0, int& n0, int& w1map, bf16_t*& dst) {
        if (tt < 8192) { const int mat = tt >> 7, r = tt & 127; k0 = (r >> 4) * 128; n0 = (r & 15) * 128; src = p.in[I_W1] + (size_t)mat * 1024 * 2048; ld = 2048; dst = (bf16_t*)(ws + WS_W1T) + (size_t)mat * 2048 * 1024; w1map = 1; }
        else { tt -= 8192; const int mat = tt >> 6, r = tt & 63; k0 = (r >> 3) * 128; n0 = (r & 7) * 128; src = p.in[I_W2] + (size_t)mat * 1024 * 1024; ld = 1024; dst = (bf16_t*)(ws + WS_W2T) + (size_t)mat * 1024 * 1024; w1map = 0; }
    };
    f32x4 v[8];
    if (first < 12288) { const float* src; int ld, k0, n0, w1; bf16_t* dst; decode(first, src, ld, k0, n0, w1, dst);
#pragma unroll
        for (int r = 0; r < 8; ++r) v[r] = __builtin_nontemporal_load((const f32x4*)(src + (size_t)(k0 + i0 + 16 * r) * ld + n0 + j4)); }
    for (int t = first; t < 12288; t += stride) {
        const float* src; int ld, k0, n0, w1map; bf16_t* dst; decode(t, src, ld, k0, n0, w1map, dst);
#pragma unroll
        for (int r = 0; r < 8; ++r) { LAS float* tp = tile + (i0 + 16 * r) * 129 + j4; tp[0] = v[r][0]; tp[1] = v[r][1]; tp[2] = v[r][2]; tp[3] = v[r][3]; }
        __syncthreads();
        if (t + stride < 12288) { const float* s2; int ld2, k2, n2, w2; bf16_t* d2; decode(t + stride, s2, ld2, k2, n2, w2, d2);
#pragma unroll
            for (int r = 0; r < 8; ++r) v[r] = __builtin_nontemporal_load((const f32x4*)(s2 + (size_t)(k2 + i0 + 16 * r) * ld2 + n2 + j4)); }
        { const int ip = (tid & 15) * 8, j0 = tid >> 4;
            const int rho0 = w1map ? ((((n0 & 1023) >> 7) << 8) + ((n0 >> 10) << 7)) : n0;
#pragma unroll
            for (int r = 0; r < 4; ++r) { const int j = j0 + 32 * r;
                u32x4 w; w.x = pack_bf16(tile[ip * 129 + j], tile[(ip + 1) * 129 + j]); w.y = pack_bf16(tile[(ip + 2) * 129 + j], tile[(ip + 3) * 129 + j]);
                w.z = pack_bf16(tile[(ip + 4) * 129 + j], tile[(ip + 5) * 129 + j]); w.w = pack_bf16(tile[(ip + 6) * 129 + j], tile[(ip + 7) * 129 + j]);
                const int rho = rho0 + j, kk8 = k0 + ip; *(u32x4*)(dst + ((size_t)((rho >> 8) * 16 + (kk8 >> 6)) * 256 + (rho & 255)) * 64 + (kk8 & 63)) = w; } }
        __syncthreads();
    }
}
__device__ __forceinline__ void ph_r2(const Params& p, LAS unsigned char* lds, int bid, int nblk) {
    const int tid = threadIdx.x, wid = tid >> 6, lane = tid & 63, fr = lane & 15, g = lane >> 4;
    const int nchainwg = nblk >= 128 ? 64 : 0;
    if (bid >= nchainwg) {
        const int nconv = nblk - nchainwg, cb = bid - nchainwg;
        if (tid < 256) {
            const float* CHA = (const float*)(p.ws + WS_CHA); const float* CHH = (const float*)(p.ws + WS_CHH); float* CIN = (float*)(p.ws + WS_CIN);
            for (int item = cb; item < 16; item += nconv) {
                const int gi = item * 256 + tid, d = gi >> 11, b = (gi >> 9) & 3, c = gi & 511;
                float carry = 0.f;
                for (int s0 = 0; s0 < 128; s0 += 16) {
                    float av[16], hv[16];
#pragma unroll
                    for (int q = 0; q < 16; ++q) { const int st = s0 + q; const int cl = d == 0 ? st : (st < 64 ? 63 - st : 191 - st);
                        const size_t o = (size_t)(d * 512 + b * 128 + cl) * 512 + c; av[q] = CHA[o]; hv[q] = CHH[o]; }
#pragma unroll
                    for (int q = 0; q < 16; ++q) { const int st = s0 + q; const int cl = d == 0 ? st : (st < 64 ? 63 - st : 191 - st);
                        CIN[(size_t)(d * 512 + b * 128 + cl) * 512 + c] = carry; carry = av[q] * carry + hv[q]; }
                }
            }
        }
        __syncthreads();
        moe_weight_tiles(p, lds, cb, nconv);
        if (nchainwg) return;
    }
    LAS float* ring = (LAS float*)(lds + LDS_WORK);
    const float* RU = (const float*)(p.ws + WS_RU);
    float* EA = (float*)(p.ws + WS_EARR);
    for (int chain = nchainwg ? bid : bid; chain < 64; chain += (nchainwg ? 64 : nblk)) {
        const int d = chain >> 5, b = (chain >> 3) & 3, h = chain & 7;
        bf16_t* Od = (bf16_t*)(EA + (size_t)(E_O0 + d) * ((size_t)MROWS * 512));
        auto issue = [&](int c) {
            const float* src = RU + ((size_t)chain * NRCH + c) * 4 * 4096; LAS float* dst = ring + (c & 1) * 4 * 4096;
#pragma unroll
            for (int i = 0; i < 16; ++i) { const int slot = ((wid - 4) * 16 + i) * 64;
                __builtin_amdgcn_global_load_lds((const unsigned*)(src + (size_t)(slot + lane) * 4), (LAS unsigned*)(dst + slot * 4), 16, 0, 0); }
        };
        if (tid >= 256) { issue(0); asm volatile("s_waitcnt vmcnt(0)" ::: "memory"); }
        asm volatile("" ::: "memory"); __builtin_amdgcn_s_barrier(); asm volatile("" ::: "memory");
        f32x4 S[4];
#pragma unroll
        for (int m = 0; m < 4; ++m) S[m] = (f32x4){0.f, 0.f, 0.f, 0.f};
        const int v0 = wid * 16;
        for (int c = 0; c < NRCH; ++c) {
            if (tid >= 256) { if (c + 1 < NRCH) issue(c + 1); asm volatile("s_waitcnt vmcnt(0)" ::: "memory"); }
            else {
                const LAS float* PM = ring + (c & 1) * 4 * 4096; const LAS float* QQ = PM + 4096; const LAS float* RHT = PM + 8192; const LAS float* OL = PM + 12288;
                f32x4 acc[4], Sn[4];
#pragma unroll
                for (int tt = 0; tt < 4; ++tt) {
#pragma unroll
                    for (int i = 0; i < 4; ++i) acc[tt][i] = OL[(16 * tt + 4 * g + i) * 64 + v0 + fr];
                    Sn[tt] = *(const LAS f32x4*)(QQ + (v0 + fr) * 64 + 16 * tt + 4 * g); }
                float A[3][4];
#pragma unroll
                for (int s0 = 0; s0 < 2; ++s0) { const LAS float* ar = RHT + (16 * (s0 >> 2) + 4 * g + (s0 & 3)) * 64 + fr;
#pragma unroll
                    for (int u = 0; u < 4; ++u) A[s0][u] = ar[16 * u]; }
#pragma unroll
                for (int st = 0; st < 32; ++st) {
                    if (st + 2 < 32) { const int s2 = st + 2, mi = s2 & 15; const LAS float* ar = (s2 < 16 ? RHT : PM) + (16 * (mi >> 2) + 4 * g + (mi & 3)) * 64 + fr;
#pragma unroll
                        for (int u = 0; u < 4; ++u) A[s2 % 3][u] = ar[16 * u]; }
                    __builtin_amdgcn_sched_barrier(0);
                    const int mi = st & 15; const float bq = S[mi >> 2][mi & 3];
                    if (st < 16) {
#pragma unroll
                        for (int u = 0; u < 4; ++u) acc[u] = __builtin_amdgcn_mfma_f32_16x16x4f32(A[st % 3][u], bq, acc[u], 0, 0, 0);
                    } else {
#pragma unroll
                        for (int u = 0; u < 4; ++u) Sn[u] = __builtin_amdgcn_mfma_f32_16x16x4f32(A[st % 3][u], bq, Sn[u], 0, 0, 0);
                    }
                }
#pragma unroll
                for (int tt = 0; tt < 4; ++tt)
#pragma unroll
                    for (int i = 0; i < 4; ++i) { const int row = scan_row(d, b, c * RCH + 16 * tt + 4 * g + i); Od[(size_t)row * 512 + h * 64 + v0 + fr] = f2bf(acc[tt][i]); }
#pragma unroll
                for (int m = 0; m < 4; ++m) S[m] = Sn[m];
                asm volatile("s_waitcnt lgkmcnt(0)" ::: "memory");
            }
            asm volatile("" ::: "memory"); __builtin_amdgcn_s_barrier(); asm volatile("" ::: "memory");
        }
    }
}
__device__ __forceinline__ float half_max(float v, int lane) {
    const int ninf = 0xff800000;
    v = fmaxf(v, __int_as_float(__builtin_amdgcn_update_dpp(ninf, __float_as_int(v), 0x121, 0xf, 0xf, false)));
    v = fmaxf(v, __int_as_float(__builtin_amdgcn_update_dpp(ninf, __float_as_int(v), 0x122, 0xf, 0xf, false)));
    v = fmaxf(v, __int_as_float(__builtin_amdgcn_update_dpp(ninf, __float_as_int(v), 0x124, 0xf, 0xf, false)));
    v = fmaxf(v, __int_as_float(__builtin_amdgcn_update_dpp(ninf, __float_as_int(v), 0x128, 0xf, 0xf, false)));
    v = fmaxf(v, __int_as_float(__builtin_amdgcn_update_dpp(ninf, __float_as_int(v), 0x142, 0xa, 0xf, false)));
    const float lo = __int_as_float(__builtin_amdgcn_readlane(__float_as_int(v), 31)), hi = __int_as_float(__builtin_amdgcn_readlane(__float_as_int(v), 63));
    return (lane & 32) ? hi : lo;
}
__device__ __forceinline__ int half_min_i(int v, int lane) {
    const int big = 0x7fffffff;
    v = min(v, __builtin_amdgcn_update_dpp(big, v, 0x121, 0xf, 0xf, false));
    v = min(v, __builtin_amdgcn_update_dpp(big, v, 0x122, 0xf, 0xf, false));
    v = min(v, __builtin_amdgcn_update_dpp(big, v, 0x124, 0xf, 0xf, false));
    v = min(v, __builtin_amdgcn_update_dpp(big, v, 0x128, 0xf, 0xf, false));
    v = min(v, __builtin_amdgcn_update_dpp(big, v, 0x142, 0xa, 0xf, false));
    const int lo = __builtin_amdgcn_readlane(v, 31), hi = __builtin_amdgcn_readlane(v, 63);
    return (lane & 32) ? hi : lo;
}
template <int LAYER>
__device__ __forceinline__ void ph_ln1(const Params& p, LAS unsigned char* lds, int bid, int nblk) {
    const int tid = threadIdx.x, wid = tid >> 6, lane = tid & 63, fr = lane & 15, fq = lane >> 4;
    LAS float* vb = (LAS float*)(lds + LDS_WORK);
    LAS float* part = vb + 16 * 1028;
    LAS int* lcnt = (LAS int*)(part + 8 * 16 * 32);
    float rwf[2][32];
    { const float* rw = p.in[I_RW] + (size_t)LAYER * 32768 + (size_t)(128 * wid + 32 * fq) * 32 + fr;
#pragma unroll
        for (int s2 = 0; s2 < 32; ++s2) { rwf[0][s2] = rw[s2 * 32]; rwf[1][s2] = rw[s2 * 32 + 16]; } }
    if (tid < 32) lcnt[tid] = 0;
    __syncthreads();
    const float* MOD = (const float*)(p.ws + WS_MOD);
    bf16_t* XS = (bf16_t*)(p.ws + WS_XS); const bf16_t* YP = (const bf16_t*)(p.ws + WS_YP); bf16_t* H = (bf16_t*)(p.ws + WS_H);
    int* TOPE = (int*)(p.ws + WS_TOPE); float* TOPW = (float*)(p.ws + WS_TOPW); int* TOPS = (int*)(p.ws + WS_TOPS);
    int* CNTB = (int*)(p.ws + WS_CNTB) + (size_t)(LAYER * 512 + bid) * 32;
    const float* lng = p.in[I_LNG] + (LAYER * 2 + 0) * 1024; const float* lnb = p.in[I_LNB] + (LAYER * 2 + 0) * 1024;
    const int rstride = nblk * 8, rbase = (LAYER == 0 ? 0 : NCTX) + bid * 8;
    f32x4 nres[4], ngate[4]; u32x2 nyp[4];
    auto fetch = [&](int row) {
        const float* res = row < NCTX ? p.in[I_CTX] + (size_t)row * 1024 : p.in[I_X] + (size_t)(row - NCTX) * 1024;
        const float* md = MOD + (size_t)(LAYER * 5 + row_modr(row)) * 6144;
#pragma unroll
        for (int q = 0; q < 4; ++q) { const int col = q * 256 + lane * 4; nres[q] = LAYER == 0 ? *(const f32x4*)(res + col) : ld_bf16x4(XS + (size_t)row * 1024 + col);
            ngate[q] = *(const f32x4*)(md + 2048 + col); nyp[q] = *(const u32x2*)(YP + (size_t)row * 1024 + col); }
    };
    if (rbase < MROWS) fetch(rbase + wid);
#pragma unroll 1
    for (int j0 = 0; rbase + j0 * rstride < MROWS; j0 += 2) {
#pragma unroll 1
        for (int jj = 0; jj < 2; ++jj) {
            const int row = rbase + wid + (j0 + jj) * rstride;
            if (row >= MROWS) break;
            const float* md = MOD + (size_t)(LAYER * 5 + row_modr(row)) * 6144;
            f32x4 v[4], msc[4], msh[4]; float s = 0.f;
#pragma unroll
            for (int q = 0; q < 4; ++q) { const u32x2 w = nyp[q];
                const f32x4 y = (f32x4){__uint_as_float(w.x << 16), __uint_as_float(w.x & 0xffff0000u), __uint_as_float(w.y << 16), __uint_as_float(w.y & 0xffff0000u)};
                v[q] = nres[q] * DN_ALPHA + ngate[q] * y;
                s += (v[q][0] + v[q][1]) + (v[q][2] + v[q][3]); }
#pragma unroll
            for (int q = 0; q < 4; ++q) { const int col = q * 256 + lane * 4; msc[q] = *(const f32x4*)(md + 4096 + col); msh[q] = *(const f32x4*)(md + 3072 + col); }
            if (row + rstride < MROWS) fetch(row + rstride);
            const float mean = wave_sum(s) * (1.0f / 1024.0f);
            float ss = 0.f;
#pragma unroll
            for (int q = 0; q < 4; ++q) { v[q] = v[q] - mean; ss += (v[q][0] * v[q][0] + v[q][1] * v[q][1]) + (v[q][2] * v[q][2] + v[q][3] * v[q][3]); }
            const float rstd = rsqrtf(wave_sum(ss) * (1.0f / 1024.0f) + LN_EPS);
#pragma unroll
            for (int q = 0; q < 4; ++q) { const int col = q * 256 + lane * 4;
                const f32x4 xn = v[q] * rstd * *(const f32x4*)(lng + col) + *(const f32x4*)(lnb + col);
                { u32x2 wx; wx.x = pack_bf16(xn[0], xn[1]); wx.y = pack_bf16(xn[2], xn[3]); *(u32x2*)(XS + (size_t)row * 1024 + col) = wx; }
                v[q] = xn * (msc[q] + 1.0f) + msh[q];
                u32x2 w; w.x = pack_bf16(v[q][0], v[q][1]); w.y = pack_bf16(v[q][2], v[q][3]);
                *(u32x2*)(H + (size_t)row * 1024 + col) = w;
                *(LAS f32x4*)(vb + (wid + 8 * jj) * 1028 + col) = v[q]; }
        }
        __syncthreads();
        {
            const LAS float* ar = vb + fr * 1028 + 128 * wid + 32 * fq;
            f32x4 acc0 = {0.f, 0.f, 0.f, 0.f}, acc1 = {0.f, 0.f, 0.f, 0.f};
#pragma unroll
            for (int h = 0; h < 2; ++h) { f32x4 va[4];
#pragma unroll
                for (int u = 0; u < 4; ++u) va[u] = *(const LAS f32x4*)(ar + h * 16 + u * 4);
#pragma unroll
                for (int u = 0; u < 4; ++u)
#pragma unroll
                    for (int i = 0; i < 4; ++i) { acc0 = __builtin_amdgcn_mfma_f32_16x16x4f32(va[u][i], rwf[0][h * 16 + u * 4 + i], acc0, 0, 0, 0);
                        acc1 = __builtin_amdgcn_mfma_f32_16x16x4f32(va[u][i], rwf[1][h * 16 + u * 4 + i], acc1, 0, 0, 0); } }
            LAS float* pw = part + wid * 512 + (4 * fq) * 32 + fr;
#pragma unroll
            for (int i = 0; i < 4; ++i) { pw[i * 32] = acc0[i]; pw[i * 32 + 16] = acc1[i]; }
        }
        __syncthreads();
        {
            const int e = lane & 31, lr = 2 * wid + (lane >> 5), row = rbase + (lr & 7) + (j0 + (lr >> 3)) * rstride;
            float lg = p.in[I_RB][LAYER * 32 + e];
#pragma unroll
            for (int w2 = 0; w2 < 8; ++w2) lg += part[w2 * 512 + lr * 32 + e];
            float tv[4]; int te[4];
#pragma unroll
            for (int k = 0; k < 4; ++k) { const float bv = half_max(lg, lane); const int bi = half_min_i(lg == bv ? e : 99, lane);
                tv[k] = bv; te[k] = bi & 31; lg = e == bi ? -3.0e38f : lg; }
            const float e1 = expf(tv[1] - tv[0]), e2 = expf(tv[2] - tv[0]), e3 = expf(tv[3] - tv[0]), inv = 1.0f / (1.0f + e1 + e2 + e3);
            if (e == 0 && row < MROWS) {
                const float wv[4] = {inv, e1 * inv, e2 * inv, e3 * inv};
#pragma unroll
                for (int k = 0; k < 4; ++k) { const int slot = __hip_atomic_fetch_add(lcnt + te[k], 1, __ATOMIC_RELAXED, __HIP_MEMORY_SCOPE_WORKGROUP); TOPE[row * 4 + k] = te[k]; TOPW[row * 4 + k] = wv[k]; TOPS[row * 4 + k] = slot; }
            }
        }
    }
    __syncthreads();
    if (tid < 32) CNTB[tid] = lcnt[tid];
}
constexpr int LDS_TAB = LDS_WORK + 131072;
__device__ __forceinline__ int moe_tables(const int* cntb, int nblk, LAS int* tab, LAS int* bb) {
    const int tid = threadIdx.x, e = tid & 31, seg = tid >> 5, per = (nblk + 15) >> 4;
    const int b0 = seg * per, b1 = (b0 + per) < nblk ? (b0 + per) : nblk;
    int s = 0;
    if (per <= 16) {
        int cv[16];
#pragma unroll
        for (int u = 0; u < 16; ++u) cv[u] = (b0 + u) < b1 ? cntb[(b0 + u) * 32 + e] : 0;
#pragma unroll
        for (int u = 0; u < 16; ++u) s += cv[u];
        tab[512 + seg * 32 + e] = s;
        __syncthreads();
        if (tid < 32) { int run = 0; for (int sg = 0; sg < 16; ++sg) { const int v = tab[512 + sg * 32 + tid]; tab[512 + sg * 32 + tid] = run; run += v; } tab[448 + tid] = run; }
        __syncthreads();
        if (bb) { int run = tab[512 + seg * 32 + e];
#pragma unroll
            for (int u = 0; u < 16; ++u) if ((b0 + u) < b1) { bb[(b0 + u) * 32 + e] = run; run += cv[u]; } }
    } else {
        for (int b = b0; b < b1; ++b) s += cntb[b * 32 + e];
        tab[512 + seg * 32 + e] = s;
        __syncthreads();
        if (tid < 32) { int run = 0; for (int sg = 0; sg < 16; ++sg) { const int v = tab[512 + sg * 32 + tid]; tab[512 + sg * 32 + tid] = run; run += v; } tab[448 + tid] = run; }
        __syncthreads();
        if (bb) { int run = tab[512 + seg * 32 + e]; for (int b = b0; b < b1; ++b) { bb[b * 32 + e] = run; run += cntb[b * 32 + e]; } }
    }
    if (tid < 64) {
        const int x = tid & 31, n = (tab[448 + x] + 255) >> 8; int inc = n;
#pragma unroll
        for (int o = 1; o < 32; o <<= 1) { const int t = __shfl_up(inc, o, 64); if ((tid & 31) >= o) inc += t; }
        if (tid < 32) { const int t0 = inc - n; tab[x] = t0 * 256; for (int i = 0; i < n; ++i) tab[64 + t0 + i] = x; if (x == 31) { tab[32] = inc * 256; tab[40] = inc; } }
    }
    __syncthreads();
    return tab[40];
}
template <int LAYER>
__device__ __forceinline__ void ph_moe_gather(const Params& p, LAS unsigned char* lds, int bid, int nblk) {
    const int tid = threadIdx.x;
    LAS int* tab = (LAS int*)(lds + LDS_TAB); LAS int* bb = (LAS int*)(lds + LDS_WORK);
    (void)moe_tables((const int*)(p.ws + WS_CNTB) + (size_t)LAYER * 512 * 32, nblk, tab, bb);
    const int* TOPE = (const int*)(p.ws + WS_TOPE); const int* TOPS = (const int*)(p.ws + WS_TOPS); int* POS = (int*)(p.ws + WS_POS); int* IDX = (int*)(p.ws + WS_IDX);
    constexpr int R0 = LAYER == 0 ? 0 : NCTX;
    for (int i = R0 * 4 + bid * NTHR + tid; i < MROWS * 4; i += nblk * NTHR) {
        const int row = i >> 2, e = TOPE[i], pos = tab[e] + bb[((((row - R0) >> 3) % nblk) << 5) + e] + TOPS[i];
        POS[i] = pos; IDX[pos] = row;
    }
    for (int e = bid; e < 32; e += nblk) {
        const int cnt = tab[448 + e], beg = tab[e] + cnt, end = tab[e] + ((cnt + 255) & ~255);
        for (int q = beg + tid; q < end; q += NTHR) IDX[q] = R0;
    }
}
template <int LAYER>
__device__ __forceinline__ void ph_moe_gemm1(const Params& p, LAS unsigned char* lds, int bid, int nblk) {
    LAS int* tab = (LAS int*)(lds + LDS_TAB);
    const int T = moe_tables((const int*)(p.ws + WS_CNTB) + (size_t)LAYER * 512 * 32, nblk, tab, (LAS int*)nullptr);
    pg8::SchedMoe<8> S{T, nblk, bid, tab + 64};
    pg8::Gemm g{(const bf16_t*)(p.ws + WS_H), (const bf16_t*)(p.ws + WS_W1T) + (size_t)LAYER * 32 * 2048 * 1024, 0, 0, 1024, (const int*)(p.ws + WS_IDX)};
    pg8::EpiAct E{(bf16_t*)(p.ws + WS_ACT), p.in[I_B1] + (size_t)LAYER * 32 * 2048};
    pg8::gemm_phase<pg8::EpiAct, pg8::SchedMoe<8>, false, false, true, true>(lds + LDS_WORK, g, S, E, nullptr);
}
template <int LAYER>
__device__ __forceinline__ void ph_moe_gemm2(const Params& p, LAS unsigned char* lds, int bid, int nblk) {
    LAS int* tab = (LAS int*)(lds + LDS_TAB);
    const int T = moe_tables((const int*)(p.ws + WS_CNTB) + (size_t)LAYER * 512 * 32, nblk, tab, (LAS int*)nullptr);
    pg8::SchedMoe<4> S{T, nblk, bid, tab + 64};
    pg8::Gemm g{(const bf16_t*)(p.ws + WS_ACT), (const bf16_t*)(p.ws + WS_W2T) + (size_t)LAYER * 32 * 1024 * 1024, 0, 0, 1024};
    pg8::EpiYE E{(bf16_t*)(p.ws + WS_YE), p.in[I_B2] + (size_t)LAYER * 32 * 1024};
    pg8::gemm_phase<pg8::EpiYE, pg8::SchedMoe<4>, false, true, true>(lds + LDS_WORK, g, S, E, nullptr);
}
template <int NN>
__device__ __forceinline__ void ph_gemm_dense(LAS unsigned char* lds, const bf16_t* A, const bf16_t* Bt, bf16_t* C, int ldc, int pm0, int nM, int bid, int nblk) {
    pg8::SchedDense<NN> S{nM, pm0, nblk, bid};
    pg8::Gemm g{A, Bt, 0, 0, 1024};
    pg8::EpiStore E{C, ldc};
    pg8::gemm_phase<pg8::EpiStore, pg8::SchedDense<NN>, false>(lds + LDS_WORK, g, S, E, nullptr);
}
template <int LAYER>
__device__ __forceinline__ void ph_ln2(const Params& p, LAS unsigned char* lds, int bid, int nblk) {
    const int tid = threadIdx.x, wid = tid >> 6, lane = tid & 63, fr = lane & 15, fq = lane >> 4;
    LAS float* vb = (LAS float*)(lds + LDS_WORK);
    LAS float* part = vb + 16 * 1028;
    float wgf[32];
    if (LAYER == 0) { const float* wg = p.in[I_OWIN] + (size_t)(128 * wid + 32 * fq) * ODD_IN + 4096 + fr;
#pragma unroll
        for (int s2 = 0; s2 < 32; ++s2) wgf[s2] = wg[(size_t)s2 * ODD_IN]; }
    const float* MOD = (const float*)(p.ws + WS_MOD);
    bf16_t* XS = (bf16_t*)(p.ws + WS_XS); const bf16_t* YE = (const bf16_t*)(p.ws + WS_YE); bf16_t* H = (bf16_t*)(p.ws + WS_H); float* GT = (float*)(p.ws + WS_GT);
    const float* TOPW = (const float*)(p.ws + WS_TOPW); const int* POS = (const int*)(p.ws + WS_POS);
    const float* lng = p.in[I_LNG] + (LAYER * 2 + 1) * 1024; const float* lnb = p.in[I_LNB] + (LAYER * 2 + 1) * 1024;
    const int rstride = nblk * 8, rbase = (LAYER == 0 ? 0 : NCTX) + bid * 8, rfirst = rbase + wid;
    f32x4 nw = {0.f, 0.f, 0.f, 0.f}; int np0 = 0, np1 = 0, np2 = 0, np3 = 0;
    if (rfirst < MROWS) { nw = *(const f32x4*)(TOPW + rfirst * 4); np0 = POS[rfirst * 4]; np1 = POS[rfirst * 4 + 1]; np2 = POS[rfirst * 4 + 2]; np3 = POS[rfirst * 4 + 3]; }
    auto do_row = [&](int row, int jj) {
        const float* md = MOD + (size_t)(LAYER * 5 + row_modr(row)) * 6144;
        const float w0 = nw[0], w1 = nw[1], w2 = nw[2], w3 = nw[3];
        const bf16_t* y0 = YE + (size_t)np0 * 1024; const bf16_t* y1 = YE + (size_t)np1 * 1024;
        const bf16_t* y2 = YE + (size_t)np2 * 1024; const bf16_t* y3 = YE + (size_t)np3 * 1024;
        if (row + rstride < MROWS) { const int rn = row + rstride; nw = *(const f32x4*)(TOPW + rn * 4); np0 = POS[rn * 4]; np1 = POS[rn * 4 + 1]; np2 = POS[rn * 4 + 2]; np3 = POS[rn * 4 + 3]; }
        f32x4 v[4]; float s = 0.f;
#pragma unroll
        for (int q = 0; q < 4; ++q) { const int col = q * 256 + lane * 4;
            const f32x4 ffn = (ld_bf16x4(y0 + col) * w0 + ld_bf16x4(y1 + col) * w1) + (ld_bf16x4(y2 + col) * w2 + ld_bf16x4(y3 + col) * w3);
            v[q] = ld_bf16x4(XS + (size_t)row * 1024 + col) * DN_ALPHA + *(const f32x4*)(md + 5120 + col) * ffn;
            s += (v[q][0] + v[q][1]) + (v[q][2] + v[q][3]); }
        const float mean = wave_sum(s) * (1.0f / 1024.0f);
        float ss = 0.f;
#pragma unroll
        for (int q = 0; q < 4; ++q) { v[q] = v[q] - mean; ss += (v[q][0] * v[q][0] + v[q][1] * v[q][1]) + (v[q][2] * v[q][2] + v[q][3] * v[q][3]); }
        const float rstd = rsqrtf(wave_sum(ss) * (1.0f / 1024.0f) + LN_EPS);
        if (LAYER == 1) {
#pragma unroll
            for (int q = 0; q < 4; ++q) { const int col = q * 256 + lane * 4;
                *(f32x4*)(p.out + (size_t)(row - NCTX) * 1024 + col) = v[q] * rstd * *(const f32x4*)(lng + col) + *(const f32x4*)(lnb + col); }
        } else {
            const float* md1 = MOD + (size_t)(5 + row_modr(row)) * 6144;
#pragma unroll
            for (int q = 0; q < 4; ++q) { const int col = q * 256 + lane * 4;
                const f32x4 xn = v[q] * rstd * *(const f32x4*)(lng + col) + *(const f32x4*)(lnb + col);
                { u32x2 wx; wx.x = pack_bf16(xn[0], xn[1]); wx.y = pack_bf16(xn[2], xn[3]); *(u32x2*)(XS + (size_t)row * 1024 + col) = wx; }
                v[q] = xn * (*(const f32x4*)(md1 + 1024 + col) + 1.0f) + *(const f32x4*)(md1 + col);
                u32x2 w; w.x = pack_bf16(v[q][0], v[q][1]); w.y = pack_bf16(v[q][2], v[q][3]);
                *(u32x2*)(H + (size_t)row * 1024 + col) = w;
                *(LAS f32x4*)(vb + (wid + 8 * jj) * 1028 + col) = v[q]; }
        }
    };
    if (LAYER == 1) {
#pragma unroll 1
        for (int row = rfirst; row < MROWS; row += rstride) do_row(row, 0);
    } else {
#pragma unroll 1
        for (int j0 = 0; rbase + j0 * rstride < MROWS; j0 += 2) {
#pragma unroll 1
            for (int jj = 0; jj < 2; ++jj) { const int row = rfirst + (j0 + jj) * rstride; if (row >= MROWS) break; do_row(row, jj); }
            __syncthreads();
            {
                const LAS float* ar = vb + fr * 1028 + 128 * wid + 32 * fq;
                f32x4 acc = {0.f, 0.f, 0.f, 0.f};
#pragma unroll
                for (int h = 0; h < 2; ++h) { f32x4 va[4];
#pragma unroll
                    for (int u = 0; u < 4; ++u) va[u] = *(const LAS f32x4*)(ar + h * 16 + u * 4);
#pragma unroll
                    for (int u = 0; u < 4; ++u)
#pragma unroll
                        for (int i = 0; i < 4; ++i) acc = __builtin_amdgcn_mfma_f32_16x16x4f32(va[u][i], wgf[h * 16 + u * 4 + i], acc, 0, 0, 0); }
                LAS float* pw = part + wid * 256 + (4 * fq) * 16 + fr;
#pragma unroll
                for (int i = 0; i < 4; ++i) pw[i * 16] = acc[i];
            }
            __syncthreads();
            if (tid < 256) { const int lr = tid >> 4, row = rbase + (lr & 7) + (j0 + (lr >> 3)) * rstride;
                float a = 0.f;
#pragma unroll
                for (int w2 = 0; w2 < 8; ++w2) a += part[w2 * 256 + tid];
                if (row < MROWS) GT[row * 16 + (tid & 15)] = a; }
        }
    }
}
constexpr int LDK = 136;
__device__ __forceinline__ int sid_of(int mixer, int dir, int b, int ch, int h) { return (((mixer * 2 + dir) * 4 + b) * NCHUNK + ch) * 4 + h; }
__device__ __forceinline__ void unit_decode(int u, int& mixer, int& h, int& ch, int& b, int& row0) {
    mixer = u & 1; h = (u >> 1) & 3; const int rest = u >> 3; ch = rest % NCHUNK; b = rest / NCHUNK;
    row0 = ch < 2 ? b * 256 + ch * 128 : NCTX + b * 4096 + (ch - 2) * 128;
}
__device__ __forceinline__ void ld_raw(const bf16_t* P, int row0, int col, u32x2 (&raw)[8]) {
    const int t = threadIdx.x, i = t >> 2, part = t & 3, i0 = (part & 1) * 32 + (part >> 1) * 16;
    const bf16_t* src = P + (size_t)(row0 + i) * LDP1 + col + i0;
#pragma unroll
    for (int q = 0; q < 4; ++q) { raw[q] = *(const u32x2*)(src + q * 4); raw[4 + q] = *(const u32x2*)(src + 64 + q * 4); }
}
__device__ __forceinline__ void cvt_rows(const u32x2 (&raw)[8], bool rope, int s0, const float* ROPE, float (&lo)[16], float (&hi)[16]) {
    const int t = threadIdx.x, i = t >> 2, part = t & 3, pr = part & 1, hf = part >> 1;
#pragma unroll
    for (int q = 0; q < 4; ++q) {
        lo[q * 4] = __uint_as_float(raw[q].x << 16); lo[q * 4 + 1] = __uint_as_float(raw[q].x & 0xffff0000u); lo[q * 4 + 2] = __uint_as_float(raw[q].y << 16); lo[q * 4 + 3] = __uint_as_float(raw[q].y & 0xffff0000u);
        hi[q * 4] = __uint_as_float(raw[4 + q].x << 16); hi[q * 4 + 1] = __uint_as_float(raw[4 + q].x & 0xffff0000u); hi[q * 4 + 2] = __uint_as_float(raw[4 + q].y << 16); hi[q * 4 + 3] = __uint_as_float(raw[4 + q].y & 0xffff0000u); }
    if (rope) {
        const int s = s0 + i, pos = pr == 0 ? (s >> 6) : (s & 63);
        const float* rp = ROPE + (size_t)(pos * 32 + hf * 16) * 2;
#pragma unroll
        for (int jj = 0; jj < 16; ++jj) { const float c = rp[2 * jj], sn = rp[2 * jj + 1], a = lo[jj], b = hi[jj]; lo[jj] = a * c - b * sn; hi[jj] = a * sn + b * c; }
    }
}
__device__ __forceinline__ void st_rows(LAS bf16_t* dst, const float (&lo)[16], const float (&hi)[16], float scale) {
    const int t = threadIdx.x, i = t >> 2, part = t & 3, i0 = (part & 1) * 32 + (part >> 1) * 16;
    u32x4 w0, w1, w2, w3;
    w0.x = pack_bf16(lo[0] * scale, lo[1] * scale); w0.y = pack_bf16(lo[2] * scale, lo[3] * scale); w0.z = pack_bf16(lo[4] * scale, lo[5] * scale); w0.w = pack_bf16(lo[6] * scale, lo[7] * scale);
    w1.x = pack_bf16(lo[8] * scale, lo[9] * scale); w1.y = pack_bf16(lo[10] * scale, lo[11] * scale); w1.z = pack_bf16(lo[12] * scale, lo[13] * scale); w1.w = pack_bf16(lo[14] * scale, lo[15] * scale);
    w2.x = pack_bf16(hi[0] * scale, hi[1] * scale); w2.y = pack_bf16(hi[2] * scale, hi[3] * scale); w2.z = pack_bf16(hi[4] * scale, hi[5] * scale); w2.w = pack_bf16(hi[6] * scale, hi[7] * scale);
    w3.x = pack_bf16(hi[8] * scale, hi[9] * scale); w3.y = pack_bf16(hi[10] * scale, hi[11] * scale); w3.z = pack_bf16(hi[12] * scale, hi[13] * scale); w3.w = pack_bf16(hi[14] * scale, hi[15] * scale);
    LAS bf16_t* d = dst + i * LDK + i0;
    *(LAS u32x4*)d = w0; *(LAS u32x4*)(d + 8) = w1; *(LAS u32x4*)(d + 64) = w2; *(LAS u32x4*)(d + 72) = w3;
}
__device__ __forceinline__ void st_rows_T(LAS bf16_t* dst, const float (&lo)[16], const float (&hi)[16], float scale) {
    const int t = threadIdx.x, i = t >> 2, part = t & 3, i0 = (part & 1) * 32 + (part >> 1) * 16;
#pragma unroll
    for (int jj = 0; jj < 16; ++jj) { dst[(i0 + jj) * LDK + i] = f2bf(lo[jj] * scale); dst[(i0 + 64 + jj) * LDK + i] = f2bf(hi[jj] * scale); }
}
__device__ __forceinline__ void mma_128(const LAS bf16_t* A, const LAS bf16_t* B, f32x4 (&acc)[2][4], int wr, int wc, int lane) {
    const int fr = lane & 15, fq = lane >> 4;
#pragma unroll
    for (int ks = 0; ks < 4; ++ks) {
        bf16x8 a[2], b[4];
#pragma unroll
        for (int mt = 0; mt < 2; ++mt) a[mt] = *(const LAS bf16x8*)(A + (wr * 32 + mt * 16 + fr) * LDK + ks * 32 + fq * 8);
#pragma unroll
        for (int nt = 0; nt < 4; ++nt) b[nt] = *(const LAS bf16x8*)(B + (wc * 64 + nt * 16 + fr) * LDK + ks * 32 + fq * 8);
#pragma unroll
        for (int mt = 0; mt < 2; ++mt)
#pragma unroll
            for (int nt = 0; nt < 4; ++nt) acc[mt][nt] = __builtin_amdgcn_mfma_f32_16x16x32_bf16(a[mt], b[nt], acc[mt][nt], 0, 0, 0);
    }
}
__device__ __forceinline__ void zero_acc(f32x4 (&acc)[2][4]) {
#pragma unroll
    for (int mt = 0; mt < 2; ++mt)
#pragma unroll
        for (int nt = 0; nt < 4; ++nt) acc[mt][nt] = (f32x4){0.f, 0.f, 0.f, 0.f};
}
__device__ __forceinline__ void wave_scan_sum2(float x0, float x1, float& p0, float& p1, float& total) {
    const int lane = threadIdx.x & 63; float s = x0 + x1, inc = s;
#pragma unroll
    for (int o = 1; o < 64; o <<= 1) { const float t = __shfl_up(inc, o, 64); if (lane >= o) inc += t; }
    const float exc = inc - s; p0 = exc + x0; p1 = exc + s; total = __shfl(inc, 63, 64);
}
__device__ __forceinline__ void wave_scan_max2(float x0, float x1, float& p0, float& p1) {
    const int lane = threadIdx.x & 63; const float m = fmaxf(x0, x1); float inc = m;
#pragma unroll
    for (int o = 1; o < 64; o <<= 1) { const float t = __shfl_up(inc, o, 64); if (lane >= o) inc = fmaxf(inc, t); }
    float exc = __shfl_up(inc, 1, 64); if (lane == 0) exc = -3.0e38f;
    p0 = fmaxf(exc, x0); p1 = fmaxf(exc, m);
}
__device__ __forceinline__ void ph_c1(const Params& p, LAS unsigned char* lds, int bid, int nblk) {
    const int tid = threadIdx.x, wid = tid >> 6, lane = tid & 63, wr = wid >> 1, wc = wid & 1, fr = lane & 15, fq = lane >> 4;
    LAS bf16_t* KsT = (LAS bf16_t*)(lds + LDS_WORK); LAS bf16_t* VsT0 = KsT + 128 * LDK; LAS bf16_t* VsT1 = VsT0 + 128 * LDK;
    LAS float* z = (LAS float*)(VsT1 + 128 * LDK);
    LAS float* lfA = z + 256; LAS float* igA = lfA + 256; LAS float* zmax = igA + 256;
    const bf16_t* P = (const bf16_t*)(p.ws + WS_P); const float* GT = (const float*)(p.ws + WS_GT); const float* ROPE = (const float*)(p.ws + WS_ROPE);
    float* ST = (float*)(p.ws + WS_ST); float* NST = (float*)(p.ws + WS_NST); float* MEND = (float*)(p.ws + WS_MEND); float* BEND = (float*)(p.ws + WS_BEND);
    for (int u = bid; u < NB * NCHUNK * 4 * 2; u += nblk) {
        int mixer, h, ch, b, row0; unit_decode(u, mixer, h, ch, b, row0);
        const int colQ = mixer * 2048 + h * 128;
        u32x2 rawK[8], rawV[8]; ld_raw(P, row0, colQ + 512, rawK); ld_raw(P, row0, colQ + 1024, rawV);
        if (mixer == 0) {
            if (tid < 256) { const int dir = tid >> 7, j = tid & 127; const float lg = p.in[I_CLG][dir * 4 + h]; z[tid] = fexp(lg * (float)(dir == 0 ? 127 - j : j)); }
        } else {
            if (tid < 256) { const int dir = tid >> 7, j = tid & 127, row = row0 + j;
                igA[tid] = GT[row * 16 + dir * 4 + h] + p.in[I_DIB][dir * 4 + h];
                lfA[tid] = -softplusf(-(GT[row * 16 + 8 + dir * 4 + h] + p.in[I_DFB][dir * 4 + h])); }
            __syncthreads();
            if (tid < 128) { const int dir = tid >> 6, j0 = 2 * lane, j1 = j0 + 1;
                const float l0 = lfA[dir * 128 + j0], l1 = lfA[dir * 128 + j1], g0 = igA[dir * 128 + j0], g1 = igA[dir * 128 + j1];
                float r0, r1, total; wave_scan_sum2(l0, l1, r0, r1, total);
                const float w0 = (dir == 0 ? total - r0 : r0 - l0) + g0, w1 = (dir == 0 ? total - r1 : r1 - l1) + g1;
                const float mx = wave_max(fmaxf(w0, w1));
                z[dir * 128 + j0] = fexp(w0 - mx); z[dir * 128 + j1] = fexp(w1 - mx);
                const int sid = sid_of(1, dir, b, ch, h);
                if (lane == 0) { MEND[sid] = mx; BEND[sid] = total; }
                float* CB = (float*)(p.ws + WS_CB) + (size_t)sid * 128; float* CMI = (float*)(p.ws + WS_CMI) + (size_t)sid * 128;
                if (dir == 0) { float m0, m1; wave_scan_max2(g0 - r0, g1 - r1, m0, m1); CB[j0] = r0; CB[j1] = r1; CMI[j0] = r0 + m0; CMI[j1] = r1 + m1; }
                else { const float s0 = total - r0 + l0, s1 = total - r1 + l1;
                    lfA[128 + j0] = g0 - s0; lfA[128 + j1] = g1 - s1; igA[128 + j0] = s0; igA[128 + j1] = s1; CB[j0] = s0; CB[j1] = s1;
                    asm volatile("s_waitcnt lgkmcnt(0)" ::: "memory");
                    const int q0 = 127 - 2 * lane, q1 = q0 - 1; float m0, m1; wave_scan_max2(lfA[128 + q0], lfA[128 + q1], m0, m1);
                    CMI[q0] = igA[128 + q0] + m0; CMI[q1] = igA[128 + q1] + m1; } }
        }
        __syncthreads();
        {
            float lo[16], hi[16];
            cvt_rows(rawK, mixer == 0 && ch >= 2, (ch - 2) * 128, ROPE, lo, hi);
            st_rows_T(KsT, lo, hi, 0.08838834764831845f);
            cvt_rows(rawV, false, 0, ROPE, lo, hi);
            const int i = tid >> 2;
            st_rows_T(VsT0, lo, hi, z[i]); st_rows_T(VsT1, lo, hi, z[128 + i]);
        }
        __syncthreads();
#pragma unroll
        for (int dir = 0; dir < 2; ++dir) {
            f32x4 acc[2][4]; zero_acc(acc);
            mma_128(dir == 0 ? VsT0 : VsT1, KsT, acc, wr, wc, lane);
            bf16_t* dst = (bf16_t*)ST + (size_t)sid_of(mixer, dir, b, ch, h) * 16384;
#pragma unroll
            for (int mt = 0; mt < 2; ++mt)
#pragma unroll
                for (int nt = 0; nt < 4; ++nt)
#pragma unroll
                    for (int r = 0; r < 4; ++r) dst[(wr * 32 + mt * 16 + fq * 4 + r) * 128 + wc * 64 + nt * 16 + fr] = f2bf(acc[mt][nt][r]);
        }
        if (mixer == 1 && tid < 256) { const int dir = tid >> 7, dd = tid & 127; float s = 0.f;
            for (int j = 0; j < 128; ++j) s += z[dir * 128 + j] * bf2f(KsT[dd * LDK + j]);
            NST[(size_t)sid_of(1, dir, b, ch, h) * 128 + dd] = s; }
        __syncthreads();
    }
}
__device__ __forceinline__ void ph_c2(const Params& p, int bid, int nblk) {
    const int tid = threadIdx.x;
    float* ST = (float*)(p.ws + WS_ST); float* NST = (float*)(p.ws + WS_NST); bf16_t* STB = (bf16_t*)(p.ws + WS_STB);
    const float* MEND = (const float*)(p.ws + WS_MEND); const float* BEND = (const float*)(p.ws + WS_BEND); float* MPREV = (float*)(p.ws + WS_MPREV);
    for (int item = bid; item < 2048; item += nblk) {
        const int mixer = item >> 10, chain = (item >> 5) & 31, slab = item & 31, dir = chain >> 4, b = (chain >> 2) & 3, h = chain & 3;
        const int idx = slab * 512 + tid;
        float kv[NCHUNK];
#pragma unroll
        for (int k = 0; k < NCHUNK; ++k) { const int ch = dir == 0 ? k : (k < 2 ? 1 - k : 35 - k); kv[k] = bf2f(((const bf16_t*)ST)[(size_t)sid_of(mixer, dir, b, ch, h) * 16384 + idx]); }
        if (mixer == 0) {
            const float gdec = fexp(p.in[I_CLG][dir * 4 + h] * 128.0f); float r = 0.f;
#pragma unroll
            for (int k = 0; k < NCHUNK; ++k) { const int ch = dir == 0 ? k : (k < 2 ? 1 - k : 35 - k); STB[(size_t)sid_of(0, dir, b, ch, h) * 16384 + idx] = f2bf(r); r = r * gdec + kv[k]; }
        } else {
            const bool do_n = slab == 0 && tid < 128;
            float nv[NCHUNK];
#pragma unroll
            for (int k = 0; k < NCHUNK; ++k) { const int ch = dir == 0 ? k : (k < 2 ? 1 - k : 35 - k); nv[k] = do_n ? NST[(size_t)sid_of(1, dir, b, ch, h) * 128 + tid] : 0.f; }
            float m = -__builtin_inff(), c = 0.f, n = 0.f;
#pragma unroll
            for (int k = 0; k < NCHUNK; ++k) { const int ch = dir == 0 ? k : (k < 2 ? 1 - k : 35 - k); const int sid = sid_of(1, dir, b, ch, h);
                const float me = MEND[sid], be = BEND[sid], mnew = fmaxf(be + m, me), so = fexp(be + m - mnew), sn = fexp(me - mnew);
                STB[(size_t)sid * 16384 + idx] = f2bf(c); c = c * so + kv[k] * sn;
                if (do_n) { NST[(size_t)sid * 128 + tid] = n; n = n * so + nv[k] * sn; }
                if (slab == 0 && tid == 0) MPREV[sid] = m;
                m = mnew; }
        }
    }
}
template <int mixer>
__device__ __forceinline__ void c3_unit(const Params& p, LAS unsigned char* lds, int h, int ch, int b, int row0) {
    const int tid = threadIdx.x, wid = tid >> 6, lane = tid & 63, wr = wid >> 1, wc = wid & 1, fr = lane & 15, fq = lane >> 4;
    LAS bf16_t* Qs = (LAS bf16_t*)(lds + LDS_WORK); LAS bf16_t* Ks = Qs + 128 * LDK; LAS bf16_t* VsT = Ks + 128 * LDK; LAS bf16_t* RT = VsT + 128 * LDK;
    LAS float* fa = (LAS float*)(RT + 128 * LDK);
    LAS float* lfA = fa; LAS float* igA = fa + 256; LAS float* bA = fa + 512; LAS float* miA = fa + 768; LAS float* mtA = fa + 1024; LAS float* sintA = fa + 1280;
    LAS float* rowsum = fa + 1536; LAS float* qn = fa + 2048; LAS float* nA = fa + 2304;
    LAS float* Os = (LAS float*)Qs;
    LAS bf16_t* Pm = Ks;
    const bf16_t* P = (const bf16_t*)(p.ws + WS_P); const float* GT = (const float*)(p.ws + WS_GT); const float* ROPE = (const float*)(p.ws + WS_ROPE);
    const bf16_t* STB = (const bf16_t*)(p.ws + WS_STB); const float* NST = (const float*)(p.ws + WS_NST); const float* MPREV = (const float*)(p.ws + WS_MPREV);
    bf16_t* Y = (bf16_t*)(p.ws + WS_YMIX);
    {
        const int colQ = mixer * 2048 + h * 128; const bool rope = mixer == 0 && ch >= 2;
        {
            u32x2 rawQ[8], rawK[8], rawV[8]; ld_raw(P, row0, colQ, rawQ); ld_raw(P, row0, colQ + 512, rawK); ld_raw(P, row0, colQ + 1024, rawV);
            float lo[16], hi[16];
            cvt_rows(rawQ, rope, (ch - 2) * 128, ROPE, lo, hi); st_rows(Qs, lo, hi, 1.0f);
            cvt_rows(rawK, rope, (ch - 2) * 128, ROPE, lo, hi); st_rows(Ks, lo, hi, 0.08838834764831845f);
            cvt_rows(rawV, false, 0, ROPE, lo, hi); st_rows_T(VsT, lo, hi, 1.0f);
        }
        if (mixer == 1) {
            if (tid < 256) { const int dir = tid >> 7, j = tid & 127, row = row0 + j;
                igA[tid] = GT[row * 16 + dir * 4 + h] + p.in[I_DIB][dir * 4 + h];
                nA[tid] = NST[(size_t)sid_of(1, dir, b, ch, h) * 128 + j];
                bA[tid] = ((const float*)(p.ws + WS_CB))[(size_t)sid_of(1, dir, b, ch, h) * 128 + j]; miA[tid] = ((const float*)(p.ws + WS_CMI))[(size_t)sid_of(1, dir, b, ch, h) * 128 + j]; }
            __syncthreads();
            __syncthreads();
            if (tid < 256) { const int dir = tid >> 7, i = tid & 127; const float mprev = MPREV[sid_of(1, dir, b, ch, h)];
                const float gi = bA[tid] + mprev, mt = fmaxf(gi, miA[tid]); mtA[tid] = mt; sintA[tid] = fexp(gi - mt);
                float s = 0.f;
                for (int d0 = 0; d0 < 128; ++d0) s += bf2f(Qs[i * LDK + d0]) * nA[dir * 128 + d0];
                qn[tid] = s; }
        }
        __syncthreads();
        f32x4 S[2][4]; zero_acc(S);
        mma_128(Qs, Ks, S, wr, wc, lane);
        __syncthreads();
        f32x4 O[2][4]; zero_acc(O);
        if (mixer == 0) {
            const float lg0 = p.in[I_CLG][h], lg1 = p.in[I_CLG][4 + h];
#pragma unroll
            for (int mt = 0; mt < 2; ++mt)
#pragma unroll
                for (int nt = 0; nt < 4; ++nt)
#pragma unroll
                    for (int r = 0; r < 4; ++r) { const int i = wr * 32 + mt * 16 + fq * 4 + r, j = wc * 64 + nt * 16 + fr;
                        const float dcy = (i >= j ? fexp(lg0 * (float)(i - j)) : 0.f) + (j >= i ? fexp(lg1 * (float)(j - i)) : 0.f);
                        Pm[i * LDK + j] = f2bf(S[mt][nt][r] * dcy); }
            __syncthreads();
            mma_128(Pm, VsT, O, wr, wc, lane);
#pragma unroll
            for (int dir = 0; dir < 2; ++dir) {
                { const bf16_t* src = STB + (size_t)sid_of(0, dir, b, ch, h) * 16384 + (tid >> 2) * 128 + (tid & 3) * 32; LAS bf16_t* d = RT + (tid >> 2) * LDK + (tid & 3) * 32;
#pragma unroll
                    for (int q = 0; q < 4; ++q) *(LAS u32x4*)(d + q * 8) = *(const u32x4*)(src + q * 8); }
                __syncthreads();
                f32x4 T[2][4]; zero_acc(T);
                mma_128(Qs, RT, T, wr, wc, lane);
#pragma unroll
                for (int mt = 0; mt < 2; ++mt)
#pragma unroll
                    for (int r = 0; r < 4; ++r) { const int i = wr * 32 + mt * 16 + fq * 4 + r; const float xi = dir == 0 ? fexp(lg0 * (float)(i + 1)) : fexp(lg1 * (float)(128 - i));
#pragma unroll
                        for (int nt = 0; nt < 4; ++nt) O[mt][nt][r] += xi * T[mt][nt][r]; }
                __syncthreads();
            }
        } else {
#pragma unroll
            for (int dir = 0; dir < 2; ++dir) {
                float rp[2][4];
#pragma unroll
                for (int mt = 0; mt < 2; ++mt)
#pragma unroll
                    for (int r = 0; r < 4; ++r) { const int i = wr * 32 + mt * 16 + fq * 4 + r; const float bi = bA[dir * 128 + i] - mtA[dir * 128 + i]; float acc = 0.f;
#pragma unroll
                        for (int nt = 0; nt < 4; ++nt) { const int j = wc * 64 + nt * 16 + fr; const bool valid = dir == 0 ? (j <= i) : (j >= i);
                            const float e = valid ? fexp(bi - bA[dir * 128 + j] + igA[dir * 128 + j]) : 0.f; const float pv = S[mt][nt][r] * e;
                            Pm[i * LDK + j] = f2bf(pv); acc += pv; }
                        rp[mt][r] = row16_sum(acc); }
                if (fr == 0) {
#pragma unroll
                    for (int mt = 0; mt < 2; ++mt)
#pragma unroll
                        for (int r = 0; r < 4; ++r) rowsum[wc * 256 + dir * 128 + wr * 32 + mt * 16 + fq * 4 + r] = rp[mt][r];
                }
                { const bf16_t* src = STB + (size_t)sid_of(1, dir, b, ch, h) * 16384 + (tid >> 2) * 128 + (tid & 3) * 32; LAS bf16_t* d = RT + (tid >> 2) * LDK + (tid & 3) * 32;
#pragma unroll
                    for (int q = 0; q < 4; ++q) *(LAS u32x4*)(d + q * 8) = *(const u32x4*)(src + q * 8); }
                __syncthreads();
                f32x4 T[2][4]; zero_acc(T);
                mma_128(Qs, RT, T, wr, wc, lane);
#pragma unroll
                for (int mt = 0; mt < 2; ++mt)
#pragma unroll
                    for (int r = 0; r < 4; ++r) { const float si = sintA[dir * 128 + wr * 32 + mt * 16 + fq * 4 + r];
#pragma unroll
                        for (int nt = 0; nt < 4; ++nt) T[mt][nt][r] *= si; }
                mma_128(Pm, VsT, T, wr, wc, lane);
#pragma unroll
                for (int mt = 0; mt < 2; ++mt)
#pragma unroll
                    for (int r = 0; r < 4; ++r) { const int i = wr * 32 + mt * 16 + fq * 4 + r; const float si = sintA[dir * 128 + i];
                        float den = (rowsum[dir * 128 + i] + rowsum[256 + dir * 128 + i]) + qn[dir * 128 + i] * si; den = fmaxf(fabsf(den), fexp(-mtA[dir * 128 + i])); const float rden = frcp(den);
#pragma unroll
                        for (int nt = 0; nt < 4; ++nt) O[mt][nt][r] += T[mt][nt][r] * rden; }
                __syncthreads();
            }
        }
#pragma unroll
        for (int mt = 0; mt < 2; ++mt)
#pragma unroll
            for (int nt = 0; nt < 4; ++nt)
#pragma unroll
                for (int r = 0; r < 4; ++r) Os[(wr * 32 + mt * 16 + fq * 4 + r) * 132 + wc * 64 + nt * 16 + fr] = O[mt][nt][r];
        __syncthreads();
        {
            const float* gng = (mixer == 0 ? p.in[I_CGNG] : p.in[I_DGNG]) + h * 128; const float* gnb = (mixer == 0 ? p.in[I_CGNB] : p.in[I_DGNB]) + h * 128;
            const float g0 = gng[lane], g1 = gng[lane + 64], b0 = gnb[lane], b1 = gnb[lane + 64];
#pragma unroll 1
            for (int i4 = 0; i4 < 16; i4 += 4) {
                float qg0[4], qg1[4];
#pragma unroll
                for (int u = 0; u < 4; ++u) { const int row = row0 + wid * 16 + i4 + u; qg0[u] = bf2f(P[(size_t)row * LDP1 + colQ + 1536 + lane]); qg1[u] = bf2f(P[(size_t)row * LDP1 + colQ + 1536 + 64 + lane]); }
#pragma unroll
                for (int u = 0; u < 4; ++u) { const int i = wid * 16 + i4 + u, row = row0 + i;
                    const float x0 = Os[i * 132 + lane], x1 = Os[i * 132 + 64 + lane];
                    const float mean = wave_sum(x0 + x1) * (1.0f / 128.0f), d0 = x0 - mean, d1 = x1 - mean;
                    const float rstd = rsqrtf(wave_sum(d0 * d0 + d1 * d1) * (1.0f / 128.0f) + LN_EPS);
                    const float q0 = qg0[u], q1 = qg1[u];
                    const float s0 = sigm(q0), s1 = sigm(q1);
                    const float y0 = (d0 * rstd * g0 + b0) * (mixer == 0 ? q0 * s0 : s0), y1 = (d1 * rstd * g1 + b1) * (mixer == 0 ? q1 * s1 : s1);
                    Y[(size_t)row * 1024 + mixer * 512 + h * 128 + lane] = f2bf(y0); Y[(size_t)row * 1024 + mixer * 512 + h * 128 + 64 + lane] = f2bf(y1); }
            }
        }
        __syncthreads();
    }
}
__device__ __forceinline__ void ph_c3(const Params& p, LAS unsigned char* lds, int bid, int nblk) {
    for (int u2 = bid; u2 < NB * NCHUNK * 4; u2 += nblk) {
        int mixer, h, ch, b, row0; unit_decode(u2 * 2, mixer, h, ch, b, row0);
        c3_unit<0>(p, lds, h, ch, b, row0);
    }
    for (int u2 = nblk - 1 - bid; u2 < NB * NCHUNK * 4; u2 += nblk) {
        int mixer, h, ch, b, row0; unit_decode(u2 * 2 + 1, mixer, h, ch, b, row0);
        c3_unit<1>(p, lds, h, ch, b, row0);
    }
}
constexpr int NPHASE = 23;
__global__ void __launch_bounds__(NTHR, 2) fwd(Params p) {
    extern __shared__ __attribute__((aligned(16))) unsigned char smem_raw[];
    LAS unsigned char* lds = (LAS unsigned char*)smem_raw;
    if (threadIdx.x == 0) { LAS unsigned* st = (LAS unsigned*)(lds + LDS_BAR); st[0] = 0u; st[1] = 0u; st[2] = 0u; st[3] = 0u; }
    __syncthreads();
    XcdBarrier bar = xcd_barrier_post((unsigned*)(p.ws + WS_CTL), (volatile LAS unsigned*)(lds + LDS_BAR));
    const int bid = blockIdx.x, nblk = gridDim.x;
    unsigned char* ws = p.ws;
#ifndef PHASE_ONLY
#define PHASE_ONLY -1
#endif
#ifndef DBL_MASK
#define DBL_MASK 0u
#endif
#define PHASE(k, call) if constexpr (PHASE_ONLY < 0 || PHASE_ONLY == (k)) { if (p.lo <= (k) && (k) < p.hi) { call; if constexpr ((DBL_MASK >> (k)) & 1u) { xcd_barrier(bar); call; } if ((k) + 1 < p.hi) xcd_barrier(bar); } }
    PHASE(0, ph_prologue(p, lds, bid, nblk))
    PHASE(1, ph_mod_in(p, bid, nblk))
    PHASE(2, ph_gemm_dense<12>(lds, (const bf16_t*)(ws + WS_H), (const bf16_t*)(ws + WS_WIN0T), (bf16_t*)(ws + WS_P), LDP0, 0, 68, bid, nblk))
    PHASE(3, ph_prep_even(p, lds, bid, nblk))
    PHASE(4, ph_r1(p, lds, bid, nblk))
    PHASE(5, ph_r2(p, lds, bid, nblk))
    PHASE(6, ph_fin_even(p, bid, nblk))
    PHASE(7, ph_gemm_dense<4>(lds, (const bf16_t*)(ws + WS_YMIX), (const bf16_t*)(ws + WS_WOUTT), (bf16_t*)(ws + WS_YP), 1024, 0, 68, bid, nblk))
    PHASE(8, ph_ln1<0>(p, lds, bid, nblk))
    PHASE(9, ph_moe_gather<0>(p, lds, bid, nblk))
    PHASE(10, ph_moe_gemm1<0>(p, lds, bid, nblk))
    PHASE(11, ph_moe_gemm2<0>(p, lds, bid, nblk))
    PHASE(12, ph_ln2<0>(p, lds, bid, nblk))
    PHASE(13, ph_gemm_dense<16>(lds, (const bf16_t*)(ws + WS_H), (const bf16_t*)(ws + WS_WIN1T), (bf16_t*)(ws + WS_P), LDP1, 0, 68, bid, nblk))
    PHASE(14, ph_c1(p, lds, bid, nblk))
    PHASE(15, ph_c2(p, bid, nblk))
    PHASE(16, ph_c3(p, lds, bid, nblk))
    PHASE(17, ph_gemm_dense<4>(lds, (const bf16_t*)(ws + WS_YMIX), (const bf16_t*)(ws + WS_WOUTT) + (size_t)1024 * 1024, (bf16_t*)(ws + WS_YP), 1024, 4, 64, bid, nblk))
    PHASE(18, ph_ln1<1>(p, lds, bid, nblk))
    PHASE(19, ph_moe_gather<1>(p, lds, bid, nblk))
    PHASE(20, ph_moe_gemm1<1>(p, lds, bid, nblk))
    PHASE(21, ph_moe_gemm2<1>(p, lds, bid, nblk))
    PHASE(22, ph_ln2<1>(p, lds, bid, nblk))
#undef PHASE
}

#ifndef MK_ONE_LAUNCH
#define MK_ONE_LAUNCH 1
#endif
extern "C" void kernel_launch(void* const* d_in, const int* in_sizes, int n_in, void* d_out, int out_size, void* d_ws, size_t ws_size, hipStream_t stream) {
    static int grid = 0;
    if (grid == 0) {
        if (n_in != N_INPUTS || out_size != NB * SEQL * DM || ws_size < WS_TOTAL) { fprintf(stderr, "kernel_launch: unexpected problem (n_in %d, out %d, ws %zu < %zu)\n", n_in, out_size, ws_size, (size_t)WS_TOTAL); grid = -1; return; }
        int dev = 0, cus = 0, per_cu = 0;
        if (hipGetDevice(&dev) != hipSuccess || hipDeviceGetAttribute(&cus, hipDeviceAttributeMultiprocessorCount, dev) != hipSuccess) { grid = -1; return; }
        if (hipFuncSetAttribute((const void*)fwd, hipFuncAttributeMaxDynamicSharedMemorySize, LDS_BYTES) != hipSuccess) { fprintf(stderr, "kernel_launch: hipFuncSetAttribute failed\n"); grid = -1; return; }
        if (hipOccupancyMaxActiveBlocksPerMultiprocessor(&per_cu, (const void*)fwd, NTHR, LDS_BYTES) != hipSuccess || per_cu < 1) { fprintf(stderr, "kernel_launch: occupancy query says %d\n", per_cu); (void)hipGetLastError(); per_cu = 1; }
        grid = cus;
    }
    if (grid < 0) return;
    (void)hipMemsetAsync((char*)d_ws + WS_CTL, 0, CTL_BYTES, stream);
    Params p{};
    for (int i = 0; i < N_INPUTS; ++i) p.in[i] = (const float*)d_in[i];
    p.out = (float*)d_out; p.ws = (unsigned char*)d_ws;
#if MK_ONE_LAUNCH
    p.lo = 0; p.hi = NPHASE;
    hipLaunchKernelGGL(fwd, dim3(grid), dim3(NTHR), LDS_BYTES, stream, p);
#else
    for (int k = 0; k < NPHASE; ++k) { p.lo = k; p.hi = k + 1; hipLaunchKernelGGL(fwd, dim3(grid), dim3(NTHR), LDS_BYTES, stream, p); }
#endif
}
```

```cpp
#include <hip/hip_runtime.h>
#include <stdint.h>
#include <stdio.h>

#define LAS __attribute__((address_space(3)))
typedef unsigned short bf16_t;
typedef short bf16x8 __attribute__((ext_vector_type(8)));
typedef float f32x4 __attribute__((ext_vector_type(4)));
typedef float f32x2 __attribute__((ext_vector_type(2)));
typedef unsigned u32x4 __attribute__((ext_vector_type(4)));
typedef unsigned u32x2 __attribute__((ext_vector_type(2)));

constexpr int NB = 4, SEQL = 4096, CTXL = 256, DM = 1024;
constexpr int NCTX = NB * CTXL;
constexpr int MROWS = NCTX + NB * SEQL;
constexpr int NTHR = 512;
constexpr int LDP0 = 3072, LDP1 = 4096;
constexpr int A_IN = 1920, EVEN_IN = 2944, ODD_IN = 4112;
constexpr int NEXP = 32, DFF = 1024;
constexpr int MOE_ROWS_MAX = 69632 + 32 * 256;
constexpr float DN_ALPHA = 1.41421356237309515f;
constexpr float LN_EPS = 1e-5f;
constexpr int NCHUNK = 34;

enum { I_X = 0, I_C, I_CTX, I_CCTX, I_WMOD, I_BMOD, I_LNG, I_LNB, I_EWIN, I_EWOUT, I_AMU, I_AW0, I_AWB, I_AA0, I_AAB, I_AGB, I_AKK, I_AKA, I_ARK,
       I_AGNG, I_AGNB, I_BCW, I_BCB, I_BGW, I_BGB, I_BLAM, I_OWIN, I_OWOUT, I_CLG, I_CGNG, I_CGNB, I_DIB, I_DFB, I_DGNG, I_DGNB, I_RW, I_RB,
       I_W1, I_B1, I_W2, I_B2, N_INPUTS };

constexpr size_t al256(size_t x) { return (x + 255) & ~(size_t)255; }
constexpr size_t WS_CTL   = 0;
constexpr size_t CTL_BYTES = 65536;
constexpr size_t CTL_CNT  = 16384;
constexpr size_t WS_MOD   = WS_CTL + CTL_BYTES;
constexpr size_t WS_ROPE  = WS_MOD + al256((size_t)2 * 5 * 6144 * 4);
constexpr size_t WS_WIN0T = WS_ROPE + 16384;
constexpr size_t WS_WIN1T = WS_WIN0T + (size_t)3072 * 1024 * 2;
constexpr size_t WS_WOUTT = WS_WIN1T + (size_t)4096 * 1024 * 2;
constexpr size_t WS_W1T   = WS_WOUTT + (size_t)2 * 1024 * 1024 * 2;
constexpr size_t WS_W2T   = WS_W1T + (size_t)2 * 32 * 2048 * 1024 * 2;
constexpr size_t WS_XS    = WS_W2T + (size_t)2 * 32 * 1024 * 1024 * 2;
constexpr size_t WS_H     = WS_XS + (size_t)MROWS * 1024 * 4;
constexpr size_t WS_YMIX  = WS_H + (size_t)MROWS * 1024 * 2;
constexpr size_t WS_YP    = WS_YMIX + (size_t)MROWS * 1024 * 2;
constexpr size_t WS_GT    = WS_YP + (size_t)MROWS * 1024 * 4;
constexpr size_t WS_TOPE  = WS_GT + (size_t)MROWS * 16 * 4;
constexpr size_t WS_TOPW  = WS_TOPE + (size_t)MROWS * 16;
constexpr size_t WS_TOPS  = WS_TOPW + (size_t)MROWS * 16;
constexpr size_t WS_POS   = WS_TOPS + (size_t)MROWS * 16;
constexpr size_t WS_CNTB  = WS_POS + (size_t)MROWS * 16;
constexpr size_t WS_WLT   = WS_CNTB + (size_t)2 * 512 * 32 * 4;
constexpr size_t WLT_WB = 0, WLT_AB = 65536, WLT_GB = 131072, WLT_GW = 196608, WLT_N = 327680;
constexpr size_t WS_P     = WS_WLT + (size_t)WLT_N * 2;
constexpr size_t WS_BIG   = WS_P + (size_t)MROWS * 4096 * 4;
constexpr size_t ARR512   = (size_t)MROWS * 512 * 4;
constexpr int SCREC = 448;
constexpr int SCLEN = CTXL + SEQL;
constexpr size_t WS_SC    = WS_BIG;
enum { E_G = 0, E_O0, E_O1, E_A0, E_A1, E_BX0, E_BX1, E_GATE, E_NARR };
constexpr size_t WS_EARR  = WS_SC + (size_t)64 * SCLEN * SCREC * 2;
constexpr size_t WS_BC    = WS_EARR + (size_t)E_NARR * ARR512;
constexpr size_t WS_CHA   = WS_BC + (size_t)MROWS * 8 * 4;
constexpr size_t WS_CHH   = WS_CHA + (size_t)2 * 512 * 512 * 4;
constexpr size_t WS_CIN   = WS_CHH + (size_t)2 * 512 * 512 * 4;
constexpr int RCH = 64, NRCH = SCLEN / RCH, NRUNIT = 64 * NRCH;
constexpr size_t WS_RU    = WS_CIN + (size_t)2 * 512 * 512 * 4;
constexpr size_t WS_EEND  = WS_RU + (size_t)NRUNIT * 4 * 4096 * 4;
constexpr int NSID = 2 * 2 * NB * NCHUNK * 4;
constexpr size_t WS_ST    = WS_BIG;
constexpr size_t WS_NST   = WS_ST + (size_t)NSID * 16384 * 4;
constexpr size_t WS_MEND  = WS_NST + (size_t)NSID * 128 * 4;
constexpr size_t WS_BEND  = WS_MEND + al256((size_t)NSID * 4);
constexpr size_t WS_MPREV = WS_BEND + al256((size_t)NSID * 4);
constexpr size_t WS_CB    = WS_MPREV + al256((size_t)NSID * 4);
constexpr size_t WS_CMI   = WS_CB + (size_t)NSID * 128 * 4;
constexpr size_t WS_STB   = WS_CMI + (size_t)NSID * 128 * 4;
constexpr size_t WS_OEND  = WS_STB + (size_t)NSID * 16384 * 2;
constexpr size_t WS_ASORT = WS_BIG;
constexpr size_t WS_IDX   = WS_BIG;
constexpr size_t WS_ACT   = WS_ASORT + (size_t)MOE_ROWS_MAX * 1024 * 2;
constexpr size_t WS_YE    = WS_ACT + (size_t)MOE_ROWS_MAX * 1024 * 2;
constexpr size_t WS_MEND_ = WS_YE + (size_t)MOE_ROWS_MAX * 1024 * 4;
constexpr size_t WS_TOTAL = (WS_EEND > WS_MEND_ ? (WS_EEND > WS_OEND ? WS_EEND : WS_OEND) : (WS_MEND_ > WS_OEND ? WS_MEND_ : WS_OEND));

constexpr int LDS_BYTES = 155648;
constexpr int LDS_BAR = 0;
constexpr int LDS_WORK = 1024;

struct Params {
    const float* in[N_INPUTS];
    float* out;
    unsigned char* ws;
    int lo, hi;
};

typedef __bf16 nbf16x2 __attribute__((ext_vector_type(2)));
__device__ __forceinline__ unsigned pack_bf16(float lo, float hi) { const nbf16x2 v = {(__bf16)lo, (__bf16)hi}; return __builtin_bit_cast(unsigned, v); }
__device__ __forceinline__ bf16_t f2bf(float f) { return __builtin_bit_cast(bf16_t, (__bf16)f); }
__device__ __forceinline__ float bf2f(bf16_t b) { return __uint_as_float(((unsigned)b) << 16); }
__device__ __forceinline__ f32x4 ld_bf16x4(const bf16_t* p) { const u32x2 w = *(const u32x2*)p; return (f32x4){__uint_as_float(w.x << 16), __uint_as_float(w.x & 0xffff0000u), __uint_as_float(w.y << 16), __uint_as_float(w.y & 0xffff0000u)}; }
__device__ __forceinline__ float fexp(float x) { return __builtin_amdgcn_exp2f(x * 1.4426950408889634f); }
__device__ __forceinline__ float frcp(float x) { return __builtin_amdgcn_rcpf(x); }
__device__ __forceinline__ float fsqrt(float x) { return __builtin_amdgcn_sqrtf(x); }
__device__ __forceinline__ float sigm(float x) { return frcp(1.0f + fexp(-x)); }
__device__ __forceinline__ float ftanh(float x) { const float e = fexp(-2.0f * fabsf(x)), t = (1.0f - e) * frcp(1.0f + e); return x < 0.f ? -t : t; }
__device__ __forceinline__ float fexpm1_neg(float x) {
    const float p = x * (1.0f + x * (0.5f + x * (0.16666667f + x * (0.041666668f + x * 0.0083333338f))));
    return x > -0.25f ? p : fexp(x) - 1.0f; }
__device__ __forceinline__ float softplusf(float x) { return fmaxf(x, 0.f) + log1pf(expf(-fabsf(x))); }
__device__ __forceinline__ float wave_sum(float v) {
    v += __int_as_float(__builtin_amdgcn_update_dpp(0, __float_as_int(v), 0x121, 0xf, 0xf, false));
    v += __int_as_float(__builtin_amdgcn_update_dpp(0, __float_as_int(v), 0x122, 0xf, 0xf, false));
    v += __int_as_float(__builtin_amdgcn_update_dpp(0, __float_as_int(v), 0x124, 0xf, 0xf, false));
    v += __int_as_float(__builtin_amdgcn_update_dpp(0, __float_as_int(v), 0x128, 0xf, 0xf, false));
    v += __int_as_float(__builtin_amdgcn_update_dpp(0, __float_as_int(v), 0x142, 0xa, 0xf, false));
    v += __int_as_float(__builtin_amdgcn_update_dpp(0, __float_as_int(v), 0x143, 0xc, 0xf, false));
    return __int_as_float(__builtin_amdgcn_readlane(__float_as_int(v), 63));
}
__device__ __forceinline__ float wave_max(float v) {
    const int ninf = 0xff800000;
    v = fmaxf(v, __int_as_float(__builtin_amdgcn_update_dpp(ninf, __float_as_int(v), 0x121, 0xf, 0xf, false)));
    v = fmaxf(v, __int_as_float(__builtin_amdgcn_update_dpp(ninf, __float_as_int(v), 0x122, 0xf, 0xf, false)));
    v = fmaxf(v, __int_as_float(__builtin_amdgcn_update_dpp(ninf, __float_as_int(v), 0x124, 0xf, 0xf, false)));
    v = fmaxf(v, __int_as_float(__builtin_amdgcn_update_dpp(ninf, __float_as_int(v), 0x128, 0xf, 0xf, false)));
    v = fmaxf(v, __int_as_float(__builtin_amdgcn_update_dpp(ninf, __float_as_int(v), 0x142, 0xa, 0xf, false)));
    v = fmaxf(v, __int_as_float(__builtin_amdgcn_update_dpp(ninf, __float_as_int(v), 0x143, 0xc, 0xf, false)));
    return __int_as_float(__builtin_amdgcn_readlane(__float_as_int(v), 63));
}
__device__ __forceinline__ int wave_min_i(int v) {
    const int big = 0x7fffffff;
    v = min(v, __builtin_amdgcn_update_dpp(big, v, 0x121, 0xf, 0xf, false));
    v = min(v, __builtin_amdgcn_update_dpp(big, v, 0x122, 0xf, 0xf, false));
    v = min(v, __builtin_amdgcn_update_dpp(big, v, 0x124, 0xf, 0xf, false));
    v = min(v, __builtin_amdgcn_update_dpp(big, v, 0x128, 0xf, 0xf, false));
    v = min(v, __builtin_amdgcn_update_dpp(big, v, 0x142, 0xa, 0xf, false));
    v = min(v, __builtin_amdgcn_update_dpp(big, v, 0x143, 0xc, 0xf, false));
    return __builtin_amdgcn_readlane(v, 63);
}
__device__ __forceinline__ float row16_sum(float v) {
    v += __int_as_float(__builtin_amdgcn_update_dpp(0, __float_as_int(v), 0x121, 0xf, 0xf, false));
    v += __int_as_float(__builtin_amdgcn_update_dpp(0, __float_as_int(v), 0x122, 0xf, 0xf, false));
    v += __int_as_float(__builtin_amdgcn_update_dpp(0, __float_as_int(v), 0x124, 0xf, 0xf, false));
    v += __int_as_float(__builtin_amdgcn_update_dpp(0, __float_as_int(v), 0x128, 0xf, 0xf, false));
    return v;
}
__device__ __forceinline__ int row_batch(int row) { return row < NCTX ? (row >> 8) : ((row - NCTX) >> 12); }
__device__ __forceinline__ int row_modr(int row) { return row < NCTX ? 4 : ((row - NCTX) >> 12); }
#define XB_TMO      128
#define XB_XCNT(j)  (256  + 64 * (j))
#define XB_XSUB(j)  (1280 + 64 * (j))
#define XB_XGEN(j)  (2304 + 64 * (j))
#define XB_TOP      3328
#define XB_TOPGEN   3392
#define XCD_BAR_WORDS 3456
#define XB_SPIN_CAP (1u << 18)

__device__ __forceinline__ unsigned xb_ld(unsigned* p)              { return __hip_atomic_load(p, __ATOMIC_RELAXED, __HIP_MEMORY_SCOPE_AGENT); }
__device__ __forceinline__ unsigned xb_add(unsigned* p, unsigned v) { return __hip_atomic_fetch_add(p, v, __ATOMIC_RELAXED, __HIP_MEMORY_SCOPE_AGENT); }
__device__ __forceinline__ unsigned xb_xcc_id() { return (unsigned)__builtin_amdgcn_s_getreg((3 << 11) | 20) & 0xFu; }
#define XB_SPIN(cond, bar) do { unsigned _sp = 0; while (cond) { __builtin_amdgcn_s_sleep(1); \
    if ((++_sp & 255u) == 0u) { if (xb_ld(&(bar)[XB_TMO])) break; if (_sp > XB_SPIN_CAP) { atomicAdd(&(bar)[XB_TMO], 1u); break; } } } } while (0)

struct XcdBarrier {
    unsigned* bar; unsigned x;
    volatile LAS unsigned* st;
};

__device__ __forceinline__ XcdBarrier xcd_barrier_post(unsigned* bar, volatile LAS unsigned* st) {
    XcdBarrier b; b.bar = bar; b.x = xb_xcc_id(); b.st = st;
    if (threadIdx.x == 0) (void)xb_add(&bar[XB_XCNT(b.x)], 1u);
    return b;
}
__device__ __forceinline__ void xcd_barrier_complete(unsigned* bar, unsigned x, unsigned& nloc, unsigned& nx) {
    const unsigned G = gridDim.x * gridDim.y * gridDim.z;
    unsigned sum, cnt, mine, sp = 0u;
    for (;;) {
        sum = 0u; cnt = 0u; mine = 0u;
#pragma unroll
        for (unsigned j = 0; j < 16; ++j) { const unsigned c = xb_ld(&bar[XB_XCNT(j)]); sum += c; cnt += (c > 0u) ? 1u : 0u; mine = (j == x) ? c : mine; }
        if (sum == G) break;
        __builtin_amdgcn_s_sleep(1);
        if ((++sp & 255u) == 0u) { if (xb_ld(&bar[XB_TMO])) break; if (sp > XB_SPIN_CAP) { atomicAdd(&bar[XB_TMO], 1u); break; } }
    }
    nloc = mine > 0u ? mine : 1u; nx = cnt > 0u ? cnt : 1u;
}

__device__ __forceinline__ void xcd_barrier(const XcdBarrier& b) {
    asm volatile("s_waitcnt vmcnt(0)" ::: "memory");
    __syncthreads();
    if (threadIdx.x == 0) {
        unsigned* bar = b.bar;
        __builtin_amdgcn_s_waitcnt(0);
        unsigned nloc = b.st[0], nx = b.st[1];
        if (nloc == 0u) { xcd_barrier_complete(bar, b.x, nloc, nx); b.st[0] = nloc; b.st[1] = nx; }
        const unsigned old = xb_add(&bar[XB_XSUB(b.x)], 1u);
        const unsigned gen = old / nloc;
        if (old + 1u == (gen + 1u) * nloc) {
            __builtin_amdgcn_fence(__ATOMIC_RELEASE, "agent");
            asm volatile("s_waitcnt vmcnt(0)" ::: "memory");
            const unsigned og = xb_add(&bar[XB_TOP], 1u);
            const unsigned tg = og / nx;
            if (og + 1u == (tg + 1u) * nx) xb_add(&bar[XB_TOPGEN], 1u);
            else XB_SPIN(xb_ld(&bar[XB_TOPGEN]) == tg, bar);
            __builtin_amdgcn_fence(__ATOMIC_ACQUIRE, "agent");
            xb_add(&bar[XB_XGEN(b.x)], 1u);
            asm volatile("s_waitcnt vmcnt(0)" ::: "memory");
        } else {
            XB_SPIN(xb_ld(&bar[XB_XGEN(b.x)]) == gen, bar);
            __builtin_amdgcn_fence(__ATOMIC_ACQUIRE, "agent");
            asm volatile("s_waitcnt vmcnt(0)" ::: "memory");
        }
    }
    __syncthreads();
}
namespace pg8 {
constexpr int BM = 256, BK = 64, HALF = 128, HTB = HALF * BK * 2  , STAGE_BYTES = 8 * HTB, NXCD = 8, WGM = 8;

__host__ __device__ __forceinline__ int lds_byte(int r, int c) { const int st = (r >> 4) * 2 + (c >> 5), rr = r & 15, cc = c & 31, ob = rr * 64 + cc * 2; return st * 1024 + (ob ^ (((ob >> 9) & 1) << 5)); }
__host__ __device__ __forceinline__ void stage_rc(int b, int& R, int& C) { const int st = b / 1024, sb = b % 1024, swz = sb ^ (((sb >> 9) & 1) << 5); R = (st >> 1) * 16 + swz / 64; C = (st & 1) * 32 + (swz % 64) / 2; }
__host__ __device__ __forceinline__ int perm32(int rho) { const int n = rho >> 4, i = rho & 15; return 8 * (i >> 2) + 4 * n + (i & 3); }

struct Unit { int pm, pn; };
struct Gemm { const bf16_t* A; const bf16_t* Bt; int M, N, K; const int* aidx; };
__device__ __forceinline__ unsigned cvt_pk_bf16(float lo, float hi) { return pack_bf16(lo, hi); }
template <class Epi, class Sched, bool STAMP = false, bool ATILED = false, bool BTILED = false, bool AGATHER = false>
__device__ __forceinline__ void gemm_phase(LAS unsigned char* lds, const Gemm g, const Sched& S, const Epi& E, unsigned long long* stamps) {
    const int tid = threadIdx.x, wid = __builtin_amdgcn_readfirstlane(tid >> 6), lane = tid & 63, wr = wid >> 2, wc = wid & 3, fr = lane & 15, fq = lane >> 4;
    const int K = g.K, nt = K / BK;
    int ts_lo = 0, ts_hi = 0, nts = 0; const unsigned long long rt_entry = STAMP ? (unsigned long long)wall_clock64() : 0ull;
#define PG8_STAMP() do { if (STAMP && wid == 0 && nts < 64) { const unsigned long long _c = (unsigned long long)clock64(); \
        ts_lo = (lane == nts) ? (int)(unsigned)_c : ts_lo; ts_hi = (lane == nts) ? (int)(unsigned)(_c >> 32) : ts_hi; ++nts; } } while (0)
    PG8_STAMP();
    unsigned voffA[2], voffB[2];
#pragma unroll
    for (int i = 0; i < 2; ++i) { int R, C; stage_rc(tid * 16 + i * 8192, R, C); const int Rb = Epi::PERM ? ((R & ~31) + perm32(R & 31)) : R;
        voffA[i] = (unsigned)(R * (ATILED ? BK : K) + C) * 2u; voffB[i] = (unsigned)(Rb * (BTILED ? BK : K) + C) * 2u; }
    const size_t kstepA = ATILED ? (size_t)BM * BK * 2 : (size_t)(BK * 2), kstepB = BTILED ? (size_t)BM * BK * 2 : (size_t)(BK * 2);
    const size_t hstepA = ATILED ? (size_t)HALF * BK * 2 : (size_t)HALF * K * 2, hstepB = BTILED ? (size_t)HALF * BK * 2 : (size_t)HALF * K * 2;
    const size_t tstep = (size_t)BM * K * 2;
    const unsigned ldsw = (unsigned)wid * 1024u;
    static_assert(!(AGATHER && ATILED), "a gathered operand is row-major");
    int gR0 = 0, gC0 = 0; { int R, C; stage_rc(tid * 16, R, C); gR0 = R; gC0 = C * 2; }
    unsigned vAc[4] = {0u, 0u, 0u, 0u};
    LAS int* gslot = (LAS int*)(lds + STAGE_BYTES + 8192 + 2048);
    const int aoff = lds_byte(wr * 64 + fr, fq * 8), boff = lds_byte(wc * 32 + fr, fq * 8);
#define PG8_SA(b, h) (((b) * 2 + (h)) * HTB)
#define PG8_SB(b, h) ((4 + (b) * 2 + (h)) * HTB)
#define PG8_STAGE(bufoff, gbase, voff) do { _Pragma("unroll") for (int _i = 0; _i < 2; ++_i) \
        __builtin_amdgcn_global_load_lds((const unsigned*)((const char*)(gbase) + (voff)[_i]), (LAS unsigned*)(lds + (bufoff) + ldsw + _i * 8192), 16, 0, 0); } while (0)
#define PG8_STAGE_A(bufoff, gbase, kbytes, h, vg) do { if constexpr (AGATHER) { _Pragma("unroll") for (int _i = 0; _i < 2; ++_i) \
        __builtin_amdgcn_global_load_lds((const unsigned*)((const char*)g.A + (kbytes) + (vg)[(h) * 2 + _i]), (LAS unsigned*)(lds + (bufoff) + ldsw + _i * 8192), 16, 0, 0); } \
        else PG8_STAGE(bufoff, gbase, voffA); } while (0)
#define PG8_LDA(dst, b, h) do { _Pragma("unroll") for (int m = 0; m < 4; ++m) _Pragma("unroll") for (int k = 0; k < 2; ++k) dst[m][k] = *(const LAS bf16x8*)(lds + PG8_SA(b, h) + aoff + m * 2048 + k * 1024); } while (0)
#define PG8_LDB(dst, b, h) do { _Pragma("unroll") for (int n = 0; n < 2; ++n) _Pragma("unroll") for (int k = 0; k < 2; ++k) dst[n][k] = *(const LAS bf16x8*)(lds + PG8_SB(b, h) + boff + n * 2048 + k * 1024); } while (0)
#define PG8_MMA(ai, bj, At, Bt) do { __builtin_amdgcn_s_setprio(1); _Pragma("unroll") for (int m = 0; m < 4; ++m) _Pragma("unroll") for (int n = 0; n < 2; ++n) _Pragma("unroll") for (int k = 0; k < 2; ++k) \
        acc[ai][bj][m][n] = __builtin_amdgcn_mfma_f32_16x16x32_bf16(Bt[n][k], At[m][k], acc[ai][bj][m][n], 0, 0, 0); __builtin_amdgcn_s_setprio(0); } while (0)
#define PG8_WAIT_V(n) asm volatile("s_waitcnt vmcnt(" #n ")" ::: "memory")
#define PG8_WAIT_L(n) asm volatile("s_waitcnt lgkmcnt(" #n ")" ::: "memory")
#define PG8_BAR __builtin_amdgcn_s_barrier()
#define PG8_SCHED __builtin_amdgcn_sched_barrier(0)
    Unit cur, nxt; int ui = 0;
    if (!S.next(0, cur)) return;
    f32x4 acc[2][2][4][2];
#pragma unroll
    for (int a = 0; a < 2; ++a)
#pragma unroll
        for (int b = 0; b < 2; ++b)
#pragma unroll
            for (int m = 0; m < 4; ++m)
#pragma unroll
                for (int n = 0; n < 2; ++n) acc[a][b][m][n] = (f32x4){0.f, 0.f, 0.f, 0.f};
    bf16x8 At[4][2], B0[2][2], B1[2][2];
    const char* cA = (const char*)g.A + (size_t)cur.pm * tstep; const char* cB = (const char*)g.Bt + (size_t)cur.pn * tstep;
    S.a_ready(cur);
    if constexpr (AGATHER) {
#pragma unroll
        for (int j = 0; j < 4; ++j) vAc[j] = (unsigned)g.aidx[cur.pm * BM + gR0 + 64 * j] * (unsigned)(K * 2) + (unsigned)gC0;
    }
    PG8_STAGE(PG8_SB(0, 0), cB, voffB); PG8_STAGE_A(PG8_SA(0, 0), cA, 0, 0, vAc); PG8_STAGE(PG8_SB(0, 1), cB + hstepB, voffB); PG8_STAGE_A(PG8_SA(0, 1), cA + hstepA, 0, 1, vAc);
    if (wr == 1) PG8_BAR;
    PG8_WAIT_V(4); PG8_BAR;
    PG8_STAGE(PG8_SB(1, 0), cB + kstepB, voffB); PG8_STAGE_A(PG8_SA(1, 0), cA + kstepA, BK * 2, 0, vAc); PG8_STAGE(PG8_SB(1, 1), cB + hstepB + kstepB, voffB);
    PG8_WAIT_V(6); PG8_BAR;
    PG8_STAMP();
    for (;;) {
        const bool has_next = S.next(ui + 1, nxt);
        const char* nA = has_next ? (const char*)g.A + (size_t)nxt.pm * tstep : cA; const char* nB = has_next ? (const char*)g.Bt + (size_t)nxt.pn * tstep : cB;
        E.pre(lds, ui & 1, cur, wid, lane);
        if constexpr (AGATHER) { if (has_next && wid == 0) __builtin_amdgcn_global_load_lds((const unsigned*)(g.aidx + nxt.pm * BM + lane * 4), (LAS unsigned*)(gslot + ((ui + 1) & 1) * 256), 16, 0, 0); }
        for (int t = 0; t < nt; t += 2) {
            const bool last = (t == nt - 2);
            const char* a1 = cA + (size_t)(t + 1) * kstepA;
            const char* a2 = last ? nA : cA + (size_t)(t + 2) * kstepA; const char* b2 = last ? nB : cB + (size_t)(t + 2) * kstepB;
            const char* a3 = a2 + kstepA; const char* b3 = b2 + kstepB;
            if (last && has_next) S.a_ready(nxt);
            const int kb2 = AGATHER ? (last ? 0 : (t + 2) * BK * 2) : 0;
            PG8_LDB(B0, 0, 0); PG8_SCHED; PG8_LDA(At, 0, 0); PG8_STAGE_A(PG8_SA(1, 1), a1 + hstepA, (t + 1) * BK * 2, 1, vAc);
            if constexpr (AGATHER) { if (last && has_next) {
#pragma unroll
                for (int j = 0; j < 4; ++j) vAc[j] = (unsigned)gslot[((ui + 1) & 1) * 256 + gR0 + 64 * j] * (unsigned)(K * 2) + (unsigned)gC0; } }
            PG8_WAIT_L(8); PG8_BAR; PG8_WAIT_L(0); PG8_MMA(0, 0, At, B0); PG8_BAR; PG8_SCHED;
            PG8_LDB(B1, 0, 1); PG8_STAGE(PG8_SB(0, 0), b2, voffB);
            PG8_BAR; PG8_WAIT_L(0); PG8_MMA(0, 1, At, B1); PG8_BAR;
            PG8_LDA(At, 0, 1); PG8_STAGE_A(PG8_SA(0, 0), a2, kb2, 0, vAc);
            PG8_BAR; PG8_WAIT_L(0); PG8_MMA(1, 0, At, B0); PG8_BAR; PG8_SCHED;
            PG8_STAGE(PG8_SB(0, 1), b2 + hstepB, voffB);
            PG8_WAIT_V(6); PG8_BAR; PG8_MMA(1, 1, At, B1); PG8_BAR;
            PG8_LDB(B0, 1, 0); PG8_SCHED; PG8_LDA(At, 1, 0); PG8_STAGE_A(PG8_SA(0, 1), a2 + hstepA, kb2, 1, vAc);
            PG8_WAIT_L(8); PG8_BAR; PG8_WAIT_L(0); PG8_MMA(0, 0, At, B0); PG8_BAR; PG8_SCHED;
            PG8_LDB(B1, 1, 1); PG8_STAGE(PG8_SB(1, 0), b3, voffB);
            PG8_BAR; PG8_WAIT_L(0); PG8_MMA(0, 1, At, B1); PG8_BAR;
            PG8_LDA(At, 1, 1); PG8_STAGE_A(PG8_SA(1, 0), a3, kb2 + BK * 2, 0, vAc);
            PG8_BAR; PG8_WAIT_L(0); PG8_MMA(1, 0, At, B0); PG8_BAR; PG8_SCHED;
            PG8_STAGE(PG8_SB(1, 1), b3 + hstepB, voffB);
            PG8_WAIT_V(6); PG8_BAR; PG8_MMA(1, 1, At, B1); PG8_BAR;
        }
        PG8_STAMP();
        if constexpr (!Epi::AFTER_DRAIN) { E(acc, cur, wr, wc, fr, fq, lds, ui & 1); S.done(cur); }
        PG8_STAMP();
        if (!has_next) break;
#pragma unroll
        for (int a = 0; a < 2; ++a)
#pragma unroll
            for (int b = 0; b < 2; ++b)
#pragma unroll
                for (int m = 0; m < 4; ++m)
#pragma unroll
                    for (int n = 0; n < 2; ++n) acc[a][b][m][n] = (f32x4){0.f, 0.f, 0.f, 0.f};
        cur = nxt; cA = nA; cB = nB; ++ui;

    }
    PG8_WAIT_V(0);
    if (wr == 0) PG8_BAR;
    PG8_BAR;
    if constexpr (Epi::AFTER_DRAIN) { E.fused(acc, cur, wr, wc, fr, fq, lds, wid, lane); S.done(cur); }
    PG8_STAMP();
    if (STAMP && wid == 0) { stamps[lane] = lane < nts ? (((unsigned long long)(unsigned)ts_hi << 32) | (unsigned)ts_lo) : 0ull;
        if (lane == 62) stamps[62] = rt_entry; if (lane == 63) stamps[63] = (unsigned long long)wall_clock64(); }
#undef PG8_STAMP
#undef PG8_SA
#undef PG8_SB
#undef PG8_STAGE
#undef PG8_STAGE_A
#undef PG8_LDA
#undef PG8_LDB
#undef PG8_MMA
#undef PG8_WAIT_V
#undef PG8_WAIT_L
#undef PG8_BAR
#undef PG8_SCHED
}
__device__ __forceinline__ int xcd_contig(long L, int nwg) { const int q = nwg / NXCD, r = nwg % NXCD, xcd = (int)(L % NXCD), off = (int)(L / NXCD); return (xcd < r ? xcd * (q + 1) : r * (q + 1) + (xcd - r) * q) + off; }
template <int nN>
struct SchedDense {
    int nM, pm0, G, c;
    __device__ __forceinline__ bool next(int i, Unit& u) const {
        const long L = (long)i * G + c; const int nwg = nM * nN; if (L >= nwg) return false;
        const int wgid = xcd_contig(L, nwg);
        constexpr int nig = WGM * nN; const int gid = wgid / nig, fm = gid * WGM, gsz = (nM - fm) < WGM ? (nM - fm) : WGM, w = wgid % nig;
        if (gsz == WGM) { u.pm = pm0 + fm + (w & (WGM - 1)); u.pn = w >> 3; } else { u.pm = pm0 + fm + (w % gsz); u.pn = w / gsz; }
        return true; }
    __device__ __forceinline__ void a_ready(const Unit&) const {}
    __device__ __forceinline__ void done(const Unit&) const {}
};
template <int nN>
struct SchedMoe {
    int T, G, c; const LAS int* tileE;
    __device__ __forceinline__ bool next(int i, Unit& u) const { const long L = (long)i * G + c; const int nwg = T * nN; if (L >= nwg) return false;
        const int wgid = xcd_contig(L, nwg), pt = wgid / nN; u.pm = pt; u.pn = tileE[pt] * nN + (wgid % nN); return true; }
    __device__ __forceinline__ void a_ready(const Unit&) const {}
    __device__ __forceinline__ void done(const Unit&) const {}
};
constexpr int EPI_BIAS_OFF = STAGE_BYTES + 8192;
struct EpiStore {
    static constexpr bool PERM = true, AFTER_DRAIN = false;
    bf16_t* O; int ldc;
    __device__ __forceinline__ void pre(LAS unsigned char*, int, const Unit&, int, int) const {}
    __device__ __forceinline__ void operator()(const f32x4 (&acc)[2][2][4][2], const Unit& u, int wr, int wc, int fr, int fq, const LAS unsigned char*, int) const {
        const int row0 = u.pm * BM + wr * 64 + fr, col0 = u.pn * BM + wc * 32 + 8 * fq;
#pragma unroll
        for (int ai = 0; ai < 2; ++ai)
#pragma unroll
            for (int m = 0; m < 4; ++m) { bf16_t* rowp = O + (size_t)(row0 + ai * HALF + m * 16) * ldc + col0;
#pragma unroll
                for (int bj = 0; bj < 2; ++bj) { const f32x4 v0 = acc[ai][bj][m][0], v1 = acc[ai][bj][m][1];
                    u32x4 w; w.x = cvt_pk_bf16(v0[0], v0[1]); w.y = cvt_pk_bf16(v0[2], v0[3]); w.z = cvt_pk_bf16(v1[0], v1[1]); w.w = cvt_pk_bf16(v1[2], v1[3]);
                    *(u32x4*)(rowp + bj * HALF) = w; } }
    }
};
struct EpiYE {
    static constexpr bool PERM = true, AFTER_DRAIN = false;
    bf16_t* O; const float* b2;
    __device__ __forceinline__ void pre(LAS unsigned char* lds, int par, const Unit& u, int wid, int lane) const {
        if (wid == 0) __builtin_amdgcn_global_load_lds((const unsigned*)(b2 + (u.pn >> 2) * 1024 + (u.pn & 3) * BM + lane * 4), (LAS unsigned*)(lds + EPI_BIAS_OFF + par * 1024), 16, 0, 0);
    }
    __device__ __forceinline__ void operator()(const f32x4 (&acc)[2][2][4][2], const Unit& u, int wr, int wc, int fr, int fq, const LAS unsigned char* lds, int par) const {
        const int pn = u.pn & 3;
        const int row0 = u.pm * BM + wr * 64 + fr, col0 = pn * BM + wc * 32 + 8 * fq;
        const LAS float* bp = (const LAS float*)(lds + EPI_BIAS_OFF + par * 1024) + wc * 32 + 8 * fq;
        f32x4 bv[2][2];
#pragma unroll
        for (int bj = 0; bj < 2; ++bj)
#pragma unroll
            for (int n = 0; n < 2; ++n) bv[bj][n] = *(const LAS f32x4*)(bp + bj * HALF + 4 * n);
#pragma unroll
        for (int ai = 0; ai < 2; ++ai)
#pragma unroll
            for (int m = 0; m < 4; ++m) { bf16_t* rowp = O + (size_t)(row0 + ai * HALF + m * 16) * 1024 + col0;
#pragma unroll
                for (int bj = 0; bj < 2; ++bj) { const f32x4 v0 = acc[ai][bj][m][0] + bv[bj][0], v1 = acc[ai][bj][m][1] + bv[bj][1];
                    u32x4 w; w.x = cvt_pk_bf16(v0[0], v0[1]); w.y = cvt_pk_bf16(v0[2], v0[3]); w.z = cvt_pk_bf16(v1[0], v1[1]); w.w = cvt_pk_bf16(v1[2], v1[3]);
                    *(u32x4*)(rowp + bj * HALF) = w; } }
    }
};
struct EpiAct {
    static constexpr bool PERM = true, AFTER_DRAIN = false;
    bf16_t* O; const float* b1;
    __device__ __forceinline__ void pre(LAS unsigned char* lds, int par, const Unit& u, int wid, int lane) const {
        if (wid == 0) __builtin_amdgcn_global_load_lds((const unsigned*)(b1 + (u.pn >> 3) * 2048 + (lane >> 5) * 1024 + (u.pn & 7) * 128 + (lane & 31) * 4), (LAS unsigned*)(lds + EPI_BIAS_OFF + par * 1024), 16, 0, 0);
    }
    __device__ __forceinline__ void operator()(const f32x4 (&acc)[2][2][4][2], const Unit& u, int wr, int wc, int fr, int fq, const LAS unsigned char* lds, int par) const {
        const int pn = u.pn & 7;
        const int row0 = u.pm * BM + wr * 64 + fr, x0 = pn * 128 + wc * 32 + 8 * fq;
        const LAS float* bg = (const LAS float*)(lds + EPI_BIAS_OFF + par * 1024) + wc * 32 + 8 * fq; const LAS float* bl = bg + 128;
        const f32x4 g0 = *(const LAS f32x4*)bg, g1 = *(const LAS f32x4*)(bg + 4), l0 = *(const LAS f32x4*)bl, l1 = *(const LAS f32x4*)(bl + 4);
#pragma unroll
        for (int ai = 0; ai < 2; ++ai)
#pragma unroll
            for (int m = 0; m < 4; ++m) {
                float o[8];
#pragma unroll
                for (int n = 0; n < 2; ++n)
#pragma unroll
                    for (int j = 0; j < 4; ++j) {
                        float glu = acc[ai][0][m][n][j] + (n ? g1[j] : g0[j]);
                        float lin = acc[ai][1][m][n][j] + (n ? l1[j] : l0[j]);
                        glu = fminf(glu, 7.0f); lin = fminf(fmaxf(lin, -7.0f), 7.0f);
                        o[n * 4 + j] = (lin + 1.0f) * glu * __builtin_amdgcn_rcpf(1.0f + __expf(-1.702f * glu));
                    }
                u32x4 w; w.x = cvt_pk_bf16(o[0], o[1]); w.y = cvt_pk_bf16(o[2], o[3]); w.z = cvt_pk_bf16(o[4], o[5]); w.w = cvt_pk_bf16(o[6], o[7]);
                *(u32x4*)(O + ((size_t)(u.pm * 16 + (x0 >> 6)) * 256 + (wr * 64 + fr + ai * HALF + m * 16)) * 64 + (x0 & 63)) = w;
            }
    }
};
}
using pg8::Unit;
__device__ __forceinline__ void my_sincos(double a, float& s, float& c) {
    const double n = rint(a * 0.63661977236758134308);
    const double r = (a - n * 1.57079632679489655800e+00) - n * 6.12323399573676603587e-17;
    const double r2 = r * r;
    const double sp = r * (1.0 + r2 * (-1.0 / 6.0 + r2 * (1.0 / 120.0 + r2 * (-1.0 / 5040.0 + r2 * (1.0 / 362880.0 + r2 * (-1.0 / 39916800.0 + r2 * (1.0 / 6227020800.0 + r2 * (-1.0 / 1307674368000.0))))))));
    const double cp = 1.0 + r2 * (-0.5 + r2 * (1.0 / 24.0 + r2 * (-1.0 / 720.0 + r2 * (1.0 / 40320.0 + r2 * (-1.0 / 3628800.0 + r2 * (1.0 / 479001600.0 + r2 * (-1.0 / 87178291200.0 + r2 * (1.0 / 20922789888000.0))))))));
    const int q = ((int)n) & 3;
    const double sn = q == 0 ? sp : q == 1 ? cp : q == 2 ? -sp : -cp;
    const double cn = q == 0 ? cp : q == 1 ? -sp : q == 2 ? -cp : sp;
    s = (float)sn; c = (float)cn;
}
__device__ __forceinline__ void ph_prologue(const Params& p, LAS unsigned char* lds, int bid, int nblk) {
    const int tid = threadIdx.x;
    unsigned char* ws = p.ws;
    {
        LAS float* sv = (LAS float*)(lds + LDS_WORK);
        LAS float* red = sv + 5 * 1024;
        for (int i = tid; i < 5 * 1024; i += NTHR) { const int r = i >> 10, k = i & 1023; const float c = r < 4 ? p.in[I_C][r * 1024 + k] : p.in[I_CCTX][k]; sv[i] = c / (1.0f + expf(-c)); }
        __syncthreads();
        float* MOD = (float*)(ws + WS_MOD);
        for (int item = bid; item < 256; item += nblk) {
            if (tid < 480) {
                const int cl = tid % 48, kp = tid / 48;
                const int gc = item * 48 + cl, l = gc / 6144, n = gc % 6144;
                const float* w = p.in[I_WMOD] + (size_t)l * 1024 * 6144 + n;
                float a0 = 0.f, a1 = 0.f, a2 = 0.f, a3 = 0.f, a4 = 0.f;
#pragma unroll 1
                for (int k0 = kp; k0 < 1024; k0 += 130) {
                    float wv[13];
#pragma unroll
                    for (int u = 0; u < 13; ++u) { const int k = k0 + 10 * u; wv[u] = k < 1024 ? w[(size_t)k * 6144] : 0.f; }
#pragma unroll
                    for (int u = 0; u < 13; ++u) { const int k = k0 + 10 * u < 1024 ? k0 + 10 * u : 1023; a0 += sv[k] * wv[u]; a1 += sv[1024 + k] * wv[u]; a2 += sv[2048 + k] * wv[u]; a3 += sv[3072 + k] * wv[u]; a4 += sv[4096 + k] * wv[u]; }
                }
                LAS float* rp = red + (kp * 48 + cl) * 5; rp[0] = a0; rp[1] = a1; rp[2] = a2; rp[3] = a3; rp[4] = a4;
            }
            __syncthreads();
            if (tid < 240) {
                const int cl = tid / 5, r = tid % 5; float s = 0.f;
                for (int kp = 0; kp < 10; ++kp) s += red[(kp * 48 + cl) * 5 + r];
                const int gc = item * 48 + cl, l = gc / 6144, n = gc % 6144;
                MOD[(size_t)(l * 5 + r) * 6144 + n] = s + p.in[I_BMOD][l * 6144 + n];
            }
            __syncthreads();
        }
    }
    if (bid == (nblk > 1 ? 1 : 0)) {
        float* ROPE = (float*)(ws + WS_ROPE);
        for (int i = tid; i < 2048; i += NTHR) { const int pos = i >> 5, f = i & 31; const double inv = exp(-(double)f * 0.28782313662425575); float s, c; my_sincos((double)pos * inv, s, c); ROPE[2 * i] = c; ROPE[2 * i + 1] = s; }
    }
    {
        bf16_t* WLT = (bf16_t*)(ws + WS_WLT);
        for (int i = bid * NTHR + tid; i < (int)WLT_N; i += nblk * NTHR) {
            float v;
            if (i < 131072) { const int which = i >> 16, r = i & 65535, d = r >> 15, n = (r >> 6) & 511, k = r & 63; v = (which ? p.in[I_AAB] : p.in[I_AWB])[(size_t)(d * 64 + k) * 512 + n]; }
            else if (i < 196608) { const int r = i - 131072, n = r >> 7, k = r & 127; v = p.in[I_AGB][(size_t)k * 512 + n]; }
            else { const int r = i - 196608, blk = r >> 12, o = (r >> 6) & 63, ii = r & 63; v = p.in[I_BGW][(size_t)blk * 4096 + ii * 64 + o]; }
            WLT[i] = f2bf(v);
        }
    }
    {
        LAS float* tile = (LAS float*)(lds + LDS_WORK);
        for (int t = bid; t < 576; t += nblk) {
            const float* src; int ld, nvalid, k0, n0, w1map = 0; bf16_t* dst; int tt = t;
            if (tt < 192) { k0 = (tt / 12) * 64; n0 = (tt % 12) * 256; src = p.in[I_EWIN]; ld = EVEN_IN; nvalid = EVEN_IN; dst = (bf16_t*)(ws + WS_WIN0T); }
            else if ((tt -= 192) < 256) { k0 = (tt >> 4) * 64; n0 = (tt & 15) * 256; src = p.in[I_OWIN]; ld = ODD_IN; nvalid = 4096; dst = (bf16_t*)(ws + WS_WIN1T); }
            else { tt -= 256; const int mat = tt >> 6, r = tt & 63; k0 = (r >> 2) * 64; n0 = (r & 3) * 256; src = mat ? p.in[I_OWOUT] : p.in[I_EWOUT]; ld = 1024; nvalid = 1024; dst = (bf16_t*)(ws + WS_WOUTT) + (size_t)mat * 1024 * 1024; }
            {
                const int j4 = (tid & 63) * 4, i0 = tid >> 6;
                f32x4 v[8];
#pragma unroll
                for (int r = 0; r < 8; ++r) v[r] = (n0 + j4 < nvalid) ? *(const f32x4*)(src + (size_t)(k0 + i0 + 8 * r) * ld + n0 + j4) : (f32x4){0.f, 0.f, 0.f, 0.f};
#pragma unroll
                for (int r = 0; r < 8; ++r) { LAS float* tp = tile + (i0 + 8 * r) * 257 + j4; tp[0] = v[r][0]; tp[1] = v[r][1]; tp[2] = v[r][2]; tp[3] = v[r][3]; }
            }
            __syncthreads();
            {
                const int ip = (tid & 31) * 2, j0 = tid >> 5;
#pragma unroll
                for (int r = 0; r < 16; ++r) {
                    const int j = j0 + 16 * r, n = n0 + j;
                    const int rho = w1map ? ((((n & 1023) >> 7) << 8) + ((n >> 10) << 7) + (n & 127)) : n;
                    *(unsigned*)(dst + (size_t)rho * 1024 + k0 + ip) = pack_bf16(tile[ip * 257 + j], tile[(ip + 1) * 257 + j]);
                }
            }
            __syncthreads();
        }
    }
}
__device__ __forceinline__ void ph_mod_in(const Params& p, int bid, int nblk) {
    const int tid = threadIdx.x, wid = tid >> 6, lane = tid & 63;
    const float* MOD = (const float*)(p.ws + WS_MOD);
    bf16_t* H = (bf16_t*)(p.ws + WS_H);
    for (int row = bid * 8 + wid; row < MROWS; row += nblk * 8) {
        const float* src = row < NCTX ? p.in[I_CTX] + (size_t)row * 1024 : p.in[I_X] + (size_t)(row - NCTX) * 1024;
        const float* md = MOD + (size_t)row_modr(row) * 6144;
#pragma unroll
        for (int q = 0; q < 4; ++q) {
            const int col = q * 256 + lane * 4;
            const f32x4 x = *(const f32x4*)(src + col), sh = *(const f32x4*)(md + col), sc = *(const f32x4*)(md + 1024 + col);
            const f32x4 h = x * (sc + 1.0f) + sh;
            u32x2 w; w.x = pack_bf16(h[0], h[1]); w.y = pack_bf16(h[2], h[3]);
            *(u32x2*)(H + (size_t)row * 1024 + col) = w;
        }
    }
}
__device__ __forceinline__ int even_tok_row(int w, int idx) { return idx < 64 ? NCTX + (w >> 6) * 4096 + (w & 63) * 64 + idx : w * 4 + (idx - 64); }
__device__ __forceinline__ int shift_nb(int row, int cc) {
    if (row >= NCTX) { const int s = (row - NCTX) & 4095, gr = s >> 6, gc = s & 63, slot = cc & 3;
        if (slot == 0) return gc > 0 ? row - 1 : -1;
        if (slot == 1) return gc < 63 ? row + 1 : -1;
        if (slot == 2) return gr > 0 ? row - 64 : -1;
        return gr < 63 ? row + 64 : -1; }
    const int t = row & 255; return (cc & 1) == 0 ? (t > 0 ? row - 1 : -1) : (t < 255 ? row + 1 : -1);
}
__device__ __forceinline__ float shifted_z(const bf16_t* P, const float* mu, int row, int cc) {
    const float pv = bf2f(P[(size_t)row * LDP0 + cc]); const int nb = shift_nb(row, cc);
    const float sv = nb >= 0 ? bf2f(P[(size_t)nb * LDP0 + cc]) : 0.f;
    return pv + (sv - pv) * mu[cc];
}
__device__ __forceinline__ int scan_q(int row, int d) {
    if (row < NCTX) { const int t = row & 255; return d ? 255 - t : t; }
    const int s = (row - NCTX) & 4095; return 256 + (d ? 4095 - s : s);
}
__device__ __forceinline__ bf16_t* sc_rec(float* SC, int d, int row, int h) { return (bf16_t*)SC + ((size_t)((d * 4 + row_batch(row)) * 8 + h) * SCLEN + scan_q(row, d)) * SCREC; }
constexpr int LDL = 392, LDU = 520;
template <int KS>
__device__ __forceinline__ void load_b(const bf16_t* Bt, bf16x8 (&b)[4][KS], int lane) {
    const int fr = lane & 15, fq = lane >> 4;
#pragma unroll
    for (int nt = 0; nt < 4; ++nt)
#pragma unroll
        for (int ks = 0; ks < KS; ++ks) b[nt][ks] = *(const bf16x8*)(Bt + (size_t)(nt * 16 + fr) * (32 * KS) + ks * 32 + fq * 8);
}
template <int KS>
__device__ __forceinline__ void mma_mt(const LAS bf16_t* A, int lda, int mt, const bf16x8 (&b)[4][KS], f32x4 (&acc)[4], int lane) {
    const int fr = lane & 15, fq = lane >> 4;
#pragma unroll
    for (int nt = 0; nt < 4; ++nt) acc[nt] = (f32x4){0.f, 0.f, 0.f, 0.f};
#pragma unroll
    for (int ks = 0; ks < KS; ++ks) {
        const bf16x8 a = *(const LAS bf16x8*)(A + (mt * 16 + fr) * lda + ks * 32 + fq * 8);
#pragma unroll
        for (int nt = 0; nt < 4; ++nt) acc[nt] = __builtin_amdgcn_mfma_f32_16x16x32_bf16(a, b[nt][ks], acc[nt], 0, 0, 0);
    }
}
__device__ __forceinline__ void ph_prep_even(const Params& p, LAS unsigned char* lds, int bid, int nblk) {
    const int tid = threadIdx.x, wid = tid >> 6, lane = tid & 63, c = tid, fr = lane & 15, fq = lane >> 4;
    const bf16_t* P = (const bf16_t*)(p.ws + WS_P);
    float* SC = (float*)(p.ws + WS_SC);
    float* EA = (float*)(p.ws + WS_EARR);
#define EARR(k) (EA + (size_t)(k) * ((size_t)MROWS * 512))
    float* BC = (float*)(p.ws + WS_BC);
    float* CHA = (float*)(p.ws + WS_CHA); float* CHH = (float*)(p.ws + WS_CHH);
    const bf16_t* WLT = (const bf16_t*)(p.ws + WS_WLT);
    const float* mu = p.in[I_AMU];
    LAS bf16_t* linb = (LAS bf16_t*)(lds + LDS_WORK);
    LAS bf16_t* ub = linb + 80 * LDL;
    LAS float* rnorm = (LAS float*)(ub + 80 * LDU);
    for (int w = bid; w < 256; w += nblk) {
        for (int i = tid; i < 12 * LDL; i += NTHR) linb[68 * LDL + i] = 0;
        for (int i = tid; i < 12 * LDU; i += NTHR) ub[68 * LDU + i] = 0;
        if (lane < 48) {
            float mul8[8];
#pragma unroll
            for (int i = 0; i < 8; ++i) mul8[i] = mu[1536 + lane * 8 + i];
#pragma unroll 1
            for (int tok = wid; tok < 68; tok += 8) {
                const int row = even_tok_row(w, tok);
                const u32x4 ps = *(const u32x4*)(P + (size_t)row * LDP0 + 1536 + lane * 8);
                u32x4 pn[4];
#pragma unroll
                for (int sl = 0; sl < 4; ++sl) { const int nb = shift_nb(row, sl); pn[sl] = nb >= 0 ? *(const u32x4*)(P + (size_t)nb * LDP0 + 1536 + lane * 8) : (u32x4){0u, 0u, 0u, 0u}; }
                float z[8];
#pragma unroll
                for (int i = 0; i < 8; ++i) { const unsigned wp = ps[i >> 1], wn = pn[i & 3][i >> 1];
                    const float pv = __uint_as_float((i & 1) ? (wp & 0xffff0000u) : (wp << 16)), sv = __uint_as_float((i & 1) ? (wn & 0xffff0000u) : (wn << 16));
                    const float zz = pv + (sv - pv) * mul8[i];
                    z[i] = lane < 16 ? ftanh(zz) : (lane < 32 ? zz : sigm(zz)); }
                u32x4 q;
#pragma unroll
                for (int i = 0; i < 4; ++i) q[i] = pack_bf16(z[2 * i], z[2 * i + 1]);
                *(LAS u32x4*)(linb + tok * LDL + lane * 8) = q;
            }
        }
        {
            float murv[8], mukv8[8], muvv[8], kkc8[8];
#pragma unroll
            for (int i = 0; i < 8; ++i) { murv[i] = mu[lane * 8 + i]; mukv8[i] = mu[512 + lane * 8 + i]; muvv[i] = mu[1024 + lane * 8 + i]; kkc8[i] = p.in[I_AKK][lane * 8 + i]; }
#pragma unroll 1
            for (int tok = wid; tok < 68; tok += 8) {
                const int row = even_tok_row(w, tok);
                int nbr[4];
#pragma unroll
                for (int sl = 0; sl < 4; ++sl) nbr[sl] = shift_nb(row, sl);
                u32x4 ps[3], pn[3][4];
#pragma unroll
                for (int a = 0; a < 3; ++a) { ps[a] = *(const u32x4*)(P + (size_t)row * LDP0 + a * 512 + lane * 8);
#pragma unroll
                    for (int sl = 0; sl < 4; ++sl) pn[a][sl] = nbr[sl] >= 0 ? *(const u32x4*)(P + (size_t)nbr[sl] * LDP0 + a * 512 + lane * 8) : (u32x4){0u, 0u, 0u, 0u}; }
                float z[3][8];
#pragma unroll
                for (int a = 0; a < 3; ++a)
#pragma unroll
                    for (int i = 0; i < 8; ++i) { const unsigned wp = ps[a][i >> 1], wn = pn[a][i & 3][i >> 1];
                        const float pv = __uint_as_float((i & 1) ? (wp & 0xffff0000u) : (wp << 16)), sv = __uint_as_float((i & 1) ? (wn & 0xffff0000u) : (wn << 16));
                        z[a][i] = pv + (sv - pv) * (a == 0 ? murv[i] : (a == 1 ? mukv8[i] : muvv[i])); }
                float kkr[8], ss = 0.f;
#pragma unroll
                for (int i = 0; i < 8; ++i) { kkr[i] = z[1][i] * kkc8[i]; ss += kkr[i] * kkr[i]; }
                ss += __int_as_float(__builtin_amdgcn_update_dpp(0, __float_as_int(ss), 0xb1, 0xf, 0xf, false));
                ss += __int_as_float(__builtin_amdgcn_update_dpp(0, __float_as_int(ss), 0x4e, 0xf, 0xf, false));
                ss += __int_as_float(__builtin_amdgcn_update_dpp(0, __float_as_int(ss), 0x141, 0xf, 0xf, false));
                const float rn = frcp(fmaxf(fsqrt(ss), 1e-12f));
                if ((lane & 7) == 0) rnorm[tok * 8 + (lane >> 3)] = rn;
                u32x4 qk, qr, qv;
#pragma unroll
                for (int i = 0; i < 4; ++i) { qk[i] = pack_bf16(kkr[2 * i] * rn, kkr[2 * i + 1] * rn); qr[i] = pack_bf16(z[0][2 * i], z[0][2 * i + 1]); qv[i] = pack_bf16(z[2][2 * i], z[2][2 * i + 1]); }
#pragma unroll
                for (int d = 0; d < 2; ++d) { bf16_t* rec = sc_rec(SC, d, row, lane >> 3) + (lane & 7) * 8; *(u32x4*)(rec + 128) = qk; *(u32x4*)(rec + 320) = qr; *(u32x4*)(rec + 384) = qv; }
            }
        }
        {
            float cw[4][8], cb8[8];
#pragma unroll
            for (int i = 0; i < 8; ++i) { cb8[i] = p.in[I_BCB][lane * 8 + i];
#pragma unroll
                for (int k = 0; k < 4; ++k) cw[k][i] = p.in[I_BCW][k * 512 + lane * 8 + i]; }
#pragma unroll 1
            for (int tok = wid; tok < 68; tok += 8) {
                const int row = even_tok_row(w, tok);
                int pos, len;
                if (row >= NCTX) { pos = (row - NCTX) & 4095; len = 4096; } else { pos = row & 255; len = 256; }
                const u32x4 zero4 = {0u, 0u, 0u, 0u};
                const bf16_t* px = P + (size_t)row * LDP0 + 1920 + lane * 8;
                u32x4 xv[4];
                xv[0] = pos >= 2 ? *(const u32x4*)(px - 2 * (size_t)LDP0) : zero4; xv[1] = pos >= 1 ? *(const u32x4*)(px - (size_t)LDP0) : zero4;
                xv[2] = *(const u32x4*)px; xv[3] = pos + 1 < len ? *(const u32x4*)(px + (size_t)LDP0) : zero4;
                const u32x4 gxv = *(const u32x4*)(px + 512);
                float uu[8], gg[8];
#pragma unroll
                for (int i = 0; i < 8; ++i) { float a = cb8[i];
#pragma unroll
                    for (int k = 0; k < 4; ++k) { const unsigned wv = xv[k][i >> 1]; a += cw[k][i] * __uint_as_float((i & 1) ? (wv & 0xffff0000u) : (wv << 16)); }
                    uu[i] = a;
                    const unsigned wg = gxv[i >> 1]; const float gx = __uint_as_float((i & 1) ? (wg & 0xffff0000u) : (wg << 16));
                    gg[i] = 0.5f * gx * (1.0f + ftanh(0.7978845608028654f * (gx + 0.044715f * gx * gx * gx))); }
                u32x4 qu, qg;
#pragma unroll
                for (int i = 0; i < 4; ++i) { qu[i] = pack_bf16(uu[2 * i], uu[2 * i + 1]); qg[i] = pack_bf16(gg[2 * i], gg[2 * i + 1]); }
                *(LAS u32x4*)(ub + tok * LDU + lane * 8) = qu;
                *(u32x4*)((bf16_t*)EARR(E_GATE) + (size_t)row * 512 + lane * 8) = qg;
            }
        }
        __syncthreads();
#pragma unroll 1
        for (int d = 0; d < 2; ++d) {
            {
                bf16x8 bw[4][2]; load_b<2>(WLT + WLT_WB + (size_t)(d * 512 + wid * 64) * 64, bw, lane);
                float w0v[4];
#pragma unroll
                for (int nt = 0; nt < 4; ++nt) w0v[nt] = p.in[I_AW0][d * 512 + wid * 64 + nt * 16 + fr];
#pragma unroll 1
                for (int mt = 0; mt < 5; ++mt) {
                    f32x4 acc[4]; mma_mt<2>(linb + d * 64, LDL, mt, bw, acc, lane);
#pragma unroll
                    for (int r = 0; r < 4; ++r) { const int tok = mt * 16 + fq * 4 + r;
                        if (tok < 68) { float* rec = (float*)sc_rec(SC, d, even_tok_row(w, tok), wid) + fr;
#pragma unroll
                            for (int nt = 0; nt < 4; ++nt) rec[nt * 16] = -0.60653065971263342f * sigm(w0v[nt] + acc[nt][r]);   } }
                }
            }
            {
                bf16x8 bw[4][2]; load_b<2>(WLT + WLT_AB + (size_t)(d * 512 + wid * 64) * 64, bw, lane);
                float a0v[4], kav[4], mukv[4], kkcv[4];
#pragma unroll
                for (int nt = 0; nt < 4; ++nt) { const int n = wid * 64 + nt * 16 + fr; a0v[nt] = p.in[I_AA0][d * 512 + n]; kav[nt] = p.in[I_AKA][n]; mukv[nt] = mu[512 + n]; kkcv[nt] = p.in[I_AKK][n]; }
#pragma unroll 1
                for (int mt = 0; mt < 5; ++mt) {
                    f32x4 acc[4]; mma_mt<2>(linb + 128 + d * 64, LDL, mt, bw, acc, lane);
                    float pkv[4][4], skv[4][4];
#pragma unroll
                    for (int r = 0; r < 4; ++r) { const int tok = mt * 16 + fq * 4 + r, row = even_tok_row(w, tok < 68 ? tok : 0);
#pragma unroll
                        for (int nt = 0; nt < 4; ++nt) { const int n = wid * 64 + nt * 16 + fr, nb = shift_nb(row, n);
                            pkv[r][nt] = bf2f(P[(size_t)row * LDP0 + 512 + n]); skv[r][nt] = nb >= 0 ? bf2f(P[(size_t)nb * LDP0 + 512 + n]) : 0.f; } }
#pragma unroll
                    for (int r = 0; r < 4; ++r) { const int tok = mt * 16 + fq * 4 + r;
                        if (tok < 68) { bf16_t* rec = sc_rec(SC, d, even_tok_row(w, tok), wid) + fr; const float rn = rnorm[tok * 8 + wid];
#pragma unroll
                            for (int nt = 0; nt < 4; ++nt) { const float a = sigm(a0v[nt] + acc[nt][r]);
                                const float zk = pkv[r][nt] + (skv[r][nt] - pkv[r][nt]) * mukv[nt];
                                rec[192 + nt * 16] = f2bf(zk * (1.0f + (a - 1.0f) * kav[nt])); rec[256 + nt * 16] = f2bf(zk * kkcv[nt] * rn * a); } } }
                }
            }
        }
        {
            bf16x8 bw[4][4]; load_b<4>(WLT + WLT_GB + (size_t)(wid * 64) * 128, bw, lane);
            bf16_t* G = (bf16_t*)EARR(E_G);
#pragma unroll 1
            for (int mt = 0; mt < 5; ++mt) {
                f32x4 acc[4]; mma_mt<4>(linb + 256, LDL, mt, bw, acc, lane);
#pragma unroll
                for (int r = 0; r < 4; ++r) { const int tok = mt * 16 + fq * 4 + r;
                    if (tok < 68) { bf16_t* gp = G + (size_t)even_tok_row(w, tok) * 512 + wid * 64 + fr;
#pragma unroll
                        for (int nt = 0; nt < 4; ++nt) gp[nt * 16] = f2bf(acc[nt][r]); } }
            }
        }
#pragma unroll 1
        for (int d = 0; d < 2; ++d) {
            bf16x8 b0[4][2];
            load_b<2>(WLT + WLT_GW + (size_t)(((d * 2 + 0) * 8 + wid) * 64) * 64, b0, lane);
            float gb0[4], gb1[4], spl[4];
#pragma unroll
            for (int nt = 0; nt < 4; ++nt) { const int n = wid * 64 + nt * 16 + fr; gb0[nt] = p.in[I_BGB][(d * 2 + 0) * 512 + n]; gb1[nt] = p.in[I_BGB][(d * 2 + 1) * 512 + n]; spl[nt] = softplusf(-p.in[I_BLAM][d * 512 + n]); }
            float* Ad = EARR(E_A0 + d); float* BXd = EARR(E_BX0 + d);
#pragma unroll 1
            for (int mt = 0; mt < 5; ++mt) {
                f32x4 la[4], acc[4];
                mma_mt<2>(ub + wid * 64, LDU, mt, b0, la, lane);
                { bf16x8 b1[4][2]; load_b<2>(WLT + WLT_GW + (size_t)(((d * 2 + 1) * 8 + wid) * 64) * 64, b1, lane); mma_mt<2>(ub + wid * 64, LDU, mt, b1, acc, lane); }
#pragma unroll
                for (int r = 0; r < 4; ++r) { const int tok = mt * 16 + fq * 4 + r;
                    if (tok < 68) { const size_t o = (size_t)even_tok_row(w, tok) * 512 + wid * 64 + fr;
#pragma unroll
                        for (int nt = 0; nt < 4; ++nt) { const float lg = -8.0f * sigm(gb0[nt] + la[nt][r]) * spl[nt];
                            const float av = fexp(lg); Ad[o + nt * 16] = av; BXd[o + nt * 16] = fsqrt(fmaxf(1.0f - av * av, 0.f)) * sigm(gb1[nt] + acc[nt][r]) * bf2f(ub[tok * LDU + wid * 64 + nt * 16 + fr]);         } } }
            }
        }
        __syncthreads();
        {
            float rk8[8];
#pragma unroll
            for (int i = 0; i < 8; ++i) rk8[i] = p.in[I_ARK][lane * 8 + i];
#pragma unroll 1
            for (int tok = wid; tok < 68; tok += 8) {
                const int row = even_tok_row(w, tok);
                const bf16_t* r0 = sc_rec(SC, 0, row, lane >> 3) + (lane & 7) * 8; const bf16_t* r1 = sc_rec(SC, 1, row, lane >> 3) + (lane & 7) * 8;
                const u32x4 qr = *(const u32x4*)(r0 + 320), q0 = *(const u32x4*)(r0 + 192), q1 = *(const u32x4*)(r1 + 192);
                float sm = 0.f;
#pragma unroll
                for (int i = 0; i < 8; ++i) { const unsigned a = qr[i >> 1], b0 = q0[i >> 1], b1 = q1[i >> 1];
                    const float av = __uint_as_float((i & 1) ? (a & 0xffff0000u) : (a << 16)), b0v = __uint_as_float((i & 1) ? (b0 & 0xffff0000u) : (b0 << 16)), b1v = __uint_as_float((i & 1) ? (b1 & 0xffff0000u) : (b1 << 16));
                    sm += av * (b0v + b1v) * rk8[i]; }
                sm += __int_as_float(__builtin_amdgcn_update_dpp(0, __float_as_int(sm), 0xb1, 0xf, 0xf, false));
                sm += __int_as_float(__builtin_amdgcn_update_dpp(0, __float_as_int(sm), 0x4e, 0xf, 0xf, false));
                sm += __int_as_float(__builtin_amdgcn_update_dpp(0, __float_as_int(sm), 0x141, 0xf, 0xf, false));
                if ((lane & 7) == 0) BC[row * 8 + (lane >> 3)] = sm;
            }
        }
        if (tid < 256) {
            const int d = tid >> 7, c4 = (tid & 127) * 4;
            float* Ad = EARR(E_A0 + d); float* BXd = EARR(E_BX0 + d);
            f32x4 h = {0.f, 0.f, 0.f, 0.f}, cum = {1.f, 1.f, 1.f, 1.f};
#pragma unroll 1
            for (int n0 = 0; n0 < 64; n0 += 8) {
                f32x4 av[8], bv[8];
#pragma unroll
                for (int i = 0; i < 8; ++i) { const int tok = d == 0 ? n0 + i : 63 - n0 - i; const size_t o = (size_t)even_tok_row(w, tok) * 512 + c4; av[i] = *(const f32x4*)(Ad + o); bv[i] = *(const f32x4*)(BXd + o); }
#pragma unroll
                for (int i = 0; i < 8; ++i) { const int tok = d == 0 ? n0 + i : 63 - n0 - i; const size_t o = (size_t)even_tok_row(w, tok) * 512 + c4;
                    h = av[i] * h + bv[i]; cum = cum * av[i]; *(f32x4*)(Ad + o) = cum; *(f32x4*)(BXd + o) = h; }
            }
            { const int cid = (w >> 6) * 128 + 64 + (w & 63); *(f32x4*)(CHA + (size_t)(d * 512 + cid) * 512 + c4) = cum; *(f32x4*)(CHH + (size_t)(d * 512 + cid) * 512 + c4) = h; }
            h = (f32x4){0.f, 0.f, 0.f, 0.f}; cum = (f32x4){1.f, 1.f, 1.f, 1.f};
#pragma unroll
            for (int i = 0; i < 4; ++i) { const int tok = 64 + (d == 0 ? i : 3 - i); const size_t o = (size_t)even_tok_row(w, tok) * 512 + c4;
                const f32x4 a = *(const f32x4*)(Ad + o), bx = *(const f32x4*)(BXd + o); h = a * h + bx; cum = cum * a; *(f32x4*)(Ad + o) = cum; *(f32x4*)(BXd + o) = h; }
            { const int cid = (w >> 6) * 128 + (w & 63); *(f32x4*)(CHA + (size_t)(d * 512 + cid) * 512 + c4) = cum; *(f32x4*)(CHH + (size_t)(d * 512 + cid) * 512 + c4) = h; }
        }
        __syncthreads();
    }
}
__device__ __forceinline__ float vfma(float a, float b, float c) { float d; asm("v_fma_f32 %0, %1, %2, %3" : "=v"(d) : "v"(a), "v"(b), "v"(c)); return d; }
__device__ __forceinline__ float vmul(float a, float b) { float d; asm("v_mul_f32 %0, %1, %2" : "=v"(d) : "v"(a), "v"(b)); return d; }
#define WG_BAR() do { asm volatile("" ::: "memory"); __builtin_amdgcn_s_barrier(); asm volatile("" ::: "memory"); } while (0)
__device__ __forceinline__ int scan_row(int d, int b, int q) {
    if (q < 256) return b * 256 + (d ? 255 - q : q);
    const int s = q - 256; return NCTX + b * 4096 + (d ? 4095 - s : s);
}
__device__ __forceinline__ void ph_fin_even(const Params& p, int bid, int nblk) {
    const int tid = threadIdx.x, wid = tid >> 6, c = tid;
    float* EA = (float*)(p.ws + WS_EARR);
    float* SC = (float*)(p.ws + WS_SC);
    const float* BC = (const float*)(p.ws + WS_BC); const float* CIN = (const float*)(p.ws + WS_CIN);
    bf16_t* Y = (bf16_t*)(p.ws + WS_YMIX);
    const float gg = p.in[I_AGNG][c], gb = p.in[I_AGNB][c];
    for (int r0 = bid * 4; r0 < MROWS; r0 += nblk * 4) {
        float o0[4], o1[4], vv[4], gv[4], bc[4], x0[4], x1[4], a0[4], a1[4], c0[4], c1[4], gt[4];
#pragma unroll
        for (int u = 0; u < 4; ++u) { const int row = r0 + u; const size_t o = (size_t)row * 512 + c;
            const int cid = row < NCTX ? (row >> 8) * 128 + ((row >> 2) & 63) : ((row - NCTX) >> 12) * 128 + 64 + (((row - NCTX) & 4095) >> 6);
            o0[u] = bf2f(((const bf16_t*)EARR(E_O0))[o]); o1[u] = bf2f(((const bf16_t*)EARR(E_O1))[o]); vv[u] = bf2f(sc_rec(SC, 0, row, wid)[384 + (tid & 63)]); gv[u] = bf2f(((const bf16_t*)EARR(E_G))[o]); bc[u] = BC[row * 8 + wid];
            x0[u] = EARR(E_BX0)[o]; x1[u] = EARR(E_BX1)[o]; a0[u] = EARR(E_A0)[o]; a1[u] = EARR(E_A1)[o];
            c0[u] = CIN[(size_t)cid * 512 + c]; c1[u] = CIN[(size_t)(512 + cid) * 512 + c]; gt[u] = bf2f(((const bf16_t*)EARR(E_GATE))[o]); }
#pragma unroll
        for (int u = 0; u < 4; ++u) { const int row = r0 + u;
            const float wkv = o0[u] + o1[u];
            const float mean = wave_sum(wkv) * (1.0f / 64.0f), dv = wkv - mean, var = wave_sum(dv * dv) * (1.0f / 64.0f);
            const float y = (dv * rsqrtf(var + 64e-5f) * gg + gb + bc[u] * vv[u]) * gv[u];
            Y[(size_t)row * 1024 + c] = f2bf(y);
            Y[(size_t)row * 1024 + 512 + c] = f2bf(((x0[u] + a0[u] * c0[u]) + (x1[u] + a1[u] * c1[u])) * gt[u]); }
    }
#undef EARR
}
constexpr int LDT = 72;
__device__ __forceinline__ float quad_sum(float v) {
    v += __int_as_float(__builtin_amdgcn_update_dpp(0, __float_as_int(v), 0xB1, 0xf, 0xf, false));
    v += __int_as_float(__builtin_amdgcn_update_dpp(0, __float_as_int(v), 0x4E, 0xf, 0xf, false));
    return v;
}
template <int PO> __device__ __forceinline__ float quad_bcast(float v) { return __int_as_float(__builtin_amdgcn_update_dpp(0, __float_as_int(v), PO * 0x55, 0xf, 0xf, false)); }
__device__ __forceinline__ bf16x8 ldt8(const LAS bf16_t* T, int row, int col) { return *(const LAS bf16x8*)(T + row * LDT + col); }
__device__ __forceinline__ void ph_r1(const Params& p, LAS unsigned char* lds, int bid, int nblk) {
    const int tid = threadIdx.x, wid = tid >> 6, lane = tid & 63, fr = lane & 15, fq = lane >> 4;
    LAS bf16_t* T0 = (LAS bf16_t*)(lds + LDS_WORK);
#define TL(i) (T0 + (i) * 64 * LDT)
    LAS float* F0 = (LAS float*)(T0 + 11 * 64 * LDT);
    LAS float* F1 = F0 + 4096;
    LAS float* F2 = F1 + 4096;
    LAS float* segt = F2 + 4096;
    LAS float* gl = segt + 512;
    const float* SC = (const float*)(p.ws + WS_SC);
    float* RU = (float*)(p.ws + WS_RU);
    const int k = tid & 63, seg = tid >> 6, t0 = seg * 8;
    const int tr = (wid >> 1) * 16, tc0 = (wid & 1) * 32;
    float kk[8], lw[8], kd[8], ka[8], rr[8], vv[8];
    auto fetch = [&](int unit) {
        const int chain = unit / NRCH, c = unit - chain * NRCH;
        const bf16_t* rec = (const bf16_t*)SC + ((size_t)chain * SCLEN + c * RCH + t0) * SCREC + k;
#pragma unroll
        for (int u = 0; u < 8; ++u) { const bf16_t* r = rec + u * SCREC; lw[u] = ((const float*)(r - k))[k]; kk[u] = bf2f(r[128]); kd[u] = bf2f(r[192]); ka[u] = bf2f(r[256]); rr[u] = bf2f(r[320]); vv[u] = bf2f(r[384]); }
    };
    if (bid < NRUNIT) fetch(bid);
    for (int unit = bid; unit < NRUNIT; unit += nblk) {
        float cum[8]; { float run = 0.f;
#pragma unroll
            for (int u = 0; u < 8; ++u) { run += lw[u]; cum[u] = run; }
            segt[seg * 64 + k] = run; }
        __syncthreads();
        float off = 0.f, tot = 0.f;
#pragma unroll
        for (int s2 = 0; s2 < 8; ++s2) { const float v = segt[s2 * 64 + k]; off += s2 < seg ? v : 0.f; tot += v; }
        if (seg == 0) gl[k] = fexp(tot);
        {
            u32x4 wk, wb, wv; unsigned pk[4], pb[4], pv[4]; float hk = 0.f, hb = 0.f, hv = 0.f;
#pragma unroll
            for (int u = 0; u < 8; ++u) { const int t = t0 + u; const float cu = cum[u] + off;
                const float ginc = fexp(cu), gexc = fexp(cu - lw[u]), ginv = fexp(-cu), gtail = fexp(tot - cu);
                const float kt = kk[u] * gexc;
                TL(0)[t * LDT + k] = f2bf(kt); F0[t * 64 + k] = kt;
                TL(1)[t * LDT + k] = f2bf(kd[u] * ginv); TL(2)[t * LDT + k] = f2bf(ka[u] * ginv); TL(3)[t * LDT + k] = f2bf(rr[u] * ginc);
                const float ktl = kd[u] * gtail, btl = ka[u] * gtail;
                if (u & 1) { pk[u >> 1] = pack_bf16(hk, ktl); pb[u >> 1] = pack_bf16(hb, btl); pv[u >> 1] = pack_bf16(hv, vv[u]); } else { hk = ktl; hb = btl; hv = vv[u]; } }
            wk.x = pk[0]; wk.y = pk[1]; wk.z = pk[2]; wk.w = pk[3]; wb.x = pb[0]; wb.y = pb[1]; wb.z = pb[2]; wb.w = pb[3]; wv.x = pv[0]; wv.y = pv[1]; wv.z = pv[2]; wv.w = pv[3];
            *(LAS u32x4*)(TL(4) + k * LDT + t0) = wk; *(LAS u32x4*)(TL(5) + k * LDT + t0) = wb; *(LAS u32x4*)(TL(6) + k * LDT + t0) = wv;
        }
        if (unit + nblk < NRUNIT) fetch(unit + nblk);
        __syncthreads();
        {
            f32x4 mk[2], mb[2], ak[2], ab[2];
#pragma unroll
            for (int nt = 0; nt < 2; ++nt) { mk[nt] = (f32x4){0.f, 0.f, 0.f, 0.f}; mb[nt] = mk[nt]; ak[nt] = mk[nt]; ab[nt] = mk[nt]; }
#pragma unroll
            for (int ks = 0; ks < 2; ++ks) { const bf16x8 aK = ldt8(TL(0), tr + fr, ks * 32 + fq * 8), aR = ldt8(TL(3), tr + fr, ks * 32 + fq * 8);
#pragma unroll
                for (int nt = 0; nt < 2; ++nt) { const bf16x8 bK = ldt8(TL(1), tc0 + nt * 16 + fr, ks * 32 + fq * 8), bB = ldt8(TL(2), tc0 + nt * 16 + fr, ks * 32 + fq * 8);
                    mk[nt] = __builtin_amdgcn_mfma_f32_16x16x32_bf16(aK, bK, mk[nt], 0, 0, 0); mb[nt] = __builtin_amdgcn_mfma_f32_16x16x32_bf16(aK, bB, mb[nt], 0, 0, 0);
                    ak[nt] = __builtin_amdgcn_mfma_f32_16x16x32_bf16(aR, bK, ak[nt], 0, 0, 0); ab[nt] = __builtin_amdgcn_mfma_f32_16x16x32_bf16(aR, bB, ab[nt], 0, 0, 0); } }
#pragma unroll
            for (int nt = 0; nt < 2; ++nt)
#pragma unroll
                for (int r = 0; r < 4; ++r) { const int t = tr + fq * 4 + r, j = tc0 + nt * 16 + fr;
                    TL(7)[t * LDT + j] = f2bf(j < t ? mk[nt][r] : 0.f); F1[j * 64 + (t & 3) * 16 + (t >> 2)] = j < t ? mb[nt][r] : 0.f;
                    TL(8)[t * LDT + j] = f2bf(j <= t ? ak[nt][r] : 0.f); TL(9)[t * LDT + j] = f2bf(j <= t ? ab[nt][r] : 0.f); }
        }
        __syncthreads();
        {
            f32x4 acc[2] = {(f32x4){0.f, 0.f, 0.f, 0.f}, (f32x4){0.f, 0.f, 0.f, 0.f}};
#pragma unroll
            for (int ks = 0; ks < 2; ++ks) { const bf16x8 a = ldt8(TL(7), tr + fr, ks * 32 + fq * 8);
#pragma unroll
                for (int nt = 0; nt < 2; ++nt) acc[nt] = __builtin_amdgcn_mfma_f32_16x16x32_bf16(a, ldt8(TL(6), tc0 + nt * 16 + fr, ks * 32 + fq * 8), acc[nt], 0, 0, 0); }
#pragma unroll
            for (int nt = 0; nt < 2; ++nt)
#pragma unroll
                for (int r = 0; r < 4; ++r) F2[(tr + fq * 4 + r) * 64 + tc0 + nt * 16 + fr] = acc[nt][r];
        }
        __syncthreads();
        {
            const int col = tid >> 2, part = tid & 3;
            f32x2 acc2[8]; float x[16];
#pragma unroll
            for (int q = 0; q < 16; ++q) { const int t = 4 * q + part; acc2[q >> 1][q & 1] = col < 64 ? F0[t * 64 + col] : F2[t * 64 + col - 64]; x[q] = 0.f; }
#pragma unroll
            for (int t = 0; t < 64; ++t) {
                const int qo = t >> 2, po = t & 3; const float aq = acc2[qo >> 1][qo & 1];
                const float xt = po == 0 ? quad_bcast<0>(aq) : po == 1 ? quad_bcast<1>(aq) : po == 2 ? quad_bcast<2>(aq) : quad_bcast<3>(aq);
                x[qo] = part == po ? xt : x[qo];
                const f32x2 nx = {-xt, -xt};
#pragma unroll
                for (int q4 = qo >> 2; q4 < 4; ++q4) { const f32x4 m = *(const LAS f32x4*)(F1 + t * 64 + part * 16 + q4 * 4);
                    acc2[q4 * 2] = (f32x2){m[0], m[1]} * nx + acc2[q4 * 2]; acc2[q4 * 2 + 1] = (f32x2){m[2], m[3]} * nx + acc2[q4 * 2 + 1]; }
            }
            LAS bf16_t* dstT = col < 64 ? TL(7) + col * LDT : TL(10) + (col - 64) * LDT;
#pragma unroll
            for (int q = 0; q < 16; ++q) dstT[4 * q + part] = f2bf(-x[q]);
        }
        __syncthreads();
        {
            f32x4 rh[2], ol[2], pm[2], qq[2];
#pragma unroll
            for (int nt = 0; nt < 2; ++nt) { rh[nt] = (f32x4){0.f, 0.f, 0.f, 0.f}; ol[nt] = rh[nt]; pm[nt] = rh[nt]; qq[nt] = rh[nt]; }
#pragma unroll
            for (int ks = 0; ks < 2; ++ks) { const int kc = ks * 32 + fq * 8;
                const bf16x8 a7 = ldt8(TL(7), tr + fr, kc), a8 = ldt8(TL(8), tr + fr, kc), a9 = ldt8(TL(9), tr + fr, kc), a6 = ldt8(TL(6), tr + fr, kc), a10 = ldt8(TL(10), tr + fr, kc);
#pragma unroll
                for (int nt = 0; nt < 2; ++nt) { const int br = tc0 + nt * 16 + fr;
                    const bf16x8 b9 = ldt8(TL(9), br, kc), b6 = ldt8(TL(6), br, kc), b10 = ldt8(TL(10), br, kc), b5 = ldt8(TL(5), br, kc), b4 = ldt8(TL(4), br, kc);
                    rh[nt] = __builtin_amdgcn_mfma_f32_16x16x32_bf16(a7, b9, rh[nt], 0, 0, 0);
                    ol[nt] = __builtin_amdgcn_mfma_f32_16x16x32_bf16(a8, b6, ol[nt], 0, 0, 0); ol[nt] = __builtin_amdgcn_mfma_f32_16x16x32_bf16(a9, b10, ol[nt], 0, 0, 0);
                    pm[nt] = __builtin_amdgcn_mfma_f32_16x16x32_bf16(a7, b5, pm[nt], 0, 0, 0);
                    qq[nt] = __builtin_amdgcn_mfma_f32_16x16x32_bf16(a6, b4, qq[nt], 0, 0, 0); qq[nt] = __builtin_amdgcn_mfma_f32_16x16x32_bf16(a10, b5, qq[nt], 0, 0, 0); } }
            float* U = RU + (size_t)unit * 4 * 4096;
#pragma unroll
            for (int nt = 0; nt < 2; ++nt)
#pragma unroll
                for (int r = 0; r < 4; ++r) { const int row = tr + fq * 4 + r, cx = tc0 + nt * 16 + fr; const int o = row * 64 + cx;
                    U[o] = pm[nt][r] + (row == cx ? gl[row] : 0.f);
                    U[4096 + o] = qq[nt][r];
                    U[8192 + o] = rh[nt][r] + bf2f(TL(3)[cx * LDT + row]);
                    U[12288 + o] = ol[nt][r]; }
        }
        __syncthreads();
    }
#undef TL
}
__device__ __forceinline__ void moe_weight_tiles(const Params& p, LAS unsigned char* lds, int first, int stride) {
    const int tid = threadIdx.x; unsigned char* ws = p.ws;
    LAS float* tile = (LAS float*)(lds + LDS_WORK);
    const int j4 = (tid & 31) * 4, i0 = tid >> 5;
    auto decode = [&](int tt, const float*& src, int& ld, int& k0, int& n0, int& w1map, bf16_t*& dst) {
        if (tt < 8192) { const int mat = tt >> 7, r = tt & 127; k0 = (r >> 4) * 128; n0 = (r & 15) * 128; src = p.in[I_W1] + (size_t)mat * 1024 * 2048; ld = 2048; dst = (bf16_t*)(ws + WS_W1T) + (size_t)mat * 2048 * 1024; w1map = 1; }
        else { tt -= 8192; const int mat = tt >> 6, r = tt & 63; k0 = (r >> 3) * 128; n0 = (r & 7) * 128; src = p.in[I_W2] + (size_t)mat * 1024 * 1024; ld = 1024; dst = (bf16_t*)(ws + WS_W2T) + (size_t)mat * 1024 * 1024; w1map = 0; }
    };
    f32x4 v[8];
    if (first < 12288) { const float* src; int ld, k0, n0, w1; bf16_t* dst; decode(first, src, ld, k0, n0, w1, dst);
#pragma unroll
        for (int r = 0; r < 8; ++r) v[r] = __builtin_nontemporal_load((const f32x4*)(src + (size_t)(k0 + i0 + 16 * r) * ld + n0 + j4)); }
    for (int t = first; t < 12288; t += stride) {
        const float* src; int ld, k0, n0, w1map; bf16_t* dst; decode(t, src, ld, k0, n0, w1map, dst);
#pragma unroll
        for (int r = 0; r < 8; ++r) { LAS float* tp = tile + (i0 + 16 * r) * 129 + j4; tp[0] = v[r][0]; tp[1] = v[r][1]; tp[2] = v[r][2]; tp[3] = v[r][3]; }
        __syncthreads();
        if (t + stride < 12288) { const float* s2; int ld2, k2, n2, w2; bf16_t* d2; decode(t + stride, s2, ld2, k2, n2, w2, d2);
#pragma unroll
            for (int r = 0; r < 8; ++r) v[r] = __builtin_nontemporal_load((const f32x4*)(s2 + (size_t)(k2 + i0 + 16 * r) * ld2 + n2 + j4)); }
        { const int ip = (tid & 15) * 8, j0 = tid >> 4;
            const int rho0 = w1map ? ((((n0 & 1023) >> 7) << 8) + ((n0 >> 10) << 7)) : n0;
#pragma unroll
            for (int r = 0; r < 4; ++r) { const int j = j0 + 32 * r;
                u32x4 w; w.x = pack_bf16(tile[ip * 129 + j], tile[(ip + 1) * 129 + j]); w.y = pack_bf16(tile[(ip + 2) * 129 + j], tile[(ip + 3) * 129 + j]);
                w.z = pack_bf16(tile[(ip + 4) * 129 + j], tile[(ip + 5) * 129 + j]); w.w = pack_bf16(tile[(ip + 6) * 129 + j], tile[(ip + 7) * 129 + j]);
                const int rho = rho0 + j, kk8 = k0 + ip; *(u32x4*)(dst + ((size_t)((rho >> 8) * 16 + (kk8 >> 6)) * 256 + (rho & 255)) * 64 + (kk8 & 63)) = w; } }
        __syncthreads();
    }
}
__device__ __forceinline__ void ph_r2(const Params& p, LAS unsigned char* lds, int bid, int nblk) {
    const int tid = threadIdx.x, wid = tid >> 6, lane = tid & 63, fr = lane & 15, g = lane >> 4;
    const int nchainwg = nblk >= 128 ? 64 : 0;
    if (bid >= nchainwg) {
        const int nconv = nblk - nchainwg, cb = bid - nchainwg;
        if (tid < 256) {
            const float* CHA = (const float*)(p.ws + WS_CHA); const float* CHH = (const float*)(p.ws + WS_CHH); float* CIN = (float*)(p.ws + WS_CIN);
            for (int item = cb; item < 16; item += nconv) {
                const int gi = item * 256 + tid, d = gi >> 11, b = (gi >> 9) & 3, c = gi & 511;
                float carry = 0.f;
                for (int s0 = 0; s0 < 128; s0 += 16) {
                    float av[16], hv[16];
#pragma unroll
                    for (int q = 0; q < 16; ++q) { const int st = s0 + q; const int cl = d == 0 ? st : (st < 64 ? 63 - st : 191 - st);
                        const size_t o = (size_t)(d * 512 + b * 128 + cl) * 512 + c; av[q] = CHA[o]; hv[q] = CHH[o]; }
#pragma unroll
                    for (int q = 0; q < 16; ++q) { const int st = s0 + q; const int cl = d == 0 ? st : (st < 64 ? 63 - st : 191 - st);
                        CIN[(size_t)(d * 512 + b * 128 + cl) * 512 + c] = carry; carry = av[q] * carry + hv[q]; }
                }
            }
        }
        __syncthreads();
        moe_weight_tiles(p, lds, cb, nconv);
        if (nchainwg) return;
    }
    LAS float* ring = (LAS float*)(lds + LDS_WORK);
    const float* RU = (const float*)(p.ws + WS_RU);
    float* EA = (float*)(p.ws + WS_EARR);
    for (int chain = nchainwg ? bid : bid; chain < 64; chain += (nchainwg ? 64 : nblk)) {
        const int d = chain >> 5, b = (chain >> 3) & 3, h = chain & 7;
        bf16_t* Od = (bf16_t*)(EA + (size_t)(E_O0 + d) * ((size_t)MROWS * 512));
        auto issue = [&](int c) {
            const float* src = RU + ((size_t)chain * NRCH + c) * 4 * 4096; LAS float* dst = ring + (c & 1) * 4 * 4096;
#pragma unroll
            for (int i = 0; i < 16; ++i) { const int slot = ((wid - 4) * 16 + i) * 64;
                __builtin_amdgcn_global_load_lds((const unsigned*)(src + (size_t)(slot + lane) * 4), (LAS unsigned*)(dst + slot * 4), 16, 0, 0); }
        };
        if (tid >= 256) { issue(0); asm volatile("s_waitcnt vmcnt(0)" ::: "memory"); }
        asm volatile("" ::: "memory"); __builtin_amdgcn_s_barrier(); asm volatile("" ::: "memory");
        f32x4 S[4];
#pragma unroll
        for (int m = 0; m < 4; ++m) S[m] = (f32x4){0.f, 0.f, 0.f, 0.f};
        const int v0 = wid * 16;
        for (int c = 0; c < NRCH; ++c) {
            if (tid >= 256) { if (c + 1 < NRCH) issue(c + 1); asm volatile("s_waitcnt vmcnt(0)" ::: "memory"); }
            else {
                const LAS float* PM = ring + (c & 1) * 4 * 4096; const LAS float* QQ = PM + 4096; const LAS float* RHT = PM + 8192; const LAS float* OL = PM + 12288;
                f32x4 acc[4], Sn[4];
#pragma unroll
                for (int tt = 0; tt < 4; ++tt) {
#pragma unroll
                    for (int i = 0; i < 4; ++i) acc[tt][i] = OL[(16 * tt + 4 * g + i) * 64 + v0 + fr];
                    Sn[tt] = *(const LAS f32x4*)(QQ + (v0 + fr) * 64 + 16 * tt + 4 * g); }
                float A[3][4];
#pragma unroll
                for (int s0 = 0; s0 < 2; ++s0) { const LAS float* ar = RHT + (16 * (s0 >> 2) + 4 * g + (s0 & 3)) * 64 + fr;
#pragma unroll
                    for (int u = 0; u < 4; ++u) A[s0][u] = ar[16 * u]; }
#pragma unroll
                for (int st = 0; st < 32; ++st) {
                    if (st + 2 < 32) { const int s2 = st + 2, mi = s2 & 15; const LAS float* ar = (s2 < 16 ? RHT : PM) + (16 * (mi >> 2) + 4 * g + (mi & 3)) * 64 + fr;
#pragma unroll
                        for (int u = 0; u < 4; ++u) A[s2 % 3][u] = ar[16 * u]; }
                    __builtin_amdgcn_sched_barrier(0);
                    const int mi = st & 15; const float bq = S[mi >> 2][mi & 3];
                    if (st < 16) {
#pragma unroll
                        for (int u = 0; u < 4; ++u) acc[u] = __builtin_amdgcn_mfma_f32_16x16x4f32(A[st % 3][u], bq, acc[u], 0, 0, 0);
                    } else {
#pragma unroll
                        for (int u = 0; u < 4; ++u) Sn[u] = __builtin_amdgcn_mfma_f32_16x16x4f32(A[st % 3][u], bq, Sn[u], 0, 0, 0);
                    }
                }
#pragma unroll
                for (int tt = 0; tt < 4; ++tt)
#pragma unroll
                    for (int i = 0; i < 4; ++i) { const int row = scan_row(d, b, c * RCH + 16 * tt + 4 * g + i); Od[(size_t)row * 512 + h * 64 + v0 + fr] = f2bf(acc[tt][i]); }
#pragma unroll
                for (int m = 0; m < 4; ++m) S[m] = Sn[m];
                asm volatile("s_waitcnt lgkmcnt(0)" ::: "memory");
            }
            asm volatile("" ::: "memory"); __builtin_amdgcn_s_barrier(); asm volatile("" ::: "memory");
        }
    }
}
__device__ __forceinline__ float half_max(float v, int lane) {
    const int ninf = 0xff800000;
    v = fmaxf(v, __int_as_float(__builtin_amdgcn_update_dpp(ninf, __float_as_int(v), 0x121, 0xf, 0xf, false)));
    v = fmaxf(v, __int_as_float(__builtin_amdgcn_update_dpp(ninf, __float_as_int(v), 0x122, 0xf, 0xf, false)));
    v = fmaxf(v, __int_as_float(__builtin_amdgcn_update_dpp(ninf, __float_as_int(v), 0x124, 0xf, 0xf, false)));
    v = fmaxf(v, __int_as_float(__builtin_amdgcn_update_dpp(ninf, __float_as_int(v), 0x128, 0xf, 0xf, false)));
    v = fmaxf(v, __int_as_float(__builtin_amdgcn_update_dpp(ninf, __float_as_int(v), 0x142, 0xa, 0xf, false)));
    const float lo = __int_as_float(__builtin_amdgcn_readlane(__float_as_int(v), 31)), hi = __int_as_float(__builtin_amdgcn_readlane(__float_as_int(v), 63));
    return (lane & 32) ? hi : lo;
}
__device__ __forceinline__ int half_min_i(int v, int lane) {
    const int big = 0x7fffffff;
    v = min(v, __builtin_amdgcn_update_dpp(big, v, 0x121, 0xf, 0xf, false));
    v = min(v, __builtin_amdgcn_update_dpp(big, v, 0x122, 0xf, 0xf, false));
    v = min(v, __builtin_amdgcn_update_dpp(big, v, 0x124, 0xf, 0xf, false));
    v = min(v, __builtin_amdgcn_update_dpp(big, v, 0x128, 0xf, 0xf, false));
    v = min(v, __builtin_amdgcn_update_dpp(big, v, 0x142, 0xa, 0xf, false));
    const int lo = __builtin_amdgcn_readlane(v, 31), hi = __builtin_amdgcn_readlane(v, 63);
    return (lane & 32) ? hi : lo;
}
template <int LAYER>
__device__ __forceinline__ void ph_ln1(const Params& p, LAS unsigned char* lds, int bid, int nblk) {
    const int tid = threadIdx.x, wid = tid >> 6, lane = tid & 63, fr = lane & 15, fq = lane >> 4;
    LAS float* vb = (LAS float*)(lds + LDS_WORK);
    LAS float* part = vb + 16 * 1028;
    LAS int* lcnt = (LAS int*)(part + 8 * 16 * 32);
    float rwf[2][32];
    { const float* rw = p.in[I_RW] + (size_t)LAYER * 32768 + (size_t)(128 * wid + 32 * fq) * 32 + fr;
#pragma unroll
        for (int s2 = 0; s2 < 32; ++s2) { rwf[0][s2] = rw[s2 * 32]; rwf[1][s2] = rw[s2 * 32 + 16]; } }
    if (tid < 32) lcnt[tid] = 0;
    __syncthreads();
    const float* MOD = (const float*)(p.ws + WS_MOD);
    bf16_t* XS = (bf16_t*)(p.ws + WS_XS); const bf16_t* YP = (const bf16_t*)(p.ws + WS_YP); bf16_t* H = (bf16_t*)(p.ws + WS_H);
    int* TOPE = (int*)(p.ws + WS_TOPE); float* TOPW = (float*)(p.ws + WS_TOPW); int* TOPS = (int*)(p.ws + WS_TOPS);
    int* CNTB = (int*)(p.ws + WS_CNTB) + (size_t)(LAYER * 512 + bid) * 32;
    const float* lng = p.in[I_LNG] + (LAYER * 2 + 0) * 1024; const float* lnb = p.in[I_LNB] + (LAYER * 2 + 0) * 1024;
    const int rstride = nblk * 8, rbase = (LAYER == 0 ? 0 : NCTX) + bid * 8;
    f32x4 nres[4], ngate[4]; u32x2 nyp[4];
    auto fetch = [&](int row) {
        const float* res = row < NCTX ? p.in[I_CTX] + (size_t)row * 1024 : p.in[I_X] + (size_t)(row - NCTX) * 1024;
        const float* md = MOD + (size_t)(LAYER * 5 + row_modr(row)) * 6144;
#pragma unroll
        for (int q = 0; q < 4; ++q) { const int col = q * 256 + lane * 4; nres[q] = LAYER == 0 ? *(const f32x4*)(res + col) : ld_bf16x4(XS + (size_t)row * 1024 + col);
            ngate[q] = *(const f32x4*)(md + 2048 + col); nyp[q] = *(const u32x2*)(YP + (size_t)row * 1024 + col); }
    };
    if (rbase < MROWS) fetch(rbase + wid);
#pragma unroll 1
    for (int j0 = 0; rbase + j0 * rstride < MROWS; j0 += 2) {
#pragma unroll 1
        for (int jj = 0; jj < 2; ++jj) {
            const int row = rbase + wid + (j0 + jj) * rstride;
            if (row >= MROWS) break;
            const float* md = MOD + (size_t)(LAYER * 5 + row_modr(row)) * 6144;
            f32x4 v[4], msc[4], msh[4]; float s = 0.f;
#pragma unroll
            for (int q = 0; q < 4; ++q) { const u32x2 w = nyp[q];
                const f32x4 y = (f32x4){__uint_as_float(w.x << 16), __uint_as_float(w.x & 0xffff0000u), __uint_as_float(w.y << 16), __uint_as_float(w.y & 0xffff0000u)};
                v[q] = nres[q] * DN_ALPHA + ngate[q] * y;
                s += (v[q][0] + v[q][1]) + (v[q][2] + v[q][3]); }
#pragma unroll
            for (int q = 0; q < 4; ++q) { const int col = q * 256 + lane * 4; msc[q] = *(const f32x4*)(md + 4096 + col); msh[q] = *(const f32x4*)(md + 3072 + col); }
            if (row + rstride < MROWS) fetch(row + rstride);
            const float mean = wave_sum(s) * (1.0f / 1024.0f);
            float ss = 0.f;
#pragma unroll
            for (int q = 0; q < 4; ++q) { v[q] = v[q] - mean; ss += (v[q][0] * v[q][0] + v[q][1] * v[q][1]) + (v[q][2] * v[q][2] + v[q][3] * v[q][3]); }
            const float rstd = rsqrtf(wave_sum(ss) * (1.0f / 1024.0f) + LN_EPS);
#pragma unroll
            for (int q = 0; q < 4; ++q) { const int col = q * 256 + lane * 4;
                const f32x4 xn = v[q] * rstd * *(const f32x4*)(lng + col) + *(const f32x4*)(lnb + col);
                { u32x2 wx; wx.x = pack_bf16(xn[0], xn[1]); wx.y = pack_bf16(xn[2], xn[3]); *(u32x2*)(XS + (size_t)row * 1024 + col) = wx; }
                v[q] = xn * (msc[q] + 1.0f) + msh[q];
                u32x2 w; w.x = pack_bf16(v[q][0], v[q][1]); w.y = pack_bf16(v[q][2], v[q][3]);
                *(u32x2*)(H + (size_t)row * 1024 + col) = w;
                *(LAS f32x4*)(vb + (wid + 8 * jj) * 1028 + col) = v[q]; }
        }
        __syncthreads();
        {
            const LAS float* ar = vb + fr * 1028 + 128 * wid + 32 * fq;
            f32x4 acc0 = {0.f, 0.f, 0.f, 0.f}, acc1 = {0.f, 0.f, 0.f, 0.f};
#pragma unroll
            for (int h = 0; h < 2; ++h) { f32x4 va[4];
#pragma unroll
                for (int u = 0; u < 4; ++u) va[u] = *(const LAS f32x4*)(ar + h * 16 + u * 4);
#pragma unroll
                for (int u = 0; u < 4; ++u)
#pragma unroll
                    for (int i = 0; i < 4; ++i) { acc0 = __builtin_amdgcn_mfma_f32_16x16x4f32(va[u][i], rwf[0][h * 16 + u * 4 + i], acc0, 0, 0, 0);
                        acc1 = __builtin_amdgcn_mfma_f32_16x16x4f32(va[u][i], rwf[1][h * 16 + u * 4 + i], acc1, 0, 0, 0); } }
            LAS float* pw = part + wid * 512 + (4 * fq) * 32 + fr;
#pragma unroll
            for (int i = 0; i < 4; ++i) { pw[i * 32] = acc0[i]; pw[i * 32 + 16] = acc1[i]; }
        }
        __syncthreads();
        {
            const int e = lane & 31, lr = 2 * wid + (lane >> 5), row = rbase + (lr & 7) + (j0 + (lr >> 3)) * rstride;
            float lg = p.in[I_RB][LAYER * 32 + e];
#pragma unroll
            for (int w2 = 0; w2 < 8; ++w2) lg += part[w2 * 512 + lr * 32 + e];
            float tv[4]; int te[4];
#pragma unroll
            for (int k = 0; k < 4; ++k) { const float bv = half_max(lg, lane); const int bi = half_min_i(lg == bv ? e : 99, lane);
                tv[k] = bv; te[k] = bi & 31; lg = e == bi ? -3.0e38f : lg; }
            const float e1 = expf(tv[1] - tv[0]), e2 = expf(tv[2] - tv[0]), e3 = expf(tv[3] - tv[0]), inv = 1.0f / (1.0f + e1 + e2 + e3);
            if (e == 0 && row < MROWS) {
                const float wv[4] = {inv, e1 * inv, e2 * inv, e3 * inv};
#pragma unroll
                for (int k = 0; k < 4; ++k) { const int slot = __hip_atomic_fetch_add(lcnt + te[k], 1, __ATOMIC_RELAXED, __HIP_MEMORY_SCOPE_WORKGROUP); TOPE[row * 4 + k] = te[k]; TOPW[row * 4 + k] = wv[k]; TOPS[row * 4 + k] = slot; }
            }
        }
    }
    __syncthreads();
    if (tid < 32) CNTB[tid] = lcnt[tid];
}
constexpr int LDS_TAB = LDS_WORK + 131072;
__device__ __forceinline__ int moe_tables(const int* cntb, int nblk, LAS int* tab, LAS int* bb) {
    const int tid = threadIdx.x, e = tid & 31, seg = tid >> 5, per = (nblk + 15) >> 4;
    const int b0 = seg * per, b1 = (b0 + per) < nblk ? (b0 + per) : nblk;
    int s = 0;
    if (per <= 16) {
        int cv[16];
#pragma unroll
        for (int u = 0; u < 16; ++u) cv[u] = (b0 + u) < b1 ? cntb[(b0 + u) * 32 + e] : 0;
#pragma unroll
        for (int u = 0; u < 16; ++u) s += cv[u];
        tab[512 + seg * 32 + e] = s;
        __syncthreads();
        if (tid < 32) { int run = 0; for (int sg = 0; sg < 16; ++sg) { const int v = tab[512 + sg * 32 + tid]; tab[512 + sg * 32 + tid] = run; run += v; } tab[448 + tid] = run; }
        __syncthreads();
        if (bb) { int run = tab[512 + seg * 32 + e];
#pragma unroll
            for (int u = 0; u < 16; ++u) if ((b0 + u) < b1) { bb[(b0 + u) * 32 + e] = run; run += cv[u]; } }
    } else {
        for (int b = b0; b < b1; ++b) s += cntb[b * 32 + e];
        tab[512 + seg * 32 + e] = s;
        __syncthreads();
        if (tid < 32) { int run = 0; for (int sg = 0; sg < 16; ++sg) { const int v = tab[512 + sg * 32 + tid]; tab[512 + sg * 32 + tid] = run; run += v; } tab[448 + tid] = run; }
        __syncthreads();
        if (bb) { int run = tab[512 + seg * 32 + e]; for (int b = b0; b < b1; ++b) { bb[b * 32 + e] = run; run += cntb[b * 32 + e]; } }
    }
    if (tid < 64) {
        const int x = tid & 31, n = (tab[448 + x] + 255) >> 8; int inc = n;
#pragma unroll
        for (int o = 1; o < 32; o <<= 1) { const int t = __shfl_up(inc, o, 64); if ((tid & 31) >= o) inc += t; }
        if (tid < 32) { const int t0 = inc - n; tab[x] = t0 * 256; for (int i = 0; i < n; ++i) tab[64 + t0 + i] = x; if (x == 31) { tab[32] = inc * 256; tab[40] = inc; } }
    }
    __syncthreads();
    return tab[40];
}
template <int LAYER>
__device__ __forceinline__ void ph_moe_gather(const Params& p, LAS unsigned char* lds, int bid, int nblk) {
    const int tid = threadIdx.x;
    LAS int* tab = (LAS int*)(lds + LDS_TAB); LAS int* bb = (LAS int*)(lds + LDS_WORK);
    (void)moe_tables((const int*)(p.ws + WS_CNTB) + (size_t)LAYER * 512 * 32, nblk, tab, bb);
    const int* TOPE = (const int*)(p.ws + WS_TOPE); const int* TOPS = (const int*)(p.ws + WS_TOPS); int* POS = (int*)(p.ws + WS_POS); int* IDX = (int*)(p.ws + WS_IDX);
    constexpr int R0 = LAYER == 0 ? 0 : NCTX;
    for (int i = R0 * 4 + bid * NTHR + tid; i < MROWS * 4; i += nblk * NTHR) {
        const int row = i >> 2, e = TOPE[i], pos = tab[e] + bb[((((row - R0) >> 3) % nblk) << 5) + e] + TOPS[i];
        POS[i] = pos; IDX[pos] = row;
    }
    for (int e = bid; e < 32; e += nblk) {
        const int cnt = tab[448 + e], beg = tab[e] + cnt, end = tab[e] + ((cnt + 255) & ~255);
        for (int q = beg + tid; q < end; q += NTHR) IDX[q] = R0;
    }
}
template <int LAYER>
__device__ __forceinline__ void ph_moe_gemm1(const Params& p, LAS unsigned char* lds, int bid, int nblk) {
    LAS int* tab = (LAS int*)(lds + LDS_TAB);
    const int T = moe_tables((const int*)(p.ws + WS_CNTB) + (size_t)LAYER * 512 * 32, nblk, tab, (LAS int*)nullptr);
    pg8::SchedMoe<8> S{T, nblk, bid, tab + 64};
    pg8::Gemm g{(const bf16_t*)(p.ws + WS_H), (const bf16_t*)(p.ws + WS_W1T) + (size_t)LAYER * 32 * 2048 * 1024, 0, 0, 1024, (const int*)(p.ws + WS_IDX)};
    pg8::EpiAct E{(bf16_t*)(p.ws + WS_ACT), p.in[I_B1] + (size_t)LAYER * 32 * 2048};
    pg8::gemm_phase<pg8::EpiAct, pg8::SchedMoe<8>, false, false, true, true>(lds + LDS_WORK, g, S, E, nullptr);
}
template <int LAYER>
__device__ __forceinline__ void ph_moe_gemm2(const Params& p, LAS unsigned char* lds, int bid, int nblk) {
    LAS int* tab = (LAS int*)(lds + LDS_TAB);
    const int T = moe_tables((const int*)(p.ws + WS_CNTB) + (size_t)LAYER * 512 * 32, nblk, tab, (LAS int*)nullptr);
    pg8::SchedMoe<4> S{T, nblk, bid, tab + 64};
    pg8::Gemm g{(const bf16_t*)(p.ws + WS_ACT), (const bf16_t*)(p.ws + WS_W2T) + (size_t)LAYER * 32 * 1024 * 1024, 0, 0, 1024};
    pg8::EpiYE E{(bf16_t*)(p.ws + WS_YE), p.in[I_B2] + (size_t)LAYER * 32 * 1024};
    pg8::gemm_phase<pg8::EpiYE, pg8::SchedMoe<4>, false, true, true>(lds + LDS_WORK, g, S, E, nullptr);
}
template <int NN>
__device__ __forceinline__ void ph_gemm_dense(LAS unsigned char* lds, const bf16_t* A, const bf16_t* Bt, bf16_t* C, int ldc, int pm0, int nM, int bid, int nblk) {
    pg8::SchedDense<NN> S{nM, pm0, nblk, bid};
    pg8::Gemm g{A, Bt, 0, 0, 1024};
    pg8::EpiStore E{C, ldc};
    pg8::gemm_phase<pg8::EpiStore, pg8::SchedDense<NN>, false>(lds + LDS_WORK, g, S, E, nullptr);
}
template <int LAYER>
__device__ __forceinline__ void ph_ln2(const Params& p, LAS unsigned char* lds, int bid, int nblk) {
    const int tid = threadIdx.x, wid = tid >> 6, lane = tid & 63, fr = lane & 15, fq = lane >> 4;
    LAS float* vb = (LAS float*)(lds + LDS_WORK);
    LAS float* part = vb + 16 * 1028;
    float wgf[32];
    if (LAYER == 0) { const float* wg = p.in[I_OWIN] + (size_t)(128 * wid + 32 * fq) * ODD_IN + 4096 + fr;
#pragma unroll
        for (int s2 = 0; s2 < 32; ++s2) wgf[s2] = wg[(size_t)s2 * ODD_IN]; }
    const float* MOD = (const float*)(p.ws + WS_MOD);
    bf16_t* XS = (bf16_t*)(p.ws + WS_XS); const bf16_t* YE = (const bf16_t*)(p.ws + WS_YE); bf16_t* H = (bf16_t*)(p.ws + WS_H); float* GT = (float*)(p.ws + WS_GT);
    const float* TOPW = (const float*)(p.ws + WS_TOPW); const int* POS = (const int*)(p.ws + WS_POS);
    const float* lng = p.in[I_LNG] + (LAYER * 2 + 1) * 1024; const float* lnb = p.in[I_LNB] + (LAYER * 2 + 1) * 1024;
    const int rstride = nblk * 8, rbase = (LAYER == 0 ? 0 : NCTX) + bid * 8, rfirst = rbase + wid;
    f32x4 nw = {0.f, 0.f, 0.f, 0.f}; int np0 = 0, np1 = 0, np2 = 0, np3 = 0;
    if (rfirst < MROWS) { nw = *(const f32x4*)(TOPW + rfirst * 4); np0 = POS[rfirst * 4]; np1 = POS[rfirst * 4 + 1]; np2 = POS[rfirst * 4 + 2]; np3 = POS[rfirst * 4 + 3]; }
    auto do_row = [&](int row, int jj) {
        const float* md = MOD + (size_t)(LAYER * 5 + row_modr(row)) * 6144;
        const float w0 = nw[0], w1 = nw[1], w2 = nw[2], w3 = nw[3];
        const bf16_t* y0 = YE + (size_t)np0 * 1024; const bf16_t* y1 = YE + (size_t)np1 * 1024;
        const bf16_t* y2 = YE + (size_t)np2 * 1024; const bf16_t* y3 = YE + (size_t)np3 * 1024;
        if (row + rstride < MROWS) { const int rn = row + rstride; nw = *(const f32x4*)(TOPW + rn * 4); np0 = POS[rn * 4]; np1 = POS[rn * 4 + 1]; np2 = POS[rn * 4 + 2]; np3 = POS[rn * 4 + 3]; }
        f32x4 v[4]; float s = 0.f;
#pragma unroll
        for (int q = 0; q < 4; ++q) { const int col = q * 256 + lane * 4;
            const f32x4 ffn = (ld_bf16x4(y0 + col) * w0 + ld_bf16x4(y1 + col) * w1) + (ld_bf16x4(y2 + col) * w2 + ld_bf16x4(y3 + col) * w3);
            v[q] = ld_bf16x4(XS + (size_t)row * 1024 + col) * DN_ALPHA + *(const f32x4*)(md + 5120 + col) * ffn;
            s += (v[q][0] + v[q][1]) + (v[q][2] + v[q][3]); }
        const float mean = wave_sum(s) * (1.0f / 1024.0f);
        float ss = 0.f;
#pragma unroll
        for (int q = 0; q < 4; ++q) { v[q] = v[q] - mean; ss += (v[q][0] * v[q][0] + v[q][1] * v[q][1]) + (v[q][2] * v[q][2] + v[q][3] * v[q][3]); }
        const float rstd = rsqrtf(wave_sum(ss) * (1.0f / 1024.0f) + LN_EPS);
        if (LAYER == 1) {
#pragma unroll
            for (int q = 0; q < 4; ++q) { const int col = q * 256 + lane * 4;
                *(f32x4*)(p.out + (size_t)(row - NCTX) * 1024 + col) = v[q] * rstd * *(const f32x4*)(lng + col) + *(const f32x4*)(lnb + col); }
        } else {
            const float* md1 = MOD + (size_t)(5 + row_modr(row)) * 6144;
#pragma unroll
            for (int q = 0; q < 4; ++q) { const int col = q * 256 + lane * 4;
                const f32x4 xn = v[q] * rstd * *(const f32x4*)(lng + col) + *(const f32x4*)(lnb + col);
                { u32x2 wx; wx.x = pack_bf16(xn[0], xn[1]); wx.y = pack_bf16(xn[2], xn[3]); *(u32x2*)(XS + (size_t)row * 1024 + col) = wx; }
                v[q] = xn * (*(const f32x4*)(md1 + 1024 + col) + 1.0f) + *(const f32x4*)(md1 + col);
                u32x2 w; w.x = pack_bf16(v[q][0], v[q][1]); w.y = pack_bf16(v[q][2], v[q][3]);
                *(u32x2*)(H + (size_t)row * 1024 + col) = w;
                *(LAS f32x4*)(vb + (wid + 8 * jj) * 1028 + col) = v[q]; }
        }
    };
    if (LAYER == 1) {
#pragma unroll 1
        for (int row = rfirst; row < MROWS; row += rstride) do_row(row, 0);
    } else {
#pragma unroll 1
        for (int j0 = 0; rbase + j0 * rstride < MROWS; j0 += 2) {
#pragma unroll 1
            for (int jj = 0; jj < 2; ++jj) { const int row = rfirst + (j0 + jj) * rstride; if (row >= MROWS) break; do_row(row, jj); }
            __syncthreads();
            {
                const LAS float* ar = vb + fr * 1028 + 128 * wid + 32 * fq;
                f32x4 acc = {0.f, 0.f, 0.f, 0.f};
#pragma unroll
                for (int h = 0; h < 2; ++h) { f32x4 va[4];
#pragma unroll
                    for (int u = 0; u < 4; ++u) va[u] = *(const LAS f32x4*)(ar + h * 16 + u * 4);
#pragma unroll
                    for (int u = 0; u < 4; ++u)
#pragma unroll
                        for (int i = 0; i < 4; ++i) acc = __builtin_amdgcn_mfma_f32_16x16x4f32(va[u][i], wgf[h * 16 + u * 4 + i], acc, 0, 0, 0); }
                LAS float* pw = part + wid * 256 + (4 * fq) * 16 + fr;
#pragma unroll
                for (int i = 0; i < 4; ++i) pw[i * 16] = acc[i];
            }
            __syncthreads();
            if (tid < 256) { const int lr = tid >> 4, row = rbase + (lr & 7) + (j0 + (lr >> 3)) * rstride;
                float a = 0.f;
#pragma unroll
                for (int w2 = 0; w2 < 8; ++w2) a += part[w2 * 256 + tid];
                if (row < MROWS) GT[row * 16 + (tid & 15)] = a; }
        }
    }
}
constexpr int LDK = 136;
__device__ __forceinline__ int sid_of(int mixer, int dir, int b, int ch, int h) { return (((mixer * 2 + dir) * 4 + b) * NCHUNK + ch) * 4 + h; }
__device__ __forceinline__ void unit_decode(int u, int& mixer, int& h, int& ch, int& b, int& row0) {
    mixer = u & 1; h = (u >> 1) & 3; const int rest = u >> 3; ch = rest % NCHUNK; b = rest / NCHUNK;
    row0 = ch < 2 ? b * 256 + ch * 128 : NCTX + b * 4096 + (ch - 2) * 128;
}
__device__ __forceinline__ void ld_raw(const bf16_t* P, int row0, int col, u32x2 (&raw)[8]) {
    const int t = threadIdx.x, i = t >> 2, part = t & 3, i0 = (part & 1) * 32 + (part >> 1) * 16;
    const bf16_t* src = P + (size_t)(row0 + i) * LDP1 + col + i0;
#pragma unroll
    for (int q = 0; q < 4; ++q) { raw[q] = *(const u32x2*)(src + q * 4); raw[4 + q] = *(const u32x2*)(src + 64 + q * 4); }
}
__device__ __forceinline__ void cvt_rows(const u32x2 (&raw)[8], bool rope, int s0, const float* ROPE, float (&lo)[16], float (&hi)[16]) {
    const int t = threadIdx.x, i = t >> 2, part = t & 3, pr = part & 1, hf = part >> 1;
#pragma unroll
    for (int q = 0; q < 4; ++q) {
        lo[q * 4] = __uint_as_float(raw[q].x << 16); lo[q * 4 + 1] = __uint_as_float(raw[q].x & 0xffff0000u); lo[q * 4 + 2] = __uint_as_float(raw[q].y << 16); lo[q * 4 + 3] = __uint_as_float(raw[q].y & 0xffff0000u);
        hi[q * 4] = __uint_as_float(raw[4 + q].x << 16); hi[q * 4 + 1] = __uint_as_float(raw[4 + q].x & 0xffff0000u); hi[q * 4 + 2] = __uint_as_float(raw[4 + q].y << 16); hi[q * 4 + 3] = __uint_as_float(raw[4 + q].y & 0xffff0000u); }
    if (rope) {
        const int s = s0 + i, pos = pr == 0 ? (s >> 6) : (s & 63);
        const float* rp = ROPE + (size_t)(pos * 32 + hf * 16) * 2;
#pragma unroll
        for (int jj = 0; jj < 16; ++jj) { const float c = rp[2 * jj], sn = rp[2 * jj + 1], a = lo[jj], b = hi[jj]; lo[jj] = a * c - b * sn; hi[jj] = a * sn + b * c; }
    }
}
__device__ __forceinline__ void st_rows(LAS bf16_t* dst, const float (&lo)[16], const float (&hi)[16], float scale) {
    const int t = threadIdx.x, i = t >> 2, part = t & 3, i0 = (part & 1) * 32 + (part >> 1) * 16;
    u32x4 w0, w1, w2, w3;
    w0.x = pack_bf16(lo[0] * scale, lo[1] * scale); w0.y = pack_bf16(lo[2] * scale, lo[3] * scale); w0.z = pack_bf16(lo[4] * scale, lo[5] * scale); w0.w = pack_bf16(lo[6] * scale, lo[7] * scale);
    w1.x = pack_bf16(lo[8] * scale, lo[9] * scale); w1.y = pack_bf16(lo[10] * scale, lo[11] * scale); w1.z = pack_bf16(lo[12] * scale, lo[13] * scale); w1.w = pack_bf16(lo[14] * scale, lo[15] * scale);
    w2.x = pack_bf16(hi[0] * scale, hi[1] * scale); w2.y = pack_bf16(hi[2] * scale, hi[3] * scale); w2.z = pack_bf16(hi[4] * scale, hi[5] * scale); w2.w = pack_bf16(hi[6] * scale, hi[7] * scale);
    w3.x = pack_bf16(hi[8] * scale, hi[9] * scale); w3.y = pack_bf16(hi[10] * scale, hi[11] * scale); w3.z = pack_bf16(hi[12] * scale, hi[13] * scale); w3.w = pack_bf16(hi[14] * scale, hi[15] * scale);
    LAS bf16_t* d = dst + i * LDK + i0;
    *(LAS u32x4*)d = w0; *(LAS u32x4*)(d + 8) = w1; *(LAS u32x4*)(d + 64) = w2; *(LAS u32x4*)(d + 72) = w3;
}
__device__ __forceinline__ void st_rows_T(LAS bf16_t* dst, const float (&lo)[16], const float (&hi)[16], float scale) {
    const int t = threadIdx.x, i = t >> 2, part = t & 3, i0 = (part & 1) * 32 + (part >> 1) * 16;
#pragma unroll
    for (int jj = 0; jj < 16; ++jj) { dst[(i0 + jj) * LDK + i] = f2bf(lo[jj] * scale); dst[(i0 + 64 + jj) * LDK + i] = f2bf(hi[jj] * scale); }
}
__device__ __forceinline__ void mma_128(const LAS bf16_t* A, const LAS bf16_t* B, f32x4 (&acc)[2][4], int wr, int wc, int lane) {
    const int fr = lane & 15, fq = lane >> 4;
#pragma unroll
    for (int ks = 0; ks < 4; ++ks) {
        bf16x8 a[2], b[4];
#pragma unroll
        for (int mt = 0; mt < 2; ++mt) a[mt] = *(const LAS bf16x8*)(A + (wr * 32 + mt * 16 + fr) * LDK + ks * 32 + fq * 8);
#pragma unroll
        for (int nt = 0; nt < 4; ++nt) b[nt] = *(const LAS bf16x8*)(B + (wc * 64 + nt * 16 + fr) * LDK + ks * 32 + fq * 8);
#pragma unroll
        for (int mt = 0; mt < 2; ++mt)
#pragma unroll
            for (int nt = 0; nt < 4; ++nt) acc[mt][nt] = __builtin_amdgcn_mfma_f32_16x16x32_bf16(a[mt], b[nt], acc[mt][nt], 0, 0, 0);
    }
}
__device__ __forceinline__ void zero_acc(f32x4 (&acc)[2][4]) {
#pragma unroll
    for (int mt = 0; mt < 2; ++mt)
#pragma unroll
        for (int nt = 0; nt < 4; ++nt) acc[mt][nt] = (f32x4){0.f, 0.f, 0.f, 0.f};
}
__device__ __forceinline__ void wave_scan_sum2(float x0, float x1, float& p0, float& p1, float& total) {
    const int lane = threadIdx.x & 63; float s = x0 + x1, inc = s;
#pragma unroll
    for (int o = 1; o < 64; o <<= 1) { const float t = __shfl_up(inc, o, 64); if (lane >= o) inc += t; }
    const float exc = inc - s; p0 = exc + x0; p1 = exc + s; total = __shfl(inc, 63, 64);
}
__device__ __forceinline__ void wave_scan_max2(float x0, float x1, float& p0, float& p1) {
    const int lane = threadIdx.x & 63; const float m = fmaxf(x0, x1); float inc = m;
#pragma unroll
    for (int o = 1; o < 64; o <<= 1) { const float t = __shfl_up(inc, o, 64); if (lane >= o) inc = fmaxf(inc, t); }
    float exc = __shfl_up(inc, 1, 64); if (lane == 0) exc = -3.0e38f;
    p0 = fmaxf(exc, x0); p1 = fmaxf(exc, m);
}
__device__ __forceinline__ void ph_c1(const Params& p, LAS unsigned char* lds, int bid, int nblk) {
    const int tid = threadIdx.x, wid = tid >> 6, lane = tid & 63, wr = wid >> 1, wc = wid & 1, fr = lane & 15, fq = lane >> 4;
    LAS bf16_t* KsT = (LAS bf16_t*)(lds + LDS_WORK); LAS bf16_t* VsT0 = KsT + 128 * LDK; LAS bf16_t* VsT1 = VsT0 + 128 * LDK;
    LAS float* z = (LAS float*)(VsT1 + 128 * LDK);
    LAS float* lfA = z + 256; LAS float* igA = lfA + 256; LAS float* zmax = igA + 256;
    const bf16_t* P = (const bf16_t*)(p.ws + WS_P); const float* GT = (const float*)(p.ws + WS_GT); const float* ROPE = (const float*)(p.ws + WS_ROPE);
    float* ST = (float*)(p.ws + WS_ST); float* NST = (float*)(p.ws + WS_NST); float* MEND = (float*)(p.ws + WS_MEND); float* BEND = (float*)(p.ws + WS_BEND);
    for (int u = bid; u < NB * NCHUNK * 4 * 2; u += nblk) {
        int mixer, h, ch, b, row0; unit_decode(u, mixer, h, ch, b, row0);
        const int colQ = mixer * 2048 + h * 128;
        u32x2 rawK[8], rawV[8]; ld_raw(P, row0, colQ + 512, rawK); ld_raw(P, row0, colQ + 1024, rawV);
        if (mixer == 0) {
            if (tid < 256) { const int dir = tid >> 7, j = tid & 127; const float lg = p.in[I_CLG][dir * 4 + h]; z[tid] = fexp(lg * (float)(dir == 0 ? 127 - j : j)); }
        } else {
            if (tid < 256) { const int dir = tid >> 7, j = tid & 127, row = row0 + j;
                igA[tid] = GT[row * 16 + dir * 4 + h] + p.in[I_DIB][dir * 4 + h];
                lfA[tid] = -softplusf(-(GT[row * 16 + 8 + dir * 4 + h] + p.in[I_DFB][dir * 4 + h])); }
            __syncthreads();
            if (tid < 128) { const int dir = tid >> 6, j0 = 2 * lane, j1 = j0 + 1;
                const float l0 = lfA[dir * 128 + j0], l1 = lfA[dir * 128 + j1], g0 = igA[dir * 128 + j0], g1 = igA[dir * 128 + j1];
                float r0, r1, total; wave_scan_sum2(l0, l1, r0, r1, total);
                const float w0 = (dir == 0 ? total - r0 : r0 - l0) + g0, w1 = (dir == 0 ? total - r1 : r1 - l1) + g1;
                const float mx = wave_max(fmaxf(w0, w1));
                z[dir * 128 + j0] = fexp(w0 - mx); z[dir * 128 + j1] = fexp(w1 - mx);
                const int sid = sid_of(1, dir, b, ch, h);
                if (lane == 0) { MEND[sid] = mx; BEND[sid] = total; }
                float* CB = (float*)(p.ws + WS_CB) + (size_t)sid * 128; float* CMI = (float*)(p.ws + WS_CMI) + (size_t)sid * 128;
                if (dir == 0) { float m0, m1; wave_scan_max2(g0 - r0, g1 - r1, m0, m1); CB[j0] = r0; CB[j1] = r1; CMI[j0] = r0 + m0; CMI[j1] = r1 + m1; }
                else { const float s0 = total - r0 + l0, s1 = total - r1 + l1;
                    lfA[128 + j0] = g0 - s0; lfA[128 + j1] = g1 - s1; igA[128 + j0] = s0; igA[128 + j1] = s1; CB[j0] = s0; CB[j1] = s1;
                    asm volatile("s_waitcnt lgkmcnt(0)" ::: "memory");
                    const int q0 = 127 - 2 * lane, q1 = q0 - 1; float m0, m1; wave_scan_max2(lfA[128 + q0], lfA[128 + q1], m0, m1);
                    CMI[q0] = igA[128 + q0] + m0; CMI[q1] = igA[128 + q1] + m1; } }
        }
        __syncthreads();
        {
            float lo[16], hi[16];
            cvt_rows(rawK, mixer == 0 && ch >= 2, (ch - 2) * 128, ROPE, lo, hi);
            st_rows_T(KsT, lo, hi, 0.08838834764831845f);
            cvt_rows(rawV, false, 0, ROPE, lo, hi);
            const int i = tid >> 2;
            st_rows_T(VsT0, lo, hi, z[i]); st_rows_T(VsT1, lo, hi, z[128 + i]);
        }
        __syncthreads();
#pragma unroll
        for (int dir = 0; dir < 2; ++dir) {
            f32x4 acc[2][4]; zero_acc(acc);
            mma_128(dir == 0 ? VsT0 : VsT1, KsT, acc, wr, wc, lane);
            bf16_t* dst = (bf16_t*)ST + (size_t)sid_of(mixer, dir, b, ch, h) * 16384;
#pragma unroll
            for (int mt = 0; mt < 2; ++mt)
#pragma unroll
                for (int nt = 0; nt < 4; ++nt)
#pragma unroll
                    for (int r = 0; r < 4; ++r) dst[(wr * 32 + mt * 16 + fq * 4 + r) * 128 + wc * 64 + nt * 16 + fr] = f2bf(acc[mt][nt][r]);
        }
        if (mixer == 1 && tid < 256) { const int dir = tid >> 7, dd = tid & 127; float s = 0.f;
            for (int j = 0; j < 128; ++j) s += z[dir * 128 + j] * bf2f(KsT[dd * LDK + j]);
            NST[(size_t)sid_of(1, dir, b, ch, h) * 128 + dd] = s; }
        __syncthreads();
    }
}
__device__ __forceinline__ void ph_c2(const Params& p, int bid, int nblk) {
    const int tid = threadIdx.x;
    float* ST = (float*)(p.ws + WS_ST); float* NST = (float*)(p.ws + WS_NST); bf16_t* STB = (bf16_t*)(p.ws + WS_STB);
    const float* MEND = (const float*)(p.ws + WS_MEND); const float* BEND = (const float*)(p.ws + WS_BEND); float* MPREV = (float*)(p.ws + WS_MPREV);
    for (int item = bid; item < 2048; item += nblk) {
        const int mixer = item >> 10, chain = (item >> 5) & 31, slab = item & 31, dir = chain >> 4, b = (chain >> 2) & 3, h = chain & 3;
        const int idx = slab * 512 + tid;
        float kv[NCHUNK];
#pragma unroll
        for (int k = 0; k < NCHUNK; ++k) { const int ch = dir == 0 ? k : (k < 2 ? 1 - k : 35 - k); kv[k] = bf2f(((const bf16_t*)ST)[(size_t)sid_of(mixer, dir, b, ch, h) * 16384 + idx]); }
        if (mixer == 0) {
            const float gdec = fexp(p.in[I_CLG][dir * 4 + h] * 128.0f); float r = 0.f;
#pragma unroll
            for (int k = 0; k < NCHUNK; ++k) { const int ch = dir == 0 ? k : (k < 2 ? 1 - k : 35 - k); STB[(size_t)sid_of(0, dir, b, ch, h) * 16384 + idx] = f2bf(r); r = r * gdec + kv[k]; }
        } else {
            const bool do_n = slab == 0 && tid < 128;
            float nv[NCHUNK];
#pragma unroll
            for (int k = 0; k < NCHUNK; ++k) { const int ch = dir == 0 ? k : (k < 2 ? 1 - k : 35 - k); nv[k] = do_n ? NST[(size_t)sid_of(1, dir, b, ch, h) * 128 + tid] : 0.f; }
            float m = -__builtin_inff(), c = 0.f, n = 0.f;
#pragma unroll
            for (int k = 0; k < NCHUNK; ++k) { const int ch = dir == 0 ? k : (k < 2 ? 1 - k : 35 - k); const int sid = sid_of(1, dir, b, ch, h);
                const float me = MEND[sid], be = BEND[sid], mnew = fmaxf(be + m, me), so = fexp(be + m - mnew), sn = fexp(me - mnew);
                STB[(size_t)sid * 16384 + idx] = f2bf(c); c = c * so + kv[k] * sn;
                if (do_n) { NST[(size_t)sid * 128 + tid] = n; n = n * so + nv[k] * sn; }
                if (slab == 0 && tid == 0) MPREV[sid] = m;
                m = mnew; }
        }
    }
}
template <int mixer>
__device__ __forceinline__ void c3_unit(const Params& p, LAS unsigned char* lds, int h, int ch, int b, int row0) {
    const int tid = threadIdx.x, wid = tid >> 6, lane = tid & 63, wr = wid >> 1, wc = wid & 1, fr = lane & 15, fq = lane >> 4;
    LAS bf16_t* Qs = (LAS bf16_t*)(lds + LDS_WORK); LAS bf16_t* Ks = Qs + 128 * LDK; LAS bf16_t* VsT = Ks + 128 * LDK; LAS bf16_t* RT = VsT + 128 * LDK;
    LAS float* fa = (LAS float*)(RT + 128 * LDK);
    LAS float* lfA = fa; LAS float* igA = fa + 256; LAS float* bA = fa + 512; LAS float* miA = fa + 768; LAS float* mtA = fa + 1024; LAS float* sintA = fa + 1280;
    LAS float* rowsum = fa + 1536; LAS float* qn = fa + 2048; LAS float* nA = fa + 2304;
    LAS float* Os = (LAS float*)Qs;
    LAS bf16_t* Pm = Ks;
    const bf16_t* P = (const bf16_t*)(p.ws + WS_P); const float* GT = (const float*)(p.ws + WS_GT); const float* ROPE = (const float*)(p.ws + WS_ROPE);
    const bf16_t* STB = (const bf16_t*)(p.ws + WS_STB); const float* NST = (const float*)(p.ws + WS_NST); const float* MPREV = (const float*)(p.ws + WS_MPREV);
    bf16_t* Y = (bf16_t*)(p.ws + WS_YMIX);
    {
        const int colQ = mixer * 2048 + h * 128; const bool rope = mixer == 0 && ch >= 2;
        {
            u32x2 rawQ[8], rawK[8], rawV[8]; ld_raw(P, row0, colQ, rawQ); ld_raw(P, row0, colQ + 512, rawK); ld_raw(P, row0, colQ + 1024, rawV);
            float lo[16], hi[16];
            cvt_rows(rawQ, rope, (ch - 2) * 128, ROPE, lo, hi); st_rows(Qs, lo, hi, 1.0f);
            cvt_rows(rawK, rope, (ch - 2) * 128, ROPE, lo, hi); st_rows(Ks, lo, hi, 0.08838834764831845f);
            cvt_rows(rawV, false, 0, ROPE, lo, hi); st_rows_T(VsT, lo, hi, 1.0f);
        }
        if (mixer == 1) {
            if (tid < 256) { const int dir = tid >> 7, j = tid & 127, row = row0 + j;
                igA[tid] = GT[row * 16 + dir * 4 + h] + p.in[I_DIB][dir * 4 + h];
                nA[tid] = NST[(size_t)sid_of(1, dir, b, ch, h) * 128 + j];
                bA[tid] = ((const float*)(p.ws + WS_CB))[(size_t)sid_of(1, dir, b, ch, h) * 128 + j]; miA[tid] = ((const float*)(p.ws + WS_CMI))[(size_t)sid_of(1, dir, b, ch, h) * 128 + j]; }
            __syncthreads();
            __syncthreads();
            if (tid < 256) { const int dir = tid >> 7, i = tid & 127; const float mprev = MPREV[sid_of(1, dir, b, ch, h)];
                const float gi = bA[tid] + mprev, mt = fmaxf(gi, miA[tid]); mtA[tid] = mt; sintA[tid] = fexp(gi - mt);
                float s = 0.f;
                for (int d0 = 0; d0 < 128; ++d0) s += bf2f(Qs[i * LDK + d0]) * nA[dir * 128 + d0];
                qn[tid] = s; }
        }
        __syncthreads();
        f32x4 S[2][4]; zero_acc(S);
        mma_128(Qs, Ks, S, wr, wc, lane);
        __syncthreads();
        f32x4 O[2][4]; zero_acc(O);
        if (mixer == 0) {
            const float lg0 = p.in[I_CLG][h], lg1 = p.in[I_CLG][4 + h];
#pragma unroll
            for (int mt = 0; mt < 2; ++mt)
#pragma unroll
                for (int nt = 0; nt < 4; ++nt)
#pragma unroll
                    for (int r = 0; r < 4; ++r) { const int i = wr * 32 + mt * 16 + fq * 4 + r, j = wc * 64 + nt * 16 + fr;
                        const float dcy = (i >= j ? fexp(lg0 * (float)(i - j)) : 0.f) + (j >= i ? fexp(lg1 * (float)(j - i)) : 0.f);
                        Pm[i * LDK + j] = f2bf(S[mt][nt][r] * dcy); }
            __syncthreads();
            mma_128(Pm, VsT, O, wr, wc, lane);
#pragma unroll
            for (int dir = 0; dir < 2; ++dir) {
                { const bf16_t* src = STB + (size_t)sid_of(0, dir, b, ch, h) * 16384 + (tid >> 2) * 128 + (tid & 3) * 32; LAS bf16_t* d = RT + (tid >> 2) * LDK + (tid & 3) * 32;
#pragma unroll
                    for (int q = 0; q < 4; ++q) *(LAS u32x4*)(d + q * 8) = *(const u32x4*)(src + q * 8); }
                __syncthreads();
                f32x4 T[2][4]; zero_acc(T);
                mma_128(Qs, RT, T, wr, wc, lane);
#pragma unroll
                for (int mt = 0; mt < 2; ++mt)
#pragma unroll
                    for (int r = 0; r < 4; ++r) { const int i = wr * 32 + mt * 16 + fq * 4 + r; const float xi = dir == 0 ? fexp(lg0 * (float)(i + 1)) : fexp(lg1 * (float)(128 - i));
#pragma unroll
                        for (int nt = 0; nt < 4; ++nt) O[mt][nt][r] += xi * T[mt][nt][r]; }
                __syncthreads();
            }
        } else {
#pragma unroll
            for (int dir = 0; dir < 2; ++dir) {
                float rp[2][4];
#pragma unroll
                for (int mt = 0; mt < 2; ++mt)
#pragma unroll
                    for (int r = 0; r < 4; ++r) { const int i = wr * 32 + mt * 16 + fq * 4 + r; const float bi = bA[dir * 128 + i] - mtA[dir * 128 + i]; float acc = 0.f;
#pragma unroll
                        for (int nt = 0; nt < 4; ++nt) { const int j = wc * 64 + nt * 16 + fr; const bool valid = dir == 0 ? (j <= i) : (j >= i);
                            const float e = valid ? fexp(bi - bA[dir * 128 + j] + igA[dir * 128 + j]) : 0.f; const float pv = S[mt][nt][r] * e;
                            Pm[i * LDK + j] = f2bf(pv); acc += pv; }
                        rp[mt][r] = row16_sum(acc); }
                if (fr == 0) {
#pragma unroll
                    for (int mt = 0; mt < 2; ++mt)
#pragma unroll
                        for (int r = 0; r < 4; ++r) rowsum[wc * 256 + dir * 128 + wr * 32 + mt * 16 + fq * 4 + r] = rp[mt][r];
                }
                { const bf16_t* src = STB + (size_t)sid_of(1, dir, b, ch, h) * 16384 + (tid >> 2) * 128 + (tid & 3) * 32; LAS bf16_t* d = RT + (tid >> 2) * LDK + (tid & 3) * 32;
#pragma unroll
                    for (int q = 0; q < 4; ++q) *(LAS u32x4*)(d + q * 8) = *(const u32x4*)(src + q * 8); }
                __syncthreads();
                f32x4 T[2][4]; zero_acc(T);
                mma_128(Qs, RT, T, wr, wc, lane);
#pragma unroll
                for (int mt = 0; mt < 2; ++mt)
#pragma unroll
                    for (int r = 0; r < 4; ++r) { const float si = sintA[dir * 128 + wr * 32 + mt * 16 + fq * 4 + r];
#pragma unroll
                        for (int nt = 0; nt < 4; ++nt) T[mt][nt][r] *= si; }
                mma_128(Pm, VsT, T, wr, wc, lane);
#pragma unroll
                for (int mt = 0; mt < 2; ++mt)
#pragma unroll
                    for (int r = 0; r < 4; ++r) { const int i = wr * 32 + mt * 16 + fq * 4 + r; const float si = sintA[dir * 128 + i];
                        float den = (rowsum[dir * 128 + i] + rowsum[256 + dir * 128 + i]) + qn[dir * 128 + i] * si; den = fmaxf(fabsf(den), fexp(-mtA[dir * 128 + i])); const float rden = frcp(den);
#pragma unroll
                        for (int nt = 0; nt < 4; ++nt) O[mt][nt][r] += T[mt][nt][r] * rden; }
                __syncthreads();
            }
        }
#pragma unroll
        for (int mt = 0; mt < 2; ++mt)
#pragma unroll
            for (int nt = 0; nt < 4; ++nt)
#pragma unroll
                for (int r = 0; r < 4; ++r) Os[(wr * 32 + mt * 16 + fq * 4 + r) * 132 + wc * 64 + nt * 16 + fr] = O[mt][nt][r];
        __syncthreads();
        {
            const float* gng = (mixer == 0 ? p.in[I_CGNG] : p.in[I_DGNG]) + h * 128; const float* gnb = (mixer == 0 ? p.in[I_CGNB] : p.in[I_DGNB]) + h * 128;
            const float g0 = gng[lane], g1 = gng[lane + 64], b0 = gnb[lane], b1 = gnb[lane + 64];
#pragma unroll 1
            for (int i4 = 0; i4 < 16; i4 += 4) {
                float qg0[4], qg1[4];
#pragma unroll
                for (int u = 0; u < 4; ++u) { const int row = row0 + wid * 16 + i4 + u; qg0[u] = bf2f(P[(size_t)row * LDP1 + colQ + 1536 + lane]); qg1[u] = bf2f(P[(size_t)row * LDP1 + colQ + 1536 + 64 + lane]); }
#pragma unroll
                for (int u = 0; u < 4; ++u) { const int i = wid * 16 + i4 + u, row = row0 + i;
                    const float x0 = Os[i * 132 + lane], x1 = Os[i * 132 + 64 + lane];
                    const float mean = wave_sum(x0 + x1) * (1.0f / 128.0f), d0 = x0 - mean, d1 = x1 - mean;
                    const float rstd = rsqrtf(wave_sum(d0 * d0 + d1 * d1) * (1.0f / 128.0f) + LN_EPS);
                    const float q0 = qg0[u], q1 = qg1[u];
                    const float s0 = sigm(q0), s1 = sigm(q1);
                    const float y0 = (d0 * rstd * g0 + b0) * (mixer == 0 ? q0 * s0 : s0), y1 = (d1 * rstd * g1 + b1) * (mixer == 0 ? q1 * s1 : s1);
                    Y[(size_t)row * 1024 + mixer * 512 + h * 128 + lane] = f2bf(y0); Y[(size_t)row * 1024 + mixer * 512 + h * 128 + 64 + lane] = f2bf(y1); }
            }
        }
        __syncthreads();
    }
}
__device__ __forceinline__ void ph_c3(const Params& p, LAS unsigned char* lds, int bid, int nblk) {
    for (int u2 = bid; u2 < NB * NCHUNK * 4; u2 += nblk) {
        int mixer, h, ch, b, row0; unit_decode(u2 * 2, mixer, h, ch, b, row0);
        c3_unit<0>(p, lds, h, ch, b, row0);
    }
    for (int u2 = nblk - 1 - bid; u2 < NB * NCHUNK * 4; u2 += nblk) {
        int mixer, h, ch, b, row0; unit_decode(u2 * 2 + 1, mixer, h, ch, b, row0);
        c3_unit<1>(p, lds, h, ch, b, row0);
    }
}
constexpr int NPHASE = 23;
__global__ void __launch_bounds__(NTHR, 2) fwd(Params p) {
    extern __shared__ __attribute__((aligned(16))) unsigned char smem_raw[];
    LAS unsigned char* lds = (LAS unsigned char*)smem_raw;
    if (threadIdx.x == 0) { LAS unsigned* st = (LAS unsigned*)(lds + LDS_BAR); st[0] = 0u; st[1] = 0u; st[2] = 0u; st[3] = 0u; }
    __syncthreads();
    XcdBarrier bar = xcd_barrier_post((unsigned*)(p.ws + WS_CTL), (volatile LAS unsigned*)(lds + LDS_BAR));
    const int bid = blockIdx.x, nblk = gridDim.x;
    unsigned char* ws = p.ws;
#ifndef PHASE_ONLY
#define PHASE_ONLY -1
#endif
#ifndef DBL_MASK
#define DBL_MASK 0u
#endif
#define PHASE(k, call) if constexpr (PHASE_ONLY < 0 || PHASE_ONLY == (k)) { if (p.lo <= (k) && (k) < p.hi) { call; if constexpr ((DBL_MASK >> (k)) & 1u) { xcd_barrier(bar); call; } if ((k) + 1 < p.hi) xcd_barrier(bar); } }
    PHASE(0, ph_prologue(p, lds, bid, nblk))
    PHASE(1, ph_mod_in(p, bid, nblk))
    PHASE(2, ph_gemm_dense<12>(lds, (const bf16_t*)(ws + WS_H), (const bf16_t*)(ws + WS_WIN0T), (bf16_t*)(ws + WS_P), LDP0, 0, 68, bid, nblk))
    PHASE(3, ph_prep_even(p, lds, bid, nblk))
    PHASE(4, ph_r1(p, lds, bid, nblk))
    PHASE(5, ph_r2(p, lds, bid, nblk))
    PHASE(6, ph_fin_even(p, bid, nblk))
    PHASE(7, ph_gemm_dense<4>(lds, (const bf16_t*)(ws + WS_YMIX), (const bf16_t*)(ws + WS_WOUTT), (bf16_t*)(ws + WS_YP), 1024, 0, 68, bid, nblk))
    PHASE(8, ph_ln1<0>(p, lds, bid, nblk))
    PHASE(9, ph_moe_gather<0>(p, lds, bid, nblk))
    PHASE(10, ph_moe_gemm1<0>(p, lds, bid, nblk))
    PHASE(11, ph_moe_gemm2<0>(p, lds, bid, nblk))
    PHASE(12, ph_ln2<0>(p, lds, bid, nblk))
    PHASE(13, ph_gemm_dense<16>(lds, (const bf16_t*)(ws + WS_H), (const bf16_t*)(ws + WS_WIN1T), (bf16_t*)(ws + WS_P), LDP1, 0, 68, bid, nblk))
    PHASE(14, ph_c1(p, lds, bid, nblk))
    PHASE(15, ph_c2(p, bid, nblk))
    PHASE(16, ph_c3(p, lds, bid, nblk))
    PHASE(17, ph_gemm_dense<4>(lds, (const bf16_t*)(ws + WS_YMIX), (const bf16_t*)(ws + WS_WOUTT) + (size_t)1024 * 1024, (bf16_t*)(ws + WS_YP), 1024, 4, 64, bid, nblk))
    PHASE(18, ph_ln1<1>(p, lds, bid, nblk))
    PHASE(19, ph_moe_gather<1>(p, lds, bid, nblk))
    PHASE(20, ph_moe_gemm1<1>(p, lds, bid, nblk))
    PHASE(21, ph_moe_gemm2<1>(p, lds, bid, nblk))
    PHASE(22, ph_ln2<1>(p, lds, bid, nblk))
#undef PHASE
}

#ifndef MK_ONE_LAUNCH
#define MK_ONE_LAUNCH 1
#endif
extern "C" void kernel_launch(void* const* d_in, const int* in_sizes, int n_in, void* d_out, int out_size, void* d_ws, size_t ws_size, hipStream_t stream) {
    static int grid = 0;
    if (grid == 0) {
        if (n_in != N_INPUTS || out_size != NB * SEQL * DM || ws_size < WS_TOTAL) { fprintf(stderr, "kernel_launch: unexpected problem (n_in %d, out %d, ws %zu < %zu)\n", n_in, out_size, ws_size, (size_t)WS_TOTAL); grid = -1; return; }
        int dev = 0, cus = 0, per_cu = 0;
        if (hipGetDevice(&dev) != hipSuccess || hipDeviceGetAttribute(&cus, hipDeviceAttributeMultiprocessorCount, dev) != hipSuccess) { grid = -1; return; }
        if (hipFuncSetAttribute((const void*)fwd, hipFuncAttributeMaxDynamicSharedMemorySize, LDS_BYTES) != hipSuccess) { fprintf(stderr, "kernel_launch: hipFuncSetAttribute failed\n"); grid = -1; return; }
        if (hipOccupancyMaxActiveBlocksPerMultiprocessor(&per_cu, (const void*)fwd, NTHR, LDS_BYTES) != hipSuccess || per_cu < 1) { fprintf(stderr, "kernel_launch: occupancy query says %d\n", per_cu); (void)hipGetLastError(); per_cu = 1; }
        grid = cus;
    }
    if (grid < 0) return;
    (void)hipMemsetAsync((char*)d_ws + WS_CTL, 0, CTL_BYTES, stream);
    Params p{};
    for (int i = 0; i < N_INPUTS; ++i) p.in[i] = (const float*)d_in[i];
    p.out = (float*)d_out; p.ws = (unsigned char*)d_ws;
#if MK_ONE_LAUNCH
    p.lo = 0; p.hi = NPHASE;
    hipLaunchKernelGGL(fwd, dim3(grid), dim3(NTHR), LDS_BYTES, stream, p);
#else
    for (int k = 0; k < NPHASE; ++k) { p.lo = k; p.hi = k + 1; hipLaunchKernelGGL(fwd, dim3(grid), dim3(NTHR), LDS_BYTES, stream, p); }
#endif
}
```

```cpp
#include <hip/hip_runtime.h>
#include <stdint.h>
#include <stdio.h>

#define LAS __attribute__((address_space(3)))
typedef unsigned short bf16_t;
typedef short bf16x8 __attribute__((ext_vector_type(8)));
typedef float f32x4 __attribute__((ext_vector_type(4)));
typedef float f32x2 __attribute__((ext_vector_type(2)));
typedef unsigned u32x4 __attribute__((ext_vector_type(4)));
typedef unsigned u32x2 __attribute__((ext_vector_type(2)));

constexpr int NB = 4, SEQL = 4096, CTXL = 256, DM = 1024;
constexpr int NCTX = NB * CTXL;
constexpr int MROWS = NCTX + NB * SEQL;
constexpr int NTHR = 512;
constexpr int LDP0 = 3072, LDP1 = 4096;
constexpr int A_IN = 1920, EVEN_IN = 2944, ODD_IN = 4112;
constexpr int NEXP = 32, DFF = 1024;
constexpr int MOE_ROWS_MAX = 69632 + 32 * 256;
constexpr float DN_ALPHA = 1.41421356237309515f;
constexpr float LN_EPS = 1e-5f;
constexpr int NCHUNK = 34;

enum { I_X = 0, I_C, I_CTX, I_CCTX, I_WMOD, I_BMOD, I_LNG, I_LNB, I_EWIN, I_EWOUT, I_AMU, I_AW0, I_AWB, I_AA0, I_AAB, I_AGB, I_AKK, I_AKA, I_ARK,
       I_AGNG, I_AGNB, I_BCW, I_BCB, I_BGW, I_BGB, I_BLAM, I_OWIN, I_OWOUT, I_CLG, I_CGNG, I_CGNB, I_DIB, I_DFB, I_DGNG, I_DGNB, I_RW, I_RB,
       I_W1, I_B1, I_W2, I_B2, N_INPUTS };

constexpr size_t al256(size_t x) { return (x + 255) & ~(size_t)255; }
constexpr size_t WS_CTL   = 0;
constexpr size_t CTL_BYTES = 65536;
constexpr size_t CTL_CNT  = 16384;
constexpr size_t WS_MOD   = WS_CTL + CTL_BYTES;
constexpr size_t WS_ROPE  = WS_MOD + al256((size_t)2 * 5 * 6144 * 4);
constexpr size_t WS_WIN0T = WS_ROPE + 16384;
constexpr size_t WS_WIN1T = WS_WIN0T + (size_t)3072 * 1024 * 2;
constexpr size_t WS_WOUTT = WS_WIN1T + (size_t)4096 * 1024 * 2;
constexpr size_t WS_W1T   = WS_WOUTT + (size_t)2 * 1024 * 1024 * 2;
constexpr size_t WS_W2T   = WS_W1T + (size_t)2 * 32 * 2048 * 1024 * 2;
constexpr size_t WS_XS    = WS_W2T + (size_t)2 * 32 * 1024 * 1024 * 2;
constexpr size_t WS_H     = WS_XS + (size_t)MROWS * 1024 * 4;
constexpr size_t WS_YMIX  = WS_H + (size_t)MROWS * 1024 * 2;
constexpr size_t WS_YP    = WS_YMIX + (size_t)MROWS * 1024 * 2;
constexpr size_t WS_GT    = WS_YP + (size_t)MROWS * 1024 * 4;
constexpr size_t WS_TOPE  = WS_GT + (size_t)MROWS * 16 * 4;
constexpr size_t WS_TOPW  = WS_TOPE + (size_t)MROWS * 16;
constexpr size_t WS_TOPS  = WS_TOPW + (size_t)MROWS * 16;
constexpr size_t WS_POS   = WS_TOPS + (size_t)MROWS * 16;
constexpr size_t WS_CNTB  = WS_POS + (size_t)MROWS * 16;
constexpr size_t WS_WLT   = WS_CNTB + (size_t)2 * 512 * 32 * 4;
constexpr size_t WLT_WB = 0, WLT_AB = 65536, WLT_GB = 131072, WLT_GW = 196608, WLT_N = 327680;
constexpr size_t WS_P     = WS_WLT + (size_t)WLT_N * 2;
constexpr size_t WS_BIG   = WS_P + (size_t)MROWS * 4096 * 4;
constexpr size_t ARR512   = (size_t)MROWS * 512 * 4;
constexpr int SCREC = 448;
constexpr int SCLEN = CTXL + SEQL;
constexpr size_t WS_SC    = WS_BIG;
enum { E_G = 0, E_O0, E_O1, E_A0, E_A1, E_BX0, E_BX1, E_GATE, E_NARR };
constexpr size_t WS_EARR  = WS_SC + (size_t)64 * SCLEN * SCREC * 2;
constexpr size_t WS_BC    = WS_EARR + (size_t)E_NARR * ARR512;
constexpr size_t WS_CHA   = WS_BC + (size_t)MROWS * 8 * 4;
constexpr size_t WS_CHH   = WS_CHA + (size_t)2 * 512 * 512 * 4;
constexpr size_t WS_CIN   = WS_CHH + (size_t)2 * 512 * 512 * 4;
constexpr int RCH = 64, NRCH = SCLEN / RCH, NRUNIT = 64 * NRCH;
constexpr size_t WS_RU    = WS_CIN + (size_t)2 * 512 * 512 * 4;
constexpr size_t WS_EEND  = WS_RU + (size_t)NRUNIT * 4 * 4096 * 4;
constexpr int NSID = 2 * 2 * NB * NCHUNK * 4;
constexpr size_t WS_ST    = WS_BIG;
constexpr size_t WS_NST   = WS_ST + (size_t)NSID * 16384 * 4;
constexpr size_t WS_MEND  = WS_NST + (size_t)NSID * 128 * 4;
constexpr size_t WS_BEND  = WS_MEND + al256((size_t)NSID * 4);
constexpr size_t WS_MPREV = WS_BEND + al256((size_t)NSID * 4);
constexpr size_t WS_CB    = WS_MPREV + al256((size_t)NSID * 4);
constexpr size_t WS_CMI   = WS_CB + (size_t)NSID * 128 * 4;
constexpr size_t WS_STB   = WS_CMI + (size_t)NSID * 128 * 4;
constexpr size_t WS_OEND  = WS_STB + (size_t)NSID * 16384 * 2;
constexpr size_t WS_ASORT = WS_BIG;
constexpr size_t WS_IDX   = WS_BIG;
constexpr size_t WS_ACT   = WS_ASORT + (size_t)MOE_ROWS_MAX * 1024 * 2;
constexpr size_t WS_YE    = WS_ACT + (size_t)MOE_ROWS_MAX * 1024 * 2;
constexpr size_t WS_MEND_ = WS_YE + (size_t)MOE_ROWS_MAX * 1024 * 4;
constexpr size_t WS_TOTAL = (WS_EEND > WS_MEND_ ? (WS_EEND > WS_OEND ? WS_EEND : WS_OEND) : (WS_MEND_ > WS_OEND ? WS_MEND_ : WS_OEND));

constexpr int LDS_BYTES = 155648;
constexpr int LDS_BAR = 0;
constexpr int LDS_WORK = 1024;

struct Params {
    const float* in[N_INPUTS];
    float* out;
    unsigned char* ws;
    int lo, hi;
};

typedef __bf16 nbf16x2 __attribute__((ext_vector_type(2)));
__device__ __forceinline__ unsigned pack_bf16(float lo, float hi) { const nbf16x2 v = {(__bf16)lo, (__bf16)hi}; return __builtin_bit_cast(unsigned, v); }
__device__ __forceinline__ bf16_t f2bf(float f) { return __builtin_bit_cast(bf16_t, (__bf16)f); }
__device__ __forceinline__ float bf2f(bf16_t b) { return __uint_as_float(((unsigned)b) << 16); }
__device__ __forceinline__ f32x4 ld_bf16x4(const bf16_t* p) { const u32x2 w = *(const u32x2*)p; return (f32x4){__uint_as_float(w.x << 16), __uint_as_float(w.x & 0xffff0000u), __uint_as_float(w.y << 16), __uint_as_float(w.y & 0xffff0000u)}; }
__device__ __forceinline__ float fexp(float x) { return __builtin_amdgcn_exp2f(x * 1.4426950408889634f); }
__device__ __forceinline__ float frcp(float x) { return __builtin_amdgcn_rcpf(x); }
__device__ __forceinline__ float fsqrt(float x) { return __builtin_amdgcn_sqrtf(x); }
__device__ __forceinline__ float sigm(float x) { return frcp(1.0f + fexp(-x)); }
__device__ __forceinline__ float ftanh(float x) { const float e = fexp(-2.0f * fabsf(x)), t = (1.0f - e) * frcp(1.0f + e); return x < 0.f ? -t : t; }
__device__ __forceinline__ float fexpm1_neg(float x) {
    const float p = x * (1.0f + x * (0.5f + x * (0.16666667f + x * (0.041666668f + x * 0.0083333338f))));
    return x > -0.25f ? p : fexp(x) - 1.0f; }
__device__ __forceinline__ float softplusf(float x) { return fmaxf(x, 0.f) + log1pf(expf(-fabsf(x))); }
__device__ __forceinline__ float wave_sum(float v) {
    v += __int_as_float(__builtin_amdgcn_update_dpp(0, __float_as_int(v), 0x121, 0xf, 0xf, false));
    v += __int_as_float(__builtin_amdgcn_update_dpp(0, __float_as_int(v), 0x122, 0xf, 0xf, false));
    v += __int_as_float(__builtin_amdgcn_update_dpp(0, __float_as_int(v), 0x124, 0xf, 0xf, false));
    v += __int_as_float(__builtin_amdgcn_update_dpp(0, __float_as_int(v), 0x128, 0xf, 0xf, false));
    v += __int_as_float(__builtin_amdgcn_update_dpp(0, __float_as_int(v), 0x142, 0xa, 0xf, false));
    v += __int_as_float(__builtin_amdgcn_update_dpp(0, __float_as_int(v), 0x143, 0xc, 0xf, false));
    return __int_as_float(__builtin_amdgcn_readlane(__float_as_int(v), 63));
}
__device__ __forceinline__ float wave_max(float v) {
    const int ninf = 0xff800000;
    v = fmaxf(v, __int_as_float(__builtin_amdgcn_update_dpp(ninf, __float_as_int(v), 0x121, 0xf, 0xf, false)));
    v = fmaxf(v, __int_as_float(__builtin_amdgcn_update_dpp(ninf, __float_as_int(v), 0x122, 0xf, 0xf, false)));
    v = fmaxf(v, __int_as_float(__builtin_amdgcn_update_dpp(ninf, __float_as_int(v), 0x124, 0xf, 0xf, false)));
    v = fmaxf(v, __int_as_float(__builtin_amdgcn_update_dpp(ninf, __float_as_int(v), 0x128, 0xf, 0xf, false)));
    v = fmaxf(v, __int_as_float(__builtin_amdgcn_update_dpp(ninf, __float_as_int(v), 0x142, 0xa, 0xf, false)));
    v = fmaxf(v, __int_as_float(__builtin_amdgcn_update_dpp(ninf, __float_as_int(v), 0x143, 0xc, 0xf, false)));
    return __int_as_float(__builtin_amdgcn_readlane(__float_as_int(v), 63));
}
__device__ __forceinline__ int wave_min_i(int v) {
    const int big = 0x7fffffff;
    v = min(v, __builtin_amdgcn_update_dpp(big, v, 0x121, 0xf, 0xf, false));
    v = min(v, __builtin_amdgcn_update_dpp(big, v, 0x122, 0xf, 0xf, false));
    v = min(v, __builtin_amdgcn_update_dpp(big, v, 0x124, 0xf, 0xf, false));
    v = min(v, __builtin_amdgcn_update_dpp(big, v, 0x128, 0xf, 0xf, false));
    v = min(v, __builtin_amdgcn_update_dpp(big, v, 0x142, 0xa, 0xf, false));
    v = min(v, __builtin_amdgcn_update_dpp(big, v, 0x143, 0xc, 0xf, false));
    return __builtin_amdgcn_readlane(v, 63);
}
__device__ __forceinline__ float row16_sum(float v) {
    v += __int_as_float(__builtin_amdgcn_update_dpp(0, __float_as_int(v), 0x121, 0xf, 0xf, false));
    v += __int_as_float(__builtin_amdgcn_update_dpp(0, __float_as_int(v), 0x122, 0xf, 0xf, false));
    v += __int_as_float(__builtin_amdgcn_update_dpp(0, __float_as_int(v), 0x124, 0xf, 0xf, false));
    v += __int_as_float(__builtin_amdgcn_update_dpp(0, __float_as_int(v), 0x128, 0xf, 0xf, false));
    return v;
}
__device__ __forceinline__ int row_batch(int row) { return row < NCTX ? (row >> 8) : ((row - NCTX) >> 12); }
__device__ __forceinline__ int row_modr(int row) { return row < NCTX ? 4 : ((row - NCTX) >> 12); }
#define XB_TMO      128
#define XB_XCNT(j)  (256  + 64 * (j))
#define XB_XSUB(j)  (1280 + 64 * (j))
#define XB_XGEN(j)  (2304 + 64 * (j))
#define XB_TOP      3328
#define XB_TOPGEN   3392
#define XCD_BAR_WORDS 3456
#define XB_SPIN_CAP (1u << 18)

__device__ __forceinline__ unsigned xb_ld(unsigned* p)              { return __hip_atomic_load(p, __ATOMIC_RELAXED, __HIP_MEMORY_SCOPE_AGENT); }
__device__ __forceinline__ unsigned xb_add(unsigned* p, unsigned v) { return __hip_atomic_fetch_add(p, v, __ATOMIC_RELAXED, __HIP_MEMORY_SCOPE_AGENT); }
__device__ __forceinline__ unsigned xb_xcc_id() { return (unsigned)__builtin_amdgcn_s_getreg((3 << 11) | 20) & 0xFu; }
#define XB_SPIN(cond, bar) do { unsigned _sp = 0; while (cond) { __builtin_amdgcn_s_sleep(1); \
    if ((++_sp & 255u) == 0u) { if (xb_ld(&(bar)[XB_TMO])) break; if (_sp > XB_SPIN_CAP) { atomicAdd(&(bar)[XB_TMO], 1u); break; } } } } while (0)

struct XcdBarrier {
    unsigned* bar; unsigned x;
    volatile LAS unsigned* st;
};

__device__ __forceinline__ XcdBarrier xcd_barrier_post(unsigned* bar, volatile LAS unsigned* st) {
    XcdBarrier b; b.bar = bar; b.x = xb_xcc_id(); b.st = st;
    if (threadIdx.x == 0) (void)xb_add(&bar[XB_XCNT(b.x)], 1u);
    return b;
}
__device__ __forceinline__ void xcd_barrier_complete(unsigned* bar, unsigned x, unsigned& nloc, unsigned& nx) {
    const unsigned G = gridDim.x * gridDim.y * gridDim.z;
    unsigned sum, cnt, mine, sp = 0u;
    for (;;) {
        sum = 0u; cnt = 0u; mine = 0u;
#pragma unroll
        for (unsigned j = 0; j < 16; ++j) { const unsigned c = xb_ld(&bar[XB_XCNT(j)]); sum += c; cnt += (c > 0u) ? 1u : 0u; mine = (j == x) ? c : mine; }
        if (sum == G) break;
        __builtin_amdgcn_s_sleep(1);
        if ((++sp & 255u) == 0u) { if (xb_ld(&bar[XB_TMO])) break; if (sp > XB_SPIN_CAP) { atomicAdd(&bar[XB_TMO], 1u); break; } }
    }
    nloc = mine > 0u ? mine : 1u; nx = cnt > 0u ? cnt : 1u;
}

__device__ __forceinline__ void xcd_barrier(const XcdBarrier& b) {
    asm volatile("s_waitcnt vmcnt(0)" ::: "memory");
    __syncthreads();
    if (threadIdx.x == 0) {
        unsigned* bar = b.bar;
        __builtin_amdgcn_s_waitcnt(0);
        unsigned nloc = b.st[0], nx = b.st[1];
        if (nloc == 0u) { xcd_barrier_complete(bar, b.x, nloc, nx); b.st[0] = nloc; b.st[1] = nx; }
        const unsigned old = xb_add(&bar[XB_XSUB(b.x)], 1u);
        const unsigned gen = old / nloc;
        if (old + 1u == (gen + 1u) * nloc) {
            __builtin_amdgcn_fence(__ATOMIC_RELEASE, "agent");
            asm volatile("s_waitcnt vmcnt(0)" ::: "memory");
            const unsigned og = xb_add(&bar[XB_TOP], 1u);
            const unsigned tg = og / nx;
            if (og + 1u == (tg + 1u) * nx) xb_add(&bar[XB_TOPGEN], 1u);
            else XB_SPIN(xb_ld(&bar[XB_TOPGEN]) == tg, bar);
            __builtin_amdgcn_fence(__ATOMIC_ACQUIRE, "agent");
            xb_add(&bar[XB_XGEN(b.x)], 1u);
            asm volatile("s_waitcnt vmcnt(0)" ::: "memory");
        } else {
            XB_SPIN(xb_ld(&bar[XB_XGEN(b.x)]) == gen, bar);
            __builtin_amdgcn_fence(__ATOMIC_ACQUIRE, "agent");
            asm volatile("s_waitcnt vmcnt(0)" ::: "memory");
        }
    }
    __syncthreads();
}
namespace pg8 {
constexpr int BM = 256, BK = 64, HALF = 128, HTB = HALF * BK * 2  , STAGE_BYTES = 8 * HTB, NXCD = 8, WGM = 8;

__host__ __device__ __forceinline__ int lds_byte(int r, int c) { const int st = (r >> 4) * 2 + (c >> 5), rr = r & 15, cc = c & 31, ob = rr * 64 + cc * 2; return st * 1024 + (ob ^ (((ob >> 9) & 1) << 5)); }
__host__ __device__ __forceinline__ void stage_rc(int b, int& R, int& C) { const int st = b / 1024, sb = b % 1024, swz = sb ^ (((sb >> 9) & 1) << 5); R = (st >> 1) * 16 + swz / 64; C = (st & 1) * 32 + (swz % 64) / 2; }
__host__ __device__ __forceinline__ int perm32(int rho) { const int n = rho >> 4, i = rho & 15; return 8 * (i >> 2) + 4 * n + (i & 3); }

struct Unit { int pm, pn, hh; };
struct Gemm { const bf16_t* A; const bf16_t* Bt; int M, N, K; const int* aidx; };
__device__ __forceinline__ unsigned cvt_pk_bf16(float lo, float hi) { return pack_bf16(lo, hi); }
template <class Epi, class Sched, bool STAMP = false, bool ATILED = false, bool BTILED = false, bool AGATHER = false, bool HALFM = false>
__device__ __forceinline__ void gemm_phase(LAS unsigned char* lds, const Gemm g, const Sched& S, const Epi& E, unsigned long long* stamps) {
    const int tid = threadIdx.x, wid = __builtin_amdgcn_readfirstlane(tid >> 6), lane = tid & 63, wr = wid >> 2, wc = wid & 3, fr = lane & 15, fq = lane >> 4;
    const int K = g.K, nt = K / BK;
    int ts_lo = 0, ts_hi = 0, nts = 0; const unsigned long long rt_entry = STAMP ? (unsigned long long)wall_clock64() : 0ull;
#define PG8_STAMP() do { if (STAMP && wid == 0 && nts < 64) { const unsigned long long _c = (unsigned long long)clock64(); \
        ts_lo = (lane == nts) ? (int)(unsigned)_c : ts_lo; ts_hi = (lane == nts) ? (int)(unsigned)(_c >> 32) : ts_hi; ++nts; } } while (0)
    PG8_STAMP();
    unsigned voffA[2], voffB[2];
#pragma unroll
    for (int i = 0; i < 2; ++i) { int R, C; stage_rc(tid * 16 + i * 8192, R, C); const int Rb = Epi::PERM ? ((R & ~31) + perm32(R & 31)) : R;
        voffA[i] = (unsigned)(R * (ATILED ? BK : K) + C) * 2u; voffB[i] = (unsigned)(Rb * (BTILED ? BK : K) + C) * 2u; }
    const size_t kstepA = ATILED ? (size_t)BM * BK * 2 : (size_t)(BK * 2), kstepB = BTILED ? (size_t)BM * BK * 2 : (size_t)(BK * 2);
    const size_t hstepA = ATILED ? (size_t)HALF * BK * 2 : (size_t)HALF * K * 2, hstepB = BTILED ? (size_t)HALF * BK * 2 : (size_t)HALF * K * 2;
    const size_t tstep = (size_t)BM * K * 2;
    const unsigned ldsw = (unsigned)wid * 1024u;
    static_assert(!(AGATHER && ATILED), "a gathered operand is row-major");
    int gR0 = 0, gC0 = 0; { int R, C; stage_rc(tid * 16, R, C); gR0 = R; gC0 = C * 2; }
    unsigned vAc[4] = {0u, 0u, 0u, 0u};
    LAS int* gslot = (LAS int*)(lds + STAGE_BYTES + 8192 + 2048);
    const int aoff = lds_byte(wr * 64 + fr, fq * 8), boff = lds_byte(wc * 32 + fr, fq * 8);
#define PG8_SA(b, h) (((b) * 2 + (h)) * HTB)
#define PG8_SB(b, h) ((4 + (b) * 2 + (h)) * HTB)
#define PG8_STAGE(bufoff, gbase, voff) do { _Pragma("unroll") for (int _i = 0; _i < 2; ++_i) \
        __builtin_amdgcn_global_load_lds((const unsigned*)((const char*)(gbase) + (voff)[_i]), (LAS unsigned*)(lds + (bufoff) + ldsw + _i * 8192), 16, 0, 0); } while (0)
#define PG8_STAGE_A(bufoff, gbase, kbytes, h, vg) do { if constexpr (AGATHER) { _Pragma("unroll") for (int _i = 0; _i < 2; ++_i) \
        __builtin_amdgcn_global_load_lds((const unsigned*)((const char*)g.A + (kbytes) + (vg)[(HALFM ? hsrc : (h)) * 2 + _i]), (LAS unsigned*)(lds + (bufoff) + ldsw + _i * 8192), 16, 0, 0); } \
        else PG8_STAGE(bufoff, (gbase) + (HALFM ? (size_t)hsrc * hstepA : (size_t)0), voffA); } while (0)
#define PG8_LDA(dst, b, h) do { _Pragma("unroll") for (int m = 0; m < 4; ++m) _Pragma("unroll") for (int k = 0; k < 2; ++k) dst[m][k] = *(const LAS bf16x8*)(lds + PG8_SA(b, h) + aoff + m * 2048 + k * 1024); } while (0)
#define PG8_LDB(dst, b, h) do { _Pragma("unroll") for (int n = 0; n < 2; ++n) _Pragma("unroll") for (int k = 0; k < 2; ++k) dst[n][k] = *(const LAS bf16x8*)(lds + PG8_SB(b, h) + boff + n * 2048 + k * 1024); } while (0)
#define PG8_MMA(ai, bj, At, Bt) do { __builtin_amdgcn_s_setprio(1); _Pragma("unroll") for (int m = 0; m < 4; ++m) _Pragma("unroll") for (int n = 0; n < 2; ++n) _Pragma("unroll") for (int k = 0; k < 2; ++k) \
        acc[ai][bj][m][n] = __builtin_amdgcn_mfma_f32_16x16x32_bf16(Bt[n][k], At[m][k], acc[ai][bj][m][n], 0, 0, 0); __builtin_amdgcn_s_setprio(0); } while (0)
#define PG8_WAIT_V(n) asm volatile("s_waitcnt vmcnt(" #n ")" ::: "memory")
#define PG8_WAIT_L(n) asm volatile("s_waitcnt lgkmcnt(" #n ")" ::: "memory")
#define PG8_BAR __builtin_amdgcn_s_barrier()
#define PG8_SCHED __builtin_amdgcn_sched_barrier(0)
    Unit cur, nxt; int ui = 0;
    if (!S.next(0, cur)) return;
    f32x4 acc[2][2][4][2];
#pragma unroll
    for (int a = 0; a < 2; ++a)
#pragma unroll
        for (int b = 0; b < 2; ++b)
#pragma unroll
            for (int m = 0; m < 4; ++m)
#pragma unroll
                for (int n = 0; n < 2; ++n) acc[a][b][m][n] = (f32x4){0.f, 0.f, 0.f, 0.f};
    bf16x8 At[4][2], B0[2][2], B1[2][2];
    const char* cA = (const char*)g.A + (size_t)cur.pm * tstep; const char* cB = (const char*)g.Bt + (size_t)cur.pn * tstep;
    S.a_ready(cur);
    if constexpr (AGATHER) {
#pragma unroll
        for (int j = 0; j < 4; ++j) vAc[j] = (unsigned)g.aidx[cur.pm * BM + gR0 + 64 * j] * (unsigned)(K * 2) + (unsigned)gC0;
    }
    int hsrc = HALFM ? cur.hh : 0;
    if constexpr (HALFM) {
        PG8_STAGE(PG8_SB(0, 0), cB, voffB); PG8_STAGE_A(PG8_SA(0, 0), cA, 0, 0, vAc); PG8_STAGE(PG8_SB(0, 1), cB + hstepB, voffB);
        if (wr == 1) PG8_BAR;
        PG8_WAIT_V(2); PG8_BAR;
    } else {
    PG8_STAGE(PG8_SB(0, 0), cB, voffB); PG8_STAGE_A(PG8_SA(0, 0), cA, 0, 0, vAc); PG8_STAGE(PG8_SB(0, 1), cB + hstepB, voffB); PG8_STAGE_A(PG8_SA(0, 1), cA + hstepA, 0, 1, vAc);
    if (wr == 1) PG8_BAR;
    PG8_WAIT_V(4); PG8_BAR;
    }
    PG8_STAGE(PG8_SB(1, 0), cB + kstepB, voffB); PG8_STAGE_A(PG8_SA(1, 0), cA + kstepA, BK * 2, 0, vAc); PG8_STAGE(PG8_SB(1, 1), cB + hstepB + kstepB, voffB);
    PG8_WAIT_V(6); PG8_BAR;
    PG8_STAMP();
    for (;;) {
        const bool has_next = S.next(ui + 1, nxt);
        const char* nA = has_next ? (const char*)g.A + (size_t)nxt.pm * tstep : cA; const char* nB = has_next ? (const char*)g.Bt + (size_t)nxt.pn * tstep : cB;
        E.pre(lds, ui & 1, cur, wid, lane);
        if constexpr (AGATHER) { if (has_next && wid == 0) __builtin_amdgcn_global_load_lds((const unsigned*)(g.aidx + nxt.pm * BM + lane * 4), (LAS unsigned*)(gslot + ((ui + 1) & 1) * 256), 16, 0, 0); }
        for (int t = 0; t < nt; t += 2) {
            const bool last = (t == nt - 2);
            const char* a1 = cA + (size_t)(t + 1) * kstepA;
            const char* a2 = last ? nA : cA + (size_t)(t + 2) * kstepA; const char* b2 = last ? nB : cB + (size_t)(t + 2) * kstepB;
            const char* a3 = a2 + kstepA; const char* b3 = b2 + kstepB;
            if (last && has_next) S.a_ready(nxt);
            const int kb2 = AGATHER ? (last ? 0 : (t + 2) * BK * 2) : 0;
            PG8_LDB(B0, 0, 0); PG8_SCHED; PG8_LDA(At, 0, 0); if constexpr (!HALFM) PG8_STAGE_A(PG8_SA(1, 1), a1 + hstepA, (t + 1) * BK * 2, 1, vAc);
            if constexpr (AGATHER) { if (last && has_next) {
#pragma unroll
                for (int j = 0; j < 4; ++j) vAc[j] = (unsigned)gslot[((ui + 1) & 1) * 256 + gR0 + 64 * j] * (unsigned)(K * 2) + (unsigned)gC0; } }
            PG8_WAIT_L(8); PG8_BAR; PG8_WAIT_L(0); PG8_MMA(0, 0, At, B0); PG8_BAR; PG8_SCHED;
            PG8_LDB(B1, 0, 1); PG8_STAGE(PG8_SB(0, 0), b2, voffB);
            PG8_BAR; PG8_WAIT_L(0); PG8_MMA(0, 1, At, B1); PG8_BAR;
            if constexpr (HALFM) { if (last && has_next) hsrc = nxt.hh; }
            if constexpr (!HALFM) PG8_LDA(At, 0, 1); PG8_STAGE_A(PG8_SA(0, 0), a2, kb2, 0, vAc);
            PG8_BAR; PG8_WAIT_L(0); if constexpr (!HALFM) PG8_MMA(1, 0, At, B0); PG8_BAR; PG8_SCHED;
            PG8_STAGE(PG8_SB(0, 1), b2 + hstepB, voffB);
            PG8_WAIT_V(6); PG8_BAR; if constexpr (!HALFM) PG8_MMA(1, 1, At, B1); PG8_BAR;
            PG8_LDB(B0, 1, 0); PG8_SCHED; PG8_LDA(At, 1, 0); if constexpr (!HALFM) PG8_STAGE_A(PG8_SA(0, 1), a2 + hstepA, kb2, 1, vAc);
            PG8_WAIT_L(8); PG8_BAR; PG8_WAIT_L(0); PG8_MMA(0, 0, At, B0); PG8_BAR; PG8_SCHED;
            PG8_LDB(B1, 1, 1); PG8_STAGE(PG8_SB(1, 0), b3, voffB);
            PG8_BAR; PG8_WAIT_L(0); PG8_MMA(0, 1, At, B1); PG8_BAR;
            if constexpr (!HALFM) PG8_LDA(At, 1, 1); PG8_STAGE_A(PG8_SA(1, 0), a3, kb2 + BK * 2, 0, vAc);
            PG8_BAR; PG8_WAIT_L(0); if constexpr (!HALFM) PG8_MMA(1, 0, At, B0); PG8_BAR; PG8_SCHED;
            PG8_STAGE(PG8_SB(1, 1), b3 + hstepB, voffB);
            PG8_WAIT_V(6); PG8_BAR; if constexpr (!HALFM) PG8_MMA(1, 1, At, B1); PG8_BAR;
        }
        PG8_STAMP();
        if constexpr (!Epi::AFTER_DRAIN) { E.template store<HALFM>(acc, cur, wr, wc, fr, fq, lds, ui & 1); S.done(cur); }
        PG8_STAMP();
        if (!has_next) break;
#pragma unroll
        for (int a = 0; a < 2; ++a)
#pragma unroll
            for (int b = 0; b < 2; ++b)
#pragma unroll
                for (int m = 0; m < 4; ++m)
#pragma unroll
                    for (int n = 0; n < 2; ++n) acc[a][b][m][n] = (f32x4){0.f, 0.f, 0.f, 0.f};
        cur = nxt; cA = nA; cB = nB; ++ui;

    }
    PG8_WAIT_V(0);
    if (wr == 0) PG8_BAR;
    PG8_BAR;
    if constexpr (Epi::AFTER_DRAIN) { E.fused(acc, cur, wr, wc, fr, fq, lds, wid, lane); S.done(cur); }
    PG8_STAMP();
    if (STAMP && wid == 0) { stamps[lane] = lane < nts ? (((unsigned long long)(unsigned)ts_hi << 32) | (unsigned)ts_lo) : 0ull;
        if (lane == 62) stamps[62] = rt_entry; if (lane == 63) stamps[63] = (unsigned long long)wall_clock64(); }
#undef PG8_STAMP
#undef PG8_SA
#undef PG8_SB
#undef PG8_STAGE
#undef PG8_STAGE_A
#undef PG8_LDA
#undef PG8_LDB
#undef PG8_MMA
#undef PG8_WAIT_V
#undef PG8_WAIT_L
#undef PG8_BAR
#undef PG8_SCHED
}
__device__ __forceinline__ int xcd_contig(long L, int nwg) { const int q = nwg / NXCD, r = nwg % NXCD, xcd = (int)(L % NXCD), off = (int)(L / NXCD); return (xcd < r ? xcd * (q + 1) : r * (q + 1) + (xcd - r) * q) + off; }
__device__ __forceinline__ bool tail_split(int nwg, int G, int& nlim) { const int full = (nwg / G) * G, tail = nwg - full; const bool sp = tail > 0 && 2 * tail <= G && (G & 15) == 0; nlim = sp ? full : nwg; return sp; }
template <int nN, int MODE = 0>
struct SchedDense {
    int nM, pm0, G, c;
    __device__ __forceinline__ bool next(int i, Unit& u) const {
        const int nwg = nM * nN; long L = (long)i * G + c; int hh = 0;
        if (MODE != 0) { int nlim; const bool sp = tail_split(nwg, G, nlim);
            if (MODE == 1) { if (L >= nlim) return false; }
            else { if (!sp || i != 0) return false; const int j = (c & 7) + 8 * (c >> 4); if (nlim + j >= nwg) return false; L = nlim + j; hh = (c >> 3) & 1; } }
        if (L >= nwg) return false;
        const int wgid = xcd_contig(L, nwg);
        constexpr int nig = WGM * nN; const int gid = wgid / nig, fm = gid * WGM, gsz = (nM - fm) < WGM ? (nM - fm) : WGM, w = wgid % nig;
        if (gsz == WGM) { u.pm = pm0 + fm + (w & (WGM - 1)); u.pn = w >> 3; } else { u.pm = pm0 + fm + (w % gsz); u.pn = w / gsz; }
        u.hh = hh;
        return true; }
    __device__ __forceinline__ void a_ready(const Unit&) const {}
    __device__ __forceinline__ void done(const Unit&) const {}
};
template <int nN, int MODE = 0>
struct SchedMoe {
    int T, G, c; const LAS int* tileE;
    __device__ __forceinline__ bool next(int i, Unit& u) const { const int nwg = T * nN; long L = (long)i * G + c; int hh = 0;
        if (MODE != 0) { int nlim; const bool sp = tail_split(nwg, G, nlim);
            if (MODE == 1) { if (L >= nlim) return false; }
            else { if (!sp || i != 0) return false; const int j = (c & 7) + 8 * (c >> 4); if (nlim + j >= nwg) return false; L = nlim + j; hh = (c >> 3) & 1; } }
        if (L >= nwg) return false;
        const int wgid = xcd_contig(L, nwg), pt = wgid / nN; u.pm = pt; u.pn = tileE[pt] * nN + (wgid % nN); u.hh = hh; return true; }
    __device__ __forceinline__ void a_ready(const Unit&) const {}
    __device__ __forceinline__ void done(const Unit&) const {}
};
constexpr int EPI_BIAS_OFF = STAGE_BYTES + 8192;
struct EpiStore {
    static constexpr bool PERM = true, AFTER_DRAIN = false;
    bf16_t* O; int ldc;
    __device__ __forceinline__ void pre(LAS unsigned char*, int, const Unit&, int, int) const {}
    template <bool HF> __device__ __forceinline__ void store(const f32x4 (&acc)[2][2][4][2], const Unit& u, int wr, int wc, int fr, int fq, const LAS unsigned char*, int) const {
        const int row0 = u.pm * BM + wr * 64 + fr + (HF ? u.hh * HALF : 0), col0 = u.pn * BM + wc * 32 + 8 * fq;
#pragma unroll
        for (int ai = 0; ai < (HF ? 1 : 2); ++ai)
#pragma unroll
            for (int m = 0; m < 4; ++m) { bf16_t* rowp = O + (size_t)(row0 + ai * HALF + m * 16) * ldc + col0;
#pragma unroll
                for (int bj = 0; bj < 2; ++bj) { const f32x4 v0 = acc[ai][bj][m][0], v1 = acc[ai][bj][m][1];
                    u32x4 w; w.x = cvt_pk_bf16(v0[0], v0[1]); w.y = cvt_pk_bf16(v0[2], v0[3]); w.z = cvt_pk_bf16(v1[0], v1[1]); w.w = cvt_pk_bf16(v1[2], v1[3]);
                    *(u32x4*)(rowp + bj * HALF) = w; } }
    }
};
struct EpiYE {
    static constexpr bool PERM = true, AFTER_DRAIN = false;
    bf16_t* O; const float* b2;
    __device__ __forceinline__ void pre(LAS unsigned char* lds, int par, const Unit& u, int wid, int lane) const {
        if (wid == 0) __builtin_amdgcn_global_load_lds((const unsigned*)(b2 + (u.pn >> 2) * 1024 + (u.pn & 3) * BM + lane * 4), (LAS unsigned*)(lds + EPI_BIAS_OFF + par * 1024), 16, 0, 0);
    }
    template <bool HF> __device__ __forceinline__ void store(const f32x4 (&acc)[2][2][4][2], const Unit& u, int wr, int wc, int fr, int fq, const LAS unsigned char* lds, int par) const {
        const int pn = u.pn & 3;
        const int row0 = u.pm * BM + wr * 64 + fr + (HF ? u.hh * HALF : 0), col0 = pn * BM + wc * 32 + 8 * fq;
        const LAS float* bp = (const LAS float*)(lds + EPI_BIAS_OFF + par * 1024) + wc * 32 + 8 * fq;
        f32x4 bv[2][2];
#pragma unroll
        for (int bj = 0; bj < 2; ++bj)
#pragma unroll
            for (int n = 0; n < 2; ++n) bv[bj][n] = *(const LAS f32x4*)(bp + bj * HALF + 4 * n);
#pragma unroll
        for (int ai = 0; ai < (HF ? 1 : 2); ++ai)
#pragma unroll
            for (int m = 0; m < 4; ++m) { bf16_t* rowp = O + (size_t)(row0 + ai * HALF + m * 16) * 1024 + col0;
#pragma unroll
                for (int bj = 0; bj < 2; ++bj) { const f32x4 v0 = acc[ai][bj][m][0] + bv[bj][0], v1 = acc[ai][bj][m][1] + bv[bj][1];
                    u32x4 w; w.x = cvt_pk_bf16(v0[0], v0[1]); w.y = cvt_pk_bf16(v0[2], v0[3]); w.z = cvt_pk_bf16(v1[0], v1[1]); w.w = cvt_pk_bf16(v1[2], v1[3]);
                    *(u32x4*)(rowp + bj * HALF) = w; } }
    }
};
struct EpiAct {
    static constexpr bool PERM = true, AFTER_DRAIN = false;
    bf16_t* O; const float* b1;
    __device__ __forceinline__ void pre(LAS unsigned char* lds, int par, const Unit& u, int wid, int lane) const {
        if (wid == 0) __builtin_amdgcn_global_load_lds((const unsigned*)(b1 + (u.pn >> 3) * 2048 + (lane >> 5) * 1024 + (u.pn & 7) * 128 + (lane & 31) * 4), (LAS unsigned*)(lds + EPI_BIAS_OFF + par * 1024), 16, 0, 0);
    }
    template <bool HF> __device__ __forceinline__ void store(const f32x4 (&acc)[2][2][4][2], const Unit& u, int wr, int wc, int fr, int fq, const LAS unsigned char* lds, int par) const {
        const int pn = u.pn & 7;
        const int row0 = u.pm * BM + wr * 64 + fr, x0 = pn * 128 + wc * 32 + 8 * fq, hro = HF ? u.hh * HALF : 0;
        const LAS float* bg = (const LAS float*)(lds + EPI_BIAS_OFF + par * 1024) + wc * 32 + 8 * fq; const LAS float* bl = bg + 128;
        const f32x4 g0 = *(const LAS f32x4*)bg, g1 = *(const LAS f32x4*)(bg + 4), l0 = *(const LAS f32x4*)bl, l1 = *(const LAS f32x4*)(bl + 4);
#pragma unroll
        for (int ai = 0; ai < (HF ? 1 : 2); ++ai)
#pragma unroll
            for (int m = 0; m < 4; ++m) {
                float o[8];
#pragma unroll
                for (int n = 0; n < 2; ++n)
#pragma unroll
                    for (int j = 0; j < 4; ++j) {
                        float glu = acc[ai][0][m][n][j] + (n ? g1[j] : g0[j]);
                        float lin = acc[ai][1][m][n][j] + (n ? l1[j] : l0[j]);
                        glu = fminf(glu, 7.0f); lin = fminf(fmaxf(lin, -7.0f), 7.0f);
                        o[n * 4 + j] = (lin + 1.0f) * glu * __builtin_amdgcn_rcpf(1.0f + __expf(-1.702f * glu));
                    }
                u32x4 w; w.x = cvt_pk_bf16(o[0], o[1]); w.y = cvt_pk_bf16(o[2], o[3]); w.z = cvt_pk_bf16(o[4], o[5]); w.w = cvt_pk_bf16(o[6], o[7]);
                *(u32x4*)(O + ((size_t)(u.pm * 16 + (x0 >> 6)) * 256 + (wr * 64 + fr + hro + ai * HALF + m * 16)) * 64 + (x0 & 63)) = w;
            }
    }
};
}
using pg8::Unit;
__device__ __forceinline__ void my_sincos(double a, float& s, float& c) {
    const double n = rint(a * 0.63661977236758134308);
    const double r = (a - n * 1.57079632679489655800e+00) - n * 6.12323399573676603587e-17;
    const double r2 = r * r;
    const double sp = r * (1.0 + r2 * (-1.0 / 6.0 + r2 * (1.0 / 120.0 + r2 * (-1.0 / 5040.0 + r2 * (1.0 / 362880.0 + r2 * (-1.0 / 39916800.0 + r2 * (1.0 / 6227020800.0 + r2 * (-1.0 / 1307674368000.0))))))));
    const double cp = 1.0 + r2 * (-0.5 + r2 * (1.0 / 24.0 + r2 * (-1.0 / 720.0 + r2 * (1.0 / 40320.0 + r2 * (-1.0 / 3628800.0 + r2 * (1.0 / 479001600.0 + r2 * (-1.0 / 87178291200.0 + r2 * (1.0 / 20922789888000.0))))))));
    const int q = ((int)n) & 3;
    const double sn = q == 0 ? sp : q == 1 ? cp : q == 2 ? -sp : -cp;
    const double cn = q == 0 ? cp : q == 1 ? -sp : q == 2 ? -cp : sp;
    s = (float)sn; c = (float)cn;
}
__device__ __forceinline__ void ph_prologue(const Params& p, LAS unsigned char* lds, int bid, int nblk) {
    const int tid = threadIdx.x;
    unsigned char* ws = p.ws;
    {
        LAS float* sv = (LAS float*)(lds + LDS_WORK);
        LAS float* red = sv + 5 * 1024;
        for (int i = tid; i < 5 * 1024; i += NTHR) { const int r = i >> 10, k = i & 1023; const float c = r < 4 ? p.in[I_C][r * 1024 + k] : p.in[I_CCTX][k]; sv[i] = c / (1.0f + expf(-c)); }
        __syncthreads();
        float* MOD = (float*)(ws + WS_MOD);
        for (int item = bid; item < 256; item += nblk) {
            if (tid < 480) {
                const int cl = tid % 48, kp = tid / 48;
                const int gc = item * 48 + cl, l = gc / 6144, n = gc % 6144;
                const float* w = p.in[I_WMOD] + (size_t)l * 1024 * 6144 + n;
                float a0 = 0.f, a1 = 0.f, a2 = 0.f, a3 = 0.f, a4 = 0.f;
#pragma unroll 1
                for (int k0 = kp; k0 < 1024; k0 += 130) {
                    float wv[13];
#pragma unroll
                    for (int u = 0; u < 13; ++u) { const int k = k0 + 10 * u; wv[u] = k < 1024 ? w[(size_t)k * 6144] : 0.f; }
#pragma unroll
                    for (int u = 0; u < 13; ++u) { const int k = k0 + 10 * u < 1024 ? k0 + 10 * u : 1023; a0 += sv[k] * wv[u]; a1 += sv[1024 + k] * wv[u]; a2 += sv[2048 + k] * wv[u]; a3 += sv[3072 + k] * wv[u]; a4 += sv[4096 + k] * wv[u]; }
                }
                LAS float* rp = red + (kp * 48 + cl) * 5; rp[0] = a0; rp[1] = a1; rp[2] = a2; rp[3] = a3; rp[4] = a4;
            }
            __syncthreads();
            if (tid < 240) {
                const int cl = tid / 5, r = tid % 5; float s = 0.f;
                for (int kp = 0; kp < 10; ++kp) s += red[(kp * 48 + cl) * 5 + r];
                const int gc = item * 48 + cl, l = gc / 6144, n = gc % 6144;
                MOD[(size_t)(l * 5 + r) * 6144 + n] = s + p.in[I_BMOD][l * 6144 + n];
            }
            __syncthreads();
        }
    }
    if (bid == (nblk > 1 ? 1 : 0)) {
        float* ROPE = (float*)(ws + WS_ROPE);
        for (int i = tid; i < 2048; i += NTHR) { const int pos = i >> 5, f = i & 31; const double inv = exp(-(double)f * 0.28782313662425575); float s, c; my_sincos((double)pos * inv, s, c); ROPE[2 * i] = c; ROPE[2 * i + 1] = s; }
    }
    {
        bf16_t* WLT = (bf16_t*)(ws + WS_WLT);
        for (int i = bid * NTHR + tid; i < (int)WLT_N; i += nblk * NTHR) {
            float v;
            if (i < 131072) { const int which = i >> 16, r = i & 65535, d = r >> 15, n = (r >> 6) & 511, k = r & 63; v = (which ? p.in[I_AAB] : p.in[I_AWB])[(size_t)(d * 64 + k) * 512 + n]; }
            else if (i < 196608) { const int r = i - 131072, n = r >> 7, k = r & 127; v = p.in[I_AGB][(size_t)k * 512 + n]; }
            else { const int r = i - 196608, blk = r >> 12, o = (r >> 6) & 63, ii = r & 63; v = p.in[I_BGW][(size_t)blk * 4096 + ii * 64 + o]; }
            WLT[i] = f2bf(v);
        }
    }
    {
        LAS float* tile = (LAS float*)(lds + LDS_WORK);
        for (int t = bid; t < 576; t += nblk) {
            const float* src; int ld, nvalid, k0, n0, w1map = 0; bf16_t* dst; int tt = t;
            if (tt < 192) { k0 = (tt / 12) * 64; n0 = (tt % 12) * 256; src = p.in[I_EWIN]; ld = EVEN_IN; nvalid = EVEN_IN; dst = (bf16_t*)(ws + WS_WIN0T); }
            else if ((tt -= 192) < 256) { k0 = (tt >> 4) * 64; n0 = (tt & 15) * 256; src = p.in[I_OWIN]; ld = ODD_IN; nvalid = 4096; dst = (bf16_t*)(ws + WS_WIN1T); }
            else { tt -= 256; const int mat = tt >> 6, r = tt & 63; k0 = (r >> 2) * 64; n0 = (r & 3) * 256; src = mat ? p.in[I_OWOUT] : p.in[I_EWOUT]; ld = 1024; nvalid = 1024; dst = (bf16_t*)(ws + WS_WOUTT) + (size_t)mat * 1024 * 1024; }
            {
                const int j4 = (tid & 63) * 4, i0 = tid >> 6;
                f32x4 v[8];
#pragma unroll
                for (int r = 0; r < 8; ++r) v[r] = (n0 + j4 < nvalid) ? *(const f32x4*)(src + (size_t)(k0 + i0 + 8 * r) * ld + n0 + j4) : (f32x4){0.f, 0.f, 0.f, 0.f};
#pragma unroll
                for (int r = 0; r < 8; ++r) { LAS float* tp = tile + (i0 + 8 * r) * 257 + j4; tp[0] = v[r][0]; tp[1] = v[r][1]; tp[2] = v[r][2]; tp[3] = v[r][3]; }
            }
            __syncthreads();
            {
                const int ip = (tid & 31) * 2, j0 = tid >> 5;
#pragma unroll
                for (int r = 0; r < 16; ++r) {
                    const int j = j0 + 16 * r, n = n0 + j;
                    const int rho = w1map ? ((((n & 1023) >> 7) << 8) + ((n >> 10) << 7) + (n & 127)) : n;
                    *(unsigned*)(dst + (size_t)rho * 1024 + k0 + ip) = pack_bf16(tile[ip * 257 + j], tile[(ip + 1) * 257 + j]);
                }
            }
            __syncthreads();
        }
    }
}
__device__ __forceinline__ void ph_mod_in(const Params& p, int bid, int nblk) {
    const int tid = threadIdx.x, wid = tid >> 6, lane = tid & 63;
    const float* MOD = (const float*)(p.ws + WS_MOD);
    bf16_t* H = (bf16_t*)(p.ws + WS_H);
    for (int row = bid * 8 + wid; row < MROWS; row += nblk * 8) {
        const float* src = row < NCTX ? p.in[I_CTX] + (size_t)row * 1024 : p.in[I_X] + (size_t)(row - NCTX) * 1024;
        const float* md = MOD + (size_t)row_modr(row) * 6144;
#pragma unroll
        for (int q = 0; q < 4; ++q) {
            const int col = q * 256 + lane * 4;
            const f32x4 x = *(const f32x4*)(src + col), sh = *(const f32x4*)(md + col), sc = *(const f32x4*)(md + 1024 + col);
            const f32x4 h = x * (sc + 1.0f) + sh;
            u32x2 w; w.x = pack_bf16(h[0], h[1]); w.y = pack_bf16(h[2], h[3]);
            *(u32x2*)(H + (size_t)row * 1024 + col) = w;
        }
    }
}
__device__ __forceinline__ int even_tok_row(int w, int idx) { return idx < 64 ? NCTX + (w >> 6) * 4096 + (w & 63) * 64 + idx : w * 4 + (idx - 64); }
__device__ __forceinline__ int shift_nb(int row, int cc) {
    if (row >= NCTX) { const int s = (row - NCTX) & 4095, gr = s >> 6, gc = s & 63, slot = cc & 3;
        if (slot == 0) return gc > 0 ? row - 1 : -1;
        if (slot == 1) return gc < 63 ? row + 1 : -1;
        if (slot == 2) return gr > 0 ? row - 64 : -1;
        return gr < 63 ? row + 64 : -1; }
    const int t = row & 255; return (cc & 1) == 0 ? (t > 0 ? row - 1 : -1) : (t < 255 ? row + 1 : -1);
}
__device__ __forceinline__ float shifted_z(const bf16_t* P, const float* mu, int row, int cc) {
    const float pv = bf2f(P[(size_t)row * LDP0 + cc]); const int nb = shift_nb(row, cc);
    const float sv = nb >= 0 ? bf2f(P[(size_t)nb * LDP0 + cc]) : 0.f;
    return pv + (sv - pv) * mu[cc];
}
__device__ __forceinline__ int scan_q(int row, int d) {
    if (row < NCTX) { const int t = row & 255; return d ? 255 - t : t; }
    const int s = (row - NCTX) & 4095; return 256 + (d ? 4095 - s : s);
}
__device__ __forceinline__ bf16_t* sc_rec(float* SC, int d, int row, int h) { return (bf16_t*)SC + ((size_t)((d * 4 + row_batch(row)) * 8 + h) * SCLEN + scan_q(row, d)) * SCREC; }
constexpr int LDL = 392, LDU = 520;
template <int KS>
__device__ __forceinline__ void load_b(const bf16_t* Bt, bf16x8 (&b)[4][KS], int lane) {
    const int fr = lane & 15, fq = lane >> 4;
#pragma unroll
    for (int nt = 0; nt < 4; ++nt)
#pragma unroll
        for (int ks = 0; ks < KS; ++ks) b[nt][ks] = *(const bf16x8*)(Bt + (size_t)(nt * 16 + fr) * (32 * KS) + ks * 32 + fq * 8);
}
template <int KS>
__device__ __forceinline__ void mma_mt(const LAS bf16_t* A, int lda, int mt, const bf16x8 (&b)[4][KS], f32x4 (&acc)[4], int lane) {
    const int fr = lane & 15, fq = lane >> 4;
#pragma unroll
    for (int nt = 0; nt < 4; ++nt) acc[nt] = (f32x4){0.f, 0.f, 0.f, 0.f};
#pragma unroll
    for (int ks = 0; ks < KS; ++ks) {
        const bf16x8 a = *(const LAS bf16x8*)(A + (mt * 16 + fr) * lda + ks * 32 + fq * 8);
#pragma unroll
        for (int nt = 0; nt < 4; ++nt) acc[nt] = __builtin_amdgcn_mfma_f32_16x16x32_bf16(a, b[nt][ks], acc[nt], 0, 0, 0);
    }
}
__device__ __forceinline__ void ph_prep_even(const Params& p, LAS unsigned char* lds, int bid, int nblk) {
    const bf16_t* P = (const bf16_t*)(p.ws + WS_P);
    float* SC = (float*)(p.ws + WS_SC);
    float* EA = (float*)(p.ws + WS_EARR);
#define EARR(k) (EA + (size_t)(k) * ((size_t)MROWS * 512))
    float* BC = (float*)(p.ws + WS_BC);
    float* CHA = (float*)(p.ws + WS_CHA); float* CHH = (float*)(p.ws + WS_CHH);
    const bf16_t* WLT = (const bf16_t*)(p.ws + WS_WLT);
    const float* mu = p.in[I_AMU];
    LAS bf16_t* linb = (LAS bf16_t*)(lds + LDS_WORK);
    LAS bf16_t* ub = linb + 80 * LDL;
    LAS float* rnorm = (LAS float*)(ub + 80 * LDU);
    for (int w = bid; w < 256; w += nblk) {
        int tid_ = threadIdx.x; asm volatile("" : "+v"(tid_));
        const int tid = tid_, wid = tid >> 6, lane = tid & 63, fr = lane & 15, fq = lane >> 4;
        for (int i = tid; i < 12 * LDL; i += NTHR) linb[68 * LDL + i] = 0;
        for (int i = tid; i < 12 * LDU; i += NTHR) ub[68 * LDU + i] = 0;
        if (lane < 48) {
            float mul8[8];
#pragma unroll
            for (int i = 0; i < 8; ++i) mul8[i] = mu[1536 + lane * 8 + i];
#pragma unroll 1
            for (int tok = wid; tok < 68; tok += 8) {
                const int row = even_tok_row(w, tok);
                const u32x4 ps = *(const u32x4*)(P + (size_t)row * LDP0 + 1536 + lane * 8);
                u32x4 pn[4];
#pragma unroll
                for (int sl = 0; sl < 4; ++sl) { const int nb = shift_nb(row, sl); pn[sl] = nb >= 0 ? *(const u32x4*)(P + (size_t)nb * LDP0 + 1536 + lane * 8) : (u32x4){0u, 0u, 0u, 0u}; }
                float z[8];
#pragma unroll
                for (int i = 0; i < 8; ++i) { const unsigned wp = ps[i >> 1], wn = pn[i & 3][i >> 1];
                    const float pv = __uint_as_float((i & 1) ? (wp & 0xffff0000u) : (wp << 16)), sv = __uint_as_float((i & 1) ? (wn & 0xffff0000u) : (wn << 16));
                    const float zz = pv + (sv - pv) * mul8[i];
                    z[i] = lane < 16 ? ftanh(zz) : (lane < 32 ? zz : sigm(zz)); }
                u32x4 q;
#pragma unroll
                for (int i = 0; i < 4; ++i) q[i] = pack_bf16(z[2 * i], z[2 * i + 1]);
                *(LAS u32x4*)(linb + tok * LDL + lane * 8) = q;
            }
        }
        {
            float murv[8], mukv8[8], muvv[8], kkc8[8];
#pragma unroll
            for (int i = 0; i < 8; ++i) { murv[i] = mu[lane * 8 + i]; mukv8[i] = mu[512 + lane * 8 + i]; muvv[i] = mu[1024 + lane * 8 + i]; kkc8[i] = p.in[I_AKK][lane * 8 + i]; }
#pragma unroll 1
            for (int tok = wid; tok < 68; tok += 8) {
                const int row = even_tok_row(w, tok);
                int nbr[4];
#pragma unroll
                for (int sl = 0; sl < 4; ++sl) nbr[sl] = shift_nb(row, sl);
                u32x4 ps[3], pn[3][4];
#pragma unroll
                for (int a = 0; a < 3; ++a) { ps[a] = *(const u32x4*)(P + (size_t)row * LDP0 + a * 512 + lane * 8);
#pragma unroll
                    for (int sl = 0; sl < 4; ++sl) pn[a][sl] = nbr[sl] >= 0 ? *(const u32x4*)(P + (size_t)nbr[sl] * LDP0 + a * 512 + lane * 8) : (u32x4){0u, 0u, 0u, 0u}; }
                float z[3][8];
#pragma unroll
                for (int a = 0; a < 3; ++a)
#pragma unroll
                    for (int i = 0; i < 8; ++i) { const unsigned wp = ps[a][i >> 1], wn = pn[a][i & 3][i >> 1];
                        const float pv = __uint_as_float((i & 1) ? (wp & 0xffff0000u) : (wp << 16)), sv = __uint_as_float((i & 1) ? (wn & 0xffff0000u) : (wn << 16));
                        z[a][i] = pv + (sv - pv) * (a == 0 ? murv[i] : (a == 1 ? mukv8[i] : muvv[i])); }
                float kkr[8], ss = 0.f;
#pragma unroll
                for (int i = 0; i < 8; ++i) { kkr[i] = z[1][i] * kkc8[i]; ss += kkr[i] * kkr[i]; }
                ss += __int_as_float(__builtin_amdgcn_update_dpp(0, __float_as_int(ss), 0xb1, 0xf, 0xf, false));
                ss += __int_as_float(__builtin_amdgcn_update_dpp(0, __float_as_int(ss), 0x4e, 0xf, 0xf, false));
                ss += __int_as_float(__builtin_amdgcn_update_dpp(0, __float_as_int(ss), 0x141, 0xf, 0xf, false));
                const float rn = frcp(fmaxf(fsqrt(ss), 1e-12f));
                if ((lane & 7) == 0) rnorm[tok * 8 + (lane >> 3)] = rn;
                u32x4 qk, qr, qv;
#pragma unroll
                for (int i = 0; i < 4; ++i) { qk[i] = pack_bf16(kkr[2 * i] * rn, kkr[2 * i + 1] * rn); qr[i] = pack_bf16(z[0][2 * i], z[0][2 * i + 1]); qv[i] = pack_bf16(z[2][2 * i], z[2][2 * i + 1]); }
#pragma unroll
                for (int d = 0; d < 2; ++d) { bf16_t* rec = sc_rec(SC, d, row, lane >> 3) + (lane & 7) * 8; *(u32x4*)(rec + 128) = qk; *(u32x4*)(rec + 320) = qr; *(u32x4*)(rec + 384) = qv; }
            }
        }
        {
            float cw[4][8], cb8[8];
#pragma unroll
            for (int i = 0; i < 8; ++i) { cb8[i] = p.in[I_BCB][lane * 8 + i];
#pragma unroll
                for (int k = 0; k < 4; ++k) cw[k][i] = p.in[I_BCW][k * 512 + lane * 8 + i]; }
#pragma unroll 1
            for (int tok = wid; tok < 68; tok += 8) {
                const int row = even_tok_row(w, tok);
                int pos, len;
                if (row >= NCTX) { pos = (row - NCTX) & 4095; len = 4096; } else { pos = row & 255; len = 256; }
                const u32x4 zero4 = {0u, 0u, 0u, 0u};
                const bf16_t* px = P + (size_t)row * LDP0 + 1920 + lane * 8;
                u32x4 xv[4];
                xv[0] = pos >= 2 ? *(const u32x4*)(px - 2 * (size_t)LDP0) : zero4; xv[1] = pos >= 1 ? *(const u32x4*)(px - (size_t)LDP0) : zero4;
                xv[2] = *(const u32x4*)px; xv[3] = pos + 1 < len ? *(const u32x4*)(px + (size_t)LDP0) : zero4;
                const u32x4 gxv = *(const u32x4*)(px + 512);
                float uu[8], gg[8];
#pragma unroll
                for (int i = 0; i < 8; ++i) { float a = cb8[i];
#pragma unroll
                    for (int k = 0; k < 4; ++k) { const unsigned wv = xv[k][i >> 1]; a += cw[k][i] * __uint_as_float((i & 1) ? (wv & 0xffff0000u) : (wv << 16)); }
                    uu[i] = a;
                    const unsigned wg = gxv[i >> 1]; const float gx = __uint_as_float((i & 1) ? (wg & 0xffff0000u) : (wg << 16));
                    gg[i] = 0.5f * gx * (1.0f + ftanh(0.7978845608028654f * (gx + 0.044715f * gx * gx * gx))); }
                u32x4 qu, qg;
#pragma unroll
                for (int i = 0; i < 4; ++i) { qu[i] = pack_bf16(uu[2 * i], uu[2 * i + 1]); qg[i] = pack_bf16(gg[2 * i], gg[2 * i + 1]); }
                *(LAS u32x4*)(ub + tok * LDU + lane * 8) = qu;
                *(u32x4*)((bf16_t*)EARR(E_GATE) + (size_t)row * 512 + lane * 8) = qg;
            }
        }
        __syncthreads();
#pragma unroll 1
        for (int d = 0; d < 2; ++d) {
            {
                bf16x8 bw[4][2]; load_b<2>(WLT + WLT_WB + (size_t)(d * 512 + wid * 64) * 64, bw, lane);
                float w0v[4];
#pragma unroll
                for (int nt = 0; nt < 4; ++nt) w0v[nt] = p.in[I_AW0][d * 512 + wid * 64 + nt * 16 + fr];
#pragma unroll 1
                for (int mt = 0; mt < 5; ++mt) {
                    f32x4 acc[4]; mma_mt<2>(linb + d * 64, LDL, mt, bw, acc, lane);
#pragma unroll
                    for (int r = 0; r < 4; ++r) { const int tok = mt * 16 + fq * 4 + r;
                        if (tok < 68) { float* rec = (float*)sc_rec(SC, d, even_tok_row(w, tok), wid) + fr;
#pragma unroll
                            for (int nt = 0; nt < 4; ++nt) rec[nt * 16] = -0.60653065971263342f * sigm(w0v[nt] + acc[nt][r]);   } }
                }
            }
            {
                bf16x8 bw[4][2]; load_b<2>(WLT + WLT_AB + (size_t)(d * 512 + wid * 64) * 64, bw, lane);
                float a0v[4], kav[4], mukv[4], kkcv[4];
#pragma unroll
                for (int nt = 0; nt < 4; ++nt) { const int n = wid * 64 + nt * 16 + fr; a0v[nt] = p.in[I_AA0][d * 512 + n]; kav[nt] = p.in[I_AKA][n]; mukv[nt] = mu[512 + n]; kkcv[nt] = p.in[I_AKK][n]; }
#pragma unroll 1
                for (int mt = 0; mt < 5; ++mt) {
                    f32x4 acc[4]; mma_mt<2>(linb + 128 + d * 64, LDL, mt, bw, acc, lane);
                    float pkv[4][4], skv[4][4];
#pragma unroll
                    for (int r = 0; r < 4; ++r) { const int tok = mt * 16 + fq * 4 + r, row = even_tok_row(w, tok < 68 ? tok : 0);
#pragma unroll
                        for (int nt = 0; nt < 4; ++nt) { const int n = wid * 64 + nt * 16 + fr, nb = shift_nb(row, n);
                            pkv[r][nt] = bf2f(P[(size_t)row * LDP0 + 512 + n]); skv[r][nt] = nb >= 0 ? bf2f(P[(size_t)nb * LDP0 + 512 + n]) : 0.f; } }
#pragma unroll
                    for (int r = 0; r < 4; ++r) { const int tok = mt * 16 + fq * 4 + r;
                        if (tok < 68) { bf16_t* rec = sc_rec(SC, d, even_tok_row(w, tok), wid) + fr; const float rn = rnorm[tok * 8 + wid];
#pragma unroll
                            for (int nt = 0; nt < 4; ++nt) { const float a = sigm(a0v[nt] + acc[nt][r]);
                                const float zk = pkv[r][nt] + (skv[r][nt] - pkv[r][nt]) * mukv[nt];
                                rec[192 + nt * 16] = f2bf(zk * (1.0f + (a - 1.0f) * kav[nt])); rec[256 + nt * 16] = f2bf(zk * kkcv[nt] * rn * a); } } }
                }
            }
        }
        {
            bf16x8 bw[4][4]; load_b<4>(WLT + WLT_GB + (size_t)(wid * 64) * 128, bw, lane);
            bf16_t* G = (bf16_t*)EARR(E_G);
#pragma unroll 1
            for (int mt = 0; mt < 5; ++mt) {
                f32x4 acc[4]; mma_mt<4>(linb + 256, LDL, mt, bw, acc, lane);
#pragma unroll
                for (int r = 0; r < 4; ++r) { const int tok = mt * 16 + fq * 4 + r;
                    if (tok < 68) { bf16_t* gp = G + (size_t)even_tok_row(w, tok) * 512 + wid * 64 + fr;
#pragma unroll
                        for (int nt = 0; nt < 4; ++nt) gp[nt * 16] = f2bf(acc[nt][r]); } }
            }
        }
#pragma unroll 1
        for (int d = 0; d < 2; ++d) {
            bf16x8 b0[4][2];
            load_b<2>(WLT + WLT_GW + (size_t)(((d * 2 + 0) * 8 + wid) * 64) * 64, b0, lane);
            float gb0[4], gb1[4], spl[4];
#pragma unroll
            for (int nt = 0; nt < 4; ++nt) { const int n = wid * 64 + nt * 16 + fr; gb0[nt] = p.in[I_BGB][(d * 2 + 0) * 512 + n]; gb1[nt] = p.in[I_BGB][(d * 2 + 1) * 512 + n]; spl[nt] = softplusf(-p.in[I_BLAM][d * 512 + n]); }
            float* Ad = EARR(E_A0 + d); float* BXd = EARR(E_BX0 + d);
#pragma unroll 1
            for (int mt = 0; mt < 5; ++mt) {
                f32x4 la[4], acc[4];
                mma_mt<2>(ub + wid * 64, LDU, mt, b0, la, lane);
                { bf16x8 b1[4][2]; load_b<2>(WLT + WLT_GW + (size_t)(((d * 2 + 1) * 8 + wid) * 64) * 64, b1, lane); mma_mt<2>(ub + wid * 64, LDU, mt, b1, acc, lane); }
#pragma unroll
                for (int r = 0; r < 4; ++r) { const int tok = mt * 16 + fq * 4 + r;
                    if (tok < 68) { const size_t o = (size_t)even_tok_row(w, tok) * 512 + wid * 64 + fr;
#pragma unroll
                        for (int nt = 0; nt < 4; ++nt) { const float lg = -8.0f * sigm(gb0[nt] + la[nt][r]) * spl[nt];
                            const float av = fexp(lg); Ad[o + nt * 16] = av; BXd[o + nt * 16] = fsqrt(fmaxf(1.0f - av * av, 0.f)) * sigm(gb1[nt] + acc[nt][r]) * bf2f(ub[tok * LDU + wid * 64 + nt * 16 + fr]);         } } }
            }
        }
        __syncthreads();
        {
            float rk8[8];
#pragma unroll
            for (int i = 0; i < 8; ++i) rk8[i] = p.in[I_ARK][lane * 8 + i];
#pragma unroll 1
            for (int tok = wid; tok < 68; tok += 8) {
                const int row = even_tok_row(w, tok);
                const bf16_t* r0 = sc_rec(SC, 0, row, lane >> 3) + (lane & 7) * 8; const bf16_t* r1 = sc_rec(SC, 1, row, lane >> 3) + (lane & 7) * 8;
                const u32x4 qr = *(const u32x4*)(r0 + 320), q0 = *(const u32x4*)(r0 + 192), q1 = *(const u32x4*)(r1 + 192);
                float sm = 0.f;
#pragma unroll
                for (int i = 0; i < 8; ++i) { const unsigned a = qr[i >> 1], b0 = q0[i >> 1], b1 = q1[i >> 1];
                    const float av = __uint_as_float((i & 1) ? (a & 0xffff0000u) : (a << 16)), b0v = __uint_as_float((i & 1) ? (b0 & 0xffff0000u) : (b0 << 16)), b1v = __uint_as_float((i & 1) ? (b1 & 0xffff0000u) : (b1 << 16));
                    sm += av * (b0v + b1v) * rk8[i]; }
                sm += __int_as_float(__builtin_amdgcn_update_dpp(0, __float_as_int(sm), 0xb1, 0xf, 0xf, false));
                sm += __int_as_float(__builtin_amdgcn_update_dpp(0, __float_as_int(sm), 0x4e, 0xf, 0xf, false));
                sm += __int_as_float(__builtin_amdgcn_update_dpp(0, __float_as_int(sm), 0x141, 0xf, 0xf, false));
                if ((lane & 7) == 0) BC[row * 8 + (lane >> 3)] = sm;
            }
        }
        if (tid < 256) {
            const int d = tid >> 7, c4 = (tid & 127) * 4;
            float* Ad = EARR(E_A0 + d); float* BXd = EARR(E_BX0 + d);
            f32x4 h = {0.f, 0.f, 0.f, 0.f}, cum = {1.f, 1.f, 1.f, 1.f};
#pragma unroll 1
            for (int n0 = 0; n0 < 64; n0 += 8) {
                f32x4 av[8], bv[8];
#pragma unroll
                for (int i = 0; i < 8; ++i) { const int tok = d == 0 ? n0 + i : 63 - n0 - i; const size_t o = (size_t)even_tok_row(w, tok) * 512 + c4; av[i] = *(const f32x4*)(Ad + o); bv[i] = *(const f32x4*)(BXd + o); }
#pragma unroll
                for (int i = 0; i < 8; ++i) { const int tok = d == 0 ? n0 + i : 63 - n0 - i; const size_t o = (size_t)even_tok_row(w, tok) * 512 + c4;
                    h = av[i] * h + bv[i]; cum = cum * av[i]; *(f32x4*)(Ad + o) = cum; *(f32x4*)(BXd + o) = h; }
            }
            { const int cid = (w >> 6) * 128 + 64 + (w & 63); *(f32x4*)(CHA + (size_t)(d * 512 + cid) * 512 + c4) = cum; *(f32x4*)(CHH + (size_t)(d * 512 + cid) * 512 + c4) = h; }
            h = (f32x4){0.f, 0.f, 0.f, 0.f}; cum = (f32x4){1.f, 1.f, 1.f, 1.f};
#pragma unroll
            for (int i = 0; i < 4; ++i) { const int tok = 64 + (d == 0 ? i : 3 - i); const size_t o = (size_t)even_tok_row(w, tok) * 512 + c4;
                const f32x4 a = *(const f32x4*)(Ad + o), bx = *(const f32x4*)(BXd + o); h = a * h + bx; cum = cum * a; *(f32x4*)(Ad + o) = cum; *(f32x4*)(BXd + o) = h; }
            { const int cid = (w >> 6) * 128 + (w & 63); *(f32x4*)(CHA + (size_t)(d * 512 + cid) * 512 + c4) = cum; *(f32x4*)(CHH + (size_t)(d * 512 + cid) * 512 + c4) = h; }
        }
        __syncthreads();
    }
}
__device__ __forceinline__ float vfma(float a, float b, float c) { float d; asm("v_fma_f32 %0, %1, %2, %3" : "=v"(d) : "v"(a), "v"(b), "v"(c)); return d; }
__device__ __forceinline__ float vmul(float a, float b) { float d; asm("v_mul_f32 %0, %1, %2" : "=v"(d) : "v"(a), "v"(b)); return d; }
#define WG_BAR() do { asm volatile("" ::: "memory"); __builtin_amdgcn_s_barrier(); asm volatile("" ::: "memory"); } while (0)
__device__ __forceinline__ int scan_row(int d, int b, int q) {
    if (q < 256) return b * 256 + (d ? 255 - q : q);
    const int s = q - 256; return NCTX + b * 4096 + (d ? 4095 - s : s);
}
__device__ __forceinline__ void ph_fin_even(const Params& p, int bid, int nblk) {
    const int tid = threadIdx.x, wid = tid >> 6, c = tid;
    float* EA = (float*)(p.ws + WS_EARR);
    float* SC = (float*)(p.ws + WS_SC);
    const float* BC = (const float*)(p.ws + WS_BC); const float* CIN = (const float*)(p.ws + WS_CIN);
    bf16_t* Y = (bf16_t*)(p.ws + WS_YMIX);
    const float gg = p.in[I_AGNG][c], gb = p.in[I_AGNB][c];
    for (int r0 = bid * 4; r0 < MROWS; r0 += nblk * 4) {
        float o0[4], o1[4], vv[4], gv[4], bc[4], x0[4], x1[4], a0[4], a1[4], c0[4], c1[4], gt[4];
#pragma unroll
        for (int u = 0; u < 4; ++u) { const int row = r0 + u; const size_t o = (size_t)row * 512 + c;
            const int cid = row < NCTX ? (row >> 8) * 128 + ((row >> 2) & 63) : ((row - NCTX) >> 12) * 128 + 64 + (((row - NCTX) & 4095) >> 6);
            o0[u] = bf2f(((const bf16_t*)EARR(E_O0))[o]); o1[u] = bf2f(((const bf16_t*)EARR(E_O1))[o]); vv[u] = bf2f(sc_rec(SC, 0, row, wid)[384 + (tid & 63)]); gv[u] = bf2f(((const bf16_t*)EARR(E_G))[o]); bc[u] = BC[row * 8 + wid];
            x0[u] = EARR(E_BX0)[o]; x1[u] = EARR(E_BX1)[o]; a0[u] = EARR(E_A0)[o]; a1[u] = EARR(E_A1)[o];
            c0[u] = CIN[(size_t)cid * 512 + c]; c1[u] = CIN[(size_t)(512 + cid) * 512 + c]; gt[u] = bf2f(((const bf16_t*)EARR(E_GATE))[o]); }
#pragma unroll
        for (int u = 0; u < 4; ++u) { const int row = r0 + u;
            const float wkv = o0[u] + o1[u];
            const float mean = wave_sum(wkv) * (1.0f / 64.0f), dv = wkv - mean, var = wave_sum(dv * dv) * (1.0f / 64.0f);
            const float y = (dv * rsqrtf(var + 64e-5f) * gg + gb + bc[u] * vv[u]) * gv[u];
            Y[(size_t)row * 1024 + c] = f2bf(y);
            Y[(size_t)row * 1024 + 512 + c] = f2bf(((x0[u] + a0[u] * c0[u]) + (x1[u] + a1[u] * c1[u])) * gt[u]); }
    }
#undef EARR
}
constexpr int LDT = 72;
__device__ __forceinline__ float quad_sum(float v) {
    v += __int_as_float(__builtin_amdgcn_update_dpp(0, __float_as_int(v), 0xB1, 0xf, 0xf, false));
    v += __int_as_float(__builtin_amdgcn_update_dpp(0, __float_as_int(v), 0x4E, 0xf, 0xf, false));
    return v;
}
template <int PO> __device__ __forceinline__ float quad_bcast(float v) { return __int_as_float(__builtin_amdgcn_update_dpp(0, __float_as_int(v), PO * 0x55, 0xf, 0xf, false)); }
__device__ __forceinline__ bf16x8 ldt8(const LAS bf16_t* T, int row, int col) { return *(const LAS bf16x8*)(T + row * LDT + col); }
__device__ __forceinline__ void ph_r1(const Params& p, LAS unsigned char* lds, int bid, int nblk) {
    const int tid = threadIdx.x, wid = tid >> 6, lane = tid & 63, fr = lane & 15, fq = lane >> 4;
    LAS bf16_t* T0 = (LAS bf16_t*)(lds + LDS_WORK);
#define TL(i) (T0 + (i) * 64 * LDT)
    LAS float* F0 = (LAS float*)(T0 + 11 * 64 * LDT);
    LAS float* F1 = F0 + 4096;
    LAS float* F2 = F1 + 4096;
    LAS float* segt = F2 + 4096;
    LAS float* gl = segt + 512;
    const float* SC = (const float*)(p.ws + WS_SC);
    float* RU = (float*)(p.ws + WS_RU);
    const int k = tid & 63, seg = tid >> 6, t0 = seg * 8;
    const int tr = (wid >> 1) * 16, tc0 = (wid & 1) * 32;
    float kk[8], lw[8], kd[8], ka[8], rr[8], vv[8];
    auto fetch = [&](int unit) {
        const int chain = unit / NRCH, c = unit - chain * NRCH;
        const bf16_t* rec = (const bf16_t*)SC + ((size_t)chain * SCLEN + c * RCH + t0) * SCREC + k;
#pragma unroll
        for (int u = 0; u < 8; ++u) { const bf16_t* r = rec + u * SCREC; lw[u] = ((const float*)(r - k))[k]; kk[u] = bf2f(r[128]); kd[u] = bf2f(r[192]); ka[u] = bf2f(r[256]); rr[u] = bf2f(r[320]); vv[u] = bf2f(r[384]); }
    };
    if (bid < NRUNIT) fetch(bid);
    for (int unit = bid; unit < NRUNIT; unit += nblk) {
        int tid_ = threadIdx.x; asm volatile("" : "+v"(tid_));
        const int tid = tid_, wid = tid >> 6, lane = tid & 63, fr = lane & 15, fq = lane >> 4, k = tid & 63, seg = tid >> 6, t0 = seg * 8, tr = (wid >> 1) * 16, tc0 = (wid & 1) * 32;
        float cum[8]; { float run = 0.f;
#pragma unroll
            for (int u = 0; u < 8; ++u) { run += lw[u]; cum[u] = run; }
            segt[seg * 64 + k] = run; }
        __syncthreads();
        float off = 0.f, tot = 0.f;
#pragma unroll
        for (int s2 = 0; s2 < 8; ++s2) { const float v = segt[s2 * 64 + k]; off += s2 < seg ? v : 0.f; tot += v; }
        if (seg == 0) gl[k] = fexp(tot);
        {
            u32x4 wk, wb, wv; unsigned pk[4], pb[4], pv[4]; float hk = 0.f, hb = 0.f, hv = 0.f;
#pragma unroll
            for (int u = 0; u < 8; ++u) { const int t = t0 + u; const float cu = cum[u] + off;
                const float ginc = fexp(cu), gexc = fexp(cu - lw[u]), ginv = fexp(-cu), gtail = fexp(tot - cu);
                const float kt = kk[u] * gexc;
                TL(0)[t * LDT + k] = f2bf(kt); F0[t * 64 + k] = kt;
                TL(1)[t * LDT + k] = f2bf(kd[u] * ginv); TL(2)[t * LDT + k] = f2bf(ka[u] * ginv); TL(3)[t * LDT + k] = f2bf(rr[u] * ginc);
                const float ktl = kd[u] * gtail, btl = ka[u] * gtail;
                if (u & 1) { pk[u >> 1] = pack_bf16(hk, ktl); pb[u >> 1] = pack_bf16(hb, btl); pv[u >> 1] = pack_bf16(hv, vv[u]); } else { hk = ktl; hb = btl; hv = vv[u]; } }
            wk.x = pk[0]; wk.y = pk[1]; wk.z = pk[2]; wk.w = pk[3]; wb.x = pb[0]; wb.y = pb[1]; wb.z = pb[2]; wb.w = pb[3]; wv.x = pv[0]; wv.y = pv[1]; wv.z = pv[2]; wv.w = pv[3];
            *(LAS u32x4*)(TL(4) + k * LDT + t0) = wk; *(LAS u32x4*)(TL(5) + k * LDT + t0) = wb; *(LAS u32x4*)(TL(6) + k * LDT + t0) = wv;
        }
        if (unit + nblk < NRUNIT) fetch(unit + nblk);
        __syncthreads();
        {
            f32x4 mk[2], mb[2], ak[2], ab[2];
#pragma unroll
            for (int nt = 0; nt < 2; ++nt) { mk[nt] = (f32x4){0.f, 0.f, 0.f, 0.f}; mb[nt] = mk[nt]; ak[nt] = mk[nt]; ab[nt] = mk[nt]; }
#pragma unroll
            for (int ks = 0; ks < 2; ++ks) { const bf16x8 aK = ldt8(TL(0), tr + fr, ks * 32 + fq * 8), aR = ldt8(TL(3), tr + fr, ks * 32 + fq * 8);
#pragma unroll
                for (int nt = 0; nt < 2; ++nt) { const bf16x8 bK = ldt8(TL(1), tc0 + nt * 16 + fr, ks * 32 + fq * 8), bB = ldt8(TL(2), tc0 + nt * 16 + fr, ks * 32 + fq * 8);
                    mk[nt] = __builtin_amdgcn_mfma_f32_16x16x32_bf16(aK, bK, mk[nt], 0, 0, 0); mb[nt] = __builtin_amdgcn_mfma_f32_16x16x32_bf16(aK, bB, mb[nt], 0, 0, 0);
                    ak[nt] = __builtin_amdgcn_mfma_f32_16x16x32_bf16(aR, bK, ak[nt], 0, 0, 0); ab[nt] = __builtin_amdgcn_mfma_f32_16x16x32_bf16(aR, bB, ab[nt], 0, 0, 0); } }
#pragma unroll
            for (int nt = 0; nt < 2; ++nt)
#pragma unroll
                for (int r = 0; r < 4; ++r) { const int t = tr + fq * 4 + r, j = tc0 + nt * 16 + fr;
                    TL(7)[t * LDT + j] = f2bf(j < t ? mk[nt][r] : 0.f); F1[j * 64 + (t & 3) * 16 + (t >> 2)] = j < t ? mb[nt][r] : 0.f;
                    TL(8)[t * LDT + j] = f2bf(j <= t ? ak[nt][r] : 0.f); TL(9)[t * LDT + j] = f2bf(j <= t ? ab[nt][r] : 0.f); }
        }
        __syncthreads();
        {
            f32x4 acc[2] = {(f32x4){0.f, 0.f, 0.f, 0.f}, (f32x4){0.f, 0.f, 0.f, 0.f}};
#pragma unroll
            for (int ks = 0; ks < 2; ++ks) { const bf16x8 a = ldt8(TL(7), tr + fr, ks * 32 + fq * 8);
#pragma unroll
                for (int nt = 0; nt < 2; ++nt) acc[nt] = __builtin_amdgcn_mfma_f32_16x16x32_bf16(a, ldt8(TL(6), tc0 + nt * 16 + fr, ks * 32 + fq * 8), acc[nt], 0, 0, 0); }
#pragma unroll
            for (int nt = 0; nt < 2; ++nt)
#pragma unroll
                for (int r = 0; r < 4; ++r) F2[(tr + fq * 4 + r) * 64 + tc0 + nt * 16 + fr] = acc[nt][r];
        }
        __syncthreads();
        {
            const int col = tid >> 2, part = tid & 3;
            f32x2 acc2[8]; float x[16];
#pragma unroll
            for (int q = 0; q < 16; ++q) { const int t = 4 * q + part; acc2[q >> 1][q & 1] = col < 64 ? F0[t * 64 + col] : F2[t * 64 + col - 64]; x[q] = 0.f; }
#pragma unroll
            for (int t = 0; t < 64; ++t) {
                const int qo = t >> 2, po = t & 3; const float aq = acc2[qo >> 1][qo & 1];
                const float xt = po == 0 ? quad_bcast<0>(aq) : po == 1 ? quad_bcast<1>(aq) : po == 2 ? quad_bcast<2>(aq) : quad_bcast<3>(aq);
                x[qo] = part == po ? xt : x[qo];
                const f32x2 nx = {-xt, -xt};
#pragma unroll
                for (int q4 = qo >> 2; q4 < 4; ++q4) { const f32x4 m = *(const LAS f32x4*)(F1 + t * 64 + part * 16 + q4 * 4);
                    acc2[q4 * 2] = (f32x2){m[0], m[1]} * nx + acc2[q4 * 2]; acc2[q4 * 2 + 1] = (f32x2){m[2], m[3]} * nx + acc2[q4 * 2 + 1]; }
            }
            LAS bf16_t* dstT = col < 64 ? TL(7) + col * LDT : TL(10) + (col - 64) * LDT;
#pragma unroll
            for (int q = 0; q < 16; ++q) dstT[4 * q + part] = f2bf(-x[q]);
        }
        __syncthreads();
        {
            f32x4 rh[2], ol[2], pm[2], qq[2];
#pragma unroll
            for (int nt = 0; nt < 2; ++nt) { rh[nt] = (f32x4){0.f, 0.f, 0.f, 0.f}; ol[nt] = rh[nt]; pm[nt] = rh[nt]; qq[nt] = rh[nt]; }
#pragma unroll
            for (int ks = 0; ks < 2; ++ks) { const int kc = ks * 32 + fq * 8;
                const bf16x8 a7 = ldt8(TL(7), tr + fr, kc), a8 = ldt8(TL(8), tr + fr, kc), a9 = ldt8(TL(9), tr + fr, kc), a6 = ldt8(TL(6), tr + fr, kc), a10 = ldt8(TL(10), tr + fr, kc);
#pragma unroll
                for (int nt = 0; nt < 2; ++nt) { const int br = tc0 + nt * 16 + fr;
                    const bf16x8 b9 = ldt8(TL(9), br, kc), b6 = ldt8(TL(6), br, kc), b10 = ldt8(TL(10), br, kc), b5 = ldt8(TL(5), br, kc), b4 = ldt8(TL(4), br, kc);
                    rh[nt] = __builtin_amdgcn_mfma_f32_16x16x32_bf16(a7, b9, rh[nt], 0, 0, 0);
                    ol[nt] = __builtin_amdgcn_mfma_f32_16x16x32_bf16(a8, b6, ol[nt], 0, 0, 0); ol[nt] = __builtin_amdgcn_mfma_f32_16x16x32_bf16(a9, b10, ol[nt], 0, 0, 0);
                    pm[nt] = __builtin_amdgcn_mfma_f32_16x16x32_bf16(a7, b5, pm[nt], 0, 0, 0);
                    qq[nt] = __builtin_amdgcn_mfma_f32_16x16x32_bf16(a6, b4, qq[nt], 0, 0, 0); qq[nt] = __builtin_amdgcn_mfma_f32_16x16x32_bf16(a10, b5, qq[nt], 0, 0, 0); } }
            float* U = RU + (size_t)unit * 4 * 4096;
#pragma unroll
            for (int nt = 0; nt < 2; ++nt)
#pragma unroll
                for (int r = 0; r < 4; ++r) { const int row = tr + fq * 4 + r, cx = tc0 + nt * 16 + fr; const int o = row * 64 + cx;
                    U[o] = pm[nt][r] + (row == cx ? gl[row] : 0.f);
                    U[4096 + o] = qq[nt][r];
                    U[8192 + o] = rh[nt][r] + bf2f(TL(3)[cx * LDT + row]);
                    U[12288 + o] = ol[nt][r]; }
        }
        __syncthreads();
    }
#undef TL
}
__device__ __forceinline__ void moe_weight_tiles(const Params& p, LAS unsigned char* lds, int first, int stride) {
    const int tid = threadIdx.x; unsigned char* ws = p.ws;
    LAS float* tile = (LAS float*)(lds + LDS_WORK);
    const int j4 = (tid & 31) * 4, i0 = tid >> 5;
    auto decode = [&](int tt, const float*& src, int& ld, int& k0, int& n0, int& w1map, bf16_t*& dst) {
        if (tt < 8192) { const int mat = tt >> 7, r = tt & 127; k0 = (r >> 4) * 128; n0 = (r & 15) * 128; src = p.in[I_W1] + (size_t)mat * 1024 * 2048; ld = 2048; dst = (bf16_t*)(ws + WS_W1T) + (size_t)mat * 2048 * 1024; w1map = 1; }
        else { tt -= 8192; const int mat = tt >> 6, r = tt & 63; k0 = (r >> 3) * 128; n0 = (r & 7) * 128; src = p.in[I_W2] + (size_t)mat * 1024 * 1024; ld = 1024; dst = (bf16_t*)(ws + WS_W2T) + (size_t)mat * 1024 * 1024; w1map = 0; }
    };
    f32x4 v[8];
    if (first < 12288) { const float* src; int ld, k0, n0, w1; bf16_t* dst; decode(first, src, ld, k0, n0, w1, dst);
#pragma unroll
        for (int r = 0; r < 8; ++r) v[r] = __builtin_nontemporal_load((const f32x4*)(src + (size_t)(k0 + i0 + 16 * r) * ld + n0 + j4)); }
    for (int t = first; t < 12288; t += stride) {
        const float* src; int ld, k0, n0, w1map; bf16_t* dst; decode(t, src, ld, k0, n0, w1map, dst);
#pragma unroll
        for (int r = 0; r < 8; ++r) { LAS float* tp = tile + (i0 + 16 * r) * 129 + j4; tp[0] = v[r][0]; tp[1] = v[r][1]; tp[2] = v[r][2]; tp[3] = v[r][3]; }
        __syncthreads();
        if (t + stride < 12288) { const float* s2; int ld2, k2, n2, w2; bf16_t* d2; decode(t + stride, s2, ld2, k2, n2, w2, d2);
#pragma unroll
            for (int r = 0; r < 8; ++r) v[r] = __builtin_nontemporal_load((const f32x4*)(s2 + (size_t)(k2 + i0 + 16 * r) * ld2 + n2 + j4)); }
        { const int ip = (tid & 15) * 8, j0 = tid >> 4;
            const int rho0 = w1map ? ((((n0 & 1023) >> 7) << 8) + ((n0 >> 10) << 7)) : n0;
#pragma unroll
            for (int r = 0; r < 4; ++r) { const int j = j0 + 32 * r;
                u32x4 w; w.x = pack_bf16(tile[ip * 129 + j], tile[(ip + 1) * 129 + j]); w.y = pack_bf16(tile[(ip + 2) * 129 + j], tile[(ip + 3) * 129 + j]);
                w.z = pack_bf16(tile[(ip + 4) * 129 + j], tile[(ip + 5) * 129 + j]); w.w = pack_bf16(tile[(ip + 6) * 129 + j], tile[(ip + 7) * 129 + j]);
                const int rho = rho0 + j, kk8 = k0 + ip; *(u32x4*)(dst + ((size_t)((rho >> 8) * 16 + (kk8 >> 6)) * 256 + (rho & 255)) * 64 + (kk8 & 63)) = w; } }
        __syncthreads();
    }
}
__device__ __forceinline__ void ph_r2(const Params& p, LAS unsigned char* lds, int bid, int nblk) {
    const int tid = threadIdx.x, wid = tid >> 6, lane = tid & 63, fr = lane & 15, g = lane >> 4;
    const int nchainwg = nblk >= 128 ? 64 : 0;
    if (bid >= nchainwg) {
        const int nconv = nblk - nchainwg, cb = bid - nchainwg;
        if (tid < 256) {
            const float* CHA = (const float*)(p.ws + WS_CHA); const float* CHH = (const float*)(p.ws + WS_CHH); float* CIN = (float*)(p.ws + WS_CIN);
            for (int item = cb; item < 16; item += nconv) {
                const int gi = item * 256 + tid, d = gi >> 11, b = (gi >> 9) & 3, c = gi & 511;
                float carry = 0.f;
                for (int s0 = 0; s0 < 128; s0 += 16) {
                    float av[16], hv[16];
#pragma unroll
                    for (int q = 0; q < 16; ++q) { const int st = s0 + q; const int cl = d == 0 ? st : (st < 64 ? 63 - st : 191 - st);
                        const size_t o = (size_t)(d * 512 + b * 128 + cl) * 512 + c; av[q] = CHA[o]; hv[q] = CHH[o]; }
#pragma unroll
                    for (int q = 0; q < 16; ++q) { const int st = s0 + q; const int cl = d == 0 ? st : (st < 64 ? 63 - st : 191 - st);
                        CIN[(size_t)(d * 512 + b * 128 + cl) * 512 + c] = carry; carry = av[q] * carry + hv[q]; }
                }
            }
        }
        __syncthreads();
        moe_weight_tiles(p, lds, cb, nconv);
        if (nchainwg) return;
    }
    LAS float* ring = (LAS float*)(lds + LDS_WORK);
    const float* RU = (const float*)(p.ws + WS_RU);
    float* EA = (float*)(p.ws + WS_EARR);
    for (int chain = nchainwg ? bid : bid; chain < 64; chain += (nchainwg ? 64 : nblk)) {
        const int d = chain >> 5, b = (chain >> 3) & 3, h = chain & 7;
        bf16_t* Od = (bf16_t*)(EA + (size_t)(E_O0 + d) * ((size_t)MROWS * 512));
        auto issue = [&](int c) {
            const float* src = RU + ((size_t)chain * NRCH + c) * 4 * 4096; LAS float* dst = ring + (c & 1) * 4 * 4096;
#pragma unroll
            for (int i = 0; i < 16; ++i) { const int slot = ((wid - 4) * 16 + i) * 64;
                __builtin_amdgcn_global_load_lds((const unsigned*)(src + (size_t)(slot + lane) * 4), (LAS unsigned*)(dst + slot * 4), 16, 0, 0); }
        };
        if (tid >= 256) { issue(0); asm volatile("s_waitcnt vmcnt(0)" ::: "memory"); }
        asm volatile("" ::: "memory"); __builtin_amdgcn_s_barrier(); asm volatile("" ::: "memory");
        f32x4 S[4];
#pragma unroll
        for (int m = 0; m < 4; ++m) S[m] = (f32x4){0.f, 0.f, 0.f, 0.f};
        const int v0 = wid * 16;
        for (int c = 0; c < NRCH; ++c) {
            if (tid >= 256) { if (c + 1 < NRCH) issue(c + 1); asm volatile("s_waitcnt vmcnt(0)" ::: "memory"); }
            else {
                const LAS float* PM = ring + (c & 1) * 4 * 4096; const LAS float* QQ = PM + 4096; const LAS float* RHT = PM + 8192; const LAS float* OL = PM + 12288;
                f32x4 acc[4], Sn[4];
#pragma unroll
                for (int tt = 0; tt < 4; ++tt) {
#pragma unroll
                    for (int i = 0; i < 4; ++i) acc[tt][i] = OL[(16 * tt + 4 * g + i) * 64 + v0 + fr];
                    Sn[tt] = *(const LAS f32x4*)(QQ + (v0 + fr) * 64 + 16 * tt + 4 * g); }
                float A[3][4];
#pragma unroll
                for (int s0 = 0; s0 < 2; ++s0) { const LAS float* ar = RHT + (16 * (s0 >> 2) + 4 * g + (s0 & 3)) * 64 + fr;
#pragma unroll
                    for (int u = 0; u < 4; ++u) A[s0][u] = ar[16 * u]; }
#pragma unroll
                for (int st = 0; st < 32; ++st) {
                    if (st + 2 < 32) { const int s2 = st + 2, mi = s2 & 15; const LAS float* ar = (s2 < 16 ? RHT : PM) + (16 * (mi >> 2) + 4 * g + (mi & 3)) * 64 + fr;
#pragma unroll
                        for (int u = 0; u < 4; ++u) A[s2 % 3][u] = ar[16 * u]; }
                    __builtin_amdgcn_sched_barrier(0);
                    const int mi = st & 15; const float bq = S[mi >> 2][mi & 3];
                    if (st < 16) {
#pragma unroll
                        for (int u = 0; u < 4; ++u) acc[u] = __builtin_amdgcn_mfma_f32_16x16x4f32(A[st % 3][u], bq, acc[u], 0, 0, 0);
                    } else {
#pragma unroll
                        for (int u = 0; u < 4; ++u) Sn[u] = __builtin_amdgcn_mfma_f32_16x16x4f32(A[st % 3][u], bq, Sn[u], 0, 0, 0);
                    }
                }
#pragma unroll
                for (int tt = 0; tt < 4; ++tt)
#pragma unroll
                    for (int i = 0; i < 4; ++i) { const int row = scan_row(d, b, c * RCH + 16 * tt + 4 * g + i); Od[(size_t)row * 512 + h * 64 + v0 + fr] = f2bf(acc[tt][i]); }
#pragma unroll
                for (int m = 0; m < 4; ++m) S[m] = Sn[m];
                asm volatile("s_waitcnt lgkmcnt(0)" ::: "memory");
            }
            asm volatile("" ::: "memory"); __builtin_amdgcn_s_barrier(); asm volatile("" ::: "memory");
        }
    }
}
__device__ __forceinline__ float half_max(float v, int lane) {
    const int ninf = 0xff800000;
    v = fmaxf(v, __int_as_float(__builtin_amdgcn_update_dpp(ninf, __float_as_int(v), 0x121, 0xf, 0xf, false)));
    v = fmaxf(v, __int_as_float(__builtin_amdgcn_update_dpp(ninf, __float_as_int(v), 0x122, 0xf, 0xf, false)));
    v = fmaxf(v, __int_as_float(__builtin_amdgcn_update_dpp(ninf, __float_as_int(v), 0x124, 0xf, 0xf, false)));
    v = fmaxf(v, __int_as_float(__builtin_amdgcn_update_dpp(ninf, __float_as_int(v), 0x128, 0xf, 0xf, false)));
    v = fmaxf(v, __int_as_float(__builtin_amdgcn_update_dpp(ninf, __float_as_int(v), 0x142, 0xa, 0xf, false)));
    const float lo = __int_as_float(__builtin_amdgcn_readlane(__float_as_int(v), 31)), hi = __int_as_float(__builtin_amdgcn_readlane(__float_as_int(v), 63));
    return (lane & 32) ? hi : lo;
}
__device__ __forceinline__ int half_min_i(int v, int lane) {
    const int big = 0x7fffffff;
    v = min(v, __builtin_amdgcn_update_dpp(big, v, 0x121, 0xf, 0xf, false));
    v = min(v, __builtin_amdgcn_update_dpp(big, v, 0x122, 0xf, 0xf, false));
    v = min(v, __builtin_amdgcn_update_dpp(big, v, 0x124, 0xf, 0xf, false));
    v = min(v, __builtin_amdgcn_update_dpp(big, v, 0x128, 0xf, 0xf, false));
    v = min(v, __builtin_amdgcn_update_dpp(big, v, 0x142, 0xa, 0xf, false));
    const int lo = __builtin_amdgcn_readlane(v, 31), hi = __builtin_amdgcn_readlane(v, 63);
    return (lane & 32) ? hi : lo;
}
template <int LAYER>
__device__ __forceinline__ void ph_ln1(const Params& p, LAS unsigned char* lds, int bid, int nblk) {
    const int tid = threadIdx.x, wid = tid >> 6, lane = tid & 63, fr = lane & 15, fq = lane >> 4;
    LAS float* vb = (LAS float*)(lds + LDS_WORK);
    LAS float* part = vb + 16 * 1028;
    LAS int* lcnt = (LAS int*)(part + 8 * 16 * 32);
    float rwf[2][32];
    { const float* rw = p.in[I_RW] + (size_t)LAYER * 32768 + (size_t)(128 * wid + 32 * fq) * 32 + fr;
#pragma unroll
        for (int s2 = 0; s2 < 32; ++s2) { rwf[0][s2] = rw[s2 * 32]; rwf[1][s2] = rw[s2 * 32 + 16]; } }
    if (tid < 32) lcnt[tid] = 0;
    __syncthreads();
    const float* MOD = (const float*)(p.ws + WS_MOD);
    bf16_t* XS = (bf16_t*)(p.ws + WS_XS); const bf16_t* YP = (const bf16_t*)(p.ws + WS_YP); bf16_t* H = (bf16_t*)(p.ws + WS_H);
    int* TOPE = (int*)(p.ws + WS_TOPE); float* TOPW = (float*)(p.ws + WS_TOPW); int* TOPS = (int*)(p.ws + WS_TOPS);
    int* CNTB = (int*)(p.ws + WS_CNTB) + (size_t)(LAYER * 512 + bid) * 32;
    const float* lng = p.in[I_LNG] + (LAYER * 2 + 0) * 1024; const float* lnb = p.in[I_LNB] + (LAYER * 2 + 0) * 1024;
    const int rstride = nblk * 8, rbase = (LAYER == 0 ? 0 : NCTX) + bid * 8;
    f32x4 nres[4], ngate[4]; u32x2 nyp[4];
    auto fetch = [&](int row) {
        const float* res = row < NCTX ? p.in[I_CTX] + (size_t)row * 1024 : p.in[I_X] + (size_t)(row - NCTX) * 1024;
        const float* md = MOD + (size_t)(LAYER * 5 + row_modr(row)) * 6144;
#pragma unroll
        for (int q = 0; q < 4; ++q) { const int col = q * 256 + lane * 4; nres[q] = LAYER == 0 ? *(const f32x4*)(res + col) : ld_bf16x4(XS + (size_t)row * 1024 + col);
            ngate[q] = *(const f32x4*)(md + 2048 + col); nyp[q] = *(const u32x2*)(YP + (size_t)row * 1024 + col); }
    };
    if (rbase < MROWS) fetch(rbase + wid);
#pragma unroll 1
    for (int j0 = 0; rbase + j0 * rstride < MROWS; j0 += 2) {
#pragma unroll 1
        for (int jj = 0; jj < 2; ++jj) {
            const int row = rbase + wid + (j0 + jj) * rstride;
            if (row >= MROWS) break;
            const float* md = MOD + (size_t)(LAYER * 5 + row_modr(row)) * 6144;
            f32x4 v[4], msc[4], msh[4]; float s = 0.f;
#pragma unroll
            for (int q = 0; q < 4; ++q) { const u32x2 w = nyp[q];
                const f32x4 y = (f32x4){__uint_as_float(w.x << 16), __uint_as_float(w.x & 0xffff0000u), __uint_as_float(w.y << 16), __uint_as_float(w.y & 0xffff0000u)};
                v[q] = nres[q] * DN_ALPHA + ngate[q] * y;
                s += (v[q][0] + v[q][1]) + (v[q][2] + v[q][3]); }
#pragma unroll
            for (int q = 0; q < 4; ++q) { const int col = q * 256 + lane * 4; msc[q] = *(const f32x4*)(md + 4096 + col); msh[q] = *(const f32x4*)(md + 3072 + col); }
            if (row + rstride < MROWS) fetch(row + rstride);
            const float mean = wave_sum(s) * (1.0f / 1024.0f);
            float ss = 0.f;
#pragma unroll
            for (int q = 0; q < 4; ++q) { v[q] = v[q] - mean; ss += (v[q][0] * v[q][0] + v[q][1] * v[q][1]) + (v[q][2] * v[q][2] + v[q][3] * v[q][3]); }
            const float rstd = rsqrtf(wave_sum(ss) * (1.0f / 1024.0f) + LN_EPS);
#pragma unroll
            for (int q = 0; q < 4; ++q) { const int col = q * 256 + lane * 4;
                const f32x4 xn = v[q] * rstd * *(const f32x4*)(lng + col) + *(const f32x4*)(lnb + col);
                { u32x2 wx; wx.x = pack_bf16(xn[0], xn[1]); wx.y = pack_bf16(xn[2], xn[3]); *(u32x2*)(XS + (size_t)row * 1024 + col) = wx; }
                v[q] = xn * (msc[q] + 1.0f) + msh[q];
                u32x2 w; w.x = pack_bf16(v[q][0], v[q][1]); w.y = pack_bf16(v[q][2], v[q][3]);
                *(u32x2*)(H + (size_t)row * 1024 + col) = w;
                *(LAS f32x4*)(vb + (wid + 8 * jj) * 1028 + col) = v[q]; }
        }
        __syncthreads();
        {
            const LAS float* ar = vb + fr * 1028 + 128 * wid + 32 * fq;
            f32x4 acc0 = {0.f, 0.f, 0.f, 0.f}, acc1 = {0.f, 0.f, 0.f, 0.f};
#pragma unroll
            for (int h = 0; h < 2; ++h) { f32x4 va[4];
#pragma unroll
                for (int u = 0; u < 4; ++u) va[u] = *(const LAS f32x4*)(ar + h * 16 + u * 4);
#pragma unroll
                for (int u = 0; u < 4; ++u)
#pragma unroll
                    for (int i = 0; i < 4; ++i) { acc0 = __builtin_amdgcn_mfma_f32_16x16x4f32(va[u][i], rwf[0][h * 16 + u * 4 + i], acc0, 0, 0, 0);
                        acc1 = __builtin_amdgcn_mfma_f32_16x16x4f32(va[u][i], rwf[1][h * 16 + u * 4 + i], acc1, 0, 0, 0); } }
            LAS float* pw = part + wid * 512 + (4 * fq) * 32 + fr;
#pragma unroll
            for (int i = 0; i < 4; ++i) { pw[i * 32] = acc0[i]; pw[i * 32 + 16] = acc1[i]; }
        }
        __syncthreads();
        {
            const int e = lane & 31, lr = 2 * wid + (lane >> 5), row = rbase + (lr & 7) + (j0 + (lr >> 3)) * rstride;
            float lg = p.in[I_RB][LAYER * 32 + e];
#pragma unroll
            for (int w2 = 0; w2 < 8; ++w2) lg += part[w2 * 512 + lr * 32 + e];
            float tv[4]; int te[4];
#pragma unroll
            for (int k = 0; k < 4; ++k) { const float bv = half_max(lg, lane); const int bi = half_min_i(lg == bv ? e : 99, lane);
                tv[k] = bv; te[k] = bi & 31; lg = e == bi ? -3.0e38f : lg; }
            const float e1 = expf(tv[1] - tv[0]), e2 = expf(tv[2] - tv[0]), e3 = expf(tv[3] - tv[0]), inv = 1.0f / (1.0f + e1 + e2 + e3);
            if (e == 0 && row < MROWS) {
                const float wv[4] = {inv, e1 * inv, e2 * inv, e3 * inv};
#pragma unroll
                for (int k = 0; k < 4; ++k) { const int slot = __hip_atomic_fetch_add(lcnt + te[k], 1, __ATOMIC_RELAXED, __HIP_MEMORY_SCOPE_WORKGROUP); TOPE[row * 4 + k] = te[k]; TOPW[row * 4 + k] = wv[k]; TOPS[row * 4 + k] = slot; }
            }
        }
    }
    __syncthreads();
    if (tid < 32) CNTB[tid] = lcnt[tid];
}
constexpr int LDS_TAB = LDS_WORK + 131072;
__device__ __forceinline__ int moe_tables(const int* cntb, int nblk, LAS int* tab, LAS int* bb) {
    const int tid = threadIdx.x, e = tid & 31, seg = tid >> 5, per = (nblk + 15) >> 4;
    const int b0 = seg * per, b1 = (b0 + per) < nblk ? (b0 + per) : nblk;
    int s = 0;
    if (per <= 16) {
        int cv[16];
#pragma unroll
        for (int u = 0; u < 16; ++u) cv[u] = (b0 + u) < b1 ? cntb[(b0 + u) * 32 + e] : 0;
#pragma unroll
        for (int u = 0; u < 16; ++u) s += cv[u];
        tab[512 + seg * 32 + e] = s;
        __syncthreads();
        if (tid < 32) { int run = 0; for (int sg = 0; sg < 16; ++sg) { const int v = tab[512 + sg * 32 + tid]; tab[512 + sg * 32 + tid] = run; run += v; } tab[448 + tid] = run; }
        __syncthreads();
        if (bb) { int run = tab[512 + seg * 32 + e];
#pragma unroll
            for (int u = 0; u < 16; ++u) if ((b0 + u) < b1) { bb[(b0 + u) * 32 + e] = run; run += cv[u]; } }
    } else {
        for (int b = b0; b < b1; ++b) s += cntb[b * 32 + e];
        tab[512 + seg * 32 + e] = s;
        __syncthreads();
        if (tid < 32) { int run = 0; for (int sg = 0; sg < 16; ++sg) { const int v = tab[512 + sg * 32 + tid]; tab[512 + sg * 32 + tid] = run; run += v; } tab[448 + tid] = run; }
        __syncthreads();
        if (bb) { int run = tab[512 + seg * 32 + e]; for (int b = b0; b < b1; ++b) { bb[b * 32 + e] = run; run += cntb[b * 32 + e]; } }
    }
    if (tid < 64) {
        const int x = tid & 31, n = (tab[448 + x] + 255) >> 8; int inc = n;
#pragma unroll
        for (int o = 1; o < 32; o <<= 1) { const int t = __shfl_up(inc, o, 64); if ((tid & 31) >= o) inc += t; }
        if (tid < 32) { const int t0 = inc - n; tab[x] = t0 * 256; for (int i = 0; i < n; ++i) tab[64 + t0 + i] = x; if (x == 31) { tab[32] = inc * 256; tab[40] = inc; } }
    }
    __syncthreads();
    return tab[40];
}
template <int LAYER>
__device__ __forceinline__ void ph_moe_gather(const Params& p, LAS unsigned char* lds, int bid, int nblk) {
    const int tid = threadIdx.x;
    LAS int* tab = (LAS int*)(lds + LDS_TAB); LAS int* bb = (LAS int*)(lds + LDS_WORK);
    (void)moe_tables((const int*)(p.ws + WS_CNTB) + (size_t)LAYER * 512 * 32, nblk, tab, bb);
    const int* TOPE = (const int*)(p.ws + WS_TOPE); const int* TOPS = (const int*)(p.ws + WS_TOPS); int* POS = (int*)(p.ws + WS_POS); int* IDX = (int*)(p.ws + WS_IDX);
    constexpr int R0 = LAYER == 0 ? 0 : NCTX;
    for (int i = R0 * 4 + bid * NTHR + tid; i < MROWS * 4; i += nblk * NTHR) {
        const int row = i >> 2, e = TOPE[i], pos = tab[e] + bb[((((row - R0) >> 3) % nblk) << 5) + e] + TOPS[i];
        POS[i] = pos; IDX[pos] = row;
    }
    for (int e = bid; e < 32; e += nblk) {
        const int cnt = tab[448 + e], beg = tab[e] + cnt, end = tab[e] + ((cnt + 255) & ~255);
        for (int q = beg + tid; q < end; q += NTHR) IDX[q] = R0;
    }
}
template <int LAYER>
__device__ __forceinline__ void ph_moe_gemm1(const Params& p, LAS unsigned char* lds, int bid, int nblk) {
    LAS int* tab = (LAS int*)(lds + LDS_TAB);
    const int T = moe_tables((const int*)(p.ws + WS_CNTB) + (size_t)LAYER * 512 * 32, nblk, tab, (LAS int*)nullptr);
    pg8::Gemm g{(const bf16_t*)(p.ws + WS_H), (const bf16_t*)(p.ws + WS_W1T) + (size_t)LAYER * 32 * 2048 * 1024, 0, 0, 1024, (const int*)(p.ws + WS_IDX)};
    pg8::EpiAct E{(bf16_t*)(p.ws + WS_ACT), p.in[I_B1] + (size_t)LAYER * 32 * 2048};
    pg8::SchedMoe<8> S{T, nblk, bid, tab + 64};
    pg8::gemm_phase<pg8::EpiAct, pg8::SchedMoe<8>, false, false, true, true>(lds + LDS_WORK, g, S, E, nullptr);
}
template <int LAYER>
__device__ __forceinline__ void ph_moe_gemm2(const Params& p, LAS unsigned char* lds, int bid, int nblk) {
    LAS int* tab = (LAS int*)(lds + LDS_TAB);
    const int T = moe_tables((const int*)(p.ws + WS_CNTB) + (size_t)LAYER * 512 * 32, nblk, tab, (LAS int*)nullptr);
    pg8::Gemm g{(const bf16_t*)(p.ws + WS_ACT), (const bf16_t*)(p.ws + WS_W2T) + (size_t)LAYER * 32 * 1024 * 1024, 0, 0, 1024};
    pg8::EpiYE E{(bf16_t*)(p.ws + WS_YE), p.in[I_B2] + (size_t)LAYER * 32 * 1024};
    { pg8::SchedMoe<4, 1> S{T, nblk, bid, tab + 64}; pg8::gemm_phase<pg8::EpiYE, pg8::SchedMoe<4, 1>, false, true, true>(lds + LDS_WORK, g, S, E, nullptr); }
    { pg8::SchedMoe<4, 2> S{T, nblk, bid, tab + 64}; pg8::gemm_phase<pg8::EpiYE, pg8::SchedMoe<4, 2>, false, true, true, false, true>(lds + LDS_WORK, g, S, E, nullptr); }
}
template <int NN>
__device__ __forceinline__ void ph_gemm_dense(LAS unsigned char* lds, const bf16_t* A, const bf16_t* Bt, bf16_t* C, int ldc, int pm0, int nM, int bid, int nblk) {
    pg8::Gemm g{A, Bt, 0, 0, 1024};
    pg8::EpiStore E{C, ldc};
    { pg8::SchedDense<NN, 1> S{nM, pm0, nblk, bid}; pg8::gemm_phase<pg8::EpiStore, pg8::SchedDense<NN, 1>, false>(lds + LDS_WORK, g, S, E, nullptr); }
    { pg8::SchedDense<NN, 2> S{nM, pm0, nblk, bid}; pg8::gemm_phase<pg8::EpiStore, pg8::SchedDense<NN, 2>, false, false, false, false, true>(lds + LDS_WORK, g, S, E, nullptr); }
}
template <int LAYER>
__device__ __forceinline__ void ph_ln2(const Params& p, LAS unsigned char* lds, int bid, int nblk) {
    const int tid = threadIdx.x, wid = tid >> 6, lane = tid & 63, fr = lane & 15, fq = lane >> 4;
    LAS float* vb = (LAS float*)(lds + LDS_WORK);
    LAS float* part = vb + 16 * 1028;
    float wgf[32];
    if (LAYER == 0) { const float* wg = p.in[I_OWIN] + (size_t)(128 * wid + 32 * fq) * ODD_IN + 4096 + fr;
#pragma unroll
        for (int s2 = 0; s2 < 32; ++s2) wgf[s2] = wg[(size_t)s2 * ODD_IN]; }
    const float* MOD = (const float*)(p.ws + WS_MOD);
    bf16_t* XS = (bf16_t*)(p.ws + WS_XS); const bf16_t* YE = (const bf16_t*)(p.ws + WS_YE); bf16_t* H = (bf16_t*)(p.ws + WS_H); float* GT = (float*)(p.ws + WS_GT);
    const float* TOPW = (const float*)(p.ws + WS_TOPW); const int* POS = (const int*)(p.ws + WS_POS);
    const float* lng = p.in[I_LNG] + (LAYER * 2 + 1) * 1024; const float* lnb = p.in[I_LNB] + (LAYER * 2 + 1) * 1024;
    const int rstride = nblk * 8, rbase = (LAYER == 0 ? 0 : NCTX) + bid * 8, rfirst = rbase + wid;
    f32x4 nw = {0.f, 0.f, 0.f, 0.f}; int np0 = 0, np1 = 0, np2 = 0, np3 = 0;
    if (rfirst < MROWS) { nw = *(const f32x4*)(TOPW + rfirst * 4); np0 = POS[rfirst * 4]; np1 = POS[rfirst * 4 + 1]; np2 = POS[rfirst * 4 + 2]; np3 = POS[rfirst * 4 + 3]; }
    auto do_row = [&](int row, int jj) {
        const float* md = MOD + (size_t)(LAYER * 5 + row_modr(row)) * 6144;
        const float w0 = nw[0], w1 = nw[1], w2 = nw[2], w3 = nw[3];
        const bf16_t* y0 = YE + (size_t)np0 * 1024; const bf16_t* y1 = YE + (size_t)np1 * 1024;
        const bf16_t* y2 = YE + (size_t)np2 * 1024; const bf16_t* y3 = YE + (size_t)np3 * 1024;
        if (row + rstride < MROWS) { const int rn = row + rstride; nw = *(const f32x4*)(TOPW + rn * 4); np0 = POS[rn * 4]; np1 = POS[rn * 4 + 1]; np2 = POS[rn * 4 + 2]; np3 = POS[rn * 4 + 3]; }
        f32x4 v[4]; float s = 0.f;
#pragma unroll
        for (int q = 0; q < 4; ++q) { const int col = q * 256 + lane * 4;
            const f32x4 ffn = (ld_bf16x4(y0 + col) * w0 + ld_bf16x4(y1 + col) * w1) + (ld_bf16x4(y2 + col) * w2 + ld_bf16x4(y3 + col) * w3);
            v[q] = ld_bf16x4(XS + (size_t)row * 1024 + col) * DN_ALPHA + *(const f32x4*)(md + 5120 + col) * ffn;
            s += (v[q][0] + v[q][1]) + (v[q][2] + v[q][3]); }
        const float mean = wave_sum(s) * (1.0f / 1024.0f);
        float ss = 0.f;
#pragma unroll
        for (int q = 0; q < 4; ++q) { v[q] = v[q] - mean; ss += (v[q][0] * v[q][0] + v[q][1] * v[q][1]) + (v[q][2] * v[q][2] + v[q][3] * v[q][3]); }
        const float rstd = rsqrtf(wave_sum(ss) * (1.0f / 1024.0f) + LN_EPS);
        if (LAYER == 1) {
#pragma unroll
            for (int q = 0; q < 4; ++q) { const int col = q * 256 + lane * 4;
                *(f32x4*)(p.out + (size_t)(row - NCTX) * 1024 + col) = v[q] * rstd * *(const f32x4*)(lng + col) + *(const f32x4*)(lnb + col); }
        } else {
            const float* md1 = MOD + (size_t)(5 + row_modr(row)) * 6144;
#pragma unroll
            for (int q = 0; q < 4; ++q) { const int col = q * 256 + lane * 4;
                const f32x4 xn = v[q] * rstd * *(const f32x4*)(lng + col) + *(const f32x4*)(lnb + col);
                { u32x2 wx; wx.x = pack_bf16(xn[0], xn[1]); wx.y = pack_bf16(xn[2], xn[3]); *(u32x2*)(XS + (size_t)row * 1024 + col) = wx; }
                v[q] = xn * (*(const f32x4*)(md1 + 1024 + col) + 1.0f) + *(const f32x4*)(md1 + col);
                u32x2 w; w.x = pack_bf16(v[q][0], v[q][1]); w.y = pack_bf16(v[q][2], v[q][3]);
                *(u32x2*)(H + (size_t)row * 1024 + col) = w;
                *(LAS f32x4*)(vb + (wid + 8 * jj) * 1028 + col) = v[q]; }
        }
    };
    if (LAYER == 1) {
#pragma unroll 1
        for (int row = rfirst; row < MROWS; row += rstride) do_row(row, 0);
    } else {
#pragma unroll 1
        for (int j0 = 0; rbase + j0 * rstride < MROWS; j0 += 2) {
#pragma unroll 1
            for (int jj = 0; jj < 2; ++jj) { const int row = rfirst + (j0 + jj) * rstride; if (row >= MROWS) break; do_row(row, jj); }
            __syncthreads();
            {
                const LAS float* ar = vb + fr * 1028 + 128 * wid + 32 * fq;
                f32x4 acc = {0.f, 0.f, 0.f, 0.f};
#pragma unroll
                for (int h = 0; h < 2; ++h) { f32x4 va[4];
#pragma unroll
                    for (int u = 0; u < 4; ++u) va[u] = *(const LAS f32x4*)(ar + h * 16 + u * 4);
#pragma unroll
                    for (int u = 0; u < 4; ++u)
#pragma unroll
                        for (int i = 0; i < 4; ++i) acc = __builtin_amdgcn_mfma_f32_16x16x4f32(va[u][i], wgf[h * 16 + u * 4 + i], acc, 0, 0, 0); }
                LAS float* pw = part + wid * 256 + (4 * fq) * 16 + fr;
#pragma unroll
                for (int i = 0; i < 4; ++i) pw[i * 16] = acc[i];
            }
            __syncthreads();
            if (tid < 256) { const int lr = tid >> 4, row = rbase + (lr & 7) + (j0 + (lr >> 3)) * rstride;
                float a = 0.f;
#pragma unroll
                for (int w2 = 0; w2 < 8; ++w2) a += part[w2 * 256 + tid];
                if (row < MROWS) GT[row * 16 + (tid & 15)] = a; }
        }
    }
}
constexpr int LDK = 136;
__device__ __forceinline__ int sid_of(int mixer, int dir, int b, int ch, int h) { return (((mixer * 2 + dir) * 4 + b) * NCHUNK + ch) * 4 + h; }
__device__ __forceinline__ void unit_decode(int u, int& mixer, int& h, int& ch, int& b, int& row0) {
    mixer = u & 1; h = (u >> 1) & 3; const int rest = u >> 3; ch = rest % NCHUNK; b = rest / NCHUNK;
    row0 = ch < 2 ? b * 256 + ch * 128 : NCTX + b * 4096 + (ch - 2) * 128;
}
__device__ __forceinline__ void ld_raw(const bf16_t* P, int row0, int col, u32x2 (&raw)[8]) {
    const int t = threadIdx.x, i = t >> 2, part = t & 3, i0 = (part & 1) * 32 + (part >> 1) * 16;
    const bf16_t* src = P + (size_t)(row0 + i) * LDP1 + col + i0;
#pragma unroll
    for (int q = 0; q < 4; ++q) { raw[q] = *(const u32x2*)(src + q * 4); raw[4 + q] = *(const u32x2*)(src + 64 + q * 4); }
}
__device__ __forceinline__ void cvt_rows(const u32x2 (&raw)[8], bool rope, int s0, const float* ROPE, float (&lo)[16], float (&hi)[16]) {
    const int t = threadIdx.x, i = t >> 2, part = t & 3, pr = part & 1, hf = part >> 1;
#pragma unroll
    for (int q = 0; q < 4; ++q) {
        lo[q * 4] = __uint_as_float(raw[q].x << 16); lo[q * 4 + 1] = __uint_as_float(raw[q].x & 0xffff0000u); lo[q * 4 + 2] = __uint_as_float(raw[q].y << 16); lo[q * 4 + 3] = __uint_as_float(raw[q].y & 0xffff0000u);
        hi[q * 4] = __uint_as_float(raw[4 + q].x << 16); hi[q * 4 + 1] = __uint_as_float(raw[4 + q].x & 0xffff0000u); hi[q * 4 + 2] = __uint_as_float(raw[4 + q].y << 16); hi[q * 4 + 3] = __uint_as_float(raw[4 + q].y & 0xffff0000u); }
    if (rope) {
        const int s = s0 + i, pos = pr == 0 ? (s >> 6) : (s & 63);
        const float* rp = ROPE + (size_t)(pos * 32 + hf * 16) * 2;
#pragma unroll
        for (int jj = 0; jj < 16; ++jj) { const float c = rp[2 * jj], sn = rp[2 * jj + 1], a = lo[jj], b = hi[jj]; lo[jj] = a * c - b * sn; hi[jj] = a * sn + b * c; }
    }
}
__device__ __forceinline__ void st_rows(LAS bf16_t* dst, const float (&lo)[16], const float (&hi)[16], float scale) {
    const int t = threadIdx.x, i = t >> 2, part = t & 3, i0 = (part & 1) * 32 + (part >> 1) * 16;
    u32x4 w0, w1, w2, w3;
    w0.x = pack_bf16(lo[0] * scale, lo[1] * scale); w0.y = pack_bf16(lo[2] * scale, lo[3] * scale); w0.z = pack_bf16(lo[4] * scale, lo[5] * scale); w0.w = pack_bf16(lo[6] * scale, lo[7] * scale);
    w1.x = pack_bf16(lo[8] * scale, lo[9] * scale); w1.y = pack_bf16(lo[10] * scale, lo[11] * scale); w1.z = pack_bf16(lo[12] * scale, lo[13] * scale); w1.w = pack_bf16(lo[14] * scale, lo[15] * scale);
    w2.x = pack_bf16(hi[0] * scale, hi[1] * scale); w2.y = pack_bf16(hi[2] * scale, hi[3] * scale); w2.z = pack_bf16(hi[4] * scale, hi[5] * scale); w2.w = pack_bf16(hi[6] * scale, hi[7] * scale);
    w3.x = pack_bf16(hi[8] * scale, hi[9] * scale); w3.y = pack_bf16(hi[10] * scale, hi[11] * scale); w3.z = pack_bf16(hi[12] * scale, hi[13] * scale); w3.w = pack_bf16(hi[14] * scale, hi[15] * scale);
    LAS bf16_t* d = dst + i * LDK + i0;
    *(LAS u32x4*)d = w0; *(LAS u32x4*)(d + 8) = w1; *(LAS u32x4*)(d + 64) = w2; *(LAS u32x4*)(d + 72) = w3;
}
__device__ __forceinline__ void st_rows_T(LAS bf16_t* dst, const float (&lo)[16], const float (&hi)[16], float scale) {
    const int t = threadIdx.x, i = t >> 2, part = t & 3, i0 = (part & 1) * 32 + (part >> 1) * 16;
#pragma unroll
    for (int jj = 0; jj < 16; ++jj) { dst[(i0 + jj) * LDK + i] = f2bf(lo[jj] * scale); dst[(i0 + 64 + jj) * LDK + i] = f2bf(hi[jj] * scale); }
}
__device__ __forceinline__ void mma_128(const LAS bf16_t* A, const LAS bf16_t* B, f32x4 (&acc)[2][4], int wr, int wc, int lane) {
    const int fr = lane & 15, fq = lane >> 4;
#pragma unroll
    for (int ks = 0; ks < 4; ++ks) {
        bf16x8 a[2], b[4];
#pragma unroll
        for (int mt = 0; mt < 2; ++mt) a[mt] = *(const LAS bf16x8*)(A + (wr * 32 + mt * 16 + fr) * LDK + ks * 32 + fq * 8);
#pragma unroll
        for (int nt = 0; nt < 4; ++nt) b[nt] = *(const LAS bf16x8*)(B + (wc * 64 + nt * 16 + fr) * LDK + ks * 32 + fq * 8);
#pragma unroll
        for (int mt = 0; mt < 2; ++mt)
#pragma unroll
            for (int nt = 0; nt < 4; ++nt) acc[mt][nt] = __builtin_amdgcn_mfma_f32_16x16x32_bf16(a[mt], b[nt], acc[mt][nt], 0, 0, 0);
    }
}
__device__ __forceinline__ void zero_acc(f32x4 (&acc)[2][4]) {
#pragma unroll
    for (int mt = 0; mt < 2; ++mt)
#pragma unroll
        for (int nt = 0; nt < 4; ++nt) acc[mt][nt] = (f32x4){0.f, 0.f, 0.f, 0.f};
}
__device__ __forceinline__ void wave_scan_sum2(float x0, float x1, float& p0, float& p1, float& total) {
    const int lane = threadIdx.x & 63; float s = x0 + x1, inc = s;
#pragma unroll
    for (int o = 1; o < 64; o <<= 1) { const float t = __shfl_up(inc, o, 64); if (lane >= o) inc += t; }
    const float exc = inc - s; p0 = exc + x0; p1 = exc + s; total = __shfl(inc, 63, 64);
}
__device__ __forceinline__ void wave_scan_max2(float x0, float x1, float& p0, float& p1) {
    const int lane = threadIdx.x & 63; const float m = fmaxf(x0, x1); float inc = m;
#pragma unroll
    for (int o = 1; o < 64; o <<= 1) { const float t = __shfl_up(inc, o, 64); if (lane >= o) inc = fmaxf(inc, t); }
    float exc = __shfl_up(inc, 1, 64); if (lane == 0) exc = -3.0e38f;
    p0 = fmaxf(exc, x0); p1 = fmaxf(exc, m);
}
__device__ __forceinline__ void ph_c1(const Params& p, LAS unsigned char* lds, int bid, int nblk) {
    const int tid = threadIdx.x, wid = tid >> 6, lane = tid & 63, wr = wid >> 1, wc = wid & 1, fr = lane & 15, fq = lane >> 4;
    LAS bf16_t* KsT = (LAS bf16_t*)(lds + LDS_WORK); LAS bf16_t* VsT0 = KsT + 128 * LDK; LAS bf16_t* VsT1 = VsT0 + 128 * LDK;
    LAS float* z = (LAS float*)(VsT1 + 128 * LDK);
    LAS float* lfA = z + 256; LAS float* igA = lfA + 256; LAS float* zmax = igA + 256;
    const bf16_t* P = (const bf16_t*)(p.ws + WS_P); const float* GT = (const float*)(p.ws + WS_GT); const float* ROPE = (const float*)(p.ws + WS_ROPE);
    float* ST = (float*)(p.ws + WS_ST); float* NST = (float*)(p.ws + WS_NST); float* MEND = (float*)(p.ws + WS_MEND); float* BEND = (float*)(p.ws + WS_BEND);
    for (int u = bid; u < NB * NCHUNK * 4 * 2; u += nblk) {
        int mixer, h, ch, b, row0; unit_decode(u, mixer, h, ch, b, row0);
        const int colQ = mixer * 2048 + h * 128;
        u32x2 rawK[8], rawV[8]; ld_raw(P, row0, colQ + 512, rawK); ld_raw(P, row0, colQ + 1024, rawV);
        if (mixer == 0) {
            if (tid < 256) { const int dir = tid >> 7, j = tid & 127; const float lg = p.in[I_CLG][dir * 4 + h]; z[tid] = fexp(lg * (float)(dir == 0 ? 127 - j : j)); }
        } else {
            if (tid < 256) { const int dir = tid >> 7, j = tid & 127, row = row0 + j;
                igA[tid] = GT[row * 16 + dir * 4 + h] + p.in[I_DIB][dir * 4 + h];
                lfA[tid] = -softplusf(-(GT[row * 16 + 8 + dir * 4 + h] + p.in[I_DFB][dir * 4 + h])); }
            __syncthreads();
            if (tid < 128) { const int dir = tid >> 6, j0 = 2 * lane, j1 = j0 + 1;
                const float l0 = lfA[dir * 128 + j0], l1 = lfA[dir * 128 + j1], g0 = igA[dir * 128 + j0], g1 = igA[dir * 128 + j1];
                float r0, r1, total; wave_scan_sum2(l0, l1, r0, r1, total);
                const float w0 = (dir == 0 ? total - r0 : r0 - l0) + g0, w1 = (dir == 0 ? total - r1 : r1 - l1) + g1;
                const float mx = wave_max(fmaxf(w0, w1));
                z[dir * 128 + j0] = fexp(w0 - mx); z[dir * 128 + j1] = fexp(w1 - mx);
                const int sid = sid_of(1, dir, b, ch, h);
                if (lane == 0) { MEND[sid] = mx; BEND[sid] = total; }
                float* CB = (float*)(p.ws + WS_CB) + (size_t)sid * 128; float* CMI = (float*)(p.ws + WS_CMI) + (size_t)sid * 128;
                if (dir == 0) { float m0, m1; wave_scan_max2(g0 - r0, g1 - r1, m0, m1); CB[j0] = r0; CB[j1] = r1; CMI[j0] = r0 + m0; CMI[j1] = r1 + m1; }
                else { const float s0 = total - r0 + l0, s1 = total - r1 + l1;
                    lfA[128 + j0] = g0 - s0; lfA[128 + j1] = g1 - s1; igA[128 + j0] = s0; igA[128 + j1] = s1; CB[j0] = s0; CB[j1] = s1;
                    asm volatile("s_waitcnt lgkmcnt(0)" ::: "memory");
                    const int q0 = 127 - 2 * lane, q1 = q0 - 1; float m0, m1; wave_scan_max2(lfA[128 + q0], lfA[128 + q1], m0, m1);
                    CMI[q0] = igA[128 + q0] + m0; CMI[q1] = igA[128 + q1] + m1; } }
        }
        __syncthreads();
        {
            float lo[16], hi[16];
            cvt_rows(rawK, mixer == 0 && ch >= 2, (ch - 2) * 128, ROPE, lo, hi);
            st_rows_T(KsT, lo, hi, 0.08838834764831845f);
            cvt_rows(rawV, false, 0, ROPE, lo, hi);
            const int i = tid >> 2;
            st_rows_T(VsT0, lo, hi, z[i]); st_rows_T(VsT1, lo, hi, z[128 + i]);
        }
        __syncthreads();
#pragma unroll
        for (int dir = 0; dir < 2; ++dir) {
            f32x4 acc[2][4]; zero_acc(acc);
            mma_128(dir == 0 ? VsT0 : VsT1, KsT, acc, wr, wc, lane);
            bf16_t* dst = (bf16_t*)ST + (size_t)sid_of(mixer, dir, b, ch, h) * 16384;
#pragma unroll
            for (int mt = 0; mt < 2; ++mt)
#pragma unroll
                for (int nt = 0; nt < 4; ++nt)
#pragma unroll
                    for (int r = 0; r < 4; ++r) dst[(wr * 32 + mt * 16 + fq * 4 + r) * 128 + wc * 64 + nt * 16 + fr] = f2bf(acc[mt][nt][r]);
        }
        if (mixer == 1 && tid < 256) { const int dir = tid >> 7, dd = tid & 127; float s = 0.f;
            for (int j = 0; j < 128; ++j) s += z[dir * 128 + j] * bf2f(KsT[dd * LDK + j]);
            NST[(size_t)sid_of(1, dir, b, ch, h) * 128 + dd] = s; }
        __syncthreads();
    }
}
__device__ __forceinline__ void ph_c2(const Params& p, int bid, int nblk) {
    const int tid = threadIdx.x;
    float* ST = (float*)(p.ws + WS_ST); float* NST = (float*)(p.ws + WS_NST); bf16_t* STB = (bf16_t*)(p.ws + WS_STB);
    const float* MEND = (const float*)(p.ws + WS_MEND); const float* BEND = (const float*)(p.ws + WS_BEND); float* MPREV = (float*)(p.ws + WS_MPREV);
    for (int item = bid; item < 2048; item += nblk) {
        const int mixer = item >> 10, chain = (item >> 5) & 31, slab = item & 31, dir = chain >> 4, b = (chain >> 2) & 3, h = chain & 3;
        const int idx = slab * 512 + tid;
        float kv[NCHUNK];
#pragma unroll
        for (int k = 0; k < NCHUNK; ++k) { const int ch = dir == 0 ? k : (k < 2 ? 1 - k : 35 - k); kv[k] = bf2f(((const bf16_t*)ST)[(size_t)sid_of(mixer, dir, b, ch, h) * 16384 + idx]); }
        if (mixer == 0) {
            const float gdec = fexp(p.in[I_CLG][dir * 4 + h] * 128.0f); float r = 0.f;
#pragma unroll
            for (int k = 0; k < NCHUNK; ++k) { const int ch = dir == 0 ? k : (k < 2 ? 1 - k : 35 - k); STB[(size_t)sid_of(0, dir, b, ch, h) * 16384 + idx] = f2bf(r); r = r * gdec + kv[k]; }
        } else {
            const bool do_n = slab == 0 && tid < 128;
            float nv[NCHUNK];
#pragma unroll
            for (int k = 0; k < NCHUNK; ++k) { const int ch = dir == 0 ? k : (k < 2 ? 1 - k : 35 - k); nv[k] = do_n ? NST[(size_t)sid_of(1, dir, b, ch, h) * 128 + tid] : 0.f; }
            float m = -__builtin_inff(), c = 0.f, n = 0.f;
#pragma unroll
            for (int k = 0; k < NCHUNK; ++k) { const int ch = dir == 0 ? k : (k < 2 ? 1 - k : 35 - k); const int sid = sid_of(1, dir, b, ch, h);
                const float me = MEND[sid], be = BEND[sid], mnew = fmaxf(be + m, me), so = fexp(be + m - mnew), sn = fexp(me - mnew);
                STB[(size_t)sid * 16384 + idx] = f2bf(c); c = c * so + kv[k] * sn;
                if (do_n) { NST[(size_t)sid * 128 + tid] = n; n = n * so + nv[k] * sn; }
                if (slab == 0 && tid == 0) MPREV[sid] = m;
                m = mnew; }
        }
    }
}
template <int mixer>
__device__ __forceinline__ void c3_unit(const Params& p, LAS unsigned char* lds, int h, int ch, int b, int row0) {
    int tid_ = threadIdx.x; asm volatile("" : "+v"(tid_));
    const int tid = tid_, wid = tid >> 6, lane = tid & 63, wr = wid >> 1, wc = wid & 1, fr = lane & 15, fq = lane >> 4;
    LAS bf16_t* Qs = (LAS bf16_t*)(lds + LDS_WORK); LAS bf16_t* Ks = Qs + 128 * LDK; LAS bf16_t* VsT = Ks + 128 * LDK; LAS bf16_t* RT = VsT + 128 * LDK;
    LAS float* fa = (LAS float*)(RT + 128 * LDK);
    LAS float* lfA = fa; LAS float* igA = fa + 256; LAS float* bA = fa + 512; LAS float* miA = fa + 768; LAS float* mtA = fa + 1024; LAS float* sintA = fa + 1280;
    LAS float* rowsum = fa + 1536; LAS float* qn = fa + 2048; LAS float* nA = fa + 2304;
    LAS float* Os = (LAS float*)Qs;
    LAS bf16_t* Pm = Ks;
    const bf16_t* P = (const bf16_t*)(p.ws + WS_P); const float* GT = (const float*)(p.ws + WS_GT); const float* ROPE = (const float*)(p.ws + WS_ROPE);
    const bf16_t* STB = (const bf16_t*)(p.ws + WS_STB); const float* NST = (const float*)(p.ws + WS_NST); const float* MPREV = (const float*)(p.ws + WS_MPREV);
    bf16_t* Y = (bf16_t*)(p.ws + WS_YMIX);
    {
        const int colQ = mixer * 2048 + h * 128; const bool rope = mixer == 0 && ch >= 2;
        {
            u32x2 rawQ[8], rawK[8], rawV[8]; ld_raw(P, row0, colQ, rawQ); ld_raw(P, row0, colQ + 512, rawK); ld_raw(P, row0, colQ + 1024, rawV);
            float lo[16], hi[16];
            cvt_rows(rawQ, rope, (ch - 2) * 128, ROPE, lo, hi); st_rows(Qs, lo, hi, 1.0f);
            cvt_rows(rawK, rope, (ch - 2) * 128, ROPE, lo, hi); st_rows(Ks, lo, hi, 0.08838834764831845f);
            cvt_rows(rawV, false, 0, ROPE, lo, hi); st_rows_T(VsT, lo, hi, 1.0f);
        }
        if (mixer == 1) {
            if (tid < 256) { const int dir = tid >> 7, j = tid & 127, row = row0 + j;
                igA[tid] = GT[row * 16 + dir * 4 + h] + p.in[I_DIB][dir * 4 + h];
                nA[tid] = NST[(size_t)sid_of(1, dir, b, ch, h) * 128 + j];
                bA[tid] = ((const float*)(p.ws + WS_CB))[(size_t)sid_of(1, dir, b, ch, h) * 128 + j]; miA[tid] = ((const float*)(p.ws + WS_CMI))[(size_t)sid_of(1, dir, b, ch, h) * 128 + j]; }
            __syncthreads();
            __syncthreads();
            if (tid < 256) { const int dir = tid >> 7, i = tid & 127; const float mprev = MPREV[sid_of(1, dir, b, ch, h)];
                const float gi = bA[tid] + mprev, mt = fmaxf(gi, miA[tid]); mtA[tid] = mt; sintA[tid] = fexp(gi - mt);
                float s = 0.f;
                for (int d0 = 0; d0 < 128; ++d0) s += bf2f(Qs[i * LDK + d0]) * nA[dir * 128 + d0];
                qn[tid] = s; }
        }
        __syncthreads();
        f32x4 S[2][4]; zero_acc(S);
        mma_128(Qs, Ks, S, wr, wc, lane);
        __syncthreads();
        f32x4 O[2][4]; zero_acc(O);
        if (mixer == 0) {
            const float lg0 = p.in[I_CLG][h], lg1 = p.in[I_CLG][4 + h];
#pragma unroll
            for (int mt = 0; mt < 2; ++mt)
#pragma unroll
                for (int nt = 0; nt < 4; ++nt)
#pragma unroll
                    for (int r = 0; r < 4; ++r) { const int i = wr * 32 + mt * 16 + fq * 4 + r, j = wc * 64 + nt * 16 + fr;
                        const float dcy = (i >= j ? fexp(lg0 * (float)(i - j)) : 0.f) + (j >= i ? fexp(lg1 * (float)(j - i)) : 0.f);
                        Pm[i * LDK + j] = f2bf(S[mt][nt][r] * dcy); }
            __syncthreads();
            mma_128(Pm, VsT, O, wr, wc, lane);
#pragma unroll
            for (int dir = 0; dir < 2; ++dir) {
                { const bf16_t* src = STB + (size_t)sid_of(0, dir, b, ch, h) * 16384 + (tid >> 2) * 128 + (tid & 3) * 32; LAS bf16_t* d = RT + (tid >> 2) * LDK + (tid & 3) * 32;
#pragma unroll
                    for (int q = 0; q < 4; ++q) *(LAS u32x4*)(d + q * 8) = *(const u32x4*)(src + q * 8); }
                __syncthreads();
                f32x4 T[2][4]; zero_acc(T);
                mma_128(Qs, RT, T, wr, wc, lane);
#pragma unroll
                for (int mt = 0; mt < 2; ++mt)
#pragma unroll
                    for (int r = 0; r < 4; ++r) { const int i = wr * 32 + mt * 16 + fq * 4 + r; const float xi = dir == 0 ? fexp(lg0 * (float)(i + 1)) : fexp(lg1 * (float)(128 - i));
#pragma unroll
                        for (int nt = 0; nt < 4; ++nt) O[mt][nt][r] += xi * T[mt][nt][r]; }
                __syncthreads();
            }
        } else {
#pragma unroll
            for (int dir = 0; dir < 2; ++dir) {
                float rp[2][4];
#pragma unroll
                for (int mt = 0; mt < 2; ++mt)
#pragma unroll
                    for (int r = 0; r < 4; ++r) { const int i = wr * 32 + mt * 16 + fq * 4 + r; const float bi = bA[dir * 128 + i] - mtA[dir * 128 + i]; float acc = 0.f;
#pragma unroll
                        for (int nt = 0; nt < 4; ++nt) { const int j = wc * 64 + nt * 16 + fr; const bool valid = dir == 0 ? (j <= i) : (j >= i);
                            const float e = valid ? fexp(bi - bA[dir * 128 + j] + igA[dir * 128 + j]) : 0.f; const float pv = S[mt][nt][r] * e;
                            Pm[i * LDK + j] = f2bf(pv); acc += pv; }
                        rp[mt][r] = row16_sum(acc); }
                if (fr == 0) {
#pragma unroll
                    for (int mt = 0; mt < 2; ++mt)
#pragma unroll
                        for (int r = 0; r < 4; ++r) rowsum[wc * 256 + dir * 128 + wr * 32 + mt * 16 + fq * 4 + r] = rp[mt][r];
                }
                { const bf16_t* src = STB + (size_t)sid_of(1, dir, b, ch, h) * 16384 + (tid >> 2) * 128 + (tid & 3) * 32; LAS bf16_t* d = RT + (tid >> 2) * LDK + (tid & 3) * 32;
#pragma unroll
                    for (int q = 0; q < 4; ++q) *(LAS u32x4*)(d + q * 8) = *(const u32x4*)(src + q * 8); }
                __syncthreads();
                f32x4 T[2][4]; zero_acc(T);
                mma_128(Qs, RT, T, wr, wc, lane);
#pragma unroll
                for (int mt = 0; mt < 2; ++mt)
#pragma unroll
                    for (int r = 0; r < 4; ++r) { const float si = sintA[dir * 128 + wr * 32 + mt * 16 + fq * 4 + r];
#pragma unroll
                        for (int nt = 0; nt < 4; ++nt) T[mt][nt][r] *= si; }
                mma_128(Pm, VsT, T, wr, wc, lane);
#pragma unroll
                for (int mt = 0; mt < 2; ++mt)
#pragma unroll
                    for (int r = 0; r < 4; ++r) { const int i = wr * 32 + mt * 16 + fq * 4 + r; const float si = sintA[dir * 128 + i];
                        float den = (rowsum[dir * 128 + i] + rowsum[256 + dir * 128 + i]) + qn[dir * 128 + i] * si; den = fmaxf(fabsf(den), fexp(-mtA[dir * 128 + i])); const float rden = frcp(den);
#pragma unroll
                        for (int nt = 0; nt < 4; ++nt) O[mt][nt][r] += T[mt][nt][r] * rden; }
                __syncthreads();
            }
        }
#pragma unroll
        for (int mt = 0; mt < 2; ++mt)
#pragma unroll
            for (int nt = 0; nt < 4; ++nt)
#pragma unroll
                for (int r = 0; r < 4; ++r) Os[(wr * 32 + mt * 16 + fq * 4 + r) * 132 + wc * 64 + nt * 16 + fr] = O[mt][nt][r];
        __syncthreads();
        {
            const float* gng = (mixer == 0 ? p.in[I_CGNG] : p.in[I_DGNG]) + h * 128; const float* gnb = (mixer == 0 ? p.in[I_CGNB] : p.in[I_DGNB]) + h * 128;
            const float g0 = gng[lane], g1 = gng[lane + 64], b0 = gnb[lane], b1 = gnb[lane + 64];
#pragma unroll 1
            for (int i4 = 0; i4 < 16; i4 += 4) {
                float qg0[4], qg1[4];
#pragma unroll
                for (int u = 0; u < 4; ++u) { const int row = row0 + wid * 16 + i4 + u; qg0[u] = bf2f(P[(size_t)row * LDP1 + colQ + 1536 + lane]); qg1[u] = bf2f(P[(size_t)row * LDP1 + colQ + 1536 + 64 + lane]); }
#pragma unroll
                for (int u = 0; u < 4; ++u) { const int i = wid * 16 + i4 + u, row = row0 + i;
                    const float x0 = Os[i * 132 + lane], x1 = Os[i * 132 + 64 + lane];
                    const float mean = wave_sum(x0 + x1) * (1.0f / 128.0f), d0 = x0 - mean, d1 = x1 - mean;
                    const float rstd = rsqrtf(wave_sum(d0 * d0 + d1 * d1) * (1.0f / 128.0f) + LN_EPS);
                    const float q0 = qg0[u], q1 = qg1[u];
                    const float s0 = sigm(q0), s1 = sigm(q1);
                    const float y0 = (d0 * rstd * g0 + b0) * (mixer == 0 ? q0 * s0 : s0), y1 = (d1 * rstd * g1 + b1) * (mixer == 0 ? q1 * s1 : s1);
                    Y[(size_t)row * 1024 + mixer * 512 + h * 128 + lane] = f2bf(y0); Y[(size_t)row * 1024 + mixer * 512 + h * 128 + 64 + lane] = f2bf(y1); }
            }
        }
        __syncthreads();
    }
}
__device__ __forceinline__ void ph_c3(const Params& p, LAS unsigned char* lds, int bid, int nblk) {
    for (int u2 = bid; u2 < NB * NCHUNK * 4; u2 += nblk) {
        int mixer, h, ch, b, row0; unit_decode(u2 * 2, mixer, h, ch, b, row0);
        c3_unit<0>(p, lds, h, ch, b, row0);
    }
    for (int u2 = nblk - 1 - bid; u2 < NB * NCHUNK * 4; u2 += nblk) {
        int mixer, h, ch, b, row0; unit_decode(u2 * 2 + 1, mixer, h, ch, b, row0);
        c3_unit<1>(p, lds, h, ch, b, row0);
    }
}
constexpr int NPHASE = 23;
__global__ void __launch_bounds__(NTHR, 2) fwd(Params p) {
    extern __shared__ __attribute__((aligned(16))) unsigned char smem_raw[];
    LAS unsigned char* lds = (LAS unsigned char*)smem_raw;
    if (threadIdx.x == 0) { LAS unsigned* st = (LAS unsigned*)(lds + LDS_BAR); st[0] = 0u; st[1] = 0u; st[2] = 0u; st[3] = 0u; }
    __syncthreads();
    XcdBarrier bar = xcd_barrier_post((unsigned*)(p.ws + WS_CTL), (volatile LAS unsigned*)(lds + LDS_BAR));
    const int bid = blockIdx.x, nblk = gridDim.x;
    unsigned char* ws = p.ws;
#ifndef PHASE_ONLY
#define PHASE_ONLY -1
#endif
#ifndef DBL_MASK
#define DBL_MASK 0u
#endif
#define PHASE(k, call) if constexpr (PHASE_ONLY < 0 || PHASE_ONLY == (k)) { if (p.lo <= (k) && (k) < p.hi) { call; if constexpr ((DBL_MASK >> (k)) & 1u) { xcd_barrier(bar); call; } if ((k) + 1 < p.hi) xcd_barrier(bar); } }
    PHASE(0, ph_prologue(p, lds, bid, nblk))
    PHASE(1, ph_mod_in(p, bid, nblk))
    PHASE(2, ph_gemm_dense<12>(lds, (const bf16_t*)(ws + WS_H), (const bf16_t*)(ws + WS_WIN0T), (bf16_t*)(ws + WS_P), LDP0, 0, 68, bid, nblk))
    PHASE(3, ph_prep_even(p, lds, bid, nblk))
    PHASE(4, ph_r1(p, lds, bid, nblk))
    PHASE(5, ph_r2(p, lds, bid, nblk))
    PHASE(6, ph_fin_even(p, bid, nblk))
    PHASE(7, ph_gemm_dense<4>(lds, (const bf16_t*)(ws + WS_YMIX), (const bf16_t*)(ws + WS_WOUTT), (bf16_t*)(ws + WS_YP), 1024, 0, 68, bid, nblk))
    PHASE(8, ph_ln1<0>(p, lds, bid, nblk))
    PHASE(9, ph_moe_gather<0>(p, lds, bid, nblk))
    PHASE(10, ph_moe_gemm1<0>(p, lds, bid, nblk))
    PHASE(11, ph_moe_gemm2<0>(p, lds, bid, nblk))
    PHASE(12, ph_ln2<0>(p, lds, bid, nblk))
    PHASE(13, ph_gemm_dense<16>(lds, (const bf16_t*)(ws + WS_H), (const bf16_t*)(ws + WS_WIN1T), (bf16_t*)(ws + WS_P), LDP1, 0, 68, bid, nblk))
    PHASE(14, ph_c1(p, lds, bid, nblk))
    PHASE(15, ph_c2(p, bid, nblk))
    PHASE(16, ph_c3(p, lds, bid, nblk))
    PHASE(17, ph_gemm_dense<4>(lds, (const bf16_t*)(ws + WS_YMIX), (const bf16_t*)(ws + WS_WOUTT) + (size_t)1024 * 1024, (bf16_t*)(ws + WS_YP), 1024, 4, 64, bid, nblk))
    PHASE(18, ph_ln1<1>(p, lds, bid, nblk))
    PHASE(19, ph_moe_gather<1>(p, lds, bid, nblk))
    PHASE(20, ph_moe_gemm1<1>(p, lds, bid, nblk))
    PHASE(21, ph_moe_gemm2<1>(p, lds, bid, nblk))
    PHASE(22, ph_ln2<1>(p, lds, bid, nblk))
#undef PHASE
}

#ifndef MK_ONE_LAUNCH
#define MK_ONE_LAUNCH 1
#endif
extern "C" void kernel_launch(void* const* d_in, const int* in_sizes, int n_in, void* d_out, int out_size, void* d_ws, size_t ws_size, hipStream_t stream) {
    static int grid = 0;
    if (grid == 0) {
        if (n_in != N_INPUTS || out_size != NB * SEQL * DM || ws_size < WS_TOTAL) { fprintf(stderr, "kernel_launch: unexpected problem (n_in %d, out %d, ws %zu < %zu)\n", n_in, out_size, ws_size, (size_t)WS_TOTAL); grid = -1; return; }
        int dev = 0, cus = 0, per_cu = 0;
        if (hipGetDevice(&dev) != hipSuccess || hipDeviceGetAttribute(&cus, hipDeviceAttributeMultiprocessorCount, dev) != hipSuccess) { grid = -1; return; }
        if (hipFuncSetAttribute((const void*)fwd, hipFuncAttributeMaxDynamicSharedMemorySize, LDS_BYTES) != hipSuccess) { fprintf(stderr, "kernel_launch: hipFuncSetAttribute failed\n"); grid = -1; return; }
        if (hipOccupancyMaxActiveBlocksPerMultiprocessor(&per_cu, (const void*)fwd, NTHR, LDS_BYTES) != hipSuccess || per_cu < 1) { fprintf(stderr, "kernel_launch: occupancy query says %d\n", per_cu); (void)hipGetLastError(); per_cu = 1; }
        grid = cus;
    }
    if (grid < 0) return;
    (void)hipMemsetAsync((char*)d_ws + WS_CTL, 0, CTL_BYTES, stream);
    Params p{};
    for (int i = 0; i < N_INPUTS; ++i) p.in[i] = (const float*)d_in[i];
    p.out = (float*)d_out; p.ws = (unsigned char*)d_ws;
#if MK_ONE_LAUNCH
    p.lo = 0; p.hi = NPHASE;
    hipLaunchKernelGGL(fwd, dim3(grid), dim3(NTHR), LDS_BYTES, stream, p);
#else
    for (int k = 0; k < NPHASE; ++k) { p.lo = k; p.hi = k + 1; hipLaunchKernelGGL(fwd, dim3(grid), dim3(NTHR), LDS_BYTES, stream, p); }
#endif
}
```

```cpp
#include <hip/hip_runtime.h>
#include <stdint.h>
#include <stdio.h>

#define LAS __attribute__((address_space(3)))
typedef unsigned short bf16_t;
typedef short bf16x8 __attribute__((ext_vector_type(8)));
typedef float f32x4 __attribute__((ext_vector_type(4)));
typedef float f32x2 __attribute__((ext_vector_type(2)));
typedef unsigned u32x4 __attribute__((ext_vector_type(4)));
typedef unsigned u32x2 __attribute__((ext_vector_type(2)));

constexpr int NB = 4, SEQL = 4096, CTXL = 256, DM = 1024;
constexpr int NCTX = NB * CTXL;
constexpr int MROWS = NCTX + NB * SEQL;
constexpr int NTHR = 512;
constexpr int LDP0 = 3072, LDP1 = 4096;
constexpr int A_IN = 1920, EVEN_IN = 2944, ODD_IN = 4112;
constexpr int NEXP = 32, DFF = 1024;
constexpr int MOE_ROWS_MAX = 69632 + 32 * 256;
constexpr float DN_ALPHA = 1.41421356237309515f;
constexpr float LN_EPS = 1e-5f;
constexpr int NCHUNK = 34;

enum { I_X = 0, I_C, I_CTX, I_CCTX, I_WMOD, I_BMOD, I_LNG, I_LNB, I_EWIN, I_EWOUT, I_AMU, I_AW0, I_AWB, I_AA0, I_AAB, I_AGB, I_AKK, I_AKA, I_ARK,
       I_AGNG, I_AGNB, I_BCW, I_BCB, I_BGW, I_BGB, I_BLAM, I_OWIN, I_OWOUT, I_CLG, I_CGNG, I_CGNB, I_DIB, I_DFB, I_DGNG, I_DGNB, I_RW, I_RB,
       I_W1, I_B1, I_W2, I_B2, N_INPUTS };

constexpr size_t al256(size_t x) { return (x + 255) & ~(size_t)255; }
constexpr size_t WS_CTL   = 0;
constexpr size_t CTL_BYTES = 65536;
constexpr size_t CTL_CNT  = 16384;
constexpr size_t WS_MOD   = WS_CTL + CTL_BYTES;
constexpr size_t WS_ROPE  = WS_MOD + al256((size_t)2 * 5 * 6144 * 4);
constexpr size_t WS_WIN0T = WS_ROPE + 16384;
constexpr size_t WS_WIN1T = WS_WIN0T + (size_t)3072 * 1024 * 2;
constexpr size_t WS_WOUTT = WS_WIN1T + (size_t)4096 * 1024 * 2;
constexpr size_t WS_W1T   = WS_WOUTT + (size_t)2 * 1024 * 1024 * 2;
constexpr size_t WS_W2T   = WS_W1T + (size_t)2 * 32 * 2048 * 1024 * 2;
constexpr size_t WS_XS    = WS_W2T + (size_t)2 * 32 * 1024 * 1024 * 2;
constexpr size_t WS_H     = WS_XS + (size_t)MROWS * 1024 * 4;
constexpr size_t WS_YMIX  = WS_H + (size_t)MROWS * 1024 * 2;
constexpr size_t WS_YP    = WS_YMIX + (size_t)MROWS * 1024 * 2;
constexpr size_t WS_GT    = WS_YP + (size_t)MROWS * 1024 * 4;
constexpr size_t WS_TOPE  = WS_GT + (size_t)MROWS * 16 * 4;
constexpr size_t WS_TOPW  = WS_TOPE + (size_t)MROWS * 16;
constexpr size_t WS_TOPS  = WS_TOPW + (size_t)MROWS * 16;
constexpr size_t WS_POS   = WS_TOPS + (size_t)MROWS * 16;
constexpr size_t WS_CNTB  = WS_POS + (size_t)MROWS * 16;
constexpr size_t WS_WLT   = WS_CNTB + (size_t)2 * 512 * 32 * 4;
constexpr size_t WLT_WB = 0, WLT_AB = 65536, WLT_GB = 131072, WLT_GW = 196608, WLT_N = 327680;
constexpr size_t WS_P     = WS_WLT + (size_t)WLT_N * 2;
constexpr size_t WS_BIG   = WS_P + (size_t)MROWS * 4096 * 4;
constexpr size_t ARR512   = (size_t)MROWS * 512 * 4;
constexpr int SCREC = 448;
constexpr int SCLEN = CTXL + SEQL;
constexpr size_t WS_SC    = WS_BIG;
enum { E_G = 0, E_O0, E_O1, E_A0, E_A1, E_BX0, E_BX1, E_GATE, E_NARR };
constexpr size_t WS_EARR  = WS_SC + (size_t)64 * SCLEN * SCREC * 2;
constexpr size_t WS_BC    = WS_EARR + (size_t)E_NARR * ARR512;
constexpr size_t WS_CHA   = WS_BC + (size_t)MROWS * 8 * 4;
constexpr size_t WS_CHH   = WS_CHA + (size_t)2 * 512 * 512 * 4;
constexpr size_t WS_CIN   = WS_CHH + (size_t)2 * 512 * 512 * 4;
constexpr int RCH = 64, NRCH = SCLEN / RCH, NRUNIT = 64 * NRCH;
constexpr size_t WS_RU    = WS_CIN + (size_t)2 * 512 * 512 * 4;
constexpr size_t WS_EEND  = WS_RU + (size_t)NRUNIT * 4 * 4096 * 4;
constexpr int NSID = 2 * 2 * NB * NCHUNK * 4;
constexpr size_t WS_ST    = WS_BIG;
constexpr size_t WS_NST   = WS_ST + (size_t)NSID * 16384 * 4;
constexpr size_t WS_MEND  = WS_NST + (size_t)NSID * 128 * 4;
constexpr size_t WS_BEND  = WS_MEND + al256((size_t)NSID * 4);
constexpr size_t WS_MPREV = WS_BEND + al256((size_t)NSID * 4);
constexpr size_t WS_CB    = WS_MPREV + al256((size_t)NSID * 4);
constexpr size_t WS_CMI   = WS_CB + (size_t)NSID * 128 * 4;
constexpr size_t WS_STB   = WS_CMI + (size_t)NSID * 128 * 4;
constexpr size_t WS_OEND  = WS_STB + (size_t)NSID * 16384 * 2;
constexpr size_t WS_ASORT = WS_BIG;
constexpr size_t WS_IDX   = WS_BIG;
constexpr size_t WS_ACT   = WS_ASORT + (size_t)MOE_ROWS_MAX * 1024 * 2;
constexpr size_t WS_YE    = WS_ACT + (size_t)MOE_ROWS_MAX * 1024 * 2;
constexpr size_t WS_MEND_ = WS_YE + (size_t)MOE_ROWS_MAX * 1024 * 4;
constexpr size_t WS_TOTAL = (WS_EEND > WS_MEND_ ? (WS_EEND > WS_OEND ? WS_EEND : WS_OEND) : (WS_MEND_ > WS_OEND ? WS_MEND_ : WS_OEND));

constexpr int LDS_BYTES = 155648;
constexpr int LDS_BAR = 0;
constexpr int LDS_WORK = 1024;

struct Params {
    const float* in[N_INPUTS];
    float* out;
    unsigned char* ws;
    int lo, hi;
};

typedef __bf16 nbf16x2 __attribute__((ext_vector_type(2)));
__device__ __forceinline__ unsigned pack_bf16(float lo, float hi) { const nbf16x2 v = {(__bf16)lo, (__bf16)hi}; return __builtin_bit_cast(unsigned, v); }
__device__ __forceinline__ bf16_t f2bf(float f) { return __builtin_bit_cast(bf16_t, (__bf16)f); }
__device__ __forceinline__ float bf2f(bf16_t b) { return __uint_as_float(((unsigned)b) << 16); }
__device__ __forceinline__ f32x4 ld_bf16x4(const bf16_t* p) { const u32x2 w = *(const u32x2*)p; return (f32x4){__uint_as_float(w.x << 16), __uint_as_float(w.x & 0xffff0000u), __uint_as_float(w.y << 16), __uint_as_float(w.y & 0xffff0000u)}; }
__device__ __forceinline__ float fexp(float x) { return __builtin_amdgcn_exp2f(x * 1.4426950408889634f); }
__device__ __forceinline__ float frcp(float x) { return __builtin_amdgcn_rcpf(x); }
__device__ __forceinline__ float fsqrt(float x) { return __builtin_amdgcn_sqrtf(x); }
__device__ __forceinline__ float sigm(float x) { return frcp(1.0f + fexp(-x)); }
__device__ __forceinline__ float ftanh(float x) { const float e = fexp(-2.0f * fabsf(x)), t = (1.0f - e) * frcp(1.0f + e); return x < 0.f ? -t : t; }
__device__ __forceinline__ float fexpm1_neg(float x) {
    const float p = x * (1.0f + x * (0.5f + x * (0.16666667f + x * (0.041666668f + x * 0.0083333338f))));
    return x > -0.25f ? p : fexp(x) - 1.0f; }
__device__ __forceinline__ float softplusf(float x) { return fmaxf(x, 0.f) + log1pf(expf(-fabsf(x))); }
__device__ __forceinline__ float wave_sum(float v) {
    v += __int_as_float(__builtin_amdgcn_update_dpp(0, __float_as_int(v), 0x121, 0xf, 0xf, false));
    v += __int_as_float(__builtin_amdgcn_update_dpp(0, __float_as_int(v), 0x122, 0xf, 0xf, false));
    v += __int_as_float(__builtin_amdgcn_update_dpp(0, __float_as_int(v), 0x124, 0xf, 0xf, false));
    v += __int_as_float(__builtin_amdgcn_update_dpp(0, __float_as_int(v), 0x128, 0xf, 0xf, false));
    v += __int_as_float(__builtin_amdgcn_update_dpp(0, __float_as_int(v), 0x142, 0xa, 0xf, false));
    v += __int_as_float(__builtin_amdgcn_update_dpp(0, __float_as_int(v), 0x143, 0xc, 0xf, false));
    return __int_as_float(__builtin_amdgcn_readlane(__float_as_int(v), 63));
}
__device__ __forceinline__ float wave_max(float v) {
    const int ninf = 0xff800000;
    v = fmaxf(v, __int_as_float(__builtin_amdgcn_update_dpp(ninf, __float_as_int(v), 0x121, 0xf, 0xf, false)));
    v = fmaxf(v, __int_as_float(__builtin_amdgcn_update_dpp(ninf, __float_as_int(v), 0x122, 0xf, 0xf, false)));
    v = fmaxf(v, __int_as_float(__builtin_amdgcn_update_dpp(ninf, __float_as_int(v), 0x124, 0xf, 0xf, false)));
    v = fmaxf(v, __int_as_float(__builtin_amdgcn_update_dpp(ninf, __float_as_int(v), 0x128, 0xf, 0xf, false)));
    v = fmaxf(v, __int_as_float(__builtin_amdgcn_update_dpp(ninf, __float_as_int(v), 0x142, 0xa, 0xf, false)));
    v = fmaxf(v, __int_as_float(__builtin_amdgcn_update_dpp(ninf, __float_as_int(v), 0x143, 0xc, 0xf, false)));
    return __int_as_float(__builtin_amdgcn_readlane(__float_as_int(v), 63));
}
__device__ __forceinline__ int wave_min_i(int v) {
    const int big = 0x7fffffff;
    v = min(v, __builtin_amdgcn_update_dpp(big, v, 0x121, 0xf, 0xf, false));
    v = min(v, __builtin_amdgcn_update_dpp(big, v, 0x122, 0xf, 0xf, false));
    v = min(v, __builtin_amdgcn_update_dpp(big, v, 0x124, 0xf, 0xf, false));
    v = min(v, __builtin_amdgcn_update_dpp(big, v, 0x128, 0xf, 0xf, false));
    v = min(v, __builtin_amdgcn_update_dpp(big, v, 0x142, 0xa, 0xf, false));
    v = min(v, __builtin_amdgcn_update_dpp(big, v, 0x143, 0xc, 0xf, false));
    return __builtin_amdgcn_readlane(v, 63);
}
__device__ __forceinline__ float row16_sum(float v) {
    v += __int_as_float(__builtin_amdgcn_update_dpp(0, __float_as_int(v), 0x121, 0xf, 0xf, false));
    v += __int_as_float(__builtin_amdgcn_update_dpp(0, __float_as_int(v), 0x122, 0xf, 0xf, false));
    v += __int_as_float(__builtin_amdgcn_update_dpp(0, __float_as_int(v), 0x124, 0xf, 0xf, false));
    v += __int_as_float(__builtin_amdgcn_update_dpp(0, __float_as_int(v), 0x128, 0xf, 0xf, false));
    return v;
}
__device__ __forceinline__ int row_batch(int row) { return row < NCTX ? (row >> 8) : ((row - NCTX) >> 12); }
__device__ __forceinline__ int row_modr(int row) { return row < NCTX ? 4 : ((row - NCTX) >> 12); }
#define XB_TMO      128
#define XB_XCNT(j)  (256  + 64 * (j))
#define XB_XSUB(j)  (1280 + 64 * (j))
#define XB_XGEN(j)  (2304 + 64 * (j))
#define XB_TOP      3328
#define XB_TOPGEN   3392
#define XCD_BAR_WORDS 3456
#define XB_SPIN_CAP (1u << 18)

__device__ __forceinline__ unsigned xb_ld(unsigned* p)              { return __hip_atomic_load(p, __ATOMIC_RELAXED, __HIP_MEMORY_SCOPE_AGENT); }
__device__ __forceinline__ unsigned xb_add(unsigned* p, unsigned v) { return __hip_atomic_fetch_add(p, v, __ATOMIC_RELAXED, __HIP_MEMORY_SCOPE_AGENT); }
__device__ __forceinline__ unsigned xb_xcc_id() { return (unsigned)__builtin_amdgcn_s_getreg((3 << 11) | 20) & 0xFu; }
#define XB_SPIN(cond, bar) do { unsigned _sp = 0; while (cond) { __builtin_amdgcn_s_sleep(1); \
    if ((++_sp & 255u) == 0u) { if (xb_ld(&(bar)[XB_TMO])) break; if (_sp > XB_SPIN_CAP) { atomicAdd(&(bar)[XB_TMO], 1u); break; } } } } while (0)

struct XcdBarrier {
    unsigned* bar; unsigned x;
    volatile LAS unsigned* st;
};

__device__ __forceinline__ XcdBarrier xcd_barrier_post(unsigned* bar, volatile LAS unsigned* st) {
    XcdBarrier b; b.bar = bar; b.x = xb_xcc_id(); b.st = st;
    if (threadIdx.x == 0) (void)xb_add(&bar[XB_XCNT(b.x)], 1u);
    return b;
}
__device__ __forceinline__ void xcd_barrier_complete(unsigned* bar, unsigned x, unsigned& nloc, unsigned& nx) {
    const unsigned G = gridDim.x * gridDim.y * gridDim.z;
    unsigned sum, cnt, mine, sp = 0u;
    for (;;) {
        sum = 0u; cnt = 0u; mine = 0u;
#pragma unroll
        for (unsigned j = 0; j < 16; ++j) { const unsigned c = xb_ld(&bar[XB_XCNT(j)]); sum += c; cnt += (c > 0u) ? 1u : 0u; mine = (j == x) ? c : mine; }
        if (sum == G) break;
        __builtin_amdgcn_s_sleep(1);
        if ((++sp & 255u) == 0u) { if (xb_ld(&bar[XB_TMO])) break; if (sp > XB_SPIN_CAP) { atomicAdd(&bar[XB_TMO], 1u); break; } }
    }
    nloc = mine > 0u ? mine : 1u; nx = cnt > 0u ? cnt : 1u;
}

__device__ __forceinline__ void xcd_barrier(const XcdBarrier& b) {
    asm volatile("s_waitcnt vmcnt(0)" ::: "memory");
    __syncthreads();
    if (threadIdx.x == 0) {
        unsigned* bar = b.bar;
        __builtin_amdgcn_s_waitcnt(0);
        unsigned nloc = b.st[0], nx = b.st[1];
        if (nloc == 0u) { xcd_barrier_complete(bar, b.x, nloc, nx); b.st[0] = nloc; b.st[1] = nx; }
        const unsigned old = xb_add(&bar[XB_XSUB(b.x)], 1u);
        const unsigned gen = old / nloc;
        if (old + 1u == (gen + 1u) * nloc) {
            __builtin_amdgcn_fence(__ATOMIC_RELEASE, "agent");
            asm volatile("s_waitcnt vmcnt(0)" ::: "memory");
            const unsigned og = xb_add(&bar[XB_TOP], 1u);
            const unsigned tg = og / nx;
            if (og + 1u == (tg + 1u) * nx) xb_add(&bar[XB_TOPGEN], 1u);
            else XB_SPIN(xb_ld(&bar[XB_TOPGEN]) == tg, bar);
            __builtin_amdgcn_fence(__ATOMIC_ACQUIRE, "agent");
            xb_add(&bar[XB_XGEN(b.x)], 1u);
            asm volatile("s_waitcnt vmcnt(0)" ::: "memory");
        } else {
            XB_SPIN(xb_ld(&bar[XB_XGEN(b.x)]) == gen, bar);
            __builtin_amdgcn_fence(__ATOMIC_ACQUIRE, "agent");
            asm volatile("s_waitcnt vmcnt(0)" ::: "memory");
        }
    }
    __syncthreads();
}
namespace pg8 {
constexpr int BM = 256, BK = 64, HALF = 128, HTB = HALF * BK * 2  , STAGE_BYTES = 8 * HTB, NXCD = 8, WGM = 8;

__host__ __device__ __forceinline__ int lds_byte(int r, int c) { const int st = (r >> 4) * 2 + (c >> 5), rr = r & 15, cc = c & 31, ob = rr * 64 + cc * 2; return st * 1024 + (ob ^ (((ob >> 9) & 1) << 5)); }
__host__ __device__ __forceinline__ void stage_rc(int b, int& R, int& C) { const int st = b / 1024, sb = b % 1024, swz = sb ^ (((sb >> 9) & 1) << 5); R = (st >> 1) * 16 + swz / 64; C = (st & 1) * 32 + (swz % 64) / 2; }
__host__ __device__ __forceinline__ int perm32(int rho) { const int n = rho >> 4, i = rho & 15; return 8 * (i >> 2) + 4 * n + (i & 3); }

struct Unit { int pm, pn, hh; };
struct Gemm { const bf16_t* A; const bf16_t* Bt; int M, N, K; const int* aidx; };
__device__ __forceinline__ unsigned cvt_pk_bf16(float lo, float hi) { return pack_bf16(lo, hi); }
template <class Epi, class Sched, bool STAMP = false, bool ATILED = false, bool BTILED = false, bool AGATHER = false, bool HALFM = false>
__device__ __forceinline__ void gemm_phase(LAS unsigned char* lds, const Gemm g, const Sched& S, const Epi& E, unsigned long long* stamps) {
    const int tid = threadIdx.x, wid = __builtin_amdgcn_readfirstlane(tid >> 6), lane = tid & 63, wr = wid >> 2, wc = wid & 3, fr = lane & 15, fq = lane >> 4;
    const int K = g.K, nt = K / BK;
    int ts_lo = 0, ts_hi = 0, nts = 0; const unsigned long long rt_entry = STAMP ? (unsigned long long)wall_clock64() : 0ull;
#define PG8_STAMP() do { if (STAMP && wid == 0 && nts < 64) { const unsigned long long _c = (unsigned long long)clock64(); \
        ts_lo = (lane == nts) ? (int)(unsigned)_c : ts_lo; ts_hi = (lane == nts) ? (int)(unsigned)(_c >> 32) : ts_hi; ++nts; } } while (0)
    PG8_STAMP();
    unsigned voffA[2], voffB[2];
#pragma unroll
    for (int i = 0; i < 2; ++i) { int R, C; stage_rc(tid * 16 + i * 8192, R, C); const int Rb = Epi::PERM ? ((R & ~31) + perm32(R & 31)) : R;
        voffA[i] = (unsigned)(R * (ATILED ? BK : K) + C) * 2u; voffB[i] = (unsigned)(Rb * (BTILED ? BK : K) + C) * 2u; }
    const size_t kstepA = ATILED ? (size_t)BM * BK * 2 : (size_t)(BK * 2), kstepB = BTILED ? (size_t)BM * BK * 2 : (size_t)(BK * 2);
    const size_t hstepA = ATILED ? (size_t)HALF * BK * 2 : (size_t)HALF * K * 2, hstepB = BTILED ? (size_t)HALF * BK * 2 : (size_t)HALF * K * 2;
    const size_t tstep = (size_t)BM * K * 2;
    const unsigned ldsw = (unsigned)wid * 1024u;
    static_assert(!(AGATHER && ATILED), "a gathered operand is row-major");
    int gR0 = 0, gC0 = 0; { int R, C; stage_rc(tid * 16, R, C); gR0 = R; gC0 = C * 2; }
    unsigned vAc[4] = {0u, 0u, 0u, 0u};
    LAS int* gslot = (LAS int*)(lds + STAGE_BYTES + 8192 + 2048);
    const int aoff = lds_byte(wr * 64 + fr, fq * 8), boff = lds_byte(wc * 32 + fr, fq * 8);
#define PG8_SA(b, h) (((b) * 2 + (h)) * HTB)
#define PG8_SB(b, h) ((4 + (b) * 2 + (h)) * HTB)
#define PG8_STAGE(bufoff, gbase, voff) do { _Pragma("unroll") for (int _i = 0; _i < 2; ++_i) \
        __builtin_amdgcn_global_load_lds((const unsigned*)((const char*)(gbase) + (voff)[_i]), (LAS unsigned*)(lds + (bufoff) + ldsw + _i * 8192), 16, 0, 0); } while (0)
#define PG8_STAGE_A(bufoff, gbase, kbytes, h, vg) do { if constexpr (AGATHER) { _Pragma("unroll") for (int _i = 0; _i < 2; ++_i) \
        __builtin_amdgcn_global_load_lds((const unsigned*)((const char*)g.A + (kbytes) + (vg)[(HALFM ? hsrc : (h)) * 2 + _i]), (LAS unsigned*)(lds + (bufoff) + ldsw + _i * 8192), 16, 0, 0); } \
        else PG8_STAGE(bufoff, (gbase) + (HALFM ? (size_t)hsrc * hstepA : (size_t)0), voffA); } while (0)
#define PG8_LDA(dst, b, h) do { _Pragma("unroll") for (int m = 0; m < 4; ++m) _Pragma("unroll") for (int k = 0; k < 2; ++k) dst[m][k] = *(const LAS bf16x8*)(lds + PG8_SA(b, h) + aoff + m * 2048 + k * 1024); } while (0)
#define PG8_LDB(dst, b, h) do { _Pragma("unroll") for (int n = 0; n < 2; ++n) _Pragma("unroll") for (int k = 0; k < 2; ++k) dst[n][k] = *(const LAS bf16x8*)(lds + PG8_SB(b, h) + boff + n * 2048 + k * 1024); } while (0)
#define PG8_MMA(ai, bj, At, Bt) do { __builtin_amdgcn_s_setprio(1); _Pragma("unroll") for (int m = 0; m < 4; ++m) _Pragma("unroll") for (int n = 0; n < 2; ++n) _Pragma("unroll") for (int k = 0; k < 2; ++k) \
        acc[ai][bj][m][n] = __builtin_amdgcn_mfma_f32_16x16x32_bf16(Bt[n][k], At[m][k], acc[ai][bj][m][n], 0, 0, 0); __builtin_amdgcn_s_setprio(0); } while (0)
#define PG8_WAIT_V(n) asm volatile("s_waitcnt vmcnt(" #n ")" ::: "memory")
#define PG8_WAIT_L(n) asm volatile("s_waitcnt lgkmcnt(" #n ")" ::: "memory")
#define PG8_BAR __builtin_amdgcn_s_barrier()
#define PG8_SCHED __builtin_amdgcn_sched_barrier(0)
    Unit cur, nxt; int ui = 0;
    if (!S.next(0, cur)) return;
    f32x4 acc[2][2][4][2];
#pragma unroll
    for (int a = 0; a < 2; ++a)
#pragma unroll
        for (int b = 0; b < 2; ++b)
#pragma unroll
            for (int m = 0; m < 4; ++m)
#pragma unroll
                for (int n = 0; n < 2; ++n) acc[a][b][m][n] = (f32x4){0.f, 0.f, 0.f, 0.f};
    bf16x8 At[4][2], B0[2][2], B1[2][2];
    const char* cA = (const char*)g.A + (size_t)cur.pm * tstep; const char* cB = (const char*)g.Bt + (size_t)cur.pn * tstep;
    S.a_ready(cur);
    if constexpr (AGATHER) {
#pragma unroll
        for (int j = 0; j < 4; ++j) vAc[j] = (unsigned)g.aidx[cur.pm * BM + gR0 + 64 * j] * (unsigned)(K * 2) + (unsigned)gC0;
    }
    int hsrc = HALFM ? cur.hh : 0;
    if constexpr (HALFM) {
        PG8_STAGE(PG8_SB(0, 0), cB, voffB); PG8_STAGE_A(PG8_SA(0, 0), cA, 0, 0, vAc); PG8_STAGE(PG8_SB(0, 1), cB + hstepB, voffB);
        if (wr == 1) PG8_BAR;
        PG8_WAIT_V(2); PG8_BAR;
    } else {
    PG8_STAGE(PG8_SB(0, 0), cB, voffB); PG8_STAGE_A(PG8_SA(0, 0), cA, 0, 0, vAc); PG8_STAGE(PG8_SB(0, 1), cB + hstepB, voffB); PG8_STAGE_A(PG8_SA(0, 1), cA + hstepA, 0, 1, vAc);
    if (wr == 1) PG8_BAR;
    PG8_WAIT_V(4); PG8_BAR;
    }
    PG8_STAGE(PG8_SB(1, 0), cB + kstepB, voffB); PG8_STAGE_A(PG8_SA(1, 0), cA + kstepA, BK * 2, 0, vAc); PG8_STAGE(PG8_SB(1, 1), cB + hstepB + kstepB, voffB);
    PG8_WAIT_V(6); PG8_BAR;
    PG8_STAMP();
    for (;;) {
        const bool has_next = S.next(ui + 1, nxt);
        const char* nA = has_next ? (const char*)g.A + (size_t)nxt.pm * tstep : cA; const char* nB = has_next ? (const char*)g.Bt + (size_t)nxt.pn * tstep : cB;
        E.pre(lds, ui & 1, cur, wid, lane);
        if constexpr (AGATHER) { if (has_next && wid == 0) __builtin_amdgcn_global_load_lds((const unsigned*)(g.aidx + nxt.pm * BM + lane * 4), (LAS unsigned*)(gslot + ((ui + 1) & 1) * 256), 16, 0, 0); }
        for (int t = 0; t < nt; t += 2) {
            const bool last = (t == nt - 2);
            const char* a1 = cA + (size_t)(t + 1) * kstepA;
            const char* a2 = last ? nA : cA + (size_t)(t + 2) * kstepA; const char* b2 = last ? nB : cB + (size_t)(t + 2) * kstepB;
            const char* a3 = a2 + kstepA; const char* b3 = b2 + kstepB;
            if (last && has_next) S.a_ready(nxt);
            const int kb2 = AGATHER ? (last ? 0 : (t + 2) * BK * 2) : 0;
            PG8_LDB(B0, 0, 0); PG8_SCHED; PG8_LDA(At, 0, 0); if constexpr (!HALFM) PG8_STAGE_A(PG8_SA(1, 1), a1 + hstepA, (t + 1) * BK * 2, 1, vAc);
            if constexpr (AGATHER) { if (last && has_next) {
#pragma unroll
                for (int j = 0; j < 4; ++j) vAc[j] = (unsigned)gslot[((ui + 1) & 1) * 256 + gR0 + 64 * j] * (unsigned)(K * 2) + (unsigned)gC0; } }
            PG8_WAIT_L(8); PG8_BAR; PG8_WAIT_L(0); PG8_MMA(0, 0, At, B0); PG8_BAR; PG8_SCHED;
            PG8_LDB(B1, 0, 1); PG8_STAGE(PG8_SB(0, 0), b2, voffB);
            PG8_BAR; PG8_WAIT_L(0); PG8_MMA(0, 1, At, B1); PG8_BAR;
            if constexpr (HALFM) { if (last && has_next) hsrc = nxt.hh; }
            if constexpr (!HALFM) PG8_LDA(At, 0, 1); PG8_STAGE_A(PG8_SA(0, 0), a2, kb2, 0, vAc);
            PG8_BAR; PG8_WAIT_L(0); if constexpr (!HALFM) PG8_MMA(1, 0, At, B0); PG8_BAR; PG8_SCHED;
            PG8_STAGE(PG8_SB(0, 1), b2 + hstepB, voffB);
            PG8_WAIT_V(6); PG8_BAR; if constexpr (!HALFM) PG8_MMA(1, 1, At, B1); PG8_BAR;
            PG8_LDB(B0, 1, 0); PG8_SCHED; PG8_LDA(At, 1, 0); if constexpr (!HALFM) PG8_STAGE_A(PG8_SA(0, 1), a2 + hstepA, kb2, 1, vAc);
            PG8_WAIT_L(8); PG8_BAR; PG8_WAIT_L(0); PG8_MMA(0, 0, At, B0); PG8_BAR; PG8_SCHED;
            PG8_LDB(B1, 1, 1); PG8_STAGE(PG8_SB(1, 0), b3, voffB);
            PG8_BAR; PG8_WAIT_L(0); PG8_MMA(0, 1, At, B1); PG8_BAR;
            if constexpr (!HALFM) PG8_LDA(At, 1, 1); PG8_STAGE_A(PG8_SA(1, 0), a3, kb2 + BK * 2, 0, vAc);
            PG8_BAR; PG8_WAIT_L(0); if constexpr (!HALFM) PG8_MMA(1, 0, At, B0); PG8_BAR; PG8_SCHED;
            PG8_STAGE(PG8_SB(1, 1), b3 + hstepB, voffB);
            PG8_WAIT_V(6); PG8_BAR; if constexpr (!HALFM) PG8_MMA(1, 1, At, B1); PG8_BAR;
        }
        PG8_STAMP();
        if constexpr (!Epi::AFTER_DRAIN) { E.template store<HALFM>(acc, cur, wr, wc, fr, fq, lds, ui & 1); S.done(cur); }
        PG8_STAMP();
        if (!has_next) break;
#pragma unroll
        for (int a = 0; a < 2; ++a)
#pragma unroll
            for (int b = 0; b < 2; ++b)
#pragma unroll
                for (int m = 0; m < 4; ++m)
#pragma unroll
                    for (int n = 0; n < 2; ++n) acc[a][b][m][n] = (f32x4){0.f, 0.f, 0.f, 0.f};
        cur = nxt; cA = nA; cB = nB; ++ui;

    }
    PG8_WAIT_V(0);
    if (wr == 0) PG8_BAR;
    PG8_BAR;
    if constexpr (Epi::AFTER_DRAIN) { E.fused(acc, cur, wr, wc, fr, fq, lds, wid, lane); S.done(cur); }
    PG8_STAMP();
    if (STAMP && wid == 0) { stamps[lane] = lane < nts ? (((unsigned long long)(unsigned)ts_hi << 32) | (unsigned)ts_lo) : 0ull;
        if (lane == 62) stamps[62] = rt_entry; if (lane == 63) stamps[63] = (unsigned long long)wall_clock64(); }
#undef PG8_STAMP
#undef PG8_SA
#undef PG8_SB
#undef PG8_STAGE
#undef PG8_STAGE_A
#undef PG8_LDA
#undef PG8_LDB
#undef PG8_MMA
#undef PG8_WAIT_V
#undef PG8_WAIT_L
#undef PG8_BAR
#undef PG8_SCHED
}
__device__ __forceinline__ int xcd_contig(long L, int nwg) { const int q = nwg / NXCD, r = nwg % NXCD, xcd = (int)(L % NXCD), off = (int)(L / NXCD); return (xcd < r ? xcd * (q + 1) : r * (q + 1) + (xcd - r) * q) + off; }
__device__ __forceinline__ bool tail_split(int nwg, int G, int& nlim) { const int full = (nwg / G) * G, tail = nwg - full; const bool sp = tail > 0 && 2 * tail <= G && (G & 15) == 0; nlim = sp ? full : nwg; return sp; }
template <int nN, int MODE = 0>
struct SchedDense {
    int nM, pm0, G, c;
    __device__ __forceinline__ bool next(int i, Unit& u) const {
        const int nwg = nM * nN; long L = (long)i * G + c; int hh = 0;
        if (MODE != 0) { int nlim; const bool sp = tail_split(nwg, G, nlim);
            if (MODE == 1) { if (L >= nlim) return false; }
            else { if (!sp || i != 0) return false; const int j = (c & 7) + 8 * (c >> 4); if (nlim + j >= nwg) return false; L = nlim + j; hh = (c >> 3) & 1; } }
        if (L >= nwg) return false;
        const int wgid = xcd_contig(L, nwg);
        constexpr int nig = WGM * nN; const int gid = wgid / nig, fm = gid * WGM, gsz = (nM - fm) < WGM ? (nM - fm) : WGM, w = wgid % nig;
        if (gsz == WGM) { u.pm = pm0 + fm + (w & (WGM - 1)); u.pn = w >> 3; } else { u.pm = pm0 + fm + (w % gsz); u.pn = w / gsz; }
        u.hh = hh;
        return true; }
    __device__ __forceinline__ void a_ready(const Unit&) const {}
    __device__ __forceinline__ void done(const Unit&) const {}
};
template <int nN, int MODE = 0>
struct SchedMoe {
    int T, G, c; const LAS int* tileE;
    __device__ __forceinline__ bool next(int i, Unit& u) const { const int nwg = T * nN; long L = (long)i * G + c; int hh = 0;
        if (MODE != 0) { int nlim; const bool sp = tail_split(nwg, G, nlim);
            if (MODE == 1) { if (L >= nlim) return false; }
            else { if (!sp || i != 0) return false; const int j = (c & 7) + 8 * (c >> 4); if (nlim + j >= nwg) return false; L = nlim + j; hh = (c >> 3) & 1; } }
        if (L >= nwg) return false;
        const int wgid = xcd_contig(L, nwg), pt = wgid / nN; u.pm = pt; u.pn = tileE[pt] * nN + (wgid % nN); u.hh = hh; return true; }
    __device__ __forceinline__ void a_ready(const Unit&) const {}
    __device__ __forceinline__ void done(const Unit&) const {}
};
constexpr int EPI_BIAS_OFF = STAGE_BYTES + 8192;
struct EpiStore {
    static constexpr bool PERM = true, AFTER_DRAIN = false;
    bf16_t* O; int ldc;
    __device__ __forceinline__ void pre(LAS unsigned char*, int, const Unit&, int, int) const {}
    template <bool HF> __device__ __forceinline__ void store(const f32x4 (&acc)[2][2][4][2], const Unit& u, int wr, int wc, int fr, int fq, const LAS unsigned char*, int) const {
        const int row0 = u.pm * BM + wr * 64 + fr + (HF ? u.hh * HALF : 0), col0 = u.pn * BM + wc * 32 + 8 * fq;
#pragma unroll
        for (int ai = 0; ai < (HF ? 1 : 2); ++ai)
#pragma unroll
            for (int m = 0; m < 4; ++m) { bf16_t* rowp = O + (size_t)(row0 + ai * HALF + m * 16) * ldc + col0;
#pragma unroll
                for (int bj = 0; bj < 2; ++bj) { const f32x4 v0 = acc[ai][bj][m][0], v1 = acc[ai][bj][m][1];
                    u32x4 w; w.x = cvt_pk_bf16(v0[0], v0[1]); w.y = cvt_pk_bf16(v0[2], v0[3]); w.z = cvt_pk_bf16(v1[0], v1[1]); w.w = cvt_pk_bf16(v1[2], v1[3]);
                    *(u32x4*)(rowp + bj * HALF) = w; } }
    }
};
struct EpiYE {
    static constexpr bool PERM = true, AFTER_DRAIN = false;
    bf16_t* O; const float* b2;
    __device__ __forceinline__ void pre(LAS unsigned char* lds, int par, const Unit& u, int wid, int lane) const {
        if (wid == 0) __builtin_amdgcn_global_load_lds((const unsigned*)(b2 + (u.pn >> 2) * 1024 + (u.pn & 3) * BM + lane * 4), (LAS unsigned*)(lds + EPI_BIAS_OFF + par * 1024), 16, 0, 0);
    }
    template <bool HF> __device__ __forceinline__ void store(const f32x4 (&acc)[2][2][4][2], const Unit& u, int wr, int wc, int fr, int fq, const LAS unsigned char* lds, int par) const {
        const int pn = u.pn & 3;
        const int row0 = u.pm * BM + wr * 64 + fr + (HF ? u.hh * HALF : 0), col0 = pn * BM + wc * 32 + 8 * fq;
        const LAS float* bp = (const LAS float*)(lds + EPI_BIAS_OFF + par * 1024) + wc * 32 + 8 * fq;
        f32x4 bv[2][2];
#pragma unroll
        for (int bj = 0; bj < 2; ++bj)
#pragma unroll
            for (int n = 0; n < 2; ++n) bv[bj][n] = *(const LAS f32x4*)(bp + bj * HALF + 4 * n);
#pragma unroll
        for (int ai = 0; ai < (HF ? 1 : 2); ++ai)
#pragma unroll
            for (int m = 0; m < 4; ++m) { bf16_t* rowp = O + (size_t)(row0 + ai * HALF + m * 16) * 1024 + col0;
#pragma unroll
                for (int bj = 0; bj < 2; ++bj) { const f32x4 v0 = acc[ai][bj][m][0] + bv[bj][0], v1 = acc[ai][bj][m][1] + bv[bj][1];
                    u32x4 w; w.x = cvt_pk_bf16(v0[0], v0[1]); w.y = cvt_pk_bf16(v0[2], v0[3]); w.z = cvt_pk_bf16(v1[0], v1[1]); w.w = cvt_pk_bf16(v1[2], v1[3]);
                    *(u32x4*)(rowp + bj * HALF) = w; } }
    }
};
struct EpiAct {
    static constexpr bool PERM = true, AFTER_DRAIN = false;
    bf16_t* O; const float* b1;
    __device__ __forceinline__ void pre(LAS unsigned char* lds, int par, const Unit& u, int wid, int lane) const {
        if (wid == 0) __builtin_amdgcn_global_load_lds((const unsigned*)(b1 + (u.pn >> 3) * 2048 + (lane >> 5) * 1024 + (u.pn & 7) * 128 + (lane & 31) * 4), (LAS unsigned*)(lds + EPI_BIAS_OFF + par * 1024), 16, 0, 0);
    }
    template <bool HF> __device__ __forceinline__ void store(const f32x4 (&acc)[2][2][4][2], const Unit& u, int wr, int wc, int fr, int fq, const LAS unsigned char* lds, int par) const {
        const int pn = u.pn & 7;
        const int row0 = u.pm * BM + wr * 64 + fr, x0 = pn * 128 + wc * 32 + 8 * fq, hro = HF ? u.hh * HALF : 0;
        const LAS float* bg = (const LAS float*)(lds + EPI_BIAS_OFF + par * 1024) + wc * 32 + 8 * fq; const LAS float* bl = bg + 128;
        const f32x4 g0 = *(const LAS f32x4*)bg, g1 = *(const LAS f32x4*)(bg + 4), l0 = *(const LAS f32x4*)bl, l1 = *(const LAS f32x4*)(bl + 4);
#pragma unroll
        for (int ai = 0; ai < (HF ? 1 : 2); ++ai)
#pragma unroll
            for (int m = 0; m < 4; ++m) {
                float o[8];
#pragma unroll
                for (int n = 0; n < 2; ++n)
#pragma unroll
                    for (int j = 0; j < 4; ++j) {
                        float glu = acc[ai][0][m][n][j] + (n ? g1[j] : g0[j]);
                        float lin = acc[ai][1][m][n][j] + (n ? l1[j] : l0[j]);
                        glu = fminf(glu, 7.0f); lin = fminf(fmaxf(lin, -7.0f), 7.0f);
                        o[n * 4 + j] = (lin + 1.0f) * glu * __builtin_amdgcn_rcpf(1.0f + __expf(-1.702f * glu));
                    }
                u32x4 w; w.x = cvt_pk_bf16(o[0], o[1]); w.y = cvt_pk_bf16(o[2], o[3]); w.z = cvt_pk_bf16(o[4], o[5]); w.w = cvt_pk_bf16(o[6], o[7]);
                *(u32x4*)(O + ((size_t)(u.pm * 16 + (x0 >> 6)) * 256 + (wr * 64 + fr + hro + ai * HALF + m * 16)) * 64 + (x0 & 63)) = w;
            }
    }
};
}
using pg8::Unit;
__device__ __forceinline__ void my_sincos(double a, float& s, float& c) {
    const double n = rint(a * 0.63661977236758134308);
    const double r = (a - n * 1.57079632679489655800e+00) - n * 6.12323399573676603587e-17;
    const double r2 = r * r;
    const double sp = r * (1.0 + r2 * (-1.0 / 6.0 + r2 * (1.0 / 120.0 + r2 * (-1.0 / 5040.0 + r2 * (1.0 / 362880.0 + r2 * (-1.0 / 39916800.0 + r2 * (1.0 / 6227020800.0 + r2 * (-1.0 / 1307674368000.0))))))));
    const double cp = 1.0 + r2 * (-0.5 + r2 * (1.0 / 24.0 + r2 * (-1.0 / 720.0 + r2 * (1.0 / 40320.0 + r2 * (-1.0 / 3628800.0 + r2 * (1.0 / 479001600.0 + r2 * (-1.0 / 87178291200.0 + r2 * (1.0 / 20922789888000.0))))))));
    const int q = ((int)n) & 3;
    const double sn = q == 0 ? sp : q == 1 ? cp : q == 2 ? -sp : -cp;
    const double cn = q == 0 ? cp : q == 1 ? -sp : q == 2 ? -cp : sp;
    s = (float)sn; c = (float)cn;
}
__device__ __forceinline__ void ph_prologue(const Params& p, LAS unsigned char* lds, int bid, int nblk) {
    const int tid = threadIdx.x;
    unsigned char* ws = p.ws;
    {
        LAS float* sv = (LAS float*)(lds + LDS_WORK);
        LAS float* red = sv + 5 * 1024;
        for (int i = tid; i < 5 * 1024; i += NTHR) { const int r = i >> 10, k = i & 1023; const float c = r < 4 ? p.in[I_C][r * 1024 + k] : p.in[I_CCTX][k]; sv[i] = c / (1.0f + expf(-c)); }
        __syncthreads();
        float* MOD = (float*)(ws + WS_MOD);
        for (int item = bid; item < 256; item += nblk) {
            if (tid < 480) {
                const int cl = tid % 48, kp = tid / 48;
                const int gc = item * 48 + cl, l = gc / 6144, n = gc % 6144;
                const float* w = p.in[I_WMOD] + (size_t)l * 1024 * 6144 + n;
                float a0 = 0.f, a1 = 0.f, a2 = 0.f, a3 = 0.f, a4 = 0.f;
#pragma unroll 1
                for (int k0 = kp; k0 < 1024; k0 += 130) {
                    float wv[13];
#pragma unroll
                    for (int u = 0; u < 13; ++u) { const int k = k0 + 10 * u; wv[u] = k < 1024 ? w[(size_t)k * 6144] : 0.f; }
#pragma unroll
                    for (int u = 0; u < 13; ++u) { const int k = k0 + 10 * u < 1024 ? k0 + 10 * u : 1023; a0 += sv[k] * wv[u]; a1 += sv[1024 + k] * wv[u]; a2 += sv[2048 + k] * wv[u]; a3 += sv[3072 + k] * wv[u]; a4 += sv[4096 + k] * wv[u]; }
                }
                LAS float* rp = red + (kp * 48 + cl) * 5; rp[0] = a0; rp[1] = a1; rp[2] = a2; rp[3] = a3; rp[4] = a4;
            }
            __syncthreads();
            if (tid < 240) {
                const int cl = tid / 5, r = tid % 5; float s = 0.f;
                for (int kp = 0; kp < 10; ++kp) s += red[(kp * 48 + cl) * 5 + r];
                const int gc = item * 48 + cl, l = gc / 6144, n = gc % 6144;
                MOD[(size_t)(l * 5 + r) * 6144 + n] = s + p.in[I_BMOD][l * 6144 + n];
            }
            __syncthreads();
        }
    }
    if (bid == (nblk > 1 ? 1 : 0)) {
        float* ROPE = (float*)(ws + WS_ROPE);
        for (int i = tid; i < 2048; i += NTHR) { const int pos = i >> 5, f = i & 31; const double inv = exp(-(double)f * 0.28782313662425575); float s, c; my_sincos((double)pos * inv, s, c); ROPE[2 * i] = c; ROPE[2 * i + 1] = s; }
    }
    {
        bf16_t* WLT = (bf16_t*)(ws + WS_WLT);
        for (int i = bid * NTHR + tid; i < (int)WLT_N; i += nblk * NTHR) {
            float v;
            if (i < 131072) { const int which = i >> 16, r = i & 65535, d = r >> 15, n = (r >> 6) & 511, k = r & 63; v = (which ? p.in[I_AAB] : p.in[I_AWB])[(size_t)(d * 64 + k) * 512 + n]; }
            else if (i < 196608) { const int r = i - 131072, n = r >> 7, k = r & 127; v = p.in[I_AGB][(size_t)k * 512 + n]; }
            else { const int r = i - 196608, blk = r >> 12, o = (r >> 6) & 63, ii = r & 63; v = p.in[I_BGW][(size_t)blk * 4096 + ii * 64 + o]; }
            WLT[i] = f2bf(v);
        }
    }
    {
        LAS float* tile = (LAS float*)(lds + LDS_WORK);
        for (int t = bid; t < 576; t += nblk) {
            const float* src; int ld, nvalid, k0, n0, w1map = 0; bf16_t* dst; int tt = t;
            if (tt < 192) { k0 = (tt / 12) * 64; n0 = (tt % 12) * 256; src = p.in[I_EWIN]; ld = EVEN_IN; nvalid = EVEN_IN; dst = (bf16_t*)(ws + WS_WIN0T); }
            else if ((tt -= 192) < 256) { k0 = (tt >> 4) * 64; n0 = (tt & 15) * 256; src = p.in[I_OWIN]; ld = ODD_IN; nvalid = 4096; dst = (bf16_t*)(ws + WS_WIN1T); }
            else { tt -= 256; const int mat = tt >> 6, r = tt & 63; k0 = (r >> 2) * 64; n0 = (r & 3) * 256; src = mat ? p.in[I_OWOUT] : p.in[I_EWOUT]; ld = 1024; nvalid = 1024; dst = (bf16_t*)(ws + WS_WOUTT) + (size_t)mat * 1024 * 1024; }
            {
                const int j4 = (tid & 63) * 4, i0 = tid >> 6;
                f32x4 v[8];
#pragma unroll
                for (int r = 0; r < 8; ++r) v[r] = (n0 + j4 < nvalid) ? *(const f32x4*)(src + (size_t)(k0 + i0 + 8 * r) * ld + n0 + j4) : (f32x4){0.f, 0.f, 0.f, 0.f};
#pragma unroll
                for (int r = 0; r < 8; ++r) { LAS float* tp = tile + (i0 + 8 * r) * 257 + j4; tp[0] = v[r][0]; tp[1] = v[r][1]; tp[2] = v[r][2]; tp[3] = v[r][3]; }
            }
            __syncthreads();
            {
                const int ip = (tid & 31) * 2, j0 = tid >> 5;
#pragma unroll
                for (int r = 0; r < 16; ++r) {
                    const int j = j0 + 16 * r, n = n0 + j;
                    const int rho = w1map ? ((((n & 1023) >> 7) << 8) + ((n >> 10) << 7) + (n & 127)) : n;
                    *(unsigned*)(dst + (size_t)rho * 1024 + k0 + ip) = pack_bf16(tile[ip * 257 + j], tile[(ip + 1) * 257 + j]);
                }
            }
            __syncthreads();
        }
    }
}
__device__ __forceinline__ void ph_mod_in(const Params& p, int bid, int nblk) {
    const int tid = threadIdx.x, wid = tid >> 6, lane = tid & 63;
    const float* MOD = (const float*)(p.ws + WS_MOD);
    bf16_t* H = (bf16_t*)(p.ws + WS_H);
    for (int row = bid * 8 + wid; row < MROWS; row += nblk * 8) {
        const float* src = row < NCTX ? p.in[I_CTX] + (size_t)row * 1024 : p.in[I_X] + (size_t)(row - NCTX) * 1024;
        const float* md = MOD + (size_t)row_modr(row) * 6144;
#pragma unroll
        for (int q = 0; q < 4; ++q) {
            const int col = q * 256 + lane * 4;
            const f32x4 x = *(const f32x4*)(src + col), sh = *(const f32x4*)(md + col), sc = *(const f32x4*)(md + 1024 + col);
            const f32x4 h = x * (sc + 1.0f) + sh;
            u32x2 w; w.x = pack_bf16(h[0], h[1]); w.y = pack_bf16(h[2], h[3]);
            *(u32x2*)(H + (size_t)row * 1024 + col) = w;
        }
    }
}
__device__ __forceinline__ int even_tok_row(int w, int idx) { return idx < 64 ? NCTX + (w >> 6) * 4096 + (w & 63) * 64 + idx : w * 4 + (idx - 64); }
__device__ __forceinline__ int shift_nb(int row, int cc) {
    if (row >= NCTX) { const int s = (row - NCTX) & 4095, gr = s >> 6, gc = s & 63, slot = cc & 3;
        if (slot == 0) return gc > 0 ? row - 1 : -1;
        if (slot == 1) return gc < 63 ? row + 1 : -1;
        if (slot == 2) return gr > 0 ? row - 64 : -1;
        return gr < 63 ? row + 64 : -1; }
    const int t = row & 255; return (cc & 1) == 0 ? (t > 0 ? row - 1 : -1) : (t < 255 ? row + 1 : -1);
}
__device__ __forceinline__ float shifted_z(const bf16_t* P, const float* mu, int row, int cc) {
    const float pv = bf2f(P[(size_t)row * LDP0 + cc]); const int nb = shift_nb(row, cc);
    const float sv = nb >= 0 ? bf2f(P[(size_t)nb * LDP0 + cc]) : 0.f;
    return pv + (sv - pv) * mu[cc];
}
__device__ __forceinline__ int scan_q(int row, int d) {
    if (row < NCTX) { const int t = row & 255; return d ? 255 - t : t; }
    const int s = (row - NCTX) & 4095; return 256 + (d ? 4095 - s : s);
}
__device__ __forceinline__ bf16_t* sc_rec(float* SC, int d, int row, int h) { return (bf16_t*)SC + ((size_t)((d * 4 + row_batch(row)) * 8 + h) * SCLEN + scan_q(row, d)) * SCREC; }
constexpr int LDL = 392, LDU = 520;
template <int KS>
__device__ __forceinline__ void load_b(const bf16_t* Bt, bf16x8 (&b)[4][KS], int lane) {
    const int fr = lane & 15, fq = lane >> 4;
#pragma unroll
    for (int nt = 0; nt < 4; ++nt)
#pragma unroll
        for (int ks = 0; ks < KS; ++ks) b[nt][ks] = *(const bf16x8*)(Bt + (size_t)(nt * 16 + fr) * (32 * KS) + ks * 32 + fq * 8);
}
template <int KS>
__device__ __forceinline__ void mma_mt(const LAS bf16_t* A, int lda, int mt, const bf16x8 (&b)[4][KS], f32x4 (&acc)[4], int lane) {
    const int fr = lane & 15, fq = lane >> 4;
#pragma unroll
    for (int nt = 0; nt < 4; ++nt) acc[nt] = (f32x4){0.f, 0.f, 0.f, 0.f};
#pragma unroll
    for (int ks = 0; ks < KS; ++ks) {
        const bf16x8 a = *(const LAS bf16x8*)(A + (mt * 16 + fr) * lda + ks * 32 + fq * 8);
#pragma unroll
        for (int nt = 0; nt < 4; ++nt) acc[nt] = __builtin_amdgcn_mfma_f32_16x16x32_bf16(a, b[nt][ks], acc[nt], 0, 0, 0);
    }
}
__device__ __forceinline__ void ph_prep_even(const Params& p, LAS unsigned char* lds, int bid, int nblk) {
    const bf16_t* P = (const bf16_t*)(p.ws + WS_P);
    float* SC = (float*)(p.ws + WS_SC);
    float* EA = (float*)(p.ws + WS_EARR);
#define EARR(k) (EA + (size_t)(k) * ((size_t)MROWS * 512))
    float* BC = (float*)(p.ws + WS_BC);
    float* CHA = (float*)(p.ws + WS_CHA); float* CHH = (float*)(p.ws + WS_CHH);
    const bf16_t* WLT = (const bf16_t*)(p.ws + WS_WLT);
    const float* mu = p.in[I_AMU];
    LAS bf16_t* linb = (LAS bf16_t*)(lds + LDS_WORK);
    LAS bf16_t* ub = linb + 80 * LDL;
    LAS float* rnorm = (LAS float*)(ub + 80 * LDU);
    for (int w = bid; w < 256; w += nblk) {
        int tid_ = threadIdx.x; asm volatile("" : "+v"(tid_));
        const int tid = tid_, wid = tid >> 6, lane = tid & 63, fr = lane & 15, fq = lane >> 4;
        for (int i = tid; i < 12 * LDL; i += NTHR) linb[68 * LDL + i] = 0;
        for (int i = tid; i < 12 * LDU; i += NTHR) ub[68 * LDU + i] = 0;
        if (lane < 48) {
            float mul8[8];
#pragma unroll
            for (int i = 0; i < 8; ++i) mul8[i] = mu[1536 + lane * 8 + i];
#pragma unroll 1
            for (int tok = wid; tok < 68; tok += 8) {
                const int row = even_tok_row(w, tok);
                const u32x4 ps = *(const u32x4*)(P + (size_t)row * LDP0 + 1536 + lane * 8);
                u32x4 pn[4];
#pragma unroll
                for (int sl = 0; sl < 4; ++sl) { const int nb = shift_nb(row, sl); pn[sl] = nb >= 0 ? *(const u32x4*)(P + (size_t)nb * LDP0 + 1536 + lane * 8) : (u32x4){0u, 0u, 0u, 0u}; }
                float z[8];
#pragma unroll
                for (int i = 0; i < 8; ++i) { const unsigned wp = ps[i >> 1], wn = pn[i & 3][i >> 1];
                    const float pv = __uint_as_float((i & 1) ? (wp & 0xffff0000u) : (wp << 16)), sv = __uint_as_float((i & 1) ? (wn & 0xffff0000u) : (wn << 16));
                    const float zz = pv + (sv - pv) * mul8[i];
                    z[i] = lane < 16 ? ftanh(zz) : (lane < 32 ? zz : sigm(zz)); }
                u32x4 q;
#pragma unroll
                for (int i = 0; i < 4; ++i) q[i] = pack_bf16(z[2 * i], z[2 * i + 1]);
                *(LAS u32x4*)(linb + tok * LDL + lane * 8) = q;
            }
        }
        {
            float murv[8], mukv8[8], muvv[8], kkc8[8];
#pragma unroll
            for (int i = 0; i < 8; ++i) { murv[i] = mu[lane * 8 + i]; mukv8[i] = mu[512 + lane * 8 + i]; muvv[i] = mu[1024 + lane * 8 + i]; kkc8[i] = p.in[I_AKK][lane * 8 + i]; }
#pragma unroll 1
            for (int tok = wid; tok < 68; tok += 8) {
                const int row = even_tok_row(w, tok);
                int nbr[4];
#pragma unroll
                for (int sl = 0; sl < 4; ++sl) nbr[sl] = shift_nb(row, sl);
                u32x4 ps[3], pn[3][4];
#pragma unroll
                for (int a = 0; a < 3; ++a) { ps[a] = *(const u32x4*)(P + (size_t)row * LDP0 + a * 512 + lane * 8);
#pragma unroll
                    for (int sl = 0; sl < 4; ++sl) pn[a][sl] = nbr[sl] >= 0 ? *(const u32x4*)(P + (size_t)nbr[sl] * LDP0 + a * 512 + lane * 8) : (u32x4){0u, 0u, 0u, 0u}; }
                float z[3][8];
#pragma unroll
                for (int a = 0; a < 3; ++a)
#pragma unroll
                    for (int i = 0; i < 8; ++i) { const unsigned wp = ps[a][i >> 1], wn = pn[a][i & 3][i >> 1];
                        const float pv = __uint_as_float((i & 1) ? (wp & 0xffff0000u) : (wp << 16)), sv = __uint_as_float((i & 1) ? (wn & 0xffff0000u) : (wn << 16));
                        z[a][i] = pv + (sv - pv) * (a == 0 ? murv[i] : (a == 1 ? mukv8[i] : muvv[i])); }
                float kkr[8], ss = 0.f;
#pragma unroll
                for (int i = 0; i < 8; ++i) { kkr[i] = z[1][i] * kkc8[i]; ss += kkr[i] * kkr[i]; }
                ss += __int_as_float(__builtin_amdgcn_update_dpp(0, __float_as_int(ss), 0xb1, 0xf, 0xf, false));
                ss += __int_as_float(__builtin_amdgcn_update_dpp(0, __float_as_int(ss), 0x4e, 0xf, 0xf, false));
                ss += __int_as_float(__builtin_amdgcn_update_dpp(0, __float_as_int(ss), 0x141, 0xf, 0xf, false));
                const float rn = frcp(fmaxf(fsqrt(ss), 1e-12f));
                if ((lane & 7) == 0) rnorm[tok * 8 + (lane >> 3)] = rn;
                u32x4 qk, qr, qv;
#pragma unroll
                for (int i = 0; i < 4; ++i) { qk[i] = pack_bf16(kkr[2 * i] * rn, kkr[2 * i + 1] * rn); qr[i] = pack_bf16(z[0][2 * i], z[0][2 * i + 1]); qv[i] = pack_bf16(z[2][2 * i], z[2][2 * i + 1]); }
#pragma unroll
                for (int d = 0; d < 2; ++d) { bf16_t* rec = sc_rec(SC, d, row, lane >> 3) + (lane & 7) * 8; *(u32x4*)(rec + 128) = qk; *(u32x4*)(rec + 320) = qr; *(u32x4*)(rec + 384) = qv; }
            }
        }
        {
            float cw[4][8], cb8[8];
#pragma unroll
            for (int i = 0; i < 8; ++i) { cb8[i] = p.in[I_BCB][lane * 8 + i];
#pragma unroll
                for (int k = 0; k < 4; ++k) cw[k][i] = p.in[I_BCW][k * 512 + lane * 8 + i]; }
#pragma unroll 1
            for (int tok = wid; tok < 68; tok += 8) {
                const int row = even_tok_row(w, tok);
                int pos, len;
                if (row >= NCTX) { pos = (row - NCTX) & 4095; len = 4096; } else { pos = row & 255; len = 256; }
                const u32x4 zero4 = {0u, 0u, 0u, 0u};
                const bf16_t* px = P + (size_t)row * LDP0 + 1920 + lane * 8;
                u32x4 xv[4];
                xv[0] = pos >= 2 ? *(const u32x4*)(px - 2 * (size_t)LDP0) : zero4; xv[1] = pos >= 1 ? *(const u32x4*)(px - (size_t)LDP0) : zero4;
                xv[2] = *(const u32x4*)px; xv[3] = pos + 1 < len ? *(const u32x4*)(px + (size_t)LDP0) : zero4;
                const u32x4 gxv = *(const u32x4*)(px + 512);
                float uu[8], gg[8];
#pragma unroll
                for (int i = 0; i < 8; ++i) { float a = cb8[i];
#pragma unroll
                    for (int k = 0; k < 4; ++k) { const unsigned wv = xv[k][i >> 1]; a += cw[k][i] * __uint_as_float((i & 1) ? (wv & 0xffff0000u) : (wv << 16)); }
                    uu[i] = a;
                    const unsigned wg = gxv[i >> 1]; const float gx = __uint_as_float((i & 1) ? (wg & 0xffff0000u) : (wg << 16));
                    gg[i] = 0.5f * gx * (1.0f + ftanh(0.7978845608028654f * (gx + 0.044715f * gx * gx * gx))); }
                u32x4 qu, qg;
#pragma unroll
                for (int i = 0; i < 4; ++i) { qu[i] = pack_bf16(uu[2 * i], uu[2 * i + 1]); qg[i] = pack_bf16(gg[2 * i], gg[2 * i + 1]); }
                *(LAS u32x4*)(ub + tok * LDU + lane * 8) = qu;
                *(u32x4*)((bf16_t*)EARR(E_GATE) + (size_t)row * 512 + lane * 8) = qg;
            }
        }
        __syncthreads();
#pragma unroll 1
        for (int d = 0; d < 2; ++d) {
            {
                bf16x8 bw[4][2]; load_b<2>(WLT + WLT_WB + (size_t)(d * 512 + wid * 64) * 64, bw, lane);
                float w0v[4];
#pragma unroll
                for (int nt = 0; nt < 4; ++nt) w0v[nt] = p.in[I_AW0][d * 512 + wid * 64 + nt * 16 + fr];
#pragma unroll 1
                for (int mt = 0; mt < 5; ++mt) {
                    f32x4 acc[4]; mma_mt<2>(linb + d * 64, LDL, mt, bw, acc, lane);
#pragma unroll
                    for (int r = 0; r < 4; ++r) { const int tok = mt * 16 + fq * 4 + r;
                        if (tok < 68) { float* rec = (float*)sc_rec(SC, d, even_tok_row(w, tok), wid) + fr;
#pragma unroll
                            for (int nt = 0; nt < 4; ++nt) rec[nt * 16] = -0.60653065971263342f * sigm(w0v[nt] + acc[nt][r]);   } }
                }
            }
            {
                bf16x8 bw[4][2]; load_b<2>(WLT + WLT_AB + (size_t)(d * 512 + wid * 64) * 64, bw, lane);
                float a0v[4], kav[4], mukv[4], kkcv[4];
#pragma unroll
                for (int nt = 0; nt < 4; ++nt) { const int n = wid * 64 + nt * 16 + fr; a0v[nt] = p.in[I_AA0][d * 512 + n]; kav[nt] = p.in[I_AKA][n]; mukv[nt] = mu[512 + n]; kkcv[nt] = p.in[I_AKK][n]; }
#pragma unroll 1
                for (int mt = 0; mt < 5; ++mt) {
                    f32x4 acc[4]; mma_mt<2>(linb + 128 + d * 64, LDL, mt, bw, acc, lane);
                    float pkv[4][4], skv[4][4];
#pragma unroll
                    for (int r = 0; r < 4; ++r) { const int tok = mt * 16 + fq * 4 + r, row = even_tok_row(w, tok < 68 ? tok : 0);
#pragma unroll
                        for (int nt = 0; nt < 4; ++nt) { const int n = wid * 64 + nt * 16 + fr, nb = shift_nb(row, n);
                            pkv[r][nt] = bf2f(P[(size_t)row * LDP0 + 512 + n]); skv[r][nt] = nb >= 0 ? bf2f(P[(size_t)nb * LDP0 + 512 + n]) : 0.f; } }
#pragma unroll
                    for (int r = 0; r < 4; ++r) { const int tok = mt * 16 + fq * 4 + r;
                        if (tok < 68) { bf16_t* rec = sc_rec(SC, d, even_tok_row(w, tok), wid) + fr; const float rn = rnorm[tok * 8 + wid];
#pragma unroll
                            for (int nt = 0; nt < 4; ++nt) { const float a = sigm(a0v[nt] + acc[nt][r]);
                                const float zk = pkv[r][nt] + (skv[r][nt] - pkv[r][nt]) * mukv[nt];
                                rec[192 + nt * 16] = f2bf(zk * (1.0f + (a - 1.0f) * kav[nt])); rec[256 + nt * 16] = f2bf(zk * kkcv[nt] * rn * a); } } }
                }
            }
        }
        {
            bf16x8 bw[4][4]; load_b<4>(WLT + WLT_GB + (size_t)(wid * 64) * 128, bw, lane);
            bf16_t* G = (bf16_t*)EARR(E_G);
#pragma unroll 1
            for (int mt = 0; mt < 5; ++mt) {
                f32x4 acc[4]; mma_mt<4>(linb + 256, LDL, mt, bw, acc, lane);
#pragma unroll
                for (int r = 0; r < 4; ++r) { const int tok = mt * 16 + fq * 4 + r;
                    if (tok < 68) { bf16_t* gp = G + (size_t)even_tok_row(w, tok) * 512 + wid * 64 + fr;
#pragma unroll
                        for (int nt = 0; nt < 4; ++nt) gp[nt * 16] = f2bf(acc[nt][r]); } }
            }
        }
#pragma unroll 1
        for (int d = 0; d < 2; ++d) {
            bf16x8 b0[4][2];
            load_b<2>(WLT + WLT_GW + (size_t)(((d * 2 + 0) * 8 + wid) * 64) * 64, b0, lane);
            float gb0[4], gb1[4], spl[4];
#pragma unroll
            for (int nt = 0; nt < 4; ++nt) { const int n = wid * 64 + nt * 16 + fr; gb0[nt] = p.in[I_BGB][(d * 2 + 0) * 512 + n]; gb1[nt] = p.in[I_BGB][(d * 2 + 1) * 512 + n]; spl[nt] = softplusf(-p.in[I_BLAM][d * 512 + n]); }
            float* Ad = EARR(E_A0 + d); float* BXd = EARR(E_BX0 + d);
#pragma unroll 1
            for (int mt = 0; mt < 5; ++mt) {
                f32x4 la[4], acc[4];
                mma_mt<2>(ub + wid * 64, LDU, mt, b0, la, lane);
                { bf16x8 b1[4][2]; load_b<2>(WLT + WLT_GW + (size_t)(((d * 2 + 1) * 8 + wid) * 64) * 64, b1, lane); mma_mt<2>(ub + wid * 64, LDU, mt, b1, acc, lane); }
#pragma unroll
                for (int r = 0; r < 4; ++r) { const int tok = mt * 16 + fq * 4 + r;
                    if (tok < 68) { const size_t o = (size_t)even_tok_row(w, tok) * 512 + wid * 64 + fr;
#pragma unroll
                        for (int nt = 0; nt < 4; ++nt) { const float lg = -8.0f * sigm(gb0[nt] + la[nt][r]) * spl[nt];
                            const float av = fexp(lg); Ad[o + nt * 16] = av; BXd[o + nt * 16] = fsqrt(fmaxf(1.0f - av * av, 0.f)) * sigm(gb1[nt] + acc[nt][r]) * bf2f(ub[tok * LDU + wid * 64 + nt * 16 + fr]);         } } }
            }
        }
        __syncthreads();
        {
            float rk8[8];
#pragma unroll
            for (int i = 0; i < 8; ++i) rk8[i] = p.in[I_ARK][lane * 8 + i];
#pragma unroll 1
            for (int tok = wid; tok < 68; tok += 8) {
                const int row = even_tok_row(w, tok);
                const bf16_t* r0 = sc_rec(SC, 0, row, lane >> 3) + (lane & 7) * 8; const bf16_t* r1 = sc_rec(SC, 1, row, lane >> 3) + (lane & 7) * 8;
                const u32x4 qr = *(const u32x4*)(r0 + 320), q0 = *(const u32x4*)(r0 + 192), q1 = *(const u32x4*)(r1 + 192);
                float sm = 0.f;
#pragma unroll
                for (int i = 0; i < 8; ++i) { const unsigned a = qr[i >> 1], b0 = q0[i >> 1], b1 = q1[i >> 1];
                    const float av = __uint_as_float((i & 1) ? (a & 0xffff0000u) : (a << 16)), b0v = __uint_as_float((i & 1) ? (b0 & 0xffff0000u) : (b0 << 16)), b1v = __uint_as_float((i & 1) ? (b1 & 0xffff0000u) : (b1 << 16));
                    sm += av * (b0v + b1v) * rk8[i]; }
                sm += __int_as_float(__builtin_amdgcn_update_dpp(0, __float_as_int(sm), 0xb1, 0xf, 0xf, false));
                sm += __int_as_float(__builtin_amdgcn_update_dpp(0, __float_as_int(sm), 0x4e, 0xf, 0xf, false));
                sm += __int_as_float(__builtin_amdgcn_update_dpp(0, __float_as_int(sm), 0x141, 0xf, 0xf, false));
                if ((lane & 7) == 0) BC[row * 8 + (lane >> 3)] = sm;
            }
        }
        if (tid < 256) {
            const int d = tid >> 7, c4 = (tid & 127) * 4;
            float* Ad = EARR(E_A0 + d); float* BXd = EARR(E_BX0 + d);
            f32x4 h = {0.f, 0.f, 0.f, 0.f}, cum = {1.f, 1.f, 1.f, 1.f};
#pragma unroll 1
            for (int n0 = 0; n0 < 64; n0 += 8) {
                f32x4 av[8], bv[8];
#pragma unroll
                for (int i = 0; i < 8; ++i) { const int tok = d == 0 ? n0 + i : 63 - n0 - i; const size_t o = (size_t)even_tok_row(w, tok) * 512 + c4; av[i] = *(const f32x4*)(Ad + o); bv[i] = *(const f32x4*)(BXd + o); }
#pragma unroll
                for (int i = 0; i < 8; ++i) { const int tok = d == 0 ? n0 + i : 63 - n0 - i; const size_t o = (size_t)even_tok_row(w, tok) * 512 + c4;
                    h = av[i] * h + bv[i]; cum = cum * av[i]; *(f32x4*)(Ad + o) = cum; *(f32x4*)(BXd + o) = h; }
            }
            { const int cid = (w >> 6) * 128 + 64 + (w & 63); *(f32x4*)(CHA + (size_t)(d * 512 + cid) * 512 + c4) = cum; *(f32x4*)(CHH + (size_t)(d * 512 + cid) * 512 + c4) = h; }
            h = (f32x4){0.f, 0.f, 0.f, 0.f}; cum = (f32x4){1.f, 1.f, 1.f, 1.f};
#pragma unroll
            for (int i = 0; i < 4; ++i) { const int tok = 64 + (d == 0 ? i : 3 - i); const size_t o = (size_t)even_tok_row(w, tok) * 512 + c4;
                const f32x4 a = *(const f32x4*)(Ad + o), bx = *(const f32x4*)(BXd + o); h = a * h + bx; cum = cum * a; *(f32x4*)(Ad + o) = cum; *(f32x4*)(BXd + o) = h; }
            { const int cid = (w >> 6) * 128 + (w & 63); *(f32x4*)(CHA + (size_t)(d * 512 + cid) * 512 + c4) = cum; *(f32x4*)(CHH + (size_t)(d * 512 + cid) * 512 + c4) = h; }
        }
        __syncthreads();
    }
}
__device__ __forceinline__ float vfma(float a, float b, float c) { float d; asm("v_fma_f32 %0, %1, %2, %3" : "=v"(d) : "v"(a), "v"(b), "v"(c)); return d; }
__device__ __forceinline__ float vmul(float a, float b) { float d; asm("v_mul_f32 %0, %1, %2" : "=v"(d) : "v"(a), "v"(b)); return d; }
#define WG_BAR() do { asm volatile("" ::: "memory"); __builtin_amdgcn_s_barrier(); asm volatile("" ::: "memory"); } while (0)
__device__ __forceinline__ int scan_row(int d, int b, int q) {
    if (q < 256) return b * 256 + (d ? 255 - q : q);
    const int s = q - 256; return NCTX + b * 4096 + (d ? 4095 - s : s);
}
__device__ __forceinline__ void ph_fin_even(const Params& p, int bid, int nblk) {
    const int tid = threadIdx.x, wid = tid >> 6, c = tid;
    float* EA = (float*)(p.ws + WS_EARR);
    float* SC = (float*)(p.ws + WS_SC);
    const float* BC = (const float*)(p.ws + WS_BC); const float* CIN = (const float*)(p.ws + WS_CIN);
    bf16_t* Y = (bf16_t*)(p.ws + WS_YMIX);
    const float gg = p.in[I_AGNG][c], gb = p.in[I_AGNB][c];
    for (int r0 = bid * 4; r0 < MROWS; r0 += nblk * 4) {
        float o0[4], o1[4], vv[4], gv[4], bc[4], x0[4], x1[4], a0[4], a1[4], c0[4], c1[4], gt[4];
#pragma unroll
        for (int u = 0; u < 4; ++u) { const int row = r0 + u; const size_t o = (size_t)row * 512 + c;
            const int cid = row < NCTX ? (row >> 8) * 128 + ((row >> 2) & 63) : ((row - NCTX) >> 12) * 128 + 64 + (((row - NCTX) & 4095) >> 6);
            o0[u] = bf2f(((const bf16_t*)EARR(E_O0))[o]); o1[u] = bf2f(((const bf16_t*)EARR(E_O1))[o]); vv[u] = bf2f(sc_rec(SC, 0, row, wid)[384 + (tid & 63)]); gv[u] = bf2f(((const bf16_t*)EARR(E_G))[o]); bc[u] = BC[row * 8 + wid];
            x0[u] = EARR(E_BX0)[o]; x1[u] = EARR(E_BX1)[o]; a0[u] = EARR(E_A0)[o]; a1[u] = EARR(E_A1)[o];
            c0[u] = CIN[(size_t)cid * 512 + c]; c1[u] = CIN[(size_t)(512 + cid) * 512 + c]; gt[u] = bf2f(((const bf16_t*)EARR(E_GATE))[o]); }
#pragma unroll
        for (int u = 0; u < 4; ++u) { const int row = r0 + u;
            const float wkv = o0[u] + o1[u];
            const float mean = wave_sum(wkv) * (1.0f / 64.0f), dv = wkv - mean, var = wave_sum(dv * dv) * (1.0f / 64.0f);
            const float y = (dv * rsqrtf(var + 64e-5f) * gg + gb + bc[u] * vv[u]) * gv[u];
            Y[(size_t)row * 1024 + c] = f2bf(y);
            Y[(size_t)row * 1024 + 512 + c] = f2bf(((x0[u] + a0[u] * c0[u]) + (x1[u] + a1[u] * c1[u])) * gt[u]); }
    }
#undef EARR
}
constexpr int LDT = 72;
__device__ __forceinline__ float quad_sum(float v) {
    v += __int_as_float(__builtin_amdgcn_update_dpp(0, __float_as_int(v), 0xB1, 0xf, 0xf, false));
    v += __int_as_float(__builtin_amdgcn_update_dpp(0, __float_as_int(v), 0x4E, 0xf, 0xf, false));
    return v;
}
template <int PO> __device__ __forceinline__ float quad_bcast(float v) { return __int_as_float(__builtin_amdgcn_update_dpp(0, __float_as_int(v), PO * 0x55, 0xf, 0xf, false)); }
__device__ __forceinline__ bf16x8 ldt8(const LAS bf16_t* T, int row, int col) { return *(const LAS bf16x8*)(T + row * LDT + col); }
__device__ __forceinline__ void ph_r1(const Params& p, LAS unsigned char* lds, int bid, int nblk) {
    const int tid = threadIdx.x, wid = tid >> 6, lane = tid & 63, fr = lane & 15, fq = lane >> 4;
    LAS bf16_t* T0 = (LAS bf16_t*)(lds + LDS_WORK);
#define TL(i) (T0 + (i) * 64 * LDT)
    LAS float* F0 = (LAS float*)(T0 + 11 * 64 * LDT);
    LAS float* F1 = F0 + 4096;
    LAS float* F2 = F1 + 4096;
    LAS float* segt = F2 + 4096;
    LAS float* gl = segt + 512;
    const float* SC = (const float*)(p.ws + WS_SC);
    float* RU = (float*)(p.ws + WS_RU);
    const int k = tid & 63, seg = tid >> 6, t0 = seg * 8;
    const int tr = (wid >> 1) * 16, tc0 = (wid & 1) * 32;
    float kk[8], lw[8], kd[8], ka[8], rr[8], vv[8];
    auto fetch = [&](int unit) {
        const int chain = unit / NRCH, c = unit - chain * NRCH;
        const bf16_t* rec = (const bf16_t*)SC + ((size_t)chain * SCLEN + c * RCH + t0) * SCREC + k;
#pragma unroll
        for (int u = 0; u < 8; ++u) { const bf16_t* r = rec + u * SCREC; lw[u] = ((const float*)(r - k))[k]; kk[u] = bf2f(r[128]); kd[u] = bf2f(r[192]); ka[u] = bf2f(r[256]); rr[u] = bf2f(r[320]); vv[u] = bf2f(r[384]); }
    };
    if (bid < NRUNIT) fetch(bid);
    for (int unit = bid; unit < NRUNIT; unit += nblk) {
        int tid_ = threadIdx.x; asm volatile("" : "+v"(tid_));
        const int tid = tid_, wid = tid >> 6, lane = tid & 63, fr = lane & 15, fq = lane >> 4, k = tid & 63, seg = tid >> 6, t0 = seg * 8, tr = (wid >> 1) * 16, tc0 = (wid & 1) * 32;
        float cum[8]; { float run = 0.f;
#pragma unroll
            for (int u = 0; u < 8; ++u) { run += lw[u]; cum[u] = run; }
            segt[seg * 64 + k] = run; }
        __syncthreads();
        float off = 0.f, tot = 0.f;
#pragma unroll
        for (int s2 = 0; s2 < 8; ++s2) { const float v = segt[s2 * 64 + k]; off += s2 < seg ? v : 0.f; tot += v; }
        if (seg == 0) gl[k] = fexp(tot);
        {
            u32x4 wk, wb, wv; unsigned pk[4], pb[4], pv[4]; float hk = 0.f, hb = 0.f, hv = 0.f;
#pragma unroll
            for (int u = 0; u < 8; ++u) { const int t = t0 + u; const float cu = cum[u] + off;
                const float ginc = fexp(cu), gexc = fexp(cu - lw[u]), ginv = fexp(-cu), gtail = fexp(tot - cu);
                const float kt = kk[u] * gexc;
                TL(0)[t * LDT + k] = f2bf(kt); F0[t * 64 + k] = kt;
                TL(1)[t * LDT + k] = f2bf(kd[u] * ginv); TL(2)[t * LDT + k] = f2bf(ka[u] * ginv); TL(3)[t * LDT + k] = f2bf(rr[u] * ginc);
                const float ktl = kd[u] * gtail, btl = ka[u] * gtail;
                if (u & 1) { pk[u >> 1] = pack_bf16(hk, ktl); pb[u >> 1] = pack_bf16(hb, btl); pv[u >> 1] = pack_bf16(hv, vv[u]); } else { hk = ktl; hb = btl; hv = vv[u]; } }
            wk.x = pk[0]; wk.y = pk[1]; wk.z = pk[2]; wk.w = pk[3]; wb.x = pb[0]; wb.y = pb[1]; wb.z = pb[2]; wb.w = pb[3]; wv.x = pv[0]; wv.y = pv[1]; wv.z = pv[2]; wv.w = pv[3];
            *(LAS u32x4*)(TL(4) + k * LDT + t0) = wk; *(LAS u32x4*)(TL(5) + k * LDT + t0) = wb; *(LAS u32x4*)(TL(6) + k * LDT + t0) = wv;
        }
        if (unit + nblk < NRUNIT) fetch(unit + nblk);
        __syncthreads();
        {
            f32x4 mk[2], mb[2], ak[2], ab[2];
#pragma unroll
            for (int nt = 0; nt < 2; ++nt) { mk[nt] = (f32x4){0.f, 0.f, 0.f, 0.f}; mb[nt] = mk[nt]; ak[nt] = mk[nt]; ab[nt] = mk[nt]; }
#pragma unroll
            for (int ks = 0; ks < 2; ++ks) { const bf16x8 aK = ldt8(TL(0), tr + fr, ks * 32 + fq * 8), aR = ldt8(TL(3), tr + fr, ks * 32 + fq * 8);
#pragma unroll
                for (int nt = 0; nt < 2; ++nt) { const bf16x8 bK = ldt8(TL(1), tc0 + nt * 16 + fr, ks * 32 + fq * 8), bB = ldt8(TL(2), tc0 + nt * 16 + fr, ks * 32 + fq * 8);
                    mk[nt] = __builtin_amdgcn_mfma_f32_16x16x32_bf16(aK, bK, mk[nt], 0, 0, 0); mb[nt] = __builtin_amdgcn_mfma_f32_16x16x32_bf16(aK, bB, mb[nt], 0, 0, 0);
                    ak[nt] = __builtin_amdgcn_mfma_f32_16x16x32_bf16(aR, bK, ak[nt], 0, 0, 0); ab[nt] = __builtin_amdgcn_mfma_f32_16x16x32_bf16(aR, bB, ab[nt], 0, 0, 0); } }
#pragma unroll
            for (int nt = 0; nt < 2; ++nt)
#pragma unroll
                for (int r = 0; r < 4; ++r) { const int t = tr + fq * 4 + r, j = tc0 + nt * 16 + fr;
                    TL(7)[t * LDT + j] = f2bf(j < t ? mk[nt][r] : 0.f); F1[j * 64 + (t & 3) * 16 + (t >> 2)] = j < t ? mb[nt][r] : 0.f;
                    TL(8)[t * LDT + j] = f2bf(j <= t ? ak[nt][r] : 0.f); TL(9)[t * LDT + j] = f2bf(j <= t ? ab[nt][r] : 0.f); }
        }
        __syncthreads();
        {
            f32x4 acc[2] = {(f32x4){0.f, 0.f, 0.f, 0.f}, (f32x4){0.f, 0.f, 0.f, 0.f}};
#pragma unroll
            for (int ks = 0; ks < 2; ++ks) { const bf16x8 a = ldt8(TL(7), tr + fr, ks * 32 + fq * 8);
#pragma unroll
                for (int nt = 0; nt < 2; ++nt) acc[nt] = __builtin_amdgcn_mfma_f32_16x16x32_bf16(a, ldt8(TL(6), tc0 + nt * 16 + fr, ks * 32 + fq * 8), acc[nt], 0, 0, 0); }
#pragma unroll
            for (int nt = 0; nt < 2; ++nt)
#pragma unroll
                for (int r = 0; r < 4; ++r) F2[(tr + fq * 4 + r) * 64 + tc0 + nt * 16 + fr] = acc[nt][r];
        }
        __syncthreads();
        {
            const int col = tid >> 2, part = tid & 3;
            f32x2 acc2[8]; float x[16];
#pragma unroll
            for (int q = 0; q < 16; ++q) { const int t = 4 * q + part; acc2[q >> 1][q & 1] = col < 64 ? F0[t * 64 + col] : F2[t * 64 + col - 64]; x[q] = 0.f; }
#pragma unroll
            for (int t = 0; t < 64; ++t) {
                const int qo = t >> 2, po = t & 3; const float aq = acc2[qo >> 1][qo & 1];
                const float xt = po == 0 ? quad_bcast<0>(aq) : po == 1 ? quad_bcast<1>(aq) : po == 2 ? quad_bcast<2>(aq) : quad_bcast<3>(aq);
                x[qo] = part == po ? xt : x[qo];
                const f32x2 nx = {-xt, -xt};
#pragma unroll
                for (int q4 = qo >> 2; q4 < 4; ++q4) { const f32x4 m = *(const LAS f32x4*)(F1 + t * 64 + part * 16 + q4 * 4);
                    acc2[q4 * 2] = (f32x2){m[0], m[1]} * nx + acc2[q4 * 2]; acc2[q4 * 2 + 1] = (f32x2){m[2], m[3]} * nx + acc2[q4 * 2 + 1]; }
            }
            LAS bf16_t* dstT = col < 64 ? TL(7) + col * LDT : TL(10) + (col - 64) * LDT;
#pragma unroll
            for (int q = 0; q < 16; ++q) dstT[4 * q + part] = f2bf(-x[q]);
        }
        __syncthreads();
        {
            f32x4 rh[2], ol[2], pm[2], qq[2];
#pragma unroll
            for (int nt = 0; nt < 2; ++nt) { rh[nt] = (f32x4){0.f, 0.f, 0.f, 0.f}; ol[nt] = rh[nt]; pm[nt] = rh[nt]; qq[nt] = rh[nt]; }
#pragma unroll
            for (int ks = 0; ks < 2; ++ks) { const int kc = ks * 32 + fq * 8;
                const bf16x8 a7 = ldt8(TL(7), tr + fr, kc), a8 = ldt8(TL(8), tr + fr, kc), a9 = ldt8(TL(9), tr + fr, kc), a6 = ldt8(TL(6), tr + fr, kc), a10 = ldt8(TL(10), tr + fr, kc);
#pragma unroll
                for (int nt = 0; nt < 2; ++nt) { const int br = tc0 + nt * 16 + fr;
                    const bf16x8 b9 = ldt8(TL(9), br, kc), b6 = ldt8(TL(6), br, kc), b10 = ldt8(TL(10), br, kc), b5 = ldt8(TL(5), br, kc), b4 = ldt8(TL(4), br, kc);
                    rh[nt] = __builtin_amdgcn_mfma_f32_16x16x32_bf16(a7, b9, rh[nt], 0, 0, 0);
                    ol[nt] = __builtin_amdgcn_mfma_f32_16x16x32_bf16(a8, b6, ol[nt], 0, 0, 0); ol[nt] = __builtin_amdgcn_mfma_f32_16x16x32_bf16(a9, b10, ol[nt], 0, 0, 0);
                    pm[nt] = __builtin_amdgcn_mfma_f32_16x16x32_bf16(a7, b5, pm[nt], 0, 0, 0);
                    qq[nt] = __builtin_amdgcn_mfma_f32_16x16x32_bf16(a6, b4, qq[nt], 0, 0, 0); qq[nt] = __builtin_amdgcn_mfma_f32_16x16x32_bf16(a10, b5, qq[nt], 0, 0, 0); } }
            float* U = RU + (size_t)unit * 4 * 4096;
#pragma unroll
            for (int nt = 0; nt < 2; ++nt)
#pragma unroll
                for (int r = 0; r < 4; ++r) { const int row = tr + fq * 4 + r, cx = tc0 + nt * 16 + fr; const int o = row * 64 + cx;
                    U[o] = pm[nt][r] + (row == cx ? gl[row] : 0.f);
                    U[4096 + o] = qq[nt][r];
                    U[8192 + o] = rh[nt][r] + bf2f(TL(3)[cx * LDT + row]);
                    U[12288 + o] = ol[nt][r]; }
        }
        __syncthreads();
    }
#undef TL
}
__device__ __forceinline__ void moe_weight_tiles(const Params& p, LAS unsigned char* lds, int first, int stride) {
    const int tid = threadIdx.x; unsigned char* ws = p.ws;
    LAS float* tile = (LAS float*)(lds + LDS_WORK);
    const int j4 = (tid & 31) * 4, i0 = tid >> 5;
    auto decode = [&](int tt, const float*& src, int& ld, int& k0, int& n0, int& w1map, bf16_t*& dst) {
        if (tt < 8192) { const int mat = tt >> 7, r = tt & 127; k0 = (r >> 4) * 128; n0 = (r & 15) * 128; src = p.in[I_W1] + (size_t)mat * 1024 * 2048; ld = 2048; dst = (bf16_t*)(ws + WS_W1T) + (size_t)mat * 2048 * 1024; w1map = 1; }
        else { tt -= 8192; const int mat = tt >> 6, r = tt & 63; k0 = (r >> 3) * 128; n0 = (r & 7) * 128; src = p.in[I_W2] + (size_t)mat * 1024 * 1024; ld = 1024; dst = (bf16_t*)(ws + WS_W2T) + (size_t)mat * 1024 * 1024; w1map = 0; }
    };
    f32x4 v[8];
    if (first < 12288) { const float* src; int ld, k0, n0, w1; bf16_t* dst; decode(first, src, ld, k0, n0, w1, dst);
#pragma unroll
        for (int r = 0; r < 8; ++r) v[r] = __builtin_nontemporal_load((const f32x4*)(src + (size_t)(k0 + i0 + 16 * r) * ld + n0 + j4)); }
    for (int t = first; t < 12288; t += stride) {
        const float* src; int ld, k0, n0, w1map; bf16_t* dst; decode(t, src, ld, k0, n0, w1map, dst);
#pragma unroll
        for (int r = 0; r < 8; ++r) { LAS float* tp = tile + (i0 + 16 * r) * 129 + j4; tp[0] = v[r][0]; tp[1] = v[r][1]; tp[2] = v[r][2]; tp[3] = v[r][3]; }
        __syncthreads();
        if (t + stride < 12288) { const float* s2; int ld2, k2, n2, w2; bf16_t* d2; decode(t + stride, s2, ld2, k2, n2, w2, d2);
#pragma unroll
            for (int r = 0; r < 8; ++r) v[r] = __builtin_nontemporal_load((const f32x4*)(s2 + (size_t)(k2 + i0 + 16 * r) * ld2 + n2 + j4)); }
        { const int ip = (tid & 15) * 8, j0 = tid >> 4;
            const int rho0 = w1map ? ((((n0 & 1023) >> 7) << 8) + ((n0 >> 10) << 7)) : n0;
#pragma unroll
            for (int r = 0; r < 4; ++r) { const int j = j0 + 32 * r;
                u32x4 w; w.x = pack_bf16(tile[ip * 129 + j], tile[(ip + 1) * 129 + j]); w.y = pack_bf16(tile[(ip + 2) * 129 + j], tile[(ip + 3) * 129 + j]);
                w.z = pack_bf16(tile[(ip + 4) * 129 + j], tile[(ip + 5) * 129 + j]); w.w = pack_bf16(tile[(ip + 6) * 129 + j], tile[(ip + 7) * 129 + j]);
                const int rho = rho0 + j, kk8 = k0 + ip; *(u32x4*)(dst + ((size_t)((rho >> 8) * 16 + (kk8 >> 6)) * 256 + (rho & 255)) * 64 + (kk8 & 63)) = w; } }
        __syncthreads();
    }
}
__device__ __forceinline__ void ph_r2(const Params& p, LAS unsigned char* lds, int bid, int nblk) {
    const int tid = threadIdx.x, wid = tid >> 6, lane = tid & 63, fr = lane & 15, g = lane >> 4;
    const int nchainwg = nblk >= 128 ? 64 : 0;
    if (bid >= nchainwg) {
        const int nconv = nblk - nchainwg, cb = bid - nchainwg;
        if (tid < 256) {
            const float* CHA = (const float*)(p.ws + WS_CHA); const float* CHH = (const float*)(p.ws + WS_CHH); float* CIN = (float*)(p.ws + WS_CIN);
            for (int item = cb; item < 16; item += nconv) {
                const int gi = item * 256 + tid, d = gi >> 11, b = (gi >> 9) & 3, c = gi & 511;
                float carry = 0.f;
                for (int s0 = 0; s0 < 128; s0 += 16) {
                    float av[16], hv[16];
#pragma unroll
                    for (int q = 0; q < 16; ++q) { const int st = s0 + q; const int cl = d == 0 ? st : (st < 64 ? 63 - st : 191 - st);
                        const size_t o = (size_t)(d * 512 + b * 128 + cl) * 512 + c; av[q] = CHA[o]; hv[q] = CHH[o]; }
#pragma unroll
                    for (int q = 0; q < 16; ++q) { const int st = s0 + q; const int cl = d == 0 ? st : (st < 64 ? 63 - st : 191 - st);
                        CIN[(size_t)(d * 512 + b * 128 + cl) * 512 + c] = carry; carry = av[q] * carry + hv[q]; }
                }
            }
        }
        __syncthreads();
        moe_weight_tiles(p, lds, cb, nconv);
        if (nchainwg) return;
    }
    LAS float* ring = (LAS float*)(lds + LDS_WORK);
    const float* RU = (const float*)(p.ws + WS_RU);
    float* EA = (float*)(p.ws + WS_EARR);
    for (int chain = nchainwg ? bid : bid; chain < 64; chain += (nchainwg ? 64 : nblk)) {
        const int d = chain >> 5, b = (chain >> 3) & 3, h = chain & 7;
        bf16_t* Od = (bf16_t*)(EA + (size_t)(E_O0 + d) * ((size_t)MROWS * 512));
        auto issue = [&](int c) {
            const float* src = RU + ((size_t)chain * NRCH + c) * 4 * 4096; LAS float* dst = ring + (c & 1) * 4 * 4096;
#pragma unroll
            for (int i = 0; i < 16; ++i) { const int slot = ((wid - 4) * 16 + i) * 64;
                __builtin_amdgcn_global_load_lds((const unsigned*)(src + (size_t)(slot + lane) * 4), (LAS unsigned*)(dst + slot * 4), 16, 0, 0); }
        };
        if (tid >= 256) { issue(0); asm volatile("s_waitcnt vmcnt(0)" ::: "memory"); }
        asm volatile("" ::: "memory"); __builtin_amdgcn_s_barrier(); asm volatile("" ::: "memory");
        f32x4 S[4];
#pragma unroll
        for (int m = 0; m < 4; ++m) S[m] = (f32x4){0.f, 0.f, 0.f, 0.f};
        const int v0 = wid * 16;
        for (int c = 0; c < NRCH; ++c) {
            if (tid >= 256) { if (c + 1 < NRCH) issue(c + 1); asm volatile("s_waitcnt vmcnt(0)" ::: "memory"); }
            else {
                const LAS float* PM = ring + (c & 1) * 4 * 4096; const LAS float* QQ = PM + 4096; const LAS float* RHT = PM + 8192; const LAS float* OL = PM + 12288;
                f32x4 acc[4], Sn[4];
#pragma unroll
                for (int tt = 0; tt < 4; ++tt) {
#pragma unroll
                    for (int i = 0; i < 4; ++i) acc[tt][i] = OL[(16 * tt + 4 * g + i) * 64 + v0 + fr];
                    Sn[tt] = *(const LAS f32x4*)(QQ + (v0 + fr) * 64 + 16 * tt + 4 * g); }
                float A[3][4];
#pragma unroll
                for (int s0 = 0; s0 < 2; ++s0) { const LAS float* ar = RHT + (16 * (s0 >> 2) + 4 * g + (s0 & 3)) * 64 + fr;
#pragma unroll
                    for (int u = 0; u < 4; ++u) A[s0][u] = ar[16 * u]; }
#pragma unroll
                for (int st = 0; st < 32; ++st) {
                    if (st + 2 < 32) { const int s2 = st + 2, mi = s2 & 15; const LAS float* ar = (s2 < 16 ? RHT : PM) + (16 * (mi >> 2) + 4 * g + (mi & 3)) * 64 + fr;
#pragma unroll
                        for (int u = 0; u < 4; ++u) A[s2 % 3][u] = ar[16 * u]; }
                    __builtin_amdgcn_sched_barrier(0);
                    const int mi = st & 15; const float bq = S[mi >> 2][mi & 3];
                    if (st < 16) {
#pragma unroll
                        for (int u = 0; u < 4; ++u) acc[u] = __builtin_amdgcn_mfma_f32_16x16x4f32(A[st % 3][u], bq, acc[u], 0, 0, 0);
                    } else {
#pragma unroll
                        for (int u = 0; u < 4; ++u) Sn[u] = __builtin_amdgcn_mfma_f32_16x16x4f32(A[st % 3][u], bq, Sn[u], 0, 0, 0);
                    }
                }
#pragma unroll
                for (int tt = 0; tt < 4; ++tt)
#pragma unroll
                    for (int i = 0; i < 4; ++i) { const int row = scan_row(d, b, c * RCH + 16 * tt + 4 * g + i); Od[(size_t)row * 512 + h * 64 + v0 + fr] = f2bf(acc[tt][i]); }
#pragma unroll
                for (int m = 0; m < 4; ++m) S[m] = Sn[m];
                asm volatile("s_waitcnt lgkmcnt(0)" ::: "memory");
            }
            asm volatile("" ::: "memory"); __builtin_amdgcn_s_barrier(); asm volatile("" ::: "memory");
        }
    }
}
__device__ __forceinline__ float half_max(float v, int lane) {
    const int ninf = 0xff800000;
    v = fmaxf(v, __int_as_float(__builtin_amdgcn_update_dpp(ninf, __float_as_int(v), 0x121, 0xf, 0xf, false)));
    v = fmaxf(v, __int_as_float(__builtin_amdgcn_update_dpp(ninf, __float_as_int(v), 0x122, 0xf, 0xf, false)));
    v = fmaxf(v, __int_as_float(__builtin_amdgcn_update_dpp(ninf, __float_as_int(v), 0x124, 0xf, 0xf, false)));
    v = fmaxf(v, __int_as_float(__builtin_amdgcn_update_dpp(ninf, __float_as_int(v), 0x128, 0xf, 0xf, false)));
    v = fmaxf(v, __int_as_float(__builtin_amdgcn_update_dpp(ninf, __float_as_int(v), 0x142, 0xa, 0xf, false)));
    const float lo = __int_as_float(__builtin_amdgcn_readlane(__float_as_int(v), 31)), hi = __int_as_float(__builtin_amdgcn_readlane(__float_as_int(v), 63));
    return (lane & 32) ? hi : lo;
}
__device__ __forceinline__ int half_min_i(int v, int lane) {
    const int big = 0x7fffffff;
    v = min(v, __builtin_amdgcn_update_dpp(big, v, 0x121, 0xf, 0xf, false));
    v = min(v, __builtin_amdgcn_update_dpp(big, v, 0x122, 0xf, 0xf, false));
    v = min(v, __builtin_amdgcn_update_dpp(big, v, 0x124, 0xf, 0xf, false));
    v = min(v, __builtin_amdgcn_update_dpp(big, v, 0x128, 0xf, 0xf, false));
    v = min(v, __builtin_amdgcn_update_dpp(big, v, 0x142, 0xa, 0xf, false));
    const int lo = __builtin_amdgcn_readlane(v, 31), hi = __builtin_amdgcn_readlane(v, 63);
    return (lane & 32) ? hi : lo;
}
template <int LAYER>
__device__ __forceinline__ void ph_ln1(const Params& p, LAS unsigned char* lds, int bid, int nblk) {
    const int tid = threadIdx.x, wid = tid >> 6, lane = tid & 63, fr = lane & 15, fq = lane >> 4;
    LAS float* vb = (LAS float*)(lds + LDS_WORK);
    LAS float* part = vb + 16 * 1028;
    LAS int* lcnt = (LAS int*)(part + 8 * 16 * 32);
    float rwf[2][32];
    { const float* rw = p.in[I_RW] + (size_t)LAYER * 32768 + (size_t)(128 * wid + 32 * fq) * 32 + fr;
#pragma unroll
        for (int s2 = 0; s2 < 32; ++s2) { rwf[0][s2] = rw[s2 * 32]; rwf[1][s2] = rw[s2 * 32 + 16]; } }
    if (tid < 32) lcnt[tid] = 0;
    __syncthreads();
    const float* MOD = (const float*)(p.ws + WS_MOD);
    bf16_t* XS = (bf16_t*)(p.ws + WS_XS); const bf16_t* YP = (const bf16_t*)(p.ws + WS_YP); bf16_t* H = (bf16_t*)(p.ws + WS_H);
    int* TOPE = (int*)(p.ws + WS_TOPE); float* TOPW = (float*)(p.ws + WS_TOPW); int* TOPS = (int*)(p.ws + WS_TOPS);
    int* CNTB = (int*)(p.ws + WS_CNTB) + (size_t)(LAYER * 512 + bid) * 32;
    const float* lng = p.in[I_LNG] + (LAYER * 2 + 0) * 1024; const float* lnb = p.in[I_LNB] + (LAYER * 2 + 0) * 1024;
    const int rstride = nblk * 8, rbase = (LAYER == 0 ? 0 : NCTX) + bid * 8;
    f32x4 nres[4], ngate[4]; u32x2 nyp[4];
    auto fetch = [&](int row) {
        const float* res = row < NCTX ? p.in[I_CTX] + (size_t)row * 1024 : p.in[I_X] + (size_t)(row - NCTX) * 1024;
        const float* md = MOD + (size_t)(LAYER * 5 + row_modr(row)) * 6144;
#pragma unroll
        for (int q = 0; q < 4; ++q) { const int col = q * 256 + lane * 4; nres[q] = LAYER == 0 ? *(const f32x4*)(res + col) : ld_bf16x4(XS + (size_t)row * 1024 + col);
            ngate[q] = *(const f32x4*)(md + 2048 + col); nyp[q] = *(const u32x2*)(YP + (size_t)row * 1024 + col); }
    };
    if (rbase < MROWS) fetch(rbase + wid);
#pragma unroll 1
    for (int j0 = 0; rbase + j0 * rstride < MROWS; j0 += 2) {
#pragma unroll 1
        for (int jj = 0; jj < 2; ++jj) {
            const int row = rbase + wid + (j0 + jj) * rstride;
            if (row >= MROWS) break;
            const float* md = MOD + (size_t)(LAYER * 5 + row_modr(row)) * 6144;
            f32x4 v[4], msc[4], msh[4]; float s = 0.f;
#pragma unroll
            for (int q = 0; q < 4; ++q) { const u32x2 w = nyp[q];
                const f32x4 y = (f32x4){__uint_as_float(w.x << 16), __uint_as_float(w.x & 0xffff0000u), __uint_as_float(w.y << 16), __uint_as_float(w.y & 0xffff0000u)};
                v[q] = nres[q] * DN_ALPHA + ngate[q] * y;
                s += (v[q][0] + v[q][1]) + (v[q][2] + v[q][3]); }
#pragma unroll
            for (int q = 0; q < 4; ++q) { const int col = q * 256 + lane * 4; msc[q] = *(const f32x4*)(md + 4096 + col); msh[q] = *(const f32x4*)(md + 3072 + col); }
            if (row + rstride < MROWS) fetch(row + rstride);
            const float mean = wave_sum(s) * (1.0f / 1024.0f);
            float ss = 0.f;
#pragma unroll
            for (int q = 0; q < 4; ++q) { v[q] = v[q] - mean; ss += (v[q][0] * v[q][0] + v[q][1] * v[q][1]) + (v[q][2] * v[q][2] + v[q][3] * v[q][3]); }
            const float rstd = rsqrtf(wave_sum(ss) * (1.0f / 1024.0f) + LN_EPS);
#pragma unroll
            for (int q = 0; q < 4; ++q) { const int col = q * 256 + lane * 4;
                const f32x4 xn = v[q] * rstd * *(const f32x4*)(lng + col) + *(const f32x4*)(lnb + col);
                { u32x2 wx; wx.x = pack_bf16(xn[0], xn[1]); wx.y = pack_bf16(xn[2], xn[3]); *(u32x2*)(XS + (size_t)row * 1024 + col) = wx; }
                v[q] = xn * (msc[q] + 1.0f) + msh[q];
                u32x2 w; w.x = pack_bf16(v[q][0], v[q][1]); w.y = pack_bf16(v[q][2], v[q][3]);
                *(u32x2*)(H + (size_t)row * 1024 + col) = w;
                *(LAS f32x4*)(vb + (wid + 8 * jj) * 1028 + col) = v[q]; }
        }
        __syncthreads();
        {
            const LAS float* ar = vb + fr * 1028 + 128 * wid + 32 * fq;
            f32x4 acc0 = {0.f, 0.f, 0.f, 0.f}, acc1 = {0.f, 0.f, 0.f, 0.f};
#pragma unroll
            for (int h = 0; h < 2; ++h) { f32x4 va[4];
#pragma unroll
                for (int u = 0; u < 4; ++u) va[u] = *(const LAS f32x4*)(ar + h * 16 + u * 4);
#pragma unroll
                for (int u = 0; u < 4; ++u)
#pragma unroll
                    for (int i = 0; i < 4; ++i) { acc0 = __builtin_amdgcn_mfma_f32_16x16x4f32(va[u][i], rwf[0][h * 16 + u * 4 + i], acc0, 0, 0, 0);
                        acc1 = __builtin_amdgcn_mfma_f32_16x16x4f32(va[u][i], rwf[1][h * 16 + u * 4 + i], acc1, 0, 0, 0); } }
            LAS float* pw = part + wid * 512 + (4 * fq) * 32 + fr;
#pragma unroll
            for (int i = 0; i < 4; ++i) { pw[i * 32] = acc0[i]; pw[i * 32 + 16] = acc1[i]; }
        }
        __syncthreads();
        {
            const int e = lane & 31, lr = 2 * wid + (lane >> 5), row = rbase + (lr & 7) + (j0 + (lr >> 3)) * rstride;
            float lg = p.in[I_RB][LAYER * 32 + e];
#pragma unroll
            for (int w2 = 0; w2 < 8; ++w2) lg += part[w2 * 512 + lr * 32 + e];
            float tv[4]; int te[4];
#pragma unroll
            for (int k = 0; k < 4; ++k) { const float bv = half_max(lg, lane); const int bi = half_min_i(lg == bv ? e : 99, lane);
                tv[k] = bv; te[k] = bi & 31; lg = e == bi ? -3.0e38f : lg; }
            const float e1 = expf(tv[1] - tv[0]), e2 = expf(tv[2] - tv[0]), e3 = expf(tv[3] - tv[0]), inv = 1.0f / (1.0f + e1 + e2 + e3);
            if (e == 0 && row < MROWS) {
                const float wv[4] = {inv, e1 * inv, e2 * inv, e3 * inv};
#pragma unroll
                for (int k = 0; k < 4; ++k) { const int slot = __hip_atomic_fetch_add(lcnt + te[k], 1, __ATOMIC_RELAXED, __HIP_MEMORY_SCOPE_WORKGROUP); TOPE[row * 4 + k] = te[k]; TOPW[row * 4 + k] = wv[k]; TOPS[row * 4 + k] = slot; }
            }
        }
    }
    __syncthreads();
    if (tid < 32) CNTB[tid] = lcnt[tid];
}
constexpr int LDS_TAB = LDS_WORK + 131072;
__device__ __forceinline__ int moe_tables(const int* cntb, int nblk, LAS int* tab, LAS int* bb) {
    const int tid = threadIdx.x, e = tid & 31, seg = tid >> 5, per = (nblk + 15) >> 4;
    const int b0 = seg * per, b1 = (b0 + per) < nblk ? (b0 + per) : nblk;
    int s = 0;
    if (per <= 16) {
        int cv[16];
#pragma unroll
        for (int u = 0; u < 16; ++u) cv[u] = (b0 + u) < b1 ? cntb[(b0 + u) * 32 + e] : 0;
#pragma unroll
        for (int u = 0; u < 16; ++u) s += cv[u];
        tab[512 + seg * 32 + e] = s;
        __syncthreads();
        if (tid < 32) { int run = 0; for (int sg = 0; sg < 16; ++sg) { const int v = tab[512 + sg * 32 + tid]; tab[512 + sg * 32 + tid] = run; run += v; } tab[448 + tid] = run; }
        __syncthreads();
        if (bb) { int run = tab[512 + seg * 32 + e];
#pragma unroll
            for (int u = 0; u < 16; ++u) if ((b0 + u) < b1) { bb[(b0 + u) * 32 + e] = run; run += cv[u]; } }
    } else {
        for (int b = b0; b < b1; ++b) s += cntb[b * 32 + e];
        tab[512 + seg * 32 + e] = s;
        __syncthreads();
        if (tid < 32) { int run = 0; for (int sg = 0; sg < 16; ++sg) { const int v = tab[512 + sg * 32 + tid]; tab[512 + sg * 32 + tid] = run; run += v; } tab[448 + tid] = run; }
        __syncthreads();
        if (bb) { int run = tab[512 + seg * 32 + e]; for (int b = b0; b < b1; ++b) { bb[b * 32 + e] = run; run += cntb[b * 32 + e]; } }
    }
    if (tid < 64) {
        const int x = tid & 31, n = (tab[448 + x] + 255) >> 8; int inc = n;
#pragma unroll
        for (int o = 1; o < 32; o <<= 1) { const int t = __shfl_up(inc, o, 64); if ((tid & 31) >= o) inc += t; }
        if (tid < 32) { const int t0 = inc - n; tab[x] = t0 * 256; for (int i = 0; i < n; ++i) tab[64 + t0 + i] = x; if (x == 31) { tab[32] = inc * 256; tab[40] = inc; } }
    }
    __syncthreads();
    return tab[40];
}
template <int LAYER>
__device__ __forceinline__ void ph_moe_gather(const Params& p, LAS unsigned char* lds, int bid, int nblk) {
    const int tid = threadIdx.x;
    LAS int* tab = (LAS int*)(lds + LDS_TAB); LAS int* bb = (LAS int*)(lds + LDS_WORK);
    (void)moe_tables((const int*)(p.ws + WS_CNTB) + (size_t)LAYER * 512 * 32, nblk, tab, bb);
    const int* TOPE = (const int*)(p.ws + WS_TOPE); const int* TOPS = (const int*)(p.ws + WS_TOPS); int* POS = (int*)(p.ws + WS_POS); int* IDX = (int*)(p.ws + WS_IDX);
    constexpr int R0 = LAYER == 0 ? 0 : NCTX;
    for (int i = R0 * 4 + bid * NTHR + tid; i < MROWS * 4; i += nblk * NTHR) {
        const int row = i >> 2, e = TOPE[i], pos = tab[e] + bb[((((row - R0) >> 3) % nblk) << 5) + e] + TOPS[i];
        POS[i] = pos; IDX[pos] = row;
    }
    for (int e = bid; e < 32; e += nblk) {
        const int cnt = tab[448 + e], beg = tab[e] + cnt, end = tab[e] + ((cnt + 255) & ~255);
        for (int q = beg + tid; q < end; q += NTHR) IDX[q] = R0;
    }
}
template <int LAYER>
__device__ __forceinline__ void ph_moe_gemm1(const Params& p, LAS unsigned char* lds, int bid, int nblk) {
    LAS int* tab = (LAS int*)(lds + LDS_TAB);
    const int T = moe_tables((const int*)(p.ws + WS_CNTB) + (size_t)LAYER * 512 * 32, nblk, tab, (LAS int*)nullptr);
    pg8::Gemm g{(const bf16_t*)(p.ws + WS_H), (const bf16_t*)(p.ws + WS_W1T) + (size_t)LAYER * 32 * 2048 * 1024, 0, 0, 1024, (const int*)(p.ws + WS_IDX)};
    pg8::EpiAct E{(bf16_t*)(p.ws + WS_ACT), p.in[I_B1] + (size_t)LAYER * 32 * 2048};
    pg8::SchedMoe<8> S{T, nblk, bid, tab + 64};
    pg8::gemm_phase<pg8::EpiAct, pg8::SchedMoe<8>, false, false, true, true>(lds + LDS_WORK, g, S, E, nullptr);
}
template <int LAYER>
__device__ __forceinline__ void ph_moe_gemm2(const Params& p, LAS unsigned char* lds, int bid, int nblk) {
    LAS int* tab = (LAS int*)(lds + LDS_TAB);
    const int T = moe_tables((const int*)(p.ws + WS_CNTB) + (size_t)LAYER * 512 * 32, nblk, tab, (LAS int*)nullptr);
    pg8::Gemm g{(const bf16_t*)(p.ws + WS_ACT), (const bf16_t*)(p.ws + WS_W2T) + (size_t)LAYER * 32 * 1024 * 1024, 0, 0, 1024};
    pg8::EpiYE E{(bf16_t*)(p.ws + WS_YE), p.in[I_B2] + (size_t)LAYER * 32 * 1024};
    { pg8::SchedMoe<4, 1> S{T, nblk, bid, tab + 64}; pg8::gemm_phase<pg8::EpiYE, pg8::SchedMoe<4, 1>, false, true, true>(lds + LDS_WORK, g, S, E, nullptr); }
    { pg8::SchedMoe<4, 2> S{T, nblk, bid, tab + 64}; pg8::gemm_phase<pg8::EpiYE, pg8::SchedMoe<4, 2>, false, true, true, false, true>(lds + LDS_WORK, g, S, E, nullptr); }
}
template <int NN>
__device__ __forceinline__ void ph_gemm_dense(LAS unsigned char* lds, const bf16_t* A, const bf16_t* Bt, bf16_t* C, int ldc, int pm0, int nM, int bid, int nblk) {
    pg8::Gemm g{A, Bt, 0, 0, 1024};
    pg8::EpiStore E{C, ldc};
    { pg8::SchedDense<NN, 1> S{nM, pm0, nblk, bid}; pg8::gemm_phase<pg8::EpiStore, pg8::SchedDense<NN, 1>, false>(lds + LDS_WORK, g, S, E, nullptr); }
    { pg8::SchedDense<NN, 2> S{nM, pm0, nblk, bid}; pg8::gemm_phase<pg8::EpiStore, pg8::SchedDense<NN, 2>, false, false, false, false, true>(lds + LDS_WORK, g, S, E, nullptr); }
}
template <int LAYER>
__device__ __forceinline__ void ph_ln2(const Params& p, LAS unsigned char* lds, int bid, int nblk) {
    const int tid = threadIdx.x, wid = tid >> 6, lane = tid & 63, fr = lane & 15, fq = lane >> 4;
    LAS float* vb = (LAS float*)(lds + LDS_WORK);
    LAS float* part = vb + 16 * 1028;
    float wgf[32];
    if (LAYER == 0) { const float* wg = p.in[I_OWIN] + (size_t)(128 * wid + 32 * fq) * ODD_IN + 4096 + fr;
#pragma unroll
        for (int s2 = 0; s2 < 32; ++s2) wgf[s2] = wg[(size_t)s2 * ODD_IN]; }
    const float* MOD = (const float*)(p.ws + WS_MOD);
    bf16_t* XS = (bf16_t*)(p.ws + WS_XS); const bf16_t* YE = (const bf16_t*)(p.ws + WS_YE); bf16_t* H = (bf16_t*)(p.ws + WS_H); float* GT = (float*)(p.ws + WS_GT);
    const float* TOPW = (const float*)(p.ws + WS_TOPW); const int* POS = (const int*)(p.ws + WS_POS);
    const float* lng = p.in[I_LNG] + (LAYER * 2 + 1) * 1024; const float* lnb = p.in[I_LNB] + (LAYER * 2 + 1) * 1024;
    const int rstride = nblk * 8, rbase = (LAYER == 0 ? 0 : NCTX) + bid * 8, rfirst = rbase + wid;
    f32x4 nw = {0.f, 0.f, 0.f, 0.f}; int np0 = 0, np1 = 0, np2 = 0, np3 = 0;
    if (rfirst < MROWS) { nw = *(const f32x4*)(TOPW + rfirst * 4); np0 = POS[rfirst * 4]; np1 = POS[rfirst * 4 + 1]; np2 = POS[rfirst * 4 + 2]; np3 = POS[rfirst * 4 + 3]; }
    auto do_row = [&](int row, int jj) {
        const float* md = MOD + (size_t)(LAYER * 5 + row_modr(row)) * 6144;
        const float w0 = nw[0], w1 = nw[1], w2 = nw[2], w3 = nw[3];
        const bf16_t* y0 = YE + (size_t)np0 * 1024; const bf16_t* y1 = YE + (size_t)np1 * 1024;
        const bf16_t* y2 = YE + (size_t)np2 * 1024; const bf16_t* y3 = YE + (size_t)np3 * 1024;
        if (row + rstride < MROWS) { const int rn = row + rstride; nw = *(const f32x4*)(TOPW + rn * 4); np0 = POS[rn * 4]; np1 = POS[rn * 4 + 1]; np2 = POS[rn * 4 + 2]; np3 = POS[rn * 4 + 3]; }
        f32x4 v[4]; float s = 0.f;
#pragma unroll
        for (int q = 0; q < 4; ++q) { const int col = q * 256 + lane * 4;
            const f32x4 ffn = (ld_bf16x4(y0 + col) * w0 + ld_bf16x4(y1 + col) * w1) + (ld_bf16x4(y2 + col) * w2 + ld_bf16x4(y3 + col) * w3);
            v[q] = ld_bf16x4(XS + (size_t)row * 1024 + col) * DN_ALPHA + *(const f32x4*)(md + 5120 + col) * ffn;
            s += (v[q][0] + v[q][1]) + (v[q][2] + v[q][3]); }
        const float mean = wave_sum(s) * (1.0f / 1024.0f);
        float ss = 0.f;
#pragma unroll
        for (int q = 0; q < 4; ++q) { v[q] = v[q] - mean; ss += (v[q][0] * v[q][0] + v[q][1] * v[q][1]) + (v[q][2] * v[q][2] + v[q][3] * v[q][3]); }
        const float rstd = rsqrtf(wave_sum(ss) * (1.0f / 1024.0f) + LN_EPS);
        if (LAYER == 1) {
#pragma unroll
            for (int q = 0; q < 4; ++q) { const int col = q * 256 + lane * 4;
                *(f32x4*)(p.out + (size_t)(row - NCTX) * 1024 + col) = v[q] * rstd * *(const f32x4*)(lng + col) + *(const f32x4*)(lnb + col); }
        } else {
            const float* md1 = MOD + (size_t)(5 + row_modr(row)) * 6144;
#pragma unroll
            for (int q = 0; q < 4; ++q) { const int col = q * 256 + lane * 4;
                const f32x4 xn = v[q] * rstd * *(const f32x4*)(lng + col) + *(const f32x4*)(lnb + col);
                { u32x2 wx; wx.x = pack_bf16(xn[0], xn[1]); wx.y = pack_bf16(xn[2], xn[3]); *(u32x2*)(XS + (size_t)row * 1024 + col) = wx; }
                v[q] = xn * (*(const f32x4*)(md1 + 1024 + col) + 1.0f) + *(const f32x4*)(md1 + col);
                u32x2 w; w.x = pack_bf16(v[q][0], v[q][1]); w.y = pack_bf16(v[q][2], v[q][3]);
                *(u32x2*)(H + (size_t)row * 1024 + col) = w;
                *(LAS f32x4*)(vb + (wid + 8 * jj) * 1028 + col) = v[q]; }
        }
    };
    if (LAYER == 1) {
#pragma unroll 1
        for (int row = rfirst; row < MROWS; row += rstride) do_row(row, 0);
    } else {
#pragma unroll 1
        for (int j0 = 0; rbase + j0 * rstride < MROWS; j0 += 2) {
#pragma unroll 1
            for (int jj = 0; jj < 2; ++jj) { const int row = rfirst + (j0 + jj) * rstride; if (row >= MROWS) break; do_row(row, jj); }
            __syncthreads();
            {
                const LAS float* ar = vb + fr * 1028 + 128 * wid + 32 * fq;
                f32x4 acc = {0.f, 0.f, 0.f, 0.f};
#pragma unroll
                for (int h = 0; h < 2; ++h) { f32x4 va[4];
#pragma unroll
                    for (int u = 0; u < 4; ++u) va[u] = *(const LAS f32x4*)(ar + h * 16 + u * 4);
#pragma unroll
                    for (int u = 0; u < 4; ++u)
#pragma unroll
                        for (int i = 0; i < 4; ++i) acc = __builtin_amdgcn_mfma_f32_16x16x4f32(va[u][i], wgf[h * 16 + u * 4 + i], acc, 0, 0, 0); }
                LAS float* pw = part + wid * 256 + (4 * fq) * 16 + fr;
#pragma unroll
                for (int i = 0; i < 4; ++i) pw[i * 16] = acc[i];
            }
            __syncthreads();
            if (tid < 256) { const int lr = tid >> 4, row = rbase + (lr & 7) + (j0 + (lr >> 3)) * rstride;
                float a = 0.f;
#pragma unroll
                for (int w2 = 0; w2 < 8; ++w2) a += part[w2 * 256 + tid];
                if (row < MROWS) GT[row * 16 + (tid & 15)] = a; }
        }
    }
}
constexpr int LDK = 136;
__device__ __forceinline__ int sid_of(int mixer, int dir, int b, int ch, int h) { return (((mixer * 2 + dir) * 4 + b) * NCHUNK + ch) * 4 + h; }
__device__ __forceinline__ void unit_decode(int u, int& mixer, int& h, int& ch, int& b, int& row0) {
    mixer = u & 1; h = (u >> 1) & 3; const int rest = u >> 3; ch = rest % NCHUNK; b = rest / NCHUNK;
    row0 = ch < 2 ? b * 256 + ch * 128 : NCTX + b * 4096 + (ch - 2) * 128;
}
__device__ __forceinline__ void ld_raw(const bf16_t* P, int row0, int col, u32x2 (&raw)[8]) {
    const int t = threadIdx.x, i = t >> 2, part = t & 3, i0 = (part & 1) * 32 + (part >> 1) * 16;
    const bf16_t* src = P + (size_t)(row0 + i) * LDP1 + col + i0;
#pragma unroll
    for (int q = 0; q < 4; ++q) { raw[q] = *(const u32x2*)(src + q * 4); raw[4 + q] = *(const u32x2*)(src + 64 + q * 4); }
}
__device__ __forceinline__ void cvt_rows(const u32x2 (&raw)[8], bool rope, int s0, const float* ROPE, float (&lo)[16], float (&hi)[16]) {
    const int t = threadIdx.x, i = t >> 2, part = t & 3, pr = part & 1, hf = part >> 1;
#pragma unroll
    for (int q = 0; q < 4; ++q) {
        lo[q * 4] = __uint_as_float(raw[q].x << 16); lo[q * 4 + 1] = __uint_as_float(raw[q].x & 0xffff0000u); lo[q * 4 + 2] = __uint_as_float(raw[q].y << 16); lo[q * 4 + 3] = __uint_as_float(raw[q].y & 0xffff0000u);
        hi[q * 4] = __uint_as_float(raw[4 + q].x << 16); hi[q * 4 + 1] = __uint_as_float(raw[4 + q].x & 0xffff0000u); hi[q * 4 + 2] = __uint_as_float(raw[4 + q].y << 16); hi[q * 4 + 3] = __uint_as_float(raw[4 + q].y & 0xffff0000u); }
    if (rope) {
        const int s = s0 + i, pos = pr == 0 ? (s >> 6) : (s & 63);
        const float* rp = ROPE + (size_t)(pos * 32 + hf * 16) * 2;
#pragma unroll
        for (int jj = 0; jj < 16; ++jj) { const float c = rp[2 * jj], sn = rp[2 * jj + 1], a = lo[jj], b = hi[jj]; lo[jj] = a * c - b * sn; hi[jj] = a * sn + b * c; }
    }
}
__device__ __forceinline__ void st_rows(LAS bf16_t* dst, const float (&lo)[16], const float (&hi)[16], float scale) {
    const int t = threadIdx.x, i = t >> 2, part = t & 3, i0 = (part & 1) * 32 + (part >> 1) * 16;
    u32x4 w0, w1, w2, w3;
    w0.x = pack_bf16(lo[0] * scale, lo[1] * scale); w0.y = pack_bf16(lo[2] * scale, lo[3] * scale); w0.z = pack_bf16(lo[4] * scale, lo[5] * scale); w0.w = pack_bf16(lo[6] * scale, lo[7] * scale);
    w1.x = pack_bf16(lo[8] * scale, lo[9] * scale); w1.y = pack_bf16(lo[10] * scale, lo[11] * scale); w1.z = pack_bf16(lo[12] * scale, lo[13] * scale); w1.w = pack_bf16(lo[14] * scale, lo[15] * scale);
    w2.x = pack_bf16(hi[0] * scale, hi[1] * scale); w2.y = pack_bf16(hi[2] * scale, hi[3] * scale); w2.z = pack_bf16(hi[4] * scale, hi[5] * scale); w2.w = pack_bf16(hi[6] * scale, hi[7] * scale);
    w3.x = pack_bf16(hi[8] * scale, hi[9] * scale); w3.y = pack_bf16(hi[10] * scale, hi[11] * scale); w3.z = pack_bf16(hi[12] * scale, hi[13] * scale); w3.w = pack_bf16(hi[14] * scale, hi[15] * scale);
    LAS bf16_t* d = dst + i * LDK + i0;
    *(LAS u32x4*)d = w0; *(LAS u32x4*)(d + 8) = w1; *(LAS u32x4*)(d + 64) = w2; *(LAS u32x4*)(d + 72) = w3;
}
__device__ __forceinline__ void st_rows_T(LAS bf16_t* dst, const float (&lo)[16], const float (&hi)[16], float scale) {
    const int t = threadIdx.x, i = t >> 2, part = t & 3, i0 = (part & 1) * 32 + (part >> 1) * 16;
#pragma unroll
    for (int jj = 0; jj < 16; ++jj) { dst[(i0 + jj) * LDK + i] = f2bf(lo[jj] * scale); dst[(i0 + 64 + jj) * LDK + i] = f2bf(hi[jj] * scale); }
}
__device__ __forceinline__ void mma_128(const LAS bf16_t* A, const LAS bf16_t* B, f32x4 (&acc)[2][4], int wr, int wc, int lane) {
    const int fr = lane & 15, fq = lane >> 4;
#pragma unroll
    for (int ks = 0; ks < 4; ++ks) {
        bf16x8 a[2], b[4];
#pragma unroll
        for (int mt = 0; mt < 2; ++mt) a[mt] = *(const LAS bf16x8*)(A + (wr * 32 + mt * 16 + fr) * LDK + ks * 32 + fq * 8);
#pragma unroll
        for (int nt = 0; nt < 4; ++nt) b[nt] = *(const LAS bf16x8*)(B + (wc * 64 + nt * 16 + fr) * LDK + ks * 32 + fq * 8);
#pragma unroll
        for (int mt = 0; mt < 2; ++mt)
#pragma unroll
            for (int nt = 0; nt < 4; ++nt) acc[mt][nt] = __builtin_amdgcn_mfma_f32_16x16x32_bf16(a[mt], b[nt], acc[mt][nt], 0, 0, 0);
    }
}
__device__ __forceinline__ void zero_acc(f32x4 (&acc)[2][4]) {
#pragma unroll
    for (int mt = 0; mt < 2; ++mt)
#pragma unroll
        for (int nt = 0; nt < 4; ++nt) acc[mt][nt] = (f32x4){0.f, 0.f, 0.f, 0.f};
}
__device__ __forceinline__ void wave_scan_sum2(float x0, float x1, float& p0, float& p1, float& total) {
    const int lane = threadIdx.x & 63; float s = x0 + x1, inc = s;
#pragma unroll
    for (int o = 1; o < 64; o <<= 1) { const float t = __shfl_up(inc, o, 64); if (lane >= o) inc += t; }
    const float exc = inc - s; p0 = exc + x0; p1 = exc + s; total = __shfl(inc, 63, 64);
}
__device__ __forceinline__ void wave_scan_max2(float x0, float x1, float& p0, float& p1) {
    const int lane = threadIdx.x & 63; const float m = fmaxf(x0, x1); float inc = m;
#pragma unroll
    for (int o = 1; o < 64; o <<= 1) { const float t = __shfl_up(inc, o, 64); if (lane >= o) inc = fmaxf(inc, t); }
    float exc = __shfl_up(inc, 1, 64); if (lane == 0) exc = -3.0e38f;
    p0 = fmaxf(exc, x0); p1 = fmaxf(exc, m);
}
__device__ __forceinline__ void ph_c1(const Params& p, LAS unsigned char* lds, int bid, int nblk) {
    const int tid = threadIdx.x, wid = tid >> 6, lane = tid & 63, wr = wid >> 1, wc = wid & 1, fr = lane & 15, fq = lane >> 4;
    LAS bf16_t* KsT = (LAS bf16_t*)(lds + LDS_WORK); LAS bf16_t* VsT0 = KsT + 128 * LDK; LAS bf16_t* VsT1 = VsT0 + 128 * LDK;
    LAS float* z = (LAS float*)(VsT1 + 128 * LDK);
    LAS float* lfA = z + 256; LAS float* igA = lfA + 256; LAS float* zmax = igA + 256;
    const bf16_t* P = (const bf16_t*)(p.ws + WS_P); const float* GT = (const float*)(p.ws + WS_GT); const float* ROPE = (const float*)(p.ws + WS_ROPE);
    float* ST = (float*)(p.ws + WS_ST); float* NST = (float*)(p.ws + WS_NST); float* MEND = (float*)(p.ws + WS_MEND); float* BEND = (float*)(p.ws + WS_BEND);
    for (int u = bid; u < NB * NCHUNK * 4 * 2; u += nblk) {
        int mixer, h, ch, b, row0; unit_decode(u, mixer, h, ch, b, row0);
        const int colQ = mixer * 2048 + h * 128;
        u32x2 rawK[8], rawV[8]; ld_raw(P, row0, colQ + 512, rawK); ld_raw(P, row0, colQ + 1024, rawV);
        if (mixer == 0) {
            if (tid < 256) { const int dir = tid >> 7, j = tid & 127; const float lg = p.in[I_CLG][dir * 4 + h]; z[tid] = fexp(lg * (float)(dir == 0 ? 127 - j : j)); }
        } else {
            if (tid < 256) { const int dir = tid >> 7, j = tid & 127, row = row0 + j;
                igA[tid] = GT[row * 16 + dir * 4 + h] + p.in[I_DIB][dir * 4 + h];
                lfA[tid] = -softplusf(-(GT[row * 16 + 8 + dir * 4 + h] + p.in[I_DFB][dir * 4 + h])); }
            __syncthreads();
            if (tid < 128) { const int dir = tid >> 6, j0 = 2 * lane, j1 = j0 + 1;
                const float l0 = lfA[dir * 128 + j0], l1 = lfA[dir * 128 + j1], g0 = igA[dir * 128 + j0], g1 = igA[dir * 128 + j1];
                float r0, r1, total; wave_scan_sum2(l0, l1, r0, r1, total);
                const float w0 = (dir == 0 ? total - r0 : r0 - l0) + g0, w1 = (dir == 0 ? total - r1 : r1 - l1) + g1;
                const float mx = wave_max(fmaxf(w0, w1));
                z[dir * 128 + j0] = fexp(w0 - mx); z[dir * 128 + j1] = fexp(w1 - mx);
                const int sid = sid_of(1, dir, b, ch, h);
                if (lane == 0) { MEND[sid] = mx; BEND[sid] = total; }
                float* CB = (float*)(p.ws + WS_CB) + (size_t)sid * 128; float* CMI = (float*)(p.ws + WS_CMI) + (size_t)sid * 128;
                if (dir == 0) { float m0, m1; wave_scan_max2(g0 - r0, g1 - r1, m0, m1); CB[j0] = r0; CB[j1] = r1; CMI[j0] = r0 + m0; CMI[j1] = r1 + m1; }
                else { const float s0 = total - r0 + l0, s1 = total - r1 + l1;
                    lfA[128 + j0] = g0 - s0; lfA[128 + j1] = g1 - s1; igA[128 + j0] = s0; igA[128 + j1] = s1; CB[j0] = s0; CB[j1] = s1;
                    asm volatile("s_waitcnt lgkmcnt(0)" ::: "memory");
                    const int q0 = 127 - 2 * lane, q1 = q0 - 1; float m0, m1; wave_scan_max2(lfA[128 + q0], lfA[128 + q1], m0, m1);
                    CMI[q0] = igA[128 + q0] + m0; CMI[q1] = igA[128 + q1] + m1; } }
        }
        __syncthreads();
        {
            float lo[16], hi[16];
            cvt_rows(rawK, mixer == 0 && ch >= 2, (ch - 2) * 128, ROPE, lo, hi);
            st_rows_T(KsT, lo, hi, 0.08838834764831845f);
            cvt_rows(rawV, false, 0, ROPE, lo, hi);
            const int i = tid >> 2;
            st_rows_T(VsT0, lo, hi, z[i]); st_rows_T(VsT1, lo, hi, z[128 + i]);
        }
        __syncthreads();
#pragma unroll
        for (int dir = 0; dir < 2; ++dir) {
            f32x4 acc[2][4]; zero_acc(acc);
            mma_128(dir == 0 ? VsT0 : VsT1, KsT, acc, wr, wc, lane);
            bf16_t* dst = (bf16_t*)ST + (size_t)sid_of(mixer, dir, b, ch, h) * 16384;
#pragma unroll
            for (int mt = 0; mt < 2; ++mt)
#pragma unroll
                for (int nt = 0; nt < 4; ++nt)
#pragma unroll
                    for (int r = 0; r < 4; ++r) dst[(wr * 32 + mt * 16 + fq * 4 + r) * 128 + wc * 64 + nt * 16 + fr] = f2bf(acc[mt][nt][r]);
        }
        if (mixer == 1 && tid < 256) { const int dir = tid >> 7, dd = tid & 127; float s = 0.f;
            for (int j = 0; j < 128; ++j) s += z[dir * 128 + j] * bf2f(KsT[dd * LDK + j]);
            NST[(size_t)sid_of(1, dir, b, ch, h) * 128 + dd] = s; }
        __syncthreads();
    }
}
__device__ __forceinline__ void ph_c2(const Params& p, int bid, int nblk) {
    const int tid = threadIdx.x;
    float* ST = (float*)(p.ws + WS_ST); float* NST = (float*)(p.ws + WS_NST); bf16_t* STB = (bf16_t*)(p.ws + WS_STB);
    const float* MEND = (const float*)(p.ws + WS_MEND); const float* BEND = (const float*)(p.ws + WS_BEND); float* MPREV = (float*)(p.ws + WS_MPREV);
    for (int item = bid; item < 256; item += nblk) {
        const int mixer = item >> 7, chain = (item >> 2) & 31, slab = item & 3, dir = chain >> 4, b = (chain >> 2) & 3, h = chain & 3;
        const int idx = slab * 4096 + tid * 8;
        float st[8];
#pragma unroll
        for (int i = 0; i < 8; ++i) st[i] = 0.f;
        const float gdec = mixer == 0 ? fexp(p.in[I_CLG][dir * 4 + h] * 128.0f) : 0.f;
        const bool do_n = mixer == 1 && slab == 0 && tid < 128;
        float m = -__builtin_inff(), n = 0.f;
#pragma unroll 1
        for (int k0 = 0; k0 < NCHUNK; k0 += 17) {
            u32x4 kv[17]; float nv[17];
#pragma unroll
            for (int k = 0; k < 17; ++k) { const int kk = k0 + k, ch = dir == 0 ? kk : (kk < 2 ? 1 - kk : 35 - kk); const int sid = sid_of(mixer, dir, b, ch, h);
                kv[k] = *(const u32x4*)((const bf16_t*)ST + (size_t)sid * 16384 + idx); nv[k] = do_n ? NST[(size_t)sid * 128 + tid] : 0.f; }
#pragma unroll
            for (int k = 0; k < 17; ++k) { const int kk = k0 + k, ch = dir == 0 ? kk : (kk < 2 ? 1 - kk : 35 - kk); const int sid = sid_of(mixer, dir, b, ch, h);
                u32x4 q;
#pragma unroll
                for (int i = 0; i < 4; ++i) q[i] = pack_bf16(st[2 * i], st[2 * i + 1]);
                *(u32x4*)(STB + (size_t)sid * 16384 + idx) = q;
                float so = gdec, sn = 1.0f;
                if (mixer == 1) { const float me = MEND[sid], be = BEND[sid], mnew = fmaxf(be + m, me); so = fexp(be + m - mnew); sn = fexp(me - mnew);
                    if (do_n) { NST[(size_t)sid * 128 + tid] = n; n = n * so + nv[k] * sn; }
                    if (slab == 0 && tid == 0) MPREV[sid] = m;
                    m = mnew; }
#pragma unroll
                for (int i = 0; i < 8; ++i) { const unsigned wv = kv[k][i >> 1]; st[i] = st[i] * so + __uint_as_float((i & 1) ? (wv & 0xffff0000u) : (wv << 16)) * sn; } }
        }
    }
}
template <int mixer>
__device__ __forceinline__ void c3_unit(const Params& p, LAS unsigned char* lds, int h, int ch, int b, int row0) {
    int tid_ = threadIdx.x; asm volatile("" : "+v"(tid_));
    const int tid = tid_, wid = tid >> 6, lane = tid & 63, wr = wid >> 1, wc = wid & 1, fr = lane & 15, fq = lane >> 4;
    LAS bf16_t* Qs = (LAS bf16_t*)(lds + LDS_WORK); LAS bf16_t* Ks = Qs + 128 * LDK; LAS bf16_t* VsT = Ks + 128 * LDK; LAS bf16_t* RT = VsT + 128 * LDK;
    LAS float* fa = (LAS float*)(RT + 128 * LDK);
    LAS float* lfA = fa; LAS float* igA = fa + 256; LAS float* bA = fa + 512; LAS float* miA = fa + 768; LAS float* mtA = fa + 1024; LAS float* sintA = fa + 1280;
    LAS float* rowsum = fa + 1536; LAS float* qn = fa + 2048; LAS float* nA = fa + 2304;
    LAS float* Os = (LAS float*)Qs;
    LAS bf16_t* Pm = Ks;
    const bf16_t* P = (const bf16_t*)(p.ws + WS_P); const float* GT = (const float*)(p.ws + WS_GT); const float* ROPE = (const float*)(p.ws + WS_ROPE);
    const bf16_t* STB = (const bf16_t*)(p.ws + WS_STB); const float* NST = (const float*)(p.ws + WS_NST); const float* MPREV = (const float*)(p.ws + WS_MPREV);
    bf16_t* Y = (bf16_t*)(p.ws + WS_YMIX);
    {
        const int colQ = mixer * 2048 + h * 128; const bool rope = mixer == 0 && ch >= 2;
        {
            u32x2 rawQ[8], rawK[8], rawV[8]; ld_raw(P, row0, colQ, rawQ); ld_raw(P, row0, colQ + 512, rawK); ld_raw(P, row0, colQ + 1024, rawV);
            float lo[16], hi[16];
            cvt_rows(rawQ, rope, (ch - 2) * 128, ROPE, lo, hi); st_rows(Qs, lo, hi, 1.0f);
            cvt_rows(rawK, rope, (ch - 2) * 128, ROPE, lo, hi); st_rows(Ks, lo, hi, 0.08838834764831845f);
            cvt_rows(rawV, false, 0, ROPE, lo, hi); st_rows_T(VsT, lo, hi, 1.0f);
        }
        if (mixer == 1) {
            if (tid < 256) { const int dir = tid >> 7, j = tid & 127, row = row0 + j;
                igA[tid] = GT[row * 16 + dir * 4 + h] + p.in[I_DIB][dir * 4 + h];
                nA[tid] = NST[(size_t)sid_of(1, dir, b, ch, h) * 128 + j];
                bA[tid] = ((const float*)(p.ws + WS_CB))[(size_t)sid_of(1, dir, b, ch, h) * 128 + j]; miA[tid] = ((const float*)(p.ws + WS_CMI))[(size_t)sid_of(1, dir, b, ch, h) * 128 + j]; }
            __syncthreads();
            __syncthreads();
            if (tid < 256) { const int dir = tid >> 7, i = tid & 127; const float mprev = MPREV[sid_of(1, dir, b, ch, h)];
                const float gi = bA[tid] + mprev, mt = fmaxf(gi, miA[tid]); mtA[tid] = mt; sintA[tid] = fexp(gi - mt);
                float s = 0.f;
                for (int d0 = 0; d0 < 128; ++d0) s += bf2f(Qs[i * LDK + d0]) * nA[dir * 128 + d0];
                qn[tid] = s; }
        }
        __syncthreads();
        f32x4 S[2][4]; zero_acc(S);
        mma_128(Qs, Ks, S, wr, wc, lane);
        __syncthreads();
        f32x4 O[2][4]; zero_acc(O);
        if (mixer == 0) {
            const float lg0 = p.in[I_CLG][h], lg1 = p.in[I_CLG][4 + h];
#pragma unroll
            for (int mt = 0; mt < 2; ++mt)
#pragma unroll
                for (int nt = 0; nt < 4; ++nt)
#pragma unroll
                    for (int r = 0; r < 4; ++r) { const int i = wr * 32 + mt * 16 + fq * 4 + r, j = wc * 64 + nt * 16 + fr;
                        const float dcy = (i >= j ? fexp(lg0 * (float)(i - j)) : 0.f) + (j >= i ? fexp(lg1 * (float)(j - i)) : 0.f);
                        Pm[i * LDK + j] = f2bf(S[mt][nt][r] * dcy); }
            __syncthreads();
            mma_128(Pm, VsT, O, wr, wc, lane);
#pragma unroll
            for (int dir = 0; dir < 2; ++dir) {
                { const bf16_t* src = STB + (size_t)sid_of(0, dir, b, ch, h) * 16384 + (tid >> 2) * 128 + (tid & 3) * 32; LAS bf16_t* d = RT + (tid >> 2) * LDK + (tid & 3) * 32;
#pragma unroll
                    for (int q = 0; q < 4; ++q) *(LAS u32x4*)(d + q * 8) = *(const u32x4*)(src + q * 8); }
                __syncthreads();
                f32x4 T[2][4]; zero_acc(T);
                mma_128(Qs, RT, T, wr, wc, lane);
#pragma unroll
                for (int mt = 0; mt < 2; ++mt)
#pragma unroll
                    for (int r = 0; r < 4; ++r) { const int i = wr * 32 + mt * 16 + fq * 4 + r; const float xi = dir == 0 ? fexp(lg0 * (float)(i + 1)) : fexp(lg1 * (float)(128 - i));
#pragma unroll
                        for (int nt = 0; nt < 4; ++nt) O[mt][nt][r] += xi * T[mt][nt][r]; }
                __syncthreads();
            }
        } else {
#pragma unroll
            for (int dir = 0; dir < 2; ++dir) {
                float rp[2][4];
#pragma unroll
                for (int mt = 0; mt < 2; ++mt)
#pragma unroll
                    for (int r = 0; r < 4; ++r) { const int i = wr * 32 + mt * 16 + fq * 4 + r; const float bi = bA[dir * 128 + i] - mtA[dir * 128 + i]; float acc = 0.f;
#pragma unroll
                        for (int nt = 0; nt < 4; ++nt) { const int j = wc * 64 + nt * 16 + fr; const bool valid = dir == 0 ? (j <= i) : (j >= i);
                            const float e = valid ? fexp(bi - bA[dir * 128 + j] + igA[dir * 128 + j]) : 0.f; const float pv = S[mt][nt][r] * e;
                            Pm[i * LDK + j] = f2bf(pv); acc += pv; }
                        rp[mt][r] = row16_sum(acc); }
                if (fr == 0) {
#pragma unroll
                    for (int mt = 0; mt < 2; ++mt)
#pragma unroll
                        for (int r = 0; r < 4; ++r) rowsum[wc * 256 + dir * 128 + wr * 32 + mt * 16 + fq * 4 + r] = rp[mt][r];
                }
                { const bf16_t* src = STB + (size_t)sid_of(1, dir, b, ch, h) * 16384 + (tid >> 2) * 128 + (tid & 3) * 32; LAS bf16_t* d = RT + (tid >> 2) * LDK + (tid & 3) * 32;
#pragma unroll
                    for (int q = 0; q < 4; ++q) *(LAS u32x4*)(d + q * 8) = *(const u32x4*)(src + q * 8); }
                __syncthreads();
                f32x4 T[2][4]; zero_acc(T);
                mma_128(Qs, RT, T, wr, wc, lane);
#pragma unroll
                for (int mt = 0; mt < 2; ++mt)
#pragma unroll
                    for (int r = 0; r < 4; ++r) { const float si = sintA[dir * 128 + wr * 32 + mt * 16 + fq * 4 + r];
#pragma unroll
                        for (int nt = 0; nt < 4; ++nt) T[mt][nt][r] *= si; }
                mma_128(Pm, VsT, T, wr, wc, lane);
#pragma unroll
                for (int mt = 0; mt < 2; ++mt)
#pragma unroll
                    for (int r = 0; r < 4; ++r) { const int i = wr * 32 + mt * 16 + fq * 4 + r; const float si = sintA[dir * 128 + i];
                        float den = (rowsum[dir * 128 + i] + rowsum[256 + dir * 128 + i]) + qn[dir * 128 + i] * si; den = fmaxf(fabsf(den), fexp(-mtA[dir * 128 + i])); const float rden = frcp(den);
#pragma unroll
                        for (int nt = 0; nt < 4; ++nt) O[mt][nt][r] += T[mt][nt][r] * rden; }
                __syncthreads();
            }
        }
#pragma unroll
        for (int mt = 0; mt < 2; ++mt)
#pragma unroll
            for (int nt = 0; nt < 4; ++nt)
#pragma unroll
                for (int r = 0; r < 4; ++r) Os[(wr * 32 + mt * 16 + fq * 4 + r) * 132 + wc * 64 + nt * 16 + fr] = O[mt][nt][r];
        __syncthreads();
        {
            const float* gng = (mixer == 0 ? p.in[I_CGNG] : p.in[I_DGNG]) + h * 128; const float* gnb = (mixer == 0 ? p.in[I_CGNB] : p.in[I_DGNB]) + h * 128;
            const float g0 = gng[lane], g1 = gng[lane + 64], b0 = gnb[lane], b1 = gnb[lane + 64];
#pragma unroll 1
            for (int i4 = 0; i4 < 16; i4 += 4) {
                float qg0[4], qg1[4];
#pragma unroll
                for (int u = 0; u < 4; ++u) { const int row = row0 + wid * 16 + i4 + u; qg0[u] = bf2f(P[(size_t)row * LDP1 + colQ + 1536 + lane]); qg1[u] = bf2f(P[(size_t)row * LDP1 + colQ + 1536 + 64 + lane]); }
#pragma unroll
                for (int u = 0; u < 4; ++u) { const int i = wid * 16 + i4 + u, row = row0 + i;
                    const float x0 = Os[i * 132 + lane], x1 = Os[i * 132 + 64 + lane];
                    const float mean = wave_sum(x0 + x1) * (1.0f / 128.0f), d0 = x0 - mean, d1 = x1 - mean;
                    const float rstd = rsqrtf(wave_sum(d0 * d0 + d1 * d1) * (1.0f / 128.0f) + LN_EPS);
                    const float q0 = qg0[u], q1 = qg1[u];
                    const float s0 = sigm(q0), s1 = sigm(q1);
                    const float y0 = (d0 * rstd * g0 + b0) * (mixer == 0 ? q0 * s0 : s0), y1 = (d1 * rstd * g1 + b1) * (mixer == 0 ? q1 * s1 : s1);
                    Y[(size_t)row * 1024 + mixer * 512 + h * 128 + lane] = f2bf(y0); Y[(size_t)row * 1024 + mixer * 512 + h * 128 + 64 + lane] = f2bf(y1); }
            }
        }
        __syncthreads();
    }
}
__device__ __forceinline__ void ph_c3(const Params& p, LAS unsigned char* lds, int bid, int nblk) {
    for (int u2 = bid; u2 < NB * NCHUNK * 4; u2 += nblk) {
        int mixer, h, ch, b, row0; unit_decode(u2 * 2, mixer, h, ch, b, row0);
        c3_unit<0>(p, lds, h, ch, b, row0);
    }
    for (int u2 = nblk - 1 - bid; u2 < NB * NCHUNK * 4; u2 += nblk) {
        int mixer, h, ch, b, row0; unit_decode(u2 * 2 + 1, mixer, h, ch, b, row0);
        c3_unit<1>(p, lds, h, ch, b, row0);
    }
}
constexpr int NPHASE = 23;
__global__ void __launch_bounds__(NTHR, 2) fwd(Params p) {
    extern __shared__ __attribute__((aligned(16))) unsigned char smem_raw[];
    LAS unsigned char* lds = (LAS unsigned char*)smem_raw;
    if (threadIdx.x == 0) { LAS unsigned* st = (LAS unsigned*)(lds + LDS_BAR); st[0] = 0u; st[1] = 0u; st[2] = 0u; st[3] = 0u; }
    __syncthreads();
    XcdBarrier bar = xcd_barrier_post((unsigned*)(p.ws + WS_CTL), (volatile LAS unsigned*)(lds + LDS_BAR));
    const int bid = blockIdx.x, nblk = gridDim.x;
    unsigned char* ws = p.ws;
#ifndef PHASE_ONLY
#define PHASE_ONLY -1
#endif
#ifndef DBL_MASK
#define DBL_MASK 0u
#endif
#define PHASE(k, call) if constexpr (PHASE_ONLY < 0 || PHASE_ONLY == (k)) { if (p.lo <= (k) && (k) < p.hi) { call; if constexpr ((DBL_MASK >> (k)) & 1u) { xcd_barrier(bar); call; } if ((k) + 1 < p.hi) xcd_barrier(bar); } }
    PHASE(0, ph_prologue(p, lds, bid, nblk))
    PHASE(1, ph_mod_in(p, bid, nblk))
    PHASE(2, ph_gemm_dense<12>(lds, (const bf16_t*)(ws + WS_H), (const bf16_t*)(ws + WS_WIN0T), (bf16_t*)(ws + WS_P), LDP0, 0, 68, bid, nblk))
    PHASE(3, ph_prep_even(p, lds, bid, nblk))
    PHASE(4, ph_r1(p, lds, bid, nblk))
    PHASE(5, ph_r2(p, lds, bid, nblk))
    PHASE(6, ph_fin_even(p, bid, nblk))
    PHASE(7, ph_gemm_dense<4>(lds, (const bf16_t*)(ws + WS_YMIX), (const bf16_t*)(ws + WS_WOUTT), (bf16_t*)(ws + WS_YP), 1024, 0, 68, bid, nblk))
    PHASE(8, ph_ln1<0>(p, lds, bid, nblk))
    PHASE(9, ph_moe_gather<0>(p, lds, bid, nblk))
    PHASE(10, ph_moe_gemm1<0>(p, lds, bid, nblk))
    PHASE(11, ph_moe_gemm2<0>(p, lds, bid, nblk))
    PHASE(12, ph_ln2<0>(p, lds, bid, nblk))
    PHASE(13, ph_gemm_dense<16>(lds, (const bf16_t*)(ws + WS_H), (const bf16_t*)(ws + WS_WIN1T), (bf16_t*)(ws + WS_P), LDP1, 0, 68, bid, nblk))
    PHASE(14, ph_c1(p, lds, bid, nblk))
    PHASE(15, ph_c2(p, bid, nblk))
    PHASE(16, ph_c3(p, lds, bid, nblk))
    PHASE(17, ph_gemm_dense<4>(lds, (const bf16_t*)(ws + WS_YMIX), (const bf16_t*)(ws + WS_WOUTT) + (size_t)1024 * 1024, (bf16_t*)(ws + WS_YP), 1024, 4, 64, bid, nblk))
    PHASE(18, ph_ln1<1>(p, lds, bid, nblk))
    PHASE(19, ph_moe_gather<1>(p, lds, bid, nblk))
    PHASE(20, ph_moe_gemm1<1>(p, lds, bid, nblk))
    PHASE(21, ph_moe_gemm2<1>(p, lds, bid, nblk))
    PHASE(22, ph_ln2<1>(p, lds, bid, nblk))
#undef PHASE
}

#ifndef MK_ONE_LAUNCH
#define MK_ONE_LAUNCH 1
#endif
extern "C" void kernel_launch(void* const* d_in, const int* in_sizes, int n_in, void* d_out, int out_size, void* d_ws, size_t ws_size, hipStream_t stream) {
    static int grid = 0;
    if (grid == 0) {
        if (n_in != N_INPUTS || out_size != NB * SEQL * DM || ws_size < WS_TOTAL) { fprintf(stderr, "kernel_launch: unexpected problem (n_in %d, out %d, ws %zu < %zu)\n", n_in, out_size, ws_size, (size_t)WS_TOTAL); grid = -1; return; }
        int dev = 0, cus = 0, per_cu = 0;
        if (hipGetDevice(&dev) != hipSuccess || hipDeviceGetAttribute(&cus, hipDeviceAttributeMultiprocessorCount, dev) != hipSuccess) { grid = -1; return; }
        if (hipFuncSetAttribute((const void*)fwd, hipFuncAttributeMaxDynamicSharedMemorySize, LDS_BYTES) != hipSuccess) { fprintf(stderr, "kernel_launch: hipFuncSetAttribute failed\n"); grid = -1; return; }
        if (hipOccupancyMaxActiveBlocksPerMultiprocessor(&per_cu, (const void*)fwd, NTHR, LDS_BYTES) != hipSuccess || per_cu < 1) { fprintf(stderr, "kernel_launch: occupancy query says %d\n", per_cu); (void)hipGetLastError(); per_cu = 1; }
        grid = cus;
    }
    if (grid < 0) return;
    (void)hipMemsetAsync((char*)d_ws + WS_CTL, 0, CTL_BYTES, stream);
    Params p{};
    for (int i = 0; i < N_INPUTS; ++i) p.in[i] = (const float*)d_in[i];
    p.out = (float*)d_out; p.ws = (unsigned char*)d_ws;
#if MK_ONE_LAUNCH
    p.lo = 0; p.hi = NPHASE;
    hipLaunchKernelGGL(fwd, dim3(grid), dim3(NTHR), LDS_BYTES, stream, p);
#else
    for (int k = 0; k < NPHASE; ++k) { p.lo = k; p.hi = k + 1; hipLaunchKernelGGL(fwd, dim3(grid), dim3(NTHR), LDS_BYTES, stream, p); }
#endif
}
```

```cpp
#include <hip/hip_runtime.h>
#include <stdint.h>
#include <stdio.h>

#define LAS __attribute__((address_space(3)))
typedef unsigned short bf16_t;
typedef short bf16x8 __attribute__((ext_vector_type(8)));
typedef float f32x4 __attribute__((ext_vector_type(4)));
typedef float f32x2 __attribute__((ext_vector_type(2)));
typedef unsigned u32x4 __attribute__((ext_vector_type(4)));
typedef unsigned u32x2 __attribute__((ext_vector_type(2)));

constexpr int NB = 4, SEQL = 4096, CTXL = 256, DM = 1024;
constexpr int NCTX = NB * CTXL;
constexpr int MROWS = NCTX + NB * SEQL;
constexpr int NTHR = 512;
constexpr int LDP0 = 3072, LDP1 = 4096;
constexpr int A_IN = 1920, EVEN_IN = 2944, ODD_IN = 4112;
constexpr int NEXP = 32, DFF = 1024;
constexpr int MOE_ROWS_MAX = 69632 + 32 * 256;
constexpr float DN_ALPHA = 1.41421356237309515f;
constexpr float LN_EPS = 1e-5f;
constexpr int NCHUNK = 34;

enum { I_X = 0, I_C, I_CTX, I_CCTX, I_WMOD, I_BMOD, I_LNG, I_LNB, I_EWIN, I_EWOUT, I_AMU, I_AW0, I_AWB, I_AA0, I_AAB, I_AGB, I_AKK, I_AKA, I_ARK,
       I_AGNG, I_AGNB, I_BCW, I_BCB, I_BGW, I_BGB, I_BLAM, I_OWIN, I_OWOUT, I_CLG, I_CGNG, I_CGNB, I_DIB, I_DFB, I_DGNG, I_DGNB, I_RW, I_RB,
       I_W1, I_B1, I_W2, I_B2, N_INPUTS };

constexpr size_t al256(size_t x) { return (x + 255) & ~(size_t)255; }
constexpr size_t WS_CTL   = 0;
constexpr size_t CTL_BYTES = 65536;
constexpr size_t CTL_CNT  = 16384;
constexpr size_t WS_MOD   = WS_CTL + CTL_BYTES;
constexpr size_t WS_ROPE  = WS_MOD + al256((size_t)2 * 5 * 6144 * 4);
constexpr size_t WS_WIN0T = WS_ROPE + 16384;
constexpr size_t WS_WIN1T = WS_WIN0T + (size_t)3072 * 1024 * 2;
constexpr size_t WS_WOUTT = WS_WIN1T + (size_t)4096 * 1024 * 2;
constexpr size_t WS_W1T   = WS_WOUTT + (size_t)2 * 1024 * 1024 * 2;
constexpr size_t WS_W2T   = WS_W1T + (size_t)2 * 32 * 2048 * 1024 * 2;
constexpr size_t WS_XS    = WS_W2T + (size_t)2 * 32 * 1024 * 1024 * 2;
constexpr size_t WS_H     = WS_XS + (size_t)MROWS * 1024 * 4;
constexpr size_t WS_YMIX  = WS_H + (size_t)MROWS * 1024 * 2;
constexpr size_t WS_YP    = WS_YMIX + (size_t)MROWS * 1024 * 2;
constexpr size_t WS_GT    = WS_YP + (size_t)MROWS * 1024 * 4;
constexpr size_t WS_TOPE  = WS_GT + (size_t)MROWS * 16 * 4;
constexpr size_t WS_TOPW  = WS_TOPE + (size_t)MROWS * 16;
constexpr size_t WS_TOPS  = WS_TOPW + (size_t)MROWS * 16;
constexpr size_t WS_POS   = WS_TOPS + (size_t)MROWS * 16;
constexpr size_t WS_CNTB  = WS_POS + (size_t)MROWS * 16;
constexpr size_t WS_WLT   = WS_CNTB + (size_t)2 * 512 * 32 * 4;
constexpr size_t WLT_WB = 0, WLT_AB = 65536, WLT_GB = 131072, WLT_GW = 196608, WLT_N = 327680;
constexpr size_t WS_P     = WS_WLT + (size_t)WLT_N * 2;
constexpr size_t WS_BIG   = WS_P + (size_t)MROWS * 4096 * 4;
constexpr size_t ARR512   = (size_t)MROWS * 512 * 4;
constexpr int SCREC = 448;
constexpr int SCLEN = CTXL + SEQL;
constexpr size_t WS_SC    = WS_BIG;
enum { E_G = 0, E_O0, E_O1, E_A0, E_A1, E_BX0, E_BX1, E_GATE, E_NARR };
constexpr size_t WS_EARR  = WS_SC + (size_t)64 * SCLEN * SCREC * 2;
constexpr size_t WS_BC    = WS_EARR + (size_t)E_NARR * ARR512;
constexpr size_t WS_CHA   = WS_BC + (size_t)MROWS * 8 * 4;
constexpr size_t WS_CHH   = WS_CHA + (size_t)2 * 512 * 512 * 4;
constexpr size_t WS_CIN   = WS_CHH + (size_t)2 * 512 * 512 * 4;
constexpr int RCH = 64, NRCH = SCLEN / RCH, NRUNIT = 64 * NRCH;
constexpr size_t WS_RU    = WS_CIN + (size_t)2 * 512 * 512 * 4;
constexpr size_t WS_EEND  = WS_RU + (size_t)NRUNIT * 4 * 4096 * 4;
constexpr int NSID = 2 * 2 * NB * NCHUNK * 4;
constexpr size_t WS_ST    = WS_BIG;
constexpr size_t WS_NST   = WS_ST + (size_t)NSID * 16384 * 4;
constexpr size_t WS_MEND  = WS_NST + (size_t)NSID * 128 * 4;
constexpr size_t WS_BEND  = WS_MEND + al256((size_t)NSID * 4);
constexpr size_t WS_MPREV = WS_BEND + al256((size_t)NSID * 4);
constexpr size_t WS_CB    = WS_MPREV + al256((size_t)NSID * 4);
constexpr size_t WS_CMI   = WS_CB + (size_t)NSID * 128 * 4;
constexpr size_t WS_STB   = WS_CMI + (size_t)NSID * 128 * 4;
constexpr size_t WS_OEND  = WS_STB + (size_t)NSID * 16384 * 2;
constexpr size_t WS_ASORT = WS_BIG;
constexpr size_t WS_IDX   = WS_BIG;
constexpr size_t WS_ACT   = WS_ASORT + (size_t)MOE_ROWS_MAX * 1024 * 2;
constexpr size_t WS_YE    = WS_ACT + (size_t)MOE_ROWS_MAX * 1024 * 2;
constexpr size_t WS_MEND_ = WS_YE + (size_t)MOE_ROWS_MAX * 1024 * 4;
constexpr size_t WS_TOTAL = (WS_EEND > WS_MEND_ ? (WS_EEND > WS_OEND ? WS_EEND : WS_OEND) : (WS_MEND_ > WS_OEND ? WS_MEND_ : WS_OEND));

constexpr int LDS_BYTES = 155648;
constexpr int LDS_BAR = 0;
constexpr int LDS_WORK = 1024;

struct Params {
    const float* in[N_INPUTS];
    float* out;
    unsigned char* ws;
    int lo, hi;
};

typedef __bf16 nbf16x2 __attribute__((ext_vector_type(2)));
__device__ __forceinline__ unsigned pack_bf16(float lo, float hi) { const nbf16x2 v = {(__bf16)lo, (__bf16)hi}; return __builtin_bit_cast(unsigned, v); }
__device__ __forceinline__ bf16_t f2bf(float f) { return __builtin_bit_cast(bf16_t, (__bf16)f); }
__device__ __forceinline__ float bf2f(bf16_t b) { return __uint_as_float(((unsigned)b) << 16); }
__device__ __forceinline__ f32x4 ld_bf16x4(const bf16_t* p) { const u32x2 w = *(const u32x2*)p; return (f32x4){__uint_as_float(w.x << 16), __uint_as_float(w.x & 0xffff0000u), __uint_as_float(w.y << 16), __uint_as_float(w.y & 0xffff0000u)}; }
__device__ __forceinline__ float fexp(float x) { return __builtin_amdgcn_exp2f(x * 1.4426950408889634f); }
__device__ __forceinline__ float frcp(float x) { return __builtin_amdgcn_rcpf(x); }
__device__ __forceinline__ float fsqrt(float x) { return __builtin_amdgcn_sqrtf(x); }
__device__ __forceinline__ float sigm(float x) { return frcp(1.0f + fexp(-x)); }
__device__ __forceinline__ float ftanh(float x) { const float e = fexp(-2.0f * fabsf(x)), t = (1.0f - e) * frcp(1.0f + e); return x < 0.f ? -t : t; }
__device__ __forceinline__ float fexpm1_neg(float x) {
    const float p = x * (1.0f + x * (0.5f + x * (0.16666667f + x * (0.041666668f + x * 0.0083333338f))));
    return x > -0.25f ? p : fexp(x) - 1.0f; }
__device__ __forceinline__ float softplusf(float x) { return fmaxf(x, 0.f) + log1pf(expf(-fabsf(x))); }
__device__ __forceinline__ float wave_sum(float v) {
    v += __int_as_float(__builtin_amdgcn_update_dpp(0, __float_as_int(v), 0x121, 0xf, 0xf, false));
    v += __int_as_float(__builtin_amdgcn_update_dpp(0, __float_as_int(v), 0x122, 0xf, 0xf, false));
    v += __int_as_float(__builtin_amdgcn_update_dpp(0, __float_as_int(v), 0x124, 0xf, 0xf, false));
    v += __int_as_float(__builtin_amdgcn_update_dpp(0, __float_as_int(v), 0x128, 0xf, 0xf, false));
    v += __int_as_float(__builtin_amdgcn_update_dpp(0, __float_as_int(v), 0x142, 0xa, 0xf, false));
    v += __int_as_float(__builtin_amdgcn_update_dpp(0, __float_as_int(v), 0x143, 0xc, 0xf, false));
    return __int_as_float(__builtin_amdgcn_readlane(__float_as_int(v), 63));
}
__device__ __forceinline__ float wave_max(float v) {
    const int ninf = 0xff800000;
    v = fmaxf(v, __int_as_float(__builtin_amdgcn_update_dpp(ninf, __float_as_int(v), 0x121, 0xf, 0xf, false)));
    v = fmaxf(v, __int_as_float(__builtin_amdgcn_update_dpp(ninf, __float_as_int(v), 0x122, 0xf, 0xf, false)));
    v = fmaxf(v, __int_as_float(__builtin_amdgcn_update_dpp(ninf, __float_as_int(v), 0x124, 0xf, 0xf, false)));
    v = fmaxf(v, __int_as_float(__builtin_amdgcn_update_dpp(ninf, __float_as_int(v), 0x128, 0xf, 0xf, false)));
    v = fmaxf(v, __int_as_float(__builtin_amdgcn_update_dpp(ninf, __float_as_int(v), 0x142, 0xa, 0xf, false)));
    v = fmaxf(v, __int_as_float(__builtin_amdgcn_update_dpp(ninf, __float_as_int(v), 0x143, 0xc, 0xf, false)));
    return __int_as_float(__builtin_amdgcn_readlane(__float_as_int(v), 63));
}
__device__ __forceinline__ int wave_min_i(int v) {
    const int big = 0x7fffffff;
    v = min(v, __builtin_amdgcn_update_dpp(big, v, 0x121, 0xf, 0xf, false));
    v = min(v, __builtin_amdgcn_update_dpp(big, v, 0x122, 0xf, 0xf, false));
    v = min(v, __builtin_amdgcn_update_dpp(big, v, 0x124, 0xf, 0xf, false));
    v = min(v, __builtin_amdgcn_update_dpp(big, v, 0x128, 0xf, 0xf, false));
    v = min(v, __builtin_amdgcn_update_dpp(big, v, 0x142, 0xa, 0xf, false));
    v = min(v, __builtin_amdgcn_update_dpp(big, v, 0x143, 0xc, 0xf, false));
    return __builtin_amdgcn_readlane(v, 63);
}
__device__ __forceinline__ float row16_sum(float v) {
    v += __int_as_float(__builtin_amdgcn_update_dpp(0, __float_as_int(v), 0x121, 0xf, 0xf, false));
    v += __int_as_float(__builtin_amdgcn_update_dpp(0, __float_as_int(v), 0x122, 0xf, 0xf, false));
    v += __int_as_float(__builtin_amdgcn_update_dpp(0, __float_as_int(v), 0x124, 0xf, 0xf, false));
    v += __int_as_float(__builtin_amdgcn_update_dpp(0, __float_as_int(v), 0x128, 0xf, 0xf, false));
    return v;
}
__device__ __forceinline__ int row_batch(int row) { return row < NCTX ? (row >> 8) : ((row - NCTX) >> 12); }
__device__ __forceinline__ int row_modr(int row) { return row < NCTX ? 4 : ((row - NCTX) >> 12); }
#define XB_TMO      128
#define XB_XCNT(j)  (256  + 64 * (j))
#define XB_XSUB(j)  (1280 + 64 * (j))
#define XB_XGEN(j)  (2304 + 64 * (j))
#define XB_TOP      3328
#define XB_TOPGEN   3392
#define XCD_BAR_WORDS 3456
#define XB_SPIN_CAP (1u << 18)

__device__ __forceinline__ unsigned xb_ld(unsigned* p)              { return __hip_atomic_load(p, __ATOMIC_RELAXED, __HIP_MEMORY_SCOPE_AGENT); }
__device__ __forceinline__ unsigned xb_add(unsigned* p, unsigned v) { return __hip_atomic_fetch_add(p, v, __ATOMIC_RELAXED, __HIP_MEMORY_SCOPE_AGENT); }
__device__ __forceinline__ unsigned xb_xcc_id() { return (unsigned)__builtin_amdgcn_s_getreg((3 << 11) | 20) & 0xFu; }
#define XB_SPIN(cond, bar) do { unsigned _sp = 0; while (cond) { __builtin_amdgcn_s_sleep(1); \
    if ((++_sp & 255u) == 0u) { if (xb_ld(&(bar)[XB_TMO])) break; if (_sp > XB_SPIN_CAP) { atomicAdd(&(bar)[XB_TMO], 1u); break; } } } } while (0)

struct XcdBarrier {
    unsigned* bar; unsigned x;
    volatile LAS unsigned* st;
};

__device__ __forceinline__ XcdBarrier xcd_barrier_post(unsigned* bar, volatile LAS unsigned* st) {
    XcdBarrier b; b.bar = bar; b.x = xb_xcc_id(); b.st = st;
    if (threadIdx.x == 0) (void)xb_add(&bar[XB_XCNT(b.x)], 1u);
    return b;
}
__device__ __forceinline__ void xcd_barrier_complete(unsigned* bar, unsigned x, unsigned& nloc, unsigned& nx) {
    const unsigned G = gridDim.x * gridDim.y * gridDim.z;
    unsigned sum, cnt, mine, sp = 0u;
    for (;;) {
        sum = 0u; cnt = 0u; mine = 0u;
#pragma unroll
        for (unsigned j = 0; j < 16; ++j) { const unsigned c = xb_ld(&bar[XB_XCNT(j)]); sum += c; cnt += (c > 0u) ? 1u : 0u; mine = (j == x) ? c : mine; }
        if (sum == G) break;
        __builtin_amdgcn_s_sleep(1);
        if ((++sp & 255u) == 0u) { if (xb_ld(&bar[XB_TMO])) break; if (sp > XB_SPIN_CAP) { atomicAdd(&bar[XB_TMO], 1u); break; } }
    }
    nloc = mine > 0u ? mine : 1u; nx = cnt > 0u ? cnt : 1u;
}

__device__ __forceinline__ void xcd_barrier(const XcdBarrier& b) {
    asm volatile("s_waitcnt vmcnt(0)" ::: "memory");
    __syncthreads();
    if (threadIdx.x == 0) {
        unsigned* bar = b.bar;
        __builtin_amdgcn_s_waitcnt(0);
        unsigned nloc = b.st[0], nx = b.st[1];
        if (nloc == 0u) { xcd_barrier_complete(bar, b.x, nloc, nx); b.st[0] = nloc; b.st[1] = nx; }
        const unsigned old = xb_add(&bar[XB_XSUB(b.x)], 1u);
        const unsigned gen = old / nloc;
        if (old + 1u == (gen + 1u) * nloc) {
            __builtin_amdgcn_fence(__ATOMIC_RELEASE, "agent");
            asm volatile("s_waitcnt vmcnt(0)" ::: "memory");
            const unsigned og = xb_add(&bar[XB_TOP], 1u);
            const unsigned tg = og / nx;
            if (og + 1u == (tg + 1u) * nx) xb_add(&bar[XB_TOPGEN], 1u);
            else XB_SPIN(xb_ld(&bar[XB_TOPGEN]) == tg, bar);
            __builtin_amdgcn_fence(__ATOMIC_ACQUIRE, "agent");
            xb_add(&bar[XB_XGEN(b.x)], 1u);
            asm volatile("s_waitcnt vmcnt(0)" ::: "memory");
        } else {
            XB_SPIN(xb_ld(&bar[XB_XGEN(b.x)]) == gen, bar);
            __builtin_amdgcn_fence(__ATOMIC_ACQUIRE, "agent");
            asm volatile("s_waitcnt vmcnt(0)" ::: "memory");
        }
    }
    __syncthreads();
}
namespace pg8 {
constexpr int BM = 256, BK = 64, HALF = 128, HTB = HALF * BK * 2  , STAGE_BYTES = 8 * HTB, NXCD = 8, WGM = 8;

__host__ __device__ __forceinline__ int lds_byte(int r, int c) { const int st = (r >> 4) * 2 + (c >> 5), rr = r & 15, cc = c & 31, ob = rr * 64 + cc * 2; return st * 1024 + (ob ^ (((ob >> 9) & 1) << 5)); }
__host__ __device__ __forceinline__ void stage_rc(int b, int& R, int& C) { const int st = b / 1024, sb = b % 1024, swz = sb ^ (((sb >> 9) & 1) << 5); R = (st >> 1) * 16 + swz / 64; C = (st & 1) * 32 + (swz % 64) / 2; }
__host__ __device__ __forceinline__ int perm32(int rho) { const int n = rho >> 4, i = rho & 15; return 8 * (i >> 2) + 4 * n + (i & 3); }

struct Unit { int pm, pn, hh; };
struct Gemm { const bf16_t* A; const bf16_t* Bt; int M, N, K; const int* aidx; };
__device__ __forceinline__ unsigned cvt_pk_bf16(float lo, float hi) { return pack_bf16(lo, hi); }
template <class Epi, class Sched, bool STAMP = false, bool ATILED = false, bool BTILED = false, bool AGATHER = false, bool HALFM = false>
__device__ __forceinline__ void gemm_phase(LAS unsigned char* lds, const Gemm g, const Sched& S, const Epi& E, unsigned long long* stamps) {
    const int tid = threadIdx.x, wid = __builtin_amdgcn_readfirstlane(tid >> 6), lane = tid & 63, wr = wid >> 2, wc = wid & 3, fr = lane & 15, fq = lane >> 4;
    const int K = g.K, nt = K / BK;
    int ts_lo = 0, ts_hi = 0, nts = 0; const unsigned long long rt_entry = STAMP ? (unsigned long long)wall_clock64() : 0ull;
#define PG8_STAMP() do { if (STAMP && wid == 0 && nts < 64) { const unsigned long long _c = (unsigned long long)clock64(); \
        ts_lo = (lane == nts) ? (int)(unsigned)_c : ts_lo; ts_hi = (lane == nts) ? (int)(unsigned)(_c >> 32) : ts_hi; ++nts; } } while (0)
    PG8_STAMP();
    unsigned voffA[2], voffB[2];
#pragma unroll
    for (int i = 0; i < 2; ++i) { int R, C; stage_rc(tid * 16 + i * 8192, R, C); const int Rb = Epi::PERM ? ((R & ~31) + perm32(R & 31)) : R;
        voffA[i] = (unsigned)(R * (ATILED ? BK : K) + C) * 2u; voffB[i] = (unsigned)(Rb * (BTILED ? BK : K) + C) * 2u; }
    const size_t kstepA = ATILED ? (size_t)BM * BK * 2 : (size_t)(BK * 2), kstepB = BTILED ? (size_t)BM * BK * 2 : (size_t)(BK * 2);
    const size_t hstepA = ATILED ? (size_t)HALF * BK * 2 : (size_t)HALF * K * 2, hstepB = BTILED ? (size_t)HALF * BK * 2 : (size_t)HALF * K * 2;
    const size_t tstep = (size_t)BM * K * 2;
    const unsigned ldsw = (unsigned)wid * 1024u;
    static_assert(!(AGATHER && ATILED), "a gathered operand is row-major");
    int gR0 = 0, gC0 = 0; { int R, C; stage_rc(tid * 16, R, C); gR0 = R; gC0 = C * 2; }
    unsigned vAc[4] = {0u, 0u, 0u, 0u};
    LAS int* gslot = (LAS int*)(lds + STAGE_BYTES + 8192 + 2048);
    const int aoff = lds_byte(wr * 64 + fr, fq * 8), boff = lds_byte(wc * 32 + fr, fq * 8);
#define PG8_SA(b, h) (((b) * 2 + (h)) * HTB)
#define PG8_SB(b, h) ((4 + (b) * 2 + (h)) * HTB)
#define PG8_STAGE(bufoff, gbase, voff) do { _Pragma("unroll") for (int _i = 0; _i < 2; ++_i) \
        __builtin_amdgcn_global_load_lds((const unsigned*)((const char*)(gbase) + (voff)[_i]), (LAS unsigned*)(lds + (bufoff) + ldsw + _i * 8192), 16, 0, 0); } while (0)
#define PG8_STAGE_A(bufoff, gbase, kbytes, h, vg) do { if constexpr (AGATHER) { _Pragma("unroll") for (int _i = 0; _i < 2; ++_i) \
        __builtin_amdgcn_global_load_lds((const unsigned*)((const char*)g.A + (kbytes) + (vg)[(HALFM ? hsrc : (h)) * 2 + _i]), (LAS unsigned*)(lds + (bufoff) + ldsw + _i * 8192), 16, 0, 0); } \
        else PG8_STAGE(bufoff, (gbase) + (HALFM ? (size_t)hsrc * hstepA : (size_t)0), voffA); } while (0)
#define PG8_LDA(dst, b, h) do { _Pragma("unroll") for (int m = 0; m < 4; ++m) _Pragma("unroll") for (int k = 0; k < 2; ++k) dst[m][k] = *(const LAS bf16x8*)(lds + PG8_SA(b, h) + aoff + m * 2048 + k * 1024); } while (0)
#define PG8_LDB(dst, b, h) do { _Pragma("unroll") for (int n = 0; n < 2; ++n) _Pragma("unroll") for (int k = 0; k < 2; ++k) dst[n][k] = *(const LAS bf16x8*)(lds + PG8_SB(b, h) + boff + n * 2048 + k * 1024); } while (0)
#define PG8_MMA(ai, bj, At, Bt) do { __builtin_amdgcn_s_setprio(1); _Pragma("unroll") for (int m = 0; m < 4; ++m) _Pragma("unroll") for (int n = 0; n < 2; ++n) _Pragma("unroll") for (int k = 0; k < 2; ++k) \
        acc[ai][bj][m][n] = __builtin_amdgcn_mfma_f32_16x16x32_bf16(Bt[n][k], At[m][k], acc[ai][bj][m][n], 0, 0, 0); __builtin_amdgcn_s_setprio(0); } while (0)
#define PG8_WAIT_V(n) asm volatile("s_waitcnt vmcnt(" #n ")" ::: "memory")
#define PG8_WAIT_L(n) asm volatile("s_waitcnt lgkmcnt(" #n ")" ::: "memory")
#define PG8_BAR __builtin_amdgcn_s_barrier()
#define PG8_SCHED __builtin_amdgcn_sched_barrier(0)
    Unit cur, nxt; int ui = 0;
    if (!S.next(0, cur)) return;
    f32x4 acc[2][2][4][2];
#pragma unroll
    for (int a = 0; a < 2; ++a)
#pragma unroll
        for (int b = 0; b < 2; ++b)
#pragma unroll
            for (int m = 0; m < 4; ++m)
#pragma unroll
                for (int n = 0; n < 2; ++n) acc[a][b][m][n] = (f32x4){0.f, 0.f, 0.f, 0.f};
    bf16x8 At[4][2], B0[2][2], B1[2][2];
    const char* cA = (const char*)g.A + (size_t)cur.pm * tstep; const char* cB = (const char*)g.Bt + (size_t)cur.pn * tstep;
    S.a_ready(cur);
    if constexpr (AGATHER) {
#pragma unroll
        for (int j = 0; j < 4; ++j) vAc[j] = (unsigned)g.aidx[cur.pm * BM + gR0 + 64 * j] * (unsigned)(K * 2) + (unsigned)gC0;
    }
    int hsrc = HALFM ? cur.hh : 0;
    if constexpr (HALFM) {
        PG8_STAGE(PG8_SB(0, 0), cB, voffB); PG8_STAGE_A(PG8_SA(0, 0), cA, 0, 0, vAc); PG8_STAGE(PG8_SB(0, 1), cB + hstepB, voffB);
        if (wr == 1) PG8_BAR;
        PG8_WAIT_V(2); PG8_BAR;
    } else {
    PG8_STAGE(PG8_SB(0, 0), cB, voffB); PG8_STAGE_A(PG8_SA(0, 0), cA, 0, 0, vAc); PG8_STAGE(PG8_SB(0, 1), cB + hstepB, voffB); PG8_STAGE_A(PG8_SA(0, 1), cA + hstepA, 0, 1, vAc);
    if (wr == 1) PG8_BAR;
    PG8_WAIT_V(4); PG8_BAR;
    }
    PG8_STAGE(PG8_SB(1, 0), cB + kstepB, voffB); PG8_STAGE_A(PG8_SA(1, 0), cA + kstepA, BK * 2, 0, vAc); PG8_STAGE(PG8_SB(1, 1), cB + hstepB + kstepB, voffB);
    PG8_WAIT_V(6); PG8_BAR;
    PG8_STAMP();
    for (;;) {
        const bool has_next = S.next(ui + 1, nxt);
        const char* nA = has_next ? (const char*)g.A + (size_t)nxt.pm * tstep : cA; const char* nB = has_next ? (const char*)g.Bt + (size_t)nxt.pn * tstep : cB;
        E.pre(lds, ui & 1, cur, wid, lane);
        if constexpr (AGATHER) { if (has_next && wid == 0) __builtin_amdgcn_global_load_lds((const unsigned*)(g.aidx + nxt.pm * BM + lane * 4), (LAS unsigned*)(gslot + ((ui + 1) & 1) * 256), 16, 0, 0); }
        for (int t = 0; t < nt; t += 2) {
            const bool last = (t == nt - 2);
            const char* a1 = cA + (size_t)(t + 1) * kstepA;
            const char* a2 = last ? nA : cA + (size_t)(t + 2) * kstepA; const char* b2 = last ? nB : cB + (size_t)(t + 2) * kstepB;
            const char* a3 = a2 + kstepA; const char* b3 = b2 + kstepB;
            if (last && has_next) S.a_ready(nxt);
            const int kb2 = AGATHER ? (last ? 0 : (t + 2) * BK * 2) : 0;
            PG8_LDB(B0, 0, 0); PG8_SCHED; PG8_LDA(At, 0, 0); if constexpr (!HALFM) PG8_STAGE_A(PG8_SA(1, 1), a1 + hstepA, (t + 1) * BK * 2, 1, vAc);
            if constexpr (AGATHER) { if (last && has_next) {
#pragma unroll
                for (int j = 0; j < 4; ++j) vAc[j] = (unsigned)gslot[((ui + 1) & 1) * 256 + gR0 + 64 * j] * (unsigned)(K * 2) + (unsigned)gC0; } }
            PG8_WAIT_L(8); PG8_BAR; PG8_WAIT_L(0); PG8_MMA(0, 0, At, B0); PG8_BAR; PG8_SCHED;
            PG8_LDB(B1, 0, 1); PG8_STAGE(PG8_SB(0, 0), b2, voffB);
            PG8_BAR; PG8_WAIT_L(0); PG8_MMA(0, 1, At, B1); PG8_BAR;
            if constexpr (HALFM) { if (last && has_next) hsrc = nxt.hh; }
            if constexpr (!HALFM) PG8_LDA(At, 0, 1); PG8_STAGE_A(PG8_SA(0, 0), a2, kb2, 0, vAc);
            PG8_BAR; PG8_WAIT_L(0); if constexpr (!HALFM) PG8_MMA(1, 0, At, B0); PG8_BAR; PG8_SCHED;
            PG8_STAGE(PG8_SB(0, 1), b2 + hstepB, voffB);
            PG8_WAIT_V(6); PG8_BAR; if constexpr (!HALFM) PG8_MMA(1, 1, At, B1); PG8_BAR;
            PG8_LDB(B0, 1, 0); PG8_SCHED; PG8_LDA(At, 1, 0); if constexpr (!HALFM) PG8_STAGE_A(PG8_SA(0, 1), a2 + hstepA, kb2, 1, vAc);
            PG8_WAIT_L(8); PG8_BAR; PG8_WAIT_L(0); PG8_MMA(0, 0, At, B0); PG8_BAR; PG8_SCHED;
            PG8_LDB(B1, 1, 1); PG8_STAGE(PG8_SB(1, 0), b3, voffB);
            PG8_BAR; PG8_WAIT_L(0); PG8_MMA(0, 1, At, B1); PG8_BAR;
            if constexpr (!HALFM) PG8_LDA(At, 1, 1); PG8_STAGE_A(PG8_SA(1, 0), a3, kb2 + BK * 2, 0, vAc);
            PG8_BAR; PG8_WAIT_L(0); if constexpr (!HALFM) PG8_MMA(1, 0, At, B0); PG8_BAR; PG8_SCHED;
            PG8_STAGE(PG8_SB(1, 1), b3 + hstepB, voffB);
            PG8_WAIT_V(6); PG8_BAR; if constexpr (!HALFM) PG8_MMA(1, 1, At, B1); PG8_BAR;
        }
        PG8_STAMP();
        if constexpr (!Epi::AFTER_DRAIN) { E.template store<HALFM>(acc, cur, wr, wc, fr, fq, lds, ui & 1); S.done(cur); }
        PG8_STAMP();
        if (!has_next) break;
#pragma unroll
        for (int a = 0; a < 2; ++a)
#pragma unroll
            for (int b = 0; b < 2; ++b)
#pragma unroll
                for (int m = 0; m < 4; ++m)
#pragma unroll
                    for (int n = 0; n < 2; ++n) acc[a][b][m][n] = (f32x4){0.f, 0.f, 0.f, 0.f};
        cur = nxt; cA = nA; cB = nB; ++ui;

    }
    PG8_WAIT_V(0);
    if (wr == 0) PG8_BAR;
    PG8_BAR;
    if constexpr (Epi::AFTER_DRAIN) { E.fused(acc, cur, wr, wc, fr, fq, lds, wid, lane); S.done(cur); }
    PG8_STAMP();
    if (STAMP && wid == 0) { stamps[lane] = lane < nts ? (((unsigned long long)(unsigned)ts_hi << 32) | (unsigned)ts_lo) : 0ull;
        if (lane == 62) stamps[62] = rt_entry; if (lane == 63) stamps[63] = (unsigned long long)wall_clock64(); }
#undef PG8_STAMP
#undef PG8_SA
#undef PG8_SB
#undef PG8_STAGE
#undef PG8_STAGE_A
#undef PG8_LDA
#undef PG8_LDB
#undef PG8_MMA
#undef PG8_WAIT_V
#undef PG8_WAIT_L
#undef PG8_BAR
#undef PG8_SCHED
}
__device__ __forceinline__ int xcd_contig(long L, int nwg) { const int q = nwg / NXCD, r = nwg % NXCD, xcd = (int)(L % NXCD), off = (int)(L / NXCD); return (xcd < r ? xcd * (q + 1) : r * (q + 1) + (xcd - r) * q) + off; }
__device__ __forceinline__ bool tail_split(int nwg, int G, int& nlim) { const int full = (nwg / G) * G, tail = nwg - full; const bool sp = tail > 0 && 2 * tail <= G && (G & 15) == 0; nlim = sp ? full : nwg; return sp; }
template <int nN, int MODE = 0>
struct SchedDense {
    int nM, pm0, G, c;
    __device__ __forceinline__ bool next(int i, Unit& u) const {
        const int nwg = nM * nN; long L = (long)i * G + c; int hh = 0;
        if (MODE != 0) { int nlim; const bool sp = tail_split(nwg, G, nlim);
            if (MODE == 1) { if (L >= nlim) return false; }
            else { if (!sp || i != 0) return false; const int j = (c & 7) + 8 * (c >> 4); if (nlim + j >= nwg) return false; L = nlim + j; hh = (c >> 3) & 1; } }
        if (L >= nwg) return false;
        const int wgid = xcd_contig(L, nwg);
        constexpr int nig = WGM * nN; const int gid = wgid / nig, fm = gid * WGM, gsz = (nM - fm) < WGM ? (nM - fm) : WGM, w = wgid % nig;
        if (gsz == WGM) { u.pm = pm0 + fm + (w & (WGM - 1)); u.pn = w >> 3; } else { u.pm = pm0 + fm + (w % gsz); u.pn = w / gsz; }
        u.hh = hh;
        return true; }
    __device__ __forceinline__ void a_ready(const Unit&) const {}
    __device__ __forceinline__ void done(const Unit&) const {}
};
template <int nN, int MODE = 0>
struct SchedMoe {
    int T, G, c; const LAS int* tileE;
    __device__ __forceinline__ bool next(int i, Unit& u) const { const int nwg = T * nN; long L = (long)i * G + c; int hh = 0;
        if (MODE != 0) { int nlim; const bool sp = tail_split(nwg, G, nlim);
            if (MODE == 1) { if (L >= nlim) return false; }
            else { if (!sp || i != 0) return false; const int j = (c & 7) + 8 * (c >> 4); if (nlim + j >= nwg) return false; L = nlim + j; hh = (c >> 3) & 1; } }
        if (L >= nwg) return false;
        const int wgid = xcd_contig(L, nwg), pt = wgid / nN; u.pm = pt; u.pn = tileE[pt] * nN + (wgid % nN); u.hh = hh; return true; }
    __device__ __forceinline__ void a_ready(const Unit&) const {}
    __device__ __forceinline__ void done(const Unit&) const {}
};
constexpr int EPI_BIAS_OFF = STAGE_BYTES + 8192;
struct EpiStore {
    static constexpr bool PERM = true, AFTER_DRAIN = false;
    bf16_t* O; int ldc;
    __device__ __forceinline__ void pre(LAS unsigned char*, int, const Unit&, int, int) const {}
    template <bool HF> __device__ __forceinline__ void store(const f32x4 (&acc)[2][2][4][2], const Unit& u, int wr, int wc, int fr, int fq, const LAS unsigned char*, int) const {
        const int row0 = u.pm * BM + wr * 64 + fr + (HF ? u.hh * HALF : 0), col0 = u.pn * BM + wc * 32 + 8 * fq;
#pragma unroll
        for (int ai = 0; ai < (HF ? 1 : 2); ++ai)
#pragma unroll
            for (int m = 0; m < 4; ++m) { bf16_t* rowp = O + (size_t)(row0 + ai * HALF + m * 16) * ldc + col0;
#pragma unroll
                for (int bj = 0; bj < 2; ++bj) { const f32x4 v0 = acc[ai][bj][m][0], v1 = acc[ai][bj][m][1];
                    u32x4 w; w.x = cvt_pk_bf16(v0[0], v0[1]); w.y = cvt_pk_bf16(v0[2], v0[3]); w.z = cvt_pk_bf16(v1[0], v1[1]); w.w = cvt_pk_bf16(v1[2], v1[3]);
                    *(u32x4*)(rowp + bj * HALF) = w; } }
    }
};
struct EpiYE {
    static constexpr bool PERM = true, AFTER_DRAIN = false;
    bf16_t* O; const float* b2;
    __device__ __forceinline__ void pre(LAS unsigned char* lds, int par, const Unit& u, int wid, int lane) const {
        if (wid == 0) __builtin_amdgcn_global_load_lds((const unsigned*)(b2 + (u.pn >> 2) * 1024 + (u.pn & 3) * BM + lane * 4), (LAS unsigned*)(lds + EPI_BIAS_OFF + par * 1024), 16, 0, 0);
    }
    template <bool HF> __device__ __forceinline__ void store(const f32x4 (&acc)[2][2][4][2], const Unit& u, int wr, int wc, int fr, int fq, const LAS unsigned char* lds, int par) const {
        const int pn = u.pn & 3;
        const int row0 = u.pm * BM + wr * 64 + fr + (HF ? u.hh * HALF : 0), col0 = pn * BM + wc * 32 + 8 * fq;
        const LAS float* bp = (const LAS float*)(lds + EPI_BIAS_OFF + par * 1024) + wc * 32 + 8 * fq;
        f32x4 bv[2][2];
#pragma unroll
        for (int bj = 0; bj < 2; ++bj)
#pragma unroll
            for (int n = 0; n < 2; ++n) bv[bj][n] = *(const LAS f32x4*)(bp + bj * HALF + 4 * n);
#pragma unroll
        for (int ai = 0; ai < (HF ? 1 : 2); ++ai)
#pragma unroll
            for (int m = 0; m < 4; ++m) { bf16_t* rowp = O + (size_t)(row0 + ai * HALF + m * 16) * 1024 + col0;
#pragma unroll
                for (int bj = 0; bj < 2; ++bj) { const f32x4 v0 = acc[ai][bj][m][0] + bv[bj][0], v1 = acc[ai][bj][m][1] + bv[bj][1];
                    u32x4 w; w.x = cvt_pk_bf16(v0[0], v0[1]); w.y = cvt_pk_bf16(v0[2], v0[3]); w.z = cvt_pk_bf16(v1[0], v1[1]); w.w = cvt_pk_bf16(v1[2], v1[3]);
                    *(u32x4*)(rowp + bj * HALF) = w; } }
    }
};
struct EpiAct {
    static constexpr bool PERM = true, AFTER_DRAIN = false;
    bf16_t* O; const float* b1;
    __device__ __forceinline__ void pre(LAS unsigned char* lds, int par, const Unit& u, int wid, int lane) const {
        if (wid == 0) __builtin_amdgcn_global_load_lds((const unsigned*)(b1 + (u.pn >> 3) * 2048 + (lane >> 5) * 1024 + (u.pn & 7) * 128 + (lane & 31) * 4), (LAS unsigned*)(lds + EPI_BIAS_OFF + par * 1024), 16, 0, 0);
    }
    template <bool HF> __device__ __forceinline__ void store(const f32x4 (&acc)[2][2][4][2], const Unit& u, int wr, int wc, int fr, int fq, const LAS unsigned char* lds, int par) const {
        const int pn = u.pn & 7;
        const int row0 = u.pm * BM + wr * 64 + fr, x0 = pn * 128 + wc * 32 + 8 * fq, hro = HF ? u.hh * HALF : 0;
        const LAS float* bg = (const LAS float*)(lds + EPI_BIAS_OFF + par * 1024) + wc * 32 + 8 * fq; const LAS float* bl = bg + 128;
        const f32x4 g0 = *(const LAS f32x4*)bg, g1 = *(const LAS f32x4*)(bg + 4), l0 = *(const LAS f32x4*)bl, l1 = *(const LAS f32x4*)(bl + 4);
#pragma unroll
        for (int ai = 0; ai < (HF ? 1 : 2); ++ai)
#pragma unroll
            for (int m = 0; m < 4; ++m) {
                float o[8];
#pragma unroll
                for (int n = 0; n < 2; ++n)
#pragma unroll
                    for (int j = 0; j < 4; ++j) {
                        float glu = acc[ai][0][m][n][j] + (n ? g1[j] : g0[j]);
                        float lin = acc[ai][1][m][n][j] + (n ? l1[j] : l0[j]);
                        glu = fminf(glu, 7.0f); lin = fminf(fmaxf(lin, -7.0f), 7.0f);
                        o[n * 4 + j] = (lin + 1.0f) * glu * __builtin_amdgcn_rcpf(1.0f + __expf(-1.702f * glu));
                    }
                u32x4 w; w.x = cvt_pk_bf16(o[0], o[1]); w.y = cvt_pk_bf16(o[2], o[3]); w.z = cvt_pk_bf16(o[4], o[5]); w.w = cvt_pk_bf16(o[6], o[7]);
                *(u32x4*)(O + ((size_t)(u.pm * 16 + (x0 >> 6)) * 256 + (wr * 64 + fr + hro + ai * HALF + m * 16)) * 64 + (x0 & 63)) = w;
            }
    }
};
}
using pg8::Unit;
__device__ __forceinline__ void my_sincos(double a, float& s, float& c) {
    const double n = rint(a * 0.63661977236758134308);
    const double r = (a - n * 1.57079632679489655800e+00) - n * 6.12323399573676603587e-17;
    const double r2 = r * r;
    const double sp = r * (1.0 + r2 * (-1.0 / 6.0 + r2 * (1.0 / 120.0 + r2 * (-1.0 / 5040.0 + r2 * (1.0 / 362880.0 + r2 * (-1.0 / 39916800.0 + r2 * (1.0 / 6227020800.0 + r2 * (-1.0 / 1307674368000.0))))))));
    const double cp = 1.0 + r2 * (-0.5 + r2 * (1.0 / 24.0 + r2 * (-1.0 / 720.0 + r2 * (1.0 / 40320.0 + r2 * (-1.0 / 3628800.0 + r2 * (1.0 / 479001600.0 + r2 * (-1.0 / 87178291200.0 + r2 * (1.0 / 20922789888000.0))))))));
    const int q = ((int)n) & 3;
    const double sn = q == 0 ? sp : q == 1 ? cp : q == 2 ? -sp : -cp;
    const double cn = q == 0 ? cp : q == 1 ? -sp : q == 2 ? -cp : sp;
    s = (float)sn; c = (float)cn;
}
__device__ __forceinline__ void ph_prologue(const Params& p, LAS unsigned char* lds, int bid, int nblk) {
    const int tid = threadIdx.x;
    unsigned char* ws = p.ws;
    {
        LAS float* sv = (LAS float*)(lds + LDS_WORK);
        LAS float* red = sv + 5 * 1024;
        for (int i = tid; i < 5 * 1024; i += NTHR) { const int r = i >> 10, k = i & 1023; const float c = r < 4 ? p.in[I_C][r * 1024 + k] : p.in[I_CCTX][k]; sv[i] = c / (1.0f + expf(-c)); }
        __syncthreads();
        float* MOD = (float*)(ws + WS_MOD);
        for (int item = bid; item < 256; item += nblk) {
            if (tid < 480) {
                const int cl = tid % 48, kp = tid / 48;
                const int gc = item * 48 + cl, l = gc / 6144, n = gc % 6144;
                const float* w = p.in[I_WMOD] + (size_t)l * 1024 * 6144 + n;
                float a0 = 0.f, a1 = 0.f, a2 = 0.f, a3 = 0.f, a4 = 0.f;
#pragma unroll 1
                for (int k0 = kp; k0 < 1024; k0 += 130) {
                    float wv[13];
#pragma unroll
                    for (int u = 0; u < 13; ++u) { const int k = k0 + 10 * u; wv[u] = k < 1024 ? w[(size_t)k * 6144] : 0.f; }
#pragma unroll
                    for (int u = 0; u < 13; ++u) { const int k = k0 + 10 * u < 1024 ? k0 + 10 * u : 1023; a0 += sv[k] * wv[u]; a1 += sv[1024 + k] * wv[u]; a2 += sv[2048 + k] * wv[u]; a3 += sv[3072 + k] * wv[u]; a4 += sv[4096 + k] * wv[u]; }
                }
                LAS float* rp = red + (kp * 48 + cl) * 5; rp[0] = a0; rp[1] = a1; rp[2] = a2; rp[3] = a3; rp[4] = a4;
            }
            __syncthreads();
            if (tid < 240) {
                const int cl = tid / 5, r = tid % 5; float s = 0.f;
                for (int kp = 0; kp < 10; ++kp) s += red[(kp * 48 + cl) * 5 + r];
                const int gc = item * 48 + cl, l = gc / 6144, n = gc % 6144;
                MOD[(size_t)(l * 5 + r) * 6144 + n] = s + p.in[I_BMOD][l * 6144 + n];
            }
            __syncthreads();
        }
    }
    if (bid == (nblk > 1 ? 1 : 0)) {
        float* ROPE = (float*)(ws + WS_ROPE);
        for (int i = tid; i < 2048; i += NTHR) { const int pos = i >> 5, f = i & 31; const double inv = exp(-(double)f * 0.28782313662425575); float s, c; my_sincos((double)pos * inv, s, c); ROPE[2 * i] = c; ROPE[2 * i + 1] = s; }
    }
    {
        bf16_t* WLT = (bf16_t*)(ws + WS_WLT);
        for (int i = bid * NTHR + tid; i < (int)WLT_N; i += nblk * NTHR) {
            float v;
            if (i < 131072) { const int which = i >> 16, r = i & 65535, d = r >> 15, n = (r >> 6) & 511, k = r & 63; v = (which ? p.in[I_AAB] : p.in[I_AWB])[(size_t)(d * 64 + k) * 512 + n]; }
            else if (i < 196608) { const int r = i - 131072, n = r >> 7, k = r & 127; v = p.in[I_AGB][(size_t)k * 512 + n]; }
            else { const int r = i - 196608, blk = r >> 12, o = (r >> 6) & 63, ii = r & 63; v = p.in[I_BGW][(size_t)blk * 4096 + ii * 64 + o]; }
            WLT[i] = f2bf(v);
        }
    }
    {
        LAS float* tile = (LAS float*)(lds + LDS_WORK);
        for (int t = bid; t < 576; t += nblk) {
            const float* src; int ld, nvalid, k0, n0, w1map = 0; bf16_t* dst; int tt = t;
            if (tt < 192) { k0 = (tt / 12) * 64; n0 = (tt % 12) * 256; src = p.in[I_EWIN]; ld = EVEN_IN; nvalid = EVEN_IN; dst = (bf16_t*)(ws + WS_WIN0T); }
            else if ((tt -= 192) < 256) { k0 = (tt >> 4) * 64; n0 = (tt & 15) * 256; src = p.in[I_OWIN]; ld = ODD_IN; nvalid = 4096; dst = (bf16_t*)(ws + WS_WIN1T); }
            else { tt -= 256; const int mat = tt >> 6, r = tt & 63; k0 = (r >> 2) * 64; n0 = (r & 3) * 256; src = mat ? p.in[I_OWOUT] : p.in[I_EWOUT]; ld = 1024; nvalid = 1024; dst = (bf16_t*)(ws + WS_WOUTT) + (size_t)mat * 1024 * 1024; }
            {
                const int j4 = (tid & 63) * 4, i0 = tid >> 6;
                f32x4 v[8];
#pragma unroll
                for (int r = 0; r < 8; ++r) v[r] = (n0 + j4 < nvalid) ? *(const f32x4*)(src + (size_t)(k0 + i0 + 8 * r) * ld + n0 + j4) : (f32x4){0.f, 0.f, 0.f, 0.f};
#pragma unroll
                for (int r = 0; r < 8; ++r) { LAS float* tp = tile + (i0 + 8 * r) * 257 + j4; tp[0] = v[r][0]; tp[1] = v[r][1]; tp[2] = v[r][2]; tp[3] = v[r][3]; }
            }
            __syncthreads();
            {
                const int ip = (tid & 31) * 2, j0 = tid >> 5;
#pragma unroll
                for (int r = 0; r < 16; ++r) {
                    const int j = j0 + 16 * r, n = n0 + j;
                    const int rho = w1map ? ((((n & 1023) >> 7) << 8) + ((n >> 10) << 7) + (n & 127)) : n;
                    *(unsigned*)(dst + (size_t)rho * 1024 + k0 + ip) = pack_bf16(tile[ip * 257 + j], tile[(ip + 1) * 257 + j]);
                }
            }
            __syncthreads();
        }
    }
}
__device__ __forceinline__ void ph_mod_in(const Params& p, int bid, int nblk) {
    const int tid = threadIdx.x, wid = tid >> 6, lane = tid & 63;
    const float* MOD = (const float*)(p.ws + WS_MOD);
    bf16_t* H = (bf16_t*)(p.ws + WS_H);
    for (int row = bid * 8 + wid; row < MROWS; row += nblk * 8) {
        const float* src = row < NCTX ? p.in[I_CTX] + (size_t)row * 1024 : p.in[I_X] + (size_t)(row - NCTX) * 1024;
        const float* md = MOD + (size_t)row_modr(row) * 6144;
#pragma unroll
        for (int q = 0; q < 4; ++q) {
            const int col = q * 256 + lane * 4;
            const f32x4 x = *(const f32x4*)(src + col), sh = *(const f32x4*)(md + col), sc = *(const f32x4*)(md + 1024 + col);
            const f32x4 h = x * (sc + 1.0f) + sh;
            u32x2 w; w.x = pack_bf16(h[0], h[1]); w.y = pack_bf16(h[2], h[3]);
            *(u32x2*)(H + (size_t)row * 1024 + col) = w;
        }
    }
}
__device__ __forceinline__ int even_tok_row(int w, int idx) { return idx < 64 ? NCTX + (w >> 6) * 4096 + (w & 63) * 64 + idx : w * 4 + (idx - 64); }
__device__ __forceinline__ int shift_nb(int row, int cc) {
    if (row >= NCTX) { const int s = (row - NCTX) & 4095, gr = s >> 6, gc = s & 63, slot = cc & 3;
        if (slot == 0) return gc > 0 ? row - 1 : -1;
        if (slot == 1) return gc < 63 ? row + 1 : -1;
        if (slot == 2) return gr > 0 ? row - 64 : -1;
        return gr < 63 ? row + 64 : -1; }
    const int t = row & 255; return (cc & 1) == 0 ? (t > 0 ? row - 1 : -1) : (t < 255 ? row + 1 : -1);
}
__device__ __forceinline__ float shifted_z(const bf16_t* P, const float* mu, int row, int cc) {
    const float pv = bf2f(P[(size_t)row * LDP0 + cc]); const int nb = shift_nb(row, cc);
    const float sv = nb >= 0 ? bf2f(P[(size_t)nb * LDP0 + cc]) : 0.f;
    return pv + (sv - pv) * mu[cc];
}
__device__ __forceinline__ int scan_q(int row, int d) {
    if (row < NCTX) { const int t = row & 255; return d ? 255 - t : t; }
    const int s = (row - NCTX) & 4095; return 256 + (d ? 4095 - s : s);
}
__device__ __forceinline__ bf16_t* sc_rec(float* SC, int d, int row, int h) { return (bf16_t*)SC + ((size_t)((d * 4 + row_batch(row)) * 8 + h) * SCLEN + scan_q(row, d)) * SCREC; }
constexpr int LDL = 392, LDU = 520;
template <int KS>
__device__ __forceinline__ void load_b(const bf16_t* Bt, bf16x8 (&b)[4][KS], int lane) {
    const int fr = lane & 15, fq = lane >> 4;
#pragma unroll
    for (int nt = 0; nt < 4; ++nt)
#pragma unroll
        for (int ks = 0; ks < KS; ++ks) b[nt][ks] = *(const bf16x8*)(Bt + (size_t)(nt * 16 + fr) * (32 * KS) + ks * 32 + fq * 8);
}
template <int KS>
__device__ __forceinline__ void mma_mt(const LAS bf16_t* A, int lda, int mt, const bf16x8 (&b)[4][KS], f32x4 (&acc)[4], int lane) {
    const int fr = lane & 15, fq = lane >> 4;
#pragma unroll
    for (int nt = 0; nt < 4; ++nt) acc[nt] = (f32x4){0.f, 0.f, 0.f, 0.f};
#pragma unroll
    for (int ks = 0; ks < KS; ++ks) {
        const bf16x8 a = *(const LAS bf16x8*)(A + (mt * 16 + fr) * lda + ks * 32 + fq * 8);
#pragma unroll
        for (int nt = 0; nt < 4; ++nt) acc[nt] = __builtin_amdgcn_mfma_f32_16x16x32_bf16(a, b[nt][ks], acc[nt], 0, 0, 0);
    }
}
__device__ __forceinline__ void ph_prep_even(const Params& p, LAS unsigned char* lds, int bid, int nblk) {
    const bf16_t* P = (const bf16_t*)(p.ws + WS_P);
    float* SC = (float*)(p.ws + WS_SC);
    float* EA = (float*)(p.ws + WS_EARR);
#define EARR(k) (EA + (size_t)(k) * ((size_t)MROWS * 512))
    float* BC = (float*)(p.ws + WS_BC);
    float* CHA = (float*)(p.ws + WS_CHA); float* CHH = (float*)(p.ws + WS_CHH);
    const bf16_t* WLT = (const bf16_t*)(p.ws + WS_WLT);
    const float* mu = p.in[I_AMU];
    LAS bf16_t* linb = (LAS bf16_t*)(lds + LDS_WORK);
    LAS bf16_t* ub = linb + 80 * LDL;
    LAS float* rnorm = (LAS float*)(ub + 80 * LDU);
    for (int w = bid; w < 256; w += nblk) {
        int tid_ = threadIdx.x; asm volatile("" : "+v"(tid_));
        const int tid = tid_, wid = tid >> 6, lane = tid & 63, fr = lane & 15, fq = lane >> 4;
        for (int i = tid; i < 12 * LDL; i += NTHR) linb[68 * LDL + i] = 0;
        for (int i = tid; i < 12 * LDU; i += NTHR) ub[68 * LDU + i] = 0;
        if (lane < 48) {
            float mul8[8];
#pragma unroll
            for (int i = 0; i < 8; ++i) mul8[i] = mu[1536 + lane * 8 + i];
#pragma unroll 1
            for (int tok = wid; tok < 68; tok += 8) {
                const int row = even_tok_row(w, tok);
                const u32x4 ps = *(const u32x4*)(P + (size_t)row * LDP0 + 1536 + lane * 8);
                u32x4 pn[4];
#pragma unroll
                for (int sl = 0; sl < 4; ++sl) { const int nb = shift_nb(row, sl); pn[sl] = nb >= 0 ? *(const u32x4*)(P + (size_t)nb * LDP0 + 1536 + lane * 8) : (u32x4){0u, 0u, 0u, 0u}; }
                float z[8];
#pragma unroll
                for (int i = 0; i < 8; ++i) { const unsigned wp = ps[i >> 1], wn = pn[i & 3][i >> 1];
                    const float pv = __uint_as_float((i & 1) ? (wp & 0xffff0000u) : (wp << 16)), sv = __uint_as_float((i & 1) ? (wn & 0xffff0000u) : (wn << 16));
                    const float zz = pv + (sv - pv) * mul8[i];
                    z[i] = lane < 16 ? ftanh(zz) : (lane < 32 ? zz : sigm(zz)); }
                u32x4 q;
#pragma unroll
                for (int i = 0; i < 4; ++i) q[i] = pack_bf16(z[2 * i], z[2 * i + 1]);
                *(LAS u32x4*)(linb + tok * LDL + lane * 8) = q;
            }
        }
        {
            float murv[8], mukv8[8], muvv[8], kkc8[8];
#pragma unroll
            for (int i = 0; i < 8; ++i) { murv[i] = mu[lane * 8 + i]; mukv8[i] = mu[512 + lane * 8 + i]; muvv[i] = mu[1024 + lane * 8 + i]; kkc8[i] = p.in[I_AKK][lane * 8 + i]; }
#pragma unroll 1
            for (int tok = wid; tok < 68; tok += 8) {
                const int row = even_tok_row(w, tok);
                int nbr[4];
#pragma unroll
                for (int sl = 0; sl < 4; ++sl) nbr[sl] = shift_nb(row, sl);
                u32x4 ps[3], pn[3][4];
#pragma unroll
                for (int a = 0; a < 3; ++a) { ps[a] = *(const u32x4*)(P + (size_t)row * LDP0 + a * 512 + lane * 8);
#pragma unroll
                    for (int sl = 0; sl < 4; ++sl) pn[a][sl] = nbr[sl] >= 0 ? *(const u32x4*)(P + (size_t)nbr[sl] * LDP0 + a * 512 + lane * 8) : (u32x4){0u, 0u, 0u, 0u}; }
                float z[3][8];
#pragma unroll
                for (int a = 0; a < 3; ++a)
#pragma unroll
                    for (int i = 0; i < 8; ++i) { const unsigned wp = ps[a][i >> 1], wn = pn[a][i & 3][i >> 1];
                        const float pv = __uint_as_float((i & 1) ? (wp & 0xffff0000u) : (wp << 16)), sv = __uint_as_float((i & 1) ? (wn & 0xffff0000u) : (wn << 16));
                        z[a][i] = pv + (sv - pv) * (a == 0 ? murv[i] : (a == 1 ? mukv8[i] : muvv[i])); }
                float kkr[8], ss = 0.f;
#pragma unroll
                for (int i = 0; i < 8; ++i) { kkr[i] = z[1][i] * kkc8[i]; ss += kkr[i] * kkr[i]; }
                ss += __int_as_float(__builtin_amdgcn_update_dpp(0, __float_as_int(ss), 0xb1, 0xf, 0xf, false));
                ss += __int_as_float(__builtin_amdgcn_update_dpp(0, __float_as_int(ss), 0x4e, 0xf, 0xf, false));
                ss += __int_as_float(__builtin_amdgcn_update_dpp(0, __float_as_int(ss), 0x141, 0xf, 0xf, false));
                const float rn = frcp(fmaxf(fsqrt(ss), 1e-12f));
                if ((lane & 7) == 0) rnorm[tok * 8 + (lane >> 3)] = rn;
                u32x4 qk, qr, qv;
#pragma unroll
                for (int i = 0; i < 4; ++i) { qk[i] = pack_bf16(kkr[2 * i] * rn, kkr[2 * i + 1] * rn); qr[i] = pack_bf16(z[0][2 * i], z[0][2 * i + 1]); qv[i] = pack_bf16(z[2][2 * i], z[2][2 * i + 1]); }
#pragma unroll
                for (int d = 0; d < 2; ++d) { bf16_t* rec = sc_rec(SC, d, row, lane >> 3) + (lane & 7) * 8; *(u32x4*)(rec + 128) = qk; *(u32x4*)(rec + 320) = qr; *(u32x4*)(rec + 384) = qv; }
            }
        }
        {
            float cw[4][8], cb8[8];
#pragma unroll
            for (int i = 0; i < 8; ++i) { cb8[i] = p.in[I_BCB][lane * 8 + i];
#pragma unroll
                for (int k = 0; k < 4; ++k) cw[k][i] = p.in[I_BCW][k * 512 + lane * 8 + i]; }
#pragma unroll 1
            for (int tok = wid; tok < 68; tok += 8) {
                const int row = even_tok_row(w, tok);
                int pos, len;
                if (row >= NCTX) { pos = (row - NCTX) & 4095; len = 4096; } else { pos = row & 255; len = 256; }
                const u32x4 zero4 = {0u, 0u, 0u, 0u};
                const bf16_t* px = P + (size_t)row * LDP0 + 1920 + lane * 8;
                u32x4 xv[4];
                xv[0] = pos >= 2 ? *(const u32x4*)(px - 2 * (size_t)LDP0) : zero4; xv[1] = pos >= 1 ? *(const u32x4*)(px - (size_t)LDP0) : zero4;
                xv[2] = *(const u32x4*)px; xv[3] = pos + 1 < len ? *(const u32x4*)(px + (size_t)LDP0) : zero4;
                const u32x4 gxv = *(const u32x4*)(px + 512);
                float uu[8], gg[8];
#pragma unroll
                for (int i = 0; i < 8; ++i) { float a = cb8[i];
#pragma unroll
                    for (int k = 0; k < 4; ++k) { const unsigned wv = xv[k][i >> 1]; a += cw[k][i] * __uint_as_float((i & 1) ? (wv & 0xffff0000u) : (wv << 16)); }
                    uu[i] = a;
                    const unsigned wg = gxv[i >> 1]; const float gx = __uint_as_float((i & 1) ? (wg & 0xffff0000u) : (wg << 16));
                    gg[i] = 0.5f * gx * (1.0f + ftanh(0.7978845608028654f * (gx + 0.044715f * gx * gx * gx))); }
                u32x4 qu, qg;
#pragma unroll
                for (int i = 0; i < 4; ++i) { qu[i] = pack_bf16(uu[2 * i], uu[2 * i + 1]); qg[i] = pack_bf16(gg[2 * i], gg[2 * i + 1]); }
                *(LAS u32x4*)(ub + tok * LDU + lane * 8) = qu;
                *(u32x4*)((bf16_t*)EARR(E_GATE) + (size_t)row * 512 + lane * 8) = qg;
            }
        }
        __syncthreads();
#pragma unroll 1
        for (int d = 0; d < 2; ++d) {
            {
                bf16x8 bw[4][2]; load_b<2>(WLT + WLT_WB + (size_t)(d * 512 + wid * 64) * 64, bw, lane);
                float w0v[4];
#pragma unroll
                for (int nt = 0; nt < 4; ++nt) w0v[nt] = p.in[I_AW0][d * 512 + wid * 64 + nt * 16 + fr];
#pragma unroll 1
                for (int mt = 0; mt < 5; ++mt) {
                    f32x4 acc[4]; mma_mt<2>(linb + d * 64, LDL, mt, bw, acc, lane);
#pragma unroll
                    for (int r = 0; r < 4; ++r) { const int tok = mt * 16 + fq * 4 + r;
                        if (tok < 68) { float* rec = (float*)sc_rec(SC, d, even_tok_row(w, tok), wid) + fr;
#pragma unroll
                            for (int nt = 0; nt < 4; ++nt) rec[nt * 16] = -0.60653065971263342f * sigm(w0v[nt] + acc[nt][r]);   } }
                }
            }
            {
                bf16x8 bw[4][2]; load_b<2>(WLT + WLT_AB + (size_t)(d * 512 + wid * 64) * 64, bw, lane);
                float a0v[4], kav[4], mukv[4], kkcv[4];
#pragma unroll
                for (int nt = 0; nt < 4; ++nt) { const int n = wid * 64 + nt * 16 + fr; a0v[nt] = p.in[I_AA0][d * 512 + n]; kav[nt] = p.in[I_AKA][n]; mukv[nt] = mu[512 + n]; kkcv[nt] = p.in[I_AKK][n]; }
#pragma unroll 1
                for (int mt = 0; mt < 5; ++mt) {
                    f32x4 acc[4]; mma_mt<2>(linb + 128 + d * 64, LDL, mt, bw, acc, lane);
                    float pkv[4][4], skv[4][4];
#pragma unroll
                    for (int r = 0; r < 4; ++r) { const int tok = mt * 16 + fq * 4 + r, row = even_tok_row(w, tok < 68 ? tok : 0);
#pragma unroll
                        for (int nt = 0; nt < 4; ++nt) { const int n = wid * 64 + nt * 16 + fr, nb = shift_nb(row, n);
                            pkv[r][nt] = bf2f(P[(size_t)row * LDP0 + 512 + n]); skv[r][nt] = nb >= 0 ? bf2f(P[(size_t)nb * LDP0 + 512 + n]) : 0.f; } }
#pragma unroll
                    for (int r = 0; r < 4; ++r) { const int tok = mt * 16 + fq * 4 + r;
                        if (tok < 68) { bf16_t* rec = sc_rec(SC, d, even_tok_row(w, tok), wid) + fr; const float rn = rnorm[tok * 8 + wid];
#pragma unroll
                            for (int nt = 0; nt < 4; ++nt) { const float a = sigm(a0v[nt] + acc[nt][r]);
                                const float zk = pkv[r][nt] + (skv[r][nt] - pkv[r][nt]) * mukv[nt];
                                rec[192 + nt * 16] = f2bf(zk * (1.0f + (a - 1.0f) * kav[nt])); rec[256 + nt * 16] = f2bf(zk * kkcv[nt] * rn * a); } } }
                }
            }
        }
        {
            bf16x8 bw[4][4]; load_b<4>(WLT + WLT_GB + (size_t)(wid * 64) * 128, bw, lane);
            bf16_t* G = (bf16_t*)EARR(E_G);
#pragma unroll 1
            for (int mt = 0; mt < 5; ++mt) {
                f32x4 acc[4]; mma_mt<4>(linb + 256, LDL, mt, bw, acc, lane);
#pragma unroll
                for (int r = 0; r < 4; ++r) { const int tok = mt * 16 + fq * 4 + r;
                    if (tok < 68) { bf16_t* gp = G + (size_t)even_tok_row(w, tok) * 512 + wid * 64 + fr;
#pragma unroll
                        for (int nt = 0; nt < 4; ++nt) gp[nt * 16] = f2bf(acc[nt][r]); } }
            }
        }
#pragma unroll 1
        for (int d = 0; d < 2; ++d) {
            bf16x8 b0[4][2];
            load_b<2>(WLT + WLT_GW + (size_t)(((d * 2 + 0) * 8 + wid) * 64) * 64, b0, lane);
            float gb0[4], gb1[4], spl[4];
#pragma unroll
            for (int nt = 0; nt < 4; ++nt) { const int n = wid * 64 + nt * 16 + fr; gb0[nt] = p.in[I_BGB][(d * 2 + 0) * 512 + n]; gb1[nt] = p.in[I_BGB][(d * 2 + 1) * 512 + n]; spl[nt] = softplusf(-p.in[I_BLAM][d * 512 + n]); }
            float* Ad = EARR(E_A0 + d); float* BXd = EARR(E_BX0 + d);
            float Cc[4], Hc[4];
#pragma unroll
            for (int nt = 0; nt < 4; ++nt) { Cc[nt] = 1.f; Hc[nt] = 0.f; }
#pragma unroll 1
            for (int it = 0; it < 5; ++it) {
                const int mt = it < 4 ? (d ? 3 - it : it) : 4;
                f32x4 la[4], acc[4];
                mma_mt<2>(ub + wid * 64, LDU, mt, b0, la, lane);
                { bf16x8 b1[4][2]; load_b<2>(WLT + WLT_GW + (size_t)(((d * 2 + 1) * 8 + wid) * 64) * 64, b1, lane); mma_mt<2>(ub + wid * 64, LDU, mt, b1, acc, lane); }
                if (it == 4) {
#pragma unroll
                    for (int nt = 0; nt < 4; ++nt) { Cc[nt] = 1.f; Hc[nt] = 0.f; } }
#pragma unroll
                for (int nt = 0; nt < 4; ++nt) {
                    float av[4], bx[4], lc[4], lh[4];
#pragma unroll
                    for (int r = 0; r < 4; ++r) { const int tok = mt * 16 + fq * 4 + r; const float lg = -8.0f * sigm(gb0[nt] + la[nt][r]) * spl[nt];
                        av[r] = fexp(lg); bx[r] = fsqrt(fmaxf(1.0f - av[r] * av[r], 0.f)) * sigm(gb1[nt] + acc[nt][r]) * bf2f(ub[tok * LDU + wid * 64 + nt * 16 + fr]);     }
                    float c = 1.f, hh = 0.f;
#pragma unroll
                    for (int i = 0; i < 4; ++i) { const int r = d ? 3 - i : i; hh = av[r] * hh + bx[r]; c *= av[r]; lc[r] = c; lh[r] = hh; }
                    float Ae = 1.f, Be = 0.f, At = 1.f, Bt = 0.f;
                    if (it < 4) {
#pragma unroll
                        for (int j = 0; j < 4; ++j) { const int g = d ? 3 - j : j; const float Ag = __shfl(c, fr + 16 * g, 64), Bg = __shfl(hh, fr + 16 * g, 64);
                            const bool before = d ? (g > fq) : (g < fq);
                            Be = before ? Ag * Be + Bg : Be; Ae = before ? Ae * Ag : Ae;
                            Bt = Ag * Bt + Bg; At = At * Ag; }
                    } else { At = __shfl(c, fr, 64); Bt = __shfl(hh, fr, 64); }
                    const float Hin = Ae * Hc[nt] + Be, Cin = Cc[nt] * Ae;
#pragma unroll
                    for (int r = 0; r < 4; ++r) { const int tok = mt * 16 + fq * 4 + r;
                        if (tok < 68) { const size_t o = (size_t)even_tok_row(w, tok) * 512 + wid * 64 + nt * 16 + fr; Ad[o] = Cin * lc[r]; BXd[o] = lh[r] + lc[r] * Hin; } }
                    Hc[nt] = At * Hc[nt] + Bt; Cc[nt] = Cc[nt] * At;
                }
                if (it >= 3 && fq == 0) {
                    const int cid = (w >> 6) * 128 + (it == 3 ? 64 : 0) + (w & 63);
#pragma unroll
                    for (int nt = 0; nt < 4; ++nt) { CHA[(size_t)(d * 512 + cid) * 512 + wid * 64 + nt * 16 + fr] = Cc[nt]; CHH[(size_t)(d * 512 + cid) * 512 + wid * 64 + nt * 16 + fr] = Hc[nt]; } }
            }
        }
        __syncthreads();
        {
            float rk8[8];
#pragma unroll
            for (int i = 0; i < 8; ++i) rk8[i] = p.in[I_ARK][lane * 8 + i];
#pragma unroll 1
            for (int tok = wid; tok < 68; tok += 8) {
                const int row = even_tok_row(w, tok);
                const bf16_t* r0 = sc_rec(SC, 0, row, lane >> 3) + (lane & 7) * 8; const bf16_t* r1 = sc_rec(SC, 1, row, lane >> 3) + (lane & 7) * 8;
                const u32x4 qr = *(const u32x4*)(r0 + 320), q0 = *(const u32x4*)(r0 + 192), q1 = *(const u32x4*)(r1 + 192);
                float sm = 0.f;
#pragma unroll
                for (int i = 0; i < 8; ++i) { const unsigned a = qr[i >> 1], b0 = q0[i >> 1], b1 = q1[i >> 1];
                    const float av = __uint_as_float((i & 1) ? (a & 0xffff0000u) : (a << 16)), b0v = __uint_as_float((i & 1) ? (b0 & 0xffff0000u) : (b0 << 16)), b1v = __uint_as_float((i & 1) ? (b1 & 0xffff0000u) : (b1 << 16));
                    sm += av * (b0v + b1v) * rk8[i]; }
                sm += __int_as_float(__builtin_amdgcn_update_dpp(0, __float_as_int(sm), 0xb1, 0xf, 0xf, false));
                sm += __int_as_float(__builtin_amdgcn_update_dpp(0, __float_as_int(sm), 0x4e, 0xf, 0xf, false));
                sm += __int_as_float(__builtin_amdgcn_update_dpp(0, __float_as_int(sm), 0x141, 0xf, 0xf, false));
                if ((lane & 7) == 0) BC[row * 8 + (lane >> 3)] = sm;
            }
        }
        __syncthreads();
    }
}
__device__ __forceinline__ float vfma(float a, float b, float c) { float d; asm("v_fma_f32 %0, %1, %2, %3" : "=v"(d) : "v"(a), "v"(b), "v"(c)); return d; }
__device__ __forceinline__ float vmul(float a, float b) { float d; asm("v_mul_f32 %0, %1, %2" : "=v"(d) : "v"(a), "v"(b)); return d; }
#define WG_BAR() do { asm volatile("" ::: "memory"); __builtin_amdgcn_s_barrier(); asm volatile("" ::: "memory"); } while (0)
__device__ __forceinline__ int scan_row(int d, int b, int q) {
    if (q < 256) return b * 256 + (d ? 255 - q : q);
    const int s = q - 256; return NCTX + b * 4096 + (d ? 4095 - s : s);
}
__device__ __forceinline__ void ph_fin_even(const Params& p, int bid, int nblk) {
    const int tid = threadIdx.x, wid = tid >> 6, c = tid;
    float* EA = (float*)(p.ws + WS_EARR);
    float* SC = (float*)(p.ws + WS_SC);
    const float* BC = (const float*)(p.ws + WS_BC); const float* CIN = (const float*)(p.ws + WS_CIN);
    bf16_t* Y = (bf16_t*)(p.ws + WS_YMIX);
    const float gg = p.in[I_AGNG][c], gb = p.in[I_AGNB][c];
    for (int r0 = bid * 4; r0 < MROWS; r0 += nblk * 4) {
        float o0[4], o1[4], vv[4], gv[4], bc[4], x0[4], x1[4], a0[4], a1[4], c0[4], c1[4], gt[4];
#pragma unroll
        for (int u = 0; u < 4; ++u) { const int row = r0 + u; const size_t o = (size_t)row * 512 + c;
            const int cid = row < NCTX ? (row >> 8) * 128 + ((row >> 2) & 63) : ((row - NCTX) >> 12) * 128 + 64 + (((row - NCTX) & 4095) >> 6);
            o0[u] = bf2f(((const bf16_t*)EARR(E_O0))[o]); o1[u] = bf2f(((const bf16_t*)EARR(E_O1))[o]); vv[u] = bf2f(sc_rec(SC, 0, row, wid)[384 + (tid & 63)]); gv[u] = bf2f(((const bf16_t*)EARR(E_G))[o]); bc[u] = BC[row * 8 + wid];
            x0[u] = EARR(E_BX0)[o]; x1[u] = EARR(E_BX1)[o]; a0[u] = EARR(E_A0)[o]; a1[u] = EARR(E_A1)[o];
            c0[u] = CIN[(size_t)cid * 512 + c]; c1[u] = CIN[(size_t)(512 + cid) * 512 + c]; gt[u] = bf2f(((const bf16_t*)EARR(E_GATE))[o]); }
#pragma unroll
        for (int u = 0; u < 4; ++u) { const int row = r0 + u;
            const float wkv = o0[u] + o1[u];
            const float mean = wave_sum(wkv) * (1.0f / 64.0f), dv = wkv - mean, var = wave_sum(dv * dv) * (1.0f / 64.0f);
            const float y = (dv * rsqrtf(var + 64e-5f) * gg + gb + bc[u] * vv[u]) * gv[u];
            Y[(size_t)row * 1024 + c] = f2bf(y);
            Y[(size_t)row * 1024 + 512 + c] = f2bf(((x0[u] + a0[u] * c0[u]) + (x1[u] + a1[u] * c1[u])) * gt[u]); }
    }
#undef EARR
}
constexpr int LDT = 72;
__device__ __forceinline__ float quad_sum(float v) {
    v += __int_as_float(__builtin_amdgcn_update_dpp(0, __float_as_int(v), 0xB1, 0xf, 0xf, false));
    v += __int_as_float(__builtin_amdgcn_update_dpp(0, __float_as_int(v), 0x4E, 0xf, 0xf, false));
    return v;
}
template <int PO> __device__ __forceinline__ float quad_bcast(float v) { return __int_as_float(__builtin_amdgcn_update_dpp(0, __float_as_int(v), PO * 0x55, 0xf, 0xf, false)); }
__device__ __forceinline__ bf16x8 ldt8(const LAS bf16_t* T, int row, int col) { return *(const LAS bf16x8*)(T + row * LDT + col); }
__device__ __forceinline__ void ph_r1(const Params& p, LAS unsigned char* lds, int bid, int nblk) {
    const int tid = threadIdx.x, wid = tid >> 6, lane = tid & 63, fr = lane & 15, fq = lane >> 4;
    LAS bf16_t* T0 = (LAS bf16_t*)(lds + LDS_WORK);
#define TL(i) (T0 + (i) * 64 * LDT)
    LAS float* F0 = (LAS float*)(T0 + 11 * 64 * LDT);
    LAS float* F1 = F0 + 4096;
    LAS float* F2 = F1 + 4096;
    LAS float* segt = F2 + 4096;
    LAS float* gl = segt + 512;
    const float* SC = (const float*)(p.ws + WS_SC);
    float* RU = (float*)(p.ws + WS_RU);
    const int k = tid & 63, seg = tid >> 6, t0 = seg * 8;
    const int tr = (wid >> 1) * 16, tc0 = (wid & 1) * 32;
    float kk[8], lw[8], kd[8], ka[8], rr[8], vv[8];
    auto fetch = [&](int unit) {
        const int chain = unit / NRCH, c = unit - chain * NRCH;
        const bf16_t* rec = (const bf16_t*)SC + ((size_t)chain * SCLEN + c * RCH + t0) * SCREC + k;
#pragma unroll
        for (int u = 0; u < 8; ++u) { const bf16_t* r = rec + u * SCREC; lw[u] = ((const float*)(r - k))[k]; kk[u] = bf2f(r[128]); kd[u] = bf2f(r[192]); ka[u] = bf2f(r[256]); rr[u] = bf2f(r[320]); vv[u] = bf2f(r[384]); }
    };
    if (bid < NRUNIT) fetch(bid);
    for (int unit = bid; unit < NRUNIT; unit += nblk) {
        int tid_ = threadIdx.x; asm volatile("" : "+v"(tid_));
        const int tid = tid_, wid = tid >> 6, lane = tid & 63, fr = lane & 15, fq = lane >> 4, k = tid & 63, seg = tid >> 6, t0 = seg * 8, tr = (wid >> 1) * 16, tc0 = (wid & 1) * 32;
        float cum[8]; { float run = 0.f;
#pragma unroll
            for (int u = 0; u < 8; ++u) { run += lw[u]; cum[u] = run; }
            segt[seg * 64 + k] = run; }
        __syncthreads();
        float off = 0.f, tot = 0.f;
#pragma unroll
        for (int s2 = 0; s2 < 8; ++s2) { const float v = segt[s2 * 64 + k]; off += s2 < seg ? v : 0.f; tot += v; }
        if (seg == 0) gl[k] = fexp(tot);
        {
            u32x4 wk, wb, wv; unsigned pk[4], pb[4], pv[4]; float hk = 0.f, hb = 0.f, hv = 0.f;
#pragma unroll
            for (int u = 0; u < 8; ++u) { const int t = t0 + u; const float cu = cum[u] + off;
                const float ginc = fexp(cu), gexc = fexp(cu - lw[u]), ginv = fexp(-cu), gtail = fexp(tot - cu);
                const float kt = kk[u] * gexc;
                TL(0)[t * LDT + k] = f2bf(kt); F0[t * 64 + k] = kt;
                TL(1)[t * LDT + k] = f2bf(kd[u] * ginv); TL(2)[t * LDT + k] = f2bf(ka[u] * ginv); TL(3)[t * LDT + k] = f2bf(rr[u] * ginc);
                const float ktl = kd[u] * gtail, btl = ka[u] * gtail;
                if (u & 1) { pk[u >> 1] = pack_bf16(hk, ktl); pb[u >> 1] = pack_bf16(hb, btl); pv[u >> 1] = pack_bf16(hv, vv[u]); } else { hk = ktl; hb = btl; hv = vv[u]; } }
            wk.x = pk[0]; wk.y = pk[1]; wk.z = pk[2]; wk.w = pk[3]; wb.x = pb[0]; wb.y = pb[1]; wb.z = pb[2]; wb.w = pb[3]; wv.x = pv[0]; wv.y = pv[1]; wv.z = pv[2]; wv.w = pv[3];
            *(LAS u32x4*)(TL(4) + k * LDT + t0) = wk; *(LAS u32x4*)(TL(5) + k * LDT + t0) = wb; *(LAS u32x4*)(TL(6) + k * LDT + t0) = wv;
        }
        if (unit + nblk < NRUNIT) fetch(unit + nblk);
        __syncthreads();
        {
            f32x4 mk[2], mb[2], ak[2], ab[2];
#pragma unroll
            for (int nt = 0; nt < 2; ++nt) { mk[nt] = (f32x4){0.f, 0.f, 0.f, 0.f}; mb[nt] = mk[nt]; ak[nt] = mk[nt]; ab[nt] = mk[nt]; }
#pragma unroll
            for (int ks = 0; ks < 2; ++ks) { const bf16x8 aK = ldt8(TL(0), tr + fr, ks * 32 + fq * 8), aR = ldt8(TL(3), tr + fr, ks * 32 + fq * 8);
#pragma unroll
                for (int nt = 0; nt < 2; ++nt) { const bf16x8 bK = ldt8(TL(1), tc0 + nt * 16 + fr, ks * 32 + fq * 8), bB = ldt8(TL(2), tc0 + nt * 16 + fr, ks * 32 + fq * 8);
                    mk[nt] = __builtin_amdgcn_mfma_f32_16x16x32_bf16(aK, bK, mk[nt], 0, 0, 0); mb[nt] = __builtin_amdgcn_mfma_f32_16x16x32_bf16(aK, bB, mb[nt], 0, 0, 0);
                    ak[nt] = __builtin_amdgcn_mfma_f32_16x16x32_bf16(aR, bK, ak[nt], 0, 0, 0); ab[nt] = __builtin_amdgcn_mfma_f32_16x16x32_bf16(aR, bB, ab[nt], 0, 0, 0); } }
#pragma unroll
            for (int nt = 0; nt < 2; ++nt)
#pragma unroll
                for (int r = 0; r < 4; ++r) { const int t = tr + fq * 4 + r, j = tc0 + nt * 16 + fr;
                    TL(7)[t * LDT + j] = f2bf(j < t ? mk[nt][r] : 0.f); F1[j * 64 + (t & 3) * 16 + (t >> 2)] = j < t ? mb[nt][r] : 0.f;
                    TL(8)[t * LDT + j] = f2bf(j <= t ? ak[nt][r] : 0.f); TL(9)[t * LDT + j] = f2bf(j <= t ? ab[nt][r] : 0.f); }
        }
        __syncthreads();
        {
            f32x4 acc[2] = {(f32x4){0.f, 0.f, 0.f, 0.f}, (f32x4){0.f, 0.f, 0.f, 0.f}};
#pragma unroll
            for (int ks = 0; ks < 2; ++ks) { const bf16x8 a = ldt8(TL(7), tr + fr, ks * 32 + fq * 8);
#pragma unroll
                for (int nt = 0; nt < 2; ++nt) acc[nt] = __builtin_amdgcn_mfma_f32_16x16x32_bf16(a, ldt8(TL(6), tc0 + nt * 16 + fr, ks * 32 + fq * 8), acc[nt], 0, 0, 0); }
#pragma unroll
            for (int nt = 0; nt < 2; ++nt)
#pragma unroll
                for (int r = 0; r < 4; ++r) F2[(tr + fq * 4 + r) * 64 + tc0 + nt * 16 + fr] = acc[nt][r];
        }
        __syncthreads();
        {
            const int col = tid >> 2, part = tid & 3;
            f32x2 acc2[8]; float x[16];
#pragma unroll
            for (int q = 0; q < 16; ++q) { const int t = 4 * q + part; acc2[q >> 1][q & 1] = col < 64 ? F0[t * 64 + col] : F2[t * 64 + col - 64]; x[q] = 0.f; }
#pragma unroll
            for (int t = 0; t < 64; ++t) {
                const int qo = t >> 2, po = t & 3; const float aq = acc2[qo >> 1][qo & 1];
                const float xt = po == 0 ? quad_bcast<0>(aq) : po == 1 ? quad_bcast<1>(aq) : po == 2 ? quad_bcast<2>(aq) : quad_bcast<3>(aq);
                x[qo] = part == po ? xt : x[qo];
                const f32x2 nx = {-xt, -xt};
#pragma unroll
                for (int q4 = qo >> 2; q4 < 4; ++q4) { const f32x4 m = *(const LAS f32x4*)(F1 + t * 64 + part * 16 + q4 * 4);
                    acc2[q4 * 2] = (f32x2){m[0], m[1]} * nx + acc2[q4 * 2]; acc2[q4 * 2 + 1] = (f32x2){m[2], m[3]} * nx + acc2[q4 * 2 + 1]; }
            }
            LAS bf16_t* dstT = col < 64 ? TL(7) + col * LDT : TL(10) + (col - 64) * LDT;
#pragma unroll
            for (int q = 0; q < 16; ++q) dstT[4 * q + part] = f2bf(-x[q]);
        }
        __syncthreads();
        {
            f32x4 rh[2], ol[2], pm[2], qq[2];
#pragma unroll
            for (int nt = 0; nt < 2; ++nt) { rh[nt] = (f32x4){0.f, 0.f, 0.f, 0.f}; ol[nt] = rh[nt]; pm[nt] = rh[nt]; qq[nt] = rh[nt]; }
#pragma unroll
            for (int ks = 0; ks < 2; ++ks) { const int kc = ks * 32 + fq * 8;
                const bf16x8 a7 = ldt8(TL(7), tr + fr, kc), a8 = ldt8(TL(8), tr + fr, kc), a9 = ldt8(TL(9), tr + fr, kc), a6 = ldt8(TL(6), tr + fr, kc), a10 = ldt8(TL(10), tr + fr, kc);
#pragma unroll
                for (int nt = 0; nt < 2; ++nt) { const int br = tc0 + nt * 16 + fr;
                    const bf16x8 b9 = ldt8(TL(9), br, kc), b6 = ldt8(TL(6), br, kc), b10 = ldt8(TL(10), br, kc), b5 = ldt8(TL(5), br, kc), b4 = ldt8(TL(4), br, kc);
                    rh[nt] = __builtin_amdgcn_mfma_f32_16x16x32_bf16(a7, b9, rh[nt], 0, 0, 0);
                    ol[nt] = __builtin_amdgcn_mfma_f32_16x16x32_bf16(a8, b6, ol[nt], 0, 0, 0); ol[nt] = __builtin_amdgcn_mfma_f32_16x16x32_bf16(a9, b10, ol[nt], 0, 0, 0);
                    pm[nt] = __builtin_amdgcn_mfma_f32_16x16x32_bf16(a7, b5, pm[nt], 0, 0, 0);
                    qq[nt] = __builtin_amdgcn_mfma_f32_16x16x32_bf16(a6, b4, qq[nt], 0, 0, 0); qq[nt] = __builtin_amdgcn_mfma_f32_16x16x32_bf16(a10, b5, qq[nt], 0, 0, 0); } }
            float* U = RU + (size_t)unit * 4 * 4096;
#pragma unroll
            for (int nt = 0; nt < 2; ++nt)
#pragma unroll
                for (int r = 0; r < 4; ++r) { const int row = tr + fq * 4 + r, cx = tc0 + nt * 16 + fr; const int o = row * 64 + cx;
                    U[o] = pm[nt][r] + (row == cx ? gl[row] : 0.f);
                    U[4096 + o] = qq[nt][r];
                    U[8192 + o] = rh[nt][r] + bf2f(TL(3)[cx * LDT + row]);
                    U[12288 + o] = ol[nt][r]; }
        }
        __syncthreads();
    }
#undef TL
}
__device__ __forceinline__ void moe_weight_tiles(const Params& p, LAS unsigned char* lds, int first, int stride) {
    const int tid = threadIdx.x; unsigned char* ws = p.ws;
    LAS float* tile = (LAS float*)(lds + LDS_WORK);
    const int j4 = (tid & 31) * 4, i0 = tid >> 5;
    auto decode = [&](int tt, const float*& src, int& ld, int& k0, int& n0, int& w1map, bf16_t*& dst) {
        if (tt < 8192) { const int mat = tt >> 7, r = tt & 127; k0 = (r >> 4) * 128; n0 = (r & 15) * 128; src = p.in[I_W1] + (size_t)mat * 1024 * 2048; ld = 2048; dst = (bf16_t*)(ws + WS_W1T) + (size_t)mat * 2048 * 1024; w1map = 1; }
        else { tt -= 8192; const int mat = tt >> 6, r = tt & 63; k0 = (r >> 3) * 128; n0 = (r & 7) * 128; src = p.in[I_W2] + (size_t)mat * 1024 * 1024; ld = 1024; dst = (bf16_t*)(ws + WS_W2T) + (size_t)mat * 1024 * 1024; w1map = 0; }
    };
    f32x4 v[8];
    if (first < 12288) { const float* src; int ld, k0, n0, w1; bf16_t* dst; decode(first, src, ld, k0, n0, w1, dst);
#pragma unroll
        for (int r = 0; r < 8; ++r) v[r] = __builtin_nontemporal_load((const f32x4*)(src + (size_t)(k0 + i0 + 16 * r) * ld + n0 + j4)); }
    for (int t = first; t < 12288; t += stride) {
        const float* src; int ld, k0, n0, w1map; bf16_t* dst; decode(t, src, ld, k0, n0, w1map, dst);
#pragma unroll
        for (int r = 0; r < 8; ++r) { LAS float* tp = tile + (i0 + 16 * r) * 129 + j4; tp[0] = v[r][0]; tp[1] = v[r][1]; tp[2] = v[r][2]; tp[3] = v[r][3]; }
        __syncthreads();
        if (t + stride < 12288) { const float* s2; int ld2, k2, n2, w2; bf16_t* d2; decode(t + stride, s2, ld2, k2, n2, w2, d2);
#pragma unroll
            for (int r = 0; r < 8; ++r) v[r] = __builtin_nontemporal_load((const f32x4*)(s2 + (size_t)(k2 + i0 + 16 * r) * ld2 + n2 + j4)); }
        { const int ip = (tid & 15) * 8, j0 = tid >> 4;
            const int rho0 = w1map ? ((((n0 & 1023) >> 7) << 8) + ((n0 >> 10) << 7)) : n0;
#pragma unroll
            for (int r = 0; r < 4; ++r) { const int j = j0 + 32 * r;
                u32x4 w; w.x = pack_bf16(tile[ip * 129 + j], tile[(ip + 1) * 129 + j]); w.y = pack_bf16(tile[(ip + 2) * 129 + j], tile[(ip + 3) * 129 + j]);
                w.z = pack_bf16(tile[(ip + 4) * 129 + j], tile[(ip + 5) * 129 + j]); w.w = pack_bf16(tile[(ip + 6) * 129 + j], tile[(ip + 7) * 129 + j]);
                const int rho = rho0 + j, kk8 = k0 + ip; *(u32x4*)(dst + ((size_t)((rho >> 8) * 16 + (kk8 >> 6)) * 256 + (rho & 255)) * 64 + (kk8 & 63)) = w; } }
        __syncthreads();
    }
}
__device__ __forceinline__ void ph_r2(const Params& p, LAS unsigned char* lds, int bid, int nblk) {
    const int tid = threadIdx.x, wid = tid >> 6, lane = tid & 63, fr = lane & 15, g = lane >> 4;
    const int nchainwg = nblk >= 128 ? 64 : 0;
    if (bid >= nchainwg) {
        const int nconv = nblk - nchainwg, cb = bid - nchainwg;
        if (tid < 256) {
            const float* CHA = (const float*)(p.ws + WS_CHA); const float* CHH = (const float*)(p.ws + WS_CHH); float* CIN = (float*)(p.ws + WS_CIN);
            for (int item = cb; item < 16; item += nconv) {
                const int gi = item * 256 + tid, d = gi >> 11, b = (gi >> 9) & 3, c = gi & 511;
                float carry = 0.f;
                for (int s0 = 0; s0 < 128; s0 += 16) {
                    float av[16], hv[16];
#pragma unroll
                    for (int q = 0; q < 16; ++q) { const int st = s0 + q; const int cl = d == 0 ? st : (st < 64 ? 63 - st : 191 - st);
                        const size_t o = (size_t)(d * 512 + b * 128 + cl) * 512 + c; av[q] = CHA[o]; hv[q] = CHH[o]; }
#pragma unroll
                    for (int q = 0; q < 16; ++q) { const int st = s0 + q; const int cl = d == 0 ? st : (st < 64 ? 63 - st : 191 - st);
                        CIN[(size_t)(d * 512 + b * 128 + cl) * 512 + c] = carry; carry = av[q] * carry + hv[q]; }
                }
            }
        }
        __syncthreads();
        moe_weight_tiles(p, lds, cb, nconv);
        if (nchainwg) return;
    }
    LAS float* ring = (LAS float*)(lds + LDS_WORK);
    const float* RU = (const float*)(p.ws + WS_RU);
    float* EA = (float*)(p.ws + WS_EARR);
    for (int chain = nchainwg ? bid : bid; chain < 64; chain += (nchainwg ? 64 : nblk)) {
        const int d = chain >> 5, b = (chain >> 3) & 3, h = chain & 7;
        bf16_t* Od = (bf16_t*)(EA + (size_t)(E_O0 + d) * ((size_t)MROWS * 512));
        auto issue = [&](int c) {
            const float* src = RU + ((size_t)chain * NRCH + c) * 4 * 4096; LAS float* dst = ring + (c & 1) * 4 * 4096;
#pragma unroll
            for (int i = 0; i < 16; ++i) { const int slot = ((wid - 4) * 16 + i) * 64;
                __builtin_amdgcn_global_load_lds((const unsigned*)(src + (size_t)(slot + lane) * 4), (LAS unsigned*)(dst + slot * 4), 16, 0, 0); }
        };
        if (tid >= 256) { issue(0); asm volatile("s_waitcnt vmcnt(0)" ::: "memory"); }
        asm volatile("" ::: "memory"); __builtin_amdgcn_s_barrier(); asm volatile("" ::: "memory");
        f32x4 S[4];
#pragma unroll
        for (int m = 0; m < 4; ++m) S[m] = (f32x4){0.f, 0.f, 0.f, 0.f};
        const int v0 = wid * 16;
        for (int c = 0; c < NRCH; ++c) {
            if (tid >= 256) { if (c + 1 < NRCH) issue(c + 1); asm volatile("s_waitcnt vmcnt(0)" ::: "memory"); }
            else {
                const LAS float* PM = ring + (c & 1) * 4 * 4096; const LAS float* QQ = PM + 4096; const LAS float* RHT = PM + 8192; const LAS float* OL = PM + 12288;
                f32x4 acc[4], Sn[4];
#pragma unroll
                for (int tt = 0; tt < 4; ++tt) {
#pragma unroll
                    for (int i = 0; i < 4; ++i) acc[tt][i] = OL[(16 * tt + 4 * g + i) * 64 + v0 + fr];
                    Sn[tt] = *(const LAS f32x4*)(QQ + (v0 + fr) * 64 + 16 * tt + 4 * g); }
                float A[3][4];
#pragma unroll
                for (int s0 = 0; s0 < 2; ++s0) { const LAS float* ar = RHT + (16 * (s0 >> 2) + 4 * g + (s0 & 3)) * 64 + fr;
#pragma unroll
                    for (int u = 0; u < 4; ++u) A[s0][u] = ar[16 * u]; }
#pragma unroll
                for (int st = 0; st < 32; ++st) {
                    if (st + 2 < 32) { const int s2 = st + 2, mi = s2 & 15; const LAS float* ar = (s2 < 16 ? RHT : PM) + (16 * (mi >> 2) + 4 * g + (mi & 3)) * 64 + fr;
#pragma unroll
                        for (int u = 0; u < 4; ++u) A[s2 % 3][u] = ar[16 * u]; }
                    __builtin_amdgcn_sched_barrier(0);
                    const int mi = st & 15; const float bq = S[mi >> 2][mi & 3];
                    if (st < 16) {
#pragma unroll
                        for (int u = 0; u < 4; ++u) acc[u] = __builtin_amdgcn_mfma_f32_16x16x4f32(A[st % 3][u], bq, acc[u], 0, 0, 0);
                    } else {
#pragma unroll
                        for (int u = 0; u < 4; ++u) Sn[u] = __builtin_amdgcn_mfma_f32_16x16x4f32(A[st % 3][u], bq, Sn[u], 0, 0, 0);
                    }
                }
#pragma unroll
                for (int tt = 0; tt < 4; ++tt)
#pragma unroll
                    for (int i = 0; i < 4; ++i) { const int row = scan_row(d, b, c * RCH + 16 * tt + 4 * g + i); Od[(size_t)row * 512 + h * 64 + v0 + fr] = f2bf(acc[tt][i]); }
#pragma unroll
                for (int m = 0; m < 4; ++m) S[m] = Sn[m];
                asm volatile("s_waitcnt lgkmcnt(0)" ::: "memory");
            }
            asm volatile("" ::: "memory"); __builtin_amdgcn_s_barrier(); asm volatile("" ::: "memory");
        }
    }
}
__device__ __forceinline__ float half_max(float v, int lane) {
    const int ninf = 0xff800000;
    v = fmaxf(v, __int_as_float(__builtin_amdgcn_update_dpp(ninf, __float_as_int(v), 0x121, 0xf, 0xf, false)));
    v = fmaxf(v, __int_as_float(__builtin_amdgcn_update_dpp(ninf, __float_as_int(v), 0x122, 0xf, 0xf, false)));
    v = fmaxf(v, __int_as_float(__builtin_amdgcn_update_dpp(ninf, __float_as_int(v), 0x124, 0xf, 0xf, false)));
    v = fmaxf(v, __int_as_float(__builtin_amdgcn_update_dpp(ninf, __float_as_int(v), 0x128, 0xf, 0xf, false)));
    v = fmaxf(v, __int_as_float(__builtin_amdgcn_update_dpp(ninf, __float_as_int(v), 0x142, 0xa, 0xf, false)));
    const float lo = __int_as_float(__builtin_amdgcn_readlane(__float_as_int(v), 31)), hi = __int_as_float(__builtin_amdgcn_readlane(__float_as_int(v), 63));
    return (lane & 32) ? hi : lo;
}
__device__ __forceinline__ int half_min_i(int v, int lane) {
    const int big = 0x7fffffff;
    v = min(v, __builtin_amdgcn_update_dpp(big, v, 0x121, 0xf, 0xf, false));
    v = min(v, __builtin_amdgcn_update_dpp(big, v, 0x122, 0xf, 0xf, false));
    v = min(v, __builtin_amdgcn_update_dpp(big, v, 0x124, 0xf, 0xf, false));
    v = min(v, __builtin_amdgcn_update_dpp(big, v, 0x128, 0xf, 0xf, false));
    v = min(v, __builtin_amdgcn_update_dpp(big, v, 0x142, 0xa, 0xf, false));
    const int lo = __builtin_amdgcn_readlane(v, 31), hi = __builtin_amdgcn_readlane(v, 63);
    return (lane & 32) ? hi : lo;
}
template <int LAYER>
__device__ __forceinline__ void ph_ln1(const Params& p, LAS unsigned char* lds, int bid, int nblk) {
    const int tid = threadIdx.x, wid = tid >> 6, lane = tid & 63, fr = lane & 15, fq = lane >> 4;
    LAS float* vb = (LAS float*)(lds + LDS_WORK);
    LAS float* part = vb + 16 * 1028;
    LAS int* lcnt = (LAS int*)(part + 8 * 16 * 32);
    float rwf[2][32];
    { const float* rw = p.in[I_RW] + (size_t)LAYER * 32768 + (size_t)(128 * wid + 32 * fq) * 32 + fr;
#pragma unroll
        for (int s2 = 0; s2 < 32; ++s2) { rwf[0][s2] = rw[s2 * 32]; rwf[1][s2] = rw[s2 * 32 + 16]; } }
    if (tid < 32) lcnt[tid] = 0;
    __syncthreads();
    const float* MOD = (const float*)(p.ws + WS_MOD);
    bf16_t* XS = (bf16_t*)(p.ws + WS_XS); const bf16_t* YP = (const bf16_t*)(p.ws + WS_YP); bf16_t* H = (bf16_t*)(p.ws + WS_H);
    int* TOPE = (int*)(p.ws + WS_TOPE); float* TOPW = (float*)(p.ws + WS_TOPW); int* TOPS = (int*)(p.ws + WS_TOPS);
    int* CNTB = (int*)(p.ws + WS_CNTB) + (size_t)(LAYER * 512 + bid) * 32;
    const float* lng = p.in[I_LNG] + (LAYER * 2 + 0) * 1024; const float* lnb = p.in[I_LNB] + (LAYER * 2 + 0) * 1024;
    const int rstride = nblk * 8, rbase = (LAYER == 0 ? 0 : NCTX) + bid * 8;
    f32x4 nres[4], ngate[4]; u32x2 nyp[4];
    auto fetch = [&](int row) {
        const float* res = row < NCTX ? p.in[I_CTX] + (size_t)row * 1024 : p.in[I_X] + (size_t)(row - NCTX) * 1024;
        const float* md = MOD + (size_t)(LAYER * 5 + row_modr(row)) * 6144;
#pragma unroll
        for (int q = 0; q < 4; ++q) { const int col = q * 256 + lane * 4; nres[q] = LAYER == 0 ? *(const f32x4*)(res + col) : ld_bf16x4(XS + (size_t)row * 1024 + col);
            ngate[q] = *(const f32x4*)(md + 2048 + col); nyp[q] = *(const u32x2*)(YP + (size_t)row * 1024 + col); }
    };
    if (rbase < MROWS) fetch(rbase + wid);
#pragma unroll 1
    for (int j0 = 0; rbase + j0 * rstride < MROWS; j0 += 2) {
#pragma unroll 1
        for (int jj = 0; jj < 2; ++jj) {
            const int row = rbase + wid + (j0 + jj) * rstride;
            if (row >= MROWS) break;
            const float* md = MOD + (size_t)(LAYER * 5 + row_modr(row)) * 6144;
            f32x4 v[4], msc[4], msh[4]; float s = 0.f;
#pragma unroll
            for (int q = 0; q < 4; ++q) { const u32x2 w = nyp[q];
                const f32x4 y = (f32x4){__uint_as_float(w.x << 16), __uint_as_float(w.x & 0xffff0000u), __uint_as_float(w.y << 16), __uint_as_float(w.y & 0xffff0000u)};
                v[q] = nres[q] * DN_ALPHA + ngate[q] * y;
                s += (v[q][0] + v[q][1]) + (v[q][2] + v[q][3]); }
#pragma unroll
            for (int q = 0; q < 4; ++q) { const int col = q * 256 + lane * 4; msc[q] = *(const f32x4*)(md + 4096 + col); msh[q] = *(const f32x4*)(md + 3072 + col); }
            if (row + rstride < MROWS) fetch(row + rstride);
            const float mean = wave_sum(s) * (1.0f / 1024.0f);
            float ss = 0.f;
#pragma unroll
            for (int q = 0; q < 4; ++q) { v[q] = v[q] - mean; ss += (v[q][0] * v[q][0] + v[q][1] * v[q][1]) + (v[q][2] * v[q][2] + v[q][3] * v[q][3]); }
            const float rstd = rsqrtf(wave_sum(ss) * (1.0f / 1024.0f) + LN_EPS);
#pragma unroll
            for (int q = 0; q < 4; ++q) { const int col = q * 256 + lane * 4;
                const f32x4 xn = v[q] * rstd * *(const f32x4*)(lng + col) + *(const f32x4*)(lnb + col);
                { u32x2 wx; wx.x = pack_bf16(xn[0], xn[1]); wx.y = pack_bf16(xn[2], xn[3]); *(u32x2*)(XS + (size_t)row * 1024 + col) = wx; }
                v[q] = xn * (msc[q] + 1.0f) + msh[q];
                u32x2 w; w.x = pack_bf16(v[q][0], v[q][1]); w.y = pack_bf16(v[q][2], v[q][3]);
                *(u32x2*)(H + (size_t)row * 1024 + col) = w;
                *(LAS f32x4*)(vb + (wid + 8 * jj) * 1028 + col) = v[q]; }
        }
        __syncthreads();
        {
            const LAS float* ar = vb + fr * 1028 + 128 * wid + 32 * fq;
            f32x4 acc0 = {0.f, 0.f, 0.f, 0.f}, acc1 = {0.f, 0.f, 0.f, 0.f};
#pragma unroll
            for (int h = 0; h < 2; ++h) { f32x4 va[4];
#pragma unroll
                for (int u = 0; u < 4; ++u) va[u] = *(const LAS f32x4*)(ar + h * 16 + u * 4);
#pragma unroll
                for (int u = 0; u < 4; ++u)
#pragma unroll
                    for (int i = 0; i < 4; ++i) { acc0 = __builtin_amdgcn_mfma_f32_16x16x4f32(va[u][i], rwf[0][h * 16 + u * 4 + i], acc0, 0, 0, 0);
                        acc1 = __builtin_amdgcn_mfma_f32_16x16x4f32(va[u][i], rwf[1][h * 16 + u * 4 + i], acc1, 0, 0, 0); } }
            LAS float* pw = part + wid * 512 + (4 * fq) * 32 + fr;
#pragma unroll
            for (int i = 0; i < 4; ++i) { pw[i * 32] = acc0[i]; pw[i * 32 + 16] = acc1[i]; }
        }
        __syncthreads();
        {
            const int e = lane & 31, lr = 2 * wid + (lane >> 5), row = rbase + (lr & 7) + (j0 + (lr >> 3)) * rstride;
            float lg = p.in[I_RB][LAYER * 32 + e];
#pragma unroll
            for (int w2 = 0; w2 < 8; ++w2) lg += part[w2 * 512 + lr * 32 + e];
            float tv[4]; int te[4];
#pragma unroll
            for (int k = 0; k < 4; ++k) { const float bv = half_max(lg, lane); const int bi = half_min_i(lg == bv ? e : 99, lane);
                tv[k] = bv; te[k] = bi & 31; lg = e == bi ? -3.0e38f : lg; }
            const float e1 = expf(tv[1] - tv[0]), e2 = expf(tv[2] - tv[0]), e3 = expf(tv[3] - tv[0]), inv = 1.0f / (1.0f + e1 + e2 + e3);
            if (e == 0 && row < MROWS) {
                const float wv[4] = {inv, e1 * inv, e2 * inv, e3 * inv};
#pragma unroll
                for (int k = 0; k < 4; ++k) { const int slot = __hip_atomic_fetch_add(lcnt + te[k], 1, __ATOMIC_RELAXED, __HIP_MEMORY_SCOPE_WORKGROUP); TOPE[row * 4 + k] = te[k]; TOPW[row * 4 + k] = wv[k]; TOPS[row * 4 + k] = slot; }
            }
        }
    }
    __syncthreads();
    if (tid < 32) CNTB[tid] = lcnt[tid];
}
constexpr int LDS_TAB = LDS_WORK + 131072;
__device__ __forceinline__ int moe_tables(const int* cntb, int nblk, LAS int* tab, LAS int* bb) {
    const int tid = threadIdx.x, e = tid & 31, seg = tid >> 5, per = (nblk + 15) >> 4;
    const int b0 = seg * per, b1 = (b0 + per) < nblk ? (b0 + per) : nblk;
    int s = 0;
    if (per <= 16) {
        int cv[16];
#pragma unroll
        for (int u = 0; u < 16; ++u) cv[u] = (b0 + u) < b1 ? cntb[(b0 + u) * 32 + e] : 0;
#pragma unroll
        for (int u = 0; u < 16; ++u) s += cv[u];
        tab[512 + seg * 32 + e] = s;
        __syncthreads();
        if (tid < 32) { int run = 0; for (int sg = 0; sg < 16; ++sg) { const int v = tab[512 + sg * 32 + tid]; tab[512 + sg * 32 + tid] = run; run += v; } tab[448 + tid] = run; }
        __syncthreads();
        if (bb) { int run = tab[512 + seg * 32 + e];
#pragma unroll
            for (int u = 0; u < 16; ++u) if ((b0 + u) < b1) { bb[(b0 + u) * 32 + e] = run; run += cv[u]; } }
    } else {
        for (int b = b0; b < b1; ++b) s += cntb[b * 32 + e];
        tab[512 + seg * 32 + e] = s;
        __syncthreads();
        if (tid < 32) { int run = 0; for (int sg = 0; sg < 16; ++sg) { const int v = tab[512 + sg * 32 + tid]; tab[512 + sg * 32 + tid] = run; run += v; } tab[448 + tid] = run; }
        __syncthreads();
        if (bb) { int run = tab[512 + seg * 32 + e]; for (int b = b0; b < b1; ++b) { bb[b * 32 + e] = run; run += cntb[b * 32 + e]; } }
    }
    if (tid < 64) {
        const int x = tid & 31, n = (tab[448 + x] + 255) >> 8; int inc = n;
#pragma unroll
        for (int o = 1; o < 32; o <<= 1) { const int t = __shfl_up(inc, o, 64); if ((tid & 31) >= o) inc += t; }
        if (tid < 32) { const int t0 = inc - n; tab[x] = t0 * 256; for (int i = 0; i < n; ++i) tab[64 + t0 + i] = x; if (x == 31) { tab[32] = inc * 256; tab[40] = inc; } }
    }
    __syncthreads();
    return tab[40];
}
template <int LAYER>
__device__ __forceinline__ void ph_moe_gather(const Params& p, LAS unsigned char* lds, int bid, int nblk) {
    const int tid = threadIdx.x;
    LAS int* tab = (LAS int*)(lds + LDS_TAB); LAS int* bb = (LAS int*)(lds + LDS_WORK);
    (void)moe_tables((const int*)(p.ws + WS_CNTB) + (size_t)LAYER * 512 * 32, nblk, tab, bb);
    const int* TOPE = (const int*)(p.ws + WS_TOPE); const int* TOPS = (const int*)(p.ws + WS_TOPS); int* POS = (int*)(p.ws + WS_POS); int* IDX = (int*)(p.ws + WS_IDX);
    constexpr int R0 = LAYER == 0 ? 0 : NCTX;
    for (int i = R0 * 4 + bid * NTHR + tid; i < MROWS * 4; i += nblk * NTHR) {
        const int row = i >> 2, e = TOPE[i], pos = tab[e] + bb[((((row - R0) >> 3) % nblk) << 5) + e] + TOPS[i];
        POS[i] = pos; IDX[pos] = row;
    }
    for (int e = bid; e < 32; e += nblk) {
        const int cnt = tab[448 + e], beg = tab[e] + cnt, end = tab[e] + ((cnt + 255) & ~255);
        for (int q = beg + tid; q < end; q += NTHR) IDX[q] = R0;
    }
}
template <int LAYER>
__device__ __forceinline__ void ph_moe_gemm1(const Params& p, LAS unsigned char* lds, int bid, int nblk) {
    LAS int* tab = (LAS int*)(lds + LDS_TAB);
    const int T = moe_tables((const int*)(p.ws + WS_CNTB) + (size_t)LAYER * 512 * 32, nblk, tab, (LAS int*)nullptr);
    pg8::Gemm g{(const bf16_t*)(p.ws + WS_H), (const bf16_t*)(p.ws + WS_W1T) + (size_t)LAYER * 32 * 2048 * 1024, 0, 0, 1024, (const int*)(p.ws + WS_IDX)};
    pg8::EpiAct E{(bf16_t*)(p.ws + WS_ACT), p.in[I_B1] + (size_t)LAYER * 32 * 2048};
    pg8::SchedMoe<8> S{T, nblk, bid, tab + 64};
    pg8::gemm_phase<pg8::EpiAct, pg8::SchedMoe<8>, false, false, true, true>(lds + LDS_WORK, g, S, E, nullptr);
}
template <int LAYER>
__device__ __forceinline__ void ph_moe_gemm2(const Params& p, LAS unsigned char* lds, int bid, int nblk) {
    LAS int* tab = (LAS int*)(lds + LDS_TAB);
    const int T = moe_tables((const int*)(p.ws + WS_CNTB) + (size_t)LAYER * 512 * 32, nblk, tab, (LAS int*)nullptr);
    pg8::Gemm g{(const bf16_t*)(p.ws + WS_ACT), (const bf16_t*)(p.ws + WS_W2T) + (size_t)LAYER * 32 * 1024 * 1024, 0, 0, 1024};
    pg8::EpiYE E{(bf16_t*)(p.ws + WS_YE), p.in[I_B2] + (size_t)LAYER * 32 * 1024};
    { pg8::SchedMoe<4, 1> S{T, nblk, bid, tab + 64}; pg8::gemm_phase<pg8::EpiYE, pg8::SchedMoe<4, 1>, false, true, true>(lds + LDS_WORK, g, S, E, nullptr); }
    { pg8::SchedMoe<4, 2> S{T, nblk, bid, tab + 64}; pg8::gemm_phase<pg8::EpiYE, pg8::SchedMoe<4, 2>, false, true, true, false, true>(lds + LDS_WORK, g, S, E, nullptr); }
}
template <int NN>
__device__ __forceinline__ void ph_gemm_dense(LAS unsigned char* lds, const bf16_t* A, const bf16_t* Bt, bf16_t* C, int ldc, int pm0, int nM, int bid, int nblk) {
    pg8::Gemm g{A, Bt, 0, 0, 1024};
    pg8::EpiStore E{C, ldc};
    { pg8::SchedDense<NN, 1> S{nM, pm0, nblk, bid}; pg8::gemm_phase<pg8::EpiStore, pg8::SchedDense<NN, 1>, false>(lds + LDS_WORK, g, S, E, nullptr); }
    { pg8::SchedDense<NN, 2> S{nM, pm0, nblk, bid}; pg8::gemm_phase<pg8::EpiStore, pg8::SchedDense<NN, 2>, false, false, false, false, true>(lds + LDS_WORK, g, S, E, nullptr); }
}
template <int LAYER>
__device__ __forceinline__ void ph_ln2(const Params& p, LAS unsigned char* lds, int bid, int nblk) {
    const int tid = threadIdx.x, wid = tid >> 6, lane = tid & 63, fr = lane & 15, fq = lane >> 4;
    LAS float* vb = (LAS float*)(lds + LDS_WORK);
    LAS float* part = vb + 16 * 1028;
    float wgf[32];
    if (LAYER == 0) { const float* wg = p.in[I_OWIN] + (size_t)(128 * wid + 32 * fq) * ODD_IN + 4096 + fr;
#pragma unroll
        for (int s2 = 0; s2 < 32; ++s2) wgf[s2] = wg[(size_t)s2 * ODD_IN]; }
    const float* MOD = (const float*)(p.ws + WS_MOD);
    bf16_t* XS = (bf16_t*)(p.ws + WS_XS); const bf16_t* YE = (const bf16_t*)(p.ws + WS_YE); bf16_t* H = (bf16_t*)(p.ws + WS_H); float* GT = (float*)(p.ws + WS_GT);
    const float* TOPW = (const float*)(p.ws + WS_TOPW); const int* POS = (const int*)(p.ws + WS_POS);
    const float* lng = p.in[I_LNG] + (LAYER * 2 + 1) * 1024; const float* lnb = p.in[I_LNB] + (LAYER * 2 + 1) * 1024;
    const int rstride = nblk * 8, rbase = (LAYER == 0 ? 0 : NCTX) + bid * 8, rfirst = rbase + wid;
    f32x4 nw = {0.f, 0.f, 0.f, 0.f}; int np0 = 0, np1 = 0, np2 = 0, np3 = 0;
    if (rfirst < MROWS) { nw = *(const f32x4*)(TOPW + rfirst * 4); np0 = POS[rfirst * 4]; np1 = POS[rfirst * 4 + 1]; np2 = POS[rfirst * 4 + 2]; np3 = POS[rfirst * 4 + 3]; }
    auto do_row = [&](int row, int jj) {
        const float* md = MOD + (size_t)(LAYER * 5 + row_modr(row)) * 6144;
        const float w0 = nw[0], w1 = nw[1], w2 = nw[2], w3 = nw[3];
        const bf16_t* y0 = YE + (size_t)np0 * 1024; const bf16_t* y1 = YE + (size_t)np1 * 1024;
        const bf16_t* y2 = YE + (size_t)np2 * 1024; const bf16_t* y3 = YE + (size_t)np3 * 1024;
        if (row + rstride < MROWS) { const int rn = row + rstride; nw = *(const f32x4*)(TOPW + rn * 4); np0 = POS[rn * 4]; np1 = POS[rn * 4 + 1]; np2 = POS[rn * 4 + 2]; np3 = POS[rn * 4 + 3]; }
        f32x4 v[4]; float s = 0.f;
#pragma unroll
        for (int q = 0; q < 4; ++q) { const int col = q * 256 + lane * 4;
            const f32x4 ffn = (ld_bf16x4(y0 + col) * w0 + ld_bf16x4(y1 + col) * w1) + (ld_bf16x4(y2 + col) * w2 + ld_bf16x4(y3 + col) * w3);
            v[q] = ld_bf16x4(XS + (size_t)row * 1024 + col) * DN_ALPHA + *(const f32x4*)(md + 5120 + col) * ffn;
            s += (v[q][0] + v[q][1]) + (v[q][2] + v[q][3]); }
        const float mean = wave_sum(s) * (1.0f / 1024.0f);
        float ss = 0.f;
#pragma unroll
        for (int q = 0; q < 4; ++q) { v[q] = v[q] - mean; ss += (v[q][0] * v[q][0] + v[q][1] * v[q][1]) + (v[q][2] * v[q][2] + v[q][3] * v[q][3]); }
        const float rstd = rsqrtf(wave_sum(ss) * (1.0f / 1024.0f) + LN_EPS);
        if (LAYER == 1) {
#pragma unroll
            for (int q = 0; q < 4; ++q) { const int col = q * 256 + lane * 4;
                *(f32x4*)(p.out + (size_t)(row - NCTX) * 1024 + col) = v[q] * rstd * *(const f32x4*)(lng + col) + *(const f32x4*)(lnb + col); }
        } else {
            const float* md1 = MOD + (size_t)(5 + row_modr(row)) * 6144;
#pragma unroll
            for (int q = 0; q < 4; ++q) { const int col = q * 256 + lane * 4;
                const f32x4 xn = v[q] * rstd * *(const f32x4*)(lng + col) + *(const f32x4*)(lnb + col);
                { u32x2 wx; wx.x = pack_bf16(xn[0], xn[1]); wx.y = pack_bf16(xn[2], xn[3]); *(u32x2*)(XS + (size_t)row * 1024 + col) = wx; }
                v[q] = xn * (*(const f32x4*)(md1 + 1024 + col) + 1.0f) + *(const f32x4*)(md1 + col);
                u32x2 w; w.x = pack_bf16(v[q][0], v[q][1]); w.y = pack_bf16(v[q][2], v[q][3]);
                *(u32x2*)(H + (size_t)row * 1024 + col) = w;
                *(LAS f32x4*)(vb + (wid + 8 * jj) * 1028 + col) = v[q]; }
        }
    };
    if (LAYER == 1) {
#pragma unroll 1
        for (int row = rfirst; row < MROWS; row += rstride) do_row(row, 0);
    } else {
#pragma unroll 1
        for (int j0 = 0; rbase + j0 * rstride < MROWS; j0 += 2) {
#pragma unroll 1
            for (int jj = 0; jj < 2; ++jj) { const int row = rfirst + (j0 + jj) * rstride; if (row >= MROWS) break; do_row(row, jj); }
            __syncthreads();
            {
                const LAS float* ar = vb + fr * 1028 + 128 * wid + 32 * fq;
                f32x4 acc = {0.f, 0.f, 0.f, 0.f};
#pragma unroll
                for (int h = 0; h < 2; ++h) { f32x4 va[4];
#pragma unroll
                    for (int u = 0; u < 4; ++u) va[u] = *(const LAS f32x4*)(ar + h * 16 + u * 4);
#pragma unroll
                    for (int u = 0; u < 4; ++u)
#pragma unroll
                        for (int i = 0; i < 4; ++i) acc = __builtin_amdgcn_mfma_f32_16x16x4f32(va[u][i], wgf[h * 16 + u * 4 + i], acc, 0, 0, 0); }
                LAS float* pw = part + wid * 256 + (4 * fq) * 16 + fr;
#pragma unroll
                for (int i = 0; i < 4; ++i) pw[i * 16] = acc[i];
            }
            __syncthreads();
            if (tid < 256) { const int lr = tid >> 4, row = rbase + (lr & 7) + (j0 + (lr >> 3)) * rstride;
                float a = 0.f;
#pragma unroll
                for (int w2 = 0; w2 < 8; ++w2) a += part[w2 * 256 + tid];
                if (row < MROWS) GT[row * 16 + (tid & 15)] = a; }
        }
    }
}
constexpr int LDK = 136;
__device__ __forceinline__ int sid_of(int mixer, int dir, int b, int ch, int h) { return (((mixer * 2 + dir) * 4 + b) * NCHUNK + ch) * 4 + h; }
__device__ __forceinline__ void unit_decode(int u, int& mixer, int& h, int& ch, int& b, int& row0) {
    mixer = u & 1; h = (u >> 1) & 3; const int rest = u >> 3; ch = rest % NCHUNK; b = rest / NCHUNK;
    row0 = ch < 2 ? b * 256 + ch * 128 : NCTX + b * 4096 + (ch - 2) * 128;
}
__device__ __forceinline__ void ld_raw(const bf16_t* P, int row0, int col, u32x2 (&raw)[8]) {
    const int t = threadIdx.x, i = t >> 2, part = t & 3, i0 = (part & 1) * 32 + (part >> 1) * 16;
    const bf16_t* src = P + (size_t)(row0 + i) * LDP1 + col + i0;
#pragma unroll
    for (int q = 0; q < 4; ++q) { raw[q] = *(const u32x2*)(src + q * 4); raw[4 + q] = *(const u32x2*)(src + 64 + q * 4); }
}
__device__ __forceinline__ void cvt_rows(const u32x2 (&raw)[8], bool rope, int s0, const float* ROPE, float (&lo)[16], float (&hi)[16]) {
    const int t = threadIdx.x, i = t >> 2, part = t & 3, pr = part & 1, hf = part >> 1;
#pragma unroll
    for (int q = 0; q < 4; ++q) {
        lo[q * 4] = __uint_as_float(raw[q].x << 16); lo[q * 4 + 1] = __uint_as_float(raw[q].x & 0xffff0000u); lo[q * 4 + 2] = __uint_as_float(raw[q].y << 16); lo[q * 4 + 3] = __uint_as_float(raw[q].y & 0xffff0000u);
        hi[q * 4] = __uint_as_float(raw[4 + q].x << 16); hi[q * 4 + 1] = __uint_as_float(raw[4 + q].x & 0xffff0000u); hi[q * 4 + 2] = __uint_as_float(raw[4 + q].y << 16); hi[q * 4 + 3] = __uint_as_float(raw[4 + q].y & 0xffff0000u); }
    if (rope) {
        const int s = s0 + i, pos = pr == 0 ? (s >> 6) : (s & 63);
        const float* rp = ROPE + (size_t)(pos * 32 + hf * 16) * 2;
#pragma unroll
        for (int jj = 0; jj < 16; ++jj) { const float c = rp[2 * jj], sn = rp[2 * jj + 1], a = lo[jj], b = hi[jj]; lo[jj] = a * c - b * sn; hi[jj] = a * sn + b * c; }
    }
}
__device__ __forceinline__ void st_rows(LAS bf16_t* dst, const float (&lo)[16], const float (&hi)[16], float scale) {
    const int t = threadIdx.x, i = t >> 2, part = t & 3, i0 = (part & 1) * 32 + (part >> 1) * 16;
    u32x4 w0, w1, w2, w3;
    w0.x = pack_bf16(lo[0] * scale, lo[1] * scale); w0.y = pack_bf16(lo[2] * scale, lo[3] * scale); w0.z = pack_bf16(lo[4] * scale, lo[5] * scale); w0.w = pack_bf16(lo[6] * scale, lo[7] * scale);
    w1.x = pack_bf16(lo[8] * scale, lo[9] * scale); w1.y = pack_bf16(lo[10] * scale, lo[11] * scale); w1.z = pack_bf16(lo[12] * scale, lo[13] * scale); w1.w = pack_bf16(lo[14] * scale, lo[15] * scale);
    w2.x = pack_bf16(hi[0] * scale, hi[1] * scale); w2.y = pack_bf16(hi[2] * scale, hi[3] * scale); w2.z = pack_bf16(hi[4] * scale, hi[5] * scale); w2.w = pack_bf16(hi[6] * scale, hi[7] * scale);
    w3.x = pack_bf16(hi[8] * scale, hi[9] * scale); w3.y = pack_bf16(hi[10] * scale, hi[11] * scale); w3.z = pack_bf16(hi[12] * scale, hi[13] * scale); w3.w = pack_bf16(hi[14] * scale, hi[15] * scale);
    LAS bf16_t* d = dst + i * LDK + i0;
    *(LAS u32x4*)d = w0; *(LAS u32x4*)(d + 8) = w1; *(LAS u32x4*)(d + 64) = w2; *(LAS u32x4*)(d + 72) = w3;
}
__device__ __forceinline__ void st_rows_T(LAS bf16_t* dst, const float (&lo)[16], const float (&hi)[16], float scale) {
    const int t = threadIdx.x, i = t >> 2, part = t & 3, i0 = (part & 1) * 32 + (part >> 1) * 16;
#pragma unroll
    for (int jj = 0; jj < 16; ++jj) { dst[(i0 + jj) * LDK + i] = f2bf(lo[jj] * scale); dst[(i0 + 64 + jj) * LDK + i] = f2bf(hi[jj] * scale); }
}
__device__ __forceinline__ void mma_128(const LAS bf16_t* A, const LAS bf16_t* B, f32x4 (&acc)[2][4], int wr, int wc, int lane) {
    const int fr = lane & 15, fq = lane >> 4;
#pragma unroll
    for (int ks = 0; ks < 4; ++ks) {
        bf16x8 a[2], b[4];
#pragma unroll
        for (int mt = 0; mt < 2; ++mt) a[mt] = *(const LAS bf16x8*)(A + (wr * 32 + mt * 16 + fr) * LDK + ks * 32 + fq * 8);
#pragma unroll
        for (int nt = 0; nt < 4; ++nt) b[nt] = *(const LAS bf16x8*)(B + (wc * 64 + nt * 16 + fr) * LDK + ks * 32 + fq * 8);
#pragma unroll
        for (int mt = 0; mt < 2; ++mt)
#pragma unroll
            for (int nt = 0; nt < 4; ++nt) acc[mt][nt] = __builtin_amdgcn_mfma_f32_16x16x32_bf16(a[mt], b[nt], acc[mt][nt], 0, 0, 0);
    }
}
__device__ __forceinline__ void zero_acc(f32x4 (&acc)[2][4]) {
#pragma unroll
    for (int mt = 0; mt < 2; ++mt)
#pragma unroll
        for (int nt = 0; nt < 4; ++nt) acc[mt][nt] = (f32x4){0.f, 0.f, 0.f, 0.f};
}
__device__ __forceinline__ void wave_scan_sum2(float x0, float x1, float& p0, float& p1, float& total) {
    const int lane = threadIdx.x & 63; float s = x0 + x1, inc = s;
#pragma unroll
    for (int o = 1; o < 64; o <<= 1) { const float t = __shfl_up(inc, o, 64); if (lane >= o) inc += t; }
    const float exc = inc - s; p0 = exc + x0; p1 = exc + s; total = __shfl(inc, 63, 64);
}
__device__ __forceinline__ void wave_scan_max2(float x0, float x1, float& p0, float& p1) {
    const int lane = threadIdx.x & 63; const float m = fmaxf(x0, x1); float inc = m;
#pragma unroll
    for (int o = 1; o < 64; o <<= 1) { const float t = __shfl_up(inc, o, 64); if (lane >= o) inc = fmaxf(inc, t); }
    float exc = __shfl_up(inc, 1, 64); if (lane == 0) exc = -3.0e38f;
    p0 = fmaxf(exc, x0); p1 = fmaxf(exc, m);
}
__device__ __forceinline__ void ph_c1(const Params& p, LAS unsigned char* lds, int bid, int nblk) {
    const int tid = threadIdx.x, wid = tid >> 6, lane = tid & 63, wr = wid >> 1, wc = wid & 1, fr = lane & 15, fq = lane >> 4;
    LAS bf16_t* KsT = (LAS bf16_t*)(lds + LDS_WORK); LAS bf16_t* VsT0 = KsT + 128 * LDK; LAS bf16_t* VsT1 = VsT0 + 128 * LDK;
    LAS float* z = (LAS float*)(VsT1 + 128 * LDK);
    LAS float* lfA = z + 256; LAS float* igA = lfA + 256; LAS float* zmax = igA + 256;
    const bf16_t* P = (const bf16_t*)(p.ws + WS_P); const float* GT = (const float*)(p.ws + WS_GT); const float* ROPE = (const float*)(p.ws + WS_ROPE);
    float* ST = (float*)(p.ws + WS_ST); float* NST = (float*)(p.ws + WS_NST); float* MEND = (float*)(p.ws + WS_MEND); float* BEND = (float*)(p.ws + WS_BEND);
    for (int u = bid; u < NB * NCHUNK * 4 * 2; u += nblk) {
        int mixer, h, ch, b, row0; unit_decode(u, mixer, h, ch, b, row0);
        const int colQ = mixer * 2048 + h * 128;
        u32x2 rawK[8], rawV[8]; ld_raw(P, row0, colQ + 512, rawK); ld_raw(P, row0, colQ + 1024, rawV);
        if (mixer == 0) {
            if (tid < 256) { const int dir = tid >> 7, j = tid & 127; const float lg = p.in[I_CLG][dir * 4 + h]; z[tid] = fexp(lg * (float)(dir == 0 ? 127 - j : j)); }
        } else {
            if (tid < 256) { const int dir = tid >> 7, j = tid & 127, row = row0 + j;
                igA[tid] = GT[row * 16 + dir * 4 + h] + p.in[I_DIB][dir * 4 + h];
                lfA[tid] = -softplusf(-(GT[row * 16 + 8 + dir * 4 + h] + p.in[I_DFB][dir * 4 + h])); }
            __syncthreads();
            if (tid < 128) { const int dir = tid >> 6, j0 = 2 * lane, j1 = j0 + 1;
                const float l0 = lfA[dir * 128 + j0], l1 = lfA[dir * 128 + j1], g0 = igA[dir * 128 + j0], g1 = igA[dir * 128 + j1];
                float r0, r1, total; wave_scan_sum2(l0, l1, r0, r1, total);
                const float w0 = (dir == 0 ? total - r0 : r0 - l0) + g0, w1 = (dir == 0 ? total - r1 : r1 - l1) + g1;
                const float mx = wave_max(fmaxf(w0, w1));
                z[dir * 128 + j0] = fexp(w0 - mx); z[dir * 128 + j1] = fexp(w1 - mx);
                const int sid = sid_of(1, dir, b, ch, h);
                if (lane == 0) { MEND[sid] = mx; BEND[sid] = total; }
                float* CB = (float*)(p.ws + WS_CB) + (size_t)sid * 128; float* CMI = (float*)(p.ws + WS_CMI) + (size_t)sid * 128;
                if (dir == 0) { float m0, m1; wave_scan_max2(g0 - r0, g1 - r1, m0, m1); CB[j0] = r0; CB[j1] = r1; CMI[j0] = r0 + m0; CMI[j1] = r1 + m1; }
                else { const float s0 = total - r0 + l0, s1 = total - r1 + l1;
                    lfA[128 + j0] = g0 - s0; lfA[128 + j1] = g1 - s1; igA[128 + j0] = s0; igA[128 + j1] = s1; CB[j0] = s0; CB[j1] = s1;
                    asm volatile("s_waitcnt lgkmcnt(0)" ::: "memory");
                    const int q0 = 127 - 2 * lane, q1 = q0 - 1; float m0, m1; wave_scan_max2(lfA[128 + q0], lfA[128 + q1], m0, m1);
                    CMI[q0] = igA[128 + q0] + m0; CMI[q1] = igA[128 + q1] + m1; } }
        }
        __syncthreads();
        {
            float lo[16], hi[16];
            cvt_rows(rawK, mixer == 0 && ch >= 2, (ch - 2) * 128, ROPE, lo, hi);
            st_rows_T(KsT, lo, hi, 0.08838834764831845f);
            cvt_rows(rawV, false, 0, ROPE, lo, hi);
            const int i = tid >> 2;
            st_rows_T(VsT0, lo, hi, z[i]); st_rows_T(VsT1, lo, hi, z[128 + i]);
        }
        __syncthreads();
#pragma unroll
        for (int dir = 0; dir < 2; ++dir) {
            f32x4 acc[2][4]; zero_acc(acc);
            mma_128(dir == 0 ? VsT0 : VsT1, KsT, acc, wr, wc, lane);
            bf16_t* dst = (bf16_t*)ST + (size_t)sid_of(mixer, dir, b, ch, h) * 16384;
#pragma unroll
            for (int mt = 0; mt < 2; ++mt)
#pragma unroll
                for (int nt = 0; nt < 4; ++nt)
#pragma unroll
                    for (int r = 0; r < 4; ++r) dst[(wr * 32 + mt * 16 + fq * 4 + r) * 128 + wc * 64 + nt * 16 + fr] = f2bf(acc[mt][nt][r]);
        }
        if (mixer == 1 && tid < 256) { const int dir = tid >> 7, dd = tid & 127; float s = 0.f;
            for (int j = 0; j < 128; ++j) s += z[dir * 128 + j] * bf2f(KsT[dd * LDK + j]);
            NST[(size_t)sid_of(1, dir, b, ch, h) * 128 + dd] = s; }
        __syncthreads();
    }
}
__device__ __forceinline__ void ph_c2(const Params& p, int bid, int nblk) {
    const int tid = threadIdx.x;
    float* ST = (float*)(p.ws + WS_ST); float* NST = (float*)(p.ws + WS_NST); bf16_t* STB = (bf16_t*)(p.ws + WS_STB);
    const float* MEND = (const float*)(p.ws + WS_MEND); const float* BEND = (const float*)(p.ws + WS_BEND); float* MPREV = (float*)(p.ws + WS_MPREV);
    for (int item = bid; item < 256; item += nblk) {
        const int mixer = item >> 7, chain = (item >> 2) & 31, slab = item & 3, dir = chain >> 4, b = (chain >> 2) & 3, h = chain & 3;
        const int idx = slab * 4096 + tid * 8;
        float st[8];
#pragma unroll
        for (int i = 0; i < 8; ++i) st[i] = 0.f;
        const float gdec = mixer == 0 ? fexp(p.in[I_CLG][dir * 4 + h] * 128.0f) : 0.f;
        const bool do_n = mixer == 1 && slab == 0 && tid < 128;
        float m = -__builtin_inff(), n = 0.f;
#pragma unroll 1
        for (int k0 = 0; k0 < NCHUNK; k0 += 17) {
            u32x4 kv[17]; float nv[17];
#pragma unroll
            for (int k = 0; k < 17; ++k) { const int kk = k0 + k, ch = dir == 0 ? kk : (kk < 2 ? 1 - kk : 35 - kk); const int sid = sid_of(mixer, dir, b, ch, h);
                kv[k] = *(const u32x4*)((const bf16_t*)ST + (size_t)sid * 16384 + idx); nv[k] = do_n ? NST[(size_t)sid * 128 + tid] : 0.f; }
#pragma unroll
            for (int k = 0; k < 17; ++k) { const int kk = k0 + k, ch = dir == 0 ? kk : (kk < 2 ? 1 - kk : 35 - kk); const int sid = sid_of(mixer, dir, b, ch, h);
                u32x4 q;
#pragma unroll
                for (int i = 0; i < 4; ++i) q[i] = pack_bf16(st[2 * i], st[2 * i + 1]);
                *(u32x4*)(STB + (size_t)sid * 16384 + idx) = q;
                float so = gdec, sn = 1.0f;
                if (mixer == 1) { const float me = MEND[sid], be = BEND[sid], mnew = fmaxf(be + m, me); so = fexp(be + m - mnew); sn = fexp(me - mnew);
                    if (do_n) { NST[(size_t)sid * 128 + tid] = n; n = n * so + nv[k] * sn; }
                    if (slab == 0 && tid == 0) MPREV[sid] = m;
                    m = mnew; }
#pragma unroll
                for (int i = 0; i < 8; ++i) { const unsigned wv = kv[k][i >> 1]; st[i] = st[i] * so + __uint_as_float((i & 1) ? (wv & 0xffff0000u) : (wv << 16)) * sn; } }
        }
    }
}
template <int mixer>
__device__ __forceinline__ void c3_unit(const Params& p, LAS unsigned char* lds, int h, int ch, int b, int row0) {
    int tid_ = threadIdx.x; asm volatile("" : "+v"(tid_));
    const int tid = tid_, wid = tid >> 6, lane = tid & 63, wr = wid >> 1, wc = wid & 1, fr = lane & 15, fq = lane >> 4;
    LAS bf16_t* Qs = (LAS bf16_t*)(lds + LDS_WORK); LAS bf16_t* Ks = Qs + 128 * LDK; LAS bf16_t* VsT = Ks + 128 * LDK; LAS bf16_t* RT = VsT + 128 * LDK;
    LAS float* fa = (LAS float*)(RT + 128 * LDK);
    LAS float* lfA = fa; LAS float* igA = fa + 256; LAS float* bA = fa + 512; LAS float* miA = fa + 768; LAS float* mtA = fa + 1024; LAS float* sintA = fa + 1280;
    LAS float* rowsum = fa + 1536; LAS float* qn = fa + 2048; LAS float* nA = fa + 2304;
    LAS float* Os = (LAS float*)Qs;
    LAS bf16_t* Pm = Ks;
    const bf16_t* P = (const bf16_t*)(p.ws + WS_P); const float* GT = (const float*)(p.ws + WS_GT); const float* ROPE = (const float*)(p.ws + WS_ROPE);
    const bf16_t* STB = (const bf16_t*)(p.ws + WS_STB); const float* NST = (const float*)(p.ws + WS_NST); const float* MPREV = (const float*)(p.ws + WS_MPREV);
    bf16_t* Y = (bf16_t*)(p.ws + WS_YMIX);
    {
        const int colQ = mixer * 2048 + h * 128; const bool rope = mixer == 0 && ch >= 2;
        {
            u32x2 rawQ[8], rawK[8], rawV[8]; ld_raw(P, row0, colQ, rawQ); ld_raw(P, row0, colQ + 512, rawK); ld_raw(P, row0, colQ + 1024, rawV);
            float lo[16], hi[16];
            cvt_rows(rawQ, rope, (ch - 2) * 128, ROPE, lo, hi); st_rows(Qs, lo, hi, 1.0f);
            cvt_rows(rawK, rope, (ch - 2) * 128, ROPE, lo, hi); st_rows(Ks, lo, hi, 0.08838834764831845f);
            cvt_rows(rawV, false, 0, ROPE, lo, hi); st_rows_T(VsT, lo, hi, 1.0f);
        }
        if (mixer == 1) {
            if (tid < 256) { const int dir = tid >> 7, j = tid & 127, row = row0 + j;
                igA[tid] = GT[row * 16 + dir * 4 + h] + p.in[I_DIB][dir * 4 + h];
                nA[tid] = NST[(size_t)sid_of(1, dir, b, ch, h) * 128 + j];
                bA[tid] = ((const float*)(p.ws + WS_CB))[(size_t)sid_of(1, dir, b, ch, h) * 128 + j]; miA[tid] = ((const float*)(p.ws + WS_CMI))[(size_t)sid_of(1, dir, b, ch, h) * 128 + j]; }
            __syncthreads();
            __syncthreads();
            if (tid < 256) { const int dir = tid >> 7, i = tid & 127; const float mprev = MPREV[sid_of(1, dir, b, ch, h)];
                const float gi = bA[tid] + mprev, mt = fmaxf(gi, miA[tid]); mtA[tid] = mt; sintA[tid] = fexp(gi - mt);
                float s = 0.f;
                for (int d0 = 0; d0 < 128; ++d0) s += bf2f(Qs[i * LDK + d0]) * nA[dir * 128 + d0];
                qn[tid] = s; }
        }
        __syncthreads();
        f32x4 S[2][4]; zero_acc(S);
        mma_128(Qs, Ks, S, wr, wc, lane);
        __syncthreads();
        f32x4 O[2][4]; zero_acc(O);
        if (mixer == 0) {
            const float lg0 = p.in[I_CLG][h], lg1 = p.in[I_CLG][4 + h];
#pragma unroll
            for (int mt = 0; mt < 2; ++mt)
#pragma unroll
                for (int nt = 0; nt < 4; ++nt)
#pragma unroll
                    for (int r = 0; r < 4; ++r) { const int i = wr * 32 + mt * 16 + fq * 4 + r, j = wc * 64 + nt * 16 + fr;
                        const float dcy = (i >= j ? fexp(lg0 * (float)(i - j)) : 0.f) + (j >= i ? fexp(lg1 * (float)(j - i)) : 0.f);
                        Pm[i * LDK + j] = f2bf(S[mt][nt][r] * dcy); }
            __syncthreads();
            mma_128(Pm, VsT, O, wr, wc, lane);
#pragma unroll
            for (int dir = 0; dir < 2; ++dir) {
                { const bf16_t* src = STB + (size_t)sid_of(0, dir, b, ch, h) * 16384 + (tid >> 2) * 128 + (tid & 3) * 32; LAS bf16_t* d = RT + (tid >> 2) * LDK + (tid & 3) * 32;
#pragma unroll
                    for (int q = 0; q < 4; ++q) *(LAS u32x4*)(d + q * 8) = *(const u32x4*)(src + q * 8); }
                __syncthreads();
                f32x4 T[2][4]; zero_acc(T);
                mma_128(Qs, RT, T, wr, wc, lane);
#pragma unroll
                for (int mt = 0; mt < 2; ++mt)
#pragma unroll
                    for (int r = 0; r < 4; ++r) { const int i = wr * 32 + mt * 16 + fq * 4 + r; const float xi = dir == 0 ? fexp(lg0 * (float)(i + 1)) : fexp(lg1 * (float)(128 - i));
#pragma unroll
                        for (int nt = 0; nt < 4; ++nt) O[mt][nt][r] += xi * T[mt][nt][r]; }
                __syncthreads();
            }
        } else {
#pragma unroll
            for (int dir = 0; dir < 2; ++dir) {
                float rp[2][4];
#pragma unroll
                for (int mt = 0; mt < 2; ++mt)
#pragma unroll
                    for (int r = 0; r < 4; ++r) { const int i = wr * 32 + mt * 16 + fq * 4 + r; const float bi = bA[dir * 128 + i] - mtA[dir * 128 + i]; float acc = 0.f;
#pragma unroll
                        for (int nt = 0; nt < 4; ++nt) { const int j = wc * 64 + nt * 16 + fr; const bool valid = dir == 0 ? (j <= i) : (j >= i);
                            const float e = valid ? fexp(bi - bA[dir * 128 + j] + igA[dir * 128 + j]) : 0.f; const float pv = S[mt][nt][r] * e;
                            Pm[i * LDK + j] = f2bf(pv); acc += pv; }
                        rp[mt][r] = row16_sum(acc); }
                if (fr == 0) {
#pragma unroll
                    for (int mt = 0; mt < 2; ++mt)
#pragma unroll
                        for (int r = 0; r < 4; ++r) rowsum[wc * 256 + dir * 128 + wr * 32 + mt * 16 + fq * 4 + r] = rp[mt][r];
                }
                { const bf16_t* src = STB + (size_t)sid_of(1, dir, b, ch, h) * 16384 + (tid >> 2) * 128 + (tid & 3) * 32; LAS bf16_t* d = RT + (tid >> 2) * LDK + (tid & 3) * 32;
#pragma unroll
                    for (int q = 0; q < 4; ++q) *(LAS u32x4*)(d + q * 8) = *(const u32x4*)(src + q * 8); }
                __syncthreads();
                f32x4 T[2][4]; zero_acc(T);
                mma_128(Qs, RT, T, wr, wc, lane);
#pragma unroll
                for (int mt = 0; mt < 2; ++mt)
#pragma unroll
                    for (int r = 0; r < 4; ++r) { const float si = sintA[dir * 128 + wr * 32 + mt * 16 + fq * 4 + r];
#pragma unroll
                        for (int nt = 0; nt < 4; ++nt) T[mt][nt][r] *= si; }
                mma_128(Pm, VsT, T, wr, wc, lane);
#pragma unroll
                for (int mt = 0; mt < 2; ++mt)
#pragma unroll
                    for (int r = 0; r < 4; ++r) { const int i = wr * 32 + mt * 16 + fq * 4 + r; const float si = sintA[dir * 128 + i];
                        float den = (rowsum[dir * 128 + i] + rowsum[256 + dir * 128 + i]) + qn[dir * 128 + i] * si; den = fmaxf(fabsf(den), fexp(-mtA[dir * 128 + i])); const float rden = frcp(den);
#pragma unroll
                        for (int nt = 0; nt < 4; ++nt) O[mt][nt][r] += T[mt][nt][r] * rden; }
                __syncthreads();
            }
        }
#pragma unroll
        for (int mt = 0; mt < 2; ++mt)
#pragma unroll
            for (int nt = 0; nt < 4; ++nt)
#pragma unroll
                for (int r = 0; r < 4; ++r) Os[(wr * 32 + mt * 16 + fq * 4 + r) * 132 + wc * 64 + nt * 16 + fr] = O[mt][nt][r];
        __syncthreads();
        {
            const float* gng = (mixer == 0 ? p.in[I_CGNG] : p.in[I_DGNG]) + h * 128; const float* gnb = (mixer == 0 ? p.in[I_CGNB] : p.in[I_DGNB]) + h * 128;
            const float g0 = gng[lane], g1 = gng[lane + 64], b0 = gnb[lane], b1 = gnb[lane + 64];
#pragma unroll 1
            for (int i4 = 0; i4 < 16; i4 += 4) {
                float qg0[4], qg1[4];
#pragma unroll
                for (int u = 0; u < 4; ++u) { const int row = row0 + wid * 16 + i4 + u; qg0[u] = bf2f(P[(size_t)row * LDP1 + colQ + 1536 + lane]); qg1[u] = bf2f(P[(size_t)row * LDP1 + colQ + 1536 + 64 + lane]); }
#pragma unroll
                for (int u = 0; u < 4; ++u) { const int i = wid * 16 + i4 + u, row = row0 + i;
                    const float x0 = Os[i * 132 + lane], x1 = Os[i * 132 + 64 + lane];
                    const float mean = wave_sum(x0 + x1) * (1.0f / 128.0f), d0 = x0 - mean, d1 = x1 - mean;
                    const float rstd = rsqrtf(wave_sum(d0 * d0 + d1 * d1) * (1.0f / 128.0f) + LN_EPS);
                    const float q0 = qg0[u], q1 = qg1[u];
                    const float s0 = sigm(q0), s1 = sigm(q1);
                    const float y0 = (d0 * rstd * g0 + b0) * (mixer == 0 ? q0 * s0 : s0), y1 = (d1 * rstd * g1 + b1) * (mixer == 0 ? q1 * s1 : s1);
                    Y[(size_t)row * 1024 + mixer * 512 + h * 128 + lane] = f2bf(y0); Y[(size_t)row * 1024 + mixer * 512 + h * 128 + 64 + lane] = f2bf(y1); }
            }
        }
        __syncthreads();
    }
}
__device__ __forceinline__ void ph_c3(const Params& p, LAS unsigned char* lds, int bid, int nblk) {
    for (int u2 = bid; u2 < NB * NCHUNK * 4; u2 += nblk) {
        int mixer, h, ch, b, row0; unit_decode(u2 * 2, mixer, h, ch, b, row0);
        c3_unit<0>(p, lds, h, ch, b, row0);
    }
    for (int u2 = nblk - 1 - bid; u2 < NB * NCHUNK * 4; u2 += nblk) {
        int mixer, h, ch, b, row0; unit_decode(u2 * 2 + 1, mixer, h, ch, b, row0);
        c3_unit<1>(p, lds, h, ch, b, row0);
    }
}
constexpr int NPHASE = 23;
__global__ void __launch_bounds__(NTHR, 2) fwd(Params p) {
    extern __shared__ __attribute__((aligned(16))) unsigned char smem_raw[];
    LAS unsigned char* lds = (LAS unsigned char*)smem_raw;
    if (threadIdx.x == 0) { LAS unsigned* st = (LAS unsigned*)(lds + LDS_BAR); st[0] = 0u; st[1] = 0u; st[2] = 0u; st[3] = 0u; }
    __syncthreads();
    XcdBarrier bar = xcd_barrier_post((unsigned*)(p.ws + WS_CTL), (volatile LAS unsigned*)(lds + LDS_BAR));
    const int bid = blockIdx.x, nblk = gridDim.x;
    unsigned char* ws = p.ws;
#ifndef PHASE_ONLY
#define PHASE_ONLY -1
#endif
#ifndef DBL_MASK
#define DBL_MASK 0u
#endif
#define PHASE(k, call) if constexpr (PHASE_ONLY < 0 || PHASE_ONLY == (k)) { if (p.lo <= (k) && (k) < p.hi) { call; if constexpr ((DBL_MASK >> (k)) & 1u) { xcd_barrier(bar); call; } if ((k) + 1 < p.hi) xcd_barrier(bar); } }
    PHASE(0, ph_prologue(p, lds, bid, nblk))
    PHASE(1, ph_mod_in(p, bid, nblk))
    PHASE(2, ph_gemm_dense<12>(lds, (const bf16_t*)(ws + WS_H), (const bf16_t*)(ws + WS_WIN0T), (bf16_t*)(ws + WS_P), LDP0, 0, 68, bid, nblk))
    PHASE(3, ph_prep_even(p, lds, bid, nblk))
    PHASE(4, ph_r1(p, lds, bid, nblk))
    PHASE(5, ph_r2(p, lds, bid, nblk))
    PHASE(6, ph_fin_even(p, bid, nblk))
    PHASE(7, ph_gemm_dense<4>(lds, (const bf16_t*)(ws + WS_YMIX), (const bf16_t*)(ws + WS_WOUTT), (bf16_t*)(ws + WS_YP), 1024, 0, 68, bid, nblk))
    PHASE(8, ph_ln1<0>(p, lds, bid, nblk))
    PHASE(9, ph_moe_gather<0>(p, lds, bid, nblk))
    PHASE(10, ph_moe_gemm1<0>(p, lds, bid, nblk))
    PHASE(11, ph_moe_gemm2<0>(p, lds, bid, nblk))
    PHASE(12, ph_ln2<0>(p, lds, bid, nblk))
    PHASE(13, ph_gemm_dense<16>(lds, (const bf16_t*)(ws + WS_H), (const bf16_t*)(ws + WS_WIN1T), (bf16_t*)(ws + WS_P), LDP1, 0, 68, bid, nblk))
    PHASE(14, ph_c1(p, lds, bid, nblk))
    PHASE(15, ph_c2(p, bid, nblk))
    PHASE(16, ph_c3(p, lds, bid, nblk))
    PHASE(17, ph_gemm_dense<4>(lds, (const bf16_t*)(ws + WS_YMIX), (const bf16_t*)(ws + WS_WOUTT) + (size_t)1024 * 1024, (bf16_t*)(ws + WS_YP), 1024, 4, 64, bid, nblk))
    PHASE(18, ph_ln1<1>(p, lds, bid, nblk))
    PHASE(19, ph_moe_gather<1>(p, lds, bid, nblk))
    PHASE(20, ph_moe_gemm1<1>(p, lds, bid, nblk))
    PHASE(21, ph_moe_gemm2<1>(p, lds, bid, nblk))
    PHASE(22, ph_ln2<1>(p, lds, bid, nblk))
#undef PHASE
}

#ifndef MK_ONE_LAUNCH
#define MK_ONE_LAUNCH 1
#endif
extern "C" void kernel_launch(void* const* d_in, const int* in_sizes, int n_in, void* d_out, int out_size, void* d_ws, size_t ws_size, hipStream_t stream) {
    static int grid = 0;
    if (grid == 0) {
        if (n_in != N_INPUTS || out_size != NB * SEQL * DM || ws_size < WS_TOTAL) { fprintf(stderr, "kernel_launch: unexpected problem (n_in %d, out %d, ws %zu < %zu)\n", n_in, out_size, ws_size, (size_t)WS_TOTAL); grid = -1; return; }
        int dev = 0, cus = 0, per_cu = 0;
        if (hipGetDevice(&dev) != hipSuccess || hipDeviceGetAttribute(&cus, hipDeviceAttributeMultiprocessorCount, dev) != hipSuccess) { grid = -1; return; }
        if (hipFuncSetAttribute((const void*)fwd, hipFuncAttributeMaxDynamicSharedMemorySize, LDS_BYTES) != hipSuccess) { fprintf(stderr, "kernel_launch: hipFuncSetAttribute failed\n"); grid = -1; return; }
        if (hipOccupancyMaxActiveBlocksPerMultiprocessor(&per_cu, (const void*)fwd, NTHR, LDS_BYTES) != hipSuccess || per_cu < 1) { fprintf(stderr, "kernel_launch: occupancy query says %d\n", per_cu); (void)hipGetLastError(); per_cu = 1; }
        grid = cus;
    }
    if (grid < 0) return;
    (void)hipMemsetAsync((char*)d_ws + WS_CTL, 0, CTL_BYTES, stream);
    Params p{};
    for (int i = 0; i < N_INPUTS; ++i) p.in[i] = (const float*)d_in[i];
    p.out = (float*)d_out; p.ws = (unsigned char*)d_ws;
#if MK_ONE_LAUNCH
    p.lo = 0; p.hi = NPHASE;
    hipLaunchKernelGGL(fwd, dim3(grid), dim3(NTHR), LDS_BYTES, stream, p);
#else
    for (int k = 0; k < NPHASE; ++k) { p.lo = k; p.hi = k + 1; hipLaunchKernelGGL(fwd, dim3(grid), dim3(NTHR), LDS_BYTES, stream, p); }
#endif
}
```

```cpp
#include <hip/hip_runtime.h>
#include <stdint.h>
#include <stdio.h>

#define LAS __attribute__((address_space(3)))
typedef unsigned short bf16_t;
typedef short bf16x8 __attribute__((ext_vector_type(8)));
typedef float f32x4 __attribute__((ext_vector_type(4)));
typedef float f32x2 __attribute__((ext_vector_type(2)));
typedef unsigned u32x4 __attribute__((ext_vector_type(4)));
typedef unsigned u32x2 __attribute__((ext_vector_type(2)));

constexpr int NB = 4, SEQL = 4096, CTXL = 256, DM = 1024;
constexpr int NCTX = NB * CTXL;
constexpr int MROWS = NCTX + NB * SEQL;
constexpr int NTHR = 512;
constexpr int LDP0 = 3072, LDP1 = 4096;
constexpr int A_IN = 1920, EVEN_IN = 2944, ODD_IN = 4112;
constexpr int NEXP = 32, DFF = 1024;
constexpr int MOE_ROWS_MAX = 69632 + 32 * 256;
constexpr float DN_ALPHA = 1.41421356237309515f;
constexpr float LN_EPS = 1e-5f;
constexpr int NCHUNK = 34;

enum { I_X = 0, I_C, I_CTX, I_CCTX, I_WMOD, I_BMOD, I_LNG, I_LNB, I_EWIN, I_EWOUT, I_AMU, I_AW0, I_AWB, I_AA0, I_AAB, I_AGB, I_AKK, I_AKA, I_ARK,
       I_AGNG, I_AGNB, I_BCW, I_BCB, I_BGW, I_BGB, I_BLAM, I_OWIN, I_OWOUT, I_CLG, I_CGNG, I_CGNB, I_DIB, I_DFB, I_DGNG, I_DGNB, I_RW, I_RB,
       I_W1, I_B1, I_W2, I_B2, N_INPUTS };

constexpr size_t al256(size_t x) { return (x + 255) & ~(size_t)255; }
constexpr size_t WS_CTL   = 0;
constexpr size_t CTL_BYTES = 65536;
constexpr size_t CTL_CNT  = 16384;
constexpr size_t WS_MOD   = WS_CTL + CTL_BYTES;
constexpr size_t WS_ROPE  = WS_MOD + al256((size_t)2 * 5 * 6144 * 4);
constexpr size_t WS_WIN0T = WS_ROPE + 16384;
constexpr size_t WS_WIN1T = WS_WIN0T + (size_t)3072 * 1024 * 2;
constexpr size_t WS_WOUTT = WS_WIN1T + (size_t)4096 * 1024 * 2;
constexpr size_t WS_W1T   = WS_WOUTT + (size_t)2 * 1024 * 1024 * 2;
constexpr size_t WS_W2T   = WS_W1T + (size_t)2 * 32 * 2048 * 1024 * 2;
constexpr size_t WS_XS    = WS_W2T + (size_t)2 * 32 * 1024 * 1024 * 2;
constexpr size_t WS_H     = WS_XS + (size_t)MROWS * 1024 * 4;
constexpr size_t WS_YMIX  = WS_H + (size_t)MROWS * 1024 * 2;
constexpr size_t WS_YP    = WS_YMIX + (size_t)MROWS * 1024 * 2;
constexpr size_t WS_GT    = WS_YP + (size_t)MROWS * 1024 * 4;
constexpr size_t WS_TOPE  = WS_GT + (size_t)MROWS * 16 * 4;
constexpr size_t WS_TOPW  = WS_TOPE + (size_t)MROWS * 16;
constexpr size_t WS_TOPS  = WS_TOPW + (size_t)MROWS * 16;
constexpr size_t WS_POS   = WS_TOPS + (size_t)MROWS * 16;
constexpr size_t WS_CNTB  = WS_POS + (size_t)MROWS * 16;
constexpr size_t WS_WLT   = WS_CNTB + (size_t)2 * 512 * 32 * 4;
constexpr size_t WLT_WB = 0, WLT_AB = 65536, WLT_GB = 131072, WLT_GW = 196608, WLT_N = 327680;
constexpr size_t WS_P     = WS_WLT + (size_t)WLT_N * 2;
constexpr size_t WS_BIG   = WS_P + (size_t)MROWS * 4096 * 4;
constexpr size_t ARR512   = (size_t)MROWS * 512 * 4;
constexpr int SCREC = 448;
constexpr int SCLEN = CTXL + SEQL;
constexpr size_t WS_SC    = WS_BIG;
enum { E_G = 0, E_O0, E_O1, E_A0, E_A1, E_BX0, E_BX1, E_GATE, E_NARR };
constexpr size_t WS_EARR  = WS_SC + (size_t)64 * SCLEN * SCREC * 2;
constexpr size_t WS_BC    = WS_EARR + (size_t)E_NARR * ARR512;
constexpr size_t WS_CHA   = WS_BC + (size_t)MROWS * 8 * 4;
constexpr size_t WS_CHH   = WS_CHA + (size_t)2 * 512 * 512 * 4;
constexpr size_t WS_CIN   = WS_CHH + (size_t)2 * 512 * 512 * 4;
constexpr int RCH = 64, NRCH = SCLEN / RCH, NRUNIT = 64 * NRCH;
constexpr int RUS = 12288;
constexpr size_t WS_RU    = WS_CIN + (size_t)2 * 512 * 512 * 4;
constexpr size_t WS_EEND  = WS_RU + (size_t)NRUNIT * 4 * 4096 * 4;
constexpr int NSID = 2 * 2 * NB * NCHUNK * 4;
constexpr size_t WS_ST    = WS_BIG;
constexpr size_t WS_NST   = WS_ST + (size_t)NSID * 16384 * 4;
constexpr size_t WS_MEND  = WS_NST + (size_t)NSID * 128 * 4;
constexpr size_t WS_BEND  = WS_MEND + al256((size_t)NSID * 4);
constexpr size_t WS_MPREV = WS_BEND + al256((size_t)NSID * 4);
constexpr size_t WS_CB    = WS_MPREV + al256((size_t)NSID * 4);
constexpr size_t WS_CMI   = WS_CB + (size_t)NSID * 128 * 4;
constexpr size_t WS_STB   = WS_CMI + (size_t)NSID * 128 * 4;
constexpr size_t WS_OEND  = WS_STB + (size_t)NSID * 16384 * 2;
constexpr size_t WS_ASORT = WS_BIG;
constexpr size_t WS_IDX   = WS_BIG;
constexpr size_t WS_ACT   = WS_ASORT + (size_t)MOE_ROWS_MAX * 1024 * 2;
constexpr size_t WS_YE    = WS_ACT + (size_t)MOE_ROWS_MAX * 1024 * 2;
constexpr size_t WS_MEND_ = WS_YE + (size_t)MOE_ROWS_MAX * 1024 * 4;
constexpr size_t WS_TOTAL = (WS_EEND > WS_MEND_ ? (WS_EEND > WS_OEND ? WS_EEND : WS_OEND) : (WS_MEND_ > WS_OEND ? WS_MEND_ : WS_OEND));

constexpr int LDS_BYTES = 155648;
constexpr int LDS_BAR = 0;
constexpr int LDS_WORK = 1024;

struct Params {
    const float* in[N_INPUTS];
    float* out;
    unsigned char* ws;
    int lo, hi;
};

typedef __bf16 nbf16x2 __attribute__((ext_vector_type(2)));
__device__ __forceinline__ unsigned pack_bf16(float lo, float hi) { const nbf16x2 v = {(__bf16)lo, (__bf16)hi}; return __builtin_bit_cast(unsigned, v); }
__device__ __forceinline__ bf16_t f2bf(float f) { return __builtin_bit_cast(bf16_t, (__bf16)f); }
__device__ __forceinline__ float bf2f(bf16_t b) { return __uint_as_float(((unsigned)b) << 16); }
__device__ __forceinline__ f32x4 ld_bf16x4(const bf16_t* p) { const u32x2 w = *(const u32x2*)p; return (f32x4){__uint_as_float(w.x << 16), __uint_as_float(w.x & 0xffff0000u), __uint_as_float(w.y << 16), __uint_as_float(w.y & 0xffff0000u)}; }
__device__ __forceinline__ float fexp(float x) { return __builtin_amdgcn_exp2f(x * 1.4426950408889634f); }
__device__ __forceinline__ float frcp(float x) { return __builtin_amdgcn_rcpf(x); }
__device__ __forceinline__ float fsqrt(float x) { return __builtin_amdgcn_sqrtf(x); }
__device__ __forceinline__ float sigm(float x) { return frcp(1.0f + fexp(-x)); }
__device__ __forceinline__ float ftanh(float x) { const float e = fexp(-2.0f * fabsf(x)), t = (1.0f - e) * frcp(1.0f + e); return x < 0.f ? -t : t; }
__device__ __forceinline__ float fexpm1_neg(float x) {
    const float p = x * (1.0f + x * (0.5f + x * (0.16666667f + x * (0.041666668f + x * 0.0083333338f))));
    return x > -0.25f ? p : fexp(x) - 1.0f; }
__device__ __forceinline__ float softplusf(float x) { return fmaxf(x, 0.f) + log1pf(expf(-fabsf(x))); }
__device__ __forceinline__ float wave_sum(float v) {
    v += __int_as_float(__builtin_amdgcn_update_dpp(0, __float_as_int(v), 0x121, 0xf, 0xf, false));
    v += __int_as_float(__builtin_amdgcn_update_dpp(0, __float_as_int(v), 0x122, 0xf, 0xf, false));
    v += __int_as_float(__builtin_amdgcn_update_dpp(0, __float_as_int(v), 0x124, 0xf, 0xf, false));
    v += __int_as_float(__builtin_amdgcn_update_dpp(0, __float_as_int(v), 0x128, 0xf, 0xf, false));
    v += __int_as_float(__builtin_amdgcn_update_dpp(0, __float_as_int(v), 0x142, 0xa, 0xf, false));
    v += __int_as_float(__builtin_amdgcn_update_dpp(0, __float_as_int(v), 0x143, 0xc, 0xf, false));
    return __int_as_float(__builtin_amdgcn_readlane(__float_as_int(v), 63));
}
__device__ __forceinline__ float wave_max(float v) {
    const int ninf = 0xff800000;
    v = fmaxf(v, __int_as_float(__builtin_amdgcn_update_dpp(ninf, __float_as_int(v), 0x121, 0xf, 0xf, false)));
    v = fmaxf(v, __int_as_float(__builtin_amdgcn_update_dpp(ninf, __float_as_int(v), 0x122, 0xf, 0xf, false)));
    v = fmaxf(v, __int_as_float(__builtin_amdgcn_update_dpp(ninf, __float_as_int(v), 0x124, 0xf, 0xf, false)));
    v = fmaxf(v, __int_as_float(__builtin_amdgcn_update_dpp(ninf, __float_as_int(v), 0x128, 0xf, 0xf, false)));
    v = fmaxf(v, __int_as_float(__builtin_amdgcn_update_dpp(ninf, __float_as_int(v), 0x142, 0xa, 0xf, false)));
    v = fmaxf(v, __int_as_float(__builtin_amdgcn_update_dpp(ninf, __float_as_int(v), 0x143, 0xc, 0xf, false)));
    return __int_as_float(__builtin_amdgcn_readlane(__float_as_int(v), 63));
}
__device__ __forceinline__ int wave_min_i(int v) {
    const int big = 0x7fffffff;
    v = min(v, __builtin_amdgcn_update_dpp(big, v, 0x121, 0xf, 0xf, false));
    v = min(v, __builtin_amdgcn_update_dpp(big, v, 0x122, 0xf, 0xf, false));
    v = min(v, __builtin_amdgcn_update_dpp(big, v, 0x124, 0xf, 0xf, false));
    v = min(v, __builtin_amdgcn_update_dpp(big, v, 0x128, 0xf, 0xf, false));
    v = min(v, __builtin_amdgcn_update_dpp(big, v, 0x142, 0xa, 0xf, false));
    v = min(v, __builtin_amdgcn_update_dpp(big, v, 0x143, 0xc, 0xf, false));
    return __builtin_amdgcn_readlane(v, 63);
}
__device__ __forceinline__ float row16_sum(float v) {
    v += __int_as_float(__builtin_amdgcn_update_dpp(0, __float_as_int(v), 0x121, 0xf, 0xf, false));
    v += __int_as_float(__builtin_amdgcn_update_dpp(0, __float_as_int(v), 0x122, 0xf, 0xf, false));
    v += __int_as_float(__builtin_amdgcn_update_dpp(0, __float_as_int(v), 0x124, 0xf, 0xf, false));
    v += __int_as_float(__builtin_amdgcn_update_dpp(0, __float_as_int(v), 0x128, 0xf, 0xf, false));
    return v;
}
__device__ __forceinline__ int row_batch(int row) { return row < NCTX ? (row >> 8) : ((row - NCTX) >> 12); }
__device__ __forceinline__ int row_modr(int row) { return row < NCTX ? 4 : ((row - NCTX) >> 12); }
#define XB_TMO      128
#define XB_XCNT(j)  (256  + 64 * (j))
#define XB_XSUB(j)  (1280 + 64 * (j))
#define XB_XGEN(j)  (2304 + 64 * (j))
#define XB_TOP      3328
#define XB_TOPGEN   3392
#define XCD_BAR_WORDS 3456
#define XB_SPIN_CAP (1u << 18)

__device__ __forceinline__ unsigned xb_ld(unsigned* p)              { return __hip_atomic_load(p, __ATOMIC_RELAXED, __HIP_MEMORY_SCOPE_AGENT); }
__device__ __forceinline__ unsigned xb_add(unsigned* p, unsigned v) { return __hip_atomic_fetch_add(p, v, __ATOMIC_RELAXED, __HIP_MEMORY_SCOPE_AGENT); }
__device__ __forceinline__ unsigned xb_xcc_id() { return (unsigned)__builtin_amdgcn_s_getreg((3 << 11) | 20) & 0xFu; }
#define XB_SPIN(cond, bar) do { unsigned _sp = 0; while (cond) { __builtin_amdgcn_s_sleep(1); \
    if ((++_sp & 255u) == 0u) { if (xb_ld(&(bar)[XB_TMO])) break; if (_sp > XB_SPIN_CAP) { atomicAdd(&(bar)[XB_TMO], 1u); break; } } } } while (0)

struct XcdBarrier {
    unsigned* bar; unsigned x;
    volatile LAS unsigned* st;
};

__device__ __forceinline__ XcdBarrier xcd_barrier_post(unsigned* bar, volatile LAS unsigned* st) {
    XcdBarrier b; b.bar = bar; b.x = xb_xcc_id(); b.st = st;
    if (threadIdx.x == 0) (void)xb_add(&bar[XB_XCNT(b.x)], 1u);
    return b;
}
__device__ __forceinline__ void xcd_barrier_complete(unsigned* bar, unsigned x, unsigned& nloc, unsigned& nx) {
    const unsigned G = gridDim.x * gridDim.y * gridDim.z;
    unsigned sum, cnt, mine, sp = 0u;
    for (;;) {
        sum = 0u; cnt = 0u; mine = 0u;
#pragma unroll
        for (unsigned j = 0; j < 16; ++j) { const unsigned c = xb_ld(&bar[XB_XCNT(j)]); sum += c; cnt += (c > 0u) ? 1u : 0u; mine = (j == x) ? c : mine; }
        if (sum == G) break;
        __builtin_amdgcn_s_sleep(1);
        if ((++sp & 255u) == 0u) { if (xb_ld(&bar[XB_TMO])) break; if (sp > XB_SPIN_CAP) { atomicAdd(&bar[XB_TMO], 1u); break; } }
    }
    nloc = mine > 0u ? mine : 1u; nx = cnt > 0u ? cnt : 1u;
}

__device__ __forceinline__ void xcd_barrier(const XcdBarrier& b) {
    asm volatile("s_waitcnt vmcnt(0)" ::: "memory");
    __syncthreads();
    if (threadIdx.x == 0) {
        unsigned* bar = b.bar;
        __builtin_amdgcn_s_waitcnt(0);
        unsigned nloc = b.st[0], nx = b.st[1];
        if (nloc == 0u) { xcd_barrier_complete(bar, b.x, nloc, nx); b.st[0] = nloc; b.st[1] = nx; }
        const unsigned old = xb_add(&bar[XB_XSUB(b.x)], 1u);
        const unsigned gen = old / nloc;
        if (old + 1u == (gen + 1u) * nloc) {
            __builtin_amdgcn_fence(__ATOMIC_RELEASE, "agent");
            asm volatile("s_waitcnt vmcnt(0)" ::: "memory");
            const unsigned og = xb_add(&bar[XB_TOP], 1u);
            const unsigned tg = og / nx;
            if (og + 1u == (tg + 1u) * nx) xb_add(&bar[XB_TOPGEN], 1u);
            else XB_SPIN(xb_ld(&bar[XB_TOPGEN]) == tg, bar);
            __builtin_amdgcn_fence(__ATOMIC_ACQUIRE, "agent");
            xb_add(&bar[XB_XGEN(b.x)], 1u);
            asm volatile("s_waitcnt vmcnt(0)" ::: "memory");
        } else {
            XB_SPIN(xb_ld(&bar[XB_XGEN(b.x)]) == gen, bar);
            __builtin_amdgcn_fence(__ATOMIC_ACQUIRE, "agent");
            asm volatile("s_waitcnt vmcnt(0)" ::: "memory");
        }
    }
    __syncthreads();
}
namespace pg8 {
constexpr int BM = 256, BK = 64, HALF = 128, HTB = HALF * BK * 2  , STAGE_BYTES = 8 * HTB, NXCD = 8, WGM = 8;

__host__ __device__ __forceinline__ int lds_byte(int r, int c) { const int st = (r >> 4) * 2 + (c >> 5), rr = r & 15, cc = c & 31, ob = rr * 64 + cc * 2; return st * 1024 + (ob ^ (((ob >> 9) & 1) << 5)); }
__host__ __device__ __forceinline__ void stage_rc(int b, int& R, int& C) { const int st = b / 1024, sb = b % 1024, swz = sb ^ (((sb >> 9) & 1) << 5); R = (st >> 1) * 16 + swz / 64; C = (st & 1) * 32 + (swz % 64) / 2; }
__host__ __device__ __forceinline__ int perm32(int rho) { const int n = rho >> 4, i = rho & 15; return 8 * (i >> 2) + 4 * n + (i & 3); }

struct Unit { int pm, pn, hh; };
struct Gemm { const bf16_t* A; const bf16_t* Bt; int M, N, K; const int* aidx; };
__device__ __forceinline__ unsigned cvt_pk_bf16(float lo, float hi) { return pack_bf16(lo, hi); }
template <class Epi, class Sched, bool STAMP = false, bool ATILED = false, bool BTILED = false, bool AGATHER = false, bool HALFM = false>
__device__ __forceinline__ void gemm_phase(LAS unsigned char* lds, const Gemm g, const Sched& S, const Epi& E, unsigned long long* stamps) {
    const int tid = threadIdx.x, wid = __builtin_amdgcn_readfirstlane(tid >> 6), lane = tid & 63, wr = wid >> 2, wc = wid & 3, fr = lane & 15, fq = lane >> 4;
    const int K = g.K, nt = K / BK;
    int ts_lo = 0, ts_hi = 0, nts = 0; const unsigned long long rt_entry = STAMP ? (unsigned long long)wall_clock64() : 0ull;
#define PG8_STAMP() do { if (STAMP && wid == 0 && nts < 64) { const unsigned long long _c = (unsigned long long)clock64(); \
        ts_lo = (lane == nts) ? (int)(unsigned)_c : ts_lo; ts_hi = (lane == nts) ? (int)(unsigned)(_c >> 32) : ts_hi; ++nts; } } while (0)
    PG8_STAMP();
    unsigned voffA[2], voffB[2];
#pragma unroll
    for (int i = 0; i < 2; ++i) { int R, C; stage_rc(tid * 16 + i * 8192, R, C); const int Rb = Epi::PERM ? ((R & ~31) + perm32(R & 31)) : R;
        voffA[i] = (unsigned)(R * (ATILED ? BK : K) + C) * 2u; voffB[i] = (unsigned)(Rb * (BTILED ? BK : K) + C) * 2u; }
    const size_t kstepA = ATILED ? (size_t)BM * BK * 2 : (size_t)(BK * 2), kstepB = BTILED ? (size_t)BM * BK * 2 : (size_t)(BK * 2);
    const size_t hstepA = ATILED ? (size_t)HALF * BK * 2 : (size_t)HALF * K * 2, hstepB = BTILED ? (size_t)HALF * BK * 2 : (size_t)HALF * K * 2;
    const size_t tstep = (size_t)BM * K * 2;
    const unsigned ldsw = (unsigned)wid * 1024u;
    static_assert(!(AGATHER && ATILED), "a gathered operand is row-major");
    int gR0 = 0, gC0 = 0; { int R, C; stage_rc(tid * 16, R, C); gR0 = R; gC0 = C * 2; }
    unsigned vAc[4] = {0u, 0u, 0u, 0u};
    LAS int* gslot = (LAS int*)(lds + STAGE_BYTES + 8192 + 2048);
    const int aoff = lds_byte(wr * 64 + fr, fq * 8), boff = lds_byte(wc * 32 + fr, fq * 8);
#define PG8_SA(b, h) (((b) * 2 + (h)) * HTB)
#define PG8_SB(b, h) ((4 + (b) * 2 + (h)) * HTB)
#define PG8_STAGE(bufoff, gbase, voff) do { _Pragma("unroll") for (int _i = 0; _i < 2; ++_i) \
        __builtin_amdgcn_global_load_lds((const unsigned*)((const char*)(gbase) + (voff)[_i]), (LAS unsigned*)(lds + (bufoff) + ldsw + _i * 8192), 16, 0, 0); } while (0)
#define PG8_STAGE_A(bufoff, gbase, kbytes, h, vg) do { if constexpr (AGATHER) { _Pragma("unroll") for (int _i = 0; _i < 2; ++_i) \
        __builtin_amdgcn_global_load_lds((const unsigned*)((const char*)g.A + (kbytes) + (HALFM ? (hsrc ? (vg)[2 + _i] : (vg)[_i]) : (vg)[(h) * 2 + _i])), (LAS unsigned*)(lds + (bufoff) + ldsw + _i * 8192), 16, 0, 0); } \
        else PG8_STAGE(bufoff, (gbase) + (HALFM ? (size_t)hsrc * hstepA : (size_t)0), voffA); } while (0)
#define PG8_LDA(dst, b, h) do { _Pragma("unroll") for (int m = 0; m < 4; ++m) _Pragma("unroll") for (int k = 0; k < 2; ++k) dst[m][k] = *(const LAS bf16x8*)(lds + PG8_SA(b, h) + aoff + m * 2048 + k * 1024); } while (0)
#define PG8_LDB(dst, b, h) do { _Pragma("unroll") for (int n = 0; n < 2; ++n) _Pragma("unroll") for (int k = 0; k < 2; ++k) dst[n][k] = *(const LAS bf16x8*)(lds + PG8_SB(b, h) + boff + n * 2048 + k * 1024); } while (0)
#define PG8_MMA(ai, bj, At, Bt) do { __builtin_amdgcn_s_setprio(1); _Pragma("unroll") for (int m = 0; m < 4; ++m) _Pragma("unroll") for (int n = 0; n < 2; ++n) _Pragma("unroll") for (int k = 0; k < 2; ++k) \
        acc[ai][bj][m][n] = __builtin_amdgcn_mfma_f32_16x16x32_bf16(Bt[n][k], At[m][k], acc[ai][bj][m][n], 0, 0, 0); __builtin_amdgcn_s_setprio(0); } while (0)
#define PG8_WAIT_V(n) asm volatile("s_waitcnt vmcnt(" #n ")" ::: "memory")
#define PG8_WAIT_L(n) asm volatile("s_waitcnt lgkmcnt(" #n ")" ::: "memory")
#define PG8_BAR __builtin_amdgcn_s_barrier()
#define PG8_SCHED __builtin_amdgcn_sched_barrier(0)
    Unit cur, nxt; int ui = 0;
    if (!S.next(0, cur)) return;
    f32x4 acc[2][2][4][2];
#pragma unroll
    for (int a = 0; a < 2; ++a)
#pragma unroll
        for (int b = 0; b < 2; ++b)
#pragma unroll
            for (int m = 0; m < 4; ++m)
#pragma unroll
                for (int n = 0; n < 2; ++n) acc[a][b][m][n] = (f32x4){0.f, 0.f, 0.f, 0.f};
    bf16x8 At[4][2], B0[2][2], B1[2][2];
    const char* cA = (const char*)g.A + (size_t)cur.pm * tstep; const char* cB = (const char*)g.Bt + (size_t)cur.pn * tstep;
    S.a_ready(cur);
    if constexpr (AGATHER) {
#pragma unroll
        for (int j = 0; j < 4; ++j) vAc[j] = (unsigned)g.aidx[cur.pm * BM + gR0 + 64 * j] * (unsigned)(K * 2) + (unsigned)gC0;
    }
    int hsrc = HALFM ? cur.hh : 0;
    if constexpr (HALFM) {
        PG8_STAGE(PG8_SB(0, 0), cB, voffB); PG8_STAGE_A(PG8_SA(0, 0), cA, 0, 0, vAc); PG8_STAGE(PG8_SB(0, 1), cB + hstepB, voffB);
        if (wr == 1) PG8_BAR;
        PG8_WAIT_V(2); PG8_BAR;
    } else {
    PG8_STAGE(PG8_SB(0, 0), cB, voffB); PG8_STAGE_A(PG8_SA(0, 0), cA, 0, 0, vAc); PG8_STAGE(PG8_SB(0, 1), cB + hstepB, voffB); PG8_STAGE_A(PG8_SA(0, 1), cA + hstepA, 0, 1, vAc);
    if (wr == 1) PG8_BAR;
    PG8_WAIT_V(4); PG8_BAR;
    }
    PG8_STAGE(PG8_SB(1, 0), cB + kstepB, voffB); PG8_STAGE_A(PG8_SA(1, 0), cA + kstepA, BK * 2, 0, vAc); PG8_STAGE(PG8_SB(1, 1), cB + hstepB + kstepB, voffB);
    PG8_WAIT_V(6); PG8_BAR;
    PG8_STAMP();
    for (;;) {
        const bool has_next = S.next(ui + 1, nxt);
        const char* nA = has_next ? (const char*)g.A + (size_t)nxt.pm * tstep : cA; const char* nB = has_next ? (const char*)g.Bt + (size_t)nxt.pn * tstep : cB;
        E.pre(lds, ui & 1, cur, wid, lane);
        if constexpr (AGATHER) { if (has_next && wid == 0) __builtin_amdgcn_global_load_lds((const unsigned*)(g.aidx + nxt.pm * BM + lane * 4), (LAS unsigned*)(gslot + ((ui + 1) & 1) * 256), 16, 0, 0); }
        for (int t = 0; t < nt; t += 2) {
            const bool last = (t == nt - 2);
            const char* a1 = cA + (size_t)(t + 1) * kstepA;
            const char* a2 = last ? nA : cA + (size_t)(t + 2) * kstepA; const char* b2 = last ? nB : cB + (size_t)(t + 2) * kstepB;
            const char* a3 = a2 + kstepA; const char* b3 = b2 + kstepB;
            if (last && has_next) S.a_ready(nxt);
            const int kb2 = AGATHER ? (last ? 0 : (t + 2) * BK * 2) : 0;
            PG8_LDB(B0, 0, 0); PG8_SCHED; PG8_LDA(At, 0, 0); if constexpr (!HALFM) PG8_STAGE_A(PG8_SA(1, 1), a1 + hstepA, (t + 1) * BK * 2, 1, vAc);
            if constexpr (AGATHER) { if (last && has_next) {
#pragma unroll
                for (int j = 0; j < 4; ++j) vAc[j] = (unsigned)gslot[((ui + 1) & 1) * 256 + gR0 + 64 * j] * (unsigned)(K * 2) + (unsigned)gC0; } }
            PG8_WAIT_L(8); PG8_BAR; PG8_WAIT_L(0); PG8_MMA(0, 0, At, B0); PG8_BAR; PG8_SCHED;
            PG8_LDB(B1, 0, 1); PG8_STAGE(PG8_SB(0, 0), b2, voffB);
            PG8_BAR; PG8_WAIT_L(0); PG8_MMA(0, 1, At, B1); PG8_BAR;
            if constexpr (HALFM) { if (last && has_next) hsrc = nxt.hh; }
            if constexpr (!HALFM) PG8_LDA(At, 0, 1); PG8_STAGE_A(PG8_SA(0, 0), a2, kb2, 0, vAc);
            PG8_BAR; PG8_WAIT_L(0); if constexpr (!HALFM) PG8_MMA(1, 0, At, B0); PG8_BAR; PG8_SCHED;
            PG8_STAGE(PG8_SB(0, 1), b2 + hstepB, voffB);
            PG8_WAIT_V(6); PG8_BAR; if constexpr (!HALFM) PG8_MMA(1, 1, At, B1); PG8_BAR;
            PG8_LDB(B0, 1, 0); PG8_SCHED; PG8_LDA(At, 1, 0); if constexpr (!HALFM) PG8_STAGE_A(PG8_SA(0, 1), a2 + hstepA, kb2, 1, vAc);
            PG8_WAIT_L(8); PG8_BAR; PG8_WAIT_L(0); PG8_MMA(0, 0, At, B0); PG8_BAR; PG8_SCHED;
            PG8_LDB(B1, 1, 1); PG8_STAGE(PG8_SB(1, 0), b3, voffB);
            PG8_BAR; PG8_WAIT_L(0); PG8_MMA(0, 1, At, B1); PG8_BAR;
            if constexpr (!HALFM) PG8_LDA(At, 1, 1); PG8_STAGE_A(PG8_SA(1, 0), a3, kb2 + BK * 2, 0, vAc);
            PG8_BAR; PG8_WAIT_L(0); if constexpr (!HALFM) PG8_MMA(1, 0, At, B0); PG8_BAR; PG8_SCHED;
            PG8_STAGE(PG8_SB(1, 1), b3 + hstepB, voffB);
            PG8_WAIT_V(6); PG8_BAR; if constexpr (!HALFM) PG8_MMA(1, 1, At, B1); PG8_BAR;
        }
        PG8_STAMP();
        if constexpr (!Epi::AFTER_DRAIN) { E.template store<HALFM>(acc, cur, wr, wc, fr, fq, lds, ui & 1); S.done(cur); }
        PG8_STAMP();
        if (!has_next) break;
#pragma unroll
        for (int a = 0; a < 2; ++a)
#pragma unroll
            for (int b = 0; b < 2; ++b)
#pragma unroll
                for (int m = 0; m < 4; ++m)
#pragma unroll
                    for (int n = 0; n < 2; ++n) acc[a][b][m][n] = (f32x4){0.f, 0.f, 0.f, 0.f};
        cur = nxt; cA = nA; cB = nB; ++ui;

    }
    PG8_WAIT_V(0);
    if (wr == 0) PG8_BAR;
    PG8_BAR;
    if constexpr (Epi::AFTER_DRAIN) { E.fused(acc, cur, wr, wc, fr, fq, lds, wid, lane); S.done(cur); }
    PG8_STAMP();
    if (STAMP && wid == 0) { stamps[lane] = lane < nts ? (((unsigned long long)(unsigned)ts_hi << 32) | (unsigned)ts_lo) : 0ull;
        if (lane == 62) stamps[62] = rt_entry; if (lane == 63) stamps[63] = (unsigned long long)wall_clock64(); }
#undef PG8_STAMP
#undef PG8_SA
#undef PG8_SB
#undef PG8_STAGE
#undef PG8_STAGE_A
#undef PG8_LDA
#undef PG8_LDB
#undef PG8_MMA
#undef PG8_WAIT_V
#undef PG8_WAIT_L
#undef PG8_BAR
#undef PG8_SCHED
}
__device__ __forceinline__ int xcd_contig(long L, int nwg) { const int q = nwg / NXCD, r = nwg % NXCD, xcd = (int)(L % NXCD), off = (int)(L / NXCD); return (xcd < r ? xcd * (q + 1) : r * (q + 1) + (xcd - r) * q) + off; }
__device__ __forceinline__ bool tail_split(int nwg, int G, int& nlim) { const int full = (nwg / G) * G, tail = nwg - full; const bool sp = tail > 0 && 2 * tail <= G && (G & 15) == 0; nlim = sp ? full : nwg; return sp; }
template <int nN, int MODE = 0>
struct SchedDense {
    int nM, pm0, G, c;
    __device__ __forceinline__ bool next(int i, Unit& u) const {
        const int nwg = nM * nN; long L = (long)i * G + c; int hh = 0;
        if (MODE != 0) { int nlim; const bool sp = tail_split(nwg, G, nlim);
            if (MODE == 1) { if (L >= nlim) return false; }
            else { if (!sp || i != 0) return false; const int j = (c & 7) + 8 * (c >> 4); if (nlim + j >= nwg) return false; L = nlim + j; hh = (c >> 3) & 1; } }
        if (L >= nwg) return false;
        const int wgid = xcd_contig(L, nwg);
        constexpr int nig = WGM * nN; const int gid = wgid / nig, fm = gid * WGM, gsz = (nM - fm) < WGM ? (nM - fm) : WGM, w = wgid % nig;
        if (gsz == WGM) { u.pm = pm0 + fm + (w & (WGM - 1)); u.pn = w >> 3; } else { u.pm = pm0 + fm + (w % gsz); u.pn = w / gsz; }
        u.hh = hh;
        return true; }
    __device__ __forceinline__ void a_ready(const Unit&) const {}
    __device__ __forceinline__ void done(const Unit&) const {}
};
template <int nN, int MODE = 0>
struct SchedMoe {
    int T, G, c; const LAS int* tileE;
    __device__ __forceinline__ bool next(int i, Unit& u) const { const int nwg = T * nN; long L = (long)i * G + c; int hh = 0;
        if (MODE != 0) { int nlim; const bool sp = tail_split(nwg, G, nlim);
            if (MODE == 1) { if (L >= nlim) return false; }
            else { if (!sp || i != 0) return false; const int j = (c & 7) + 8 * (c >> 4); if (nlim + j >= nwg) return false; L = nlim + j; hh = (c >> 3) & 1; } }
        if (L >= nwg) return false;
        const int wgid = xcd_contig(L, nwg), pt = wgid / nN; u.pm = pt; u.pn = tileE[pt] * nN + (wgid % nN); u.hh = hh; return true; }
    __device__ __forceinline__ void a_ready(const Unit&) const {}
    __device__ __forceinline__ void done(const Unit&) const {}
};
constexpr int EPI_BIAS_OFF = STAGE_BYTES + 8192;
struct EpiStore {
    static constexpr bool PERM = true, AFTER_DRAIN = false;
    bf16_t* O; int ldc;
    __device__ __forceinline__ void pre(LAS unsigned char*, int, const Unit&, int, int) const {}
    template <bool HF> __device__ __forceinline__ void store(const f32x4 (&acc)[2][2][4][2], const Unit& u, int wr, int wc, int fr, int fq, const LAS unsigned char*, int) const {
        const int row0 = u.pm * BM + wr * 64 + fr + (HF ? u.hh * HALF : 0), col0 = u.pn * BM + wc * 32 + 8 * fq;
#pragma unroll
        for (int ai = 0; ai < (HF ? 1 : 2); ++ai)
#pragma unroll
            for (int m = 0; m < 4; ++m) { bf16_t* rowp = O + (size_t)(row0 + ai * HALF + m * 16) * ldc + col0;
#pragma unroll
                for (int bj = 0; bj < 2; ++bj) { const f32x4 v0 = acc[ai][bj][m][0], v1 = acc[ai][bj][m][1];
                    u32x4 w; w.x = cvt_pk_bf16(v0[0], v0[1]); w.y = cvt_pk_bf16(v0[2], v0[3]); w.z = cvt_pk_bf16(v1[0], v1[1]); w.w = cvt_pk_bf16(v1[2], v1[3]);
                    *(u32x4*)(rowp + bj * HALF) = w; } }
    }
};
struct EpiYE {
    static constexpr bool PERM = true, AFTER_DRAIN = false;
    bf16_t* O; const float* b2;
    __device__ __forceinline__ void pre(LAS unsigned char* lds, int par, const Unit& u, int wid, int lane) const {
        if (wid == 0) __builtin_amdgcn_global_load_lds((const unsigned*)(b2 + (u.pn >> 2) * 1024 + (u.pn & 3) * BM + lane * 4), (LAS unsigned*)(lds + EPI_BIAS_OFF + par * 1024), 16, 0, 0);
    }
    template <bool HF> __device__ __forceinline__ void store(const f32x4 (&acc)[2][2][4][2], const Unit& u, int wr, int wc, int fr, int fq, const LAS unsigned char* lds, int par) const {
        const int pn = u.pn & 3;
        const int row0 = u.pm * BM + wr * 64 + fr + (HF ? u.hh * HALF : 0), col0 = pn * BM + wc * 32 + 8 * fq;
        const LAS float* bp = (const LAS float*)(lds + EPI_BIAS_OFF + par * 1024) + wc * 32 + 8 * fq;
        f32x4 bv[2][2];
#pragma unroll
        for (int bj = 0; bj < 2; ++bj)
#pragma unroll
            for (int n = 0; n < 2; ++n) bv[bj][n] = *(const LAS f32x4*)(bp + bj * HALF + 4 * n);
#pragma unroll
        for (int ai = 0; ai < (HF ? 1 : 2); ++ai)
#pragma unroll
            for (int m = 0; m < 4; ++m) { bf16_t* rowp = O + (size_t)(row0 + ai * HALF + m * 16) * 1024 + col0;
#pragma unroll
                for (int bj = 0; bj < 2; ++bj) { const f32x4 v0 = acc[ai][bj][m][0] + bv[bj][0], v1 = acc[ai][bj][m][1] + bv[bj][1];
                    u32x4 w; w.x = cvt_pk_bf16(v0[0], v0[1]); w.y = cvt_pk_bf16(v0[2], v0[3]); w.z = cvt_pk_bf16(v1[0], v1[1]); w.w = cvt_pk_bf16(v1[2], v1[3]);
                    *(u32x4*)(rowp + bj * HALF) = w; } }
    }
};
struct EpiAct {
    static constexpr bool PERM = true, AFTER_DRAIN = false;
    bf16_t* O; const float* b1;
    __device__ __forceinline__ void pre(LAS unsigned char* lds, int par, const Unit& u, int wid, int lane) const {
        if (wid == 0) __builtin_amdgcn_global_load_lds((const unsigned*)(b1 + (u.pn >> 3) * 2048 + (lane >> 5) * 1024 + (u.pn & 7) * 128 + (lane & 31) * 4), (LAS unsigned*)(lds + EPI_BIAS_OFF + par * 1024), 16, 0, 0);
    }
    template <bool HF> __device__ __forceinline__ void store(const f32x4 (&acc)[2][2][4][2], const Unit& u, int wr, int wc, int fr, int fq, const LAS unsigned char* lds, int par) const {
        const int pn = u.pn & 7;
        const int row0 = u.pm * BM + wr * 64 + fr, x0 = pn * 128 + wc * 32 + 8 * fq, hro = HF ? u.hh * HALF : 0;
        const LAS float* bg = (const LAS float*)(lds + EPI_BIAS_OFF + par * 1024) + wc * 32 + 8 * fq; const LAS float* bl = bg + 128;
        const f32x4 g0 = *(const LAS f32x4*)bg, g1 = *(const LAS f32x4*)(bg + 4), l0 = *(const LAS f32x4*)bl, l1 = *(const LAS f32x4*)(bl + 4);
#pragma unroll
        for (int ai = 0; ai < (HF ? 1 : 2); ++ai)
#pragma unroll
            for (int m = 0; m < 4; ++m) {
                float o[8];
#pragma unroll
                for (int n = 0; n < 2; ++n)
#pragma unroll
                    for (int j = 0; j < 4; ++j) {
                        float glu = acc[ai][0][m][n][j] + (n ? g1[j] : g0[j]);
                        float lin = acc[ai][1][m][n][j] + (n ? l1[j] : l0[j]);
                        glu = fminf(glu, 7.0f); lin = fminf(fmaxf(lin, -7.0f), 7.0f);
                        o[n * 4 + j] = (lin + 1.0f) * glu * __builtin_amdgcn_rcpf(1.0f + __expf(-1.702f * glu));
                    }
                u32x4 w; w.x = cvt_pk_bf16(o[0], o[1]); w.y = cvt_pk_bf16(o[2], o[3]); w.z = cvt_pk_bf16(o[4], o[5]); w.w = cvt_pk_bf16(o[6], o[7]);
                *(u32x4*)(O + ((size_t)(u.pm * 16 + (x0 >> 6)) * 256 + (wr * 64 + fr + hro + ai * HALF + m * 16)) * 64 + (x0 & 63)) = w;
            }
    }
};
}
using pg8::Unit;
__device__ __forceinline__ void my_sincos(double a, float& s, float& c) {
    const double n = rint(a * 0.63661977236758134308);
    const double r = (a - n * 1.57079632679489655800e+00) - n * 6.12323399573676603587e-17;
    const double r2 = r * r;
    const double sp = r * (1.0 + r2 * (-1.0 / 6.0 + r2 * (1.0 / 120.0 + r2 * (-1.0 / 5040.0 + r2 * (1.0 / 362880.0 + r2 * (-1.0 / 39916800.0 + r2 * (1.0 / 6227020800.0 + r2 * (-1.0 / 1307674368000.0))))))));
    const double cp = 1.0 + r2 * (-0.5 + r2 * (1.0 / 24.0 + r2 * (-1.0 / 720.0 + r2 * (1.0 / 40320.0 + r2 * (-1.0 / 3628800.0 + r2 * (1.0 / 479001600.0 + r2 * (-1.0 / 87178291200.0 + r2 * (1.0 / 20922789888000.0))))))));
    const int q = ((int)n) & 3;
    const double sn = q == 0 ? sp : q == 1 ? cp : q == 2 ? -sp : -cp;
    const double cn = q == 0 ? cp : q == 1 ? -sp : q == 2 ? -cp : sp;
    s = (float)sn; c = (float)cn;
}
__device__ __forceinline__ void ph_prologue(const Params& p, LAS unsigned char* lds, int bid, int nblk) {
    const int tid = threadIdx.x;
    unsigned char* ws = p.ws;
    {
        LAS float* sv = (LAS float*)(lds + LDS_WORK);
        LAS float* red = sv + 5 * 1024;
        for (int i = tid; i < 5 * 1024; i += NTHR) { const int r = i >> 10, k = i & 1023; const float c = r < 4 ? p.in[I_C][r * 1024 + k] : p.in[I_CCTX][k]; sv[i] = c / (1.0f + expf(-c)); }
        __syncthreads();
        float* MOD = (float*)(ws + WS_MOD);
        for (int item = bid; item < 256; item += nblk) {
            if (tid < 480) {
                const int cl = tid % 48, kp = tid / 48;
                const int gc = item * 48 + cl, l = gc / 6144, n = gc % 6144;
                const float* w = p.in[I_WMOD] + (size_t)l * 1024 * 6144 + n;
                float a0 = 0.f, a1 = 0.f, a2 = 0.f, a3 = 0.f, a4 = 0.f;
#pragma unroll 1
                for (int k0 = kp; k0 < 1024; k0 += 130) {
                    float wv[13];
#pragma unroll
                    for (int u = 0; u < 13; ++u) { const int k = k0 + 10 * u; wv[u] = k < 1024 ? w[(size_t)k * 6144] : 0.f; }
#pragma unroll
                    for (int u = 0; u < 13; ++u) { const int k = k0 + 10 * u < 1024 ? k0 + 10 * u : 1023; a0 += sv[k] * wv[u]; a1 += sv[1024 + k] * wv[u]; a2 += sv[2048 + k] * wv[u]; a3 += sv[3072 + k] * wv[u]; a4 += sv[4096 + k] * wv[u]; }
                }
                LAS float* rp = red + (kp * 48 + cl) * 5; rp[0] = a0; rp[1] = a1; rp[2] = a2; rp[3] = a3; rp[4] = a4;
            }
            __syncthreads();
            if (tid < 240) {
                const int cl = tid / 5, r = tid % 5; float s = 0.f;
                for (int kp = 0; kp < 10; ++kp) s += red[(kp * 48 + cl) * 5 + r];
                const int gc = item * 48 + cl, l = gc / 6144, n = gc % 6144;
                MOD[(size_t)(l * 5 + r) * 6144 + n] = s + p.in[I_BMOD][l * 6144 + n];
            }
            __syncthreads();
        }
    }
    if (bid == (nblk > 1 ? 1 : 0)) {
        float* ROPE = (float*)(ws + WS_ROPE);
        for (int i = tid; i < 2048; i += NTHR) { const int pos = i >> 5, f = i & 31; const double inv = exp(-(double)f * 0.28782313662425575); float s, c; my_sincos((double)pos * inv, s, c); ROPE[2 * i] = c; ROPE[2 * i + 1] = s; }
    }
    {
        bf16_t* WLT = (bf16_t*)(ws + WS_WLT);
        for (int i = bid * NTHR + tid; i < (int)WLT_N; i += nblk * NTHR) {
            float v;
            if (i < 131072) { const int which = i >> 16, r = i & 65535, d = r >> 15, n = (r >> 6) & 511, k = r & 63; v = (which ? p.in[I_AAB] : p.in[I_AWB])[(size_t)(d * 64 + k) * 512 + n]; }
            else if (i < 196608) { const int r = i - 131072, n = r >> 7, k = r & 127; v = p.in[I_AGB][(size_t)k * 512 + n]; }
            else { const int r = i - 196608, blk = r >> 12, o = (r >> 6) & 63, ii = r & 63; v = p.in[I_BGW][(size_t)blk * 4096 + ii * 64 + o]; }
            WLT[i] = f2bf(v);
        }
    }
    {
        LAS float* tile = (LAS float*)(lds + LDS_WORK);
        for (int t = bid; t < 576; t += nblk) {
            const float* src; int ld, nvalid, k0, n0, w1map = 0; bf16_t* dst; int tt = t;
            if (tt < 192) { k0 = (tt / 12) * 64; n0 = (tt % 12) * 256; src = p.in[I_EWIN]; ld = EVEN_IN; nvalid = EVEN_IN; dst = (bf16_t*)(ws + WS_WIN0T); }
            else if ((tt -= 192) < 256) { k0 = (tt >> 4) * 64; n0 = (tt & 15) * 256; src = p.in[I_OWIN]; ld = ODD_IN; nvalid = 4096; dst = (bf16_t*)(ws + WS_WIN1T); }
            else { tt -= 256; const int mat = tt >> 6, r = tt & 63; k0 = (r >> 2) * 64; n0 = (r & 3) * 256; src = mat ? p.in[I_OWOUT] : p.in[I_EWOUT]; ld = 1024; nvalid = 1024; dst = (bf16_t*)(ws + WS_WOUTT) + (size_t)mat * 1024 * 1024; }
            {
                const int j4 = (tid & 63) * 4, i0 = tid >> 6;
                f32x4 v[8];
#pragma unroll
                for (int r = 0; r < 8; ++r) v[r] = (n0 + j4 < nvalid) ? *(const f32x4*)(src + (size_t)(k0 + i0 + 8 * r) * ld + n0 + j4) : (f32x4){0.f, 0.f, 0.f, 0.f};
#pragma unroll
                for (int r = 0; r < 8; ++r) { LAS float* tp = tile + (i0 + 8 * r) * 257 + j4; tp[0] = v[r][0]; tp[1] = v[r][1]; tp[2] = v[r][2]; tp[3] = v[r][3]; }
            }
            __syncthreads();
            {
                const int ip = (tid & 31) * 2, j0 = tid >> 5;
#pragma unroll
                for (int r = 0; r < 16; ++r) {
                    const int j = j0 + 16 * r, n = n0 + j;
                    const int rho = w1map ? ((((n & 1023) >> 7) << 8) + ((n >> 10) << 7) + (n & 127)) : n;
                    *(unsigned*)(dst + (size_t)rho * 1024 + k0 + ip) = pack_bf16(tile[ip * 257 + j], tile[(ip + 1) * 257 + j]);
                }
            }
            __syncthreads();
        }
    }
}
__device__ __forceinline__ void ph_mod_in(const Params& p, int bid, int nblk) {
    const int tid = threadIdx.x, wid = tid >> 6, lane = tid & 63;
    const float* MOD = (const float*)(p.ws + WS_MOD);
    bf16_t* H = (bf16_t*)(p.ws + WS_H);
    for (int row = bid * 8 + wid; row < MROWS; row += nblk * 8) {
        const float* src = row < NCTX ? p.in[I_CTX] + (size_t)row * 1024 : p.in[I_X] + (size_t)(row - NCTX) * 1024;
        const float* md = MOD + (size_t)row_modr(row) * 6144;
#pragma unroll
        for (int q = 0; q < 4; ++q) {
            const int col = q * 256 + lane * 4;
            const f32x4 x = *(const f32x4*)(src + col), sh = *(const f32x4*)(md + col), sc = *(const f32x4*)(md + 1024 + col);
            const f32x4 h = x * (sc + 1.0f) + sh;
            u32x2 w; w.x = pack_bf16(h[0], h[1]); w.y = pack_bf16(h[2], h[3]);
            *(u32x2*)(H + (size_t)row * 1024 + col) = w;
        }
    }
}
__device__ __forceinline__ int even_tok_row(int w, int idx) { return idx < 64 ? NCTX + (w >> 6) * 4096 + (w & 63) * 64 + idx : w * 4 + (idx - 64); }
__device__ __forceinline__ int shift_nb(int row, int cc) {
    if (row >= NCTX) { const int s = (row - NCTX) & 4095, gr = s >> 6, gc = s & 63, slot = cc & 3;
        if (slot == 0) return gc > 0 ? row - 1 : -1;
        if (slot == 1) return gc < 63 ? row + 1 : -1;
        if (slot == 2) return gr > 0 ? row - 64 : -1;
        return gr < 63 ? row + 64 : -1; }
    const int t = row & 255; return (cc & 1) == 0 ? (t > 0 ? row - 1 : -1) : (t < 255 ? row + 1 : -1);
}
__device__ __forceinline__ float shifted_z(const bf16_t* P, const float* mu, int row, int cc) {
    const float pv = bf2f(P[(size_t)row * LDP0 + cc]); const int nb = shift_nb(row, cc);
    const float sv = nb >= 0 ? bf2f(P[(size_t)nb * LDP0 + cc]) : 0.f;
    return pv + (sv - pv) * mu[cc];
}
__device__ __forceinline__ int scan_q(int row, int d) {
    if (row < NCTX) { const int t = row & 255; return d ? 255 - t : t; }
    const int s = (row - NCTX) & 4095; return 256 + (d ? 4095 - s : s);
}
__device__ __forceinline__ bf16_t* sc_rec(float* SC, int d, int row, int h) { return (bf16_t*)SC + ((size_t)((d * 4 + row_batch(row)) * 8 + h) * SCLEN + scan_q(row, d)) * SCREC; }
constexpr int LDL = 392, LDU = 520;
template <int KS>
__device__ __forceinline__ void load_b(const bf16_t* Bt, bf16x8 (&b)[4][KS], int lane) {
    const int fr = lane & 15, fq = lane >> 4;
#pragma unroll
    for (int nt = 0; nt < 4; ++nt)
#pragma unroll
        for (int ks = 0; ks < KS; ++ks) b[nt][ks] = *(const bf16x8*)(Bt + (size_t)(nt * 16 + fr) * (32 * KS) + ks * 32 + fq * 8);
}
template <int KS>
__device__ __forceinline__ void mma_mt(const LAS bf16_t* A, int lda, int mt, const bf16x8 (&b)[4][KS], f32x4 (&acc)[4], int lane) {
    const int fr = lane & 15, fq = lane >> 4;
#pragma unroll
    for (int nt = 0; nt < 4; ++nt) acc[nt] = (f32x4){0.f, 0.f, 0.f, 0.f};
#pragma unroll
    for (int ks = 0; ks < KS; ++ks) {
        const bf16x8 a = *(const LAS bf16x8*)(A + (mt * 16 + fr) * lda + ks * 32 + fq * 8);
#pragma unroll
        for (int nt = 0; nt < 4; ++nt) acc[nt] = __builtin_amdgcn_mfma_f32_16x16x32_bf16(a, b[nt][ks], acc[nt], 0, 0, 0);
    }
}
__device__ __forceinline__ void ph_prep_even(const Params& p, LAS unsigned char* lds, int bid, int nblk) {
    const bf16_t* P = (const bf16_t*)(p.ws + WS_P);
    float* SC = (float*)(p.ws + WS_SC);
    float* EA = (float*)(p.ws + WS_EARR);
#define EARR(k) (EA + (size_t)(k) * ((size_t)MROWS * 512))
    float* BC = (float*)(p.ws + WS_BC);
    float* CHA = (float*)(p.ws + WS_CHA); float* CHH = (float*)(p.ws + WS_CHH);
    const bf16_t* WLT = (const bf16_t*)(p.ws + WS_WLT);
    const float* mu = p.in[I_AMU];
    LAS bf16_t* linb = (LAS bf16_t*)(lds + LDS_WORK);
    LAS bf16_t* ub = linb + 80 * LDL;
    LAS float* rnorm = (LAS float*)(ub + 80 * LDU);
    for (int w = bid; w < 256; w += nblk) {
        int tid_ = threadIdx.x; asm volatile("" : "+v"(tid_));
        const int tid = tid_, wid = tid >> 6, lane = tid & 63, fr = lane & 15, fq = lane >> 4;
        for (int i = tid; i < 12 * LDL; i += NTHR) linb[68 * LDL + i] = 0;
        for (int i = tid; i < 12 * LDU; i += NTHR) ub[68 * LDU + i] = 0;
        if (lane < 48) {
            float mul8[8];
#pragma unroll
            for (int i = 0; i < 8; ++i) mul8[i] = mu[1536 + lane * 8 + i];
#pragma unroll 1
            for (int tok = wid; tok < 68; tok += 8) {
                const int row = even_tok_row(w, tok);
                const u32x4 ps = *(const u32x4*)(P + (size_t)row * LDP0 + 1536 + lane * 8);
                u32x4 pn[4];
#pragma unroll
                for (int sl = 0; sl < 4; ++sl) { const int nb = shift_nb(row, sl); pn[sl] = nb >= 0 ? *(const u32x4*)(P + (size_t)nb * LDP0 + 1536 + lane * 8) : (u32x4){0u, 0u, 0u, 0u}; }
                float z[8];
#pragma unroll
                for (int i = 0; i < 8; ++i) { const unsigned wp = ps[i >> 1], wn = pn[i & 3][i >> 1];
                    const float pv = __uint_as_float((i & 1) ? (wp & 0xffff0000u) : (wp << 16)), sv = __uint_as_float((i & 1) ? (wn & 0xffff0000u) : (wn << 16));
                    const float zz = pv + (sv - pv) * mul8[i];
                    z[i] = lane < 16 ? ftanh(zz) : (lane < 32 ? zz : sigm(zz)); }
                u32x4 q;
#pragma unroll
                for (int i = 0; i < 4; ++i) q[i] = pack_bf16(z[2 * i], z[2 * i + 1]);
                *(LAS u32x4*)(linb + tok * LDL + lane * 8) = q;
            }
        }
        {
            float murv[8], mukv8[8], muvv[8], kkc8[8];
#pragma unroll
            for (int i = 0; i < 8; ++i) { murv[i] = mu[lane * 8 + i]; mukv8[i] = mu[512 + lane * 8 + i]; muvv[i] = mu[1024 + lane * 8 + i]; kkc8[i] = p.in[I_AKK][lane * 8 + i]; }
#pragma unroll 1
            for (int tok = wid; tok < 68; tok += 8) {
                const int row = even_tok_row(w, tok);
                int nbr[4];
#pragma unroll
                for (int sl = 0; sl < 4; ++sl) nbr[sl] = shift_nb(row, sl);
                u32x4 ps[3], pn[3][4];
#pragma unroll
                for (int a = 0; a < 3; ++a) { ps[a] = *(const u32x4*)(P + (size_t)row * LDP0 + a * 512 + lane * 8);
#pragma unroll
                    for (int sl = 0; sl < 4; ++sl) pn[a][sl] = nbr[sl] >= 0 ? *(const u32x4*)(P + (size_t)nbr[sl] * LDP0 + a * 512 + lane * 8) : (u32x4){0u, 0u, 0u, 0u}; }
                float z[3][8];
#pragma unroll
                for (int a = 0; a < 3; ++a)
#pragma unroll
                    for (int i = 0; i < 8; ++i) { const unsigned wp = ps[a][i >> 1], wn = pn[a][i & 3][i >> 1];
                        const float pv = __uint_as_float((i & 1) ? (wp & 0xffff0000u) : (wp << 16)), sv = __uint_as_float((i & 1) ? (wn & 0xffff0000u) : (wn << 16));
                        z[a][i] = pv + (sv - pv) * (a == 0 ? murv[i] : (a == 1 ? mukv8[i] : muvv[i])); }
                float kkr[8], ss = 0.f;
#pragma unroll
                for (int i = 0; i < 8; ++i) { kkr[i] = z[1][i] * kkc8[i]; ss += kkr[i] * kkr[i]; }
                ss += __int_as_float(__builtin_amdgcn_update_dpp(0, __float_as_int(ss), 0xb1, 0xf, 0xf, false));
                ss += __int_as_float(__builtin_amdgcn_update_dpp(0, __float_as_int(ss), 0x4e, 0xf, 0xf, false));
                ss += __int_as_float(__builtin_amdgcn_update_dpp(0, __float_as_int(ss), 0x141, 0xf, 0xf, false));
                const float rn = frcp(fmaxf(fsqrt(ss), 1e-12f));
                if ((lane & 7) == 0) rnorm[tok * 8 + (lane >> 3)] = rn;
                u32x4 qk, qr, qv;
#pragma unroll
                for (int i = 0; i < 4; ++i) { qk[i] = pack_bf16(kkr[2 * i] * rn, kkr[2 * i + 1] * rn); qr[i] = pack_bf16(z[0][2 * i], z[0][2 * i + 1]); qv[i] = pack_bf16(z[2][2 * i], z[2][2 * i + 1]); }
#pragma unroll
                for (int d = 0; d < 2; ++d) { bf16_t* rec = sc_rec(SC, d, row, lane >> 3) + (lane & 7) * 8; *(u32x4*)(rec + 128) = qk; *(u32x4*)(rec + 320) = qr; *(u32x4*)(rec + 384) = qv; }
            }
        }
        {
            float cw[4][8], cb8[8];
#pragma unroll
            for (int i = 0; i < 8; ++i) { cb8[i] = p.in[I_BCB][lane * 8 + i];
#pragma unroll
                for (int k = 0; k < 4; ++k) cw[k][i] = p.in[I_BCW][k * 512 + lane * 8 + i]; }
#pragma unroll 1
            for (int tok = wid; tok < 68; tok += 8) {
                const int row = even_tok_row(w, tok);
                int pos, len;
                if (row >= NCTX) { pos = (row - NCTX) & 4095; len = 4096; } else { pos = row & 255; len = 256; }
                const u32x4 zero4 = {0u, 0u, 0u, 0u};
                const bf16_t* px = P + (size_t)row * LDP0 + 1920 + lane * 8;
                u32x4 xv[4];
                xv[0] = pos >= 2 ? *(const u32x4*)(px - 2 * (size_t)LDP0) : zero4; xv[1] = pos >= 1 ? *(const u32x4*)(px - (size_t)LDP0) : zero4;
                xv[2] = *(const u32x4*)px; xv[3] = pos + 1 < len ? *(const u32x4*)(px + (size_t)LDP0) : zero4;
                const u32x4 gxv = *(const u32x4*)(px + 512);
                float uu[8], gg[8];
#pragma unroll
                for (int i = 0; i < 8; ++i) { float a = cb8[i];
#pragma unroll
                    for (int k = 0; k < 4; ++k) { const unsigned wv = xv[k][i >> 1]; a += cw[k][i] * __uint_as_float((i & 1) ? (wv & 0xffff0000u) : (wv << 16)); }
                    uu[i] = a;
                    const unsigned wg = gxv[i >> 1]; const float gx = __uint_as_float((i & 1) ? (wg & 0xffff0000u) : (wg << 16));
                    gg[i] = 0.5f * gx * (1.0f + ftanh(0.7978845608028654f * (gx + 0.044715f * gx * gx * gx))); }
                u32x4 qu, qg;
#pragma unroll
                for (int i = 0; i < 4; ++i) { qu[i] = pack_bf16(uu[2 * i], uu[2 * i + 1]); qg[i] = pack_bf16(gg[2 * i], gg[2 * i + 1]); }
                *(LAS u32x4*)(ub + tok * LDU + lane * 8) = qu;
                *(u32x4*)((bf16_t*)EARR(E_GATE) + (size_t)row * 512 + lane * 8) = qg;
            }
        }
        __syncthreads();
#pragma unroll 1
        for (int d = 0; d < 2; ++d) {
            {
                bf16x8 bw[4][2]; load_b<2>(WLT + WLT_WB + (size_t)(d * 512 + wid * 64) * 64, bw, lane);
                float w0v[4];
#pragma unroll
                for (int nt = 0; nt < 4; ++nt) w0v[nt] = p.in[I_AW0][d * 512 + wid * 64 + nt * 16 + fr];
#pragma unroll 1
                for (int mt = 0; mt < 5; ++mt) {
                    f32x4 acc[4]; mma_mt<2>(linb + d * 64, LDL, mt, bw, acc, lane);
#pragma unroll
                    for (int r = 0; r < 4; ++r) { const int tok = mt * 16 + fq * 4 + r;
                        if (tok < 68) { float* rec = (float*)sc_rec(SC, d, even_tok_row(w, tok), wid) + fr;
#pragma unroll
                            for (int nt = 0; nt < 4; ++nt) rec[nt * 16] = -0.60653065971263342f * sigm(w0v[nt] + acc[nt][r]);   } }
                }
            }
            {
                bf16x8 bw[4][2]; load_b<2>(WLT + WLT_AB + (size_t)(d * 512 + wid * 64) * 64, bw, lane);
                float a0v[4], kav[4], mukv[4], kkcv[4];
#pragma unroll
                for (int nt = 0; nt < 4; ++nt) { const int n = wid * 64 + nt * 16 + fr; a0v[nt] = p.in[I_AA0][d * 512 + n]; kav[nt] = p.in[I_AKA][n]; mukv[nt] = mu[512 + n]; kkcv[nt] = p.in[I_AKK][n]; }
                unsigned short pkc[4][4], skc[4][4], pkn[4][4], skn[4][4];
                auto kload = [&](int mt, unsigned short (&pk)[4][4], unsigned short (&sk)[4][4]) __attribute__((always_inline)) {
#pragma unroll
                    for (int r = 0; r < 4; ++r) { const int tok = mt * 16 + fq * 4 + r, row = even_tok_row(w, tok < 68 ? tok : 0);
#pragma unroll
                        for (int nt = 0; nt < 4; ++nt) { const int n = wid * 64 + nt * 16 + fr, nb = shift_nb(row, n);
                            pk[r][nt] = P[(size_t)row * LDP0 + 512 + n]; sk[r][nt] = P[(size_t)(nb >= 0 ? nb : row) * LDP0 + 512 + n]; } } };
                kload(0, pkc, skc);
#pragma unroll 1
                for (int mt = 0; mt < 5; ++mt) {
                    kload(mt < 4 ? mt + 1 : 4, pkn, skn);
                    f32x4 acc[4]; mma_mt<2>(linb + 128 + d * 64, LDL, mt, bw, acc, lane);
#pragma unroll
                    for (int r = 0; r < 4; ++r) { const int tok = mt * 16 + fq * 4 + r;
                        if (tok < 68) { const int row = even_tok_row(w, tok); bf16_t* rec = sc_rec(SC, d, row, wid) + fr; const float rn = rnorm[tok * 8 + wid];
#pragma unroll
                            for (int nt = 0; nt < 4; ++nt) { const float a = sigm(a0v[nt] + acc[nt][r]);
                                const float pv = bf2f(pkc[r][nt]), sv = shift_nb(row, wid * 64 + nt * 16 + fr) >= 0 ? bf2f(skc[r][nt]) : 0.f;
                                const float zk = pv + (sv - pv) * mukv[nt];
                                rec[192 + nt * 16] = f2bf(zk * (1.0f + (a - 1.0f) * kav[nt])); rec[256 + nt * 16] = f2bf(zk * kkcv[nt] * rn * a); } } }
#pragma unroll
                    for (int r = 0; r < 4; ++r)
#pragma unroll
                        for (int nt = 0; nt < 4; ++nt) { pkc[r][nt] = pkn[r][nt]; skc[r][nt] = skn[r][nt]; }
                }
            }
        }
        {
            bf16x8 bw[4][4]; load_b<4>(WLT + WLT_GB + (size_t)(wid * 64) * 128, bw, lane);
            bf16_t* G = (bf16_t*)EARR(E_G);
#pragma unroll 1
            for (int mt = 0; mt < 5; ++mt) {
                f32x4 acc[4]; mma_mt<4>(linb + 256, LDL, mt, bw, acc, lane);
#pragma unroll
                for (int r = 0; r < 4; ++r) { const int tok = mt * 16 + fq * 4 + r;
                    if (tok < 68) { bf16_t* gp = G + (size_t)even_tok_row(w, tok) * 512 + wid * 64 + fr;
#pragma unroll
                        for (int nt = 0; nt < 4; ++nt) gp[nt * 16] = f2bf(acc[nt][r]); } }
            }
        }
        __syncthreads();
        LAS float* T = (LAS float*)linb + wid * (16 * 68);
#pragma unroll 1
        for (int d = 0; d < 2; ++d) {
            bf16x8 b0[4][2];
            load_b<2>(WLT + WLT_GW + (size_t)(((d * 2 + 0) * 8 + wid) * 64) * 64, b0, lane);
            bf16x8 b1[4][2]; load_b<2>(WLT + WLT_GW + (size_t)(((d * 2 + 1) * 8 + wid) * 64) * 64, b1, lane);
            float gb0[4], gb1[4], spl[4];
#pragma unroll
            for (int nt = 0; nt < 4; ++nt) { const int n = wid * 64 + nt * 16 + fr; gb0[nt] = p.in[I_BGB][(d * 2 + 0) * 512 + n]; gb1[nt] = p.in[I_BGB][(d * 2 + 1) * 512 + n]; spl[nt] = softplusf(-p.in[I_BLAM][d * 512 + n]); }
            bf16_t* Ad = (bf16_t*)EARR(E_A0 + d); bf16_t* BXd = (bf16_t*)EARR(E_BX0 + d);
            float Cc[4], Hc[4];
#pragma unroll
            for (int nt = 0; nt < 4; ++nt) { Cc[nt] = 1.f; Hc[nt] = 0.f; }
#pragma unroll 1
            for (int it = 0; it < 5; ++it) {
                const int mt = it < 4 ? (d ? 3 - it : it) : 4;
                f32x4 la[4], acc[4];
                mma_mt<2>(ub + wid * 64, LDU, mt, b0, la, lane);
                mma_mt<2>(ub + wid * 64, LDU, mt, b1, acc, lane);
                if (it == 4) {
#pragma unroll
                    for (int nt = 0; nt < 4; ++nt) { Cc[nt] = 1.f; Hc[nt] = 0.f; } }
                float hout[4][4];
#pragma unroll
                for (int nt = 0; nt < 4; ++nt) {
                    float av[4], bx[4], lc[4], lh[4];
#pragma unroll
                    for (int r = 0; r < 4; ++r) { const int tok = mt * 16 + fq * 4 + r; const float lg = -8.0f * sigm(gb0[nt] + la[nt][r]) * spl[nt];
                        av[r] = fexp(lg); bx[r] = fsqrt(fmaxf(1.0f - av[r] * av[r], 0.f)) * sigm(gb1[nt] + acc[nt][r]) * bf2f(ub[tok * LDU + wid * 64 + nt * 16 + fr]);     }
                    float c = 1.f, hh = 0.f;
#pragma unroll
                    for (int i = 0; i < 4; ++i) { const int r = d ? 3 - i : i; hh = av[r] * hh + bx[r]; c *= av[r]; lc[r] = c; lh[r] = hh; }
                    float Ae = 1.f, Be = 0.f, At = 1.f, Bt = 0.f;
                    if (it < 4) {
#pragma unroll
                        for (int j = 0; j < 4; ++j) { const int g = d ? 3 - j : j; const float Ag = __shfl(c, fr + 16 * g, 64), Bg = __shfl(hh, fr + 16 * g, 64);
                            const bool before = d ? (g > fq) : (g < fq);
                            Be = before ? Ag * Be + Bg : Be; Ae = before ? Ae * Ag : Ae;
                            Bt = Ag * Bt + Bg; At = At * Ag; }
                    } else { At = __shfl(c, fr, 64); Bt = __shfl(hh, fr, 64); }
                    const float Hin = Ae * Hc[nt] + Be, Cin = Cc[nt] * Ae;
#pragma unroll
                    for (int r = 0; r < 4; ++r) { T[(fq * 4 + r) * 68 + nt * 16 + fr] = Cin * lc[r]; hout[nt][r] = lh[r] + lc[r] * Hin; }
                    Hc[nt] = At * Hc[nt] + Bt; Cc[nt] = Cc[nt] * At;
                }
#pragma unroll
                for (int q = 0; q < 4; ++q) { const int tl = q * 4 + fq, tok = mt * 16 + tl;
                    const f32x4 v = *(const LAS f32x4*)(T + tl * 68 + fr * 4);
                    if (tok < 68) { u32x2 q2; q2.x = pack_bf16(v[0], v[1]); q2.y = pack_bf16(v[2], v[3]); *(u32x2*)(Ad + (size_t)even_tok_row(w, tok) * 512 + wid * 64 + fr * 4) = q2; } }
#pragma unroll
                for (int nt = 0; nt < 4; ++nt)
#pragma unroll
                    for (int r = 0; r < 4; ++r) T[(fq * 4 + r) * 68 + nt * 16 + fr] = hout[nt][r];
#pragma unroll
                for (int q = 0; q < 4; ++q) { const int tl = q * 4 + fq, tok = mt * 16 + tl;
                    const f32x4 v = *(const LAS f32x4*)(T + tl * 68 + fr * 4);
                    if (tok < 68) { u32x2 q2; q2.x = pack_bf16(v[0], v[1]); q2.y = pack_bf16(v[2], v[3]); *(u32x2*)(BXd + (size_t)even_tok_row(w, tok) * 512 + wid * 64 + fr * 4) = q2; } }
                if (it >= 3 && fq == 0) {
                    const int cid = (w >> 6) * 128 + (it == 3 ? 64 : 0) + (w & 63);
#pragma unroll
                    for (int nt = 0; nt < 4; ++nt) { CHA[(size_t)(d * 512 + cid) * 512 + wid * 64 + nt * 16 + fr] = Cc[nt]; CHH[(size_t)(d * 512 + cid) * 512 + wid * 64 + nt * 16 + fr] = Hc[nt]; } }
            }
        }
        __syncthreads();
        {
            float rk8[8];
#pragma unroll
            for (int i = 0; i < 8; ++i) rk8[i] = p.in[I_ARK][lane * 8 + i];
#pragma unroll 1
            for (int tok = wid; tok < 68; tok += 8) {
                const int row = even_tok_row(w, tok);
                const bf16_t* r0 = sc_rec(SC, 0, row, lane >> 3) + (lane & 7) * 8; const bf16_t* r1 = sc_rec(SC, 1, row, lane >> 3) + (lane & 7) * 8;
                const u32x4 qr = *(const u32x4*)(r0 + 320), q0 = *(const u32x4*)(r0 + 192), q1 = *(const u32x4*)(r1 + 192);
                float sm = 0.f;
#pragma unroll
                for (int i = 0; i < 8; ++i) { const unsigned a = qr[i >> 1], b0 = q0[i >> 1], b1 = q1[i >> 1];
                    const float av = __uint_as_float((i & 1) ? (a & 0xffff0000u) : (a << 16)), b0v = __uint_as_float((i & 1) ? (b0 & 0xffff0000u) : (b0 << 16)), b1v = __uint_as_float((i & 1) ? (b1 & 0xffff0000u) : (b1 << 16));
                    sm += av * (b0v + b1v) * rk8[i]; }
                sm += __int_as_float(__builtin_amdgcn_update_dpp(0, __float_as_int(sm), 0xb1, 0xf, 0xf, false));
                sm += __int_as_float(__builtin_amdgcn_update_dpp(0, __float_as_int(sm), 0x4e, 0xf, 0xf, false));
                sm += __int_as_float(__builtin_amdgcn_update_dpp(0, __float_as_int(sm), 0x141, 0xf, 0xf, false));
                if ((lane & 7) == 0) BC[row * 8 + (lane >> 3)] = sm;
            }
        }
        __syncthreads();
    }
}
__device__ __forceinline__ float vfma(float a, float b, float c) { float d; asm("v_fma_f32 %0, %1, %2, %3" : "=v"(d) : "v"(a), "v"(b), "v"(c)); return d; }
__device__ __forceinline__ float vmul(float a, float b) { float d; asm("v_mul_f32 %0, %1, %2" : "=v"(d) : "v"(a), "v"(b)); return d; }
#define WG_BAR() do { asm volatile("" ::: "memory"); __builtin_amdgcn_s_barrier(); asm volatile("" ::: "memory"); } while (0)
__device__ __forceinline__ int scan_row(int d, int b, int q) {
    if (q < 256) return b * 256 + (d ? 255 - q : q);
    const int s = q - 256; return NCTX + b * 4096 + (d ? 4095 - s : s);
}
__device__ __forceinline__ void ph_fin_even(const Params& p, int bid, int nblk) {
    const int tid = threadIdx.x, wid = tid >> 6, c = tid;
    float* EA = (float*)(p.ws + WS_EARR);
    float* SC = (float*)(p.ws + WS_SC);
    const float* BC = (const float*)(p.ws + WS_BC); const float* CIN = (const float*)(p.ws + WS_CIN);
    bf16_t* Y = (bf16_t*)(p.ws + WS_YMIX);
    const float gg = p.in[I_AGNG][c], gb = p.in[I_AGNB][c];
    for (int r0 = bid * 4; r0 < MROWS; r0 += nblk * 4) {
        float o0[4], o1[4], vv[4], gv[4], bc[4], x0[4], x1[4], a0[4], a1[4], c0[4], c1[4], gt[4];
#pragma unroll
        for (int u = 0; u < 4; ++u) { const int row = r0 + u; const size_t o = (size_t)row * 512 + c;
            const int cid = row < NCTX ? (row >> 8) * 128 + ((row >> 2) & 63) : ((row - NCTX) >> 12) * 128 + 64 + (((row - NCTX) & 4095) >> 6);
            o0[u] = bf2f(((const bf16_t*)EARR(E_O0))[o]); o1[u] = bf2f(((const bf16_t*)EARR(E_O1))[o]); vv[u] = bf2f(sc_rec(SC, 0, row, wid)[384 + (tid & 63)]); gv[u] = bf2f(((const bf16_t*)EARR(E_G))[o]); bc[u] = BC[row * 8 + wid];
            x0[u] = bf2f(((const bf16_t*)EARR(E_BX0))[o]); x1[u] = bf2f(((const bf16_t*)EARR(E_BX1))[o]); a0[u] = bf2f(((const bf16_t*)EARR(E_A0))[o]); a1[u] = bf2f(((const bf16_t*)EARR(E_A1))[o]);
            c0[u] = CIN[(size_t)cid * 512 + c]; c1[u] = CIN[(size_t)(512 + cid) * 512 + c]; gt[u] = bf2f(((const bf16_t*)EARR(E_GATE))[o]); }
#pragma unroll
        for (int u = 0; u < 4; ++u) { const int row = r0 + u;
            const float wkv = o0[u] + o1[u];
            const float mean = wave_sum(wkv) * (1.0f / 64.0f), dv = wkv - mean, var = wave_sum(dv * dv) * (1.0f / 64.0f);
            const float y = (dv * rsqrtf(var + 64e-5f) * gg + gb + bc[u] * vv[u]) * gv[u];
            Y[(size_t)row * 1024 + c] = f2bf(y);
            Y[(size_t)row * 1024 + 512 + c] = f2bf(((x0[u] + a0[u] * c0[u]) + (x1[u] + a1[u] * c1[u])) * gt[u]); }
    }
#undef EARR
}
constexpr int LDT = 72;
__device__ __forceinline__ float quad_sum(float v) {
    v += __int_as_float(__builtin_amdgcn_update_dpp(0, __float_as_int(v), 0xB1, 0xf, 0xf, false));
    v += __int_as_float(__builtin_amdgcn_update_dpp(0, __float_as_int(v), 0x4E, 0xf, 0xf, false));
    return v;
}
template <int PO> __device__ __forceinline__ float quad_bcast(float v) { return __int_as_float(__builtin_amdgcn_update_dpp(0, __float_as_int(v), PO * 0x55, 0xf, 0xf, false)); }
__device__ __forceinline__ bf16x8 ldt8(const LAS bf16_t* T, int row, int col) { return *(const LAS bf16x8*)(T + row * LDT + col); }
__device__ __forceinline__ void ph_r1(const Params& p, LAS unsigned char* lds, int bid, int nblk) {
    const int tid = threadIdx.x, wid = tid >> 6, lane = tid & 63, fr = lane & 15, fq = lane >> 4;
    LAS bf16_t* T0 = (LAS bf16_t*)(lds + LDS_WORK);
#define TL(i) (T0 + (i) * 64 * LDT)
    LAS float* F0 = (LAS float*)(T0 + 11 * 64 * LDT);
    LAS float* F1 = F0 + 4096;
    LAS float* F2 = F1 + 4096;
    LAS float* segt = F2 + 4096;
    LAS float* gl = segt + 512;
    const float* SC = (const float*)(p.ws + WS_SC);
    float* RU = (float*)(p.ws + WS_RU);
    const int k = tid & 63, seg = tid >> 6, t0 = seg * 8;
    const int tr = (wid >> 1) * 16, tc0 = (wid & 1) * 32;
    float kk[8], lw[8], kd[8], ka[8], rr[8], vv[8];
    auto fetch = [&](int unit) {
        const int chain = unit / NRCH, c = unit - chain * NRCH;
        const bf16_t* rec = (const bf16_t*)SC + ((size_t)chain * SCLEN + c * RCH + t0) * SCREC + k;
#pragma unroll
        for (int u = 0; u < 8; ++u) { const bf16_t* r = rec + u * SCREC; lw[u] = ((const float*)(r - k))[k]; kk[u] = bf2f(r[128]); kd[u] = bf2f(r[192]); ka[u] = bf2f(r[256]); rr[u] = bf2f(r[320]); vv[u] = bf2f(r[384]); }
    };
    if (bid < NRUNIT) fetch(bid);
    for (int unit = bid; unit < NRUNIT; unit += nblk) {
        int tid_ = threadIdx.x; asm volatile("" : "+v"(tid_));
        const int tid = tid_, wid = tid >> 6, lane = tid & 63, fr = lane & 15, fq = lane >> 4, k = tid & 63, seg = tid >> 6, t0 = seg * 8, tr = (wid >> 1) * 16, tc0 = (wid & 1) * 32;
        float cum[8]; { float run = 0.f;
#pragma unroll
            for (int u = 0; u < 8; ++u) { run += lw[u]; cum[u] = run; }
            segt[seg * 64 + k] = run; }
        __syncthreads();
        float off = 0.f, tot = 0.f;
#pragma unroll
        for (int s2 = 0; s2 < 8; ++s2) { const float v = segt[s2 * 64 + k]; off += s2 < seg ? v : 0.f; tot += v; }
        if (seg == 0) gl[k] = fexp(tot);
        {
            u32x4 wk, wb, wv; unsigned pk[4], pb[4], pv[4]; float hk = 0.f, hb = 0.f, hv = 0.f;
#pragma unroll
            for (int u = 0; u < 8; ++u) { const int t = t0 + u; const float cu = cum[u] + off;
                const float ginc = fexp(cu), gexc = fexp(cu - lw[u]), ginv = fexp(-cu), gtail = fexp(tot - cu);
                const float kt = kk[u] * gexc;
                TL(0)[t * LDT + k] = f2bf(kt); F0[t * 64 + (k ^ ((((t >> 2) ^ t) & 3) << 4))] = kt;
                TL(1)[t * LDT + k] = f2bf(kd[u] * ginv); TL(2)[t * LDT + k] = f2bf(ka[u] * ginv); TL(3)[t * LDT + k] = f2bf(rr[u] * ginc);
                const float ktl = kd[u] * gtail, btl = ka[u] * gtail;
                if (u & 1) { pk[u >> 1] = pack_bf16(hk, ktl); pb[u >> 1] = pack_bf16(hb, btl); pv[u >> 1] = pack_bf16(hv, vv[u]); } else { hk = ktl; hb = btl; hv = vv[u]; } }
            wk.x = pk[0]; wk.y = pk[1]; wk.z = pk[2]; wk.w = pk[3]; wb.x = pb[0]; wb.y = pb[1]; wb.z = pb[2]; wb.w = pb[3]; wv.x = pv[0]; wv.y = pv[1]; wv.z = pv[2]; wv.w = pv[3];
            *(LAS u32x4*)(TL(4) + k * LDT + t0) = wk; *(LAS u32x4*)(TL(5) + k * LDT + t0) = wb; *(LAS u32x4*)(TL(6) + k * LDT + t0) = wv;
        }
        if (unit + nblk < NRUNIT) fetch(unit + nblk);
        __syncthreads();
        {
            f32x4 mk[2], mb[2], ak[2], ab[2];
#pragma unroll
            for (int nt = 0; nt < 2; ++nt) { mk[nt] = (f32x4){0.f, 0.f, 0.f, 0.f}; mb[nt] = mk[nt]; ak[nt] = mk[nt]; ab[nt] = mk[nt]; }
#pragma unroll
            for (int ks = 0; ks < 2; ++ks) { const bf16x8 aK = ldt8(TL(0), tr + fr, ks * 32 + fq * 8), aR = ldt8(TL(3), tr + fr, ks * 32 + fq * 8);
#pragma unroll
                for (int nt = 0; nt < 2; ++nt) { const bf16x8 bK = ldt8(TL(1), tc0 + nt * 16 + fr, ks * 32 + fq * 8), bB = ldt8(TL(2), tc0 + nt * 16 + fr, ks * 32 + fq * 8);
                    mk[nt] = __builtin_amdgcn_mfma_f32_16x16x32_bf16(aK, bK, mk[nt], 0, 0, 0); mb[nt] = __builtin_amdgcn_mfma_f32_16x16x32_bf16(aK, bB, mb[nt], 0, 0, 0);
                    ak[nt] = __builtin_amdgcn_mfma_f32_16x16x32_bf16(aR, bK, ak[nt], 0, 0, 0); ab[nt] = __builtin_amdgcn_mfma_f32_16x16x32_bf16(aR, bB, ab[nt], 0, 0, 0); } }
#pragma unroll
            for (int nt = 0; nt < 2; ++nt)
#pragma unroll
                for (int r = 0; r < 4; ++r) { const int t = tr + fq * 4 + r, j = tc0 + nt * 16 + fr;
                    TL(7)[t * LDT + j] = f2bf(j < t ? mk[nt][r] : 0.f); F1[j * 64 + (((t & 3) * 16 + (t >> 2)) ^ ((j & 7) << 2))] = j < t ? mb[nt][r] : 0.f;
                    TL(8)[t * LDT + j] = f2bf(j <= t ? ak[nt][r] : 0.f); TL(9)[t * LDT + j] = f2bf(j <= t ? ab[nt][r] : 0.f); }
        }
        __syncthreads();
        {
            f32x4 acc[2] = {(f32x4){0.f, 0.f, 0.f, 0.f}, (f32x4){0.f, 0.f, 0.f, 0.f}};
#pragma unroll
            for (int ks = 0; ks < 2; ++ks) { const bf16x8 a = ldt8(TL(7), tr + fr, ks * 32 + fq * 8);
#pragma unroll
                for (int nt = 0; nt < 2; ++nt) acc[nt] = __builtin_amdgcn_mfma_f32_16x16x32_bf16(a, ldt8(TL(6), tc0 + nt * 16 + fr, ks * 32 + fq * 8), acc[nt], 0, 0, 0); }
#pragma unroll
            for (int nt = 0; nt < 2; ++nt)
#pragma unroll
                for (int r = 0; r < 4; ++r) { const int t = tr + fq * 4 + r; F2[t * 64 + ((tc0 + nt * 16 + fr) ^ ((((t >> 2) ^ t) & 3) << 4))] = acc[nt][r]; }
        }
        __syncthreads();
        {
            const int col = tid >> 2, part = tid & 3;
            f32x2 acc2[8]; float x[16];
#pragma unroll
            for (int q = 0; q < 16; ++q) { const int t = 4 * q + part; const int sw = (((t >> 2) ^ t) & 3) << 4; acc2[q >> 1][q & 1] = col < 64 ? F0[t * 64 + (col ^ sw)] : F2[t * 64 + ((col - 64) ^ sw)]; x[q] = 0.f; }
#pragma unroll
            for (int t = 0; t < 64; ++t) {
                const int qo = t >> 2, po = t & 3; const float aq = acc2[qo >> 1][qo & 1];
                const float xt = po == 0 ? quad_bcast<0>(aq) : po == 1 ? quad_bcast<1>(aq) : po == 2 ? quad_bcast<2>(aq) : quad_bcast<3>(aq);
                x[qo] = part == po ? xt : x[qo];
                const f32x2 nx = {-xt, -xt};
#pragma unroll
                for (int q4 = qo >> 2; q4 < 4; ++q4) { const f32x4 m = *(const LAS f32x4*)(F1 + t * 64 + ((part * 16 + q4 * 4) ^ ((t & 7) << 2)));
                    acc2[q4 * 2] = (f32x2){m[0], m[1]} * nx + acc2[q4 * 2]; acc2[q4 * 2 + 1] = (f32x2){m[2], m[3]} * nx + acc2[q4 * 2 + 1]; }
            }
            LAS bf16_t* dstT = col < 64 ? TL(7) + col * LDT : TL(10) + (col - 64) * LDT;
#pragma unroll
            for (int q = 0; q < 16; ++q) dstT[4 * q + part] = f2bf(-x[q]);
        }
        __syncthreads();
        {
            f32x4 rh[2], ol[2], pm[2], qq[2];
#pragma unroll
            for (int nt = 0; nt < 2; ++nt) { rh[nt] = (f32x4){0.f, 0.f, 0.f, 0.f}; ol[nt] = rh[nt]; pm[nt] = rh[nt]; qq[nt] = rh[nt]; }
#pragma unroll
            for (int ks = 0; ks < 2; ++ks) { const int kc = ks * 32 + fq * 8;
                const bf16x8 a7 = ldt8(TL(7), tr + fr, kc), a8 = ldt8(TL(8), tr + fr, kc), a9 = ldt8(TL(9), tr + fr, kc), a6 = ldt8(TL(6), tr + fr, kc), a10 = ldt8(TL(10), tr + fr, kc);
#pragma unroll
                for (int nt = 0; nt < 2; ++nt) { const int br = tc0 + nt * 16 + fr;
                    const bf16x8 b9 = ldt8(TL(9), br, kc), b6 = ldt8(TL(6), br, kc), b10 = ldt8(TL(10), br, kc), b5 = ldt8(TL(5), br, kc), b4 = ldt8(TL(4), br, kc);
                    rh[nt] = __builtin_amdgcn_mfma_f32_16x16x32_bf16(a7, b9, rh[nt], 0, 0, 0);
                    ol[nt] = __builtin_amdgcn_mfma_f32_16x16x32_bf16(a8, b6, ol[nt], 0, 0, 0); ol[nt] = __builtin_amdgcn_mfma_f32_16x16x32_bf16(a9, b10, ol[nt], 0, 0, 0);
                    pm[nt] = __builtin_amdgcn_mfma_f32_16x16x32_bf16(a7, b5, pm[nt], 0, 0, 0);
                    qq[nt] = __builtin_amdgcn_mfma_f32_16x16x32_bf16(a6, b4, qq[nt], 0, 0, 0); qq[nt] = __builtin_amdgcn_mfma_f32_16x16x32_bf16(a10, b5, qq[nt], 0, 0, 0); } }
            float* U = RU + (size_t)unit * RUS;
#pragma unroll
            for (int nt = 0; nt < 2; ++nt)
#pragma unroll
                for (int r = 0; r < 4; ++r) { const int row = tr + fq * 4 + r, cx = tc0 + nt * 16 + fr; const int o = row * 64 + cx;
                    U[o] = pm[nt][r] + (row == cx ? gl[row] : 0.f);
                    ((bf16_t*)(U + 4096))[o] = f2bf(qq[nt][r]);
                    U[6144 + o] = rh[nt][r] + bf2f(TL(3)[cx * LDT + row]);
                    ((bf16_t*)(U + 10240))[o] = f2bf(ol[nt][r]); }
        }
        __syncthreads();
    }
#undef TL
}
constexpr int CVT_EARLY = 1024;
__device__ __forceinline__ void moe_weight_tiles(const Params& p, LAS unsigned char* lds, int first, int stride, int end = 12288) {
    const int tid = threadIdx.x; unsigned char* ws = p.ws;
    LAS float* tile = (LAS float*)(lds + LDS_WORK);
    const int j4 = (tid & 31) * 4, i0 = tid >> 5;
    auto decode = [&](int tt, const float*& src, int& ld, int& k0, int& n0, int& w1map, bf16_t*& dst) {
        if (tt < 8192) { const int mat = tt >> 7, r = tt & 127; k0 = (r >> 4) * 128; n0 = (r & 15) * 128; src = p.in[I_W1] + (size_t)mat * 1024 * 2048; ld = 2048; dst = (bf16_t*)(ws + WS_W1T) + (size_t)mat * 2048 * 1024; w1map = 1; }
        else { tt -= 8192; const int mat = tt >> 6, r = tt & 63; k0 = (r >> 3) * 128; n0 = (r & 7) * 128; src = p.in[I_W2] + (size_t)mat * 1024 * 1024; ld = 1024; dst = (bf16_t*)(ws + WS_W2T) + (size_t)mat * 1024 * 1024; w1map = 0; }
    };
    f32x4 v[8];
    if (first < end) { const float* src; int ld, k0, n0, w1; bf16_t* dst; decode(first, src, ld, k0, n0, w1, dst);
#pragma unroll
        for (int r = 0; r < 8; ++r) v[r] = __builtin_nontemporal_load((const f32x4*)(src + (size_t)(k0 + i0 + 16 * r) * ld + n0 + j4)); }
    for (int t = first; t < end; t += stride) {
        const float* src; int ld, k0, n0, w1map; bf16_t* dst; decode(t, src, ld, k0, n0, w1map, dst);
#pragma unroll
        for (int r = 0; r < 8; ++r) { LAS float* tp = tile + (i0 + 16 * r) * 129 + j4; tp[0] = v[r][0]; tp[1] = v[r][1]; tp[2] = v[r][2]; tp[3] = v[r][3]; }
        __syncthreads();
        if (t + stride < end) { const float* s2; int ld2, k2, n2, w2; bf16_t* d2; decode(t + stride, s2, ld2, k2, n2, w2, d2);
#pragma unroll
            for (int r = 0; r < 8; ++r) v[r] = __builtin_nontemporal_load((const f32x4*)(s2 + (size_t)(k2 + i0 + 16 * r) * ld2 + n2 + j4)); }
        { const int ip = (tid & 15) * 8, j0 = tid >> 4;
            const int rho0 = w1map ? ((((n0 & 1023) >> 7) << 8) + ((n0 >> 10) << 7)) : n0;
#pragma unroll
            for (int r = 0; r < 4; ++r) { const int j = j0 + 32 * r;
                u32x4 w; w.x = pack_bf16(tile[ip * 129 + j], tile[(ip + 1) * 129 + j]); w.y = pack_bf16(tile[(ip + 2) * 129 + j], tile[(ip + 3) * 129 + j]);
                w.z = pack_bf16(tile[(ip + 4) * 129 + j], tile[(ip + 5) * 129 + j]); w.w = pack_bf16(tile[(ip + 6) * 129 + j], tile[(ip + 7) * 129 + j]);
                const int rho = rho0 + j, kk8 = k0 + ip; *(u32x4*)(dst + ((size_t)((rho >> 8) * 16 + (kk8 >> 6)) * 256 + (rho & 255)) * 64 + (kk8 & 63)) = w; } }
        __syncthreads();
    }
}
__device__ __forceinline__ void ph_r2(const Params& p, LAS unsigned char* lds, int bid, int nblk) {
    const int tid = threadIdx.x, wid = tid >> 6, lane = tid & 63, fr = lane & 15, g = lane >> 4;
    const int nchainwg = nblk >= 128 ? 64 : 0;
    if (bid >= nchainwg) {
        const int nconv = nblk - nchainwg, cb = bid - nchainwg;
        if (tid < 256) {
            const float* CHA = (const float*)(p.ws + WS_CHA); const float* CHH = (const float*)(p.ws + WS_CHH); float* CIN = (float*)(p.ws + WS_CIN);
            for (int item = cb; item < 16; item += nconv) {
                const int gi = item * 256 + tid, d = gi >> 11, b = (gi >> 9) & 3, c = gi & 511;
                float carry = 0.f;
                for (int s0 = 0; s0 < 128; s0 += 16) {
                    float av[16], hv[16];
#pragma unroll
                    for (int q = 0; q < 16; ++q) { const int st = s0 + q; const int cl = d == 0 ? st : (st < 64 ? 63 - st : 191 - st);
                        const size_t o = (size_t)(d * 512 + b * 128 + cl) * 512 + c; av[q] = CHA[o]; hv[q] = CHH[o]; }
#pragma unroll
                    for (int q = 0; q < 16; ++q) { const int st = s0 + q; const int cl = d == 0 ? st : (st < 64 ? 63 - st : 191 - st);
                        CIN[(size_t)(d * 512 + b * 128 + cl) * 512 + c] = carry; carry = av[q] * carry + hv[q]; }
                }
            }
        }
        __syncthreads();
        moe_weight_tiles(p, lds, CVT_EARLY + cb, nconv);
        if (nchainwg) return;
    }
    LAS float* ring = (LAS float*)(lds + LDS_WORK);
    const float* RU = (const float*)(p.ws + WS_RU);
    float* EA = (float*)(p.ws + WS_EARR);
    for (int chain = nchainwg ? bid : bid; chain < 64; chain += (nchainwg ? 64 : nblk)) {
        const int d = chain >> 5, b = (chain >> 3) & 3, h = chain & 7;
        bf16_t* Od = (bf16_t*)(EA + (size_t)(E_O0 + d) * ((size_t)MROWS * 512));
        auto issue = [&](int c) {
            const float* src = RU + ((size_t)chain * NRCH + c) * RUS; LAS float* dst = ring + (c & 1) * RUS;
#pragma unroll
            for (int i = 0; i < 12; ++i) { const int slot = ((wid - 4) * 12 + i) * 64;
                __builtin_amdgcn_global_load_lds((const unsigned*)(src + (size_t)(slot + lane) * 4), (LAS unsigned*)(dst + slot * 4), 16, 0, 0); }
        };
        if (tid >= 256) { issue(0); asm volatile("s_waitcnt vmcnt(0)" ::: "memory"); }
        asm volatile("" ::: "memory"); __builtin_amdgcn_s_barrier(); asm volatile("" ::: "memory");
        f32x4 S[4];
#pragma unroll
        for (int m = 0; m < 4; ++m) S[m] = (f32x4){0.f, 0.f, 0.f, 0.f};
        const int v0 = wid * 16;
        for (int c = 0; c < NRCH; ++c) {
            if (tid >= 256) { if (c + 1 < NRCH) issue(c + 1); asm volatile("s_waitcnt vmcnt(0)" ::: "memory"); }
            else {
                const LAS float* PM = ring + (c & 1) * RUS; const LAS bf16_t* QQ = (const LAS bf16_t*)(PM + 4096); const LAS float* RHT = PM + 6144; const LAS bf16_t* OL = (const LAS bf16_t*)(PM + 10240);
                f32x4 acc[4], Sn[4];
#pragma unroll
                for (int tt = 0; tt < 4; ++tt) {
#pragma unroll
                    for (int i = 0; i < 4; ++i) acc[tt][i] = bf2f(OL[(16 * tt + 4 * g + i) * 64 + v0 + fr]);
                    { const u32x2 q2 = *(const LAS u32x2*)(QQ + (v0 + fr) * 64 + 16 * tt + 4 * g);
                      Sn[tt] = (f32x4){__uint_as_float(q2.x << 16), __uint_as_float(q2.x & 0xffff0000u), __uint_as_float(q2.y << 16), __uint_as_float(q2.y & 0xffff0000u)}; } }
                float A[3][4];
#pragma unroll
                for (int s0 = 0; s0 < 2; ++s0) { const LAS float* ar = RHT + (16 * (s0 >> 2) + 4 * g + (s0 & 3)) * 64 + fr;
#pragma unroll
                    for (int u = 0; u < 4; ++u) A[s0][u] = ar[16 * u]; }
#pragma unroll
                for (int st = 0; st < 32; ++st) {
                    if (st + 2 < 32) { const int s2 = st + 2, mi = s2 & 15; const LAS float* ar = (s2 < 16 ? RHT : PM) + (16 * (mi >> 2) + 4 * g + (mi & 3)) * 64 + fr;
#pragma unroll
                        for (int u = 0; u < 4; ++u) A[s2 % 3][u] = ar[16 * u]; }
                    __builtin_amdgcn_sched_barrier(0);
                    const int mi = st & 15; const float bq = S[mi >> 2][mi & 3];
                    if (st < 16) {
#pragma unroll
                        for (int u = 0; u < 4; ++u) acc[u] = __builtin_amdgcn_mfma_f32_16x16x4f32(A[st % 3][u], bq, acc[u], 0, 0, 0);
                    } else {
#pragma unroll
                        for (int u = 0; u < 4; ++u) Sn[u] = __builtin_amdgcn_mfma_f32_16x16x4f32(A[st % 3][u], bq, Sn[u], 0, 0, 0);
                    }
                }
#pragma unroll
                for (int tt = 0; tt < 4; ++tt)
#pragma unroll
                    for (int i = 0; i < 4; ++i) { const int row = scan_row(d, b, c * RCH + 16 * tt + 4 * g + i); Od[(size_t)row * 512 + h * 64 + v0 + fr] = f2bf(acc[tt][i]); }
#pragma unroll
                for (int m = 0; m < 4; ++m) S[m] = Sn[m];
                asm volatile("s_waitcnt lgkmcnt(0)" ::: "memory");
            }
            asm volatile("" ::: "memory"); __builtin_amdgcn_s_barrier(); asm volatile("" ::: "memory");
        }
    }
}
__device__ __forceinline__ float half_max(float v, int lane) {
    const int ninf = 0xff800000;
    v = fmaxf(v, __int_as_float(__builtin_amdgcn_update_dpp(ninf, __float_as_int(v), 0x121, 0xf, 0xf, false)));
    v = fmaxf(v, __int_as_float(__builtin_amdgcn_update_dpp(ninf, __float_as_int(v), 0x122, 0xf, 0xf, false)));
    v = fmaxf(v, __int_as_float(__builtin_amdgcn_update_dpp(ninf, __float_as_int(v), 0x124, 0xf, 0xf, false)));
    v = fmaxf(v, __int_as_float(__builtin_amdgcn_update_dpp(ninf, __float_as_int(v), 0x128, 0xf, 0xf, false)));
    v = fmaxf(v, __int_as_float(__builtin_amdgcn_update_dpp(ninf, __float_as_int(v), 0x142, 0xa, 0xf, false)));
    const float lo = __int_as_float(__builtin_amdgcn_readlane(__float_as_int(v), 31)), hi = __int_as_float(__builtin_amdgcn_readlane(__float_as_int(v), 63));
    return (lane & 32) ? hi : lo;
}
__device__ __forceinline__ int half_min_i(int v, int lane) {
    const int big = 0x7fffffff;
    v = min(v, __builtin_amdgcn_update_dpp(big, v, 0x121, 0xf, 0xf, false));
    v = min(v, __builtin_amdgcn_update_dpp(big, v, 0x122, 0xf, 0xf, false));
    v = min(v, __builtin_amdgcn_update_dpp(big, v, 0x124, 0xf, 0xf, false));
    v = min(v, __builtin_amdgcn_update_dpp(big, v, 0x128, 0xf, 0xf, false));
    v = min(v, __builtin_amdgcn_update_dpp(big, v, 0x142, 0xa, 0xf, false));
    const int lo = __builtin_amdgcn_readlane(v, 31), hi = __builtin_amdgcn_readlane(v, 63);
    return (lane & 32) ? hi : lo;
}
template <int LAYER>
__device__ __forceinline__ void ph_ln1(const Params& p, LAS unsigned char* lds, int bid, int nblk) {
    const int tid = threadIdx.x, wid = tid >> 6, lane = tid & 63, fr = lane & 15, fq = lane >> 4;
    LAS float* vb = (LAS float*)(lds + LDS_WORK);
    LAS float* part = vb + 16 * 1028;
    LAS int* lcnt = (LAS int*)(part + 8 * 16 * 32);
    float rwf[2][32];
    { const float* rw = p.in[I_RW] + (size_t)LAYER * 32768 + (size_t)(128 * wid + 32 * fq) * 32 + fr;
#pragma unroll
        for (int s2 = 0; s2 < 32; ++s2) { rwf[0][s2] = rw[s2 * 32]; rwf[1][s2] = rw[s2 * 32 + 16]; } }
    if (tid < 32) lcnt[tid] = 0;
    __syncthreads();
    const float* MOD = (const float*)(p.ws + WS_MOD);
    bf16_t* XS = (bf16_t*)(p.ws + WS_XS); const bf16_t* YP = (const bf16_t*)(p.ws + WS_YP); bf16_t* H = (bf16_t*)(p.ws + WS_H);
    int* TOPE = (int*)(p.ws + WS_TOPE); float* TOPW = (float*)(p.ws + WS_TOPW); int* TOPS = (int*)(p.ws + WS_TOPS);
    int* CNTB = (int*)(p.ws + WS_CNTB) + (size_t)(LAYER * 512 + bid) * 32;
    const float* lng = p.in[I_LNG] + (LAYER * 2 + 0) * 1024; const float* lnb = p.in[I_LNB] + (LAYER * 2 + 0) * 1024;
    const int rstride = nblk * 8, rbase = (LAYER == 0 ? 0 : NCTX) + bid * 8;
    f32x4 nres[4], ngate[4]; u32x2 nyp[4];
    auto fetch = [&](int row) {
        const float* res = row < NCTX ? p.in[I_CTX] + (size_t)row * 1024 : p.in[I_X] + (size_t)(row - NCTX) * 1024;
        const float* md = MOD + (size_t)(LAYER * 5 + row_modr(row)) * 6144;
#pragma unroll
        for (int q = 0; q < 4; ++q) { const int col = q * 256 + lane * 4; nres[q] = LAYER == 0 ? __builtin_nontemporal_load((const f32x4*)(res + col)) : ld_bf16x4(XS + (size_t)row * 1024 + col);
            ngate[q] = *(const f32x4*)(md + 2048 + col); nyp[q] = *(const u32x2*)(YP + (size_t)row * 1024 + col); }
    };
    if (rbase < MROWS) fetch(rbase + wid);
#pragma unroll 1
    for (int j0 = 0; rbase + j0 * rstride < MROWS; j0 += 2) {
#pragma unroll 1
        for (int jj = 0; jj < 2; ++jj) {
            const int row = rbase + wid + (j0 + jj) * rstride;
            if (row >= MROWS) break;
            const float* md = MOD + (size_t)(LAYER * 5 + row_modr(row)) * 6144;
            f32x4 v[4], msc[4], msh[4]; float s = 0.f;
#pragma unroll
            for (int q = 0; q < 4; ++q) { const u32x2 w = nyp[q];
                const f32x4 y = (f32x4){__uint_as_float(w.x << 16), __uint_as_float(w.x & 0xffff0000u), __uint_as_float(w.y << 16), __uint_as_float(w.y & 0xffff0000u)};
                v[q] = nres[q] * DN_ALPHA + ngate[q] * y;
                s += (v[q][0] + v[q][1]) + (v[q][2] + v[q][3]); }
#pragma unroll
            for (int q = 0; q < 4; ++q) { const int col = q * 256 + lane * 4; msc[q] = *(const f32x4*)(md + 4096 + col); msh[q] = *(const f32x4*)(md + 3072 + col); }
            if (row + rstride < MROWS) fetch(row + rstride);
            const float mean = wave_sum(s) * (1.0f / 1024.0f);
            float ss = 0.f;
#pragma unroll
            for (int q = 0; q < 4; ++q) { v[q] = v[q] - mean; ss += (v[q][0] * v[q][0] + v[q][1] * v[q][1]) + (v[q][2] * v[q][2] + v[q][3] * v[q][3]); }
            const float rstd = rsqrtf(wave_sum(ss) * (1.0f / 1024.0f) + LN_EPS);
#pragma unroll
            for (int q = 0; q < 4; ++q) { const int col = q * 256 + lane * 4;
                const f32x4 xn = v[q] * rstd * *(const f32x4*)(lng + col) + *(const f32x4*)(lnb + col);
                { u32x2 wx; wx.x = pack_bf16(xn[0], xn[1]); wx.y = pack_bf16(xn[2], xn[3]); *(u32x2*)(XS + (size_t)row * 1024 + col) = wx; }
                v[q] = xn * (msc[q] + 1.0f) + msh[q];
                u32x2 w; w.x = pack_bf16(v[q][0], v[q][1]); w.y = pack_bf16(v[q][2], v[q][3]);
                *(u32x2*)(H + (size_t)row * 1024 + col) = w;
                *(LAS f32x4*)(vb + (wid + 8 * jj) * 1028 + col) = v[q]; }
        }
        __syncthreads();
        {
            const LAS float* ar = vb + fr * 1028 + 128 * wid + 32 * fq;
            f32x4 acc0 = {0.f, 0.f, 0.f, 0.f}, acc1 = {0.f, 0.f, 0.f, 0.f};
#pragma unroll
            for (int h = 0; h < 2; ++h) { f32x4 va[4];
#pragma unroll
                for (int u = 0; u < 4; ++u) va[u] = *(const LAS f32x4*)(ar + h * 16 + u * 4);
#pragma unroll
                for (int u = 0; u < 4; ++u)
#pragma unroll
                    for (int i = 0; i < 4; ++i) { acc0 = __builtin_amdgcn_mfma_f32_16x16x4f32(va[u][i], rwf[0][h * 16 + u * 4 + i], acc0, 0, 0, 0);
                        acc1 = __builtin_amdgcn_mfma_f32_16x16x4f32(va[u][i], rwf[1][h * 16 + u * 4 + i], acc1, 0, 0, 0); } }
            LAS float* pw = part + wid * 512 + (4 * fq) * 32 + fr;
#pragma unroll
            for (int i = 0; i < 4; ++i) { pw[i * 32] = acc0[i]; pw[i * 32 + 16] = acc1[i]; }
        }
        __syncthreads();
        {
            const int e = lane & 31, lr = 2 * wid + (lane >> 5), row = rbase + (lr & 7) + (j0 + (lr >> 3)) * rstride;
            float lg = p.in[I_RB][LAYER * 32 + e];
#pragma unroll
            for (int w2 = 0; w2 < 8; ++w2) lg += part[w2 * 512 + lr * 32 + e];
            float tv[4]; int te[4];
#pragma unroll
            for (int k = 0; k < 4; ++k) { const float bv = half_max(lg, lane); const int bi = half_min_i(lg == bv ? e : 99, lane);
                tv[k] = bv; te[k] = bi & 31; lg = e == bi ? -3.0e38f : lg; }
            const float e1 = expf(tv[1] - tv[0]), e2 = expf(tv[2] - tv[0]), e3 = expf(tv[3] - tv[0]), inv = 1.0f / (1.0f + e1 + e2 + e3);
            if (e == 0 && row < MROWS) {
                const float wv[4] = {inv, e1 * inv, e2 * inv, e3 * inv};
#pragma unroll
                for (int k = 0; k < 4; ++k) { const int slot = __hip_atomic_fetch_add(lcnt + te[k], 1, __ATOMIC_RELAXED, __HIP_MEMORY_SCOPE_WORKGROUP); TOPE[row * 4 + k] = te[k]; TOPW[row * 4 + k] = wv[k]; TOPS[row * 4 + k] = slot; }
            }
        }
    }
    __syncthreads();
    if (tid < 32) CNTB[tid] = lcnt[tid];
}
constexpr int LDS_TAB = LDS_WORK + 131072;
__device__ __forceinline__ int moe_tables(const int* cntb, int nblk, LAS int* tab, LAS int* bb) {
    const int tid = threadIdx.x, e = tid & 31, seg = tid >> 5, per = (nblk + 15) >> 4;
    const int b0 = seg * per, b1 = (b0 + per) < nblk ? (b0 + per) : nblk;
    int s = 0;
    if (per <= 16) {
        int cv[16];
#pragma unroll
        for (int u = 0; u < 16; ++u) cv[u] = (b0 + u) < b1 ? cntb[(b0 + u) * 32 + e] : 0;
#pragma unroll
        for (int u = 0; u < 16; ++u) s += cv[u];
        tab[512 + seg * 32 + e] = s;
        __syncthreads();
        if (tid < 32) { int run = 0; for (int sg = 0; sg < 16; ++sg) { const int v = tab[512 + sg * 32 + tid]; tab[512 + sg * 32 + tid] = run; run += v; } tab[448 + tid] = run; }
        __syncthreads();
        if (bb) { int run = tab[512 + seg * 32 + e];
#pragma unroll
            for (int u = 0; u < 16; ++u) if ((b0 + u) < b1) { bb[(b0 + u) * 32 + e] = run; run += cv[u]; } }
    } else {
        for (int b = b0; b < b1; ++b) s += cntb[b * 32 + e];
        tab[512 + seg * 32 + e] = s;
        __syncthreads();
        if (tid < 32) { int run = 0; for (int sg = 0; sg < 16; ++sg) { const int v = tab[512 + sg * 32 + tid]; tab[512 + sg * 32 + tid] = run; run += v; } tab[448 + tid] = run; }
        __syncthreads();
        if (bb) { int run = tab[512 + seg * 32 + e]; for (int b = b0; b < b1; ++b) { bb[b * 32 + e] = run; run += cntb[b * 32 + e]; } }
    }
    if (tid < 64) {
        const int x = tid & 31, n = (tab[448 + x] + 255) >> 8; int inc = n;
#pragma unroll
        for (int o = 1; o < 32; o <<= 1) { const int t = __shfl_up(inc, o, 64); if ((tid & 31) >= o) inc += t; }
        if (tid < 32) { const int t0 = inc - n; tab[x] = t0 * 256; for (int i = 0; i < n; ++i) tab[64 + t0 + i] = x; if (x == 31) { tab[32] = inc * 256; tab[40] = inc; } }
    }
    __syncthreads();
    return tab[40];
}
template <int LAYER>
__device__ __forceinline__ void ph_moe_gather(const Params& p, LAS unsigned char* lds, int bid, int nblk) {
    const int tid = threadIdx.x;
    LAS int* tab = (LAS int*)(lds + LDS_TAB); LAS int* bb = (LAS int*)(lds + LDS_WORK);
    (void)moe_tables((const int*)(p.ws + WS_CNTB) + (size_t)LAYER * 512 * 32, nblk, tab, bb);
    const int* TOPE = (const int*)(p.ws + WS_TOPE); const int* TOPS = (const int*)(p.ws + WS_TOPS); int* POS = (int*)(p.ws + WS_POS); int* IDX = (int*)(p.ws + WS_IDX);
    constexpr int R0 = LAYER == 0 ? 0 : NCTX;
    for (int i = R0 * 4 + bid * NTHR + tid; i < MROWS * 4; i += nblk * NTHR) {
        const int row = i >> 2, e = TOPE[i], pos = tab[e] + bb[((((row - R0) >> 3) % nblk) << 5) + e] + TOPS[i];
        POS[i] = pos; IDX[pos] = row;
    }
    for (int e = bid; e < 32; e += nblk) {
        const int cnt = tab[448 + e], beg = tab[e] + cnt, end = tab[e] + ((cnt + 255) & ~255);
        for (int q = beg + tid; q < end; q += NTHR) IDX[q] = R0;
    }
}
template <int LAYER>
__device__ __forceinline__ void ph_moe_gemm1(const Params& p, LAS unsigned char* lds, int bid, int nblk) {
    LAS int* tab = (LAS int*)(lds + LDS_TAB);
    const int T = tab[40];
    pg8::Gemm g{(const bf16_t*)(p.ws + WS_H), (const bf16_t*)(p.ws + WS_W1T) + (size_t)LAYER * 32 * 2048 * 1024, 0, 0, 1024, (const int*)(p.ws + WS_IDX)};
    pg8::EpiAct E{(bf16_t*)(p.ws + WS_ACT), p.in[I_B1] + (size_t)LAYER * 32 * 2048};
    { pg8::SchedMoe<8, 1> S{T, nblk, bid, tab + 64}; pg8::gemm_phase<pg8::EpiAct, pg8::SchedMoe<8, 1>, false, false, true, true>(lds + LDS_WORK, g, S, E, nullptr); }
    { pg8::SchedMoe<8, 2> S{T, nblk, bid, tab + 64}; pg8::gemm_phase<pg8::EpiAct, pg8::SchedMoe<8, 2>, false, false, true, true, true>(lds + LDS_WORK, g, S, E, nullptr); }
}
template <int LAYER>
__device__ __forceinline__ void ph_moe_gemm2(const Params& p, LAS unsigned char* lds, int bid, int nblk) {
    LAS int* tab = (LAS int*)(lds + LDS_TAB);
    const int T = tab[40];
    pg8::Gemm g{(const bf16_t*)(p.ws + WS_ACT), (const bf16_t*)(p.ws + WS_W2T) + (size_t)LAYER * 32 * 1024 * 1024, 0, 0, 1024};
    pg8::EpiYE E{(bf16_t*)(p.ws + WS_YE), p.in[I_B2] + (size_t)LAYER * 32 * 1024};
    { pg8::SchedMoe<4, 1> S{T, nblk, bid, tab + 64}; pg8::gemm_phase<pg8::EpiYE, pg8::SchedMoe<4, 1>, false, true, true>(lds + LDS_WORK, g, S, E, nullptr); }
    { pg8::SchedMoe<4, 2> S{T, nblk, bid, tab + 64}; pg8::gemm_phase<pg8::EpiYE, pg8::SchedMoe<4, 2>, false, true, true, false, true>(lds + LDS_WORK, g, S, E, nullptr); }
}
template <int NN>
__device__ __forceinline__ void ph_gemm_dense(LAS unsigned char* lds, const bf16_t* A, const bf16_t* Bt, bf16_t* C, int ldc, int pm0, int nM, int bid, int nblk) {
    pg8::Gemm g{A, Bt, 0, 0, 1024};
    pg8::EpiStore E{C, ldc};
    { pg8::SchedDense<NN, 1> S{nM, pm0, nblk, bid}; pg8::gemm_phase<pg8::EpiStore, pg8::SchedDense<NN, 1>, false>(lds + LDS_WORK, g, S, E, nullptr); }
    { pg8::SchedDense<NN, 2> S{nM, pm0, nblk, bid}; pg8::gemm_phase<pg8::EpiStore, pg8::SchedDense<NN, 2>, false, false, false, false, true>(lds + LDS_WORK, g, S, E, nullptr); }
}
template <int LAYER>
__device__ __forceinline__ void ph_ln2(const Params& p, LAS unsigned char* lds, int bid, int nblk) {
    const int tid = threadIdx.x, wid = tid >> 6, lane = tid & 63, fr = lane & 15, fq = lane >> 4;
    LAS float* vb = (LAS float*)(lds + LDS_WORK);
    LAS float* part = vb + 16 * 1028;
    float wgf[32];
    if (LAYER == 0) { const float* wg = p.in[I_OWIN] + (size_t)(128 * wid + 32 * fq) * ODD_IN + 4096 + fr;
#pragma unroll
        for (int s2 = 0; s2 < 32; ++s2) wgf[s2] = wg[(size_t)s2 * ODD_IN]; }
    const float* MOD = (const float*)(p.ws + WS_MOD);
    bf16_t* XS = (bf16_t*)(p.ws + WS_XS); const bf16_t* YE = (const bf16_t*)(p.ws + WS_YE); bf16_t* H = (bf16_t*)(p.ws + WS_H); float* GT = (float*)(p.ws + WS_GT);
    const float* TOPW = (const float*)(p.ws + WS_TOPW); const int* POS = (const int*)(p.ws + WS_POS);
    const float* lng = p.in[I_LNG] + (LAYER * 2 + 1) * 1024; const float* lnb = p.in[I_LNB] + (LAYER * 2 + 1) * 1024;
    const int rstride = nblk * 8, rbase = (LAYER == 0 ? 0 : NCTX) + bid * 8, rfirst = rbase + wid;
    f32x4 nw = {0.f, 0.f, 0.f, 0.f}; int np0 = 0, np1 = 0, np2 = 0, np3 = 0;
    if (rfirst < MROWS) { nw = *(const f32x4*)(TOPW + rfirst * 4); np0 = POS[rfirst * 4]; np1 = POS[rfirst * 4 + 1]; np2 = POS[rfirst * 4 + 2]; np3 = POS[rfirst * 4 + 3]; }
    auto do_row = [&](int row, int jj) {
        const float* md = MOD + (size_t)(LAYER * 5 + row_modr(row)) * 6144;
        const float w0 = nw[0], w1 = nw[1], w2 = nw[2], w3 = nw[3];
        const bf16_t* y0 = YE + (size_t)np0 * 1024; const bf16_t* y1 = YE + (size_t)np1 * 1024;
        const bf16_t* y2 = YE + (size_t)np2 * 1024; const bf16_t* y3 = YE + (size_t)np3 * 1024;
        if (row + rstride < MROWS) { const int rn = row + rstride; nw = *(const f32x4*)(TOPW + rn * 4); np0 = POS[rn * 4]; np1 = POS[rn * 4 + 1]; np2 = POS[rn * 4 + 2]; np3 = POS[rn * 4 + 3]; }
        f32x4 v[4]; float s = 0.f;
#pragma unroll
        for (int q = 0; q < 4; ++q) { const int col = q * 256 + lane * 4;
            const f32x4 ffn = (ld_bf16x4(y0 + col) * w0 + ld_bf16x4(y1 + col) * w1) + (ld_bf16x4(y2 + col) * w2 + ld_bf16x4(y3 + col) * w3);
            v[q] = ld_bf16x4(XS + (size_t)row * 1024 + col) * DN_ALPHA + *(const f32x4*)(md + 5120 + col) * ffn;
            s += (v[q][0] + v[q][1]) + (v[q][2] + v[q][3]); }
        const float mean = wave_sum(s) * (1.0f / 1024.0f);
        float ss = 0.f;
#pragma unroll
        for (int q = 0; q < 4; ++q) { v[q] = v[q] - mean; ss += (v[q][0] * v[q][0] + v[q][1] * v[q][1]) + (v[q][2] * v[q][2] + v[q][3] * v[q][3]); }
        const float rstd = rsqrtf(wave_sum(ss) * (1.0f / 1024.0f) + LN_EPS);
        if (LAYER == 1) {
#pragma unroll
            for (int q = 0; q < 4; ++q) { const int col = q * 256 + lane * 4;
                *(f32x4*)(p.out + (size_t)(row - NCTX) * 1024 + col) = v[q] * rstd * *(const f32x4*)(lng + col) + *(const f32x4*)(lnb + col); }
        } else {
            const float* md1 = MOD + (size_t)(5 + row_modr(row)) * 6144;
#pragma unroll
            for (int q = 0; q < 4; ++q) { const int col = q * 256 + lane * 4;
                const f32x4 xn = v[q] * rstd * *(const f32x4*)(lng + col) + *(const f32x4*)(lnb + col);
                { u32x2 wx; wx.x = pack_bf16(xn[0], xn[1]); wx.y = pack_bf16(xn[2], xn[3]); *(u32x2*)(XS + (size_t)row * 1024 + col) = wx; }
                v[q] = xn * (*(const f32x4*)(md1 + 1024 + col) + 1.0f) + *(const f32x4*)(md1 + col);
                u32x2 w; w.x = pack_bf16(v[q][0], v[q][1]); w.y = pack_bf16(v[q][2], v[q][3]);
                *(u32x2*)(H + (size_t)row * 1024 + col) = w;
                *(LAS f32x4*)(vb + (wid + 8 * jj) * 1028 + col) = v[q]; }
        }
    };
    if (LAYER == 1) {
#pragma unroll 1
        for (int row = rfirst; row < MROWS; row += rstride) do_row(row, 0);
    } else {
#pragma unroll 1
        for (int j0 = 0; rbase + j0 * rstride < MROWS; j0 += 2) {
#pragma unroll 1
            for (int jj = 0; jj < 2; ++jj) { const int row = rfirst + (j0 + jj) * rstride; if (row >= MROWS) break; do_row(row, jj); }
            __syncthreads();
            {
                const LAS float* ar = vb + fr * 1028 + 128 * wid + 32 * fq;
                f32x4 acc = {0.f, 0.f, 0.f, 0.f};
#pragma unroll
                for (int h = 0; h < 2; ++h) { f32x4 va[4];
#pragma unroll
                    for (int u = 0; u < 4; ++u) va[u] = *(const LAS f32x4*)(ar + h * 16 + u * 4);
#pragma unroll
                    for (int u = 0; u < 4; ++u)
#pragma unroll
                        for (int i = 0; i < 4; ++i) acc = __builtin_amdgcn_mfma_f32_16x16x4f32(va[u][i], wgf[h * 16 + u * 4 + i], acc, 0, 0, 0); }
                LAS float* pw = part + wid * 256 + (4 * fq) * 16 + fr;
#pragma unroll
                for (int i = 0; i < 4; ++i) pw[i * 16] = acc[i];
            }
            __syncthreads();
            if (tid < 256) { const int lr = tid >> 4, row = rbase + (lr & 7) + (j0 + (lr >> 3)) * rstride;
                float a = 0.f;
#pragma unroll
                for (int w2 = 0; w2 < 8; ++w2) a += part[w2 * 256 + tid];
                if (row < MROWS) GT[row * 16 + (tid & 15)] = a; }
        }
    }
}
constexpr int LDK = 136;
__device__ __forceinline__ int sid_of(int mixer, int dir, int b, int ch, int h) { return (((mixer * 2 + dir) * 4 + b) * NCHUNK + ch) * 4 + h; }
__device__ __forceinline__ void unit_decode(int u, int& mixer, int& h, int& ch, int& b, int& row0) {
    mixer = u & 1; h = (u >> 1) & 3; const int rest = u >> 3; ch = rest % NCHUNK; b = rest / NCHUNK;
    row0 = ch < 2 ? b * 256 + ch * 128 : NCTX + b * 4096 + (ch - 2) * 128;
}
__device__ __forceinline__ void ld_raw(const bf16_t* P, int row0, int col, u32x2 (&raw)[8]) {
    const int t = threadIdx.x, i = t >> 2, part = t & 3, i0 = (part & 1) * 32 + (part >> 1) * 16;
    const bf16_t* src = P + (size_t)(row0 + i) * LDP1 + col + i0;
#pragma unroll
    for (int q = 0; q < 4; ++q) { raw[q] = *(const u32x2*)(src + q * 4); raw[4 + q] = *(const u32x2*)(src + 64 + q * 4); }
}
__device__ __forceinline__ void cvt_rows(const u32x2 (&raw)[8], bool rope, int s0, const float* ROPE, float (&lo)[16], float (&hi)[16]) {
    const int t = threadIdx.x, i = t >> 2, part = t & 3, pr = part & 1, hf = part >> 1;
#pragma unroll
    for (int q = 0; q < 4; ++q) {
        lo[q * 4] = __uint_as_float(raw[q].x << 16); lo[q * 4 + 1] = __uint_as_float(raw[q].x & 0xffff0000u); lo[q * 4 + 2] = __uint_as_float(raw[q].y << 16); lo[q * 4 + 3] = __uint_as_float(raw[q].y & 0xffff0000u);
        hi[q * 4] = __uint_as_float(raw[4 + q].x << 16); hi[q * 4 + 1] = __uint_as_float(raw[4 + q].x & 0xffff0000u); hi[q * 4 + 2] = __uint_as_float(raw[4 + q].y << 16); hi[q * 4 + 3] = __uint_as_float(raw[4 + q].y & 0xffff0000u); }
    if (rope) {
        const int s = s0 + i, pos = pr == 0 ? (s >> 6) : (s & 63);
        const float* rp = ROPE + (size_t)(pos * 32 + hf * 16) * 2;
#pragma unroll
        for (int jj = 0; jj < 16; ++jj) { const float c = rp[2 * jj], sn = rp[2 * jj + 1], a = lo[jj], b = hi[jj]; lo[jj] = a * c - b * sn; hi[jj] = a * sn + b * c; }
    }
}
__device__ __forceinline__ void st_rows(LAS bf16_t* dst, const float (&lo)[16], const float (&hi)[16], float scale) {
    const int t = threadIdx.x, i = t >> 2, part = t & 3, i0 = (part & 1) * 32 + (part >> 1) * 16;
    u32x4 w0, w1, w2, w3;
    w0.x = pack_bf16(lo[0] * scale, lo[1] * scale); w0.y = pack_bf16(lo[2] * scale, lo[3] * scale); w0.z = pack_bf16(lo[4] * scale, lo[5] * scale); w0.w = pack_bf16(lo[6] * scale, lo[7] * scale);
    w1.x = pack_bf16(lo[8] * scale, lo[9] * scale); w1.y = pack_bf16(lo[10] * scale, lo[11] * scale); w1.z = pack_bf16(lo[12] * scale, lo[13] * scale); w1.w = pack_bf16(lo[14] * scale, lo[15] * scale);
    w2.x = pack_bf16(hi[0] * scale, hi[1] * scale); w2.y = pack_bf16(hi[2] * scale, hi[3] * scale); w2.z = pack_bf16(hi[4] * scale, hi[5] * scale); w2.w = pack_bf16(hi[6] * scale, hi[7] * scale);
    w3.x = pack_bf16(hi[8] * scale, hi[9] * scale); w3.y = pack_bf16(hi[10] * scale, hi[11] * scale); w3.z = pack_bf16(hi[12] * scale, hi[13] * scale); w3.w = pack_bf16(hi[14] * scale, hi[15] * scale);
    LAS bf16_t* d = dst + i * LDK + i0;
    *(LAS u32x4*)d = w0; *(LAS u32x4*)(d + 8) = w1; *(LAS u32x4*)(d + 64) = w2; *(LAS u32x4*)(d + 72) = w3;
}
__device__ __forceinline__ void st_rows_T(LAS bf16_t* dst, const float (&lo)[16], const float (&hi)[16], float scale) {
    const int t = threadIdx.x, i = t >> 2, part = t & 3, i0 = (part & 1) * 32 + (part >> 1) * 16;
#pragma unroll
    for (int jj = 0; jj < 16; ++jj) { dst[(i0 + jj) * LDK + i] = f2bf(lo[jj] * scale); dst[(i0 + 64 + jj) * LDK + i] = f2bf(hi[jj] * scale); }
}
__device__ __forceinline__ void mma_128(const LAS bf16_t* A, const LAS bf16_t* B, f32x4 (&acc)[2][4], int wr, int wc, int lane) {
    const int fr = lane & 15, fq = lane >> 4;
#pragma unroll
    for (int ks = 0; ks < 4; ++ks) {
        bf16x8 a[2], b[4];
#pragma unroll
        for (int mt = 0; mt < 2; ++mt) a[mt] = *(const LAS bf16x8*)(A + (wr * 32 + mt * 16 + fr) * LDK + ks * 32 + fq * 8);
#pragma unroll
        for (int nt = 0; nt < 4; ++nt) b[nt] = *(const LAS bf16x8*)(B + (wc * 64 + nt * 16 + fr) * LDK + ks * 32 + fq * 8);
#pragma unroll
        for (int mt = 0; mt < 2; ++mt)
#pragma unroll
            for (int nt = 0; nt < 4; ++nt) acc[mt][nt] = __builtin_amdgcn_mfma_f32_16x16x32_bf16(a[mt], b[nt], acc[mt][nt], 0, 0, 0);
    }
}
typedef short v4i16_t __attribute__((ext_vector_type(4)));
__device__ __forceinline__ bf16x8 ld_tr8(const LAS bf16_t* S, int k0, int f0, int lane) {
    const int j = lane & 15;
    const LAS bf16_t* a = S + (k0 + 8 * (lane >> 4) + (j >> 2)) * LDK + f0 + 4 * (j & 3);
    const v4i16_t lo = __builtin_amdgcn_ds_read_tr16_b64_v4i16((LAS v4i16_t*)a), hi = __builtin_amdgcn_ds_read_tr16_b64_v4i16((LAS v4i16_t*)(a + 4 * LDK));
    return (bf16x8){lo[0], lo[1], lo[2], lo[3], hi[0], hi[1], hi[2], hi[3]};
}
__device__ __forceinline__ void mma_128_nt(const LAS bf16_t* A, const LAS bf16_t* Bt, f32x4 (&acc)[2][4], int wr, int wc, int lane) {
    const int fr = lane & 15, fq = lane >> 4;
#pragma unroll
    for (int ks = 0; ks < 4; ++ks) {
        bf16x8 a[2], b[4];
#pragma unroll
        for (int mt = 0; mt < 2; ++mt) a[mt] = *(const LAS bf16x8*)(A + (wr * 32 + mt * 16 + fr) * LDK + ks * 32 + fq * 8);
#pragma unroll
        for (int nt = 0; nt < 4; ++nt) b[nt] = ld_tr8(Bt, ks * 32, wc * 64 + nt * 16, lane);
#pragma unroll
        for (int mt = 0; mt < 2; ++mt)
#pragma unroll
            for (int nt = 0; nt < 4; ++nt) acc[mt][nt] = __builtin_amdgcn_mfma_f32_16x16x32_bf16(a[mt], b[nt], acc[mt][nt], 0, 0, 0);
    }
}
__device__ __forceinline__ void mma_128_tt2(const LAS bf16_t* At0, const LAS bf16_t* At1, const LAS bf16_t* Bt, f32x4 (&acc0)[2][4], f32x4 (&acc1)[2][4], int wr, int wc, int lane) {
#pragma unroll
    for (int ks = 0; ks < 4; ++ks) {
        bf16x8 a0[2], a1[2], b[4];
#pragma unroll
        for (int mt = 0; mt < 2; ++mt) { a0[mt] = ld_tr8(At0, ks * 32, wr * 32 + mt * 16, lane); a1[mt] = ld_tr8(At1, ks * 32, wr * 32 + mt * 16, lane); }
#pragma unroll
        for (int nt = 0; nt < 4; ++nt) b[nt] = ld_tr8(Bt, ks * 32, wc * 64 + nt * 16, lane);
#pragma unroll
        for (int mt = 0; mt < 2; ++mt)
#pragma unroll
            for (int nt = 0; nt < 4; ++nt) { acc0[mt][nt] = __builtin_amdgcn_mfma_f32_16x16x32_bf16(a0[mt], b[nt], acc0[mt][nt], 0, 0, 0); acc1[mt][nt] = __builtin_amdgcn_mfma_f32_16x16x32_bf16(a1[mt], b[nt], acc1[mt][nt], 0, 0, 0); }
    }
}
__device__ __forceinline__ void zero_acc(f32x4 (&acc)[2][4]) {
#pragma unroll
    for (int mt = 0; mt < 2; ++mt)
#pragma unroll
        for (int nt = 0; nt < 4; ++nt) acc[mt][nt] = (f32x4){0.f, 0.f, 0.f, 0.f};
}
__device__ __forceinline__ void wave_scan_sum2(float x0, float x1, float& p0, float& p1, float& total) {
    const int lane = threadIdx.x & 63; float s = x0 + x1, inc = s;
#pragma unroll
    for (int o = 1; o < 64; o <<= 1) { const float t = __shfl_up(inc, o, 64); if (lane >= o) inc += t; }
    const float exc = inc - s; p0 = exc + x0; p1 = exc + s; total = __shfl(inc, 63, 64);
}
__device__ __forceinline__ void wave_scan_max2(float x0, float x1, float& p0, float& p1) {
    const int lane = threadIdx.x & 63; const float m = fmaxf(x0, x1); float inc = m;
#pragma unroll
    for (int o = 1; o < 64; o <<= 1) { const float t = __shfl_up(inc, o, 64); if (lane >= o) inc = fmaxf(inc, t); }
    float exc = __shfl_up(inc, 1, 64); if (lane == 0) exc = -3.0e38f;
    p0 = fmaxf(exc, x0); p1 = fmaxf(exc, m);
}
__device__ __forceinline__ void ph_c1(const Params& p, LAS unsigned char* lds, int bid, int nblk) {
    const int tid = threadIdx.x, wid = tid >> 6, lane = tid & 63, wr = wid >> 1, wc = wid & 1, fr = lane & 15, fq = lane >> 4;
    LAS bf16_t* KsT = (LAS bf16_t*)(lds + LDS_WORK); LAS bf16_t* VsT0 = KsT + 128 * LDK; LAS bf16_t* VsT1 = VsT0 + 128 * LDK;
    LAS float* z = (LAS float*)(VsT1 + 128 * LDK);
    LAS float* lfA = z + 256; LAS float* igA = lfA + 256; LAS float* zmax = igA + 256;
    const bf16_t* P = (const bf16_t*)(p.ws + WS_P); const float* GT = (const float*)(p.ws + WS_GT); const float* ROPE = (const float*)(p.ws + WS_ROPE);
    float* ST = (float*)(p.ws + WS_ST); float* NST = (float*)(p.ws + WS_NST); float* MEND = (float*)(p.ws + WS_MEND); float* BEND = (float*)(p.ws + WS_BEND);
    for (int u = bid; u < NB * NCHUNK * 4 * 2; u += nblk) {
        int mixer, h, ch, b, row0; unit_decode(u, mixer, h, ch, b, row0);
        const int colQ = mixer * 2048 + h * 128;
        u32x2 rawK[8], rawV[8]; ld_raw(P, row0, colQ + 512, rawK); ld_raw(P, row0, colQ + 1024, rawV);
        if (mixer == 0) {
            if (tid < 256) { const int dir = tid >> 7, j = tid & 127; const float lg = p.in[I_CLG][dir * 4 + h]; z[tid] = fexp(lg * (float)(dir == 0 ? 127 - j : j)); }
        } else {
            if (tid < 256) { const int dir = tid >> 7, j = tid & 127, row = row0 + j;
                igA[tid] = GT[row * 16 + dir * 4 + h] + p.in[I_DIB][dir * 4 + h];
                lfA[tid] = -softplusf(-(GT[row * 16 + 8 + dir * 4 + h] + p.in[I_DFB][dir * 4 + h])); }
            __syncthreads();
            if (tid < 128) { const int dir = tid >> 6, j0 = 2 * lane, j1 = j0 + 1;
                const float l0 = lfA[dir * 128 + j0], l1 = lfA[dir * 128 + j1], g0 = igA[dir * 128 + j0], g1 = igA[dir * 128 + j1];
                float r0, r1, total; wave_scan_sum2(l0, l1, r0, r1, total);
                const float w0 = (dir == 0 ? total - r0 : r0 - l0) + g0, w1 = (dir == 0 ? total - r1 : r1 - l1) + g1;
                const float mx = wave_max(fmaxf(w0, w1));
                z[dir * 128 + j0] = fexp(w0 - mx); z[dir * 128 + j1] = fexp(w1 - mx);
                const int sid = sid_of(1, dir, b, ch, h);
                if (lane == 0) { MEND[sid] = mx; BEND[sid] = total; }
                float* CB = (float*)(p.ws + WS_CB) + (size_t)sid * 128; float* CMI = (float*)(p.ws + WS_CMI) + (size_t)sid * 128;
                if (dir == 0) { float m0, m1; wave_scan_max2(g0 - r0, g1 - r1, m0, m1); CB[j0] = r0; CB[j1] = r1; CMI[j0] = r0 + m0; CMI[j1] = r1 + m1; }
                else { const float s0 = total - r0 + l0, s1 = total - r1 + l1;
                    lfA[128 + j0] = g0 - s0; lfA[128 + j1] = g1 - s1; igA[128 + j0] = s0; igA[128 + j1] = s1; CB[j0] = s0; CB[j1] = s1;
                    asm volatile("s_waitcnt lgkmcnt(0)" ::: "memory");
                    const int q0 = 127 - 2 * lane, q1 = q0 - 1; float m0, m1; wave_scan_max2(lfA[128 + q0], lfA[128 + q1], m0, m1);
                    CMI[q0] = igA[128 + q0] + m0; CMI[q1] = igA[128 + q1] + m1; } }
        }
        __syncthreads();
        {
            float lo[16], hi[16];
            cvt_rows(rawK, mixer == 0 && ch >= 2, (ch - 2) * 128, ROPE, lo, hi);
            st_rows(KsT, lo, hi, 0.08838834764831845f);
            cvt_rows(rawV, false, 0, ROPE, lo, hi);
            const int i = tid >> 2;
            st_rows(VsT0, lo, hi, z[i]); st_rows(VsT1, lo, hi, z[128 + i]);
        }
        __syncthreads();
        f32x4 accd[2][2][4]; zero_acc(accd[0]); zero_acc(accd[1]);
        mma_128_tt2(VsT0, VsT1, KsT, accd[0], accd[1], wr, wc, lane);
#pragma unroll
        for (int dir = 0; dir < 2; ++dir) {
            bf16_t* dst = (bf16_t*)ST + (size_t)sid_of(mixer, dir, b, ch, h) * 16384;
#pragma unroll
            for (int mt = 0; mt < 2; ++mt)
#pragma unroll
                for (int nt = 0; nt < 4; ++nt)
#pragma unroll
                    for (int r = 0; r < 4; ++r) dst[(wr * 32 + mt * 16 + fq * 4 + r) * 128 + wc * 64 + nt * 16 + fr] = f2bf(accd[dir][mt][nt][r]);
        }
        if (mixer == 1 && tid < 256) { const int dir = tid >> 7, dd = tid & 127; float s = 0.f;
            for (int j = 0; j < 128; ++j) s += z[dir * 128 + j] * bf2f(KsT[j * LDK + dd]);
            NST[(size_t)sid_of(1, dir, b, ch, h) * 128 + dd] = s; }
        __syncthreads();
    }
}
__device__ __forceinline__ void ph_c2(const Params& p, int bid, int nblk) {
    const int tid = threadIdx.x;
    float* ST = (float*)(p.ws + WS_ST); float* NST = (float*)(p.ws + WS_NST); bf16_t* STB = (bf16_t*)(p.ws + WS_STB);
    const float* MEND = (const float*)(p.ws + WS_MEND); const float* BEND = (const float*)(p.ws + WS_BEND); float* MPREV = (float*)(p.ws + WS_MPREV);
    for (int item = bid; item < 256; item += nblk) {
        const int mixer = item >> 7, chain = (item >> 2) & 31, slab = item & 3, dir = chain >> 4, b = (chain >> 2) & 3, h = chain & 3;
        const int idx = slab * 4096 + tid * 8;
        float st[8];
#pragma unroll
        for (int i = 0; i < 8; ++i) st[i] = 0.f;
        const float gdec = mixer == 0 ? fexp(p.in[I_CLG][dir * 4 + h] * 128.0f) : 0.f;
        const bool do_n = mixer == 1 && slab == 0 && tid < 128;
        float m = -__builtin_inff(), n = 0.f;
#pragma unroll 1
        for (int k0 = 0; k0 < NCHUNK; k0 += 17) {
            u32x4 kv[17]; float nv[17];
#pragma unroll
            for (int k = 0; k < 17; ++k) { const int kk = k0 + k, ch = dir == 0 ? kk : (kk < 2 ? 1 - kk : 35 - kk); const int sid = sid_of(mixer, dir, b, ch, h);
                kv[k] = *(const u32x4*)((const bf16_t*)ST + (size_t)sid * 16384 + idx); nv[k] = do_n ? NST[(size_t)sid * 128 + tid] : 0.f; }
#pragma unroll
            for (int k = 0; k < 17; ++k) { const int kk = k0 + k, ch = dir == 0 ? kk : (kk < 2 ? 1 - kk : 35 - kk); const int sid = sid_of(mixer, dir, b, ch, h);
                u32x4 q;
#pragma unroll
                for (int i = 0; i < 4; ++i) q[i] = pack_bf16(st[2 * i], st[2 * i + 1]);
                *(u32x4*)(STB + (size_t)sid * 16384 + idx) = q;
                float so = gdec, sn = 1.0f;
                if (mixer == 1) { const float me = MEND[sid], be = BEND[sid], mnew = fmaxf(be + m, me); so = fexp(be + m - mnew); sn = fexp(me - mnew);
                    if (do_n) { NST[(size_t)sid * 128 + tid] = n; n = n * so + nv[k] * sn; }
                    if (slab == 0 && tid == 0) MPREV[sid] = m;
                    m = mnew; }
#pragma unroll
                for (int i = 0; i < 8; ++i) { const unsigned wv = kv[k][i >> 1]; st[i] = st[i] * so + __uint_as_float((i & 1) ? (wv & 0xffff0000u) : (wv << 16)) * sn; } }
        }
    }
}
template <int mixer>
__device__ __forceinline__ void c3_unit(const Params& p, LAS unsigned char* lds, int h, int ch, int b, int row0) {
    int tid_ = threadIdx.x; asm volatile("" : "+v"(tid_));
    const int tid = tid_, wid = tid >> 6, lane = tid & 63, wr = wid >> 1, wc = wid & 1, fr = lane & 15, fq = lane >> 4;
    LAS bf16_t* Qs = (LAS bf16_t*)(lds + LDS_WORK); LAS bf16_t* Ks = Qs + 128 * LDK; LAS bf16_t* VsT = Ks + 128 * LDK; LAS bf16_t* RT = VsT + 128 * LDK;
    LAS float* fa = (LAS float*)(RT + 128 * LDK);
    LAS float* lfA = fa; LAS float* igA = fa + 256; LAS float* bA = fa + 512; LAS float* miA = fa + 768; LAS float* mtA = fa + 1024; LAS float* sintA = fa + 1280;
    LAS float* rowsum = fa + 1536; LAS float* qn = fa + 2048; LAS float* nA = fa + 2304;
    LAS float* Os = (LAS float*)Qs;
    LAS bf16_t* Pm = Ks;
    const bf16_t* P = (const bf16_t*)(p.ws + WS_P); const float* GT = (const float*)(p.ws + WS_GT); const float* ROPE = (const float*)(p.ws + WS_ROPE);
    const bf16_t* STB = (const bf16_t*)(p.ws + WS_STB); const float* NST = (const float*)(p.ws + WS_NST); const float* MPREV = (const float*)(p.ws + WS_MPREV);
    bf16_t* Y = (bf16_t*)(p.ws + WS_YMIX);
    {
        const int colQ = mixer * 2048 + h * 128; const bool rope = mixer == 0 && ch >= 2;
        {
            u32x2 rawQ[8], rawK[8], rawV[8]; ld_raw(P, row0, colQ, rawQ); ld_raw(P, row0, colQ + 512, rawK); ld_raw(P, row0, colQ + 1024, rawV);
            float lo[16], hi[16];
            cvt_rows(rawQ, rope, (ch - 2) * 128, ROPE, lo, hi); st_rows(Qs, lo, hi, 1.0f);
            cvt_rows(rawK, rope, (ch - 2) * 128, ROPE, lo, hi); st_rows(Ks, lo, hi, 0.08838834764831845f);
            cvt_rows(rawV, false, 0, ROPE, lo, hi); st_rows(VsT, lo, hi, 1.0f);
        }
        if (mixer == 1) {
            if (tid < 256) { const int dir = tid >> 7, j = tid & 127, row = row0 + j;
                igA[tid] = GT[row * 16 + dir * 4 + h] + p.in[I_DIB][dir * 4 + h];
                nA[tid] = NST[(size_t)sid_of(1, dir, b, ch, h) * 128 + j];
                bA[tid] = ((const float*)(p.ws + WS_CB))[(size_t)sid_of(1, dir, b, ch, h) * 128 + j]; miA[tid] = ((const float*)(p.ws + WS_CMI))[(size_t)sid_of(1, dir, b, ch, h) * 128 + j]; }
            __syncthreads();
            __syncthreads();
            if (tid < 256) { const int dir = tid >> 7, i = tid & 127; const float mprev = MPREV[sid_of(1, dir, b, ch, h)];
                const float gi = bA[tid] + mprev, mt = fmaxf(gi, miA[tid]); mtA[tid] = mt; sintA[tid] = fexp(gi - mt);
                float s = 0.f;
                for (int d0 = 0; d0 < 128; ++d0) s += bf2f(Qs[i * LDK + d0]) * nA[dir * 128 + d0];
                qn[tid] = s; }
        }
        __syncthreads();
        f32x4 S[2][4]; zero_acc(S);
        mma_128(Qs, Ks, S, wr, wc, lane);
        __syncthreads();
        f32x4 O[2][4]; zero_acc(O);
        if (mixer == 0) {
            const float lg0 = p.in[I_CLG][h], lg1 = p.in[I_CLG][4 + h];
#pragma unroll
            for (int mt = 0; mt < 2; ++mt)
#pragma unroll
                for (int nt = 0; nt < 4; ++nt)
#pragma unroll
                    for (int r = 0; r < 4; ++r) { const int i = wr * 32 + mt * 16 + fq * 4 + r, j = wc * 64 + nt * 16 + fr;
                        const float dcy = (i >= j ? fexp(lg0 * (float)(i - j)) : 0.f) + (j >= i ? fexp(lg1 * (float)(j - i)) : 0.f);
                        Pm[i * LDK + j] = f2bf(S[mt][nt][r] * dcy); }
            __syncthreads();
            mma_128_nt(Pm, VsT, O, wr, wc, lane);
#pragma unroll
            for (int dir = 0; dir < 2; ++dir) {
                { const bf16_t* src = STB + (size_t)sid_of(0, dir, b, ch, h) * 16384 + (tid >> 2) * 128 + (tid & 3) * 32; LAS bf16_t* d = RT + (tid >> 2) * LDK + (tid & 3) * 32;
#pragma unroll
                    for (int q = 0; q < 4; ++q) *(LAS u32x4*)(d + q * 8) = *(const u32x4*)(src + q * 8); }
                __syncthreads();
                f32x4 T[2][4]; zero_acc(T);
                mma_128(Qs, RT, T, wr, wc, lane);
#pragma unroll
                for (int mt = 0; mt < 2; ++mt)
#pragma unroll
                    for (int r = 0; r < 4; ++r) { const int i = wr * 32 + mt * 16 + fq * 4 + r; const float xi = dir == 0 ? fexp(lg0 * (float)(i + 1)) : fexp(lg1 * (float)(128 - i));
#pragma unroll
                        for (int nt = 0; nt < 4; ++nt) O[mt][nt][r] += xi * T[mt][nt][r]; }
                __syncthreads();
            }
        } else {
#pragma unroll
            for (int dir = 0; dir < 2; ++dir) {
                float rp[2][4];
#pragma unroll
                for (int mt = 0; mt < 2; ++mt)
#pragma unroll
                    for (int r = 0; r < 4; ++r) { const int i = wr * 32 + mt * 16 + fq * 4 + r; const float bi = bA[dir * 128 + i] - mtA[dir * 128 + i]; float acc = 0.f;
#pragma unroll
                        for (int nt = 0; nt < 4; ++nt) { const int j = wc * 64 + nt * 16 + fr; const bool valid = dir == 0 ? (j <= i) : (j >= i);
                            const float e = valid ? fexp(bi - bA[dir * 128 + j] + igA[dir * 128 + j]) : 0.f; const float pv = S[mt][nt][r] * e;
                            Pm[i * LDK + j] = f2bf(pv); acc += pv; }
                        rp[mt][r] = row16_sum(acc); }
                if (fr == 0) {
#pragma unroll
                    for (int mt = 0; mt < 2; ++mt)
#pragma unroll
                        for (int r = 0; r < 4; ++r) rowsum[wc * 256 + dir * 128 + wr * 32 + mt * 16 + fq * 4 + r] = rp[mt][r];
                }
                { const bf16_t* src = STB + (size_t)sid_of(1, dir, b, ch, h) * 16384 + (tid >> 2) * 128 + (tid & 3) * 32; LAS bf16_t* d = RT + (tid >> 2) * LDK + (tid & 3) * 32;
#pragma unroll
                    for (int q = 0; q < 4; ++q) *(LAS u32x4*)(d + q * 8) = *(const u32x4*)(src + q * 8); }
                __syncthreads();
                f32x4 T[2][4]; zero_acc(T);
                mma_128(Qs, RT, T, wr, wc, lane);
#pragma unroll
                for (int mt = 0; mt < 2; ++mt)
#pragma unroll
                    for (int r = 0; r < 4; ++r) { const float si = sintA[dir * 128 + wr * 32 + mt * 16 + fq * 4 + r];
#pragma unroll
                        for (int nt = 0; nt < 4; ++nt) T[mt][nt][r] *= si; }
                mma_128_nt(Pm, VsT, T, wr, wc, lane);
#pragma unroll
                for (int mt = 0; mt < 2; ++mt)
#pragma unroll
                    for (int r = 0; r < 4; ++r) { const int i = wr * 32 + mt * 16 + fq * 4 + r; const float si = sintA[dir * 128 + i];
                        float den = (rowsum[dir * 128 + i] + rowsum[256 + dir * 128 + i]) + qn[dir * 128 + i] * si; den = fmaxf(fabsf(den), fexp(-mtA[dir * 128 + i])); const float rden = frcp(den);
#pragma unroll
                        for (int nt = 0; nt < 4; ++nt) O[mt][nt][r] += T[mt][nt][r] * rden; }
                __syncthreads();
            }
        }
#pragma unroll
        for (int mt = 0; mt < 2; ++mt)
#pragma unroll
            for (int nt = 0; nt < 4; ++nt)
#pragma unroll
                for (int r = 0; r < 4; ++r) Os[(wr * 32 + mt * 16 + fq * 4 + r) * 132 + wc * 64 + nt * 16 + fr] = O[mt][nt][r];
        __syncthreads();
        {
            const float* gng = (mixer == 0 ? p.in[I_CGNG] : p.in[I_DGNG]) + h * 128; const float* gnb = (mixer == 0 ? p.in[I_CGNB] : p.in[I_DGNB]) + h * 128;
            const float g0 = gng[lane], g1 = gng[lane + 64], b0 = gnb[lane], b1 = gnb[lane + 64];
#pragma unroll 1
            for (int i4 = 0; i4 < 16; i4 += 4) {
                float qg0[4], qg1[4];
#pragma unroll
                for (int u = 0; u < 4; ++u) { const int row = row0 + wid * 16 + i4 + u; qg0[u] = bf2f(P[(size_t)row * LDP1 + colQ + 1536 + lane]); qg1[u] = bf2f(P[(size_t)row * LDP1 + colQ + 1536 + 64 + lane]); }
#pragma unroll
                for (int u = 0; u < 4; ++u) { const int i = wid * 16 + i4 + u, row = row0 + i;
                    const float x0 = Os[i * 132 + lane], x1 = Os[i * 132 + 64 + lane];
                    const float mean = wave_sum(x0 + x1) * (1.0f / 128.0f), d0 = x0 - mean, d1 = x1 - mean;
                    const float rstd = rsqrtf(wave_sum(d0 * d0 + d1 * d1) * (1.0f / 128.0f) + LN_EPS);
                    const float q0 = qg0[u], q1 = qg1[u];
                    const float s0 = sigm(q0), s1 = sigm(q1);
                    const float y0 = (d0 * rstd * g0 + b0) * (mixer == 0 ? q0 * s0 : s0), y1 = (d1 * rstd * g1 + b1) * (mixer == 0 ? q1 * s1 : s1);
                    Y[(size_t)row * 1024 + mixer * 512 + h * 128 + lane] = f2bf(y0); Y[(size_t)row * 1024 + mixer * 512 + h * 128 + 64 + lane] = f2bf(y1); }
            }
        }
        __syncthreads();
    }
}
__device__ __forceinline__ void ph_c3(const Params& p, LAS unsigned char* lds, int bid, int nblk) {
    for (int u2 = bid; u2 < NB * 32 * 4; u2 += nblk) {
        const int h = u2 & 3, rest = u2 >> 2, ch = 2 + (rest & 31), b = rest >> 5, row0 = NCTX + b * 4096 + (ch - 2) * 128;
        c3_unit<0>(p, lds, h, ch, b, row0);
    }
    for (int u2 = nblk - 1 - bid; u2 < NB * 32 * 4; u2 += nblk) {
        const int h = u2 & 3, rest = u2 >> 2, ch = 2 + (rest & 31), b = rest >> 5, row0 = NCTX + b * 4096 + (ch - 2) * 128;
        c3_unit<1>(p, lds, h, ch, b, row0);
    }
}
constexpr int NPHASE = 23;
__global__ void __launch_bounds__(NTHR, 2) fwd(Params p) {
    extern __shared__ __attribute__((aligned(16))) unsigned char smem_raw[];
    LAS unsigned char* lds = (LAS unsigned char*)smem_raw;
    if (threadIdx.x == 0) { LAS unsigned* st = (LAS unsigned*)(lds + LDS_BAR); st[0] = 0u; st[1] = 0u; st[2] = 0u; st[3] = 0u; }
    __syncthreads();
    XcdBarrier bar = xcd_barrier_post((unsigned*)(p.ws + WS_CTL), (volatile LAS unsigned*)(lds + LDS_BAR));
    const int bid = blockIdx.x, nblk = gridDim.x;
    unsigned char* ws = p.ws;
#ifndef PHASE_ONLY
#define PHASE_ONLY -1
#endif
#ifndef DBL_MASK
#define DBL_MASK 0u
#endif
#define PHASE(k, call) if constexpr (PHASE_ONLY < 0 || PHASE_ONLY == (k)) { if (p.lo <= (k) && (k) < p.hi) { call; if constexpr ((DBL_MASK >> (k)) & 1u) { xcd_barrier(bar); call; } if ((k) + 1 < p.hi) xcd_barrier(bar); } }
    PHASE(0, (ph_prologue(p, lds, bid, nblk), __syncthreads(), moe_weight_tiles(p, lds, bid, nblk, CVT_EARLY)))
    PHASE(1, ph_mod_in(p, bid, nblk))
    PHASE(2, ph_gemm_dense<12>(lds, (const bf16_t*)(ws + WS_H), (const bf16_t*)(ws + WS_WIN0T), (bf16_t*)(ws + WS_P), LDP0, 0, 68, bid, nblk))
    PHASE(3, ph_prep_even(p, lds, bid, nblk))
    PHASE(4, ph_r1(p, lds, bid, nblk))
    PHASE(5, ph_r2(p, lds, bid, nblk))
    PHASE(6, ph_fin_even(p, bid, nblk))
    PHASE(7, ph_gemm_dense<4>(lds, (const bf16_t*)(ws + WS_YMIX), (const bf16_t*)(ws + WS_WOUTT), (bf16_t*)(ws + WS_YP), 1024, 0, 68, bid, nblk))
    PHASE(8, ph_ln1<0>(p, lds, bid, nblk))
    PHASE(9, ph_moe_gather<0>(p, lds, bid, nblk))
    PHASE(10, ph_moe_gemm1<0>(p, lds, bid, nblk))
    PHASE(11, ph_moe_gemm2<0>(p, lds, bid, nblk))
    PHASE(12, ph_ln2<0>(p, lds, bid, nblk))
    PHASE(13, ph_gemm_dense<16>(lds, (const bf16_t*)(ws + WS_H), (const bf16_t*)(ws + WS_WIN1T), (bf16_t*)(ws + WS_P), LDP1, 0, 68, bid, nblk))
    PHASE(14, ph_c1(p, lds, bid, nblk))
    PHASE(15, ph_c2(p, bid, nblk))
    PHASE(16, ph_c3(p, lds, bid, nblk))
    PHASE(17, ph_gemm_dense<4>(lds, (const bf16_t*)(ws + WS_YMIX), (const bf16_t*)(ws + WS_WOUTT) + (size_t)1024 * 1024, (bf16_t*)(ws + WS_YP), 1024, 4, 64, bid, nblk))
    PHASE(18, ph_ln1<1>(p, lds, bid, nblk))
    PHASE(19, ph_moe_gather<1>(p, lds, bid, nblk))
    PHASE(20, ph_moe_gemm1<1>(p, lds, bid, nblk))
    PHASE(21, ph_moe_gemm2<1>(p, lds, bid, nblk))
    PHASE(22, ph_ln2<1>(p, lds, bid, nblk))
#undef PHASE
}

#ifndef MK_ONE_LAUNCH
#define MK_ONE_LAUNCH 1
#endif
extern "C" void kernel_launch(void* const* d_in, const int* in_sizes, int n_in, void* d_out, int out_size, void* d_ws, size_t ws_size, hipStream_t stream) {
    static int grid = 0;
    if (grid == 0) {
        if (n_in != N_INPUTS || out_size != NB * SEQL * DM || ws_size < WS_TOTAL) { fprintf(stderr, "kernel_launch: unexpected problem (n_in %d, out %d, ws %zu < %zu)\n", n_in, out_size, ws_size, (size_t)WS_TOTAL); grid = -1; return; }
        int dev = 0, cus = 0, per_cu = 0;
        if (hipGetDevice(&dev) != hipSuccess || hipDeviceGetAttribute(&cus, hipDeviceAttributeMultiprocessorCount, dev) != hipSuccess) { grid = -1; return; }
        if (hipFuncSetAttribute((const void*)fwd, hipFuncAttributeMaxDynamicSharedMemorySize, LDS_BYTES) != hipSuccess) { fprintf(stderr, "kernel_launch: hipFuncSetAttribute failed\n"); grid = -1; return; }
        if (hipOccupancyMaxActiveBlocksPerMultiprocessor(&per_cu, (const void*)fwd, NTHR, LDS_BYTES) != hipSuccess || per_cu < 1) { fprintf(stderr, "kernel_launch: occupancy query says %d\n", per_cu); (void)hipGetLastError(); per_cu = 1; }
        grid = cus;
    }
    if (grid < 0) return;
    (void)hipMemsetAsync((char*)d_ws + WS_CTL, 0, CTL_BYTES, stream);
    Params p{};
    for (int i = 0; i < N_INPUTS; ++i) p.in[i] = (const float*)d_in[i];
    p.out = (float*)d_out; p.ws = (unsigned char*)d_ws;
#if MK_ONE_LAUNCH
    p.lo = 0; p.hi = NPHASE;
    hipLaunchKernelGGL(fwd, dim3(grid), dim3(NTHR), LDS_BYTES, stream, p);
#else
    for (int k = 0; k < NPHASE; ++k) { p.lo = k; p.hi = k + 1; hipLaunchKernelGGL(fwd, dim3(grid), dim3(NTHR), LDS_BYTES, stream, p); }
#endif
}
```
